# Optimizing an MI355X kernel written in HIP

```python
import jax, jax.numpy as jnp
from jax import lax
import numpy as np

D_MODEL = 1024
BATCH = 2
SEQ = 8192
DEPTH = 2

CTX_LEN = 256
GRID_W = 64
D_MIX = D_MODEL
RET_DIM = D_MIX // 2
DIFF_DIM = D_MIX - RET_DIM
RET_HEADS = 4
RET_HEAD_DIM = RET_DIM // RET_HEADS
DIFF_HEADS = 4
DIFF_V_HEAD = DIFF_DIM // DIFF_HEADS
DIFF_QK_HEAD = DIFF_V_HEAD // 2
D_PROJ = 4 * RET_DIM + 3 * DIFF_DIM
PROJ_SPLITS = [RET_DIM, 2 * RET_DIM, 3 * RET_DIM, 4 * RET_DIM, 4 * RET_DIM + DIFF_DIM, 4 * RET_DIM + 2 * DIFF_DIM]
CHUNK = 128
Q_BLOCK = 128
D_FF = 2816
N_EXPERTS = 8
TOP_K = 2
N_DENSE = (DEPTH + 1) // 2
N_MOE = DEPTH // 2
ROPE_BASE = 10000.0
EPS = 1e-6

kernel_name = "hymba_retnet_diffattn_moe_prefix_block"


def rms_norm(x, g):
    xf = x.astype(jnp.float32)
    y = xf * lax.rsqrt(jnp.mean(xf * xf, axis=-1, keepdims=True) + EPS)
    return (y * g.astype(jnp.float32)).astype(x.dtype)


def modulate(h, shift, scale):
    return h * (1.0 + scale) + shift


def axial_rope(row_pos, col_pos, dim):
    n_freq = dim // 4
    inv_freq = ROPE_BASE ** (-jnp.arange(n_freq, dtype=jnp.float32) / n_freq)
    ang = jnp.concatenate([row_pos[:, None] * inv_freq, col_pos[:, None] * inv_freq], axis=-1)
    ang = jnp.concatenate([ang, ang], axis=-1)
    return jnp.cos(ang), jnp.sin(ang)


def apply_rope(x, cos, sin):
    half = x.shape[-1] // 2
    xf = x.astype(jnp.float32)
    rot = jnp.concatenate([-xf[..., half:], xf[..., :half]], axis=-1)
    return (xf * cos + rot * sin).astype(x.dtype)


def to_heads(a, n_heads):
    b, t, _ = a.shape
    return a.reshape(b, t, n_heads, -1).transpose(0, 2, 1, 3)


def retention_chunkwise(q, k, v, log_gamma, s0):
    b, h, t, dk = q.shape
    dv = v.shape[-1]
    n = t // CHUNK
    qc = q.astype(jnp.float32).reshape(b, h, n, CHUNK, dk)
    kc = k.astype(jnp.float32).reshape(b, h, n, CHUNK, dk)
    vc = v.astype(jnp.float32).reshape(b, h, n, CHUNK, dv)
    pos = jnp.arange(CHUNK, dtype=jnp.float32)
    rel = pos[:, None] - pos[None, :]
    dmat = jnp.where(rel >= 0, jnp.exp(log_gamma[:, None, None] * jnp.maximum(rel, 0.0)), 0.0)
    scores = jnp.einsum('bhncd,bhnmd->bhncm', qc, kc) * dmat[None, :, None]
    o_inner = jnp.einsum('bhncm,bhnme->bhnce', scores, vc)
    lg = log_gamma[:, None]
    zeta = jnp.exp(lg * (CHUNK - 1.0 - pos))
    xi = jnp.exp(lg * (pos + 1.0))
    kv = jnp.einsum('bhnmd,bhnme->nbhde', kc * zeta[None, :, None, :, None], vc)
    chunk_decay = jnp.exp(log_gamma * CHUNK)[None, :, None, None]

    def step(s, kv_n):
        return chunk_decay * s + kv_n, s

    s_final, s_prev = lax.scan(step, s0.astype(jnp.float32), kv)
    o_cross = jnp.einsum('bhncd,nbhde->bhnce', qc * xi[None, :, None, :, None], s_prev)
    return (o_inner + o_cross).reshape(b, h, t, dv), s_final


def retention_final_state(k, v, log_gamma):
    t = k.shape[2]
    w = jnp.exp(log_gamma[:, None] * (t - 1.0 - jnp.arange(t, dtype=jnp.float32)))
    return jnp.einsum('bhtd,bhte->bhde', k.astype(jnp.float32) * w[None, :, :, None], v.astype(jnp.float32))


def retention_out(y, gproj, gn_g):
    b, h, t, dv = y.shape
    mu = jnp.mean(y, axis=-1, keepdims=True)
    yc = y - mu
    yn = yc * lax.rsqrt(jnp.mean(yc * yc, axis=-1, keepdims=True) + EPS)
    yn = yn.transpose(0, 2, 1, 3).reshape(b, t, h * dv) * gn_g.astype(jnp.float32)
    return (jax.nn.silu(gproj.astype(jnp.float32)) * yn).astype(gproj.dtype)


def diff_qk(p, g):
    b, t, _ = p.shape
    a = p.reshape(b, t, DIFF_HEADS, 2, DIFF_QK_HEAD).transpose(0, 2, 3, 1, 4)
    return rms_norm(a, g)


def diff_attend(q, k, v, lam):
    b, h, _, tq, d = q.shape
    dv = v.shape[-1]
    nb = tq // Q_BLOCK
    qb = jnp.moveaxis(q.reshape(b, h, 2, nb, Q_BLOCK, d), 3, 0)

    def block(qi):
        s = jnp.einsum('bhcqd,bhckd->bhcqk', qi, k).astype(jnp.float32)
        p = jax.nn.softmax(s, axis=-1)
        a = p[:, :, 0] - lam * p[:, :, 1]
        return jnp.einsum('bhqk,bhkv->bhqv', a.astype(v.dtype), v)

    o = lax.map(block, qb)
    return jnp.moveaxis(o, 0, 2).reshape(b, h, tq, dv)


def diff_post(o, g, lam_init):
    b, h, t, dv = o.shape
    y = rms_norm(o, g) * (1.0 - lam_init)
    return y.transpose(0, 2, 1, 3).reshape(b, t, h * dv)


def hybrid_mixer(h, hc, w_in, dec_f, dec_b, gn_g, qn_g, kn_g, lq1, lk1, lq2, lk2, subln_g, w_out,
                 lam_init, cos, sin, ctx_out):
    rq, rk, rv, rg, dq, dk, dv = jnp.split(h @ w_in, PROJ_SPLITS, axis=-1)
    if ctx_out:
        rqc, rkc, rvc, rgc, dqc, dkc, dvc = jnp.split(hc @ w_in, PROJ_SPLITS, axis=-1)
    else:
        rkc, rvc = jnp.split(hc @ w_in[:, RET_DIM:3 * RET_DIM], 2, axis=-1)
        dkc, dvc = jnp.split(hc @ w_in[:, 4 * RET_DIM + DIFF_DIM:], 2, axis=-1)

    lg_f = jax.nn.log_sigmoid(dec_f.astype(jnp.float32))
    lg_b = jax.nn.log_sigmoid(dec_b.astype(jnp.float32))
    k_scale = RET_HEAD_DIM ** -0.5
    flip = lambda a: jnp.flip(a, axis=2)
    ql, kl, vl = to_heads(rq, RET_HEADS), to_heads(rk, RET_HEADS) * k_scale, to_heads(rv, RET_HEADS)
    kc_r, vc_r = to_heads(rkc, RET_HEADS) * k_scale, to_heads(rvc, RET_HEADS)
    if ctx_out:
        qc_r = to_heads(rqc, RET_HEADS)
        zeros = jnp.zeros((hc.shape[0], RET_HEADS, RET_HEAD_DIM, RET_HEAD_DIM), jnp.float32)
        oc_f, sc_f = retention_chunkwise(qc_r, kc_r, vc_r, lg_f, zeros)
        oc_b, sc_b = retention_chunkwise(flip(qc_r), flip(kc_r), flip(vc_r), lg_b, zeros)
        ret_c = retention_out(oc_f + flip(oc_b), rgc, gn_g)
    else:
        sc_f = retention_final_state(kc_r, vc_r, lg_f)
        sc_b = retention_final_state(flip(kc_r), flip(vc_r), lg_b)
    o_f, _ = retention_chunkwise(ql, kl, vl, lg_f, sc_f)
    o_b, _ = retention_chunkwise(flip(ql), flip(kl), flip(vl), lg_b, sc_b)
    ret = retention_out(o_f + flip(o_b), rg, gn_g)

    f32 = jnp.float32
    lam = (jnp.exp(jnp.sum(lq1.astype(f32) * lk1.astype(f32)))
           - jnp.exp(jnp.sum(lq2.astype(f32) * lk2.astype(f32))) + lam_init)
    q_scale = DIFF_QK_HEAD ** -0.5
    qd = apply_rope(diff_qk(dq, qn_g), cos, sin) * q_scale
    kd = apply_rope(diff_qk(dk, kn_g), cos, sin)
    vd = to_heads(dv, DIFF_HEADS)
    kdc = diff_qk(dkc, kn_g)
    vdc = to_heads(dvc, DIFF_HEADS)
    k_all = jnp.concatenate([kdc, kd], axis=3)
    v_all = jnp.concatenate([vdc, vd], axis=2)
    diff = diff_post(diff_attend(qd, k_all, v_all, lam), subln_g, lam_init)
    out = jnp.concatenate([ret, diff], axis=-1) @ w_out
    if ctx_out:
        qdc = diff_qk(dqc, qn_g) * q_scale
        diff_c = diff_post(diff_attend(qdc, kdc, vdc, lam), subln_g, lam_init)
        out_c = jnp.concatenate([ret_c, diff_c], axis=-1) @ w_out
        return out, out_c
    return out, None


def swiglu(h, wg, wu, wd):
    return (jax.nn.silu(h @ wg) * (h @ wu)) @ wd


def moe_swiglu(h, rw, rb, wg, wu, wd):
    shp = h.shape
    t = h.reshape(-1, shp[-1])
    logits = (t @ rw).astype(jnp.float32) + rb.astype(jnp.float32)
    top_v, top_i = lax.top_k(logits, TOP_K)
    top_w = jax.nn.softmax(top_v, axis=-1)
    gates = jnp.sum(jax.nn.one_hot(top_i, N_EXPERTS, dtype=jnp.float32) * top_w[..., None], axis=1)
    y = jnp.zeros_like(t)
    for e in range(N_EXPERTS):
        y = y + gates[:, e:e + 1].astype(t.dtype) * swiglu(t, wg[e], wu[e], wd[e])
    return y.reshape(shp)


def setup_inputs(seed: int = 0) -> dict:
    key = jax.random.key(seed)
    ks = jax.random.split(key, 28)
    nrm = jax.random.normal
    f32 = jnp.float32
    base_decay = jnp.log(2.0 ** (5.0 + jnp.arange(RET_HEADS, dtype=f32)) - 1.0)
    return {
        "x": nrm(ks[0], (BATCH, SEQ, D_MODEL), f32),
        "c": nrm(ks[1], (BATCH, D_MODEL), f32),
        "ctx": nrm(ks[2], (BATCH, CTX_LEN, D_MODEL), f32),
        "c_ctx": nrm(ks[3], (D_MODEL,), f32),
        "ada_w": nrm(ks[4], (DEPTH, D_MODEL, 6 * D_MODEL), f32) * D_MODEL ** -0.5,
        "ada_b": nrm(ks[5], (DEPTH, 6 * D_MODEL), f32) * 0.02,
        "norm1_g": 1.0 + 0.02 * nrm(ks[6], (DEPTH, D_MODEL), f32),
        "norm2_g": 1.0 + 0.02 * nrm(ks[7], (DEPTH, D_MODEL), f32),
        "w_in": nrm(ks[8], (DEPTH, D_MODEL, D_PROJ), f32) * D_MODEL ** -0.5,
        "ret_decay_fwd": base_decay + 0.05 * nrm(ks[9], (DEPTH, RET_HEADS), f32),
        "ret_decay_bwd": base_decay + 0.05 * nrm(ks[10], (DEPTH, RET_HEADS), f32),
        "ret_gn_g": 1.0 + 0.02 * nrm(ks[11], (DEPTH, RET_DIM), f32),
        "diff_qn_g": 1.0 + 0.02 * nrm(ks[12], (DEPTH, DIFF_QK_HEAD), f32),
        "diff_kn_g": 1.0 + 0.02 * nrm(ks[13], (DEPTH, DIFF_QK_HEAD), f32),
        "lam_q1": 0.1 * nrm(ks[14], (DEPTH, DIFF_QK_HEAD), f32),
        "lam_k1": 0.1 * nrm(ks[15], (DEPTH, DIFF_QK_HEAD), f32),
        "lam_q2": 0.1 * nrm(ks[16], (DEPTH, DIFF_QK_HEAD), f32),
        "lam_k2": 0.1 * nrm(ks[17], (DEPTH, DIFF_QK_HEAD), f32),
        "diff_subln_g": 1.0 + 0.02 * nrm(ks[18], (DEPTH, DIFF_V_HEAD), f32),
        "w_out": nrm(ks[19], (DEPTH, D_MIX, D_MODEL), f32) * D_MIX ** -0.5,
        "ffn_w_gate": nrm(ks[20], (N_DENSE, D_MODEL, D_FF), f32) * D_MODEL ** -0.5,
        "ffn_w_up": nrm(ks[21], (N_DENSE, D_MODEL, D_FF), f32) * D_MODEL ** -0.5,
        "ffn_w_down": nrm(ks[22], (N_DENSE, D_FF, D_MODEL), f32) * D_FF ** -0.5,
        "router_w": nrm(ks[23], (N_MOE, D_MODEL, N_EXPERTS), f32) * D_MODEL ** -0.5,
        "router_b": nrm(ks[24], (N_MOE, N_EXPERTS), f32) * 0.01,
        "moe_w_gate": nrm(ks[25], (N_MOE, N_EXPERTS, D_MODEL, D_FF), f32) * D_MODEL ** -0.5,
        "moe_w_up": nrm(ks[26], (N_MOE, N_EXPERTS, D_MODEL, D_FF), f32) * D_MODEL ** -0.5,
        "moe_w_down": nrm(ks[27], (N_MOE, N_EXPERTS, D_FF, D_MODEL), f32) * D_FF ** -0.5,
    }


def reference(x, c, ctx, c_ctx, ada_w, ada_b, norm1_g, norm2_g, w_in, ret_decay_fwd, ret_decay_bwd,
              ret_gn_g, diff_qn_g, diff_kn_g, lam_q1, lam_k1, lam_q2, lam_k2, diff_subln_g, w_out,
              ffn_w_gate, ffn_w_up, ffn_w_down, router_w, router_b, moe_w_gate, moe_w_up, moe_w_down):
    b, t, _ = x.shape
    rows = t // GRID_W
    row_pos = jnp.repeat(jnp.arange(rows, dtype=jnp.float32), GRID_W)
    col_pos = jnp.tile(jnp.arange(GRID_W, dtype=jnp.float32), rows)
    cos, sin = axial_rope(row_pos, col_pos, DIFF_QK_HEAD)

    def channel_mixer(h, l):
        if l % 2 == 0:
            i = l // 2
            return swiglu(h, ffn_w_gate[i], ffn_w_up[i], ffn_w_down[i])
        i = l // 2
        return moe_swiglu(h, router_w[i], router_b[i], moe_w_gate[i], moe_w_up[i], moe_w_down[i])

    xc = ctx
    for l in range(DEPTH):
        ctx_out = l < DEPTH - 1
        lam_init = 0.8 - 0.6 * float(np.exp(-0.3 * l))
        mod = jnp.split(jax.nn.silu(c) @ ada_w[l] + ada_b[l], 6, axis=-1)
        mod = [m[:, None, :] for m in mod]
        modc = jnp.split(jax.nn.silu(c_ctx) @ ada_w[l] + ada_b[l], 6, axis=-1)

        h = modulate(rms_norm(x, norm1_g[l]), mod[0], mod[1])
        hc = modulate(rms_norm(xc, norm1_g[l]), modc[0], modc[1])
        mix, mix_c = hybrid_mixer(h, hc, w_in[l], ret_decay_fwd[l], ret_decay_bwd[l], ret_gn_g[l],
                                  diff_qn_g[l], diff_kn_g[l], lam_q1[l], lam_k1[l], lam_q2[l], lam_k2[l],
                                  diff_subln_g[l], w_out[l], lam_init, cos, sin, ctx_out)
        x = x + mod[2] * mix
        h2 = modulate(rms_norm(x, norm2_g[l]), mod[3], mod[4])
        x = x + mod[5] * channel_mixer(h2, l)
        if ctx_out:
            xc = xc + modc[2] * mix_c
            h2c = modulate(rms_norm(xc, norm2_g[l]), modc[3], modc[4])
            xc = xc + modc[5] * channel_mixer(h2c, l)
    return x
```

```cpp
#include <hip/hip_runtime.h>
#include <cstdint>
#include <cstdio>
#define FAST_MASK 0x1fffffu
#define FAST_ATT 1
#define FAST_RET 1

constexpr int NB = 2, T = 8192, DM = 1024, TC = 256;
constexpr int NL = NB * T;
constexpr int NC = NB * TC;
constexpr int NR = NL + NC;
constexpr int DP = 3584, DFF = 2816, NE = 8, NH = 4;
constexpr float EPS = 1e-6f;
constexpr int C_RQ = 0, C_RK = 512, C_RV = 1024, C_RG = 1536, C_DQ = 2048, C_DK = 2560, C_DV = 3072;
constexpr int MP_MAX = 2 * NL + NE * 256;

typedef unsigned short bf16_t;
__device__ __forceinline__ float bf2f(bf16_t v) { return __uint_as_float(((unsigned)v) << 16); }
__device__ __forceinline__ bf16_t f2bf(float f) { unsigned u = __float_as_uint(f); u += 0x7fffu + ((u >> 16) & 1u); return (bf16_t)(u >> 16); }
typedef float f32x2_t __attribute__((ext_vector_type(2)));
typedef __bf16 bf16x2_t __attribute__((ext_vector_type(2)));
__device__ __forceinline__ unsigned pk2(float lo, float hi) { const f32x2_t v = {lo, hi}; const bf16x2_t b = __builtin_convertvector(v, bf16x2_t); return __builtin_bit_cast(unsigned, b); }
__device__ __forceinline__ unsigned pk4_fp8(float a, float b, float c, float d) {
    a = __builtin_amdgcn_fmed3f(a, -448.f, 448.f); b = __builtin_amdgcn_fmed3f(b, -448.f, 448.f); c = __builtin_amdgcn_fmed3f(c, -448.f, 448.f); d = __builtin_amdgcn_fmed3f(d, -448.f, 448.f);
    int r = 0; r = __builtin_amdgcn_cvt_pk_fp8_f32(a, b, r, false); r = __builtin_amdgcn_cvt_pk_fp8_f32(c, d, r, true); return (unsigned)r;
}
constexpr float W8_SCALE = 64.f, A8_SCALE = 8.f;
__device__ __forceinline__ float wave_sum(float v) {
#pragma unroll
    for (int o = 1; o < 64; o <<= 1) v += __shfl_xor(v, o);
    return v;
}
__device__ __forceinline__ int lane_id() { int l = (int)__builtin_amdgcn_mbcnt_hi(~0u, __builtin_amdgcn_mbcnt_lo(~0u, 0u)); asm volatile("" : "+v"(l)); return l; }
__device__ __forceinline__ float siluf(float v) { return v / (1.f + __expf(-v)); }

constexpr size_t MiB = 1u << 20;
constexpr size_t WS_CTL = 0, CTL_ZERO_BYTES = 1 * MiB;
constexpr size_t WS_MODV = 1 * MiB;
constexpr size_t WS_ROUTE = 2 * MiB;
constexpr size_t WS_XRC = 3 * MiB;
constexpr size_t WS_W = 6 * MiB;
constexpr size_t W_WIN = WS_W;
constexpr size_t W_WOUT = W_WIN + (size_t)2 * DP * DM * 2;
constexpr size_t W_FGU = W_WOUT + (size_t)2 * DM * DM * 2;
constexpr size_t W_FD = W_FGU + (size_t)2 * DFF * DM * 2;
constexpr size_t W_MGU = W_FD + (size_t)DM * DFF * 2;
constexpr size_t W_MD = W_MGU + (size_t)NE * 2 * DFF * DM * 2;
constexpr size_t W_END = W_MD + (size_t)NE * DM * DFF * 2;
constexpr size_t WS_HBUF = 173 * MiB;
constexpr size_t WS_PROJ = 206 * MiB;
constexpr size_t WS_CONCAT = 322 * MiB;
constexpr size_t WS_ACT = 206 * MiB;
constexpr size_t WS_ACTS = 173 * MiB;
constexpr size_t WS_H2S = 361 * MiB;
constexpr size_t WS_KT = 394 * MiB, WS_VT = WS_KT + (size_t)NB * NH * 132 * 16384;
static_assert(WS_VT + (size_t)NB * NH * 132 * 16384 <= 429 * MiB && WS_H2S + (size_t)NB * NH * 2 * 66 * 32768 <= WS_KT, "K/V tile images");
constexpr size_t WS_YBUF = WS_H2S, WS_CS = WS_H2S, WS_PART = WS_H2S;
constexpr size_t WS_END = 430 * MiB;
static_assert(W_END <= WS_HBUF && WS_ACTS + (size_t)MP_MAX * DFF * 2 <= WS_H2S && WS_H2S + (size_t)MP_MAX * DM * 2 <= WS_END && WS_ACT + (size_t)2 * NL * DFF * 2 <= WS_END, "ws map");
constexpr int CW_BAR = 4096;
constexpr int CW_CNT = 200000;

struct Params {
    const float* in[28];
    float* out;
    unsigned char* ws;
};
enum { I_X = 0, I_C, I_CTX, I_CCTX, I_ADAW, I_ADAB, I_N1G, I_N2G, I_WIN, I_DECF, I_DECB, I_GNG, I_QNG, I_KNG, I_LQ1, I_LK1, I_LQ2, I_LK2, I_SUBLN, I_WOUT,
       I_FWG, I_FWU, I_FWD, I_RW, I_RB, I_MWG, I_MWU, I_MWD };

__device__ __forceinline__ int rowtype(int m) { return m < NL ? m / T : 2; }
__device__ __forceinline__ const float* modv(const Params& p, int l, int rt, int i) { return (const float*)(p.ws + WS_MODV) + ((size_t)(l * 3 + rt) * 6 + i) * DM; }
__device__ __forceinline__ float* xr_row(const Params& p, int m) { return m < NL ? p.out + (size_t)m * DM : (float*)(p.ws + WS_XRC) + (size_t)(m - NL) * DM; }
__device__ __forceinline__ float lam_init_of(int l) { return l == 0 ? 0.2f : (0.8f - 0.6f * 0.74081822068171788f); }

#ifndef FAST_ATT
#define FAST_ATT 0
#endif
#ifndef FAST_RET
#define FAST_RET 0
#endif
#ifndef ATT_V3
#define ATT_V3 1
#endif
__global__ void k_mod(Params p) {
    const int idx = blockIdx.x * blockDim.x + threadIdx.x;
    if (idx >= 2 * 3 * 6144) return;
    const int n = idx % 6144, rt = (idx / 6144) % 3, l = idx / (6144 * 3);
    const float* cv = rt < 2 ? p.in[I_C] + rt * DM : p.in[I_CCTX];
    const float* W = p.in[I_ADAW] + (size_t)l * DM * 6144;
    float acc = 0.f;
    for (int k = 0; k < DM; ++k) acc += siluf(cv[k]) * W[(size_t)k * 6144 + n];
    ((float*)(p.ws + WS_MODV))[(size_t)(l * 3 + rt) * 6144 + n] = acc + p.in[I_ADAB][l * 6144 + n];
}

__global__ void k_norm(Params p, int l, int which, int nrows) {
    const int m = blockIdx.x * (blockDim.x / 64) + (threadIdx.x >> 6), lane = threadIdx.x & 63;
    if (m >= nrows) return;
    const float* xrow;
    if (l == 0 && which == 0) xrow = m < NL ? p.in[I_X] + (size_t)m * DM : p.in[I_CTX] + (size_t)(m - NL) * DM;
    else xrow = xr_row(p, m);
    const int rt = rowtype(m);
    const float* g = p.in[which ? I_N2G : I_N1G] + l * DM;
    const float* sh = modv(p, l, rt, which ? 3 : 0);
    const float* sc = modv(p, l, rt, which ? 4 : 1);
    float v[16]; float ss = 0.f;
#pragma unroll
    for (int j = 0; j < 4; ++j) { const float4 t = *(const float4*)(xrow + 256 * j + 4 * lane); v[4 * j] = t.x; v[4 * j + 1] = t.y; v[4 * j + 2] = t.z; v[4 * j + 3] = t.w; ss += t.x * t.x + t.y * t.y + t.z * t.z + t.w * t.w; }
    const float r = rsqrtf(wave_sum(ss) * (1.f / DM) + EPS);
    bf16_t* hb = (bf16_t*)(p.ws + WS_HBUF) + (size_t)m * DM;
#pragma unroll
    for (int j = 0; j < 4; ++j)
#pragma unroll
        for (int q = 0; q < 4; ++q) { const int col = 256 * j + 4 * lane + q; const float y = v[4 * j + q] * r * g[col]; v[4 * j + q] = y * (1.f + sc[col]) + sh[col]; hb[col] = f2bf(v[4 * j + q]); }
    if (l == 1 && which == 1) {
        const float* rw = p.in[I_RW]; float lg[8];
#pragma unroll
        for (int e = 0; e < 8; ++e) { float a = 0.f;
#pragma unroll
            for (int j = 0; j < 4; ++j)
#pragma unroll
                for (int q = 0; q < 4; ++q) a += v[4 * j + q] * rw[(size_t)(256 * j + 4 * lane + q) * 8 + e];
            lg[e] = wave_sum(a) + p.in[I_RB][e]; }
        int i1 = 0; float v1 = lg[0];
#pragma unroll
        for (int e = 1; e < 8; ++e) if (lg[e] > v1) { v1 = lg[e]; i1 = e; }
        int i2 = -1; float v2 = -3.4e38f;
#pragma unroll
        for (int e = 0; e < 8; ++e) if (e != i1 && lg[e] > v2) { v2 = lg[e]; i2 = e; }
        const float w1 = 1.f / (1.f + __expf(v2 - v1));
        if (lane == 0) { int* te = (int*)(p.ws + WS_ROUTE); float* tw = (float*)(p.ws + WS_ROUTE) + 2 * NL; te[2 * m] = i1; te[2 * m + 1] = i2; tw[2 * m] = w1; tw[2 * m + 1] = 1.f - w1; }
    }
}

__global__ void k_gemm_proj(Params p, int l) {
    const int n = blockIdx.x * 64 + threadIdx.x, m = blockIdx.y * 4 + threadIdx.y;
    const bf16_t* a = (const bf16_t*)(p.ws + WS_HBUF) + (size_t)m * DM;
    const float* W = p.in[I_WIN] + (size_t)l * DM * DP + n;
    float acc = 0.f;
#pragma unroll 8
    for (int k = 0; k < DM; ++k) acc += bf2f(a[k]) * W[(size_t)k * DP];
    if (n >= C_RK && n < C_RV) acc *= 0.08838834764831845f;
    ((bf16_t*)(p.ws + WS_PROJ))[(size_t)m * DP + n] = f2bf(acc);
}

__global__ void k_qkrope(Params p, int l) {
    const int m = blockIdx.x * (blockDim.x / 64) + (threadIdx.x >> 6), lane = threadIdx.x & 63;
    if (m >= NR) return;
    bf16_t* row = (bf16_t*)(p.ws + WS_PROJ) + (size_t)m * DP;
    const bool lat = m < NL; const int t = m % T;
    const int j = lane & 31; const float pos = (float)((j < 16) ? (t / 64) : (t % 64));
    const float inv_freq = exp2f(-(float)(j & 15) * (13.287712379549449f / 16.f));
    const float ang = pos * inv_freq; const float cs = __cosf(ang), sn = __sinf(ang);
    for (int part = 0; part < 2; ++part) {
        const float* g = p.in[part ? I_KNG : I_QNG] + l * 64;
        for (int hc = 0; hc < 8; ++hc) {
            bf16_t* q = row + (part ? C_DK : C_DQ) + hc * 64;
            const float v = bf2f(q[lane]);
            const float r = rsqrtf(wave_sum(v * v) * (1.f / 64.f) + EPS);
            float y = v * r * g[lane];
            if (lat) { const float o = __shfl_xor(y, 32); y = lane < 32 ? y * cs - o * sn : y * cs + o * sn; }
            if (part == 0) y *= 0.18033688011112042f;
            q[lane] = f2bf(y);
        }
    }
}

__global__ void k_ret_naive(Params p, int l, int nrows) {
    const int w = blockIdx.x * (blockDim.x / 64) + (threadIdx.x >> 6), lane = threadIdx.x & 63;
    if (w >= nrows * NH) return;
    const int m = w / NH, h = w % NH;
    const bf16_t* proj = (const bf16_t*)(p.ws + WS_PROJ);
    const float df = p.in[I_DECF][l * NH + h], db = p.in[I_DECB][l * NH + h];
    const float lgf = -log1pf(__expf(-df)), lgb = -log1pf(__expf(-db));
    const bf16_t* qrow = proj + (size_t)m * DP + C_RQ + h * 128 + 2 * lane;
    const float q0 = bf2f(qrow[0]), q1 = bf2f(qrow[1]);
    float o0 = 0.f, o1 = 0.f;
    if (m < NL) {
        const int b = m / T, t = m % T;
        for (int s = 0; s < T; ++s) {
            const bf16_t* kr = proj + (size_t)(b * T + s) * DP + h * 128 + 2 * lane;
            const float dot = wave_sum(q0 * bf2f(kr[C_RK]) + q1 * bf2f(kr[C_RK + 1]));
            const float wgt = s < t ? __expf(lgf * (float)(t - s)) : (s == t ? 2.f : __expf(lgb * (float)(s - t)));
            o0 += wgt * dot * bf2f(kr[C_RV]); o1 += wgt * dot * bf2f(kr[C_RV + 1]);
        }
        for (int i = 0; i < TC; ++i) {
            const bf16_t* kr = proj + (size_t)(NL + b * TC + i) * DP + h * 128 + 2 * lane;
            const float dot = wave_sum(q0 * bf2f(kr[C_RK]) + q1 * bf2f(kr[C_RK + 1]));
            const float wgt = __expf(lgf * (float)(t + TC - i)) + __expf(lgb * (float)(T - t + i));
            o0 += wgt * dot * bf2f(kr[C_RV]); o1 += wgt * dot * bf2f(kr[C_RV + 1]);
        }
    } else {
        const int b = (m - NL) / TC, t = (m - NL) % TC;
        for (int s = 0; s < TC; ++s) {
            const bf16_t* kr = proj + (size_t)(NL + b * TC + s) * DP + h * 128 + 2 * lane;
            const float dot = wave_sum(q0 * bf2f(kr[C_RK]) + q1 * bf2f(kr[C_RK + 1]));
            const float wgt = s < t ? __expf(lgf * (float)(t - s)) : (s == t ? 2.f : __expf(lgb * (float)(s - t)));
            o0 += wgt * dot * bf2f(kr[C_RV]); o1 += wgt * dot * bf2f(kr[C_RV + 1]);
        }
    }
    const float mu = wave_sum(o0 + o1) * (1.f / 128.f);
    const float d0 = o0 - mu, d1 = o1 - mu;
    const float r = rsqrtf(wave_sum(d0 * d0 + d1 * d1) * (1.f / 128.f) + EPS);
    const float* gn = p.in[I_GNG] + l * 512 + h * 128 + 2 * lane;
    const bf16_t* gr = proj + (size_t)m * DP + C_RG + h * 128 + 2 * lane;
    bf16_t* cc = (bf16_t*)(p.ws + WS_CONCAT) + (size_t)m * DM + h * 128 + 2 * lane;
    cc[0] = f2bf(siluf(bf2f(gr[0])) * d0 * r * gn[0]);
    cc[1] = f2bf(siluf(bf2f(gr[1])) * d1 * r * gn[1]);
}

__global__ void k_attn_naive(Params p, int l, int nrows) {
    const int w = blockIdx.x * (blockDim.x / 64) + (threadIdx.x >> 6), lane = threadIdx.x & 63;
    if (w >= nrows * NH) return;
    const int m = w / NH, h = w % NH;
    const bf16_t* proj = (const bf16_t*)(p.ws + WS_PROJ);
    const bool lat = m < NL; const int b = lat ? m / T : (m - NL) / TC;
    float O[2][2];
    for (int c = 0; c < 2; ++c) {
        const float q = bf2f(proj[(size_t)m * DP + C_DQ + h * 128 + c * 64 + lane]);
        float mx = -1e30f, ls = 0.f, o0 = 0.f, o1 = 0.f;
        const int nk = lat ? TC + T : TC;
        for (int s = 0; s < nk; ++s) {
            const int mk = s < TC ? NL + b * TC + s : b * T + (s - TC);
            const bf16_t* kr = proj + (size_t)mk * DP + h * 128;
            const float sc = wave_sum(q * bf2f(kr[C_DK + c * 64 + lane]));
            const float mn = fmaxf(mx, sc), al = exp2f(mx - mn), pp = exp2f(sc - mn);
            ls = ls * al + pp; o0 = o0 * al + pp * bf2f(kr[C_DV + 2 * lane]); o1 = o1 * al + pp * bf2f(kr[C_DV + 2 * lane + 1]); mx = mn;
        }
        O[c][0] = o0 / ls; O[c][1] = o1 / ls;
    }
    float s1 = 0.f, s2 = 0.f;
    { const float a = p.in[I_LQ1][l * 64 + lane] * p.in[I_LK1][l * 64 + lane], bq = p.in[I_LQ2][l * 64 + lane] * p.in[I_LK2][l * 64 + lane]; s1 = wave_sum(a); s2 = wave_sum(bq); }
    const float li = lam_init_of(l), lam = __expf(s1) - __expf(s2) + li;
    const float d0 = O[0][0] - lam * O[1][0], d1 = O[0][1] - lam * O[1][1];
    const float r = rsqrtf(wave_sum(d0 * d0 + d1 * d1) * (1.f / 128.f) + EPS);
    const float* sg = p.in[I_SUBLN] + l * 128 + 2 * lane;
    bf16_t* cc = (bf16_t*)(p.ws + WS_CONCAT) + (size_t)m * DM + 512 + h * 128 + 2 * lane;
    cc[0] = f2bf(d0 * r * sg[0] * (1.f - li)); cc[1] = f2bf(d1 * r * sg[1] * (1.f - li));
}

__global__ void k_gemm_out(Params p, int l) {
    const int n = blockIdx.x * 64 + threadIdx.x, m = blockIdx.y * 4 + threadIdx.y;
    const bf16_t* a = (const bf16_t*)(p.ws + WS_CONCAT) + (size_t)m * DM;
    const float* W = p.in[I_WOUT] + (size_t)l * DM * DM + n;
    float acc = 0.f;
#pragma unroll 8
    for (int k = 0; k < DM; ++k) acc += bf2f(a[k]) * W[(size_t)k * DM];
    const float xin = l == 0 ? (m < NL ? p.in[I_X][(size_t)m * DM + n] : p.in[I_CTX][(size_t)(m - NL) * DM + n]) : xr_row(p, m)[n];
    xr_row(p, m)[n] = xin + modv(p, l, rowtype(m), 2)[n] * acc;
}

__global__ void k_ffn_gu(Params p) {
    const int j = blockIdx.x * 64 + threadIdx.x, m = blockIdx.y * 4 + threadIdx.y;
    const bf16_t* a = (const bf16_t*)(p.ws + WS_HBUF) + (size_t)m * DM;
    const float* Wg = p.in[I_FWG] + j; const float* Wu = p.in[I_FWU] + j;
    float ag = 0.f, au = 0.f;
#pragma unroll 8
    for (int k = 0; k < DM; ++k) { const float x = bf2f(a[k]); ag += x * Wg[(size_t)k * DFF]; au += x * Wu[(size_t)k * DFF]; }
    ((bf16_t*)(p.ws + WS_ACT))[(size_t)m * DFF + j] = f2bf(siluf(ag) * au);
}
__global__ void k_ffn_down(Params p) {
    const int n = blockIdx.x * 64 + threadIdx.x, m = blockIdx.y * 4 + threadIdx.y;
    const bf16_t* a = (const bf16_t*)(p.ws + WS_ACT) + (size_t)m * DFF;
    const float* W = p.in[I_FWD] + n;
    float acc = 0.f;
#pragma unroll 8
    for (int k = 0; k < DFF; ++k) acc += bf2f(a[k]) * W[(size_t)k * DM];
    xr_row(p, m)[n] += modv(p, 0, rowtype(m), 5)[n] * acc;
}
__global__ void k_moe_gu(Params p) {
    const int j = blockIdx.x * 64 + threadIdx.x, ts = blockIdx.y * 4 + threadIdx.y;
    const int t = ts >> 1; const int e = ((const int*)(p.ws + WS_ROUTE))[ts];
    const bf16_t* a = (const bf16_t*)(p.ws + WS_HBUF) + (size_t)t * DM;
    const float* Wg = p.in[I_MWG] + (size_t)e * DM * DFF + j; const float* Wu = p.in[I_MWU] + (size_t)e * DM * DFF + j;
    float ag = 0.f, au = 0.f;
#pragma unroll 8
    for (int k = 0; k < DM; ++k) { const float x = bf2f(a[k]); ag += x * Wg[(size_t)k * DFF]; au += x * Wu[(size_t)k * DFF]; }
    ((bf16_t*)(p.ws + WS_ACT))[(size_t)ts * DFF + j] = f2bf(siluf(ag) * au);
}
__global__ void k_moe_down(Params p) {
    const int n = blockIdx.x * 64 + threadIdx.x, t = blockIdx.y * 4 + threadIdx.y;
    const int* te = (const int*)(p.ws + WS_ROUTE); const float* tw = (const float*)(p.ws + WS_ROUTE) + 2 * NL;
    float y = 0.f;
    for (int s = 0; s < 2; ++s) {
        const bf16_t* a = (const bf16_t*)(p.ws + WS_ACT) + (size_t)(2 * t + s) * DFF;
        const float* W = p.in[I_MWD] + (size_t)te[2 * t + s] * DFF * DM + n;
        float acc = 0.f;
#pragma unroll 8
        for (int k = 0; k < DFF; ++k) acc += bf2f(a[k]) * W[(size_t)k * DM];
        y += tw[2 * t + s] * acc;
    }
    p.out[(size_t)t * DM + n] += modv(p, 1, t / T, 5)[n] * y;
}


typedef unsigned v2u __attribute__((ext_vector_type(2)));
namespace pg8 {
#define PG8_LAS __attribute__((address_space(3)))
typedef unsigned short bf16_t;
typedef short bf16x8 __attribute__((ext_vector_type(8)));
typedef float f32x4 __attribute__((ext_vector_type(4)));
typedef unsigned u32x4 __attribute__((ext_vector_type(4)));
typedef int i32x4 __attribute__((ext_vector_type(4)));
typedef int i32x8 __attribute__((ext_vector_type(8)));
constexpr int BM = 256, BK = 64, HALF = 128, HTB = HALF * BK * 2  , STAGE_BYTES = 8 * HTB, NXCD = 8, WGM = 8;

__host__ __device__ __forceinline__ int lds_byte(int r, int c) { const int st = (r >> 4) * 2 + (c >> 5), rr = r & 15, cc = c & 31, ob = rr * 64 + cc * 2; return st * 1024 + (ob ^ (((ob >> 9) & 1) << 5)); }
__host__ __device__ __forceinline__ void stage_rc(int b, int& R, int& C) { const int st = b / 1024, sb = b % 1024, swz = sb ^ (((sb >> 9) & 1) << 5); R = (st >> 1) * 16 + swz / 64; C = (st & 1) * 32 + (swz % 64) / 2; }
__host__ __device__ __forceinline__ int perm32(int rho) { const int n = rho >> 4, i = rho & 15; return 8 * (i >> 2) + 4 * n + (i & 3); }

struct Unit { int pm, pn; long bofs, kofs; };
struct Gemm { const bf16_t* A; const bf16_t* Bt; int M, N, K, ld; };

struct Order {
    int nM, nN, nwg, G, c;
    int e1, e2, e3, e4, e5, e6, e7; long estride;
    __device__ __forceinline__ void init(int nM_, int nN_, int G_, int c_) { nM = nM_; nN = nN_; nwg = nM * nN; G = G_; c = c_; estride = 0; e1 = e2 = e3 = e4 = e5 = e6 = e7 = 0; }
    __device__ __forceinline__ bool next(int i, Unit& u) const {
        const long L = (long)i * G + c; if (L >= nwg) return false;
        int wgid = (int)L; { const int q = nwg / NXCD, r = nwg % NXCD, xcd = wgid % NXCD, off = wgid / NXCD; wgid = (xcd < r ? xcd * (q + 1) : r * (q + 1) + (xcd - r) * q) + off; }
        const int nig = WGM * nN, gid = wgid / nig, fm = gid * WGM, gsz = (nM - fm) < WGM ? (nM - fm) : WGM;
        u.pm = fm + ((wgid % nig) % gsz); u.pn = (wgid % nig) / gsz;
        const int e = (u.pm >= e1) + (u.pm >= e2) + (u.pm >= e3) + (u.pm >= e4) + (u.pm >= e5) + (u.pm >= e6) + (u.pm >= e7);
        u.bofs = estride ? (long)e * estride : 0; u.kofs = 0;
        return true;
    }
    __device__ __forceinline__ void a_ready(const Unit&) const {}
    __device__ __forceinline__ void done(const Unit&) const {}
};

struct SplitOrder {
    int nN, ns, nwg, G, c, pm0;
    __device__ __forceinline__ void init(int pm0_, int npan, int nN_, int ns_, int G_, int c_) { pm0 = pm0_; nN = nN_; ns = ns_; nwg = npan * nN * ns; G = G_; c = c_; }
    __device__ __forceinline__ bool next(int i, Unit& u) const {
        const int L = i * G + c; if (L >= nwg) return false;
        const int ks = L % ns, rest = L / ns; u.pn = rest % nN; u.pm = pm0 + rest / nN; u.bofs = 0; u.kofs = (long)ks * 256 * 2; return true;
    }
    __device__ __forceinline__ void a_ready(const Unit&) const {}
    __device__ __forceinline__ void done(const Unit&) const {}
};
__device__ __forceinline__ unsigned cvt_pk_bf16(float lo, float hi) { unsigned r; asm volatile("v_cvt_pk_bf16_f32 %0, %1, %2" : "=v"(r) : "v"(lo), "v"(hi)); return r; }
__device__ __forceinline__ float silu_fast(float x) { return x * __builtin_amdgcn_rcpf(1.f + __builtin_amdgcn_exp2f(-1.4426950408889634f * x)); }

struct EpiProj {
    static constexpr bool PERM = true, AFTER_DRAIN = false;
    bf16_t* O;
    __device__ __forceinline__ void operator()(const f32x4 (&acc)[2][2][4][2], const Unit& u, int wr, int wc, int fr, int fq) const {
        const int row0 = u.pm * BM + wr * 64 + fr, col0 = u.pn * BM + wc * 32 + 8 * fq;
        const float sc = (u.pn == 2 || u.pn == 3) ? 0.08838834764831845f : 1.f;
#pragma unroll
        for (int ai = 0; ai < 2; ++ai)
#pragma unroll
            for (int m = 0; m < 4; ++m) { bf16_t* rowp = O + (size_t)(row0 + ai * HALF + m * 16) * DP + col0;
#pragma unroll
                for (int bj = 0; bj < 2; ++bj) { const f32x4 v0 = acc[ai][bj][m][0] * sc, v1 = acc[ai][bj][m][1] * sc;
                    u32x4 w; w.x = cvt_pk_bf16(v0[0], v0[1]); w.y = cvt_pk_bf16(v0[2], v0[3]); w.z = cvt_pk_bf16(v1[0], v1[1]); w.w = cvt_pk_bf16(v1[2], v1[3]);
                    *(u32x4*)(rowp + bj * HALF) = w; } }
    }
};
struct EpiResid {
    static constexpr bool PERM = false, AFTER_DRAIN = false;
    const float* base_lat; const float* base_ctx; float* out_lat; float* out_ctx; const float* gl; const float* gc;
    __device__ __forceinline__ void operator()(const f32x4 (&acc)[2][2][4][2], const Unit& u, int wr, int wc, int fr, int fq) const {
        const bool lat = u.pm < NL / BM;
        const int row0 = (lat ? u.pm * BM : u.pm * BM - NL) + wr * 64 + fr, col0 = u.pn * BM + wc * 32 + 4 * fq;
        const float* base = lat ? base_lat : base_ctx; float* out = lat ? out_lat : out_ctx;
        const float* gate = lat ? gl + (size_t)(u.pm / (T / BM)) * 6 * DM : gc;
        f32x4 gv[2][2];
#pragma unroll
        for (int bj = 0; bj < 2; ++bj)
#pragma unroll
            for (int n = 0; n < 2; ++n) gv[bj][n] = *(const f32x4*)(gate + col0 + bj * HALF + n * 16);
#pragma unroll
        for (int ai = 0; ai < 2; ++ai)
#pragma unroll
            for (int m = 0; m < 4; ++m) { const size_t off = (size_t)(row0 + ai * HALF + m * 16) * DM + col0;
#pragma unroll
                for (int bj = 0; bj < 2; ++bj)
#pragma unroll
                    for (int n = 0; n < 2; ++n) { const f32x4 bs = *(const f32x4*)(base + off + bj * HALF + n * 16); *(f32x4*)(out + off + bj * HALF + n * 16) = bs + gv[bj][n] * acc[ai][bj][m][n]; }
                asm volatile("" ::: "memory"); }
    }
};
struct EpiPartial {
    static constexpr bool PERM = false, AFTER_DRAIN = false;
    float* part; int pm0, nrows;
    __device__ __forceinline__ void operator()(const f32x4 (&acc)[2][2][4][2], const Unit& u, int wr, int wc, int fr, int fq) const {
        const int row0 = (u.pm - pm0) * BM + wr * 64 + fr, col0 = u.pn * BM + wc * 32 + 4 * fq;
        float* base = part + (size_t)(u.kofs / 512) * nrows * DM;
#pragma unroll
        for (int ai = 0; ai < 2; ++ai)
#pragma unroll
            for (int m = 0; m < 4; ++m) { float* rowp = base + (size_t)(row0 + ai * HALF + m * 16) * DM + col0;
#pragma unroll
                for (int bj = 0; bj < 2; ++bj)
#pragma unroll
                    for (int n = 0; n < 2; ++n) *(f32x4*)(rowp + bj * HALF + n * 16) = acc[ai][bj][m][n]; }
    }
};
struct EpiSwiglu {
    static constexpr bool PERM = true, AFTER_DRAIN = false;
    bf16_t* O;
    __device__ __forceinline__ void operator()(const f32x4 (&acc)[2][2][4][2], const Unit& u, int wr, int wc, int fr, int fq) const {
        const int row0 = u.pm * BM + wr * 64 + fr, col0 = u.pn * HALF + wc * 32 + 8 * fq;
#pragma unroll
        for (int ai = 0; ai < 2; ++ai)
#pragma unroll
            for (int m = 0; m < 4; ++m) { bf16_t* rowp = O + (size_t)(row0 + ai * HALF + m * 16) * DFF + col0;
                const f32x4 g0 = acc[ai][0][m][0], g1 = acc[ai][0][m][1], u0 = acc[ai][1][m][0], u1 = acc[ai][1][m][1];
                u32x4 w; w.x = cvt_pk_bf16(silu_fast(g0[0]) * u0[0], silu_fast(g0[1]) * u0[1]); w.y = cvt_pk_bf16(silu_fast(g0[2]) * u0[2], silu_fast(g0[3]) * u0[3]);
                w.z = cvt_pk_bf16(silu_fast(g1[0]) * u1[0], silu_fast(g1[1]) * u1[1]); w.w = cvt_pk_bf16(silu_fast(g1[2]) * u1[2], silu_fast(g1[3]) * u1[3]);
                *(u32x4*)rowp = w; }
    }
};
struct EpiSwiglu8 {
    static constexpr bool PERM = true, AFTER_DRAIN = false;
    unsigned char* O;
    __device__ __forceinline__ void operator()(const f32x4 (&acc)[2][2][4][2], const Unit& u, int wr, int wc, int fr, int fq) const {
        const int row0 = u.pm * BM + wr * 64 + fr, col0 = u.pn * HALF + wc * 32 + 8 * fq;
        constexpr float WI = 1.f / W8_SCALE;
#pragma unroll
        for (int ai = 0; ai < 2; ++ai)
#pragma unroll
            for (int m = 0; m < 4; ++m) { unsigned char* rowp = O + (size_t)(row0 + ai * HALF + m * 16) * DFF + col0;
                const f32x4 g0 = acc[ai][0][m][0] * WI, g1 = acc[ai][0][m][1] * WI, u0 = acc[ai][1][m][0] * (WI * A8_SCALE), u1 = acc[ai][1][m][1] * (WI * A8_SCALE);
                v2u w; w.x = pk4_fp8(silu_fast(g0[0]) * u0[0], silu_fast(g0[1]) * u0[1], silu_fast(g0[2]) * u0[2], silu_fast(g0[3]) * u0[3]);
                w.y = pk4_fp8(silu_fast(g1[0]) * u1[0], silu_fast(g1[1]) * u1[1], silu_fast(g1[2]) * u1[2], silu_fast(g1[3]) * u1[3]);
                *(v2u*)rowp = w; }
    }
};
struct EpiMoeDown {
    static constexpr bool PERM = true, AFTER_DRAIN = false;
    bf16_t* O; const float* rgate; float scale;
    __device__ __forceinline__ void operator()(const f32x4 (&acc)[2][2][4][2], const Unit& u, int wr, int wc, int fr, int fq) const {
        const int row0 = u.pm * BM + wr * 64 + fr, col0 = u.pn * BM + wc * 32 + 8 * fq;
#pragma unroll
        for (int ai = 0; ai < 2; ++ai)
#pragma unroll
            for (int m = 0; m < 4; ++m) { const int row = row0 + ai * HALF + m * 16; const float sc = rgate[row] * scale; bf16_t* rowp = O + (size_t)row * DM + col0;
#pragma unroll
                for (int bj = 0; bj < 2; ++bj) { const f32x4 v0 = acc[ai][bj][m][0] * sc, v1 = acc[ai][bj][m][1] * sc;
                    u32x4 w; w.x = cvt_pk_bf16(v0[0], v0[1]); w.y = cvt_pk_bf16(v0[2], v0[3]); w.z = cvt_pk_bf16(v1[0], v1[1]); w.w = cvt_pk_bf16(v1[2], v1[3]);
                    *(u32x4*)(rowp + bj * HALF) = w; } }
    }
};

template <class Epi, class Sched, bool ALIGN_EPI = false, bool SP2 = false, bool F8 = false>
__device__ __forceinline__ void gemm_phase(PG8_LAS unsigned char* lds, const Gemm g, const Sched& S, const Epi& E, const int wid  ) {
    const int lane = lane_id(), tid = wid * 64 + lane, wr = wid >> 2, wc = wid & 3, fr = lane & 15, fq = lane >> 4;
    const int K = g.ld, nt = g.K / BK;
    unsigned voffA[2], voffB[2];
#pragma unroll
    for (int i = 0; i < 2; ++i) { int R, C; stage_rc(tid * 16 + i * 8192, R, C); const int Rb = Epi::PERM ? ((R & ~31) + perm32(R & 31)) : R;
        voffA[i] = (unsigned)(R * K + C) * 2u; voffB[i] = (unsigned)(Rb * K + C) * 2u; }
    const size_t kstep = (size_t)(BK * 2);
    const size_t hstep = (size_t)HALF * K * 2;
    const size_t tstep = 2 * hstep;
    const unsigned ldsw = (unsigned)wid * 1024u;
    const int aoff = lds_byte(wr * 64 + fr, fq * 8), boff = lds_byte(wc * 32 + fr, fq * 8);
#define PG8_SA(b, h) (((b) * 2 + (h)) * HTB)
#define PG8_SB(b, h) ((4 + (b) * 2 + (h)) * HTB)
#define PG8_STAGE(bufoff, gbase, voff) do { _Pragma("unroll") for (int _i = 0; _i < 2; ++_i) \
        __builtin_amdgcn_global_load_lds((const unsigned*)((const char*)(gbase) + (voff)[_i]), (PG8_LAS unsigned*)(lds + (bufoff) + ldsw + _i * 8192), 16, 0, 0); } while (0)
#define PG8_LD8(addr) __builtin_shufflevector(*(const PG8_LAS i32x4*)(addr), *(const PG8_LAS i32x4*)((addr) + 1024), 0, 1, 2, 3, 4, 5, 6, 7)
#define PG8_LDA(dst, dst8, b, h) do { if constexpr (F8) { _Pragma("unroll") for (int m = 0; m < 4; ++m) dst8[m] = PG8_LD8(lds + PG8_SA(b, h) + aoff + m * 2048); } \
        else { _Pragma("unroll") for (int m = 0; m < 4; ++m) _Pragma("unroll") for (int k = 0; k < 2; ++k) dst[m][k] = *(const PG8_LAS bf16x8*)(lds + PG8_SA(b, h) + aoff + m * 2048 + k * 1024); } } while (0)
#define PG8_LDB(dst, dst8, b, h) do { if constexpr (F8) { _Pragma("unroll") for (int n = 0; n < 2; ++n) dst8[n] = PG8_LD8(lds + PG8_SB(b, h) + boff + n * 2048); } \
        else { _Pragma("unroll") for (int n = 0; n < 2; ++n) _Pragma("unroll") for (int k = 0; k < 2; ++k) dst[n][k] = *(const PG8_LAS bf16x8*)(lds + PG8_SB(b, h) + boff + n * 2048 + k * 1024); } } while (0)
#define PG8_MMA(ai, bj, At, At8, Bt, Bt8) do { __builtin_amdgcn_s_setprio(1); \
        if constexpr (F8) { _Pragma("unroll") for (int m = 0; m < 4; ++m) _Pragma("unroll") for (int n = 0; n < 2; ++n) \
            asm volatile("v_mfma_scale_f32_16x16x128_f8f6f4 %0, %1, %2, %0, %3, %3 op_sel_hi:[0,0,0]" : "+v"(acc[ai][bj][m][n]) : "v"(Bt8[n]), "v"(At8[m]), "v"(sc8_)); } \
        else { _Pragma("unroll") for (int m = 0; m < 4; ++m) _Pragma("unroll") for (int n = 0; n < 2; ++n) _Pragma("unroll") for (int k = 0; k < 2; ++k) \
            acc[ai][bj][m][n] = __builtin_amdgcn_mfma_f32_16x16x32_bf16(Bt[n][k], At[m][k], acc[ai][bj][m][n], 0, 0, 0); } \
        __builtin_amdgcn_s_setprio(0); } while (0)
#define PG8_WAIT_V(n) asm volatile("s_waitcnt vmcnt(" #n ")" ::: "memory")
#define PG8_WAIT_L(n) asm volatile("s_waitcnt lgkmcnt(" #n ")" ::: "memory")
#define PG8_BAR __builtin_amdgcn_s_barrier()
#define PG8_SCHED __builtin_amdgcn_sched_barrier(0)
#define PG8_SCHED8 do { if constexpr (F8) __builtin_amdgcn_sched_barrier(0); } while (0)
    Unit cur, nxt; int ui = 0;
    if (!S.next(0, cur)) return;
    constexpr float zero_ = 0.f;
    const int sc8_ = 0x7f7f7f7f;
    f32x4 acc[2][2][4][2];
#pragma unroll
    for (int a = 0; a < 2; ++a)
#pragma unroll
        for (int b = 0; b < 2; ++b)
#pragma unroll
            for (int m = 0; m < 4; ++m)
#pragma unroll
                for (int n = 0; n < 2; ++n) acc[a][b][m][n] = (f32x4){zero_, zero_, zero_, zero_};
    bf16x8 At[4][2], B0[2][2], B1[2][2];
    i32x8 At8[4], B08[2], B18[2];
    const char* cA = (const char*)g.A + cur.kofs + (size_t)cur.pm * tstep; const char* cB = (const char*)g.Bt + cur.bofs + cur.kofs + (size_t)cur.pn * tstep;
    S.a_ready(cur);
    if constexpr (SP2) {
        PG8_STAGE(PG8_SB(0, 0), cB, voffB); PG8_STAGE(PG8_SB(0, 1), cB + hstep, voffB); PG8_STAGE(PG8_SA(0, 0), cA, voffA); PG8_STAGE(PG8_SA(0, 1), cA + hstep, voffA);
        if (wr == 1) PG8_BAR;
        PG8_WAIT_V(2); PG8_BAR;
        PG8_STAGE(PG8_SB(1, 0), cB + kstep, voffB); PG8_STAGE(PG8_SA(1, 0), cA + kstep, voffA); PG8_STAGE(PG8_SB(1, 1), cB + hstep + kstep, voffB);
        PG8_WAIT_V(6); PG8_BAR;
    } else {
        PG8_STAGE(PG8_SB(0, 0), cB, voffB); PG8_STAGE(PG8_SA(0, 0), cA, voffA); PG8_STAGE(PG8_SB(0, 1), cB + hstep, voffB); PG8_STAGE(PG8_SA(0, 1), cA + hstep, voffA);
        if (wr == 1) PG8_BAR;
        PG8_WAIT_V(4); PG8_BAR;
        PG8_STAGE(PG8_SB(1, 0), cB + kstep, voffB); PG8_STAGE(PG8_SA(1, 0), cA + kstep, voffA); PG8_STAGE(PG8_SB(1, 1), cB + hstep + kstep, voffB);
        PG8_WAIT_V(6); PG8_BAR;
    }
    for (;;) {
        const bool has_next = S.next(ui + 1, nxt);
        const char* nA = has_next ? (const char*)g.A + nxt.kofs + (size_t)nxt.pm * tstep : cA; const char* nB = has_next ? (const char*)g.Bt + nxt.bofs + nxt.kofs + (size_t)nxt.pn * tstep : cB;
#pragma clang loop unroll(disable)
        for (int t = 0; t < nt; t += 2) {
            const bool last = (t == nt - 2);
            const char* a1 = cA + (size_t)(t + 1) * kstep;
            const char* a2 = last ? nA : cA + (size_t)(t + 2) * kstep; const char* b2 = last ? nB : cB + (size_t)(t + 2) * kstep;
            const char* a3 = a2 + kstep; const char* b3 = b2 + kstep;
            if (last && has_next) S.a_ready(nxt);
            if constexpr (SP2) {
            PG8_LDB(B0, B08, 0, 0); PG8_LDB(B1, B18, 0, 1); PG8_SCHED; PG8_LDA(At, At8, 0, 0); PG8_STAGE(PG8_SA(1, 1), a1 + hstep, voffA);
            PG8_WAIT_V(8); PG8_WAIT_L(0); PG8_BAR; PG8_SCHED8; PG8_MMA(0, 0, At, At8, B0, B08); PG8_MMA(0, 1, At, At8, B1, B18); PG8_SCHED8; PG8_BAR; PG8_SCHED;
            PG8_LDA(At, At8, 0, 1); PG8_STAGE(PG8_SB(0, 0), b2, voffB); PG8_STAGE(PG8_SB(0, 1), b2 + hstep, voffB); PG8_STAGE(PG8_SA(0, 0), a2, voffA);
            PG8_WAIT_V(8); PG8_WAIT_L(0); PG8_BAR; PG8_SCHED8; PG8_MMA(1, 0, At, At8, B0, B08); PG8_MMA(1, 1, At, At8, B1, B18); PG8_SCHED8; PG8_BAR; PG8_SCHED;
            PG8_LDB(B0, B08, 1, 0); PG8_LDB(B1, B18, 1, 1); PG8_SCHED; PG8_LDA(At, At8, 1, 0); PG8_STAGE(PG8_SA(0, 1), a2 + hstep, voffA);
            PG8_WAIT_V(8); PG8_WAIT_L(0); PG8_BAR; PG8_SCHED8; PG8_MMA(0, 0, At, At8, B0, B08); PG8_MMA(0, 1, At, At8, B1, B18); PG8_SCHED8; PG8_BAR; PG8_SCHED;
            PG8_LDA(At, At8, 1, 1); PG8_STAGE(PG8_SB(1, 0), b3, voffB); PG8_STAGE(PG8_SB(1, 1), b3 + hstep, voffB); PG8_STAGE(PG8_SA(1, 0), a3, voffA);
            PG8_WAIT_V(8); PG8_WAIT_L(0); PG8_BAR; PG8_SCHED8; PG8_MMA(1, 0, At, At8, B0, B08); PG8_MMA(1, 1, At, At8, B1, B18); PG8_SCHED8; PG8_BAR; PG8_SCHED;
            } else {
            PG8_LDB(B0, B08, 0, 0); PG8_SCHED; PG8_LDA(At, At8, 0, 0); PG8_STAGE(PG8_SA(1, 1), a1 + hstep, voffA);
            PG8_WAIT_L(8); PG8_BAR; PG8_WAIT_L(0); PG8_MMA(0, 0, At, At8, B0, B08); PG8_BAR; PG8_SCHED;
            PG8_LDB(B1, B18, 0, 1); PG8_STAGE(PG8_SB(0, 0), b2, voffB);
            PG8_BAR; PG8_WAIT_L(0); PG8_MMA(0, 1, At, At8, B1, B18); PG8_BAR;
            PG8_LDA(At, At8, 0, 1); PG8_STAGE(PG8_SA(0, 0), a2, voffA);
            PG8_BAR; PG8_WAIT_L(0); PG8_MMA(1, 0, At, At8, B0, B08); PG8_BAR; PG8_SCHED;
            PG8_STAGE(PG8_SB(0, 1), b2 + hstep, voffB);
            PG8_WAIT_V(6); PG8_BAR; PG8_MMA(1, 1, At, At8, B1, B18); PG8_BAR;
            PG8_LDB(B0, B08, 1, 0); PG8_SCHED; PG8_LDA(At, At8, 1, 0); PG8_STAGE(PG8_SA(0, 1), a2 + hstep, voffA);
            PG8_WAIT_L(8); PG8_BAR; PG8_WAIT_L(0); PG8_MMA(0, 0, At, At8, B0, B08); PG8_BAR; PG8_SCHED;
            PG8_LDB(B1, B18, 1, 1); PG8_STAGE(PG8_SB(1, 0), b3, voffB);
            PG8_BAR; PG8_WAIT_L(0); PG8_MMA(0, 1, At, At8, B1, B18); PG8_BAR;
            PG8_LDA(At, At8, 1, 1); PG8_STAGE(PG8_SA(1, 0), a3, voffA);
            PG8_BAR; PG8_WAIT_L(0); PG8_MMA(1, 0, At, At8, B0, B08); PG8_BAR; PG8_SCHED;
            PG8_STAGE(PG8_SB(1, 1), b3 + hstep, voffB);
            PG8_WAIT_V(6); PG8_BAR; PG8_MMA(1, 1, At, At8, B1, B18); PG8_BAR;
            }
        }
        if constexpr (ALIGN_EPI) { if (wr == 0) PG8_BAR; }
        if constexpr (F8) asm volatile("s_nop 15\n\ts_nop 15" ::: "memory");
        if constexpr (!Epi::AFTER_DRAIN) { E(acc, cur, wr, wc, fr, fq); S.done(cur); }
        if (!has_next) break;
#pragma unroll
        for (int a = 0; a < 2; ++a)
#pragma unroll
            for (int b = 0; b < 2; ++b)
#pragma unroll
                for (int m = 0; m < 4; ++m)
#pragma unroll
                    for (int n = 0; n < 2; ++n) acc[a][b][m][n] = (f32x4){zero_, zero_, zero_, zero_};
        cur = nxt; cA = nA; cB = nB; ++ui;
        if constexpr (ALIGN_EPI) { if (wr == 1) PG8_BAR; }
    }
    PG8_WAIT_V(0);
    if constexpr (!ALIGN_EPI) { if (wr == 0) PG8_BAR; }
    PG8_BAR;
    if constexpr (Epi::AFTER_DRAIN) { E.fused(acc, cur, wr, wc, fr, fq, lds, wid, lane); S.done(cur); }
#undef PG8_SA
#undef PG8_SB
#undef PG8_STAGE
#undef PG8_LDA
#undef PG8_LDB
#undef PG8_MMA
#undef PG8_LD8
#undef PG8_WAIT_V
#undef PG8_WAIT_L
#undef PG8_BAR
#undef PG8_SCHED
#undef PG8_SCHED8
}

}

#define GAS __attribute__((address_space(1)))
#define LAS __attribute__((address_space(3)))
typedef unsigned v4u __attribute__((ext_vector_type(4)));
typedef float f32x4 __attribute__((ext_vector_type(4)));
#define LDS_WAIT() asm volatile("s_waitcnt lgkmcnt(0)" ::: "memory")
#define VM_WAIT() asm volatile("s_waitcnt vmcnt(0)" ::: "memory")

#define XB_TMO      128
#define XB_XCNT(j)  (256  + 64 * (j))
#define XB_XSUB(j)  (1280 + 64 * (j))
#define XB_XGEN(j)  (2304 + 64 * (j))
#define XB_TOP      3328
#define XB_TOPGEN   3392
#define XCD_BAR_WORDS 3456
#define XB_SPIN_CAP (1u << 18)

__device__ __forceinline__ unsigned xb_ld(unsigned* p)              { return __hip_atomic_load(p, __ATOMIC_RELAXED, __HIP_MEMORY_SCOPE_AGENT); }
__device__ __forceinline__ unsigned xb_add(unsigned* p, unsigned v) { return __hip_atomic_fetch_add(p, v, __ATOMIC_RELAXED, __HIP_MEMORY_SCOPE_AGENT); }
__device__ __forceinline__ unsigned xb_xcc_id() { return (unsigned)__builtin_amdgcn_s_getreg((3 << 11) | 20) & 0xFu; }
#define XB_SPIN(cond, bar) do { unsigned _sp = 0; while (cond) { __builtin_amdgcn_s_sleep(1); \
    if ((++_sp & 255u) == 0u) { if (xb_ld(&(bar)[XB_TMO])) break; if (_sp > XB_SPIN_CAP) { atomicAdd(&(bar)[XB_TMO], 1u); break; } } } } while (0)

struct XcdBarrier {
    unsigned* bar; unsigned x;
    volatile LAS unsigned* st;
};

__device__ __forceinline__ XcdBarrier xcd_barrier_post(unsigned* bar, volatile LAS unsigned* st, bool t0) {
    XcdBarrier b; b.bar = bar; b.x = xb_xcc_id(); b.st = st;
    if (t0) (void)xb_add(&bar[XB_XCNT(b.x)], 1u);
    return b;
}
__device__ __forceinline__ void xcd_barrier_complete(unsigned* bar, unsigned x, unsigned& nloc, unsigned& nx) {
    const unsigned G = gridDim.x * gridDim.y * gridDim.z;
    unsigned sum, cnt, mine, sp = 0u;
    for (;;) {
        sum = 0u; cnt = 0u; mine = 0u;
#pragma unroll
        for (unsigned j = 0; j < 16; ++j) { const unsigned c = xb_ld(&bar[XB_XCNT(j)]); sum += c; cnt += (c > 0u) ? 1u : 0u; mine = (j == x) ? c : mine; }
        if (sum == G) break;
        __builtin_amdgcn_s_sleep(1);
        if ((++sp & 255u) == 0u) { if (xb_ld(&bar[XB_TMO])) break; if (sp > XB_SPIN_CAP) { atomicAdd(&bar[XB_TMO], 1u); break; } }
    }
    nloc = mine > 0u ? mine : 1u; nx = cnt > 0u ? cnt : 1u;
}

__device__ __forceinline__ void xcd_barrier(const XcdBarrier& b, bool t0) {
    asm volatile("s_waitcnt vmcnt(0)" ::: "memory");
    __syncthreads();
    if (t0) {
        unsigned* bar = b.bar;
        __builtin_amdgcn_s_waitcnt(0);
        unsigned nloc = b.st[0], nx = b.st[1];
        if (nloc == 0u) { xcd_barrier_complete(bar, b.x, nloc, nx); b.st[0] = nloc; b.st[1] = nx; }
        const unsigned old = xb_add(&bar[XB_XSUB(b.x)], 1u);
        const unsigned gen = old / nloc;
        if (old + 1u == (gen + 1u) * nloc) {
            __builtin_amdgcn_fence(__ATOMIC_RELEASE, "agent");
            asm volatile("s_waitcnt vmcnt(0)" ::: "memory");
            const unsigned og = xb_add(&bar[XB_TOP], 1u);
            const unsigned tg = og / nx;
            if (og + 1u == (tg + 1u) * nx) xb_add(&bar[XB_TOPGEN], 1u);
            else XB_SPIN(xb_ld(&bar[XB_TOPGEN]) == tg, bar);
            __builtin_amdgcn_fence(__ATOMIC_ACQUIRE, "agent");
            xb_add(&bar[XB_XGEN(b.x)], 1u);
            asm volatile("s_waitcnt vmcnt(0)" ::: "memory");
        } else {
            XB_SPIN(xb_ld(&bar[XB_XGEN(b.x)]) == gen, bar);
            __builtin_amdgcn_fence(__ATOMIC_ACQUIRE, "agent");
            asm volatile("s_waitcnt vmcnt(0)" ::: "memory");
        }
    }
    __syncthreads();
}

constexpr int RING_OFF = 0, RING_BYTES = 131072;
constexpr int MISC_OFF = 143360;
constexpr int LDS_BYTES = 147456;
constexpr int NWAVES = 8;

struct Ctx { LAS unsigned char* lds; volatile LAS unsigned* MISC; unsigned* ctl; int wave, G, gw, NGW; };

__device__ __forceinline__ void cvt_item(const float* W, int K, int N, bf16_t* WT, int mode, LAS float* scr, int item, int lane) {
    const int kblk = K / 64, nb = item / kblk, kb = item % kblk, k0 = 64 * kb, n0 = 64 * nb;
    f32x4 ld[16];
#pragma unroll
    for (int i = 0; i < 16; ++i) { const int kk = 4 * i + (lane >> 4), c4 = 4 * (lane & 15); ld[i] = __builtin_nontemporal_load((const f32x4*)(W + (size_t)(k0 + kk) * N + n0 + c4));     }
#pragma unroll
    for (int i = 0; i < 16; ++i) { const int kk = 4 * i + (lane >> 4), c4 = 4 * (lane & 15);
        LAS float* s = scr + kk * 65 + c4; s[0] = ld[i][0]; s[1] = ld[i][1]; s[2] = ld[i][2]; s[3] = ld[i][3]; }
    LDS_WAIT(); asm volatile("" ::: "memory");
    const int c = lane >> 3;
#pragma unroll
    for (int j = 0; j < 8; ++j) { const int n = (lane & 7) + 8 * j; const LAS float* s = scr + (8 * c) * 65 + n;
        v4u o; o.x = pk2(s[0 * 65], s[1 * 65]); o.y = pk2(s[2 * 65], s[3 * 65]); o.z = pk2(s[4 * 65], s[5 * 65]); o.w = pk2(s[6 * 65], s[7 * 65]);
        const int nn = n0 + n; const int drow = mode == 0 ? nn : (nn / 128) * 256 + (mode - 1) * 128 + (nn % 128);
        *(v4u*)(WT + (size_t)drow * K + k0 + 8 * c) = o; }
    LDS_WAIT(); asm volatile("" ::: "memory");
}
__device__ __forceinline__ void cvt_item8(const float* W, int K, int N, unsigned char* WT, int mode, LAS float* scr, int item, int lane) {
    const int kblk = K / 64, nb = item / kblk, kb = item % kblk, k0 = 64 * kb, n0 = 64 * nb;
    f32x4 ld[16];
#pragma unroll
    for (int i = 0; i < 16; ++i) { const int kk = 4 * i + (lane >> 4), c4 = 4 * (lane & 15); ld[i] = __builtin_nontemporal_load((const f32x4*)(W + (size_t)(k0 + kk) * N + n0 + c4));     }
#pragma unroll
    for (int i = 0; i < 16; ++i) { const int kk = 4 * i + (lane >> 4), c4 = 4 * (lane & 15);
        LAS float* s = scr + kk * 65 + c4; s[0] = ld[i][0]; s[1] = ld[i][1]; s[2] = ld[i][2]; s[3] = ld[i][3]; }
    LDS_WAIT(); asm volatile("" ::: "memory");
    const int c = lane >> 3;
#pragma unroll
    for (int j = 0; j < 8; ++j) { const int n = (lane & 7) + 8 * j; const LAS float* s = scr + (8 * c) * 65 + n;
        v2u o; o.x = pk4_fp8(s[0 * 65] * W8_SCALE, s[1 * 65] * W8_SCALE, s[2 * 65] * W8_SCALE, s[3 * 65] * W8_SCALE); o.y = pk4_fp8(s[4 * 65] * W8_SCALE, s[5 * 65] * W8_SCALE, s[6 * 65] * W8_SCALE, s[7 * 65] * W8_SCALE);
        const int nn = n0 + n; const int drow = mode == 0 ? nn : (nn / 128) * 256 + (mode - 1) * 128 + (nn % 128);
        *(v2u*)(WT + (size_t)drow * K + k0 + 8 * c) = o; }
    LDS_WAIT(); asm volatile("" ::: "memory");
}
__device__ __forceinline__ void p0_prologue(const Params& p, Ctx& F) {
    const int lane_ = lane_id(), tid_ = F.wave * 64 + lane_;
    LAS float* fl = (LAS float*)(F.lds + RING_OFF);
    for (int it = blockIdx.x; it < 192; it += F.G) {
        const int l = it / 96, n = (it % 96) * 64 + lane_;
        LAS float* sv = fl;
        LAS float* red = fl + 3 * 1024;
        for (int i = tid_; i < 3 * 1024; i += 512) { const int rt = i >> 10, k = i & 1023; const float v = rt < 2 ? p.in[I_C][rt * DM + k] : p.in[I_CCTX][k]; sv[i] = siluf(v); }
        __syncthreads();
        const float* W = p.in[I_ADAW] + (size_t)l * DM * 6144 + n;
        float a0 = 0.f, a1 = 0.f, a2 = 0.f;
        for (int kb = 0; kb < 128; kb += 32) {
            float wv[32];
#pragma unroll
            for (int j = 0; j < 32; ++j) wv[j] = W[(size_t)(F.wave * 128 + kb + j) * 6144];
#pragma unroll
            for (int j = 0; j < 32; ++j) { const int k = F.wave * 128 + kb + j; a0 += sv[k] * wv[j]; a1 += sv[1024 + k] * wv[j]; a2 += sv[2048 + k] * wv[j]; }
        }
        red[(F.wave * 3 + 0) * 64 + lane_] = a0; red[(F.wave * 3 + 1) * 64 + lane_] = a1; red[(F.wave * 3 + 2) * 64 + lane_] = a2;
        __syncthreads();
        if (tid_ < 192) { const int rt = tid_ >> 6, ln = tid_ & 63; float s = 0.f;
#pragma unroll
            for (int w = 0; w < 8; ++w) s += red[(w * 3 + rt) * 64 + ln];
            const int nn = (it % 96) * 64 + ln;
            ((float*)(p.ws + WS_MODV))[(size_t)(l * 3 + rt) * 6144 + nn] = s + p.in[I_ADAB][l * 6144 + nn]; }
        __syncthreads();
    }
    LAS float* scr = (LAS float*)(F.lds + RING_OFF) + F.wave * (64 * 65);
    constexpr int S_WIN = 16 * 56, S_WOUT = 16 * 16, S_F = 16 * 44;
    constexpr int NITEMS = 2 * S_WIN + 2 * S_WOUT + 3 * S_F + 24 * S_F;
    static_assert(NITEMS == 21312, "items");
    for (int it = F.gw; it < NITEMS; it += F.NGW) {
        int r = it;
        if (r < 2 * S_WIN) { const int l = r / S_WIN; cvt_item(p.in[I_WIN] + (size_t)l * DM * DP, DM, DP, (bf16_t*)(p.ws + W_WIN) + (size_t)l * DP * DM, 0, scr, r % S_WIN, lane_); continue; } r -= 2 * S_WIN;
        if (r < 2 * S_WOUT) { const int l = r / S_WOUT; cvt_item(p.in[I_WOUT] + (size_t)l * DM * DM, DM, DM, (bf16_t*)(p.ws + W_WOUT) + (size_t)l * DM * DM, 0, scr, r % S_WOUT, lane_); continue; } r -= 2 * S_WOUT;
        if (r < S_F) { cvt_item(p.in[I_FWG], DM, DFF, (bf16_t*)(p.ws + W_FGU), 1, scr, r, lane_); continue; } r -= S_F;
        if (r < S_F) { cvt_item(p.in[I_FWU], DM, DFF, (bf16_t*)(p.ws + W_FGU), 2, scr, r, lane_); continue; } r -= S_F;
        if (r < S_F) { cvt_item(p.in[I_FWD], DFF, DM, (bf16_t*)(p.ws + W_FD), 0, scr, r, lane_); continue; } r -= S_F;
        if (r < 8 * S_F) { const int e = r / S_F; cvt_item8(p.in[I_MWG] + (size_t)e * DM * DFF, DM, DFF, (unsigned char*)(p.ws + W_MGU) + (size_t)e * 2 * DFF * DM, 1, scr, r % S_F, lane_); continue; } r -= 8 * S_F;
        if (r < 8 * S_F) { const int e = r / S_F; cvt_item8(p.in[I_MWU] + (size_t)e * DM * DFF, DM, DFF, (unsigned char*)(p.ws + W_MGU) + (size_t)e * 2 * DFF * DM, 2, scr, r % S_F, lane_); continue; } r -= 8 * S_F;
        { const int e = r / S_F; cvt_item8(p.in[I_MWD] + (size_t)e * DFF * DM, DFF, DM, (unsigned char*)(p.ws + W_MD) + (size_t)e * DM * DFF, 0, scr, r % S_F, lane_); }
    }
}

__device__ __forceinline__ void norm_phase(const Params& p, Ctx& F, int l, int which, int nrows) {
    const int lane_ = lane_id(), tid_ = F.wave * 64 + lane_;
    const float* g = p.in[which ? I_N2G : I_N1G] + l * DM;
    for (int m = F.gw; m < nrows; m += F.NGW) {
        const float* xrow;
        if (l == 0 && which == 0) xrow = m < NL ? p.in[I_X] + (size_t)m * DM : p.in[I_CTX] + (size_t)(m - NL) * DM;
        else xrow = xr_row(p, m);
        const int rt = rowtype(m);
        const float* sh = modv(p, l, rt, which ? 3 : 0); const float* sc = modv(p, l, rt, which ? 4 : 1);
        f32x4 v[4]; float ss = 0.f;
        if (m >= NL && !(l == 0 && which == 0)) {
            const int nsl = which ? DM / 256 : DFF / 256; const float* gate = modv(p, 0, 2, which ? 2 : 5);
            const float* base = (l == 0) ? p.in[I_CTX] + (size_t)(m - NL) * DM : xrow;
            const float* part = (const float*)(p.ws + WS_PART) + (size_t)(m - NL) * DM;
#pragma unroll
            for (int j = 0; j < 4; ++j) { const int col = 256 * j + 4 * lane_; f32x4 a = {0.f, 0.f, 0.f, 0.f};
                for (int sl = 0; sl < nsl; ++sl) a += *(const f32x4*)(part + (size_t)sl * NC * DM + col);
                v[j] = *(const f32x4*)(base + col) + *(const f32x4*)(gate + col) * a;
                *(f32x4*)((float*)(p.ws + WS_XRC) + (size_t)(m - NL) * DM + col) = v[j];
                ss += (v[j][0] * v[j][0] + v[j][1] * v[j][1]) + (v[j][2] * v[j][2] + v[j][3] * v[j][3]); }
        } else
#pragma unroll
        for (int j = 0; j < 4; ++j) { v[j] = *(const f32x4*)(xrow + 256 * j + 4 * lane_); ss += (v[j][0] * v[j][0] + v[j][1] * v[j][1]) + (v[j][2] * v[j][2] + v[j][3] * v[j][3]); }
        const float r = rsqrtf(wave_sum(ss) * (1.f / DM) + EPS);
        bf16_t* hb = (bf16_t*)(p.ws + WS_HBUF) + (size_t)m * DM;
#pragma unroll
        for (int j = 0; j < 4; ++j) { const int col = 256 * j + 4 * lane_;
            const f32x4 gg = *(const f32x4*)(g + col), s4 = *(const f32x4*)(sc + col), h4 = *(const f32x4*)(sh + col);
            const f32x4 y = v[j] * r * gg * (1.f + s4) + h4;
            v2u o; o.x = pk2(y[0], y[1]); o.y = pk2(y[2], y[3]); *(v2u*)(hb + col) = o; }
    }
}


__device__ __forceinline__ void router_phase(const Params& p, Ctx& F) {
    const int lane_ = lane_id(), tid_ = F.wave * 64 + lane_;
    LAS int* lcnt = (LAS int*)(F.lds + RING_OFF);
    LAS int* gbase = lcnt + 8;
    LAS int* ent_e = lcnt + 16;
    LAS int* ent_pos = lcnt + 16 + 128;
    const float* g = p.in[I_N2G] + DM; const float* rw = p.in[I_RW];
    int* tok_e = (int*)(p.ws + WS_ROUTE); float* tok_w = (float*)(p.ws + WS_ROUTE) + 2 * NL; int* tok_pos = (int*)(p.ws + WS_ROUTE) + 4 * NL;
    f32x4 rwa[4][4], rwb[4][4];
#pragma unroll
    for (int j = 0; j < 4; ++j)
#pragma unroll
        for (int q = 0; q < 4; ++q) { const int col = 256 * j + 4 * lane_ + q; rwa[j][q] = *(const f32x4*)(rw + (size_t)col * 8); rwb[j][q] = *(const f32x4*)(rw + (size_t)col * 8 + 4); }
    const int myexp = ((lane_ >> 5) & 1) * 4 + ((lane_ >> 4) & 1) * 2 + ((lane_ >> 3) & 1);
    for (int ch = blockIdx.x; ch < NL / 64; ch += F.G) {
        if (tid_ < 8) lcnt[tid_] = 0;
        __syncthreads();
        const int rt = (ch * 64) / T;
        const float* sh = modv(p, 1, rt, 3); const float* sc = modv(p, 1, rt, 4);
        f32x4 gs[4], hs[4]; float bsum;
        { float bb[8] = {0.f, 0.f, 0.f, 0.f, 0.f, 0.f, 0.f, 0.f};
#pragma unroll
          for (int j = 0; j < 4; ++j) { const int col = 256 * j + 4 * lane_; gs[j] = *(const f32x4*)(g + col) * (1.f + *(const f32x4*)(sc + col)); hs[j] = *(const f32x4*)(sh + col);
#pragma unroll
            for (int q = 0; q < 4; ++q) { bb[0] += hs[j][q] * rwa[j][q][0]; bb[1] += hs[j][q] * rwa[j][q][1]; bb[2] += hs[j][q] * rwa[j][q][2]; bb[3] += hs[j][q] * rwa[j][q][3];
                                          bb[4] += hs[j][q] * rwb[j][q][0]; bb[5] += hs[j][q] * rwb[j][q][1]; bb[6] += hs[j][q] * rwb[j][q][2]; bb[7] += hs[j][q] * rwb[j][q][3]; } }
          float c4[4];
#pragma unroll
          for (int k = 0; k < 4; ++k) { const float keep = (lane_ & 32) ? bb[k + 4] : bb[k], give = (lane_ & 32) ? bb[k] : bb[k + 4]; c4[k] = keep + __shfl_xor(give, 32); }
          float c2[2];
#pragma unroll
          for (int k = 0; k < 2; ++k) { const float keep = (lane_ & 16) ? c4[k + 2] : c4[k], give = (lane_ & 16) ? c4[k] : c4[k + 2]; c2[k] = keep + __shfl_xor(give, 16); }
          float c1 = ((lane_ & 8) ? c2[1] : c2[0]) + __shfl_xor((lane_ & 8) ? c2[0] : c2[1], 8);
          c1 += __shfl_xor(c1, 4); c1 += __shfl_xor(c1, 2); c1 += __shfl_xor(c1, 1);
          bsum = c1 + p.in[I_RB][myexp]; }
        for (int i = 0; i < 8; ++i) {
            const int ti = F.wave * 8 + i, m = ch * 64 + ti;
            const float* xrow = p.out + (size_t)m * DM;
            f32x4 v[4]; float ss = 0.f; float aa[8] = {0.f, 0.f, 0.f, 0.f, 0.f, 0.f, 0.f, 0.f};
#pragma unroll
            for (int j = 0; j < 4; ++j) { v[j] = *(const f32x4*)(xrow + 256 * j + 4 * lane_); ss += (v[j][0] * v[j][0] + v[j][1] * v[j][1]) + (v[j][2] * v[j][2] + v[j][3] * v[j][3]); }
#pragma unroll
            for (int j = 0; j < 4; ++j) { v[j] = v[j] * gs[j];
#pragma unroll
                for (int q = 0; q < 4; ++q) { aa[0] += v[j][q] * rwa[j][q][0]; aa[1] += v[j][q] * rwa[j][q][1]; aa[2] += v[j][q] * rwa[j][q][2]; aa[3] += v[j][q] * rwa[j][q][3];
                                              aa[4] += v[j][q] * rwb[j][q][0]; aa[5] += v[j][q] * rwb[j][q][1]; aa[6] += v[j][q] * rwb[j][q][2]; aa[7] += v[j][q] * rwb[j][q][3]; } }
            float c4[4];
#pragma unroll
            for (int k = 0; k < 4; ++k) { const float keep = (lane_ & 32) ? aa[k + 4] : aa[k], give = (lane_ & 32) ? aa[k] : aa[k + 4]; c4[k] = keep + __shfl_xor(give, 32); }
            float c2[2];
#pragma unroll
            for (int k = 0; k < 2; ++k) { const float keep = (lane_ & 16) ? c4[k + 2] : c4[k], give = (lane_ & 16) ? c4[k] : c4[k + 2]; c2[k] = keep + __shfl_xor(give, 16); }
            float c1 = ((lane_ & 8) ? c2[1] : c2[0]) + __shfl_xor((lane_ & 8) ? c2[0] : c2[1], 8);
            c1 += __shfl_xor(c1, 4); c1 += __shfl_xor(c1, 2); c1 += __shfl_xor(c1, 1);
            const float r = rsqrtf(wave_sum(ss) * (1.f / DM) + EPS);
            const float mylogit = r * c1 + bsum;
#define RLF(L) __uint_as_float((unsigned)__builtin_amdgcn_readlane((int)__float_as_uint(mylogit), L))
            const float lg0 = RLF(0), lg1 = RLF(8), lg2 = RLF(16), lg3 = RLF(24), lg4 = RLF(32), lg5 = RLF(40), lg6 = RLF(48), lg7 = RLF(56);
#undef RLF
            unsigned char* hb = (unsigned char*)(p.ws + WS_HBUF) + (size_t)m * DM;
#pragma unroll
            for (int j = 0; j < 4; ++j) { const f32x4 y = v[j] * r + hs[j]; *(unsigned*)(hb + 256 * j + 4 * lane_) = pk4_fp8(y[0], y[1], y[2], y[3]); }
            int i1 = 0; float v1 = lg0;
            if (lg1 > v1) { v1 = lg1; i1 = 1; } if (lg2 > v1) { v1 = lg2; i1 = 2; } if (lg3 > v1) { v1 = lg3; i1 = 3; }
            if (lg4 > v1) { v1 = lg4; i1 = 4; } if (lg5 > v1) { v1 = lg5; i1 = 5; } if (lg6 > v1) { v1 = lg6; i1 = 6; } if (lg7 > v1) { v1 = lg7; i1 = 7; }
            int i2 = -1; float v2 = -3.4e38f;
            if (i1 != 0 && lg0 > v2) { v2 = lg0; i2 = 0; } if (i1 != 1 && lg1 > v2) { v2 = lg1; i2 = 1; } if (i1 != 2 && lg2 > v2) { v2 = lg2; i2 = 2; } if (i1 != 3 && lg3 > v2) { v2 = lg3; i2 = 3; }
            if (i1 != 4 && lg4 > v2) { v2 = lg4; i2 = 4; } if (i1 != 5 && lg5 > v2) { v2 = lg5; i2 = 5; } if (i1 != 6 && lg6 > v2) { v2 = lg6; i2 = 6; } if (i1 != 7 && lg7 > v2) { v2 = lg7; i2 = 7; }
            const float w1 = 1.f / (1.f + __expf(v2 - v1));
            if (lane_ == 0) {
                const int p1 = __hip_atomic_fetch_add(lcnt + i1, 1, __ATOMIC_RELAXED, __HIP_MEMORY_SCOPE_WORKGROUP);
                const int p2 = __hip_atomic_fetch_add(lcnt + i2, 1, __ATOMIC_RELAXED, __HIP_MEMORY_SCOPE_WORKGROUP);
                ent_e[2 * ti] = i1; ent_e[2 * ti + 1] = i2; ent_pos[2 * ti] = p1; ent_pos[2 * ti + 1] = p2;
                tok_e[2 * m] = i1; tok_e[2 * m + 1] = i2; tok_w[2 * m] = w1; tok_w[2 * m + 1] = 1.f - w1; }
        }
        __syncthreads();
        if (tid_ < 8) gbase[tid_] = (int)__hip_atomic_fetch_add(F.ctl + CW_CNT + 64 * tid_, (unsigned)lcnt[tid_], __ATOMIC_RELAXED, __HIP_MEMORY_SCOPE_AGENT);
        __syncthreads();
        if (tid_ < 128) tok_pos[ch * 128 + tid_] = gbase[ent_e[tid_]] + ent_pos[tid_];
        __syncthreads();
    }
}
__device__ __forceinline__ void moe_table(Ctx& F) {
    const int lane_ = lane_id(), tid_ = F.wave * 64 + lane_;
    volatile LAS unsigned* tb = F.MISC + 32;
    if (tid_ == 0) { unsigned acc = 0;
        for (int e = 0; e < 8; ++e) { const unsigned c = __hip_atomic_load(F.ctl + CW_CNT + 64 * e, __ATOMIC_RELAXED, __HIP_MEMORY_SCOPE_AGENT); tb[e] = acc; tb[16 + e] = c; acc += (c + 255u) / 256u * 256u; }
        tb[8] = acc; }
    __syncthreads();
}
__device__ __forceinline__ void moe_order(Ctx& F, pg8::Order& S, int nN, long estride) {
    volatile LAS unsigned* tb = F.MISC + 32;
#define RFL(x) __builtin_amdgcn_readfirstlane((int)(x))
    S.init(RFL(tb[8] / 256u), nN, F.G, (int)blockIdx.x);
    S.e1 = RFL(tb[1] / 256u); S.e2 = RFL(tb[2] / 256u); S.e3 = RFL(tb[3] / 256u); S.e4 = RFL(tb[4] / 256u); S.e5 = RFL(tb[5] / 256u); S.e6 = RFL(tb[6] / 256u); S.e7 = RFL(tb[7] / 256u);
#undef RFL
    S.estride = estride;
}
__device__ __forceinline__ void gather_phase(const Params& p, Ctx& F) {
    const int lane_ = lane_id(), tid_ = F.wave * 64 + lane_;
    moe_table(F);
    volatile LAS unsigned* tb = F.MISC + 32;
    const int* tok_e = (const int*)(p.ws + WS_ROUTE); const float* tok_w = (const float*)(p.ws + WS_ROUTE) + 2 * NL; const int* tok_pos = (const int*)(p.ws + WS_ROUTE) + 4 * NL;
    int* row_tok = (int*)(p.ws + WS_ROUTE) + 6 * NL; float* row_gate = (float*)(p.ws + WS_ROUTE) + 6 * NL + MP_MAX;
    const unsigned char* hb = (const unsigned char*)(p.ws + WS_HBUF); unsigned char* h2s = (unsigned char*)(p.ws + WS_H2S);
    for (int it = F.gw; it < 2 * NL; it += F.NGW) {
        const int t = it >> 1, e = tok_e[it], r = (int)tb[e] + tok_pos[it];
        *((v4u*)(h2s + (size_t)r * DM) + lane_) = *((const v4u*)(hb + (size_t)t * DM) + lane_);
        if (lane_ == 0) { row_tok[r] = t; row_gate[r] = tok_w[it]; }
    }
    for (int i = F.gw; i < NE * 256; i += F.NGW) {
        const int e = i >> 8, j = i & 255, r = (int)tb[e] + (int)tb[16 + e] + j;
        if (r < (int)tb[e + 1]) { const v4u z = {0u, 0u, 0u, 0u}; *((v4u*)(h2s + (size_t)r * DM) + lane_) = z; if (lane_ == 0) { row_tok[r] = -1; row_gate[r] = 0.f; } }
    }
}
__device__ __forceinline__ void combine_phase(const Params& p, Ctx& F) {
    const int lane_ = lane_id(), tid_ = F.wave * 64 + lane_;
    moe_table(F);
    volatile LAS unsigned* tb = F.MISC + 32;
    const int* tok_e = (const int*)(p.ws + WS_ROUTE); const int* tok_pos = (const int*)(p.ws + WS_ROUTE) + 4 * NL;
    const bf16_t* yb = (const bf16_t*)(p.ws + WS_YBUF);
    for (int t = F.gw; t < NL; t += F.NGW) {
        const int r0 = (int)tb[tok_e[2 * t]] + tok_pos[2 * t], r1 = (int)tb[tok_e[2 * t + 1]] + tok_pos[2 * t + 1];
        const float* g5 = modv(p, 1, t / T, 5);
        float* orow = p.out + (size_t)t * DM;
#pragma unroll
        for (int j = 0; j < 4; ++j) { const int col = 256 * j + 4 * lane_;
            const v2u a = *(const v2u*)(yb + (size_t)r0 * DM + col), b = *(const v2u*)(yb + (size_t)r1 * DM + col);
            f32x4 y; y[0] = __uint_as_float(a.x << 16) + __uint_as_float(b.x << 16); y[1] = __uint_as_float(a.x & 0xffff0000u) + __uint_as_float(b.x & 0xffff0000u);
            y[2] = __uint_as_float(a.y << 16) + __uint_as_float(b.y << 16); y[3] = __uint_as_float(a.y & 0xffff0000u) + __uint_as_float(b.y & 0xffff0000u);
            const f32x4 x = *(const f32x4*)(orow + col), gg = *(const f32x4*)(g5 + col);
            *(f32x4*)(orow + col) = x + gg * y; }
    }
}

namespace att {
constexpr float THR = 8.f;
constexpr int KVBLK = 64;
constexpr int SHM_V = KVBLK * 128 * 2, SHM_K = KVBLK * 128 * 2;
using bf16x8 = __attribute__((ext_vector_type(8))) short;
using s16x4  = __attribute__((ext_vector_type(4))) short;
using f32x16 = __attribute__((ext_vector_type(16))) float;
using f32x8  = __attribute__((ext_vector_type(8))) float;
using u32x4  = __attribute__((ext_vector_type(4))) unsigned;
using f32x4v = __attribute__((ext_vector_type(4))) float;
#define KSWZ(row, colB) ((row) * 256 + ((colB) ^ (((row) & 7) << 4)))
#define SBAR() __builtin_amdgcn_sched_barrier(0)
__device__ __forceinline__ int crow(int r, int hi) { return (r & 3) + 8 * (r >> 2) + 4 * hi; }
__device__ __forceinline__ unsigned cvtpk(float lo, float hi) {
  unsigned r; asm volatile("v_cvt_pk_bf16_f32 %0, %1, %2" : "=v"(r) : "v"(lo), "v"(hi)); return r;
}
__device__ __forceinline__ void partialSM(f32x16& p0, f32x16& p1, float& m_reg, float& mn, float& alpha) {
  constexpr float C = 1.4426950408889634f;
  float pmax = p0[0]; for (int r = 1; r < 16; ++r) pmax = fmaxf(pmax, p0[r]); for (int r = 0; r < 16; ++r) pmax = fmaxf(pmax, p1[r]);
  { auto rr = __builtin_amdgcn_permlane32_swap(__float_as_uint(pmax), __float_as_uint(pmax), false, false);
    pmax = fmaxf(__uint_as_float(rr[0]), __uint_as_float(rr[1])); }
  if (__builtin_expect(__all(pmax - m_reg <= THR), 1)) { mn = m_reg; alpha = 1.f; }
  else { mn = fmaxf(m_reg, pmax); alpha = __builtin_amdgcn_exp2f((m_reg - mn) * C); m_reg = mn; }
  float mnC = -mn * C;
  for (int r = 0; r < 16; ++r) p0[r] = fmaf(p0[r], C, mnC); for (int r = 0; r < 16; ++r) p1[r] = fmaf(p1[r], C, mnC);
  for (int r = 0; r < 16; ++r) p0[r] = __builtin_amdgcn_exp2f(p0[r]);
}
__device__ __forceinline__ void finishSM(f32x16& p0, f32x16& p1, float alpha, float& l_reg, bf16x8& pa0, bf16x8& pa1, bf16x8& pa2, bf16x8& pa3) {
  for (int r = 0; r < 16; ++r) p1[r] = __builtin_amdgcn_exp2f(p1[r]);
  float ps = 0; for (int r = 0; r < 16; ++r) ps += p0[r]; for (int r = 0; r < 16; ++r) ps += p1[r];
  { auto rr = __builtin_amdgcn_permlane32_swap(__float_as_uint(ps), __float_as_uint(ps), false, false);
    ps = __uint_as_float(rr[0]) + __uint_as_float(rr[1]); }
  l_reg = l_reg * alpha + ps;
#define PK4(P, BASE, OUT) do { unsigned a0 = cvtpk(P[BASE + 0], P[BASE + 1]), a1 = cvtpk(P[BASE + 2], P[BASE + 3]);   \
    unsigned b0 = cvtpk(P[BASE + 4], P[BASE + 5]), b1 = cvtpk(P[BASE + 6], P[BASE + 7]);                              \
    auto r0 = __builtin_amdgcn_permlane32_swap(a0, b0, false, false); auto r1 = __builtin_amdgcn_permlane32_swap(a1, b1, false, false); \
    u32x4 w = {r0[0], r1[0], r0[1], r1[1]}; OUT = *reinterpret_cast<bf16x8*>(&w); } while (0)
  PK4(p0, 0, pa0); PK4(p0, 8, pa1); PK4(p1, 0, pa2); PK4(p1, 8, pa3);
#undef PK4
}
template <int ND0>
__device__ __forceinline__ void qkt(f32x16& p0, f32x16& p1, const LAS char* Ks, const bf16x8* qr, int r32, int hi, int dbase) {
  p0 = f32x16{}; p1 = f32x16{};
#pragma unroll
  for (int d0 = 0; d0 < ND0; ++d0) { int cb = ((dbase + d0) * 16 + hi * 8) * 2;
    bf16x8 b0 = *reinterpret_cast<const LAS bf16x8*>(Ks + KSWZ(r32, cb));
    bf16x8 b1 = *reinterpret_cast<const LAS bf16x8*>(Ks + KSWZ(32 + r32, cb));
    p0 = __builtin_amdgcn_mfma_f32_32x32x16_bf16(b0, qr[d0], p0, 0, 0, 0);
    p1 = __builtin_amdgcn_mfma_f32_32x32x16_bf16(b1, qr[d0], p1, 0, 0, 0); }
}
__device__ __forceinline__ int v_st(int k, int c) { const int kk = (k & ~0xC) | ((k & 4) << 1) | ((k & 8) >> 1); return ((kk >> 3) * 4 + (c >> 5)) * 512 + ((kk & 7) * 32 + (c & 31)) * 2; }
__device__ __forceinline__ int v_st_lin(int k, int c) { return ((k >> 3) * 4 + (c >> 5)) * 512 + ((k & 7) * 32 + (c & 31)) * 2; }
__device__ __forceinline__ int v_rd_base(int lane) { return ((lane & 3) << 3) | (((lane >> 2) & 3) << 6) | (((lane >> 4) & 1) << 5) | (((lane >> 5) & 1) << 8); }
constexpr int v_rd_off(int d0, int ks, int half) { return d0 * 512 + ks * 4096 + half * 2048; }
template <int OFF> __device__ __forceinline__ s16x4 tr_read(int vb) {
  s16x4 r; asm volatile("ds_read_b64_tr_b16 %0, %1 offset:%2" : "=&v"(r) : "v"(vb), "i"(OFF) : "memory"); return r;
}
template <int D0> __device__ __forceinline__ void pv_one(f32x16& od, int vb, bf16x8 pa0, bf16x8 pa1, bf16x8 pa2, bf16x8 pa3) {
  const s16x4 l0 = tr_read<v_rd_off(D0, 0, 0)>(vb), h0 = tr_read<v_rd_off(D0, 0, 1)>(vb), l1 = tr_read<v_rd_off(D0, 1, 0)>(vb), h1 = tr_read<v_rd_off(D0, 1, 1)>(vb);
  const s16x4 l2 = tr_read<v_rd_off(D0, 2, 0)>(vb), h2 = tr_read<v_rd_off(D0, 2, 1)>(vb), l3 = tr_read<v_rd_off(D0, 3, 0)>(vb), h3 = tr_read<v_rd_off(D0, 3, 1)>(vb);
#if defined(DUMMY_TR) && DUMMY_TR
  { s16x4 dd; for (int i = 0; i < DUMMY_TR; ++i) asm volatile("ds_read_b64_tr_b16 %0, %1 offset:%2" : "=&v"(dd) : "v"(vb), "i"(v_rd_off(D0, 0, 0)) : "memory"); }
#endif
#if defined(DUMMY_MFMA) && DUMMY_MFMA
  { f32x4v dm = {0.f, 0.f, 0.f, 0.f}; for (int i = 0; i < DUMMY_MFMA; ++i) asm volatile("v_mfma_f32_16x16x32_bf16 %0, %1, %2, %0" : "+v"(dm) : "v"(pa0), "v"(pa1)); }
#endif
  asm volatile("s_waitcnt lgkmcnt(0)" ::: "memory"); SBAR();
#define PK(L, H) (bf16x8){L[0], L[1], L[2], L[3], H[0], H[1], H[2], H[3]}
  od = __builtin_amdgcn_mfma_f32_32x32x16_bf16(pa0, PK(l0, h0), od, 0, 0, 0);
  od = __builtin_amdgcn_mfma_f32_32x32x16_bf16(pa1, PK(l1, h1), od, 0, 0, 0);
  od = __builtin_amdgcn_mfma_f32_32x32x16_bf16(pa2, PK(l2, h2), od, 0, 0, 0);
  od = __builtin_amdgcn_mfma_f32_32x32x16_bf16(pa3, PK(l3, h3), od, 0, 0, 0);
#undef PK
}
__device__ __forceinline__ void pv_d0(f32x16* o, int vb, bf16x8 pa0, bf16x8 pa1, bf16x8 pa2, bf16x8 pa3) {
  pv_one<0>(o[0], vb, pa0, pa1, pa2, pa3); pv_one<1>(o[1], vb, pa0, pa1, pa2, pa3); pv_one<2>(o[2], vb, pa0, pa1, pa2, pa3); pv_one<3>(o[3], vb, pa0, pa1, pa2, pa3);
}

#ifndef DUMMY_EXP
#define DUMMY_EXP 0
#endif
#ifndef DUMMY_TR
#define DUMMY_TR 0
#endif
#ifndef DUMMY_MFMA
#define DUMMY_MFMA 0
#endif
__device__ __forceinline__ void dummy_exp(float x) { float d; for (int i = 0; i < DUMMY_EXP; ++i) asm volatile("v_exp_f32 %0, %1" : "=v"(d) : "v"(x)); }
__device__ __forceinline__ void expA(f32x16& p0) {
#pragma unroll
  for (int r = 0; r < 16; ++r) { dummy_exp(p0[r]); p0[r] = __builtin_amdgcn_exp2f(p0[r]); }
}
__device__ __forceinline__ void expB_sum_pack(f32x16& p0, f32x16& p1, float& l_reg, bf16x8& pa0, bf16x8& pa1, bf16x8& pa2, bf16x8& pa3) {
#pragma unroll
  for (int r = 0; r < 16; ++r) { dummy_exp(p1[r]); p1[r] = __builtin_amdgcn_exp2f(p1[r]); }
  float ps = 0;
#pragma unroll
  for (int r = 0; r < 16; ++r) ps += p0[r];
#pragma unroll
  for (int r = 0; r < 16; ++r) ps += p1[r];
  { auto rr = __builtin_amdgcn_permlane32_swap(__float_as_uint(ps), __float_as_uint(ps), false, false);
    ps = __uint_as_float(rr[0]) + __uint_as_float(rr[1]); }
  l_reg += ps;
#define PK4(P, BASE, OUT) do { unsigned a0 = cvtpk(P[BASE + 0], P[BASE + 1]), a1 = cvtpk(P[BASE + 2], P[BASE + 3]);   \
    unsigned b0 = cvtpk(P[BASE + 4], P[BASE + 5]), b1 = cvtpk(P[BASE + 6], P[BASE + 7]);                              \
    auto r0 = __builtin_amdgcn_permlane32_swap(a0, b0, false, false); auto r1 = __builtin_amdgcn_permlane32_swap(a1, b1, false, false); \
    u32x4 w = {r0[0], r1[0], r0[1], r1[1]}; OUT = *reinterpret_cast<bf16x8*>(&w); } while (0)
  PK4(p0, 0, pa0); PK4(p0, 8, pa1); PK4(p1, 0, pa2); PK4(p1, 8, pa3);
#undef PK4
}
__device__ __forceinline__ bf16x8 ld8(const bf16_t* p) { return *reinterpret_cast<const bf16x8*>(p); }

constexpr int TP = 132;
__device__ __forceinline__ void tile_to_rows(const f32x16 (&o)[4], LAS float* scr, int r32, int hi, float (&v)[64]) {
#pragma unroll
  for (int d0 = 0; d0 < 4; ++d0)
#pragma unroll
    for (int r = 0; r < 16; ++r) scr[crow(r, hi) * TP + 32 * d0 + r32] = o[d0][r];
  asm volatile("s_waitcnt lgkmcnt(0)" ::: "memory");
#pragma unroll
  for (int i = 0; i < 16; ++i) { const f32x4v t = *(const LAS f32x4v*)(scr + r32 * TP + 64 * hi + 4 * i); v[4 * i] = t[0]; v[4 * i + 1] = t[1]; v[4 * i + 2] = t[2]; v[4 * i + 3] = t[3]; }
}
__device__ __forceinline__ float pair_sum(float x) {
  auto rr = __builtin_amdgcn_permlane32_swap(__float_as_uint(x), __float_as_uint(x), false, false); return __uint_as_float(rr[0]) + __uint_as_float(rr[1]);
}


#define PVX_RD2(L0, H0, D0, KS) do { L0 = tr_read<v_rd_off(D0, KS, 0)>(vb); H0 = tr_read<v_rd_off(D0, KS, 1)>(vb); } while (0)
#define PVX_PK(L, H) (bf16x8){L[0], L[1], L[2], L[3], H[0], H[1], H[2], H[3]}
#define PVX_E(i) do { if (DOEXP) { pn[i] = __builtin_amdgcn_exp2f(pn[i]); psn += pn[i]; } } while (0)
#define PVX_W(n) asm volatile("s_waitcnt lgkmcnt(" #n ")" ::: "memory")
#define PVX_BLOCK(D0, E0) do { \
    PVX_W(6); SBAR(); o[D0] = __builtin_amdgcn_mfma_f32_32x32x16_bf16(pa0, PVX_PK(fl0, fh0), o[D0], 0, 0, 0); PVX_E(E0 + 0); PVX_RD2(fl0, fh0, D0 + 1, 0); SBAR(); \
    PVX_W(6); SBAR(); o[D0] = __builtin_amdgcn_mfma_f32_32x32x16_bf16(pa1, PVX_PK(fl1, fh1), o[D0], 0, 0, 0); PVX_E(E0 + 1); PVX_RD2(fl1, fh1, D0 + 1, 1); SBAR(); \
    PVX_W(6); SBAR(); o[D0] = __builtin_amdgcn_mfma_f32_32x32x16_bf16(pa2, PVX_PK(fl2, fh2), o[D0], 0, 0, 0); PVX_E(E0 + 2); PVX_RD2(fl2, fh2, D0 + 1, 2); SBAR(); \
    PVX_W(6); SBAR(); o[D0] = __builtin_amdgcn_mfma_f32_32x32x16_bf16(pa3, PVX_PK(fl3, fh3), o[D0], 0, 0, 0); PVX_E(E0 + 3); PVX_RD2(fl3, fh3, D0 + 1, 3); SBAR(); } while (0)
template <bool DOEXP>
__device__ __forceinline__ void pv_exp(f32x16* o, int vb, bf16x8 pa0, bf16x8 pa1, bf16x8 pa2, bf16x8 pa3, f32x16& pn, float& psn) {
  s16x4 fl0, fh0, fl1, fh1, fl2, fh2, fl3, fh3;
  asm volatile("s_waitcnt lgkmcnt(0)" ::: "memory");
  PVX_RD2(fl0, fh0, 0, 0); PVX_RD2(fl1, fh1, 0, 1); PVX_RD2(fl2, fh2, 0, 2); PVX_RD2(fl3, fh3, 0, 3);
  PVX_BLOCK(0, 0); PVX_BLOCK(1, 4); PVX_BLOCK(2, 8);
  PVX_W(6); SBAR(); o[3] = __builtin_amdgcn_mfma_f32_32x32x16_bf16(pa0, PVX_PK(fl0, fh0), o[3], 0, 0, 0); PVX_E(12); SBAR();
  PVX_W(4); SBAR(); o[3] = __builtin_amdgcn_mfma_f32_32x32x16_bf16(pa1, PVX_PK(fl1, fh1), o[3], 0, 0, 0); PVX_E(13); SBAR();
  PVX_W(2); SBAR(); o[3] = __builtin_amdgcn_mfma_f32_32x32x16_bf16(pa2, PVX_PK(fl2, fh2), o[3], 0, 0, 0); PVX_E(14); SBAR();
  PVX_W(0); SBAR(); o[3] = __builtin_amdgcn_mfma_f32_32x32x16_bf16(pa3, PVX_PK(fl3, fh3), o[3], 0, 0, 0); PVX_E(15); SBAR();
}
__device__ __forceinline__ void expB_sum_pack2(f32x16& p0, f32x16& p1, float ps, float& l_reg, bf16x8& pa0, bf16x8& pa1, bf16x8& pa2, bf16x8& pa3) {
#pragma unroll
  for (int r = 0; r < 16; ++r) { p1[r] = __builtin_amdgcn_exp2f(p1[r]); ps += p1[r]; }
  { auto rr = __builtin_amdgcn_permlane32_swap(__float_as_uint(ps), __float_as_uint(ps), false, false);
    ps = __uint_as_float(rr[0]) + __uint_as_float(rr[1]); }
  l_reg += ps;
#define PK4(P, BASE, OUT) do { unsigned a0 = cvtpk(P[BASE + 0], P[BASE + 1]), a1 = cvtpk(P[BASE + 2], P[BASE + 3]);   \
    unsigned b0 = cvtpk(P[BASE + 4], P[BASE + 5]), b1 = cvtpk(P[BASE + 6], P[BASE + 7]);                              \
    auto r0 = __builtin_amdgcn_permlane32_swap(a0, b0, false, false); auto r1 = __builtin_amdgcn_permlane32_swap(a1, b1, false, false); \
    u32x4 w = {r0[0], r1[0], r0[1], r1[1]}; OUT = *reinterpret_cast<bf16x8*>(&w); } while (0)
  PK4(p0, 0, pa0); PK4(p0, 8, pa1); PK4(p1, 0, pa2); PK4(p1, 8, pa3);
#undef PK4
}
__device__ __forceinline__ float exp_sum16(f32x16& p0) { float ps = 0.f;
#pragma unroll
  for (int r = 0; r < 16; ++r) { p0[r] = __builtin_amdgcn_exp2f(p0[r]); ps += p0[r]; }
  return ps; }

__device__ __forceinline__ void attn_unit(const int wid, const bf16_t* __restrict__ proj, const char* __restrict__ Kt_bh, const char* __restrict__ Vt_bh, bf16_t* __restrict__ concat, int qrow0, int NT, int h,
                                          LAS char* lds, float lam, float omli, const float* __restrict__ subln) {
  const int lane = lane_id(), tid = wid * 64 + lane, r32 = lane & 31, hi = lane >> 5, rg = wid & 3, c = wid >> 2;
  LAS char* V_lds = lds; LAS char* K_lds = lds + 4 * SHM_V;
  LAS float* li_l = (LAS float*)(lds + 4 * SHM_V + 4 * SHM_K) + wid * 64;
  float l_reg = 0; f32x16 o[4] = {}; bf16x8 qr[4];
  const bf16_t* Qw = proj + (size_t)(qrow0 + rg * 32 + r32) * DP + C_DQ + h * 128 + c * 64 + hi * 8;
#pragma unroll
  for (int d0 = 0; d0 < 4; ++d0) qr[d0] = ld8(Qw + d0 * 16);
  const int vb0 = (int)(uintptr_t)V_lds + v_rd_base(lane);
  const char* kg0 = Kt_bh + wid * 2048 + lane * 16; const char* vg0 = Vt_bh + wid * 2048 + lane * 16;
#define DMA_TILE(tile, slot) do { const size_t to_ = (size_t)(tile) * 16384; \
    __builtin_amdgcn_global_load_lds((const unsigned*)(kg0 + to_), (LAS unsigned*)(K_lds + (slot) * SHM_K + wid * 2048), 16, 0, 0); \
    __builtin_amdgcn_global_load_lds((const unsigned*)(kg0 + to_ + 1024), (LAS unsigned*)(K_lds + (slot) * SHM_K + wid * 2048 + 1024), 16, 0, 0); \
    __builtin_amdgcn_global_load_lds((const unsigned*)(vg0 + to_), (LAS unsigned*)(V_lds + (slot) * SHM_V + wid * 2048), 16, 0, 0); \
    __builtin_amdgcn_global_load_lds((const unsigned*)(vg0 + to_ + 1024), (LAS unsigned*)(V_lds + (slot) * SHM_V + wid * 2048 + 1024), 16, 0, 0); } while (0)
#define BAR() do { asm volatile("s_waitcnt vmcnt(0) lgkmcnt(0)" ::: "memory"); __builtin_amdgcn_s_barrier(); asm volatile("" ::: "memory"); } while (0)
#define STAGE(b) do { if ((b) + 3 < NT) DMA_TILE((b) + 3, ((b) + 3) & 3); } while (0)
#define STAGES(b, slot) do { if ((b) + 3 < NT) DMA_TILE((b) + 3, slot); } while (0)
#define QKT(P0, P1, t) qkt<4>(P0, P1, K_lds + ((t) & 3) * SHM_K, qr, r32, hi, 4 * c)
#define QKTS(P0, P1, slot) qkt<4>(P0, P1, K_lds + (slot) * SHM_K, qr, r32, hi, 4 * c)
#define PV(t) pv_d0(o, vb0 + ((t) & 3) * SHM_V, pa0, pa1, pa2, pa3)
  f32x16 pA0, pA1, pB0, pB1; bf16x8 pa0, pa1, pa2, pa3; float psA = 0.f, psB = 0.f;
#define PVE(t, PN, PSN) do { PSN = 0.f; pv_exp<true>(o, vb0 + ((t) & 3) * SHM_V, pa0, pa1, pa2, pa3, PN, PSN); } while (0)
#define PVES(slot, PN, PSN) do { PSN = 0.f; pv_exp<true>(o, vb0 + (slot) * SHM_V, pa0, pa1, pa2, pa3, PN, PSN); } while (0)
#define PVL(t) do { float d_ = 0.f; pv_exp<false>(o, vb0 + ((t) & 3) * SHM_V, pa0, pa1, pa2, pa3, pA0, d_); } while (0)
  DMA_TILE(0, 0); DMA_TILE(1, 1); DMA_TILE(2, 2);
  BAR();
  QKT(pA0, pA1, 0); psA = exp_sum16(pA0);
  for (int t = 0; t < NT; t += 4) {
    if (c == 0) { BAR(); STAGES(t, 3); } SBAR();
    QKTS(pB0, pB1, 1); expB_sum_pack2(pA0, pA1, psA, l_reg, pa0, pa1, pa2, pa3); SBAR();
    if (c == 1) { BAR(); STAGES(t, 3); } SBAR();
    PVES(0, pB0, psB); SBAR();
    if (c == 0) { BAR(); STAGES(t + 1, 0); } SBAR();
    QKTS(pA0, pA1, 2); expB_sum_pack2(pB0, pB1, psB, l_reg, pa0, pa1, pa2, pa3); SBAR();
    if (c == 1) { BAR(); STAGES(t + 1, 0); } SBAR();
    PVES(1, pA0, psA); SBAR();
    if (c == 0) { BAR(); STAGES(t + 2, 1); } SBAR();
    QKTS(pB0, pB1, 3); expB_sum_pack2(pA0, pA1, psA, l_reg, pa0, pa1, pa2, pa3); SBAR();
    if (c == 1) { BAR(); STAGES(t + 2, 1); } SBAR();
    PVES(2, pB0, psB); SBAR();
    if (c == 0) { BAR(); STAGES(t + 3, 2); } SBAR();
    if (t + 4 < NT) QKTS(pA0, pA1, 0);
    expB_sum_pack2(pB0, pB1, psB, l_reg, pa0, pa1, pa2, pa3); SBAR();
    if (c == 1) { BAR(); STAGES(t + 3, 2); } SBAR();
    PVES(3, pA0, psA);
    SBAR();
  }
#undef PVE
#undef PVES
#undef QKTS
#undef STAGES
#undef PVL
  if (hi == 0) li_l[r32] = l_reg; asm volatile("s_waitcnt lgkmcnt(0)" ::: "memory");
#pragma unroll
  for (int r = 0; r < 16; ++r) { const float rl = __builtin_amdgcn_rcpf(li_l[crow(r, hi)]);
#pragma unroll
    for (int d0 = 0; d0 < 4; ++d0) o[d0][r] *= rl; }
  __syncthreads();
  LAS float* xch = (LAS float*)lds + rg * 4096;
  if (c == 1) {
#pragma unroll
    for (int d0 = 0; d0 < 4; ++d0)
#pragma unroll
      for (int r = 0; r < 16; ++r) xch[(d0 * 16 + r) * 64 + lane] = o[d0][r];
  }
  __syncthreads();
  if (c == 0) {
#pragma unroll
    for (int r = 0; r < 16; ++r) { float s = 0.f;
#pragma unroll
      for (int d0 = 0; d0 < 4; ++d0) { const float d = o[d0][r] - lam * xch[(d0 * 16 + r) * 64 + lane]; o[d0][r] = d; s += d * d; }
      s += __shfl_xor(s, 1); s += __shfl_xor(s, 2); s += __shfl_xor(s, 4); s += __shfl_xor(s, 8); s += __shfl_xor(s, 16);
      const float rr = rsqrtf(s * (1.f / 128.f) + EPS) * omli;
      bf16_t* orow = concat + (size_t)(qrow0 + rg * 32 + crow(r, hi)) * DM + 512 + h * 128 + r32;
#pragma unroll
      for (int d0 = 0; d0 < 4; ++d0) orow[d0 * 32] = f2bf(o[d0][r] * rr * subln[d0 * 32 + r32]); }
  }
  __syncthreads();
#undef DMA_TILE
#undef BAR
#undef STAGE
#undef QKT
#undef PV
}


typedef float f32x2 __attribute__((ext_vector_type(2)));
__device__ __forceinline__ void exp_half(f32x16& ph, f32x2& lacc) {
#pragma unroll
  for (int r = 0; r < 16; r += 2) { ph[r] = __builtin_amdgcn_exp2f(ph[r]); ph[r + 1] = __builtin_amdgcn_exp2f(ph[r + 1]); const f32x2 e = {ph[r], ph[r + 1]}; lacc += e; }
}
__device__ __forceinline__ void pack_half(const f32x16& ph, bf16x8& x0, bf16x8& x1) {
  { u32x4 w = {cvtpk(ph[0], ph[1]), cvtpk(ph[2], ph[3]), cvtpk(ph[4], ph[5]), cvtpk(ph[6], ph[7])}; x0 = *reinterpret_cast<bf16x8*>(&w); }
  { u32x4 w = {cvtpk(ph[8], ph[9]), cvtpk(ph[10], ph[11]), cvtpk(ph[12], ph[13]), cvtpk(ph[14], ph[15])}; x1 = *reinterpret_cast<bf16x8*>(&w); }
}

template <int D0> __device__ __forceinline__ void pv2_block(f32x16& oa, f32x16& ob, int vb, s16x4& fl0, s16x4& fh0, s16x4& fl1, s16x4& fh1, s16x4& fl2, s16x4& fh2, s16x4& fl3, s16x4& fh3,
                                                           bf16x8 a0, bf16x8 a1, bf16x8 a2, bf16x8 a3, bf16x8 b0, bf16x8 b1, bf16x8 b2, bf16x8 b3) {
#define PV2_STEP(A, B, FL, FH, KS, WN) do { asm volatile("s_waitcnt lgkmcnt(" #WN ")" ::: "memory"); SBAR(); \
    oa = __builtin_amdgcn_mfma_f32_32x32x16_bf16(A, PVX_PK(FL, FH), oa, 0, 0, 0); ob = __builtin_amdgcn_mfma_f32_32x32x16_bf16(B, PVX_PK(FL, FH), ob, 0, 0, 0); \
    if (D0 < 3) { FL = tr_read<v_rd_off((D0 + 1) & 3, KS, 0)>(vb); FH = tr_read<v_rd_off((D0 + 1) & 3, KS, 1)>(vb); } SBAR(); } while (0)
  if (D0 < 3) { PV2_STEP(a0, b0, fl0, fh0, 0, 6); PV2_STEP(a1, b1, fl1, fh1, 1, 6); PV2_STEP(a2, b2, fl2, fh2, 2, 6); PV2_STEP(a3, b3, fl3, fh3, 3, 6); }
  else        { PV2_STEP(a0, b0, fl0, fh0, 0, 6); PV2_STEP(a1, b1, fl1, fh1, 1, 4); PV2_STEP(a2, b2, fl2, fh2, 2, 2); PV2_STEP(a3, b3, fl3, fh3, 3, 0); }
#undef PV2_STEP
}
__device__ __forceinline__ void attn_unit3p(const int wid, const bf16_t* __restrict__ proj, const char* __restrict__ Kt_bh, const char* __restrict__ Vt_bh, bf16_t* __restrict__ concat, int qrow0, int NT, int h,
                                            LAS char* lds, float lam, float omli, const float* __restrict__ subln) {
  const int lane = lane_id(), r32 = lane & 31, hi = lane >> 5;
  LAS char* V_lds = lds; LAS char* K_lds = lds + 2 * SHM_V; LAS char* Qw = lds + 65536 + wid * 8192;
  LAS float* li_l = (LAS float*)(lds + 131072) + wid * 64;
  f32x2 l0v = {0.f, 0.f}, l1v = {0.f, 0.f}; f32x16 o0[4] = {}, o1[4] = {};
  const int vb0 = (int)(uintptr_t)V_lds + v_rd_base(lane);
  const char* kg0 = Kt_bh + wid * 2048 + lane * 16; const char* vg0 = Vt_bh + wid * 2048 + lane * 16;
#define DMA_TILE(tile, slot) do { const size_t to_ = (size_t)(tile) * 16384; \
    __builtin_amdgcn_global_load_lds((const unsigned*)(kg0 + to_), (LAS unsigned*)(K_lds + (slot) * SHM_K + wid * 2048), 16, 0, 0); \
    __builtin_amdgcn_global_load_lds((const unsigned*)(kg0 + to_ + 1024), (LAS unsigned*)(K_lds + (slot) * SHM_K + wid * 2048 + 1024), 16, 0, 0); \
    __builtin_amdgcn_global_load_lds((const unsigned*)(vg0 + to_), (LAS unsigned*)(V_lds + (slot) * SHM_V + wid * 2048), 16, 0, 0); \
    __builtin_amdgcn_global_load_lds((const unsigned*)(vg0 + to_ + 1024), (LAS unsigned*)(V_lds + (slot) * SHM_V + wid * 2048 + 1024), 16, 0, 0); } while (0)
#define BAR() do { asm volatile("s_waitcnt vmcnt(0) lgkmcnt(0)" ::: "memory"); __builtin_amdgcn_s_barrier(); asm volatile("" ::: "memory"); } while (0)
  { const char* qg = (const char*)(proj + (size_t)(qrow0 + wid * 32) * DP + C_DQ + h * 128);
#pragma unroll
    for (int i = 0; i < 8; ++i) { const int row = 4 * i + (lane >> 4), ch = (lane & 15) ^ (row & 7);
      __builtin_amdgcn_global_load_lds((const unsigned*)(qg + (size_t)row * (DP * 2) + ch * 16), (LAS unsigned*)(Qw + i * 1024), 16, 0, 0); } }
  DMA_TILE(0, 0);
  bf16x8 a0, a1, a2, a3, b0, b1, b2, b3;
  int sw0 = KSWZ(r32, (0 * 16 + hi * 8) * 2), sw1 = KSWZ(r32, (1 * 16 + hi * 8) * 2), sw2 = KSWZ(r32, (2 * 16 + hi * 8) * 2), sw3 = KSWZ(r32, (3 * 16 + hi * 8) * 2);
  int kad0_ = (int)(uintptr_t)K_lds + sw0, kad1_ = (int)(uintptr_t)K_lds + sw1, kad2_ = (int)(uintptr_t)K_lds + sw2, kad3_ = (int)(uintptr_t)K_lds + sw3;
  int qad0_ = (int)(uintptr_t)Qw + sw0, qad1_ = (int)(uintptr_t)Qw + sw1, qad2_ = (int)(uintptr_t)Qw + sw2, qad3_ = (int)(uintptr_t)Qw + sw3;
  asm volatile("" : "+v"(kad0_), "+v"(kad1_), "+v"(kad2_), "+v"(kad3_), "+v"(qad0_), "+v"(qad1_), "+v"(qad2_), "+v"(qad3_));
  LAS char* const kad0 = (LAS char*)(uintptr_t)kad0_; LAS char* const kad1 = (LAS char*)(uintptr_t)kad1_; LAS char* const kad2 = (LAS char*)(uintptr_t)kad2_; LAS char* const kad3 = (LAS char*)(uintptr_t)kad3_;
  LAS char* const qad0 = (LAS char*)(uintptr_t)qad0_; LAS char* const qad1 = (LAS char*)(uintptr_t)qad1_; LAS char* const qad2 = (LAS char*)(uintptr_t)qad2_; LAS char* const qad3 = (LAS char*)(uintptr_t)qad3_;
#define QK2(P0, P1, so, cc) do { P0 = f32x16{}; P1 = f32x16{}; _Pragma("unroll") for (int d0 = 0; d0 < 4; ++d0) { const int cb = ((4 * (cc) + d0) * 16 + hi * 8) * 2; \
    const bf16x8 ka_ = *reinterpret_cast<const LAS bf16x8*>(K_lds + (so) * SHM_K + KSWZ(r32, cb)), kb_ = *reinterpret_cast<const LAS bf16x8*>(K_lds + (so) * SHM_K + KSWZ(32 + r32, cb)); \
    const bf16x8 q_ = *reinterpret_cast<const LAS bf16x8*>(Qw + KSWZ(r32, cb)); \
    P0 = __builtin_amdgcn_mfma_f32_32x32x16_bf16(ka_, q_, P0, 0, 0, 0); P1 = __builtin_amdgcn_mfma_f32_32x32x16_bf16(kb_, q_, P1, 0, 0, 0); } } while (0)
#define QKA(PH, so, cc, koff) do { PH = f32x16{}; \
    { const bf16x8 k_ = *reinterpret_cast<const LAS bf16x8*>(kad0 + ((so) * SHM_K + (koff) * 256 + 128 * (cc))); const bf16x8 q_ = *reinterpret_cast<const LAS bf16x8*>(qad0 + 128 * (cc)); PH = __builtin_amdgcn_mfma_f32_32x32x16_bf16(k_, q_, PH, 0, 0, 0); } \
    { const bf16x8 k_ = *reinterpret_cast<const LAS bf16x8*>(kad1 + ((so) * SHM_K + (koff) * 256 + 128 * (cc))); const bf16x8 q_ = *reinterpret_cast<const LAS bf16x8*>(qad1 + 128 * (cc)); PH = __builtin_amdgcn_mfma_f32_32x32x16_bf16(k_, q_, PH, 0, 0, 0); } } while (0)
#define QKB(PH, so, cc, koff) do { \
    { const bf16x8 k_ = *reinterpret_cast<const LAS bf16x8*>(kad2 + ((so) * SHM_K + (koff) * 256 + 128 * (cc))); const bf16x8 q_ = *reinterpret_cast<const LAS bf16x8*>(qad2 + 128 * (cc)); PH = __builtin_amdgcn_mfma_f32_32x32x16_bf16(k_, q_, PH, 0, 0, 0); } \
    { const bf16x8 k_ = *reinterpret_cast<const LAS bf16x8*>(kad3 + ((so) * SHM_K + (koff) * 256 + 128 * (cc))); const bf16x8 q_ = *reinterpret_cast<const LAS bf16x8*>(qad3 + 128 * (cc)); PH = __builtin_amdgcn_mfma_f32_32x32x16_bf16(k_, q_, PH, 0, 0, 0); } } while (0)
#define QKH(PH, so, cc, koff) do { QKA(PH, so, cc, koff); QKB(PH, so, cc, koff); } while (0)
#define SGB(m, n) __builtin_amdgcn_sched_group_barrier(m, n, 0)
#define STEP(PN, so, cc, koff, PO, LV, X0, X1) do { \
    QKA(PN, so, cc, koff); exp_half(PO, LV); SGB(0x100, 4); SGB(0x8, 1); SGB(0x2, 12); SGB(0x8, 1); SGB(0x2, 12); SBAR(); asm volatile("" : "+v"(LV)); SBAR(); \
    QKB(PN, so, cc, koff); pack_half(PO, X0, X1); SGB(0x100, 4); SGB(0x8, 1); SGB(0x2, 4); SGB(0x8, 1); SGB(0x2, 4); MBAR(PN); } while (0)
#define MBAR(X) do { SBAR(); asm volatile("" : "+v"(X) :: "memory"); SBAR(); } while (0)
#define TILE(t, so) do { BAR(); if ((t) + 1 < NT) DMA_TILE((t) + 1, 1 - (so)); SBAR(); \
    { f32x16 p0, p1; \
      QKH(p0, so, 0, 0); MBAR(p0); \
      STEP(p1, so, 0, 32, p0, l0v, a0, a1); \
      STEP(p0, so, 1, 0, p1, l0v, a2, a3); \
      STEP(p1, so, 1, 32, p0, l1v, b0, b1); \
      exp_half(p1, l1v); SBAR(); asm volatile("" : "+v"(l1v)); SBAR(); pack_half(p1, b2, b3); } SBAR(); \
    { const int vb = vb0 + (so) * SHM_V; s16x4 fl0, fh0, fl1, fh1, fl2, fh2, fl3, fh3; \
      asm volatile("s_waitcnt lgkmcnt(0)" ::: "memory"); \
      PVX_RD2(fl0, fh0, 0, 0); PVX_RD2(fl1, fh1, 0, 1); PVX_RD2(fl2, fh2, 0, 2); PVX_RD2(fl3, fh3, 0, 3); \
      pv2_block<0>(o0[0], o1[0], vb, fl0, fh0, fl1, fh1, fl2, fh2, fl3, fh3, a0, a1, a2, a3, b0, b1, b2, b3); \
      pv2_block<1>(o0[1], o1[1], vb, fl0, fh0, fl1, fh1, fl2, fh2, fl3, fh3, a0, a1, a2, a3, b0, b1, b2, b3); \
      pv2_block<2>(o0[2], o1[2], vb, fl0, fh0, fl1, fh1, fl2, fh2, fl3, fh3, a0, a1, a2, a3, b0, b1, b2, b3); \
      pv2_block<3>(o0[3], o1[3], vb, fl0, fh0, fl1, fh1, fl2, fh2, fl3, fh3, a0, a1, a2, a3, b0, b1, b2, b3); } SBAR(); } while (0)
  for (int t = 0; t < NT; t += 2) { TILE(t, 0); TILE(t + 1, 1); }
  const float l0 = pair_sum(l0v[0] + l0v[1]), l1 = pair_sum(l1v[0] + l1v[1]);
  if (hi == 0) { li_l[r32] = l0; li_l[32 + r32] = l1; } asm volatile("s_waitcnt lgkmcnt(0)" ::: "memory");
#pragma unroll
  for (int r = 0; r < 16; ++r) { const float ra = __builtin_amdgcn_rcpf(li_l[crow(r, hi)]), rb = lam * __builtin_amdgcn_rcpf(li_l[32 + crow(r, hi)]);
    float s = 0.f;
#pragma unroll
    for (int d0 = 0; d0 < 4; ++d0) { const float d = o0[d0][r] * ra - o1[d0][r] * rb; o0[d0][r] = d; s += d * d; }
    s += __shfl_xor(s, 1); s += __shfl_xor(s, 2); s += __shfl_xor(s, 4); s += __shfl_xor(s, 8); s += __shfl_xor(s, 16);
    const float rr = rsqrtf(s * (1.f / 128.f) + EPS) * omli;
    bf16_t* orow = concat + (size_t)(qrow0 + wid * 32 + crow(r, hi)) * DM + 512 + h * 128 + r32;
#pragma unroll
    for (int d0 = 0; d0 < 4; ++d0) orow[d0 * 32] = f2bf(o0[d0][r] * rr * subln[d0 * 32 + r32]); }
  asm volatile("s_waitcnt vmcnt(0) lgkmcnt(0)" ::: "memory"); __syncthreads();
#undef DMA_TILE
#undef BAR
#undef QK2
#undef QKH
#undef QKA
#undef QKB
#undef TILE
#undef STEP
#undef MBAR
#undef SGB
}

__device__ __forceinline__ bf16x8 scale8(bf16x8 v, float s) {
  u32x4 w;
#pragma unroll
  for (int i = 0; i < 4; ++i) { const float a = __uint_as_float(((unsigned)(unsigned short)v[2 * i]) << 16) * s, b = __uint_as_float(((unsigned)(unsigned short)v[2 * i + 1]) << 16) * s; w[i] = cvtpk(a, b); }
  return *reinterpret_cast<bf16x8*>(&w);
}
template <int KS> __device__ __forceinline__ void trfrag_issue(int vb, s16x4& l, s16x4& h) { l = tr_read<v_rd_off(0, KS, 0)>(vb); h = tr_read<v_rd_off(0, KS, 1)>(vb); }
#define PKF(L, H) (bf16x8){L[0], L[1], L[2], L[3], H[0], H[1], H[2], H[3]}
template <int KS> __device__ __forceinline__ void cs_step(f32x16* acc, int kb, int vv) {
  s16x4 al, ah, b0l, b0h, b1l, b1h, b2l, b2h, b3l, b3h;
  trfrag_issue<KS>(kb, al, ah); trfrag_issue<KS>(vv, b0l, b0h); trfrag_issue<KS>(vv + 512, b1l, b1h); trfrag_issue<KS>(vv + 1024, b2l, b2h); trfrag_issue<KS>(vv + 1536, b3l, b3h);
  asm volatile("s_waitcnt lgkmcnt(0)" ::: "memory"); SBAR();
  const bf16x8 a = PKF(al, ah);
  acc[0] = __builtin_amdgcn_mfma_f32_32x32x16_bf16(a, PKF(b0l, b0h), acc[0], 0, 0, 0);
  acc[1] = __builtin_amdgcn_mfma_f32_32x32x16_bf16(a, PKF(b1l, b1h), acc[1], 0, 0, 0);
  acc[2] = __builtin_amdgcn_mfma_f32_32x32x16_bf16(a, PKF(b2l, b2h), acc[2], 0, 0, 0);
  acc[3] = __builtin_amdgcn_mfma_f32_32x32x16_bf16(a, PKF(b3l, b3h), acc[3], 0, 0, 0);
}
__device__ __forceinline__ void chunk_state_unit(const int wid, const bf16_t* __restrict__ proj, bf16_t* __restrict__ csf, bf16_t* __restrict__ csb, int rowbase, int h, float lgf2, float lgb2, LAS char* lds) {
  const int lane = lane_id(), tid = wid * 64 + lane, r32 = lane & 31, hi = lane >> 5;
  const int sr = tid >> 4, sc = (tid & 15) * 8;
  { bf16x8 kv[4], vv[4];
#pragma unroll
    for (int g = 0; g < 4; ++g) { const bf16_t* rp = proj + (size_t)(rowbase + 32 * g + sr) * DP + h * 128 + sc; kv[g] = ld8(rp + C_RK); vv[g] = ld8(rp + C_RV); }
#pragma unroll
    for (int g = 0; g < 4; ++g) { const int row = 32 * g + sr;
      const float wf = __builtin_amdgcn_exp2f(lgf2 * (float)(127 - row)), wb = __builtin_amdgcn_exp2f(lgb2 * (float)row);
      const int off = (row >> 6) * 16384 + v_st(row & 63, sc);
      *(LAS bf16x8*)(lds + off) = vv[g]; *(LAS bf16x8*)(lds + 32768 + off) = scale8(kv[g], wf); *(LAS bf16x8*)(lds + 65536 + off) = scale8(kv[g], wb); } }
  __syncthreads();
  const int dir = wid >> 2, ib = wid & 3;
  const int vbK = (int)(uintptr_t)(lds + 32768 + dir * 32768) + v_rd_base(lane) + ib * 512, vbV = (int)(uintptr_t)lds + v_rd_base(lane);
  f32x16 acc[4] = {};
  cs_step<0>(acc, vbK, vbV); cs_step<1>(acc, vbK, vbV); cs_step<2>(acc, vbK, vbV); cs_step<3>(acc, vbK, vbV);
  cs_step<0>(acc, vbK + 16384, vbV + 16384); cs_step<1>(acc, vbK + 16384, vbV + 16384); cs_step<2>(acc, vbK + 16384, vbV + 16384); cs_step<3>(acc, vbK + 16384, vbV + 16384);
  bf16_t* outp = (dir ? csb : csf) + r32;
#pragma unroll
  for (int r = 0; r < 16; ++r) { bf16_t* orow = outp + (size_t)(32 * ib + crow(r, hi)) * 128;
#pragma unroll
    for (int jb = 0; jb < 4; ++jb) orow[32 * jb] = f2bf(acc[jb][r]); }
  __syncthreads();
}
__device__ __forceinline__ void pack_p(const f32x16& p0, const f32x16& p1, bf16x8& pa0, bf16x8& pa1, bf16x8& pa2, bf16x8& pa3) {
#define PK4(P, BASE, OUT) do { unsigned a0 = cvtpk(P[BASE + 0], P[BASE + 1]), a1 = cvtpk(P[BASE + 2], P[BASE + 3]);   \
    unsigned b0 = cvtpk(P[BASE + 4], P[BASE + 5]), b1 = cvtpk(P[BASE + 6], P[BASE + 7]);                              \
    auto r0 = __builtin_amdgcn_permlane32_swap(a0, b0, false, false); auto r1 = __builtin_amdgcn_permlane32_swap(a1, b1, false, false); \
    u32x4 w = {r0[0], r1[0], r0[1], r1[1]}; OUT = *reinterpret_cast<bf16x8*>(&w); } while (0)
  PK4(p0, 0, pa0); PK4(p0, 8, pa1); PK4(p1, 0, pa2); PK4(p1, 8, pa3);
#undef PK4
}
__device__ __forceinline__ float decay_w(int d, float lgf2, float lgb2) {
  const float e = __builtin_amdgcn_exp2f(d < 0 ? lgf2 * (float)(-d) : lgb2 * (float)d); return d == 0 ? 2.f : e;
}
__device__ __forceinline__ void ret_out_unit(const int wid, const bf16_t* __restrict__ proj, bf16_t* __restrict__ concat, const bf16_t* __restrict__ spA, const bf16_t* __restrict__ spB, size_t dstride,
                                             int rowA, int rowB, int h, float lgf2, float lgb2, const float* __restrict__ gn, LAS char* lds) {
  const int lane = lane_id(), tid = wid * 64 + lane, r32 = lane & 31, hi = lane >> 5, rg = wid & 3, ch = wid >> 2;
  const int sr = tid >> 4, sc = (tid & 15) * 8;
  const int rowbase = ch ? rowB : rowA;
  { bf16x8 kv[8], vv[8];
#pragma unroll
    for (int c2 = 0; c2 < 2; ++c2)
#pragma unroll
      for (int g = 0; g < 4; ++g) { const bf16_t* rp = proj + (size_t)((c2 ? rowB : rowA) + 32 * g + sr) * DP + h * 128 + sc; kv[c2 * 4 + g] = ld8(rp + C_RK); vv[c2 * 4 + g] = ld8(rp + C_RV); }
#pragma unroll
    for (int c2 = 0; c2 < 2; ++c2)
#pragma unroll
      for (int g = 0; g < 4; ++g) { const int row = 32 * g + sr;
        *(LAS bf16x8*)(lds + c2 * 65536 + (row >> 6) * 16384 + KSWZ(row & 63, sc * 2)) = kv[c2 * 4 + g];
        *(LAS bf16x8*)(lds + c2 * 65536 + 32768 + (row >> 6) * 16384 + v_st(row & 63, sc)) = vv[c2 * 4 + g]; } }
  bf16x8 qr[8];
  const bf16_t* Qw = proj + (size_t)(rowbase + rg * 32 + r32) * DP + C_RQ + h * 128 + hi * 8;
#pragma unroll
  for (int d0 = 0; d0 < 8; ++d0) qr[d0] = ld8(Qw + d0 * 16);
  __syncthreads();
  const int m = rg * 32 + r32;
  LAS char* myreg = lds + ch * 65536;
  const int vb = (int)(uintptr_t)myreg + v_rd_base(lane);
  f32x16 o[4] = {}; f32x16 p0, p1; bf16x8 pa0, pa1, pa2, pa3;
#pragma unroll
  for (int kt = 0; kt < 2; ++kt) {
    qkt<8>(p0, p1, myreg + kt * 16384, qr, r32, hi, 0);
    int mm = m - 4 * hi; asm volatile("" : "+v"(mm));
#pragma unroll
    for (int r = 0; r < 16; ++r) { const int s0 = 64 * kt + (r & 3) + 8 * (r >> 2); p0[r] *= decay_w(s0 - mm, lgf2, lgb2); p1[r] *= decay_w(s0 + 32 - mm, lgf2, lgb2); }
    pack_p(p0, p1, pa0, pa1, pa2, pa3);
    pv_d0(o, vb + 32768 + kt * 16384, pa0, pa1, pa2, pa3);
  }
  __syncthreads();
  { bf16x8 sv[16];
#pragma unroll
    for (int c2 = 0; c2 < 2; ++c2)
#pragma unroll
      for (int d = 0; d < 2; ++d)
#pragma unroll
        for (int g = 0; g < 4; ++g) sv[(c2 * 2 + d) * 4 + g] = ld8((c2 ? spB : spA) + (size_t)d * dstride + (size_t)(32 * g + sr) * 128 + sc);
#pragma unroll
    for (int c2 = 0; c2 < 2; ++c2)
#pragma unroll
      for (int d = 0; d < 2; ++d)
#pragma unroll
        for (int g = 0; g < 4; ++g) { const int row = 32 * g + sr;
          *(LAS bf16x8*)(lds + c2 * 65536 + d * 32768 + (row >> 6) * 16384 + v_st(row & 63, sc)) = sv[(c2 * 2 + d) * 4 + g]; } }
  const float xf = __builtin_amdgcn_exp2f(lgf2 * (float)(m + 1)), xb = __builtin_amdgcn_exp2f(lgb2 * (float)(128 - m));
  __syncthreads();
#pragma unroll
  for (int d = 0; d < 2; ++d) { const float xs = d ? xb : xf;
#pragma unroll
    for (int sub = 0; sub < 2; ++sub) {
      const bf16x8 a0 = scale8(qr[4 * sub + 0], xs), a1 = scale8(qr[4 * sub + 1], xs), a2 = scale8(qr[4 * sub + 2], xs), a3 = scale8(qr[4 * sub + 3], xs);
      pv_d0(o, vb + d * 32768 + sub * 16384, a0, a1, a2, a3); } }
#pragma unroll
  for (int r = 0; r < 16; ++r) {
    float s = (o[0][r] + o[1][r]) + (o[2][r] + o[3][r]);
    s += __shfl_xor(s, 1); s += __shfl_xor(s, 2); s += __shfl_xor(s, 4); s += __shfl_xor(s, 8); s += __shfl_xor(s, 16);
    const float mu = s * (1.f / 128.f);
    float q = 0.f;
#pragma unroll
    for (int d0 = 0; d0 < 4; ++d0) { const float dd = o[d0][r] - mu; o[d0][r] = dd; q += dd * dd; }
    q += __shfl_xor(q, 1); q += __shfl_xor(q, 2); q += __shfl_xor(q, 4); q += __shfl_xor(q, 8); q += __shfl_xor(q, 16);
    const float rr = rsqrtf(q * (1.f / 128.f) + EPS);
    const size_t grow = (size_t)(rowbase + rg * 32 + crow(r, hi));
    const bf16_t* gp = proj + grow * DP + C_RG + h * 128 + r32; bf16_t* op = concat + grow * DM + h * 128 + r32;
#pragma unroll
    for (int d0 = 0; d0 < 4; ++d0) { const float gv = bf2f(gp[32 * d0]); op[32 * d0] = f2bf(o[d0][r] * rr * gn[32 * d0 + r32] * (gv * __builtin_amdgcn_rcpf(1.f + __builtin_amdgcn_exp2f(-1.4426950408889634f * gv)))); }
  }
  __syncthreads();
}

}


__device__ __forceinline__ float log2_sigmoid(float x) { return -log1pf(__expf(-x)) * 1.4426950408889634f; }
__device__ __forceinline__ bf16_t* cs_ptr(const Params& p, int b, int h, int dir, int j) { return (bf16_t*)(p.ws + WS_CS) + ((size_t)((b * NH + h) * 2 + dir) * 66 + j) * 16384; }
__device__ __forceinline__ void qkrope_phase(const Params& p, Ctx& F, int l) {
    const int lane = lane_id();
    float gq[8], gk[8], fr[8];
#pragma unroll
    for (int i = 0; i < 8; ++i) { gq[i] = p.in[I_QNG][l * 64 + 8 * (lane & 7) + i] * 0.18033688011112042f;
        gk[i] = p.in[I_KNG][l * 64 + 8 * (lane & 7) + i];
        fr[i] = exp2f(-(float)(8 * (lane & 1) + i) * (13.287712379549449f / 16.f)) * 0.15915494309189535f; }
    const bool lowhalf = (lane & 4) == 0;
    for (int m = F.gw; m < NR; m += F.NGW) {
        bf16_t* row = (bf16_t*)(p.ws + WS_PROJ) + (size_t)m * DP;
        v4u* qp = (v4u*)(row + C_DQ) + lane; const v4u* kp = (const v4u*)(row + C_DK) + lane;
        const v4u qv = *qp, kv = *kp, vv = *((const v4u*)(row + C_DV) + lane);
        float q[8], k[8];
#pragma unroll
        for (int i = 0; i < 4; ++i) { q[2 * i] = __uint_as_float(qv[i] << 16); q[2 * i + 1] = __uint_as_float(qv[i] & 0xffff0000u); k[2 * i] = __uint_as_float(kv[i] << 16); k[2 * i + 1] = __uint_as_float(kv[i] & 0xffff0000u); }
        float sq = 0.f, sk = 0.f;
#pragma unroll
        for (int i = 0; i < 8; ++i) { sq += q[i] * q[i]; sk += k[i] * k[i]; }
        sq += __shfl_xor(sq, 1); sq += __shfl_xor(sq, 2); sq += __shfl_xor(sq, 4);
        sk += __shfl_xor(sk, 1); sk += __shfl_xor(sk, 2); sk += __shfl_xor(sk, 4);
        const float rq = rsqrtf(sq * (1.f / 64.f) + EPS), rk = rsqrtf(sk * (1.f / 64.f) + EPS);
#pragma unroll
        for (int i = 0; i < 8; ++i) { q[i] *= rq * gq[i]; k[i] *= rk * gk[i]; }
        if (m < NL) {
            const int t = m % T; const float pos = (float)((lane & 2) ? (t % 64) : (t / 64));
#pragma unroll
            for (int i = 0; i < 8; ++i) {
                const float rev = pos * fr[i]; const float cs = __builtin_amdgcn_cosf(rev), sn = __builtin_amdgcn_sinf(rev);
                const float oq = __shfl_xor(q[i], 4), ok = __shfl_xor(k[i], 4);
                q[i] = lowhalf ? q[i] * cs - oq * sn : q[i] * cs + oq * sn;
                k[i] = lowhalf ? k[i] * cs - ok * sn : k[i] * cs + ok * sn;
            }
        }
        v4u qo, ko;
#pragma unroll
        for (int i = 0; i < 4; ++i) { qo[i] = pk2(q[2 * i], q[2 * i + 1]); ko[i] = pk2(k[2 * i], k[2 * i + 1]); }
        *qp = qo;
        { const int bb = m < NL ? m / T : (m - NL) / TC, kidx = m < NL ? TC + (m % T) : (m - NL) % TC, tile = kidx >> 6, r = kidx & 63, hh = lane >> 4, ci = lane & 15;
          const size_t blk = ((size_t)(bb * NH + hh) * 132 + tile) * 16384;
          *(v4u*)(p.ws + WS_KT + blk + KSWZ(r, 16 * ci)) = ko;
#if FAST_ATT
          *(v4u*)(p.ws + WS_VT + blk + att::v_st_lin(r, 8 * ci)) = vv; }
#else
          *(v4u*)(p.ws + WS_VT + blk + att::v_st(r, 8 * ci)) = vv; }
#endif
    }
}
__device__ __forceinline__ void scan_phase(const Params& p, Ctx& F, int l) {
    const int lane_ = lane_id(), tid_ = F.wave * 64 + lane_;
    unsigned* cs = (unsigned*)(p.ws + WS_CS);
    for (int i = blockIdx.x * (NWAVES * 64) + tid_; i < 16 * 8192; i += F.G * NWAVES * 64) {
        const int combo = i >> 13, e2 = i & 8191, dir = combo & 1, h = (combo >> 1) & 3;
        const float lg2 = log2_sigmoid(dir ? p.in[I_DECB][l * NH + h] : p.in[I_DECF][l * NH + h]);
        const float decay = exp2f(lg2 * 128.f);
        unsigned* base = cs + (size_t)combo * 66 * 8192 + e2;
        float s0 = 0.f, s1 = 0.f;
#pragma unroll 1
        for (int jj = 0; jj < 66; jj += 22) {
            unsigned tv[22];
#pragma unroll
            for (int k = 0; k < 22; ++k) { const int q = jj + k, idx = dir ? (q < 2 ? 1 - q : 67 - q) : q; tv[k] = base[(size_t)idx * 8192]; }
#pragma unroll
            for (int k = 0; k < 22; ++k) { const int q = jj + k, idx = dir ? (q < 2 ? 1 - q : 67 - q) : q;
                base[(size_t)idx * 8192] = pk2(s0, s1);
                s0 = decay * s0 + __uint_as_float(tv[k] << 16); s1 = decay * s1 + __uint_as_float(tv[k] & 0xffff0000u); }
        }
    }
}

#define IN(k) (lo <= (k) && (k) < hi)
#define SEAM(k) do { if (IN(k) && IN((k) + 1)) xcd_barrier(bar, F.wave == 0 && lane_id() == 0); } while (0)
#ifndef REP_ATT
#define REP_ATT 1
#endif
#ifndef REP_RET
#define REP_RET 1
#endif
#ifndef REP_B
#define REP_B 1
#endif
#ifndef REP_H0
#define REP_H0 1
#endif
#ifndef REP_H1
#define REP_H1 1
#endif
#ifndef REP_I1
#define REP_I1 1
#endif
#ifndef REP_P0
#define REP_P0 1
#endif
#ifndef REP_CS
#define REP_CS 1
#endif
#ifndef REP_A
#define REP_A 1
#endif
#ifndef REP_I0
#define REP_I0 1
#endif
#ifndef REP_F0
#define REP_F0 1
#endif
#ifndef REP_G2
#define REP_G2 1
#endif
#ifndef REP_BAR
#define REP_BAR 0
#endif
template <int l>
__device__ __forceinline__ void layer_phases(const Params& p, Ctx& F, const XcdBarrier& bar, const int lo, const int hi) {
    constexpr int base = 1 + 9 * l;

        if (IN(base + 0)) { for (int rep_ = 0; rep_ < REP_A; ++rep_) norm_phase(p, F, l, 0, NR); for (int rep_ = 0; rep_ < REP_BAR; ++rep_) xcd_barrier(bar, F.wave == 0 && lane_id() == 0); SEAM(base + 0); }
        if (IN(base + 1)) {
            pg8::Gemm g{(const bf16_t*)(p.ws + WS_HBUF), (const bf16_t*)(p.ws + W_WIN) + (size_t)l * DP * DM, NR, DP, DM, DM};
            pg8::Order S; S.init(NR / 256, DP / 256, F.G, (int)blockIdx.x);
            pg8::EpiProj E{(bf16_t*)(p.ws + WS_PROJ)};
            { pg8::gemm_phase<pg8::EpiProj, pg8::Order, true, true>(F.lds + RING_OFF, g, S, E, F.wave); if (REP_B > 1) { pg8::gemm_phase<pg8::EpiProj, pg8::Order, true, true>(F.lds + RING_OFF, g, S, E, F.wave); } }
            SEAM(base + 1);
        }
        if (IN(base + 2)) {
            qkrope_phase(p, F, l);
            for (int rep_ = 0; rep_ < REP_CS; ++rep_)
            for (int u = blockIdx.x; u < 8 * 66; u += F.G) {
                const int bh = u & 7, j = u >> 3, b = bh >> 2, h = bh & 3;
                const int rowbase = j < 2 ? NL + b * TC + 128 * j : b * T + 128 * (j - 2);
                att::chunk_state_unit(F.wave, (const bf16_t*)(p.ws + WS_PROJ), cs_ptr(p, b, h, 0, j), cs_ptr(p, b, h, 1, j), rowbase, h,
                                      log2_sigmoid(p.in[I_DECF][l * NH + h]), log2_sigmoid(p.in[I_DECB][l * NH + h]), (LAS char*)(F.lds + RING_OFF));
            }
            SEAM(base + 2);
        }
        if (IN(base + 3)) { scan_phase(p, F, l); SEAM(base + 3); }
        if (IN(base + 4)) {
#if FAST_RET
            for (int rep_ = 0; rep_ < REP_RET; ++rep_)
            for (int u = blockIdx.x; u < (l == 0 ? 8 * 33 : 8 * 32); u += F.G) {
                const int bh = u & 7, jp = (u >> 3) + (l == 0 ? 0 : 1), b = bh >> 2, h = bh & 3;
                const int rowA = jp == 0 ? NL + b * TC : b * T + 128 * (2 * jp - 2);
                att::ret_out_unit(F.wave, (const bf16_t*)(p.ws + WS_PROJ), (bf16_t*)(p.ws + WS_CONCAT), cs_ptr(p, b, h, 0, 2 * jp), cs_ptr(p, b, h, 0, 2 * jp + 1), (size_t)66 * 16384,
                                  rowA, rowA + 128, h, log2_sigmoid(p.in[I_DECF][l * NH + h]), log2_sigmoid(p.in[I_DECB][l * NH + h]), p.in[I_GNG] + l * 512 + h * 128, (LAS char*)(F.lds + RING_OFF));
            }
#endif
#if FAST_ATT
            { const int lane_ = lane_id();
              const float s1 = wave_sum(p.in[I_LQ1][l * 64 + lane_] * p.in[I_LK1][l * 64 + lane_]), s2 = wave_sum(p.in[I_LQ2][l * 64 + lane_] * p.in[I_LK2][l * 64 + lane_]);
              const float li = lam_init_of(l), lam = __expf(s1) - __expf(s2) + li;
#if ATT_V3
              constexpr int nunits = 256 + (l == 0 ? 8 : 0);
              for (int rep_ = 0; rep_ < REP_ATT; ++rep_)
              for (int u = blockIdx.x; u < nunits; u += F.G) {
                  int b, h, qrow0, NT;
                  if (u < 256) { const int bh = u & 7, qb = u >> 3; b = bh >> 2; h = bh & 3; qrow0 = b * T + qb * 256; NT = (TC + T) / 64; }
                  else { const int bh = u - 256; b = bh >> 2; h = bh & 3; qrow0 = NL + b * TC; NT = TC / 64; }
                  att::attn_unit3p(F.wave, (const bf16_t*)(p.ws + WS_PROJ), (const char*)(p.ws + WS_KT) + (size_t)(b * NH + h) * 132 * 16384, (const char*)(p.ws + WS_VT) + (size_t)(b * NH + h) * 132 * 16384, (bf16_t*)(p.ws + WS_CONCAT), qrow0, NT, h, (LAS char*)(F.lds + RING_OFF), lam, 1.f - li, p.in[I_SUBLN] + l * 128);
              }
#else
              constexpr int nunits = 512 + (l == 0 ? 16 : 0);
              for (int rep_ = 0; rep_ < REP_ATT; ++rep_)
              for (int u = blockIdx.x; u < nunits; u += F.G) {
                  int b, h, qrow0, NT;
                  if (u < 512) { const int bh = u & 7, qb = u >> 3; b = bh >> 2; h = bh & 3; qrow0 = b * T + qb * 128; NT = (TC + T) / 64; }
                  else { const int v = u - 512, bh = v & 7, blk = v >> 3; b = bh >> 2; h = bh & 3; qrow0 = NL + b * TC + blk * 128; NT = TC / 64; }
                  att::attn_unit(F.wave, (const bf16_t*)(p.ws + WS_PROJ), (const char*)(p.ws + WS_KT) + (size_t)(b * NH + h) * 132 * 16384, (const char*)(p.ws + WS_VT) + (size_t)(b * NH + h) * 132 * 16384, (bf16_t*)(p.ws + WS_CONCAT), qrow0, NT, h, (LAS char*)(F.lds + RING_OFF), lam, 1.f - li, p.in[I_SUBLN] + l * 128);
              }
#endif
            }
#endif
            SEAM(base + 4);
        }
        if (IN(base + 5)) {
            pg8::Gemm g{(const bf16_t*)(p.ws + WS_CONCAT), (const bf16_t*)(p.ws + W_WOUT) + (size_t)l * DM * DM, NR, DM, DM, DM};
            pg8::Order S; S.init(NL / 256, DM / 256, F.G, (int)blockIdx.x);
            pg8::EpiResid E{l == 0 ? p.in[I_X] : p.out, l == 0 ? p.in[I_CTX] : (const float*)(p.ws + WS_XRC), p.out, (float*)(p.ws + WS_XRC), modv(p, l, 0, 2), modv(p, l, 2, 2)};
            if (REP_F0 > 1 && l == 0) { pg8::gemm_phase<pg8::EpiResid, pg8::Order, true, true>(F.lds + RING_OFF, g, S, E, F.wave); }
            pg8::gemm_phase<pg8::EpiResid, pg8::Order, true, true>(F.lds + RING_OFF, g, S, E, F.wave);
            if constexpr (l == 0) {
                pg8::Gemm g2{(const bf16_t*)(p.ws + WS_CONCAT), (const bf16_t*)(p.ws + W_WOUT), NR, DM, 256, DM};
                pg8::SplitOrder S2; S2.init(NL / 256, 2, DM / 256, DM / 256, F.G, (int)blockIdx.x);
                pg8::EpiPartial E2{(float*)(p.ws + WS_PART), NL / 256, NC};
                pg8::gemm_phase<pg8::EpiPartial, pg8::SplitOrder, true, true>(F.lds + RING_OFF, g2, S2, E2, F.wave);
            }
            SEAM(base + 5);
        }
        if (IN(base + 6)) { if constexpr (l == 0) norm_phase(p, F, 0, 1, NR); else router_phase(p, F); SEAM(base + 6); }
        if constexpr (l == 0) {
            if (IN(8)) {
                pg8::Gemm g{(const bf16_t*)(p.ws + WS_HBUF), (const bf16_t*)(p.ws + W_FGU), NR, 2 * DFF, DM, DM};
                pg8::Order S; S.init(NR / 256, 2 * DFF / 256, F.G, (int)blockIdx.x);
                pg8::EpiSwiglu E{(bf16_t*)(p.ws + WS_ACT)};
                { pg8::gemm_phase<pg8::EpiSwiglu, pg8::Order, true, true>(F.lds + RING_OFF, g, S, E, F.wave); if (REP_H0 > 1) { pg8::gemm_phase<pg8::EpiSwiglu, pg8::Order, true, true>(F.lds + RING_OFF, g, S, E, F.wave); } }
                SEAM(8);
            }
            if (IN(9)) {
                pg8::Gemm g{(const bf16_t*)(p.ws + WS_ACT), (const bf16_t*)(p.ws + W_FD), NR, DM, DFF, DFF};
                pg8::Order S; S.init(NL / 256, DM / 256, F.G, (int)blockIdx.x);
                pg8::EpiResid E{p.out, (const float*)(p.ws + WS_XRC), p.out, (float*)(p.ws + WS_XRC), modv(p, 0, 0, 5), modv(p, 0, 2, 5)};
                if (REP_I0 > 1) { pg8::EpiResid Ed{p.out, (const float*)(p.ws + WS_XRC), (float*)(p.ws + WS_H2S), (float*)(p.ws + WS_H2S) + (size_t)NL * DM, modv(p, 0, 0, 5), modv(p, 0, 2, 5)}; pg8::gemm_phase<pg8::EpiResid, pg8::Order, true, true>(F.lds + RING_OFF, g, S, Ed, F.wave); }
                pg8::gemm_phase<pg8::EpiResid, pg8::Order, true, true>(F.lds + RING_OFF, g, S, E, F.wave);
                {
                    pg8::Gemm g2{(const bf16_t*)(p.ws + WS_ACT), (const bf16_t*)(p.ws + W_FD), NR, DM, 256, DFF};
                    pg8::SplitOrder S2; S2.init(NL / 256, 2, DM / 256, DFF / 256, F.G, (int)blockIdx.x);
                    pg8::EpiPartial E2{(float*)(p.ws + WS_PART), NL / 256, NC};
                    pg8::gemm_phase<pg8::EpiPartial, pg8::SplitOrder, true, true>(F.lds + RING_OFF, g2, S2, E2, F.wave);
                }
                SEAM(9);
            }
        } else {
            if (IN(17)) { for (int rep_ = 0; rep_ < REP_G2; ++rep_) gather_phase(p, F); SEAM(17); }
            if (IN(18)) {
                moe_table(F);
                pg8::Gemm g{(const bf16_t*)(p.ws + WS_H2S), (const bf16_t*)(p.ws + W_MGU), MP_MAX, 2 * DFF, DM / 2, DM / 2};
                pg8::Order S; moe_order(F, S, 2 * DFF / 256, (long)2 * DFF * DM);
                pg8::EpiSwiglu8 E{(unsigned char*)(p.ws + WS_ACTS)};
                { pg8::gemm_phase<pg8::EpiSwiglu8, pg8::Order, true, true, true>(F.lds + RING_OFF, g, S, E, F.wave); if (REP_H1 > 1) { pg8::gemm_phase<pg8::EpiSwiglu8, pg8::Order, true, true, true>(F.lds + RING_OFF, g, S, E, F.wave); } }
                SEAM(18);
            }
            if (IN(19)) {
                moe_table(F);
                pg8::Gemm g{(const bf16_t*)(p.ws + WS_ACTS), (const bf16_t*)(p.ws + W_MD), MP_MAX, DM, DFF / 2, DFF / 2};
                pg8::Order S; moe_order(F, S, DM / 256, (long)DM * DFF);
                pg8::EpiMoeDown E{(bf16_t*)(p.ws + WS_YBUF), (const float*)(p.ws + WS_ROUTE) + 6 * NL + MP_MAX, 1.f / (W8_SCALE * A8_SCALE)};
                { pg8::gemm_phase<pg8::EpiMoeDown, pg8::Order, true, true, true>(F.lds + RING_OFF, g, S, E, F.wave); if (REP_I1 > 1) { pg8::gemm_phase<pg8::EpiMoeDown, pg8::Order, true, true, true>(F.lds + RING_OFF, g, S, E, F.wave); } }
                SEAM(19);
            }
            if (IN(20)) { combine_phase(p, F); }
        }
}
struct MArgs { Params p; int ph_lo, ph_hi, li, pad; };
constexpr int N_PHASES = 21;
__global__ void __launch_bounds__(NWAVES * 64, 2) mega(MArgs args) {
    extern __shared__ __attribute__((aligned(16))) unsigned char lds_raw[];
    const Params& p = args.p;
    Ctx F;
    F.lds = (LAS unsigned char*)lds_raw; F.MISC = (volatile LAS unsigned*)(F.lds + MISC_OFF);
    F.wave = __builtin_amdgcn_readfirstlane((int)threadIdx.x >> 6);
    const int lane_ = lane_id(), tid_ = F.wave * 64 + lane_;
    F.G = gridDim.x; F.gw = blockIdx.x * NWAVES + F.wave; F.NGW = F.G * NWAVES;
    F.ctl = (unsigned*)(p.ws + WS_CTL);
    for (int u = tid_; u < (LDS_BYTES - MISC_OFF) / 4; u += NWAVES * 64) ((LAS unsigned*)(F.lds + MISC_OFF))[u] = 0u;
    __syncthreads();
    XcdBarrier bar = xcd_barrier_post(F.ctl + CW_BAR + args.li * XCD_BAR_WORDS, F.MISC + 8, tid_ == 0);
    const int lo = args.ph_lo, hi = args.ph_hi;

    if (IN(0)) { for (int rep_ = 0; rep_ < REP_P0; ++rep_) { if (rep_) __syncthreads(); p0_prologue(p, F); } SEAM(0); }
    layer_phases<0>(p, F, bar, lo, hi);
    layer_phases<1>(p, F, bar, lo, hi);
#undef IN
#undef SEAM
}

#ifndef FAST_MASK
#define FAST_MASK 0x1u
#endif
static void launch_naive_e(const Params& p, int l, bool ret, bool att, hipStream_t stream) {
    const int nrows_mix = l == 0 ? NR : NL;
    if (ret) k_ret_naive<<<nrows_mix * NH / 4, 256, 0, stream>>>(p, l, nrows_mix);
    if (att) k_attn_naive<<<nrows_mix * NH / 4, 256, 0, stream>>>(p, l, nrows_mix);
}
static void launch_naive(const Params& p, int ph, hipStream_t stream) {
    const int l = ph >= 10 ? 1 : 0, rel = ph == 0 ? -1 : (ph - 1 - 9 * l);
    const int nrows_mix = l == 0 ? NR : NL;
    if (ph == 0) { k_mod<<<(2 * 3 * 6144 + 255) / 256, 256, 0, stream>>>(p); return; }
    switch (rel) {
    case 0: k_norm<<<NR / 4, 256, 0, stream>>>(p, l, 0, NR); break;
    case 1: k_gemm_proj<<<dim3(DP / 64, NR / 4), dim3(64, 4), 0, stream>>>(p, l); break;
    case 2: k_qkrope<<<NR / 4, 256, 0, stream>>>(p, l); break;
    case 3: break;
    case 4: launch_naive_e(p, l, true, true, stream); break;
    case 5: k_gemm_out<<<dim3(DM / 64, nrows_mix / 4), dim3(64, 4), 0, stream>>>(p, l); break;
    case 6: k_norm<<<nrows_mix / 4, 256, 0, stream>>>(p, l, 1, nrows_mix); break;
    case 7: if (l == 0) k_ffn_gu<<<dim3(DFF / 64, NR / 4), dim3(64, 4), 0, stream>>>(p); break;
    case 8: if (l == 0) k_ffn_down<<<dim3(DM / 64, NR / 4), dim3(64, 4), 0, stream>>>(p); else k_moe_gu<<<dim3(DFF / 64, 2 * NL / 4), dim3(64, 4), 0, stream>>>(p); break;
    case 9: k_moe_down<<<dim3(DM / 64, NL / 4), dim3(64, 4), 0, stream>>>(p); break;
    default: break;
    }
}
extern "C" void kernel_launch(void* const* d_in, const int* in_sizes, int n_in, void* d_out, int out_size, void* d_ws, size_t ws_size, hipStream_t stream) {
    static int grid = 0;
    if (grid == 0) {
        if (n_in != 28 || out_size != NL * DM || ws_size < WS_END) { fprintf(stderr, "kernel_launch: unexpected shapes (n_in %d out %d ws %zu need %zu)\n", n_in, out_size, ws_size, (size_t)WS_END); grid = -1; return; }
        int dev = 0, cus = 0, per_cu = 0;
        if (hipGetDevice(&dev) != hipSuccess || hipDeviceGetAttribute(&cus, hipDeviceAttributeMultiprocessorCount, dev) != hipSuccess) { grid = -1; return; }
        if (hipFuncSetAttribute((const void*)mega, hipFuncAttributeMaxDynamicSharedMemorySize, LDS_BYTES) != hipSuccess) { fprintf(stderr, "kernel_launch: hipFuncSetAttribute failed\n"); grid = -1; return; }
        if (hipOccupancyMaxActiveBlocksPerMultiprocessor(&per_cu, (const void*)mega, NWAVES * 64, LDS_BYTES) != hipSuccess || per_cu < 1) { fprintf(stderr, "kernel_launch: occupancy query says %d\n", per_cu); (void)hipGetLastError(); grid = -1; return; }
        grid = cus;
    }
    if (grid < 0) return;
    (void)hipMemsetAsync((char*)d_ws + WS_CTL, 0, CTL_ZERO_BYTES, stream);
    MArgs a{};
    for (int i = 0; i < 28; ++i) a.p.in[i] = (const float*)d_in[i];
    a.p.out = (float*)d_out; a.p.ws = (unsigned char*)d_ws;
    const unsigned mask = FAST_MASK;
    int li = 0, ph = 0;
    while (ph < N_PHASES) {
        if ((mask >> ph) & 1u) { int e = ph; bool cutE = false;
            while (e < N_PHASES && ((mask >> e) & 1u)) { const bool isE = (e == 5 || e == 14); ++e; if (isE && !(FAST_ATT && FAST_RET)) { cutE = true; break; } }
            a.ph_lo = ph; a.ph_hi = e; a.li = li++;
            hipLaunchKernelGGL(mega, dim3(grid), dim3(NWAVES * 64), LDS_BYTES, stream, a);
            if (cutE) launch_naive_e(a.p, e - 1 == 5 ? 0 : 1, !FAST_RET, !FAST_ATT, stream);
            ph = e; }
        else { launch_naive(a.p, ph, stream); ++ph; }
    }
}
```

```cpp
#include <hip/hip_runtime.h>
#include <cstdint>
#include <cstdio>
#define FAST_MASK 0x1fffffu
#define FAST_ATT 1
#define FAST_RET 1

constexpr int NB = 2, T = 8192, DM = 1024, TC = 256;
constexpr int NL = NB * T;
constexpr int NC = NB * TC;
constexpr int NR = NL + NC;
constexpr int DP = 3584, DFF = 2816, NE = 8, NH = 4;
constexpr float EPS = 1e-6f;
constexpr int C_RQ = 0, C_RK = 512, C_RV = 1024, C_RG = 1536, C_DQ = 2048, C_DK = 2560, C_DV = 3072;
constexpr int MP_MAX = 2 * NL + NE * 256;

typedef unsigned short bf16_t;
__device__ __forceinline__ float bf2f(bf16_t v) { return __uint_as_float(((unsigned)v) << 16); }
__device__ __forceinline__ bf16_t f2bf(float f) { unsigned u = __float_as_uint(f); u += 0x7fffu + ((u >> 16) & 1u); return (bf16_t)(u >> 16); }
typedef float f32x2_t __attribute__((ext_vector_type(2)));
typedef __bf16 bf16x2_t __attribute__((ext_vector_type(2)));
__device__ __forceinline__ unsigned pk2(float lo, float hi) { const f32x2_t v = {lo, hi}; const bf16x2_t b = __builtin_convertvector(v, bf16x2_t); return __builtin_bit_cast(unsigned, b); }
__device__ __forceinline__ unsigned pk4_fp8(float a, float b, float c, float d) {
    a = __builtin_amdgcn_fmed3f(a, -448.f, 448.f); b = __builtin_amdgcn_fmed3f(b, -448.f, 448.f); c = __builtin_amdgcn_fmed3f(c, -448.f, 448.f); d = __builtin_amdgcn_fmed3f(d, -448.f, 448.f);
    int r = 0; r = __builtin_amdgcn_cvt_pk_fp8_f32(a, b, r, false); r = __builtin_amdgcn_cvt_pk_fp8_f32(c, d, r, true); return (unsigned)r;
}
constexpr float W8_SCALE = 64.f, A8_SCALE = 8.f;
__device__ __forceinline__ float wave_sum(float v) {
#pragma unroll
    for (int o = 1; o < 64; o <<= 1) v += __shfl_xor(v, o);
    return v;
}
__device__ __forceinline__ int lane_id() { int l = (int)__builtin_amdgcn_mbcnt_hi(~0u, __builtin_amdgcn_mbcnt_lo(~0u, 0u)); asm volatile("" : "+v"(l)); return l; }
__device__ __forceinline__ float siluf(float v) { return v / (1.f + __expf(-v)); }

constexpr size_t MiB = 1u << 20;
constexpr size_t WS_CTL = 0, CTL_ZERO_BYTES = 1 * MiB;
constexpr size_t WS_MODV = 1 * MiB;
constexpr size_t WS_ROUTE = 2 * MiB;
constexpr size_t WS_XRC = 3 * MiB;
constexpr size_t WS_W = 6 * MiB;
constexpr size_t W_WIN = WS_W;
constexpr size_t W_WOUT = W_WIN + (size_t)2 * DP * DM * 2;
constexpr size_t W_FGU = W_WOUT + (size_t)2 * DM * DM * 2;
constexpr size_t W_FD = W_FGU + (size_t)2 * DFF * DM * 2;
constexpr size_t W_MGU = W_FD + (size_t)DM * DFF * 2;
constexpr size_t W_MD = W_MGU + (size_t)NE * 2 * DFF * DM * 2;
constexpr size_t W_END = W_MD + (size_t)NE * DM * DFF * 2;
constexpr size_t WS_HBUF = 173 * MiB;
constexpr size_t WS_PROJ = 206 * MiB;
constexpr size_t WS_CONCAT = 322 * MiB;
constexpr size_t WS_ACT = 206 * MiB;
constexpr size_t WS_ACTS = 173 * MiB;
constexpr size_t WS_H2S = 361 * MiB;
constexpr size_t WS_KT = 394 * MiB, WS_VT = WS_KT + (size_t)NB * NH * 132 * 16384;
static_assert(WS_VT + (size_t)NB * NH * 132 * 16384 <= 429 * MiB && WS_H2S + (size_t)NB * NH * 2 * 66 * 32768 <= WS_KT, "K/V tile images");
constexpr size_t WS_YBUF = WS_H2S, WS_CS = WS_H2S, WS_PART = WS_H2S;
constexpr size_t WS_END = 430 * MiB;
static_assert(W_END <= WS_HBUF && WS_ACTS + (size_t)MP_MAX * DFF * 2 <= WS_H2S && WS_H2S + (size_t)MP_MAX * DM * 2 <= WS_END && WS_ACT + (size_t)2 * NL * DFF * 2 <= WS_END, "ws map");
constexpr int CW_BAR = 4096;
constexpr int CW_CNT = 200000;

struct Params {
    const float* in[28];
    float* out;
    unsigned char* ws;
};
enum { I_X = 0, I_C, I_CTX, I_CCTX, I_ADAW, I_ADAB, I_N1G, I_N2G, I_WIN, I_DECF, I_DECB, I_GNG, I_QNG, I_KNG, I_LQ1, I_LK1, I_LQ2, I_LK2, I_SUBLN, I_WOUT,
       I_FWG, I_FWU, I_FWD, I_RW, I_RB, I_MWG, I_MWU, I_MWD };

__device__ __forceinline__ int rowtype(int m) { return m < NL ? m / T : 2; }
__device__ __forceinline__ const float* modv(const Params& p, int l, int rt, int i) { return (const float*)(p.ws + WS_MODV) + ((size_t)(l * 3 + rt) * 6 + i) * DM; }
__device__ __forceinline__ float* xr_row(const Params& p, int m) { return m < NL ? p.out + (size_t)m * DM : (float*)(p.ws + WS_XRC) + (size_t)(m - NL) * DM; }
__device__ __forceinline__ float lam_init_of(int l) { return l == 0 ? 0.2f : (0.8f - 0.6f * 0.74081822068171788f); }

#ifndef FAST_ATT
#define FAST_ATT 0
#endif
#ifndef FAST_RET
#define FAST_RET 0
#endif
#ifndef ATT_V3
#define ATT_V3 1
#endif
__global__ void k_mod(Params p) {
    const int idx = blockIdx.x * blockDim.x + threadIdx.x;
    if (idx >= 2 * 3 * 6144) return;
    const int n = idx % 6144, rt = (idx / 6144) % 3, l = idx / (6144 * 3);
    const float* cv = rt < 2 ? p.in[I_C] + rt * DM : p.in[I_CCTX];
    const float* W = p.in[I_ADAW] + (size_t)l * DM * 6144;
    float acc = 0.f;
    for (int k = 0; k < DM; ++k) acc += siluf(cv[k]) * W[(size_t)k * 6144 + n];
    ((float*)(p.ws + WS_MODV))[(size_t)(l * 3 + rt) * 6144 + n] = acc + p.in[I_ADAB][l * 6144 + n];
}

__global__ void k_norm(Params p, int l, int which, int nrows) {
    const int m = blockIdx.x * (blockDim.x / 64) + (threadIdx.x >> 6), lane = threadIdx.x & 63;
    if (m >= nrows) return;
    const float* xrow;
    if (l == 0 && which == 0) xrow = m < NL ? p.in[I_X] + (size_t)m * DM : p.in[I_CTX] + (size_t)(m - NL) * DM;
    else xrow = xr_row(p, m);
    const int rt = rowtype(m);
    const float* g = p.in[which ? I_N2G : I_N1G] + l * DM;
    const float* sh = modv(p, l, rt, which ? 3 : 0);
    const float* sc = modv(p, l, rt, which ? 4 : 1);
    float v[16]; float ss = 0.f;
#pragma unroll
    for (int j = 0; j < 4; ++j) { const float4 t = *(const float4*)(xrow + 256 * j + 4 * lane); v[4 * j] = t.x; v[4 * j + 1] = t.y; v[4 * j + 2] = t.z; v[4 * j + 3] = t.w; ss += t.x * t.x + t.y * t.y + t.z * t.z + t.w * t.w; }
    const float r = rsqrtf(wave_sum(ss) * (1.f / DM) + EPS);
    bf16_t* hb = (bf16_t*)(p.ws + WS_HBUF) + (size_t)m * DM;
#pragma unroll
    for (int j = 0; j < 4; ++j)
#pragma unroll
        for (int q = 0; q < 4; ++q) { const int col = 256 * j + 4 * lane + q; const float y = v[4 * j + q] * r * g[col]; v[4 * j + q] = y * (1.f + sc[col]) + sh[col]; hb[col] = f2bf(v[4 * j + q]); }
    if (l == 1 && which == 1) {
        const float* rw = p.in[I_RW]; float lg[8];
#pragma unroll
        for (int e = 0; e < 8; ++e) { float a = 0.f;
#pragma unroll
            for (int j = 0; j < 4; ++j)
#pragma unroll
                for (int q = 0; q < 4; ++q) a += v[4 * j + q] * rw[(size_t)(256 * j + 4 * lane + q) * 8 + e];
            lg[e] = wave_sum(a) + p.in[I_RB][e]; }
        int i1 = 0; float v1 = lg[0];
#pragma unroll
        for (int e = 1; e < 8; ++e) if (lg[e] > v1) { v1 = lg[e]; i1 = e; }
        int i2 = -1; float v2 = -3.4e38f;
#pragma unroll
        for (int e = 0; e < 8; ++e) if (e != i1 && lg[e] > v2) { v2 = lg[e]; i2 = e; }
        const float w1 = 1.f / (1.f + __expf(v2 - v1));
        if (lane == 0) { int* te = (int*)(p.ws + WS_ROUTE); float* tw = (float*)(p.ws + WS_ROUTE) + 2 * NL; te[2 * m] = i1; te[2 * m + 1] = i2; tw[2 * m] = w1; tw[2 * m + 1] = 1.f - w1; }
    }
}

__global__ void k_gemm_proj(Params p, int l) {
    const int n = blockIdx.x * 64 + threadIdx.x, m = blockIdx.y * 4 + threadIdx.y;
    const bf16_t* a = (const bf16_t*)(p.ws + WS_HBUF) + (size_t)m * DM;
    const float* W = p.in[I_WIN] + (size_t)l * DM * DP + n;
    float acc = 0.f;
#pragma unroll 8
    for (int k = 0; k < DM; ++k) acc += bf2f(a[k]) * W[(size_t)k * DP];
    if (n >= C_RK && n < C_RV) acc *= 0.08838834764831845f;
    ((bf16_t*)(p.ws + WS_PROJ))[(size_t)m * DP + n] = f2bf(acc);
}

__global__ void k_qkrope(Params p, int l) {
    const int m = blockIdx.x * (blockDim.x / 64) + (threadIdx.x >> 6), lane = threadIdx.x & 63;
    if (m >= NR) return;
    bf16_t* row = (bf16_t*)(p.ws + WS_PROJ) + (size_t)m * DP;
    const bool lat = m < NL; const int t = m % T;
    const int j = lane & 31; const float pos = (float)((j < 16) ? (t / 64) : (t % 64));
    const float inv_freq = exp2f(-(float)(j & 15) * (13.287712379549449f / 16.f));
    const float ang = pos * inv_freq; const float cs = __cosf(ang), sn = __sinf(ang);
    for (int part = 0; part < 2; ++part) {
        const float* g = p.in[part ? I_KNG : I_QNG] + l * 64;
        for (int hc = 0; hc < 8; ++hc) {
            bf16_t* q = row + (part ? C_DK : C_DQ) + hc * 64;
            const float v = bf2f(q[lane]);
            const float r = rsqrtf(wave_sum(v * v) * (1.f / 64.f) + EPS);
            float y = v * r * g[lane];
            if (lat) { const float o = __shfl_xor(y, 32); y = lane < 32 ? y * cs - o * sn : y * cs + o * sn; }
            if (part == 0) y *= 0.18033688011112042f;
            q[lane] = f2bf(y);
        }
    }
}

__global__ void k_ret_naive(Params p, int l, int nrows) {
    const int w = blockIdx.x * (blockDim.x / 64) + (threadIdx.x >> 6), lane = threadIdx.x & 63;
    if (w >= nrows * NH) return;
    const int m = w / NH, h = w % NH;
    const bf16_t* proj = (const bf16_t*)(p.ws + WS_PROJ);
    const float df = p.in[I_DECF][l * NH + h], db = p.in[I_DECB][l * NH + h];
    const float lgf = -log1pf(__expf(-df)), lgb = -log1pf(__expf(-db));
    const bf16_t* qrow = proj + (size_t)m * DP + C_RQ + h * 128 + 2 * lane;
    const float q0 = bf2f(qrow[0]), q1 = bf2f(qrow[1]);
    float o0 = 0.f, o1 = 0.f;
    if (m < NL) {
        const int b = m / T, t = m % T;
        for (int s = 0; s < T; ++s) {
            const bf16_t* kr = proj + (size_t)(b * T + s) * DP + h * 128 + 2 * lane;
            const float dot = wave_sum(q0 * bf2f(kr[C_RK]) + q1 * bf2f(kr[C_RK + 1]));
            const float wgt = s < t ? __expf(lgf * (float)(t - s)) : (s == t ? 2.f : __expf(lgb * (float)(s - t)));
            o0 += wgt * dot * bf2f(kr[C_RV]); o1 += wgt * dot * bf2f(kr[C_RV + 1]);
        }
        for (int i = 0; i < TC; ++i) {
            const bf16_t* kr = proj + (size_t)(NL + b * TC + i) * DP + h * 128 + 2 * lane;
            const float dot = wave_sum(q0 * bf2f(kr[C_RK]) + q1 * bf2f(kr[C_RK + 1]));
            const float wgt = __expf(lgf * (float)(t + TC - i)) + __expf(lgb * (float)(T - t + i));
            o0 += wgt * dot * bf2f(kr[C_RV]); o1 += wgt * dot * bf2f(kr[C_RV + 1]);
        }
    } else {
        const int b = (m - NL) / TC, t = (m - NL) % TC;
        for (int s = 0; s < TC; ++s) {
            const bf16_t* kr = proj + (size_t)(NL + b * TC + s) * DP + h * 128 + 2 * lane;
            const float dot = wave_sum(q0 * bf2f(kr[C_RK]) + q1 * bf2f(kr[C_RK + 1]));
            const float wgt = s < t ? __expf(lgf * (float)(t - s)) : (s == t ? 2.f : __expf(lgb * (float)(s - t)));
            o0 += wgt * dot * bf2f(kr[C_RV]); o1 += wgt * dot * bf2f(kr[C_RV + 1]);
        }
    }
    const float mu = wave_sum(o0 + o1) * (1.f / 128.f);
    const float d0 = o0 - mu, d1 = o1 - mu;
    const float r = rsqrtf(wave_sum(d0 * d0 + d1 * d1) * (1.f / 128.f) + EPS);
    const float* gn = p.in[I_GNG] + l * 512 + h * 128 + 2 * lane;
    const bf16_t* gr = proj + (size_t)m * DP + C_RG + h * 128 + 2 * lane;
    bf16_t* cc = (bf16_t*)(p.ws + WS_CONCAT) + (size_t)m * DM + h * 128 + 2 * lane;
    cc[0] = f2bf(siluf(bf2f(gr[0])) * d0 * r * gn[0]);
    cc[1] = f2bf(siluf(bf2f(gr[1])) * d1 * r * gn[1]);
}

__global__ void k_attn_naive(Params p, int l, int nrows) {
    const int w = blockIdx.x * (blockDim.x / 64) + (threadIdx.x >> 6), lane = threadIdx.x & 63;
    if (w >= nrows * NH) return;
    const int m = w / NH, h = w % NH;
    const bf16_t* proj = (const bf16_t*)(p.ws + WS_PROJ);
    const bool lat = m < NL; const int b = lat ? m / T : (m - NL) / TC;
    float O[2][2];
    for (int c = 0; c < 2; ++c) {
        const float q = bf2f(proj[(size_t)m * DP + C_DQ + h * 128 + c * 64 + lane]);
        float mx = -1e30f, ls = 0.f, o0 = 0.f, o1 = 0.f;
        const int nk = lat ? TC + T : TC;
        for (int s = 0; s < nk; ++s) {
            const int mk = s < TC ? NL + b * TC + s : b * T + (s - TC);
            const bf16_t* kr = proj + (size_t)mk * DP + h * 128;
            const float sc = wave_sum(q * bf2f(kr[C_DK + c * 64 + lane]));
            const float mn = fmaxf(mx, sc), al = exp2f(mx - mn), pp = exp2f(sc - mn);
            ls = ls * al + pp; o0 = o0 * al + pp * bf2f(kr[C_DV + 2 * lane]); o1 = o1 * al + pp * bf2f(kr[C_DV + 2 * lane + 1]); mx = mn;
        }
        O[c][0] = o0 / ls; O[c][1] = o1 / ls;
    }
    float s1 = 0.f, s2 = 0.f;
    { const float a = p.in[I_LQ1][l * 64 + lane] * p.in[I_LK1][l * 64 + lane], bq = p.in[I_LQ2][l * 64 + lane] * p.in[I_LK2][l * 64 + lane]; s1 = wave_sum(a); s2 = wave_sum(bq); }
    const float li = lam_init_of(l), lam = __expf(s1) - __expf(s2) + li;
    const float d0 = O[0][0] - lam * O[1][0], d1 = O[0][1] - lam * O[1][1];
    const float r = rsqrtf(wave_sum(d0 * d0 + d1 * d1) * (1.f / 128.f) + EPS);
    const float* sg = p.in[I_SUBLN] + l * 128 + 2 * lane;
    bf16_t* cc = (bf16_t*)(p.ws + WS_CONCAT) + (size_t)m * DM + 512 + h * 128 + 2 * lane;
    cc[0] = f2bf(d0 * r * sg[0] * (1.f - li)); cc[1] = f2bf(d1 * r * sg[1] * (1.f - li));
}

__global__ void k_gemm_out(Params p, int l) {
    const int n = blockIdx.x * 64 + threadIdx.x, m = blockIdx.y * 4 + threadIdx.y;
    const bf16_t* a = (const bf16_t*)(p.ws + WS_CONCAT) + (size_t)m * DM;
    const float* W = p.in[I_WOUT] + (size_t)l * DM * DM + n;
    float acc = 0.f;
#pragma unroll 8
    for (int k = 0; k < DM; ++k) acc += bf2f(a[k]) * W[(size_t)k * DM];
    const float xin = l == 0 ? (m < NL ? p.in[I_X][(size_t)m * DM + n] : p.in[I_CTX][(size_t)(m - NL) * DM + n]) : xr_row(p, m)[n];
    xr_row(p, m)[n] = xin + modv(p, l, rowtype(m), 2)[n] * acc;
}

__global__ void k_ffn_gu(Params p) {
    const int j = blockIdx.x * 64 + threadIdx.x, m = blockIdx.y * 4 + threadIdx.y;
    const bf16_t* a = (const bf16_t*)(p.ws + WS_HBUF) + (size_t)m * DM;
    const float* Wg = p.in[I_FWG] + j; const float* Wu = p.in[I_FWU] + j;
    float ag = 0.f, au = 0.f;
#pragma unroll 8
    for (int k = 0; k < DM; ++k) { const float x = bf2f(a[k]); ag += x * Wg[(size_t)k * DFF]; au += x * Wu[(size_t)k * DFF]; }
    ((bf16_t*)(p.ws + WS_ACT))[(size_t)m * DFF + j] = f2bf(siluf(ag) * au);
}
__global__ void k_ffn_down(Params p) {
    const int n = blockIdx.x * 64 + threadIdx.x, m = blockIdx.y * 4 + threadIdx.y;
    const bf16_t* a = (const bf16_t*)(p.ws + WS_ACT) + (size_t)m * DFF;
    const float* W = p.in[I_FWD] + n;
    float acc = 0.f;
#pragma unroll 8
    for (int k = 0; k < DFF; ++k) acc += bf2f(a[k]) * W[(size_t)k * DM];
    xr_row(p, m)[n] += modv(p, 0, rowtype(m), 5)[n] * acc;
}
__global__ void k_moe_gu(Params p) {
    const int j = blockIdx.x * 64 + threadIdx.x, ts = blockIdx.y * 4 + threadIdx.y;
    const int t = ts >> 1; const int e = ((const int*)(p.ws + WS_ROUTE))[ts];
    const bf16_t* a = (const bf16_t*)(p.ws + WS_HBUF) + (size_t)t * DM;
    const float* Wg = p.in[I_MWG] + (size_t)e * DM * DFF + j; const float* Wu = p.in[I_MWU] + (size_t)e * DM * DFF + j;
    float ag = 0.f, au = 0.f;
#pragma unroll 8
    for (int k = 0; k < DM; ++k) { const float x = bf2f(a[k]); ag += x * Wg[(size_t)k * DFF]; au += x * Wu[(size_t)k * DFF]; }
    ((bf16_t*)(p.ws + WS_ACT))[(size_t)ts * DFF + j] = f2bf(siluf(ag) * au);
}
__global__ void k_moe_down(Params p) {
    const int n = blockIdx.x * 64 + threadIdx.x, t = blockIdx.y * 4 + threadIdx.y;
    const int* te = (const int*)(p.ws + WS_ROUTE); const float* tw = (const float*)(p.ws + WS_ROUTE) + 2 * NL;
    float y = 0.f;
    for (int s = 0; s < 2; ++s) {
        const bf16_t* a = (const bf16_t*)(p.ws + WS_ACT) + (size_t)(2 * t + s) * DFF;
        const float* W = p.in[I_MWD] + (size_t)te[2 * t + s] * DFF * DM + n;
        float acc = 0.f;
#pragma unroll 8
        for (int k = 0; k < DFF; ++k) acc += bf2f(a[k]) * W[(size_t)k * DM];
        y += tw[2 * t + s] * acc;
    }
    p.out[(size_t)t * DM + n] += modv(p, 1, t / T, 5)[n] * y;
}


typedef unsigned v2u __attribute__((ext_vector_type(2)));
namespace pg8 {
#define PG8_LAS __attribute__((address_space(3)))
typedef unsigned short bf16_t;
typedef short bf16x8 __attribute__((ext_vector_type(8)));
typedef float f32x4 __attribute__((ext_vector_type(4)));
typedef unsigned u32x4 __attribute__((ext_vector_type(4)));
typedef int i32x4 __attribute__((ext_vector_type(4)));
typedef int i32x8 __attribute__((ext_vector_type(8)));
constexpr int BM = 256, BK = 64, HALF = 128, HTB = HALF * BK * 2  , STAGE_BYTES = 8 * HTB, NXCD = 8, WGM = 8;

__host__ __device__ __forceinline__ int lds_byte(int r, int c) { const int st = (r >> 4) * 2 + (c >> 5), rr = r & 15, cc = c & 31, ob = rr * 64 + cc * 2; return st * 1024 + (ob ^ (((ob >> 9) & 1) << 5)); }
__host__ __device__ __forceinline__ void stage_rc(int b, int& R, int& C) { const int st = b / 1024, sb = b % 1024, swz = sb ^ (((sb >> 9) & 1) << 5); R = (st >> 1) * 16 + swz / 64; C = (st & 1) * 32 + (swz % 64) / 2; }
__host__ __device__ __forceinline__ int perm32(int rho) { const int n = rho >> 4, i = rho & 15; return 8 * (i >> 2) + 4 * n + (i & 3); }

struct Unit { int pm, pn; long bofs, kofs; };
struct Gemm { const bf16_t* A; const bf16_t* Bt; int M, N, K, ld; };

struct Order {
    int nM, nN, nwg, G, c;
    int e1, e2, e3, e4, e5, e6, e7; long estride;
    __device__ __forceinline__ void init(int nM_, int nN_, int G_, int c_) { nM = nM_; nN = nN_; nwg = nM * nN; G = G_; c = c_; estride = 0; e1 = e2 = e3 = e4 = e5 = e6 = e7 = 0; }
    __device__ __forceinline__ bool next(int i, Unit& u) const {
        const long L = (long)i * G + c; if (L >= nwg) return false;
        int wgid = (int)L; { const int q = nwg / NXCD, r = nwg % NXCD, xcd = wgid % NXCD, off = wgid / NXCD; wgid = (xcd < r ? xcd * (q + 1) : r * (q + 1) + (xcd - r) * q) + off; }
        const int nig = WGM * nN, gid = wgid / nig, fm = gid * WGM, gsz = (nM - fm) < WGM ? (nM - fm) : WGM;
        u.pm = fm + ((wgid % nig) % gsz); u.pn = (wgid % nig) / gsz;
        const int e = (u.pm >= e1) + (u.pm >= e2) + (u.pm >= e3) + (u.pm >= e4) + (u.pm >= e5) + (u.pm >= e6) + (u.pm >= e7);
        u.bofs = estride ? (long)e * estride : 0; u.kofs = 0;
        return true;
    }
    __device__ __forceinline__ void a_ready(const Unit&) const {}
    __device__ __forceinline__ void done(const Unit&) const {}
};

struct SplitOrder {
    int nN, ns, nwg, G, c, pm0;
    __device__ __forceinline__ void init(int pm0_, int npan, int nN_, int ns_, int G_, int c_) { pm0 = pm0_; nN = nN_; ns = ns_; nwg = npan * nN * ns; G = G_; c = c_; }
    __device__ __forceinline__ bool next(int i, Unit& u) const {
        const int L = i * G + c; if (L >= nwg) return false;
        const int ks = L % ns, rest = L / ns; u.pn = rest % nN; u.pm = pm0 + rest / nN; u.bofs = 0; u.kofs = (long)ks * 256 * 2; return true;
    }
    __device__ __forceinline__ void a_ready(const Unit&) const {}
    __device__ __forceinline__ void done(const Unit&) const {}
};
__device__ __forceinline__ unsigned cvt_pk_bf16(float lo, float hi) { unsigned r; asm volatile("v_cvt_pk_bf16_f32 %0, %1, %2" : "=v"(r) : "v"(lo), "v"(hi)); return r; }
__device__ __forceinline__ float silu_fast(float x) { return x * __builtin_amdgcn_rcpf(1.f + __builtin_amdgcn_exp2f(-1.4426950408889634f * x)); }

struct EpiProj {
    static constexpr bool PERM = true, AFTER_DRAIN = false;
    bf16_t* O;
    __device__ __forceinline__ void operator()(const f32x4 (&acc)[2][2][4][2], const Unit& u, int wr, int wc, int fr, int fq) const {
        const int row0 = u.pm * BM + wr * 64 + fr, col0 = u.pn * BM + wc * 32 + 8 * fq;
        const float sc = (u.pn == 2 || u.pn == 3) ? 0.08838834764831845f : 1.f;
#pragma unroll
        for (int ai = 0; ai < 2; ++ai)
#pragma unroll
            for (int m = 0; m < 4; ++m) { bf16_t* rowp = O + (size_t)(row0 + ai * HALF + m * 16) * DP + col0;
#pragma unroll
                for (int bj = 0; bj < 2; ++bj) { const f32x4 v0 = acc[ai][bj][m][0] * sc, v1 = acc[ai][bj][m][1] * sc;
                    u32x4 w; w.x = cvt_pk_bf16(v0[0], v0[1]); w.y = cvt_pk_bf16(v0[2], v0[3]); w.z = cvt_pk_bf16(v1[0], v1[1]); w.w = cvt_pk_bf16(v1[2], v1[3]);
                    *(u32x4*)(rowp + bj * HALF) = w; } }
    }
};
struct EpiResid {
    static constexpr bool PERM = false, AFTER_DRAIN = false;
    const float* base_lat; const float* base_ctx; float* out_lat; float* out_ctx; const float* gl; const float* gc;
    __device__ __forceinline__ void operator()(const f32x4 (&acc)[2][2][4][2], const Unit& u, int wr, int wc, int fr, int fq) const {
        const bool lat = u.pm < NL / BM;
        const int row0 = (lat ? u.pm * BM : u.pm * BM - NL) + wr * 64 + fr, col0 = u.pn * BM + wc * 32 + 4 * fq;
        const float* base = lat ? base_lat : base_ctx; float* out = lat ? out_lat : out_ctx;
        const float* gate = lat ? gl + (size_t)(u.pm / (T / BM)) * 6 * DM : gc;
        f32x4 gv[2][2];
#pragma unroll
        for (int bj = 0; bj < 2; ++bj)
#pragma unroll
            for (int n = 0; n < 2; ++n) gv[bj][n] = *(const f32x4*)(gate + col0 + bj * HALF + n * 16);
#pragma unroll
        for (int ai = 0; ai < 2; ++ai)
#pragma unroll
            for (int m = 0; m < 4; ++m) { const size_t off = (size_t)(row0 + ai * HALF + m * 16) * DM + col0;
#pragma unroll
                for (int bj = 0; bj < 2; ++bj)
#pragma unroll
                    for (int n = 0; n < 2; ++n) { const f32x4 bs = *(const f32x4*)(base + off + bj * HALF + n * 16); *(f32x4*)(out + off + bj * HALF + n * 16) = bs + gv[bj][n] * acc[ai][bj][m][n]; }
                asm volatile("" ::: "memory"); }
    }
};
struct EpiPartial {
    static constexpr bool PERM = false, AFTER_DRAIN = false;
    float* part; int pm0, nrows;
    __device__ __forceinline__ void operator()(const f32x4 (&acc)[2][2][4][2], const Unit& u, int wr, int wc, int fr, int fq) const {
        const int row0 = (u.pm - pm0) * BM + wr * 64 + fr, col0 = u.pn * BM + wc * 32 + 4 * fq;
        float* base = part + (size_t)(u.kofs / 512) * nrows * DM;
#pragma unroll
        for (int ai = 0; ai < 2; ++ai)
#pragma unroll
            for (int m = 0; m < 4; ++m) { float* rowp = base + (size_t)(row0 + ai * HALF + m * 16) * DM + col0;
#pragma unroll
                for (int bj = 0; bj < 2; ++bj)
#pragma unroll
                    for (int n = 0; n < 2; ++n) *(f32x4*)(rowp + bj * HALF + n * 16) = acc[ai][bj][m][n]; }
    }
};
struct EpiSwiglu {
    static constexpr bool PERM = true, AFTER_DRAIN = false;
    bf16_t* O;
    __device__ __forceinline__ void operator()(const f32x4 (&acc)[2][2][4][2], const Unit& u, int wr, int wc, int fr, int fq) const {
        const int row0 = u.pm * BM + wr * 64 + fr, col0 = u.pn * HALF + wc * 32 + 8 * fq;
#pragma unroll
        for (int ai = 0; ai < 2; ++ai)
#pragma unroll
            for (int m = 0; m < 4; ++m) { bf16_t* rowp = O + (size_t)(row0 + ai * HALF + m * 16) * DFF + col0;
                const f32x4 g0 = acc[ai][0][m][0], g1 = acc[ai][0][m][1], u0 = acc[ai][1][m][0], u1 = acc[ai][1][m][1];
                u32x4 w; w.x = cvt_pk_bf16(silu_fast(g0[0]) * u0[0], silu_fast(g0[1]) * u0[1]); w.y = cvt_pk_bf16(silu_fast(g0[2]) * u0[2], silu_fast(g0[3]) * u0[3]);
                w.z = cvt_pk_bf16(silu_fast(g1[0]) * u1[0], silu_fast(g1[1]) * u1[1]); w.w = cvt_pk_bf16(silu_fast(g1[2]) * u1[2], silu_fast(g1[3]) * u1[3]);
                *(u32x4*)rowp = w; }
    }
};
struct EpiSwiglu8 {
    static constexpr bool PERM = true, AFTER_DRAIN = false;
    unsigned char* O;
    __device__ __forceinline__ void operator()(const f32x4 (&acc)[2][2][4][2], const Unit& u, int wr, int wc, int fr, int fq) const {
        const int row0 = u.pm * BM + wr * 64 + fr, col0 = u.pn * HALF + wc * 32 + 8 * fq;
        constexpr float WI = 1.f / W8_SCALE;
#pragma unroll
        for (int ai = 0; ai < 2; ++ai)
#pragma unroll
            for (int m = 0; m < 4; ++m) { unsigned char* rowp = O + (size_t)(row0 + ai * HALF + m * 16) * DFF + col0;
                const f32x4 g0 = acc[ai][0][m][0] * WI, g1 = acc[ai][0][m][1] * WI, u0 = acc[ai][1][m][0] * (WI * A8_SCALE), u1 = acc[ai][1][m][1] * (WI * A8_SCALE);
                v2u w; w.x = pk4_fp8(silu_fast(g0[0]) * u0[0], silu_fast(g0[1]) * u0[1], silu_fast(g0[2]) * u0[2], silu_fast(g0[3]) * u0[3]);
                w.y = pk4_fp8(silu_fast(g1[0]) * u1[0], silu_fast(g1[1]) * u1[1], silu_fast(g1[2]) * u1[2], silu_fast(g1[3]) * u1[3]);
                *(v2u*)rowp = w; }
    }
};
struct EpiMoeDown {
    static constexpr bool PERM = true, AFTER_DRAIN = false;
    bf16_t* O; const float* rgate; float scale;
    __device__ __forceinline__ void operator()(const f32x4 (&acc)[2][2][4][2], const Unit& u, int wr, int wc, int fr, int fq) const {
        const int row0 = u.pm * BM + wr * 64 + fr, col0 = u.pn * BM + wc * 32 + 8 * fq;
#pragma unroll
        for (int ai = 0; ai < 2; ++ai)
#pragma unroll
            for (int m = 0; m < 4; ++m) { const int row = row0 + ai * HALF + m * 16; const float sc = rgate[row] * scale; bf16_t* rowp = O + (size_t)row * DM + col0;
#pragma unroll
                for (int bj = 0; bj < 2; ++bj) { const f32x4 v0 = acc[ai][bj][m][0] * sc, v1 = acc[ai][bj][m][1] * sc;
                    u32x4 w; w.x = cvt_pk_bf16(v0[0], v0[1]); w.y = cvt_pk_bf16(v0[2], v0[3]); w.z = cvt_pk_bf16(v1[0], v1[1]); w.w = cvt_pk_bf16(v1[2], v1[3]);
                    *(u32x4*)(rowp + bj * HALF) = w; } }
    }
};

template <class Epi, class Sched, bool ALIGN_EPI = false, bool SP2 = false, bool F8 = false>
__device__ __forceinline__ void gemm_phase(PG8_LAS unsigned char* lds, const Gemm g, const Sched& S, const Epi& E, const int wid  ) {
    const int lane = lane_id(), tid = wid * 64 + lane, wr = wid >> 2, wc = wid & 3, fr = lane & 15, fq = lane >> 4;
    const int K = g.ld, nt = g.K / BK;
    unsigned voffA[2], voffB[2];
#pragma unroll
    for (int i = 0; i < 2; ++i) { int R, C; stage_rc(tid * 16 + i * 8192, R, C); const int Rb = Epi::PERM ? ((R & ~31) + perm32(R & 31)) : R;
        voffA[i] = (unsigned)(R * K + C) * 2u; voffB[i] = (unsigned)(Rb * K + C) * 2u; }
    const size_t kstep = (size_t)(BK * 2);
    const size_t hstep = (size_t)HALF * K * 2;
    const size_t tstep = 2 * hstep;
    const unsigned ldsw = (unsigned)wid * 1024u;
    const int aoff = lds_byte(wr * 64 + fr, fq * 8), boff = lds_byte(wc * 32 + fr, fq * 8);
#define PG8_SA(b, h) (((b) * 2 + (h)) * HTB)
#define PG8_SB(b, h) ((4 + (b) * 2 + (h)) * HTB)
#define PG8_STAGE(bufoff, gbase, voff) do { _Pragma("unroll") for (int _i = 0; _i < 2; ++_i) \
        __builtin_amdgcn_global_load_lds((const unsigned*)((const char*)(gbase) + (voff)[_i]), (PG8_LAS unsigned*)(lds + (bufoff) + ldsw + _i * 8192), 16, 0, 0); } while (0)
#define PG8_LD8(addr) __builtin_shufflevector(*(const PG8_LAS i32x4*)(addr), *(const PG8_LAS i32x4*)((addr) + 1024), 0, 1, 2, 3, 4, 5, 6, 7)
#define PG8_LDA(dst, dst8, b, h) do { if constexpr (F8) { _Pragma("unroll") for (int m = 0; m < 4; ++m) dst8[m] = PG8_LD8(lds + PG8_SA(b, h) + aoff + m * 2048); } \
        else { _Pragma("unroll") for (int m = 0; m < 4; ++m) _Pragma("unroll") for (int k = 0; k < 2; ++k) dst[m][k] = *(const PG8_LAS bf16x8*)(lds + PG8_SA(b, h) + aoff + m * 2048 + k * 1024); } } while (0)
#define PG8_LDB(dst, dst8, b, h) do { if constexpr (F8) { _Pragma("unroll") for (int n = 0; n < 2; ++n) dst8[n] = PG8_LD8(lds + PG8_SB(b, h) + boff + n * 2048); } \
        else { _Pragma("unroll") for (int n = 0; n < 2; ++n) _Pragma("unroll") for (int k = 0; k < 2; ++k) dst[n][k] = *(const PG8_LAS bf16x8*)(lds + PG8_SB(b, h) + boff + n * 2048 + k * 1024); } } while (0)
#define PG8_MMA(ai, bj, At, At8, Bt, Bt8) do { __builtin_amdgcn_s_setprio(1); \
        if constexpr (F8) { _Pragma("unroll") for (int m = 0; m < 4; ++m) _Pragma("unroll") for (int n = 0; n < 2; ++n) \
            asm volatile("v_mfma_scale_f32_16x16x128_f8f6f4 %0, %1, %2, %0, %3, %3 op_sel_hi:[0,0,0]" : "+v"(acc[ai][bj][m][n]) : "v"(Bt8[n]), "v"(At8[m]), "v"(sc8_)); } \
        else { _Pragma("unroll") for (int m = 0; m < 4; ++m) _Pragma("unroll") for (int n = 0; n < 2; ++n) _Pragma("unroll") for (int k = 0; k < 2; ++k) \
            acc[ai][bj][m][n] = __builtin_amdgcn_mfma_f32_16x16x32_bf16(Bt[n][k], At[m][k], acc[ai][bj][m][n], 0, 0, 0); } \
        __builtin_amdgcn_s_setprio(0); } while (0)
#define PG8_WAIT_V(n) asm volatile("s_waitcnt vmcnt(" #n ")" ::: "memory")
#define PG8_WAIT_L(n) asm volatile("s_waitcnt lgkmcnt(" #n ")" ::: "memory")
#define PG8_BAR __builtin_amdgcn_s_barrier()
#define PG8_SCHED __builtin_amdgcn_sched_barrier(0)
#define PG8_SCHED8 do { if constexpr (F8) __builtin_amdgcn_sched_barrier(0); } while (0)
    Unit cur, nxt; int ui = 0;
    if (!S.next(0, cur)) return;
    constexpr float zero_ = 0.f;
    const int sc8_ = 0x7f7f7f7f;
    f32x4 acc[2][2][4][2];
#pragma unroll
    for (int a = 0; a < 2; ++a)
#pragma unroll
        for (int b = 0; b < 2; ++b)
#pragma unroll
            for (int m = 0; m < 4; ++m)
#pragma unroll
                for (int n = 0; n < 2; ++n) acc[a][b][m][n] = (f32x4){zero_, zero_, zero_, zero_};
    bf16x8 At[4][2], B0[2][2], B1[2][2];
    i32x8 At8[4], B08[2], B18[2];
    const char* cA = (const char*)g.A + cur.kofs + (size_t)cur.pm * tstep; const char* cB = (const char*)g.Bt + cur.bofs + cur.kofs + (size_t)cur.pn * tstep;
    S.a_ready(cur);
    if constexpr (SP2) {
        PG8_STAGE(PG8_SB(0, 0), cB, voffB); PG8_STAGE(PG8_SB(0, 1), cB + hstep, voffB); PG8_STAGE(PG8_SA(0, 0), cA, voffA); PG8_STAGE(PG8_SA(0, 1), cA + hstep, voffA);
        if (wr == 1) PG8_BAR;
        PG8_WAIT_V(2); PG8_BAR;
        PG8_STAGE(PG8_SB(1, 0), cB + kstep, voffB); PG8_STAGE(PG8_SA(1, 0), cA + kstep, voffA); PG8_STAGE(PG8_SB(1, 1), cB + hstep + kstep, voffB);
        PG8_WAIT_V(6); PG8_BAR;
    } else {
        PG8_STAGE(PG8_SB(0, 0), cB, voffB); PG8_STAGE(PG8_SA(0, 0), cA, voffA); PG8_STAGE(PG8_SB(0, 1), cB + hstep, voffB); PG8_STAGE(PG8_SA(0, 1), cA + hstep, voffA);
        if (wr == 1) PG8_BAR;
        PG8_WAIT_V(4); PG8_BAR;
        PG8_STAGE(PG8_SB(1, 0), cB + kstep, voffB); PG8_STAGE(PG8_SA(1, 0), cA + kstep, voffA); PG8_STAGE(PG8_SB(1, 1), cB + hstep + kstep, voffB);
        PG8_WAIT_V(6); PG8_BAR;
    }
    for (;;) {
        const bool has_next = S.next(ui + 1, nxt);
        const char* nA = has_next ? (const char*)g.A + nxt.kofs + (size_t)nxt.pm * tstep : cA; const char* nB = has_next ? (const char*)g.Bt + nxt.bofs + nxt.kofs + (size_t)nxt.pn * tstep : cB;
#pragma clang loop unroll(disable)
        for (int t = 0; t < nt; t += 2) {
            const bool last = (t == nt - 2);
            const char* a1 = cA + (size_t)(t + 1) * kstep;
            const char* a2 = last ? nA : cA + (size_t)(t + 2) * kstep; const char* b2 = last ? nB : cB + (size_t)(t + 2) * kstep;
            const char* a3 = a2 + kstep; const char* b3 = b2 + kstep;
            if (last && has_next) S.a_ready(nxt);
            if constexpr (SP2) {
            PG8_LDB(B0, B08, 0, 0); PG8_LDB(B1, B18, 0, 1); PG8_SCHED; PG8_LDA(At, At8, 0, 0); PG8_STAGE(PG8_SA(1, 1), a1 + hstep, voffA);
            PG8_WAIT_V(8); PG8_WAIT_L(0); PG8_BAR; PG8_SCHED8; PG8_MMA(0, 0, At, At8, B0, B08); PG8_MMA(0, 1, At, At8, B1, B18); PG8_SCHED8; PG8_BAR; PG8_SCHED;
            PG8_LDA(At, At8, 0, 1); PG8_STAGE(PG8_SB(0, 0), b2, voffB); PG8_STAGE(PG8_SB(0, 1), b2 + hstep, voffB); PG8_STAGE(PG8_SA(0, 0), a2, voffA);
            PG8_WAIT_V(8); PG8_WAIT_L(0); PG8_BAR; PG8_SCHED8; PG8_MMA(1, 0, At, At8, B0, B08); PG8_MMA(1, 1, At, At8, B1, B18); PG8_SCHED8; PG8_BAR; PG8_SCHED;
            PG8_LDB(B0, B08, 1, 0); PG8_LDB(B1, B18, 1, 1); PG8_SCHED; PG8_LDA(At, At8, 1, 0); PG8_STAGE(PG8_SA(0, 1), a2 + hstep, voffA);
            PG8_WAIT_V(8); PG8_WAIT_L(0); PG8_BAR; PG8_SCHED8; PG8_MMA(0, 0, At, At8, B0, B08); PG8_MMA(0, 1, At, At8, B1, B18); PG8_SCHED8; PG8_BAR; PG8_SCHED;
            PG8_LDA(At, At8, 1, 1); PG8_STAGE(PG8_SB(1, 0), b3, voffB); PG8_STAGE(PG8_SB(1, 1), b3 + hstep, voffB); PG8_STAGE(PG8_SA(1, 0), a3, voffA);
            PG8_WAIT_V(8); PG8_WAIT_L(0); PG8_BAR; PG8_SCHED8; PG8_MMA(1, 0, At, At8, B0, B08); PG8_MMA(1, 1, At, At8, B1, B18); PG8_SCHED8; PG8_BAR; PG8_SCHED;
            } else {
            PG8_LDB(B0, B08, 0, 0); PG8_SCHED; PG8_LDA(At, At8, 0, 0); PG8_STAGE(PG8_SA(1, 1), a1 + hstep, voffA);
            PG8_WAIT_L(8); PG8_BAR; PG8_WAIT_L(0); PG8_MMA(0, 0, At, At8, B0, B08); PG8_BAR; PG8_SCHED;
            PG8_LDB(B1, B18, 0, 1); PG8_STAGE(PG8_SB(0, 0), b2, voffB);
            PG8_BAR; PG8_WAIT_L(0); PG8_MMA(0, 1, At, At8, B1, B18); PG8_BAR;
            PG8_LDA(At, At8, 0, 1); PG8_STAGE(PG8_SA(0, 0), a2, voffA);
            PG8_BAR; PG8_WAIT_L(0); PG8_MMA(1, 0, At, At8, B0, B08); PG8_BAR; PG8_SCHED;
            PG8_STAGE(PG8_SB(0, 1), b2 + hstep, voffB);
            PG8_WAIT_V(6); PG8_BAR; PG8_MMA(1, 1, At, At8, B1, B18); PG8_BAR;
            PG8_LDB(B0, B08, 1, 0); PG8_SCHED; PG8_LDA(At, At8, 1, 0); PG8_STAGE(PG8_SA(0, 1), a2 + hstep, voffA);
            PG8_WAIT_L(8); PG8_BAR; PG8_WAIT_L(0); PG8_MMA(0, 0, At, At8, B0, B08); PG8_BAR; PG8_SCHED;
            PG8_LDB(B1, B18, 1, 1); PG8_STAGE(PG8_SB(1, 0), b3, voffB);
            PG8_BAR; PG8_WAIT_L(0); PG8_MMA(0, 1, At, At8, B1, B18); PG8_BAR;
            PG8_LDA(At, At8, 1, 1); PG8_STAGE(PG8_SA(1, 0), a3, voffA);
            PG8_BAR; PG8_WAIT_L(0); PG8_MMA(1, 0, At, At8, B0, B08); PG8_BAR; PG8_SCHED;
            PG8_STAGE(PG8_SB(1, 1), b3 + hstep, voffB);
            PG8_WAIT_V(6); PG8_BAR; PG8_MMA(1, 1, At, At8, B1, B18); PG8_BAR;
            }
        }
        if constexpr (ALIGN_EPI) { if (wr == 0) PG8_BAR; }
        if constexpr (F8) asm volatile("s_nop 15\n\ts_nop 15" ::: "memory");
        if constexpr (!Epi::AFTER_DRAIN) { E(acc, cur, wr, wc, fr, fq); S.done(cur); }
        if (!has_next) break;
#pragma unroll
        for (int a = 0; a < 2; ++a)
#pragma unroll
            for (int b = 0; b < 2; ++b)
#pragma unroll
                for (int m = 0; m < 4; ++m)
#pragma unroll
                    for (int n = 0; n < 2; ++n) acc[a][b][m][n] = (f32x4){zero_, zero_, zero_, zero_};
        cur = nxt; cA = nA; cB = nB; ++ui;
        if constexpr (ALIGN_EPI) { if (wr == 1) PG8_BAR; }
    }
    PG8_WAIT_V(0);
    if constexpr (!ALIGN_EPI) { if (wr == 0) PG8_BAR; }
    PG8_BAR;
    if constexpr (Epi::AFTER_DRAIN) { E.fused(acc, cur, wr, wc, fr, fq, lds, wid, lane); S.done(cur); }
#undef PG8_SA
#undef PG8_SB
#undef PG8_STAGE
#undef PG8_LDA
#undef PG8_LDB
#undef PG8_MMA
#undef PG8_LD8
#undef PG8_WAIT_V
#undef PG8_WAIT_L
#undef PG8_BAR
#undef PG8_SCHED
#undef PG8_SCHED8
}

}

#define GAS __attribute__((address_space(1)))
#define LAS __attribute__((address_space(3)))
typedef unsigned v4u __attribute__((ext_vector_type(4)));
typedef float f32x4 __attribute__((ext_vector_type(4)));
#define LDS_WAIT() asm volatile("s_waitcnt lgkmcnt(0)" ::: "memory")
#define VM_WAIT() asm volatile("s_waitcnt vmcnt(0)" ::: "memory")

#define XB_TMO      128
#define XB_XCNT(j)  (256  + 64 * (j))
#define XB_XSUB(j)  (1280 + 64 * (j))
#define XB_XGEN(j)  (2304 + 64 * (j))
#define XB_TOP      3328
#define XB_TOPGEN   3392
#define XCD_BAR_WORDS 3456
#define XB_SPIN_CAP (1u << 18)

__device__ __forceinline__ unsigned xb_ld(unsigned* p)              { return __hip_atomic_load(p, __ATOMIC_RELAXED, __HIP_MEMORY_SCOPE_AGENT); }
__device__ __forceinline__ unsigned xb_add(unsigned* p, unsigned v) { return __hip_atomic_fetch_add(p, v, __ATOMIC_RELAXED, __HIP_MEMORY_SCOPE_AGENT); }
__device__ __forceinline__ unsigned xb_xcc_id() { return (unsigned)__builtin_amdgcn_s_getreg((3 << 11) | 20) & 0xFu; }
#define XB_SPIN(cond, bar) do { unsigned _sp = 0; while (cond) { __builtin_amdgcn_s_sleep(1); \
    if ((++_sp & 255u) == 0u) { if (xb_ld(&(bar)[XB_TMO])) break; if (_sp > XB_SPIN_CAP) { atomicAdd(&(bar)[XB_TMO], 1u); break; } } } } while (0)

struct XcdBarrier {
    unsigned* bar; unsigned x;
    volatile LAS unsigned* st;
};

__device__ __forceinline__ XcdBarrier xcd_barrier_post(unsigned* bar, volatile LAS unsigned* st, bool t0) {
    XcdBarrier b; b.bar = bar; b.x = xb_xcc_id(); b.st = st;
    if (t0) (void)xb_add(&bar[XB_XCNT(b.x)], 1u);
    return b;
}
__device__ __forceinline__ void xcd_barrier_complete(unsigned* bar, unsigned x, unsigned& nloc, unsigned& nx) {
    const unsigned G = gridDim.x * gridDim.y * gridDim.z;
    unsigned sum, cnt, mine, sp = 0u;
    for (;;) {
        sum = 0u; cnt = 0u; mine = 0u;
#pragma unroll
        for (unsigned j = 0; j < 16; ++j) { const unsigned c = xb_ld(&bar[XB_XCNT(j)]); sum += c; cnt += (c > 0u) ? 1u : 0u; mine = (j == x) ? c : mine; }
        if (sum == G) break;
        __builtin_amdgcn_s_sleep(1);
        if ((++sp & 255u) == 0u) { if (xb_ld(&bar[XB_TMO])) break; if (sp > XB_SPIN_CAP) { atomicAdd(&bar[XB_TMO], 1u); break; } }
    }
    nloc = mine > 0u ? mine : 1u; nx = cnt > 0u ? cnt : 1u;
}

__device__ __forceinline__ void xcd_barrier(const XcdBarrier& b, bool t0) {
    asm volatile("s_waitcnt vmcnt(0)" ::: "memory");
    __syncthreads();
    if (t0) {
        unsigned* bar = b.bar;
        __builtin_amdgcn_s_waitcnt(0);
        unsigned nloc = b.st[0], nx = b.st[1];
        if (nloc == 0u) { xcd_barrier_complete(bar, b.x, nloc, nx); b.st[0] = nloc; b.st[1] = nx; }
        const unsigned old = xb_add(&bar[XB_XSUB(b.x)], 1u);
        const unsigned gen = old / nloc;
        if (old + 1u == (gen + 1u) * nloc) {
            __builtin_amdgcn_fence(__ATOMIC_RELEASE, "agent");
            asm volatile("s_waitcnt vmcnt(0)" ::: "memory");
            const unsigned og = xb_add(&bar[XB_TOP], 1u);
            const unsigned tg = og / nx;
            if (og + 1u == (tg + 1u) * nx) xb_add(&bar[XB_TOPGEN], 1u);
            else XB_SPIN(xb_ld(&bar[XB_TOPGEN]) == tg, bar);
            __builtin_amdgcn_fence(__ATOMIC_ACQUIRE, "agent");
            xb_add(&bar[XB_XGEN(b.x)], 1u);
            asm volatile("s_waitcnt vmcnt(0)" ::: "memory");
        } else {
            XB_SPIN(xb_ld(&bar[XB_XGEN(b.x)]) == gen, bar);
            __builtin_amdgcn_fence(__ATOMIC_ACQUIRE, "agent");
            asm volatile("s_waitcnt vmcnt(0)" ::: "memory");
        }
    }
    __syncthreads();
}

constexpr int RING_OFF = 0, RING_BYTES = 131072;
constexpr int MISC_OFF = 143360;
constexpr int LDS_BYTES = 147456;
constexpr int NWAVES = 8;

struct Ctx { LAS unsigned char* lds; volatile LAS unsigned* MISC; unsigned* ctl; int wave, G, gw, NGW; };

__device__ __forceinline__ void cvt_item(const float* W, int K, int N, bf16_t* WT, int mode, LAS float* scr, int item, int lane) {
    const int kblk = K / 64, nb = item / kblk, kb = item % kblk, k0 = 64 * kb, n0 = 64 * nb;
    f32x4 ld[16];
#pragma unroll
    for (int i = 0; i < 16; ++i) { const int kk = 4 * i + (lane >> 4), c4 = 4 * (lane & 15); ld[i] = __builtin_nontemporal_load((const f32x4*)(W + (size_t)(k0 + kk) * N + n0 + c4));     }
#pragma unroll
    for (int i = 0; i < 16; ++i) { const int kk = 4 * i + (lane >> 4), c4 = 4 * (lane & 15);
        LAS float* s = scr + kk * 65 + c4; s[0] = ld[i][0]; s[1] = ld[i][1]; s[2] = ld[i][2]; s[3] = ld[i][3]; }
    LDS_WAIT(); asm volatile("" ::: "memory");
    const int c = lane >> 3;
#pragma unroll
    for (int j = 0; j < 8; ++j) { const int n = (lane & 7) + 8 * j; const LAS float* s = scr + (8 * c) * 65 + n;
        v4u o; o.x = pk2(s[0 * 65], s[1 * 65]); o.y = pk2(s[2 * 65], s[3 * 65]); o.z = pk2(s[4 * 65], s[5 * 65]); o.w = pk2(s[6 * 65], s[7 * 65]);
        const int nn = n0 + n; const int drow = mode == 0 ? nn : (nn / 128) * 256 + (mode - 1) * 128 + (nn % 128);
        *(v4u*)(WT + (size_t)drow * K + k0 + 8 * c) = o; }
    LDS_WAIT(); asm volatile("" ::: "memory");
}
__device__ __forceinline__ void cvt_item8(const float* W, int K, int N, unsigned char* WT, int mode, LAS float* scr, int item, int lane) {
    const int kblk = K / 64, nb = item / kblk, kb = item % kblk, k0 = 64 * kb, n0 = 64 * nb;
    f32x4 ld[16];
#pragma unroll
    for (int i = 0; i < 16; ++i) { const int kk = 4 * i + (lane >> 4), c4 = 4 * (lane & 15); ld[i] = __builtin_nontemporal_load((const f32x4*)(W + (size_t)(k0 + kk) * N + n0 + c4));     }
#pragma unroll
    for (int i = 0; i < 16; ++i) { const int kk = 4 * i + (lane >> 4), c4 = 4 * (lane & 15);
        LAS float* s = scr + kk * 65 + c4; s[0] = ld[i][0]; s[1] = ld[i][1]; s[2] = ld[i][2]; s[3] = ld[i][3]; }
    LDS_WAIT(); asm volatile("" ::: "memory");
    const int c = lane >> 3;
#pragma unroll
    for (int j = 0; j < 8; ++j) { const int n = (lane & 7) + 8 * j; const LAS float* s = scr + (8 * c) * 65 + n;
        v2u o; o.x = pk4_fp8(s[0 * 65] * W8_SCALE, s[1 * 65] * W8_SCALE, s[2 * 65] * W8_SCALE, s[3 * 65] * W8_SCALE); o.y = pk4_fp8(s[4 * 65] * W8_SCALE, s[5 * 65] * W8_SCALE, s[6 * 65] * W8_SCALE, s[7 * 65] * W8_SCALE);
        const int nn = n0 + n; const int drow = mode == 0 ? nn : (nn / 128) * 256 + (mode - 1) * 128 + (nn % 128);
        *(v2u*)(WT + (size_t)drow * K + k0 + 8 * c) = o; }
    LDS_WAIT(); asm volatile("" ::: "memory");
}
__device__ __forceinline__ void p0_prologue(const Params& p, Ctx& F) {
    const int lane_ = lane_id(), tid_ = F.wave * 64 + lane_;
    LAS float* fl = (LAS float*)(F.lds + RING_OFF);
    for (int it = blockIdx.x; it < 192; it += F.G) {
        const int l = it / 96, n = (it % 96) * 64 + lane_;
        LAS float* sv = fl;
        LAS float* red = fl + 3 * 1024;
        for (int i = tid_; i < 3 * 1024; i += 512) { const int rt = i >> 10, k = i & 1023; const float v = rt < 2 ? p.in[I_C][rt * DM + k] : p.in[I_CCTX][k]; sv[i] = siluf(v); }
        __syncthreads();
        const float* W = p.in[I_ADAW] + (size_t)l * DM * 6144 + n;
        float a0 = 0.f, a1 = 0.f, a2 = 0.f;
        for (int kb = 0; kb < 128; kb += 32) {
            float wv[32];
#pragma unroll
            for (int j = 0; j < 32; ++j) wv[j] = W[(size_t)(F.wave * 128 + kb + j) * 6144];
#pragma unroll
            for (int j = 0; j < 32; ++j) { const int k = F.wave * 128 + kb + j; a0 += sv[k] * wv[j]; a1 += sv[1024 + k] * wv[j]; a2 += sv[2048 + k] * wv[j]; }
        }
        red[(F.wave * 3 + 0) * 64 + lane_] = a0; red[(F.wave * 3 + 1) * 64 + lane_] = a1; red[(F.wave * 3 + 2) * 64 + lane_] = a2;
        __syncthreads();
        if (tid_ < 192) { const int rt = tid_ >> 6, ln = tid_ & 63; float s = 0.f;
#pragma unroll
            for (int w = 0; w < 8; ++w) s += red[(w * 3 + rt) * 64 + ln];
            const int nn = (it % 96) * 64 + ln;
            ((float*)(p.ws + WS_MODV))[(size_t)(l * 3 + rt) * 6144 + nn] = s + p.in[I_ADAB][l * 6144 + nn]; }
        __syncthreads();
    }
    LAS float* scr = (LAS float*)(F.lds + RING_OFF) + F.wave * (64 * 65);
    constexpr int S_WIN = 16 * 56, S_WOUT = 16 * 16, S_F = 16 * 44;
    constexpr int NITEMS = 2 * S_WIN + 2 * S_WOUT + 3 * S_F + 24 * S_F;
    static_assert(NITEMS == 21312, "items");
    for (int it = F.gw; it < NITEMS; it += F.NGW) {
        int r = it;
        if (r < 2 * S_WIN) { const int l = r / S_WIN; cvt_item(p.in[I_WIN] + (size_t)l * DM * DP, DM, DP, (bf16_t*)(p.ws + W_WIN) + (size_t)l * DP * DM, 0, scr, r % S_WIN, lane_); continue; } r -= 2 * S_WIN;
        if (r < 2 * S_WOUT) { const int l = r / S_WOUT; cvt_item(p.in[I_WOUT] + (size_t)l * DM * DM, DM, DM, (bf16_t*)(p.ws + W_WOUT) + (size_t)l * DM * DM, 0, scr, r % S_WOUT, lane_); continue; } r -= 2 * S_WOUT;
        if (r < S_F) { cvt_item(p.in[I_FWG], DM, DFF, (bf16_t*)(p.ws + W_FGU), 1, scr, r, lane_); continue; } r -= S_F;
        if (r < S_F) { cvt_item(p.in[I_FWU], DM, DFF, (bf16_t*)(p.ws + W_FGU), 2, scr, r, lane_); continue; } r -= S_F;
        if (r < S_F) { cvt_item(p.in[I_FWD], DFF, DM, (bf16_t*)(p.ws + W_FD), 0, scr, r, lane_); continue; } r -= S_F;
        if (r < 8 * S_F) { const int e = r / S_F; cvt_item8(p.in[I_MWG] + (size_t)e * DM * DFF, DM, DFF, (unsigned char*)(p.ws + W_MGU) + (size_t)e * 2 * DFF * DM, 1, scr, r % S_F, lane_); continue; } r -= 8 * S_F;
        if (r < 8 * S_F) { const int e = r / S_F; cvt_item8(p.in[I_MWU] + (size_t)e * DM * DFF, DM, DFF, (unsigned char*)(p.ws + W_MGU) + (size_t)e * 2 * DFF * DM, 2, scr, r % S_F, lane_); continue; } r -= 8 * S_F;
        { const int e = r / S_F; cvt_item8(p.in[I_MWD] + (size_t)e * DFF * DM, DFF, DM, (unsigned char*)(p.ws + W_MD) + (size_t)e * DM * DFF, 0, scr, r % S_F, lane_); }
    }
}

__device__ __forceinline__ void norm_phase(const Params& p, Ctx& F, int l, int which, int nrows) {
    const int lane_ = lane_id(), tid_ = F.wave * 64 + lane_;
    const float* g = p.in[which ? I_N2G : I_N1G] + l * DM;
    for (int m = F.gw; m < nrows; m += F.NGW) {
        const float* xrow;
        if (l == 0 && which == 0) xrow = m < NL ? p.in[I_X] + (size_t)m * DM : p.in[I_CTX] + (size_t)(m - NL) * DM;
        else xrow = xr_row(p, m);
        const int rt = rowtype(m);
        const float* sh = modv(p, l, rt, which ? 3 : 0); const float* sc = modv(p, l, rt, which ? 4 : 1);
        f32x4 v[4]; float ss = 0.f;
        if (m >= NL && !(l == 0 && which == 0)) {
            const int nsl = which ? DM / 256 : DFF / 256; const float* gate = modv(p, 0, 2, which ? 2 : 5);
            const float* base = (l == 0) ? p.in[I_CTX] + (size_t)(m - NL) * DM : xrow;
            const float* part = (const float*)(p.ws + WS_PART) + (size_t)(m - NL) * DM;
#pragma unroll
            for (int j = 0; j < 4; ++j) { const int col = 256 * j + 4 * lane_; f32x4 a = {0.f, 0.f, 0.f, 0.f};
                for (int sl = 0; sl < nsl; ++sl) a += *(const f32x4*)(part + (size_t)sl * NC * DM + col);
                v[j] = *(const f32x4*)(base + col) + *(const f32x4*)(gate + col) * a;
                *(f32x4*)((float*)(p.ws + WS_XRC) + (size_t)(m - NL) * DM + col) = v[j];
                ss += (v[j][0] * v[j][0] + v[j][1] * v[j][1]) + (v[j][2] * v[j][2] + v[j][3] * v[j][3]); }
        } else
#pragma unroll
        for (int j = 0; j < 4; ++j) { v[j] = *(const f32x4*)(xrow + 256 * j + 4 * lane_); ss += (v[j][0] * v[j][0] + v[j][1] * v[j][1]) + (v[j][2] * v[j][2] + v[j][3] * v[j][3]); }
        const float r = rsqrtf(wave_sum(ss) * (1.f / DM) + EPS);
        bf16_t* hb = (bf16_t*)(p.ws + WS_HBUF) + (size_t)m * DM;
#pragma unroll
        for (int j = 0; j < 4; ++j) { const int col = 256 * j + 4 * lane_;
            const f32x4 gg = *(const f32x4*)(g + col), s4 = *(const f32x4*)(sc + col), h4 = *(const f32x4*)(sh + col);
            const f32x4 y = v[j] * r * gg * (1.f + s4) + h4;
            v2u o; o.x = pk2(y[0], y[1]); o.y = pk2(y[2], y[3]); *(v2u*)(hb + col) = o; }
    }
}


__device__ __forceinline__ void router_phase(const Params& p, Ctx& F) {
    const int lane_ = lane_id(), tid_ = F.wave * 64 + lane_;
    LAS int* lcnt = (LAS int*)(F.lds + RING_OFF);
    LAS int* gbase = lcnt + 8;
    LAS int* ent_e = lcnt + 16;
    LAS int* ent_pos = lcnt + 16 + 128;
    const float* g = p.in[I_N2G] + DM; const float* rw = p.in[I_RW];
    int* tok_e = (int*)(p.ws + WS_ROUTE); float* tok_w = (float*)(p.ws + WS_ROUTE) + 2 * NL; int* tok_pos = (int*)(p.ws + WS_ROUTE) + 4 * NL;
    f32x4 rwa[4][4], rwb[4][4];
#pragma unroll
    for (int j = 0; j < 4; ++j)
#pragma unroll
        for (int q = 0; q < 4; ++q) { const int col = 256 * j + 4 * lane_ + q; rwa[j][q] = *(const f32x4*)(rw + (size_t)col * 8); rwb[j][q] = *(const f32x4*)(rw + (size_t)col * 8 + 4); }
    const int myexp = ((lane_ >> 5) & 1) * 4 + ((lane_ >> 4) & 1) * 2 + ((lane_ >> 3) & 1);
    for (int ch = blockIdx.x; ch < NL / 64; ch += F.G) {
        if (tid_ < 8) lcnt[tid_] = 0;
        __syncthreads();
        const int rt = (ch * 64) / T;
        const float* sh = modv(p, 1, rt, 3); const float* sc = modv(p, 1, rt, 4);
        f32x4 gs[4], hs[4]; float bsum;
        { float bb[8] = {0.f, 0.f, 0.f, 0.f, 0.f, 0.f, 0.f, 0.f};
#pragma unroll
          for (int j = 0; j < 4; ++j) { const int col = 256 * j + 4 * lane_; gs[j] = *(const f32x4*)(g + col) * (1.f + *(const f32x4*)(sc + col)); hs[j] = *(const f32x4*)(sh + col);
#pragma unroll
            for (int q = 0; q < 4; ++q) { bb[0] += hs[j][q] * rwa[j][q][0]; bb[1] += hs[j][q] * rwa[j][q][1]; bb[2] += hs[j][q] * rwa[j][q][2]; bb[3] += hs[j][q] * rwa[j][q][3];
                                          bb[4] += hs[j][q] * rwb[j][q][0]; bb[5] += hs[j][q] * rwb[j][q][1]; bb[6] += hs[j][q] * rwb[j][q][2]; bb[7] += hs[j][q] * rwb[j][q][3]; } }
          float c4[4];
#pragma unroll
          for (int k = 0; k < 4; ++k) { const float keep = (lane_ & 32) ? bb[k + 4] : bb[k], give = (lane_ & 32) ? bb[k] : bb[k + 4]; c4[k] = keep + __shfl_xor(give, 32); }
          float c2[2];
#pragma unroll
          for (int k = 0; k < 2; ++k) { const float keep = (lane_ & 16) ? c4[k + 2] : c4[k], give = (lane_ & 16) ? c4[k] : c4[k + 2]; c2[k] = keep + __shfl_xor(give, 16); }
          float c1 = ((lane_ & 8) ? c2[1] : c2[0]) + __shfl_xor((lane_ & 8) ? c2[0] : c2[1], 8);
          c1 += __shfl_xor(c1, 4); c1 += __shfl_xor(c1, 2); c1 += __shfl_xor(c1, 1);
          bsum = c1 + p.in[I_RB][myexp]; }
        for (int i = 0; i < 8; ++i) {
            const int ti = F.wave * 8 + i, m = ch * 64 + ti;
            const float* xrow = p.out + (size_t)m * DM;
            f32x4 v[4]; float ss = 0.f; float aa[8] = {0.f, 0.f, 0.f, 0.f, 0.f, 0.f, 0.f, 0.f};
#pragma unroll
            for (int j = 0; j < 4; ++j) { v[j] = *(const f32x4*)(xrow + 256 * j + 4 * lane_); ss += (v[j][0] * v[j][0] + v[j][1] * v[j][1]) + (v[j][2] * v[j][2] + v[j][3] * v[j][3]); }
#pragma unroll
            for (int j = 0; j < 4; ++j) { v[j] = v[j] * gs[j];
#pragma unroll
                for (int q = 0; q < 4; ++q) { aa[0] += v[j][q] * rwa[j][q][0]; aa[1] += v[j][q] * rwa[j][q][1]; aa[2] += v[j][q] * rwa[j][q][2]; aa[3] += v[j][q] * rwa[j][q][3];
                                              aa[4] += v[j][q] * rwb[j][q][0]; aa[5] += v[j][q] * rwb[j][q][1]; aa[6] += v[j][q] * rwb[j][q][2]; aa[7] += v[j][q] * rwb[j][q][3]; } }
            float c4[4];
#pragma unroll
            for (int k = 0; k < 4; ++k) { const float keep = (lane_ & 32) ? aa[k + 4] : aa[k], give = (lane_ & 32) ? aa[k] : aa[k + 4]; c4[k] = keep + __shfl_xor(give, 32); }
            float c2[2];
#pragma unroll
            for (int k = 0; k < 2; ++k) { const float keep = (lane_ & 16) ? c4[k + 2] : c4[k], give = (lane_ & 16) ? c4[k] : c4[k + 2]; c2[k] = keep + __shfl_xor(give, 16); }
            float c1 = ((lane_ & 8) ? c2[1] : c2[0]) + __shfl_xor((lane_ & 8) ? c2[0] : c2[1], 8);
            c1 += __shfl_xor(c1, 4); c1 += __shfl_xor(c1, 2); c1 += __shfl_xor(c1, 1);
            const float r = rsqrtf(wave_sum(ss) * (1.f / DM) + EPS);
            const float mylogit = r * c1 + bsum;
#define RLF(L) __uint_as_float((unsigned)__builtin_amdgcn_readlane((int)__float_as_uint(mylogit), L))
            const float lg0 = RLF(0), lg1 = RLF(8), lg2 = RLF(16), lg3 = RLF(24), lg4 = RLF(32), lg5 = RLF(40), lg6 = RLF(48), lg7 = RLF(56);
#undef RLF
            unsigned char* hb = (unsigned char*)(p.ws + WS_HBUF) + (size_t)m * DM;
#pragma unroll
            for (int j = 0; j < 4; ++j) { const f32x4 y = v[j] * r + hs[j]; *(unsigned*)(hb + 256 * j + 4 * lane_) = pk4_fp8(y[0], y[1], y[2], y[3]); }
            int i1 = 0; float v1 = lg0;
            if (lg1 > v1) { v1 = lg1; i1 = 1; } if (lg2 > v1) { v1 = lg2; i1 = 2; } if (lg3 > v1) { v1 = lg3; i1 = 3; }
            if (lg4 > v1) { v1 = lg4; i1 = 4; } if (lg5 > v1) { v1 = lg5; i1 = 5; } if (lg6 > v1) { v1 = lg6; i1 = 6; } if (lg7 > v1) { v1 = lg7; i1 = 7; }
            int i2 = -1; float v2 = -3.4e38f;
            if (i1 != 0 && lg0 > v2) { v2 = lg0; i2 = 0; } if (i1 != 1 && lg1 > v2) { v2 = lg1; i2 = 1; } if (i1 != 2 && lg2 > v2) { v2 = lg2; i2 = 2; } if (i1 != 3 && lg3 > v2) { v2 = lg3; i2 = 3; }
            if (i1 != 4 && lg4 > v2) { v2 = lg4; i2 = 4; } if (i1 != 5 && lg5 > v2) { v2 = lg5; i2 = 5; } if (i1 != 6 && lg6 > v2) { v2 = lg6; i2 = 6; } if (i1 != 7 && lg7 > v2) { v2 = lg7; i2 = 7; }
            const float w1 = 1.f / (1.f + __expf(v2 - v1));
            if (lane_ == 0) {
                const int p1 = __hip_atomic_fetch_add(lcnt + i1, 1, __ATOMIC_RELAXED, __HIP_MEMORY_SCOPE_WORKGROUP);
                const int p2 = __hip_atomic_fetch_add(lcnt + i2, 1, __ATOMIC_RELAXED, __HIP_MEMORY_SCOPE_WORKGROUP);
                ent_e[2 * ti] = i1; ent_e[2 * ti + 1] = i2; ent_pos[2 * ti] = p1; ent_pos[2 * ti + 1] = p2;
                tok_e[2 * m] = i1; tok_e[2 * m + 1] = i2; tok_w[2 * m] = w1; tok_w[2 * m + 1] = 1.f - w1; }
        }
        __syncthreads();
        if (tid_ < 8) gbase[tid_] = (int)__hip_atomic_fetch_add(F.ctl + CW_CNT + 64 * tid_, (unsigned)lcnt[tid_], __ATOMIC_RELAXED, __HIP_MEMORY_SCOPE_AGENT);
        __syncthreads();
        if (tid_ < 128) tok_pos[ch * 128 + tid_] = gbase[ent_e[tid_]] + ent_pos[tid_];
        __syncthreads();
    }
}
__device__ __forceinline__ void moe_table(Ctx& F) {
    const int lane_ = lane_id(), tid_ = F.wave * 64 + lane_;
    volatile LAS unsigned* tb = F.MISC + 32;
    if (tid_ == 0) { unsigned acc = 0;
        for (int e = 0; e < 8; ++e) { const unsigned c = __hip_atomic_load(F.ctl + CW_CNT + 64 * e, __ATOMIC_RELAXED, __HIP_MEMORY_SCOPE_AGENT); tb[e] = acc; tb[16 + e] = c; acc += (c + 255u) / 256u * 256u; }
        tb[8] = acc; }
    __syncthreads();
}
__device__ __forceinline__ void moe_order(Ctx& F, pg8::Order& S, int nN, long estride) {
    volatile LAS unsigned* tb = F.MISC + 32;
#define RFL(x) __builtin_amdgcn_readfirstlane((int)(x))
    S.init(RFL(tb[8] / 256u), nN, F.G, (int)blockIdx.x);
    S.e1 = RFL(tb[1] / 256u); S.e2 = RFL(tb[2] / 256u); S.e3 = RFL(tb[3] / 256u); S.e4 = RFL(tb[4] / 256u); S.e5 = RFL(tb[5] / 256u); S.e6 = RFL(tb[6] / 256u); S.e7 = RFL(tb[7] / 256u);
#undef RFL
    S.estride = estride;
}
__device__ __forceinline__ void gather_phase(const Params& p, Ctx& F) {
    const int lane_ = lane_id(), tid_ = F.wave * 64 + lane_;
    moe_table(F);
    volatile LAS unsigned* tb = F.MISC + 32;
    const int* tok_e = (const int*)(p.ws + WS_ROUTE); const float* tok_w = (const float*)(p.ws + WS_ROUTE) + 2 * NL; const int* tok_pos = (const int*)(p.ws + WS_ROUTE) + 4 * NL;
    int* row_tok = (int*)(p.ws + WS_ROUTE) + 6 * NL; float* row_gate = (float*)(p.ws + WS_ROUTE) + 6 * NL + MP_MAX;
    const unsigned char* hb = (const unsigned char*)(p.ws + WS_HBUF); unsigned char* h2s = (unsigned char*)(p.ws + WS_H2S);
    for (int it = F.gw; it < 2 * NL; it += F.NGW) {
        const int t = it >> 1, e = tok_e[it], r = (int)tb[e] + tok_pos[it];
        *((v4u*)(h2s + (size_t)r * DM) + lane_) = *((const v4u*)(hb + (size_t)t * DM) + lane_);
        if (lane_ == 0) { row_tok[r] = t; row_gate[r] = tok_w[it]; }
    }
    for (int i = F.gw; i < NE * 256; i += F.NGW) {
        const int e = i >> 8, j = i & 255, r = (int)tb[e] + (int)tb[16 + e] + j;
        if (r < (int)tb[e + 1]) { const v4u z = {0u, 0u, 0u, 0u}; *((v4u*)(h2s + (size_t)r * DM) + lane_) = z; if (lane_ == 0) { row_tok[r] = -1; row_gate[r] = 0.f; } }
    }
}
__device__ __forceinline__ void combine_phase(const Params& p, Ctx& F) {
    const int lane_ = lane_id(), tid_ = F.wave * 64 + lane_;
    moe_table(F);
    volatile LAS unsigned* tb = F.MISC + 32;
    const int* tok_e = (const int*)(p.ws + WS_ROUTE); const int* tok_pos = (const int*)(p.ws + WS_ROUTE) + 4 * NL;
    const bf16_t* yb = (const bf16_t*)(p.ws + WS_YBUF);
    for (int t = F.gw; t < NL; t += F.NGW) {
        const int r0 = (int)tb[tok_e[2 * t]] + tok_pos[2 * t], r1 = (int)tb[tok_e[2 * t + 1]] + tok_pos[2 * t + 1];
        const float* g5 = modv(p, 1, t / T, 5);
        float* orow = p.out + (size_t)t * DM;
#pragma unroll
        for (int j = 0; j < 4; ++j) { const int col = 256 * j + 4 * lane_;
            const v2u a = *(const v2u*)(yb + (size_t)r0 * DM + col), b = *(const v2u*)(yb + (size_t)r1 * DM + col);
            f32x4 y; y[0] = __uint_as_float(a.x << 16) + __uint_as_float(b.x << 16); y[1] = __uint_as_float(a.x & 0xffff0000u) + __uint_as_float(b.x & 0xffff0000u);
            y[2] = __uint_as_float(a.y << 16) + __uint_as_float(b.y << 16); y[3] = __uint_as_float(a.y & 0xffff0000u) + __uint_as_float(b.y & 0xffff0000u);
            const f32x4 x = *(const f32x4*)(orow + col), gg = *(const f32x4*)(g5 + col);
            *(f32x4*)(orow + col) = x + gg * y; }
    }
}

namespace att {
constexpr float THR = 8.f;
constexpr int KVBLK = 64;
constexpr int SHM_V = KVBLK * 128 * 2, SHM_K = KVBLK * 128 * 2;
using bf16x8 = __attribute__((ext_vector_type(8))) short;
using s16x4  = __attribute__((ext_vector_type(4))) short;
using f32x16 = __attribute__((ext_vector_type(16))) float;
using f32x8  = __attribute__((ext_vector_type(8))) float;
using u32x4  = __attribute__((ext_vector_type(4))) unsigned;
using f32x4v = __attribute__((ext_vector_type(4))) float;
#define KSWZ(row, colB) ((row) * 256 + ((colB) ^ (((row) & 7) << 4)))
#define SBAR() __builtin_amdgcn_sched_barrier(0)
__device__ __forceinline__ int crow(int r, int hi) { return (r & 3) + 8 * (r >> 2) + 4 * hi; }
__device__ __forceinline__ unsigned cvtpk(float lo, float hi) {
  unsigned r; asm volatile("v_cvt_pk_bf16_f32 %0, %1, %2" : "=v"(r) : "v"(lo), "v"(hi)); return r;
}
__device__ __forceinline__ void partialSM(f32x16& p0, f32x16& p1, float& m_reg, float& mn, float& alpha) {
  constexpr float C = 1.4426950408889634f;
  float pmax = p0[0]; for (int r = 1; r < 16; ++r) pmax = fmaxf(pmax, p0[r]); for (int r = 0; r < 16; ++r) pmax = fmaxf(pmax, p1[r]);
  { auto rr = __builtin_amdgcn_permlane32_swap(__float_as_uint(pmax), __float_as_uint(pmax), false, false);
    pmax = fmaxf(__uint_as_float(rr[0]), __uint_as_float(rr[1])); }
  if (__builtin_expect(__all(pmax - m_reg <= THR), 1)) { mn = m_reg; alpha = 1.f; }
  else { mn = fmaxf(m_reg, pmax); alpha = __builtin_amdgcn_exp2f((m_reg - mn) * C); m_reg = mn; }
  float mnC = -mn * C;
  for (int r = 0; r < 16; ++r) p0[r] = fmaf(p0[r], C, mnC); for (int r = 0; r < 16; ++r) p1[r] = fmaf(p1[r], C, mnC);
  for (int r = 0; r < 16; ++r) p0[r] = __builtin_amdgcn_exp2f(p0[r]);
}
__device__ __forceinline__ void finishSM(f32x16& p0, f32x16& p1, float alpha, float& l_reg, bf16x8& pa0, bf16x8& pa1, bf16x8& pa2, bf16x8& pa3) {
  for (int r = 0; r < 16; ++r) p1[r] = __builtin_amdgcn_exp2f(p1[r]);
  float ps = 0; for (int r = 0; r < 16; ++r) ps += p0[r]; for (int r = 0; r < 16; ++r) ps += p1[r];
  { auto rr = __builtin_amdgcn_permlane32_swap(__float_as_uint(ps), __float_as_uint(ps), false, false);
    ps = __uint_as_float(rr[0]) + __uint_as_float(rr[1]); }
  l_reg = l_reg * alpha + ps;
#define PK4(P, BASE, OUT) do { unsigned a0 = cvtpk(P[BASE + 0], P[BASE + 1]), a1 = cvtpk(P[BASE + 2], P[BASE + 3]);   \
    unsigned b0 = cvtpk(P[BASE + 4], P[BASE + 5]), b1 = cvtpk(P[BASE + 6], P[BASE + 7]);                              \
    auto r0 = __builtin_amdgcn_permlane32_swap(a0, b0, false, false); auto r1 = __builtin_amdgcn_permlane32_swap(a1, b1, false, false); \
    u32x4 w = {r0[0], r1[0], r0[1], r1[1]}; OUT = *reinterpret_cast<bf16x8*>(&w); } while (0)
  PK4(p0, 0, pa0); PK4(p0, 8, pa1); PK4(p1, 0, pa2); PK4(p1, 8, pa3);
#undef PK4
}
template <int ND0>
__device__ __forceinline__ void qkt(f32x16& p0, f32x16& p1, const LAS char* Ks, const bf16x8* qr, int r32, int hi, int dbase) {
  p0 = f32x16{}; p1 = f32x16{};
#pragma unroll
  for (int d0 = 0; d0 < ND0; ++d0) { int cb = ((dbase + d0) * 16 + hi * 8) * 2;
    bf16x8 b0 = *reinterpret_cast<const LAS bf16x8*>(Ks + KSWZ(r32, cb));
    bf16x8 b1 = *reinterpret_cast<const LAS bf16x8*>(Ks + KSWZ(32 + r32, cb));
    p0 = __builtin_amdgcn_mfma_f32_32x32x16_bf16(b0, qr[d0], p0, 0, 0, 0);
    p1 = __builtin_amdgcn_mfma_f32_32x32x16_bf16(b1, qr[d0], p1, 0, 0, 0); }
}
__device__ __forceinline__ int v_st(int k, int c) { const int kk = (k & ~0xC) | ((k & 4) << 1) | ((k & 8) >> 1); return ((kk >> 3) * 4 + (c >> 5)) * 512 + ((kk & 7) * 32 + (c & 31)) * 2; }
__device__ __forceinline__ int v_st_lin(int k, int c) { return ((k >> 3) * 4 + (c >> 5)) * 512 + ((k & 7) * 32 + (c & 31)) * 2; }
__device__ __forceinline__ int v_rd_base(int lane) { return ((lane & 3) << 3) | (((lane >> 2) & 3) << 6) | (((lane >> 4) & 1) << 5) | (((lane >> 5) & 1) << 8); }
constexpr int v_rd_off(int d0, int ks, int half) { return d0 * 512 + ks * 4096 + half * 2048; }
template <int OFF> __device__ __forceinline__ s16x4 tr_read(int vb) {
  s16x4 r; asm volatile("ds_read_b64_tr_b16 %0, %1 offset:%2" : "=&v"(r) : "v"(vb), "i"(OFF) : "memory"); return r;
}
template <int D0> __device__ __forceinline__ void pv_one(f32x16& od, int vb, bf16x8 pa0, bf16x8 pa1, bf16x8 pa2, bf16x8 pa3) {
  const s16x4 l0 = tr_read<v_rd_off(D0, 0, 0)>(vb), h0 = tr_read<v_rd_off(D0, 0, 1)>(vb), l1 = tr_read<v_rd_off(D0, 1, 0)>(vb), h1 = tr_read<v_rd_off(D0, 1, 1)>(vb);
  const s16x4 l2 = tr_read<v_rd_off(D0, 2, 0)>(vb), h2 = tr_read<v_rd_off(D0, 2, 1)>(vb), l3 = tr_read<v_rd_off(D0, 3, 0)>(vb), h3 = tr_read<v_rd_off(D0, 3, 1)>(vb);
#if defined(DUMMY_TR) && DUMMY_TR
  { s16x4 dd; for (int i = 0; i < DUMMY_TR; ++i) asm volatile("ds_read_b64_tr_b16 %0, %1 offset:%2" : "=&v"(dd) : "v"(vb), "i"(v_rd_off(D0, 0, 0)) : "memory"); }
#endif
#if defined(DUMMY_MFMA) && DUMMY_MFMA
  { f32x4v dm = {0.f, 0.f, 0.f, 0.f}; for (int i = 0; i < DUMMY_MFMA; ++i) asm volatile("v_mfma_f32_16x16x32_bf16 %0, %1, %2, %0" : "+v"(dm) : "v"(pa0), "v"(pa1)); }
#endif
  asm volatile("s_waitcnt lgkmcnt(0)" ::: "memory"); SBAR();
#define PK(L, H) (bf16x8){L[0], L[1], L[2], L[3], H[0], H[1], H[2], H[3]}
  od = __builtin_amdgcn_mfma_f32_32x32x16_bf16(pa0, PK(l0, h0), od, 0, 0, 0);
  od = __builtin_amdgcn_mfma_f32_32x32x16_bf16(pa1, PK(l1, h1), od, 0, 0, 0);
  od = __builtin_amdgcn_mfma_f32_32x32x16_bf16(pa2, PK(l2, h2), od, 0, 0, 0);
  od = __builtin_amdgcn_mfma_f32_32x32x16_bf16(pa3, PK(l3, h3), od, 0, 0, 0);
#undef PK
}
__device__ __forceinline__ void pv_d0(f32x16* o, int vb, bf16x8 pa0, bf16x8 pa1, bf16x8 pa2, bf16x8 pa3) {
  pv_one<0>(o[0], vb, pa0, pa1, pa2, pa3); pv_one<1>(o[1], vb, pa0, pa1, pa2, pa3); pv_one<2>(o[2], vb, pa0, pa1, pa2, pa3); pv_one<3>(o[3], vb, pa0, pa1, pa2, pa3);
}

#ifndef DUMMY_EXP
#define DUMMY_EXP 0
#endif
#ifndef DUMMY_TR
#define DUMMY_TR 0
#endif
#ifndef DUMMY_MFMA
#define DUMMY_MFMA 0
#endif
__device__ __forceinline__ void dummy_exp(float x) { float d; for (int i = 0; i < DUMMY_EXP; ++i) asm volatile("v_exp_f32 %0, %1" : "=v"(d) : "v"(x)); }
__device__ __forceinline__ void expA(f32x16& p0) {
#pragma unroll
  for (int r = 0; r < 16; ++r) { dummy_exp(p0[r]); p0[r] = __builtin_amdgcn_exp2f(p0[r]); }
}
__device__ __forceinline__ void expB_sum_pack(f32x16& p0, f32x16& p1, float& l_reg, bf16x8& pa0, bf16x8& pa1, bf16x8& pa2, bf16x8& pa3) {
#pragma unroll
  for (int r = 0; r < 16; ++r) { dummy_exp(p1[r]); p1[r] = __builtin_amdgcn_exp2f(p1[r]); }
  float ps = 0;
#pragma unroll
  for (int r = 0; r < 16; ++r) ps += p0[r];
#pragma unroll
  for (int r = 0; r < 16; ++r) ps += p1[r];
  { auto rr = __builtin_amdgcn_permlane32_swap(__float_as_uint(ps), __float_as_uint(ps), false, false);
    ps = __uint_as_float(rr[0]) + __uint_as_float(rr[1]); }
  l_reg += ps;
#define PK4(P, BASE, OUT) do { unsigned a0 = cvtpk(P[BASE + 0], P[BASE + 1]), a1 = cvtpk(P[BASE + 2], P[BASE + 3]);   \
    unsigned b0 = cvtpk(P[BASE + 4], P[BASE + 5]), b1 = cvtpk(P[BASE + 6], P[BASE + 7]);                              \
    auto r0 = __builtin_amdgcn_permlane32_swap(a0, b0, false, false); auto r1 = __builtin_amdgcn_permlane32_swap(a1, b1, false, false); \
    u32x4 w = {r0[0], r1[0], r0[1], r1[1]}; OUT = *reinterpret_cast<bf16x8*>(&w); } while (0)
  PK4(p0, 0, pa0); PK4(p0, 8, pa1); PK4(p1, 0, pa2); PK4(p1, 8, pa3);
#undef PK4
}
__device__ __forceinline__ bf16x8 ld8(const bf16_t* p) { return *reinterpret_cast<const bf16x8*>(p); }

constexpr int TP = 132;
__device__ __forceinline__ void tile_to_rows(const f32x16 (&o)[4], LAS float* scr, int r32, int hi, float (&v)[64]) {
#pragma unroll
  for (int d0 = 0; d0 < 4; ++d0)
#pragma unroll
    for (int r = 0; r < 16; ++r) scr[crow(r, hi) * TP + 32 * d0 + r32] = o[d0][r];
  asm volatile("s_waitcnt lgkmcnt(0)" ::: "memory");
#pragma unroll
  for (int i = 0; i < 16; ++i) { const f32x4v t = *(const LAS f32x4v*)(scr + r32 * TP + 64 * hi + 4 * i); v[4 * i] = t[0]; v[4 * i + 1] = t[1]; v[4 * i + 2] = t[2]; v[4 * i + 3] = t[3]; }
}
__device__ __forceinline__ float pair_sum(float x) {
  auto rr = __builtin_amdgcn_permlane32_swap(__float_as_uint(x), __float_as_uint(x), false, false); return __uint_as_float(rr[0]) + __uint_as_float(rr[1]);
}


#define PVX_RD2(L0, H0, D0, KS) do { L0 = tr_read<v_rd_off(D0, KS, 0)>(vb); H0 = tr_read<v_rd_off(D0, KS, 1)>(vb); } while (0)
#define PVX_PK(L, H) (bf16x8){L[0], L[1], L[2], L[3], H[0], H[1], H[2], H[3]}
#define PVX_E(i) do { if (DOEXP) { pn[i] = __builtin_amdgcn_exp2f(pn[i]); psn += pn[i]; } } while (0)
#define PVX_W(n) asm volatile("s_waitcnt lgkmcnt(" #n ")" ::: "memory")
#define PVX_BLOCK(D0, E0) do { \
    PVX_W(6); SBAR(); o[D0] = __builtin_amdgcn_mfma_f32_32x32x16_bf16(pa0, PVX_PK(fl0, fh0), o[D0], 0, 0, 0); PVX_E(E0 + 0); PVX_RD2(fl0, fh0, D0 + 1, 0); SBAR(); \
    PVX_W(6); SBAR(); o[D0] = __builtin_amdgcn_mfma_f32_32x32x16_bf16(pa1, PVX_PK(fl1, fh1), o[D0], 0, 0, 0); PVX_E(E0 + 1); PVX_RD2(fl1, fh1, D0 + 1, 1); SBAR(); \
    PVX_W(6); SBAR(); o[D0] = __builtin_amdgcn_mfma_f32_32x32x16_bf16(pa2, PVX_PK(fl2, fh2), o[D0], 0, 0, 0); PVX_E(E0 + 2); PVX_RD2(fl2, fh2, D0 + 1, 2); SBAR(); \
    PVX_W(6); SBAR(); o[D0] = __builtin_amdgcn_mfma_f32_32x32x16_bf16(pa3, PVX_PK(fl3, fh3), o[D0], 0, 0, 0); PVX_E(E0 + 3); PVX_RD2(fl3, fh3, D0 + 1, 3); SBAR(); } while (0)
template <bool DOEXP>
__device__ __forceinline__ void pv_exp(f32x16* o, int vb, bf16x8 pa0, bf16x8 pa1, bf16x8 pa2, bf16x8 pa3, f32x16& pn, float& psn) {
  s16x4 fl0, fh0, fl1, fh1, fl2, fh2, fl3, fh3;
  asm volatile("s_waitcnt lgkmcnt(0)" ::: "memory");
  PVX_RD2(fl0, fh0, 0, 0); PVX_RD2(fl1, fh1, 0, 1); PVX_RD2(fl2, fh2, 0, 2); PVX_RD2(fl3, fh3, 0, 3);
  PVX_BLOCK(0, 0); PVX_BLOCK(1, 4); PVX_BLOCK(2, 8);
  PVX_W(6); SBAR(); o[3] = __builtin_amdgcn_mfma_f32_32x32x16_bf16(pa0, PVX_PK(fl0, fh0), o[3], 0, 0, 0); PVX_E(12); SBAR();
  PVX_W(4); SBAR(); o[3] = __builtin_amdgcn_mfma_f32_32x32x16_bf16(pa1, PVX_PK(fl1, fh1), o[3], 0, 0, 0); PVX_E(13); SBAR();
  PVX_W(2); SBAR(); o[3] = __builtin_amdgcn_mfma_f32_32x32x16_bf16(pa2, PVX_PK(fl2, fh2), o[3], 0, 0, 0); PVX_E(14); SBAR();
  PVX_W(0); SBAR(); o[3] = __builtin_amdgcn_mfma_f32_32x32x16_bf16(pa3, PVX_PK(fl3, fh3), o[3], 0, 0, 0); PVX_E(15); SBAR();
}
__device__ __forceinline__ void expB_sum_pack2(f32x16& p0, f32x16& p1, float ps, float& l_reg, bf16x8& pa0, bf16x8& pa1, bf16x8& pa2, bf16x8& pa3) {
#pragma unroll
  for (int r = 0; r < 16; ++r) { p1[r] = __builtin_amdgcn_exp2f(p1[r]); ps += p1[r]; }
  { auto rr = __builtin_amdgcn_permlane32_swap(__float_as_uint(ps), __float_as_uint(ps), false, false);
    ps = __uint_as_float(rr[0]) + __uint_as_float(rr[1]); }
  l_reg += ps;
#define PK4(P, BASE, OUT) do { unsigned a0 = cvtpk(P[BASE + 0], P[BASE + 1]), a1 = cvtpk(P[BASE + 2], P[BASE + 3]);   \
    unsigned b0 = cvtpk(P[BASE + 4], P[BASE + 5]), b1 = cvtpk(P[BASE + 6], P[BASE + 7]);                              \
    auto r0 = __builtin_amdgcn_permlane32_swap(a0, b0, false, false); auto r1 = __builtin_amdgcn_permlane32_swap(a1, b1, false, false); \
    u32x4 w = {r0[0], r1[0], r0[1], r1[1]}; OUT = *reinterpret_cast<bf16x8*>(&w); } while (0)
  PK4(p0, 0, pa0); PK4(p0, 8, pa1); PK4(p1, 0, pa2); PK4(p1, 8, pa3);
#undef PK4
}
__device__ __forceinline__ float exp_sum16(f32x16& p0) { float ps = 0.f;
#pragma unroll
  for (int r = 0; r < 16; ++r) { p0[r] = __builtin_amdgcn_exp2f(p0[r]); ps += p0[r]; }
  return ps; }

__device__ __forceinline__ void attn_unit(const int wid, const bf16_t* __restrict__ proj, const char* __restrict__ Kt_bh, const char* __restrict__ Vt_bh, bf16_t* __restrict__ concat, int qrow0, int NT, int h,
                                          LAS char* lds, float lam, float omli, const float* __restrict__ subln) {
  const int lane = lane_id(), tid = wid * 64 + lane, r32 = lane & 31, hi = lane >> 5, rg = wid & 3, c = wid >> 2;
  LAS char* V_lds = lds; LAS char* K_lds = lds + 4 * SHM_V;
  LAS float* li_l = (LAS float*)(lds + 4 * SHM_V + 4 * SHM_K) + wid * 64;
  float l_reg = 0; f32x16 o[4] = {}; bf16x8 qr[4];
  const bf16_t* Qw = proj + (size_t)(qrow0 + rg * 32 + r32) * DP + C_DQ + h * 128 + c * 64 + hi * 8;
#pragma unroll
  for (int d0 = 0; d0 < 4; ++d0) qr[d0] = ld8(Qw + d0 * 16);
  const int vb0 = (int)(uintptr_t)V_lds + v_rd_base(lane);
  const char* kg0 = Kt_bh + wid * 2048 + lane * 16; const char* vg0 = Vt_bh + wid * 2048 + lane * 16;
#define DMA_TILE(tile, slot) do { const size_t to_ = (size_t)(tile) * 16384; \
    __builtin_amdgcn_global_load_lds((const unsigned*)(kg0 + to_), (LAS unsigned*)(K_lds + (slot) * SHM_K + wid * 2048), 16, 0, 0); \
    __builtin_amdgcn_global_load_lds((const unsigned*)(kg0 + to_ + 1024), (LAS unsigned*)(K_lds + (slot) * SHM_K + wid * 2048 + 1024), 16, 0, 0); \
    __builtin_amdgcn_global_load_lds((const unsigned*)(vg0 + to_), (LAS unsigned*)(V_lds + (slot) * SHM_V + wid * 2048), 16, 0, 0); \
    __builtin_amdgcn_global_load_lds((const unsigned*)(vg0 + to_ + 1024), (LAS unsigned*)(V_lds + (slot) * SHM_V + wid * 2048 + 1024), 16, 0, 0); } while (0)
#define BAR() do { asm volatile("s_waitcnt vmcnt(0) lgkmcnt(0)" ::: "memory"); __builtin_amdgcn_s_barrier(); asm volatile("" ::: "memory"); } while (0)
#define STAGE(b) do { if ((b) + 3 < NT) DMA_TILE((b) + 3, ((b) + 3) & 3); } while (0)
#define STAGES(b, slot) do { if ((b) + 3 < NT) DMA_TILE((b) + 3, slot); } while (0)
#define QKT(P0, P1, t) qkt<4>(P0, P1, K_lds + ((t) & 3) * SHM_K, qr, r32, hi, 4 * c)
#define QKTS(P0, P1, slot) qkt<4>(P0, P1, K_lds + (slot) * SHM_K, qr, r32, hi, 4 * c)
#define PV(t) pv_d0(o, vb0 + ((t) & 3) * SHM_V, pa0, pa1, pa2, pa3)
  f32x16 pA0, pA1, pB0, pB1; bf16x8 pa0, pa1, pa2, pa3; float psA = 0.f, psB = 0.f;
#define PVE(t, PN, PSN) do { PSN = 0.f; pv_exp<true>(o, vb0 + ((t) & 3) * SHM_V, pa0, pa1, pa2, pa3, PN, PSN); } while (0)
#define PVES(slot, PN, PSN) do { PSN = 0.f; pv_exp<true>(o, vb0 + (slot) * SHM_V, pa0, pa1, pa2, pa3, PN, PSN); } while (0)
#define PVL(t) do { float d_ = 0.f; pv_exp<false>(o, vb0 + ((t) & 3) * SHM_V, pa0, pa1, pa2, pa3, pA0, d_); } while (0)
  DMA_TILE(0, 0); DMA_TILE(1, 1); DMA_TILE(2, 2);
  BAR();
  QKT(pA0, pA1, 0); psA = exp_sum16(pA0);
  for (int t = 0; t < NT; t += 4) {
    if (c == 0) { BAR(); STAGES(t, 3); } SBAR();
    QKTS(pB0, pB1, 1); expB_sum_pack2(pA0, pA1, psA, l_reg, pa0, pa1, pa2, pa3); SBAR();
    if (c == 1) { BAR(); STAGES(t, 3); } SBAR();
    PVES(0, pB0, psB); SBAR();
    if (c == 0) { BAR(); STAGES(t + 1, 0); } SBAR();
    QKTS(pA0, pA1, 2); expB_sum_pack2(pB0, pB1, psB, l_reg, pa0, pa1, pa2, pa3); SBAR();
    if (c == 1) { BAR(); STAGES(t + 1, 0); } SBAR();
    PVES(1, pA0, psA); SBAR();
    if (c == 0) { BAR(); STAGES(t + 2, 1); } SBAR();
    QKTS(pB0, pB1, 3); expB_sum_pack2(pA0, pA1, psA, l_reg, pa0, pa1, pa2, pa3); SBAR();
    if (c == 1) { BAR(); STAGES(t + 2, 1); } SBAR();
    PVES(2, pB0, psB); SBAR();
    if (c == 0) { BAR(); STAGES(t + 3, 2); } SBAR();
    if (t + 4 < NT) QKTS(pA0, pA1, 0);
    expB_sum_pack2(pB0, pB1, psB, l_reg, pa0, pa1, pa2, pa3); SBAR();
    if (c == 1) { BAR(); STAGES(t + 3, 2); } SBAR();
    PVES(3, pA0, psA);
    SBAR();
  }
#undef PVE
#undef PVES
#undef QKTS
#undef STAGES
#undef PVL
  if (hi == 0) li_l[r32] = l_reg; asm volatile("s_waitcnt lgkmcnt(0)" ::: "memory");
#pragma unroll
  for (int r = 0; r < 16; ++r) { const float rl = __builtin_amdgcn_rcpf(li_l[crow(r, hi)]);
#pragma unroll
    for (int d0 = 0; d0 < 4; ++d0) o[d0][r] *= rl; }
  __syncthreads();
  LAS float* xch = (LAS float*)lds + rg * 4096;
  if (c == 1) {
#pragma unroll
    for (int d0 = 0; d0 < 4; ++d0)
#pragma unroll
      for (int r = 0; r < 16; ++r) xch[(d0 * 16 + r) * 64 + lane] = o[d0][r];
  }
  __syncthreads();
  if (c == 0) {
#pragma unroll
    for (int r = 0; r < 16; ++r) { float s = 0.f;
#pragma unroll
      for (int d0 = 0; d0 < 4; ++d0) { const float d = o[d0][r] - lam * xch[(d0 * 16 + r) * 64 + lane]; o[d0][r] = d; s += d * d; }
      s += __shfl_xor(s, 1); s += __shfl_xor(s, 2); s += __shfl_xor(s, 4); s += __shfl_xor(s, 8); s += __shfl_xor(s, 16);
      const float rr = rsqrtf(s * (1.f / 128.f) + EPS) * omli;
      bf16_t* orow = concat + (size_t)(qrow0 + rg * 32 + crow(r, hi)) * DM + 512 + h * 128 + r32;
#pragma unroll
      for (int d0 = 0; d0 < 4; ++d0) orow[d0 * 32] = f2bf(o[d0][r] * rr * subln[d0 * 32 + r32]); }
  }
  __syncthreads();
#undef DMA_TILE
#undef BAR
#undef STAGE
#undef QKT
#undef PV
}


typedef float f32x2 __attribute__((ext_vector_type(2)));
__device__ __forceinline__ void exp_half(f32x16& ph, f32x2& lacc) {
#pragma unroll
  for (int r = 0; r < 16; r += 2) { ph[r] = __builtin_amdgcn_exp2f(ph[r]); ph[r + 1] = __builtin_amdgcn_exp2f(ph[r + 1]); const f32x2 e = {ph[r], ph[r + 1]}; lacc += e; }
}
__device__ __forceinline__ void pack_half(const f32x16& ph, bf16x8& x0, bf16x8& x1) {
  { u32x4 w = {cvtpk(ph[0], ph[1]), cvtpk(ph[2], ph[3]), cvtpk(ph[4], ph[5]), cvtpk(ph[6], ph[7])}; x0 = *reinterpret_cast<bf16x8*>(&w); }
  { u32x4 w = {cvtpk(ph[8], ph[9]), cvtpk(ph[10], ph[11]), cvtpk(ph[12], ph[13]), cvtpk(ph[14], ph[15])}; x1 = *reinterpret_cast<bf16x8*>(&w); }
}

template <int D0> __device__ __forceinline__ void pv2_block(f32x16& oa, f32x16& ob, int vb, s16x4& fl0, s16x4& fh0, s16x4& fl1, s16x4& fh1, s16x4& fl2, s16x4& fh2, s16x4& fl3, s16x4& fh3,
                                                           bf16x8 a0, bf16x8 a1, bf16x8 a2, bf16x8 a3, bf16x8 b0, bf16x8 b1, bf16x8 b2, bf16x8 b3) {
#define PV2_STEP(A, B, FL, FH, KS, WN) do { asm volatile("s_waitcnt lgkmcnt(" #WN ")" ::: "memory"); SBAR(); \
    oa = __builtin_amdgcn_mfma_f32_32x32x16_bf16(A, PVX_PK(FL, FH), oa, 0, 0, 0); ob = __builtin_amdgcn_mfma_f32_32x32x16_bf16(B, PVX_PK(FL, FH), ob, 0, 0, 0); \
    if (D0 < 3) { FL = tr_read<v_rd_off((D0 + 1) & 3, KS, 0)>(vb); FH = tr_read<v_rd_off((D0 + 1) & 3, KS, 1)>(vb); } SBAR(); } while (0)
  if (D0 < 3) { PV2_STEP(a0, b0, fl0, fh0, 0, 6); PV2_STEP(a1, b1, fl1, fh1, 1, 6); PV2_STEP(a2, b2, fl2, fh2, 2, 6); PV2_STEP(a3, b3, fl3, fh3, 3, 6); }
  else        { PV2_STEP(a0, b0, fl0, fh0, 0, 6); PV2_STEP(a1, b1, fl1, fh1, 1, 4); PV2_STEP(a2, b2, fl2, fh2, 2, 2); PV2_STEP(a3, b3, fl3, fh3, 3, 0); }
#undef PV2_STEP
}
__device__ __forceinline__ void attn_unit3p(const int wid, const bf16_t* __restrict__ proj, const char* __restrict__ Kt_bh, const char* __restrict__ Vt_bh, bf16_t* __restrict__ concat, int qrow0, int NT, int h,
                                            LAS char* lds, float lam, float omli, const float* __restrict__ subln) {
  const int lane = lane_id(), r32 = lane & 31, hi = lane >> 5;
  LAS char* V_lds = lds; LAS char* K_lds = lds + 2 * SHM_V; LAS char* Qw = lds + 65536 + wid * 8192;
  LAS float* li_l = (LAS float*)(lds + 131072) + wid * 64;
  f32x2 l0v = {0.f, 0.f}, l1v = {0.f, 0.f}; f32x16 o0[4] = {}, o1[4] = {};
  const int vb0 = (int)(uintptr_t)V_lds + v_rd_base(lane);
  const char* kg0 = Kt_bh + wid * 2048 + lane * 16; const char* vg0 = Vt_bh + wid * 2048 + lane * 16;
#define DMA_TILE(tile, slot) do { const size_t to_ = (size_t)(tile) * 16384; \
    __builtin_amdgcn_global_load_lds((const unsigned*)(kg0 + to_), (LAS unsigned*)(K_lds + (slot) * SHM_K + wid * 2048), 16, 0, 0); \
    __builtin_amdgcn_global_load_lds((const unsigned*)(kg0 + to_ + 1024), (LAS unsigned*)(K_lds + (slot) * SHM_K + wid * 2048 + 1024), 16, 0, 0); \
    __builtin_amdgcn_global_load_lds((const unsigned*)(vg0 + to_), (LAS unsigned*)(V_lds + (slot) * SHM_V + wid * 2048), 16, 0, 0); \
    __builtin_amdgcn_global_load_lds((const unsigned*)(vg0 + to_ + 1024), (LAS unsigned*)(V_lds + (slot) * SHM_V + wid * 2048 + 1024), 16, 0, 0); } while (0)
#define BAR() do { asm volatile("s_waitcnt vmcnt(0) lgkmcnt(0)" ::: "memory"); __builtin_amdgcn_s_barrier(); asm volatile("" ::: "memory"); } while (0)
  { const char* qg = (const char*)(proj + (size_t)(qrow0 + wid * 32) * DP + C_DQ + h * 128);
#pragma unroll
    for (int i = 0; i < 8; ++i) { const int row = 4 * i + (lane >> 4), ch = (lane & 15) ^ (row & 7);
      __builtin_amdgcn_global_load_lds((const unsigned*)(qg + (size_t)row * (DP * 2) + ch * 16), (LAS unsigned*)(Qw + i * 1024), 16, 0, 0); } }
  DMA_TILE(0, 0);
  bf16x8 a0, a1, a2, a3, b0, b1, b2, b3;
  int sw0 = KSWZ(r32, (0 * 16 + hi * 8) * 2), sw1 = KSWZ(r32, (1 * 16 + hi * 8) * 2), sw2 = KSWZ(r32, (2 * 16 + hi * 8) * 2), sw3 = KSWZ(r32, (3 * 16 + hi * 8) * 2);
  int kad0_ = (int)(uintptr_t)K_lds + sw0, kad1_ = (int)(uintptr_t)K_lds + sw1, kad2_ = (int)(uintptr_t)K_lds + sw2, kad3_ = (int)(uintptr_t)K_lds + sw3;
  int qad0_ = (int)(uintptr_t)Qw + sw0, qad1_ = (int)(uintptr_t)Qw + sw1, qad2_ = (int)(uintptr_t)Qw + sw2, qad3_ = (int)(uintptr_t)Qw + sw3;
  asm volatile("" : "+v"(kad0_), "+v"(kad1_), "+v"(kad2_), "+v"(kad3_), "+v"(qad0_), "+v"(qad1_), "+v"(qad2_), "+v"(qad3_));
  LAS char* const kad0 = (LAS char*)(uintptr_t)kad0_; LAS char* const kad1 = (LAS char*)(uintptr_t)kad1_; LAS char* const kad2 = (LAS char*)(uintptr_t)kad2_; LAS char* const kad3 = (LAS char*)(uintptr_t)kad3_;
  LAS char* const qad0 = (LAS char*)(uintptr_t)qad0_; LAS char* const qad1 = (LAS char*)(uintptr_t)qad1_; LAS char* const qad2 = (LAS char*)(uintptr_t)qad2_; LAS char* const qad3 = (LAS char*)(uintptr_t)qad3_;
#define QK2(P0, P1, so, cc) do { P0 = f32x16{}; P1 = f32x16{}; _Pragma("unroll") for (int d0 = 0; d0 < 4; ++d0) { const int cb = ((4 * (cc) + d0) * 16 + hi * 8) * 2; \
    const bf16x8 ka_ = *reinterpret_cast<const LAS bf16x8*>(K_lds + (so) * SHM_K + KSWZ(r32, cb)), kb_ = *reinterpret_cast<const LAS bf16x8*>(K_lds + (so) * SHM_K + KSWZ(32 + r32, cb)); \
    const bf16x8 q_ = *reinterpret_cast<const LAS bf16x8*>(Qw + KSWZ(r32, cb)); \
    P0 = __builtin_amdgcn_mfma_f32_32x32x16_bf16(ka_, q_, P0, 0, 0, 0); P1 = __builtin_amdgcn_mfma_f32_32x32x16_bf16(kb_, q_, P1, 0, 0, 0); } } while (0)
#define QKA(PH, so, cc, koff, LQ) do { PH = f32x16{}; \
    { if (LQ) qf0 = *reinterpret_cast<const LAS bf16x8*>(qad0 + 128 * (cc)); const bf16x8 k_ = *reinterpret_cast<const LAS bf16x8*>(kad0 + ((so) * SHM_K + (koff) * 256 + 128 * (cc))); PH = __builtin_amdgcn_mfma_f32_32x32x16_bf16(k_, qf0, PH, 0, 0, 0); } \
    { if (LQ) qf1 = *reinterpret_cast<const LAS bf16x8*>(qad1 + 128 * (cc)); const bf16x8 k_ = *reinterpret_cast<const LAS bf16x8*>(kad1 + ((so) * SHM_K + (koff) * 256 + 128 * (cc))); PH = __builtin_amdgcn_mfma_f32_32x32x16_bf16(k_, qf1, PH, 0, 0, 0); } } while (0)
#define QKB(PH, so, cc, koff, LQ) do { \
    { if (LQ) qf2 = *reinterpret_cast<const LAS bf16x8*>(qad2 + 128 * (cc)); const bf16x8 k_ = *reinterpret_cast<const LAS bf16x8*>(kad2 + ((so) * SHM_K + (koff) * 256 + 128 * (cc))); PH = __builtin_amdgcn_mfma_f32_32x32x16_bf16(k_, qf2, PH, 0, 0, 0); } \
    { if (LQ) qf3 = *reinterpret_cast<const LAS bf16x8*>(qad3 + 128 * (cc)); const bf16x8 k_ = *reinterpret_cast<const LAS bf16x8*>(kad3 + ((so) * SHM_K + (koff) * 256 + 128 * (cc))); PH = __builtin_amdgcn_mfma_f32_32x32x16_bf16(k_, qf3, PH, 0, 0, 0); } } while (0)
#define QKH(PH, so, cc, koff, LQ) do { QKA(PH, so, cc, koff, LQ); QKB(PH, so, cc, koff, LQ); } while (0)
#define SGB(m, n) __builtin_amdgcn_sched_group_barrier(m, n, 0)
#define STEP(PN, so, cc, koff, LQ, PO, LV, X0, X1) do { \
    QKA(PN, so, cc, koff, LQ); exp_half(PO, LV); SGB(0x100, (LQ) ? 4 : 2); SGB(0x8, 1); SGB(0x2, 12); SGB(0x8, 1); SGB(0x2, 12); SBAR(); asm volatile("" : "+v"(LV)); SBAR(); \
    QKB(PN, so, cc, koff, LQ); pack_half(PO, X0, X1); SGB(0x100, (LQ) ? 4 : 2); SGB(0x8, 1); SGB(0x2, 4); SGB(0x8, 1); SGB(0x2, 4); MBAR(PN); } while (0)
#define MBAR(X) do { SBAR(); asm volatile("" : "+v"(X) :: "memory"); SBAR(); } while (0)
#define TILE(t, so) do { BAR(); if ((t) + 1 < NT) DMA_TILE((t) + 1, 1 - (so)); SBAR(); \
    { f32x16 p0, p1; bf16x8 qf0, qf1, qf2, qf3; \
      QKH(p0, so, 0, 0, 1); MBAR(p0); \
      STEP(p1, so, 0, 32, 0, p0, l0v, a0, a1); \
      STEP(p0, so, 1, 0, 1, p1, l0v, a2, a3); \
      STEP(p1, so, 1, 32, 0, p0, l1v, b0, b1); \
      exp_half(p1, l1v); SBAR(); asm volatile("" : "+v"(l1v)); SBAR(); pack_half(p1, b2, b3); } SBAR(); \
    { const int vb = vb0 + (so) * SHM_V; s16x4 fl0, fh0, fl1, fh1, fl2, fh2, fl3, fh3; \
      asm volatile("s_waitcnt lgkmcnt(0)" ::: "memory"); \
      PVX_RD2(fl0, fh0, 0, 0); PVX_RD2(fl1, fh1, 0, 1); PVX_RD2(fl2, fh2, 0, 2); PVX_RD2(fl3, fh3, 0, 3); \
      pv2_block<0>(o0[0], o1[0], vb, fl0, fh0, fl1, fh1, fl2, fh2, fl3, fh3, a0, a1, a2, a3, b0, b1, b2, b3); \
      pv2_block<1>(o0[1], o1[1], vb, fl0, fh0, fl1, fh1, fl2, fh2, fl3, fh3, a0, a1, a2, a3, b0, b1, b2, b3); \
      pv2_block<2>(o0[2], o1[2], vb, fl0, fh0, fl1, fh1, fl2, fh2, fl3, fh3, a0, a1, a2, a3, b0, b1, b2, b3); \
      pv2_block<3>(o0[3], o1[3], vb, fl0, fh0, fl1, fh1, fl2, fh2, fl3, fh3, a0, a1, a2, a3, b0, b1, b2, b3); } SBAR(); } while (0)
  for (int t = 0; t < NT; t += 2) { TILE(t, 0); TILE(t + 1, 1); }
  const float l0 = pair_sum(l0v[0] + l0v[1]), l1 = pair_sum(l1v[0] + l1v[1]);
  if (hi == 0) { li_l[r32] = l0; li_l[32 + r32] = l1; } asm volatile("s_waitcnt lgkmcnt(0)" ::: "memory");
#pragma unroll
  for (int r = 0; r < 16; ++r) { const float ra = __builtin_amdgcn_rcpf(li_l[crow(r, hi)]), rb = lam * __builtin_amdgcn_rcpf(li_l[32 + crow(r, hi)]);
    float s = 0.f;
#pragma unroll
    for (int d0 = 0; d0 < 4; ++d0) { const float d = o0[d0][r] * ra - o1[d0][r] * rb; o0[d0][r] = d; s += d * d; }
    s += __shfl_xor(s, 1); s += __shfl_xor(s, 2); s += __shfl_xor(s, 4); s += __shfl_xor(s, 8); s += __shfl_xor(s, 16);
    const float rr = rsqrtf(s * (1.f / 128.f) + EPS) * omli;
    bf16_t* orow = concat + (size_t)(qrow0 + wid * 32 + crow(r, hi)) * DM + 512 + h * 128 + r32;
#pragma unroll
    for (int d0 = 0; d0 < 4; ++d0) orow[d0 * 32] = f2bf(o0[d0][r] * rr * subln[d0 * 32 + r32]); }
  asm volatile("s_waitcnt vmcnt(0) lgkmcnt(0)" ::: "memory"); __syncthreads();
#undef DMA_TILE
#undef BAR
#undef QK2
#undef QKH
#undef QKA
#undef QKB
#undef TILE
#undef STEP
#undef MBAR
#undef SGB
}

__device__ __forceinline__ bf16x8 scale8(bf16x8 v, float s) {
  u32x4 w;
#pragma unroll
  for (int i = 0; i < 4; ++i) { const float a = __uint_as_float(((unsigned)(unsigned short)v[2 * i]) << 16) * s, b = __uint_as_float(((unsigned)(unsigned short)v[2 * i + 1]) << 16) * s; w[i] = cvtpk(a, b); }
  return *reinterpret_cast<bf16x8*>(&w);
}
template <int KS> __device__ __forceinline__ void trfrag_issue(int vb, s16x4& l, s16x4& h) { l = tr_read<v_rd_off(0, KS, 0)>(vb); h = tr_read<v_rd_off(0, KS, 1)>(vb); }
#define PKF(L, H) (bf16x8){L[0], L[1], L[2], L[3], H[0], H[1], H[2], H[3]}
template <int KS> __device__ __forceinline__ void cs_step(f32x16* acc, int kb, int vv) {
  s16x4 al, ah, b0l, b0h, b1l, b1h, b2l, b2h, b3l, b3h;
  trfrag_issue<KS>(kb, al, ah); trfrag_issue<KS>(vv, b0l, b0h); trfrag_issue<KS>(vv + 512, b1l, b1h); trfrag_issue<KS>(vv + 1024, b2l, b2h); trfrag_issue<KS>(vv + 1536, b3l, b3h);
  asm volatile("s_waitcnt lgkmcnt(0)" ::: "memory"); SBAR();
  const bf16x8 a = PKF(al, ah);
  acc[0] = __builtin_amdgcn_mfma_f32_32x32x16_bf16(a, PKF(b0l, b0h), acc[0], 0, 0, 0);
  acc[1] = __builtin_amdgcn_mfma_f32_32x32x16_bf16(a, PKF(b1l, b1h), acc[1], 0, 0, 0);
  acc[2] = __builtin_amdgcn_mfma_f32_32x32x16_bf16(a, PKF(b2l, b2h), acc[2], 0, 0, 0);
  acc[3] = __builtin_amdgcn_mfma_f32_32x32x16_bf16(a, PKF(b3l, b3h), acc[3], 0, 0, 0);
}
__device__ __forceinline__ void chunk_state_unit(const int wid, const bf16_t* __restrict__ proj, bf16_t* __restrict__ csf, bf16_t* __restrict__ csb, int rowbase, int h, float lgf2, float lgb2, LAS char* lds) {
  const int lane = lane_id(), tid = wid * 64 + lane, r32 = lane & 31, hi = lane >> 5;
  const int sr = tid >> 4, sc = (tid & 15) * 8;
  { bf16x8 kv[4], vv[4];
#pragma unroll
    for (int g = 0; g < 4; ++g) { const bf16_t* rp = proj + (size_t)(rowbase + 32 * g + sr) * DP + h * 128 + sc; kv[g] = ld8(rp + C_RK); vv[g] = ld8(rp + C_RV); }
#pragma unroll
    for (int g = 0; g < 4; ++g) { const int row = 32 * g + sr;
      const float wf = __builtin_amdgcn_exp2f(lgf2 * (float)(127 - row)), wb = __builtin_amdgcn_exp2f(lgb2 * (float)row);
      const int off = (row >> 6) * 16384 + v_st(row & 63, sc);
      *(LAS bf16x8*)(lds + off) = vv[g]; *(LAS bf16x8*)(lds + 32768 + off) = scale8(kv[g], wf); *(LAS bf16x8*)(lds + 65536 + off) = scale8(kv[g], wb); } }
  __syncthreads();
  const int dir = wid >> 2, ib = wid & 3;
  const int vbK = (int)(uintptr_t)(lds + 32768 + dir * 32768) + v_rd_base(lane) + ib * 512, vbV = (int)(uintptr_t)lds + v_rd_base(lane);
  f32x16 acc[4] = {};
  cs_step<0>(acc, vbK, vbV); cs_step<1>(acc, vbK, vbV); cs_step<2>(acc, vbK, vbV); cs_step<3>(acc, vbK, vbV);
  cs_step<0>(acc, vbK + 16384, vbV + 16384); cs_step<1>(acc, vbK + 16384, vbV + 16384); cs_step<2>(acc, vbK + 16384, vbV + 16384); cs_step<3>(acc, vbK + 16384, vbV + 16384);
  bf16_t* outp = (dir ? csb : csf) + r32;
#pragma unroll
  for (int r = 0; r < 16; ++r) { bf16_t* orow = outp + (size_t)(32 * ib + crow(r, hi)) * 128;
#pragma unroll
    for (int jb = 0; jb < 4; ++jb) orow[32 * jb] = f2bf(acc[jb][r]); }
  __syncthreads();
}
__device__ __forceinline__ void pack_p(const f32x16& p0, const f32x16& p1, bf16x8& pa0, bf16x8& pa1, bf16x8& pa2, bf16x8& pa3) {
#define PK4(P, BASE, OUT) do { unsigned a0 = cvtpk(P[BASE + 0], P[BASE + 1]), a1 = cvtpk(P[BASE + 2], P[BASE + 3]);   \
    unsigned b0 = cvtpk(P[BASE + 4], P[BASE + 5]), b1 = cvtpk(P[BASE + 6], P[BASE + 7]);                              \
    auto r0 = __builtin_amdgcn_permlane32_swap(a0, b0, false, false); auto r1 = __builtin_amdgcn_permlane32_swap(a1, b1, false, false); \
    u32x4 w = {r0[0], r1[0], r0[1], r1[1]}; OUT = *reinterpret_cast<bf16x8*>(&w); } while (0)
  PK4(p0, 0, pa0); PK4(p0, 8, pa1); PK4(p1, 0, pa2); PK4(p1, 8, pa3);
#undef PK4
}
__device__ __forceinline__ float decay_w(int d, float lgf2, float lgb2) {
  const float e = __builtin_amdgcn_exp2f(d < 0 ? lgf2 * (float)(-d) : lgb2 * (float)d); return d == 0 ? 2.f : e;
}
__device__ __forceinline__ void ret_out_unit(const int wid, const bf16_t* __restrict__ proj, bf16_t* __restrict__ concat, const bf16_t* __restrict__ spA, const bf16_t* __restrict__ spB, size_t dstride,
                                             int rowA, int rowB, int h, float lgf2, float lgb2, const float* __restrict__ gn, LAS char* lds) {
  const int lane = lane_id(), tid = wid * 64 + lane, r32 = lane & 31, hi = lane >> 5, rg = wid & 3, ch = wid >> 2;
  const int sr = tid >> 4, sc = (tid & 15) * 8;
  const int rowbase = ch ? rowB : rowA;
  { bf16x8 kv[8], vv[8];
#pragma unroll
    for (int c2 = 0; c2 < 2; ++c2)
#pragma unroll
      for (int g = 0; g < 4; ++g) { const bf16_t* rp = proj + (size_t)((c2 ? rowB : rowA) + 32 * g + sr) * DP + h * 128 + sc; kv[c2 * 4 + g] = ld8(rp + C_RK); vv[c2 * 4 + g] = ld8(rp + C_RV); }
#pragma unroll
    for (int c2 = 0; c2 < 2; ++c2)
#pragma unroll
      for (int g = 0; g < 4; ++g) { const int row = 32 * g + sr;
        *(LAS bf16x8*)(lds + c2 * 65536 + (row >> 6) * 16384 + KSWZ(row & 63, sc * 2)) = kv[c2 * 4 + g];
        *(LAS bf16x8*)(lds + c2 * 65536 + 32768 + (row >> 6) * 16384 + v_st(row & 63, sc)) = vv[c2 * 4 + g]; } }
  bf16x8 qr[8];
  const bf16_t* Qw = proj + (size_t)(rowbase + rg * 32 + r32) * DP + C_RQ + h * 128 + hi * 8;
#pragma unroll
  for (int d0 = 0; d0 < 8; ++d0) qr[d0] = ld8(Qw + d0 * 16);
  __syncthreads();
  const int m = rg * 32 + r32;
  LAS char* myreg = lds + ch * 65536;
  const int vb = (int)(uintptr_t)myreg + v_rd_base(lane);
  f32x16 o[4] = {}; f32x16 p0, p1; bf16x8 pa0, pa1, pa2, pa3;
#pragma unroll
  for (int kt = 0; kt < 2; ++kt) {
    qkt<8>(p0, p1, myreg + kt * 16384, qr, r32, hi, 0);
    int mm = m - 4 * hi; asm volatile("" : "+v"(mm));
#pragma unroll
    for (int r = 0; r < 16; ++r) { const int s0 = 64 * kt + (r & 3) + 8 * (r >> 2); p0[r] *= decay_w(s0 - mm, lgf2, lgb2); p1[r] *= decay_w(s0 + 32 - mm, lgf2, lgb2); }
    pack_p(p0, p1, pa0, pa1, pa2, pa3);
    pv_d0(o, vb + 32768 + kt * 16384, pa0, pa1, pa2, pa3);
  }
  __syncthreads();
  { bf16x8 sv[16];
#pragma unroll
    for (int c2 = 0; c2 < 2; ++c2)
#pragma unroll
      for (int d = 0; d < 2; ++d)
#pragma unroll
        for (int g = 0; g < 4; ++g) sv[(c2 * 2 + d) * 4 + g] = ld8((c2 ? spB : spA) + (size_t)d * dstride + (size_t)(32 * g + sr) * 128 + sc);
#pragma unroll
    for (int c2 = 0; c2 < 2; ++c2)
#pragma unroll
      for (int d = 0; d < 2; ++d)
#pragma unroll
        for (int g = 0; g < 4; ++g) { const int row = 32 * g + sr;
          *(LAS bf16x8*)(lds + c2 * 65536 + d * 32768 + (row >> 6) * 16384 + v_st(row & 63, sc)) = sv[(c2 * 2 + d) * 4 + g]; } }
  const float xf = __builtin_amdgcn_exp2f(lgf2 * (float)(m + 1)), xb = __builtin_amdgcn_exp2f(lgb2 * (float)(128 - m));
  __syncthreads();
#pragma unroll
  for (int d = 0; d < 2; ++d) { const float xs = d ? xb : xf;
#pragma unroll
    for (int sub = 0; sub < 2; ++sub) {
      const bf16x8 a0 = scale8(qr[4 * sub + 0], xs), a1 = scale8(qr[4 * sub + 1], xs), a2 = scale8(qr[4 * sub + 2], xs), a3 = scale8(qr[4 * sub + 3], xs);
      pv_d0(o, vb + d * 32768 + sub * 16384, a0, a1, a2, a3); } }
#pragma unroll
  for (int r = 0; r < 16; ++r) {
    float s = (o[0][r] + o[1][r]) + (o[2][r] + o[3][r]);
    s += __shfl_xor(s, 1); s += __shfl_xor(s, 2); s += __shfl_xor(s, 4); s += __shfl_xor(s, 8); s += __shfl_xor(s, 16);
    const float mu = s * (1.f / 128.f);
    float q = 0.f;
#pragma unroll
    for (int d0 = 0; d0 < 4; ++d0) { const float dd = o[d0][r] - mu; o[d0][r] = dd; q += dd * dd; }
    q += __shfl_xor(q, 1); q += __shfl_xor(q, 2); q += __shfl_xor(q, 4); q += __shfl_xor(q, 8); q += __shfl_xor(q, 16);
    const float rr = rsqrtf(q * (1.f / 128.f) + EPS);
    const size_t grow = (size_t)(rowbase + rg * 32 + crow(r, hi));
    const bf16_t* gp = proj + grow * DP + C_RG + h * 128 + r32; bf16_t* op = concat + grow * DM + h * 128 + r32;
#pragma unroll
    for (int d0 = 0; d0 < 4; ++d0) { const float gv = bf2f(gp[32 * d0]); op[32 * d0] = f2bf(o[d0][r] * rr * gn[32 * d0 + r32] * (gv * __builtin_amdgcn_rcpf(1.f + __builtin_amdgcn_exp2f(-1.4426950408889634f * gv)))); }
  }
  __syncthreads();
}

}


__device__ __forceinline__ float log2_sigmoid(float x) { return -log1pf(__expf(-x)) * 1.4426950408889634f; }
__device__ __forceinline__ bf16_t* cs_ptr(const Params& p, int b, int h, int dir, int j) { return (bf16_t*)(p.ws + WS_CS) + ((size_t)((b * NH + h) * 2 + dir) * 66 + j) * 16384; }
__device__ __forceinline__ void qkrope_phase(const Params& p, Ctx& F, int l) {
    const int lane = lane_id();
    float gq[8], gk[8], fr[8];
#pragma unroll
    for (int i = 0; i < 8; ++i) { gq[i] = p.in[I_QNG][l * 64 + 8 * (lane & 7) + i] * 0.18033688011112042f;
        gk[i] = p.in[I_KNG][l * 64 + 8 * (lane & 7) + i];
        fr[i] = exp2f(-(float)(8 * (lane & 1) + i) * (13.287712379549449f / 16.f)) * 0.15915494309189535f; }
    const bool lowhalf = (lane & 4) == 0;
    for (int m = F.gw; m < NR; m += F.NGW) {
        bf16_t* row = (bf16_t*)(p.ws + WS_PROJ) + (size_t)m * DP;
        v4u* qp = (v4u*)(row + C_DQ) + lane; const v4u* kp = (const v4u*)(row + C_DK) + lane;
        const v4u qv = *qp, kv = *kp, vv = *((const v4u*)(row + C_DV) + lane);
        float q[8], k[8];
#pragma unroll
        for (int i = 0; i < 4; ++i) { q[2 * i] = __uint_as_float(qv[i] << 16); q[2 * i + 1] = __uint_as_float(qv[i] & 0xffff0000u); k[2 * i] = __uint_as_float(kv[i] << 16); k[2 * i + 1] = __uint_as_float(kv[i] & 0xffff0000u); }
        float sq = 0.f, sk = 0.f;
#pragma unroll
        for (int i = 0; i < 8; ++i) { sq += q[i] * q[i]; sk += k[i] * k[i]; }
        sq += __shfl_xor(sq, 1); sq += __shfl_xor(sq, 2); sq += __shfl_xor(sq, 4);
        sk += __shfl_xor(sk, 1); sk += __shfl_xor(sk, 2); sk += __shfl_xor(sk, 4);
        const float rq = rsqrtf(sq * (1.f / 64.f) + EPS), rk = rsqrtf(sk * (1.f / 64.f) + EPS);
#pragma unroll
        for (int i = 0; i < 8; ++i) { q[i] *= rq * gq[i]; k[i] *= rk * gk[i]; }
        if (m < NL) {
            const int t = m % T; const float pos = (float)((lane & 2) ? (t % 64) : (t / 64));
#pragma unroll
            for (int i = 0; i < 8; ++i) {
                const float rev = pos * fr[i]; const float cs = __builtin_amdgcn_cosf(rev), sn = __builtin_amdgcn_sinf(rev);
                const float oq = __shfl_xor(q[i], 4), ok = __shfl_xor(k[i], 4);
                q[i] = lowhalf ? q[i] * cs - oq * sn : q[i] * cs + oq * sn;
                k[i] = lowhalf ? k[i] * cs - ok * sn : k[i] * cs + ok * sn;
            }
        }
        v4u qo, ko;
#pragma unroll
        for (int i = 0; i < 4; ++i) { qo[i] = pk2(q[2 * i], q[2 * i + 1]); ko[i] = pk2(k[2 * i], k[2 * i + 1]); }
        *qp = qo;
        { const int bb = m < NL ? m / T : (m - NL) / TC, kidx = m < NL ? TC + (m % T) : (m - NL) % TC, tile = kidx >> 6, r = kidx & 63, hh = lane >> 4, ci = lane & 15;
          const size_t blk = ((size_t)(bb * NH + hh) * 132 + tile) * 16384;
          *(v4u*)(p.ws + WS_KT + blk + KSWZ(r, 16 * ci)) = ko;
#if FAST_ATT
          *(v4u*)(p.ws + WS_VT + blk + att::v_st_lin(r, 8 * ci)) = vv; }
#else
          *(v4u*)(p.ws + WS_VT + blk + att::v_st(r, 8 * ci)) = vv; }
#endif
    }
}
__device__ __forceinline__ void scan_phase(const Params& p, Ctx& F, int l) {
    const int lane_ = lane_id(), tid_ = F.wave * 64 + lane_;
    unsigned* cs = (unsigned*)(p.ws + WS_CS);
    for (int i = blockIdx.x * (NWAVES * 64) + tid_; i < 16 * 8192; i += F.G * NWAVES * 64) {
        const int combo = i >> 13, e2 = i & 8191, dir = combo & 1, h = (combo >> 1) & 3;
        const float lg2 = log2_sigmoid(dir ? p.in[I_DECB][l * NH + h] : p.in[I_DECF][l * NH + h]);
        const float decay = exp2f(lg2 * 128.f);
        unsigned* base = cs + (size_t)combo * 66 * 8192 + e2;
        float s0 = 0.f, s1 = 0.f;
#pragma unroll 1
        for (int jj = 0; jj < 66; jj += 22) {
            unsigned tv[22];
#pragma unroll
            for (int k = 0; k < 22; ++k) { const int q = jj + k, idx = dir ? (q < 2 ? 1 - q : 67 - q) : q; tv[k] = base[(size_t)idx * 8192]; }
#pragma unroll
            for (int k = 0; k < 22; ++k) { const int q = jj + k, idx = dir ? (q < 2 ? 1 - q : 67 - q) : q;
                base[(size_t)idx * 8192] = pk2(s0, s1);
                s0 = decay * s0 + __uint_as_float(tv[k] << 16); s1 = decay * s1 + __uint_as_float(tv[k] & 0xffff0000u); }
        }
    }
}

#define IN(k) (lo <= (k) && (k) < hi)
#define SEAM(k) do { if (IN(k) && IN((k) + 1)) xcd_barrier(bar, F.wave == 0 && lane_id() == 0); } while (0)
#ifndef REP_ATT
#define REP_ATT 1
#endif
#ifndef REP_RET
#define REP_RET 1
#endif
#ifndef REP_B
#define REP_B 1
#endif
#ifndef REP_H0
#define REP_H0 1
#endif
#ifndef REP_H1
#define REP_H1 1
#endif
#ifndef REP_I1
#define REP_I1 1
#endif
#ifndef REP_P0
#define REP_P0 1
#endif
#ifndef REP_CS
#define REP_CS 1
#endif
#ifndef REP_A
#define REP_A 1
#endif
#ifndef REP_I0
#define REP_I0 1
#endif
#ifndef REP_F0
#define REP_F0 1
#endif
#ifndef REP_G2
#define REP_G2 1
#endif
#ifndef REP_BAR
#define REP_BAR 0
#endif
template <int l>
__device__ __forceinline__ void layer_phases(const Params& p, Ctx& F, const XcdBarrier& bar, const int lo, const int hi) {
    constexpr int base = 1 + 9 * l;

        if (IN(base + 0)) { for (int rep_ = 0; rep_ < REP_A; ++rep_) norm_phase(p, F, l, 0, NR); for (int rep_ = 0; rep_ < REP_BAR; ++rep_) xcd_barrier(bar, F.wave == 0 && lane_id() == 0); SEAM(base + 0); }
        if (IN(base + 1)) {
            pg8::Gemm g{(const bf16_t*)(p.ws + WS_HBUF), (const bf16_t*)(p.ws + W_WIN) + (size_t)l * DP * DM, NR, DP, DM, DM};
            pg8::Order S; S.init(NR / 256, DP / 256, F.G, (int)blockIdx.x);
            pg8::EpiProj E{(bf16_t*)(p.ws + WS_PROJ)};
            { pg8::gemm_phase<pg8::EpiProj, pg8::Order, true, true>(F.lds + RING_OFF, g, S, E, F.wave); if (REP_B > 1) { pg8::gemm_phase<pg8::EpiProj, pg8::Order, true, true>(F.lds + RING_OFF, g, S, E, F.wave); } }
            SEAM(base + 1);
        }
        if (IN(base + 2)) {
            qkrope_phase(p, F, l);
            for (int rep_ = 0; rep_ < REP_CS; ++rep_)
            for (int u = blockIdx.x; u < 8 * 66; u += F.G) {
                const int bh = u & 7, j = u >> 3, b = bh >> 2, h = bh & 3;
                const int rowbase = j < 2 ? NL + b * TC + 128 * j : b * T + 128 * (j - 2);
                att::chunk_state_unit(F.wave, (const bf16_t*)(p.ws + WS_PROJ), cs_ptr(p, b, h, 0, j), cs_ptr(p, b, h, 1, j), rowbase, h,
                                      log2_sigmoid(p.in[I_DECF][l * NH + h]), log2_sigmoid(p.in[I_DECB][l * NH + h]), (LAS char*)(F.lds + RING_OFF));
            }
            SEAM(base + 2);
        }
        if (IN(base + 3)) { scan_phase(p, F, l); SEAM(base + 3); }
        if (IN(base + 4)) {
#if FAST_RET
            for (int rep_ = 0; rep_ < REP_RET; ++rep_)
            for (int u = blockIdx.x; u < (l == 0 ? 8 * 33 : 8 * 32); u += F.G) {
                const int bh = u & 7, jp = (u >> 3) + (l == 0 ? 0 : 1), b = bh >> 2, h = bh & 3;
                const int rowA = jp == 0 ? NL + b * TC : b * T + 128 * (2 * jp - 2);
                att::ret_out_unit(F.wave, (const bf16_t*)(p.ws + WS_PROJ), (bf16_t*)(p.ws + WS_CONCAT), cs_ptr(p, b, h, 0, 2 * jp), cs_ptr(p, b, h, 0, 2 * jp + 1), (size_t)66 * 16384,
                                  rowA, rowA + 128, h, log2_sigmoid(p.in[I_DECF][l * NH + h]), log2_sigmoid(p.in[I_DECB][l * NH + h]), p.in[I_GNG] + l * 512 + h * 128, (LAS char*)(F.lds + RING_OFF));
            }
#endif
#if FAST_ATT
            { const int lane_ = lane_id();
              const float s1 = wave_sum(p.in[I_LQ1][l * 64 + lane_] * p.in[I_LK1][l * 64 + lane_]), s2 = wave_sum(p.in[I_LQ2][l * 64 + lane_] * p.in[I_LK2][l * 64 + lane_]);
              const float li = lam_init_of(l), lam = __expf(s1) - __expf(s2) + li;
#if ATT_V3
              constexpr int nunits = 256 + (l == 0 ? 8 : 0);
              for (int rep_ = 0; rep_ < REP_ATT; ++rep_)
              for (int u = blockIdx.x; u < nunits; u += F.G) {
                  int b, h, qrow0, NT;
                  if (u < 256) { const int bh = u & 7, qb = u >> 3; b = bh >> 2; h = bh & 3; qrow0 = b * T + qb * 256; NT = (TC + T) / 64; }
                  else { const int bh = u - 256; b = bh >> 2; h = bh & 3; qrow0 = NL + b * TC; NT = TC / 64; }
                  att::attn_unit3p(F.wave, (const bf16_t*)(p.ws + WS_PROJ), (const char*)(p.ws + WS_KT) + (size_t)(b * NH + h) * 132 * 16384, (const char*)(p.ws + WS_VT) + (size_t)(b * NH + h) * 132 * 16384, (bf16_t*)(p.ws + WS_CONCAT), qrow0, NT, h, (LAS char*)(F.lds + RING_OFF), lam, 1.f - li, p.in[I_SUBLN] + l * 128);
              }
#else
              constexpr int nunits = 512 + (l == 0 ? 16 : 0);
              for (int rep_ = 0; rep_ < REP_ATT; ++rep_)
              for (int u = blockIdx.x; u < nunits; u += F.G) {
                  int b, h, qrow0, NT;
                  if (u < 512) { const int bh = u & 7, qb = u >> 3; b = bh >> 2; h = bh & 3; qrow0 = b * T + qb * 128; NT = (TC + T) / 64; }
                  else { const int v = u - 512, bh = v & 7, blk = v >> 3; b = bh >> 2; h = bh & 3; qrow0 = NL + b * TC + blk * 128; NT = TC / 64; }
                  att::attn_unit(F.wave, (const bf16_t*)(p.ws + WS_PROJ), (const char*)(p.ws + WS_KT) + (size_t)(b * NH + h) * 132 * 16384, (const char*)(p.ws + WS_VT) + (size_t)(b * NH + h) * 132 * 16384, (bf16_t*)(p.ws + WS_CONCAT), qrow0, NT, h, (LAS char*)(F.lds + RING_OFF), lam, 1.f - li, p.in[I_SUBLN] + l * 128);
              }
#endif
            }
#endif
            SEAM(base + 4);
        }
        if (IN(base + 5)) {
            pg8::Gemm g{(const bf16_t*)(p.ws + WS_CONCAT), (const bf16_t*)(p.ws + W_WOUT) + (size_t)l * DM * DM, NR, DM, DM, DM};
            pg8::Order S; S.init(NL / 256, DM / 256, F.G, (int)blockIdx.x);
            pg8::EpiResid E{l == 0 ? p.in[I_X] : p.out, l == 0 ? p.in[I_CTX] : (const float*)(p.ws + WS_XRC), p.out, (float*)(p.ws + WS_XRC), modv(p, l, 0, 2), modv(p, l, 2, 2)};
            if (REP_F0 > 1 && l == 0) { pg8::gemm_phase<pg8::EpiResid, pg8::Order, true, true>(F.lds + RING_OFF, g, S, E, F.wave); }
            pg8::gemm_phase<pg8::EpiResid, pg8::Order, true, true>(F.lds + RING_OFF, g, S, E, F.wave);
            if constexpr (l == 0) {
                pg8::Gemm g2{(const bf16_t*)(p.ws + WS_CONCAT), (const bf16_t*)(p.ws + W_WOUT), NR, DM, 256, DM};
                pg8::SplitOrder S2; S2.init(NL / 256, 2, DM / 256, DM / 256, F.G, (int)blockIdx.x);
                pg8::EpiPartial E2{(float*)(p.ws + WS_PART), NL / 256, NC};
                pg8::gemm_phase<pg8::EpiPartial, pg8::SplitOrder, true, true>(F.lds + RING_OFF, g2, S2, E2, F.wave);
            }
            SEAM(base + 5);
        }
        if (IN(base + 6)) { if constexpr (l == 0) norm_phase(p, F, 0, 1, NR); else router_phase(p, F); SEAM(base + 6); }
        if constexpr (l == 0) {
            if (IN(8)) {
                pg8::Gemm g{(const bf16_t*)(p.ws + WS_HBUF), (const bf16_t*)(p.ws + W_FGU), NR, 2 * DFF, DM, DM};
                pg8::Order S; S.init(NR / 256, 2 * DFF / 256, F.G, (int)blockIdx.x);
                pg8::EpiSwiglu E{(bf16_t*)(p.ws + WS_ACT)};
                { pg8::gemm_phase<pg8::EpiSwiglu, pg8::Order, true, true>(F.lds + RING_OFF, g, S, E, F.wave); if (REP_H0 > 1) { pg8::gemm_phase<pg8::EpiSwiglu, pg8::Order, true, true>(F.lds + RING_OFF, g, S, E, F.wave); } }
                SEAM(8);
            }
            if (IN(9)) {
                pg8::Gemm g{(const bf16_t*)(p.ws + WS_ACT), (const bf16_t*)(p.ws + W_FD), NR, DM, DFF, DFF};
                pg8::Order S; S.init(NL / 256, DM / 256, F.G, (int)blockIdx.x);
                pg8::EpiResid E{p.out, (const float*)(p.ws + WS_XRC), p.out, (float*)(p.ws + WS_XRC), modv(p, 0, 0, 5), modv(p, 0, 2, 5)};
                if (REP_I0 > 1) { pg8::EpiResid Ed{p.out, (const float*)(p.ws + WS_XRC), (float*)(p.ws + WS_H2S), (float*)(p.ws + WS_H2S) + (size_t)NL * DM, modv(p, 0, 0, 5), modv(p, 0, 2, 5)}; pg8::gemm_phase<pg8::EpiResid, pg8::Order, true, true>(F.lds + RING_OFF, g, S, Ed, F.wave); }
                pg8::gemm_phase<pg8::EpiResid, pg8::Order, true, true>(F.lds + RING_OFF, g, S, E, F.wave);
                {
                    pg8::Gemm g2{(const bf16_t*)(p.ws + WS_ACT), (const bf16_t*)(p.ws + W_FD), NR, DM, 256, DFF};
                    pg8::SplitOrder S2; S2.init(NL / 256, 2, DM / 256, DFF / 256, F.G, (int)blockIdx.x);
                    pg8::EpiPartial E2{(float*)(p.ws + WS_PART), NL / 256, NC};
                    pg8::gemm_phase<pg8::EpiPartial, pg8::SplitOrder, true, true>(F.lds + RING_OFF, g2, S2, E2, F.wave);
                }
                SEAM(9);
            }
        } else {
            if (IN(17)) { for (int rep_ = 0; rep_ < REP_G2; ++rep_) gather_phase(p, F); SEAM(17); }
            if (IN(18)) {
                moe_table(F);
                pg8::Gemm g{(const bf16_t*)(p.ws + WS_H2S), (const bf16_t*)(p.ws + W_MGU), MP_MAX, 2 * DFF, DM / 2, DM / 2};
                pg8::Order S; moe_order(F, S, 2 * DFF / 256, (long)2 * DFF * DM);
                pg8::EpiSwiglu8 E{(unsigned char*)(p.ws + WS_ACTS)};
                { pg8::gemm_phase<pg8::EpiSwiglu8, pg8::Order, true, true, true>(F.lds + RING_OFF, g, S, E, F.wave); if (REP_H1 > 1) { pg8::gemm_phase<pg8::EpiSwiglu8, pg8::Order, true, true, true>(F.lds + RING_OFF, g, S, E, F.wave); } }
                SEAM(18);
            }
            if (IN(19)) {
                moe_table(F);
                pg8::Gemm g{(const bf16_t*)(p.ws + WS_ACTS), (const bf16_t*)(p.ws + W_MD), MP_MAX, DM, DFF / 2, DFF / 2};
                pg8::Order S; moe_order(F, S, DM / 256, (long)DM * DFF);
                pg8::EpiMoeDown E{(bf16_t*)(p.ws + WS_YBUF), (const float*)(p.ws + WS_ROUTE) + 6 * NL + MP_MAX, 1.f / (W8_SCALE * A8_SCALE)};
                { pg8::gemm_phase<pg8::EpiMoeDown, pg8::Order, true, true, true>(F.lds + RING_OFF, g, S, E, F.wave); if (REP_I1 > 1) { pg8::gemm_phase<pg8::EpiMoeDown, pg8::Order, true, true, true>(F.lds + RING_OFF, g, S, E, F.wave); } }
                SEAM(19);
            }
            if (IN(20)) { combine_phase(p, F); }
        }
}
struct MArgs { Params p; int ph_lo, ph_hi, li, pad; };
constexpr int N_PHASES = 21;
__global__ void __launch_bounds__(NWAVES * 64, 2) mega(MArgs args) {
    extern __shared__ __attribute__((aligned(16))) unsigned char lds_raw[];
    const Params& p = args.p;
    Ctx F;
    F.lds = (LAS unsigned char*)lds_raw; F.MISC = (volatile LAS unsigned*)(F.lds + MISC_OFF);
    F.wave = __builtin_amdgcn_readfirstlane((int)threadIdx.x >> 6);
    const int lane_ = lane_id(), tid_ = F.wave * 64 + lane_;
    F.G = gridDim.x; F.gw = blockIdx.x * NWAVES + F.wave; F.NGW = F.G * NWAVES;
    F.ctl = (unsigned*)(p.ws + WS_CTL);
    for (int u = tid_; u < (LDS_BYTES - MISC_OFF) / 4; u += NWAVES * 64) ((LAS unsigned*)(F.lds + MISC_OFF))[u] = 0u;
    __syncthreads();
    XcdBarrier bar = xcd_barrier_post(F.ctl + CW_BAR + args.li * XCD_BAR_WORDS, F.MISC + 8, tid_ == 0);
    const int lo = args.ph_lo, hi = args.ph_hi;

    if (IN(0)) { for (int rep_ = 0; rep_ < REP_P0; ++rep_) { if (rep_) __syncthreads(); p0_prologue(p, F); } SEAM(0); }
    layer_phases<0>(p, F, bar, lo, hi);
    layer_phases<1>(p, F, bar, lo, hi);
#undef IN
#undef SEAM
}

#ifndef FAST_MASK
#define FAST_MASK 0x1u
#endif
static void launch_naive_e(const Params& p, int l, bool ret, bool att, hipStream_t stream) {
    const int nrows_mix = l == 0 ? NR : NL;
    if (ret) k_ret_naive<<<nrows_mix * NH / 4, 256, 0, stream>>>(p, l, nrows_mix);
    if (att) k_attn_naive<<<nrows_mix * NH / 4, 256, 0, stream>>>(p, l, nrows_mix);
}
static void launch_naive(const Params& p, int ph, hipStream_t stream) {
    const int l = ph >= 10 ? 1 : 0, rel = ph == 0 ? -1 : (ph - 1 - 9 * l);
    const int nrows_mix = l == 0 ? NR : NL;
    if (ph == 0) { k_mod<<<(2 * 3 * 6144 + 255) / 256, 256, 0, stream>>>(p); return; }
    switch (rel) {
    case 0: k_norm<<<NR / 4, 256, 0, stream>>>(p, l, 0, NR); break;
    case 1: k_gemm_proj<<<dim3(DP / 64, NR / 4), dim3(64, 4), 0, stream>>>(p, l); break;
    case 2: k_qkrope<<<NR / 4, 256, 0, stream>>>(p, l); break;
    case 3: break;
    case 4: launch_naive_e(p, l, true, true, stream); break;
    case 5: k_gemm_out<<<dim3(DM / 64, nrows_mix / 4), dim3(64, 4), 0, stream>>>(p, l); break;
    case 6: k_norm<<<nrows_mix / 4, 256, 0, stream>>>(p, l, 1, nrows_mix); break;
    case 7: if (l == 0) k_ffn_gu<<<dim3(DFF / 64, NR / 4), dim3(64, 4), 0, stream>>>(p); break;
    case 8: if (l == 0) k_ffn_down<<<dim3(DM / 64, NR / 4), dim3(64, 4), 0, stream>>>(p); else k_moe_gu<<<dim3(DFF / 64, 2 * NL / 4), dim3(64, 4), 0, stream>>>(p); break;
    case 9: k_moe_down<<<dim3(DM / 64, NL / 4), dim3(64, 4), 0, stream>>>(p); break;
    default: break;
    }
}
extern "C" void kernel_launch(void* const* d_in, const int* in_sizes, int n_in, void* d_out, int out_size, void* d_ws, size_t ws_size, hipStream_t stream) {
    static int grid = 0;
    if (grid == 0) {
        if (n_in != 28 || out_size != NL * DM || ws_size < WS_END) { fprintf(stderr, "kernel_launch: unexpected shapes (n_in %d out %d ws %zu need %zu)\n", n_in, out_size, ws_size, (size_t)WS_END); grid = -1; return; }
        int dev = 0, cus = 0, per_cu = 0;
        if (hipGetDevice(&dev) != hipSuccess || hipDeviceGetAttribute(&cus, hipDeviceAttributeMultiprocessorCount, dev) != hipSuccess) { grid = -1; return; }
        if (hipFuncSetAttribute((const void*)mega, hipFuncAttributeMaxDynamicSharedMemorySize, LDS_BYTES) != hipSuccess) { fprintf(stderr, "kernel_launch: hipFuncSetAttribute failed\n"); grid = -1; return; }
        if (hipOccupancyMaxActiveBlocksPerMultiprocessor(&per_cu, (const void*)mega, NWAVES * 64, LDS_BYTES) != hipSuccess || per_cu < 1) { fprintf(stderr, "kernel_launch: occupancy query says %d\n", per_cu); (void)hipGetLastError(); grid = -1; return; }
        grid = cus;
    }
    if (grid < 0) return;
    (void)hipMemsetAsync((char*)d_ws + WS_CTL, 0, CTL_ZERO_BYTES, stream);
    MArgs a{};
    for (int i = 0; i < 28; ++i) a.p.in[i] = (const float*)d_in[i];
    a.p.out = (float*)d_out; a.p.ws = (unsigned char*)d_ws;
    const unsigned mask = FAST_MASK;
    int li = 0, ph = 0;
    while (ph < N_PHASES) {
        if ((mask >> ph) & 1u) { int e = ph; bool cutE = false;
            while (e < N_PHASES && ((mask >> e) & 1u)) { const bool isE = (e == 5 || e == 14); ++e; if (isE && !(FAST_ATT && FAST_RET)) { cutE = true; break; } }
            a.ph_lo = ph; a.ph_hi = e; a.li = li++;
            hipLaunchKernelGGL(mega, dim3(grid), dim3(NWAVES * 64), LDS_BYTES, stream, a);
            if (cutE) launch_naive_e(a.p, e - 1 == 5 ? 0 : 1, !FAST_RET, !FAST_ATT, stream);
            ph = e; }
        else { launch_naive(a.p, ph, stream); ++ph; }
    }
}
```

```cpp
#include <hip/hip_runtime.h>
#include <cstdint>
#include <cstdio>
#define FAST_MASK 0x1fffffu
#define FAST_ATT 1
#define FAST_RET 1

constexpr int NB = 2, T = 8192, DM = 1024, TC = 256;
constexpr int NL = NB * T;
constexpr int NC = NB * TC;
constexpr int NR = NL + NC;
constexpr int DP = 3584, DFF = 2816, NE = 8, NH = 4;
constexpr float EPS = 1e-6f;
constexpr int C_RQ = 0, C_RK = 512, C_RV = 1024, C_RG = 1536, C_DQ = 2048, C_DK = 2560, C_DV = 3072;
constexpr int MP_MAX = 2 * NL + NE * 256;

typedef unsigned short bf16_t;
__device__ __forceinline__ float bf2f(bf16_t v) { return __uint_as_float(((unsigned)v) << 16); }
__device__ __forceinline__ bf16_t f2bf(float f) { unsigned u = __float_as_uint(f); u += 0x7fffu + ((u >> 16) & 1u); return (bf16_t)(u >> 16); }
typedef float f32x2_t __attribute__((ext_vector_type(2)));
typedef __bf16 bf16x2_t __attribute__((ext_vector_type(2)));
__device__ __forceinline__ unsigned pk2(float lo, float hi) { const f32x2_t v = {lo, hi}; const bf16x2_t b = __builtin_convertvector(v, bf16x2_t); return __builtin_bit_cast(unsigned, b); }
__device__ __forceinline__ unsigned pk4_fp8(float a, float b, float c, float d) {
    a = __builtin_amdgcn_fmed3f(a, -448.f, 448.f); b = __builtin_amdgcn_fmed3f(b, -448.f, 448.f); c = __builtin_amdgcn_fmed3f(c, -448.f, 448.f); d = __builtin_amdgcn_fmed3f(d, -448.f, 448.f);
    int r = 0; r = __builtin_amdgcn_cvt_pk_fp8_f32(a, b, r, false); r = __builtin_amdgcn_cvt_pk_fp8_f32(c, d, r, true); return (unsigned)r;
}
constexpr float W8_SCALE = 64.f, A8_SCALE = 8.f;
__device__ __forceinline__ float wave_sum(float v) {
#pragma unroll
    for (int o = 1; o < 64; o <<= 1) v += __shfl_xor(v, o);
    return v;
}
__device__ __forceinline__ int lane_id() { int l = (int)__builtin_amdgcn_mbcnt_hi(~0u, __builtin_amdgcn_mbcnt_lo(~0u, 0u)); asm volatile("" : "+v"(l)); return l; }
__device__ __forceinline__ float siluf(float v) { return v / (1.f + __expf(-v)); }

constexpr size_t MiB = 1u << 20;
constexpr size_t WS_CTL = 0, CTL_ZERO_BYTES = 1 * MiB;
constexpr size_t WS_MODV = 1 * MiB;
constexpr size_t WS_ROUTE = 2 * MiB;
constexpr size_t WS_XRC = 3 * MiB;
constexpr size_t WS_W = 6 * MiB;
constexpr size_t W_WIN = WS_W;
constexpr size_t W_WOUT = W_WIN + (size_t)2 * DP * DM * 2;
constexpr size_t W_FGU = W_WOUT + (size_t)2 * DM * DM * 2;
constexpr size_t W_FD = W_FGU + (size_t)2 * DFF * DM * 2;
constexpr size_t W_MGU = W_FD + (size_t)DM * DFF * 2;
constexpr size_t W_MD = W_MGU + (size_t)NE * 2 * DFF * DM * 2;
constexpr size_t W_END = W_MD + (size_t)NE * DM * DFF * 2;
constexpr size_t WS_HBUF = 173 * MiB;
constexpr size_t WS_PROJ = 206 * MiB;
constexpr size_t WS_CONCAT = 322 * MiB;
constexpr size_t WS_ACT = 206 * MiB;
constexpr size_t WS_ACTS = 173 * MiB;
constexpr size_t WS_H2S = 361 * MiB;
constexpr size_t WS_KT = 394 * MiB, WS_VT = WS_KT + (size_t)NB * NH * 132 * 16384;
static_assert(WS_VT + (size_t)NB * NH * 132 * 16384 <= 429 * MiB && WS_H2S + (size_t)NB * NH * 2 * 66 * 32768 <= WS_KT, "K/V tile images");
constexpr size_t WS_YBUF = WS_H2S, WS_CS = WS_H2S, WS_PART = WS_H2S;
constexpr size_t WS_END = 430 * MiB;
static_assert(W_END <= WS_HBUF && WS_ACTS + (size_t)MP_MAX * DFF * 2 <= WS_H2S && WS_H2S + (size_t)MP_MAX * DM * 2 <= WS_END && WS_ACT + (size_t)2 * NL * DFF * 2 <= WS_END, "ws map");
constexpr int CW_BAR = 4096;
constexpr int CW_CNT = 200000;

struct Params {
    const float* in[28];
    float* out;
    unsigned char* ws;
};
enum { I_X = 0, I_C, I_CTX, I_CCTX, I_ADAW, I_ADAB, I_N1G, I_N2G, I_WIN, I_DECF, I_DECB, I_GNG, I_QNG, I_KNG, I_LQ1, I_LK1, I_LQ2, I_LK2, I_SUBLN, I_WOUT,
       I_FWG, I_FWU, I_FWD, I_RW, I_RB, I_MWG, I_MWU, I_MWD };

__device__ __forceinline__ int rowtype(int m) { return m < NL ? m / T : 2; }
__device__ __forceinline__ const float* modv(const Params& p, int l, int rt, int i) { return (const float*)(p.ws + WS_MODV) + ((size_t)(l * 3 + rt) * 6 + i) * DM; }
__device__ __forceinline__ float* xr_row(const Params& p, int m) { return m < NL ? p.out + (size_t)m * DM : (float*)(p.ws + WS_XRC) + (size_t)(m - NL) * DM; }
__device__ __forceinline__ float lam_init_of(int l) { return l == 0 ? 0.2f : (0.8f - 0.6f * 0.74081822068171788f); }

#ifndef FAST_ATT
#define FAST_ATT 0
#endif
#ifndef FAST_RET
#define FAST_RET 0
#endif
#ifndef ATT_V3
#define ATT_V3 1
#endif
__global__ void k_mod(Params p) {
    const int idx = blockIdx.x * blockDim.x + threadIdx.x;
    if (idx >= 2 * 3 * 6144) return;
    const int n = idx % 6144, rt = (idx / 6144) % 3, l = idx / (6144 * 3);
    const float* cv = rt < 2 ? p.in[I_C] + rt * DM : p.in[I_CCTX];
    const float* W = p.in[I_ADAW] + (size_t)l * DM * 6144;
    float acc = 0.f;
    for (int k = 0; k < DM; ++k) acc += siluf(cv[k]) * W[(size_t)k * 6144 + n];
    ((float*)(p.ws + WS_MODV))[(size_t)(l * 3 + rt) * 6144 + n] = acc + p.in[I_ADAB][l * 6144 + n];
}

__global__ void k_norm(Params p, int l, int which, int nrows) {
    const int m = blockIdx.x * (blockDim.x / 64) + (threadIdx.x >> 6), lane = threadIdx.x & 63;
    if (m >= nrows) return;
    const float* xrow;
    if (l == 0 && which == 0) xrow = m < NL ? p.in[I_X] + (size_t)m * DM : p.in[I_CTX] + (size_t)(m - NL) * DM;
    else xrow = xr_row(p, m);
    const int rt = rowtype(m);
    const float* g = p.in[which ? I_N2G : I_N1G] + l * DM;
    const float* sh = modv(p, l, rt, which ? 3 : 0);
    const float* sc = modv(p, l, rt, which ? 4 : 1);
    float v[16]; float ss = 0.f;
#pragma unroll
    for (int j = 0; j < 4; ++j) { const float4 t = *(const float4*)(xrow + 256 * j + 4 * lane); v[4 * j] = t.x; v[4 * j + 1] = t.y; v[4 * j + 2] = t.z; v[4 * j + 3] = t.w; ss += t.x * t.x + t.y * t.y + t.z * t.z + t.w * t.w; }
    const float r = rsqrtf(wave_sum(ss) * (1.f / DM) + EPS);
    bf16_t* hb = (bf16_t*)(p.ws + WS_HBUF) + (size_t)m * DM;
#pragma unroll
    for (int j = 0; j < 4; ++j)
#pragma unroll
        for (int q = 0; q < 4; ++q) { const int col = 256 * j + 4 * lane + q; const float y = v[4 * j + q] * r * g[col]; v[4 * j + q] = y * (1.f + sc[col]) + sh[col]; hb[col] = f2bf(v[4 * j + q]); }
    if (l == 1 && which == 1) {
        const float* rw = p.in[I_RW]; float lg[8];
#pragma unroll
        for (int e = 0; e < 8; ++e) { float a = 0.f;
#pragma unroll
            for (int j = 0; j < 4; ++j)
#pragma unroll
                for (int q = 0; q < 4; ++q) a += v[4 * j + q] * rw[(size_t)(256 * j + 4 * lane + q) * 8 + e];
            lg[e] = wave_sum(a) + p.in[I_RB][e]; }
        int i1 = 0; float v1 = lg[0];
#pragma unroll
        for (int e = 1; e < 8; ++e) if (lg[e] > v1) { v1 = lg[e]; i1 = e; }
        int i2 = -1; float v2 = -3.4e38f;
#pragma unroll
        for (int e = 0; e < 8; ++e) if (e != i1 && lg[e] > v2) { v2 = lg[e]; i2 = e; }
        const float w1 = 1.f / (1.f + __expf(v2 - v1));
        if (lane == 0) { int* te = (int*)(p.ws + WS_ROUTE); float* tw = (float*)(p.ws + WS_ROUTE) + 2 * NL; te[2 * m] = i1; te[2 * m + 1] = i2; tw[2 * m] = w1; tw[2 * m + 1] = 1.f - w1; }
    }
}

__global__ void k_gemm_proj(Params p, int l) {
    const int n = blockIdx.x * 64 + threadIdx.x, m = blockIdx.y * 4 + threadIdx.y;
    const bf16_t* a = (const bf16_t*)(p.ws + WS_HBUF) + (size_t)m * DM;
    const float* W = p.in[I_WIN] + (size_t)l * DM * DP + n;
    float acc = 0.f;
#pragma unroll 8
    for (int k = 0; k < DM; ++k) acc += bf2f(a[k]) * W[(size_t)k * DP];
    if (n >= C_RK && n < C_RV) acc *= 0.08838834764831845f;
    ((bf16_t*)(p.ws + WS_PROJ))[(size_t)m * DP + n] = f2bf(acc);
}

__global__ void k_qkrope(Params p, int l) {
    const int m = blockIdx.x * (blockDim.x / 64) + (threadIdx.x >> 6), lane = threadIdx.x & 63;
    if (m >= NR) return;
    bf16_t* row = (bf16_t*)(p.ws + WS_PROJ) + (size_t)m * DP;
    const bool lat = m < NL; const int t = m % T;
    const int j = lane & 31; const float pos = (float)((j < 16) ? (t / 64) : (t % 64));
    const float inv_freq = exp2f(-(float)(j & 15) * (13.287712379549449f / 16.f));
    const float ang = pos * inv_freq; const float cs = __cosf(ang), sn = __sinf(ang);
    for (int part = 0; part < 2; ++part) {
        const float* g = p.in[part ? I_KNG : I_QNG] + l * 64;
        for (int hc = 0; hc < 8; ++hc) {
            bf16_t* q = row + (part ? C_DK : C_DQ) + hc * 64;
            const float v = bf2f(q[lane]);
            const float r = rsqrtf(wave_sum(v * v) * (1.f / 64.f) + EPS);
            float y = v * r * g[lane];
            if (lat) { const float o = __shfl_xor(y, 32); y = lane < 32 ? y * cs - o * sn : y * cs + o * sn; }
            if (part == 0) y *= 0.18033688011112042f;
            q[lane] = f2bf(y);
        }
    }
}

__global__ void k_ret_naive(Params p, int l, int nrows) {
    const int w = blockIdx.x * (blockDim.x / 64) + (threadIdx.x >> 6), lane = threadIdx.x & 63;
    if (w >= nrows * NH) return;
    const int m = w / NH, h = w % NH;
    const bf16_t* proj = (const bf16_t*)(p.ws + WS_PROJ);
    const float df = p.in[I_DECF][l * NH + h], db = p.in[I_DECB][l * NH + h];
    const float lgf = -log1pf(__expf(-df)), lgb = -log1pf(__expf(-db));
    const bf16_t* qrow = proj + (size_t)m * DP + C_RQ + h * 128 + 2 * lane;
    const float q0 = bf2f(qrow[0]), q1 = bf2f(qrow[1]);
    float o0 = 0.f, o1 = 0.f;
    if (m < NL) {
        const int b = m / T, t = m % T;
        for (int s = 0; s < T; ++s) {
            const bf16_t* kr = proj + (size_t)(b * T + s) * DP + h * 128 + 2 * lane;
            const float dot = wave_sum(q0 * bf2f(kr[C_RK]) + q1 * bf2f(kr[C_RK + 1]));
            const float wgt = s < t ? __expf(lgf * (float)(t - s)) : (s == t ? 2.f : __expf(lgb * (float)(s - t)));
            o0 += wgt * dot * bf2f(kr[C_RV]); o1 += wgt * dot * bf2f(kr[C_RV + 1]);
        }
        for (int i = 0; i < TC; ++i) {
            const bf16_t* kr = proj + (size_t)(NL + b * TC + i) * DP + h * 128 + 2 * lane;
            const float dot = wave_sum(q0 * bf2f(kr[C_RK]) + q1 * bf2f(kr[C_RK + 1]));
            const float wgt = __expf(lgf * (float)(t + TC - i)) + __expf(lgb * (float)(T - t + i));
            o0 += wgt * dot * bf2f(kr[C_RV]); o1 += wgt * dot * bf2f(kr[C_RV + 1]);
        }
    } else {
        const int b = (m - NL) / TC, t = (m - NL) % TC;
        for (int s = 0; s < TC; ++s) {
            const bf16_t* kr = proj + (size_t)(NL + b * TC + s) * DP + h * 128 + 2 * lane;
            const float dot = wave_sum(q0 * bf2f(kr[C_RK]) + q1 * bf2f(kr[C_RK + 1]));
            const float wgt = s < t ? __expf(lgf * (float)(t - s)) : (s == t ? 2.f : __expf(lgb * (float)(s - t)));
            o0 += wgt * dot * bf2f(kr[C_RV]); o1 += wgt * dot * bf2f(kr[C_RV + 1]);
        }
    }
    const float mu = wave_sum(o0 + o1) * (1.f / 128.f);
    const float d0 = o0 - mu, d1 = o1 - mu;
    const float r = rsqrtf(wave_sum(d0 * d0 + d1 * d1) * (1.f / 128.f) + EPS);
    const float* gn = p.in[I_GNG] + l * 512 + h * 128 + 2 * lane;
    const bf16_t* gr = proj + (size_t)m * DP + C_RG + h * 128 + 2 * lane;
    bf16_t* cc = (bf16_t*)(p.ws + WS_CONCAT) + (size_t)m * DM + h * 128 + 2 * lane;
    cc[0] = f2bf(siluf(bf2f(gr[0])) * d0 * r * gn[0]);
    cc[1] = f2bf(siluf(bf2f(gr[1])) * d1 * r * gn[1]);
}

__global__ void k_attn_naive(Params p, int l, int nrows) {
    const int w = blockIdx.x * (blockDim.x / 64) + (threadIdx.x >> 6), lane = threadIdx.x & 63;
    if (w >= nrows * NH) return;
    const int m = w / NH, h = w % NH;
    const bf16_t* proj = (const bf16_t*)(p.ws + WS_PROJ);
    const bool lat = m < NL; const int b = lat ? m / T : (m - NL) / TC;
    float O[2][2];
    for (int c = 0; c < 2; ++c) {
        const float q = bf2f(proj[(size_t)m * DP + C_DQ + h * 128 + c * 64 + lane]);
        float mx = -1e30f, ls = 0.f, o0 = 0.f, o1 = 0.f;
        const int nk = lat ? TC + T : TC;
        for (int s = 0; s < nk; ++s) {
            const int mk = s < TC ? NL + b * TC + s : b * T + (s - TC);
            const bf16_t* kr = proj + (size_t)mk * DP + h * 128;
            const float sc = wave_sum(q * bf2f(kr[C_DK + c * 64 + lane]));
            const float mn = fmaxf(mx, sc), al = exp2f(mx - mn), pp = exp2f(sc - mn);
            ls = ls * al + pp; o0 = o0 * al + pp * bf2f(kr[C_DV + 2 * lane]); o1 = o1 * al + pp * bf2f(kr[C_DV + 2 * lane + 1]); mx = mn;
        }
        O[c][0] = o0 / ls; O[c][1] = o1 / ls;
    }
    float s1 = 0.f, s2 = 0.f;
    { const float a = p.in[I_LQ1][l * 64 + lane] * p.in[I_LK1][l * 64 + lane], bq = p.in[I_LQ2][l * 64 + lane] * p.in[I_LK2][l * 64 + lane]; s1 = wave_sum(a); s2 = wave_sum(bq); }
    const float li = lam_init_of(l), lam = __expf(s1) - __expf(s2) + li;
    const float d0 = O[0][0] - lam * O[1][0], d1 = O[0][1] - lam * O[1][1];
    const float r = rsqrtf(wave_sum(d0 * d0 + d1 * d1) * (1.f / 128.f) + EPS);
    const float* sg = p.in[I_SUBLN] + l * 128 + 2 * lane;
    bf16_t* cc = (bf16_t*)(p.ws + WS_CONCAT) + (size_t)m * DM + 512 + h * 128 + 2 * lane;
    cc[0] = f2bf(d0 * r * sg[0] * (1.f - li)); cc[1] = f2bf(d1 * r * sg[1] * (1.f - li));
}

__global__ void k_gemm_out(Params p, int l) {
    const int n = blockIdx.x * 64 + threadIdx.x, m = blockIdx.y * 4 + threadIdx.y;
    const bf16_t* a = (const bf16_t*)(p.ws + WS_CONCAT) + (size_t)m * DM;
    const float* W = p.in[I_WOUT] + (size_t)l * DM * DM + n;
    float acc = 0.f;
#pragma unroll 8
    for (int k = 0; k < DM; ++k) acc += bf2f(a[k]) * W[(size_t)k * DM];
    const float xin = l == 0 ? (m < NL ? p.in[I_X][(size_t)m * DM + n] : p.in[I_CTX][(size_t)(m - NL) * DM + n]) : xr_row(p, m)[n];
    xr_row(p, m)[n] = xin + modv(p, l, rowtype(m), 2)[n] * acc;
}

__global__ void k_ffn_gu(Params p) {
    const int j = blockIdx.x * 64 + threadIdx.x, m = blockIdx.y * 4 + threadIdx.y;
    const bf16_t* a = (const bf16_t*)(p.ws + WS_HBUF) + (size_t)m * DM;
    const float* Wg = p.in[I_FWG] + j; const float* Wu = p.in[I_FWU] + j;
    float ag = 0.f, au = 0.f;
#pragma unroll 8
    for (int k = 0; k < DM; ++k) { const float x = bf2f(a[k]); ag += x * Wg[(size_t)k * DFF]; au += x * Wu[(size_t)k * DFF]; }
    ((bf16_t*)(p.ws + WS_ACT))[(size_t)m * DFF + j] = f2bf(siluf(ag) * au);
}
__global__ void k_ffn_down(Params p) {
    const int n = blockIdx.x * 64 + threadIdx.x, m = blockIdx.y * 4 + threadIdx.y;
    const bf16_t* a = (const bf16_t*)(p.ws + WS_ACT) + (size_t)m * DFF;
    const float* W = p.in[I_FWD] + n;
    float acc = 0.f;
#pragma unroll 8
    for (int k = 0; k < DFF; ++k) acc += bf2f(a[k]) * W[(size_t)k * DM];
    xr_row(p, m)[n] += modv(p, 0, rowtype(m), 5)[n] * acc;
}
__global__ void k_moe_gu(Params p) {
    const int j = blockIdx.x * 64 + threadIdx.x, ts = blockIdx.y * 4 + threadIdx.y;
    const int t = ts >> 1; const int e = ((const int*)(p.ws + WS_ROUTE))[ts];
    const bf16_t* a = (const bf16_t*)(p.ws + WS_HBUF) + (size_t)t * DM;
    const float* Wg = p.in[I_MWG] + (size_t)e * DM * DFF + j; const float* Wu = p.in[I_MWU] + (size_t)e * DM * DFF + j;
    float ag = 0.f, au = 0.f;
#pragma unroll 8
    for (int k = 0; k < DM; ++k) { const float x = bf2f(a[k]); ag += x * Wg[(size_t)k * DFF]; au += x * Wu[(size_t)k * DFF]; }
    ((bf16_t*)(p.ws + WS_ACT))[(size_t)ts * DFF + j] = f2bf(siluf(ag) * au);
}
__global__ void k_moe_down(Params p) {
    const int n = blockIdx.x * 64 + threadIdx.x, t = blockIdx.y * 4 + threadIdx.y;
    const int* te = (const int*)(p.ws + WS_ROUTE); const float* tw = (const float*)(p.ws + WS_ROUTE) + 2 * NL;
    float y = 0.f;
    for (int s = 0; s < 2; ++s) {
        const bf16_t* a = (const bf16_t*)(p.ws + WS_ACT) + (size_t)(2 * t + s) * DFF;
        const float* W = p.in[I_MWD] + (size_t)te[2 * t + s] * DFF * DM + n;
        float acc = 0.f;
#pragma unroll 8
        for (int k = 0; k < DFF; ++k) acc += bf2f(a[k]) * W[(size_t)k * DM];
        y += tw[2 * t + s] * acc;
    }
    p.out[(size_t)t * DM + n] += modv(p, 1, t / T, 5)[n] * y;
}


typedef unsigned v2u __attribute__((ext_vector_type(2)));
namespace pg8 {
#define PG8_LAS __attribute__((address_space(3)))
typedef unsigned short bf16_t;
typedef short bf16x8 __attribute__((ext_vector_type(8)));
typedef float f32x4 __attribute__((ext_vector_type(4)));
typedef unsigned u32x4 __attribute__((ext_vector_type(4)));
typedef int i32x4 __attribute__((ext_vector_type(4)));
typedef int i32x8 __attribute__((ext_vector_type(8)));
constexpr int BM = 256, BK = 64, HALF = 128, HTB = HALF * BK * 2  , STAGE_BYTES = 8 * HTB, NXCD = 8, WGM = 8;

__host__ __device__ __forceinline__ int lds_byte(int r, int c) { const int st = (r >> 4) * 2 + (c >> 5), rr = r & 15, cc = c & 31, ob = rr * 64 + cc * 2; return st * 1024 + (ob ^ (((ob >> 9) & 1) << 5)); }
__host__ __device__ __forceinline__ void stage_rc(int b, int& R, int& C) { const int st = b / 1024, sb = b % 1024, swz = sb ^ (((sb >> 9) & 1) << 5); R = (st >> 1) * 16 + swz / 64; C = (st & 1) * 32 + (swz % 64) / 2; }
__host__ __device__ __forceinline__ int perm32(int rho) { const int n = rho >> 4, i = rho & 15; return 8 * (i >> 2) + 4 * n + (i & 3); }

struct Unit { int pm, pn; long bofs, kofs; };
struct Gemm { const bf16_t* A; const bf16_t* Bt; int M, N, K, ld; };

struct Order {
    int nM, nN, nwg, G, c;
    int e1, e2, e3, e4, e5, e6, e7; long estride;
    __device__ __forceinline__ void init(int nM_, int nN_, int G_, int c_) { nM = nM_; nN = nN_; nwg = nM * nN; G = G_; c = c_; estride = 0; e1 = e2 = e3 = e4 = e5 = e6 = e7 = 0; }
    __device__ __forceinline__ bool next(int i, Unit& u) const {
        const long L = (long)i * G + c; if (L >= nwg) return false;
        int wgid = (int)L; { const int q = nwg / NXCD, r = nwg % NXCD, xcd = wgid % NXCD, off = wgid / NXCD; wgid = (xcd < r ? xcd * (q + 1) : r * (q + 1) + (xcd - r) * q) + off; }
        const int nig = WGM * nN, gid = wgid / nig, fm = gid * WGM, gsz = (nM - fm) < WGM ? (nM - fm) : WGM;
        u.pm = fm + ((wgid % nig) % gsz); u.pn = (wgid % nig) / gsz;
        const int e = (u.pm >= e1) + (u.pm >= e2) + (u.pm >= e3) + (u.pm >= e4) + (u.pm >= e5) + (u.pm >= e6) + (u.pm >= e7);
        u.bofs = estride ? (long)e * estride : 0; u.kofs = 0;
        return true;
    }
    __device__ __forceinline__ void a_ready(const Unit&) const {}
    __device__ __forceinline__ void done(const Unit&) const {}
};

struct SplitOrder {
    int nN, ns, nwg, G, c, pm0;
    __device__ __forceinline__ void init(int pm0_, int npan, int nN_, int ns_, int G_, int c_) { pm0 = pm0_; nN = nN_; ns = ns_; nwg = npan * nN * ns; G = G_; c = c_; }
    __device__ __forceinline__ bool next(int i, Unit& u) const {
        const int L = i * G + c; if (L >= nwg) return false;
        const int ks = L % ns, rest = L / ns; u.pn = rest % nN; u.pm = pm0 + rest / nN; u.bofs = 0; u.kofs = (long)ks * 256 * 2; return true;
    }
    __device__ __forceinline__ void a_ready(const Unit&) const {}
    __device__ __forceinline__ void done(const Unit&) const {}
};
__device__ __forceinline__ unsigned cvt_pk_bf16(float lo, float hi) { unsigned r; asm volatile("v_cvt_pk_bf16_f32 %0, %1, %2" : "=v"(r) : "v"(lo), "v"(hi)); return r; }
__device__ __forceinline__ float silu_fast(float x) { return x * __builtin_amdgcn_rcpf(1.f + __builtin_amdgcn_exp2f(-1.4426950408889634f * x)); }

struct EpiProj {
    static constexpr bool PERM = true, AFTER_DRAIN = false;
    bf16_t* O;
    __device__ __forceinline__ void operator()(const f32x4 (&acc)[2][2][4][2], const Unit& u, int wr, int wc, int fr, int fq) const {
        const int row0 = u.pm * BM + wr * 64 + fr, col0 = u.pn * BM + wc * 32 + 8 * fq;
        const float sc = (u.pn == 2 || u.pn == 3) ? 0.08838834764831845f : 1.f;
#pragma unroll
        for (int ai = 0; ai < 2; ++ai)
#pragma unroll
            for (int m = 0; m < 4; ++m) { bf16_t* rowp = O + (size_t)(row0 + ai * HALF + m * 16) * DP + col0;
#pragma unroll
                for (int bj = 0; bj < 2; ++bj) { const f32x4 v0 = acc[ai][bj][m][0] * sc, v1 = acc[ai][bj][m][1] * sc;
                    u32x4 w; w.x = cvt_pk_bf16(v0[0], v0[1]); w.y = cvt_pk_bf16(v0[2], v0[3]); w.z = cvt_pk_bf16(v1[0], v1[1]); w.w = cvt_pk_bf16(v1[2], v1[3]);
                    *(u32x4*)(rowp + bj * HALF) = w; } }
    }
};
struct EpiResid {
    static constexpr bool PERM = false, AFTER_DRAIN = false;
    const float* base_lat; const float* base_ctx; float* out_lat; float* out_ctx; const float* gl; const float* gc;
    __device__ __forceinline__ void operator()(const f32x4 (&acc)[2][2][4][2], const Unit& u, int wr, int wc, int fr, int fq) const {
        const bool lat = u.pm < NL / BM;
        const int row0 = (lat ? u.pm * BM : u.pm * BM - NL) + wr * 64 + fr, col0 = u.pn * BM + wc * 32 + 4 * fq;
        const float* base = lat ? base_lat : base_ctx; float* out = lat ? out_lat : out_ctx;
        const float* gate = lat ? gl + (size_t)(u.pm / (T / BM)) * 6 * DM : gc;
        f32x4 gv[2][2];
#pragma unroll
        for (int bj = 0; bj < 2; ++bj)
#pragma unroll
            for (int n = 0; n < 2; ++n) gv[bj][n] = *(const f32x4*)(gate + col0 + bj * HALF + n * 16);
#pragma unroll
        for (int ai = 0; ai < 2; ++ai)
#pragma unroll
            for (int m = 0; m < 4; ++m) { const size_t off = (size_t)(row0 + ai * HALF + m * 16) * DM + col0;
#pragma unroll
                for (int bj = 0; bj < 2; ++bj)
#pragma unroll
                    for (int n = 0; n < 2; ++n) { const f32x4 bs = *(const f32x4*)(base + off + bj * HALF + n * 16); *(f32x4*)(out + off + bj * HALF + n * 16) = bs + gv[bj][n] * acc[ai][bj][m][n]; }
                asm volatile("" ::: "memory"); }
    }
};
struct EpiPartial {
    static constexpr bool PERM = false, AFTER_DRAIN = false;
    float* part; int pm0, nrows;
    __device__ __forceinline__ void operator()(const f32x4 (&acc)[2][2][4][2], const Unit& u, int wr, int wc, int fr, int fq) const {
        const int row0 = (u.pm - pm0) * BM + wr * 64 + fr, col0 = u.pn * BM + wc * 32 + 4 * fq;
        float* base = part + (size_t)(u.kofs / 512) * nrows * DM;
#pragma unroll
        for (int ai = 0; ai < 2; ++ai)
#pragma unroll
            for (int m = 0; m < 4; ++m) { float* rowp = base + (size_t)(row0 + ai * HALF + m * 16) * DM + col0;
#pragma unroll
                for (int bj = 0; bj < 2; ++bj)
#pragma unroll
                    for (int n = 0; n < 2; ++n) *(f32x4*)(rowp + bj * HALF + n * 16) = acc[ai][bj][m][n]; }
    }
};
struct EpiSwiglu {
    static constexpr bool PERM = true, AFTER_DRAIN = false;
    bf16_t* O;
    __device__ __forceinline__ void operator()(const f32x4 (&acc)[2][2][4][2], const Unit& u, int wr, int wc, int fr, int fq) const {
        const int row0 = u.pm * BM + wr * 64 + fr, col0 = u.pn * HALF + wc * 32 + 8 * fq;
#pragma unroll
        for (int ai = 0; ai < 2; ++ai)
#pragma unroll
            for (int m = 0; m < 4; ++m) { bf16_t* rowp = O + (size_t)(row0 + ai * HALF + m * 16) * DFF + col0;
                const f32x4 g0 = acc[ai][0][m][0], g1 = acc[ai][0][m][1], u0 = acc[ai][1][m][0], u1 = acc[ai][1][m][1];
                u32x4 w; w.x = cvt_pk_bf16(silu_fast(g0[0]) * u0[0], silu_fast(g0[1]) * u0[1]); w.y = cvt_pk_bf16(silu_fast(g0[2]) * u0[2], silu_fast(g0[3]) * u0[3]);
                w.z = cvt_pk_bf16(silu_fast(g1[0]) * u1[0], silu_fast(g1[1]) * u1[1]); w.w = cvt_pk_bf16(silu_fast(g1[2]) * u1[2], silu_fast(g1[3]) * u1[3]);
                *(u32x4*)rowp = w; }
    }
};
struct EpiSwiglu8 {
    static constexpr bool PERM = true, AFTER_DRAIN = false;
    unsigned char* O;
    __device__ __forceinline__ void operator()(const f32x4 (&acc)[2][2][4][2], const Unit& u, int wr, int wc, int fr, int fq) const {
        const int row0 = u.pm * BM + wr * 64 + fr, col0 = u.pn * HALF + wc * 32 + 8 * fq;
        constexpr float WI = 1.f / W8_SCALE;
#pragma unroll
        for (int ai = 0; ai < 2; ++ai)
#pragma unroll
            for (int m = 0; m < 4; ++m) { unsigned char* rowp = O + (size_t)(row0 + ai * HALF + m * 16) * DFF + col0;
                const f32x4 g0 = acc[ai][0][m][0] * WI, g1 = acc[ai][0][m][1] * WI, u0 = acc[ai][1][m][0] * (WI * A8_SCALE), u1 = acc[ai][1][m][1] * (WI * A8_SCALE);
                v2u w; w.x = pk4_fp8(silu_fast(g0[0]) * u0[0], silu_fast(g0[1]) * u0[1], silu_fast(g0[2]) * u0[2], silu_fast(g0[3]) * u0[3]);
                w.y = pk4_fp8(silu_fast(g1[0]) * u1[0], silu_fast(g1[1]) * u1[1], silu_fast(g1[2]) * u1[2], silu_fast(g1[3]) * u1[3]);
                *(v2u*)rowp = w; }
    }
};
struct EpiMoeDown {
    static constexpr bool PERM = true, AFTER_DRAIN = false;
    bf16_t* O; const float* rgate; float scale;
    __device__ __forceinline__ void operator()(const f32x4 (&acc)[2][2][4][2], const Unit& u, int wr, int wc, int fr, int fq) const {
        const int row0 = u.pm * BM + wr * 64 + fr, col0 = u.pn * BM + wc * 32 + 8 * fq;
#pragma unroll
        for (int ai = 0; ai < 2; ++ai)
#pragma unroll
            for (int m = 0; m < 4; ++m) { const int row = row0 + ai * HALF + m * 16; const float sc = rgate[row] * scale; bf16_t* rowp = O + (size_t)row * DM + col0;
#pragma unroll
                for (int bj = 0; bj < 2; ++bj) { const f32x4 v0 = acc[ai][bj][m][0] * sc, v1 = acc[ai][bj][m][1] * sc;
                    u32x4 w; w.x = cvt_pk_bf16(v0[0], v0[1]); w.y = cvt_pk_bf16(v0[2], v0[3]); w.z = cvt_pk_bf16(v1[0], v1[1]); w.w = cvt_pk_bf16(v1[2], v1[3]);
                    *(u32x4*)(rowp + bj * HALF) = w; } }
    }
};

template <class Epi, class Sched, bool ALIGN_EPI = false, bool SP2 = false, bool F8 = false>
__device__ __forceinline__ void gemm_phase(PG8_LAS unsigned char* lds, const Gemm g, const Sched& S, const Epi& E, const int wid  ) {
    const int lane = lane_id(), tid = wid * 64 + lane, wr = wid >> 2, wc = wid & 3, fr = lane & 15, fq = lane >> 4;
    const int K = g.ld, nt = g.K / BK;
    unsigned voffA[2], voffB[2];
#pragma unroll
    for (int i = 0; i < 2; ++i) { int R, C; stage_rc(tid * 16 + i * 8192, R, C); const int Rb = Epi::PERM ? ((R & ~31) + perm32(R & 31)) : R;
        voffA[i] = (unsigned)(R * K + C) * 2u; voffB[i] = (unsigned)(Rb * K + C) * 2u; }
    const size_t kstep = (size_t)(BK * 2);
    const size_t hstep = (size_t)HALF * K * 2;
    const size_t tstep = 2 * hstep;
    const unsigned ldsw = (unsigned)wid * 1024u;
    const int aoff = lds_byte(wr * 64 + fr, fq * 8), boff = lds_byte(wc * 32 + fr, fq * 8);
#define PG8_SA(b, h) (((b) * 2 + (h)) * HTB)
#define PG8_SB(b, h) ((4 + (b) * 2 + (h)) * HTB)
#define PG8_STAGE(bufoff, gbase, voff) do { _Pragma("unroll") for (int _i = 0; _i < 2; ++_i) \
        __builtin_amdgcn_global_load_lds((const unsigned*)((const char*)(gbase) + (voff)[_i]), (PG8_LAS unsigned*)(lds + (bufoff) + ldsw + _i * 8192), 16, 0, 0); } while (0)
#define PG8_LD8(addr) __builtin_shufflevector(*(const PG8_LAS i32x4*)(addr), *(const PG8_LAS i32x4*)((addr) + 1024), 0, 1, 2, 3, 4, 5, 6, 7)
#define PG8_LDA(dst, dst8, b, h) do { if constexpr (F8) { _Pragma("unroll") for (int m = 0; m < 4; ++m) dst8[m] = PG8_LD8(lds + PG8_SA(b, h) + aoff + m * 2048); } \
        else { _Pragma("unroll") for (int m = 0; m < 4; ++m) _Pragma("unroll") for (int k = 0; k < 2; ++k) dst[m][k] = *(const PG8_LAS bf16x8*)(lds + PG8_SA(b, h) + aoff + m * 2048 + k * 1024); } } while (0)
#define PG8_LDB(dst, dst8, b, h) do { if constexpr (F8) { _Pragma("unroll") for (int n = 0; n < 2; ++n) dst8[n] = PG8_LD8(lds + PG8_SB(b, h) + boff + n * 2048); } \
        else { _Pragma("unroll") for (int n = 0; n < 2; ++n) _Pragma("unroll") for (int k = 0; k < 2; ++k) dst[n][k] = *(const PG8_LAS bf16x8*)(lds + PG8_SB(b, h) + boff + n * 2048 + k * 1024); } } while (0)
#define PG8_MMA(ai, bj, At, At8, Bt, Bt8) do { __builtin_amdgcn_s_setprio(1); \
        if constexpr (F8) { _Pragma("unroll") for (int m = 0; m < 4; ++m) _Pragma("unroll") for (int n = 0; n < 2; ++n) \
            asm volatile("v_mfma_scale_f32_16x16x128_f8f6f4 %0, %1, %2, %0, %3, %3 op_sel_hi:[0,0,0]" : "+v"(acc[ai][bj][m][n]) : "v"(Bt8[n]), "v"(At8[m]), "v"(sc8_)); } \
        else { _Pragma("unroll") for (int m = 0; m < 4; ++m) _Pragma("unroll") for (int n = 0; n < 2; ++n) _Pragma("unroll") for (int k = 0; k < 2; ++k) \
            acc[ai][bj][m][n] = __builtin_amdgcn_mfma_f32_16x16x32_bf16(Bt[n][k], At[m][k], acc[ai][bj][m][n], 0, 0, 0); } \
        __builtin_amdgcn_s_setprio(0); } while (0)
#define PG8_WAIT_V(n) asm volatile("s_waitcnt vmcnt(" #n ")" ::: "memory")
#define PG8_WAIT_L(n) asm volatile("s_waitcnt lgkmcnt(" #n ")" ::: "memory")
#define PG8_BAR __builtin_amdgcn_s_barrier()
#define PG8_SCHED __builtin_amdgcn_sched_barrier(0)
#define PG8_SCHED8 do { if constexpr (F8) __builtin_amdgcn_sched_barrier(0); } while (0)
    Unit cur, nxt; int ui = 0;
    if (!S.next(0, cur)) return;
    constexpr float zero_ = 0.f;
    const int sc8_ = 0x7f7f7f7f;
    f32x4 acc[2][2][4][2];
#pragma unroll
    for (int a = 0; a < 2; ++a)
#pragma unroll
        for (int b = 0; b < 2; ++b)
#pragma unroll
            for (int m = 0; m < 4; ++m)
#pragma unroll
                for (int n = 0; n < 2; ++n) acc[a][b][m][n] = (f32x4){zero_, zero_, zero_, zero_};
    bf16x8 At[4][2], B0[2][2], B1[2][2];
    i32x8 At8[4], B08[2], B18[2];
    const char* cA = (const char*)g.A + cur.kofs + (size_t)cur.pm * tstep; const char* cB = (const char*)g.Bt + cur.bofs + cur.kofs + (size_t)cur.pn * tstep;
    S.a_ready(cur);
    if constexpr (SP2) {
        PG8_STAGE(PG8_SB(0, 0), cB, voffB); PG8_STAGE(PG8_SB(0, 1), cB + hstep, voffB); PG8_STAGE(PG8_SA(0, 0), cA, voffA); PG8_STAGE(PG8_SA(0, 1), cA + hstep, voffA);
        if (wr == 1) PG8_BAR;
        PG8_WAIT_V(2); PG8_BAR;
        PG8_STAGE(PG8_SB(1, 0), cB + kstep, voffB); PG8_STAGE(PG8_SA(1, 0), cA + kstep, voffA); PG8_STAGE(PG8_SB(1, 1), cB + hstep + kstep, voffB);
        PG8_WAIT_V(6); PG8_BAR;
    } else {
        PG8_STAGE(PG8_SB(0, 0), cB, voffB); PG8_STAGE(PG8_SA(0, 0), cA, voffA); PG8_STAGE(PG8_SB(0, 1), cB + hstep, voffB); PG8_STAGE(PG8_SA(0, 1), cA + hstep, voffA);
        if (wr == 1) PG8_BAR;
        PG8_WAIT_V(4); PG8_BAR;
        PG8_STAGE(PG8_SB(1, 0), cB + kstep, voffB); PG8_STAGE(PG8_SA(1, 0), cA + kstep, voffA); PG8_STAGE(PG8_SB(1, 1), cB + hstep + kstep, voffB);
        PG8_WAIT_V(6); PG8_BAR;
    }
    for (;;) {
        const bool has_next = S.next(ui + 1, nxt);
        const char* nA = has_next ? (const char*)g.A + nxt.kofs + (size_t)nxt.pm * tstep : cA; const char* nB = has_next ? (const char*)g.Bt + nxt.bofs + nxt.kofs + (size_t)nxt.pn * tstep : cB;
#pragma clang loop unroll(disable)
        for (int t = 0; t < nt; t += 2) {
            const bool last = (t == nt - 2);
            const char* a1 = cA + (size_t)(t + 1) * kstep;
            const char* a2 = last ? nA : cA + (size_t)(t + 2) * kstep; const char* b2 = last ? nB : cB + (size_t)(t + 2) * kstep;
            const char* a3 = a2 + kstep; const char* b3 = b2 + kstep;
            if (last && has_next) S.a_ready(nxt);
            if constexpr (SP2) {
            PG8_LDB(B0, B08, 0, 0); PG8_LDB(B1, B18, 0, 1); PG8_SCHED; PG8_LDA(At, At8, 0, 0); PG8_STAGE(PG8_SA(1, 1), a1 + hstep, voffA);
            PG8_WAIT_V(8); PG8_WAIT_L(0); PG8_BAR; PG8_SCHED8; PG8_MMA(0, 0, At, At8, B0, B08); PG8_MMA(0, 1, At, At8, B1, B18); PG8_SCHED8; PG8_BAR; PG8_SCHED;
            PG8_LDA(At, At8, 0, 1); PG8_STAGE(PG8_SB(0, 0), b2, voffB); PG8_STAGE(PG8_SB(0, 1), b2 + hstep, voffB); PG8_STAGE(PG8_SA(0, 0), a2, voffA);
            PG8_WAIT_V(8); PG8_WAIT_L(0); PG8_BAR; PG8_SCHED8; PG8_MMA(1, 0, At, At8, B0, B08); PG8_MMA(1, 1, At, At8, B1, B18); PG8_SCHED8; PG8_BAR; PG8_SCHED;
            PG8_LDB(B0, B08, 1, 0); PG8_LDB(B1, B18, 1, 1); PG8_SCHED; PG8_LDA(At, At8, 1, 0); PG8_STAGE(PG8_SA(0, 1), a2 + hstep, voffA);
            PG8_WAIT_V(8); PG8_WAIT_L(0); PG8_BAR; PG8_SCHED8; PG8_MMA(0, 0, At, At8, B0, B08); PG8_MMA(0, 1, At, At8, B1, B18); PG8_SCHED8; PG8_BAR; PG8_SCHED;
            PG8_LDA(At, At8, 1, 1); PG8_STAGE(PG8_SB(1, 0), b3, voffB); PG8_STAGE(PG8_SB(1, 1), b3 + hstep, voffB); PG8_STAGE(PG8_SA(1, 0), a3, voffA);
            PG8_WAIT_V(8); PG8_WAIT_L(0); PG8_BAR; PG8_SCHED8; PG8_MMA(1, 0, At, At8, B0, B08); PG8_MMA(1, 1, At, At8, B1, B18); PG8_SCHED8; PG8_BAR; PG8_SCHED;
            } else {
            PG8_LDB(B0, B08, 0, 0); PG8_SCHED; PG8_LDA(At, At8, 0, 0); PG8_STAGE(PG8_SA(1, 1), a1 + hstep, voffA);
            PG8_WAIT_L(8); PG8_BAR; PG8_WAIT_L(0); PG8_MMA(0, 0, At, At8, B0, B08); PG8_BAR; PG8_SCHED;
            PG8_LDB(B1, B18, 0, 1); PG8_STAGE(PG8_SB(0, 0), b2, voffB);
            PG8_BAR; PG8_WAIT_L(0); PG8_MMA(0, 1, At, At8, B1, B18); PG8_BAR;
            PG8_LDA(At, At8, 0, 1); PG8_STAGE(PG8_SA(0, 0), a2, voffA);
            PG8_BAR; PG8_WAIT_L(0); PG8_MMA(1, 0, At, At8, B0, B08); PG8_BAR; PG8_SCHED;
            PG8_STAGE(PG8_SB(0, 1), b2 + hstep, voffB);
            PG8_WAIT_V(6); PG8_BAR; PG8_MMA(1, 1, At, At8, B1, B18); PG8_BAR;
            PG8_LDB(B0, B08, 1, 0); PG8_SCHED; PG8_LDA(At, At8, 1, 0); PG8_STAGE(PG8_SA(0, 1), a2 + hstep, voffA);
            PG8_WAIT_L(8); PG8_BAR; PG8_WAIT_L(0); PG8_MMA(0, 0, At, At8, B0, B08); PG8_BAR; PG8_SCHED;
            PG8_LDB(B1, B18, 1, 1); PG8_STAGE(PG8_SB(1, 0), b3, voffB);
            PG8_BAR; PG8_WAIT_L(0); PG8_MMA(0, 1, At, At8, B1, B18); PG8_BAR;
            PG8_LDA(At, At8, 1, 1); PG8_STAGE(PG8_SA(1, 0), a3, voffA);
            PG8_BAR; PG8_WAIT_L(0); PG8_MMA(1, 0, At, At8, B0, B08); PG8_BAR; PG8_SCHED;
            PG8_STAGE(PG8_SB(1, 1), b3 + hstep, voffB);
            PG8_WAIT_V(6); PG8_BAR; PG8_MMA(1, 1, At, At8, B1, B18); PG8_BAR;
            }
        }
        if constexpr (ALIGN_EPI) { if (wr == 0) PG8_BAR; }
        if constexpr (F8) asm volatile("s_nop 15\n\ts_nop 15" ::: "memory");
        if constexpr (!Epi::AFTER_DRAIN) { E(acc, cur, wr, wc, fr, fq); S.done(cur); }
        if (!has_next) break;
#pragma unroll
        for (int a = 0; a < 2; ++a)
#pragma unroll
            for (int b = 0; b < 2; ++b)
#pragma unroll
                for (int m = 0; m < 4; ++m)
#pragma unroll
                    for (int n = 0; n < 2; ++n) acc[a][b][m][n] = (f32x4){zero_, zero_, zero_, zero_};
        cur = nxt; cA = nA; cB = nB; ++ui;
        if constexpr (ALIGN_EPI) { if (wr == 1) PG8_BAR; }
    }
    PG8_WAIT_V(0);
    if constexpr (!ALIGN_EPI) { if (wr == 0) PG8_BAR; }
    PG8_BAR;
    if constexpr (Epi::AFTER_DRAIN) { E.fused(acc, cur, wr, wc, fr, fq, lds, wid, lane); S.done(cur); }
#undef PG8_SA
#undef PG8_SB
#undef PG8_STAGE
#undef PG8_LDA
#undef PG8_LDB
#undef PG8_MMA
#undef PG8_LD8
#undef PG8_WAIT_V
#undef PG8_WAIT_L
#undef PG8_BAR
#undef PG8_SCHED
#undef PG8_SCHED8
}

}

#define GAS __attribute__((address_space(1)))
#define LAS __attribute__((address_space(3)))
typedef unsigned v4u __attribute__((ext_vector_type(4)));
typedef float f32x4 __attribute__((ext_vector_type(4)));
#define LDS_WAIT() asm volatile("s_waitcnt lgkmcnt(0)" ::: "memory")
#define VM_WAIT() asm volatile("s_waitcnt vmcnt(0)" ::: "memory")

#define XB_TMO      128
#define XB_XCNT(j)  (256  + 64 * (j))
#define XB_XSUB(j)  (1280 + 64 * (j))
#define XB_XGEN(j)  (2304 + 64 * (j))
#define XB_TOP      3328
#define XB_TOPGEN   3392
#define XCD_BAR_WORDS 3456
#define XB_SPIN_CAP (1u << 18)

__device__ __forceinline__ unsigned xb_ld(unsigned* p)              { return __hip_atomic_load(p, __ATOMIC_RELAXED, __HIP_MEMORY_SCOPE_AGENT); }
__device__ __forceinline__ unsigned xb_add(unsigned* p, unsigned v) { return __hip_atomic_fetch_add(p, v, __ATOMIC_RELAXED, __HIP_MEMORY_SCOPE_AGENT); }
__device__ __forceinline__ unsigned xb_xcc_id() { return (unsigned)__builtin_amdgcn_s_getreg((3 << 11) | 20) & 0xFu; }
#define XB_SPIN(cond, bar) do { unsigned _sp = 0; while (cond) { __builtin_amdgcn_s_sleep(1); \
    if ((++_sp & 255u) == 0u) { if (xb_ld(&(bar)[XB_TMO])) break; if (_sp > XB_SPIN_CAP) { atomicAdd(&(bar)[XB_TMO], 1u); break; } } } } while (0)

struct XcdBarrier {
    unsigned* bar; unsigned x;
    volatile LAS unsigned* st;
};

__device__ __forceinline__ XcdBarrier xcd_barrier_post(unsigned* bar, volatile LAS unsigned* st, bool t0) {
    XcdBarrier b; b.bar = bar; b.x = xb_xcc_id(); b.st = st;
    if (t0) (void)xb_add(&bar[XB_XCNT(b.x)], 1u);
    return b;
}
__device__ __forceinline__ void xcd_barrier_complete(unsigned* bar, unsigned x, unsigned& nloc, unsigned& nx) {
    const unsigned G = gridDim.x * gridDim.y * gridDim.z;
    unsigned sum, cnt, mine, sp = 0u;
    for (;;) {
        sum = 0u; cnt = 0u; mine = 0u;
#pragma unroll
        for (unsigned j = 0; j < 16; ++j) { const unsigned c = xb_ld(&bar[XB_XCNT(j)]); sum += c; cnt += (c > 0u) ? 1u : 0u; mine = (j == x) ? c : mine; }
        if (sum == G) break;
        __builtin_amdgcn_s_sleep(1);
        if ((++sp & 255u) == 0u) { if (xb_ld(&bar[XB_TMO])) break; if (sp > XB_SPIN_CAP) { atomicAdd(&bar[XB_TMO], 1u); break; } }
    }
    nloc = mine > 0u ? mine : 1u; nx = cnt > 0u ? cnt : 1u;
}

__device__ __forceinline__ void xcd_barrier(const XcdBarrier& b, bool t0) {
    asm volatile("s_waitcnt vmcnt(0)" ::: "memory");
    __syncthreads();
    if (t0) {
        unsigned* bar = b.bar;
        __builtin_amdgcn_s_waitcnt(0);
        unsigned nloc = b.st[0], nx = b.st[1];
        if (nloc == 0u) { xcd_barrier_complete(bar, b.x, nloc, nx); b.st[0] = nloc; b.st[1] = nx; }
        const unsigned old = xb_add(&bar[XB_XSUB(b.x)], 1u);
        const unsigned gen = old / nloc;
        if (old + 1u == (gen + 1u) * nloc) {
            __builtin_amdgcn_fence(__ATOMIC_RELEASE, "agent");
            asm volatile("s_waitcnt vmcnt(0)" ::: "memory");
            const unsigned og = xb_add(&bar[XB_TOP], 1u);
            const unsigned tg = og / nx;
            if (og + 1u == (tg + 1u) * nx) xb_add(&bar[XB_TOPGEN], 1u);
            else XB_SPIN(xb_ld(&bar[XB_TOPGEN]) == tg, bar);
            __builtin_amdgcn_fence(__ATOMIC_ACQUIRE, "agent");
            xb_add(&bar[XB_XGEN(b.x)], 1u);
            asm volatile("s_waitcnt vmcnt(0)" ::: "memory");
        } else {
            XB_SPIN(xb_ld(&bar[XB_XGEN(b.x)]) == gen, bar);
            __builtin_amdgcn_fence(__ATOMIC_ACQUIRE, "agent");
            asm volatile("s_waitcnt vmcnt(0)" ::: "memory");
        }
    }
    __syncthreads();
}

constexpr int RING_OFF = 0, RING_BYTES = 131072;
constexpr int MISC_OFF = 143360;
constexpr int LDS_BYTES = 147456;
constexpr int NWAVES = 8;

struct Ctx { LAS unsigned char* lds; volatile LAS unsigned* MISC; unsigned* ctl; int wave, G, gw, NGW; };

__device__ __forceinline__ void cvt_item(const float* W, int K, int N, bf16_t* WT, int mode, LAS float* scr, int item, int lane) {
    const int kblk = K / 64, nb = item / kblk, kb = item % kblk, k0 = 64 * kb, n0 = 64 * nb;
    f32x4 ld[16];
#pragma unroll
    for (int i = 0; i < 16; ++i) { const int kk = 4 * i + (lane >> 4), c4 = 4 * (lane & 15); ld[i] = __builtin_nontemporal_load((const f32x4*)(W + (size_t)(k0 + kk) * N + n0 + c4));     }
#pragma unroll
    for (int i = 0; i < 16; ++i) { const int kk = 4 * i + (lane >> 4), c4 = 4 * (lane & 15);
        LAS float* s = scr + kk * 65 + c4; s[0] = ld[i][0]; s[1] = ld[i][1]; s[2] = ld[i][2]; s[3] = ld[i][3]; }
    LDS_WAIT(); asm volatile("" ::: "memory");
    const int c = lane >> 3;
#pragma unroll
    for (int j = 0; j < 8; ++j) { const int n = (lane & 7) + 8 * j; const LAS float* s = scr + (8 * c) * 65 + n;
        v4u o; o.x = pk2(s[0 * 65], s[1 * 65]); o.y = pk2(s[2 * 65], s[3 * 65]); o.z = pk2(s[4 * 65], s[5 * 65]); o.w = pk2(s[6 * 65], s[7 * 65]);
        const int nn = n0 + n; const int drow = mode == 0 ? nn : (nn / 128) * 256 + (mode - 1) * 128 + (nn % 128);
        *(v4u*)(WT + (size_t)drow * K + k0 + 8 * c) = o; }
    LDS_WAIT(); asm volatile("" ::: "memory");
}
__device__ __forceinline__ void cvt_item8(const float* W, int K, int N, unsigned char* WT, int mode, LAS float* scr, int item, int lane) {
    const int kblk = K / 64, nb = item / kblk, kb = item % kblk, k0 = 64 * kb, n0 = 64 * nb;
    f32x4 ld[16];
#pragma unroll
    for (int i = 0; i < 16; ++i) { const int kk = 4 * i + (lane >> 4), c4 = 4 * (lane & 15); ld[i] = __builtin_nontemporal_load((const f32x4*)(W + (size_t)(k0 + kk) * N + n0 + c4));     }
#pragma unroll
    for (int i = 0; i < 16; ++i) { const int kk = 4 * i + (lane >> 4), c4 = 4 * (lane & 15);
        LAS float* s = scr + kk * 65 + c4; s[0] = ld[i][0]; s[1] = ld[i][1]; s[2] = ld[i][2]; s[3] = ld[i][3]; }
    LDS_WAIT(); asm volatile("" ::: "memory");
    const int c = lane >> 3;
#pragma unroll
    for (int j = 0; j < 8; ++j) { const int n = (lane & 7) + 8 * j; const LAS float* s = scr + (8 * c) * 65 + n;
        v2u o; o.x = pk4_fp8(s[0 * 65] * W8_SCALE, s[1 * 65] * W8_SCALE, s[2 * 65] * W8_SCALE, s[3 * 65] * W8_SCALE); o.y = pk4_fp8(s[4 * 65] * W8_SCALE, s[5 * 65] * W8_SCALE, s[6 * 65] * W8_SCALE, s[7 * 65] * W8_SCALE);
        const int nn = n0 + n; const int drow = mode == 0 ? nn : (nn / 128) * 256 + (mode - 1) * 128 + (nn % 128);
        *(v2u*)(WT + (size_t)drow * K + k0 + 8 * c) = o; }
    LDS_WAIT(); asm volatile("" ::: "memory");
}
__device__ __forceinline__ void p0_prologue(const Params& p, Ctx& F) {
    const int lane_ = lane_id(), tid_ = F.wave * 64 + lane_;
    LAS float* fl = (LAS float*)(F.lds + RING_OFF);
    for (int it = blockIdx.x; it < 192; it += F.G) {
        const int l = it / 96, n = (it % 96) * 64 + lane_;
        LAS float* sv = fl;
        LAS float* red = fl + 3 * 1024;
        for (int i = tid_; i < 3 * 1024; i += 512) { const int rt = i >> 10, k = i & 1023; const float v = rt < 2 ? p.in[I_C][rt * DM + k] : p.in[I_CCTX][k]; sv[i] = siluf(v); }
        __syncthreads();
        const float* W = p.in[I_ADAW] + (size_t)l * DM * 6144 + n;
        float a0 = 0.f, a1 = 0.f, a2 = 0.f;
        for (int kb = 0; kb < 128; kb += 32) {
            float wv[32];
#pragma unroll
            for (int j = 0; j < 32; ++j) wv[j] = W[(size_t)(F.wave * 128 + kb + j) * 6144];
#pragma unroll
            for (int j = 0; j < 32; ++j) { const int k = F.wave * 128 + kb + j; a0 += sv[k] * wv[j]; a1 += sv[1024 + k] * wv[j]; a2 += sv[2048 + k] * wv[j]; }
        }
        red[(F.wave * 3 + 0) * 64 + lane_] = a0; red[(F.wave * 3 + 1) * 64 + lane_] = a1; red[(F.wave * 3 + 2) * 64 + lane_] = a2;
        __syncthreads();
        if (tid_ < 192) { const int rt = tid_ >> 6, ln = tid_ & 63; float s = 0.f;
#pragma unroll
            for (int w = 0; w < 8; ++w) s += red[(w * 3 + rt) * 64 + ln];
            const int nn = (it % 96) * 64 + ln;
            ((float*)(p.ws + WS_MODV))[(size_t)(l * 3 + rt) * 6144 + nn] = s + p.in[I_ADAB][l * 6144 + nn]; }
        __syncthreads();
    }
    LAS float* scr = (LAS float*)(F.lds + RING_OFF) + F.wave * (64 * 65);
    constexpr int S_WIN = 16 * 56, S_WOUT = 16 * 16, S_F = 16 * 44;
    constexpr int NITEMS = 2 * S_WIN + 2 * S_WOUT + 3 * S_F + 24 * S_F;
    static_assert(NITEMS == 21312, "items");
    for (int it = F.gw; it < NITEMS; it += F.NGW) {
        int r = it;
        if (r < 2 * S_WIN) { const int l = r / S_WIN; cvt_item(p.in[I_WIN] + (size_t)l * DM * DP, DM, DP, (bf16_t*)(p.ws + W_WIN) + (size_t)l * DP * DM, 0, scr, r % S_WIN, lane_); continue; } r -= 2 * S_WIN;
        if (r < 2 * S_WOUT) { const int l = r / S_WOUT; cvt_item(p.in[I_WOUT] + (size_t)l * DM * DM, DM, DM, (bf16_t*)(p.ws + W_WOUT) + (size_t)l * DM * DM, 0, scr, r % S_WOUT, lane_); continue; } r -= 2 * S_WOUT;
        if (r < S_F) { cvt_item(p.in[I_FWG], DM, DFF, (bf16_t*)(p.ws + W_FGU), 1, scr, r, lane_); continue; } r -= S_F;
        if (r < S_F) { cvt_item(p.in[I_FWU], DM, DFF, (bf16_t*)(p.ws + W_FGU), 2, scr, r, lane_); continue; } r -= S_F;
        if (r < S_F) { cvt_item(p.in[I_FWD], DFF, DM, (bf16_t*)(p.ws + W_FD), 0, scr, r, lane_); continue; } r -= S_F;
        if (r < 8 * S_F) { const int e = r / S_F; cvt_item8(p.in[I_MWG] + (size_t)e * DM * DFF, DM, DFF, (unsigned char*)(p.ws + W_MGU) + (size_t)e * 2 * DFF * DM, 1, scr, r % S_F, lane_); continue; } r -= 8 * S_F;
        if (r < 8 * S_F) { const int e = r / S_F; cvt_item8(p.in[I_MWU] + (size_t)e * DM * DFF, DM, DFF, (unsigned char*)(p.ws + W_MGU) + (size_t)e * 2 * DFF * DM, 2, scr, r % S_F, lane_); continue; } r -= 8 * S_F;
        { const int e = r / S_F; cvt_item8(p.in[I_MWD] + (size_t)e * DFF * DM, DFF, DM, (unsigned char*)(p.ws + W_MD) + (size_t)e * DM * DFF, 0, scr, r % S_F, lane_); }
    }
}

__device__ __forceinline__ void norm_phase(const Params& p, Ctx& F, int l, int which, int nrows) {
    const int lane_ = lane_id(), tid_ = F.wave * 64 + lane_;
    const float* g = p.in[which ? I_N2G : I_N1G] + l * DM;
    for (int m = F.gw; m < nrows; m += F.NGW) {
        const float* xrow;
        if (l == 0 && which == 0) xrow = m < NL ? p.in[I_X] + (size_t)m * DM : p.in[I_CTX] + (size_t)(m - NL) * DM;
        else xrow = xr_row(p, m);
        const int rt = rowtype(m);
        const float* sh = modv(p, l, rt, which ? 3 : 0); const float* sc = modv(p, l, rt, which ? 4 : 1);
        f32x4 v[4]; float ss = 0.f;
        if (m >= NL && !(l == 0 && which == 0)) {
            const int nsl = which ? DM / 256 : DFF / 256; const float* gate = modv(p, 0, 2, which ? 2 : 5);
            const float* base = (l == 0) ? p.in[I_CTX] + (size_t)(m - NL) * DM : xrow;
            const float* part = (const float*)(p.ws + WS_PART) + (size_t)(m - NL) * DM;
#pragma unroll
            for (int j = 0; j < 4; ++j) { const int col = 256 * j + 4 * lane_; f32x4 a = {0.f, 0.f, 0.f, 0.f};
                for (int sl = 0; sl < nsl; ++sl) a += *(const f32x4*)(part + (size_t)sl * NC * DM + col);
                v[j] = *(const f32x4*)(base + col) + *(const f32x4*)(gate + col) * a;
                *(f32x4*)((float*)(p.ws + WS_XRC) + (size_t)(m - NL) * DM + col) = v[j];
                ss += (v[j][0] * v[j][0] + v[j][1] * v[j][1]) + (v[j][2] * v[j][2] + v[j][3] * v[j][3]); }
        } else
#pragma unroll
        for (int j = 0; j < 4; ++j) { v[j] = *(const f32x4*)(xrow + 256 * j + 4 * lane_); ss += (v[j][0] * v[j][0] + v[j][1] * v[j][1]) + (v[j][2] * v[j][2] + v[j][3] * v[j][3]); }
        const float r = rsqrtf(wave_sum(ss) * (1.f / DM) + EPS);
        bf16_t* hb = (bf16_t*)(p.ws + WS_HBUF) + (size_t)m * DM;
#pragma unroll
        for (int j = 0; j < 4; ++j) { const int col = 256 * j + 4 * lane_;
            const f32x4 gg = *(const f32x4*)(g + col), s4 = *(const f32x4*)(sc + col), h4 = *(const f32x4*)(sh + col);
            const f32x4 y = v[j] * r * gg * (1.f + s4) + h4;
            v2u o; o.x = pk2(y[0], y[1]); o.y = pk2(y[2], y[3]); *(v2u*)(hb + col) = o; }
    }
}


__device__ __forceinline__ void router_phase(const Params& p, Ctx& F) {
    const int lane_ = lane_id(), tid_ = F.wave * 64 + lane_;
    LAS int* lcnt = (LAS int*)(F.lds + RING_OFF);
    LAS int* gbase = lcnt + 8;
    LAS int* ent_e = lcnt + 16;
    LAS int* ent_pos = lcnt + 16 + 128;
    const float* g = p.in[I_N2G] + DM; const float* rw = p.in[I_RW];
    int* tok_e = (int*)(p.ws + WS_ROUTE); float* tok_w = (float*)(p.ws + WS_ROUTE) + 2 * NL; int* tok_pos = (int*)(p.ws + WS_ROUTE) + 4 * NL;
    f32x4 rwa[4][4], rwb[4][4];
#pragma unroll
    for (int j = 0; j < 4; ++j)
#pragma unroll
        for (int q = 0; q < 4; ++q) { const int col = 256 * j + 4 * lane_ + q; rwa[j][q] = *(const f32x4*)(rw + (size_t)col * 8); rwb[j][q] = *(const f32x4*)(rw + (size_t)col * 8 + 4); }
    const int myexp = ((lane_ >> 5) & 1) * 4 + ((lane_ >> 4) & 1) * 2 + ((lane_ >> 3) & 1);
    for (int ch = blockIdx.x; ch < NL / 64; ch += F.G) {
        if (tid_ < 8) lcnt[tid_] = 0;
        __syncthreads();
        const int rt = (ch * 64) / T;
        const float* sh = modv(p, 1, rt, 3); const float* sc = modv(p, 1, rt, 4);
        f32x4 gs[4], hs[4]; float bsum;
        { float bb[8] = {0.f, 0.f, 0.f, 0.f, 0.f, 0.f, 0.f, 0.f};
#pragma unroll
          for (int j = 0; j < 4; ++j) { const int col = 256 * j + 4 * lane_; gs[j] = *(const f32x4*)(g + col) * (1.f + *(const f32x4*)(sc + col)); hs[j] = *(const f32x4*)(sh + col);
#pragma unroll
            for (int q = 0; q < 4; ++q) { bb[0] += hs[j][q] * rwa[j][q][0]; bb[1] += hs[j][q] * rwa[j][q][1]; bb[2] += hs[j][q] * rwa[j][q][2]; bb[3] += hs[j][q] * rwa[j][q][3];
                                          bb[4] += hs[j][q] * rwb[j][q][0]; bb[5] += hs[j][q] * rwb[j][q][1]; bb[6] += hs[j][q] * rwb[j][q][2]; bb[7] += hs[j][q] * rwb[j][q][3]; } }
          float c4[4];
#pragma unroll
          for (int k = 0; k < 4; ++k) { const float keep = (lane_ & 32) ? bb[k + 4] : bb[k], give = (lane_ & 32) ? bb[k] : bb[k + 4]; c4[k] = keep + __shfl_xor(give, 32); }
          float c2[2];
#pragma unroll
          for (int k = 0; k < 2; ++k) { const float keep = (lane_ & 16) ? c4[k + 2] : c4[k], give = (lane_ & 16) ? c4[k] : c4[k + 2]; c2[k] = keep + __shfl_xor(give, 16); }
          float c1 = ((lane_ & 8) ? c2[1] : c2[0]) + __shfl_xor((lane_ & 8) ? c2[0] : c2[1], 8);
          c1 += __shfl_xor(c1, 4); c1 += __shfl_xor(c1, 2); c1 += __shfl_xor(c1, 1);
          bsum = c1 + p.in[I_RB][myexp]; }
        for (int i = 0; i < 8; ++i) {
            const int ti = F.wave * 8 + i, m = ch * 64 + ti;
            const float* xrow = p.out + (size_t)m * DM;
            f32x4 v[4]; float ss = 0.f; float aa[8] = {0.f, 0.f, 0.f, 0.f, 0.f, 0.f, 0.f, 0.f};
#pragma unroll
            for (int j = 0; j < 4; ++j) { v[j] = *(const f32x4*)(xrow + 256 * j + 4 * lane_); ss += (v[j][0] * v[j][0] + v[j][1] * v[j][1]) + (v[j][2] * v[j][2] + v[j][3] * v[j][3]); }
#pragma unroll
            for (int j = 0; j < 4; ++j) { v[j] = v[j] * gs[j];
#pragma unroll
                for (int q = 0; q < 4; ++q) { aa[0] += v[j][q] * rwa[j][q][0]; aa[1] += v[j][q] * rwa[j][q][1]; aa[2] += v[j][q] * rwa[j][q][2]; aa[3] += v[j][q] * rwa[j][q][3];
                                              aa[4] += v[j][q] * rwb[j][q][0]; aa[5] += v[j][q] * rwb[j][q][1]; aa[6] += v[j][q] * rwb[j][q][2]; aa[7] += v[j][q] * rwb[j][q][3]; } }
            float c4[4];
#pragma unroll
            for (int k = 0; k < 4; ++k) { const float keep = (lane_ & 32) ? aa[k + 4] : aa[k], give = (lane_ & 32) ? aa[k] : aa[k + 4]; c4[k] = keep + __shfl_xor(give, 32); }
            float c2[2];
#pragma unroll
            for (int k = 0; k < 2; ++k) { const float keep = (lane_ & 16) ? c4[k + 2] : c4[k], give = (lane_ & 16) ? c4[k] : c4[k + 2]; c2[k] = keep + __shfl_xor(give, 16); }
            float c1 = ((lane_ & 8) ? c2[1] : c2[0]) + __shfl_xor((lane_ & 8) ? c2[0] : c2[1], 8);
            c1 += __shfl_xor(c1, 4); c1 += __shfl_xor(c1, 2); c1 += __shfl_xor(c1, 1);
            const float r = rsqrtf(wave_sum(ss) * (1.f / DM) + EPS);
            const float mylogit = r * c1 + bsum;
#define RLF(L) __uint_as_float((unsigned)__builtin_amdgcn_readlane((int)__float_as_uint(mylogit), L))
            const float lg0 = RLF(0), lg1 = RLF(8), lg2 = RLF(16), lg3 = RLF(24), lg4 = RLF(32), lg5 = RLF(40), lg6 = RLF(48), lg7 = RLF(56);
#undef RLF
            unsigned char* hb = (unsigned char*)(p.ws + WS_HBUF) + (size_t)m * DM;
#pragma unroll
            for (int j = 0; j < 4; ++j) { const f32x4 y = v[j] * r + hs[j]; *(unsigned*)(hb + 256 * j + 4 * lane_) = pk4_fp8(y[0], y[1], y[2], y[3]); }
            int i1 = 0; float v1 = lg0;
            if (lg1 > v1) { v1 = lg1; i1 = 1; } if (lg2 > v1) { v1 = lg2; i1 = 2; } if (lg3 > v1) { v1 = lg3; i1 = 3; }
            if (lg4 > v1) { v1 = lg4; i1 = 4; } if (lg5 > v1) { v1 = lg5; i1 = 5; } if (lg6 > v1) { v1 = lg6; i1 = 6; } if (lg7 > v1) { v1 = lg7; i1 = 7; }
            int i2 = -1; float v2 = -3.4e38f;
            if (i1 != 0 && lg0 > v2) { v2 = lg0; i2 = 0; } if (i1 != 1 && lg1 > v2) { v2 = lg1; i2 = 1; } if (i1 != 2 && lg2 > v2) { v2 = lg2; i2 = 2; } if (i1 != 3 && lg3 > v2) { v2 = lg3; i2 = 3; }
            if (i1 != 4 && lg4 > v2) { v2 = lg4; i2 = 4; } if (i1 != 5 && lg5 > v2) { v2 = lg5; i2 = 5; } if (i1 != 6 && lg6 > v2) { v2 = lg6; i2 = 6; } if (i1 != 7 && lg7 > v2) { v2 = lg7; i2 = 7; }
            const float w1 = 1.f / (1.f + __expf(v2 - v1));
            if (lane_ == 0) {
                const int p1 = __hip_atomic_fetch_add(lcnt + i1, 1, __ATOMIC_RELAXED, __HIP_MEMORY_SCOPE_WORKGROUP);
                const int p2 = __hip_atomic_fetch_add(lcnt + i2, 1, __ATOMIC_RELAXED, __HIP_MEMORY_SCOPE_WORKGROUP);
                ent_e[2 * ti] = i1; ent_e[2 * ti + 1] = i2; ent_pos[2 * ti] = p1; ent_pos[2 * ti + 1] = p2;
                tok_e[2 * m] = i1; tok_e[2 * m + 1] = i2; tok_w[2 * m] = w1; tok_w[2 * m + 1] = 1.f - w1; }
        }
        __syncthreads();
        if (tid_ < 8) gbase[tid_] = (int)__hip_atomic_fetch_add(F.ctl + CW_CNT + 64 * tid_, (unsigned)lcnt[tid_], __ATOMIC_RELAXED, __HIP_MEMORY_SCOPE_AGENT);
        __syncthreads();
        if (tid_ < 128) tok_pos[ch * 128 + tid_] = gbase[ent_e[tid_]] + ent_pos[tid_];
        __syncthreads();
    }
}
__device__ __forceinline__ void moe_table(Ctx& F) {
    const int lane_ = lane_id(), tid_ = F.wave * 64 + lane_;
    volatile LAS unsigned* tb = F.MISC + 32;
    if (tid_ == 0) { unsigned acc = 0;
        for (int e = 0; e < 8; ++e) { const unsigned c = __hip_atomic_load(F.ctl + CW_CNT + 64 * e, __ATOMIC_RELAXED, __HIP_MEMORY_SCOPE_AGENT); tb[e] = acc; tb[16 + e] = c; acc += (c + 255u) / 256u * 256u; }
        tb[8] = acc; }
    __syncthreads();
}
__device__ __forceinline__ void moe_order(Ctx& F, pg8::Order& S, int nN, long estride) {
    volatile LAS unsigned* tb = F.MISC + 32;
#define RFL(x) __builtin_amdgcn_readfirstlane((int)(x))
    S.init(RFL(tb[8] / 256u), nN, F.G, (int)blockIdx.x);
    S.e1 = RFL(tb[1] / 256u); S.e2 = RFL(tb[2] / 256u); S.e3 = RFL(tb[3] / 256u); S.e4 = RFL(tb[4] / 256u); S.e5 = RFL(tb[5] / 256u); S.e6 = RFL(tb[6] / 256u); S.e7 = RFL(tb[7] / 256u);
#undef RFL
    S.estride = estride;
}
__device__ __forceinline__ void gather_phase(const Params& p, Ctx& F) {
    const int lane_ = lane_id(), tid_ = F.wave * 64 + lane_;
    moe_table(F);
    volatile LAS unsigned* tb = F.MISC + 32;
    const int* tok_e = (const int*)(p.ws + WS_ROUTE); const float* tok_w = (const float*)(p.ws + WS_ROUTE) + 2 * NL; const int* tok_pos = (const int*)(p.ws + WS_ROUTE) + 4 * NL;
    int* row_tok = (int*)(p.ws + WS_ROUTE) + 6 * NL; float* row_gate = (float*)(p.ws + WS_ROUTE) + 6 * NL + MP_MAX;
    const unsigned char* hb = (const unsigned char*)(p.ws + WS_HBUF); unsigned char* h2s = (unsigned char*)(p.ws + WS_H2S);
    for (int it = F.gw; it < 2 * NL; it += F.NGW) {
        const int t = it >> 1, e = tok_e[it], r = (int)tb[e] + tok_pos[it];
        *((v4u*)(h2s + (size_t)r * DM) + lane_) = *((const v4u*)(hb + (size_t)t * DM) + lane_);
        if (lane_ == 0) { row_tok[r] = t; row_gate[r] = tok_w[it]; }
    }
    for (int i = F.gw; i < NE * 256; i += F.NGW) {
        const int e = i >> 8, j = i & 255, r = (int)tb[e] + (int)tb[16 + e] + j;
        if (r < (int)tb[e + 1]) { const v4u z = {0u, 0u, 0u, 0u}; *((v4u*)(h2s + (size_t)r * DM) + lane_) = z; if (lane_ == 0) { row_tok[r] = -1; row_gate[r] = 0.f; } }
    }
}
__device__ __forceinline__ void combine_phase(const Params& p, Ctx& F) {
    const int lane_ = lane_id(), tid_ = F.wave * 64 + lane_;
    moe_table(F);
    volatile LAS unsigned* tb = F.MISC + 32;
    const int* tok_e = (const int*)(p.ws + WS_ROUTE); const int* tok_pos = (const int*)(p.ws + WS_ROUTE) + 4 * NL;
    const bf16_t* yb = (const bf16_t*)(p.ws + WS_YBUF);
    for (int t = F.gw; t < NL; t += F.NGW) {
        const int r0 = (int)tb[tok_e[2 * t]] + tok_pos[2 * t], r1 = (int)tb[tok_e[2 * t + 1]] + tok_pos[2 * t + 1];
        const float* g5 = modv(p, 1, t / T, 5);
        float* orow = p.out + (size_t)t * DM;
#pragma unroll
        for (int j = 0; j < 4; ++j) { const int col = 256 * j + 4 * lane_;
            const v2u a = *(const v2u*)(yb + (size_t)r0 * DM + col), b = *(const v2u*)(yb + (size_t)r1 * DM + col);
            f32x4 y; y[0] = __uint_as_float(a.x << 16) + __uint_as_float(b.x << 16); y[1] = __uint_as_float(a.x & 0xffff0000u) + __uint_as_float(b.x & 0xffff0000u);
            y[2] = __uint_as_float(a.y << 16) + __uint_as_float(b.y << 16); y[3] = __uint_as_float(a.y & 0xffff0000u) + __uint_as_float(b.y & 0xffff0000u);
            const f32x4 x = *(const f32x4*)(orow + col), gg = *(const f32x4*)(g5 + col);
            *(f32x4*)(orow + col) = x + gg * y; }
    }
}

namespace att {
constexpr float THR = 8.f;
constexpr int KVBLK = 64;
constexpr int SHM_V = KVBLK * 128 * 2, SHM_K = KVBLK * 128 * 2;
using bf16x8 = __attribute__((ext_vector_type(8))) short;
using s16x4  = __attribute__((ext_vector_type(4))) short;
using f32x16 = __attribute__((ext_vector_type(16))) float;
using f32x8  = __attribute__((ext_vector_type(8))) float;
using u32x4  = __attribute__((ext_vector_type(4))) unsigned;
using f32x4v = __attribute__((ext_vector_type(4))) float;
#define KSWZ(row, colB) ((row) * 256 + ((colB) ^ (((row) & 7) << 4)))
#define SBAR() __builtin_amdgcn_sched_barrier(0)
__device__ __forceinline__ int crow(int r, int hi) { return (r & 3) + 8 * (r >> 2) + 4 * hi; }
__device__ __forceinline__ unsigned cvtpk(float lo, float hi) {
  unsigned r; asm volatile("v_cvt_pk_bf16_f32 %0, %1, %2" : "=v"(r) : "v"(lo), "v"(hi)); return r;
}
__device__ __forceinline__ void partialSM(f32x16& p0, f32x16& p1, float& m_reg, float& mn, float& alpha) {
  constexpr float C = 1.4426950408889634f;
  float pmax = p0[0]; for (int r = 1; r < 16; ++r) pmax = fmaxf(pmax, p0[r]); for (int r = 0; r < 16; ++r) pmax = fmaxf(pmax, p1[r]);
  { auto rr = __builtin_amdgcn_permlane32_swap(__float_as_uint(pmax), __float_as_uint(pmax), false, false);
    pmax = fmaxf(__uint_as_float(rr[0]), __uint_as_float(rr[1])); }
  if (__builtin_expect(__all(pmax - m_reg <= THR), 1)) { mn = m_reg; alpha = 1.f; }
  else { mn = fmaxf(m_reg, pmax); alpha = __builtin_amdgcn_exp2f((m_reg - mn) * C); m_reg = mn; }
  float mnC = -mn * C;
  for (int r = 0; r < 16; ++r) p0[r] = fmaf(p0[r], C, mnC); for (int r = 0; r < 16; ++r) p1[r] = fmaf(p1[r], C, mnC);
  for (int r = 0; r < 16; ++r) p0[r] = __builtin_amdgcn_exp2f(p0[r]);
}
__device__ __forceinline__ void finishSM(f32x16& p0, f32x16& p1, float alpha, float& l_reg, bf16x8& pa0, bf16x8& pa1, bf16x8& pa2, bf16x8& pa3) {
  for (int r = 0; r < 16; ++r) p1[r] = __builtin_amdgcn_exp2f(p1[r]);
  float ps = 0; for (int r = 0; r < 16; ++r) ps += p0[r]; for (int r = 0; r < 16; ++r) ps += p1[r];
  { auto rr = __builtin_amdgcn_permlane32_swap(__float_as_uint(ps), __float_as_uint(ps), false, false);
    ps = __uint_as_float(rr[0]) + __uint_as_float(rr[1]); }
  l_reg = l_reg * alpha + ps;
#define PK4(P, BASE, OUT) do { unsigned a0 = cvtpk(P[BASE + 0], P[BASE + 1]), a1 = cvtpk(P[BASE + 2], P[BASE + 3]);   \
    unsigned b0 = cvtpk(P[BASE + 4], P[BASE + 5]), b1 = cvtpk(P[BASE + 6], P[BASE + 7]);                              \
    auto r0 = __builtin_amdgcn_permlane32_swap(a0, b0, false, false); auto r1 = __builtin_amdgcn_permlane32_swap(a1, b1, false, false); \
    u32x4 w = {r0[0], r1[0], r0[1], r1[1]}; OUT = *reinterpret_cast<bf16x8*>(&w); } while (0)
  PK4(p0, 0, pa0); PK4(p0, 8, pa1); PK4(p1, 0, pa2); PK4(p1, 8, pa3);
#undef PK4
}
template <int ND0>
__device__ __forceinline__ void qkt(f32x16& p0, f32x16& p1, const LAS char* Ks, const bf16x8* qr, int r32, int hi, int dbase) {
  p0 = f32x16{}; p1 = f32x16{};
#pragma unroll
  for (int d0 = 0; d0 < ND0; ++d0) { int cb = ((dbase + d0) * 16 + hi * 8) * 2;
    bf16x8 b0 = *reinterpret_cast<const LAS bf16x8*>(Ks + KSWZ(r32, cb));
    bf16x8 b1 = *reinterpret_cast<const LAS bf16x8*>(Ks + KSWZ(32 + r32, cb));
    p0 = __builtin_amdgcn_mfma_f32_32x32x16_bf16(b0, qr[d0], p0, 0, 0, 0);
    p1 = __builtin_amdgcn_mfma_f32_32x32x16_bf16(b1, qr[d0], p1, 0, 0, 0); }
}
__device__ __forceinline__ int v_st(int k, int c) { const int kk = (k & ~0xC) | ((k & 4) << 1) | ((k & 8) >> 1); return ((kk >> 3) * 4 + (c >> 5)) * 512 + ((kk & 7) * 32 + (c & 31)) * 2; }
__device__ __forceinline__ int v_st_lin(int k, int c) { return ((k >> 3) * 4 + (c >> 5)) * 512 + ((k & 7) * 32 + (c & 31)) * 2; }
__device__ __forceinline__ int v_rd_base(int lane) { return ((lane & 3) << 3) | (((lane >> 2) & 3) << 6) | (((lane >> 4) & 1) << 5) | (((lane >> 5) & 1) << 8); }
constexpr int v_rd_off(int d0, int ks, int half) { return d0 * 512 + ks * 4096 + half * 2048; }
template <int OFF> __device__ __forceinline__ s16x4 tr_read(int vb) {
  s16x4 r; asm volatile("ds_read_b64_tr_b16 %0, %1 offset:%2" : "=&v"(r) : "v"(vb), "i"(OFF) : "memory"); return r;
}
template <int D0> __device__ __forceinline__ void pv_one(f32x16& od, int vb, bf16x8 pa0, bf16x8 pa1, bf16x8 pa2, bf16x8 pa3) {
  const s16x4 l0 = tr_read<v_rd_off(D0, 0, 0)>(vb), h0 = tr_read<v_rd_off(D0, 0, 1)>(vb), l1 = tr_read<v_rd_off(D0, 1, 0)>(vb), h1 = tr_read<v_rd_off(D0, 1, 1)>(vb);
  const s16x4 l2 = tr_read<v_rd_off(D0, 2, 0)>(vb), h2 = tr_read<v_rd_off(D0, 2, 1)>(vb), l3 = tr_read<v_rd_off(D0, 3, 0)>(vb), h3 = tr_read<v_rd_off(D0, 3, 1)>(vb);
#if defined(DUMMY_TR) && DUMMY_TR
  { s16x4 dd; for (int i = 0; i < DUMMY_TR; ++i) asm volatile("ds_read_b64_tr_b16 %0, %1 offset:%2" : "=&v"(dd) : "v"(vb), "i"(v_rd_off(D0, 0, 0)) : "memory"); }
#endif
#if defined(DUMMY_MFMA) && DUMMY_MFMA
  { f32x4v dm = {0.f, 0.f, 0.f, 0.f}; for (int i = 0; i < DUMMY_MFMA; ++i) asm volatile("v_mfma_f32_16x16x32_bf16 %0, %1, %2, %0" : "+v"(dm) : "v"(pa0), "v"(pa1)); }
#endif
  asm volatile("s_waitcnt lgkmcnt(0)" ::: "memory"); SBAR();
#define PK(L, H) (bf16x8){L[0], L[1], L[2], L[3], H[0], H[1], H[2], H[3]}
  od = __builtin_amdgcn_mfma_f32_32x32x16_bf16(pa0, PK(l0, h0), od, 0, 0, 0);
  od = __builtin_amdgcn_mfma_f32_32x32x16_bf16(pa1, PK(l1, h1), od, 0, 0, 0);
  od = __builtin_amdgcn_mfma_f32_32x32x16_bf16(pa2, PK(l2, h2), od, 0, 0, 0);
  od = __builtin_amdgcn_mfma_f32_32x32x16_bf16(pa3, PK(l3, h3), od, 0, 0, 0);
#undef PK
}
__device__ __forceinline__ void pv_d0(f32x16* o, int vb, bf16x8 pa0, bf16x8 pa1, bf16x8 pa2, bf16x8 pa3) {
  pv_one<0>(o[0], vb, pa0, pa1, pa2, pa3); pv_one<1>(o[1], vb, pa0, pa1, pa2, pa3); pv_one<2>(o[2], vb, pa0, pa1, pa2, pa3); pv_one<3>(o[3], vb, pa0, pa1, pa2, pa3);
}

#ifndef DUMMY_EXP
#define DUMMY_EXP 0
#endif
#ifndef DUMMY_TR
#define DUMMY_TR 0
#endif
#ifndef DUMMY_MFMA
#define DUMMY_MFMA 0
#endif
__device__ __forceinline__ void dummy_exp(float x) { float d; for (int i = 0; i < DUMMY_EXP; ++i) asm volatile("v_exp_f32 %0, %1" : "=v"(d) : "v"(x)); }
__device__ __forceinline__ void expA(f32x16& p0) {
#pragma unroll
  for (int r = 0; r < 16; ++r) { dummy_exp(p0[r]); p0[r] = __builtin_amdgcn_exp2f(p0[r]); }
}
__device__ __forceinline__ void expB_sum_pack(f32x16& p0, f32x16& p1, float& l_reg, bf16x8& pa0, bf16x8& pa1, bf16x8& pa2, bf16x8& pa3) {
#pragma unroll
  for (int r = 0; r < 16; ++r) { dummy_exp(p1[r]); p1[r] = __builtin_amdgcn_exp2f(p1[r]); }
  float ps = 0;
#pragma unroll
  for (int r = 0; r < 16; ++r) ps += p0[r];
#pragma unroll
  for (int r = 0; r < 16; ++r) ps += p1[r];
  { auto rr = __builtin_amdgcn_permlane32_swap(__float_as_uint(ps), __float_as_uint(ps), false, false);
    ps = __uint_as_float(rr[0]) + __uint_as_float(rr[1]); }
  l_reg += ps;
#define PK4(P, BASE, OUT) do { unsigned a0 = cvtpk(P[BASE + 0], P[BASE + 1]), a1 = cvtpk(P[BASE + 2], P[BASE + 3]);   \
    unsigned b0 = cvtpk(P[BASE + 4], P[BASE + 5]), b1 = cvtpk(P[BASE + 6], P[BASE + 7]);                              \
    auto r0 = __builtin_amdgcn_permlane32_swap(a0, b0, false, false); auto r1 = __builtin_amdgcn_permlane32_swap(a1, b1, false, false); \
    u32x4 w = {r0[0], r1[0], r0[1], r1[1]}; OUT = *reinterpret_cast<bf16x8*>(&w); } while (0)
  PK4(p0, 0, pa0); PK4(p0, 8, pa1); PK4(p1, 0, pa2); PK4(p1, 8, pa3);
#undef PK4
}
__device__ __forceinline__ bf16x8 ld8(const bf16_t* p) { return *reinterpret_cast<const bf16x8*>(p); }

constexpr int TP = 132;
__device__ __forceinline__ void tile_to_rows(const f32x16 (&o)[4], LAS float* scr, int r32, int hi, float (&v)[64]) {
#pragma unroll
  for (int d0 = 0; d0 < 4; ++d0)
#pragma unroll
    for (int r = 0; r < 16; ++r) scr[crow(r, hi) * TP + 32 * d0 + r32] = o[d0][r];
  asm volatile("s_waitcnt lgkmcnt(0)" ::: "memory");
#pragma unroll
  for (int i = 0; i < 16; ++i) { const f32x4v t = *(const LAS f32x4v*)(scr + r32 * TP + 64 * hi + 4 * i); v[4 * i] = t[0]; v[4 * i + 1] = t[1]; v[4 * i + 2] = t[2]; v[4 * i + 3] = t[3]; }
}
__device__ __forceinline__ float pair_sum(float x) {
  auto rr = __builtin_amdgcn_permlane32_swap(__float_as_uint(x), __float_as_uint(x), false, false); return __uint_as_float(rr[0]) + __uint_as_float(rr[1]);
}


#define PVX_RD2(L0, H0, D0, KS) do { L0 = tr_read<v_rd_off(D0, KS, 0)>(vb); H0 = tr_read<v_rd_off(D0, KS, 1)>(vb); } while (0)
#define PVX_PK(L, H) (bf16x8){L[0], L[1], L[2], L[3], H[0], H[1], H[2], H[3]}
#define PVX_E(i) do { if (DOEXP) { pn[i] = __builtin_amdgcn_exp2f(pn[i]); psn += pn[i]; } } while (0)
#define PVX_W(n) asm volatile("s_waitcnt lgkmcnt(" #n ")" ::: "memory")
#define PVX_BLOCK(D0, E0) do { \
    PVX_W(6); SBAR(); o[D0] = __builtin_amdgcn_mfma_f32_32x32x16_bf16(pa0, PVX_PK(fl0, fh0), o[D0], 0, 0, 0); PVX_E(E0 + 0); PVX_RD2(fl0, fh0, D0 + 1, 0); SBAR(); \
    PVX_W(6); SBAR(); o[D0] = __builtin_amdgcn_mfma_f32_32x32x16_bf16(pa1, PVX_PK(fl1, fh1), o[D0], 0, 0, 0); PVX_E(E0 + 1); PVX_RD2(fl1, fh1, D0 + 1, 1); SBAR(); \
    PVX_W(6); SBAR(); o[D0] = __builtin_amdgcn_mfma_f32_32x32x16_bf16(pa2, PVX_PK(fl2, fh2), o[D0], 0, 0, 0); PVX_E(E0 + 2); PVX_RD2(fl2, fh2, D0 + 1, 2); SBAR(); \
    PVX_W(6); SBAR(); o[D0] = __builtin_amdgcn_mfma_f32_32x32x16_bf16(pa3, PVX_PK(fl3, fh3), o[D0], 0, 0, 0); PVX_E(E0 + 3); PVX_RD2(fl3, fh3, D0 + 1, 3); SBAR(); } while (0)
template <bool DOEXP>
__device__ __forceinline__ void pv_exp(f32x16* o, int vb, bf16x8 pa0, bf16x8 pa1, bf16x8 pa2, bf16x8 pa3, f32x16& pn, float& psn) {
  s16x4 fl0, fh0, fl1, fh1, fl2, fh2, fl3, fh3;
  asm volatile("s_waitcnt lgkmcnt(0)" ::: "memory");
  PVX_RD2(fl0, fh0, 0, 0); PVX_RD2(fl1, fh1, 0, 1); PVX_RD2(fl2, fh2, 0, 2); PVX_RD2(fl3, fh3, 0, 3);
  PVX_BLOCK(0, 0); PVX_BLOCK(1, 4); PVX_BLOCK(2, 8);
  PVX_W(6); SBAR(); o[3] = __builtin_amdgcn_mfma_f32_32x32x16_bf16(pa0, PVX_PK(fl0, fh0), o[3], 0, 0, 0); PVX_E(12); SBAR();
  PVX_W(4); SBAR(); o[3] = __builtin_amdgcn_mfma_f32_32x32x16_bf16(pa1, PVX_PK(fl1, fh1), o[3], 0, 0, 0); PVX_E(13); SBAR();
  PVX_W(2); SBAR(); o[3] = __builtin_amdgcn_mfma_f32_32x32x16_bf16(pa2, PVX_PK(fl2, fh2), o[3], 0, 0, 0); PVX_E(14); SBAR();
  PVX_W(0); SBAR(); o[3] = __builtin_amdgcn_mfma_f32_32x32x16_bf16(pa3, PVX_PK(fl3, fh3), o[3], 0, 0, 0); PVX_E(15); SBAR();
}
__device__ __forceinline__ void expB_sum_pack2(f32x16& p0, f32x16& p1, float ps, float& l_reg, bf16x8& pa0, bf16x8& pa1, bf16x8& pa2, bf16x8& pa3) {
#pragma unroll
  for (int r = 0; r < 16; ++r) { p1[r] = __builtin_amdgcn_exp2f(p1[r]); ps += p1[r]; }
  { auto rr = __builtin_amdgcn_permlane32_swap(__float_as_uint(ps), __float_as_uint(ps), false, false);
    ps = __uint_as_float(rr[0]) + __uint_as_float(rr[1]); }
  l_reg += ps;
#define PK4(P, BASE, OUT) do { unsigned a0 = cvtpk(P[BASE + 0], P[BASE + 1]), a1 = cvtpk(P[BASE + 2], P[BASE + 3]);   \
    unsigned b0 = cvtpk(P[BASE + 4], P[BASE + 5]), b1 = cvtpk(P[BASE + 6], P[BASE + 7]);                              \
    auto r0 = __builtin_amdgcn_permlane32_swap(a0, b0, false, false); auto r1 = __builtin_amdgcn_permlane32_swap(a1, b1, false, false); \
    u32x4 w = {r0[0], r1[0], r0[1], r1[1]}; OUT = *reinterpret_cast<bf16x8*>(&w); } while (0)
  PK4(p0, 0, pa0); PK4(p0, 8, pa1); PK4(p1, 0, pa2); PK4(p1, 8, pa3);
#undef PK4
}
__device__ __forceinline__ float exp_sum16(f32x16& p0) { float ps = 0.f;
#pragma unroll
  for (int r = 0; r < 16; ++r) { p0[r] = __builtin_amdgcn_exp2f(p0[r]); ps += p0[r]; }
  return ps; }

__device__ __forceinline__ void attn_unit(const int wid, const bf16_t* __restrict__ proj, const char* __restrict__ Kt_bh, const char* __restrict__ Vt_bh, bf16_t* __restrict__ concat, int qrow0, int NT, int h,
                                          LAS char* lds, float lam, float omli, const float* __restrict__ subln) {
  const int lane = lane_id(), tid = wid * 64 + lane, r32 = lane & 31, hi = lane >> 5, rg = wid & 3, c = wid >> 2;
  LAS char* V_lds = lds; LAS char* K_lds = lds + 4 * SHM_V;
  LAS float* li_l = (LAS float*)(lds + 4 * SHM_V + 4 * SHM_K) + wid * 64;
  float l_reg = 0; f32x16 o[4] = {}; bf16x8 qr[4];
  const bf16_t* Qw = proj + (size_t)(qrow0 + rg * 32 + r32) * DP + C_DQ + h * 128 + c * 64 + hi * 8;
#pragma unroll
  for (int d0 = 0; d0 < 4; ++d0) qr[d0] = ld8(Qw + d0 * 16);
  const int vb0 = (int)(uintptr_t)V_lds + v_rd_base(lane);
  const char* kg0 = Kt_bh + wid * 2048 + lane * 16; const char* vg0 = Vt_bh + wid * 2048 + lane * 16;
#define DMA_TILE(tile, slot) do { const size_t to_ = (size_t)(tile) * 16384; \
    __builtin_amdgcn_global_load_lds((const unsigned*)(kg0 + to_), (LAS unsigned*)(K_lds + (slot) * SHM_K + wid * 2048), 16, 0, 0); \
    __builtin_amdgcn_global_load_lds((const unsigned*)(kg0 + to_ + 1024), (LAS unsigned*)(K_lds + (slot) * SHM_K + wid * 2048 + 1024), 16, 0, 0); \
    __builtin_amdgcn_global_load_lds((const unsigned*)(vg0 + to_), (LAS unsigned*)(V_lds + (slot) * SHM_V + wid * 2048), 16, 0, 0); \
    __builtin_amdgcn_global_load_lds((const unsigned*)(vg0 + to_ + 1024), (LAS unsigned*)(V_lds + (slot) * SHM_V + wid * 2048 + 1024), 16, 0, 0); } while (0)
#define BAR() do { asm volatile("s_waitcnt vmcnt(0) lgkmcnt(0)" ::: "memory"); __builtin_amdgcn_s_barrier(); asm volatile("" ::: "memory"); } while (0)
#define STAGE(b) do { if ((b) + 3 < NT) DMA_TILE((b) + 3, ((b) + 3) & 3); } while (0)
#define STAGES(b, slot) do { if ((b) + 3 < NT) DMA_TILE((b) + 3, slot); } while (0)
#define QKT(P0, P1, t) qkt<4>(P0, P1, K_lds + ((t) & 3) * SHM_K, qr, r32, hi, 4 * c)
#define QKTS(P0, P1, slot) qkt<4>(P0, P1, K_lds + (slot) * SHM_K, qr, r32, hi, 4 * c)
#define PV(t) pv_d0(o, vb0 + ((t) & 3) * SHM_V, pa0, pa1, pa2, pa3)
  f32x16 pA0, pA1, pB0, pB1; bf16x8 pa0, pa1, pa2, pa3; float psA = 0.f, psB = 0.f;
#define PVE(t, PN, PSN) do { PSN = 0.f; pv_exp<true>(o, vb0 + ((t) & 3) * SHM_V, pa0, pa1, pa2, pa3, PN, PSN); } while (0)
#define PVES(slot, PN, PSN) do { PSN = 0.f; pv_exp<true>(o, vb0 + (slot) * SHM_V, pa0, pa1, pa2, pa3, PN, PSN); } while (0)
#define PVL(t) do { float d_ = 0.f; pv_exp<false>(o, vb0 + ((t) & 3) * SHM_V, pa0, pa1, pa2, pa3, pA0, d_); } while (0)
  DMA_TILE(0, 0); DMA_TILE(1, 1); DMA_TILE(2, 2);
  BAR();
  QKT(pA0, pA1, 0); psA = exp_sum16(pA0);
  for (int t = 0; t < NT; t += 4) {
    if (c == 0) { BAR(); STAGES(t, 3); } SBAR();
    QKTS(pB0, pB1, 1); expB_sum_pack2(pA0, pA1, psA, l_reg, pa0, pa1, pa2, pa3); SBAR();
    if (c == 1) { BAR(); STAGES(t, 3); } SBAR();
    PVES(0, pB0, psB); SBAR();
    if (c == 0) { BAR(); STAGES(t + 1, 0); } SBAR();
    QKTS(pA0, pA1, 2); expB_sum_pack2(pB0, pB1, psB, l_reg, pa0, pa1, pa2, pa3); SBAR();
    if (c == 1) { BAR(); STAGES(t + 1, 0); } SBAR();
    PVES(1, pA0, psA); SBAR();
    if (c == 0) { BAR(); STAGES(t + 2, 1); } SBAR();
    QKTS(pB0, pB1, 3); expB_sum_pack2(pA0, pA1, psA, l_reg, pa0, pa1, pa2, pa3); SBAR();
    if (c == 1) { BAR(); STAGES(t + 2, 1); } SBAR();
    PVES(2, pB0, psB); SBAR();
    if (c == 0) { BAR(); STAGES(t + 3, 2); } SBAR();
    if (t + 4 < NT) QKTS(pA0, pA1, 0);
    expB_sum_pack2(pB0, pB1, psB, l_reg, pa0, pa1, pa2, pa3); SBAR();
    if (c == 1) { BAR(); STAGES(t + 3, 2); } SBAR();
    PVES(3, pA0, psA);
    SBAR();
  }
#undef PVE
#undef PVES
#undef QKTS
#undef STAGES
#undef PVL
  if (hi == 0) li_l[r32] = l_reg; asm volatile("s_waitcnt lgkmcnt(0)" ::: "memory");
#pragma unroll
  for (int r = 0; r < 16; ++r) { const float rl = __builtin_amdgcn_rcpf(li_l[crow(r, hi)]);
#pragma unroll
    for (int d0 = 0; d0 < 4; ++d0) o[d0][r] *= rl; }
  __syncthreads();
  LAS float* xch = (LAS float*)lds + rg * 4096;
  if (c == 1) {
#pragma unroll
    for (int d0 = 0; d0 < 4; ++d0)
#pragma unroll
      for (int r = 0; r < 16; ++r) xch[(d0 * 16 + r) * 64 + lane] = o[d0][r];
  }
  __syncthreads();
  if (c == 0) {
#pragma unroll
    for (int r = 0; r < 16; ++r) { float s = 0.f;
#pragma unroll
      for (int d0 = 0; d0 < 4; ++d0) { const float d = o[d0][r] - lam * xch[(d0 * 16 + r) * 64 + lane]; o[d0][r] = d; s += d * d; }
      s += __shfl_xor(s, 1); s += __shfl_xor(s, 2); s += __shfl_xor(s, 4); s += __shfl_xor(s, 8); s += __shfl_xor(s, 16);
      const float rr = rsqrtf(s * (1.f / 128.f) + EPS) * omli;
      bf16_t* orow = concat + (size_t)(qrow0 + rg * 32 + crow(r, hi)) * DM + 512 + h * 128 + r32;
#pragma unroll
      for (int d0 = 0; d0 < 4; ++d0) orow[d0 * 32] = f2bf(o[d0][r] * rr * subln[d0 * 32 + r32]); }
  }
  __syncthreads();
#undef DMA_TILE
#undef BAR
#undef STAGE
#undef QKT
#undef PV
}


typedef float f32x2 __attribute__((ext_vector_type(2)));
__device__ __forceinline__ void exp_half(f32x16& ph, f32x2& lacc) {
#pragma unroll
  for (int r = 0; r < 16; r += 2) { ph[r] = __builtin_amdgcn_exp2f(ph[r]); ph[r + 1] = __builtin_amdgcn_exp2f(ph[r + 1]); const f32x2 e = {ph[r], ph[r + 1]}; lacc += e; }
}
__device__ __forceinline__ void pack_half(const f32x16& ph, bf16x8& x0, bf16x8& x1) {
  { u32x4 w = {cvtpk(ph[0], ph[1]), cvtpk(ph[2], ph[3]), cvtpk(ph[4], ph[5]), cvtpk(ph[6], ph[7])}; x0 = *reinterpret_cast<bf16x8*>(&w); }
  { u32x4 w = {cvtpk(ph[8], ph[9]), cvtpk(ph[10], ph[11]), cvtpk(ph[12], ph[13]), cvtpk(ph[14], ph[15])}; x1 = *reinterpret_cast<bf16x8*>(&w); }
}

template <int D0> __device__ __forceinline__ void pv2_block(f32x16& oa, f32x16& ob, int vb, s16x4& fl0, s16x4& fh0, s16x4& fl1, s16x4& fh1, s16x4& fl2, s16x4& fh2, s16x4& fl3, s16x4& fh3,
                                                           bf16x8 a0, bf16x8 a1, bf16x8 a2, bf16x8 a3, bf16x8 b0, bf16x8 b1, bf16x8 b2, bf16x8 b3) {
#define PV2_STEP(A, B, FL, FH, KS, WN) do { asm volatile("s_waitcnt lgkmcnt(" #WN ")" ::: "memory"); SBAR(); \
    oa = __builtin_amdgcn_mfma_f32_32x32x16_bf16(A, PVX_PK(FL, FH), oa, 0, 0, 0); ob = __builtin_amdgcn_mfma_f32_32x32x16_bf16(B, PVX_PK(FL, FH), ob, 0, 0, 0); \
    if (D0 < 3) { FL = tr_read<v_rd_off((D0 + 1) & 3, KS, 0)>(vb); FH = tr_read<v_rd_off((D0 + 1) & 3, KS, 1)>(vb); } SBAR(); } while (0)
  if (D0 < 3) { PV2_STEP(a0, b0, fl0, fh0, 0, 6); PV2_STEP(a1, b1, fl1, fh1, 1, 6); PV2_STEP(a2, b2, fl2, fh2, 2, 6); PV2_STEP(a3, b3, fl3, fh3, 3, 6); }
  else        { PV2_STEP(a0, b0, fl0, fh0, 0, 6); PV2_STEP(a1, b1, fl1, fh1, 1, 4); PV2_STEP(a2, b2, fl2, fh2, 2, 2); PV2_STEP(a3, b3, fl3, fh3, 3, 0); }
#undef PV2_STEP
}
__device__ __forceinline__ void attn_unit3p(const int wid, const bf16_t* __restrict__ proj, const char* __restrict__ Kt_bh, const char* __restrict__ Vt_bh, bf16_t* __restrict__ concat, int qrow0, int NT, int h,
                                            LAS char* lds, float lam, float omli, const float* __restrict__ subln) {
  const int lane = lane_id(), r32 = lane & 31, hi = lane >> 5;
  LAS char* V_lds = lds; LAS char* K_lds = lds + 2 * SHM_V; LAS char* Qw = lds + 65536 + wid * 8192;
  LAS float* li_l = (LAS float*)(lds + 131072) + wid * 64;
  f32x2 l0v = {0.f, 0.f}, l1v = {0.f, 0.f}; f32x16 o0[4] = {}, o1[4] = {};
  const int vb0 = (int)(uintptr_t)V_lds + v_rd_base(lane);
  const char* kg0 = Kt_bh + wid * 2048 + lane * 16; const char* vg0 = Vt_bh + wid * 2048 + lane * 16;
#define DMA_TILE(tile, slot) do { const size_t to_ = (size_t)(tile) * 16384; \
    __builtin_amdgcn_global_load_lds((const unsigned*)(kg0 + to_), (LAS unsigned*)(K_lds + (slot) * SHM_K + wid * 2048), 16, 0, 0); \
    __builtin_amdgcn_global_load_lds((const unsigned*)(kg0 + to_ + 1024), (LAS unsigned*)(K_lds + (slot) * SHM_K + wid * 2048 + 1024), 16, 0, 0); \
    __builtin_amdgcn_global_load_lds((const unsigned*)(vg0 + to_), (LAS unsigned*)(V_lds + (slot) * SHM_V + wid * 2048), 16, 0, 0); \
    __builtin_amdgcn_global_load_lds((const unsigned*)(vg0 + to_ + 1024), (LAS unsigned*)(V_lds + (slot) * SHM_V + wid * 2048 + 1024), 16, 0, 0); } while (0)
#define BAR() do { asm volatile("s_waitcnt vmcnt(0) lgkmcnt(0)" ::: "memory"); __builtin_amdgcn_s_barrier(); asm volatile("" ::: "memory"); } while (0)
  bf16x8 qf00, qf01, qf02, qf03, qf10, qf11, qf12, qf13;
  { const bf16_t* qg = proj + (size_t)(qrow0 + wid * 32 + r32) * DP + C_DQ + h * 128 + hi * 8;
    qf00 = ld8(qg); qf01 = ld8(qg + 16); qf02 = ld8(qg + 32); qf03 = ld8(qg + 48); qf10 = ld8(qg + 64); qf11 = ld8(qg + 80); qf12 = ld8(qg + 96); qf13 = ld8(qg + 112); }
  DMA_TILE(0, 0);
  bf16x8 a0, a1, a2, a3, b0, b1, b2, b3;
  int sw0 = KSWZ(r32, (0 * 16 + hi * 8) * 2), sw1 = KSWZ(r32, (1 * 16 + hi * 8) * 2), sw2 = KSWZ(r32, (2 * 16 + hi * 8) * 2), sw3 = KSWZ(r32, (3 * 16 + hi * 8) * 2);
  int kad0_ = (int)(uintptr_t)K_lds + sw0, kad1_ = (int)(uintptr_t)K_lds + sw1, kad2_ = (int)(uintptr_t)K_lds + sw2, kad3_ = (int)(uintptr_t)K_lds + sw3;
  asm volatile("" : "+v"(kad0_), "+v"(kad1_), "+v"(kad2_), "+v"(kad3_));
  LAS char* const kad0 = (LAS char*)(uintptr_t)kad0_; LAS char* const kad1 = (LAS char*)(uintptr_t)kad1_; LAS char* const kad2 = (LAS char*)(uintptr_t)kad2_; LAS char* const kad3 = (LAS char*)(uintptr_t)kad3_;
#define QK2(P0, P1, so, cc) do { P0 = f32x16{}; P1 = f32x16{}; _Pragma("unroll") for (int d0 = 0; d0 < 4; ++d0) { const int cb = ((4 * (cc) + d0) * 16 + hi * 8) * 2; \
    const bf16x8 ka_ = *reinterpret_cast<const LAS bf16x8*>(K_lds + (so) * SHM_K + KSWZ(r32, cb)), kb_ = *reinterpret_cast<const LAS bf16x8*>(K_lds + (so) * SHM_K + KSWZ(32 + r32, cb)); \
    const bf16x8 q_ = *reinterpret_cast<const LAS bf16x8*>(Qw + KSWZ(r32, cb)); \
    P0 = __builtin_amdgcn_mfma_f32_32x32x16_bf16(ka_, q_, P0, 0, 0, 0); P1 = __builtin_amdgcn_mfma_f32_32x32x16_bf16(kb_, q_, P1, 0, 0, 0); } } while (0)
#define QKA(PH, so, cc, koff) do { PH = f32x16{}; \
    { const bf16x8 k_ = *reinterpret_cast<const LAS bf16x8*>(kad0 + ((so) * SHM_K + (koff) * 256 + 128 * (cc))); PH = __builtin_amdgcn_mfma_f32_32x32x16_bf16(k_, (cc) ? qf10 : qf00, PH, 0, 0, 0); } \
    { const bf16x8 k_ = *reinterpret_cast<const LAS bf16x8*>(kad1 + ((so) * SHM_K + (koff) * 256 + 128 * (cc))); PH = __builtin_amdgcn_mfma_f32_32x32x16_bf16(k_, (cc) ? qf11 : qf01, PH, 0, 0, 0); } } while (0)
#define QKB(PH, so, cc, koff) do { \
    { const bf16x8 k_ = *reinterpret_cast<const LAS bf16x8*>(kad2 + ((so) * SHM_K + (koff) * 256 + 128 * (cc))); PH = __builtin_amdgcn_mfma_f32_32x32x16_bf16(k_, (cc) ? qf12 : qf02, PH, 0, 0, 0); } \
    { const bf16x8 k_ = *reinterpret_cast<const LAS bf16x8*>(kad3 + ((so) * SHM_K + (koff) * 256 + 128 * (cc))); PH = __builtin_amdgcn_mfma_f32_32x32x16_bf16(k_, (cc) ? qf13 : qf03, PH, 0, 0, 0); } } while (0)
#define QKH(PH, so, cc, koff) do { QKA(PH, so, cc, koff); QKB(PH, so, cc, koff); } while (0)
#define SGB(m, n) __builtin_amdgcn_sched_group_barrier(m, n, 0)
#define STEP(PN, so, cc, koff, PO, LV, X0, X1) do { \
    QKA(PN, so, cc, koff); exp_half(PO, LV); SGB(0x100, 2); SGB(0x8, 1); SGB(0x2, 12); SGB(0x8, 1); SGB(0x2, 12); SBAR(); asm volatile("" : "+v"(LV)); SBAR(); \
    QKB(PN, so, cc, koff); pack_half(PO, X0, X1); SGB(0x100, 2); SGB(0x8, 1); SGB(0x2, 4); SGB(0x8, 1); SGB(0x2, 4); MBAR(PN); } while (0)
#define MBAR(X) do { SBAR(); asm volatile("" : "+v"(X) :: "memory"); SBAR(); } while (0)
#define TILE(t, so) do { BAR(); if ((t) + 1 < NT) DMA_TILE((t) + 1, 1 - (so)); SBAR(); \
    { f32x16 p0, p1; \
      QKH(p0, so, 0, 0); MBAR(p0); \
      STEP(p1, so, 0, 32, p0, l0v, a0, a1); \
      STEP(p0, so, 1, 0, p1, l0v, a2, a3); \
      STEP(p1, so, 1, 32, p0, l1v, b0, b1); \
      exp_half(p1, l1v); SBAR(); asm volatile("" : "+v"(l1v)); SBAR(); pack_half(p1, b2, b3); } SBAR(); \
    { const int vb = vb0 + (so) * SHM_V; s16x4 fl0, fh0, fl1, fh1, fl2, fh2, fl3, fh3; \
      asm volatile("s_waitcnt lgkmcnt(0)" ::: "memory"); \
      PVX_RD2(fl0, fh0, 0, 0); PVX_RD2(fl1, fh1, 0, 1); PVX_RD2(fl2, fh2, 0, 2); PVX_RD2(fl3, fh3, 0, 3); \
      pv2_block<0>(o0[0], o1[0], vb, fl0, fh0, fl1, fh1, fl2, fh2, fl3, fh3, a0, a1, a2, a3, b0, b1, b2, b3); \
      pv2_block<1>(o0[1], o1[1], vb, fl0, fh0, fl1, fh1, fl2, fh2, fl3, fh3, a0, a1, a2, a3, b0, b1, b2, b3); \
      pv2_block<2>(o0[2], o1[2], vb, fl0, fh0, fl1, fh1, fl2, fh2, fl3, fh3, a0, a1, a2, a3, b0, b1, b2, b3); \
      pv2_block<3>(o0[3], o1[3], vb, fl0, fh0, fl1, fh1, fl2, fh2, fl3, fh3, a0, a1, a2, a3, b0, b1, b2, b3); } SBAR(); } while (0)
  for (int t = 0; t < NT; t += 2) { TILE(t, 0); TILE(t + 1, 1); }
  const float l0 = pair_sum(l0v[0] + l0v[1]), l1 = pair_sum(l1v[0] + l1v[1]);
  if (hi == 0) { li_l[r32] = l0; li_l[32 + r32] = l1; } asm volatile("s_waitcnt lgkmcnt(0)" ::: "memory");
#pragma unroll
  for (int r = 0; r < 16; ++r) { const float ra = __builtin_amdgcn_rcpf(li_l[crow(r, hi)]), rb = lam * __builtin_amdgcn_rcpf(li_l[32 + crow(r, hi)]);
    float s = 0.f;
#pragma unroll
    for (int d0 = 0; d0 < 4; ++d0) { const float d = o0[d0][r] * ra - o1[d0][r] * rb; o0[d0][r] = d; s += d * d; }
    s += __shfl_xor(s, 1); s += __shfl_xor(s, 2); s += __shfl_xor(s, 4); s += __shfl_xor(s, 8); s += __shfl_xor(s, 16);
    const float rr = rsqrtf(s * (1.f / 128.f) + EPS) * omli;
    bf16_t* orow = concat + (size_t)(qrow0 + wid * 32 + crow(r, hi)) * DM + 512 + h * 128 + r32;
#pragma unroll
    for (int d0 = 0; d0 < 4; ++d0) orow[d0 * 32] = f2bf(o0[d0][r] * rr * subln[d0 * 32 + r32]); }
  asm volatile("s_waitcnt vmcnt(0) lgkmcnt(0)" ::: "memory"); __syncthreads();
#undef DMA_TILE
#undef BAR
#undef QK2
#undef QKH
#undef QKA
#undef QKB
#undef TILE
#undef STEP
#undef MBAR
#undef SGB
}

__device__ __forceinline__ bf16x8 scale8(bf16x8 v, float s) {
  u32x4 w;
#pragma unroll
  for (int i = 0; i < 4; ++i) { const float a = __uint_as_float(((unsigned)(unsigned short)v[2 * i]) << 16) * s, b = __uint_as_float(((unsigned)(unsigned short)v[2 * i + 1]) << 16) * s; w[i] = cvtpk(a, b); }
  return *reinterpret_cast<bf16x8*>(&w);
}
template <int KS> __device__ __forceinline__ void trfrag_issue(int vb, s16x4& l, s16x4& h) { l = tr_read<v_rd_off(0, KS, 0)>(vb); h = tr_read<v_rd_off(0, KS, 1)>(vb); }
#define PKF(L, H) (bf16x8){L[0], L[1], L[2], L[3], H[0], H[1], H[2], H[3]}
template <int KS> __device__ __forceinline__ void cs_step(f32x16* acc, int kb, int vv) {
  s16x4 al, ah, b0l, b0h, b1l, b1h, b2l, b2h, b3l, b3h;
  trfrag_issue<KS>(kb, al, ah); trfrag_issue<KS>(vv, b0l, b0h); trfrag_issue<KS>(vv + 512, b1l, b1h); trfrag_issue<KS>(vv + 1024, b2l, b2h); trfrag_issue<KS>(vv + 1536, b3l, b3h);
  asm volatile("s_waitcnt lgkmcnt(0)" ::: "memory"); SBAR();
  const bf16x8 a = PKF(al, ah);
  acc[0] = __builtin_amdgcn_mfma_f32_32x32x16_bf16(a, PKF(b0l, b0h), acc[0], 0, 0, 0);
  acc[1] = __builtin_amdgcn_mfma_f32_32x32x16_bf16(a, PKF(b1l, b1h), acc[1], 0, 0, 0);
  acc[2] = __builtin_amdgcn_mfma_f32_32x32x16_bf16(a, PKF(b2l, b2h), acc[2], 0, 0, 0);
  acc[3] = __builtin_amdgcn_mfma_f32_32x32x16_bf16(a, PKF(b3l, b3h), acc[3], 0, 0, 0);
}
__device__ __forceinline__ void chunk_state_unit(const int wid, const bf16_t* __restrict__ proj, bf16_t* __restrict__ csf, bf16_t* __restrict__ csb, int rowbase, int h, float lgf2, float lgb2, LAS char* lds) {
  const int lane = lane_id(), tid = wid * 64 + lane, r32 = lane & 31, hi = lane >> 5;
  const int sr = tid >> 4, sc = (tid & 15) * 8;
  { bf16x8 kv[4], vv[4];
#pragma unroll
    for (int g = 0; g < 4; ++g) { const bf16_t* rp = proj + (size_t)(rowbase + 32 * g + sr) * DP + h * 128 + sc; kv[g] = ld8(rp + C_RK); vv[g] = ld8(rp + C_RV); }
#pragma unroll
    for (int g = 0; g < 4; ++g) { const int row = 32 * g + sr;
      const float wf = __builtin_amdgcn_exp2f(lgf2 * (float)(127 - row)), wb = __builtin_amdgcn_exp2f(lgb2 * (float)row);
      const int off = (row >> 6) * 16384 + v_st(row & 63, sc);
      *(LAS bf16x8*)(lds + off) = vv[g]; *(LAS bf16x8*)(lds + 32768 + off) = scale8(kv[g], wf); *(LAS bf16x8*)(lds + 65536 + off) = scale8(kv[g], wb); } }
  __syncthreads();
  const int dir = wid >> 2, ib = wid & 3;
  const int vbK = (int)(uintptr_t)(lds + 32768 + dir * 32768) + v_rd_base(lane) + ib * 512, vbV = (int)(uintptr_t)lds + v_rd_base(lane);
  f32x16 acc[4] = {};
  cs_step<0>(acc, vbK, vbV); cs_step<1>(acc, vbK, vbV); cs_step<2>(acc, vbK, vbV); cs_step<3>(acc, vbK, vbV);
  cs_step<0>(acc, vbK + 16384, vbV + 16384); cs_step<1>(acc, vbK + 16384, vbV + 16384); cs_step<2>(acc, vbK + 16384, vbV + 16384); cs_step<3>(acc, vbK + 16384, vbV + 16384);
  bf16_t* outp = (dir ? csb : csf) + r32;
#pragma unroll
  for (int r = 0; r < 16; ++r) { bf16_t* orow = outp + (size_t)(32 * ib + crow(r, hi)) * 128;
#pragma unroll
    for (int jb = 0; jb < 4; ++jb) orow[32 * jb] = f2bf(acc[jb][r]); }
  __syncthreads();
}
__device__ __forceinline__ void pack_p(const f32x16& p0, const f32x16& p1, bf16x8& pa0, bf16x8& pa1, bf16x8& pa2, bf16x8& pa3) {
#define PK4(P, BASE, OUT) do { unsigned a0 = cvtpk(P[BASE + 0], P[BASE + 1]), a1 = cvtpk(P[BASE + 2], P[BASE + 3]);   \
    unsigned b0 = cvtpk(P[BASE + 4], P[BASE + 5]), b1 = cvtpk(P[BASE + 6], P[BASE + 7]);                              \
    auto r0 = __builtin_amdgcn_permlane32_swap(a0, b0, false, false); auto r1 = __builtin_amdgcn_permlane32_swap(a1, b1, false, false); \
    u32x4 w = {r0[0], r1[0], r0[1], r1[1]}; OUT = *reinterpret_cast<bf16x8*>(&w); } while (0)
  PK4(p0, 0, pa0); PK4(p0, 8, pa1); PK4(p1, 0, pa2); PK4(p1, 8, pa3);
#undef PK4
}
__device__ __forceinline__ float decay_w(int d, float lgf2, float lgb2) {
  const float e = __builtin_amdgcn_exp2f(d < 0 ? lgf2 * (float)(-d) : lgb2 * (float)d); return d == 0 ? 2.f : e;
}
__device__ __forceinline__ void ret_out_unit(const int wid, const bf16_t* __restrict__ proj, bf16_t* __restrict__ concat, const bf16_t* __restrict__ spA, const bf16_t* __restrict__ spB, size_t dstride,
                                             int rowA, int rowB, int h, float lgf2, float lgb2, const float* __restrict__ gn, LAS char* lds) {
  const int lane = lane_id(), tid = wid * 64 + lane, r32 = lane & 31, hi = lane >> 5, rg = wid & 3, ch = wid >> 2;
  const int sr = tid >> 4, sc = (tid & 15) * 8;
  const int rowbase = ch ? rowB : rowA;
  { bf16x8 kv[8], vv[8];
#pragma unroll
    for (int c2 = 0; c2 < 2; ++c2)
#pragma unroll
      for (int g = 0; g < 4; ++g) { const bf16_t* rp = proj + (size_t)((c2 ? rowB : rowA) + 32 * g + sr) * DP + h * 128 + sc; kv[c2 * 4 + g] = ld8(rp + C_RK); vv[c2 * 4 + g] = ld8(rp + C_RV); }
#pragma unroll
    for (int c2 = 0; c2 < 2; ++c2)
#pragma unroll
      for (int g = 0; g < 4; ++g) { const int row = 32 * g + sr;
        *(LAS bf16x8*)(lds + c2 * 65536 + (row >> 6) * 16384 + KSWZ(row & 63, sc * 2)) = kv[c2 * 4 + g];
        *(LAS bf16x8*)(lds + c2 * 65536 + 32768 + (row >> 6) * 16384 + v_st(row & 63, sc)) = vv[c2 * 4 + g]; } }
  bf16x8 qr[8];
  const bf16_t* Qw = proj + (size_t)(rowbase + rg * 32 + r32) * DP + C_RQ + h * 128 + hi * 8;
#pragma unroll
  for (int d0 = 0; d0 < 8; ++d0) qr[d0] = ld8(Qw + d0 * 16);
  __syncthreads();
  const int m = rg * 32 + r32;
  LAS char* myreg = lds + ch * 65536;
  const int vb = (int)(uintptr_t)myreg + v_rd_base(lane);
  f32x16 o[4] = {}; f32x16 p0, p1; bf16x8 pa0, pa1, pa2, pa3;
#pragma unroll
  for (int kt = 0; kt < 2; ++kt) {
    qkt<8>(p0, p1, myreg + kt * 16384, qr, r32, hi, 0);
    int mm = m - 4 * hi; asm volatile("" : "+v"(mm));
#pragma unroll
    for (int r = 0; r < 16; ++r) { const int s0 = 64 * kt + (r & 3) + 8 * (r >> 2); p0[r] *= decay_w(s0 - mm, lgf2, lgb2); p1[r] *= decay_w(s0 + 32 - mm, lgf2, lgb2); }
    pack_p(p0, p1, pa0, pa1, pa2, pa3);
    pv_d0(o, vb + 32768 + kt * 16384, pa0, pa1, pa2, pa3);
  }
  __syncthreads();
  { bf16x8 sv[16];
#pragma unroll
    for (int c2 = 0; c2 < 2; ++c2)
#pragma unroll
      for (int d = 0; d < 2; ++d)
#pragma unroll
        for (int g = 0; g < 4; ++g) sv[(c2 * 2 + d) * 4 + g] = ld8((c2 ? spB : spA) + (size_t)d * dstride + (size_t)(32 * g + sr) * 128 + sc);
#pragma unroll
    for (int c2 = 0; c2 < 2; ++c2)
#pragma unroll
      for (int d = 0; d < 2; ++d)
#pragma unroll
        for (int g = 0; g < 4; ++g) { const int row = 32 * g + sr;
          *(LAS bf16x8*)(lds + c2 * 65536 + d * 32768 + (row >> 6) * 16384 + v_st(row & 63, sc)) = sv[(c2 * 2 + d) * 4 + g]; } }
  const float xf = __builtin_amdgcn_exp2f(lgf2 * (float)(m + 1)), xb = __builtin_amdgcn_exp2f(lgb2 * (float)(128 - m));
  __syncthreads();
#pragma unroll
  for (int d = 0; d < 2; ++d) { const float xs = d ? xb : xf;
#pragma unroll
    for (int sub = 0; sub < 2; ++sub) {
      const bf16x8 a0 = scale8(qr[4 * sub + 0], xs), a1 = scale8(qr[4 * sub + 1], xs), a2 = scale8(qr[4 * sub + 2], xs), a3 = scale8(qr[4 * sub + 3], xs);
      pv_d0(o, vb + d * 32768 + sub * 16384, a0, a1, a2, a3); } }
#pragma unroll
  for (int r = 0; r < 16; ++r) {
    float s = (o[0][r] + o[1][r]) + (o[2][r] + o[3][r]);
    s += __shfl_xor(s, 1); s += __shfl_xor(s, 2); s += __shfl_xor(s, 4); s += __shfl_xor(s, 8); s += __shfl_xor(s, 16);
    const float mu = s * (1.f / 128.f);
    float q = 0.f;
#pragma unroll
    for (int d0 = 0; d0 < 4; ++d0) { const float dd = o[d0][r] - mu; o[d0][r] = dd; q += dd * dd; }
    q += __shfl_xor(q, 1); q += __shfl_xor(q, 2); q += __shfl_xor(q, 4); q += __shfl_xor(q, 8); q += __shfl_xor(q, 16);
    const float rr = rsqrtf(q * (1.f / 128.f) + EPS);
    const size_t grow = (size_t)(rowbase + rg * 32 + crow(r, hi));
    const bf16_t* gp = proj + grow * DP + C_RG + h * 128 + r32; bf16_t* op = concat + grow * DM + h * 128 + r32;
#pragma unroll
    for (int d0 = 0; d0 < 4; ++d0) { const float gv = bf2f(gp[32 * d0]); op[32 * d0] = f2bf(o[d0][r] * rr * gn[32 * d0 + r32] * (gv * __builtin_amdgcn_rcpf(1.f + __builtin_amdgcn_exp2f(-1.4426950408889634f * gv)))); }
  }
  __syncthreads();
}

}


__device__ __forceinline__ float log2_sigmoid(float x) { return -log1pf(__expf(-x)) * 1.4426950408889634f; }
__device__ __forceinline__ bf16_t* cs_ptr(const Params& p, int b, int h, int dir, int j) { return (bf16_t*)(p.ws + WS_CS) + ((size_t)((b * NH + h) * 2 + dir) * 66 + j) * 16384; }
__device__ __forceinline__ void qkrope_phase(const Params& p, Ctx& F, int l) {
    const int lane = lane_id();
    float gq[8], gk[8], fr[8];
#pragma unroll
    for (int i = 0; i < 8; ++i) { gq[i] = p.in[I_QNG][l * 64 + 8 * (lane & 7) + i] * 0.18033688011112042f;
        gk[i] = p.in[I_KNG][l * 64 + 8 * (lane & 7) + i];
        fr[i] = exp2f(-(float)(8 * (lane & 1) + i) * (13.287712379549449f / 16.f)) * 0.15915494309189535f; }
    const bool lowhalf = (lane & 4) == 0;
    for (int m = F.gw; m < NR; m += F.NGW) {
        bf16_t* row = (bf16_t*)(p.ws + WS_PROJ) + (size_t)m * DP;
        v4u* qp = (v4u*)(row + C_DQ) + lane; const v4u* kp = (const v4u*)(row + C_DK) + lane;
        const v4u qv = *qp, kv = *kp, vv = *((const v4u*)(row + C_DV) + lane);
        float q[8], k[8];
#pragma unroll
        for (int i = 0; i < 4; ++i) { q[2 * i] = __uint_as_float(qv[i] << 16); q[2 * i + 1] = __uint_as_float(qv[i] & 0xffff0000u); k[2 * i] = __uint_as_float(kv[i] << 16); k[2 * i + 1] = __uint_as_float(kv[i] & 0xffff0000u); }
        float sq = 0.f, sk = 0.f;
#pragma unroll
        for (int i = 0; i < 8; ++i) { sq += q[i] * q[i]; sk += k[i] * k[i]; }
        sq += __shfl_xor(sq, 1); sq += __shfl_xor(sq, 2); sq += __shfl_xor(sq, 4);
        sk += __shfl_xor(sk, 1); sk += __shfl_xor(sk, 2); sk += __shfl_xor(sk, 4);
        const float rq = rsqrtf(sq * (1.f / 64.f) + EPS), rk = rsqrtf(sk * (1.f / 64.f) + EPS);
#pragma unroll
        for (int i = 0; i < 8; ++i) { q[i] *= rq * gq[i]; k[i] *= rk * gk[i]; }
        if (m < NL) {
            const int t = m % T; const float pos = (float)((lane & 2) ? (t % 64) : (t / 64));
#pragma unroll
            for (int i = 0; i < 8; ++i) {
                const float rev = pos * fr[i]; const float cs = __builtin_amdgcn_cosf(rev), sn = __builtin_amdgcn_sinf(rev);
                const float oq = __shfl_xor(q[i], 4), ok = __shfl_xor(k[i], 4);
                q[i] = lowhalf ? q[i] * cs - oq * sn : q[i] * cs + oq * sn;
                k[i] = lowhalf ? k[i] * cs - ok * sn : k[i] * cs + ok * sn;
            }
        }
        v4u qo, ko;
#pragma unroll
        for (int i = 0; i < 4; ++i) { qo[i] = pk2(q[2 * i], q[2 * i + 1]); ko[i] = pk2(k[2 * i], k[2 * i + 1]); }
        *qp = qo;
        { const int bb = m < NL ? m / T : (m - NL) / TC, kidx = m < NL ? TC + (m % T) : (m - NL) % TC, tile = kidx >> 6, r = kidx & 63, hh = lane >> 4, ci = lane & 15;
          const size_t blk = ((size_t)(bb * NH + hh) * 132 + tile) * 16384;
          *(v4u*)(p.ws + WS_KT + blk + KSWZ(r, 16 * ci)) = ko;
#if FAST_ATT
          *(v4u*)(p.ws + WS_VT + blk + att::v_st_lin(r, 8 * ci)) = vv; }
#else
          *(v4u*)(p.ws + WS_VT + blk + att::v_st(r, 8 * ci)) = vv; }
#endif
    }
}
__device__ __forceinline__ void scan_phase(const Params& p, Ctx& F, int l) {
    const int lane_ = lane_id(), tid_ = F.wave * 64 + lane_;
    unsigned* cs = (unsigned*)(p.ws + WS_CS);
    for (int i = blockIdx.x * (NWAVES * 64) + tid_; i < 16 * 8192; i += F.G * NWAVES * 64) {
        const int combo = i >> 13, e2 = i & 8191, dir = combo & 1, h = (combo >> 1) & 3;
        const float lg2 = log2_sigmoid(dir ? p.in[I_DECB][l * NH + h] : p.in[I_DECF][l * NH + h]);
        const float decay = exp2f(lg2 * 128.f);
        unsigned* base = cs + (size_t)combo * 66 * 8192 + e2;
        float s0 = 0.f, s1 = 0.f;
#pragma unroll 1
        for (int jj = 0; jj < 66; jj += 22) {
            unsigned tv[22];
#pragma unroll
            for (int k = 0; k < 22; ++k) { const int q = jj + k, idx = dir ? (q < 2 ? 1 - q : 67 - q) : q; tv[k] = base[(size_t)idx * 8192]; }
#pragma unroll
            for (int k = 0; k < 22; ++k) { const int q = jj + k, idx = dir ? (q < 2 ? 1 - q : 67 - q) : q;
                base[(size_t)idx * 8192] = pk2(s0, s1);
                s0 = decay * s0 + __uint_as_float(tv[k] << 16); s1 = decay * s1 + __uint_as_float(tv[k] & 0xffff0000u); }
        }
    }
}

#define IN(k) (lo <= (k) && (k) < hi)
#define SEAM(k) do { if (IN(k) && IN((k) + 1)) xcd_barrier(bar, F.wave == 0 && lane_id() == 0); } while (0)
#ifndef REP_ATT
#define REP_ATT 1
#endif
#ifndef REP_RET
#define REP_RET 1
#endif
#ifndef REP_B
#define REP_B 1
#endif
#ifndef REP_H0
#define REP_H0 1
#endif
#ifndef REP_H1
#define REP_H1 1
#endif
#ifndef REP_I1
#define REP_I1 1
#endif
#ifndef REP_P0
#define REP_P0 1
#endif
#ifndef REP_CS
#define REP_CS 1
#endif
#ifndef REP_A
#define REP_A 1
#endif
#ifndef REP_I0
#define REP_I0 1
#endif
#ifndef REP_F0
#define REP_F0 1
#endif
#ifndef REP_G2
#define REP_G2 1
#endif
#ifndef REP_BAR
#define REP_BAR 0
#endif
template <int l>
__device__ __forceinline__ void layer_phases(const Params& p, Ctx& F, const XcdBarrier& bar, const int lo, const int hi) {
    constexpr int base = 1 + 9 * l;

        if (IN(base + 0)) { for (int rep_ = 0; rep_ < REP_A; ++rep_) norm_phase(p, F, l, 0, NR); for (int rep_ = 0; rep_ < REP_BAR; ++rep_) xcd_barrier(bar, F.wave == 0 && lane_id() == 0); SEAM(base + 0); }
        if (IN(base + 1)) {
            pg8::Gemm g{(const bf16_t*)(p.ws + WS_HBUF), (const bf16_t*)(p.ws + W_WIN) + (size_t)l * DP * DM, NR, DP, DM, DM};
            pg8::Order S; S.init(NR / 256, DP / 256, F.G, (int)blockIdx.x);
            pg8::EpiProj E{(bf16_t*)(p.ws + WS_PROJ)};
            { pg8::gemm_phase<pg8::EpiProj, pg8::Order, true, true>(F.lds + RING_OFF, g, S, E, F.wave); if (REP_B > 1) { pg8::gemm_phase<pg8::EpiProj, pg8::Order, true, true>(F.lds + RING_OFF, g, S, E, F.wave); } }
            SEAM(base + 1);
        }
        if (IN(base + 2)) {
            qkrope_phase(p, F, l);
            for (int rep_ = 0; rep_ < REP_CS; ++rep_)
            for (int u = blockIdx.x; u < 8 * 66; u += F.G) {
                const int bh = u & 7, j = u >> 3, b = bh >> 2, h = bh & 3;
                const int rowbase = j < 2 ? NL + b * TC + 128 * j : b * T + 128 * (j - 2);
                att::chunk_state_unit(F.wave, (const bf16_t*)(p.ws + WS_PROJ), cs_ptr(p, b, h, 0, j), cs_ptr(p, b, h, 1, j), rowbase, h,
                                      log2_sigmoid(p.in[I_DECF][l * NH + h]), log2_sigmoid(p.in[I_DECB][l * NH + h]), (LAS char*)(F.lds + RING_OFF));
            }
            SEAM(base + 2);
        }
        if (IN(base + 3)) { scan_phase(p, F, l); SEAM(base + 3); }
        if (IN(base + 4)) {
#if FAST_RET
            for (int rep_ = 0; rep_ < REP_RET; ++rep_)
            for (int u = blockIdx.x; u < (l == 0 ? 8 * 33 : 8 * 32); u += F.G) {
                const int bh = u & 7, jp = (u >> 3) + (l == 0 ? 0 : 1), b = bh >> 2, h = bh & 3;
                const int rowA = jp == 0 ? NL + b * TC : b * T + 128 * (2 * jp - 2);
                att::ret_out_unit(F.wave, (const bf16_t*)(p.ws + WS_PROJ), (bf16_t*)(p.ws + WS_CONCAT), cs_ptr(p, b, h, 0, 2 * jp), cs_ptr(p, b, h, 0, 2 * jp + 1), (size_t)66 * 16384,
                                  rowA, rowA + 128, h, log2_sigmoid(p.in[I_DECF][l * NH + h]), log2_sigmoid(p.in[I_DECB][l * NH + h]), p.in[I_GNG] + l * 512 + h * 128, (LAS char*)(F.lds + RING_OFF));
            }
#endif
#if FAST_ATT
            { const int lane_ = lane_id();
              const float s1 = wave_sum(p.in[I_LQ1][l * 64 + lane_] * p.in[I_LK1][l * 64 + lane_]), s2 = wave_sum(p.in[I_LQ2][l * 64 + lane_] * p.in[I_LK2][l * 64 + lane_]);
              const float li = lam_init_of(l), lam = __expf(s1) - __expf(s2) + li;
#if ATT_V3
              constexpr int nunits = 256 + (l == 0 ? 8 : 0);
              for (int rep_ = 0; rep_ < REP_ATT; ++rep_)
              for (int u = blockIdx.x; u < nunits; u += F.G) {
                  int b, h, qrow0, NT;
                  if (u < 256) { const int bh = u & 7, qb = u >> 3; b = bh >> 2; h = bh & 3; qrow0 = b * T + qb * 256; NT = (TC + T) / 64; }
                  else { const int bh = u - 256; b = bh >> 2; h = bh & 3; qrow0 = NL + b * TC; NT = TC / 64; }
                  att::attn_unit3p(F.wave, (const bf16_t*)(p.ws + WS_PROJ), (const char*)(p.ws + WS_KT) + (size_t)(b * NH + h) * 132 * 16384, (const char*)(p.ws + WS_VT) + (size_t)(b * NH + h) * 132 * 16384, (bf16_t*)(p.ws + WS_CONCAT), qrow0, NT, h, (LAS char*)(F.lds + RING_OFF), lam, 1.f - li, p.in[I_SUBLN] + l * 128);
              }
#else
              constexpr int nunits = 512 + (l == 0 ? 16 : 0);
              for (int rep_ = 0; rep_ < REP_ATT; ++rep_)
              for (int u = blockIdx.x; u < nunits; u += F.G) {
                  int b, h, qrow0, NT;
                  if (u < 512) { const int bh = u & 7, qb = u >> 3; b = bh >> 2; h = bh & 3; qrow0 = b * T + qb * 128; NT = (TC + T) / 64; }
                  else { const int v = u - 512, bh = v & 7, blk = v >> 3; b = bh >> 2; h = bh & 3; qrow0 = NL + b * TC + blk * 128; NT = TC / 64; }
                  att::attn_unit(F.wave, (const bf16_t*)(p.ws + WS_PROJ), (const char*)(p.ws + WS_KT) + (size_t)(b * NH + h) * 132 * 16384, (const char*)(p.ws + WS_VT) + (size_t)(b * NH + h) * 132 * 16384, (bf16_t*)(p.ws + WS_CONCAT), qrow0, NT, h, (LAS char*)(F.lds + RING_OFF), lam, 1.f - li, p.in[I_SUBLN] + l * 128);
              }
#endif
            }
#endif
            SEAM(base + 4);
        }
        if (IN(base + 5)) {
            pg8::Gemm g{(const bf16_t*)(p.ws + WS_CONCAT), (const bf16_t*)(p.ws + W_WOUT) + (size_t)l * DM * DM, NR, DM, DM, DM};
            pg8::Order S; S.init(NL / 256, DM / 256, F.G, (int)blockIdx.x);
            pg8::EpiResid E{l == 0 ? p.in[I_X] : p.out, l == 0 ? p.in[I_CTX] : (const float*)(p.ws + WS_XRC), p.out, (float*)(p.ws + WS_XRC), modv(p, l, 0, 2), modv(p, l, 2, 2)};
            if (REP_F0 > 1 && l == 0) { pg8::gemm_phase<pg8::EpiResid, pg8::Order, true, true>(F.lds + RING_OFF, g, S, E, F.wave); }
            pg8::gemm_phase<pg8::EpiResid, pg8::Order, true, true>(F.lds + RING_OFF, g, S, E, F.wave);
            if constexpr (l == 0) {
                pg8::Gemm g2{(const bf16_t*)(p.ws + WS_CONCAT), (const bf16_t*)(p.ws + W_WOUT), NR, DM, 256, DM};
                pg8::SplitOrder S2; S2.init(NL / 256, 2, DM / 256, DM / 256, F.G, (int)blockIdx.x);
                pg8::EpiPartial E2{(float*)(p.ws + WS_PART), NL / 256, NC};
                pg8::gemm_phase<pg8::EpiPartial, pg8::SplitOrder, true, true>(F.lds + RING_OFF, g2, S2, E2, F.wave);
            }
            SEAM(base + 5);
        }
        if (IN(base + 6)) { if constexpr (l == 0) norm_phase(p, F, 0, 1, NR); else router_phase(p, F); SEAM(base + 6); }
        if constexpr (l == 0) {
            if (IN(8)) {
                pg8::Gemm g{(const bf16_t*)(p.ws + WS_HBUF), (const bf16_t*)(p.ws + W_FGU), NR, 2 * DFF, DM, DM};
                pg8::Order S; S.init(NR / 256, 2 * DFF / 256, F.G, (int)blockIdx.x);
                pg8::EpiSwiglu E{(bf16_t*)(p.ws + WS_ACT)};
                { pg8::gemm_phase<pg8::EpiSwiglu, pg8::Order, true, true>(F.lds + RING_OFF, g, S, E, F.wave); if (REP_H0 > 1) { pg8::gemm_phase<pg8::EpiSwiglu, pg8::Order, true, true>(F.lds + RING_OFF, g, S, E, F.wave); } }
                SEAM(8);
            }
            if (IN(9)) {
                pg8::Gemm g{(const bf16_t*)(p.ws + WS_ACT), (const bf16_t*)(p.ws + W_FD), NR, DM, DFF, DFF};
                pg8::Order S; S.init(NL / 256, DM / 256, F.G, (int)blockIdx.x);
                pg8::EpiResid E{p.out, (const float*)(p.ws + WS_XRC), p.out, (float*)(p.ws + WS_XRC), modv(p, 0, 0, 5), modv(p, 0, 2, 5)};
                if (REP_I0 > 1) { pg8::EpiResid Ed{p.out, (const float*)(p.ws + WS_XRC), (float*)(p.ws + WS_H2S), (float*)(p.ws + WS_H2S) + (size_t)NL * DM, modv(p, 0, 0, 5), modv(p, 0, 2, 5)}; pg8::gemm_phase<pg8::EpiResid, pg8::Order, true, true>(F.lds + RING_OFF, g, S, Ed, F.wave); }
                pg8::gemm_phase<pg8::EpiResid, pg8::Order, true, true>(F.lds + RING_OFF, g, S, E, F.wave);
                {
                    pg8::Gemm g2{(const bf16_t*)(p.ws + WS_ACT), (const bf16_t*)(p.ws + W_FD), NR, DM, 256, DFF};
                    pg8::SplitOrder S2; S2.init(NL / 256, 2, DM / 256, DFF / 256, F.G, (int)blockIdx.x);
                    pg8::EpiPartial E2{(float*)(p.ws + WS_PART), NL / 256, NC};
                    pg8::gemm_phase<pg8::EpiPartial, pg8::SplitOrder, true, true>(F.lds + RING_OFF, g2, S2, E2, F.wave);
                }
                SEAM(9);
            }
        } else {
            if (IN(17)) { for (int rep_ = 0; rep_ < REP_G2; ++rep_) gather_phase(p, F); SEAM(17); }
            if (IN(18)) {
                moe_table(F);
                pg8::Gemm g{(const bf16_t*)(p.ws + WS_H2S), (const bf16_t*)(p.ws + W_MGU), MP_MAX, 2 * DFF, DM / 2, DM / 2};
                pg8::Order S; moe_order(F, S, 2 * DFF / 256, (long)2 * DFF * DM);
                pg8::EpiSwiglu8 E{(unsigned char*)(p.ws + WS_ACTS)};
                { pg8::gemm_phase<pg8::EpiSwiglu8, pg8::Order, true, true, true>(F.lds + RING_OFF, g, S, E, F.wave); if (REP_H1 > 1) { pg8::gemm_phase<pg8::EpiSwiglu8, pg8::Order, true, true, true>(F.lds + RING_OFF, g, S, E, F.wave); } }
                SEAM(18);
            }
            if (IN(19)) {
                moe_table(F);
                pg8::Gemm g{(const bf16_t*)(p.ws + WS_ACTS), (const bf16_t*)(p.ws + W_MD), MP_MAX, DM, DFF / 2, DFF / 2};
                pg8::Order S; moe_order(F, S, DM / 256, (long)DM * DFF);
                pg8::EpiMoeDown E{(bf16_t*)(p.ws + WS_YBUF), (const float*)(p.ws + WS_ROUTE) + 6 * NL + MP_MAX, 1.f / (W8_SCALE * A8_SCALE)};
                { pg8::gemm_phase<pg8::EpiMoeDown, pg8::Order, true, true, true>(F.lds + RING_OFF, g, S, E, F.wave); if (REP_I1 > 1) { pg8::gemm_phase<pg8::EpiMoeDown, pg8::Order, true, true, true>(F.lds + RING_OFF, g, S, E, F.wave); } }
                SEAM(19);
            }
            if (IN(20)) { combine_phase(p, F); }
        }
}
struct MArgs { Params p; int ph_lo, ph_hi, li, pad; };
constexpr int N_PHASES = 21;
__global__ void __launch_bounds__(NWAVES * 64, 2) mega(MArgs args) {
    extern __shared__ __attribute__((aligned(16))) unsigned char lds_raw[];
    const Params& p = args.p;
    Ctx F;
    F.lds = (LAS unsigned char*)lds_raw; F.MISC = (volatile LAS unsigned*)(F.lds + MISC_OFF);
    F.wave = __builtin_amdgcn_readfirstlane((int)threadIdx.x >> 6);
    const int lane_ = lane_id(), tid_ = F.wave * 64 + lane_;
    F.G = gridDim.x; F.gw = blockIdx.x * NWAVES + F.wave; F.NGW = F.G * NWAVES;
    F.ctl = (unsigned*)(p.ws + WS_CTL);
    for (int u = tid_; u < (LDS_BYTES - MISC_OFF) / 4; u += NWAVES * 64) ((LAS unsigned*)(F.lds + MISC_OFF))[u] = 0u;
    __syncthreads();
    XcdBarrier bar = xcd_barrier_post(F.ctl + CW_BAR + args.li * XCD_BAR_WORDS, F.MISC + 8, tid_ == 0);
    const int lo = args.ph_lo, hi = args.ph_hi;

    if (IN(0)) { for (int rep_ = 0; rep_ < REP_P0; ++rep_) { if (rep_) __syncthreads(); p0_prologue(p, F); } SEAM(0); }
    layer_phases<0>(p, F, bar, lo, hi);
    layer_phases<1>(p, F, bar, lo, hi);
#undef IN
#undef SEAM
}

#ifndef FAST_MASK
#define FAST_MASK 0x1u
#endif
static void launch_naive_e(const Params& p, int l, bool ret, bool att, hipStream_t stream) {
    const int nrows_mix = l == 0 ? NR : NL;
    if (ret) k_ret_naive<<<nrows_mix * NH / 4, 256, 0, stream>>>(p, l, nrows_mix);
    if (att) k_attn_naive<<<nrows_mix * NH / 4, 256, 0, stream>>>(p, l, nrows_mix);
}
static void launch_naive(const Params& p, int ph, hipStream_t stream) {
    const int l = ph >= 10 ? 1 : 0, rel = ph == 0 ? -1 : (ph - 1 - 9 * l);
    const int nrows_mix = l == 0 ? NR : NL;
    if (ph == 0) { k_mod<<<(2 * 3 * 6144 + 255) / 256, 256, 0, stream>>>(p); return; }
    switch (rel) {
    case 0: k_norm<<<NR / 4, 256, 0, stream>>>(p, l, 0, NR); break;
    case 1: k_gemm_proj<<<dim3(DP / 64, NR / 4), dim3(64, 4), 0, stream>>>(p, l); break;
    case 2: k_qkrope<<<NR / 4, 256, 0, stream>>>(p, l); break;
    case 3: break;
    case 4: launch_naive_e(p, l, true, true, stream); break;
    case 5: k_gemm_out<<<dim3(DM / 64, nrows_mix / 4), dim3(64, 4), 0, stream>>>(p, l); break;
    case 6: k_norm<<<nrows_mix / 4, 256, 0, stream>>>(p, l, 1, nrows_mix); break;
    case 7: if (l == 0) k_ffn_gu<<<dim3(DFF / 64, NR / 4), dim3(64, 4), 0, stream>>>(p); break;
    case 8: if (l == 0) k_ffn_down<<<dim3(DM / 64, NR / 4), dim3(64, 4), 0, stream>>>(p); else k_moe_gu<<<dim3(DFF / 64, 2 * NL / 4), dim3(64, 4), 0, stream>>>(p); break;
    case 9: k_moe_down<<<dim3(DM / 64, NL / 4), dim3(64, 4), 0, stream>>>(p); break;
    default: break;
    }
}
extern "C" void kernel_launch(void* const* d_in, const int* in_sizes, int n_in, void* d_out, int out_size, void* d_ws, size_t ws_size, hipStream_t stream) {
    static int grid = 0;
    if (grid == 0) {
        if (n_in != 28 || out_size != NL * DM || ws_size < WS_END) { fprintf(stderr, "kernel_launch: unexpected shapes (n_in %d out %d ws %zu need %zu)\n", n_in, out_size, ws_size, (size_t)WS_END); grid = -1; return; }
        int dev = 0, cus = 0, per_cu = 0;
        if (hipGetDevice(&dev) != hipSuccess || hipDeviceGetAttribute(&cus, hipDeviceAttributeMultiprocessorCount, dev) != hipSuccess) { grid = -1; return; }
        if (hipFuncSetAttribute((const void*)mega, hipFuncAttributeMaxDynamicSharedMemorySize, LDS_BYTES) != hipSuccess) { fprintf(stderr, "kernel_launch: hipFuncSetAttribute failed\n"); grid = -1; return; }
        if (hipOccupancyMaxActiveBlocksPerMultiprocessor(&per_cu, (const void*)mega, NWAVES * 64, LDS_BYTES) != hipSuccess || per_cu < 1) { fprintf(stderr, "kernel_launch: occupancy query says %d\n", per_cu); (void)hipGetLastError(); grid = -1; return; }
        grid = cus;
    }
    if (grid < 0) return;
    (void)hipMemsetAsync((char*)d_ws + WS_CTL, 0, CTL_ZERO_BYTES, stream);
    MArgs a{};
    for (int i = 0; i < 28; ++i) a.p.in[i] = (const float*)d_in[i];
    a.p.out = (float*)d_out; a.p.ws = (unsigned char*)d_ws;
    const unsigned mask = FAST_MASK;
    int li = 0, ph = 0;
    while (ph < N_PHASES) {
        if ((mask >> ph) & 1u) { int e = ph; bool cutE = false;
            while (e < N_PHASES && ((mask >> e) & 1u)) { const bool isE = (e == 5 || e == 14); ++e; if (isE && !(FAST_ATT && FAST_RET)) { cutE = true; break; } }
            a.ph_lo = ph; a.ph_hi = e; a.li = li++;
            hipLaunchKernelGGL(mega, dim3(grid), dim3(NWAVES * 64), LDS_BYTES, stream, a);
            if (cutE) launch_naive_e(a.p, e - 1 == 5 ? 0 : 1, !FAST_RET, !FAST_ATT, stream);
            ph = e; }
        else { launch_naive(a.p, ph, stream); ++ph; }
    }
}
```

```cpp
#include <hip/hip_runtime.h>
#include <cstdint>
#include <cstdio>
#define FAST_MASK 0x1fffffu
#define FAST_ATT 1
#define FAST_RET 1

constexpr int NB = 2, T = 8192, DM = 1024, TC = 256;
constexpr int NL = NB * T;
constexpr int NC = NB * TC;
constexpr int NR = NL + NC;
constexpr int DP = 3584, DFF = 2816, NE = 8, NH = 4;
constexpr float EPS = 1e-6f;
constexpr int C_RQ = 0, C_RK = 512, C_RV = 1024, C_RG = 1536, C_DQ = 2048, C_DK = 2560, C_DV = 3072;
constexpr int MP_MAX = 2 * NL + NE * 256;

typedef unsigned short bf16_t;
__device__ __forceinline__ float bf2f(bf16_t v) { return __uint_as_float(((unsigned)v) << 16); }
__device__ __forceinline__ bf16_t f2bf(float f) { unsigned u = __float_as_uint(f); u += 0x7fffu + ((u >> 16) & 1u); return (bf16_t)(u >> 16); }
typedef float f32x2_t __attribute__((ext_vector_type(2)));
typedef __bf16 bf16x2_t __attribute__((ext_vector_type(2)));
__device__ __forceinline__ unsigned pk2(float lo, float hi) { const f32x2_t v = {lo, hi}; const bf16x2_t b = __builtin_convertvector(v, bf16x2_t); return __builtin_bit_cast(unsigned, b); }
__device__ __forceinline__ unsigned pk4_fp8(float a, float b, float c, float d) {
    a = __builtin_amdgcn_fmed3f(a, -448.f, 448.f); b = __builtin_amdgcn_fmed3f(b, -448.f, 448.f); c = __builtin_amdgcn_fmed3f(c, -448.f, 448.f); d = __builtin_amdgcn_fmed3f(d, -448.f, 448.f);
    int r = 0; r = __builtin_amdgcn_cvt_pk_fp8_f32(a, b, r, false); r = __builtin_amdgcn_cvt_pk_fp8_f32(c, d, r, true); return (unsigned)r;
}
constexpr float W8_SCALE = 64.f, A8_SCALE = 8.f;
__device__ __forceinline__ float wave_sum(float v) {
#pragma unroll
    for (int o = 1; o < 64; o <<= 1) v += __shfl_xor(v, o);
    return v;
}
__device__ __forceinline__ int lane_id() { int l = (int)__builtin_amdgcn_mbcnt_hi(~0u, __builtin_amdgcn_mbcnt_lo(~0u, 0u)); asm volatile("" : "+v"(l)); return l; }
__device__ __forceinline__ float siluf(float v) { return v / (1.f + __expf(-v)); }

constexpr size_t MiB = 1u << 20;
constexpr size_t WS_CTL = 0, CTL_ZERO_BYTES = 1 * MiB;
constexpr size_t WS_MODV = 1 * MiB;
constexpr size_t WS_ROUTE = 2 * MiB;
constexpr size_t WS_XRC = 3 * MiB;
constexpr size_t WS_W = 6 * MiB;
constexpr size_t W_WIN = WS_W;
constexpr size_t W_WOUT = W_WIN + (size_t)2 * DP * DM * 2;
constexpr size_t W_FGU = W_WOUT + (size_t)2 * DM * DM * 2;
constexpr size_t W_FD = W_FGU + (size_t)2 * DFF * DM * 2;
constexpr size_t W_MGU = W_FD + (size_t)DM * DFF * 2;
constexpr size_t W_MD = W_MGU + (size_t)NE * 2 * DFF * DM * 2;
constexpr size_t W_END = W_MD + (size_t)NE * DM * DFF * 2;
constexpr size_t WS_HBUF = 173 * MiB;
constexpr size_t WS_PROJ = 206 * MiB;
constexpr size_t WS_CONCAT = 322 * MiB;
constexpr size_t WS_ACT = 206 * MiB;
constexpr size_t WS_ACTS = 173 * MiB;
constexpr size_t WS_H2S = 361 * MiB;
constexpr size_t WS_KT = 394 * MiB, WS_VT = WS_KT + (size_t)NB * NH * 132 * 16384;
static_assert(WS_VT + (size_t)NB * NH * 132 * 16384 <= 429 * MiB && WS_H2S + (size_t)NB * NH * 2 * 66 * 32768 <= WS_KT, "K/V tile images");
constexpr size_t WS_YBUF = WS_H2S, WS_CS = WS_H2S, WS_PART = WS_H2S;
constexpr size_t WS_END = 430 * MiB;
static_assert(W_END <= WS_HBUF && WS_ACTS + (size_t)MP_MAX * DFF * 2 <= WS_H2S && WS_H2S + (size_t)MP_MAX * DM * 2 <= WS_END && WS_ACT + (size_t)2 * NL * DFF * 2 <= WS_END, "ws map");
constexpr int CW_BAR = 4096;
constexpr int CW_CNT = 200000;

struct Params {
    const float* in[28];
    float* out;
    unsigned char* ws;
};
enum { I_X = 0, I_C, I_CTX, I_CCTX, I_ADAW, I_ADAB, I_N1G, I_N2G, I_WIN, I_DECF, I_DECB, I_GNG, I_QNG, I_KNG, I_LQ1, I_LK1, I_LQ2, I_LK2, I_SUBLN, I_WOUT,
       I_FWG, I_FWU, I_FWD, I_RW, I_RB, I_MWG, I_MWU, I_MWD };

__device__ __forceinline__ int rowtype(int m) { return m < NL ? m / T : 2; }
__device__ __forceinline__ const float* modv(const Params& p, int l, int rt, int i) { return (const float*)(p.ws + WS_MODV) + ((size_t)(l * 3 + rt) * 6 + i) * DM; }
__device__ __forceinline__ float* xr_row(const Params& p, int m) { return m < NL ? p.out + (size_t)m * DM : (float*)(p.ws + WS_XRC) + (size_t)(m - NL) * DM; }
__device__ __forceinline__ float lam_init_of(int l) { return l == 0 ? 0.2f : (0.8f - 0.6f * 0.74081822068171788f); }

#ifndef ATT_UNIT
#define ATT_UNIT attn_unit3q
#endif
#ifndef FAST_ATT
#define FAST_ATT 0
#endif
#ifndef FAST_RET
#define FAST_RET 0
#endif
#ifndef ATT_V3
#define ATT_V3 1
#endif
__global__ void k_mod(Params p) {
    const int idx = blockIdx.x * blockDim.x + threadIdx.x;
    if (idx >= 2 * 3 * 6144) return;
    const int n = idx % 6144, rt = (idx / 6144) % 3, l = idx / (6144 * 3);
    const float* cv = rt < 2 ? p.in[I_C] + rt * DM : p.in[I_CCTX];
    const float* W = p.in[I_ADAW] + (size_t)l * DM * 6144;
    float acc = 0.f;
    for (int k = 0; k < DM; ++k) acc += siluf(cv[k]) * W[(size_t)k * 6144 + n];
    ((float*)(p.ws + WS_MODV))[(size_t)(l * 3 + rt) * 6144 + n] = acc + p.in[I_ADAB][l * 6144 + n];
}

__global__ void k_norm(Params p, int l, int which, int nrows) {
    const int m = blockIdx.x * (blockDim.x / 64) + (threadIdx.x >> 6), lane = threadIdx.x & 63;
    if (m >= nrows) return;
    const float* xrow;
    if (l == 0 && which == 0) xrow = m < NL ? p.in[I_X] + (size_t)m * DM : p.in[I_CTX] + (size_t)(m - NL) * DM;
    else xrow = xr_row(p, m);
    const int rt = rowtype(m);
    const float* g = p.in[which ? I_N2G : I_N1G] + l * DM;
    const float* sh = modv(p, l, rt, which ? 3 : 0);
    const float* sc = modv(p, l, rt, which ? 4 : 1);
    float v[16]; float ss = 0.f;
#pragma unroll
    for (int j = 0; j < 4; ++j) { const float4 t = *(const float4*)(xrow + 256 * j + 4 * lane); v[4 * j] = t.x; v[4 * j + 1] = t.y; v[4 * j + 2] = t.z; v[4 * j + 3] = t.w; ss += t.x * t.x + t.y * t.y + t.z * t.z + t.w * t.w; }
    const float r = rsqrtf(wave_sum(ss) * (1.f / DM) + EPS);
    bf16_t* hb = (bf16_t*)(p.ws + WS_HBUF) + (size_t)m * DM;
#pragma unroll
    for (int j = 0; j < 4; ++j)
#pragma unroll
        for (int q = 0; q < 4; ++q) { const int col = 256 * j + 4 * lane + q; const float y = v[4 * j + q] * r * g[col]; v[4 * j + q] = y * (1.f + sc[col]) + sh[col]; hb[col] = f2bf(v[4 * j + q]); }
    if (l == 1 && which == 1) {
        const float* rw = p.in[I_RW]; float lg[8];
#pragma unroll
        for (int e = 0; e < 8; ++e) { float a = 0.f;
#pragma unroll
            for (int j = 0; j < 4; ++j)
#pragma unroll
                for (int q = 0; q < 4; ++q) a += v[4 * j + q] * rw[(size_t)(256 * j + 4 * lane + q) * 8 + e];
            lg[e] = wave_sum(a) + p.in[I_RB][e]; }
        int i1 = 0; float v1 = lg[0];
#pragma unroll
        for (int e = 1; e < 8; ++e) if (lg[e] > v1) { v1 = lg[e]; i1 = e; }
        int i2 = -1; float v2 = -3.4e38f;
#pragma unroll
        for (int e = 0; e < 8; ++e) if (e != i1 && lg[e] > v2) { v2 = lg[e]; i2 = e; }
        const float w1 = 1.f / (1.f + __expf(v2 - v1));
        if (lane == 0) { int* te = (int*)(p.ws + WS_ROUTE); float* tw = (float*)(p.ws + WS_ROUTE) + 2 * NL; te[2 * m] = i1; te[2 * m + 1] = i2; tw[2 * m] = w1; tw[2 * m + 1] = 1.f - w1; }
    }
}

__global__ void k_gemm_proj(Params p, int l) {
    const int n = blockIdx.x * 64 + threadIdx.x, m = blockIdx.y * 4 + threadIdx.y;
    const bf16_t* a = (const bf16_t*)(p.ws + WS_HBUF) + (size_t)m * DM;
    const float* W = p.in[I_WIN] + (size_t)l * DM * DP + n;
    float acc = 0.f;
#pragma unroll 8
    for (int k = 0; k < DM; ++k) acc += bf2f(a[k]) * W[(size_t)k * DP];
    if (n >= C_RK && n < C_RV) acc *= 0.08838834764831845f;
    ((bf16_t*)(p.ws + WS_PROJ))[(size_t)m * DP + n] = f2bf(acc);
}

__global__ void k_qkrope(Params p, int l) {
    const int m = blockIdx.x * (blockDim.x / 64) + (threadIdx.x >> 6), lane = threadIdx.x & 63;
    if (m >= NR) return;
    bf16_t* row = (bf16_t*)(p.ws + WS_PROJ) + (size_t)m * DP;
    const bool lat = m < NL; const int t = m % T;
    const int j = lane & 31; const float pos = (float)((j < 16) ? (t / 64) : (t % 64));
    const float inv_freq = exp2f(-(float)(j & 15) * (13.287712379549449f / 16.f));
    const float ang = pos * inv_freq; const float cs = __cosf(ang), sn = __sinf(ang);
    for (int part = 0; part < 2; ++part) {
        const float* g = p.in[part ? I_KNG : I_QNG] + l * 64;
        for (int hc = 0; hc < 8; ++hc) {
            bf16_t* q = row + (part ? C_DK : C_DQ) + hc * 64;
            const float v = bf2f(q[lane]);
            const float r = rsqrtf(wave_sum(v * v) * (1.f / 64.f) + EPS);
            float y = v * r * g[lane];
            if (lat) { const float o = __shfl_xor(y, 32); y = lane < 32 ? y * cs - o * sn : y * cs + o * sn; }
            if (part == 0) y *= 0.18033688011112042f;
            q[lane] = f2bf(y);
        }
    }
}

__global__ void k_ret_naive(Params p, int l, int nrows) {
    const int w = blockIdx.x * (blockDim.x / 64) + (threadIdx.x >> 6), lane = threadIdx.x & 63;
    if (w >= nrows * NH) return;
    const int m = w / NH, h = w % NH;
    const bf16_t* proj = (const bf16_t*)(p.ws + WS_PROJ);
    const float df = p.in[I_DECF][l * NH + h], db = p.in[I_DECB][l * NH + h];
    const float lgf = -log1pf(__expf(-df)), lgb = -log1pf(__expf(-db));
    const bf16_t* qrow = proj + (size_t)m * DP + C_RQ + h * 128 + 2 * lane;
    const float q0 = bf2f(qrow[0]), q1 = bf2f(qrow[1]);
    float o0 = 0.f, o1 = 0.f;
    if (m < NL) {
        const int b = m / T, t = m % T;
        for (int s = 0; s < T; ++s) {
            const bf16_t* kr = proj + (size_t)(b * T + s) * DP + h * 128 + 2 * lane;
            const float dot = wave_sum(q0 * bf2f(kr[C_RK]) + q1 * bf2f(kr[C_RK + 1]));
            const float wgt = s < t ? __expf(lgf * (float)(t - s)) : (s == t ? 2.f : __expf(lgb * (float)(s - t)));
            o0 += wgt * dot * bf2f(kr[C_RV]); o1 += wgt * dot * bf2f(kr[C_RV + 1]);
        }
        for (int i = 0; i < TC; ++i) {
            const bf16_t* kr = proj + (size_t)(NL + b * TC + i) * DP + h * 128 + 2 * lane;
            const float dot = wave_sum(q0 * bf2f(kr[C_RK]) + q1 * bf2f(kr[C_RK + 1]));
            const float wgt = __expf(lgf * (float)(t + TC - i)) + __expf(lgb * (float)(T - t + i));
            o0 += wgt * dot * bf2f(kr[C_RV]); o1 += wgt * dot * bf2f(kr[C_RV + 1]);
        }
    } else {
        const int b = (m - NL) / TC, t = (m - NL) % TC;
        for (int s = 0; s < TC; ++s) {
            const bf16_t* kr = proj + (size_t)(NL + b * TC + s) * DP + h * 128 + 2 * lane;
            const float dot = wave_sum(q0 * bf2f(kr[C_RK]) + q1 * bf2f(kr[C_RK + 1]));
            const float wgt = s < t ? __expf(lgf * (float)(t - s)) : (s == t ? 2.f : __expf(lgb * (float)(s - t)));
            o0 += wgt * dot * bf2f(kr[C_RV]); o1 += wgt * dot * bf2f(kr[C_RV + 1]);
        }
    }
    const float mu = wave_sum(o0 + o1) * (1.f / 128.f);
    const float d0 = o0 - mu, d1 = o1 - mu;
    const float r = rsqrtf(wave_sum(d0 * d0 + d1 * d1) * (1.f / 128.f) + EPS);
    const float* gn = p.in[I_GNG] + l * 512 + h * 128 + 2 * lane;
    const bf16_t* gr = proj + (size_t)m * DP + C_RG + h * 128 + 2 * lane;
    bf16_t* cc = (bf16_t*)(p.ws + WS_CONCAT) + (size_t)m * DM + h * 128 + 2 * lane;
    cc[0] = f2bf(siluf(bf2f(gr[0])) * d0 * r * gn[0]);
    cc[1] = f2bf(siluf(bf2f(gr[1])) * d1 * r * gn[1]);
}

__global__ void k_attn_naive(Params p, int l, int nrows) {
    const int w = blockIdx.x * (blockDim.x / 64) + (threadIdx.x >> 6), lane = threadIdx.x & 63;
    if (w >= nrows * NH) return;
    const int m = w / NH, h = w % NH;
    const bf16_t* proj = (const bf16_t*)(p.ws + WS_PROJ);
    const bool lat = m < NL; const int b = lat ? m / T : (m - NL) / TC;
    float O[2][2];
    for (int c = 0; c < 2; ++c) {
        const float q = bf2f(proj[(size_t)m * DP + C_DQ + h * 128 + c * 64 + lane]);
        float mx = -1e30f, ls = 0.f, o0 = 0.f, o1 = 0.f;
        const int nk = lat ? TC + T : TC;
        for (int s = 0; s < nk; ++s) {
            const int mk = s < TC ? NL + b * TC + s : b * T + (s - TC);
            const bf16_t* kr = proj + (size_t)mk * DP + h * 128;
            const float sc = wave_sum(q * bf2f(kr[C_DK + c * 64 + lane]));
            const float mn = fmaxf(mx, sc), al = exp2f(mx - mn), pp = exp2f(sc - mn);
            ls = ls * al + pp; o0 = o0 * al + pp * bf2f(kr[C_DV + 2 * lane]); o1 = o1 * al + pp * bf2f(kr[C_DV + 2 * lane + 1]); mx = mn;
        }
        O[c][0] = o0 / ls; O[c][1] = o1 / ls;
    }
    float s1 = 0.f, s2 = 0.f;
    { const float a = p.in[I_LQ1][l * 64 + lane] * p.in[I_LK1][l * 64 + lane], bq = p.in[I_LQ2][l * 64 + lane] * p.in[I_LK2][l * 64 + lane]; s1 = wave_sum(a); s2 = wave_sum(bq); }
    const float li = lam_init_of(l), lam = __expf(s1) - __expf(s2) + li;
    const float d0 = O[0][0] - lam * O[1][0], d1 = O[0][1] - lam * O[1][1];
    const float r = rsqrtf(wave_sum(d0 * d0 + d1 * d1) * (1.f / 128.f) + EPS);
    const float* sg = p.in[I_SUBLN] + l * 128 + 2 * lane;
    bf16_t* cc = (bf16_t*)(p.ws + WS_CONCAT) + (size_t)m * DM + 512 + h * 128 + 2 * lane;
    cc[0] = f2bf(d0 * r * sg[0] * (1.f - li)); cc[1] = f2bf(d1 * r * sg[1] * (1.f - li));
}

__global__ void k_gemm_out(Params p, int l) {
    const int n = blockIdx.x * 64 + threadIdx.x, m = blockIdx.y * 4 + threadIdx.y;
    const bf16_t* a = (const bf16_t*)(p.ws + WS_CONCAT) + (size_t)m * DM;
    const float* W = p.in[I_WOUT] + (size_t)l * DM * DM + n;
    float acc = 0.f;
#pragma unroll 8
    for (int k = 0; k < DM; ++k) acc += bf2f(a[k]) * W[(size_t)k * DM];
    const float xin = l == 0 ? (m < NL ? p.in[I_X][(size_t)m * DM + n] : p.in[I_CTX][(size_t)(m - NL) * DM + n]) : xr_row(p, m)[n];
    xr_row(p, m)[n] = xin + modv(p, l, rowtype(m), 2)[n] * acc;
}

__global__ void k_ffn_gu(Params p) {
    const int j = blockIdx.x * 64 + threadIdx.x, m = blockIdx.y * 4 + threadIdx.y;
    const bf16_t* a = (const bf16_t*)(p.ws + WS_HBUF) + (size_t)m * DM;
    const float* Wg = p.in[I_FWG] + j; const float* Wu = p.in[I_FWU] + j;
    float ag = 0.f, au = 0.f;
#pragma unroll 8
    for (int k = 0; k < DM; ++k) { const float x = bf2f(a[k]); ag += x * Wg[(size_t)k * DFF]; au += x * Wu[(size_t)k * DFF]; }
    ((bf16_t*)(p.ws + WS_ACT))[(size_t)m * DFF + j] = f2bf(siluf(ag) * au);
}
__global__ void k_ffn_down(Params p) {
    const int n = blockIdx.x * 64 + threadIdx.x, m = blockIdx.y * 4 + threadIdx.y;
    const bf16_t* a = (const bf16_t*)(p.ws + WS_ACT) + (size_t)m * DFF;
    const float* W = p.in[I_FWD] + n;
    float acc = 0.f;
#pragma unroll 8
    for (int k = 0; k < DFF; ++k) acc += bf2f(a[k]) * W[(size_t)k * DM];
    xr_row(p, m)[n] += modv(p, 0, rowtype(m), 5)[n] * acc;
}
__global__ void k_moe_gu(Params p) {
    const int j = blockIdx.x * 64 + threadIdx.x, ts = blockIdx.y * 4 + threadIdx.y;
    const int t = ts >> 1; const int e = ((const int*)(p.ws + WS_ROUTE))[ts];
    const bf16_t* a = (const bf16_t*)(p.ws + WS_HBUF) + (size_t)t * DM;
    const float* Wg = p.in[I_MWG] + (size_t)e * DM * DFF + j; const float* Wu = p.in[I_MWU] + (size_t)e * DM * DFF + j;
    float ag = 0.f, au = 0.f;
#pragma unroll 8
    for (int k = 0; k < DM; ++k) { const float x = bf2f(a[k]); ag += x * Wg[(size_t)k * DFF]; au += x * Wu[(size_t)k * DFF]; }
    ((bf16_t*)(p.ws + WS_ACT))[(size_t)ts * DFF + j] = f2bf(siluf(ag) * au);
}
__global__ void k_moe_down(Params p) {
    const int n = blockIdx.x * 64 + threadIdx.x, t = blockIdx.y * 4 + threadIdx.y;
    const int* te = (const int*)(p.ws + WS_ROUTE); const float* tw = (const float*)(p.ws + WS_ROUTE) + 2 * NL;
    float y = 0.f;
    for (int s = 0; s < 2; ++s) {
        const bf16_t* a = (const bf16_t*)(p.ws + WS_ACT) + (size_t)(2 * t + s) * DFF;
        const float* W = p.in[I_MWD] + (size_t)te[2 * t + s] * DFF * DM + n;
        float acc = 0.f;
#pragma unroll 8
        for (int k = 0; k < DFF; ++k) acc += bf2f(a[k]) * W[(size_t)k * DM];
        y += tw[2 * t + s] * acc;
    }
    p.out[(size_t)t * DM + n] += modv(p, 1, t / T, 5)[n] * y;
}


typedef unsigned v2u __attribute__((ext_vector_type(2)));
namespace pg8 {
#define PG8_LAS __attribute__((address_space(3)))
typedef unsigned short bf16_t;
typedef short bf16x8 __attribute__((ext_vector_type(8)));
typedef float f32x4 __attribute__((ext_vector_type(4)));
typedef unsigned u32x4 __attribute__((ext_vector_type(4)));
typedef int i32x4 __attribute__((ext_vector_type(4)));
typedef int i32x8 __attribute__((ext_vector_type(8)));
constexpr int BM = 256, BK = 64, HALF = 128, HTB = HALF * BK * 2  , STAGE_BYTES = 8 * HTB, NXCD = 8, WGM = 8;

__host__ __device__ __forceinline__ int lds_byte(int r, int c) { const int st = (r >> 4) * 2 + (c >> 5), rr = r & 15, cc = c & 31, ob = rr * 64 + cc * 2; return st * 1024 + (ob ^ (((ob >> 9) & 1) << 5)); }
__host__ __device__ __forceinline__ void stage_rc(int b, int& R, int& C) { const int st = b / 1024, sb = b % 1024, swz = sb ^ (((sb >> 9) & 1) << 5); R = (st >> 1) * 16 + swz / 64; C = (st & 1) * 32 + (swz % 64) / 2; }
__host__ __device__ __forceinline__ int perm32(int rho) { const int n = rho >> 4, i = rho & 15; return 8 * (i >> 2) + 4 * n + (i & 3); }

struct Unit { int pm, pn; long bofs, kofs; };
struct Gemm { const bf16_t* A; const bf16_t* Bt; int M, N, K, ld; };

struct Order {
    int nM, nN, nwg, G, c;
    int e1, e2, e3, e4, e5, e6, e7; long estride;
    __device__ __forceinline__ void init(int nM_, int nN_, int G_, int c_) { nM = nM_; nN = nN_; nwg = nM * nN; G = G_; c = c_; estride = 0; e1 = e2 = e3 = e4 = e5 = e6 = e7 = 0; }
    __device__ __forceinline__ bool next(int i, Unit& u) const {
        const long L = (long)i * G + c; if (L >= nwg) return false;
        int wgid = (int)L; { const int q = nwg / NXCD, r = nwg % NXCD, xcd = wgid % NXCD, off = wgid / NXCD; wgid = (xcd < r ? xcd * (q + 1) : r * (q + 1) + (xcd - r) * q) + off; }
        const int nig = WGM * nN, gid = wgid / nig, fm = gid * WGM, gsz = (nM - fm) < WGM ? (nM - fm) : WGM;
        u.pm = fm + ((wgid % nig) % gsz); u.pn = (wgid % nig) / gsz;
        const int e = (u.pm >= e1) + (u.pm >= e2) + (u.pm >= e3) + (u.pm >= e4) + (u.pm >= e5) + (u.pm >= e6) + (u.pm >= e7);
        u.bofs = estride ? (long)e * estride : 0; u.kofs = 0;
        return true;
    }
    __device__ __forceinline__ void a_ready(const Unit&) const {}
    __device__ __forceinline__ void done(const Unit&) const {}
};

struct SplitOrder {
    int nN, ns, nwg, G, c, pm0;
    __device__ __forceinline__ void init(int pm0_, int npan, int nN_, int ns_, int G_, int c_) { pm0 = pm0_; nN = nN_; ns = ns_; nwg = npan * nN * ns; G = G_; c = c_; }
    __device__ __forceinline__ bool next(int i, Unit& u) const {
        const int L = i * G + c; if (L >= nwg) return false;
        const int ks = L % ns, rest = L / ns; u.pn = rest % nN; u.pm = pm0 + rest / nN; u.bofs = 0; u.kofs = (long)ks * 256 * 2; return true;
    }
    __device__ __forceinline__ void a_ready(const Unit&) const {}
    __device__ __forceinline__ void done(const Unit&) const {}
};
__device__ __forceinline__ unsigned cvt_pk_bf16(float lo, float hi) { unsigned r; asm volatile("v_cvt_pk_bf16_f32 %0, %1, %2" : "=v"(r) : "v"(lo), "v"(hi)); return r; }
__device__ __forceinline__ float silu_fast(float x) { return x * __builtin_amdgcn_rcpf(1.f + __builtin_amdgcn_exp2f(-1.4426950408889634f * x)); }

struct EpiProj {
    static constexpr bool PERM = true, AFTER_DRAIN = false;
    bf16_t* O;
    __device__ __forceinline__ void operator()(const f32x4 (&acc)[2][2][4][2], const Unit& u, int wr, int wc, int fr, int fq) const {
        const int row0 = u.pm * BM + wr * 64 + fr, col0 = u.pn * BM + wc * 32 + 8 * fq;
        const float sc = (u.pn == 2 || u.pn == 3) ? 0.08838834764831845f : 1.f;
#pragma unroll
        for (int ai = 0; ai < 2; ++ai)
#pragma unroll
            for (int m = 0; m < 4; ++m) { bf16_t* rowp = O + (size_t)(row0 + ai * HALF + m * 16) * DP + col0;
#pragma unroll
                for (int bj = 0; bj < 2; ++bj) { const f32x4 v0 = acc[ai][bj][m][0] * sc, v1 = acc[ai][bj][m][1] * sc;
                    u32x4 w; w.x = cvt_pk_bf16(v0[0], v0[1]); w.y = cvt_pk_bf16(v0[2], v0[3]); w.z = cvt_pk_bf16(v1[0], v1[1]); w.w = cvt_pk_bf16(v1[2], v1[3]);
                    *(u32x4*)(rowp + bj * HALF) = w; } }
    }
};
struct EpiResid {
    static constexpr bool PERM = false, AFTER_DRAIN = false;
    const float* base_lat; const float* base_ctx; float* out_lat; float* out_ctx; const float* gl; const float* gc;
    __device__ __forceinline__ void operator()(const f32x4 (&acc)[2][2][4][2], const Unit& u, int wr, int wc, int fr, int fq) const {
        const bool lat = u.pm < NL / BM;
        const int row0 = (lat ? u.pm * BM : u.pm * BM - NL) + wr * 64 + fr, col0 = u.pn * BM + wc * 32 + 4 * fq;
        const float* base = lat ? base_lat : base_ctx; float* out = lat ? out_lat : out_ctx;
        const float* gate = lat ? gl + (size_t)(u.pm / (T / BM)) * 6 * DM : gc;
        f32x4 gv[2][2];
#pragma unroll
        for (int bj = 0; bj < 2; ++bj)
#pragma unroll
            for (int n = 0; n < 2; ++n) gv[bj][n] = *(const f32x4*)(gate + col0 + bj * HALF + n * 16);
#pragma unroll
        for (int ai = 0; ai < 2; ++ai)
#pragma unroll
            for (int m = 0; m < 4; ++m) { const size_t off = (size_t)(row0 + ai * HALF + m * 16) * DM + col0;
#pragma unroll
                for (int bj = 0; bj < 2; ++bj)
#pragma unroll
                    for (int n = 0; n < 2; ++n) { const f32x4 bs = *(const f32x4*)(base + off + bj * HALF + n * 16); *(f32x4*)(out + off + bj * HALF + n * 16) = bs + gv[bj][n] * acc[ai][bj][m][n]; }
                asm volatile("" ::: "memory"); }
    }
};
struct EpiPartial {
    static constexpr bool PERM = false, AFTER_DRAIN = false;
    float* part; int pm0, nrows;
    __device__ __forceinline__ void operator()(const f32x4 (&acc)[2][2][4][2], const Unit& u, int wr, int wc, int fr, int fq) const {
        const int row0 = (u.pm - pm0) * BM + wr * 64 + fr, col0 = u.pn * BM + wc * 32 + 4 * fq;
        float* base = part + (size_t)(u.kofs / 512) * nrows * DM;
#pragma unroll
        for (int ai = 0; ai < 2; ++ai)
#pragma unroll
            for (int m = 0; m < 4; ++m) { float* rowp = base + (size_t)(row0 + ai * HALF + m * 16) * DM + col0;
#pragma unroll
                for (int bj = 0; bj < 2; ++bj)
#pragma unroll
                    for (int n = 0; n < 2; ++n) *(f32x4*)(rowp + bj * HALF + n * 16) = acc[ai][bj][m][n]; }
    }
};
struct EpiSwiglu {
    static constexpr bool PERM = true, AFTER_DRAIN = false;
    bf16_t* O;
    __device__ __forceinline__ void operator()(const f32x4 (&acc)[2][2][4][2], const Unit& u, int wr, int wc, int fr, int fq) const {
        const int row0 = u.pm * BM + wr * 64 + fr, col0 = u.pn * HALF + wc * 32 + 8 * fq;
#pragma unroll
        for (int ai = 0; ai < 2; ++ai)
#pragma unroll
            for (int m = 0; m < 4; ++m) { bf16_t* rowp = O + (size_t)(row0 + ai * HALF + m * 16) * DFF + col0;
                const f32x4 g0 = acc[ai][0][m][0], g1 = acc[ai][0][m][1], u0 = acc[ai][1][m][0], u1 = acc[ai][1][m][1];
                u32x4 w; w.x = cvt_pk_bf16(silu_fast(g0[0]) * u0[0], silu_fast(g0[1]) * u0[1]); w.y = cvt_pk_bf16(silu_fast(g0[2]) * u0[2], silu_fast(g0[3]) * u0[3]);
                w.z = cvt_pk_bf16(silu_fast(g1[0]) * u1[0], silu_fast(g1[1]) * u1[1]); w.w = cvt_pk_bf16(silu_fast(g1[2]) * u1[2], silu_fast(g1[3]) * u1[3]);
                *(u32x4*)rowp = w; }
    }
};
struct EpiSwiglu8 {
    static constexpr bool PERM = true, AFTER_DRAIN = false;
    unsigned char* O;
    __device__ __forceinline__ void operator()(const f32x4 (&acc)[2][2][4][2], const Unit& u, int wr, int wc, int fr, int fq) const {
        const int row0 = u.pm * BM + wr * 64 + fr, col0 = u.pn * HALF + wc * 32 + 8 * fq;
        constexpr float WI = 1.f / W8_SCALE;
#pragma unroll
        for (int ai = 0; ai < 2; ++ai)
#pragma unroll
            for (int m = 0; m < 4; ++m) { unsigned char* rowp = O + (size_t)(row0 + ai * HALF + m * 16) * DFF + col0;
                const f32x4 g0 = acc[ai][0][m][0] * WI, g1 = acc[ai][0][m][1] * WI, u0 = acc[ai][1][m][0] * (WI * A8_SCALE), u1 = acc[ai][1][m][1] * (WI * A8_SCALE);
                v2u w; w.x = pk4_fp8(silu_fast(g0[0]) * u0[0], silu_fast(g0[1]) * u0[1], silu_fast(g0[2]) * u0[2], silu_fast(g0[3]) * u0[3]);
                w.y = pk4_fp8(silu_fast(g1[0]) * u1[0], silu_fast(g1[1]) * u1[1], silu_fast(g1[2]) * u1[2], silu_fast(g1[3]) * u1[3]);
                *(v2u*)rowp = w; }
    }
};
struct EpiMoeDown {
    static constexpr bool PERM = true, AFTER_DRAIN = false;
    bf16_t* O; const float* rgate; float scale;
    __device__ __forceinline__ void operator()(const f32x4 (&acc)[2][2][4][2], const Unit& u, int wr, int wc, int fr, int fq) const {
        const int row0 = u.pm * BM + wr * 64 + fr, col0 = u.pn * BM + wc * 32 + 8 * fq;
#pragma unroll
        for (int ai = 0; ai < 2; ++ai)
#pragma unroll
            for (int m = 0; m < 4; ++m) { const int row = row0 + ai * HALF + m * 16; const float sc = rgate[row] * scale; bf16_t* rowp = O + (size_t)row * DM + col0;
#pragma unroll
                for (int bj = 0; bj < 2; ++bj) { const f32x4 v0 = acc[ai][bj][m][0] * sc, v1 = acc[ai][bj][m][1] * sc;
                    u32x4 w; w.x = cvt_pk_bf16(v0[0], v0[1]); w.y = cvt_pk_bf16(v0[2], v0[3]); w.z = cvt_pk_bf16(v1[0], v1[1]); w.w = cvt_pk_bf16(v1[2], v1[3]);
                    *(u32x4*)(rowp + bj * HALF) = w; } }
    }
};

template <class Epi, class Sched, bool ALIGN_EPI = false, bool SP2 = false, bool F8 = false>
__device__ __forceinline__ void gemm_phase(PG8_LAS unsigned char* lds, const Gemm g, const Sched& S, const Epi& E, const int wid  ) {
    const int lane = lane_id(), tid = wid * 64 + lane, wr = wid >> 2, wc = wid & 3, fr = lane & 15, fq = lane >> 4;
    const int K = g.ld, nt = g.K / BK;
    unsigned voffA[2], voffB[2];
#pragma unroll
    for (int i = 0; i < 2; ++i) { int R, C; stage_rc(tid * 16 + i * 8192, R, C); const int Rb = Epi::PERM ? ((R & ~31) + perm32(R & 31)) : R;
        voffA[i] = (unsigned)(R * K + C) * 2u; voffB[i] = (unsigned)(Rb * K + C) * 2u; }
    const size_t kstep = (size_t)(BK * 2);
    const size_t hstep = (size_t)HALF * K * 2;
    const size_t tstep = 2 * hstep;
    const unsigned ldsw = (unsigned)wid * 1024u;
    const int aoff = lds_byte(wr * 64 + fr, fq * 8), boff = lds_byte(wc * 32 + fr, fq * 8);
#define PG8_SA(b, h) (((b) * 2 + (h)) * HTB)
#define PG8_SB(b, h) ((4 + (b) * 2 + (h)) * HTB)
#define PG8_STAGE(bufoff, gbase, voff) do { _Pragma("unroll") for (int _i = 0; _i < 2; ++_i) \
        __builtin_amdgcn_global_load_lds((const unsigned*)((const char*)(gbase) + (voff)[_i]), (PG8_LAS unsigned*)(lds + (bufoff) + ldsw + _i * 8192), 16, 0, 0); } while (0)
#define PG8_LD8(addr) __builtin_shufflevector(*(const PG8_LAS i32x4*)(addr), *(const PG8_LAS i32x4*)((addr) + 1024), 0, 1, 2, 3, 4, 5, 6, 7)
#define PG8_LDA(dst, dst8, b, h) do { if constexpr (F8) { _Pragma("unroll") for (int m = 0; m < 4; ++m) dst8[m] = PG8_LD8(lds + PG8_SA(b, h) + aoff + m * 2048); } \
        else { _Pragma("unroll") for (int m = 0; m < 4; ++m) _Pragma("unroll") for (int k = 0; k < 2; ++k) dst[m][k] = *(const PG8_LAS bf16x8*)(lds + PG8_SA(b, h) + aoff + m * 2048 + k * 1024); } } while (0)
#define PG8_LDB(dst, dst8, b, h) do { if constexpr (F8) { _Pragma("unroll") for (int n = 0; n < 2; ++n) dst8[n] = PG8_LD8(lds + PG8_SB(b, h) + boff + n * 2048); } \
        else { _Pragma("unroll") for (int n = 0; n < 2; ++n) _Pragma("unroll") for (int k = 0; k < 2; ++k) dst[n][k] = *(const PG8_LAS bf16x8*)(lds + PG8_SB(b, h) + boff + n * 2048 + k * 1024); } } while (0)
#define PG8_MMA(ai, bj, At, At8, Bt, Bt8) do { __builtin_amdgcn_s_setprio(1); \
        if constexpr (F8) { _Pragma("unroll") for (int m = 0; m < 4; ++m) _Pragma("unroll") for (int n = 0; n < 2; ++n) \
            asm volatile("v_mfma_scale_f32_16x16x128_f8f6f4 %0, %1, %2, %0, %3, %3 op_sel_hi:[0,0,0]" : "+v"(acc[ai][bj][m][n]) : "v"(Bt8[n]), "v"(At8[m]), "v"(sc8_)); } \
        else { _Pragma("unroll") for (int m = 0; m < 4; ++m) _Pragma("unroll") for (int n = 0; n < 2; ++n) _Pragma("unroll") for (int k = 0; k < 2; ++k) \
            acc[ai][bj][m][n] = __builtin_amdgcn_mfma_f32_16x16x32_bf16(Bt[n][k], At[m][k], acc[ai][bj][m][n], 0, 0, 0); } \
        __builtin_amdgcn_s_setprio(0); } while (0)
#define PG8_WAIT_V(n) asm volatile("s_waitcnt vmcnt(" #n ")" ::: "memory")
#define PG8_WAIT_L(n) asm volatile("s_waitcnt lgkmcnt(" #n ")" ::: "memory")
#define PG8_BAR __builtin_amdgcn_s_barrier()
#define PG8_SCHED __builtin_amdgcn_sched_barrier(0)
#define PG8_SCHED8 do { if constexpr (F8) __builtin_amdgcn_sched_barrier(0); } while (0)
    Unit cur, nxt; int ui = 0;
    if (!S.next(0, cur)) return;
    constexpr float zero_ = 0.f;
    const int sc8_ = 0x7f7f7f7f;
    f32x4 acc[2][2][4][2];
#pragma unroll
    for (int a = 0; a < 2; ++a)
#pragma unroll
        for (int b = 0; b < 2; ++b)
#pragma unroll
            for (int m = 0; m < 4; ++m)
#pragma unroll
                for (int n = 0; n < 2; ++n) acc[a][b][m][n] = (f32x4){zero_, zero_, zero_, zero_};
    bf16x8 At[4][2], B0[2][2], B1[2][2];
    i32x8 At8[4], B08[2], B18[2];
    const char* cA = (const char*)g.A + cur.kofs + (size_t)cur.pm * tstep; const char* cB = (const char*)g.Bt + cur.bofs + cur.kofs + (size_t)cur.pn * tstep;
    S.a_ready(cur);
    if constexpr (SP2) {
        PG8_STAGE(PG8_SB(0, 0), cB, voffB); PG8_STAGE(PG8_SB(0, 1), cB + hstep, voffB); PG8_STAGE(PG8_SA(0, 0), cA, voffA); PG8_STAGE(PG8_SA(0, 1), cA + hstep, voffA);
        if (wr == 1) PG8_BAR;
        PG8_WAIT_V(2); PG8_BAR;
        PG8_STAGE(PG8_SB(1, 0), cB + kstep, voffB); PG8_STAGE(PG8_SA(1, 0), cA + kstep, voffA); PG8_STAGE(PG8_SB(1, 1), cB + hstep + kstep, voffB);
        PG8_WAIT_V(6); PG8_BAR;
    } else {
        PG8_STAGE(PG8_SB(0, 0), cB, voffB); PG8_STAGE(PG8_SA(0, 0), cA, voffA); PG8_STAGE(PG8_SB(0, 1), cB + hstep, voffB); PG8_STAGE(PG8_SA(0, 1), cA + hstep, voffA);
        if (wr == 1) PG8_BAR;
        PG8_WAIT_V(4); PG8_BAR;
        PG8_STAGE(PG8_SB(1, 0), cB + kstep, voffB); PG8_STAGE(PG8_SA(1, 0), cA + kstep, voffA); PG8_STAGE(PG8_SB(1, 1), cB + hstep + kstep, voffB);
        PG8_WAIT_V(6); PG8_BAR;
    }
    for (;;) {
        const bool has_next = S.next(ui + 1, nxt);
        const char* nA = has_next ? (const char*)g.A + nxt.kofs + (size_t)nxt.pm * tstep : cA; const char* nB = has_next ? (const char*)g.Bt + nxt.bofs + nxt.kofs + (size_t)nxt.pn * tstep : cB;
#pragma clang loop unroll(disable)
        for (int t = 0; t < nt; t += 2) {
            const bool last = (t == nt - 2);
            const char* a1 = cA + (size_t)(t + 1) * kstep;
            const char* a2 = last ? nA : cA + (size_t)(t + 2) * kstep; const char* b2 = last ? nB : cB + (size_t)(t + 2) * kstep;
            const char* a3 = a2 + kstep; const char* b3 = b2 + kstep;
            if (last && has_next) S.a_ready(nxt);
            if constexpr (SP2) {
            PG8_LDB(B0, B08, 0, 0); PG8_LDB(B1, B18, 0, 1); PG8_SCHED; PG8_LDA(At, At8, 0, 0); PG8_STAGE(PG8_SA(1, 1), a1 + hstep, voffA);
            PG8_WAIT_V(8); PG8_WAIT_L(0); PG8_BAR; PG8_SCHED8; PG8_MMA(0, 0, At, At8, B0, B08); PG8_MMA(0, 1, At, At8, B1, B18); PG8_SCHED8; PG8_BAR; PG8_SCHED;
            PG8_LDA(At, At8, 0, 1); PG8_STAGE(PG8_SB(0, 0), b2, voffB); PG8_STAGE(PG8_SB(0, 1), b2 + hstep, voffB); PG8_STAGE(PG8_SA(0, 0), a2, voffA);
            PG8_WAIT_V(8); PG8_WAIT_L(0); PG8_BAR; PG8_SCHED8; PG8_MMA(1, 0, At, At8, B0, B08); PG8_MMA(1, 1, At, At8, B1, B18); PG8_SCHED8; PG8_BAR; PG8_SCHED;
            PG8_LDB(B0, B08, 1, 0); PG8_LDB(B1, B18, 1, 1); PG8_SCHED; PG8_LDA(At, At8, 1, 0); PG8_STAGE(PG8_SA(0, 1), a2 + hstep, voffA);
            PG8_WAIT_V(8); PG8_WAIT_L(0); PG8_BAR; PG8_SCHED8; PG8_MMA(0, 0, At, At8, B0, B08); PG8_MMA(0, 1, At, At8, B1, B18); PG8_SCHED8; PG8_BAR; PG8_SCHED;
            PG8_LDA(At, At8, 1, 1); PG8_STAGE(PG8_SB(1, 0), b3, voffB); PG8_STAGE(PG8_SB(1, 1), b3 + hstep, voffB); PG8_STAGE(PG8_SA(1, 0), a3, voffA);
            PG8_WAIT_V(8); PG8_WAIT_L(0); PG8_BAR; PG8_SCHED8; PG8_MMA(1, 0, At, At8, B0, B08); PG8_MMA(1, 1, At, At8, B1, B18); PG8_SCHED8; PG8_BAR; PG8_SCHED;
            } else {
            PG8_LDB(B0, B08, 0, 0); PG8_SCHED; PG8_LDA(At, At8, 0, 0); PG8_STAGE(PG8_SA(1, 1), a1 + hstep, voffA);
            PG8_WAIT_L(8); PG8_BAR; PG8_WAIT_L(0); PG8_MMA(0, 0, At, At8, B0, B08); PG8_BAR; PG8_SCHED;
            PG8_LDB(B1, B18, 0, 1); PG8_STAGE(PG8_SB(0, 0), b2, voffB);
            PG8_BAR; PG8_WAIT_L(0); PG8_MMA(0, 1, At, At8, B1, B18); PG8_BAR;
            PG8_LDA(At, At8, 0, 1); PG8_STAGE(PG8_SA(0, 0), a2, voffA);
            PG8_BAR; PG8_WAIT_L(0); PG8_MMA(1, 0, At, At8, B0, B08); PG8_BAR; PG8_SCHED;
            PG8_STAGE(PG8_SB(0, 1), b2 + hstep, voffB);
            PG8_WAIT_V(6); PG8_BAR; PG8_MMA(1, 1, At, At8, B1, B18); PG8_BAR;
            PG8_LDB(B0, B08, 1, 0); PG8_SCHED; PG8_LDA(At, At8, 1, 0); PG8_STAGE(PG8_SA(0, 1), a2 + hstep, voffA);
            PG8_WAIT_L(8); PG8_BAR; PG8_WAIT_L(0); PG8_MMA(0, 0, At, At8, B0, B08); PG8_BAR; PG8_SCHED;
            PG8_LDB(B1, B18, 1, 1); PG8_STAGE(PG8_SB(1, 0), b3, voffB);
            PG8_BAR; PG8_WAIT_L(0); PG8_MMA(0, 1, At, At8, B1, B18); PG8_BAR;
            PG8_LDA(At, At8, 1, 1); PG8_STAGE(PG8_SA(1, 0), a3, voffA);
            PG8_BAR; PG8_WAIT_L(0); PG8_MMA(1, 0, At, At8, B0, B08); PG8_BAR; PG8_SCHED;
            PG8_STAGE(PG8_SB(1, 1), b3 + hstep, voffB);
            PG8_WAIT_V(6); PG8_BAR; PG8_MMA(1, 1, At, At8, B1, B18); PG8_BAR;
            }
        }
        if constexpr (ALIGN_EPI) { if (wr == 0) PG8_BAR; }
        if constexpr (F8) asm volatile("s_nop 15\n\ts_nop 15" ::: "memory");
        if constexpr (!Epi::AFTER_DRAIN) { E(acc, cur, wr, wc, fr, fq); S.done(cur); }
        if (!has_next) break;
#pragma unroll
        for (int a = 0; a < 2; ++a)
#pragma unroll
            for (int b = 0; b < 2; ++b)
#pragma unroll
                for (int m = 0; m < 4; ++m)
#pragma unroll
                    for (int n = 0; n < 2; ++n) acc[a][b][m][n] = (f32x4){zero_, zero_, zero_, zero_};
        cur = nxt; cA = nA; cB = nB; ++ui;
        if constexpr (ALIGN_EPI) { if (wr == 1) PG8_BAR; }
    }
    PG8_WAIT_V(0);
    if constexpr (!ALIGN_EPI) { if (wr == 0) PG8_BAR; }
    PG8_BAR;
    if constexpr (Epi::AFTER_DRAIN) { E.fused(acc, cur, wr, wc, fr, fq, lds, wid, lane); S.done(cur); }
#undef PG8_SA
#undef PG8_SB
#undef PG8_STAGE
#undef PG8_LDA
#undef PG8_LDB
#undef PG8_MMA
#undef PG8_LD8
#undef PG8_WAIT_V
#undef PG8_WAIT_L
#undef PG8_BAR
#undef PG8_SCHED
#undef PG8_SCHED8
}

}

#define GAS __attribute__((address_space(1)))
#define LAS __attribute__((address_space(3)))
typedef unsigned v4u __attribute__((ext_vector_type(4)));
typedef float f32x4 __attribute__((ext_vector_type(4)));
#define LDS_WAIT() asm volatile("s_waitcnt lgkmcnt(0)" ::: "memory")
#define VM_WAIT() asm volatile("s_waitcnt vmcnt(0)" ::: "memory")

#define XB_TMO      128
#define XB_XCNT(j)  (256  + 64 * (j))
#define XB_XSUB(j)  (1280 + 64 * (j))
#define XB_XGEN(j)  (2304 + 64 * (j))
#define XB_TOP      3328
#define XB_TOPGEN   3392
#define XCD_BAR_WORDS 3456
#define XB_SPIN_CAP (1u << 18)

__device__ __forceinline__ unsigned xb_ld(unsigned* p)              { return __hip_atomic_load(p, __ATOMIC_RELAXED, __HIP_MEMORY_SCOPE_AGENT); }
__device__ __forceinline__ unsigned xb_add(unsigned* p, unsigned v) { return __hip_atomic_fetch_add(p, v, __ATOMIC_RELAXED, __HIP_MEMORY_SCOPE_AGENT); }
__device__ __forceinline__ unsigned xb_xcc_id() { return (unsigned)__builtin_amdgcn_s_getreg((3 << 11) | 20) & 0xFu; }
#define XB_SPIN(cond, bar) do { unsigned _sp = 0; while (cond) { __builtin_amdgcn_s_sleep(1); \
    if ((++_sp & 255u) == 0u) { if (xb_ld(&(bar)[XB_TMO])) break; if (_sp > XB_SPIN_CAP) { atomicAdd(&(bar)[XB_TMO], 1u); break; } } } } while (0)

struct XcdBarrier {
    unsigned* bar; unsigned x;
    volatile LAS unsigned* st;
};

__device__ __forceinline__ XcdBarrier xcd_barrier_post(unsigned* bar, volatile LAS unsigned* st, bool t0) {
    XcdBarrier b; b.bar = bar; b.x = xb_xcc_id(); b.st = st;
    if (t0) (void)xb_add(&bar[XB_XCNT(b.x)], 1u);
    return b;
}
__device__ __forceinline__ void xcd_barrier_complete(unsigned* bar, unsigned x, unsigned& nloc, unsigned& nx) {
    const unsigned G = gridDim.x * gridDim.y * gridDim.z;
    unsigned sum, cnt, mine, sp = 0u;
    for (;;) {
        sum = 0u; cnt = 0u; mine = 0u;
#pragma unroll
        for (unsigned j = 0; j < 16; ++j) { const unsigned c = xb_ld(&bar[XB_XCNT(j)]); sum += c; cnt += (c > 0u) ? 1u : 0u; mine = (j == x) ? c : mine; }
        if (sum == G) break;
        __builtin_amdgcn_s_sleep(1);
        if ((++sp & 255u) == 0u) { if (xb_ld(&bar[XB_TMO])) break; if (sp > XB_SPIN_CAP) { atomicAdd(&bar[XB_TMO], 1u); break; } }
    }
    nloc = mine > 0u ? mine : 1u; nx = cnt > 0u ? cnt : 1u;
}

__device__ __forceinline__ void xcd_barrier(const XcdBarrier& b, bool t0) {
    asm volatile("s_waitcnt vmcnt(0)" ::: "memory");
    __syncthreads();
    if (t0) {
        unsigned* bar = b.bar;
        __builtin_amdgcn_s_waitcnt(0);
        unsigned nloc = b.st[0], nx = b.st[1];
        if (nloc == 0u) { xcd_barrier_complete(bar, b.x, nloc, nx); b.st[0] = nloc; b.st[1] = nx; }
        const unsigned old = xb_add(&bar[XB_XSUB(b.x)], 1u);
        const unsigned gen = old / nloc;
        if (old + 1u == (gen + 1u) * nloc) {
            __builtin_amdgcn_fence(__ATOMIC_RELEASE, "agent");
            asm volatile("s_waitcnt vmcnt(0)" ::: "memory");
            const unsigned og = xb_add(&bar[XB_TOP], 1u);
            const unsigned tg = og / nx;
            if (og + 1u == (tg + 1u) * nx) xb_add(&bar[XB_TOPGEN], 1u);
            else XB_SPIN(xb_ld(&bar[XB_TOPGEN]) == tg, bar);
            __builtin_amdgcn_fence(__ATOMIC_ACQUIRE, "agent");
            xb_add(&bar[XB_XGEN(b.x)], 1u);
            asm volatile("s_waitcnt vmcnt(0)" ::: "memory");
        } else {
            XB_SPIN(xb_ld(&bar[XB_XGEN(b.x)]) == gen, bar);
            __builtin_amdgcn_fence(__ATOMIC_ACQUIRE, "agent");
            asm volatile("s_waitcnt vmcnt(0)" ::: "memory");
        }
    }
    __syncthreads();
}

constexpr int RING_OFF = 0, RING_BYTES = 131072;
constexpr int MISC_OFF = 143360;
constexpr int LDS_BYTES = 147456;
constexpr int NWAVES = 8;

struct Ctx { LAS unsigned char* lds; volatile LAS unsigned* MISC; unsigned* ctl; int wave, G, gw, NGW; };

__device__ __forceinline__ void cvt_item(const float* W, int K, int N, bf16_t* WT, int mode, LAS float* scr, int item, int lane) {
    const int kblk = K / 64, nb = item / kblk, kb = item % kblk, k0 = 64 * kb, n0 = 64 * nb;
    f32x4 ld[16];
#pragma unroll
    for (int i = 0; i < 16; ++i) { const int kk = 4 * i + (lane >> 4), c4 = 4 * (lane & 15); ld[i] = __builtin_nontemporal_load((const f32x4*)(W + (size_t)(k0 + kk) * N + n0 + c4));     }
#pragma unroll
    for (int i = 0; i < 16; ++i) { const int kk = 4 * i + (lane >> 4), c4 = 4 * (lane & 15);
        LAS float* s = scr + kk * 65 + c4; s[0] = ld[i][0]; s[1] = ld[i][1]; s[2] = ld[i][2]; s[3] = ld[i][3]; }
    LDS_WAIT(); asm volatile("" ::: "memory");
    const int c = lane >> 3;
#pragma unroll
    for (int j = 0; j < 8; ++j) { const int n = (lane & 7) + 8 * j; const LAS float* s = scr + (8 * c) * 65 + n;
        v4u o; o.x = pk2(s[0 * 65], s[1 * 65]); o.y = pk2(s[2 * 65], s[3 * 65]); o.z = pk2(s[4 * 65], s[5 * 65]); o.w = pk2(s[6 * 65], s[7 * 65]);
        const int nn = n0 + n; const int drow = mode == 0 ? nn : (nn / 128) * 256 + (mode - 1) * 128 + (nn % 128);
        *(v4u*)(WT + (size_t)drow * K + k0 + 8 * c) = o; }
    LDS_WAIT(); asm volatile("" ::: "memory");
}
__device__ __forceinline__ void cvt_item8(const float* W, int K, int N, unsigned char* WT, int mode, LAS float* scr, int item, int lane) {
    const int kblk = K / 64, nb = item / kblk, kb = item % kblk, k0 = 64 * kb, n0 = 64 * nb;
    f32x4 ld[16];
#pragma unroll
    for (int i = 0; i < 16; ++i) { const int kk = 4 * i + (lane >> 4), c4 = 4 * (lane & 15); ld[i] = __builtin_nontemporal_load((const f32x4*)(W + (size_t)(k0 + kk) * N + n0 + c4));     }
#pragma unroll
    for (int i = 0; i < 16; ++i) { const int kk = 4 * i + (lane >> 4), c4 = 4 * (lane & 15);
        LAS float* s = scr + kk * 65 + c4; s[0] = ld[i][0]; s[1] = ld[i][1]; s[2] = ld[i][2]; s[3] = ld[i][3]; }
    LDS_WAIT(); asm volatile("" ::: "memory");
    const int c = lane >> 3;
#pragma unroll
    for (int j = 0; j < 8; ++j) { const int n = (lane & 7) + 8 * j; const LAS float* s = scr + (8 * c) * 65 + n;
        v2u o; o.x = pk4_fp8(s[0 * 65] * W8_SCALE, s[1 * 65] * W8_SCALE, s[2 * 65] * W8_SCALE, s[3 * 65] * W8_SCALE); o.y = pk4_fp8(s[4 * 65] * W8_SCALE, s[5 * 65] * W8_SCALE, s[6 * 65] * W8_SCALE, s[7 * 65] * W8_SCALE);
        const int nn = n0 + n; const int drow = mode == 0 ? nn : (nn / 128) * 256 + (mode - 1) * 128 + (nn % 128);
        *(v2u*)(WT + (size_t)drow * K + k0 + 8 * c) = o; }
    LDS_WAIT(); asm volatile("" ::: "memory");
}
__device__ __forceinline__ void p0_prologue(const Params& p, Ctx& F) {
    const int lane_ = lane_id(), tid_ = F.wave * 64 + lane_;
    LAS float* fl = (LAS float*)(F.lds + RING_OFF);
    for (int it = blockIdx.x; it < 192; it += F.G) {
        const int l = it / 96, n = (it % 96) * 64 + lane_;
        LAS float* sv = fl;
        LAS float* red = fl + 3 * 1024;
        for (int i = tid_; i < 3 * 1024; i += 512) { const int rt = i >> 10, k = i & 1023; const float v = rt < 2 ? p.in[I_C][rt * DM + k] : p.in[I_CCTX][k]; sv[i] = siluf(v); }
        __syncthreads();
        const float* W = p.in[I_ADAW] + (size_t)l * DM * 6144 + n;
        float a0 = 0.f, a1 = 0.f, a2 = 0.f;
        for (int kb = 0; kb < 128; kb += 32) {
            float wv[32];
#pragma unroll
            for (int j = 0; j < 32; ++j) wv[j] = W[(size_t)(F.wave * 128 + kb + j) * 6144];
#pragma unroll
            for (int j = 0; j < 32; ++j) { const int k = F.wave * 128 + kb + j; a0 += sv[k] * wv[j]; a1 += sv[1024 + k] * wv[j]; a2 += sv[2048 + k] * wv[j]; }
        }
        red[(F.wave * 3 + 0) * 64 + lane_] = a0; red[(F.wave * 3 + 1) * 64 + lane_] = a1; red[(F.wave * 3 + 2) * 64 + lane_] = a2;
        __syncthreads();
        if (tid_ < 192) { const int rt = tid_ >> 6, ln = tid_ & 63; float s = 0.f;
#pragma unroll
            for (int w = 0; w < 8; ++w) s += red[(w * 3 + rt) * 64 + ln];
            const int nn = (it % 96) * 64 + ln;
            ((float*)(p.ws + WS_MODV))[(size_t)(l * 3 + rt) * 6144 + nn] = s + p.in[I_ADAB][l * 6144 + nn]; }
        __syncthreads();
    }
    LAS float* scr = (LAS float*)(F.lds + RING_OFF) + F.wave * (64 * 65);
    constexpr int S_WIN = 16 * 56, S_WOUT = 16 * 16, S_F = 16 * 44;
    constexpr int NITEMS = 2 * S_WIN + 2 * S_WOUT + 3 * S_F + 24 * S_F;
    static_assert(NITEMS == 21312, "items");
    for (int it = F.gw; it < NITEMS; it += F.NGW) {
        int r = it;
        if (r < 2 * S_WIN) { const int l = r / S_WIN; cvt_item(p.in[I_WIN] + (size_t)l * DM * DP, DM, DP, (bf16_t*)(p.ws + W_WIN) + (size_t)l * DP * DM, 0, scr, r % S_WIN, lane_); continue; } r -= 2 * S_WIN;
        if (r < 2 * S_WOUT) { const int l = r / S_WOUT; cvt_item(p.in[I_WOUT] + (size_t)l * DM * DM, DM, DM, (bf16_t*)(p.ws + W_WOUT) + (size_t)l * DM * DM, 0, scr, r % S_WOUT, lane_); continue; } r -= 2 * S_WOUT;
        if (r < S_F) { cvt_item(p.in[I_FWG], DM, DFF, (bf16_t*)(p.ws + W_FGU), 1, scr, r, lane_); continue; } r -= S_F;
        if (r < S_F) { cvt_item(p.in[I_FWU], DM, DFF, (bf16_t*)(p.ws + W_FGU), 2, scr, r, lane_); continue; } r -= S_F;
        if (r < S_F) { cvt_item(p.in[I_FWD], DFF, DM, (bf16_t*)(p.ws + W_FD), 0, scr, r, lane_); continue; } r -= S_F;
        if (r < 8 * S_F) { const int e = r / S_F; cvt_item8(p.in[I_MWG] + (size_t)e * DM * DFF, DM, DFF, (unsigned char*)(p.ws + W_MGU) + (size_t)e * 2 * DFF * DM, 1, scr, r % S_F, lane_); continue; } r -= 8 * S_F;
        if (r < 8 * S_F) { const int e = r / S_F; cvt_item8(p.in[I_MWU] + (size_t)e * DM * DFF, DM, DFF, (unsigned char*)(p.ws + W_MGU) + (size_t)e * 2 * DFF * DM, 2, scr, r % S_F, lane_); continue; } r -= 8 * S_F;
        { const int e = r / S_F; cvt_item8(p.in[I_MWD] + (size_t)e * DFF * DM, DFF, DM, (unsigned char*)(p.ws + W_MD) + (size_t)e * DM * DFF, 0, scr, r % S_F, lane_); }
    }
}

__device__ __forceinline__ void norm_phase(const Params& p, Ctx& F, int l, int which, int nrows) {
    const int lane_ = lane_id(), tid_ = F.wave * 64 + lane_;
    const float* g = p.in[which ? I_N2G : I_N1G] + l * DM;
    for (int m = F.gw; m < nrows; m += F.NGW) {
        const float* xrow;
        if (l == 0 && which == 0) xrow = m < NL ? p.in[I_X] + (size_t)m * DM : p.in[I_CTX] + (size_t)(m - NL) * DM;
        else xrow = xr_row(p, m);
        const int rt = rowtype(m);
        const float* sh = modv(p, l, rt, which ? 3 : 0); const float* sc = modv(p, l, rt, which ? 4 : 1);
        f32x4 v[4]; float ss = 0.f;
        if (m >= NL && !(l == 0 && which == 0)) {
            const int nsl = which ? DM / 256 : DFF / 256; const float* gate = modv(p, 0, 2, which ? 2 : 5);
            const float* base = (l == 0) ? p.in[I_CTX] + (size_t)(m - NL) * DM : xrow;
            const float* part = (const float*)(p.ws + WS_PART) + (size_t)(m - NL) * DM;
#pragma unroll
            for (int j = 0; j < 4; ++j) { const int col = 256 * j + 4 * lane_; f32x4 a = {0.f, 0.f, 0.f, 0.f};
                for (int sl = 0; sl < nsl; ++sl) a += *(const f32x4*)(part + (size_t)sl * NC * DM + col);
                v[j] = *(const f32x4*)(base + col) + *(const f32x4*)(gate + col) * a;
                *(f32x4*)((float*)(p.ws + WS_XRC) + (size_t)(m - NL) * DM + col) = v[j];
                ss += (v[j][0] * v[j][0] + v[j][1] * v[j][1]) + (v[j][2] * v[j][2] + v[j][3] * v[j][3]); }
        } else
#pragma unroll
        for (int j = 0; j < 4; ++j) { v[j] = *(const f32x4*)(xrow + 256 * j + 4 * lane_); ss += (v[j][0] * v[j][0] + v[j][1] * v[j][1]) + (v[j][2] * v[j][2] + v[j][3] * v[j][3]); }
        const float r = rsqrtf(wave_sum(ss) * (1.f / DM) + EPS);
        bf16_t* hb = (bf16_t*)(p.ws + WS_HBUF) + (size_t)m * DM;
#pragma unroll
        for (int j = 0; j < 4; ++j) { const int col = 256 * j + 4 * lane_;
            const f32x4 gg = *(const f32x4*)(g + col), s4 = *(const f32x4*)(sc + col), h4 = *(const f32x4*)(sh + col);
            const f32x4 y = v[j] * r * gg * (1.f + s4) + h4;
            v2u o; o.x = pk2(y[0], y[1]); o.y = pk2(y[2], y[3]); *(v2u*)(hb + col) = o; }
    }
}


__device__ __forceinline__ void router_phase(const Params& p, Ctx& F) {
    const int lane_ = lane_id(), tid_ = F.wave * 64 + lane_;
    LAS int* lcnt = (LAS int*)(F.lds + RING_OFF);
    LAS int* gbase = lcnt + 8;
    LAS int* ent_e = lcnt + 16;
    LAS int* ent_pos = lcnt + 16 + 128;
    const float* g = p.in[I_N2G] + DM; const float* rw = p.in[I_RW];
    int* tok_e = (int*)(p.ws + WS_ROUTE); float* tok_w = (float*)(p.ws + WS_ROUTE) + 2 * NL; int* tok_pos = (int*)(p.ws + WS_ROUTE) + 4 * NL;
    f32x4 rwa[4][4], rwb[4][4];
#pragma unroll
    for (int j = 0; j < 4; ++j)
#pragma unroll
        for (int q = 0; q < 4; ++q) { const int col = 256 * j + 4 * lane_ + q; rwa[j][q] = *(const f32x4*)(rw + (size_t)col * 8); rwb[j][q] = *(const f32x4*)(rw + (size_t)col * 8 + 4); }
    const int myexp = ((lane_ >> 5) & 1) * 4 + ((lane_ >> 4) & 1) * 2 + ((lane_ >> 3) & 1);
    for (int ch = blockIdx.x; ch < NL / 64; ch += F.G) {
        if (tid_ < 8) lcnt[tid_] = 0;
        __syncthreads();
        const int rt = (ch * 64) / T;
        const float* sh = modv(p, 1, rt, 3); const float* sc = modv(p, 1, rt, 4);
        f32x4 gs[4], hs[4]; float bsum;
        { float bb[8] = {0.f, 0.f, 0.f, 0.f, 0.f, 0.f, 0.f, 0.f};
#pragma unroll
          for (int j = 0; j < 4; ++j) { const int col = 256 * j + 4 * lane_; gs[j] = *(const f32x4*)(g + col) * (1.f + *(const f32x4*)(sc + col)); hs[j] = *(const f32x4*)(sh + col);
#pragma unroll
            for (int q = 0; q < 4; ++q) { bb[0] += hs[j][q] * rwa[j][q][0]; bb[1] += hs[j][q] * rwa[j][q][1]; bb[2] += hs[j][q] * rwa[j][q][2]; bb[3] += hs[j][q] * rwa[j][q][3];
                                          bb[4] += hs[j][q] * rwb[j][q][0]; bb[5] += hs[j][q] * rwb[j][q][1]; bb[6] += hs[j][q] * rwb[j][q][2]; bb[7] += hs[j][q] * rwb[j][q][3]; } }
          float c4[4];
#pragma unroll
          for (int k = 0; k < 4; ++k) { const float keep = (lane_ & 32) ? bb[k + 4] : bb[k], give = (lane_ & 32) ? bb[k] : bb[k + 4]; c4[k] = keep + __shfl_xor(give, 32); }
          float c2[2];
#pragma unroll
          for (int k = 0; k < 2; ++k) { const float keep = (lane_ & 16) ? c4[k + 2] : c4[k], give = (lane_ & 16) ? c4[k] : c4[k + 2]; c2[k] = keep + __shfl_xor(give, 16); }
          float c1 = ((lane_ & 8) ? c2[1] : c2[0]) + __shfl_xor((lane_ & 8) ? c2[0] : c2[1], 8);
          c1 += __shfl_xor(c1, 4); c1 += __shfl_xor(c1, 2); c1 += __shfl_xor(c1, 1);
          bsum = c1 + p.in[I_RB][myexp]; }
        for (int i = 0; i < 8; ++i) {
            const int ti = F.wave * 8 + i, m = ch * 64 + ti;
            const float* xrow = p.out + (size_t)m * DM;
            f32x4 v[4]; float ss = 0.f; float aa[8] = {0.f, 0.f, 0.f, 0.f, 0.f, 0.f, 0.f, 0.f};
#pragma unroll
            for (int j = 0; j < 4; ++j) { v[j] = *(const f32x4*)(xrow + 256 * j + 4 * lane_); ss += (v[j][0] * v[j][0] + v[j][1] * v[j][1]) + (v[j][2] * v[j][2] + v[j][3] * v[j][3]); }
#pragma unroll
            for (int j = 0; j < 4; ++j) { v[j] = v[j] * gs[j];
#pragma unroll
                for (int q = 0; q < 4; ++q) { aa[0] += v[j][q] * rwa[j][q][0]; aa[1] += v[j][q] * rwa[j][q][1]; aa[2] += v[j][q] * rwa[j][q][2]; aa[3] += v[j][q] * rwa[j][q][3];
                                              aa[4] += v[j][q] * rwb[j][q][0]; aa[5] += v[j][q] * rwb[j][q][1]; aa[6] += v[j][q] * rwb[j][q][2]; aa[7] += v[j][q] * rwb[j][q][3]; } }
            float c4[4];
#pragma unroll
            for (int k = 0; k < 4; ++k) { const float keep = (lane_ & 32) ? aa[k + 4] : aa[k], give = (lane_ & 32) ? aa[k] : aa[k + 4]; c4[k] = keep + __shfl_xor(give, 32); }
            float c2[2];
#pragma unroll
            for (int k = 0; k < 2; ++k) { const float keep = (lane_ & 16) ? c4[k + 2] : c4[k], give = (lane_ & 16) ? c4[k] : c4[k + 2]; c2[k] = keep + __shfl_xor(give, 16); }
            float c1 = ((lane_ & 8) ? c2[1] : c2[0]) + __shfl_xor((lane_ & 8) ? c2[0] : c2[1], 8);
            c1 += __shfl_xor(c1, 4); c1 += __shfl_xor(c1, 2); c1 += __shfl_xor(c1, 1);
            const float r = rsqrtf(wave_sum(ss) * (1.f / DM) + EPS);
            const float mylogit = r * c1 + bsum;
#define RLF(L) __uint_as_float((unsigned)__builtin_amdgcn_readlane((int)__float_as_uint(mylogit), L))
            const float lg0 = RLF(0), lg1 = RLF(8), lg2 = RLF(16), lg3 = RLF(24), lg4 = RLF(32), lg5 = RLF(40), lg6 = RLF(48), lg7 = RLF(56);
#undef RLF
            unsigned char* hb = (unsigned char*)(p.ws + WS_HBUF) + (size_t)m * DM;
#pragma unroll
            for (int j = 0; j < 4; ++j) { const f32x4 y = v[j] * r + hs[j]; *(unsigned*)(hb + 256 * j + 4 * lane_) = pk4_fp8(y[0], y[1], y[2], y[3]); }
            int i1 = 0; float v1 = lg0;
            if (lg1 > v1) { v1 = lg1; i1 = 1; } if (lg2 > v1) { v1 = lg2; i1 = 2; } if (lg3 > v1) { v1 = lg3; i1 = 3; }
            if (lg4 > v1) { v1 = lg4; i1 = 4; } if (lg5 > v1) { v1 = lg5; i1 = 5; } if (lg6 > v1) { v1 = lg6; i1 = 6; } if (lg7 > v1) { v1 = lg7; i1 = 7; }
            int i2 = -1; float v2 = -3.4e38f;
            if (i1 != 0 && lg0 > v2) { v2 = lg0; i2 = 0; } if (i1 != 1 && lg1 > v2) { v2 = lg1; i2 = 1; } if (i1 != 2 && lg2 > v2) { v2 = lg2; i2 = 2; } if (i1 != 3 && lg3 > v2) { v2 = lg3; i2 = 3; }
            if (i1 != 4 && lg4 > v2) { v2 = lg4; i2 = 4; } if (i1 != 5 && lg5 > v2) { v2 = lg5; i2 = 5; } if (i1 != 6 && lg6 > v2) { v2 = lg6; i2 = 6; } if (i1 != 7 && lg7 > v2) { v2 = lg7; i2 = 7; }
            const float w1 = 1.f / (1.f + __expf(v2 - v1));
            if (lane_ == 0) {
                const int p1 = __hip_atomic_fetch_add(lcnt + i1, 1, __ATOMIC_RELAXED, __HIP_MEMORY_SCOPE_WORKGROUP);
                const int p2 = __hip_atomic_fetch_add(lcnt + i2, 1, __ATOMIC_RELAXED, __HIP_MEMORY_SCOPE_WORKGROUP);
                ent_e[2 * ti] = i1; ent_e[2 * ti + 1] = i2; ent_pos[2 * ti] = p1; ent_pos[2 * ti + 1] = p2;
                tok_e[2 * m] = i1; tok_e[2 * m + 1] = i2; tok_w[2 * m] = w1; tok_w[2 * m + 1] = 1.f - w1; }
        }
        __syncthreads();
        if (tid_ < 8) gbase[tid_] = (int)__hip_atomic_fetch_add(F.ctl + CW_CNT + 64 * tid_, (unsigned)lcnt[tid_], __ATOMIC_RELAXED, __HIP_MEMORY_SCOPE_AGENT);
        __syncthreads();
        if (tid_ < 128) tok_pos[ch * 128 + tid_] = gbase[ent_e[tid_]] + ent_pos[tid_];
        __syncthreads();
    }
}
__device__ __forceinline__ void moe_table(Ctx& F) {
    const int lane_ = lane_id(), tid_ = F.wave * 64 + lane_;
    volatile LAS unsigned* tb = F.MISC + 32;
    if (tid_ == 0) { unsigned acc = 0;
        for (int e = 0; e < 8; ++e) { const unsigned c = __hip_atomic_load(F.ctl + CW_CNT + 64 * e, __ATOMIC_RELAXED, __HIP_MEMORY_SCOPE_AGENT); tb[e] = acc; tb[16 + e] = c; acc += (c + 255u) / 256u * 256u; }
        tb[8] = acc; }
    __syncthreads();
}
__device__ __forceinline__ void moe_order(Ctx& F, pg8::Order& S, int nN, long estride) {
    volatile LAS unsigned* tb = F.MISC + 32;
#define RFL(x) __builtin_amdgcn_readfirstlane((int)(x))
    S.init(RFL(tb[8] / 256u), nN, F.G, (int)blockIdx.x);
    S.e1 = RFL(tb[1] / 256u); S.e2 = RFL(tb[2] / 256u); S.e3 = RFL(tb[3] / 256u); S.e4 = RFL(tb[4] / 256u); S.e5 = RFL(tb[5] / 256u); S.e6 = RFL(tb[6] / 256u); S.e7 = RFL(tb[7] / 256u);
#undef RFL
    S.estride = estride;
}
__device__ __forceinline__ void gather_phase(const Params& p, Ctx& F) {
    const int lane_ = lane_id(), tid_ = F.wave * 64 + lane_;
    moe_table(F);
    volatile LAS unsigned* tb = F.MISC + 32;
    const int* tok_e = (const int*)(p.ws + WS_ROUTE); const float* tok_w = (const float*)(p.ws + WS_ROUTE) + 2 * NL; const int* tok_pos = (const int*)(p.ws + WS_ROUTE) + 4 * NL;
    int* row_tok = (int*)(p.ws + WS_ROUTE) + 6 * NL; float* row_gate = (float*)(p.ws + WS_ROUTE) + 6 * NL + MP_MAX;
    const unsigned char* hb = (const unsigned char*)(p.ws + WS_HBUF); unsigned char* h2s = (unsigned char*)(p.ws + WS_H2S);
    for (int it = F.gw; it < 2 * NL; it += F.NGW) {
        const int t = it >> 1, e = tok_e[it], r = (int)tb[e] + tok_pos[it];
        *((v4u*)(h2s + (size_t)r * DM) + lane_) = *((const v4u*)(hb + (size_t)t * DM) + lane_);
        if (lane_ == 0) { row_tok[r] = t; row_gate[r] = tok_w[it]; }
    }
    for (int i = F.gw; i < NE * 256; i += F.NGW) {
        const int e = i >> 8, j = i & 255, r = (int)tb[e] + (int)tb[16 + e] + j;
        if (r < (int)tb[e + 1]) { const v4u z = {0u, 0u, 0u, 0u}; *((v4u*)(h2s + (size_t)r * DM) + lane_) = z; if (lane_ == 0) { row_tok[r] = -1; row_gate[r] = 0.f; } }
    }
}
__device__ __forceinline__ void combine_phase(const Params& p, Ctx& F) {
    const int lane_ = lane_id(), tid_ = F.wave * 64 + lane_;
    moe_table(F);
    volatile LAS unsigned* tb = F.MISC + 32;
    const int* tok_e = (const int*)(p.ws + WS_ROUTE); const int* tok_pos = (const int*)(p.ws + WS_ROUTE) + 4 * NL;
    const bf16_t* yb = (const bf16_t*)(p.ws + WS_YBUF);
    for (int t = F.gw; t < NL; t += F.NGW) {
        const int r0 = (int)tb[tok_e[2 * t]] + tok_pos[2 * t], r1 = (int)tb[tok_e[2 * t + 1]] + tok_pos[2 * t + 1];
        const float* g5 = modv(p, 1, t / T, 5);
        float* orow = p.out + (size_t)t * DM;
#pragma unroll
        for (int j = 0; j < 4; ++j) { const int col = 256 * j + 4 * lane_;
            const v2u a = *(const v2u*)(yb + (size_t)r0 * DM + col), b = *(const v2u*)(yb + (size_t)r1 * DM + col);
            f32x4 y; y[0] = __uint_as_float(a.x << 16) + __uint_as_float(b.x << 16); y[1] = __uint_as_float(a.x & 0xffff0000u) + __uint_as_float(b.x & 0xffff0000u);
            y[2] = __uint_as_float(a.y << 16) + __uint_as_float(b.y << 16); y[3] = __uint_as_float(a.y & 0xffff0000u) + __uint_as_float(b.y & 0xffff0000u);
            const f32x4 x = *(const f32x4*)(orow + col), gg = *(const f32x4*)(g5 + col);
            *(f32x4*)(orow + col) = x + gg * y; }
    }
}

namespace att {
constexpr float THR = 8.f;
constexpr int KVBLK = 64;
constexpr int SHM_V = KVBLK * 128 * 2, SHM_K = KVBLK * 128 * 2;
using bf16x8 = __attribute__((ext_vector_type(8))) short;
using s16x4  = __attribute__((ext_vector_type(4))) short;
using f32x16 = __attribute__((ext_vector_type(16))) float;
using f32x8  = __attribute__((ext_vector_type(8))) float;
using u32x4  = __attribute__((ext_vector_type(4))) unsigned;
using f32x4v = __attribute__((ext_vector_type(4))) float;
#define KSWZ(row, colB) ((row) * 256 + ((colB) ^ (((row) & 7) << 4)))
#define SBAR() __builtin_amdgcn_sched_barrier(0)
__device__ __forceinline__ int crow(int r, int hi) { return (r & 3) + 8 * (r >> 2) + 4 * hi; }
__device__ __forceinline__ unsigned cvtpk(float lo, float hi) {
  unsigned r; asm volatile("v_cvt_pk_bf16_f32 %0, %1, %2" : "=v"(r) : "v"(lo), "v"(hi)); return r;
}
__device__ __forceinline__ void partialSM(f32x16& p0, f32x16& p1, float& m_reg, float& mn, float& alpha) {
  constexpr float C = 1.4426950408889634f;
  float pmax = p0[0]; for (int r = 1; r < 16; ++r) pmax = fmaxf(pmax, p0[r]); for (int r = 0; r < 16; ++r) pmax = fmaxf(pmax, p1[r]);
  { auto rr = __builtin_amdgcn_permlane32_swap(__float_as_uint(pmax), __float_as_uint(pmax), false, false);
    pmax = fmaxf(__uint_as_float(rr[0]), __uint_as_float(rr[1])); }
  if (__builtin_expect(__all(pmax - m_reg <= THR), 1)) { mn = m_reg; alpha = 1.f; }
  else { mn = fmaxf(m_reg, pmax); alpha = __builtin_amdgcn_exp2f((m_reg - mn) * C); m_reg = mn; }
  float mnC = -mn * C;
  for (int r = 0; r < 16; ++r) p0[r] = fmaf(p0[r], C, mnC); for (int r = 0; r < 16; ++r) p1[r] = fmaf(p1[r], C, mnC);
  for (int r = 0; r < 16; ++r) p0[r] = __builtin_amdgcn_exp2f(p0[r]);
}
__device__ __forceinline__ void finishSM(f32x16& p0, f32x16& p1, float alpha, float& l_reg, bf16x8& pa0, bf16x8& pa1, bf16x8& pa2, bf16x8& pa3) {
  for (int r = 0; r < 16; ++r) p1[r] = __builtin_amdgcn_exp2f(p1[r]);
  float ps = 0; for (int r = 0; r < 16; ++r) ps += p0[r]; for (int r = 0; r < 16; ++r) ps += p1[r];
  { auto rr = __builtin_amdgcn_permlane32_swap(__float_as_uint(ps), __float_as_uint(ps), false, false);
    ps = __uint_as_float(rr[0]) + __uint_as_float(rr[1]); }
  l_reg = l_reg * alpha + ps;
#define PK4(P, BASE, OUT) do { unsigned a0 = cvtpk(P[BASE + 0], P[BASE + 1]), a1 = cvtpk(P[BASE + 2], P[BASE + 3]);   \
    unsigned b0 = cvtpk(P[BASE + 4], P[BASE + 5]), b1 = cvtpk(P[BASE + 6], P[BASE + 7]);                              \
    auto r0 = __builtin_amdgcn_permlane32_swap(a0, b0, false, false); auto r1 = __builtin_amdgcn_permlane32_swap(a1, b1, false, false); \
    u32x4 w = {r0[0], r1[0], r0[1], r1[1]}; OUT = *reinterpret_cast<bf16x8*>(&w); } while (0)
  PK4(p0, 0, pa0); PK4(p0, 8, pa1); PK4(p1, 0, pa2); PK4(p1, 8, pa3);
#undef PK4
}
template <int ND0>
__device__ __forceinline__ void qkt(f32x16& p0, f32x16& p1, const LAS char* Ks, const bf16x8* qr, int r32, int hi, int dbase) {
  p0 = f32x16{}; p1 = f32x16{};
#pragma unroll
  for (int d0 = 0; d0 < ND0; ++d0) { int cb = ((dbase + d0) * 16 + hi * 8) * 2;
    bf16x8 b0 = *reinterpret_cast<const LAS bf16x8*>(Ks + KSWZ(r32, cb));
    bf16x8 b1 = *reinterpret_cast<const LAS bf16x8*>(Ks + KSWZ(32 + r32, cb));
    p0 = __builtin_amdgcn_mfma_f32_32x32x16_bf16(b0, qr[d0], p0, 0, 0, 0);
    p1 = __builtin_amdgcn_mfma_f32_32x32x16_bf16(b1, qr[d0], p1, 0, 0, 0); }
}
__device__ __forceinline__ int v_st(int k, int c) { const int kk = (k & ~0xC) | ((k & 4) << 1) | ((k & 8) >> 1); return ((kk >> 3) * 4 + (c >> 5)) * 512 + ((kk & 7) * 32 + (c & 31)) * 2; }
__device__ __forceinline__ int v_st_lin(int k, int c) { return ((k >> 3) * 4 + (c >> 5)) * 512 + ((k & 7) * 32 + (c & 31)) * 2; }
__device__ __forceinline__ int v_rd_base(int lane) { return ((lane & 3) << 3) | (((lane >> 2) & 3) << 6) | (((lane >> 4) & 1) << 5) | (((lane >> 5) & 1) << 8); }
constexpr int v_rd_off(int d0, int ks, int half) { return d0 * 512 + ks * 4096 + half * 2048; }
template <int OFF> __device__ __forceinline__ s16x4 tr_read(int vb) {
  s16x4 r; asm volatile("ds_read_b64_tr_b16 %0, %1 offset:%2" : "=&v"(r) : "v"(vb), "i"(OFF) : "memory"); return r;
}
template <int D0> __device__ __forceinline__ void pv_one(f32x16& od, int vb, bf16x8 pa0, bf16x8 pa1, bf16x8 pa2, bf16x8 pa3) {
  const s16x4 l0 = tr_read<v_rd_off(D0, 0, 0)>(vb), h0 = tr_read<v_rd_off(D0, 0, 1)>(vb), l1 = tr_read<v_rd_off(D0, 1, 0)>(vb), h1 = tr_read<v_rd_off(D0, 1, 1)>(vb);
  const s16x4 l2 = tr_read<v_rd_off(D0, 2, 0)>(vb), h2 = tr_read<v_rd_off(D0, 2, 1)>(vb), l3 = tr_read<v_rd_off(D0, 3, 0)>(vb), h3 = tr_read<v_rd_off(D0, 3, 1)>(vb);
#if defined(DUMMY_TR) && DUMMY_TR
  { s16x4 dd; for (int i = 0; i < DUMMY_TR; ++i) asm volatile("ds_read_b64_tr_b16 %0, %1 offset:%2" : "=&v"(dd) : "v"(vb), "i"(v_rd_off(D0, 0, 0)) : "memory"); }
#endif
#if defined(DUMMY_MFMA) && DUMMY_MFMA
  { f32x4v dm = {0.f, 0.f, 0.f, 0.f}; for (int i = 0; i < DUMMY_MFMA; ++i) asm volatile("v_mfma_f32_16x16x32_bf16 %0, %1, %2, %0" : "+v"(dm) : "v"(pa0), "v"(pa1)); }
#endif
  asm volatile("s_waitcnt lgkmcnt(0)" ::: "memory"); SBAR();
#define PK(L, H) (bf16x8){L[0], L[1], L[2], L[3], H[0], H[1], H[2], H[3]}
  od = __builtin_amdgcn_mfma_f32_32x32x16_bf16(pa0, PK(l0, h0), od, 0, 0, 0);
  od = __builtin_amdgcn_mfma_f32_32x32x16_bf16(pa1, PK(l1, h1), od, 0, 0, 0);
  od = __builtin_amdgcn_mfma_f32_32x32x16_bf16(pa2, PK(l2, h2), od, 0, 0, 0);
  od = __builtin_amdgcn_mfma_f32_32x32x16_bf16(pa3, PK(l3, h3), od, 0, 0, 0);
#undef PK
}
__device__ __forceinline__ void pv_d0(f32x16* o, int vb, bf16x8 pa0, bf16x8 pa1, bf16x8 pa2, bf16x8 pa3) {
  pv_one<0>(o[0], vb, pa0, pa1, pa2, pa3); pv_one<1>(o[1], vb, pa0, pa1, pa2, pa3); pv_one<2>(o[2], vb, pa0, pa1, pa2, pa3); pv_one<3>(o[3], vb, pa0, pa1, pa2, pa3);
}

#ifndef DUMMY_EXP
#define DUMMY_EXP 0
#endif
#ifndef DUMMY_TR
#define DUMMY_TR 0
#endif
#ifndef DUMMY_MFMA
#define DUMMY_MFMA 0
#endif
__device__ __forceinline__ void dummy_exp(float x) { float d; for (int i = 0; i < DUMMY_EXP; ++i) asm volatile("v_exp_f32 %0, %1" : "=v"(d) : "v"(x)); }
__device__ __forceinline__ void expA(f32x16& p0) {
#pragma unroll
  for (int r = 0; r < 16; ++r) { dummy_exp(p0[r]); p0[r] = __builtin_amdgcn_exp2f(p0[r]); }
}
__device__ __forceinline__ void expB_sum_pack(f32x16& p0, f32x16& p1, float& l_reg, bf16x8& pa0, bf16x8& pa1, bf16x8& pa2, bf16x8& pa3) {
#pragma unroll
  for (int r = 0; r < 16; ++r) { dummy_exp(p1[r]); p1[r] = __builtin_amdgcn_exp2f(p1[r]); }
  float ps = 0;
#pragma unroll
  for (int r = 0; r < 16; ++r) ps += p0[r];
#pragma unroll
  for (int r = 0; r < 16; ++r) ps += p1[r];
  { auto rr = __builtin_amdgcn_permlane32_swap(__float_as_uint(ps), __float_as_uint(ps), false, false);
    ps = __uint_as_float(rr[0]) + __uint_as_float(rr[1]); }
  l_reg += ps;
#define PK4(P, BASE, OUT) do { unsigned a0 = cvtpk(P[BASE + 0], P[BASE + 1]), a1 = cvtpk(P[BASE + 2], P[BASE + 3]);   \
    unsigned b0 = cvtpk(P[BASE + 4], P[BASE + 5]), b1 = cvtpk(P[BASE + 6], P[BASE + 7]);                              \
    auto r0 = __builtin_amdgcn_permlane32_swap(a0, b0, false, false); auto r1 = __builtin_amdgcn_permlane32_swap(a1, b1, false, false); \
    u32x4 w = {r0[0], r1[0], r0[1], r1[1]}; OUT = *reinterpret_cast<bf16x8*>(&w); } while (0)
  PK4(p0, 0, pa0); PK4(p0, 8, pa1); PK4(p1, 0, pa2); PK4(p1, 8, pa3);
#undef PK4
}
__device__ __forceinline__ bf16x8 ld8(const bf16_t* p) { return *reinterpret_cast<const bf16x8*>(p); }

constexpr int TP = 132;
__device__ __forceinline__ void tile_to_rows(const f32x16 (&o)[4], LAS float* scr, int r32, int hi, float (&v)[64]) {
#pragma unroll
  for (int d0 = 0; d0 < 4; ++d0)
#pragma unroll
    for (int r = 0; r < 16; ++r) scr[crow(r, hi) * TP + 32 * d0 + r32] = o[d0][r];
  asm volatile("s_waitcnt lgkmcnt(0)" ::: "memory");
#pragma unroll
  for (int i = 0; i < 16; ++i) { const f32x4v t = *(const LAS f32x4v*)(scr + r32 * TP + 64 * hi + 4 * i); v[4 * i] = t[0]; v[4 * i + 1] = t[1]; v[4 * i + 2] = t[2]; v[4 * i + 3] = t[3]; }
}
__device__ __forceinline__ float pair_sum(float x) {
  auto rr = __builtin_amdgcn_permlane32_swap(__float_as_uint(x), __float_as_uint(x), false, false); return __uint_as_float(rr[0]) + __uint_as_float(rr[1]);
}


#define PVX_RD2(L0, H0, D0, KS) do { L0 = tr_read<v_rd_off(D0, KS, 0)>(vb); H0 = tr_read<v_rd_off(D0, KS, 1)>(vb); } while (0)
#define PVX_PK(L, H) (bf16x8){L[0], L[1], L[2], L[3], H[0], H[1], H[2], H[3]}
#define PVX_E(i) do { if (DOEXP) { pn[i] = __builtin_amdgcn_exp2f(pn[i]); psn += pn[i]; } } while (0)
#define PVX_W(n) asm volatile("s_waitcnt lgkmcnt(" #n ")" ::: "memory")
#define PVX_BLOCK(D0, E0) do { \
    PVX_W(6); SBAR(); o[D0] = __builtin_amdgcn_mfma_f32_32x32x16_bf16(pa0, PVX_PK(fl0, fh0), o[D0], 0, 0, 0); PVX_E(E0 + 0); PVX_RD2(fl0, fh0, D0 + 1, 0); SBAR(); \
    PVX_W(6); SBAR(); o[D0] = __builtin_amdgcn_mfma_f32_32x32x16_bf16(pa1, PVX_PK(fl1, fh1), o[D0], 0, 0, 0); PVX_E(E0 + 1); PVX_RD2(fl1, fh1, D0 + 1, 1); SBAR(); \
    PVX_W(6); SBAR(); o[D0] = __builtin_amdgcn_mfma_f32_32x32x16_bf16(pa2, PVX_PK(fl2, fh2), o[D0], 0, 0, 0); PVX_E(E0 + 2); PVX_RD2(fl2, fh2, D0 + 1, 2); SBAR(); \
    PVX_W(6); SBAR(); o[D0] = __builtin_amdgcn_mfma_f32_32x32x16_bf16(pa3, PVX_PK(fl3, fh3), o[D0], 0, 0, 0); PVX_E(E0 + 3); PVX_RD2(fl3, fh3, D0 + 1, 3); SBAR(); } while (0)
template <bool DOEXP>
__device__ __forceinline__ void pv_exp(f32x16* o, int vb, bf16x8 pa0, bf16x8 pa1, bf16x8 pa2, bf16x8 pa3, f32x16& pn, float& psn) {
  s16x4 fl0, fh0, fl1, fh1, fl2, fh2, fl3, fh3;
  asm volatile("s_waitcnt lgkmcnt(0)" ::: "memory");
  PVX_RD2(fl0, fh0, 0, 0); PVX_RD2(fl1, fh1, 0, 1); PVX_RD2(fl2, fh2, 0, 2); PVX_RD2(fl3, fh3, 0, 3);
  PVX_BLOCK(0, 0); PVX_BLOCK(1, 4); PVX_BLOCK(2, 8);
  PVX_W(6); SBAR(); o[3] = __builtin_amdgcn_mfma_f32_32x32x16_bf16(pa0, PVX_PK(fl0, fh0), o[3], 0, 0, 0); PVX_E(12); SBAR();
  PVX_W(4); SBAR(); o[3] = __builtin_amdgcn_mfma_f32_32x32x16_bf16(pa1, PVX_PK(fl1, fh1), o[3], 0, 0, 0); PVX_E(13); SBAR();
  PVX_W(2); SBAR(); o[3] = __builtin_amdgcn_mfma_f32_32x32x16_bf16(pa2, PVX_PK(fl2, fh2), o[3], 0, 0, 0); PVX_E(14); SBAR();
  PVX_W(0); SBAR(); o[3] = __builtin_amdgcn_mfma_f32_32x32x16_bf16(pa3, PVX_PK(fl3, fh3), o[3], 0, 0, 0); PVX_E(15); SBAR();
}
__device__ __forceinline__ void expB_sum_pack2(f32x16& p0, f32x16& p1, float ps, float& l_reg, bf16x8& pa0, bf16x8& pa1, bf16x8& pa2, bf16x8& pa3) {
#pragma unroll
  for (int r = 0; r < 16; ++r) { p1[r] = __builtin_amdgcn_exp2f(p1[r]); ps += p1[r]; }
  { auto rr = __builtin_amdgcn_permlane32_swap(__float_as_uint(ps), __float_as_uint(ps), false, false);
    ps = __uint_as_float(rr[0]) + __uint_as_float(rr[1]); }
  l_reg += ps;
#define PK4(P, BASE, OUT) do { unsigned a0 = cvtpk(P[BASE + 0], P[BASE + 1]), a1 = cvtpk(P[BASE + 2], P[BASE + 3]);   \
    unsigned b0 = cvtpk(P[BASE + 4], P[BASE + 5]), b1 = cvtpk(P[BASE + 6], P[BASE + 7]);                              \
    auto r0 = __builtin_amdgcn_permlane32_swap(a0, b0, false, false); auto r1 = __builtin_amdgcn_permlane32_swap(a1, b1, false, false); \
    u32x4 w = {r0[0], r1[0], r0[1], r1[1]}; OUT = *reinterpret_cast<bf16x8*>(&w); } while (0)
  PK4(p0, 0, pa0); PK4(p0, 8, pa1); PK4(p1, 0, pa2); PK4(p1, 8, pa3);
#undef PK4
}
__device__ __forceinline__ float exp_sum16(f32x16& p0) { float ps = 0.f;
#pragma unroll
  for (int r = 0; r < 16; ++r) { p0[r] = __builtin_amdgcn_exp2f(p0[r]); ps += p0[r]; }
  return ps; }

__device__ __forceinline__ void attn_unit(const int wid, const bf16_t* __restrict__ proj, const char* __restrict__ Kt_bh, const char* __restrict__ Vt_bh, bf16_t* __restrict__ concat, int qrow0, int NT, int h,
                                          LAS char* lds, float lam, float omli, const float* __restrict__ subln) {
  const int lane = lane_id(), tid = wid * 64 + lane, r32 = lane & 31, hi = lane >> 5, rg = wid & 3, c = wid >> 2;
  LAS char* V_lds = lds; LAS char* K_lds = lds + 4 * SHM_V;
  LAS float* li_l = (LAS float*)(lds + 4 * SHM_V + 4 * SHM_K) + wid * 64;
  float l_reg = 0; f32x16 o[4] = {}; bf16x8 qr[4];
  const bf16_t* Qw = proj + (size_t)(qrow0 + rg * 32 + r32) * DP + C_DQ + h * 128 + c * 64 + hi * 8;
#pragma unroll
  for (int d0 = 0; d0 < 4; ++d0) qr[d0] = ld8(Qw + d0 * 16);
  const int vb0 = (int)(uintptr_t)V_lds + v_rd_base(lane);
  const char* kg0 = Kt_bh + wid * 2048 + lane * 16; const char* vg0 = Vt_bh + wid * 2048 + lane * 16;
#define DMA_TILE(tile, slot) do { const size_t to_ = (size_t)(tile) * 16384; \
    __builtin_amdgcn_global_load_lds((const unsigned*)(kg0 + to_), (LAS unsigned*)(K_lds + (slot) * SHM_K + wid * 2048), 16, 0, 0); \
    __builtin_amdgcn_global_load_lds((const unsigned*)(kg0 + to_ + 1024), (LAS unsigned*)(K_lds + (slot) * SHM_K + wid * 2048 + 1024), 16, 0, 0); \
    __builtin_amdgcn_global_load_lds((const unsigned*)(vg0 + to_), (LAS unsigned*)(V_lds + (slot) * SHM_V + wid * 2048), 16, 0, 0); \
    __builtin_amdgcn_global_load_lds((const unsigned*)(vg0 + to_ + 1024), (LAS unsigned*)(V_lds + (slot) * SHM_V + wid * 2048 + 1024), 16, 0, 0); } while (0)
#define BAR() do { asm volatile("s_waitcnt vmcnt(0) lgkmcnt(0)" ::: "memory"); __builtin_amdgcn_s_barrier(); asm volatile("" ::: "memory"); } while (0)
#define STAGE(b) do { if ((b) + 3 < NT) DMA_TILE((b) + 3, ((b) + 3) & 3); } while (0)
#define STAGES(b, slot) do { if ((b) + 3 < NT) DMA_TILE((b) + 3, slot); } while (0)
#define QKT(P0, P1, t) qkt<4>(P0, P1, K_lds + ((t) & 3) * SHM_K, qr, r32, hi, 4 * c)
#define QKTS(P0, P1, slot) qkt<4>(P0, P1, K_lds + (slot) * SHM_K, qr, r32, hi, 4 * c)
#define PV(t) pv_d0(o, vb0 + ((t) & 3) * SHM_V, pa0, pa1, pa2, pa3)
  f32x16 pA0, pA1, pB0, pB1; bf16x8 pa0, pa1, pa2, pa3; float psA = 0.f, psB = 0.f;
#define PVE(t, PN, PSN) do { PSN = 0.f; pv_exp<true>(o, vb0 + ((t) & 3) * SHM_V, pa0, pa1, pa2, pa3, PN, PSN); } while (0)
#define PVES(slot, PN, PSN) do { PSN = 0.f; pv_exp<true>(o, vb0 + (slot) * SHM_V, pa0, pa1, pa2, pa3, PN, PSN); } while (0)
#define PVL(t) do { float d_ = 0.f; pv_exp<false>(o, vb0 + ((t) & 3) * SHM_V, pa0, pa1, pa2, pa3, pA0, d_); } while (0)
  DMA_TILE(0, 0); DMA_TILE(1, 1); DMA_TILE(2, 2);
  BAR();
  QKT(pA0, pA1, 0); psA = exp_sum16(pA0);
  for (int t = 0; t < NT; t += 4) {
    if (c == 0) { BAR(); STAGES(t, 3); } SBAR();
    QKTS(pB0, pB1, 1); expB_sum_pack2(pA0, pA1, psA, l_reg, pa0, pa1, pa2, pa3); SBAR();
    if (c == 1) { BAR(); STAGES(t, 3); } SBAR();
    PVES(0, pB0, psB); SBAR();
    if (c == 0) { BAR(); STAGES(t + 1, 0); } SBAR();
    QKTS(pA0, pA1, 2); expB_sum_pack2(pB0, pB1, psB, l_reg, pa0, pa1, pa2, pa3); SBAR();
    if (c == 1) { BAR(); STAGES(t + 1, 0); } SBAR();
    PVES(1, pA0, psA); SBAR();
    if (c == 0) { BAR(); STAGES(t + 2, 1); } SBAR();
    QKTS(pB0, pB1, 3); expB_sum_pack2(pA0, pA1, psA, l_reg, pa0, pa1, pa2, pa3); SBAR();
    if (c == 1) { BAR(); STAGES(t + 2, 1); } SBAR();
    PVES(2, pB0, psB); SBAR();
    if (c == 0) { BAR(); STAGES(t + 3, 2); } SBAR();
    if (t + 4 < NT) QKTS(pA0, pA1, 0);
    expB_sum_pack2(pB0, pB1, psB, l_reg, pa0, pa1, pa2, pa3); SBAR();
    if (c == 1) { BAR(); STAGES(t + 3, 2); } SBAR();
    PVES(3, pA0, psA);
    SBAR();
  }
#undef PVE
#undef PVES
#undef QKTS
#undef STAGES
#undef PVL
  if (hi == 0) li_l[r32] = l_reg; asm volatile("s_waitcnt lgkmcnt(0)" ::: "memory");
#pragma unroll
  for (int r = 0; r < 16; ++r) { const float rl = __builtin_amdgcn_rcpf(li_l[crow(r, hi)]);
#pragma unroll
    for (int d0 = 0; d0 < 4; ++d0) o[d0][r] *= rl; }
  __syncthreads();
  LAS float* xch = (LAS float*)lds + rg * 4096;
  if (c == 1) {
#pragma unroll
    for (int d0 = 0; d0 < 4; ++d0)
#pragma unroll
      for (int r = 0; r < 16; ++r) xch[(d0 * 16 + r) * 64 + lane] = o[d0][r];
  }
  __syncthreads();
  if (c == 0) {
#pragma unroll
    for (int r = 0; r < 16; ++r) { float s = 0.f;
#pragma unroll
      for (int d0 = 0; d0 < 4; ++d0) { const float d = o[d0][r] - lam * xch[(d0 * 16 + r) * 64 + lane]; o[d0][r] = d; s += d * d; }
      s += __shfl_xor(s, 1); s += __shfl_xor(s, 2); s += __shfl_xor(s, 4); s += __shfl_xor(s, 8); s += __shfl_xor(s, 16);
      const float rr = rsqrtf(s * (1.f / 128.f) + EPS) * omli;
      bf16_t* orow = concat + (size_t)(qrow0 + rg * 32 + crow(r, hi)) * DM + 512 + h * 128 + r32;
#pragma unroll
      for (int d0 = 0; d0 < 4; ++d0) orow[d0 * 32] = f2bf(o[d0][r] * rr * subln[d0 * 32 + r32]); }
  }
  __syncthreads();
#undef DMA_TILE
#undef BAR
#undef STAGE
#undef QKT
#undef PV
}


typedef float f32x2 __attribute__((ext_vector_type(2)));
__device__ __forceinline__ void exp_half(f32x16& ph, f32x2& lacc) {
#pragma unroll
  for (int r = 0; r < 16; r += 2) { ph[r] = __builtin_amdgcn_exp2f(ph[r]); ph[r + 1] = __builtin_amdgcn_exp2f(ph[r + 1]); const f32x2 e = {ph[r], ph[r + 1]}; lacc += e; }
}
__device__ __forceinline__ void pack_half(const f32x16& ph, bf16x8& x0, bf16x8& x1) {
  { u32x4 w = {cvtpk(ph[0], ph[1]), cvtpk(ph[2], ph[3]), cvtpk(ph[4], ph[5]), cvtpk(ph[6], ph[7])}; x0 = *reinterpret_cast<bf16x8*>(&w); }
  { u32x4 w = {cvtpk(ph[8], ph[9]), cvtpk(ph[10], ph[11]), cvtpk(ph[12], ph[13]), cvtpk(ph[14], ph[15])}; x1 = *reinterpret_cast<bf16x8*>(&w); }
}

template <int D0> __device__ __forceinline__ void pv2_block(f32x16& oa, f32x16& ob, int vb, s16x4& fl0, s16x4& fh0, s16x4& fl1, s16x4& fh1, s16x4& fl2, s16x4& fh2, s16x4& fl3, s16x4& fh3,
                                                           bf16x8 a0, bf16x8 a1, bf16x8 a2, bf16x8 a3, bf16x8 b0, bf16x8 b1, bf16x8 b2, bf16x8 b3) {
#define PV2_STEP(A, B, FL, FH, KS, WN) do { asm volatile("s_waitcnt lgkmcnt(" #WN ")" ::: "memory"); SBAR(); \
    oa = __builtin_amdgcn_mfma_f32_32x32x16_bf16(A, PVX_PK(FL, FH), oa, 0, 0, 0); ob = __builtin_amdgcn_mfma_f32_32x32x16_bf16(B, PVX_PK(FL, FH), ob, 0, 0, 0); \
    if (D0 < 3) { FL = tr_read<v_rd_off((D0 + 1) & 3, KS, 0)>(vb); FH = tr_read<v_rd_off((D0 + 1) & 3, KS, 1)>(vb); } SBAR(); } while (0)
  if (D0 < 3) { PV2_STEP(a0, b0, fl0, fh0, 0, 6); PV2_STEP(a1, b1, fl1, fh1, 1, 6); PV2_STEP(a2, b2, fl2, fh2, 2, 6); PV2_STEP(a3, b3, fl3, fh3, 3, 6); }
  else        { PV2_STEP(a0, b0, fl0, fh0, 0, 6); PV2_STEP(a1, b1, fl1, fh1, 1, 4); PV2_STEP(a2, b2, fl2, fh2, 2, 2); PV2_STEP(a3, b3, fl3, fh3, 3, 0); }
#undef PV2_STEP
}
__device__ __forceinline__ void attn_unit3p(const int wid, const bf16_t* __restrict__ proj, const char* __restrict__ Kt_bh, const char* __restrict__ Vt_bh, bf16_t* __restrict__ concat, int qrow0, int NT, int h,
                                            LAS char* lds, float lam, float omli, const float* __restrict__ subln) {
  const int lane = lane_id(), r32 = lane & 31, hi = lane >> 5;
  LAS char* V_lds = lds; LAS char* K_lds = lds + 2 * SHM_V; LAS char* Qw = lds + 65536 + wid * 8192;
  LAS float* li_l = (LAS float*)(lds + 131072) + wid * 64;
  f32x2 l0v = {0.f, 0.f}, l1v = {0.f, 0.f}; f32x16 o0[4] = {}, o1[4] = {};
  const int vb0 = (int)(uintptr_t)V_lds + v_rd_base(lane);
  const char* kg0 = Kt_bh + wid * 2048 + lane * 16; const char* vg0 = Vt_bh + wid * 2048 + lane * 16;
#define DMA_TILE(tile, slot) do { const size_t to_ = (size_t)(tile) * 16384; \
    __builtin_amdgcn_global_load_lds((const unsigned*)(kg0 + to_), (LAS unsigned*)(K_lds + (slot) * SHM_K + wid * 2048), 16, 0, 0); \
    __builtin_amdgcn_global_load_lds((const unsigned*)(kg0 + to_ + 1024), (LAS unsigned*)(K_lds + (slot) * SHM_K + wid * 2048 + 1024), 16, 0, 0); \
    __builtin_amdgcn_global_load_lds((const unsigned*)(vg0 + to_), (LAS unsigned*)(V_lds + (slot) * SHM_V + wid * 2048), 16, 0, 0); \
    __builtin_amdgcn_global_load_lds((const unsigned*)(vg0 + to_ + 1024), (LAS unsigned*)(V_lds + (slot) * SHM_V + wid * 2048 + 1024), 16, 0, 0); } while (0)
#define BAR() do { asm volatile("s_waitcnt vmcnt(0) lgkmcnt(0)" ::: "memory"); __builtin_amdgcn_s_barrier(); asm volatile("" ::: "memory"); } while (0)
  bf16x8 qf00, qf01, qf02, qf03, qf10, qf11, qf12, qf13;
  { const bf16_t* qg = proj + (size_t)(qrow0 + wid * 32 + r32) * DP + C_DQ + h * 128 + hi * 8;
    qf00 = ld8(qg); qf01 = ld8(qg + 16); qf02 = ld8(qg + 32); qf03 = ld8(qg + 48); qf10 = ld8(qg + 64); qf11 = ld8(qg + 80); qf12 = ld8(qg + 96); qf13 = ld8(qg + 112); }
  DMA_TILE(0, 0);
  bf16x8 a0, a1, a2, a3, b0, b1, b2, b3;
  int sw0 = KSWZ(r32, (0 * 16 + hi * 8) * 2), sw1 = KSWZ(r32, (1 * 16 + hi * 8) * 2), sw2 = KSWZ(r32, (2 * 16 + hi * 8) * 2), sw3 = KSWZ(r32, (3 * 16 + hi * 8) * 2);
  int kad0_ = (int)(uintptr_t)K_lds + sw0, kad1_ = (int)(uintptr_t)K_lds + sw1, kad2_ = (int)(uintptr_t)K_lds + sw2, kad3_ = (int)(uintptr_t)K_lds + sw3;
  asm volatile("" : "+v"(kad0_), "+v"(kad1_), "+v"(kad2_), "+v"(kad3_));
  LAS char* const kad0 = (LAS char*)(uintptr_t)kad0_; LAS char* const kad1 = (LAS char*)(uintptr_t)kad1_; LAS char* const kad2 = (LAS char*)(uintptr_t)kad2_; LAS char* const kad3 = (LAS char*)(uintptr_t)kad3_;
#define QK2(P0, P1, so, cc) do { P0 = f32x16{}; P1 = f32x16{}; _Pragma("unroll") for (int d0 = 0; d0 < 4; ++d0) { const int cb = ((4 * (cc) + d0) * 16 + hi * 8) * 2; \
    const bf16x8 ka_ = *reinterpret_cast<const LAS bf16x8*>(K_lds + (so) * SHM_K + KSWZ(r32, cb)), kb_ = *reinterpret_cast<const LAS bf16x8*>(K_lds + (so) * SHM_K + KSWZ(32 + r32, cb)); \
    const bf16x8 q_ = *reinterpret_cast<const LAS bf16x8*>(Qw + KSWZ(r32, cb)); \
    P0 = __builtin_amdgcn_mfma_f32_32x32x16_bf16(ka_, q_, P0, 0, 0, 0); P1 = __builtin_amdgcn_mfma_f32_32x32x16_bf16(kb_, q_, P1, 0, 0, 0); } } while (0)
#define QKA(PH, so, cc, koff) do { PH = f32x16{}; \
    { const bf16x8 k_ = *reinterpret_cast<const LAS bf16x8*>(kad0 + ((so) * SHM_K + (koff) * 256 + 128 * (cc))); PH = __builtin_amdgcn_mfma_f32_32x32x16_bf16(k_, (cc) ? qf10 : qf00, PH, 0, 0, 0); } \
    { const bf16x8 k_ = *reinterpret_cast<const LAS bf16x8*>(kad1 + ((so) * SHM_K + (koff) * 256 + 128 * (cc))); PH = __builtin_amdgcn_mfma_f32_32x32x16_bf16(k_, (cc) ? qf11 : qf01, PH, 0, 0, 0); } } while (0)
#define QKB(PH, so, cc, koff) do { \
    { const bf16x8 k_ = *reinterpret_cast<const LAS bf16x8*>(kad2 + ((so) * SHM_K + (koff) * 256 + 128 * (cc))); PH = __builtin_amdgcn_mfma_f32_32x32x16_bf16(k_, (cc) ? qf12 : qf02, PH, 0, 0, 0); } \
    { const bf16x8 k_ = *reinterpret_cast<const LAS bf16x8*>(kad3 + ((so) * SHM_K + (koff) * 256 + 128 * (cc))); PH = __builtin_amdgcn_mfma_f32_32x32x16_bf16(k_, (cc) ? qf13 : qf03, PH, 0, 0, 0); } } while (0)
#define QKH(PH, so, cc, koff) do { QKA(PH, so, cc, koff); QKB(PH, so, cc, koff); } while (0)
#define SGB(m, n) __builtin_amdgcn_sched_group_barrier(m, n, 0)
#define STEP(PN, so, cc, koff, PO, LV, X0, X1) do { \
    QKA(PN, so, cc, koff); exp_half(PO, LV); SGB(0x100, 2); SGB(0x8, 1); SGB(0x2, 12); SGB(0x8, 1); SGB(0x2, 12); SBAR(); asm volatile("" : "+v"(LV)); SBAR(); \
    QKB(PN, so, cc, koff); pack_half(PO, X0, X1); SGB(0x100, 2); SGB(0x8, 1); SGB(0x2, 4); SGB(0x8, 1); SGB(0x2, 4); MBAR(PN); } while (0)
#define MBAR(X) do { SBAR(); asm volatile("" : "+v"(X) :: "memory"); SBAR(); } while (0)
#define TILE(t, so) do { BAR(); if ((t) + 1 < NT) DMA_TILE((t) + 1, 1 - (so)); SBAR(); \
    { f32x16 p0, p1; \
      QKH(p0, so, 0, 0); MBAR(p0); \
      STEP(p1, so, 0, 32, p0, l0v, a0, a1); \
      STEP(p0, so, 1, 0, p1, l0v, a2, a3); \
      STEP(p1, so, 1, 32, p0, l1v, b0, b1); \
      exp_half(p1, l1v); SBAR(); asm volatile("" : "+v"(l1v)); SBAR(); pack_half(p1, b2, b3); } SBAR(); \
    { const int vb = vb0 + (so) * SHM_V; s16x4 fl0, fh0, fl1, fh1, fl2, fh2, fl3, fh3; \
      asm volatile("s_waitcnt lgkmcnt(0)" ::: "memory"); \
      PVX_RD2(fl0, fh0, 0, 0); PVX_RD2(fl1, fh1, 0, 1); PVX_RD2(fl2, fh2, 0, 2); PVX_RD2(fl3, fh3, 0, 3); \
      pv2_block<0>(o0[0], o1[0], vb, fl0, fh0, fl1, fh1, fl2, fh2, fl3, fh3, a0, a1, a2, a3, b0, b1, b2, b3); \
      pv2_block<1>(o0[1], o1[1], vb, fl0, fh0, fl1, fh1, fl2, fh2, fl3, fh3, a0, a1, a2, a3, b0, b1, b2, b3); \
      pv2_block<2>(o0[2], o1[2], vb, fl0, fh0, fl1, fh1, fl2, fh2, fl3, fh3, a0, a1, a2, a3, b0, b1, b2, b3); \
      pv2_block<3>(o0[3], o1[3], vb, fl0, fh0, fl1, fh1, fl2, fh2, fl3, fh3, a0, a1, a2, a3, b0, b1, b2, b3); } SBAR(); } while (0)
  for (int t = 0; t < NT; t += 2) { TILE(t, 0); TILE(t + 1, 1); }
  const float l0 = pair_sum(l0v[0] + l0v[1]), l1 = pair_sum(l1v[0] + l1v[1]);
  if (hi == 0) { li_l[r32] = l0; li_l[32 + r32] = l1; } asm volatile("s_waitcnt lgkmcnt(0)" ::: "memory");
#pragma unroll
  for (int r = 0; r < 16; ++r) { const float ra = __builtin_amdgcn_rcpf(li_l[crow(r, hi)]), rb = lam * __builtin_amdgcn_rcpf(li_l[32 + crow(r, hi)]);
    float s = 0.f;
#pragma unroll
    for (int d0 = 0; d0 < 4; ++d0) { const float d = o0[d0][r] * ra - o1[d0][r] * rb; o0[d0][r] = d; s += d * d; }
    s += __shfl_xor(s, 1); s += __shfl_xor(s, 2); s += __shfl_xor(s, 4); s += __shfl_xor(s, 8); s += __shfl_xor(s, 16);
    const float rr = rsqrtf(s * (1.f / 128.f) + EPS) * omli;
    bf16_t* orow = concat + (size_t)(qrow0 + wid * 32 + crow(r, hi)) * DM + 512 + h * 128 + r32;
#pragma unroll
    for (int d0 = 0; d0 < 4; ++d0) orow[d0 * 32] = f2bf(o0[d0][r] * rr * subln[d0 * 32 + r32]); }
  asm volatile("s_waitcnt vmcnt(0) lgkmcnt(0)" ::: "memory"); __syncthreads();
#undef DMA_TILE
#undef BAR
#undef QK2
#undef QKH
#undef QKA
#undef QKB
#undef TILE
#undef STEP
#undef MBAR
#undef SGB
}

__device__ __forceinline__ void attn_unit3q(const int wid, const bf16_t* __restrict__ proj, const char* __restrict__ Kt_bh, const char* __restrict__ Vt_bh, bf16_t* __restrict__ concat, int qrow0, int NT, int h,
                                            LAS char* lds, float lam, float omli, const float* __restrict__ subln) {
  const int lane = lane_id(), r32 = lane & 31, hi = lane >> 5, rg = wid & 3, c = wid >> 2;
  LAS char* V_lds = lds; LAS char* K_lds = lds + 2 * SHM_V;
  LAS float* li_l = (LAS float*)(lds + 131072) + wid * 64;
  f32x2 l0v = {0.f, 0.f}, l1v = {0.f, 0.f}; f32x16 o0[4] = {}, o1[4] = {};
  const int vb0 = (int)(uintptr_t)V_lds + v_rd_base(lane);
  const char* kg0 = Kt_bh + wid * 2048 + lane * 16; const char* vg0 = Vt_bh + wid * 2048 + lane * 16;
#define DMA_TILE(tile, slot) do { const size_t to_ = (size_t)(tile) * 16384; \
    __builtin_amdgcn_global_load_lds((const unsigned*)(kg0 + to_), (LAS unsigned*)(K_lds + (slot) * SHM_K + wid * 2048), 16, 0, 0); \
    __builtin_amdgcn_global_load_lds((const unsigned*)(kg0 + to_ + 1024), (LAS unsigned*)(K_lds + (slot) * SHM_K + wid * 2048 + 1024), 16, 0, 0); \
    __builtin_amdgcn_global_load_lds((const unsigned*)(vg0 + to_), (LAS unsigned*)(V_lds + (slot) * SHM_V + wid * 2048), 16, 0, 0); \
    __builtin_amdgcn_global_load_lds((const unsigned*)(vg0 + to_ + 1024), (LAS unsigned*)(V_lds + (slot) * SHM_V + wid * 2048 + 1024), 16, 0, 0); } while (0)
#define BAR() do { asm volatile("s_waitcnt vmcnt(0) lgkmcnt(0)" ::: "memory"); __builtin_amdgcn_s_barrier(); asm volatile("" ::: "memory"); } while (0)
  bf16x8 qf00, qf01, qf02, qf03, qf10, qf11, qf12, qf13;
  { const bf16_t* qg = proj + (size_t)(qrow0 + rg * 64 + r32) * DP + C_DQ + h * 128 + c * 64 + hi * 8;
    qf00 = ld8(qg); qf01 = ld8(qg + 16); qf02 = ld8(qg + 32); qf03 = ld8(qg + 48); qg += (size_t)32 * DP;
    qf10 = ld8(qg); qf11 = ld8(qg + 16); qf12 = ld8(qg + 32); qf13 = ld8(qg + 48); }
  DMA_TILE(0, 0);
  bf16x8 a0, a1, a2, a3, b0, b1, b2, b3;
  int kad0_ = (int)(uintptr_t)K_lds + KSWZ(r32, (0 * 16 + hi * 8) * 2) + 128 * c, kad1_ = (int)(uintptr_t)K_lds + KSWZ(r32, (1 * 16 + hi * 8) * 2) + 128 * c;
  int kad2_ = (int)(uintptr_t)K_lds + KSWZ(r32, (2 * 16 + hi * 8) * 2) + 128 * c, kad3_ = (int)(uintptr_t)K_lds + KSWZ(r32, (3 * 16 + hi * 8) * 2) + 128 * c;
  asm volatile("" : "+v"(kad0_), "+v"(kad1_), "+v"(kad2_), "+v"(kad3_));
  LAS char* const kad0 = (LAS char*)(uintptr_t)kad0_; LAS char* const kad1 = (LAS char*)(uintptr_t)kad1_; LAS char* const kad2 = (LAS char*)(uintptr_t)kad2_; LAS char* const kad3 = (LAS char*)(uintptr_t)kad3_;
#define QKA(PH, so, rb, koff, LK) do { PH = f32x16{}; \
    { if (LK) kf0 = *reinterpret_cast<const LAS bf16x8*>(kad0 + ((so) * SHM_K + (koff) * 256)); PH = __builtin_amdgcn_mfma_f32_32x32x16_bf16(kf0, (rb) ? qf10 : qf00, PH, 0, 0, 0); } \
    { if (LK) kf1 = *reinterpret_cast<const LAS bf16x8*>(kad1 + ((so) * SHM_K + (koff) * 256)); PH = __builtin_amdgcn_mfma_f32_32x32x16_bf16(kf1, (rb) ? qf11 : qf01, PH, 0, 0, 0); } } while (0)
#define QKB(PH, so, rb, koff, LK) do { \
    { if (LK) kf2 = *reinterpret_cast<const LAS bf16x8*>(kad2 + ((so) * SHM_K + (koff) * 256)); PH = __builtin_amdgcn_mfma_f32_32x32x16_bf16(kf2, (rb) ? qf12 : qf02, PH, 0, 0, 0); } \
    { if (LK) kf3 = *reinterpret_cast<const LAS bf16x8*>(kad3 + ((so) * SHM_K + (koff) * 256)); PH = __builtin_amdgcn_mfma_f32_32x32x16_bf16(kf3, (rb) ? qf13 : qf03, PH, 0, 0, 0); } } while (0)
#define SGB(m, n) __builtin_amdgcn_sched_group_barrier(m, n, 0)
#define MBAR(X) do { SBAR(); asm volatile("" : "+v"(X) :: "memory"); SBAR(); } while (0)
#define STEP(PN, so, rb, koff, LK, PO, LV, X0, X1) do { \
    QKA(PN, so, rb, koff, LK); exp_half(PO, LV); if (LK) SGB(0x100, 2); SGB(0x8, 1); SGB(0x2, 12); SGB(0x8, 1); SGB(0x2, 12); SBAR(); asm volatile("" : "+v"(LV)); SBAR(); \
    QKB(PN, so, rb, koff, LK); pack_half(PO, X0, X1); if (LK) SGB(0x100, 2); SGB(0x8, 1); SGB(0x2, 4); SGB(0x8, 1); SGB(0x2, 4); MBAR(PN); } while (0)
#define TILE(t, so) do { BAR(); if ((t) + 1 < NT) DMA_TILE((t) + 1, 1 - (so)); SBAR(); \
    { f32x16 p0, p1; bf16x8 kf0, kf1, kf2, kf3; \
      QKA(p0, so, 0, 0, 1); QKB(p0, so, 0, 0, 1); MBAR(p0); \
      STEP(p1, so, 1, 0, 0, p0, l0v, a0, a1); \
      STEP(p0, so, 0, 32, 1, p1, l1v, b0, b1); \
      STEP(p1, so, 1, 32, 0, p0, l0v, a2, a3); \
      exp_half(p1, l1v); SBAR(); asm volatile("" : "+v"(l1v)); SBAR(); pack_half(p1, b2, b3); } SBAR(); \
    { const int vb = vb0 + (so) * SHM_V; s16x4 fl0, fh0, fl1, fh1, fl2, fh2, fl3, fh3; \
      asm volatile("s_waitcnt lgkmcnt(0)" ::: "memory"); \
      PVX_RD2(fl0, fh0, 0, 0); PVX_RD2(fl1, fh1, 0, 1); PVX_RD2(fl2, fh2, 0, 2); PVX_RD2(fl3, fh3, 0, 3); \
      pv2_block<0>(o0[0], o1[0], vb, fl0, fh0, fl1, fh1, fl2, fh2, fl3, fh3, a0, a1, a2, a3, b0, b1, b2, b3); \
      pv2_block<1>(o0[1], o1[1], vb, fl0, fh0, fl1, fh1, fl2, fh2, fl3, fh3, a0, a1, a2, a3, b0, b1, b2, b3); \
      pv2_block<2>(o0[2], o1[2], vb, fl0, fh0, fl1, fh1, fl2, fh2, fl3, fh3, a0, a1, a2, a3, b0, b1, b2, b3); \
      pv2_block<3>(o0[3], o1[3], vb, fl0, fh0, fl1, fh1, fl2, fh2, fl3, fh3, a0, a1, a2, a3, b0, b1, b2, b3); } SBAR(); } while (0)
  for (int t = 0; t < NT; t += 2) { TILE(t, 0); TILE(t + 1, 1); }
  const float l0 = pair_sum(l0v[0] + l0v[1]), l1 = pair_sum(l1v[0] + l1v[1]);
  if (hi == 0) { li_l[r32] = l0; li_l[32 + r32] = l1; }
  asm volatile("s_waitcnt vmcnt(0) lgkmcnt(0)" ::: "memory"); __syncthreads();
  LAS float* xw = (LAS float*)(lds + (rg * 2 + c) * 16384) + lane; const LAS float* xr = (const LAS float*)(lds + (rg * 2 + (1 - c)) * 16384) + lane;
  const float sgn = c ? lam : 1.f;
#define SEND(OX, LOFF) do { _Pragma("unroll") for (int r = 0; r < 16; ++r) { const float rl = sgn * __builtin_amdgcn_rcpf(li_l[(LOFF) + crow(r, hi)]); \
    _Pragma("unroll") for (int d0 = 0; d0 < 4; ++d0) xw[(d0 * 16 + r) * 64] = OX[d0][r] * rl; } } while (0)
  if (c == 0) SEND(o1, 32); else SEND(o0, 0);
  asm volatile("s_waitcnt lgkmcnt(0)" ::: "memory"); __syncthreads();
#define FINISH(OX, LOFF, RB) do { _Pragma("unroll") for (int r = 0; r < 16; ++r) { const float rl = sgn * __builtin_amdgcn_rcpf(li_l[(LOFF) + crow(r, hi)]); float s = 0.f; \
    _Pragma("unroll") for (int d0 = 0; d0 < 4; ++d0) { const float own = OX[d0][r] * rl, oth = xr[(d0 * 16 + r) * 64]; const float d = c ? oth - own : own - oth; OX[d0][r] = d; s += d * d; } \
    s += __shfl_xor(s, 1); s += __shfl_xor(s, 2); s += __shfl_xor(s, 4); s += __shfl_xor(s, 8); s += __shfl_xor(s, 16); \
    const float rr = rsqrtf(s * (1.f / 128.f) + EPS) * omli; \
    bf16_t* orow = concat + (size_t)(qrow0 + rg * 64 + (RB) * 32 + crow(r, hi)) * DM + 512 + h * 128 + r32; \
    _Pragma("unroll") for (int d0 = 0; d0 < 4; ++d0) orow[d0 * 32] = f2bf(OX[d0][r] * rr * subln[d0 * 32 + r32]); } } while (0)
  if (c == 0) FINISH(o0, 0, 0); else FINISH(o1, 32, 1);
  asm volatile("s_waitcnt vmcnt(0) lgkmcnt(0)" ::: "memory"); __syncthreads();
#undef SEND
#undef FINISH
#undef DMA_TILE
#undef BAR
#undef QKA
#undef QKB
#undef TILE
#undef STEP
#undef MBAR
#undef SGB
}

__device__ __forceinline__ bf16x8 scale8(bf16x8 v, float s) {
  u32x4 w;
#pragma unroll
  for (int i = 0; i < 4; ++i) { const float a = __uint_as_float(((unsigned)(unsigned short)v[2 * i]) << 16) * s, b = __uint_as_float(((unsigned)(unsigned short)v[2 * i + 1]) << 16) * s; w[i] = cvtpk(a, b); }
  return *reinterpret_cast<bf16x8*>(&w);
}
template <int KS> __device__ __forceinline__ void trfrag_issue(int vb, s16x4& l, s16x4& h) { l = tr_read<v_rd_off(0, KS, 0)>(vb); h = tr_read<v_rd_off(0, KS, 1)>(vb); }
#define PKF(L, H) (bf16x8){L[0], L[1], L[2], L[3], H[0], H[1], H[2], H[3]}
template <int KS> __device__ __forceinline__ void cs_step(f32x16* acc, int kb, int vv) {
  s16x4 al, ah, b0l, b0h, b1l, b1h, b2l, b2h, b3l, b3h;
  trfrag_issue<KS>(kb, al, ah); trfrag_issue<KS>(vv, b0l, b0h); trfrag_issue<KS>(vv + 512, b1l, b1h); trfrag_issue<KS>(vv + 1024, b2l, b2h); trfrag_issue<KS>(vv + 1536, b3l, b3h);
  asm volatile("s_waitcnt lgkmcnt(0)" ::: "memory"); SBAR();
  const bf16x8 a = PKF(al, ah);
  acc[0] = __builtin_amdgcn_mfma_f32_32x32x16_bf16(a, PKF(b0l, b0h), acc[0], 0, 0, 0);
  acc[1] = __builtin_amdgcn_mfma_f32_32x32x16_bf16(a, PKF(b1l, b1h), acc[1], 0, 0, 0);
  acc[2] = __builtin_amdgcn_mfma_f32_32x32x16_bf16(a, PKF(b2l, b2h), acc[2], 0, 0, 0);
  acc[3] = __builtin_amdgcn_mfma_f32_32x32x16_bf16(a, PKF(b3l, b3h), acc[3], 0, 0, 0);
}
__device__ __forceinline__ void chunk_state_unit(const int wid, const bf16_t* __restrict__ proj, bf16_t* __restrict__ csf, bf16_t* __restrict__ csb, int rowbase, int h, float lgf2, float lgb2, LAS char* lds) {
  const int lane = lane_id(), tid = wid * 64 + lane, r32 = lane & 31, hi = lane >> 5;
  const int sr = tid >> 4, sc = (tid & 15) * 8;
  { bf16x8 kv[4], vv[4];
#pragma unroll
    for (int g = 0; g < 4; ++g) { const bf16_t* rp = proj + (size_t)(rowbase + 32 * g + sr) * DP + h * 128 + sc; kv[g] = ld8(rp + C_RK); vv[g] = ld8(rp + C_RV); }
#pragma unroll
    for (int g = 0; g < 4; ++g) { const int row = 32 * g + sr;
      const float wf = __builtin_amdgcn_exp2f(lgf2 * (float)(127 - row)), wb = __builtin_amdgcn_exp2f(lgb2 * (float)row);
      const int off = (row >> 6) * 16384 + v_st(row & 63, sc);
      *(LAS bf16x8*)(lds + off) = vv[g]; *(LAS bf16x8*)(lds + 32768 + off) = scale8(kv[g], wf); *(LAS bf16x8*)(lds + 65536 + off) = scale8(kv[g], wb); } }
  __syncthreads();
  const int dir = wid >> 2, ib = wid & 3;
  const int vbK = (int)(uintptr_t)(lds + 32768 + dir * 32768) + v_rd_base(lane) + ib * 512, vbV = (int)(uintptr_t)lds + v_rd_base(lane);
  f32x16 acc[4] = {};
  cs_step<0>(acc, vbK, vbV); cs_step<1>(acc, vbK, vbV); cs_step<2>(acc, vbK, vbV); cs_step<3>(acc, vbK, vbV);
  cs_step<0>(acc, vbK + 16384, vbV + 16384); cs_step<1>(acc, vbK + 16384, vbV + 16384); cs_step<2>(acc, vbK + 16384, vbV + 16384); cs_step<3>(acc, vbK + 16384, vbV + 16384);
  bf16_t* outp = (dir ? csb : csf) + r32;
#pragma unroll
  for (int r = 0; r < 16; ++r) { bf16_t* orow = outp + (size_t)(32 * ib + crow(r, hi)) * 128;
#pragma unroll
    for (int jb = 0; jb < 4; ++jb) orow[32 * jb] = f2bf(acc[jb][r]); }
  __syncthreads();
}
__device__ __forceinline__ void pack_p(const f32x16& p0, const f32x16& p1, bf16x8& pa0, bf16x8& pa1, bf16x8& pa2, bf16x8& pa3) {
#define PK4(P, BASE, OUT) do { unsigned a0 = cvtpk(P[BASE + 0], P[BASE + 1]), a1 = cvtpk(P[BASE + 2], P[BASE + 3]);   \
    unsigned b0 = cvtpk(P[BASE + 4], P[BASE + 5]), b1 = cvtpk(P[BASE + 6], P[BASE + 7]);                              \
    auto r0 = __builtin_amdgcn_permlane32_swap(a0, b0, false, false); auto r1 = __builtin_amdgcn_permlane32_swap(a1, b1, false, false); \
    u32x4 w = {r0[0], r1[0], r0[1], r1[1]}; OUT = *reinterpret_cast<bf16x8*>(&w); } while (0)
  PK4(p0, 0, pa0); PK4(p0, 8, pa1); PK4(p1, 0, pa2); PK4(p1, 8, pa3);
#undef PK4
}
__device__ __forceinline__ float decay_w(int d, float lgf2, float lgb2) {
  const float e = __builtin_amdgcn_exp2f(d < 0 ? lgf2 * (float)(-d) : lgb2 * (float)d); return d == 0 ? 2.f : e;
}
__device__ __forceinline__ void ret_out_unit(const int wid, const bf16_t* __restrict__ proj, bf16_t* __restrict__ concat, const bf16_t* __restrict__ spA, const bf16_t* __restrict__ spB, size_t dstride,
                                             int rowA, int rowB, int h, float lgf2, float lgb2, const float* __restrict__ gn, LAS char* lds) {
  const int lane = lane_id(), tid = wid * 64 + lane, r32 = lane & 31, hi = lane >> 5, rg = wid & 3, ch = wid >> 2;
  const int sr = tid >> 4, sc = (tid & 15) * 8;
  const int rowbase = ch ? rowB : rowA;
  { bf16x8 kv[8], vv[8];
#pragma unroll
    for (int c2 = 0; c2 < 2; ++c2)
#pragma unroll
      for (int g = 0; g < 4; ++g) { const bf16_t* rp = proj + (size_t)((c2 ? rowB : rowA) + 32 * g + sr) * DP + h * 128 + sc; kv[c2 * 4 + g] = ld8(rp + C_RK); vv[c2 * 4 + g] = ld8(rp + C_RV); }
#pragma unroll
    for (int c2 = 0; c2 < 2; ++c2)
#pragma unroll
      for (int g = 0; g < 4; ++g) { const int row = 32 * g + sr;
        *(LAS bf16x8*)(lds + c2 * 65536 + (row >> 6) * 16384 + KSWZ(row & 63, sc * 2)) = kv[c2 * 4 + g];
        *(LAS bf16x8*)(lds + c2 * 65536 + 32768 + (row >> 6) * 16384 + v_st(row & 63, sc)) = vv[c2 * 4 + g]; } }
  bf16x8 qr[8];
  const bf16_t* Qw = proj + (size_t)(rowbase + rg * 32 + r32) * DP + C_RQ + h * 128 + hi * 8;
#pragma unroll
  for (int d0 = 0; d0 < 8; ++d0) qr[d0] = ld8(Qw + d0 * 16);
  __syncthreads();
  const int m = rg * 32 + r32;
  LAS char* myreg = lds + ch * 65536;
  const int vb = (int)(uintptr_t)myreg + v_rd_base(lane);
  f32x16 o[4] = {}; f32x16 p0, p1; bf16x8 pa0, pa1, pa2, pa3;
#pragma unroll
  for (int kt = 0; kt < 2; ++kt) {
    qkt<8>(p0, p1, myreg + kt * 16384, qr, r32, hi, 0);
    int mm = m - 4 * hi; asm volatile("" : "+v"(mm));
#pragma unroll
    for (int r = 0; r < 16; ++r) { const int s0 = 64 * kt + (r & 3) + 8 * (r >> 2); p0[r] *= decay_w(s0 - mm, lgf2, lgb2); p1[r] *= decay_w(s0 + 32 - mm, lgf2, lgb2); }
    pack_p(p0, p1, pa0, pa1, pa2, pa3);
    pv_d0(o, vb + 32768 + kt * 16384, pa0, pa1, pa2, pa3);
  }
  __syncthreads();
  { bf16x8 sv[16];
#pragma unroll
    for (int c2 = 0; c2 < 2; ++c2)
#pragma unroll
      for (int d = 0; d < 2; ++d)
#pragma unroll
        for (int g = 0; g < 4; ++g) sv[(c2 * 2 + d) * 4 + g] = ld8((c2 ? spB : spA) + (size_t)d * dstride + (size_t)(32 * g + sr) * 128 + sc);
#pragma unroll
    for (int c2 = 0; c2 < 2; ++c2)
#pragma unroll
      for (int d = 0; d < 2; ++d)
#pragma unroll
        for (int g = 0; g < 4; ++g) { const int row = 32 * g + sr;
          *(LAS bf16x8*)(lds + c2 * 65536 + d * 32768 + (row >> 6) * 16384 + v_st(row & 63, sc)) = sv[(c2 * 2 + d) * 4 + g]; } }
  const float xf = __builtin_amdgcn_exp2f(lgf2 * (float)(m + 1)), xb = __builtin_amdgcn_exp2f(lgb2 * (float)(128 - m));
  __syncthreads();
#pragma unroll
  for (int d = 0; d < 2; ++d) { const float xs = d ? xb : xf;
#pragma unroll
    for (int sub = 0; sub < 2; ++sub) {
      const bf16x8 a0 = scale8(qr[4 * sub + 0], xs), a1 = scale8(qr[4 * sub + 1], xs), a2 = scale8(qr[4 * sub + 2], xs), a3 = scale8(qr[4 * sub + 3], xs);
      pv_d0(o, vb + d * 32768 + sub * 16384, a0, a1, a2, a3); } }
#pragma unroll
  for (int r = 0; r < 16; ++r) {
    float s = (o[0][r] + o[1][r]) + (o[2][r] + o[3][r]);
    s += __shfl_xor(s, 1); s += __shfl_xor(s, 2); s += __shfl_xor(s, 4); s += __shfl_xor(s, 8); s += __shfl_xor(s, 16);
    const float mu = s * (1.f / 128.f);
    float q = 0.f;
#pragma unroll
    for (int d0 = 0; d0 < 4; ++d0) { const float dd = o[d0][r] - mu; o[d0][r] = dd; q += dd * dd; }
    q += __shfl_xor(q, 1); q += __shfl_xor(q, 2); q += __shfl_xor(q, 4); q += __shfl_xor(q, 8); q += __shfl_xor(q, 16);
    const float rr = rsqrtf(q * (1.f / 128.f) + EPS);
    const size_t grow = (size_t)(rowbase + rg * 32 + crow(r, hi));
    const bf16_t* gp = proj + grow * DP + C_RG + h * 128 + r32; bf16_t* op = concat + grow * DM + h * 128 + r32;
#pragma unroll
    for (int d0 = 0; d0 < 4; ++d0) { const float gv = bf2f(gp[32 * d0]); op[32 * d0] = f2bf(o[d0][r] * rr * gn[32 * d0 + r32] * (gv * __builtin_amdgcn_rcpf(1.f + __builtin_amdgcn_exp2f(-1.4426950408889634f * gv)))); }
  }
  __syncthreads();
}

}


__device__ __forceinline__ float log2_sigmoid(float x) { return -log1pf(__expf(-x)) * 1.4426950408889634f; }
__device__ __forceinline__ bf16_t* cs_ptr(const Params& p, int b, int h, int dir, int j) { return (bf16_t*)(p.ws + WS_CS) + ((size_t)((b * NH + h) * 2 + dir) * 66 + j) * 16384; }
__device__ __forceinline__ void qkrope_phase(const Params& p, Ctx& F, int l) {
    const int lane = lane_id();
    float gq[8], gk[8], fr[8];
#pragma unroll
    for (int i = 0; i < 8; ++i) { gq[i] = p.in[I_QNG][l * 64 + 8 * (lane & 7) + i] * 0.18033688011112042f;
        gk[i] = p.in[I_KNG][l * 64 + 8 * (lane & 7) + i];
        fr[i] = exp2f(-(float)(8 * (lane & 1) + i) * (13.287712379549449f / 16.f)) * 0.15915494309189535f; }
    const bool lowhalf = (lane & 4) == 0;
    for (int m = F.gw; m < NR; m += F.NGW) {
        bf16_t* row = (bf16_t*)(p.ws + WS_PROJ) + (size_t)m * DP;
        v4u* qp = (v4u*)(row + C_DQ) + lane; const v4u* kp = (const v4u*)(row + C_DK) + lane;
        const v4u qv = *qp, kv = *kp, vv = *((const v4u*)(row + C_DV) + lane);
        float q[8], k[8];
#pragma unroll
        for (int i = 0; i < 4; ++i) { q[2 * i] = __uint_as_float(qv[i] << 16); q[2 * i + 1] = __uint_as_float(qv[i] & 0xffff0000u); k[2 * i] = __uint_as_float(kv[i] << 16); k[2 * i + 1] = __uint_as_float(kv[i] & 0xffff0000u); }
        float sq = 0.f, sk = 0.f;
#pragma unroll
        for (int i = 0; i < 8; ++i) { sq += q[i] * q[i]; sk += k[i] * k[i]; }
        sq += __shfl_xor(sq, 1); sq += __shfl_xor(sq, 2); sq += __shfl_xor(sq, 4);
        sk += __shfl_xor(sk, 1); sk += __shfl_xor(sk, 2); sk += __shfl_xor(sk, 4);
        const float rq = rsqrtf(sq * (1.f / 64.f) + EPS), rk = rsqrtf(sk * (1.f / 64.f) + EPS);
#pragma unroll
        for (int i = 0; i < 8; ++i) { q[i] *= rq * gq[i]; k[i] *= rk * gk[i]; }
        if (m < NL) {
            const int t = m % T; const float pos = (float)((lane & 2) ? (t % 64) : (t / 64));
#pragma unroll
            for (int i = 0; i < 8; ++i) {
                const float rev = pos * fr[i]; const float cs = __builtin_amdgcn_cosf(rev), sn = __builtin_amdgcn_sinf(rev);
                const float oq = __shfl_xor(q[i], 4), ok = __shfl_xor(k[i], 4);
                q[i] = lowhalf ? q[i] * cs - oq * sn : q[i] * cs + oq * sn;
                k[i] = lowhalf ? k[i] * cs - ok * sn : k[i] * cs + ok * sn;
            }
        }
        v4u qo, ko;
#pragma unroll
        for (int i = 0; i < 4; ++i) { qo[i] = pk2(q[2 * i], q[2 * i + 1]); ko[i] = pk2(k[2 * i], k[2 * i + 1]); }
        *qp = qo;
        { const int bb = m < NL ? m / T : (m - NL) / TC, kidx = m < NL ? TC + (m % T) : (m - NL) % TC, tile = kidx >> 6, r = kidx & 63, hh = lane >> 4, ci = lane & 15;
          const size_t blk = ((size_t)(bb * NH + hh) * 132 + tile) * 16384;
          *(v4u*)(p.ws + WS_KT + blk + KSWZ(r, 16 * ci)) = ko;
#if FAST_ATT
          *(v4u*)(p.ws + WS_VT + blk + att::v_st_lin(r, 8 * ci)) = vv; }
#else
          *(v4u*)(p.ws + WS_VT + blk + att::v_st(r, 8 * ci)) = vv; }
#endif
    }
}
__device__ __forceinline__ void scan_phase(const Params& p, Ctx& F, int l) {
    const int lane_ = lane_id(), tid_ = F.wave * 64 + lane_;
    unsigned* cs = (unsigned*)(p.ws + WS_CS);
    for (int i = blockIdx.x * (NWAVES * 64) + tid_; i < 16 * 8192; i += F.G * NWAVES * 64) {
        const int combo = i >> 13, e2 = i & 8191, dir = combo & 1, h = (combo >> 1) & 3;
        const float lg2 = log2_sigmoid(dir ? p.in[I_DECB][l * NH + h] : p.in[I_DECF][l * NH + h]);
        const float decay = exp2f(lg2 * 128.f);
        unsigned* base = cs + (size_t)combo * 66 * 8192 + e2;
        float s0 = 0.f, s1 = 0.f;
#pragma unroll 1
        for (int jj = 0; jj < 66; jj += 22) {
            unsigned tv[22];
#pragma unroll
            for (int k = 0; k < 22; ++k) { const int q = jj + k, idx = dir ? (q < 2 ? 1 - q : 67 - q) : q; tv[k] = base[(size_t)idx * 8192]; }
#pragma unroll
            for (int k = 0; k < 22; ++k) { const int q = jj + k, idx = dir ? (q < 2 ? 1 - q : 67 - q) : q;
                base[(size_t)idx * 8192] = pk2(s0, s1);
                s0 = decay * s0 + __uint_as_float(tv[k] << 16); s1 = decay * s1 + __uint_as_float(tv[k] & 0xffff0000u); }
        }
    }
}

#define IN(k) (lo <= (k) && (k) < hi)
#define SEAM(k) do { if (IN(k) && IN((k) + 1)) xcd_barrier(bar, F.wave == 0 && lane_id() == 0); } while (0)
#ifndef REP_ATT
#define REP_ATT 1
#endif
#ifndef REP_RET
#define REP_RET 1
#endif
#ifndef REP_B
#define REP_B 1
#endif
#ifndef REP_H0
#define REP_H0 1
#endif
#ifndef REP_H1
#define REP_H1 1
#endif
#ifndef REP_I1
#define REP_I1 1
#endif
#ifndef REP_P0
#define REP_P0 1
#endif
#ifndef REP_CS
#define REP_CS 1
#endif
#ifndef REP_A
#define REP_A 1
#endif
#ifndef REP_I0
#define REP_I0 1
#endif
#ifndef REP_F0
#define REP_F0 1
#endif
#ifndef REP_G2
#define REP_G2 1
#endif
#ifndef REP_BAR
#define REP_BAR 0
#endif
template <int l>
__device__ __forceinline__ void layer_phases(const Params& p, Ctx& F, const XcdBarrier& bar, const int lo, const int hi) {
    constexpr int base = 1 + 9 * l;

        if (IN(base + 0)) { for (int rep_ = 0; rep_ < REP_A; ++rep_) norm_phase(p, F, l, 0, NR); for (int rep_ = 0; rep_ < REP_BAR; ++rep_) xcd_barrier(bar, F.wave == 0 && lane_id() == 0); SEAM(base + 0); }
        if (IN(base + 1)) {
            pg8::Gemm g{(const bf16_t*)(p.ws + WS_HBUF), (const bf16_t*)(p.ws + W_WIN) + (size_t)l * DP * DM, NR, DP, DM, DM};
            pg8::Order S; S.init(NR / 256, DP / 256, F.G, (int)blockIdx.x);
            pg8::EpiProj E{(bf16_t*)(p.ws + WS_PROJ)};
            { pg8::gemm_phase<pg8::EpiProj, pg8::Order, true, true>(F.lds + RING_OFF, g, S, E, F.wave); if (REP_B > 1) { pg8::gemm_phase<pg8::EpiProj, pg8::Order, true, true>(F.lds + RING_OFF, g, S, E, F.wave); } }
            SEAM(base + 1);
        }
        if (IN(base + 2)) {
            qkrope_phase(p, F, l);
            for (int rep_ = 0; rep_ < REP_CS; ++rep_)
            for (int u = blockIdx.x; u < 8 * 66; u += F.G) {
                const int bh = u & 7, j = u >> 3, b = bh >> 2, h = bh & 3;
                const int rowbase = j < 2 ? NL + b * TC + 128 * j : b * T + 128 * (j - 2);
                att::chunk_state_unit(F.wave, (const bf16_t*)(p.ws + WS_PROJ), cs_ptr(p, b, h, 0, j), cs_ptr(p, b, h, 1, j), rowbase, h,
                                      log2_sigmoid(p.in[I_DECF][l * NH + h]), log2_sigmoid(p.in[I_DECB][l * NH + h]), (LAS char*)(F.lds + RING_OFF));
            }
            SEAM(base + 2);
        }
        if (IN(base + 3)) { scan_phase(p, F, l); SEAM(base + 3); }
        if (IN(base + 4)) {
#if FAST_RET
            for (int rep_ = 0; rep_ < REP_RET; ++rep_)
            for (int u = blockIdx.x; u < (l == 0 ? 8 * 33 : 8 * 32); u += F.G) {
                const int bh = u & 7, jp = (u >> 3) + (l == 0 ? 0 : 1), b = bh >> 2, h = bh & 3;
                const int rowA = jp == 0 ? NL + b * TC : b * T + 128 * (2 * jp - 2);
                att::ret_out_unit(F.wave, (const bf16_t*)(p.ws + WS_PROJ), (bf16_t*)(p.ws + WS_CONCAT), cs_ptr(p, b, h, 0, 2 * jp), cs_ptr(p, b, h, 0, 2 * jp + 1), (size_t)66 * 16384,
                                  rowA, rowA + 128, h, log2_sigmoid(p.in[I_DECF][l * NH + h]), log2_sigmoid(p.in[I_DECB][l * NH + h]), p.in[I_GNG] + l * 512 + h * 128, (LAS char*)(F.lds + RING_OFF));
            }
#endif
#if FAST_ATT
            { const int lane_ = lane_id();
              const float s1 = wave_sum(p.in[I_LQ1][l * 64 + lane_] * p.in[I_LK1][l * 64 + lane_]), s2 = wave_sum(p.in[I_LQ2][l * 64 + lane_] * p.in[I_LK2][l * 64 + lane_]);
              const float li = lam_init_of(l), lam = __expf(s1) - __expf(s2) + li;
#if ATT_V3
              constexpr int nunits = 256 + (l == 0 ? 8 : 0);
              for (int rep_ = 0; rep_ < REP_ATT; ++rep_)
              for (int u = blockIdx.x; u < nunits; u += F.G) {
                  int b, h, qrow0, NT;
                  if (u < 256) { const int bh = u & 7, qb = u >> 3; b = bh >> 2; h = bh & 3; qrow0 = b * T + qb * 256; NT = (TC + T) / 64; }
                  else { const int bh = u - 256; b = bh >> 2; h = bh & 3; qrow0 = NL + b * TC; NT = TC / 64; }
                  att::ATT_UNIT(F.wave, (const bf16_t*)(p.ws + WS_PROJ), (const char*)(p.ws + WS_KT) + (size_t)(b * NH + h) * 132 * 16384, (const char*)(p.ws + WS_VT) + (size_t)(b * NH + h) * 132 * 16384, (bf16_t*)(p.ws + WS_CONCAT), qrow0, NT, h, (LAS char*)(F.lds + RING_OFF), lam, 1.f - li, p.in[I_SUBLN] + l * 128);
              }
#else
              constexpr int nunits = 512 + (l == 0 ? 16 : 0);
              for (int rep_ = 0; rep_ < REP_ATT; ++rep_)
              for (int u = blockIdx.x; u < nunits; u += F.G) {
                  int b, h, qrow0, NT;
                  if (u < 512) { const int bh = u & 7, qb = u >> 3; b = bh >> 2; h = bh & 3; qrow0 = b * T + qb * 128; NT = (TC + T) / 64; }
                  else { const int v = u - 512, bh = v & 7, blk = v >> 3; b = bh >> 2; h = bh & 3; qrow0 = NL + b * TC + blk * 128; NT = TC / 64; }
                  att::attn_unit(F.wave, (const bf16_t*)(p.ws + WS_PROJ), (const char*)(p.ws + WS_KT) + (size_t)(b * NH + h) * 132 * 16384, (const char*)(p.ws + WS_VT) + (size_t)(b * NH + h) * 132 * 16384, (bf16_t*)(p.ws + WS_CONCAT), qrow0, NT, h, (LAS char*)(F.lds + RING_OFF), lam, 1.f - li, p.in[I_SUBLN] + l * 128);
              }
#endif
            }
#endif
            SEAM(base + 4);
        }
        if (IN(base + 5)) {
            pg8::Gemm g{(const bf16_t*)(p.ws + WS_CONCAT), (const bf16_t*)(p.ws + W_WOUT) + (size_t)l * DM * DM, NR, DM, DM, DM};
            pg8::Order S; S.init(NL / 256, DM / 256, F.G, (int)blockIdx.x);
            pg8::EpiResid E{l == 0 ? p.in[I_X] : p.out, l == 0 ? p.in[I_CTX] : (const float*)(p.ws + WS_XRC), p.out, (float*)(p.ws + WS_XRC), modv(p, l, 0, 2), modv(p, l, 2, 2)};
            if (REP_F0 > 1 && l == 0) { pg8::gemm_phase<pg8::EpiResid, pg8::Order, true, true>(F.lds + RING_OFF, g, S, E, F.wave); }
            pg8::gemm_phase<pg8::EpiResid, pg8::Order, true, true>(F.lds + RING_OFF, g, S, E, F.wave);
            if constexpr (l == 0) {
                pg8::Gemm g2{(const bf16_t*)(p.ws + WS_CONCAT), (const bf16_t*)(p.ws + W_WOUT), NR, DM, 256, DM};
                pg8::SplitOrder S2; S2.init(NL / 256, 2, DM / 256, DM / 256, F.G, (int)blockIdx.x);
                pg8::EpiPartial E2{(float*)(p.ws + WS_PART), NL / 256, NC};
                pg8::gemm_phase<pg8::EpiPartial, pg8::SplitOrder, true, true>(F.lds + RING_OFF, g2, S2, E2, F.wave);
            }
            SEAM(base + 5);
        }
        if (IN(base + 6)) { if constexpr (l == 0) norm_phase(p, F, 0, 1, NR); else router_phase(p, F); SEAM(base + 6); }
        if constexpr (l == 0) {
            if (IN(8)) {
                pg8::Gemm g{(const bf16_t*)(p.ws + WS_HBUF), (const bf16_t*)(p.ws + W_FGU), NR, 2 * DFF, DM, DM};
                pg8::Order S; S.init(NR / 256, 2 * DFF / 256, F.G, (int)blockIdx.x);
                pg8::EpiSwiglu E{(bf16_t*)(p.ws + WS_ACT)};
                { pg8::gemm_phase<pg8::EpiSwiglu, pg8::Order, true, true>(F.lds + RING_OFF, g, S, E, F.wave); if (REP_H0 > 1) { pg8::gemm_phase<pg8::EpiSwiglu, pg8::Order, true, true>(F.lds + RING_OFF, g, S, E, F.wave); } }
                SEAM(8);
            }
            if (IN(9)) {
                pg8::Gemm g{(const bf16_t*)(p.ws + WS_ACT), (const bf16_t*)(p.ws + W_FD), NR, DM, DFF, DFF};
                pg8::Order S; S.init(NL / 256, DM / 256, F.G, (int)blockIdx.x);
                pg8::EpiResid E{p.out, (const float*)(p.ws + WS_XRC), p.out, (float*)(p.ws + WS_XRC), modv(p, 0, 0, 5), modv(p, 0, 2, 5)};
                if (REP_I0 > 1) { pg8::EpiResid Ed{p.out, (const float*)(p.ws + WS_XRC), (float*)(p.ws + WS_H2S), (float*)(p.ws + WS_H2S) + (size_t)NL * DM, modv(p, 0, 0, 5), modv(p, 0, 2, 5)}; pg8::gemm_phase<pg8::EpiResid, pg8::Order, true, true>(F.lds + RING_OFF, g, S, Ed, F.wave); }
                pg8::gemm_phase<pg8::EpiResid, pg8::Order, true, true>(F.lds + RING_OFF, g, S, E, F.wave);
                {
                    pg8::Gemm g2{(const bf16_t*)(p.ws + WS_ACT), (const bf16_t*)(p.ws + W_FD), NR, DM, 256, DFF};
                    pg8::SplitOrder S2; S2.init(NL / 256, 2, DM / 256, DFF / 256, F.G, (int)blockIdx.x);
                    pg8::EpiPartial E2{(float*)(p.ws + WS_PART), NL / 256, NC};
                    pg8::gemm_phase<pg8::EpiPartial, pg8::SplitOrder, true, true>(F.lds + RING_OFF, g2, S2, E2, F.wave);
                }
                SEAM(9);
            }
        } else {
            if (IN(17)) { for (int rep_ = 0; rep_ < REP_G2; ++rep_) gather_phase(p, F); SEAM(17); }
            if (IN(18)) {
                moe_table(F);
                pg8::Gemm g{(const bf16_t*)(p.ws + WS_H2S), (const bf16_t*)(p.ws + W_MGU), MP_MAX, 2 * DFF, DM / 2, DM / 2};
                pg8::Order S; moe_order(F, S, 2 * DFF / 256, (long)2 * DFF * DM);
                pg8::EpiSwiglu8 E{(unsigned char*)(p.ws + WS_ACTS)};
                { pg8::gemm_phase<pg8::EpiSwiglu8, pg8::Order, true, true, true>(F.lds + RING_OFF, g, S, E, F.wave); if (REP_H1 > 1) { pg8::gemm_phase<pg8::EpiSwiglu8, pg8::Order, true, true, true>(F.lds + RING_OFF, g, S, E, F.wave); } }
                SEAM(18);
            }
            if (IN(19)) {
                moe_table(F);
                pg8::Gemm g{(const bf16_t*)(p.ws + WS_ACTS), (const bf16_t*)(p.ws + W_MD), MP_MAX, DM, DFF / 2, DFF / 2};
                pg8::Order S; moe_order(F, S, DM / 256, (long)DM * DFF);
                pg8::EpiMoeDown E{(bf16_t*)(p.ws + WS_YBUF), (const float*)(p.ws + WS_ROUTE) + 6 * NL + MP_MAX, 1.f / (W8_SCALE * A8_SCALE)};
                { pg8::gemm_phase<pg8::EpiMoeDown, pg8::Order, true, true, true>(F.lds + RING_OFF, g, S, E, F.wave); if (REP_I1 > 1) { pg8::gemm_phase<pg8::EpiMoeDown, pg8::Order, true, true, true>(F.lds + RING_OFF, g, S, E, F.wave); } }
                SEAM(19);
            }
            if (IN(20)) { combine_phase(p, F); }
        }
}
struct MArgs { Params p; int ph_lo, ph_hi, li, pad; };
constexpr int N_PHASES = 21;
__global__ void __launch_bounds__(NWAVES * 64, 2) mega(MArgs args) {
    extern __shared__ __attribute__((aligned(16))) unsigned char lds_raw[];
    const Params& p = args.p;
    Ctx F;
    F.lds = (LAS unsigned char*)lds_raw; F.MISC = (volatile LAS unsigned*)(F.lds + MISC_OFF);
    F.wave = __builtin_amdgcn_readfirstlane((int)threadIdx.x >> 6);
    const int lane_ = lane_id(), tid_ = F.wave * 64 + lane_;
    F.G = gridDim.x; F.gw = blockIdx.x * NWAVES + F.wave; F.NGW = F.G * NWAVES;
    F.ctl = (unsigned*)(p.ws + WS_CTL);
    for (int u = tid_; u < (LDS_BYTES - MISC_OFF) / 4; u += NWAVES * 64) ((LAS unsigned*)(F.lds + MISC_OFF))[u] = 0u;
    __syncthreads();
    XcdBarrier bar = xcd_barrier_post(F.ctl + CW_BAR + args.li * XCD_BAR_WORDS, F.MISC + 8, tid_ == 0);
    const int lo = args.ph_lo, hi = args.ph_hi;

    if (IN(0)) { for (int rep_ = 0; rep_ < REP_P0; ++rep_) { if (rep_) __syncthreads(); p0_prologue(p, F); } SEAM(0); }
    layer_phases<0>(p, F, bar, lo, hi);
    layer_phases<1>(p, F, bar, lo, hi);
#undef IN
#undef SEAM
}

#ifndef FAST_MASK
#define FAST_MASK 0x1u
#endif
static void launch_naive_e(const Params& p, int l, bool ret, bool att, hipStream_t stream) {
    const int nrows_mix = l == 0 ? NR : NL;
    if (ret) k_ret_naive<<<nrows_mix * NH / 4, 256, 0, stream>>>(p, l, nrows_mix);
    if (att) k_attn_naive<<<nrows_mix * NH / 4, 256, 0, stream>>>(p, l, nrows_mix);
}
static void launch_naive(const Params& p, int ph, hipStream_t stream) {
    const int l = ph >= 10 ? 1 : 0, rel = ph == 0 ? -1 : (ph - 1 - 9 * l);
    const int nrows_mix = l == 0 ? NR : NL;
    if (ph == 0) { k_mod<<<(2 * 3 * 6144 + 255) / 256, 256, 0, stream>>>(p); return; }
    switch (rel) {
    case 0: k_norm<<<NR / 4, 256, 0, stream>>>(p, l, 0, NR); break;
    case 1: k_gemm_proj<<<dim3(DP / 64, NR / 4), dim3(64, 4), 0, stream>>>(p, l); break;
    case 2: k_qkrope<<<NR / 4, 256, 0, stream>>>(p, l); break;
    case 3: break;
    case 4: launch_naive_e(p, l, true, true, stream); break;
    case 5: k_gemm_out<<<dim3(DM / 64, nrows_mix / 4), dim3(64, 4), 0, stream>>>(p, l); break;
    case 6: k_norm<<<nrows_mix / 4, 256, 0, stream>>>(p, l, 1, nrows_mix); break;
    case 7: if (l == 0) k_ffn_gu<<<dim3(DFF / 64, NR / 4), dim3(64, 4), 0, stream>>>(p); break;
    case 8: if (l == 0) k_ffn_down<<<dim3(DM / 64, NR / 4), dim3(64, 4), 0, stream>>>(p); else k_moe_gu<<<dim3(DFF / 64, 2 * NL / 4), dim3(64, 4), 0, stream>>>(p); break;
    case 9: k_moe_down<<<dim3(DM / 64, NL / 4), dim3(64, 4), 0, stream>>>(p); break;
    default: break;
    }
}
extern "C" void kernel_launch(void* const* d_in, const int* in_sizes, int n_in, void* d_out, int out_size, void* d_ws, size_t ws_size, hipStream_t stream) {
    static int grid = 0;
    if (grid == 0) {
        if (n_in != 28 || out_size != NL * DM || ws_size < WS_END) { fprintf(stderr, "kernel_launch: unexpected shapes (n_in %d out %d ws %zu need %zu)\n", n_in, out_size, ws_size, (size_t)WS_END); grid = -1; return; }
        int dev = 0, cus = 0, per_cu = 0;
        if (hipGetDevice(&dev) != hipSuccess || hipDeviceGetAttribute(&cus, hipDeviceAttributeMultiprocessorCount, dev) != hipSuccess) { grid = -1; return; }
        if (hipFuncSetAttribute((const void*)mega, hipFuncAttributeMaxDynamicSharedMemorySize, LDS_BYTES) != hipSuccess) { fprintf(stderr, "kernel_launch: hipFuncSetAttribute failed\n"); grid = -1; return; }
        if (hipOccupancyMaxActiveBlocksPerMultiprocessor(&per_cu, (const void*)mega, NWAVES * 64, LDS_BYTES) != hipSuccess || per_cu < 1) { fprintf(stderr, "kernel_launch: occupancy query says %d\n", per_cu); (void)hipGetLastError(); grid = -1; return; }
        grid = cus;
    }
    if (grid < 0) return;
    (void)hipMemsetAsync((char*)d_ws + WS_CTL, 0, CTL_ZERO_BYTES, stream);
    MArgs a{};
    for (int i = 0; i < 28; ++i) a.p.in[i] = (const float*)d_in[i];
    a.p.out = (float*)d_out; a.p.ws = (unsigned char*)d_ws;
    const unsigned mask = FAST_MASK;
    int li = 0, ph = 0;
    while (ph < N_PHASES) {
        if ((mask >> ph) & 1u) { int e = ph; bool cutE = false;
            while (e < N_PHASES && ((mask >> e) & 1u)) { const bool isE = (e == 5 || e == 14); ++e; if (isE && !(FAST_ATT && FAST_RET)) { cutE = true; break; } }
            a.ph_lo = ph; a.ph_hi = e; a.li = li++;
            hipLaunchKernelGGL(mega, dim3(grid), dim3(NWAVES * 64), LDS_BYTES, stream, a);
            if (cutE) launch_naive_e(a.p, e - 1 == 5 ? 0 : 1, !FAST_RET, !FAST_ATT, stream);
            ph = e; }
        else { launch_naive(a.p, ph, stream); ++ph; }
    }
}
```

```cpp
#include <hip/hip_runtime.h>
#include <cstdint>
#include <cstdio>
#define FAST_MASK 0x1fffffu
#define FAST_ATT 1
#define FAST_RET 1

constexpr int NB = 2, T = 8192, DM = 1024, TC = 256;
constexpr int NL = NB * T;
constexpr int NC = NB * TC;
constexpr int NR = NL + NC;
constexpr int DP = 3584, DFF = 2816, NE = 8, NH = 4;
constexpr float EPS = 1e-6f;
constexpr int C_RQ = 0, C_RK = 512, C_RV = 1024, C_RG = 1536, C_DQ = 2048, C_DK = 2560, C_DV = 3072;
constexpr int MP_MAX = 2 * NL + NE * 256;

typedef unsigned short bf16_t;
__device__ __forceinline__ float bf2f(bf16_t v) { return __uint_as_float(((unsigned)v) << 16); }
__device__ __forceinline__ bf16_t f2bf(float f) { unsigned u = __float_as_uint(f); u += 0x7fffu + ((u >> 16) & 1u); return (bf16_t)(u >> 16); }
typedef float f32x2_t __attribute__((ext_vector_type(2)));
typedef __bf16 bf16x2_t __attribute__((ext_vector_type(2)));
__device__ __forceinline__ unsigned pk2(float lo, float hi) { const f32x2_t v = {lo, hi}; const bf16x2_t b = __builtin_convertvector(v, bf16x2_t); return __builtin_bit_cast(unsigned, b); }
__device__ __forceinline__ unsigned pk4_fp8(float a, float b, float c, float d) {
    a = __builtin_amdgcn_fmed3f(a, -448.f, 448.f); b = __builtin_amdgcn_fmed3f(b, -448.f, 448.f); c = __builtin_amdgcn_fmed3f(c, -448.f, 448.f); d = __builtin_amdgcn_fmed3f(d, -448.f, 448.f);
    int r = 0; r = __builtin_amdgcn_cvt_pk_fp8_f32(a, b, r, false); r = __builtin_amdgcn_cvt_pk_fp8_f32(c, d, r, true); return (unsigned)r;
}
constexpr float W8_SCALE = 64.f, A8_SCALE = 8.f;
__device__ __forceinline__ float wave_sum(float v) {
#pragma unroll
    for (int o = 1; o < 64; o <<= 1) v += __shfl_xor(v, o);
    return v;
}
__device__ __forceinline__ int lane_id() { int l = (int)__builtin_amdgcn_mbcnt_hi(~0u, __builtin_amdgcn_mbcnt_lo(~0u, 0u)); asm volatile("" : "+v"(l)); return l; }
__device__ __forceinline__ float siluf(float v) { return v / (1.f + __expf(-v)); }

constexpr size_t MiB = 1u << 20;
constexpr size_t WS_CTL = 0, CTL_ZERO_BYTES = 1 * MiB;
constexpr size_t WS_MODV = 1 * MiB;
constexpr size_t WS_ROUTE = 2 * MiB;
constexpr size_t WS_XRC = 3 * MiB;
constexpr size_t WS_W = 6 * MiB;
constexpr size_t W_WIN = WS_W;
constexpr size_t W_WOUT = W_WIN + (size_t)2 * DP * DM * 2;
constexpr size_t W_FGU = W_WOUT + (size_t)2 * DM * DM * 2;
constexpr size_t W_FD = W_FGU + (size_t)2 * DFF * DM * 2;
constexpr size_t W_MGU = W_FD + (size_t)DM * DFF * 2;
constexpr size_t W_MD = W_MGU + (size_t)NE * 2 * DFF * DM * 2;
constexpr size_t W_END = W_MD + (size_t)NE * DM * DFF * 2;
constexpr size_t WS_HBUF = 173 * MiB;
constexpr size_t WS_PROJ = 206 * MiB;
constexpr size_t WS_CONCAT = 322 * MiB;
constexpr size_t WS_ACT = 206 * MiB;
constexpr size_t WS_ACTS = 173 * MiB;
constexpr size_t WS_H2S = 361 * MiB;
constexpr size_t WS_KT = 394 * MiB, WS_VT = WS_KT + (size_t)NB * NH * 132 * 16384;
static_assert(WS_VT + (size_t)NB * NH * 132 * 16384 <= 429 * MiB && WS_H2S + (size_t)NB * NH * 2 * 66 * 32768 <= WS_KT, "K/V tile images");
constexpr size_t WS_YBUF = WS_H2S, WS_CS = WS_H2S, WS_PART = WS_H2S;
constexpr size_t WS_END = 430 * MiB;
static_assert(W_END <= WS_HBUF && WS_ACTS + (size_t)MP_MAX * DFF * 2 <= WS_H2S && WS_H2S + (size_t)MP_MAX * DM * 2 <= WS_END && WS_ACT + (size_t)2 * NL * DFF * 2 <= WS_END, "ws map");
constexpr int CW_BAR = 4096;
constexpr int CW_CNT = 200000;

struct Params {
    const float* in[28];
    float* out;
    unsigned char* ws;
};
enum { I_X = 0, I_C, I_CTX, I_CCTX, I_ADAW, I_ADAB, I_N1G, I_N2G, I_WIN, I_DECF, I_DECB, I_GNG, I_QNG, I_KNG, I_LQ1, I_LK1, I_LQ2, I_LK2, I_SUBLN, I_WOUT,
       I_FWG, I_FWU, I_FWD, I_RW, I_RB, I_MWG, I_MWU, I_MWD };

__device__ __forceinline__ int rowtype(int m) { return m < NL ? m / T : 2; }
__device__ __forceinline__ const float* modv(const Params& p, int l, int rt, int i) { return (const float*)(p.ws + WS_MODV) + ((size_t)(l * 3 + rt) * 6 + i) * DM; }
__device__ __forceinline__ float* xr_row(const Params& p, int m) { return m < NL ? p.out + (size_t)m * DM : (float*)(p.ws + WS_XRC) + (size_t)(m - NL) * DM; }
__device__ __forceinline__ float lam_init_of(int l) { return l == 0 ? 0.2f : (0.8f - 0.6f * 0.74081822068171788f); }

#ifndef ATT_UNIT
#define ATT_UNIT attn_unit3q
#endif
#ifndef FAST_ATT
#define FAST_ATT 0
#endif
#ifndef FAST_RET
#define FAST_RET 0
#endif
#ifndef ATT_V3
#define ATT_V3 1
#endif
__global__ void k_mod(Params p) {
    const int idx = blockIdx.x * blockDim.x + threadIdx.x;
    if (idx >= 2 * 3 * 6144) return;
    const int n = idx % 6144, rt = (idx / 6144) % 3, l = idx / (6144 * 3);
    const float* cv = rt < 2 ? p.in[I_C] + rt * DM : p.in[I_CCTX];
    const float* W = p.in[I_ADAW] + (size_t)l * DM * 6144;
    float acc = 0.f;
    for (int k = 0; k < DM; ++k) acc += siluf(cv[k]) * W[(size_t)k * 6144 + n];
    ((float*)(p.ws + WS_MODV))[(size_t)(l * 3 + rt) * 6144 + n] = acc + p.in[I_ADAB][l * 6144 + n];
}

__global__ void k_norm(Params p, int l, int which, int nrows) {
    const int m = blockIdx.x * (blockDim.x / 64) + (threadIdx.x >> 6), lane = threadIdx.x & 63;
    if (m >= nrows) return;
    const float* xrow;
    if (l == 0 && which == 0) xrow = m < NL ? p.in[I_X] + (size_t)m * DM : p.in[I_CTX] + (size_t)(m - NL) * DM;
    else xrow = xr_row(p, m);
    const int rt = rowtype(m);
    const float* g = p.in[which ? I_N2G : I_N1G] + l * DM;
    const float* sh = modv(p, l, rt, which ? 3 : 0);
    const float* sc = modv(p, l, rt, which ? 4 : 1);
    float v[16]; float ss = 0.f;
#pragma unroll
    for (int j = 0; j < 4; ++j) { const float4 t = *(const float4*)(xrow + 256 * j + 4 * lane); v[4 * j] = t.x; v[4 * j + 1] = t.y; v[4 * j + 2] = t.z; v[4 * j + 3] = t.w; ss += t.x * t.x + t.y * t.y + t.z * t.z + t.w * t.w; }
    const float r = rsqrtf(wave_sum(ss) * (1.f / DM) + EPS);
    bf16_t* hb = (bf16_t*)(p.ws + WS_HBUF) + (size_t)m * DM;
#pragma unroll
    for (int j = 0; j < 4; ++j)
#pragma unroll
        for (int q = 0; q < 4; ++q) { const int col = 256 * j + 4 * lane + q; const float y = v[4 * j + q] * r * g[col]; v[4 * j + q] = y * (1.f + sc[col]) + sh[col]; hb[col] = f2bf(v[4 * j + q]); }
    if (l == 1 && which == 1) {
        const float* rw = p.in[I_RW]; float lg[8];
#pragma unroll
        for (int e = 0; e < 8; ++e) { float a = 0.f;
#pragma unroll
            for (int j = 0; j < 4; ++j)
#pragma unroll
                for (int q = 0; q < 4; ++q) a += v[4 * j + q] * rw[(size_t)(256 * j + 4 * lane + q) * 8 + e];
            lg[e] = wave_sum(a) + p.in[I_RB][e]; }
        int i1 = 0; float v1 = lg[0];
#pragma unroll
        for (int e = 1; e < 8; ++e) if (lg[e] > v1) { v1 = lg[e]; i1 = e; }
        int i2 = -1; float v2 = -3.4e38f;
#pragma unroll
        for (int e = 0; e < 8; ++e) if (e != i1 && lg[e] > v2) { v2 = lg[e]; i2 = e; }
        const float w1 = 1.f / (1.f + __expf(v2 - v1));
        if (lane == 0) { int* te = (int*)(p.ws + WS_ROUTE); float* tw = (float*)(p.ws + WS_ROUTE) + 2 * NL; te[2 * m] = i1; te[2 * m + 1] = i2; tw[2 * m] = w1; tw[2 * m + 1] = 1.f - w1; }
    }
}

__global__ void k_gemm_proj(Params p, int l) {
    const int n = blockIdx.x * 64 + threadIdx.x, m = blockIdx.y * 4 + threadIdx.y;
    const bf16_t* a = (const bf16_t*)(p.ws + WS_HBUF) + (size_t)m * DM;
    const float* W = p.in[I_WIN] + (size_t)l * DM * DP + n;
    float acc = 0.f;
#pragma unroll 8
    for (int k = 0; k < DM; ++k) acc += bf2f(a[k]) * W[(size_t)k * DP];
    if (n >= C_RK && n < C_RV) acc *= 0.08838834764831845f;
    ((bf16_t*)(p.ws + WS_PROJ))[(size_t)m * DP + n] = f2bf(acc);
}

__global__ void k_qkrope(Params p, int l) {
    const int m = blockIdx.x * (blockDim.x / 64) + (threadIdx.x >> 6), lane = threadIdx.x & 63;
    if (m >= NR) return;
    bf16_t* row = (bf16_t*)(p.ws + WS_PROJ) + (size_t)m * DP;
    const bool lat = m < NL; const int t = m % T;
    const int j = lane & 31; const float pos = (float)((j < 16) ? (t / 64) : (t % 64));
    const float inv_freq = exp2f(-(float)(j & 15) * (13.287712379549449f / 16.f));
    const float ang = pos * inv_freq; const float cs = __cosf(ang), sn = __sinf(ang);
    for (int part = 0; part < 2; ++part) {
        const float* g = p.in[part ? I_KNG : I_QNG] + l * 64;
        for (int hc = 0; hc < 8; ++hc) {
            bf16_t* q = row + (part ? C_DK : C_DQ) + hc * 64;
            const float v = bf2f(q[lane]);
            const float r = rsqrtf(wave_sum(v * v) * (1.f / 64.f) + EPS);
            float y = v * r * g[lane];
            if (lat) { const float o = __shfl_xor(y, 32); y = lane < 32 ? y * cs - o * sn : y * cs + o * sn; }
            if (part == 0) y *= 0.18033688011112042f;
            q[lane] = f2bf(y);
        }
    }
}

__global__ void k_ret_naive(Params p, int l, int nrows) {
    const int w = blockIdx.x * (blockDim.x / 64) + (threadIdx.x >> 6), lane = threadIdx.x & 63;
    if (w >= nrows * NH) return;
    const int m = w / NH, h = w % NH;
    const bf16_t* proj = (const bf16_t*)(p.ws + WS_PROJ);
    const float df = p.in[I_DECF][l * NH + h], db = p.in[I_DECB][l * NH + h];
    const float lgf = -log1pf(__expf(-df)), lgb = -log1pf(__expf(-db));
    const bf16_t* qrow = proj + (size_t)m * DP + C_RQ + h * 128 + 2 * lane;
    const float q0 = bf2f(qrow[0]), q1 = bf2f(qrow[1]);
    float o0 = 0.f, o1 = 0.f;
    if (m < NL) {
        const int b = m / T, t = m % T;
        for (int s = 0; s < T; ++s) {
            const bf16_t* kr = proj + (size_t)(b * T + s) * DP + h * 128 + 2 * lane;
            const float dot = wave_sum(q0 * bf2f(kr[C_RK]) + q1 * bf2f(kr[C_RK + 1]));
            const float wgt = s < t ? __expf(lgf * (float)(t - s)) : (s == t ? 2.f : __expf(lgb * (float)(s - t)));
            o0 += wgt * dot * bf2f(kr[C_RV]); o1 += wgt * dot * bf2f(kr[C_RV + 1]);
        }
        for (int i = 0; i < TC; ++i) {
            const bf16_t* kr = proj + (size_t)(NL + b * TC + i) * DP + h * 128 + 2 * lane;
            const float dot = wave_sum(q0 * bf2f(kr[C_RK]) + q1 * bf2f(kr[C_RK + 1]));
            const float wgt = __expf(lgf * (float)(t + TC - i)) + __expf(lgb * (float)(T - t + i));
            o0 += wgt * dot * bf2f(kr[C_RV]); o1 += wgt * dot * bf2f(kr[C_RV + 1]);
        }
    } else {
        const int b = (m - NL) / TC, t = (m - NL) % TC;
        for (int s = 0; s < TC; ++s) {
            const bf16_t* kr = proj + (size_t)(NL + b * TC + s) * DP + h * 128 + 2 * lane;
            const float dot = wave_sum(q0 * bf2f(kr[C_RK]) + q1 * bf2f(kr[C_RK + 1]));
            const float wgt = s < t ? __expf(lgf * (float)(t - s)) : (s == t ? 2.f : __expf(lgb * (float)(s - t)));
            o0 += wgt * dot * bf2f(kr[C_RV]); o1 += wgt * dot * bf2f(kr[C_RV + 1]);
        }
    }
    const float mu = wave_sum(o0 + o1) * (1.f / 128.f);
    const float d0 = o0 - mu, d1 = o1 - mu;
    const float r = rsqrtf(wave_sum(d0 * d0 + d1 * d1) * (1.f / 128.f) + EPS);
    const float* gn = p.in[I_GNG] + l * 512 + h * 128 + 2 * lane;
    const bf16_t* gr = proj + (size_t)m * DP + C_RG + h * 128 + 2 * lane;
    bf16_t* cc = (bf16_t*)(p.ws + WS_CONCAT) + (size_t)m * DM + h * 128 + 2 * lane;
    cc[0] = f2bf(siluf(bf2f(gr[0])) * d0 * r * gn[0]);
    cc[1] = f2bf(siluf(bf2f(gr[1])) * d1 * r * gn[1]);
}

__global__ void k_attn_naive(Params p, int l, int nrows) {
    const int w = blockIdx.x * (blockDim.x / 64) + (threadIdx.x >> 6), lane = threadIdx.x & 63;
    if (w >= nrows * NH) return;
    const int m = w / NH, h = w % NH;
    const bf16_t* proj = (const bf16_t*)(p.ws + WS_PROJ);
    const bool lat = m < NL; const int b = lat ? m / T : (m - NL) / TC;
    float O[2][2];
    for (int c = 0; c < 2; ++c) {
        const float q = bf2f(proj[(size_t)m * DP + C_DQ + h * 128 + c * 64 + lane]);
        float mx = -1e30f, ls = 0.f, o0 = 0.f, o1 = 0.f;
        const int nk = lat ? TC + T : TC;
        for (int s = 0; s < nk; ++s) {
            const int mk = s < TC ? NL + b * TC + s : b * T + (s - TC);
            const bf16_t* kr = proj + (size_t)mk * DP + h * 128;
            const float sc = wave_sum(q * bf2f(kr[C_DK + c * 64 + lane]));
            const float mn = fmaxf(mx, sc), al = exp2f(mx - mn), pp = exp2f(sc - mn);
            ls = ls * al + pp; o0 = o0 * al + pp * bf2f(kr[C_DV + 2 * lane]); o1 = o1 * al + pp * bf2f(kr[C_DV + 2 * lane + 1]); mx = mn;
        }
        O[c][0] = o0 / ls; O[c][1] = o1 / ls;
    }
    float s1 = 0.f, s2 = 0.f;
    { const float a = p.in[I_LQ1][l * 64 + lane] * p.in[I_LK1][l * 64 + lane], bq = p.in[I_LQ2][l * 64 + lane] * p.in[I_LK2][l * 64 + lane]; s1 = wave_sum(a); s2 = wave_sum(bq); }
    const float li = lam_init_of(l), lam = __expf(s1) - __expf(s2) + li;
    const float d0 = O[0][0] - lam * O[1][0], d1 = O[0][1] - lam * O[1][1];
    const float r = rsqrtf(wave_sum(d0 * d0 + d1 * d1) * (1.f / 128.f) + EPS);
    const float* sg = p.in[I_SUBLN] + l * 128 + 2 * lane;
    bf16_t* cc = (bf16_t*)(p.ws + WS_CONCAT) + (size_t)m * DM + 512 + h * 128 + 2 * lane;
    cc[0] = f2bf(d0 * r * sg[0] * (1.f - li)); cc[1] = f2bf(d1 * r * sg[1] * (1.f - li));
}

__global__ void k_gemm_out(Params p, int l) {
    const int n = blockIdx.x * 64 + threadIdx.x, m = blockIdx.y * 4 + threadIdx.y;
    const bf16_t* a = (const bf16_t*)(p.ws + WS_CONCAT) + (size_t)m * DM;
    const float* W = p.in[I_WOUT] + (size_t)l * DM * DM + n;
    float acc = 0.f;
#pragma unroll 8
    for (int k = 0; k < DM; ++k) acc += bf2f(a[k]) * W[(size_t)k * DM];
    const float xin = l == 0 ? (m < NL ? p.in[I_X][(size_t)m * DM + n] : p.in[I_CTX][(size_t)(m - NL) * DM + n]) : xr_row(p, m)[n];
    xr_row(p, m)[n] = xin + modv(p, l, rowtype(m), 2)[n] * acc;
}

__global__ void k_ffn_gu(Params p) {
    const int j = blockIdx.x * 64 + threadIdx.x, m = blockIdx.y * 4 + threadIdx.y;
    const bf16_t* a = (const bf16_t*)(p.ws + WS_HBUF) + (size_t)m * DM;
    const float* Wg = p.in[I_FWG] + j; const float* Wu = p.in[I_FWU] + j;
    float ag = 0.f, au = 0.f;
#pragma unroll 8
    for (int k = 0; k < DM; ++k) { const float x = bf2f(a[k]); ag += x * Wg[(size_t)k * DFF]; au += x * Wu[(size_t)k * DFF]; }
    ((bf16_t*)(p.ws + WS_ACT))[(size_t)m * DFF + j] = f2bf(siluf(ag) * au);
}
__global__ void k_ffn_down(Params p) {
    const int n = blockIdx.x * 64 + threadIdx.x, m = blockIdx.y * 4 + threadIdx.y;
    const bf16_t* a = (const bf16_t*)(p.ws + WS_ACT) + (size_t)m * DFF;
    const float* W = p.in[I_FWD] + n;
    float acc = 0.f;
#pragma unroll 8
    for (int k = 0; k < DFF; ++k) acc += bf2f(a[k]) * W[(size_t)k * DM];
    xr_row(p, m)[n] += modv(p, 0, rowtype(m), 5)[n] * acc;
}
__global__ void k_moe_gu(Params p) {
    const int j = blockIdx.x * 64 + threadIdx.x, ts = blockIdx.y * 4 + threadIdx.y;
    const int t = ts >> 1; const int e = ((const int*)(p.ws + WS_ROUTE))[ts];
    const bf16_t* a = (const bf16_t*)(p.ws + WS_HBUF) + (size_t)t * DM;
    const float* Wg = p.in[I_MWG] + (size_t)e * DM * DFF + j; const float* Wu = p.in[I_MWU] + (size_t)e * DM * DFF + j;
    float ag = 0.f, au = 0.f;
#pragma unroll 8
    for (int k = 0; k < DM; ++k) { const float x = bf2f(a[k]); ag += x * Wg[(size_t)k * DFF]; au += x * Wu[(size_t)k * DFF]; }
    ((bf16_t*)(p.ws + WS_ACT))[(size_t)ts * DFF + j] = f2bf(siluf(ag) * au);
}
__global__ void k_moe_down(Params p) {
    const int n = blockIdx.x * 64 + threadIdx.x, t = blockIdx.y * 4 + threadIdx.y;
    const int* te = (const int*)(p.ws + WS_ROUTE); const float* tw = (const float*)(p.ws + WS_ROUTE) + 2 * NL;
    float y = 0.f;
    for (int s = 0; s < 2; ++s) {
        const bf16_t* a = (const bf16_t*)(p.ws + WS_ACT) + (size_t)(2 * t + s) * DFF;
        const float* W = p.in[I_MWD] + (size_t)te[2 * t + s] * DFF * DM + n;
        float acc = 0.f;
#pragma unroll 8
        for (int k = 0; k < DFF; ++k) acc += bf2f(a[k]) * W[(size_t)k * DM];
        y += tw[2 * t + s] * acc;
    }
    p.out[(size_t)t * DM + n] += modv(p, 1, t / T, 5)[n] * y;
}


typedef unsigned v2u __attribute__((ext_vector_type(2)));
namespace pg8 {
#define PG8_LAS __attribute__((address_space(3)))
typedef unsigned short bf16_t;
typedef short bf16x8 __attribute__((ext_vector_type(8)));
typedef float f32x4 __attribute__((ext_vector_type(4)));
typedef unsigned u32x4 __attribute__((ext_vector_type(4)));
typedef int i32x4 __attribute__((ext_vector_type(4)));
typedef int i32x8 __attribute__((ext_vector_type(8)));
constexpr int BM = 256, BK = 64, HALF = 128, HTB = HALF * BK * 2  , STAGE_BYTES = 8 * HTB, NXCD = 8, WGM = 8;

__host__ __device__ __forceinline__ int lds_byte(int r, int c) { const int st = (r >> 4) * 2 + (c >> 5), rr = r & 15, cc = c & 31, ob = rr * 64 + cc * 2; return st * 1024 + (ob ^ (((ob >> 9) & 1) << 5)); }
__host__ __device__ __forceinline__ void stage_rc(int b, int& R, int& C) { const int st = b / 1024, sb = b % 1024, swz = sb ^ (((sb >> 9) & 1) << 5); R = (st >> 1) * 16 + swz / 64; C = (st & 1) * 32 + (swz % 64) / 2; }
__host__ __device__ __forceinline__ int perm32(int rho) { const int n = rho >> 4, i = rho & 15; return 8 * (i >> 2) + 4 * n + (i & 3); }

struct Unit { int pm, pn; long bofs, kofs; };
struct Gemm { const bf16_t* A; const bf16_t* Bt; int M, N, K, ld; };

struct Order {
    int nM, nN, nwg, G, c;
    int e1, e2, e3, e4, e5, e6, e7; long estride;
    __device__ __forceinline__ void init(int nM_, int nN_, int G_, int c_) { nM = nM_; nN = nN_; nwg = nM * nN; G = G_; c = c_; estride = 0; e1 = e2 = e3 = e4 = e5 = e6 = e7 = 0; }
    __device__ __forceinline__ bool next(int i, Unit& u) const {
        const long L = (long)i * G + c; if (L >= nwg) return false;
        int wgid = (int)L; { const int q = nwg / NXCD, r = nwg % NXCD, xcd = wgid % NXCD, off = wgid / NXCD; wgid = (xcd < r ? xcd * (q + 1) : r * (q + 1) + (xcd - r) * q) + off; }
        const int nig = WGM * nN, gid = wgid / nig, fm = gid * WGM, gsz = (nM - fm) < WGM ? (nM - fm) : WGM;
        u.pm = fm + ((wgid % nig) % gsz); u.pn = (wgid % nig) / gsz;
        const int e = (u.pm >= e1) + (u.pm >= e2) + (u.pm >= e3) + (u.pm >= e4) + (u.pm >= e5) + (u.pm >= e6) + (u.pm >= e7);
        u.bofs = estride ? (long)e * estride : 0; u.kofs = 0;
        return true;
    }
    __device__ __forceinline__ void a_ready(const Unit&) const {}
    __device__ __forceinline__ void done(const Unit&) const {}
};

struct SplitOrder {
    int nN, ns, nwg, G, c, pm0;
    __device__ __forceinline__ void init(int pm0_, int npan, int nN_, int ns_, int G_, int c_) { pm0 = pm0_; nN = nN_; ns = ns_; nwg = npan * nN * ns; G = G_; c = c_; }
    __device__ __forceinline__ bool next(int i, Unit& u) const {
        const int L = i * G + c; if (L >= nwg) return false;
        const int ks = L % ns, rest = L / ns; u.pn = rest % nN; u.pm = pm0 + rest / nN; u.bofs = 0; u.kofs = (long)ks * 256 * 2; return true;
    }
    __device__ __forceinline__ void a_ready(const Unit&) const {}
    __device__ __forceinline__ void done(const Unit&) const {}
};
__device__ __forceinline__ unsigned cvt_pk_bf16(float lo, float hi) { unsigned r; asm volatile("v_cvt_pk_bf16_f32 %0, %1, %2" : "=v"(r) : "v"(lo), "v"(hi)); return r; }
__device__ __forceinline__ float silu_fast(float x) { return x * __builtin_amdgcn_rcpf(1.f + __builtin_amdgcn_exp2f(-1.4426950408889634f * x)); }

struct EpiProj {
    static constexpr bool PERM = true, AFTER_DRAIN = false;
    bf16_t* O;
    __device__ __forceinline__ void operator()(const f32x4 (&acc)[2][2][4][2], const Unit& u, int wr, int wc, int fr, int fq) const {
        const int row0 = u.pm * BM + wr * 64 + fr, col0 = u.pn * BM + wc * 32 + 8 * fq;
        const float sc = (u.pn == 2 || u.pn == 3) ? 0.08838834764831845f : 1.f;
#pragma unroll
        for (int ai = 0; ai < 2; ++ai)
#pragma unroll
            for (int m = 0; m < 4; ++m) { bf16_t* rowp = O + (size_t)(row0 + ai * HALF + m * 16) * DP + col0;
#pragma unroll
                for (int bj = 0; bj < 2; ++bj) { const f32x4 v0 = acc[ai][bj][m][0] * sc, v1 = acc[ai][bj][m][1] * sc;
                    u32x4 w; w.x = cvt_pk_bf16(v0[0], v0[1]); w.y = cvt_pk_bf16(v0[2], v0[3]); w.z = cvt_pk_bf16(v1[0], v1[1]); w.w = cvt_pk_bf16(v1[2], v1[3]);
                    *(u32x4*)(rowp + bj * HALF) = w; } }
    }
};
struct EpiResid {
    static constexpr bool PERM = false, AFTER_DRAIN = false;
    const float* base_lat; const float* base_ctx; float* out_lat; float* out_ctx; const float* gl; const float* gc;
    __device__ __forceinline__ void operator()(const f32x4 (&acc)[2][2][4][2], const Unit& u, int wr, int wc, int fr, int fq) const {
        const bool lat = u.pm < NL / BM;
        const int row0 = (lat ? u.pm * BM : u.pm * BM - NL) + wr * 64 + fr, col0 = u.pn * BM + wc * 32 + 4 * fq;
        const float* base = lat ? base_lat : base_ctx; float* out = lat ? out_lat : out_ctx;
        const float* gate = lat ? gl + (size_t)(u.pm / (T / BM)) * 6 * DM : gc;
        f32x4 gv[2][2];
#pragma unroll
        for (int bj = 0; bj < 2; ++bj)
#pragma unroll
            for (int n = 0; n < 2; ++n) gv[bj][n] = *(const f32x4*)(gate + col0 + bj * HALF + n * 16);
#pragma unroll
        for (int ai = 0; ai < 2; ++ai)
#pragma unroll
            for (int m = 0; m < 4; ++m) { const size_t off = (size_t)(row0 + ai * HALF + m * 16) * DM + col0;
#pragma unroll
                for (int bj = 0; bj < 2; ++bj)
#pragma unroll
                    for (int n = 0; n < 2; ++n) { const f32x4 bs = *(const f32x4*)(base + off + bj * HALF + n * 16); *(f32x4*)(out + off + bj * HALF + n * 16) = bs + gv[bj][n] * acc[ai][bj][m][n]; }
                asm volatile("" ::: "memory"); }
    }
};
struct EpiPartial {
    static constexpr bool PERM = false, AFTER_DRAIN = false;
    float* part; int pm0, nrows;
    __device__ __forceinline__ void operator()(const f32x4 (&acc)[2][2][4][2], const Unit& u, int wr, int wc, int fr, int fq) const {
        const int row0 = (u.pm - pm0) * BM + wr * 64 + fr, col0 = u.pn * BM + wc * 32 + 4 * fq;
        float* base = part + (size_t)(u.kofs / 512) * nrows * DM;
#pragma unroll
        for (int ai = 0; ai < 2; ++ai)
#pragma unroll
            for (int m = 0; m < 4; ++m) { float* rowp = base + (size_t)(row0 + ai * HALF + m * 16) * DM + col0;
#pragma unroll
                for (int bj = 0; bj < 2; ++bj)
#pragma unroll
                    for (int n = 0; n < 2; ++n) *(f32x4*)(rowp + bj * HALF + n * 16) = acc[ai][bj][m][n]; }
    }
};
struct EpiSwiglu {
    static constexpr bool PERM = true, AFTER_DRAIN = false;
    bf16_t* O;
    __device__ __forceinline__ void operator()(const f32x4 (&acc)[2][2][4][2], const Unit& u, int wr, int wc, int fr, int fq) const {
        const int row0 = u.pm * BM + wr * 64 + fr, col0 = u.pn * HALF + wc * 32 + 8 * fq;
#pragma unroll
        for (int ai = 0; ai < 2; ++ai)
#pragma unroll
            for (int m = 0; m < 4; ++m) { bf16_t* rowp = O + (size_t)(row0 + ai * HALF + m * 16) * DFF + col0;
                const f32x4 g0 = acc[ai][0][m][0], g1 = acc[ai][0][m][1], u0 = acc[ai][1][m][0], u1 = acc[ai][1][m][1];
                u32x4 w; w.x = cvt_pk_bf16(silu_fast(g0[0]) * u0[0], silu_fast(g0[1]) * u0[1]); w.y = cvt_pk_bf16(silu_fast(g0[2]) * u0[2], silu_fast(g0[3]) * u0[3]);
                w.z = cvt_pk_bf16(silu_fast(g1[0]) * u1[0], silu_fast(g1[1]) * u1[1]); w.w = cvt_pk_bf16(silu_fast(g1[2]) * u1[2], silu_fast(g1[3]) * u1[3]);
                *(u32x4*)rowp = w; }
    }
};
struct EpiSwiglu8 {
    static constexpr bool PERM = true, AFTER_DRAIN = false;
    unsigned char* O;
    __device__ __forceinline__ void operator()(const f32x4 (&acc)[2][2][4][2], const Unit& u, int wr, int wc, int fr, int fq) const {
        const int row0 = u.pm * BM + wr * 64 + fr, col0 = u.pn * HALF + wc * 32 + 8 * fq;
        constexpr float WI = 1.f / W8_SCALE;
#pragma unroll
        for (int ai = 0; ai < 2; ++ai)
#pragma unroll
            for (int m = 0; m < 4; ++m) { unsigned char* rowp = O + (size_t)(row0 + ai * HALF + m * 16) * DFF + col0;
                const f32x4 g0 = acc[ai][0][m][0] * WI, g1 = acc[ai][0][m][1] * WI, u0 = acc[ai][1][m][0] * (WI * A8_SCALE), u1 = acc[ai][1][m][1] * (WI * A8_SCALE);
                v2u w; w.x = pk4_fp8(silu_fast(g0[0]) * u0[0], silu_fast(g0[1]) * u0[1], silu_fast(g0[2]) * u0[2], silu_fast(g0[3]) * u0[3]);
                w.y = pk4_fp8(silu_fast(g1[0]) * u1[0], silu_fast(g1[1]) * u1[1], silu_fast(g1[2]) * u1[2], silu_fast(g1[3]) * u1[3]);
                *(v2u*)rowp = w; }
    }
};
struct EpiMoeDown {
    static constexpr bool PERM = true, AFTER_DRAIN = false;
    bf16_t* O; const float* rgate; float scale;
    __device__ __forceinline__ void operator()(const f32x4 (&acc)[2][2][4][2], const Unit& u, int wr, int wc, int fr, int fq) const {
        const int row0 = u.pm * BM + wr * 64 + fr, col0 = u.pn * BM + wc * 32 + 8 * fq;
#pragma unroll
        for (int ai = 0; ai < 2; ++ai)
#pragma unroll
            for (int m = 0; m < 4; ++m) { const int row = row0 + ai * HALF + m * 16; const float sc = rgate[row] * scale; bf16_t* rowp = O + (size_t)row * DM + col0;
#pragma unroll
                for (int bj = 0; bj < 2; ++bj) { const f32x4 v0 = acc[ai][bj][m][0] * sc, v1 = acc[ai][bj][m][1] * sc;
                    u32x4 w; w.x = cvt_pk_bf16(v0[0], v0[1]); w.y = cvt_pk_bf16(v0[2], v0[3]); w.z = cvt_pk_bf16(v1[0], v1[1]); w.w = cvt_pk_bf16(v1[2], v1[3]);
                    *(u32x4*)(rowp + bj * HALF) = w; } }
    }
};

template <class Epi, class Sched, bool ALIGN_EPI = false, bool SP2 = false, bool F8 = false>
__device__ __forceinline__ void gemm_phase(PG8_LAS unsigned char* lds, const Gemm g, const Sched& S, const Epi& E, const int wid  ) {
    const int lane = lane_id(), tid = wid * 64 + lane, wr = wid >> 2, wc = wid & 3, fr = lane & 15, fq = lane >> 4;
    const int K = g.ld, nt = g.K / BK;
    unsigned voffA[2], voffB[2];
#pragma unroll
    for (int i = 0; i < 2; ++i) { int R, C; stage_rc(tid * 16 + i * 8192, R, C); const int Rb = Epi::PERM ? ((R & ~31) + perm32(R & 31)) : R;
        voffA[i] = (unsigned)(R * K + C) * 2u; voffB[i] = (unsigned)(Rb * K + C) * 2u; }
    const size_t kstep = (size_t)(BK * 2);
    const size_t hstep = (size_t)HALF * K * 2;
    const size_t tstep = 2 * hstep;
    const unsigned ldsw = (unsigned)wid * 1024u;
    const int aoff = lds_byte(wr * 64 + fr, fq * 8), boff = lds_byte(wc * 32 + fr, fq * 8);
#define PG8_SA(b, h) (((b) * 2 + (h)) * HTB)
#define PG8_SB(b, h) ((4 + (b) * 2 + (h)) * HTB)
#define PG8_STAGE(bufoff, gbase, voff) do { _Pragma("unroll") for (int _i = 0; _i < 2; ++_i) \
        __builtin_amdgcn_global_load_lds((const unsigned*)((const char*)(gbase) + (voff)[_i]), (PG8_LAS unsigned*)(lds + (bufoff) + ldsw + _i * 8192), 16, 0, 0); } while (0)
#define PG8_LD8(addr) __builtin_shufflevector(*(const PG8_LAS i32x4*)(addr), *(const PG8_LAS i32x4*)((addr) + 1024), 0, 1, 2, 3, 4, 5, 6, 7)
#define PG8_LDA(dst, dst8, b, h) do { if constexpr (F8) { _Pragma("unroll") for (int m = 0; m < 4; ++m) dst8[m] = PG8_LD8(lds + PG8_SA(b, h) + aoff + m * 2048); } \
        else { _Pragma("unroll") for (int m = 0; m < 4; ++m) _Pragma("unroll") for (int k = 0; k < 2; ++k) dst[m][k] = *(const PG8_LAS bf16x8*)(lds + PG8_SA(b, h) + aoff + m * 2048 + k * 1024); } } while (0)
#define PG8_LDB(dst, dst8, b, h) do { if constexpr (F8) { _Pragma("unroll") for (int n = 0; n < 2; ++n) dst8[n] = PG8_LD8(lds + PG8_SB(b, h) + boff + n * 2048); } \
        else { _Pragma("unroll") for (int n = 0; n < 2; ++n) _Pragma("unroll") for (int k = 0; k < 2; ++k) dst[n][k] = *(const PG8_LAS bf16x8*)(lds + PG8_SB(b, h) + boff + n * 2048 + k * 1024); } } while (0)
#define PG8_MMA(ai, bj, At, At8, Bt, Bt8) do { __builtin_amdgcn_s_setprio(1); \
        if constexpr (F8) { _Pragma("unroll") for (int m = 0; m < 4; ++m) _Pragma("unroll") for (int n = 0; n < 2; ++n) \
            asm volatile("v_mfma_scale_f32_16x16x128_f8f6f4 %0, %1, %2, %0, %3, %3 op_sel_hi:[0,0,0]" : "+v"(acc[ai][bj][m][n]) : "v"(Bt8[n]), "v"(At8[m]), "v"(sc8_)); } \
        else { _Pragma("unroll") for (int m = 0; m < 4; ++m) _Pragma("unroll") for (int n = 0; n < 2; ++n) _Pragma("unroll") for (int k = 0; k < 2; ++k) \
            acc[ai][bj][m][n] = __builtin_amdgcn_mfma_f32_16x16x32_bf16(Bt[n][k], At[m][k], acc[ai][bj][m][n], 0, 0, 0); } \
        __builtin_amdgcn_s_setprio(0); } while (0)
#define PG8_WAIT_V(n) asm volatile("s_waitcnt vmcnt(" #n ")" ::: "memory")
#define PG8_WAIT_L(n) asm volatile("s_waitcnt lgkmcnt(" #n ")" ::: "memory")
#define PG8_BAR __builtin_amdgcn_s_barrier()
#define PG8_SCHED __builtin_amdgcn_sched_barrier(0)
#define PG8_SCHED8 do { if constexpr (F8) __builtin_amdgcn_sched_barrier(0); } while (0)
    Unit cur, nxt; int ui = 0;
    if (!S.next(0, cur)) return;
    constexpr float zero_ = 0.f;
    const int sc8_ = 0x7f7f7f7f;
    f32x4 acc[2][2][4][2];
#pragma unroll
    for (int a = 0; a < 2; ++a)
#pragma unroll
        for (int b = 0; b < 2; ++b)
#pragma unroll
            for (int m = 0; m < 4; ++m)
#pragma unroll
                for (int n = 0; n < 2; ++n) acc[a][b][m][n] = (f32x4){zero_, zero_, zero_, zero_};
    bf16x8 At[4][2], B0[2][2], B1[2][2];
    i32x8 At8[4], B08[2], B18[2];
    const char* cA = (const char*)g.A + cur.kofs + (size_t)cur.pm * tstep; const char* cB = (const char*)g.Bt + cur.bofs + cur.kofs + (size_t)cur.pn * tstep;
    S.a_ready(cur);
    if constexpr (SP2) {
        PG8_STAGE(PG8_SB(0, 0), cB, voffB); PG8_STAGE(PG8_SB(0, 1), cB + hstep, voffB); PG8_STAGE(PG8_SA(0, 0), cA, voffA); PG8_STAGE(PG8_SA(0, 1), cA + hstep, voffA);
        if (wr == 1) PG8_BAR;
        PG8_WAIT_V(2); PG8_BAR;
        PG8_STAGE(PG8_SB(1, 0), cB + kstep, voffB); PG8_STAGE(PG8_SA(1, 0), cA + kstep, voffA); PG8_STAGE(PG8_SB(1, 1), cB + hstep + kstep, voffB);
        PG8_WAIT_V(6); PG8_BAR;
    } else {
        PG8_STAGE(PG8_SB(0, 0), cB, voffB); PG8_STAGE(PG8_SA(0, 0), cA, voffA); PG8_STAGE(PG8_SB(0, 1), cB + hstep, voffB); PG8_STAGE(PG8_SA(0, 1), cA + hstep, voffA);
        if (wr == 1) PG8_BAR;
        PG8_WAIT_V(4); PG8_BAR;
        PG8_STAGE(PG8_SB(1, 0), cB + kstep, voffB); PG8_STAGE(PG8_SA(1, 0), cA + kstep, voffA); PG8_STAGE(PG8_SB(1, 1), cB + hstep + kstep, voffB);
        PG8_WAIT_V(6); PG8_BAR;
    }
    for (;;) {
        const bool has_next = S.next(ui + 1, nxt);
        const char* nA = has_next ? (const char*)g.A + nxt.kofs + (size_t)nxt.pm * tstep : cA; const char* nB = has_next ? (const char*)g.Bt + nxt.bofs + nxt.kofs + (size_t)nxt.pn * tstep : cB;
#pragma clang loop unroll(disable)
        for (int t = 0; t < nt; t += 2) {
            const bool last = (t == nt - 2);
            const char* a1 = cA + (size_t)(t + 1) * kstep;
            const char* a2 = last ? nA : cA + (size_t)(t + 2) * kstep; const char* b2 = last ? nB : cB + (size_t)(t + 2) * kstep;
            const char* a3 = a2 + kstep; const char* b3 = b2 + kstep;
            if (last && has_next) S.a_ready(nxt);
            if constexpr (SP2) {
            PG8_LDB(B0, B08, 0, 0); PG8_LDB(B1, B18, 0, 1); PG8_SCHED; PG8_LDA(At, At8, 0, 0); PG8_STAGE(PG8_SA(1, 1), a1 + hstep, voffA);
            PG8_WAIT_V(8); PG8_WAIT_L(0); PG8_BAR; PG8_SCHED8; PG8_MMA(0, 0, At, At8, B0, B08); PG8_MMA(0, 1, At, At8, B1, B18); PG8_SCHED8; PG8_BAR; PG8_SCHED;
            PG8_LDA(At, At8, 0, 1); PG8_STAGE(PG8_SB(0, 0), b2, voffB); PG8_STAGE(PG8_SB(0, 1), b2 + hstep, voffB); PG8_STAGE(PG8_SA(0, 0), a2, voffA);
            PG8_WAIT_V(8); PG8_WAIT_L(0); PG8_BAR; PG8_SCHED8; PG8_MMA(1, 0, At, At8, B0, B08); PG8_MMA(1, 1, At, At8, B1, B18); PG8_SCHED8; PG8_BAR; PG8_SCHED;
            PG8_LDB(B0, B08, 1, 0); PG8_LDB(B1, B18, 1, 1); PG8_SCHED; PG8_LDA(At, At8, 1, 0); PG8_STAGE(PG8_SA(0, 1), a2 + hstep, voffA);
            PG8_WAIT_V(8); PG8_WAIT_L(0); PG8_BAR; PG8_SCHED8; PG8_MMA(0, 0, At, At8, B0, B08); PG8_MMA(0, 1, At, At8, B1, B18); PG8_SCHED8; PG8_BAR; PG8_SCHED;
            PG8_LDA(At, At8, 1, 1); PG8_STAGE(PG8_SB(1, 0), b3, voffB); PG8_STAGE(PG8_SB(1, 1), b3 + hstep, voffB); PG8_STAGE(PG8_SA(1, 0), a3, voffA);
            PG8_WAIT_V(8); PG8_WAIT_L(0); PG8_BAR; PG8_SCHED8; PG8_MMA(1, 0, At, At8, B0, B08); PG8_MMA(1, 1, At, At8, B1, B18); PG8_SCHED8; PG8_BAR; PG8_SCHED;
            } else {
            PG8_LDB(B0, B08, 0, 0); PG8_SCHED; PG8_LDA(At, At8, 0, 0); PG8_STAGE(PG8_SA(1, 1), a1 + hstep, voffA);
            PG8_WAIT_L(8); PG8_BAR; PG8_WAIT_L(0); PG8_MMA(0, 0, At, At8, B0, B08); PG8_BAR; PG8_SCHED;
            PG8_LDB(B1, B18, 0, 1); PG8_STAGE(PG8_SB(0, 0), b2, voffB);
            PG8_BAR; PG8_WAIT_L(0); PG8_MMA(0, 1, At, At8, B1, B18); PG8_BAR;
            PG8_LDA(At, At8, 0, 1); PG8_STAGE(PG8_SA(0, 0), a2, voffA);
            PG8_BAR; PG8_WAIT_L(0); PG8_MMA(1, 0, At, At8, B0, B08); PG8_BAR; PG8_SCHED;
            PG8_STAGE(PG8_SB(0, 1), b2 + hstep, voffB);
            PG8_WAIT_V(6); PG8_BAR; PG8_MMA(1, 1, At, At8, B1, B18); PG8_BAR;
            PG8_LDB(B0, B08, 1, 0); PG8_SCHED; PG8_LDA(At, At8, 1, 0); PG8_STAGE(PG8_SA(0, 1), a2 + hstep, voffA);
            PG8_WAIT_L(8); PG8_BAR; PG8_WAIT_L(0); PG8_MMA(0, 0, At, At8, B0, B08); PG8_BAR; PG8_SCHED;
            PG8_LDB(B1, B18, 1, 1); PG8_STAGE(PG8_SB(1, 0), b3, voffB);
            PG8_BAR; PG8_WAIT_L(0); PG8_MMA(0, 1, At, At8, B1, B18); PG8_BAR;
            PG8_LDA(At, At8, 1, 1); PG8_STAGE(PG8_SA(1, 0), a3, voffA);
            PG8_BAR; PG8_WAIT_L(0); PG8_MMA(1, 0, At, At8, B0, B08); PG8_BAR; PG8_SCHED;
            PG8_STAGE(PG8_SB(1, 1), b3 + hstep, voffB);
            PG8_WAIT_V(6); PG8_BAR; PG8_MMA(1, 1, At, At8, B1, B18); PG8_BAR;
            }
        }
        if constexpr (ALIGN_EPI) { if (wr == 0) PG8_BAR; }
        if constexpr (F8) asm volatile("s_nop 15\n\ts_nop 15" ::: "memory");
        if constexpr (!Epi::AFTER_DRAIN) { E(acc, cur, wr, wc, fr, fq); S.done(cur); }
        if (!has_next) break;
#pragma unroll
        for (int a = 0; a < 2; ++a)
#pragma unroll
            for (int b = 0; b < 2; ++b)
#pragma unroll
                for (int m = 0; m < 4; ++m)
#pragma unroll
                    for (int n = 0; n < 2; ++n) acc[a][b][m][n] = (f32x4){zero_, zero_, zero_, zero_};
        cur = nxt; cA = nA; cB = nB; ++ui;
        if constexpr (ALIGN_EPI) { if (wr == 1) PG8_BAR; }
    }
    PG8_WAIT_V(0);
    if constexpr (!ALIGN_EPI) { if (wr == 0) PG8_BAR; }
    PG8_BAR;
    if constexpr (Epi::AFTER_DRAIN) { E.fused(acc, cur, wr, wc, fr, fq, lds, wid, lane); S.done(cur); }
#undef PG8_SA
#undef PG8_SB
#undef PG8_STAGE
#undef PG8_LDA
#undef PG8_LDB
#undef PG8_MMA
#undef PG8_LD8
#undef PG8_WAIT_V
#undef PG8_WAIT_L
#undef PG8_BAR
#undef PG8_SCHED
#undef PG8_SCHED8
}

}

#define GAS __attribute__((address_space(1)))
#define LAS __attribute__((address_space(3)))
typedef unsigned v4u __attribute__((ext_vector_type(4)));
typedef float f32x4 __attribute__((ext_vector_type(4)));
#define LDS_WAIT() asm volatile("s_waitcnt lgkmcnt(0)" ::: "memory")
#define VM_WAIT() asm volatile("s_waitcnt vmcnt(0)" ::: "memory")

#define XB_TMO      128
#define XB_XCNT(j)  (256  + 64 * (j))
#define XB_XSUB(j)  (1280 + 64 * (j))
#define XB_XGEN(j)  (2304 + 64 * (j))
#define XB_TOP      3328
#define XB_TOPGEN   3392
#define XCD_BAR_WORDS 3456
#define XB_SPIN_CAP (1u << 18)

__device__ __forceinline__ unsigned xb_ld(unsigned* p)              { return __hip_atomic_load(p, __ATOMIC_RELAXED, __HIP_MEMORY_SCOPE_AGENT); }
__device__ __forceinline__ unsigned xb_add(unsigned* p, unsigned v) { return __hip_atomic_fetch_add(p, v, __ATOMIC_RELAXED, __HIP_MEMORY_SCOPE_AGENT); }
__device__ __forceinline__ unsigned xb_xcc_id() { return (unsigned)__builtin_amdgcn_s_getreg((3 << 11) | 20) & 0xFu; }
#define XB_SPIN(cond, bar) do { unsigned _sp = 0; while (cond) { __builtin_amdgcn_s_sleep(1); \
    if ((++_sp & 255u) == 0u) { if (xb_ld(&(bar)[XB_TMO])) break; if (_sp > XB_SPIN_CAP) { atomicAdd(&(bar)[XB_TMO], 1u); break; } } } } while (0)

struct XcdBarrier {
    unsigned* bar; unsigned x;
    volatile LAS unsigned* st;
};

__device__ __forceinline__ XcdBarrier xcd_barrier_post(unsigned* bar, volatile LAS unsigned* st, bool t0) {
    XcdBarrier b; b.bar = bar; b.x = xb_xcc_id(); b.st = st;
    if (t0) (void)xb_add(&bar[XB_XCNT(b.x)], 1u);
    return b;
}
__device__ __forceinline__ void xcd_barrier_complete(unsigned* bar, unsigned x, unsigned& nloc, unsigned& nx) {
    const unsigned G = gridDim.x * gridDim.y * gridDim.z;
    unsigned sum, cnt, mine, sp = 0u;
    for (;;) {
        sum = 0u; cnt = 0u; mine = 0u;
#pragma unroll
        for (unsigned j = 0; j < 16; ++j) { const unsigned c = xb_ld(&bar[XB_XCNT(j)]); sum += c; cnt += (c > 0u) ? 1u : 0u; mine = (j == x) ? c : mine; }
        if (sum == G) break;
        __builtin_amdgcn_s_sleep(1);
        if ((++sp & 255u) == 0u) { if (xb_ld(&bar[XB_TMO])) break; if (sp > XB_SPIN_CAP) { atomicAdd(&bar[XB_TMO], 1u); break; } }
    }
    nloc = mine > 0u ? mine : 1u; nx = cnt > 0u ? cnt : 1u;
}

__device__ __forceinline__ void xcd_barrier(const XcdBarrier& b, bool t0) {
    asm volatile("s_waitcnt vmcnt(0)" ::: "memory");
    __syncthreads();
    if (t0) {
        unsigned* bar = b.bar;
        __builtin_amdgcn_s_waitcnt(0);
        unsigned nloc = b.st[0], nx = b.st[1];
        if (nloc == 0u) { xcd_barrier_complete(bar, b.x, nloc, nx); b.st[0] = nloc; b.st[1] = nx; }
        const unsigned old = xb_add(&bar[XB_XSUB(b.x)], 1u);
        const unsigned gen = old / nloc;
        if (old + 1u == (gen + 1u) * nloc) {
            __builtin_amdgcn_fence(__ATOMIC_RELEASE, "agent");
            asm volatile("s_waitcnt vmcnt(0)" ::: "memory");
            const unsigned og = xb_add(&bar[XB_TOP], 1u);
            const unsigned tg = og / nx;
            if (og + 1u == (tg + 1u) * nx) xb_add(&bar[XB_TOPGEN], 1u);
            else XB_SPIN(xb_ld(&bar[XB_TOPGEN]) == tg, bar);
            __builtin_amdgcn_fence(__ATOMIC_ACQUIRE, "agent");
            xb_add(&bar[XB_XGEN(b.x)], 1u);
            asm volatile("s_waitcnt vmcnt(0)" ::: "memory");
        } else {
            XB_SPIN(xb_ld(&bar[XB_XGEN(b.x)]) == gen, bar);
            __builtin_amdgcn_fence(__ATOMIC_ACQUIRE, "agent");
            asm volatile("s_waitcnt vmcnt(0)" ::: "memory");
        }
    }
    __syncthreads();
}

constexpr int RING_OFF = 0, RING_BYTES = 131072;
constexpr int MISC_OFF = 143360;
constexpr int LDS_BYTES = 147456;
constexpr int NWAVES = 8;

struct Ctx { LAS unsigned char* lds; volatile LAS unsigned* MISC; unsigned* ctl; int wave, G, gw, NGW; };

__device__ __forceinline__ void cvt_item(const float* W, int K, int N, bf16_t* WT, int mode, LAS float* scr, int item, int lane) {
    const int kblk = K / 64, nb = item / kblk, kb = item % kblk, k0 = 64 * kb, n0 = 64 * nb;
    f32x4 ld[16];
#pragma unroll
    for (int i = 0; i < 16; ++i) { const int kk = 4 * i + (lane >> 4), c4 = 4 * (lane & 15); ld[i] = __builtin_nontemporal_load((const f32x4*)(W + (size_t)(k0 + kk) * N + n0 + c4));     }
#pragma unroll
    for (int i = 0; i < 16; ++i) { const int kk = 4 * i + (lane >> 4), c4 = 4 * (lane & 15);
        LAS float* s = scr + kk * 65 + c4; s[0] = ld[i][0]; s[1] = ld[i][1]; s[2] = ld[i][2]; s[3] = ld[i][3]; }
    LDS_WAIT(); asm volatile("" ::: "memory");
    const int c = lane >> 3;
#pragma unroll
    for (int j = 0; j < 8; ++j) { const int n = (lane & 7) + 8 * j; const LAS float* s = scr + (8 * c) * 65 + n;
        v4u o; o.x = pk2(s[0 * 65], s[1 * 65]); o.y = pk2(s[2 * 65], s[3 * 65]); o.z = pk2(s[4 * 65], s[5 * 65]); o.w = pk2(s[6 * 65], s[7 * 65]);
        const int nn = n0 + n; const int drow = mode == 0 ? nn : (nn / 128) * 256 + (mode - 1) * 128 + (nn % 128);
        *(v4u*)(WT + (size_t)drow * K + k0 + 8 * c) = o; }
    LDS_WAIT(); asm volatile("" ::: "memory");
}
__device__ __forceinline__ void cvt_item8(const float* W, int K, int N, unsigned char* WT, int mode, LAS float* scr, int item, int lane) {
    const int kblk = K / 64, nb = item / kblk, kb = item % kblk, k0 = 64 * kb, n0 = 64 * nb;
    f32x4 ld[16];
#pragma unroll
    for (int i = 0; i < 16; ++i) { const int kk = 4 * i + (lane >> 4), c4 = 4 * (lane & 15); ld[i] = __builtin_nontemporal_load((const f32x4*)(W + (size_t)(k0 + kk) * N + n0 + c4));     }
#pragma unroll
    for (int i = 0; i < 16; ++i) { const int kk = 4 * i + (lane >> 4), c4 = 4 * (lane & 15);
        LAS float* s = scr + kk * 65 + c4; s[0] = ld[i][0]; s[1] = ld[i][1]; s[2] = ld[i][2]; s[3] = ld[i][3]; }
    LDS_WAIT(); asm volatile("" ::: "memory");
    const int c = lane >> 3;
#pragma unroll
    for (int j = 0; j < 8; ++j) { const int n = (lane & 7) + 8 * j; const LAS float* s = scr + (8 * c) * 65 + n;
        v2u o; o.x = pk4_fp8(s[0 * 65] * W8_SCALE, s[1 * 65] * W8_SCALE, s[2 * 65] * W8_SCALE, s[3 * 65] * W8_SCALE); o.y = pk4_fp8(s[4 * 65] * W8_SCALE, s[5 * 65] * W8_SCALE, s[6 * 65] * W8_SCALE, s[7 * 65] * W8_SCALE);
        const int nn = n0 + n; const int drow = mode == 0 ? nn : (nn / 128) * 256 + (mode - 1) * 128 + (nn % 128);
        *(v2u*)(WT + (size_t)drow * K + k0 + 8 * c) = o; }
    LDS_WAIT(); asm volatile("" ::: "memory");
}
__device__ __forceinline__ void p0_prologue(const Params& p, Ctx& F) {
    const int lane_ = lane_id(), tid_ = F.wave * 64 + lane_;
    LAS float* fl = (LAS float*)(F.lds + RING_OFF);
    for (int it = blockIdx.x; it < 192; it += F.G) {
        const int l = it / 96, n = (it % 96) * 64 + lane_;
        LAS float* sv = fl;
        LAS float* red = fl + 3 * 1024;
        for (int i = tid_; i < 3 * 1024; i += 512) { const int rt = i >> 10, k = i & 1023; const float v = rt < 2 ? p.in[I_C][rt * DM + k] : p.in[I_CCTX][k]; sv[i] = siluf(v); }
        __syncthreads();
        const float* W = p.in[I_ADAW] + (size_t)l * DM * 6144 + n;
        float a0 = 0.f, a1 = 0.f, a2 = 0.f;
        for (int kb = 0; kb < 128; kb += 32) {
            float wv[32];
#pragma unroll
            for (int j = 0; j < 32; ++j) wv[j] = W[(size_t)(F.wave * 128 + kb + j) * 6144];
#pragma unroll
            for (int j = 0; j < 32; ++j) { const int k = F.wave * 128 + kb + j; a0 += sv[k] * wv[j]; a1 += sv[1024 + k] * wv[j]; a2 += sv[2048 + k] * wv[j]; }
        }
        red[(F.wave * 3 + 0) * 64 + lane_] = a0; red[(F.wave * 3 + 1) * 64 + lane_] = a1; red[(F.wave * 3 + 2) * 64 + lane_] = a2;
        __syncthreads();
        if (tid_ < 192) { const int rt = tid_ >> 6, ln = tid_ & 63; float s = 0.f;
#pragma unroll
            for (int w = 0; w < 8; ++w) s += red[(w * 3 + rt) * 64 + ln];
            const int nn = (it % 96) * 64 + ln;
            ((float*)(p.ws + WS_MODV))[(size_t)(l * 3 + rt) * 6144 + nn] = s + p.in[I_ADAB][l * 6144 + nn]; }
        __syncthreads();
    }
    LAS float* scr = (LAS float*)(F.lds + RING_OFF) + F.wave * (64 * 65);
    constexpr int S_WIN = 16 * 56, S_WOUT = 16 * 16, S_F = 16 * 44;
    constexpr int NITEMS = 2 * S_WIN + 2 * S_WOUT + 3 * S_F + 24 * S_F;
    static_assert(NITEMS == 21312, "items");
    for (int it = F.gw; it < NITEMS; it += F.NGW) {
        int r = it;
        if (r < 2 * S_WIN) { const int l = r / S_WIN; cvt_item(p.in[I_WIN] + (size_t)l * DM * DP, DM, DP, (bf16_t*)(p.ws + W_WIN) + (size_t)l * DP * DM, 0, scr, r % S_WIN, lane_); continue; } r -= 2 * S_WIN;
        if (r < 2 * S_WOUT) { const int l = r / S_WOUT; cvt_item(p.in[I_WOUT] + (size_t)l * DM * DM, DM, DM, (bf16_t*)(p.ws + W_WOUT) + (size_t)l * DM * DM, 0, scr, r % S_WOUT, lane_); continue; } r -= 2 * S_WOUT;
        if (r < S_F) { cvt_item(p.in[I_FWG], DM, DFF, (bf16_t*)(p.ws + W_FGU), 1, scr, r, lane_); continue; } r -= S_F;
        if (r < S_F) { cvt_item(p.in[I_FWU], DM, DFF, (bf16_t*)(p.ws + W_FGU), 2, scr, r, lane_); continue; } r -= S_F;
        if (r < S_F) { cvt_item(p.in[I_FWD], DFF, DM, (bf16_t*)(p.ws + W_FD), 0, scr, r, lane_); continue; } r -= S_F;
        if (r < 8 * S_F) { const int e = r / S_F; cvt_item8(p.in[I_MWG] + (size_t)e * DM * DFF, DM, DFF, (unsigned char*)(p.ws + W_MGU) + (size_t)e * 2 * DFF * DM, 1, scr, r % S_F, lane_); continue; } r -= 8 * S_F;
        if (r < 8 * S_F) { const int e = r / S_F; cvt_item8(p.in[I_MWU] + (size_t)e * DM * DFF, DM, DFF, (unsigned char*)(p.ws + W_MGU) + (size_t)e * 2 * DFF * DM, 2, scr, r % S_F, lane_); continue; } r -= 8 * S_F;
        { const int e = r / S_F; cvt_item8(p.in[I_MWD] + (size_t)e * DFF * DM, DFF, DM, (unsigned char*)(p.ws + W_MD) + (size_t)e * DM * DFF, 0, scr, r % S_F, lane_); }
    }
}

__device__ __forceinline__ void norm_phase(const Params& p, Ctx& F, int l, int which, int nrows) {
    const int lane_ = lane_id(), tid_ = F.wave * 64 + lane_;
    const float* g = p.in[which ? I_N2G : I_N1G] + l * DM;
    for (int m = F.gw; m < nrows; m += F.NGW) {
        const float* xrow;
        if (l == 0 && which == 0) xrow = m < NL ? p.in[I_X] + (size_t)m * DM : p.in[I_CTX] + (size_t)(m - NL) * DM;
        else xrow = xr_row(p, m);
        const int rt = rowtype(m);
        const float* sh = modv(p, l, rt, which ? 3 : 0); const float* sc = modv(p, l, rt, which ? 4 : 1);
        f32x4 v[4]; float ss = 0.f;
        if (m >= NL && !(l == 0 && which == 0)) {
            const int nsl = which ? DM / 256 : DFF / 256; const float* gate = modv(p, 0, 2, which ? 2 : 5);
            const float* base = (l == 0) ? p.in[I_CTX] + (size_t)(m - NL) * DM : xrow;
            const float* part = (const float*)(p.ws + WS_PART) + (size_t)(m - NL) * DM;
#pragma unroll
            for (int j = 0; j < 4; ++j) { const int col = 256 * j + 4 * lane_; f32x4 a = {0.f, 0.f, 0.f, 0.f};
                for (int sl = 0; sl < nsl; ++sl) a += *(const f32x4*)(part + (size_t)sl * NC * DM + col);
                v[j] = *(const f32x4*)(base + col) + *(const f32x4*)(gate + col) * a;
                *(f32x4*)((float*)(p.ws + WS_XRC) + (size_t)(m - NL) * DM + col) = v[j];
                ss += (v[j][0] * v[j][0] + v[j][1] * v[j][1]) + (v[j][2] * v[j][2] + v[j][3] * v[j][3]); }
        } else
#pragma unroll
        for (int j = 0; j < 4; ++j) { v[j] = *(const f32x4*)(xrow + 256 * j + 4 * lane_); ss += (v[j][0] * v[j][0] + v[j][1] * v[j][1]) + (v[j][2] * v[j][2] + v[j][3] * v[j][3]); }
        const float r = rsqrtf(wave_sum(ss) * (1.f / DM) + EPS);
        bf16_t* hb = (bf16_t*)(p.ws + WS_HBUF) + (size_t)m * DM;
#pragma unroll
        for (int j = 0; j < 4; ++j) { const int col = 256 * j + 4 * lane_;
            const f32x4 gg = *(const f32x4*)(g + col), s4 = *(const f32x4*)(sc + col), h4 = *(const f32x4*)(sh + col);
            const f32x4 y = v[j] * r * gg * (1.f + s4) + h4;
            v2u o; o.x = pk2(y[0], y[1]); o.y = pk2(y[2], y[3]); *(v2u*)(hb + col) = o; }
    }
}


__device__ __forceinline__ void router_phase(const Params& p, Ctx& F) {
    const int lane_ = lane_id(), tid_ = F.wave * 64 + lane_;
    LAS int* lcnt = (LAS int*)(F.lds + RING_OFF);
    LAS int* gbase = lcnt + 8;
    LAS int* ent_e = lcnt + 16;
    LAS int* ent_pos = lcnt + 16 + 128;
    const float* g = p.in[I_N2G] + DM; const float* rw = p.in[I_RW];
    int* tok_e = (int*)(p.ws + WS_ROUTE); float* tok_w = (float*)(p.ws + WS_ROUTE) + 2 * NL; int* tok_pos = (int*)(p.ws + WS_ROUTE) + 4 * NL;
    f32x4 rwa[4][4], rwb[4][4];
#pragma unroll
    for (int j = 0; j < 4; ++j)
#pragma unroll
        for (int q = 0; q < 4; ++q) { const int col = 256 * j + 4 * lane_ + q; rwa[j][q] = *(const f32x4*)(rw + (size_t)col * 8); rwb[j][q] = *(const f32x4*)(rw + (size_t)col * 8 + 4); }
    const int myexp = ((lane_ >> 5) & 1) * 4 + ((lane_ >> 4) & 1) * 2 + ((lane_ >> 3) & 1);
    for (int ch = blockIdx.x; ch < NL / 64; ch += F.G) {
        if (tid_ < 8) lcnt[tid_] = 0;
        __syncthreads();
        const int rt = (ch * 64) / T;
        const float* sh = modv(p, 1, rt, 3); const float* sc = modv(p, 1, rt, 4);
        f32x4 gs[4], hs[4]; float bsum;
        { float bb[8] = {0.f, 0.f, 0.f, 0.f, 0.f, 0.f, 0.f, 0.f};
#pragma unroll
          for (int j = 0; j < 4; ++j) { const int col = 256 * j + 4 * lane_; gs[j] = *(const f32x4*)(g + col) * (1.f + *(const f32x4*)(sc + col)); hs[j] = *(const f32x4*)(sh + col);
#pragma unroll
            for (int q = 0; q < 4; ++q) { bb[0] += hs[j][q] * rwa[j][q][0]; bb[1] += hs[j][q] * rwa[j][q][1]; bb[2] += hs[j][q] * rwa[j][q][2]; bb[3] += hs[j][q] * rwa[j][q][3];
                                          bb[4] += hs[j][q] * rwb[j][q][0]; bb[5] += hs[j][q] * rwb[j][q][1]; bb[6] += hs[j][q] * rwb[j][q][2]; bb[7] += hs[j][q] * rwb[j][q][3]; } }
          float c4[4];
#pragma unroll
          for (int k = 0; k < 4; ++k) { const float keep = (lane_ & 32) ? bb[k + 4] : bb[k], give = (lane_ & 32) ? bb[k] : bb[k + 4]; c4[k] = keep + __shfl_xor(give, 32); }
          float c2[2];
#pragma unroll
          for (int k = 0; k < 2; ++k) { const float keep = (lane_ & 16) ? c4[k + 2] : c4[k], give = (lane_ & 16) ? c4[k] : c4[k + 2]; c2[k] = keep + __shfl_xor(give, 16); }
          float c1 = ((lane_ & 8) ? c2[1] : c2[0]) + __shfl_xor((lane_ & 8) ? c2[0] : c2[1], 8);
          c1 += __shfl_xor(c1, 4); c1 += __shfl_xor(c1, 2); c1 += __shfl_xor(c1, 1);
          bsum = c1 + p.in[I_RB][myexp]; }
        for (int i = 0; i < 8; ++i) {
            const int ti = F.wave * 8 + i, m = ch * 64 + ti;
            const float* xrow = p.out + (size_t)m * DM;
            f32x4 v[4]; float ss = 0.f; float aa[8] = {0.f, 0.f, 0.f, 0.f, 0.f, 0.f, 0.f, 0.f};
#pragma unroll
            for (int j = 0; j < 4; ++j) { v[j] = *(const f32x4*)(xrow + 256 * j + 4 * lane_); ss += (v[j][0] * v[j][0] + v[j][1] * v[j][1]) + (v[j][2] * v[j][2] + v[j][3] * v[j][3]); }
#pragma unroll
            for (int j = 0; j < 4; ++j) { v[j] = v[j] * gs[j];
#pragma unroll
                for (int q = 0; q < 4; ++q) { aa[0] += v[j][q] * rwa[j][q][0]; aa[1] += v[j][q] * rwa[j][q][1]; aa[2] += v[j][q] * rwa[j][q][2]; aa[3] += v[j][q] * rwa[j][q][3];
                                              aa[4] += v[j][q] * rwb[j][q][0]; aa[5] += v[j][q] * rwb[j][q][1]; aa[6] += v[j][q] * rwb[j][q][2]; aa[7] += v[j][q] * rwb[j][q][3]; } }
            float c4[4];
#pragma unroll
            for (int k = 0; k < 4; ++k) { const float keep = (lane_ & 32) ? aa[k + 4] : aa[k], give = (lane_ & 32) ? aa[k] : aa[k + 4]; c4[k] = keep + __shfl_xor(give, 32); }
            float c2[2];
#pragma unroll
            for (int k = 0; k < 2; ++k) { const float keep = (lane_ & 16) ? c4[k + 2] : c4[k], give = (lane_ & 16) ? c4[k] : c4[k + 2]; c2[k] = keep + __shfl_xor(give, 16); }
            float c1 = ((lane_ & 8) ? c2[1] : c2[0]) + __shfl_xor((lane_ & 8) ? c2[0] : c2[1], 8);
            c1 += __shfl_xor(c1, 4); c1 += __shfl_xor(c1, 2); c1 += __shfl_xor(c1, 1);
            const float r = rsqrtf(wave_sum(ss) * (1.f / DM) + EPS);
            const float mylogit = r * c1 + bsum;
#define RLF(L) __uint_as_float((unsigned)__builtin_amdgcn_readlane((int)__float_as_uint(mylogit), L))
            const float lg0 = RLF(0), lg1 = RLF(8), lg2 = RLF(16), lg3 = RLF(24), lg4 = RLF(32), lg5 = RLF(40), lg6 = RLF(48), lg7 = RLF(56);
#undef RLF
            unsigned char* hb = (unsigned char*)(p.ws + WS_HBUF) + (size_t)m * DM;
#pragma unroll
            for (int j = 0; j < 4; ++j) { const f32x4 y = v[j] * r + hs[j]; *(unsigned*)(hb + 256 * j + 4 * lane_) = pk4_fp8(y[0], y[1], y[2], y[3]); }
            int i1 = 0; float v1 = lg0;
            if (lg1 > v1) { v1 = lg1; i1 = 1; } if (lg2 > v1) { v1 = lg2; i1 = 2; } if (lg3 > v1) { v1 = lg3; i1 = 3; }
            if (lg4 > v1) { v1 = lg4; i1 = 4; } if (lg5 > v1) { v1 = lg5; i1 = 5; } if (lg6 > v1) { v1 = lg6; i1 = 6; } if (lg7 > v1) { v1 = lg7; i1 = 7; }
            int i2 = -1; float v2 = -3.4e38f;
            if (i1 != 0 && lg0 > v2) { v2 = lg0; i2 = 0; } if (i1 != 1 && lg1 > v2) { v2 = lg1; i2 = 1; } if (i1 != 2 && lg2 > v2) { v2 = lg2; i2 = 2; } if (i1 != 3 && lg3 > v2) { v2 = lg3; i2 = 3; }
            if (i1 != 4 && lg4 > v2) { v2 = lg4; i2 = 4; } if (i1 != 5 && lg5 > v2) { v2 = lg5; i2 = 5; } if (i1 != 6 && lg6 > v2) { v2 = lg6; i2 = 6; } if (i1 != 7 && lg7 > v2) { v2 = lg7; i2 = 7; }
            const float w1 = 1.f / (1.f + __expf(v2 - v1));
            if (lane_ == 0) {
                const int p1 = __hip_atomic_fetch_add(lcnt + i1, 1, __ATOMIC_RELAXED, __HIP_MEMORY_SCOPE_WORKGROUP);
                const int p2 = __hip_atomic_fetch_add(lcnt + i2, 1, __ATOMIC_RELAXED, __HIP_MEMORY_SCOPE_WORKGROUP);
                ent_e[2 * ti] = i1; ent_e[2 * ti + 1] = i2; ent_pos[2 * ti] = p1; ent_pos[2 * ti + 1] = p2;
                tok_e[2 * m] = i1; tok_e[2 * m + 1] = i2; tok_w[2 * m] = w1; tok_w[2 * m + 1] = 1.f - w1; }
        }
        __syncthreads();
        if (tid_ < 8) gbase[tid_] = (int)__hip_atomic_fetch_add(F.ctl + CW_CNT + 64 * tid_, (unsigned)lcnt[tid_], __ATOMIC_RELAXED, __HIP_MEMORY_SCOPE_AGENT);
        __syncthreads();
        if (tid_ < 128) tok_pos[ch * 128 + tid_] = gbase[ent_e[tid_]] + ent_pos[tid_];
        __syncthreads();
    }
}
__device__ __forceinline__ void moe_table(Ctx& F) {
    const int lane_ = lane_id(), tid_ = F.wave * 64 + lane_;
    volatile LAS unsigned* tb = F.MISC + 32;
    if (tid_ == 0) { unsigned acc = 0;
        for (int e = 0; e < 8; ++e) { const unsigned c = __hip_atomic_load(F.ctl + CW_CNT + 64 * e, __ATOMIC_RELAXED, __HIP_MEMORY_SCOPE_AGENT); tb[e] = acc; tb[16 + e] = c; acc += (c + 255u) / 256u * 256u; }
        tb[8] = acc; }
    __syncthreads();
}
__device__ __forceinline__ void moe_order(Ctx& F, pg8::Order& S, int nN, long estride) {
    volatile LAS unsigned* tb = F.MISC + 32;
#define RFL(x) __builtin_amdgcn_readfirstlane((int)(x))
    S.init(RFL(tb[8] / 256u), nN, F.G, (int)blockIdx.x);
    S.e1 = RFL(tb[1] / 256u); S.e2 = RFL(tb[2] / 256u); S.e3 = RFL(tb[3] / 256u); S.e4 = RFL(tb[4] / 256u); S.e5 = RFL(tb[5] / 256u); S.e6 = RFL(tb[6] / 256u); S.e7 = RFL(tb[7] / 256u);
#undef RFL
    S.estride = estride;
}
__device__ __forceinline__ void gather_phase(const Params& p, Ctx& F) {
    const int lane_ = lane_id(), tid_ = F.wave * 64 + lane_;
    moe_table(F);
    volatile LAS unsigned* tb = F.MISC + 32;
    const int* tok_e = (const int*)(p.ws + WS_ROUTE); const float* tok_w = (const float*)(p.ws + WS_ROUTE) + 2 * NL; const int* tok_pos = (const int*)(p.ws + WS_ROUTE) + 4 * NL;
    int* row_tok = (int*)(p.ws + WS_ROUTE) + 6 * NL; float* row_gate = (float*)(p.ws + WS_ROUTE) + 6 * NL + MP_MAX;
    const unsigned char* hb = (const unsigned char*)(p.ws + WS_HBUF); unsigned char* h2s = (unsigned char*)(p.ws + WS_H2S);
    for (int it = F.gw; it < 2 * NL; it += F.NGW) {
        const int t = it >> 1, e = tok_e[it], r = (int)tb[e] + tok_pos[it];
        *((v4u*)(h2s + (size_t)r * DM) + lane_) = *((const v4u*)(hb + (size_t)t * DM) + lane_);
        if (lane_ == 0) { row_tok[r] = t; row_gate[r] = tok_w[it]; }
    }
    for (int i = F.gw; i < NE * 256; i += F.NGW) {
        const int e = i >> 8, j = i & 255, r = (int)tb[e] + (int)tb[16 + e] + j;
        if (r < (int)tb[e + 1]) { const v4u z = {0u, 0u, 0u, 0u}; *((v4u*)(h2s + (size_t)r * DM) + lane_) = z; if (lane_ == 0) { row_tok[r] = -1; row_gate[r] = 0.f; } }
    }
}
__device__ __forceinline__ void combine_phase(const Params& p, Ctx& F) {
    const int lane_ = lane_id(), tid_ = F.wave * 64 + lane_;
    moe_table(F);
    volatile LAS unsigned* tb = F.MISC + 32;
    const int* tok_e = (const int*)(p.ws + WS_ROUTE); const int* tok_pos = (const int*)(p.ws + WS_ROUTE) + 4 * NL;
    const bf16_t* yb = (const bf16_t*)(p.ws + WS_YBUF);
    for (int t = F.gw; t < NL; t += F.NGW) {
        const int r0 = (int)tb[tok_e[2 * t]] + tok_pos[2 * t], r1 = (int)tb[tok_e[2 * t + 1]] + tok_pos[2 * t + 1];
        const float* g5 = modv(p, 1, t / T, 5);
        float* orow = p.out + (size_t)t * DM;
#pragma unroll
        for (int j = 0; j < 4; ++j) { const int col = 256 * j + 4 * lane_;
            const v2u a = *(const v2u*)(yb + (size_t)r0 * DM + col), b = *(const v2u*)(yb + (size_t)r1 * DM + col);
            f32x4 y; y[0] = __uint_as_float(a.x << 16) + __uint_as_float(b.x << 16); y[1] = __uint_as_float(a.x & 0xffff0000u) + __uint_as_float(b.x & 0xffff0000u);
            y[2] = __uint_as_float(a.y << 16) + __uint_as_float(b.y << 16); y[3] = __uint_as_float(a.y & 0xffff0000u) + __uint_as_float(b.y & 0xffff0000u);
            const f32x4 x = *(const f32x4*)(orow + col), gg = *(const f32x4*)(g5 + col);
            *(f32x4*)(orow + col) = x + gg * y; }
    }
}

namespace att {
constexpr float THR = 8.f;
constexpr int KVBLK = 64;
constexpr int SHM_V = KVBLK * 128 * 2, SHM_K = KVBLK * 128 * 2;
using bf16x8 = __attribute__((ext_vector_type(8))) short;
using s16x4  = __attribute__((ext_vector_type(4))) short;
using f32x16 = __attribute__((ext_vector_type(16))) float;
using f32x8  = __attribute__((ext_vector_type(8))) float;
using u32x4  = __attribute__((ext_vector_type(4))) unsigned;
using f32x4v = __attribute__((ext_vector_type(4))) float;
#define KSWZ(row, colB) ((row) * 256 + ((colB) ^ (((row) & 7) << 4)))
#define SBAR() __builtin_amdgcn_sched_barrier(0)
__device__ __forceinline__ int crow(int r, int hi) { return (r & 3) + 8 * (r >> 2) + 4 * hi; }
__device__ __forceinline__ unsigned cvtpk(float lo, float hi) {
  unsigned r; asm volatile("v_cvt_pk_bf16_f32 %0, %1, %2" : "=v"(r) : "v"(lo), "v"(hi)); return r;
}
__device__ __forceinline__ void partialSM(f32x16& p0, f32x16& p1, float& m_reg, float& mn, float& alpha) {
  constexpr float C = 1.4426950408889634f;
  float pmax = p0[0]; for (int r = 1; r < 16; ++r) pmax = fmaxf(pmax, p0[r]); for (int r = 0; r < 16; ++r) pmax = fmaxf(pmax, p1[r]);
  { auto rr = __builtin_amdgcn_permlane32_swap(__float_as_uint(pmax), __float_as_uint(pmax), false, false);
    pmax = fmaxf(__uint_as_float(rr[0]), __uint_as_float(rr[1])); }
  if (__builtin_expect(__all(pmax - m_reg <= THR), 1)) { mn = m_reg; alpha = 1.f; }
  else { mn = fmaxf(m_reg, pmax); alpha = __builtin_amdgcn_exp2f((m_reg - mn) * C); m_reg = mn; }
  float mnC = -mn * C;
  for (int r = 0; r < 16; ++r) p0[r] = fmaf(p0[r], C, mnC); for (int r = 0; r < 16; ++r) p1[r] = fmaf(p1[r], C, mnC);
  for (int r = 0; r < 16; ++r) p0[r] = __builtin_amdgcn_exp2f(p0[r]);
}
__device__ __forceinline__ void finishSM(f32x16& p0, f32x16& p1, float alpha, float& l_reg, bf16x8& pa0, bf16x8& pa1, bf16x8& pa2, bf16x8& pa3) {
  for (int r = 0; r < 16; ++r) p1[r] = __builtin_amdgcn_exp2f(p1[r]);
  float ps = 0; for (int r = 0; r < 16; ++r) ps += p0[r]; for (int r = 0; r < 16; ++r) ps += p1[r];
  { auto rr = __builtin_amdgcn_permlane32_swap(__float_as_uint(ps), __float_as_uint(ps), false, false);
    ps = __uint_as_float(rr[0]) + __uint_as_float(rr[1]); }
  l_reg = l_reg * alpha + ps;
#define PK4(P, BASE, OUT) do { unsigned a0 = cvtpk(P[BASE + 0], P[BASE + 1]), a1 = cvtpk(P[BASE + 2], P[BASE + 3]);   \
    unsigned b0 = cvtpk(P[BASE + 4], P[BASE + 5]), b1 = cvtpk(P[BASE + 6], P[BASE + 7]);                              \
    auto r0 = __builtin_amdgcn_permlane32_swap(a0, b0, false, false); auto r1 = __builtin_amdgcn_permlane32_swap(a1, b1, false, false); \
    u32x4 w = {r0[0], r1[0], r0[1], r1[1]}; OUT = *reinterpret_cast<bf16x8*>(&w); } while (0)
  PK4(p0, 0, pa0); PK4(p0, 8, pa1); PK4(p1, 0, pa2); PK4(p1, 8, pa3);
#undef PK4
}
template <int ND0>
__device__ __forceinline__ void qkt(f32x16& p0, f32x16& p1, const LAS char* Ks, const bf16x8* qr, int r32, int hi, int dbase) {
  p0 = f32x16{}; p1 = f32x16{};
#pragma unroll
  for (int d0 = 0; d0 < ND0; ++d0) { int cb = ((dbase + d0) * 16 + hi * 8) * 2;
    bf16x8 b0 = *reinterpret_cast<const LAS bf16x8*>(Ks + KSWZ(r32, cb));
    bf16x8 b1 = *reinterpret_cast<const LAS bf16x8*>(Ks + KSWZ(32 + r32, cb));
    p0 = __builtin_amdgcn_mfma_f32_32x32x16_bf16(b0, qr[d0], p0, 0, 0, 0);
    p1 = __builtin_amdgcn_mfma_f32_32x32x16_bf16(b1, qr[d0], p1, 0, 0, 0); }
}
__device__ __forceinline__ int v_st(int k, int c) { const int kk = (k & ~0xC) | ((k & 4) << 1) | ((k & 8) >> 1); return ((kk >> 3) * 4 + (c >> 5)) * 512 + ((kk & 7) * 32 + (c & 31)) * 2; }
__device__ __forceinline__ int v_st_lin(int k, int c) { return ((k >> 3) * 4 + (c >> 5)) * 512 + ((k & 7) * 32 + (c & 31)) * 2; }
__device__ __forceinline__ int v_rd_base(int lane) { return ((lane & 3) << 3) | (((lane >> 2) & 3) << 6) | (((lane >> 4) & 1) << 5) | (((lane >> 5) & 1) << 8); }
constexpr int v_rd_off(int d0, int ks, int half) { return d0 * 512 + ks * 4096 + half * 2048; }
template <int OFF> __device__ __forceinline__ s16x4 tr_read(int vb) {
  s16x4 r; asm volatile("ds_read_b64_tr_b16 %0, %1 offset:%2" : "=&v"(r) : "v"(vb), "i"(OFF) : "memory"); return r;
}
template <int D0> __device__ __forceinline__ void pv_one(f32x16& od, int vb, bf16x8 pa0, bf16x8 pa1, bf16x8 pa2, bf16x8 pa3) {
  const s16x4 l0 = tr_read<v_rd_off(D0, 0, 0)>(vb), h0 = tr_read<v_rd_off(D0, 0, 1)>(vb), l1 = tr_read<v_rd_off(D0, 1, 0)>(vb), h1 = tr_read<v_rd_off(D0, 1, 1)>(vb);
  const s16x4 l2 = tr_read<v_rd_off(D0, 2, 0)>(vb), h2 = tr_read<v_rd_off(D0, 2, 1)>(vb), l3 = tr_read<v_rd_off(D0, 3, 0)>(vb), h3 = tr_read<v_rd_off(D0, 3, 1)>(vb);
#if defined(DUMMY_TR) && DUMMY_TR
  { s16x4 dd; for (int i = 0; i < DUMMY_TR; ++i) asm volatile("ds_read_b64_tr_b16 %0, %1 offset:%2" : "=&v"(dd) : "v"(vb), "i"(v_rd_off(D0, 0, 0)) : "memory"); }
#endif
#if defined(DUMMY_MFMA) && DUMMY_MFMA
  { f32x4v dm = {0.f, 0.f, 0.f, 0.f}; for (int i = 0; i < DUMMY_MFMA; ++i) asm volatile("v_mfma_f32_16x16x32_bf16 %0, %1, %2, %0" : "+v"(dm) : "v"(pa0), "v"(pa1)); }
#endif
  asm volatile("s_waitcnt lgkmcnt(0)" ::: "memory"); SBAR();
#define PK(L, H) (bf16x8){L[0], L[1], L[2], L[3], H[0], H[1], H[2], H[3]}
  od = __builtin_amdgcn_mfma_f32_32x32x16_bf16(pa0, PK(l0, h0), od, 0, 0, 0);
  od = __builtin_amdgcn_mfma_f32_32x32x16_bf16(pa1, PK(l1, h1), od, 0, 0, 0);
  od = __builtin_amdgcn_mfma_f32_32x32x16_bf16(pa2, PK(l2, h2), od, 0, 0, 0);
  od = __builtin_amdgcn_mfma_f32_32x32x16_bf16(pa3, PK(l3, h3), od, 0, 0, 0);
#undef PK
}
__device__ __forceinline__ void pv_d0(f32x16* o, int vb, bf16x8 pa0, bf16x8 pa1, bf16x8 pa2, bf16x8 pa3) {
  pv_one<0>(o[0], vb, pa0, pa1, pa2, pa3); pv_one<1>(o[1], vb, pa0, pa1, pa2, pa3); pv_one<2>(o[2], vb, pa0, pa1, pa2, pa3); pv_one<3>(o[3], vb, pa0, pa1, pa2, pa3);
}

#ifndef DUMMY_EXP
#define DUMMY_EXP 0
#endif
#ifndef DUMMY_TR
#define DUMMY_TR 0
#endif
#ifndef DUMMY_MFMA
#define DUMMY_MFMA 0
#endif
__device__ __forceinline__ void dummy_exp(float x) { float d; for (int i = 0; i < DUMMY_EXP; ++i) asm volatile("v_exp_f32 %0, %1" : "=v"(d) : "v"(x)); }
__device__ __forceinline__ void expA(f32x16& p0) {
#pragma unroll
  for (int r = 0; r < 16; ++r) { dummy_exp(p0[r]); p0[r] = __builtin_amdgcn_exp2f(p0[r]); }
}
__device__ __forceinline__ void expB_sum_pack(f32x16& p0, f32x16& p1, float& l_reg, bf16x8& pa0, bf16x8& pa1, bf16x8& pa2, bf16x8& pa3) {
#pragma unroll
  for (int r = 0; r < 16; ++r) { dummy_exp(p1[r]); p1[r] = __builtin_amdgcn_exp2f(p1[r]); }
  float ps = 0;
#pragma unroll
  for (int r = 0; r < 16; ++r) ps += p0[r];
#pragma unroll
  for (int r = 0; r < 16; ++r) ps += p1[r];
  { auto rr = __builtin_amdgcn_permlane32_swap(__float_as_uint(ps), __float_as_uint(ps), false, false);
    ps = __uint_as_float(rr[0]) + __uint_as_float(rr[1]); }
  l_reg += ps;
#define PK4(P, BASE, OUT) do { unsigned a0 = cvtpk(P[BASE + 0], P[BASE + 1]), a1 = cvtpk(P[BASE + 2], P[BASE + 3]);   \
    unsigned b0 = cvtpk(P[BASE + 4], P[BASE + 5]), b1 = cvtpk(P[BASE + 6], P[BASE + 7]);                              \
    auto r0 = __builtin_amdgcn_permlane32_swap(a0, b0, false, false); auto r1 = __builtin_amdgcn_permlane32_swap(a1, b1, false, false); \
    u32x4 w = {r0[0], r1[0], r0[1], r1[1]}; OUT = *reinterpret_cast<bf16x8*>(&w); } while (0)
  PK4(p0, 0, pa0); PK4(p0, 8, pa1); PK4(p1, 0, pa2); PK4(p1, 8, pa3);
#undef PK4
}
__device__ __forceinline__ bf16x8 ld8(const bf16_t* p) { return *reinterpret_cast<const bf16x8*>(p); }

constexpr int TP = 132;
__device__ __forceinline__ void tile_to_rows(const f32x16 (&o)[4], LAS float* scr, int r32, int hi, float (&v)[64]) {
#pragma unroll
  for (int d0 = 0; d0 < 4; ++d0)
#pragma unroll
    for (int r = 0; r < 16; ++r) scr[crow(r, hi) * TP + 32 * d0 + r32] = o[d0][r];
  asm volatile("s_waitcnt lgkmcnt(0)" ::: "memory");
#pragma unroll
  for (int i = 0; i < 16; ++i) { const f32x4v t = *(const LAS f32x4v*)(scr + r32 * TP + 64 * hi + 4 * i); v[4 * i] = t[0]; v[4 * i + 1] = t[1]; v[4 * i + 2] = t[2]; v[4 * i + 3] = t[3]; }
}
__device__ __forceinline__ float pair_sum(float x) {
  auto rr = __builtin_amdgcn_permlane32_swap(__float_as_uint(x), __float_as_uint(x), false, false); return __uint_as_float(rr[0]) + __uint_as_float(rr[1]);
}


#define PVX_RD2(L0, H0, D0, KS) do { L0 = tr_read<v_rd_off(D0, KS, 0)>(vb); H0 = tr_read<v_rd_off(D0, KS, 1)>(vb); } while (0)
#define PVX_PK(L, H) (bf16x8){L[0], L[1], L[2], L[3], H[0], H[1], H[2], H[3]}
#define PVX_E(i) do { if (DOEXP) { pn[i] = __builtin_amdgcn_exp2f(pn[i]); psn += pn[i]; } } while (0)
#define PVX_W(n) asm volatile("s_waitcnt lgkmcnt(" #n ")" ::: "memory")
#define PVX_BLOCK(D0, E0) do { \
    PVX_W(6); SBAR(); o[D0] = __builtin_amdgcn_mfma_f32_32x32x16_bf16(pa0, PVX_PK(fl0, fh0), o[D0], 0, 0, 0); PVX_E(E0 + 0); PVX_RD2(fl0, fh0, D0 + 1, 0); SBAR(); \
    PVX_W(6); SBAR(); o[D0] = __builtin_amdgcn_mfma_f32_32x32x16_bf16(pa1, PVX_PK(fl1, fh1), o[D0], 0, 0, 0); PVX_E(E0 + 1); PVX_RD2(fl1, fh1, D0 + 1, 1); SBAR(); \
    PVX_W(6); SBAR(); o[D0] = __builtin_amdgcn_mfma_f32_32x32x16_bf16(pa2, PVX_PK(fl2, fh2), o[D0], 0, 0, 0); PVX_E(E0 + 2); PVX_RD2(fl2, fh2, D0 + 1, 2); SBAR(); \
    PVX_W(6); SBAR(); o[D0] = __builtin_amdgcn_mfma_f32_32x32x16_bf16(pa3, PVX_PK(fl3, fh3), o[D0], 0, 0, 0); PVX_E(E0 + 3); PVX_RD2(fl3, fh3, D0 + 1, 3); SBAR(); } while (0)
template <bool DOEXP>
__device__ __forceinline__ void pv_exp(f32x16* o, int vb, bf16x8 pa0, bf16x8 pa1, bf16x8 pa2, bf16x8 pa3, f32x16& pn, float& psn) {
  s16x4 fl0, fh0, fl1, fh1, fl2, fh2, fl3, fh3;
  asm volatile("s_waitcnt lgkmcnt(0)" ::: "memory");
  PVX_RD2(fl0, fh0, 0, 0); PVX_RD2(fl1, fh1, 0, 1); PVX_RD2(fl2, fh2, 0, 2); PVX_RD2(fl3, fh3, 0, 3);
  PVX_BLOCK(0, 0); PVX_BLOCK(1, 4); PVX_BLOCK(2, 8);
  PVX_W(6); SBAR(); o[3] = __builtin_amdgcn_mfma_f32_32x32x16_bf16(pa0, PVX_PK(fl0, fh0), o[3], 0, 0, 0); PVX_E(12); SBAR();
  PVX_W(4); SBAR(); o[3] = __builtin_amdgcn_mfma_f32_32x32x16_bf16(pa1, PVX_PK(fl1, fh1), o[3], 0, 0, 0); PVX_E(13); SBAR();
  PVX_W(2); SBAR(); o[3] = __builtin_amdgcn_mfma_f32_32x32x16_bf16(pa2, PVX_PK(fl2, fh2), o[3], 0, 0, 0); PVX_E(14); SBAR();
  PVX_W(0); SBAR(); o[3] = __builtin_amdgcn_mfma_f32_32x32x16_bf16(pa3, PVX_PK(fl3, fh3), o[3], 0, 0, 0); PVX_E(15); SBAR();
}
__device__ __forceinline__ void expB_sum_pack2(f32x16& p0, f32x16& p1, float ps, float& l_reg, bf16x8& pa0, bf16x8& pa1, bf16x8& pa2, bf16x8& pa3) {
#pragma unroll
  for (int r = 0; r < 16; ++r) { p1[r] = __builtin_amdgcn_exp2f(p1[r]); ps += p1[r]; }
  { auto rr = __builtin_amdgcn_permlane32_swap(__float_as_uint(ps), __float_as_uint(ps), false, false);
    ps = __uint_as_float(rr[0]) + __uint_as_float(rr[1]); }
  l_reg += ps;
#define PK4(P, BASE, OUT) do { unsigned a0 = cvtpk(P[BASE + 0], P[BASE + 1]), a1 = cvtpk(P[BASE + 2], P[BASE + 3]);   \
    unsigned b0 = cvtpk(P[BASE + 4], P[BASE + 5]), b1 = cvtpk(P[BASE + 6], P[BASE + 7]);                              \
    auto r0 = __builtin_amdgcn_permlane32_swap(a0, b0, false, false); auto r1 = __builtin_amdgcn_permlane32_swap(a1, b1, false, false); \
    u32x4 w = {r0[0], r1[0], r0[1], r1[1]}; OUT = *reinterpret_cast<bf16x8*>(&w); } while (0)
  PK4(p0, 0, pa0); PK4(p0, 8, pa1); PK4(p1, 0, pa2); PK4(p1, 8, pa3);
#undef PK4
}
__device__ __forceinline__ float exp_sum16(f32x16& p0) { float ps = 0.f;
#pragma unroll
  for (int r = 0; r < 16; ++r) { p0[r] = __builtin_amdgcn_exp2f(p0[r]); ps += p0[r]; }
  return ps; }

__device__ __forceinline__ void attn_unit(const int wid, const bf16_t* __restrict__ proj, const char* __restrict__ Kt_bh, const char* __restrict__ Vt_bh, bf16_t* __restrict__ concat, int qrow0, int NT, int h,
                                          LAS char* lds, float lam, float omli, const float* __restrict__ subln) {
  const int lane = lane_id(), tid = wid * 64 + lane, r32 = lane & 31, hi = lane >> 5, rg = wid & 3, c = wid >> 2;
  LAS char* V_lds = lds; LAS char* K_lds = lds + 4 * SHM_V;
  LAS float* li_l = (LAS float*)(lds + 4 * SHM_V + 4 * SHM_K) + wid * 64;
  float l_reg = 0; f32x16 o[4] = {}; bf16x8 qr[4];
  const bf16_t* Qw = proj + (size_t)(qrow0 + rg * 32 + r32) * DP + C_DQ + h * 128 + c * 64 + hi * 8;
#pragma unroll
  for (int d0 = 0; d0 < 4; ++d0) qr[d0] = ld8(Qw + d0 * 16);
  const int vb0 = (int)(uintptr_t)V_lds + v_rd_base(lane);
  const char* kg0 = Kt_bh + wid * 2048 + lane * 16; const char* vg0 = Vt_bh + wid * 2048 + lane * 16;
#define DMA_TILE(tile, slot) do { const size_t to_ = (size_t)(tile) * 16384; \
    __builtin_amdgcn_global_load_lds((const unsigned*)(kg0 + to_), (LAS unsigned*)(K_lds + (slot) * SHM_K + wid * 2048), 16, 0, 0); \
    __builtin_amdgcn_global_load_lds((const unsigned*)(kg0 + to_ + 1024), (LAS unsigned*)(K_lds + (slot) * SHM_K + wid * 2048 + 1024), 16, 0, 0); \
    __builtin_amdgcn_global_load_lds((const unsigned*)(vg0 + to_), (LAS unsigned*)(V_lds + (slot) * SHM_V + wid * 2048), 16, 0, 0); \
    __builtin_amdgcn_global_load_lds((const unsigned*)(vg0 + to_ + 1024), (LAS unsigned*)(V_lds + (slot) * SHM_V + wid * 2048 + 1024), 16, 0, 0); } while (0)
#define BAR() do { asm volatile("s_waitcnt vmcnt(0) lgkmcnt(0)" ::: "memory"); __builtin_amdgcn_s_barrier(); asm volatile("" ::: "memory"); } while (0)
#define STAGE(b) do { if ((b) + 3 < NT) DMA_TILE((b) + 3, ((b) + 3) & 3); } while (0)
#define STAGES(b, slot) do { if ((b) + 3 < NT) DMA_TILE((b) + 3, slot); } while (0)
#define QKT(P0, P1, t) qkt<4>(P0, P1, K_lds + ((t) & 3) * SHM_K, qr, r32, hi, 4 * c)
#define QKTS(P0, P1, slot) qkt<4>(P0, P1, K_lds + (slot) * SHM_K, qr, r32, hi, 4 * c)
#define PV(t) pv_d0(o, vb0 + ((t) & 3) * SHM_V, pa0, pa1, pa2, pa3)
  f32x16 pA0, pA1, pB0, pB1; bf16x8 pa0, pa1, pa2, pa3; float psA = 0.f, psB = 0.f;
#define PVE(t, PN, PSN) do { PSN = 0.f; pv_exp<true>(o, vb0 + ((t) & 3) * SHM_V, pa0, pa1, pa2, pa3, PN, PSN); } while (0)
#define PVES(slot, PN, PSN) do { PSN = 0.f; pv_exp<true>(o, vb0 + (slot) * SHM_V, pa0, pa1, pa2, pa3, PN, PSN); } while (0)
#define PVL(t) do { float d_ = 0.f; pv_exp<false>(o, vb0 + ((t) & 3) * SHM_V, pa0, pa1, pa2, pa3, pA0, d_); } while (0)
  DMA_TILE(0, 0); DMA_TILE(1, 1); DMA_TILE(2, 2);
  BAR();
  QKT(pA0, pA1, 0); psA = exp_sum16(pA0);
  for (int t = 0; t < NT; t += 4) {
    if (c == 0) { BAR(); STAGES(t, 3); } SBAR();
    QKTS(pB0, pB1, 1); expB_sum_pack2(pA0, pA1, psA, l_reg, pa0, pa1, pa2, pa3); SBAR();
    if (c == 1) { BAR(); STAGES(t, 3); } SBAR();
    PVES(0, pB0, psB); SBAR();
    if (c == 0) { BAR(); STAGES(t + 1, 0); } SBAR();
    QKTS(pA0, pA1, 2); expB_sum_pack2(pB0, pB1, psB, l_reg, pa0, pa1, pa2, pa3); SBAR();
    if (c == 1) { BAR(); STAGES(t + 1, 0); } SBAR();
    PVES(1, pA0, psA); SBAR();
    if (c == 0) { BAR(); STAGES(t + 2, 1); } SBAR();
    QKTS(pB0, pB1, 3); expB_sum_pack2(pA0, pA1, psA, l_reg, pa0, pa1, pa2, pa3); SBAR();
    if (c == 1) { BAR(); STAGES(t + 2, 1); } SBAR();
    PVES(2, pB0, psB); SBAR();
    if (c == 0) { BAR(); STAGES(t + 3, 2); } SBAR();
    if (t + 4 < NT) QKTS(pA0, pA1, 0);
    expB_sum_pack2(pB0, pB1, psB, l_reg, pa0, pa1, pa2, pa3); SBAR();
    if (c == 1) { BAR(); STAGES(t + 3, 2); } SBAR();
    PVES(3, pA0, psA);
    SBAR();
  }
#undef PVE
#undef PVES
#undef QKTS
#undef STAGES
#undef PVL
  if (hi == 0) li_l[r32] = l_reg; asm volatile("s_waitcnt lgkmcnt(0)" ::: "memory");
#pragma unroll
  for (int r = 0; r < 16; ++r) { const float rl = __builtin_amdgcn_rcpf(li_l[crow(r, hi)]);
#pragma unroll
    for (int d0 = 0; d0 < 4; ++d0) o[d0][r] *= rl; }
  __syncthreads();
  LAS float* xch = (LAS float*)lds + rg * 4096;
  if (c == 1) {
#pragma unroll
    for (int d0 = 0; d0 < 4; ++d0)
#pragma unroll
      for (int r = 0; r < 16; ++r) xch[(d0 * 16 + r) * 64 + lane] = o[d0][r];
  }
  __syncthreads();
  if (c == 0) {
#pragma unroll
    for (int r = 0; r < 16; ++r) { float s = 0.f;
#pragma unroll
      for (int d0 = 0; d0 < 4; ++d0) { const float d = o[d0][r] - lam * xch[(d0 * 16 + r) * 64 + lane]; o[d0][r] = d; s += d * d; }
      s += __shfl_xor(s, 1); s += __shfl_xor(s, 2); s += __shfl_xor(s, 4); s += __shfl_xor(s, 8); s += __shfl_xor(s, 16);
      const float rr = rsqrtf(s * (1.f / 128.f) + EPS) * omli;
      bf16_t* orow = concat + (size_t)(qrow0 + rg * 32 + crow(r, hi)) * DM + 512 + h * 128 + r32;
#pragma unroll
      for (int d0 = 0; d0 < 4; ++d0) orow[d0 * 32] = f2bf(o[d0][r] * rr * subln[d0 * 32 + r32]); }
  }
  __syncthreads();
#undef DMA_TILE
#undef BAR
#undef STAGE
#undef QKT
#undef PV
}


typedef float f32x2 __attribute__((ext_vector_type(2)));
__device__ __forceinline__ void exp_half(f32x16& ph, f32x2& lacc) {
#pragma unroll
  for (int r = 0; r < 16; r += 2) { ph[r] = __builtin_amdgcn_exp2f(ph[r]); ph[r + 1] = __builtin_amdgcn_exp2f(ph[r + 1]); const f32x2 e = {ph[r], ph[r + 1]}; lacc += e; }
}
__device__ __forceinline__ void pack_half(const f32x16& ph, bf16x8& x0, bf16x8& x1) {
  { u32x4 w = {cvtpk(ph[0], ph[1]), cvtpk(ph[2], ph[3]), cvtpk(ph[4], ph[5]), cvtpk(ph[6], ph[7])}; x0 = *reinterpret_cast<bf16x8*>(&w); }
  { u32x4 w = {cvtpk(ph[8], ph[9]), cvtpk(ph[10], ph[11]), cvtpk(ph[12], ph[13]), cvtpk(ph[14], ph[15])}; x1 = *reinterpret_cast<bf16x8*>(&w); }
}

template <int D0> __device__ __forceinline__ void pv2_block(f32x16& oa, f32x16& ob, int vb, s16x4& fl0, s16x4& fh0, s16x4& fl1, s16x4& fh1, s16x4& fl2, s16x4& fh2, s16x4& fl3, s16x4& fh3,
                                                           bf16x8 a0, bf16x8 a1, bf16x8 a2, bf16x8 a3, bf16x8 b0, bf16x8 b1, bf16x8 b2, bf16x8 b3) {
#define PV2_STEP(A, B, FL, FH, KS, WN) do { asm volatile("s_waitcnt lgkmcnt(" #WN ")" ::: "memory"); SBAR(); \
    oa = __builtin_amdgcn_mfma_f32_32x32x16_bf16(A, PVX_PK(FL, FH), oa, 0, 0, 0); ob = __builtin_amdgcn_mfma_f32_32x32x16_bf16(B, PVX_PK(FL, FH), ob, 0, 0, 0); \
    if (D0 < 3) { FL = tr_read<v_rd_off((D0 + 1) & 3, KS, 0)>(vb); FH = tr_read<v_rd_off((D0 + 1) & 3, KS, 1)>(vb); } SBAR(); } while (0)
  if (D0 < 3) { PV2_STEP(a0, b0, fl0, fh0, 0, 6); PV2_STEP(a1, b1, fl1, fh1, 1, 6); PV2_STEP(a2, b2, fl2, fh2, 2, 6); PV2_STEP(a3, b3, fl3, fh3, 3, 6); }
  else        { PV2_STEP(a0, b0, fl0, fh0, 0, 6); PV2_STEP(a1, b1, fl1, fh1, 1, 4); PV2_STEP(a2, b2, fl2, fh2, 2, 2); PV2_STEP(a3, b3, fl3, fh3, 3, 0); }
#undef PV2_STEP
}
__device__ __forceinline__ void attn_unit3p(const int wid, const bf16_t* __restrict__ proj, const char* __restrict__ Kt_bh, const char* __restrict__ Vt_bh, bf16_t* __restrict__ concat, int qrow0, int NT, int h,
                                            LAS char* lds, float lam, float omli, const float* __restrict__ subln) {
  const int lane = lane_id(), r32 = lane & 31, hi = lane >> 5;
  LAS char* V_lds = lds; LAS char* K_lds = lds + 2 * SHM_V; LAS char* Qw = lds + 65536 + wid * 8192;
  LAS float* li_l = (LAS float*)(lds + 131072) + wid * 64;
  f32x2 l0v = {0.f, 0.f}, l1v = {0.f, 0.f}; f32x16 o0[4] = {}, o1[4] = {};
  const int vb0 = (int)(uintptr_t)V_lds + v_rd_base(lane);
  const char* kg0 = Kt_bh + wid * 2048 + lane * 16; const char* vg0 = Vt_bh + wid * 2048 + lane * 16;
#define DMA_TILE(tile, slot) do { const size_t to_ = (size_t)(tile) * 16384; \
    __builtin_amdgcn_global_load_lds((const unsigned*)(kg0 + to_), (LAS unsigned*)(K_lds + (slot) * SHM_K + wid * 2048), 16, 0, 0); \
    __builtin_amdgcn_global_load_lds((const unsigned*)(kg0 + to_ + 1024), (LAS unsigned*)(K_lds + (slot) * SHM_K + wid * 2048 + 1024), 16, 0, 0); \
    __builtin_amdgcn_global_load_lds((const unsigned*)(vg0 + to_), (LAS unsigned*)(V_lds + (slot) * SHM_V + wid * 2048), 16, 0, 0); \
    __builtin_amdgcn_global_load_lds((const unsigned*)(vg0 + to_ + 1024), (LAS unsigned*)(V_lds + (slot) * SHM_V + wid * 2048 + 1024), 16, 0, 0); } while (0)
#define BAR() do { asm volatile("s_waitcnt vmcnt(0) lgkmcnt(0)" ::: "memory"); __builtin_amdgcn_s_barrier(); asm volatile("" ::: "memory"); } while (0)
  bf16x8 qf00, qf01, qf02, qf03, qf10, qf11, qf12, qf13;
  { const bf16_t* qg = proj + (size_t)(qrow0 + wid * 32 + r32) * DP + C_DQ + h * 128 + hi * 8;
    qf00 = ld8(qg); qf01 = ld8(qg + 16); qf02 = ld8(qg + 32); qf03 = ld8(qg + 48); qf10 = ld8(qg + 64); qf11 = ld8(qg + 80); qf12 = ld8(qg + 96); qf13 = ld8(qg + 112); }
  DMA_TILE(0, 0);
  bf16x8 a0, a1, a2, a3, b0, b1, b2, b3;
  int sw0 = KSWZ(r32, (0 * 16 + hi * 8) * 2), sw1 = KSWZ(r32, (1 * 16 + hi * 8) * 2), sw2 = KSWZ(r32, (2 * 16 + hi * 8) * 2), sw3 = KSWZ(r32, (3 * 16 + hi * 8) * 2);
  int kad0_ = (int)(uintptr_t)K_lds + sw0, kad1_ = (int)(uintptr_t)K_lds + sw1, kad2_ = (int)(uintptr_t)K_lds + sw2, kad3_ = (int)(uintptr_t)K_lds + sw3;
  asm volatile("" : "+v"(kad0_), "+v"(kad1_), "+v"(kad2_), "+v"(kad3_));
  LAS char* const kad0 = (LAS char*)(uintptr_t)kad0_; LAS char* const kad1 = (LAS char*)(uintptr_t)kad1_; LAS char* const kad2 = (LAS char*)(uintptr_t)kad2_; LAS char* const kad3 = (LAS char*)(uintptr_t)kad3_;
#define QK2(P0, P1, so, cc) do { P0 = f32x16{}; P1 = f32x16{}; _Pragma("unroll") for (int d0 = 0; d0 < 4; ++d0) { const int cb = ((4 * (cc) + d0) * 16 + hi * 8) * 2; \
    const bf16x8 ka_ = *reinterpret_cast<const LAS bf16x8*>(K_lds + (so) * SHM_K + KSWZ(r32, cb)), kb_ = *reinterpret_cast<const LAS bf16x8*>(K_lds + (so) * SHM_K + KSWZ(32 + r32, cb)); \
    const bf16x8 q_ = *reinterpret_cast<const LAS bf16x8*>(Qw + KSWZ(r32, cb)); \
    P0 = __builtin_amdgcn_mfma_f32_32x32x16_bf16(ka_, q_, P0, 0, 0, 0); P1 = __builtin_amdgcn_mfma_f32_32x32x16_bf16(kb_, q_, P1, 0, 0, 0); } } while (0)
#define QKA(PH, so, cc, koff) do { PH = f32x16{}; \
    { const bf16x8 k_ = *reinterpret_cast<const LAS bf16x8*>(kad0 + ((so) * SHM_K + (koff) * 256 + 128 * (cc))); PH = __builtin_amdgcn_mfma_f32_32x32x16_bf16(k_, (cc) ? qf10 : qf00, PH, 0, 0, 0); } \
    { const bf16x8 k_ = *reinterpret_cast<const LAS bf16x8*>(kad1 + ((so) * SHM_K + (koff) * 256 + 128 * (cc))); PH = __builtin_amdgcn_mfma_f32_32x32x16_bf16(k_, (cc) ? qf11 : qf01, PH, 0, 0, 0); } } while (0)
#define QKB(PH, so, cc, koff) do { \
    { const bf16x8 k_ = *reinterpret_cast<const LAS bf16x8*>(kad2 + ((so) * SHM_K + (koff) * 256 + 128 * (cc))); PH = __builtin_amdgcn_mfma_f32_32x32x16_bf16(k_, (cc) ? qf12 : qf02, PH, 0, 0, 0); } \
    { const bf16x8 k_ = *reinterpret_cast<const LAS bf16x8*>(kad3 + ((so) * SHM_K + (koff) * 256 + 128 * (cc))); PH = __builtin_amdgcn_mfma_f32_32x32x16_bf16(k_, (cc) ? qf13 : qf03, PH, 0, 0, 0); } } while (0)
#define QKH(PH, so, cc, koff) do { QKA(PH, so, cc, koff); QKB(PH, so, cc, koff); } while (0)
#define SGB(m, n) __builtin_amdgcn_sched_group_barrier(m, n, 0)
#define STEP(PN, so, cc, koff, PO, LV, X0, X1) do { \
    QKA(PN, so, cc, koff); exp_half(PO, LV); SGB(0x100, 2); SGB(0x8, 1); SGB(0x2, 12); SGB(0x8, 1); SGB(0x2, 12); SBAR(); asm volatile("" : "+v"(LV)); SBAR(); \
    QKB(PN, so, cc, koff); pack_half(PO, X0, X1); SGB(0x100, 2); SGB(0x8, 1); SGB(0x2, 4); SGB(0x8, 1); SGB(0x2, 4); MBAR(PN); } while (0)
#define MBAR(X) do { SBAR(); asm volatile("" : "+v"(X) :: "memory"); SBAR(); } while (0)
#define TILE(t, so) do { BAR(); if ((t) + 1 < NT) DMA_TILE((t) + 1, 1 - (so)); SBAR(); \
    { f32x16 p0, p1; \
      QKH(p0, so, 0, 0); MBAR(p0); \
      STEP(p1, so, 0, 32, p0, l0v, a0, a1); \
      STEP(p0, so, 1, 0, p1, l0v, a2, a3); \
      STEP(p1, so, 1, 32, p0, l1v, b0, b1); \
      exp_half(p1, l1v); SBAR(); asm volatile("" : "+v"(l1v)); SBAR(); pack_half(p1, b2, b3); } SBAR(); \
    { const int vb = vb0 + (so) * SHM_V; s16x4 fl0, fh0, fl1, fh1, fl2, fh2, fl3, fh3; \
      asm volatile("s_waitcnt lgkmcnt(0)" ::: "memory"); \
      PVX_RD2(fl0, fh0, 0, 0); PVX_RD2(fl1, fh1, 0, 1); PVX_RD2(fl2, fh2, 0, 2); PVX_RD2(fl3, fh3, 0, 3); \
      pv2_block<0>(o0[0], o1[0], vb, fl0, fh0, fl1, fh1, fl2, fh2, fl3, fh3, a0, a1, a2, a3, b0, b1, b2, b3); \
      pv2_block<1>(o0[1], o1[1], vb, fl0, fh0, fl1, fh1, fl2, fh2, fl3, fh3, a0, a1, a2, a3, b0, b1, b2, b3); \
      pv2_block<2>(o0[2], o1[2], vb, fl0, fh0, fl1, fh1, fl2, fh2, fl3, fh3, a0, a1, a2, a3, b0, b1, b2, b3); \
      pv2_block<3>(o0[3], o1[3], vb, fl0, fh0, fl1, fh1, fl2, fh2, fl3, fh3, a0, a1, a2, a3, b0, b1, b2, b3); } SBAR(); } while (0)
  for (int t = 0; t < NT; t += 2) { TILE(t, 0); TILE(t + 1, 1); }
  const float l0 = pair_sum(l0v[0] + l0v[1]), l1 = pair_sum(l1v[0] + l1v[1]);
  if (hi == 0) { li_l[r32] = l0; li_l[32 + r32] = l1; } asm volatile("s_waitcnt lgkmcnt(0)" ::: "memory");
#pragma unroll
  for (int r = 0; r < 16; ++r) { const float ra = __builtin_amdgcn_rcpf(li_l[crow(r, hi)]), rb = lam * __builtin_amdgcn_rcpf(li_l[32 + crow(r, hi)]);
    float s = 0.f;
#pragma unroll
    for (int d0 = 0; d0 < 4; ++d0) { const float d = o0[d0][r] * ra - o1[d0][r] * rb; o0[d0][r] = d; s += d * d; }
    s += __shfl_xor(s, 1); s += __shfl_xor(s, 2); s += __shfl_xor(s, 4); s += __shfl_xor(s, 8); s += __shfl_xor(s, 16);
    const float rr = rsqrtf(s * (1.f / 128.f) + EPS) * omli;
    bf16_t* orow = concat + (size_t)(qrow0 + wid * 32 + crow(r, hi)) * DM + 512 + h * 128 + r32;
#pragma unroll
    for (int d0 = 0; d0 < 4; ++d0) orow[d0 * 32] = f2bf(o0[d0][r] * rr * subln[d0 * 32 + r32]); }
  asm volatile("s_waitcnt vmcnt(0) lgkmcnt(0)" ::: "memory"); __syncthreads();
#undef DMA_TILE
#undef BAR
#undef QK2
#undef QKH
#undef QKA
#undef QKB
#undef TILE
#undef STEP
#undef MBAR
#undef SGB
}

__device__ __forceinline__ void attn_unit3q(const int wid, const bf16_t* __restrict__ proj, const char* __restrict__ Kt_bh, const char* __restrict__ Vt_bh, bf16_t* __restrict__ concat, int qrow0, int NT, int h,
                                            LAS char* lds, float lam, float omli, const float* __restrict__ subln) {
  const int lane = lane_id(), r32 = lane & 31, hi = lane >> 5, rg = wid & 3, c = wid >> 2;
  LAS char* V_lds = lds; LAS char* K_lds = lds + 2 * SHM_V;
  LAS float* li_l = (LAS float*)(lds + 131072) + wid * 64;
  f32x2 l0v = {0.f, 0.f}, l1v = {0.f, 0.f}; f32x16 o0[4] = {}, o1[4] = {};
  const int vb0 = (int)(uintptr_t)V_lds + v_rd_base(lane);
  const char* kg0 = Kt_bh + wid * 2048 + lane * 16; const char* vg0 = Vt_bh + wid * 2048 + lane * 16;
#define DMA_TILE(tile, slot) do { const size_t to_ = (size_t)(tile) * 16384; \
    __builtin_amdgcn_global_load_lds((const unsigned*)(kg0 + to_), (LAS unsigned*)(K_lds + (slot) * SHM_K + wid * 2048), 16, 0, 0); \
    __builtin_amdgcn_global_load_lds((const unsigned*)(kg0 + to_ + 1024), (LAS unsigned*)(K_lds + (slot) * SHM_K + wid * 2048 + 1024), 16, 0, 0); \
    __builtin_amdgcn_global_load_lds((const unsigned*)(vg0 + to_), (LAS unsigned*)(V_lds + (slot) * SHM_V + wid * 2048), 16, 0, 0); \
    __builtin_amdgcn_global_load_lds((const unsigned*)(vg0 + to_ + 1024), (LAS unsigned*)(V_lds + (slot) * SHM_V + wid * 2048 + 1024), 16, 0, 0); } while (0)
#define BAR() do { asm volatile("s_waitcnt vmcnt(0) lgkmcnt(0)" ::: "memory"); __builtin_amdgcn_s_barrier(); asm volatile("" ::: "memory"); } while (0)
  bf16x8 qf00, qf01, qf02, qf03, qf10, qf11, qf12, qf13;
  { const bf16_t* qg = proj + (size_t)(qrow0 + rg * 64 + r32) * DP + C_DQ + h * 128 + c * 64 + hi * 8;
    qf00 = ld8(qg); qf01 = ld8(qg + 16); qf02 = ld8(qg + 32); qf03 = ld8(qg + 48); qg += (size_t)32 * DP;
    qf10 = ld8(qg); qf11 = ld8(qg + 16); qf12 = ld8(qg + 32); qf13 = ld8(qg + 48); }
  DMA_TILE(0, 0);
  bf16x8 a0, a1, a2, a3, b0, b1, b2, b3;
  int kad0_ = (int)(uintptr_t)K_lds + KSWZ(r32, (0 * 16 + hi * 8) * 2) + 128 * c, kad1_ = (int)(uintptr_t)K_lds + KSWZ(r32, (1 * 16 + hi * 8) * 2) + 128 * c;
  int kad2_ = (int)(uintptr_t)K_lds + KSWZ(r32, (2 * 16 + hi * 8) * 2) + 128 * c, kad3_ = (int)(uintptr_t)K_lds + KSWZ(r32, (3 * 16 + hi * 8) * 2) + 128 * c;
  asm volatile("" : "+v"(kad0_), "+v"(kad1_), "+v"(kad2_), "+v"(kad3_));
  LAS char* const kad0 = (LAS char*)(uintptr_t)kad0_; LAS char* const kad1 = (LAS char*)(uintptr_t)kad1_; LAS char* const kad2 = (LAS char*)(uintptr_t)kad2_; LAS char* const kad3 = (LAS char*)(uintptr_t)kad3_;
#define QKA(PH, so, rb, koff, LK) do { PH = f32x16{}; \
    { if (LK) kf0 = *reinterpret_cast<const LAS bf16x8*>(kad0 + ((so) * SHM_K + (koff) * 256)); PH = __builtin_amdgcn_mfma_f32_32x32x16_bf16(kf0, (rb) ? qf10 : qf00, PH, 0, 0, 0); } \
    { if (LK) kf1 = *reinterpret_cast<const LAS bf16x8*>(kad1 + ((so) * SHM_K + (koff) * 256)); PH = __builtin_amdgcn_mfma_f32_32x32x16_bf16(kf1, (rb) ? qf11 : qf01, PH, 0, 0, 0); } } while (0)
#define QKB(PH, so, rb, koff, LK) do { \
    { if (LK) kf2 = *reinterpret_cast<const LAS bf16x8*>(kad2 + ((so) * SHM_K + (koff) * 256)); PH = __builtin_amdgcn_mfma_f32_32x32x16_bf16(kf2, (rb) ? qf12 : qf02, PH, 0, 0, 0); } \
    { if (LK) kf3 = *reinterpret_cast<const LAS bf16x8*>(kad3 + ((so) * SHM_K + (koff) * 256)); PH = __builtin_amdgcn_mfma_f32_32x32x16_bf16(kf3, (rb) ? qf13 : qf03, PH, 0, 0, 0); } } while (0)
#define SGB(m, n) __builtin_amdgcn_sched_group_barrier(m, n, 0)
#define MBAR(X) do { SBAR(); asm volatile("" : "+v"(X) :: "memory"); SBAR(); } while (0)
#define STEP(PN, so, rb, koff, LK, PO, LV, X0, X1) do { \
    QKA(PN, so, rb, koff, LK); exp_half(PO, LV); if (LK) SGB(0x100, 2); SGB(0x8, 1); SGB(0x2, 12); SGB(0x8, 1); SGB(0x2, 12); SBAR(); asm volatile("" : "+v"(LV)); SBAR(); \
    QKB(PN, so, rb, koff, LK); pack_half(PO, X0, X1); if (LK) SGB(0x100, 2); SGB(0x8, 1); SGB(0x2, 4); SGB(0x8, 1); SGB(0x2, 4); MBAR(PN); } while (0)
#define TILE(t, so) do { BAR(); if ((t) + 1 < NT) DMA_TILE((t) + 1, 1 - (so)); SBAR(); \
    const int vb = vb0 + (so) * SHM_V; s16x4 fl0, fh0, fl1, fh1, fl2, fh2, fl3, fh3; \
    { f32x16 p0, p1; bf16x8 kf0, kf1, kf2, kf3; \
      QKA(p0, so, 0, 0, 1); QKB(p0, so, 0, 0, 1); MBAR(p0); \
      STEP(p1, so, 1, 0, 0, p0, l0v, a0, a1); \
      STEP(p0, so, 0, 32, 1, p1, l1v, b0, b1); \
      STEP(p1, so, 1, 32, 0, p0, l0v, a2, a3); \
      SBAR(); PVX_RD2(fl0, fh0, 0, 0); PVX_RD2(fl1, fh1, 0, 1); PVX_RD2(fl2, fh2, 0, 2); PVX_RD2(fl3, fh3, 0, 3); SBAR();     \
      exp_half(p1, l1v); SBAR(); asm volatile("" : "+v"(l1v)); SBAR(); pack_half(p1, b2, b3); } SBAR(); \
    { \
      pv2_block<0>(o0[0], o1[0], vb, fl0, fh0, fl1, fh1, fl2, fh2, fl3, fh3, a0, a1, a2, a3, b0, b1, b2, b3); \
      pv2_block<1>(o0[1], o1[1], vb, fl0, fh0, fl1, fh1, fl2, fh2, fl3, fh3, a0, a1, a2, a3, b0, b1, b2, b3); \
      pv2_block<2>(o0[2], o1[2], vb, fl0, fh0, fl1, fh1, fl2, fh2, fl3, fh3, a0, a1, a2, a3, b0, b1, b2, b3); \
      pv2_block<3>(o0[3], o1[3], vb, fl0, fh0, fl1, fh1, fl2, fh2, fl3, fh3, a0, a1, a2, a3, b0, b1, b2, b3); } SBAR(); } while (0)
  for (int t = 0; t < NT; t += 2) { TILE(t, 0); TILE(t + 1, 1); }
  const float l0 = pair_sum(l0v[0] + l0v[1]), l1 = pair_sum(l1v[0] + l1v[1]);
  if (hi == 0) { li_l[r32] = l0; li_l[32 + r32] = l1; }
  asm volatile("s_waitcnt vmcnt(0) lgkmcnt(0)" ::: "memory"); __syncthreads();
  LAS float* xw = (LAS float*)(lds + (rg * 2 + c) * 16384) + lane; const LAS float* xr = (const LAS float*)(lds + (rg * 2 + (1 - c)) * 16384) + lane;
  const float sgn = c ? lam : 1.f;
#define SEND(OX, LOFF) do { _Pragma("unroll") for (int r = 0; r < 16; ++r) { const float rl = sgn * __builtin_amdgcn_rcpf(li_l[(LOFF) + crow(r, hi)]); \
    _Pragma("unroll") for (int d0 = 0; d0 < 4; ++d0) xw[(d0 * 16 + r) * 64] = OX[d0][r] * rl; } } while (0)
  if (c == 0) SEND(o1, 32); else SEND(o0, 0);
  asm volatile("s_waitcnt lgkmcnt(0)" ::: "memory"); __syncthreads();
#define FINISH(OX, LOFF, RB) do { _Pragma("unroll") for (int r = 0; r < 16; ++r) { const float rl = sgn * __builtin_amdgcn_rcpf(li_l[(LOFF) + crow(r, hi)]); float s = 0.f; \
    _Pragma("unroll") for (int d0 = 0; d0 < 4; ++d0) { const float own = OX[d0][r] * rl, oth = xr[(d0 * 16 + r) * 64]; const float d = c ? oth - own : own - oth; OX[d0][r] = d; s += d * d; } \
    s += __shfl_xor(s, 1); s += __shfl_xor(s, 2); s += __shfl_xor(s, 4); s += __shfl_xor(s, 8); s += __shfl_xor(s, 16); \
    const float rr = rsqrtf(s * (1.f / 128.f) + EPS) * omli; \
    bf16_t* orow = concat + (size_t)(qrow0 + rg * 64 + (RB) * 32 + crow(r, hi)) * DM + 512 + h * 128 + r32; \
    _Pragma("unroll") for (int d0 = 0; d0 < 4; ++d0) orow[d0 * 32] = f2bf(OX[d0][r] * rr * subln[d0 * 32 + r32]); } } while (0)
  if (c == 0) FINISH(o0, 0, 0); else FINISH(o1, 32, 1);
  asm volatile("s_waitcnt vmcnt(0) lgkmcnt(0)" ::: "memory"); __syncthreads();
#undef SEND
#undef FINISH
#undef DMA_TILE
#undef BAR
#undef QKA
#undef QKB
#undef TILE
#undef STEP
#undef MBAR
#undef SGB
}

__device__ __forceinline__ bf16x8 scale8(bf16x8 v, float s) {
  u32x4 w;
#pragma unroll
  for (int i = 0; i < 4; ++i) { const float a = __uint_as_float(((unsigned)(unsigned short)v[2 * i]) << 16) * s, b = __uint_as_float(((unsigned)(unsigned short)v[2 * i + 1]) << 16) * s; w[i] = cvtpk(a, b); }
  return *reinterpret_cast<bf16x8*>(&w);
}
template <int KS> __device__ __forceinline__ void trfrag_issue(int vb, s16x4& l, s16x4& h) { l = tr_read<v_rd_off(0, KS, 0)>(vb); h = tr_read<v_rd_off(0, KS, 1)>(vb); }
#define PKF(L, H) (bf16x8){L[0], L[1], L[2], L[3], H[0], H[1], H[2], H[3]}
template <int KS> __device__ __forceinline__ void cs_step(f32x16* acc, int kb, int vv) {
  s16x4 al, ah, b0l, b0h, b1l, b1h, b2l, b2h, b3l, b3h;
  trfrag_issue<KS>(kb, al, ah); trfrag_issue<KS>(vv, b0l, b0h); trfrag_issue<KS>(vv + 512, b1l, b1h); trfrag_issue<KS>(vv + 1024, b2l, b2h); trfrag_issue<KS>(vv + 1536, b3l, b3h);
  asm volatile("s_waitcnt lgkmcnt(0)" ::: "memory"); SBAR();
  const bf16x8 a = PKF(al, ah);
  acc[0] = __builtin_amdgcn_mfma_f32_32x32x16_bf16(a, PKF(b0l, b0h), acc[0], 0, 0, 0);
  acc[1] = __builtin_amdgcn_mfma_f32_32x32x16_bf16(a, PKF(b1l, b1h), acc[1], 0, 0, 0);
  acc[2] = __builtin_amdgcn_mfma_f32_32x32x16_bf16(a, PKF(b2l, b2h), acc[2], 0, 0, 0);
  acc[3] = __builtin_amdgcn_mfma_f32_32x32x16_bf16(a, PKF(b3l, b3h), acc[3], 0, 0, 0);
}
__device__ __forceinline__ void chunk_state_unit(const int wid, const bf16_t* __restrict__ proj, bf16_t* __restrict__ csf, bf16_t* __restrict__ csb, int rowbase, int h, float lgf2, float lgb2, LAS char* lds) {
  const int lane = lane_id(), tid = wid * 64 + lane, r32 = lane & 31, hi = lane >> 5;
  const int sr = tid >> 4, sc = (tid & 15) * 8;
  { bf16x8 kv[4], vv[4];
#pragma unroll
    for (int g = 0; g < 4; ++g) { const bf16_t* rp = proj + (size_t)(rowbase + 32 * g + sr) * DP + h * 128 + sc; kv[g] = ld8(rp + C_RK); vv[g] = ld8(rp + C_RV); }
#pragma unroll
    for (int g = 0; g < 4; ++g) { const int row = 32 * g + sr;
      const float wf = __builtin_amdgcn_exp2f(lgf2 * (float)(127 - row)), wb = __builtin_amdgcn_exp2f(lgb2 * (float)row);
      const int off = (row >> 6) * 16384 + v_st(row & 63, sc);
      *(LAS bf16x8*)(lds + off) = vv[g]; *(LAS bf16x8*)(lds + 32768 + off) = scale8(kv[g], wf); *(LAS bf16x8*)(lds + 65536 + off) = scale8(kv[g], wb); } }
  __syncthreads();
  const int dir = wid >> 2, ib = wid & 3;
  const int vbK = (int)(uintptr_t)(lds + 32768 + dir * 32768) + v_rd_base(lane) + ib * 512, vbV = (int)(uintptr_t)lds + v_rd_base(lane);
  f32x16 acc[4] = {};
  cs_step<0>(acc, vbK, vbV); cs_step<1>(acc, vbK, vbV); cs_step<2>(acc, vbK, vbV); cs_step<3>(acc, vbK, vbV);
  cs_step<0>(acc, vbK + 16384, vbV + 16384); cs_step<1>(acc, vbK + 16384, vbV + 16384); cs_step<2>(acc, vbK + 16384, vbV + 16384); cs_step<3>(acc, vbK + 16384, vbV + 16384);
  bf16_t* outp = (dir ? csb : csf) + r32;
#pragma unroll
  for (int r = 0; r < 16; ++r) { bf16_t* orow = outp + (size_t)(32 * ib + crow(r, hi)) * 128;
#pragma unroll
    for (int jb = 0; jb < 4; ++jb) orow[32 * jb] = f2bf(acc[jb][r]); }
  __syncthreads();
}
__device__ __forceinline__ void pack_p(const f32x16& p0, const f32x16& p1, bf16x8& pa0, bf16x8& pa1, bf16x8& pa2, bf16x8& pa3) {
#define PK4(P, BASE, OUT) do { unsigned a0 = cvtpk(P[BASE + 0], P[BASE + 1]), a1 = cvtpk(P[BASE + 2], P[BASE + 3]);   \
    unsigned b0 = cvtpk(P[BASE + 4], P[BASE + 5]), b1 = cvtpk(P[BASE + 6], P[BASE + 7]);                              \
    auto r0 = __builtin_amdgcn_permlane32_swap(a0, b0, false, false); auto r1 = __builtin_amdgcn_permlane32_swap(a1, b1, false, false); \
    u32x4 w = {r0[0], r1[0], r0[1], r1[1]}; OUT = *reinterpret_cast<bf16x8*>(&w); } while (0)
  PK4(p0, 0, pa0); PK4(p0, 8, pa1); PK4(p1, 0, pa2); PK4(p1, 8, pa3);
#undef PK4
}
__device__ __forceinline__ float decay_w(int d, float lgf2, float lgb2) {
  const float e = __builtin_amdgcn_exp2f(d < 0 ? lgf2 * (float)(-d) : lgb2 * (float)d); return d == 0 ? 2.f : e;
}
__device__ __forceinline__ void ret_out_unit(const int wid, const bf16_t* __restrict__ proj, bf16_t* __restrict__ concat, const bf16_t* __restrict__ spA, const bf16_t* __restrict__ spB, size_t dstride,
                                             int rowA, int rowB, int h, float lgf2, float lgb2, const float* __restrict__ gn, LAS char* lds) {
  const int lane = lane_id(), tid = wid * 64 + lane, r32 = lane & 31, hi = lane >> 5, rg = wid & 3, ch = wid >> 2;
  const int sr = tid >> 4, sc = (tid & 15) * 8;
  const int rowbase = ch ? rowB : rowA;
  { bf16x8 kv[8], vv[8];
#pragma unroll
    for (int c2 = 0; c2 < 2; ++c2)
#pragma unroll
      for (int g = 0; g < 4; ++g) { const bf16_t* rp = proj + (size_t)((c2 ? rowB : rowA) + 32 * g + sr) * DP + h * 128 + sc; kv[c2 * 4 + g] = ld8(rp + C_RK); vv[c2 * 4 + g] = ld8(rp + C_RV); }
#pragma unroll
    for (int c2 = 0; c2 < 2; ++c2)
#pragma unroll
      for (int g = 0; g < 4; ++g) { const int row = 32 * g + sr;
        *(LAS bf16x8*)(lds + c2 * 65536 + (row >> 6) * 16384 + KSWZ(row & 63, sc * 2)) = kv[c2 * 4 + g];
        *(LAS bf16x8*)(lds + c2 * 65536 + 32768 + (row >> 6) * 16384 + v_st(row & 63, sc)) = vv[c2 * 4 + g]; } }
  bf16x8 qr[8];
  const bf16_t* Qw = proj + (size_t)(rowbase + rg * 32 + r32) * DP + C_RQ + h * 128 + hi * 8;
#pragma unroll
  for (int d0 = 0; d0 < 8; ++d0) qr[d0] = ld8(Qw + d0 * 16);
  __syncthreads();
  const int m = rg * 32 + r32;
  LAS char* myreg = lds + ch * 65536;
  const int vb = (int)(uintptr_t)myreg + v_rd_base(lane);
  f32x16 o[4] = {}; f32x16 p0, p1; bf16x8 pa0, pa1, pa2, pa3;
#pragma unroll
  for (int kt = 0; kt < 2; ++kt) {
    qkt<8>(p0, p1, myreg + kt * 16384, qr, r32, hi, 0);
    int mm = m - 4 * hi; asm volatile("" : "+v"(mm));
#pragma unroll
    for (int r = 0; r < 16; ++r) { const int s0 = 64 * kt + (r & 3) + 8 * (r >> 2); p0[r] *= decay_w(s0 - mm, lgf2, lgb2); p1[r] *= decay_w(s0 + 32 - mm, lgf2, lgb2); }
    pack_p(p0, p1, pa0, pa1, pa2, pa3);
    pv_d0(o, vb + 32768 + kt * 16384, pa0, pa1, pa2, pa3);
  }
  __syncthreads();
  { bf16x8 sv[16];
#pragma unroll
    for (int c2 = 0; c2 < 2; ++c2)
#pragma unroll
      for (int d = 0; d < 2; ++d)
#pragma unroll
        for (int g = 0; g < 4; ++g) sv[(c2 * 2 + d) * 4 + g] = ld8((c2 ? spB : spA) + (size_t)d * dstride + (size_t)(32 * g + sr) * 128 + sc);
#pragma unroll
    for (int c2 = 0; c2 < 2; ++c2)
#pragma unroll
      for (int d = 0; d < 2; ++d)
#pragma unroll
        for (int g = 0; g < 4; ++g) { const int row = 32 * g + sr;
          *(LAS bf16x8*)(lds + c2 * 65536 + d * 32768 + (row >> 6) * 16384 + v_st(row & 63, sc)) = sv[(c2 * 2 + d) * 4 + g]; } }
  const float xf = __builtin_amdgcn_exp2f(lgf2 * (float)(m + 1)), xb = __builtin_amdgcn_exp2f(lgb2 * (float)(128 - m));
  __syncthreads();
#pragma unroll
  for (int d = 0; d < 2; ++d) { const float xs = d ? xb : xf;
#pragma unroll
    for (int sub = 0; sub < 2; ++sub) {
      const bf16x8 a0 = scale8(qr[4 * sub + 0], xs), a1 = scale8(qr[4 * sub + 1], xs), a2 = scale8(qr[4 * sub + 2], xs), a3 = scale8(qr[4 * sub + 3], xs);
      pv_d0(o, vb + d * 32768 + sub * 16384, a0, a1, a2, a3); } }
#pragma unroll
  for (int r = 0; r < 16; ++r) {
    float s = (o[0][r] + o[1][r]) + (o[2][r] + o[3][r]);
    s += __shfl_xor(s, 1); s += __shfl_xor(s, 2); s += __shfl_xor(s, 4); s += __shfl_xor(s, 8); s += __shfl_xor(s, 16);
    const float mu = s * (1.f / 128.f);
    float q = 0.f;
#pragma unroll
    for (int d0 = 0; d0 < 4; ++d0) { const float dd = o[d0][r] - mu; o[d0][r] = dd; q += dd * dd; }
    q += __shfl_xor(q, 1); q += __shfl_xor(q, 2); q += __shfl_xor(q, 4); q += __shfl_xor(q, 8); q += __shfl_xor(q, 16);
    const float rr = rsqrtf(q * (1.f / 128.f) + EPS);
    const size_t grow = (size_t)(rowbase + rg * 32 + crow(r, hi));
    const bf16_t* gp = proj + grow * DP + C_RG + h * 128 + r32; bf16_t* op = concat + grow * DM + h * 128 + r32;
#pragma unroll
    for (int d0 = 0; d0 < 4; ++d0) { const float gv = bf2f(gp[32 * d0]); op[32 * d0] = f2bf(o[d0][r] * rr * gn[32 * d0 + r32] * (gv * __builtin_amdgcn_rcpf(1.f + __builtin_amdgcn_exp2f(-1.4426950408889634f * gv)))); }
  }
  __syncthreads();
}

}


__device__ __forceinline__ float log2_sigmoid(float x) { return -log1pf(__expf(-x)) * 1.4426950408889634f; }
__device__ __forceinline__ bf16_t* cs_ptr(const Params& p, int b, int h, int dir, int j) { return (bf16_t*)(p.ws + WS_CS) + ((size_t)((b * NH + h) * 2 + dir) * 66 + j) * 16384; }
__device__ __forceinline__ void qkrope_phase(const Params& p, Ctx& F, int l) {
    const int lane = lane_id();
    float gq[8], gk[8], fr[8];
#pragma unroll
    for (int i = 0; i < 8; ++i) { gq[i] = p.in[I_QNG][l * 64 + 8 * (lane & 7) + i] * 0.18033688011112042f;
        gk[i] = p.in[I_KNG][l * 64 + 8 * (lane & 7) + i];
        fr[i] = exp2f(-(float)(8 * (lane & 1) + i) * (13.287712379549449f / 16.f)) * 0.15915494309189535f; }
    const bool lowhalf = (lane & 4) == 0;
    for (int m = F.gw; m < NR; m += F.NGW) {
        bf16_t* row = (bf16_t*)(p.ws + WS_PROJ) + (size_t)m * DP;
        v4u* qp = (v4u*)(row + C_DQ) + lane; const v4u* kp = (const v4u*)(row + C_DK) + lane;
        const v4u qv = *qp, kv = *kp, vv = *((const v4u*)(row + C_DV) + lane);
        float q[8], k[8];
#pragma unroll
        for (int i = 0; i < 4; ++i) { q[2 * i] = __uint_as_float(qv[i] << 16); q[2 * i + 1] = __uint_as_float(qv[i] & 0xffff0000u); k[2 * i] = __uint_as_float(kv[i] << 16); k[2 * i + 1] = __uint_as_float(kv[i] & 0xffff0000u); }
        float sq = 0.f, sk = 0.f;
#pragma unroll
        for (int i = 0; i < 8; ++i) { sq += q[i] * q[i]; sk += k[i] * k[i]; }
        sq += __shfl_xor(sq, 1); sq += __shfl_xor(sq, 2); sq += __shfl_xor(sq, 4);
        sk += __shfl_xor(sk, 1); sk += __shfl_xor(sk, 2); sk += __shfl_xor(sk, 4);
        const float rq = rsqrtf(sq * (1.f / 64.f) + EPS), rk = rsqrtf(sk * (1.f / 64.f) + EPS);
#pragma unroll
        for (int i = 0; i < 8; ++i) { q[i] *= rq * gq[i]; k[i] *= rk * gk[i]; }
        if (m < NL) {
            const int t = m % T; const float pos = (float)((lane & 2) ? (t % 64) : (t / 64));
#pragma unroll
            for (int i = 0; i < 8; ++i) {
                const float rev = pos * fr[i]; const float cs = __builtin_amdgcn_cosf(rev), sn = __builtin_amdgcn_sinf(rev);
                const float oq = __shfl_xor(q[i], 4), ok = __shfl_xor(k[i], 4);
                q[i] = lowhalf ? q[i] * cs - oq * sn : q[i] * cs + oq * sn;
                k[i] = lowhalf ? k[i] * cs - ok * sn : k[i] * cs + ok * sn;
            }
        }
        v4u qo, ko;
#pragma unroll
        for (int i = 0; i < 4; ++i) { qo[i] = pk2(q[2 * i], q[2 * i + 1]); ko[i] = pk2(k[2 * i], k[2 * i + 1]); }
        *qp = qo;
        { const int bb = m < NL ? m / T : (m - NL) / TC, kidx = m < NL ? TC + (m % T) : (m - NL) % TC, tile = kidx >> 6, r = kidx & 63, hh = lane >> 4, ci = lane & 15;
          const size_t blk = ((size_t)(bb * NH + hh) * 132 + tile) * 16384;
          *(v4u*)(p.ws + WS_KT + blk + KSWZ(r, 16 * ci)) = ko;
#if FAST_ATT
          *(v4u*)(p.ws + WS_VT + blk + att::v_st_lin(r, 8 * ci)) = vv; }
#else
          *(v4u*)(p.ws + WS_VT + blk + att::v_st(r, 8 * ci)) = vv; }
#endif
    }
}
__device__ __forceinline__ void scan_phase(const Params& p, Ctx& F, int l) {
    const int lane_ = lane_id(), tid_ = F.wave * 64 + lane_;
    unsigned* cs = (unsigned*)(p.ws + WS_CS);
    for (int i = blockIdx.x * (NWAVES * 64) + tid_; i < 16 * 8192; i += F.G * NWAVES * 64) {
        const int combo = i >> 13, e2 = i & 8191, dir = combo & 1, h = (combo >> 1) & 3;
        const float lg2 = log2_sigmoid(dir ? p.in[I_DECB][l * NH + h] : p.in[I_DECF][l * NH + h]);
        const float decay = exp2f(lg2 * 128.f);
        unsigned* base = cs + (size_t)combo * 66 * 8192 + e2;
        float s0 = 0.f, s1 = 0.f;
#pragma unroll 1
        for (int jj = 0; jj < 66; jj += 22) {
            unsigned tv[22];
#pragma unroll
            for (int k = 0; k < 22; ++k) { const int q = jj + k, idx = dir ? (q < 2 ? 1 - q : 67 - q) : q; tv[k] = base[(size_t)idx * 8192]; }
#pragma unroll
            for (int k = 0; k < 22; ++k) { const int q = jj + k, idx = dir ? (q < 2 ? 1 - q : 67 - q) : q;
                base[(size_t)idx * 8192] = pk2(s0, s1);
                s0 = decay * s0 + __uint_as_float(tv[k] << 16); s1 = decay * s1 + __uint_as_float(tv[k] & 0xffff0000u); }
        }
    }
}

#define IN(k) (lo <= (k) && (k) < hi)
#define SEAM(k) do { if (IN(k) && IN((k) + 1)) xcd_barrier(bar, F.wave == 0 && lane_id() == 0); } while (0)
#ifndef REP_ATT
#define REP_ATT 1
#endif
#ifndef REP_RET
#define REP_RET 1
#endif
#ifndef REP_B
#define REP_B 1
#endif
#ifndef REP_H0
#define REP_H0 1
#endif
#ifndef REP_H1
#define REP_H1 1
#endif
#ifndef REP_I1
#define REP_I1 1
#endif
#ifndef REP_P0
#define REP_P0 1
#endif
#ifndef REP_CS
#define REP_CS 1
#endif
#ifndef REP_A
#define REP_A 1
#endif
#ifndef REP_I0
#define REP_I0 1
#endif
#ifndef REP_F0
#define REP_F0 1
#endif
#ifndef REP_G2
#define REP_G2 1
#endif
#ifndef REP_BAR
#define REP_BAR 0
#endif
template <int l>
__device__ __forceinline__ void layer_phases(const Params& p, Ctx& F, const XcdBarrier& bar, const int lo, const int hi) {
    constexpr int base = 1 + 9 * l;

        if (IN(base + 0)) { for (int rep_ = 0; rep_ < REP_A; ++rep_) norm_phase(p, F, l, 0, NR); for (int rep_ = 0; rep_ < REP_BAR; ++rep_) xcd_barrier(bar, F.wave == 0 && lane_id() == 0); SEAM(base + 0); }
        if (IN(base + 1)) {
            pg8::Gemm g{(const bf16_t*)(p.ws + WS_HBUF), (const bf16_t*)(p.ws + W_WIN) + (size_t)l * DP * DM, NR, DP, DM, DM};
            pg8::Order S; S.init(NR / 256, DP / 256, F.G, (int)blockIdx.x);
            pg8::EpiProj E{(bf16_t*)(p.ws + WS_PROJ)};
            { pg8::gemm_phase<pg8::EpiProj, pg8::Order, true, true>(F.lds + RING_OFF, g, S, E, F.wave); if (REP_B > 1) { pg8::gemm_phase<pg8::EpiProj, pg8::Order, true, true>(F.lds + RING_OFF, g, S, E, F.wave); } }
            SEAM(base + 1);
        }
        if (IN(base + 2)) {
            qkrope_phase(p, F, l);
            for (int rep_ = 0; rep_ < REP_CS; ++rep_)
            for (int u = blockIdx.x; u < 8 * 66; u += F.G) {
                const int bh = u & 7, j = u >> 3, b = bh >> 2, h = bh & 3;
                const int rowbase = j < 2 ? NL + b * TC + 128 * j : b * T + 128 * (j - 2);
                att::chunk_state_unit(F.wave, (const bf16_t*)(p.ws + WS_PROJ), cs_ptr(p, b, h, 0, j), cs_ptr(p, b, h, 1, j), rowbase, h,
                                      log2_sigmoid(p.in[I_DECF][l * NH + h]), log2_sigmoid(p.in[I_DECB][l * NH + h]), (LAS char*)(F.lds + RING_OFF));
            }
            SEAM(base + 2);
        }
        if (IN(base + 3)) { scan_phase(p, F, l); SEAM(base + 3); }
        if (IN(base + 4)) {
#if FAST_RET
            for (int rep_ = 0; rep_ < REP_RET; ++rep_)
            for (int u = blockIdx.x; u < (l == 0 ? 8 * 33 : 8 * 32); u += F.G) {
                const int bh = u & 7, jp = (u >> 3) + (l == 0 ? 0 : 1), b = bh >> 2, h = bh & 3;
                const int rowA = jp == 0 ? NL + b * TC : b * T + 128 * (2 * jp - 2);
                att::ret_out_unit(F.wave, (const bf16_t*)(p.ws + WS_PROJ), (bf16_t*)(p.ws + WS_CONCAT), cs_ptr(p, b, h, 0, 2 * jp), cs_ptr(p, b, h, 0, 2 * jp + 1), (size_t)66 * 16384,
                                  rowA, rowA + 128, h, log2_sigmoid(p.in[I_DECF][l * NH + h]), log2_sigmoid(p.in[I_DECB][l * NH + h]), p.in[I_GNG] + l * 512 + h * 128, (LAS char*)(F.lds + RING_OFF));
            }
#endif
#if FAST_ATT
            { const int lane_ = lane_id();
              const float s1 = wave_sum(p.in[I_LQ1][l * 64 + lane_] * p.in[I_LK1][l * 64 + lane_]), s2 = wave_sum(p.in[I_LQ2][l * 64 + lane_] * p.in[I_LK2][l * 64 + lane_]);
              const float li = lam_init_of(l), lam = __expf(s1) - __expf(s2) + li;
#if ATT_V3
              constexpr int nunits = 256 + (l == 0 ? 8 : 0);
              for (int rep_ = 0; rep_ < REP_ATT; ++rep_)
              for (int w = ((int)blockIdx.x + F.G - (8 % F.G)) % F.G; w < nunits; w += F.G) {
                  const int u = w < 256 ? ((w + 8) & 255) : w;
                  int b, h, qrow0, NT;
                  if (u < 256) { const int bh = u & 7, qb = u >> 3; b = bh >> 2; h = bh & 3; qrow0 = b * T + qb * 256; NT = (TC + T) / 64; }
                  else { const int bh = u - 256; b = bh >> 2; h = bh & 3; qrow0 = NL + b * TC; NT = TC / 64; }
                  att::ATT_UNIT(F.wave, (const bf16_t*)(p.ws + WS_PROJ), (const char*)(p.ws + WS_KT) + (size_t)(b * NH + h) * 132 * 16384, (const char*)(p.ws + WS_VT) + (size_t)(b * NH + h) * 132 * 16384, (bf16_t*)(p.ws + WS_CONCAT), qrow0, NT, h, (LAS char*)(F.lds + RING_OFF), lam, 1.f - li, p.in[I_SUBLN] + l * 128);
              }
#else
              constexpr int nunits = 512 + (l == 0 ? 16 : 0);
              for (int rep_ = 0; rep_ < REP_ATT; ++rep_)
              for (int u = blockIdx.x; u < nunits; u += F.G) {
                  int b, h, qrow0, NT;
                  if (u < 512) { const int bh = u & 7, qb = u >> 3; b = bh >> 2; h = bh & 3; qrow0 = b * T + qb * 128; NT = (TC + T) / 64; }
                  else { const int v = u - 512, bh = v & 7, blk = v >> 3; b = bh >> 2; h = bh & 3; qrow0 = NL + b * TC + blk * 128; NT = TC / 64; }
                  att::attn_unit(F.wave, (const bf16_t*)(p.ws + WS_PROJ), (const char*)(p.ws + WS_KT) + (size_t)(b * NH + h) * 132 * 16384, (const char*)(p.ws + WS_VT) + (size_t)(b * NH + h) * 132 * 16384, (bf16_t*)(p.ws + WS_CONCAT), qrow0, NT, h, (LAS char*)(F.lds + RING_OFF), lam, 1.f - li, p.in[I_SUBLN] + l * 128);
              }
#endif
            }
#endif
            SEAM(base + 4);
        }
        if (IN(base + 5)) {
            pg8::Gemm g{(const bf16_t*)(p.ws + WS_CONCAT), (const bf16_t*)(p.ws + W_WOUT) + (size_t)l * DM * DM, NR, DM, DM, DM};
            pg8::Order S; S.init(NL / 256, DM / 256, F.G, (int)blockIdx.x);
            pg8::EpiResid E{l == 0 ? p.in[I_X] : p.out, l == 0 ? p.in[I_CTX] : (const float*)(p.ws + WS_XRC), p.out, (float*)(p.ws + WS_XRC), modv(p, l, 0, 2), modv(p, l, 2, 2)};
            if (REP_F0 > 1 && l == 0) { pg8::gemm_phase<pg8::EpiResid, pg8::Order, true, true>(F.lds + RING_OFF, g, S, E, F.wave); }
            pg8::gemm_phase<pg8::EpiResid, pg8::Order, true, true>(F.lds + RING_OFF, g, S, E, F.wave);
            if constexpr (l == 0) {
                pg8::Gemm g2{(const bf16_t*)(p.ws + WS_CONCAT), (const bf16_t*)(p.ws + W_WOUT), NR, DM, 256, DM};
                pg8::SplitOrder S2; S2.init(NL / 256, 2, DM / 256, DM / 256, F.G, (int)blockIdx.x);
                pg8::EpiPartial E2{(float*)(p.ws + WS_PART), NL / 256, NC};
                pg8::gemm_phase<pg8::EpiPartial, pg8::SplitOrder, true, true>(F.lds + RING_OFF, g2, S2, E2, F.wave);
            }
            SEAM(base + 5);
        }
        if (IN(base + 6)) { if constexpr (l == 0) norm_phase(p, F, 0, 1, NR); else router_phase(p, F); SEAM(base + 6); }
        if constexpr (l == 0) {
            if (IN(8)) {
                pg8::Gemm g{(const bf16_t*)(p.ws + WS_HBUF), (const bf16_t*)(p.ws + W_FGU), NR, 2 * DFF, DM, DM};
                pg8::Order S; S.init(NR / 256, 2 * DFF / 256, F.G, (int)blockIdx.x);
                pg8::EpiSwiglu E{(bf16_t*)(p.ws + WS_ACT)};
                { pg8::gemm_phase<pg8::EpiSwiglu, pg8::Order, true, true>(F.lds + RING_OFF, g, S, E, F.wave); if (REP_H0 > 1) { pg8::gemm_phase<pg8::EpiSwiglu, pg8::Order, true, true>(F.lds + RING_OFF, g, S, E, F.wave); } }
                SEAM(8);
            }
            if (IN(9)) {
                pg8::Gemm g{(const bf16_t*)(p.ws + WS_ACT), (const bf16_t*)(p.ws + W_FD), NR, DM, DFF, DFF};
                pg8::Order S; S.init(NL / 256, DM / 256, F.G, (int)blockIdx.x);
                pg8::EpiResid E{p.out, (const float*)(p.ws + WS_XRC), p.out, (float*)(p.ws + WS_XRC), modv(p, 0, 0, 5), modv(p, 0, 2, 5)};
                if (REP_I0 > 1) { pg8::EpiResid Ed{p.out, (const float*)(p.ws + WS_XRC), (float*)(p.ws + WS_H2S), (float*)(p.ws + WS_H2S) + (size_t)NL * DM, modv(p, 0, 0, 5), modv(p, 0, 2, 5)}; pg8::gemm_phase<pg8::EpiResid, pg8::Order, true, true>(F.lds + RING_OFF, g, S, Ed, F.wave); }
                pg8::gemm_phase<pg8::EpiResid, pg8::Order, true, true>(F.lds + RING_OFF, g, S, E, F.wave);
                {
                    pg8::Gemm g2{(const bf16_t*)(p.ws + WS_ACT), (const bf16_t*)(p.ws + W_FD), NR, DM, 256, DFF};
                    pg8::SplitOrder S2; S2.init(NL / 256, 2, DM / 256, DFF / 256, F.G, (int)blockIdx.x);
                    pg8::EpiPartial E2{(float*)(p.ws + WS_PART), NL / 256, NC};
                    pg8::gemm_phase<pg8::EpiPartial, pg8::SplitOrder, true, true>(F.lds + RING_OFF, g2, S2, E2, F.wave);
                }
                SEAM(9);
            }
        } else {
            if (IN(17)) { for (int rep_ = 0; rep_ < REP_G2; ++rep_) gather_phase(p, F); SEAM(17); }
            if (IN(18)) {
                moe_table(F);
                pg8::Gemm g{(const bf16_t*)(p.ws + WS_H2S), (const bf16_t*)(p.ws + W_MGU), MP_MAX, 2 * DFF, DM / 2, DM / 2};
                pg8::Order S; moe_order(F, S, 2 * DFF / 256, (long)2 * DFF * DM);
                pg8::EpiSwiglu8 E{(unsigned char*)(p.ws + WS_ACTS)};
                { pg8::gemm_phase<pg8::EpiSwiglu8, pg8::Order, true, true, true>(F.lds + RING_OFF, g, S, E, F.wave); if (REP_H1 > 1) { pg8::gemm_phase<pg8::EpiSwiglu8, pg8::Order, true, true, true>(F.lds + RING_OFF, g, S, E, F.wave); } }
                SEAM(18);
            }
            if (IN(19)) {
                moe_table(F);
                pg8::Gemm g{(const bf16_t*)(p.ws + WS_ACTS), (const bf16_t*)(p.ws + W_MD), MP_MAX, DM, DFF / 2, DFF / 2};
                pg8::Order S; moe_order(F, S, DM / 256, (long)DM * DFF);
                pg8::EpiMoeDown E{(bf16_t*)(p.ws + WS_YBUF), (const float*)(p.ws + WS_ROUTE) + 6 * NL + MP_MAX, 1.f / (W8_SCALE * A8_SCALE)};
                { pg8::gemm_phase<pg8::EpiMoeDown, pg8::Order, true, true, true>(F.lds + RING_OFF, g, S, E, F.wave); if (REP_I1 > 1) { pg8::gemm_phase<pg8::EpiMoeDown, pg8::Order, true, true, true>(F.lds + RING_OFF, g, S, E, F.wave); } }
                SEAM(19);
            }
            if (IN(20)) { combine_phase(p, F); }
        }
}
struct MArgs { Params p; int ph_lo, ph_hi, li, pad; };
constexpr int N_PHASES = 21;
__global__ void __launch_bounds__(NWAVES * 64, 2) mega(MArgs args) {
    extern __shared__ __attribute__((aligned(16))) unsigned char lds_raw[];
    const Params& p = args.p;
    Ctx F;
    F.lds = (LAS unsigned char*)lds_raw; F.MISC = (volatile LAS unsigned*)(F.lds + MISC_OFF);
    F.wave = __builtin_amdgcn_readfirstlane((int)threadIdx.x >> 6);
    const int lane_ = lane_id(), tid_ = F.wave * 64 + lane_;
    F.G = gridDim.x; F.gw = blockIdx.x * NWAVES + F.wave; F.NGW = F.G * NWAVES;
    F.ctl = (unsigned*)(p.ws + WS_CTL);
    for (int u = tid_; u < (LDS_BYTES - MISC_OFF) / 4; u += NWAVES * 64) ((LAS unsigned*)(F.lds + MISC_OFF))[u] = 0u;
    __syncthreads();
    XcdBarrier bar = xcd_barrier_post(F.ctl + CW_BAR + args.li * XCD_BAR_WORDS, F.MISC + 8, tid_ == 0);
    const int lo = args.ph_lo, hi = args.ph_hi;

    if (IN(0)) { for (int rep_ = 0; rep_ < REP_P0; ++rep_) { if (rep_) __syncthreads(); p0_prologue(p, F); } SEAM(0); }
    layer_phases<0>(p, F, bar, lo, hi);
    layer_phases<1>(p, F, bar, lo, hi);
#undef IN
#undef SEAM
}

#ifndef FAST_MASK
#define FAST_MASK 0x1u
#endif
static void launch_naive_e(const Params& p, int l, bool ret, bool att, hipStream_t stream) {
    const int nrows_mix = l == 0 ? NR : NL;
    if (ret) k_ret_naive<<<nrows_mix * NH / 4, 256, 0, stream>>>(p, l, nrows_mix);
    if (att) k_attn_naive<<<nrows_mix * NH / 4, 256, 0, stream>>>(p, l, nrows_mix);
}
static void launch_naive(const Params& p, int ph, hipStream_t stream) {
    const int l = ph >= 10 ? 1 : 0, rel = ph == 0 ? -1 : (ph - 1 - 9 * l);
    const int nrows_mix = l == 0 ? NR : NL;
    if (ph == 0) { k_mod<<<(2 * 3 * 6144 + 255) / 256, 256, 0, stream>>>(p); return; }
    switch (rel) {
    case 0: k_norm<<<NR / 4, 256, 0, stream>>>(p, l, 0, NR); break;
    case 1: k_gemm_proj<<<dim3(DP / 64, NR / 4), dim3(64, 4), 0, stream>>>(p, l); break;
    case 2: k_qkrope<<<NR / 4, 256, 0, stream>>>(p, l); break;
    case 3: break;
    case 4: launch_naive_e(p, l, true, true, stream); break;
    case 5: k_gemm_out<<<dim3(DM / 64, nrows_mix / 4), dim3(64, 4), 0, stream>>>(p, l); break;
    case 6: k_norm<<<nrows_mix / 4, 256, 0, stream>>>(p, l, 1, nrows_mix); break;
    case 7: if (l == 0) k_ffn_gu<<<dim3(DFF / 64, NR / 4), dim3(64, 4), 0, stream>>>(p); break;
    case 8: if (l == 0) k_ffn_down<<<dim3(DM / 64, NR / 4), dim3(64, 4), 0, stream>>>(p); else k_moe_gu<<<dim3(DFF / 64, 2 * NL / 4), dim3(64, 4), 0, stream>>>(p); break;
    case 9: k_moe_down<<<dim3(DM / 64, NL / 4), dim3(64, 4), 0, stream>>>(p); break;
    default: break;
    }
}
extern "C" void kernel_launch(void* const* d_in, const int* in_sizes, int n_in, void* d_out, int out_size, void* d_ws, size_t ws_size, hipStream_t stream) {
    static int grid = 0;
    if (grid == 0) {
        if (n_in != 28 || out_size != NL * DM || ws_size < WS_END) { fprintf(stderr, "kernel_launch: unexpected shapes (n_in %d out %d ws %zu need %zu)\n", n_in, out_size, ws_size, (size_t)WS_END); grid = -1; return; }
        int dev = 0, cus = 0, per_cu = 0;
        if (hipGetDevice(&dev) != hipSuccess || hipDeviceGetAttribute(&cus, hipDeviceAttributeMultiprocessorCount, dev) != hipSuccess) { grid = -1; return; }
        if (hipFuncSetAttribute((const void*)mega, hipFuncAttributeMaxDynamicSharedMemorySize, LDS_BYTES) != hipSuccess) { fprintf(stderr, "kernel_launch: hipFuncSetAttribute failed\n"); grid = -1; return; }
        if (hipOccupancyMaxActiveBlocksPerMultiprocessor(&per_cu, (const void*)mega, NWAVES * 64, LDS_BYTES) != hipSuccess || per_cu < 1) { fprintf(stderr, "kernel_launch: occupancy query says %d\n", per_cu); (void)hipGetLastError(); grid = -1; return; }
        grid = cus;
    }
    if (grid < 0) return;
    (void)hipMemsetAsync((char*)d_ws + WS_CTL, 0, CTL_ZERO_BYTES, stream);
    MArgs a{};
    for (int i = 0; i < 28; ++i) a.p.in[i] = (const float*)d_in[i];
    a.p.out = (float*)d_out; a.p.ws = (unsigned char*)d_ws;
    const unsigned mask = FAST_MASK;
    int li = 0, ph = 0;
    while (ph < N_PHASES) {
        if ((mask >> ph) & 1u) { int e = ph; bool cutE = false;
            while (e < N_PHASES && ((mask >> e) & 1u)) { const bool isE = (e == 5 || e == 14); ++e; if (isE && !(FAST_ATT && FAST_RET)) { cutE = true; break; } }
            a.ph_lo = ph; a.ph_hi = e; a.li = li++;
            hipLaunchKernelGGL(mega, dim3(grid), dim3(NWAVES * 64), LDS_BYTES, stream, a);
            if (cutE) launch_naive_e(a.p, e - 1 == 5 ? 0 : 1, !FAST_RET, !FAST_ATT, stream);
            ph = e; }
        else { launch_naive(a.p, ph, stream); ++ph; }
    }
}
```

```cpp
#include <hip/hip_runtime.h>
#include <cstdint>
#include <cstdio>
#define FAST_MASK 0x1fffffu
#define FAST_ATT 1
#define FAST_RET 1

constexpr int NB = 2, T = 8192, DM = 1024, TC = 256;
constexpr int NL = NB * T;
constexpr int NC = NB * TC;
constexpr int NR = NL + NC;
constexpr int DP = 3584, DFF = 2816, NE = 8, NH = 4;
constexpr float EPS = 1e-6f;
constexpr int C_RQ = 0, C_RK = 512, C_RV = 1024, C_RG = 1536, C_DQ = 2048, C_DK = 2560, C_DV = 3072;
constexpr int MP_MAX = 2 * NL + NE * 256;

typedef unsigned short bf16_t;
__device__ __forceinline__ float bf2f(bf16_t v) { return __uint_as_float(((unsigned)v) << 16); }
__device__ __forceinline__ bf16_t f2bf(float f) { unsigned u = __float_as_uint(f); u += 0x7fffu + ((u >> 16) & 1u); return (bf16_t)(u >> 16); }
typedef float f32x2_t __attribute__((ext_vector_type(2)));
typedef __bf16 bf16x2_t __attribute__((ext_vector_type(2)));
__device__ __forceinline__ unsigned pk2(float lo, float hi) { const f32x2_t v = {lo, hi}; const bf16x2_t b = __builtin_convertvector(v, bf16x2_t); return __builtin_bit_cast(unsigned, b); }
__device__ __forceinline__ unsigned pk4_fp8(float a, float b, float c, float d) {
    a = __builtin_amdgcn_fmed3f(a, -448.f, 448.f); b = __builtin_amdgcn_fmed3f(b, -448.f, 448.f); c = __builtin_amdgcn_fmed3f(c, -448.f, 448.f); d = __builtin_amdgcn_fmed3f(d, -448.f, 448.f);
    int r = 0; r = __builtin_amdgcn_cvt_pk_fp8_f32(a, b, r, false); r = __builtin_amdgcn_cvt_pk_fp8_f32(c, d, r, true); return (unsigned)r;
}
constexpr float W8_SCALE = 64.f, A8_SCALE = 8.f;
__device__ __forceinline__ float wave_sum(float v) {
#pragma unroll
    for (int o = 1; o < 64; o <<= 1) v += __shfl_xor(v, o);
    return v;
}
__device__ __forceinline__ int lane_id() { int l = (int)__builtin_amdgcn_mbcnt_hi(~0u, __builtin_amdgcn_mbcnt_lo(~0u, 0u)); asm volatile("" : "+v"(l)); return l; }
__device__ __forceinline__ float siluf(float v) { return v / (1.f + __expf(-v)); }

constexpr size_t MiB = 1u << 20;
constexpr size_t WS_CTL = 0, CTL_ZERO_BYTES = 1 * MiB;
constexpr size_t WS_MODV = 1 * MiB;
constexpr size_t WS_ROUTE = 2 * MiB;
constexpr size_t WS_XRC = 3 * MiB;
constexpr size_t WS_W = 6 * MiB;
constexpr size_t W_WIN = WS_W;
constexpr size_t W_WOUT = W_WIN + (size_t)2 * DP * DM * 2;
constexpr size_t W_FGU = W_WOUT + (size_t)2 * DM * DM * 2;
constexpr size_t W_FD = W_FGU + (size_t)2 * DFF * DM * 2;
constexpr size_t W_MGU = W_FD + (size_t)DM * DFF * 2;
constexpr size_t W_MD = W_MGU + (size_t)NE * 2 * DFF * DM * 2;
constexpr size_t W_END = W_MD + (size_t)NE * DM * DFF * 2;
constexpr size_t WS_HBUF = 173 * MiB;
constexpr size_t WS_PROJ = 206 * MiB;
constexpr size_t WS_CONCAT = 322 * MiB;
constexpr size_t WS_ACT = 206 * MiB;
constexpr size_t WS_ACTS = 173 * MiB;
constexpr size_t WS_H2S = 361 * MiB;
constexpr size_t WS_KT = 394 * MiB, WS_VT = WS_KT + (size_t)NB * NH * 132 * 16384;
static_assert(WS_VT + (size_t)NB * NH * 132 * 16384 <= 429 * MiB && WS_H2S + (size_t)NB * NH * 2 * 66 * 32768 <= WS_KT, "K/V tile images");
constexpr size_t WS_YBUF = WS_H2S, WS_CS = WS_H2S, WS_PART = WS_H2S;
constexpr size_t WS_END = 430 * MiB;
static_assert(W_END <= WS_HBUF && WS_ACTS + (size_t)MP_MAX * DFF * 2 <= WS_H2S && WS_H2S + (size_t)MP_MAX * DM * 2 <= WS_END && WS_ACT + (size_t)2 * NL * DFF * 2 <= WS_END, "ws map");
constexpr int CW_BAR = 4096;
constexpr int CW_CNT = 200000;

struct Params {
    const float* in[28];
    float* out;
    unsigned char* ws;
};
enum { I_X = 0, I_C, I_CTX, I_CCTX, I_ADAW, I_ADAB, I_N1G, I_N2G, I_WIN, I_DECF, I_DECB, I_GNG, I_QNG, I_KNG, I_LQ1, I_LK1, I_LQ2, I_LK2, I_SUBLN, I_WOUT,
       I_FWG, I_FWU, I_FWD, I_RW, I_RB, I_MWG, I_MWU, I_MWD };

__device__ __forceinline__ int rowtype(int m) { return m < NL ? m / T : 2; }
__device__ __forceinline__ const float* modv(const Params& p, int l, int rt, int i) { return (const float*)(p.ws + WS_MODV) + ((size_t)(l * 3 + rt) * 6 + i) * DM; }
__device__ __forceinline__ float* xr_row(const Params& p, int m) { return m < NL ? p.out + (size_t)m * DM : (float*)(p.ws + WS_XRC) + (size_t)(m - NL) * DM; }
__device__ __forceinline__ float lam_init_of(int l) { return l == 0 ? 0.2f : (0.8f - 0.6f * 0.74081822068171788f); }

#ifndef SEAM_CVT
#define SEAM_CVT 1
#endif
#ifndef ATT_UNIT
#define ATT_UNIT attn_unit3q
#endif
#ifndef FAST_ATT
#define FAST_ATT 0
#endif
#ifndef FAST_RET
#define FAST_RET 0
#endif
#ifndef ATT_V3
#define ATT_V3 1
#endif
__global__ void k_mod(Params p) {
    const int idx = blockIdx.x * blockDim.x + threadIdx.x;
    if (idx >= 2 * 3 * 6144) return;
    const int n = idx % 6144, rt = (idx / 6144) % 3, l = idx / (6144 * 3);
    const float* cv = rt < 2 ? p.in[I_C] + rt * DM : p.in[I_CCTX];
    const float* W = p.in[I_ADAW] + (size_t)l * DM * 6144;
    float acc = 0.f;
    for (int k = 0; k < DM; ++k) acc += siluf(cv[k]) * W[(size_t)k * 6144 + n];
    ((float*)(p.ws + WS_MODV))[(size_t)(l * 3 + rt) * 6144 + n] = acc + p.in[I_ADAB][l * 6144 + n];
}

__global__ void k_norm(Params p, int l, int which, int nrows) {
    const int m = blockIdx.x * (blockDim.x / 64) + (threadIdx.x >> 6), lane = threadIdx.x & 63;
    if (m >= nrows) return;
    const float* xrow;
    if (l == 0 && which == 0) xrow = m < NL ? p.in[I_X] + (size_t)m * DM : p.in[I_CTX] + (size_t)(m - NL) * DM;
    else xrow = xr_row(p, m);
    const int rt = rowtype(m);
    const float* g = p.in[which ? I_N2G : I_N1G] + l * DM;
    const float* sh = modv(p, l, rt, which ? 3 : 0);
    const float* sc = modv(p, l, rt, which ? 4 : 1);
    float v[16]; float ss = 0.f;
#pragma unroll
    for (int j = 0; j < 4; ++j) { const float4 t = *(const float4*)(xrow + 256 * j + 4 * lane); v[4 * j] = t.x; v[4 * j + 1] = t.y; v[4 * j + 2] = t.z; v[4 * j + 3] = t.w; ss += t.x * t.x + t.y * t.y + t.z * t.z + t.w * t.w; }
    const float r = rsqrtf(wave_sum(ss) * (1.f / DM) + EPS);
    bf16_t* hb = (bf16_t*)(p.ws + WS_HBUF) + (size_t)m * DM;
#pragma unroll
    for (int j = 0; j < 4; ++j)
#pragma unroll
        for (int q = 0; q < 4; ++q) { const int col = 256 * j + 4 * lane + q; const float y = v[4 * j + q] * r * g[col]; v[4 * j + q] = y * (1.f + sc[col]) + sh[col]; hb[col] = f2bf(v[4 * j + q]); }
    if (l == 1 && which == 1) {
        const float* rw = p.in[I_RW]; float lg[8];
#pragma unroll
        for (int e = 0; e < 8; ++e) { float a = 0.f;
#pragma unroll
            for (int j = 0; j < 4; ++j)
#pragma unroll
                for (int q = 0; q < 4; ++q) a += v[4 * j + q] * rw[(size_t)(256 * j + 4 * lane + q) * 8 + e];
            lg[e] = wave_sum(a) + p.in[I_RB][e]; }
        int i1 = 0; float v1 = lg[0];
#pragma unroll
        for (int e = 1; e < 8; ++e) if (lg[e] > v1) { v1 = lg[e]; i1 = e; }
        int i2 = -1; float v2 = -3.4e38f;
#pragma unroll
        for (int e = 0; e < 8; ++e) if (e != i1 && lg[e] > v2) { v2 = lg[e]; i2 = e; }
        const float w1 = 1.f / (1.f + __expf(v2 - v1));
        if (lane == 0) { int* te = (int*)(p.ws + WS_ROUTE); float* tw = (float*)(p.ws + WS_ROUTE) + 2 * NL; te[2 * m] = i1; te[2 * m + 1] = i2; tw[2 * m] = w1; tw[2 * m + 1] = 1.f - w1; }
    }
}

__global__ void k_gemm_proj(Params p, int l) {
    const int n = blockIdx.x * 64 + threadIdx.x, m = blockIdx.y * 4 + threadIdx.y;
    const bf16_t* a = (const bf16_t*)(p.ws + WS_HBUF) + (size_t)m * DM;
    const float* W = p.in[I_WIN] + (size_t)l * DM * DP + n;
    float acc = 0.f;
#pragma unroll 8
    for (int k = 0; k < DM; ++k) acc += bf2f(a[k]) * W[(size_t)k * DP];
    if (n >= C_RK && n < C_RV) acc *= 0.08838834764831845f;
    ((bf16_t*)(p.ws + WS_PROJ))[(size_t)m * DP + n] = f2bf(acc);
}

__global__ void k_qkrope(Params p, int l) {
    const int m = blockIdx.x * (blockDim.x / 64) + (threadIdx.x >> 6), lane = threadIdx.x & 63;
    if (m >= NR) return;
    bf16_t* row = (bf16_t*)(p.ws + WS_PROJ) + (size_t)m * DP;
    const bool lat = m < NL; const int t = m % T;
    const int j = lane & 31; const float pos = (float)((j < 16) ? (t / 64) : (t % 64));
    const float inv_freq = exp2f(-(float)(j & 15) * (13.287712379549449f / 16.f));
    const float ang = pos * inv_freq; const float cs = __cosf(ang), sn = __sinf(ang);
    for (int part = 0; part < 2; ++part) {
        const float* g = p.in[part ? I_KNG : I_QNG] + l * 64;
        for (int hc = 0; hc < 8; ++hc) {
            bf16_t* q = row + (part ? C_DK : C_DQ) + hc * 64;
            const float v = bf2f(q[lane]);
            const float r = rsqrtf(wave_sum(v * v) * (1.f / 64.f) + EPS);
            float y = v * r * g[lane];
            if (lat) { const float o = __shfl_xor(y, 32); y = lane < 32 ? y * cs - o * sn : y * cs + o * sn; }
            if (part == 0) y *= 0.18033688011112042f;
            q[lane] = f2bf(y);
        }
    }
}

__global__ void k_ret_naive(Params p, int l, int nrows) {
    const int w = blockIdx.x * (blockDim.x / 64) + (threadIdx.x >> 6), lane = threadIdx.x & 63;
    if (w >= nrows * NH) return;
    const int m = w / NH, h = w % NH;
    const bf16_t* proj = (const bf16_t*)(p.ws + WS_PROJ);
    const float df = p.in[I_DECF][l * NH + h], db = p.in[I_DECB][l * NH + h];
    const float lgf = -log1pf(__expf(-df)), lgb = -log1pf(__expf(-db));
    const bf16_t* qrow = proj + (size_t)m * DP + C_RQ + h * 128 + 2 * lane;
    const float q0 = bf2f(qrow[0]), q1 = bf2f(qrow[1]);
    float o0 = 0.f, o1 = 0.f;
    if (m < NL) {
        const int b = m / T, t = m % T;
        for (int s = 0; s < T; ++s) {
            const bf16_t* kr = proj + (size_t)(b * T + s) * DP + h * 128 + 2 * lane;
            const float dot = wave_sum(q0 * bf2f(kr[C_RK]) + q1 * bf2f(kr[C_RK + 1]));
            const float wgt = s < t ? __expf(lgf * (float)(t - s)) : (s == t ? 2.f : __expf(lgb * (float)(s - t)));
            o0 += wgt * dot * bf2f(kr[C_RV]); o1 += wgt * dot * bf2f(kr[C_RV + 1]);
        }
        for (int i = 0; i < TC; ++i) {
            const bf16_t* kr = proj + (size_t)(NL + b * TC + i) * DP + h * 128 + 2 * lane;
            const float dot = wave_sum(q0 * bf2f(kr[C_RK]) + q1 * bf2f(kr[C_RK + 1]));
            const float wgt = __expf(lgf * (float)(t + TC - i)) + __expf(lgb * (float)(T - t + i));
            o0 += wgt * dot * bf2f(kr[C_RV]); o1 += wgt * dot * bf2f(kr[C_RV + 1]);
        }
    } else {
        const int b = (m - NL) / TC, t = (m - NL) % TC;
        for (int s = 0; s < TC; ++s) {
            const bf16_t* kr = proj + (size_t)(NL + b * TC + s) * DP + h * 128 + 2 * lane;
            const float dot = wave_sum(q0 * bf2f(kr[C_RK]) + q1 * bf2f(kr[C_RK + 1]));
            const float wgt = s < t ? __expf(lgf * (float)(t - s)) : (s == t ? 2.f : __expf(lgb * (float)(s - t)));
            o0 += wgt * dot * bf2f(kr[C_RV]); o1 += wgt * dot * bf2f(kr[C_RV + 1]);
        }
    }
    const float mu = wave_sum(o0 + o1) * (1.f / 128.f);
    const float d0 = o0 - mu, d1 = o1 - mu;
    const float r = rsqrtf(wave_sum(d0 * d0 + d1 * d1) * (1.f / 128.f) + EPS);
    const float* gn = p.in[I_GNG] + l * 512 + h * 128 + 2 * lane;
    const bf16_t* gr = proj + (size_t)m * DP + C_RG + h * 128 + 2 * lane;
    bf16_t* cc = (bf16_t*)(p.ws + WS_CONCAT) + (size_t)m * DM + h * 128 + 2 * lane;
    cc[0] = f2bf(siluf(bf2f(gr[0])) * d0 * r * gn[0]);
    cc[1] = f2bf(siluf(bf2f(gr[1])) * d1 * r * gn[1]);
}

__global__ void k_attn_naive(Params p, int l, int nrows) {
    const int w = blockIdx.x * (blockDim.x / 64) + (threadIdx.x >> 6), lane = threadIdx.x & 63;
    if (w >= nrows * NH) return;
    const int m = w / NH, h = w % NH;
    const bf16_t* proj = (const bf16_t*)(p.ws + WS_PROJ);
    const bool lat = m < NL; const int b = lat ? m / T : (m - NL) / TC;
    float O[2][2];
    for (int c = 0; c < 2; ++c) {
        const float q = bf2f(proj[(size_t)m * DP + C_DQ + h * 128 + c * 64 + lane]);
        float mx = -1e30f, ls = 0.f, o0 = 0.f, o1 = 0.f;
        const int nk = lat ? TC + T : TC;
        for (int s = 0; s < nk; ++s) {
            const int mk = s < TC ? NL + b * TC + s : b * T + (s - TC);
            const bf16_t* kr = proj + (size_t)mk * DP + h * 128;
            const float sc = wave_sum(q * bf2f(kr[C_DK + c * 64 + lane]));
            const float mn = fmaxf(mx, sc), al = exp2f(mx - mn), pp = exp2f(sc - mn);
            ls = ls * al + pp; o0 = o0 * al + pp * bf2f(kr[C_DV + 2 * lane]); o1 = o1 * al + pp * bf2f(kr[C_DV + 2 * lane + 1]); mx = mn;
        }
        O[c][0] = o0 / ls; O[c][1] = o1 / ls;
    }
    float s1 = 0.f, s2 = 0.f;
    { const float a = p.in[I_LQ1][l * 64 + lane] * p.in[I_LK1][l * 64 + lane], bq = p.in[I_LQ2][l * 64 + lane] * p.in[I_LK2][l * 64 + lane]; s1 = wave_sum(a); s2 = wave_sum(bq); }
    const float li = lam_init_of(l), lam = __expf(s1) - __expf(s2) + li;
    const float d0 = O[0][0] - lam * O[1][0], d1 = O[0][1] - lam * O[1][1];
    const float r = rsqrtf(wave_sum(d0 * d0 + d1 * d1) * (1.f / 128.f) + EPS);
    const float* sg = p.in[I_SUBLN] + l * 128 + 2 * lane;
    bf16_t* cc = (bf16_t*)(p.ws + WS_CONCAT) + (size_t)m * DM + 512 + h * 128 + 2 * lane;
    cc[0] = f2bf(d0 * r * sg[0] * (1.f - li)); cc[1] = f2bf(d1 * r * sg[1] * (1.f - li));
}

__global__ void k_gemm_out(Params p, int l) {
    const int n = blockIdx.x * 64 + threadIdx.x, m = blockIdx.y * 4 + threadIdx.y;
    const bf16_t* a = (const bf16_t*)(p.ws + WS_CONCAT) + (size_t)m * DM;
    const float* W = p.in[I_WOUT] + (size_t)l * DM * DM + n;
    float acc = 0.f;
#pragma unroll 8
    for (int k = 0; k < DM; ++k) acc += bf2f(a[k]) * W[(size_t)k * DM];
    const float xin = l == 0 ? (m < NL ? p.in[I_X][(size_t)m * DM + n] : p.in[I_CTX][(size_t)(m - NL) * DM + n]) : xr_row(p, m)[n];
    xr_row(p, m)[n] = xin + modv(p, l, rowtype(m), 2)[n] * acc;
}

__global__ void k_ffn_gu(Params p) {
    const int j = blockIdx.x * 64 + threadIdx.x, m = blockIdx.y * 4 + threadIdx.y;
    const bf16_t* a = (const bf16_t*)(p.ws + WS_HBUF) + (size_t)m * DM;
    const float* Wg = p.in[I_FWG] + j; const float* Wu = p.in[I_FWU] + j;
    float ag = 0.f, au = 0.f;
#pragma unroll 8
    for (int k = 0; k < DM; ++k) { const float x = bf2f(a[k]); ag += x * Wg[(size_t)k * DFF]; au += x * Wu[(size_t)k * DFF]; }
    ((bf16_t*)(p.ws + WS_ACT))[(size_t)m * DFF + j] = f2bf(siluf(ag) * au);
}
__global__ void k_ffn_down(Params p) {
    const int n = blockIdx.x * 64 + threadIdx.x, m = blockIdx.y * 4 + threadIdx.y;
    const bf16_t* a = (const bf16_t*)(p.ws + WS_ACT) + (size_t)m * DFF;
    const float* W = p.in[I_FWD] + n;
    float acc = 0.f;
#pragma unroll 8
    for (int k = 0; k < DFF; ++k) acc += bf2f(a[k]) * W[(size_t)k * DM];
    xr_row(p, m)[n] += modv(p, 0, rowtype(m), 5)[n] * acc;
}
__global__ void k_moe_gu(Params p) {
    const int j = blockIdx.x * 64 + threadIdx.x, ts = blockIdx.y * 4 + threadIdx.y;
    const int t = ts >> 1; const int e = ((const int*)(p.ws + WS_ROUTE))[ts];
    const bf16_t* a = (const bf16_t*)(p.ws + WS_HBUF) + (size_t)t * DM;
    const float* Wg = p.in[I_MWG] + (size_t)e * DM * DFF + j; const float* Wu = p.in[I_MWU] + (size_t)e * DM * DFF + j;
    float ag = 0.f, au = 0.f;
#pragma unroll 8
    for (int k = 0; k < DM; ++k) { const float x = bf2f(a[k]); ag += x * Wg[(size_t)k * DFF]; au += x * Wu[(size_t)k * DFF]; }
    ((bf16_t*)(p.ws + WS_ACT))[(size_t)ts * DFF + j] = f2bf(siluf(ag) * au);
}
__global__ void k_moe_down(Params p) {
    const int n = blockIdx.x * 64 + threadIdx.x, t = blockIdx.y * 4 + threadIdx.y;
    const int* te = (const int*)(p.ws + WS_ROUTE); const float* tw = (const float*)(p.ws + WS_ROUTE) + 2 * NL;
    float y = 0.f;
    for (int s = 0; s < 2; ++s) {
        const bf16_t* a = (const bf16_t*)(p.ws + WS_ACT) + (size_t)(2 * t + s) * DFF;
        const float* W = p.in[I_MWD] + (size_t)te[2 * t + s] * DFF * DM + n;
        float acc = 0.f;
#pragma unroll 8
        for (int k = 0; k < DFF; ++k) acc += bf2f(a[k]) * W[(size_t)k * DM];
        y += tw[2 * t + s] * acc;
    }
    p.out[(size_t)t * DM + n] += modv(p, 1, t / T, 5)[n] * y;
}


typedef unsigned v2u __attribute__((ext_vector_type(2)));
namespace pg8 {
#define PG8_LAS __attribute__((address_space(3)))
typedef unsigned short bf16_t;
typedef short bf16x8 __attribute__((ext_vector_type(8)));
typedef float f32x4 __attribute__((ext_vector_type(4)));
typedef unsigned u32x4 __attribute__((ext_vector_type(4)));
typedef int i32x4 __attribute__((ext_vector_type(4)));
typedef int i32x8 __attribute__((ext_vector_type(8)));
constexpr int BM = 256, BK = 64, HALF = 128, HTB = HALF * BK * 2  , STAGE_BYTES = 8 * HTB, NXCD = 8, WGM = 8;

__host__ __device__ __forceinline__ int lds_byte(int r, int c) { const int st = (r >> 4) * 2 + (c >> 5), rr = r & 15, cc = c & 31, ob = rr * 64 + cc * 2; return st * 1024 + (ob ^ (((ob >> 9) & 1) << 5)); }
__host__ __device__ __forceinline__ void stage_rc(int b, int& R, int& C) { const int st = b / 1024, sb = b % 1024, swz = sb ^ (((sb >> 9) & 1) << 5); R = (st >> 1) * 16 + swz / 64; C = (st & 1) * 32 + (swz % 64) / 2; }
__host__ __device__ __forceinline__ int perm32(int rho) { const int n = rho >> 4, i = rho & 15; return 8 * (i >> 2) + 4 * n + (i & 3); }

struct Unit { int pm, pn; long bofs, kofs; };
struct Gemm { const bf16_t* A; const bf16_t* Bt; int M, N, K, ld; };

struct Order {
    int nM, nN, nwg, G, c;
    int e1, e2, e3, e4, e5, e6, e7; long estride;
    __device__ __forceinline__ void init(int nM_, int nN_, int G_, int c_) { nM = nM_; nN = nN_; nwg = nM * nN; G = G_; c = c_; estride = 0; e1 = e2 = e3 = e4 = e5 = e6 = e7 = 0; }
    __device__ __forceinline__ bool next(int i, Unit& u) const {
        const long L = (long)i * G + c; if (L >= nwg) return false;
        int wgid = (int)L; { const int q = nwg / NXCD, r = nwg % NXCD, xcd = wgid % NXCD, off = wgid / NXCD; wgid = (xcd < r ? xcd * (q + 1) : r * (q + 1) + (xcd - r) * q) + off; }
        const int nig = WGM * nN, gid = wgid / nig, fm = gid * WGM, gsz = (nM - fm) < WGM ? (nM - fm) : WGM;
        u.pm = fm + ((wgid % nig) % gsz); u.pn = (wgid % nig) / gsz;
        const int e = (u.pm >= e1) + (u.pm >= e2) + (u.pm >= e3) + (u.pm >= e4) + (u.pm >= e5) + (u.pm >= e6) + (u.pm >= e7);
        u.bofs = estride ? (long)e * estride : 0; u.kofs = 0;
        return true;
    }
    __device__ __forceinline__ void a_ready(const Unit&) const {}
    __device__ __forceinline__ void done(const Unit&) const {}
};

struct SplitOrder {
    int nN, ns, nwg, G, c, pm0;
    __device__ __forceinline__ void init(int pm0_, int npan, int nN_, int ns_, int G_, int c_) { pm0 = pm0_; nN = nN_; ns = ns_; nwg = npan * nN * ns; G = G_; c = c_; }
    __device__ __forceinline__ bool next(int i, Unit& u) const {
        const int L = i * G + c; if (L >= nwg) return false;
        const int ks = L % ns, rest = L / ns; u.pn = rest % nN; u.pm = pm0 + rest / nN; u.bofs = 0; u.kofs = (long)ks * 256 * 2; return true;
    }
    __device__ __forceinline__ void a_ready(const Unit&) const {}
    __device__ __forceinline__ void done(const Unit&) const {}
};
__device__ __forceinline__ unsigned cvt_pk_bf16(float lo, float hi) { unsigned r; asm volatile("v_cvt_pk_bf16_f32 %0, %1, %2" : "=v"(r) : "v"(lo), "v"(hi)); return r; }
__device__ __forceinline__ float silu_fast(float x) { return x * __builtin_amdgcn_rcpf(1.f + __builtin_amdgcn_exp2f(-1.4426950408889634f * x)); }

struct EpiProj {
    static constexpr bool PERM = true, AFTER_DRAIN = false;
    bf16_t* O;
    __device__ __forceinline__ void operator()(const f32x4 (&acc)[2][2][4][2], const Unit& u, int wr, int wc, int fr, int fq) const {
        const int row0 = u.pm * BM + wr * 64 + fr, col0 = u.pn * BM + wc * 32 + 8 * fq;
        const float sc = (u.pn == 2 || u.pn == 3) ? 0.08838834764831845f : 1.f;
#pragma unroll
        for (int ai = 0; ai < 2; ++ai)
#pragma unroll
            for (int m = 0; m < 4; ++m) { bf16_t* rowp = O + (size_t)(row0 + ai * HALF + m * 16) * DP + col0;
#pragma unroll
                for (int bj = 0; bj < 2; ++bj) { const f32x4 v0 = acc[ai][bj][m][0] * sc, v1 = acc[ai][bj][m][1] * sc;
                    u32x4 w; w.x = cvt_pk_bf16(v0[0], v0[1]); w.y = cvt_pk_bf16(v0[2], v0[3]); w.z = cvt_pk_bf16(v1[0], v1[1]); w.w = cvt_pk_bf16(v1[2], v1[3]);
                    *(u32x4*)(rowp + bj * HALF) = w; } }
    }
};
struct EpiResid {
    static constexpr bool PERM = false, AFTER_DRAIN = false;
    const float* base_lat; const float* base_ctx; float* out_lat; float* out_ctx; const float* gl; const float* gc;
    __device__ __forceinline__ void operator()(const f32x4 (&acc)[2][2][4][2], const Unit& u, int wr, int wc, int fr, int fq) const {
        const bool lat = u.pm < NL / BM;
        const int row0 = (lat ? u.pm * BM : u.pm * BM - NL) + wr * 64 + fr, col0 = u.pn * BM + wc * 32 + 4 * fq;
        const float* base = lat ? base_lat : base_ctx; float* out = lat ? out_lat : out_ctx;
        const float* gate = lat ? gl + (size_t)(u.pm / (T / BM)) * 6 * DM : gc;
        f32x4 gv[2][2];
#pragma unroll
        for (int bj = 0; bj < 2; ++bj)
#pragma unroll
            for (int n = 0; n < 2; ++n) gv[bj][n] = *(const f32x4*)(gate + col0 + bj * HALF + n * 16);
#pragma unroll
        for (int ai = 0; ai < 2; ++ai)
#pragma unroll
            for (int m = 0; m < 4; ++m) { const size_t off = (size_t)(row0 + ai * HALF + m * 16) * DM + col0;
#pragma unroll
                for (int bj = 0; bj < 2; ++bj)
#pragma unroll
                    for (int n = 0; n < 2; ++n) { const f32x4 bs = *(const f32x4*)(base + off + bj * HALF + n * 16); *(f32x4*)(out + off + bj * HALF + n * 16) = bs + gv[bj][n] * acc[ai][bj][m][n]; }
                asm volatile("" ::: "memory"); }
    }
};
struct EpiPartial {
    static constexpr bool PERM = false, AFTER_DRAIN = false;
    float* part; int pm0, nrows;
    __device__ __forceinline__ void operator()(const f32x4 (&acc)[2][2][4][2], const Unit& u, int wr, int wc, int fr, int fq) const {
        const int row0 = (u.pm - pm0) * BM + wr * 64 + fr, col0 = u.pn * BM + wc * 32 + 4 * fq;
        float* base = part + (size_t)(u.kofs / 512) * nrows * DM;
#pragma unroll
        for (int ai = 0; ai < 2; ++ai)
#pragma unroll
            for (int m = 0; m < 4; ++m) { float* rowp = base + (size_t)(row0 + ai * HALF + m * 16) * DM + col0;
#pragma unroll
                for (int bj = 0; bj < 2; ++bj)
#pragma unroll
                    for (int n = 0; n < 2; ++n) *(f32x4*)(rowp + bj * HALF + n * 16) = acc[ai][bj][m][n]; }
    }
};
struct EpiSwiglu {
    static constexpr bool PERM = true, AFTER_DRAIN = false;
    bf16_t* O;
    __device__ __forceinline__ void operator()(const f32x4 (&acc)[2][2][4][2], const Unit& u, int wr, int wc, int fr, int fq) const {
        const int row0 = u.pm * BM + wr * 64 + fr, col0 = u.pn * HALF + wc * 32 + 8 * fq;
#pragma unroll
        for (int ai = 0; ai < 2; ++ai)
#pragma unroll
            for (int m = 0; m < 4; ++m) { bf16_t* rowp = O + (size_t)(row0 + ai * HALF + m * 16) * DFF + col0;
                const f32x4 g0 = acc[ai][0][m][0], g1 = acc[ai][0][m][1], u0 = acc[ai][1][m][0], u1 = acc[ai][1][m][1];
                u32x4 w; w.x = cvt_pk_bf16(silu_fast(g0[0]) * u0[0], silu_fast(g0[1]) * u0[1]); w.y = cvt_pk_bf16(silu_fast(g0[2]) * u0[2], silu_fast(g0[3]) * u0[3]);
                w.z = cvt_pk_bf16(silu_fast(g1[0]) * u1[0], silu_fast(g1[1]) * u1[1]); w.w = cvt_pk_bf16(silu_fast(g1[2]) * u1[2], silu_fast(g1[3]) * u1[3]);
                *(u32x4*)rowp = w; }
    }
};
struct EpiSwiglu8 {
    static constexpr bool PERM = true, AFTER_DRAIN = false;
    unsigned char* O;
    __device__ __forceinline__ void operator()(const f32x4 (&acc)[2][2][4][2], const Unit& u, int wr, int wc, int fr, int fq) const {
        const int row0 = u.pm * BM + wr * 64 + fr, col0 = u.pn * HALF + wc * 32 + 8 * fq;
        constexpr float WI = 1.f / W8_SCALE;
#pragma unroll
        for (int ai = 0; ai < 2; ++ai)
#pragma unroll
            for (int m = 0; m < 4; ++m) { unsigned char* rowp = O + (size_t)(row0 + ai * HALF + m * 16) * DFF + col0;
                const f32x4 g0 = acc[ai][0][m][0] * WI, g1 = acc[ai][0][m][1] * WI, u0 = acc[ai][1][m][0] * (WI * A8_SCALE), u1 = acc[ai][1][m][1] * (WI * A8_SCALE);
                v2u w; w.x = pk4_fp8(silu_fast(g0[0]) * u0[0], silu_fast(g0[1]) * u0[1], silu_fast(g0[2]) * u0[2], silu_fast(g0[3]) * u0[3]);
                w.y = pk4_fp8(silu_fast(g1[0]) * u1[0], silu_fast(g1[1]) * u1[1], silu_fast(g1[2]) * u1[2], silu_fast(g1[3]) * u1[3]);
                *(v2u*)rowp = w; }
    }
};
struct EpiMoeDown {
    static constexpr bool PERM = true, AFTER_DRAIN = false;
    bf16_t* O; const float* rgate; float scale;
    __device__ __forceinline__ void operator()(const f32x4 (&acc)[2][2][4][2], const Unit& u, int wr, int wc, int fr, int fq) const {
        const int row0 = u.pm * BM + wr * 64 + fr, col0 = u.pn * BM + wc * 32 + 8 * fq;
#pragma unroll
        for (int ai = 0; ai < 2; ++ai)
#pragma unroll
            for (int m = 0; m < 4; ++m) { const int row = row0 + ai * HALF + m * 16; const float sc = rgate[row] * scale; bf16_t* rowp = O + (size_t)row * DM + col0;
#pragma unroll
                for (int bj = 0; bj < 2; ++bj) { const f32x4 v0 = acc[ai][bj][m][0] * sc, v1 = acc[ai][bj][m][1] * sc;
                    u32x4 w; w.x = cvt_pk_bf16(v0[0], v0[1]); w.y = cvt_pk_bf16(v0[2], v0[3]); w.z = cvt_pk_bf16(v1[0], v1[1]); w.w = cvt_pk_bf16(v1[2], v1[3]);
                    *(u32x4*)(rowp + bj * HALF) = w; } }
    }
};

template <class Epi, class Sched, bool ALIGN_EPI = false, bool SP2 = false, bool F8 = false>
__device__ __forceinline__ void gemm_phase(PG8_LAS unsigned char* lds, const Gemm g, const Sched& S, const Epi& E, const int wid  ) {
    const int lane = lane_id(), tid = wid * 64 + lane, wr = wid >> 2, wc = wid & 3, fr = lane & 15, fq = lane >> 4;
    const int K = g.ld, nt = g.K / BK;
    unsigned voffA[2], voffB[2];
#pragma unroll
    for (int i = 0; i < 2; ++i) { int R, C; stage_rc(tid * 16 + i * 8192, R, C); const int Rb = Epi::PERM ? ((R & ~31) + perm32(R & 31)) : R;
        voffA[i] = (unsigned)(R * K + C) * 2u; voffB[i] = (unsigned)(Rb * K + C) * 2u; }
    const size_t kstep = (size_t)(BK * 2);
    const size_t hstep = (size_t)HALF * K * 2;
    const size_t tstep = 2 * hstep;
    const unsigned ldsw = (unsigned)wid * 1024u;
    const int aoff = lds_byte(wr * 64 + fr, fq * 8), boff = lds_byte(wc * 32 + fr, fq * 8);
#define PG8_SA(b, h) (((b) * 2 + (h)) * HTB)
#define PG8_SB(b, h) ((4 + (b) * 2 + (h)) * HTB)
#define PG8_STAGE(bufoff, gbase, voff) do { _Pragma("unroll") for (int _i = 0; _i < 2; ++_i) \
        __builtin_amdgcn_global_load_lds((const unsigned*)((const char*)(gbase) + (voff)[_i]), (PG8_LAS unsigned*)(lds + (bufoff) + ldsw + _i * 8192), 16, 0, 0); } while (0)
#define PG8_LD8(addr) __builtin_shufflevector(*(const PG8_LAS i32x4*)(addr), *(const PG8_LAS i32x4*)((addr) + 1024), 0, 1, 2, 3, 4, 5, 6, 7)
#define PG8_LDA(dst, dst8, b, h) do { if constexpr (F8) { _Pragma("unroll") for (int m = 0; m < 4; ++m) dst8[m] = PG8_LD8(lds + PG8_SA(b, h) + aoff + m * 2048); } \
        else { _Pragma("unroll") for (int m = 0; m < 4; ++m) _Pragma("unroll") for (int k = 0; k < 2; ++k) dst[m][k] = *(const PG8_LAS bf16x8*)(lds + PG8_SA(b, h) + aoff + m * 2048 + k * 1024); } } while (0)
#define PG8_LDB(dst, dst8, b, h) do { if constexpr (F8) { _Pragma("unroll") for (int n = 0; n < 2; ++n) dst8[n] = PG8_LD8(lds + PG8_SB(b, h) + boff + n * 2048); } \
        else { _Pragma("unroll") for (int n = 0; n < 2; ++n) _Pragma("unroll") for (int k = 0; k < 2; ++k) dst[n][k] = *(const PG8_LAS bf16x8*)(lds + PG8_SB(b, h) + boff + n * 2048 + k * 1024); } } while (0)
#define PG8_MMA(ai, bj, At, At8, Bt, Bt8) do { __builtin_amdgcn_s_setprio(1); \
        if constexpr (F8) { _Pragma("unroll") for (int m = 0; m < 4; ++m) _Pragma("unroll") for (int n = 0; n < 2; ++n) \
            asm volatile("v_mfma_scale_f32_16x16x128_f8f6f4 %0, %1, %2, %0, %3, %3 op_sel_hi:[0,0,0]" : "+v"(acc[ai][bj][m][n]) : "v"(Bt8[n]), "v"(At8[m]), "v"(sc8_)); } \
        else { _Pragma("unroll") for (int m = 0; m < 4; ++m) _Pragma("unroll") for (int n = 0; n < 2; ++n) _Pragma("unroll") for (int k = 0; k < 2; ++k) \
            acc[ai][bj][m][n] = __builtin_amdgcn_mfma_f32_16x16x32_bf16(Bt[n][k], At[m][k], acc[ai][bj][m][n], 0, 0, 0); } \
        __builtin_amdgcn_s_setprio(0); } while (0)
#define PG8_WAIT_V(n) asm volatile("s_waitcnt vmcnt(" #n ")" ::: "memory")
#define PG8_WAIT_L(n) asm volatile("s_waitcnt lgkmcnt(" #n ")" ::: "memory")
#define PG8_BAR __builtin_amdgcn_s_barrier()
#define PG8_SCHED __builtin_amdgcn_sched_barrier(0)
#define PG8_SCHED8 do { if constexpr (F8) __builtin_amdgcn_sched_barrier(0); } while (0)
    Unit cur, nxt; int ui = 0;
    if (!S.next(0, cur)) return;
    constexpr float zero_ = 0.f;
    const int sc8_ = 0x7f7f7f7f;
    f32x4 acc[2][2][4][2];
#pragma unroll
    for (int a = 0; a < 2; ++a)
#pragma unroll
        for (int b = 0; b < 2; ++b)
#pragma unroll
            for (int m = 0; m < 4; ++m)
#pragma unroll
                for (int n = 0; n < 2; ++n) acc[a][b][m][n] = (f32x4){zero_, zero_, zero_, zero_};
    bf16x8 At[4][2], B0[2][2], B1[2][2];
    i32x8 At8[4], B08[2], B18[2];
    const char* cA = (const char*)g.A + cur.kofs + (size_t)cur.pm * tstep; const char* cB = (const char*)g.Bt + cur.bofs + cur.kofs + (size_t)cur.pn * tstep;
    S.a_ready(cur);
    if constexpr (SP2) {
        PG8_STAGE(PG8_SB(0, 0), cB, voffB); PG8_STAGE(PG8_SB(0, 1), cB + hstep, voffB); PG8_STAGE(PG8_SA(0, 0), cA, voffA); PG8_STAGE(PG8_SA(0, 1), cA + hstep, voffA);
        if (wr == 1) PG8_BAR;
        PG8_WAIT_V(2); PG8_BAR;
        PG8_STAGE(PG8_SB(1, 0), cB + kstep, voffB); PG8_STAGE(PG8_SA(1, 0), cA + kstep, voffA); PG8_STAGE(PG8_SB(1, 1), cB + hstep + kstep, voffB);
        PG8_WAIT_V(6); PG8_BAR;
    } else {
        PG8_STAGE(PG8_SB(0, 0), cB, voffB); PG8_STAGE(PG8_SA(0, 0), cA, voffA); PG8_STAGE(PG8_SB(0, 1), cB + hstep, voffB); PG8_STAGE(PG8_SA(0, 1), cA + hstep, voffA);
        if (wr == 1) PG8_BAR;
        PG8_WAIT_V(4); PG8_BAR;
        PG8_STAGE(PG8_SB(1, 0), cB + kstep, voffB); PG8_STAGE(PG8_SA(1, 0), cA + kstep, voffA); PG8_STAGE(PG8_SB(1, 1), cB + hstep + kstep, voffB);
        PG8_WAIT_V(6); PG8_BAR;
    }
    for (;;) {
        const bool has_next = S.next(ui + 1, nxt);
        const char* nA = has_next ? (const char*)g.A + nxt.kofs + (size_t)nxt.pm * tstep : cA; const char* nB = has_next ? (const char*)g.Bt + nxt.bofs + nxt.kofs + (size_t)nxt.pn * tstep : cB;
#pragma clang loop unroll(disable)
        for (int t = 0; t < nt; t += 2) {
            const bool last = (t == nt - 2);
            const char* a1 = cA + (size_t)(t + 1) * kstep;
            const char* a2 = last ? nA : cA + (size_t)(t + 2) * kstep; const char* b2 = last ? nB : cB + (size_t)(t + 2) * kstep;
            const char* a3 = a2 + kstep; const char* b3 = b2 + kstep;
            if (last && has_next) S.a_ready(nxt);
            if constexpr (SP2) {
            PG8_LDB(B0, B08, 0, 0); PG8_LDB(B1, B18, 0, 1); PG8_SCHED; PG8_LDA(At, At8, 0, 0); PG8_STAGE(PG8_SA(1, 1), a1 + hstep, voffA);
            PG8_WAIT_V(8); PG8_WAIT_L(0); PG8_BAR; PG8_SCHED8; PG8_MMA(0, 0, At, At8, B0, B08); PG8_MMA(0, 1, At, At8, B1, B18); PG8_SCHED8; PG8_BAR; PG8_SCHED;
            PG8_LDA(At, At8, 0, 1); PG8_STAGE(PG8_SB(0, 0), b2, voffB); PG8_STAGE(PG8_SB(0, 1), b2 + hstep, voffB); PG8_STAGE(PG8_SA(0, 0), a2, voffA);
            PG8_WAIT_V(8); PG8_WAIT_L(0); PG8_BAR; PG8_SCHED8; PG8_MMA(1, 0, At, At8, B0, B08); PG8_MMA(1, 1, At, At8, B1, B18); PG8_SCHED8; PG8_BAR; PG8_SCHED;
            PG8_LDB(B0, B08, 1, 0); PG8_LDB(B1, B18, 1, 1); PG8_SCHED; PG8_LDA(At, At8, 1, 0); PG8_STAGE(PG8_SA(0, 1), a2 + hstep, voffA);
            PG8_WAIT_V(8); PG8_WAIT_L(0); PG8_BAR; PG8_SCHED8; PG8_MMA(0, 0, At, At8, B0, B08); PG8_MMA(0, 1, At, At8, B1, B18); PG8_SCHED8; PG8_BAR; PG8_SCHED;
            PG8_LDA(At, At8, 1, 1); PG8_STAGE(PG8_SB(1, 0), b3, voffB); PG8_STAGE(PG8_SB(1, 1), b3 + hstep, voffB); PG8_STAGE(PG8_SA(1, 0), a3, voffA);
            PG8_WAIT_V(8); PG8_WAIT_L(0); PG8_BAR; PG8_SCHED8; PG8_MMA(1, 0, At, At8, B0, B08); PG8_MMA(1, 1, At, At8, B1, B18); PG8_SCHED8; PG8_BAR; PG8_SCHED;
            } else {
            PG8_LDB(B0, B08, 0, 0); PG8_SCHED; PG8_LDA(At, At8, 0, 0); PG8_STAGE(PG8_SA(1, 1), a1 + hstep, voffA);
            PG8_WAIT_L(8); PG8_BAR; PG8_WAIT_L(0); PG8_MMA(0, 0, At, At8, B0, B08); PG8_BAR; PG8_SCHED;
            PG8_LDB(B1, B18, 0, 1); PG8_STAGE(PG8_SB(0, 0), b2, voffB);
            PG8_BAR; PG8_WAIT_L(0); PG8_MMA(0, 1, At, At8, B1, B18); PG8_BAR;
            PG8_LDA(At, At8, 0, 1); PG8_STAGE(PG8_SA(0, 0), a2, voffA);
            PG8_BAR; PG8_WAIT_L(0); PG8_MMA(1, 0, At, At8, B0, B08); PG8_BAR; PG8_SCHED;
            PG8_STAGE(PG8_SB(0, 1), b2 + hstep, voffB);
            PG8_WAIT_V(6); PG8_BAR; PG8_MMA(1, 1, At, At8, B1, B18); PG8_BAR;
            PG8_LDB(B0, B08, 1, 0); PG8_SCHED; PG8_LDA(At, At8, 1, 0); PG8_STAGE(PG8_SA(0, 1), a2 + hstep, voffA);
            PG8_WAIT_L(8); PG8_BAR; PG8_WAIT_L(0); PG8_MMA(0, 0, At, At8, B0, B08); PG8_BAR; PG8_SCHED;
            PG8_LDB(B1, B18, 1, 1); PG8_STAGE(PG8_SB(1, 0), b3, voffB);
            PG8_BAR; PG8_WAIT_L(0); PG8_MMA(0, 1, At, At8, B1, B18); PG8_BAR;
            PG8_LDA(At, At8, 1, 1); PG8_STAGE(PG8_SA(1, 0), a3, voffA);
            PG8_BAR; PG8_WAIT_L(0); PG8_MMA(1, 0, At, At8, B0, B08); PG8_BAR; PG8_SCHED;
            PG8_STAGE(PG8_SB(1, 1), b3 + hstep, voffB);
            PG8_WAIT_V(6); PG8_BAR; PG8_MMA(1, 1, At, At8, B1, B18); PG8_BAR;
            }
        }
        if constexpr (ALIGN_EPI) { if (wr == 0) PG8_BAR; }
        if constexpr (F8) asm volatile("s_nop 15\n\ts_nop 15" ::: "memory");
        if constexpr (!Epi::AFTER_DRAIN) { E(acc, cur, wr, wc, fr, fq); S.done(cur); }
        if (!has_next) break;
#pragma unroll
        for (int a = 0; a < 2; ++a)
#pragma unroll
            for (int b = 0; b < 2; ++b)
#pragma unroll
                for (int m = 0; m < 4; ++m)
#pragma unroll
                    for (int n = 0; n < 2; ++n) acc[a][b][m][n] = (f32x4){zero_, zero_, zero_, zero_};
        cur = nxt; cA = nA; cB = nB; ++ui;
        if constexpr (ALIGN_EPI) { if (wr == 1) PG8_BAR; }
    }
    PG8_WAIT_V(0);
    if constexpr (!ALIGN_EPI) { if (wr == 0) PG8_BAR; }
    PG8_BAR;
    if constexpr (Epi::AFTER_DRAIN) { E.fused(acc, cur, wr, wc, fr, fq, lds, wid, lane); S.done(cur); }
#undef PG8_SA
#undef PG8_SB
#undef PG8_STAGE
#undef PG8_LDA
#undef PG8_LDB
#undef PG8_MMA
#undef PG8_LD8
#undef PG8_WAIT_V
#undef PG8_WAIT_L
#undef PG8_BAR
#undef PG8_SCHED
#undef PG8_SCHED8
}

}

#define GAS __attribute__((address_space(1)))
#define LAS __attribute__((address_space(3)))
typedef unsigned v4u __attribute__((ext_vector_type(4)));
typedef float f32x4 __attribute__((ext_vector_type(4)));
#define LDS_WAIT() asm volatile("s_waitcnt lgkmcnt(0)" ::: "memory")
#define VM_WAIT() asm volatile("s_waitcnt vmcnt(0)" ::: "memory")

#define XB_TMO      128
#define XB_XCNT(j)  (256  + 64 * (j))
#define XB_XSUB(j)  (1280 + 64 * (j))
#define XB_XGEN(j)  (2304 + 64 * (j))
#define XB_TOP      3328
#define XB_TOPGEN   3392
#define XCD_BAR_WORDS 3456
#define XB_SPIN_CAP (1u << 18)

__device__ __forceinline__ unsigned xb_ld(unsigned* p)              { return __hip_atomic_load(p, __ATOMIC_RELAXED, __HIP_MEMORY_SCOPE_AGENT); }
__device__ __forceinline__ unsigned xb_add(unsigned* p, unsigned v) { return __hip_atomic_fetch_add(p, v, __ATOMIC_RELAXED, __HIP_MEMORY_SCOPE_AGENT); }
__device__ __forceinline__ unsigned xb_xcc_id() { return (unsigned)__builtin_amdgcn_s_getreg((3 << 11) | 20) & 0xFu; }
#define XB_SPIN(cond, bar) do { unsigned _sp = 0; while (cond) { __builtin_amdgcn_s_sleep(1); \
    if ((++_sp & 255u) == 0u) { if (xb_ld(&(bar)[XB_TMO])) break; if (_sp > XB_SPIN_CAP) { atomicAdd(&(bar)[XB_TMO], 1u); break; } } } } while (0)

struct XcdBarrier {
    unsigned* bar; unsigned x;
    volatile LAS unsigned* st;
};

__device__ __forceinline__ XcdBarrier xcd_barrier_post(unsigned* bar, volatile LAS unsigned* st, bool t0) {
    XcdBarrier b; b.bar = bar; b.x = xb_xcc_id(); b.st = st;
    if (t0) (void)xb_add(&bar[XB_XCNT(b.x)], 1u);
    return b;
}
__device__ __forceinline__ void xcd_barrier_complete(unsigned* bar, unsigned x, unsigned& nloc, unsigned& nx) {
    const unsigned G = gridDim.x * gridDim.y * gridDim.z;
    unsigned sum, cnt, mine, sp = 0u;
    for (;;) {
        sum = 0u; cnt = 0u; mine = 0u;
#pragma unroll
        for (unsigned j = 0; j < 16; ++j) { const unsigned c = xb_ld(&bar[XB_XCNT(j)]); sum += c; cnt += (c > 0u) ? 1u : 0u; mine = (j == x) ? c : mine; }
        if (sum == G) break;
        __builtin_amdgcn_s_sleep(1);
        if ((++sp & 255u) == 0u) { if (xb_ld(&bar[XB_TMO])) break; if (sp > XB_SPIN_CAP) { atomicAdd(&bar[XB_TMO], 1u); break; } }
    }
    nloc = mine > 0u ? mine : 1u; nx = cnt > 0u ? cnt : 1u;
}

__device__ __forceinline__ void xcd_barrier(const XcdBarrier& b, bool t0) {
    asm volatile("s_waitcnt vmcnt(0)" ::: "memory");
    __syncthreads();
    if (t0) {
        unsigned* bar = b.bar;
        __builtin_amdgcn_s_waitcnt(0);
        unsigned nloc = b.st[0], nx = b.st[1];
        if (nloc == 0u) { xcd_barrier_complete(bar, b.x, nloc, nx); b.st[0] = nloc; b.st[1] = nx; }
        const unsigned old = xb_add(&bar[XB_XSUB(b.x)], 1u);
        const unsigned gen = old / nloc;
        if (old + 1u == (gen + 1u) * nloc) {
            __builtin_amdgcn_fence(__ATOMIC_RELEASE, "agent");
            asm volatile("s_waitcnt vmcnt(0)" ::: "memory");
            const unsigned og = xb_add(&bar[XB_TOP], 1u);
            const unsigned tg = og / nx;
            if (og + 1u == (tg + 1u) * nx) xb_add(&bar[XB_TOPGEN], 1u);
            else XB_SPIN(xb_ld(&bar[XB_TOPGEN]) == tg, bar);
            __builtin_amdgcn_fence(__ATOMIC_ACQUIRE, "agent");
            xb_add(&bar[XB_XGEN(b.x)], 1u);
            asm volatile("s_waitcnt vmcnt(0)" ::: "memory");
        } else {
            XB_SPIN(xb_ld(&bar[XB_XGEN(b.x)]) == gen, bar);
            __builtin_amdgcn_fence(__ATOMIC_ACQUIRE, "agent");
            asm volatile("s_waitcnt vmcnt(0)" ::: "memory");
        }
    }
    __syncthreads();
}

struct XcdToken { unsigned gen, tg; int role; };
__device__ __forceinline__ XcdToken xcd_barrier_arrive(const XcdBarrier& b, bool t0) {
    XcdToken k; k.gen = 0u; k.tg = 0u; k.role = 0;
    asm volatile("s_waitcnt vmcnt(0)" ::: "memory");
    __syncthreads();
    if (t0) {
        unsigned* bar = b.bar;
        __builtin_amdgcn_s_waitcnt(0);
        unsigned nloc = b.st[0], nx = b.st[1];
        if (nloc == 0u) { xcd_barrier_complete(bar, b.x, nloc, nx); b.st[0] = nloc; b.st[1] = nx; }
        const unsigned old = xb_add(&bar[XB_XSUB(b.x)], 1u);
        k.gen = old / nloc;
        if (old + 1u == (k.gen + 1u) * nloc) {
            __builtin_amdgcn_fence(__ATOMIC_RELEASE, "agent");
            asm volatile("s_waitcnt vmcnt(0)" ::: "memory");
            const unsigned og = xb_add(&bar[XB_TOP], 1u);
            k.tg = og / nx;
            if (og + 1u == (k.tg + 1u) * nx) { xb_add(&bar[XB_TOPGEN], 1u); k.role = 2; } else k.role = 1;
        }
    }
    return k;
}
__device__ __forceinline__ void xcd_barrier_wait(const XcdBarrier& b, const XcdToken& k, bool t0) {
    if (t0) {
        unsigned* bar = b.bar;
        if (k.role) {
            if (k.role == 1) XB_SPIN(xb_ld(&bar[XB_TOPGEN]) == k.tg, bar);
            __builtin_amdgcn_fence(__ATOMIC_ACQUIRE, "agent");
            xb_add(&bar[XB_XGEN(b.x)], 1u);
            asm volatile("s_waitcnt vmcnt(0)" ::: "memory");
        } else {
            XB_SPIN(xb_ld(&bar[XB_XGEN(b.x)]) == k.gen, bar);
            __builtin_amdgcn_fence(__ATOMIC_ACQUIRE, "agent");
            asm volatile("s_waitcnt vmcnt(0)" ::: "memory");
        }
    }
    __syncthreads();
}

constexpr int RING_OFF = 0, RING_BYTES = 131072;
constexpr int MISC_OFF = 143360;
constexpr int LDS_BYTES = 147456;
constexpr int NWAVES = 8;

struct Ctx { LAS unsigned char* lds; volatile LAS unsigned* MISC; unsigned* ctl; int wave, G, gw, NGW; };

__device__ __forceinline__ void cvt_item(const float* W, int K, int N, bf16_t* WT, int mode, LAS float* scr, int item, int lane) {
    const int kblk = K / 64, nb = item / kblk, kb = item % kblk, k0 = 64 * kb, n0 = 64 * nb;
    f32x4 ld[16];
#pragma unroll
    for (int i = 0; i < 16; ++i) { const int kk = 4 * i + (lane >> 4), c4 = 4 * (lane & 15); ld[i] = __builtin_nontemporal_load((const f32x4*)(W + (size_t)(k0 + kk) * N + n0 + c4));     }
#pragma unroll
    for (int i = 0; i < 16; ++i) { const int kk = 4 * i + (lane >> 4), c4 = 4 * (lane & 15);
        LAS float* s = scr + kk * 65 + c4; s[0] = ld[i][0]; s[1] = ld[i][1]; s[2] = ld[i][2]; s[3] = ld[i][3]; }
    LDS_WAIT(); asm volatile("" ::: "memory");
    const int c = lane >> 3;
#pragma unroll
    for (int j = 0; j < 8; ++j) { const int n = (lane & 7) + 8 * j; const LAS float* s = scr + (8 * c) * 65 + n;
        v4u o; o.x = pk2(s[0 * 65], s[1 * 65]); o.y = pk2(s[2 * 65], s[3 * 65]); o.z = pk2(s[4 * 65], s[5 * 65]); o.w = pk2(s[6 * 65], s[7 * 65]);
        const int nn = n0 + n; const int drow = mode == 0 ? nn : (nn / 128) * 256 + (mode - 1) * 128 + (nn % 128);
        *(v4u*)(WT + (size_t)drow * K + k0 + 8 * c) = o; }
    LDS_WAIT(); asm volatile("" ::: "memory");
}
__device__ __forceinline__ void cvt_item8(const float* W, int K, int N, unsigned char* WT, int mode, LAS float* scr, int item, int lane) {
    const int kblk = K / 64, nb = item / kblk, kb = item % kblk, k0 = 64 * kb, n0 = 64 * nb;
    f32x4 ld[16];
#pragma unroll
    for (int i = 0; i < 16; ++i) { const int kk = 4 * i + (lane >> 4), c4 = 4 * (lane & 15); ld[i] = __builtin_nontemporal_load((const f32x4*)(W + (size_t)(k0 + kk) * N + n0 + c4));     }
#pragma unroll
    for (int i = 0; i < 16; ++i) { const int kk = 4 * i + (lane >> 4), c4 = 4 * (lane & 15);
        LAS float* s = scr + kk * 65 + c4; s[0] = ld[i][0]; s[1] = ld[i][1]; s[2] = ld[i][2]; s[3] = ld[i][3]; }
    LDS_WAIT(); asm volatile("" ::: "memory");
    const int c = lane >> 3;
#pragma unroll
    for (int j = 0; j < 8; ++j) { const int n = (lane & 7) + 8 * j; const LAS float* s = scr + (8 * c) * 65 + n;
        v2u o; o.x = pk4_fp8(s[0 * 65] * W8_SCALE, s[1 * 65] * W8_SCALE, s[2 * 65] * W8_SCALE, s[3 * 65] * W8_SCALE); o.y = pk4_fp8(s[4 * 65] * W8_SCALE, s[5 * 65] * W8_SCALE, s[6 * 65] * W8_SCALE, s[7 * 65] * W8_SCALE);
        const int nn = n0 + n; const int drow = mode == 0 ? nn : (nn / 128) * 256 + (mode - 1) * 128 + (nn % 128);
        *(v2u*)(WT + (size_t)drow * K + k0 + 8 * c) = o; }
    LDS_WAIT(); asm volatile("" ::: "memory");
}
constexpr int MOE_S_F = 16 * 44, MOE_ITEMS = 24 * MOE_S_F;
__device__ __forceinline__ void moe_cvt_item(const Params& p, int r, LAS float* scr, int lane_) {
    constexpr int S_F = MOE_S_F;
    if (r < 8 * S_F) { const int e = r / S_F; cvt_item8(p.in[I_MWG] + (size_t)e * DM * DFF, DM, DFF, (unsigned char*)(p.ws + W_MGU) + (size_t)e * 2 * DFF * DM, 1, scr, r % S_F, lane_); return; } r -= 8 * S_F;
    if (r < 8 * S_F) { const int e = r / S_F; cvt_item8(p.in[I_MWU] + (size_t)e * DM * DFF, DM, DFF, (unsigned char*)(p.ws + W_MGU) + (size_t)e * 2 * DFF * DM, 2, scr, r % S_F, lane_); return; } r -= 8 * S_F;
    { const int e = r / S_F; cvt_item8(p.in[I_MWD] + (size_t)e * DFF * DM, DFF, DM, (unsigned char*)(p.ws + W_MD) + (size_t)e * DM * DFF, 0, scr, r % S_F, lane_); }
}
#if SEAM_CVT
constexpr int SEAM_CVT_SEAMS = 17;
__device__ __forceinline__ void seam_fill(const Params& p, Ctx& F, int s) {
    if (s >= SEAM_CVT_SEAMS || (F.wave & 1) != (s & 1)) return;
    const int it = s * (F.G * 4) + (int)blockIdx.x * 4 + (F.wave >> 1);
    if (it < MOE_ITEMS) moe_cvt_item(p, it, (LAS float*)(F.lds + RING_OFF) + F.wave * (64 * 65), lane_id());
}
__device__ __forceinline__ void moe_cvt_rest(const Params& p, Ctx& F) {
    for (int it = SEAM_CVT_SEAMS * (F.G * 4) + F.gw; it < MOE_ITEMS; it += F.NGW) moe_cvt_item(p, it, (LAS float*)(F.lds + RING_OFF) + F.wave * (64 * 65), lane_id());
}
#endif
__device__ __forceinline__ void p0_prologue(const Params& p, Ctx& F) {
    const int lane_ = lane_id(), tid_ = F.wave * 64 + lane_;
    LAS float* fl = (LAS float*)(F.lds + RING_OFF);
    for (int it = blockIdx.x; it < 192; it += F.G) {
        const int l = it / 96, n = (it % 96) * 64 + lane_;
        LAS float* sv = fl;
        LAS float* red = fl + 3 * 1024;
        for (int i = tid_; i < 3 * 1024; i += 512) { const int rt = i >> 10, k = i & 1023; const float v = rt < 2 ? p.in[I_C][rt * DM + k] : p.in[I_CCTX][k]; sv[i] = siluf(v); }
        __syncthreads();
        const float* W = p.in[I_ADAW] + (size_t)l * DM * 6144 + n;
        float a0 = 0.f, a1 = 0.f, a2 = 0.f;
        for (int kb = 0; kb < 128; kb += 32) {
            float wv[32];
#pragma unroll
            for (int j = 0; j < 32; ++j) wv[j] = W[(size_t)(F.wave * 128 + kb + j) * 6144];
#pragma unroll
            for (int j = 0; j < 32; ++j) { const int k = F.wave * 128 + kb + j; a0 += sv[k] * wv[j]; a1 += sv[1024 + k] * wv[j]; a2 += sv[2048 + k] * wv[j]; }
        }
        red[(F.wave * 3 + 0) * 64 + lane_] = a0; red[(F.wave * 3 + 1) * 64 + lane_] = a1; red[(F.wave * 3 + 2) * 64 + lane_] = a2;
        __syncthreads();
        if (tid_ < 192) { const int rt = tid_ >> 6, ln = tid_ & 63; float s = 0.f;
#pragma unroll
            for (int w = 0; w < 8; ++w) s += red[(w * 3 + rt) * 64 + ln];
            const int nn = (it % 96) * 64 + ln;
            ((float*)(p.ws + WS_MODV))[(size_t)(l * 3 + rt) * 6144 + nn] = s + p.in[I_ADAB][l * 6144 + nn]; }
        __syncthreads();
    }
    LAS float* scr = (LAS float*)(F.lds + RING_OFF) + F.wave * (64 * 65);
    constexpr int S_WIN = 16 * 56, S_WOUT = 16 * 16, S_F = 16 * 44;
    constexpr int NITEMS = 2 * S_WIN + 2 * S_WOUT + 3 * S_F + (SEAM_CVT ? 0 : 24 * S_F);
    static_assert(NITEMS + (SEAM_CVT ? 24 * S_F : 0) == 21312, "items");
    for (int it = F.gw; it < NITEMS; it += F.NGW) {
        int r = it;
        if (r < 2 * S_WIN) { const int l = r / S_WIN; cvt_item(p.in[I_WIN] + (size_t)l * DM * DP, DM, DP, (bf16_t*)(p.ws + W_WIN) + (size_t)l * DP * DM, 0, scr, r % S_WIN, lane_); continue; } r -= 2 * S_WIN;
        if (r < 2 * S_WOUT) { const int l = r / S_WOUT; cvt_item(p.in[I_WOUT] + (size_t)l * DM * DM, DM, DM, (bf16_t*)(p.ws + W_WOUT) + (size_t)l * DM * DM, 0, scr, r % S_WOUT, lane_); continue; } r -= 2 * S_WOUT;
        if (r < S_F) { cvt_item(p.in[I_FWG], DM, DFF, (bf16_t*)(p.ws + W_FGU), 1, scr, r, lane_); continue; } r -= S_F;
        if (r < S_F) { cvt_item(p.in[I_FWU], DM, DFF, (bf16_t*)(p.ws + W_FGU), 2, scr, r, lane_); continue; } r -= S_F;
        if (r < S_F) { cvt_item(p.in[I_FWD], DFF, DM, (bf16_t*)(p.ws + W_FD), 0, scr, r, lane_); continue; } r -= S_F;
        moe_cvt_item(p, r, scr, lane_);
    }
}

__device__ __forceinline__ void norm_phase(const Params& p, Ctx& F, int l, int which, int nrows) {
    const int lane_ = lane_id(), tid_ = F.wave * 64 + lane_;
    const float* g = p.in[which ? I_N2G : I_N1G] + l * DM;
    for (int m = F.gw; m < nrows; m += F.NGW) {
        const float* xrow;
        if (l == 0 && which == 0) xrow = m < NL ? p.in[I_X] + (size_t)m * DM : p.in[I_CTX] + (size_t)(m - NL) * DM;
        else xrow = xr_row(p, m);
        const int rt = rowtype(m);
        const float* sh = modv(p, l, rt, which ? 3 : 0); const float* sc = modv(p, l, rt, which ? 4 : 1);
        f32x4 v[4]; float ss = 0.f;
        if (m >= NL && !(l == 0 && which == 0)) {
            const int nsl = which ? DM / 256 : DFF / 256; const float* gate = modv(p, 0, 2, which ? 2 : 5);
            const float* base = (l == 0) ? p.in[I_CTX] + (size_t)(m - NL) * DM : xrow;
            const float* part = (const float*)(p.ws + WS_PART) + (size_t)(m - NL) * DM;
#pragma unroll
            for (int j = 0; j < 4; ++j) { const int col = 256 * j + 4 * lane_; f32x4 a = {0.f, 0.f, 0.f, 0.f};
                for (int sl = 0; sl < nsl; ++sl) a += *(const f32x4*)(part + (size_t)sl * NC * DM + col);
                v[j] = *(const f32x4*)(base + col) + *(const f32x4*)(gate + col) * a;
                *(f32x4*)((float*)(p.ws + WS_XRC) + (size_t)(m - NL) * DM + col) = v[j];
                ss += (v[j][0] * v[j][0] + v[j][1] * v[j][1]) + (v[j][2] * v[j][2] + v[j][3] * v[j][3]); }
        } else
#pragma unroll
        for (int j = 0; j < 4; ++j) { v[j] = *(const f32x4*)(xrow + 256 * j + 4 * lane_); ss += (v[j][0] * v[j][0] + v[j][1] * v[j][1]) + (v[j][2] * v[j][2] + v[j][3] * v[j][3]); }
        const float r = rsqrtf(wave_sum(ss) * (1.f / DM) + EPS);
        bf16_t* hb = (bf16_t*)(p.ws + WS_HBUF) + (size_t)m * DM;
#pragma unroll
        for (int j = 0; j < 4; ++j) { const int col = 256 * j + 4 * lane_;
            const f32x4 gg = *(const f32x4*)(g + col), s4 = *(const f32x4*)(sc + col), h4 = *(const f32x4*)(sh + col);
            const f32x4 y = v[j] * r * gg * (1.f + s4) + h4;
            v2u o; o.x = pk2(y[0], y[1]); o.y = pk2(y[2], y[3]); *(v2u*)(hb + col) = o; }
    }
}


__device__ __forceinline__ void router_phase(const Params& p, Ctx& F) {
    const int lane_ = lane_id(), tid_ = F.wave * 64 + lane_;
    LAS int* lcnt = (LAS int*)(F.lds + RING_OFF);
    LAS int* gbase = lcnt + 8;
    LAS int* ent_e = lcnt + 16;
    LAS int* ent_pos = lcnt + 16 + 128;
    const float* g = p.in[I_N2G] + DM; const float* rw = p.in[I_RW];
    int* tok_e = (int*)(p.ws + WS_ROUTE); float* tok_w = (float*)(p.ws + WS_ROUTE) + 2 * NL; int* tok_pos = (int*)(p.ws + WS_ROUTE) + 4 * NL;
    f32x4 rwa[4][4], rwb[4][4];
#pragma unroll
    for (int j = 0; j < 4; ++j)
#pragma unroll
        for (int q = 0; q < 4; ++q) { const int col = 256 * j + 4 * lane_ + q; rwa[j][q] = *(const f32x4*)(rw + (size_t)col * 8); rwb[j][q] = *(const f32x4*)(rw + (size_t)col * 8 + 4); }
    const int myexp = ((lane_ >> 5) & 1) * 4 + ((lane_ >> 4) & 1) * 2 + ((lane_ >> 3) & 1);
    for (int ch = blockIdx.x; ch < NL / 64; ch += F.G) {
        if (tid_ < 8) lcnt[tid_] = 0;
        __syncthreads();
        const int rt = (ch * 64) / T;
        const float* sh = modv(p, 1, rt, 3); const float* sc = modv(p, 1, rt, 4);
        f32x4 gs[4], hs[4]; float bsum;
        { float bb[8] = {0.f, 0.f, 0.f, 0.f, 0.f, 0.f, 0.f, 0.f};
#pragma unroll
          for (int j = 0; j < 4; ++j) { const int col = 256 * j + 4 * lane_; gs[j] = *(const f32x4*)(g + col) * (1.f + *(const f32x4*)(sc + col)); hs[j] = *(const f32x4*)(sh + col);
#pragma unroll
            for (int q = 0; q < 4; ++q) { bb[0] += hs[j][q] * rwa[j][q][0]; bb[1] += hs[j][q] * rwa[j][q][1]; bb[2] += hs[j][q] * rwa[j][q][2]; bb[3] += hs[j][q] * rwa[j][q][3];
                                          bb[4] += hs[j][q] * rwb[j][q][0]; bb[5] += hs[j][q] * rwb[j][q][1]; bb[6] += hs[j][q] * rwb[j][q][2]; bb[7] += hs[j][q] * rwb[j][q][3]; } }
          float c4[4];
#pragma unroll
          for (int k = 0; k < 4; ++k) { const float keep = (lane_ & 32) ? bb[k + 4] : bb[k], give = (lane_ & 32) ? bb[k] : bb[k + 4]; c4[k] = keep + __shfl_xor(give, 32); }
          float c2[2];
#pragma unroll
          for (int k = 0; k < 2; ++k) { const float keep = (lane_ & 16) ? c4[k + 2] : c4[k], give = (lane_ & 16) ? c4[k] : c4[k + 2]; c2[k] = keep + __shfl_xor(give, 16); }
          float c1 = ((lane_ & 8) ? c2[1] : c2[0]) + __shfl_xor((lane_ & 8) ? c2[0] : c2[1], 8);
          c1 += __shfl_xor(c1, 4); c1 += __shfl_xor(c1, 2); c1 += __shfl_xor(c1, 1);
          bsum = c1 + p.in[I_RB][myexp]; }
        for (int i = 0; i < 8; ++i) {
            const int ti = F.wave * 8 + i, m = ch * 64 + ti;
            const float* xrow = p.out + (size_t)m * DM;
            f32x4 v[4]; float ss = 0.f; float aa[8] = {0.f, 0.f, 0.f, 0.f, 0.f, 0.f, 0.f, 0.f};
#pragma unroll
            for (int j = 0; j < 4; ++j) { v[j] = *(const f32x4*)(xrow + 256 * j + 4 * lane_); ss += (v[j][0] * v[j][0] + v[j][1] * v[j][1]) + (v[j][2] * v[j][2] + v[j][3] * v[j][3]); }
#pragma unroll
            for (int j = 0; j < 4; ++j) { v[j] = v[j] * gs[j];
#pragma unroll
                for (int q = 0; q < 4; ++q) { aa[0] += v[j][q] * rwa[j][q][0]; aa[1] += v[j][q] * rwa[j][q][1]; aa[2] += v[j][q] * rwa[j][q][2]; aa[3] += v[j][q] * rwa[j][q][3];
                                              aa[4] += v[j][q] * rwb[j][q][0]; aa[5] += v[j][q] * rwb[j][q][1]; aa[6] += v[j][q] * rwb[j][q][2]; aa[7] += v[j][q] * rwb[j][q][3]; } }
            float c4[4];
#pragma unroll
            for (int k = 0; k < 4; ++k) { const float keep = (lane_ & 32) ? aa[k + 4] : aa[k], give = (lane_ & 32) ? aa[k] : aa[k + 4]; c4[k] = keep + __shfl_xor(give, 32); }
            float c2[2];
#pragma unroll
            for (int k = 0; k < 2; ++k) { const float keep = (lane_ & 16) ? c4[k + 2] : c4[k], give = (lane_ & 16) ? c4[k] : c4[k + 2]; c2[k] = keep + __shfl_xor(give, 16); }
            float c1 = ((lane_ & 8) ? c2[1] : c2[0]) + __shfl_xor((lane_ & 8) ? c2[0] : c2[1], 8);
            c1 += __shfl_xor(c1, 4); c1 += __shfl_xor(c1, 2); c1 += __shfl_xor(c1, 1);
            const float r = rsqrtf(wave_sum(ss) * (1.f / DM) + EPS);
            const float mylogit = r * c1 + bsum;
#define RLF(L) __uint_as_float((unsigned)__builtin_amdgcn_readlane((int)__float_as_uint(mylogit), L))
            const float lg0 = RLF(0), lg1 = RLF(8), lg2 = RLF(16), lg3 = RLF(24), lg4 = RLF(32), lg5 = RLF(40), lg6 = RLF(48), lg7 = RLF(56);
#undef RLF
            unsigned char* hb = (unsigned char*)(p.ws + WS_HBUF) + (size_t)m * DM;
#pragma unroll
            for (int j = 0; j < 4; ++j) { const f32x4 y = v[j] * r + hs[j]; *(unsigned*)(hb + 256 * j + 4 * lane_) = pk4_fp8(y[0], y[1], y[2], y[3]); }
            int i1 = 0; float v1 = lg0;
            if (lg1 > v1) { v1 = lg1; i1 = 1; } if (lg2 > v1) { v1 = lg2; i1 = 2; } if (lg3 > v1) { v1 = lg3; i1 = 3; }
            if (lg4 > v1) { v1 = lg4; i1 = 4; } if (lg5 > v1) { v1 = lg5; i1 = 5; } if (lg6 > v1) { v1 = lg6; i1 = 6; } if (lg7 > v1) { v1 = lg7; i1 = 7; }
            int i2 = -1; float v2 = -3.4e38f;
            if (i1 != 0 && lg0 > v2) { v2 = lg0; i2 = 0; } if (i1 != 1 && lg1 > v2) { v2 = lg1; i2 = 1; } if (i1 != 2 && lg2 > v2) { v2 = lg2; i2 = 2; } if (i1 != 3 && lg3 > v2) { v2 = lg3; i2 = 3; }
            if (i1 != 4 && lg4 > v2) { v2 = lg4; i2 = 4; } if (i1 != 5 && lg5 > v2) { v2 = lg5; i2 = 5; } if (i1 != 6 && lg6 > v2) { v2 = lg6; i2 = 6; } if (i1 != 7 && lg7 > v2) { v2 = lg7; i2 = 7; }
            const float w1 = 1.f / (1.f + __expf(v2 - v1));
            if (lane_ == 0) {
                const int p1 = __hip_atomic_fetch_add(lcnt + i1, 1, __ATOMIC_RELAXED, __HIP_MEMORY_SCOPE_WORKGROUP);
                const int p2 = __hip_atomic_fetch_add(lcnt + i2, 1, __ATOMIC_RELAXED, __HIP_MEMORY_SCOPE_WORKGROUP);
                ent_e[2 * ti] = i1; ent_e[2 * ti + 1] = i2; ent_pos[2 * ti] = p1; ent_pos[2 * ti + 1] = p2;
                tok_e[2 * m] = i1; tok_e[2 * m + 1] = i2; tok_w[2 * m] = w1; tok_w[2 * m + 1] = 1.f - w1; }
        }
        __syncthreads();
        if (tid_ < 8) gbase[tid_] = (int)__hip_atomic_fetch_add(F.ctl + CW_CNT + 64 * tid_, (unsigned)lcnt[tid_], __ATOMIC_RELAXED, __HIP_MEMORY_SCOPE_AGENT);
        __syncthreads();
        if (tid_ < 128) tok_pos[ch * 128 + tid_] = gbase[ent_e[tid_]] + ent_pos[tid_];
        __syncthreads();
    }
}
__device__ __forceinline__ void moe_table(Ctx& F) {
    const int lane_ = lane_id(), tid_ = F.wave * 64 + lane_;
    volatile LAS unsigned* tb = F.MISC + 32;
    if (tid_ == 0) { unsigned acc = 0;
        for (int e = 0; e < 8; ++e) { const unsigned c = __hip_atomic_load(F.ctl + CW_CNT + 64 * e, __ATOMIC_RELAXED, __HIP_MEMORY_SCOPE_AGENT); tb[e] = acc; tb[16 + e] = c; acc += (c + 255u) / 256u * 256u; }
        tb[8] = acc; }
    __syncthreads();
}
__device__ __forceinline__ void moe_order(Ctx& F, pg8::Order& S, int nN, long estride) {
    volatile LAS unsigned* tb = F.MISC + 32;
#define RFL(x) __builtin_amdgcn_readfirstlane((int)(x))
    S.init(RFL(tb[8] / 256u), nN, F.G, (int)blockIdx.x);
    S.e1 = RFL(tb[1] / 256u); S.e2 = RFL(tb[2] / 256u); S.e3 = RFL(tb[3] / 256u); S.e4 = RFL(tb[4] / 256u); S.e5 = RFL(tb[5] / 256u); S.e6 = RFL(tb[6] / 256u); S.e7 = RFL(tb[7] / 256u);
#undef RFL
    S.estride = estride;
}
__device__ __forceinline__ void gather_phase(const Params& p, Ctx& F) {
    const int lane_ = lane_id(), tid_ = F.wave * 64 + lane_;
    moe_table(F);
    volatile LAS unsigned* tb = F.MISC + 32;
    const int* tok_e = (const int*)(p.ws + WS_ROUTE); const float* tok_w = (const float*)(p.ws + WS_ROUTE) + 2 * NL; const int* tok_pos = (const int*)(p.ws + WS_ROUTE) + 4 * NL;
    int* row_tok = (int*)(p.ws + WS_ROUTE) + 6 * NL; float* row_gate = (float*)(p.ws + WS_ROUTE) + 6 * NL + MP_MAX;
    const unsigned char* hb = (const unsigned char*)(p.ws + WS_HBUF); unsigned char* h2s = (unsigned char*)(p.ws + WS_H2S);
    for (int it = F.gw; it < 2 * NL; it += F.NGW) {
        const int t = it >> 1, e = tok_e[it], r = (int)tb[e] + tok_pos[it];
        *((v4u*)(h2s + (size_t)r * DM) + lane_) = *((const v4u*)(hb + (size_t)t * DM) + lane_);
        if (lane_ == 0) { row_tok[r] = t; row_gate[r] = tok_w[it]; }
    }
    for (int i = F.gw; i < NE * 256; i += F.NGW) {
        const int e = i >> 8, j = i & 255, r = (int)tb[e] + (int)tb[16 + e] + j;
        if (r < (int)tb[e + 1]) { const v4u z = {0u, 0u, 0u, 0u}; *((v4u*)(h2s + (size_t)r * DM) + lane_) = z; if (lane_ == 0) { row_tok[r] = -1; row_gate[r] = 0.f; } }
    }
}
__device__ __forceinline__ void combine_phase(const Params& p, Ctx& F) {
    const int lane_ = lane_id(), tid_ = F.wave * 64 + lane_;
    moe_table(F);
    volatile LAS unsigned* tb = F.MISC + 32;
    const int* tok_e = (const int*)(p.ws + WS_ROUTE); const int* tok_pos = (const int*)(p.ws + WS_ROUTE) + 4 * NL;
    const bf16_t* yb = (const bf16_t*)(p.ws + WS_YBUF);
    for (int t = F.gw; t < NL; t += F.NGW) {
        const int r0 = (int)tb[tok_e[2 * t]] + tok_pos[2 * t], r1 = (int)tb[tok_e[2 * t + 1]] + tok_pos[2 * t + 1];
        const float* g5 = modv(p, 1, t / T, 5);
        float* orow = p.out + (size_t)t * DM;
#pragma unroll
        for (int j = 0; j < 4; ++j) { const int col = 256 * j + 4 * lane_;
            const v2u a = *(const v2u*)(yb + (size_t)r0 * DM + col), b = *(const v2u*)(yb + (size_t)r1 * DM + col);
            f32x4 y; y[0] = __uint_as_float(a.x << 16) + __uint_as_float(b.x << 16); y[1] = __uint_as_float(a.x & 0xffff0000u) + __uint_as_float(b.x & 0xffff0000u);
            y[2] = __uint_as_float(a.y << 16) + __uint_as_float(b.y << 16); y[3] = __uint_as_float(a.y & 0xffff0000u) + __uint_as_float(b.y & 0xffff0000u);
            const f32x4 x = *(const f32x4*)(orow + col), gg = *(const f32x4*)(g5 + col);
            *(f32x4*)(orow + col) = x + gg * y; }
    }
}

namespace att {
constexpr float THR = 8.f;
constexpr int KVBLK = 64;
constexpr int SHM_V = KVBLK * 128 * 2, SHM_K = KVBLK * 128 * 2;
using bf16x8 = __attribute__((ext_vector_type(8))) short;
using s16x4  = __attribute__((ext_vector_type(4))) short;
using f32x16 = __attribute__((ext_vector_type(16))) float;
using f32x8  = __attribute__((ext_vector_type(8))) float;
using u32x4  = __attribute__((ext_vector_type(4))) unsigned;
using f32x4v = __attribute__((ext_vector_type(4))) float;
#define KSWZ(row, colB) ((row) * 256 + ((colB) ^ (((row) & 7) << 4)))
#define SBAR() __builtin_amdgcn_sched_barrier(0)
__device__ __forceinline__ int crow(int r, int hi) { return (r & 3) + 8 * (r >> 2) + 4 * hi; }
__device__ __forceinline__ unsigned cvtpk(float lo, float hi) {
  unsigned r; asm volatile("v_cvt_pk_bf16_f32 %0, %1, %2" : "=v"(r) : "v"(lo), "v"(hi)); return r;
}
__device__ __forceinline__ void partialSM(f32x16& p0, f32x16& p1, float& m_reg, float& mn, float& alpha) {
  constexpr float C = 1.4426950408889634f;
  float pmax = p0[0]; for (int r = 1; r < 16; ++r) pmax = fmaxf(pmax, p0[r]); for (int r = 0; r < 16; ++r) pmax = fmaxf(pmax, p1[r]);
  { auto rr = __builtin_amdgcn_permlane32_swap(__float_as_uint(pmax), __float_as_uint(pmax), false, false);
    pmax = fmaxf(__uint_as_float(rr[0]), __uint_as_float(rr[1])); }
  if (__builtin_expect(__all(pmax - m_reg <= THR), 1)) { mn = m_reg; alpha = 1.f; }
  else { mn = fmaxf(m_reg, pmax); alpha = __builtin_amdgcn_exp2f((m_reg - mn) * C); m_reg = mn; }
  float mnC = -mn * C;
  for (int r = 0; r < 16; ++r) p0[r] = fmaf(p0[r], C, mnC); for (int r = 0; r < 16; ++r) p1[r] = fmaf(p1[r], C, mnC);
  for (int r = 0; r < 16; ++r) p0[r] = __builtin_amdgcn_exp2f(p0[r]);
}
__device__ __forceinline__ void finishSM(f32x16& p0, f32x16& p1, float alpha, float& l_reg, bf16x8& pa0, bf16x8& pa1, bf16x8& pa2, bf16x8& pa3) {
  for (int r = 0; r < 16; ++r) p1[r] = __builtin_amdgcn_exp2f(p1[r]);
  float ps = 0; for (int r = 0; r < 16; ++r) ps += p0[r]; for (int r = 0; r < 16; ++r) ps += p1[r];
  { auto rr = __builtin_amdgcn_permlane32_swap(__float_as_uint(ps), __float_as_uint(ps), false, false);
    ps = __uint_as_float(rr[0]) + __uint_as_float(rr[1]); }
  l_reg = l_reg * alpha + ps;
#define PK4(P, BASE, OUT) do { unsigned a0 = cvtpk(P[BASE + 0], P[BASE + 1]), a1 = cvtpk(P[BASE + 2], P[BASE + 3]);   \
    unsigned b0 = cvtpk(P[BASE + 4], P[BASE + 5]), b1 = cvtpk(P[BASE + 6], P[BASE + 7]);                              \
    auto r0 = __builtin_amdgcn_permlane32_swap(a0, b0, false, false); auto r1 = __builtin_amdgcn_permlane32_swap(a1, b1, false, false); \
    u32x4 w = {r0[0], r1[0], r0[1], r1[1]}; OUT = *reinterpret_cast<bf16x8*>(&w); } while (0)
  PK4(p0, 0, pa0); PK4(p0, 8, pa1); PK4(p1, 0, pa2); PK4(p1, 8, pa3);
#undef PK4
}
template <int ND0>
__device__ __forceinline__ void qkt(f32x16& p0, f32x16& p1, const LAS char* Ks, const bf16x8* qr, int r32, int hi, int dbase) {
  p0 = f32x16{}; p1 = f32x16{};
#pragma unroll
  for (int d0 = 0; d0 < ND0; ++d0) { int cb = ((dbase + d0) * 16 + hi * 8) * 2;
    bf16x8 b0 = *reinterpret_cast<const LAS bf16x8*>(Ks + KSWZ(r32, cb));
    bf16x8 b1 = *reinterpret_cast<const LAS bf16x8*>(Ks + KSWZ(32 + r32, cb));
    p0 = __builtin_amdgcn_mfma_f32_32x32x16_bf16(b0, qr[d0], p0, 0, 0, 0);
    p1 = __builtin_amdgcn_mfma_f32_32x32x16_bf16(b1, qr[d0], p1, 0, 0, 0); }
}
__device__ __forceinline__ int v_st(int k, int c) { const int kk = (k & ~0xC) | ((k & 4) << 1) | ((k & 8) >> 1); return ((kk >> 3) * 4 + (c >> 5)) * 512 + ((kk & 7) * 32 + (c & 31)) * 2; }
__device__ __forceinline__ int v_st_lin(int k, int c) { return ((k >> 3) * 4 + (c >> 5)) * 512 + ((k & 7) * 32 + (c & 31)) * 2; }
__device__ __forceinline__ int v_rd_base(int lane) { return ((lane & 3) << 3) | (((lane >> 2) & 3) << 6) | (((lane >> 4) & 1) << 5) | (((lane >> 5) & 1) << 8); }
constexpr int v_rd_off(int d0, int ks, int half) { return d0 * 512 + ks * 4096 + half * 2048; }
template <int OFF> __device__ __forceinline__ s16x4 tr_read(int vb) {
  s16x4 r; asm volatile("ds_read_b64_tr_b16 %0, %1 offset:%2" : "=&v"(r) : "v"(vb), "i"(OFF) : "memory"); return r;
}
template <int D0> __device__ __forceinline__ void pv_one(f32x16& od, int vb, bf16x8 pa0, bf16x8 pa1, bf16x8 pa2, bf16x8 pa3) {
  const s16x4 l0 = tr_read<v_rd_off(D0, 0, 0)>(vb), h0 = tr_read<v_rd_off(D0, 0, 1)>(vb), l1 = tr_read<v_rd_off(D0, 1, 0)>(vb), h1 = tr_read<v_rd_off(D0, 1, 1)>(vb);
  const s16x4 l2 = tr_read<v_rd_off(D0, 2, 0)>(vb), h2 = tr_read<v_rd_off(D0, 2, 1)>(vb), l3 = tr_read<v_rd_off(D0, 3, 0)>(vb), h3 = tr_read<v_rd_off(D0, 3, 1)>(vb);
#if defined(DUMMY_TR) && DUMMY_TR
  { s16x4 dd; for (int i = 0; i < DUMMY_TR; ++i) asm volatile("ds_read_b64_tr_b16 %0, %1 offset:%2" : "=&v"(dd) : "v"(vb), "i"(v_rd_off(D0, 0, 0)) : "memory"); }
#endif
#if defined(DUMMY_MFMA) && DUMMY_MFMA
  { f32x4v dm = {0.f, 0.f, 0.f, 0.f}; for (int i = 0; i < DUMMY_MFMA; ++i) asm volatile("v_mfma_f32_16x16x32_bf16 %0, %1, %2, %0" : "+v"(dm) : "v"(pa0), "v"(pa1)); }
#endif
  asm volatile("s_waitcnt lgkmcnt(0)" ::: "memory"); SBAR();
#define PK(L, H) (bf16x8){L[0], L[1], L[2], L[3], H[0], H[1], H[2], H[3]}
  od = __builtin_amdgcn_mfma_f32_32x32x16_bf16(pa0, PK(l0, h0), od, 0, 0, 0);
  od = __builtin_amdgcn_mfma_f32_32x32x16_bf16(pa1, PK(l1, h1), od, 0, 0, 0);
  od = __builtin_amdgcn_mfma_f32_32x32x16_bf16(pa2, PK(l2, h2), od, 0, 0, 0);
  od = __builtin_amdgcn_mfma_f32_32x32x16_bf16(pa3, PK(l3, h3), od, 0, 0, 0);
#undef PK
}
__device__ __forceinline__ void pv_d0(f32x16* o, int vb, bf16x8 pa0, bf16x8 pa1, bf16x8 pa2, bf16x8 pa3) {
  pv_one<0>(o[0], vb, pa0, pa1, pa2, pa3); pv_one<1>(o[1], vb, pa0, pa1, pa2, pa3); pv_one<2>(o[2], vb, pa0, pa1, pa2, pa3); pv_one<3>(o[3], vb, pa0, pa1, pa2, pa3);
}

#ifndef DUMMY_EXP
#define DUMMY_EXP 0
#endif
#ifndef DUMMY_TR
#define DUMMY_TR 0
#endif
#ifndef DUMMY_MFMA
#define DUMMY_MFMA 0
#endif
__device__ __forceinline__ void dummy_exp(float x) { float d; for (int i = 0; i < DUMMY_EXP; ++i) asm volatile("v_exp_f32 %0, %1" : "=v"(d) : "v"(x)); }
__device__ __forceinline__ void expA(f32x16& p0) {
#pragma unroll
  for (int r = 0; r < 16; ++r) { dummy_exp(p0[r]); p0[r] = __builtin_amdgcn_exp2f(p0[r]); }
}
__device__ __forceinline__ void expB_sum_pack(f32x16& p0, f32x16& p1, float& l_reg, bf16x8& pa0, bf16x8& pa1, bf16x8& pa2, bf16x8& pa3) {
#pragma unroll
  for (int r = 0; r < 16; ++r) { dummy_exp(p1[r]); p1[r] = __builtin_amdgcn_exp2f(p1[r]); }
  float ps = 0;
#pragma unroll
  for (int r = 0; r < 16; ++r) ps += p0[r];
#pragma unroll
  for (int r = 0; r < 16; ++r) ps += p1[r];
  { auto rr = __builtin_amdgcn_permlane32_swap(__float_as_uint(ps), __float_as_uint(ps), false, false);
    ps = __uint_as_float(rr[0]) + __uint_as_float(rr[1]); }
  l_reg += ps;
#define PK4(P, BASE, OUT) do { unsigned a0 = cvtpk(P[BASE + 0], P[BASE + 1]), a1 = cvtpk(P[BASE + 2], P[BASE + 3]);   \
    unsigned b0 = cvtpk(P[BASE + 4], P[BASE + 5]), b1 = cvtpk(P[BASE + 6], P[BASE + 7]);                              \
    auto r0 = __builtin_amdgcn_permlane32_swap(a0, b0, false, false); auto r1 = __builtin_amdgcn_permlane32_swap(a1, b1, false, false); \
    u32x4 w = {r0[0], r1[0], r0[1], r1[1]}; OUT = *reinterpret_cast<bf16x8*>(&w); } while (0)
  PK4(p0, 0, pa0); PK4(p0, 8, pa1); PK4(p1, 0, pa2); PK4(p1, 8, pa3);
#undef PK4
}
__device__ __forceinline__ bf16x8 ld8(const bf16_t* p) { return *reinterpret_cast<const bf16x8*>(p); }

constexpr int TP = 132;
__device__ __forceinline__ void tile_to_rows(const f32x16 (&o)[4], LAS float* scr, int r32, int hi, float (&v)[64]) {
#pragma unroll
  for (int d0 = 0; d0 < 4; ++d0)
#pragma unroll
    for (int r = 0; r < 16; ++r) scr[crow(r, hi) * TP + 32 * d0 + r32] = o[d0][r];
  asm volatile("s_waitcnt lgkmcnt(0)" ::: "memory");
#pragma unroll
  for (int i = 0; i < 16; ++i) { const f32x4v t = *(const LAS f32x4v*)(scr + r32 * TP + 64 * hi + 4 * i); v[4 * i] = t[0]; v[4 * i + 1] = t[1]; v[4 * i + 2] = t[2]; v[4 * i + 3] = t[3]; }
}
__device__ __forceinline__ float pair_sum(float x) {
  auto rr = __builtin_amdgcn_permlane32_swap(__float_as_uint(x), __float_as_uint(x), false, false); return __uint_as_float(rr[0]) + __uint_as_float(rr[1]);
}


#define PVX_RD2(L0, H0, D0, KS) do { L0 = tr_read<v_rd_off(D0, KS, 0)>(vb); H0 = tr_read<v_rd_off(D0, KS, 1)>(vb); } while (0)
#define PVX_PK(L, H) (bf16x8){L[0], L[1], L[2], L[3], H[0], H[1], H[2], H[3]}
#define PVX_E(i) do { if (DOEXP) { pn[i] = __builtin_amdgcn_exp2f(pn[i]); psn += pn[i]; } } while (0)
#define PVX_W(n) asm volatile("s_waitcnt lgkmcnt(" #n ")" ::: "memory")
#define PVX_BLOCK(D0, E0) do { \
    PVX_W(6); SBAR(); o[D0] = __builtin_amdgcn_mfma_f32_32x32x16_bf16(pa0, PVX_PK(fl0, fh0), o[D0], 0, 0, 0); PVX_E(E0 + 0); PVX_RD2(fl0, fh0, D0 + 1, 0); SBAR(); \
    PVX_W(6); SBAR(); o[D0] = __builtin_amdgcn_mfma_f32_32x32x16_bf16(pa1, PVX_PK(fl1, fh1), o[D0], 0, 0, 0); PVX_E(E0 + 1); PVX_RD2(fl1, fh1, D0 + 1, 1); SBAR(); \
    PVX_W(6); SBAR(); o[D0] = __builtin_amdgcn_mfma_f32_32x32x16_bf16(pa2, PVX_PK(fl2, fh2), o[D0], 0, 0, 0); PVX_E(E0 + 2); PVX_RD2(fl2, fh2, D0 + 1, 2); SBAR(); \
    PVX_W(6); SBAR(); o[D0] = __builtin_amdgcn_mfma_f32_32x32x16_bf16(pa3, PVX_PK(fl3, fh3), o[D0], 0, 0, 0); PVX_E(E0 + 3); PVX_RD2(fl3, fh3, D0 + 1, 3); SBAR(); } while (0)
template <bool DOEXP>
__device__ __forceinline__ void pv_exp(f32x16* o, int vb, bf16x8 pa0, bf16x8 pa1, bf16x8 pa2, bf16x8 pa3, f32x16& pn, float& psn) {
  s16x4 fl0, fh0, fl1, fh1, fl2, fh2, fl3, fh3;
  asm volatile("s_waitcnt lgkmcnt(0)" ::: "memory");
  PVX_RD2(fl0, fh0, 0, 0); PVX_RD2(fl1, fh1, 0, 1); PVX_RD2(fl2, fh2, 0, 2); PVX_RD2(fl3, fh3, 0, 3);
  PVX_BLOCK(0, 0); PVX_BLOCK(1, 4); PVX_BLOCK(2, 8);
  PVX_W(6); SBAR(); o[3] = __builtin_amdgcn_mfma_f32_32x32x16_bf16(pa0, PVX_PK(fl0, fh0), o[3], 0, 0, 0); PVX_E(12); SBAR();
  PVX_W(4); SBAR(); o[3] = __builtin_amdgcn_mfma_f32_32x32x16_bf16(pa1, PVX_PK(fl1, fh1), o[3], 0, 0, 0); PVX_E(13); SBAR();
  PVX_W(2); SBAR(); o[3] = __builtin_amdgcn_mfma_f32_32x32x16_bf16(pa2, PVX_PK(fl2, fh2), o[3], 0, 0, 0); PVX_E(14); SBAR();
  PVX_W(0); SBAR(); o[3] = __builtin_amdgcn_mfma_f32_32x32x16_bf16(pa3, PVX_PK(fl3, fh3), o[3], 0, 0, 0); PVX_E(15); SBAR();
}
__device__ __forceinline__ void expB_sum_pack2(f32x16& p0, f32x16& p1, float ps, float& l_reg, bf16x8& pa0, bf16x8& pa1, bf16x8& pa2, bf16x8& pa3) {
#pragma unroll
  for (int r = 0; r < 16; ++r) { p1[r] = __builtin_amdgcn_exp2f(p1[r]); ps += p1[r]; }
  { auto rr = __builtin_amdgcn_permlane32_swap(__float_as_uint(ps), __float_as_uint(ps), false, false);
    ps = __uint_as_float(rr[0]) + __uint_as_float(rr[1]); }
  l_reg += ps;
#define PK4(P, BASE, OUT) do { unsigned a0 = cvtpk(P[BASE + 0], P[BASE + 1]), a1 = cvtpk(P[BASE + 2], P[BASE + 3]);   \
    unsigned b0 = cvtpk(P[BASE + 4], P[BASE + 5]), b1 = cvtpk(P[BASE + 6], P[BASE + 7]);                              \
    auto r0 = __builtin_amdgcn_permlane32_swap(a0, b0, false, false); auto r1 = __builtin_amdgcn_permlane32_swap(a1, b1, false, false); \
    u32x4 w = {r0[0], r1[0], r0[1], r1[1]}; OUT = *reinterpret_cast<bf16x8*>(&w); } while (0)
  PK4(p0, 0, pa0); PK4(p0, 8, pa1); PK4(p1, 0, pa2); PK4(p1, 8, pa3);
#undef PK4
}
__device__ __forceinline__ float exp_sum16(f32x16& p0) { float ps = 0.f;
#pragma unroll
  for (int r = 0; r < 16; ++r) { p0[r] = __builtin_amdgcn_exp2f(p0[r]); ps += p0[r]; }
  return ps; }

__device__ __forceinline__ void attn_unit(const int wid, const bf16_t* __restrict__ proj, const char* __restrict__ Kt_bh, const char* __restrict__ Vt_bh, bf16_t* __restrict__ concat, int qrow0, int NT, int h,
                                          LAS char* lds, float lam, float omli, const float* __restrict__ subln) {
  const int lane = lane_id(), tid = wid * 64 + lane, r32 = lane & 31, hi = lane >> 5, rg = wid & 3, c = wid >> 2;
  LAS char* V_lds = lds; LAS char* K_lds = lds + 4 * SHM_V;
  LAS float* li_l = (LAS float*)(lds + 4 * SHM_V + 4 * SHM_K) + wid * 64;
  float l_reg = 0; f32x16 o[4] = {}; bf16x8 qr[4];
  const bf16_t* Qw = proj + (size_t)(qrow0 + rg * 32 + r32) * DP + C_DQ + h * 128 + c * 64 + hi * 8;
#pragma unroll
  for (int d0 = 0; d0 < 4; ++d0) qr[d0] = ld8(Qw + d0 * 16);
  const int vb0 = (int)(uintptr_t)V_lds + v_rd_base(lane);
  const char* kg0 = Kt_bh + wid * 2048 + lane * 16; const char* vg0 = Vt_bh + wid * 2048 + lane * 16;
#define DMA_TILE(tile, slot) do { const size_t to_ = (size_t)(tile) * 16384; \
    __builtin_amdgcn_global_load_lds((const unsigned*)(kg0 + to_), (LAS unsigned*)(K_lds + (slot) * SHM_K + wid * 2048), 16, 0, 0); \
    __builtin_amdgcn_global_load_lds((const unsigned*)(kg0 + to_ + 1024), (LAS unsigned*)(K_lds + (slot) * SHM_K + wid * 2048 + 1024), 16, 0, 0); \
    __builtin_amdgcn_global_load_lds((const unsigned*)(vg0 + to_), (LAS unsigned*)(V_lds + (slot) * SHM_V + wid * 2048), 16, 0, 0); \
    __builtin_amdgcn_global_load_lds((const unsigned*)(vg0 + to_ + 1024), (LAS unsigned*)(V_lds + (slot) * SHM_V + wid * 2048 + 1024), 16, 0, 0); } while (0)
#define BAR() do { asm volatile("s_waitcnt vmcnt(0) lgkmcnt(0)" ::: "memory"); __builtin_amdgcn_s_barrier(); asm volatile("" ::: "memory"); } while (0)
#define STAGE(b) do { if ((b) + 3 < NT) DMA_TILE((b) + 3, ((b) + 3) & 3); } while (0)
#define STAGES(b, slot) do { if ((b) + 3 < NT) DMA_TILE((b) + 3, slot); } while (0)
#define QKT(P0, P1, t) qkt<4>(P0, P1, K_lds + ((t) & 3) * SHM_K, qr, r32, hi, 4 * c)
#define QKTS(P0, P1, slot) qkt<4>(P0, P1, K_lds + (slot) * SHM_K, qr, r32, hi, 4 * c)
#define PV(t) pv_d0(o, vb0 + ((t) & 3) * SHM_V, pa0, pa1, pa2, pa3)
  f32x16 pA0, pA1, pB0, pB1; bf16x8 pa0, pa1, pa2, pa3; float psA = 0.f, psB = 0.f;
#define PVE(t, PN, PSN) do { PSN = 0.f; pv_exp<true>(o, vb0 + ((t) & 3) * SHM_V, pa0, pa1, pa2, pa3, PN, PSN); } while (0)
#define PVES(slot, PN, PSN) do { PSN = 0.f; pv_exp<true>(o, vb0 + (slot) * SHM_V, pa0, pa1, pa2, pa3, PN, PSN); } while (0)
#define PVL(t) do { float d_ = 0.f; pv_exp<false>(o, vb0 + ((t) & 3) * SHM_V, pa0, pa1, pa2, pa3, pA0, d_); } while (0)
  DMA_TILE(0, 0); DMA_TILE(1, 1); DMA_TILE(2, 2);
  BAR();
  QKT(pA0, pA1, 0); psA = exp_sum16(pA0);
  for (int t = 0; t < NT; t += 4) {
    if (c == 0) { BAR(); STAGES(t, 3); } SBAR();
    QKTS(pB0, pB1, 1); expB_sum_pack2(pA0, pA1, psA, l_reg, pa0, pa1, pa2, pa3); SBAR();
    if (c == 1) { BAR(); STAGES(t, 3); } SBAR();
    PVES(0, pB0, psB); SBAR();
    if (c == 0) { BAR(); STAGES(t + 1, 0); } SBAR();
    QKTS(pA0, pA1, 2); expB_sum_pack2(pB0, pB1, psB, l_reg, pa0, pa1, pa2, pa3); SBAR();
    if (c == 1) { BAR(); STAGES(t + 1, 0); } SBAR();
    PVES(1, pA0, psA); SBAR();
    if (c == 0) { BAR(); STAGES(t + 2, 1); } SBAR();
    QKTS(pB0, pB1, 3); expB_sum_pack2(pA0, pA1, psA, l_reg, pa0, pa1, pa2, pa3); SBAR();
    if (c == 1) { BAR(); STAGES(t + 2, 1); } SBAR();
    PVES(2, pB0, psB); SBAR();
    if (c == 0) { BAR(); STAGES(t + 3, 2); } SBAR();
    if (t + 4 < NT) QKTS(pA0, pA1, 0);
    expB_sum_pack2(pB0, pB1, psB, l_reg, pa0, pa1, pa2, pa3); SBAR();
    if (c == 1) { BAR(); STAGES(t + 3, 2); } SBAR();
    PVES(3, pA0, psA);
    SBAR();
  }
#undef PVE
#undef PVES
#undef QKTS
#undef STAGES
#undef PVL
  if (hi == 0) li_l[r32] = l_reg; asm volatile("s_waitcnt lgkmcnt(0)" ::: "memory");
#pragma unroll
  for (int r = 0; r < 16; ++r) { const float rl = __builtin_amdgcn_rcpf(li_l[crow(r, hi)]);
#pragma unroll
    for (int d0 = 0; d0 < 4; ++d0) o[d0][r] *= rl; }
  __syncthreads();
  LAS float* xch = (LAS float*)lds + rg * 4096;
  if (c == 1) {
#pragma unroll
    for (int d0 = 0; d0 < 4; ++d0)
#pragma unroll
      for (int r = 0; r < 16; ++r) xch[(d0 * 16 + r) * 64 + lane] = o[d0][r];
  }
  __syncthreads();
  if (c == 0) {
#pragma unroll
    for (int r = 0; r < 16; ++r) { float s = 0.f;
#pragma unroll
      for (int d0 = 0; d0 < 4; ++d0) { const float d = o[d0][r] - lam * xch[(d0 * 16 + r) * 64 + lane]; o[d0][r] = d; s += d * d; }
      s += __shfl_xor(s, 1); s += __shfl_xor(s, 2); s += __shfl_xor(s, 4); s += __shfl_xor(s, 8); s += __shfl_xor(s, 16);
      const float rr = rsqrtf(s * (1.f / 128.f) + EPS) * omli;
      bf16_t* orow = concat + (size_t)(qrow0 + rg * 32 + crow(r, hi)) * DM + 512 + h * 128 + r32;
#pragma unroll
      for (int d0 = 0; d0 < 4; ++d0) orow[d0 * 32] = f2bf(o[d0][r] * rr * subln[d0 * 32 + r32]); }
  }
  __syncthreads();
#undef DMA_TILE
#undef BAR
#undef STAGE
#undef QKT
#undef PV
}


typedef float f32x2 __attribute__((ext_vector_type(2)));
__device__ __forceinline__ void exp_half(f32x16& ph, f32x2& lacc) {
#pragma unroll
  for (int r = 0; r < 16; r += 2) { ph[r] = __builtin_amdgcn_exp2f(ph[r]); ph[r + 1] = __builtin_amdgcn_exp2f(ph[r + 1]); const f32x2 e = {ph[r], ph[r + 1]}; lacc += e; }
}
__device__ __forceinline__ void pack_half(const f32x16& ph, bf16x8& x0, bf16x8& x1) {
  { u32x4 w = {cvtpk(ph[0], ph[1]), cvtpk(ph[2], ph[3]), cvtpk(ph[4], ph[5]), cvtpk(ph[6], ph[7])}; x0 = *reinterpret_cast<bf16x8*>(&w); }
  { u32x4 w = {cvtpk(ph[8], ph[9]), cvtpk(ph[10], ph[11]), cvtpk(ph[12], ph[13]), cvtpk(ph[14], ph[15])}; x1 = *reinterpret_cast<bf16x8*>(&w); }
}

template <int D0> __device__ __forceinline__ void pv2_block(f32x16& oa, f32x16& ob, int vb, s16x4& fl0, s16x4& fh0, s16x4& fl1, s16x4& fh1, s16x4& fl2, s16x4& fh2, s16x4& fl3, s16x4& fh3,
                                                           bf16x8 a0, bf16x8 a1, bf16x8 a2, bf16x8 a3, bf16x8 b0, bf16x8 b1, bf16x8 b2, bf16x8 b3) {
#define PV2_STEP(A, B, FL, FH, KS, WN) do { asm volatile("s_waitcnt lgkmcnt(" #WN ")" ::: "memory"); SBAR(); \
    oa = __builtin_amdgcn_mfma_f32_32x32x16_bf16(A, PVX_PK(FL, FH), oa, 0, 0, 0); ob = __builtin_amdgcn_mfma_f32_32x32x16_bf16(B, PVX_PK(FL, FH), ob, 0, 0, 0); \
    if (D0 < 3) { FL = tr_read<v_rd_off((D0 + 1) & 3, KS, 0)>(vb); FH = tr_read<v_rd_off((D0 + 1) & 3, KS, 1)>(vb); } SBAR(); } while (0)
  if (D0 < 3) { PV2_STEP(a0, b0, fl0, fh0, 0, 6); PV2_STEP(a1, b1, fl1, fh1, 1, 6); PV2_STEP(a2, b2, fl2, fh2, 2, 6); PV2_STEP(a3, b3, fl3, fh3, 3, 6); }
  else        { PV2_STEP(a0, b0, fl0, fh0, 0, 6); PV2_STEP(a1, b1, fl1, fh1, 1, 4); PV2_STEP(a2, b2, fl2, fh2, 2, 2); PV2_STEP(a3, b3, fl3, fh3, 3, 0); }
#undef PV2_STEP
}
__device__ __forceinline__ void attn_unit3p(const int wid, const bf16_t* __restrict__ proj, const char* __restrict__ Kt_bh, const char* __restrict__ Vt_bh, bf16_t* __restrict__ concat, int qrow0, int NT, int h,
                                            LAS char* lds, float lam, float omli, const float* __restrict__ subln) {
  const int lane = lane_id(), r32 = lane & 31, hi = lane >> 5;
  LAS char* V_lds = lds; LAS char* K_lds = lds + 2 * SHM_V; LAS char* Qw = lds + 65536 + wid * 8192;
  LAS float* li_l = (LAS float*)(lds + 131072) + wid * 64;
  f32x2 l0v = {0.f, 0.f}, l1v = {0.f, 0.f}; f32x16 o0[4] = {}, o1[4] = {};
  const int vb0 = (int)(uintptr_t)V_lds + v_rd_base(lane);
  const char* kg0 = Kt_bh + wid * 2048 + lane * 16; const char* vg0 = Vt_bh + wid * 2048 + lane * 16;
#define DMA_TILE(tile, slot) do { const size_t to_ = (size_t)(tile) * 16384; \
    __builtin_amdgcn_global_load_lds((const unsigned*)(kg0 + to_), (LAS unsigned*)(K_lds + (slot) * SHM_K + wid * 2048), 16, 0, 0); \
    __builtin_amdgcn_global_load_lds((const unsigned*)(kg0 + to_ + 1024), (LAS unsigned*)(K_lds + (slot) * SHM_K + wid * 2048 + 1024), 16, 0, 0); \
    __builtin_amdgcn_global_load_lds((const unsigned*)(vg0 + to_), (LAS unsigned*)(V_lds + (slot) * SHM_V + wid * 2048), 16, 0, 0); \
    __builtin_amdgcn_global_load_lds((const unsigned*)(vg0 + to_ + 1024), (LAS unsigned*)(V_lds + (slot) * SHM_V + wid * 2048 + 1024), 16, 0, 0); } while (0)
#define BAR() do { asm volatile("s_waitcnt vmcnt(0) lgkmcnt(0)" ::: "memory"); __builtin_amdgcn_s_barrier(); asm volatile("" ::: "memory"); } while (0)
  bf16x8 qf00, qf01, qf02, qf03, qf10, qf11, qf12, qf13;
  { const bf16_t* qg = proj + (size_t)(qrow0 + wid * 32 + r32) * DP + C_DQ + h * 128 + hi * 8;
    qf00 = ld8(qg); qf01 = ld8(qg + 16); qf02 = ld8(qg + 32); qf03 = ld8(qg + 48); qf10 = ld8(qg + 64); qf11 = ld8(qg + 80); qf12 = ld8(qg + 96); qf13 = ld8(qg + 112); }
  DMA_TILE(0, 0);
  bf16x8 a0, a1, a2, a3, b0, b1, b2, b3;
  int sw0 = KSWZ(r32, (0 * 16 + hi * 8) * 2), sw1 = KSWZ(r32, (1 * 16 + hi * 8) * 2), sw2 = KSWZ(r32, (2 * 16 + hi * 8) * 2), sw3 = KSWZ(r32, (3 * 16 + hi * 8) * 2);
  int kad0_ = (int)(uintptr_t)K_lds + sw0, kad1_ = (int)(uintptr_t)K_lds + sw1, kad2_ = (int)(uintptr_t)K_lds + sw2, kad3_ = (int)(uintptr_t)K_lds + sw3;
  asm volatile("" : "+v"(kad0_), "+v"(kad1_), "+v"(kad2_), "+v"(kad3_));
  LAS char* const kad0 = (LAS char*)(uintptr_t)kad0_; LAS char* const kad1 = (LAS char*)(uintptr_t)kad1_; LAS char* const kad2 = (LAS char*)(uintptr_t)kad2_; LAS char* const kad3 = (LAS char*)(uintptr_t)kad3_;
#define QK2(P0, P1, so, cc) do { P0 = f32x16{}; P1 = f32x16{}; _Pragma("unroll") for (int d0 = 0; d0 < 4; ++d0) { const int cb = ((4 * (cc) + d0) * 16 + hi * 8) * 2; \
    const bf16x8 ka_ = *reinterpret_cast<const LAS bf16x8*>(K_lds + (so) * SHM_K + KSWZ(r32, cb)), kb_ = *reinterpret_cast<const LAS bf16x8*>(K_lds + (so) * SHM_K + KSWZ(32 + r32, cb)); \
    const bf16x8 q_ = *reinterpret_cast<const LAS bf16x8*>(Qw + KSWZ(r32, cb)); \
    P0 = __builtin_amdgcn_mfma_f32_32x32x16_bf16(ka_, q_, P0, 0, 0, 0); P1 = __builtin_amdgcn_mfma_f32_32x32x16_bf16(kb_, q_, P1, 0, 0, 0); } } while (0)
#define QKA(PH, so, cc, koff) do { PH = f32x16{}; \
    { const bf16x8 k_ = *reinterpret_cast<const LAS bf16x8*>(kad0 + ((so) * SHM_K + (koff) * 256 + 128 * (cc))); PH = __builtin_amdgcn_mfma_f32_32x32x16_bf16(k_, (cc) ? qf10 : qf00, PH, 0, 0, 0); } \
    { const bf16x8 k_ = *reinterpret_cast<const LAS bf16x8*>(kad1 + ((so) * SHM_K + (koff) * 256 + 128 * (cc))); PH = __builtin_amdgcn_mfma_f32_32x32x16_bf16(k_, (cc) ? qf11 : qf01, PH, 0, 0, 0); } } while (0)
#define QKB(PH, so, cc, koff) do { \
    { const bf16x8 k_ = *reinterpret_cast<const LAS bf16x8*>(kad2 + ((so) * SHM_K + (koff) * 256 + 128 * (cc))); PH = __builtin_amdgcn_mfma_f32_32x32x16_bf16(k_, (cc) ? qf12 : qf02, PH, 0, 0, 0); } \
    { const bf16x8 k_ = *reinterpret_cast<const LAS bf16x8*>(kad3 + ((so) * SHM_K + (koff) * 256 + 128 * (cc))); PH = __builtin_amdgcn_mfma_f32_32x32x16_bf16(k_, (cc) ? qf13 : qf03, PH, 0, 0, 0); } } while (0)
#define QKH(PH, so, cc, koff) do { QKA(PH, so, cc, koff); QKB(PH, so, cc, koff); } while (0)
#define SGB(m, n) __builtin_amdgcn_sched_group_barrier(m, n, 0)
#define STEP(PN, so, cc, koff, PO, LV, X0, X1) do { \
    QKA(PN, so, cc, koff); exp_half(PO, LV); SGB(0x100, 2); SGB(0x8, 1); SGB(0x2, 12); SGB(0x8, 1); SGB(0x2, 12); SBAR(); asm volatile("" : "+v"(LV)); SBAR(); \
    QKB(PN, so, cc, koff); pack_half(PO, X0, X1); SGB(0x100, 2); SGB(0x8, 1); SGB(0x2, 4); SGB(0x8, 1); SGB(0x2, 4); MBAR(PN); } while (0)
#define MBAR(X) do { SBAR(); asm volatile("" : "+v"(X) :: "memory"); SBAR(); } while (0)
#define TILE(t, so) do { BAR(); if ((t) + 1 < NT) DMA_TILE((t) + 1, 1 - (so)); SBAR(); \
    { f32x16 p0, p1; \
      QKH(p0, so, 0, 0); MBAR(p0); \
      STEP(p1, so, 0, 32, p0, l0v, a0, a1); \
      STEP(p0, so, 1, 0, p1, l0v, a2, a3); \
      STEP(p1, so, 1, 32, p0, l1v, b0, b1); \
      exp_half(p1, l1v); SBAR(); asm volatile("" : "+v"(l1v)); SBAR(); pack_half(p1, b2, b3); } SBAR(); \
    { const int vb = vb0 + (so) * SHM_V; s16x4 fl0, fh0, fl1, fh1, fl2, fh2, fl3, fh3; \
      asm volatile("s_waitcnt lgkmcnt(0)" ::: "memory"); \
      PVX_RD2(fl0, fh0, 0, 0); PVX_RD2(fl1, fh1, 0, 1); PVX_RD2(fl2, fh2, 0, 2); PVX_RD2(fl3, fh3, 0, 3); \
      pv2_block<0>(o0[0], o1[0], vb, fl0, fh0, fl1, fh1, fl2, fh2, fl3, fh3, a0, a1, a2, a3, b0, b1, b2, b3); \
      pv2_block<1>(o0[1], o1[1], vb, fl0, fh0, fl1, fh1, fl2, fh2, fl3, fh3, a0, a1, a2, a3, b0, b1, b2, b3); \
      pv2_block<2>(o0[2], o1[2], vb, fl0, fh0, fl1, fh1, fl2, fh2, fl3, fh3, a0, a1, a2, a3, b0, b1, b2, b3); \
      pv2_block<3>(o0[3], o1[3], vb, fl0, fh0, fl1, fh1, fl2, fh2, fl3, fh3, a0, a1, a2, a3, b0, b1, b2, b3); } SBAR(); } while (0)
  for (int t = 0; t < NT; t += 2) { TILE(t, 0); TILE(t + 1, 1); }
  const float l0 = pair_sum(l0v[0] + l0v[1]), l1 = pair_sum(l1v[0] + l1v[1]);
  if (hi == 0) { li_l[r32] = l0; li_l[32 + r32] = l1; } asm volatile("s_waitcnt lgkmcnt(0)" ::: "memory");
#pragma unroll
  for (int r = 0; r < 16; ++r) { const float ra = __builtin_amdgcn_rcpf(li_l[crow(r, hi)]), rb = lam * __builtin_amdgcn_rcpf(li_l[32 + crow(r, hi)]);
    float s = 0.f;
#pragma unroll
    for (int d0 = 0; d0 < 4; ++d0) { const float d = o0[d0][r] * ra - o1[d0][r] * rb; o0[d0][r] = d; s += d * d; }
    s += __shfl_xor(s, 1); s += __shfl_xor(s, 2); s += __shfl_xor(s, 4); s += __shfl_xor(s, 8); s += __shfl_xor(s, 16);
    const float rr = rsqrtf(s * (1.f / 128.f) + EPS) * omli;
    bf16_t* orow = concat + (size_t)(qrow0 + wid * 32 + crow(r, hi)) * DM + 512 + h * 128 + r32;
#pragma unroll
    for (int d0 = 0; d0 < 4; ++d0) orow[d0 * 32] = f2bf(o0[d0][r] * rr * subln[d0 * 32 + r32]); }
  asm volatile("s_waitcnt vmcnt(0) lgkmcnt(0)" ::: "memory"); __syncthreads();
#undef DMA_TILE
#undef BAR
#undef QK2
#undef QKH
#undef QKA
#undef QKB
#undef TILE
#undef STEP
#undef MBAR
#undef SGB
}

__device__ __forceinline__ void attn_unit3q(const int wid, const bf16_t* __restrict__ proj, const char* __restrict__ Kt_bh, const char* __restrict__ Vt_bh, bf16_t* __restrict__ concat, int qrow0, int NT, int h,
                                            LAS char* lds, float lam, float omli, const float* __restrict__ subln) {
  const int lane = lane_id(), r32 = lane & 31, hi = lane >> 5, rg = wid & 3, c = wid >> 2;
  LAS char* V_lds = lds; LAS char* K_lds = lds + 2 * SHM_V;
  LAS float* li_l = (LAS float*)(lds + 131072) + wid * 64;
  f32x2 l0v = {0.f, 0.f}, l1v = {0.f, 0.f}; f32x16 o0[4] = {}, o1[4] = {};
  const int vb0 = (int)(uintptr_t)V_lds + v_rd_base(lane);
  const char* kg0 = Kt_bh + wid * 2048 + lane * 16; const char* vg0 = Vt_bh + wid * 2048 + lane * 16;
#define DMA_TILE(tile, slot) do { const size_t to_ = (size_t)(tile) * 16384; \
    __builtin_amdgcn_global_load_lds((const unsigned*)(kg0 + to_), (LAS unsigned*)(K_lds + (slot) * SHM_K + wid * 2048), 16, 0, 0); \
    __builtin_amdgcn_global_load_lds((const unsigned*)(kg0 + to_ + 1024), (LAS unsigned*)(K_lds + (slot) * SHM_K + wid * 2048 + 1024), 16, 0, 0); \
    __builtin_amdgcn_global_load_lds((const unsigned*)(vg0 + to_), (LAS unsigned*)(V_lds + (slot) * SHM_V + wid * 2048), 16, 0, 0); \
    __builtin_amdgcn_global_load_lds((const unsigned*)(vg0 + to_ + 1024), (LAS unsigned*)(V_lds + (slot) * SHM_V + wid * 2048 + 1024), 16, 0, 0); } while (0)
#define BAR() do { asm volatile("s_waitcnt vmcnt(0) lgkmcnt(0)" ::: "memory"); __builtin_amdgcn_s_barrier(); asm volatile("" ::: "memory"); } while (0)
  bf16x8 qf00, qf01, qf02, qf03, qf10, qf11, qf12, qf13;
  { const bf16_t* qg = proj + (size_t)(qrow0 + rg * 64 + r32) * DP + C_DQ + h * 128 + c * 64 + hi * 8;
    qf00 = ld8(qg); qf01 = ld8(qg + 16); qf02 = ld8(qg + 32); qf03 = ld8(qg + 48); qg += (size_t)32 * DP;
    qf10 = ld8(qg); qf11 = ld8(qg + 16); qf12 = ld8(qg + 32); qf13 = ld8(qg + 48); }
  DMA_TILE(0, 0);
  bf16x8 a0, a1, a2, a3, b0, b1, b2, b3;
  int kad0_ = (int)(uintptr_t)K_lds + KSWZ(r32, (0 * 16 + hi * 8) * 2) + 128 * c, kad1_ = (int)(uintptr_t)K_lds + KSWZ(r32, (1 * 16 + hi * 8) * 2) + 128 * c;
  int kad2_ = (int)(uintptr_t)K_lds + KSWZ(r32, (2 * 16 + hi * 8) * 2) + 128 * c, kad3_ = (int)(uintptr_t)K_lds + KSWZ(r32, (3 * 16 + hi * 8) * 2) + 128 * c;
  asm volatile("" : "+v"(kad0_), "+v"(kad1_), "+v"(kad2_), "+v"(kad3_));
  LAS char* const kad0 = (LAS char*)(uintptr_t)kad0_; LAS char* const kad1 = (LAS char*)(uintptr_t)kad1_; LAS char* const kad2 = (LAS char*)(uintptr_t)kad2_; LAS char* const kad3 = (LAS char*)(uintptr_t)kad3_;
#define QKA(PH, so, rb, koff, LK) do { PH = f32x16{}; \
    { if (LK) kf0 = *reinterpret_cast<const LAS bf16x8*>(kad0 + ((so) * SHM_K + (koff) * 256)); PH = __builtin_amdgcn_mfma_f32_32x32x16_bf16(kf0, (rb) ? qf10 : qf00, PH, 0, 0, 0); } \
    { if (LK) kf1 = *reinterpret_cast<const LAS bf16x8*>(kad1 + ((so) * SHM_K + (koff) * 256)); PH = __builtin_amdgcn_mfma_f32_32x32x16_bf16(kf1, (rb) ? qf11 : qf01, PH, 0, 0, 0); } } while (0)
#define QKB(PH, so, rb, koff, LK) do { \
    { if (LK) kf2 = *reinterpret_cast<const LAS bf16x8*>(kad2 + ((so) * SHM_K + (koff) * 256)); PH = __builtin_amdgcn_mfma_f32_32x32x16_bf16(kf2, (rb) ? qf12 : qf02, PH, 0, 0, 0); } \
    { if (LK) kf3 = *reinterpret_cast<const LAS bf16x8*>(kad3 + ((so) * SHM_K + (koff) * 256)); PH = __builtin_amdgcn_mfma_f32_32x32x16_bf16(kf3, (rb) ? qf13 : qf03, PH, 0, 0, 0); } } while (0)
#define SGB(m, n) __builtin_amdgcn_sched_group_barrier(m, n, 0)
#define MBAR(X) do { SBAR(); asm volatile("" : "+v"(X) :: "memory"); SBAR(); } while (0)
#define STEP(PN, so, rb, koff, LK, PO, LV, X0, X1) do { \
    QKA(PN, so, rb, koff, LK); exp_half(PO, LV); if (LK) SGB(0x100, 2); SGB(0x8, 1); SGB(0x2, 12); SGB(0x8, 1); SGB(0x2, 12); SBAR(); asm volatile("" : "+v"(LV)); SBAR(); \
    QKB(PN, so, rb, koff, LK); pack_half(PO, X0, X1); if (LK) SGB(0x100, 2); SGB(0x8, 1); SGB(0x2, 4); SGB(0x8, 1); SGB(0x2, 4); MBAR(PN); } while (0)
#define TILE(t, so) do { BAR(); if ((t) + 1 < NT) DMA_TILE((t) + 1, 1 - (so)); SBAR(); \
    const int vb = vb0 + (so) * SHM_V; s16x4 fl0, fh0, fl1, fh1, fl2, fh2, fl3, fh3; \
    { f32x16 p0, p1; bf16x8 kf0, kf1, kf2, kf3; \
      QKA(p0, so, 0, 0, 1); QKB(p0, so, 0, 0, 1); MBAR(p0); \
      STEP(p1, so, 1, 0, 0, p0, l0v, a0, a1); \
      STEP(p0, so, 0, 32, 1, p1, l1v, b0, b1); \
      STEP(p1, so, 1, 32, 0, p0, l0v, a2, a3); \
      SBAR(); PVX_RD2(fl0, fh0, 0, 0); PVX_RD2(fl1, fh1, 0, 1); PVX_RD2(fl2, fh2, 0, 2); PVX_RD2(fl3, fh3, 0, 3); SBAR();     \
      exp_half(p1, l1v); SBAR(); asm volatile("" : "+v"(l1v)); SBAR(); pack_half(p1, b2, b3); } SBAR(); \
    { \
      pv2_block<0>(o0[0], o1[0], vb, fl0, fh0, fl1, fh1, fl2, fh2, fl3, fh3, a0, a1, a2, a3, b0, b1, b2, b3); \
      pv2_block<1>(o0[1], o1[1], vb, fl0, fh0, fl1, fh1, fl2, fh2, fl3, fh3, a0, a1, a2, a3, b0, b1, b2, b3); \
      pv2_block<2>(o0[2], o1[2], vb, fl0, fh0, fl1, fh1, fl2, fh2, fl3, fh3, a0, a1, a2, a3, b0, b1, b2, b3); \
      pv2_block<3>(o0[3], o1[3], vb, fl0, fh0, fl1, fh1, fl2, fh2, fl3, fh3, a0, a1, a2, a3, b0, b1, b2, b3); } SBAR(); } while (0)
  for (int t = 0; t < NT; t += 2) { TILE(t, 0); TILE(t + 1, 1); }
  const float l0 = pair_sum(l0v[0] + l0v[1]), l1 = pair_sum(l1v[0] + l1v[1]);
  if (hi == 0) { li_l[r32] = l0; li_l[32 + r32] = l1; }
  asm volatile("s_waitcnt vmcnt(0) lgkmcnt(0)" ::: "memory"); __syncthreads();
  LAS float* xw = (LAS float*)(lds + (rg * 2 + c) * 16384) + lane; const LAS float* xr = (const LAS float*)(lds + (rg * 2 + (1 - c)) * 16384) + lane;
  const float sgn = c ? lam : 1.f;
#define SEND(OX, LOFF) do { _Pragma("unroll") for (int r = 0; r < 16; ++r) { const float rl = sgn * __builtin_amdgcn_rcpf(li_l[(LOFF) + crow(r, hi)]); \
    _Pragma("unroll") for (int d0 = 0; d0 < 4; ++d0) xw[(d0 * 16 + r) * 64] = OX[d0][r] * rl; } } while (0)
  if (c == 0) SEND(o1, 32); else SEND(o0, 0);
  asm volatile("s_waitcnt lgkmcnt(0)" ::: "memory"); __syncthreads();
#define FINISH(OX, LOFF, RB) do { _Pragma("unroll") for (int r = 0; r < 16; ++r) { const float rl = sgn * __builtin_amdgcn_rcpf(li_l[(LOFF) + crow(r, hi)]); float s = 0.f; \
    _Pragma("unroll") for (int d0 = 0; d0 < 4; ++d0) { const float own = OX[d0][r] * rl, oth = xr[(d0 * 16 + r) * 64]; const float d = c ? oth - own : own - oth; OX[d0][r] = d; s += d * d; } \
    s += __shfl_xor(s, 1); s += __shfl_xor(s, 2); s += __shfl_xor(s, 4); s += __shfl_xor(s, 8); s += __shfl_xor(s, 16); \
    const float rr = rsqrtf(s * (1.f / 128.f) + EPS) * omli; \
    bf16_t* orow = concat + (size_t)(qrow0 + rg * 64 + (RB) * 32 + crow(r, hi)) * DM + 512 + h * 128 + r32; \
    _Pragma("unroll") for (int d0 = 0; d0 < 4; ++d0) orow[d0 * 32] = f2bf(OX[d0][r] * rr * subln[d0 * 32 + r32]); } } while (0)
  if (c == 0) FINISH(o0, 0, 0); else FINISH(o1, 32, 1);
  asm volatile("s_waitcnt vmcnt(0) lgkmcnt(0)" ::: "memory"); __syncthreads();
#undef SEND
#undef FINISH
#undef DMA_TILE
#undef BAR
#undef QKA
#undef QKB
#undef TILE
#undef STEP
#undef MBAR
#undef SGB
}

__device__ __forceinline__ bf16x8 scale8(bf16x8 v, float s) {
  u32x4 w;
#pragma unroll
  for (int i = 0; i < 4; ++i) { const float a = __uint_as_float(((unsigned)(unsigned short)v[2 * i]) << 16) * s, b = __uint_as_float(((unsigned)(unsigned short)v[2 * i + 1]) << 16) * s; w[i] = cvtpk(a, b); }
  return *reinterpret_cast<bf16x8*>(&w);
}
template <int KS> __device__ __forceinline__ void trfrag_issue(int vb, s16x4& l, s16x4& h) { l = tr_read<v_rd_off(0, KS, 0)>(vb); h = tr_read<v_rd_off(0, KS, 1)>(vb); }
#define PKF(L, H) (bf16x8){L[0], L[1], L[2], L[3], H[0], H[1], H[2], H[3]}
template <int KS> __device__ __forceinline__ void cs_step(f32x16* acc, int kb, int vv) {
  s16x4 al, ah, b0l, b0h, b1l, b1h, b2l, b2h, b3l, b3h;
  trfrag_issue<KS>(kb, al, ah); trfrag_issue<KS>(vv, b0l, b0h); trfrag_issue<KS>(vv + 512, b1l, b1h); trfrag_issue<KS>(vv + 1024, b2l, b2h); trfrag_issue<KS>(vv + 1536, b3l, b3h);
  asm volatile("s_waitcnt lgkmcnt(0)" ::: "memory"); SBAR();
  const bf16x8 a = PKF(al, ah);
  acc[0] = __builtin_amdgcn_mfma_f32_32x32x16_bf16(a, PKF(b0l, b0h), acc[0], 0, 0, 0);
  acc[1] = __builtin_amdgcn_mfma_f32_32x32x16_bf16(a, PKF(b1l, b1h), acc[1], 0, 0, 0);
  acc[2] = __builtin_amdgcn_mfma_f32_32x32x16_bf16(a, PKF(b2l, b2h), acc[2], 0, 0, 0);
  acc[3] = __builtin_amdgcn_mfma_f32_32x32x16_bf16(a, PKF(b3l, b3h), acc[3], 0, 0, 0);
}
__device__ __forceinline__ void chunk_state_unit(const int wid, const bf16_t* __restrict__ proj, bf16_t* __restrict__ csf, bf16_t* __restrict__ csb, int rowbase, int h, float lgf2, float lgb2, LAS char* lds) {
  const int lane = lane_id(), tid = wid * 64 + lane, r32 = lane & 31, hi = lane >> 5;
  const int sr = tid >> 4, sc = (tid & 15) * 8;
  { bf16x8 kv[4], vv[4];
#pragma unroll
    for (int g = 0; g < 4; ++g) { const bf16_t* rp = proj + (size_t)(rowbase + 32 * g + sr) * DP + h * 128 + sc; kv[g] = ld8(rp + C_RK); vv[g] = ld8(rp + C_RV); }
#pragma unroll
    for (int g = 0; g < 4; ++g) { const int row = 32 * g + sr;
      const float wf = __builtin_amdgcn_exp2f(lgf2 * (float)(127 - row)), wb = __builtin_amdgcn_exp2f(lgb2 * (float)row);
      const int off = (row >> 6) * 16384 + v_st(row & 63, sc);
      *(LAS bf16x8*)(lds + off) = vv[g]; *(LAS bf16x8*)(lds + 32768 + off) = scale8(kv[g], wf); *(LAS bf16x8*)(lds + 65536 + off) = scale8(kv[g], wb); } }
  __syncthreads();
  const int dir = wid >> 2, ib = wid & 3;
  const int vbK = (int)(uintptr_t)(lds + 32768 + dir * 32768) + v_rd_base(lane) + ib * 512, vbV = (int)(uintptr_t)lds + v_rd_base(lane);
  f32x16 acc[4] = {};
  cs_step<0>(acc, vbK, vbV); cs_step<1>(acc, vbK, vbV); cs_step<2>(acc, vbK, vbV); cs_step<3>(acc, vbK, vbV);
  cs_step<0>(acc, vbK + 16384, vbV + 16384); cs_step<1>(acc, vbK + 16384, vbV + 16384); cs_step<2>(acc, vbK + 16384, vbV + 16384); cs_step<3>(acc, vbK + 16384, vbV + 16384);
  bf16_t* outp = (dir ? csb : csf) + r32;
#pragma unroll
  for (int r = 0; r < 16; ++r) { bf16_t* orow = outp + (size_t)(32 * ib + crow(r, hi)) * 128;
#pragma unroll
    for (int jb = 0; jb < 4; ++jb) orow[32 * jb] = f2bf(acc[jb][r]); }
  __syncthreads();
}
__device__ __forceinline__ void pack_p(const f32x16& p0, const f32x16& p1, bf16x8& pa0, bf16x8& pa1, bf16x8& pa2, bf16x8& pa3) {
#define PK4(P, BASE, OUT) do { unsigned a0 = cvtpk(P[BASE + 0], P[BASE + 1]), a1 = cvtpk(P[BASE + 2], P[BASE + 3]);   \
    unsigned b0 = cvtpk(P[BASE + 4], P[BASE + 5]), b1 = cvtpk(P[BASE + 6], P[BASE + 7]);                              \
    auto r0 = __builtin_amdgcn_permlane32_swap(a0, b0, false, false); auto r1 = __builtin_amdgcn_permlane32_swap(a1, b1, false, false); \
    u32x4 w = {r0[0], r1[0], r0[1], r1[1]}; OUT = *reinterpret_cast<bf16x8*>(&w); } while (0)
  PK4(p0, 0, pa0); PK4(p0, 8, pa1); PK4(p1, 0, pa2); PK4(p1, 8, pa3);
#undef PK4
}
__device__ __forceinline__ float decay_w(int d, float lgf2, float lgb2) {
  const float e = __builtin_amdgcn_exp2f(d < 0 ? lgf2 * (float)(-d) : lgb2 * (float)d); return d == 0 ? 2.f : e;
}
__device__ __forceinline__ void ret_out_unit(const int wid, const bf16_t* __restrict__ proj, bf16_t* __restrict__ concat, const bf16_t* __restrict__ spA, const bf16_t* __restrict__ spB, size_t dstride,
                                             int rowA, int rowB, int h, float lgf2, float lgb2, const float* __restrict__ gn, LAS char* lds) {
  const int lane = lane_id(), tid = wid * 64 + lane, r32 = lane & 31, hi = lane >> 5, rg = wid & 3, ch = wid >> 2;
  const int sr = tid >> 4, sc = (tid & 15) * 8;
  const int rowbase = ch ? rowB : rowA;
  { bf16x8 kv[8], vv[8];
#pragma unroll
    for (int c2 = 0; c2 < 2; ++c2)
#pragma unroll
      for (int g = 0; g < 4; ++g) { const bf16_t* rp = proj + (size_t)((c2 ? rowB : rowA) + 32 * g + sr) * DP + h * 128 + sc; kv[c2 * 4 + g] = ld8(rp + C_RK); vv[c2 * 4 + g] = ld8(rp + C_RV); }
#pragma unroll
    for (int c2 = 0; c2 < 2; ++c2)
#pragma unroll
      for (int g = 0; g < 4; ++g) { const int row = 32 * g + sr;
        *(LAS bf16x8*)(lds + c2 * 65536 + (row >> 6) * 16384 + KSWZ(row & 63, sc * 2)) = kv[c2 * 4 + g];
        *(LAS bf16x8*)(lds + c2 * 65536 + 32768 + (row >> 6) * 16384 + v_st(row & 63, sc)) = vv[c2 * 4 + g]; } }
  bf16x8 qr[8];
  const bf16_t* Qw = proj + (size_t)(rowbase + rg * 32 + r32) * DP + C_RQ + h * 128 + hi * 8;
#pragma unroll
  for (int d0 = 0; d0 < 8; ++d0) qr[d0] = ld8(Qw + d0 * 16);
  __syncthreads();
  const int m = rg * 32 + r32;
  LAS char* myreg = lds + ch * 65536;
  const int vb = (int)(uintptr_t)myreg + v_rd_base(lane);
  f32x16 o[4] = {}; f32x16 p0, p1; bf16x8 pa0, pa1, pa2, pa3;
#pragma unroll
  for (int kt = 0; kt < 2; ++kt) {
    qkt<8>(p0, p1, myreg + kt * 16384, qr, r32, hi, 0);
    int mm = m - 4 * hi; asm volatile("" : "+v"(mm));
#pragma unroll
    for (int r = 0; r < 16; ++r) { const int s0 = 64 * kt + (r & 3) + 8 * (r >> 2); p0[r] *= decay_w(s0 - mm, lgf2, lgb2); p1[r] *= decay_w(s0 + 32 - mm, lgf2, lgb2); }
    pack_p(p0, p1, pa0, pa1, pa2, pa3);
    pv_d0(o, vb + 32768 + kt * 16384, pa0, pa1, pa2, pa3);
  }
  __syncthreads();
  { bf16x8 sv[16];
#pragma unroll
    for (int c2 = 0; c2 < 2; ++c2)
#pragma unroll
      for (int d = 0; d < 2; ++d)
#pragma unroll
        for (int g = 0; g < 4; ++g) sv[(c2 * 2 + d) * 4 + g] = ld8((c2 ? spB : spA) + (size_t)d * dstride + (size_t)(32 * g + sr) * 128 + sc);
#pragma unroll
    for (int c2 = 0; c2 < 2; ++c2)
#pragma unroll
      for (int d = 0; d < 2; ++d)
#pragma unroll
        for (int g = 0; g < 4; ++g) { const int row = 32 * g + sr;
          *(LAS bf16x8*)(lds + c2 * 65536 + d * 32768 + (row >> 6) * 16384 + v_st(row & 63, sc)) = sv[(c2 * 2 + d) * 4 + g]; } }
  const float xf = __builtin_amdgcn_exp2f(lgf2 * (float)(m + 1)), xb = __builtin_amdgcn_exp2f(lgb2 * (float)(128 - m));
  __syncthreads();
#pragma unroll
  for (int d = 0; d < 2; ++d) { const float xs = d ? xb : xf;
#pragma unroll
    for (int sub = 0; sub < 2; ++sub) {
      const bf16x8 a0 = scale8(qr[4 * sub + 0], xs), a1 = scale8(qr[4 * sub + 1], xs), a2 = scale8(qr[4 * sub + 2], xs), a3 = scale8(qr[4 * sub + 3], xs);
      pv_d0(o, vb + d * 32768 + sub * 16384, a0, a1, a2, a3); } }
#pragma unroll
  for (int r = 0; r < 16; ++r) {
    float s = (o[0][r] + o[1][r]) + (o[2][r] + o[3][r]);
    s += __shfl_xor(s, 1); s += __shfl_xor(s, 2); s += __shfl_xor(s, 4); s += __shfl_xor(s, 8); s += __shfl_xor(s, 16);
    const float mu = s * (1.f / 128.f);
    float q = 0.f;
#pragma unroll
    for (int d0 = 0; d0 < 4; ++d0) { const float dd = o[d0][r] - mu; o[d0][r] = dd; q += dd * dd; }
    q += __shfl_xor(q, 1); q += __shfl_xor(q, 2); q += __shfl_xor(q, 4); q += __shfl_xor(q, 8); q += __shfl_xor(q, 16);
    const float rr = rsqrtf(q * (1.f / 128.f) + EPS);
    const size_t grow = (size_t)(rowbase + rg * 32 + crow(r, hi));
    const bf16_t* gp = proj + grow * DP + C_RG + h * 128 + r32; bf16_t* op = concat + grow * DM + h * 128 + r32;
#pragma unroll
    for (int d0 = 0; d0 < 4; ++d0) { const float gv = bf2f(gp[32 * d0]); op[32 * d0] = f2bf(o[d0][r] * rr * gn[32 * d0 + r32] * (gv * __builtin_amdgcn_rcpf(1.f + __builtin_amdgcn_exp2f(-1.4426950408889634f * gv)))); }
  }
  __syncthreads();
}

}


__device__ __forceinline__ float log2_sigmoid(float x) { return -log1pf(__expf(-x)) * 1.4426950408889634f; }
__device__ __forceinline__ bf16_t* cs_ptr(const Params& p, int b, int h, int dir, int j) { return (bf16_t*)(p.ws + WS_CS) + ((size_t)((b * NH + h) * 2 + dir) * 66 + j) * 16384; }
__device__ __forceinline__ void qkrope_phase(const Params& p, Ctx& F, int l) {
    const int lane = lane_id();
    float gq[8], gk[8], fr[8];
#pragma unroll
    for (int i = 0; i < 8; ++i) { gq[i] = p.in[I_QNG][l * 64 + 8 * (lane & 7) + i] * 0.18033688011112042f;
        gk[i] = p.in[I_KNG][l * 64 + 8 * (lane & 7) + i];
        fr[i] = exp2f(-(float)(8 * (lane & 1) + i) * (13.287712379549449f / 16.f)) * 0.15915494309189535f; }
    const bool lowhalf = (lane & 4) == 0;
    for (int m = F.gw; m < NR; m += F.NGW) {
        bf16_t* row = (bf16_t*)(p.ws + WS_PROJ) + (size_t)m * DP;
        v4u* qp = (v4u*)(row + C_DQ) + lane; const v4u* kp = (const v4u*)(row + C_DK) + lane;
        const v4u qv = *qp, kv = *kp, vv = *((const v4u*)(row + C_DV) + lane);
        float q[8], k[8];
#pragma unroll
        for (int i = 0; i < 4; ++i) { q[2 * i] = __uint_as_float(qv[i] << 16); q[2 * i + 1] = __uint_as_float(qv[i] & 0xffff0000u); k[2 * i] = __uint_as_float(kv[i] << 16); k[2 * i + 1] = __uint_as_float(kv[i] & 0xffff0000u); }
        float sq = 0.f, sk = 0.f;
#pragma unroll
        for (int i = 0; i < 8; ++i) { sq += q[i] * q[i]; sk += k[i] * k[i]; }
        sq += __shfl_xor(sq, 1); sq += __shfl_xor(sq, 2); sq += __shfl_xor(sq, 4);
        sk += __shfl_xor(sk, 1); sk += __shfl_xor(sk, 2); sk += __shfl_xor(sk, 4);
        const float rq = rsqrtf(sq * (1.f / 64.f) + EPS), rk = rsqrtf(sk * (1.f / 64.f) + EPS);
#pragma unroll
        for (int i = 0; i < 8; ++i) { q[i] *= rq * gq[i]; k[i] *= rk * gk[i]; }
        if (m < NL) {
            const int t = m % T; const float pos = (float)((lane & 2) ? (t % 64) : (t / 64));
#pragma unroll
            for (int i = 0; i < 8; ++i) {
                const float rev = pos * fr[i]; const float cs = __builtin_amdgcn_cosf(rev), sn = __builtin_amdgcn_sinf(rev);
                const float oq = __shfl_xor(q[i], 4), ok = __shfl_xor(k[i], 4);
                q[i] = lowhalf ? q[i] * cs - oq * sn : q[i] * cs + oq * sn;
                k[i] = lowhalf ? k[i] * cs - ok * sn : k[i] * cs + ok * sn;
            }
        }
        v4u qo, ko;
#pragma unroll
        for (int i = 0; i < 4; ++i) { qo[i] = pk2(q[2 * i], q[2 * i + 1]); ko[i] = pk2(k[2 * i], k[2 * i + 1]); }
        *qp = qo;
        { const int bb = m < NL ? m / T : (m - NL) / TC, kidx = m < NL ? TC + (m % T) : (m - NL) % TC, tile = kidx >> 6, r = kidx & 63, hh = lane >> 4, ci = lane & 15;
          const size_t blk = ((size_t)(bb * NH + hh) * 132 + tile) * 16384;
          *(v4u*)(p.ws + WS_KT + blk + KSWZ(r, 16 * ci)) = ko;
#if FAST_ATT
          *(v4u*)(p.ws + WS_VT + blk + att::v_st_lin(r, 8 * ci)) = vv; }
#else
          *(v4u*)(p.ws + WS_VT + blk + att::v_st(r, 8 * ci)) = vv; }
#endif
    }
}
__device__ __forceinline__ void scan_phase(const Params& p, Ctx& F, int l) {
    const int lane_ = lane_id(), tid_ = F.wave * 64 + lane_;
    unsigned* cs = (unsigned*)(p.ws + WS_CS);
    for (int i = blockIdx.x * (NWAVES * 64) + tid_; i < 16 * 8192; i += F.G * NWAVES * 64) {
        const int combo = i >> 13, e2 = i & 8191, dir = combo & 1, h = (combo >> 1) & 3;
        const float lg2 = log2_sigmoid(dir ? p.in[I_DECB][l * NH + h] : p.in[I_DECF][l * NH + h]);
        const float decay = exp2f(lg2 * 128.f);
        unsigned* base = cs + (size_t)combo * 66 * 8192 + e2;
        float s0 = 0.f, s1 = 0.f;
#pragma unroll 1
        for (int jj = 0; jj < 66; jj += 22) {
            unsigned tv[22];
#pragma unroll
            for (int k = 0; k < 22; ++k) { const int q = jj + k, idx = dir ? (q < 2 ? 1 - q : 67 - q) : q; tv[k] = base[(size_t)idx * 8192]; }
#pragma unroll
            for (int k = 0; k < 22; ++k) { const int q = jj + k, idx = dir ? (q < 2 ? 1 - q : 67 - q) : q;
                base[(size_t)idx * 8192] = pk2(s0, s1);
                s0 = decay * s0 + __uint_as_float(tv[k] << 16); s1 = decay * s1 + __uint_as_float(tv[k] & 0xffff0000u); }
        }
    }
}

#define IN(k) (lo <= (k) && (k) < hi)
#if SEAM_CVT
#define SEAM(k) do { if (IN(k) && IN((k) + 1)) { const bool t0_ = F.wave == 0 && lane_id() == 0; const XcdToken tk_ = xcd_barrier_arrive(bar, t0_); seam_fill(p, F, (k)); xcd_barrier_wait(bar, tk_, t0_); } } while (0)
#else
#define SEAM(k) do { if (IN(k) && IN((k) + 1)) xcd_barrier(bar, F.wave == 0 && lane_id() == 0); } while (0)
#endif
#ifndef REP_ATT
#define REP_ATT 1
#endif
#ifndef REP_RET
#define REP_RET 1
#endif
#ifndef REP_B
#define REP_B 1
#endif
#ifndef REP_H0
#define REP_H0 1
#endif
#ifndef REP_H1
#define REP_H1 1
#endif
#ifndef REP_I1
#define REP_I1 1
#endif
#ifndef REP_P0
#define REP_P0 1
#endif
#ifndef REP_CS
#define REP_CS 1
#endif
#ifndef REP_A
#define REP_A 1
#endif
#ifndef REP_I0
#define REP_I0 1
#endif
#ifndef REP_F0
#define REP_F0 1
#endif
#ifndef REP_G2
#define REP_G2 1
#endif
#ifndef REP_BAR
#define REP_BAR 0
#endif
template <int l>
__device__ __forceinline__ void layer_phases(const Params& p, Ctx& F, const XcdBarrier& bar, const int lo, const int hi) {
    constexpr int base = 1 + 9 * l;

        if (IN(base + 0)) { for (int rep_ = 0; rep_ < REP_A; ++rep_) norm_phase(p, F, l, 0, NR); for (int rep_ = 0; rep_ < REP_BAR; ++rep_) xcd_barrier(bar, F.wave == 0 && lane_id() == 0); SEAM(base + 0); }
        if (IN(base + 1)) {
            pg8::Gemm g{(const bf16_t*)(p.ws + WS_HBUF), (const bf16_t*)(p.ws + W_WIN) + (size_t)l * DP * DM, NR, DP, DM, DM};
            pg8::Order S; S.init(NR / 256, DP / 256, F.G, (int)blockIdx.x);
            pg8::EpiProj E{(bf16_t*)(p.ws + WS_PROJ)};
            { pg8::gemm_phase<pg8::EpiProj, pg8::Order, true, true>(F.lds + RING_OFF, g, S, E, F.wave); if (REP_B > 1) { pg8::gemm_phase<pg8::EpiProj, pg8::Order, true, true>(F.lds + RING_OFF, g, S, E, F.wave); } }
            SEAM(base + 1);
        }
        if (IN(base + 2)) {
            qkrope_phase(p, F, l);
            for (int rep_ = 0; rep_ < REP_CS; ++rep_)
            for (int u = blockIdx.x; u < 8 * 66; u += F.G) {
                const int bh = u & 7, j = u >> 3, b = bh >> 2, h = bh & 3;
                const int rowbase = j < 2 ? NL + b * TC + 128 * j : b * T + 128 * (j - 2);
                att::chunk_state_unit(F.wave, (const bf16_t*)(p.ws + WS_PROJ), cs_ptr(p, b, h, 0, j), cs_ptr(p, b, h, 1, j), rowbase, h,
                                      log2_sigmoid(p.in[I_DECF][l * NH + h]), log2_sigmoid(p.in[I_DECB][l * NH + h]), (LAS char*)(F.lds + RING_OFF));
            }
            SEAM(base + 2);
        }
        if (IN(base + 3)) { scan_phase(p, F, l); SEAM(base + 3); }
        if (IN(base + 4)) {
#if FAST_RET
            for (int rep_ = 0; rep_ < REP_RET; ++rep_)
            for (int u = blockIdx.x; u < (l == 0 ? 8 * 33 : 8 * 32); u += F.G) {
                const int bh = u & 7, jp = (u >> 3) + (l == 0 ? 0 : 1), b = bh >> 2, h = bh & 3;
                const int rowA = jp == 0 ? NL + b * TC : b * T + 128 * (2 * jp - 2);
                att::ret_out_unit(F.wave, (const bf16_t*)(p.ws + WS_PROJ), (bf16_t*)(p.ws + WS_CONCAT), cs_ptr(p, b, h, 0, 2 * jp), cs_ptr(p, b, h, 0, 2 * jp + 1), (size_t)66 * 16384,
                                  rowA, rowA + 128, h, log2_sigmoid(p.in[I_DECF][l * NH + h]), log2_sigmoid(p.in[I_DECB][l * NH + h]), p.in[I_GNG] + l * 512 + h * 128, (LAS char*)(F.lds + RING_OFF));
            }
#endif
#if FAST_ATT
            { const int lane_ = lane_id();
              const float s1 = wave_sum(p.in[I_LQ1][l * 64 + lane_] * p.in[I_LK1][l * 64 + lane_]), s2 = wave_sum(p.in[I_LQ2][l * 64 + lane_] * p.in[I_LK2][l * 64 + lane_]);
              const float li = lam_init_of(l), lam = __expf(s1) - __expf(s2) + li;
#if ATT_V3
              constexpr int nunits = 256 + (l == 0 ? 8 : 0);
              for (int rep_ = 0; rep_ < REP_ATT; ++rep_)
              for (int w = ((int)blockIdx.x + F.G - (8 % F.G)) % F.G; w < nunits; w += F.G) {
                  const int u = w < 256 ? ((w + 8) & 255) : w;
                  int b, h, qrow0, NT;
                  if (u < 256) { const int bh = u & 7, qb = u >> 3; b = bh >> 2; h = bh & 3; qrow0 = b * T + qb * 256; NT = (TC + T) / 64; }
                  else { const int bh = u - 256; b = bh >> 2; h = bh & 3; qrow0 = NL + b * TC; NT = TC / 64; }
                  att::ATT_UNIT(F.wave, (const bf16_t*)(p.ws + WS_PROJ), (const char*)(p.ws + WS_KT) + (size_t)(b * NH + h) * 132 * 16384, (const char*)(p.ws + WS_VT) + (size_t)(b * NH + h) * 132 * 16384, (bf16_t*)(p.ws + WS_CONCAT), qrow0, NT, h, (LAS char*)(F.lds + RING_OFF), lam, 1.f - li, p.in[I_SUBLN] + l * 128);
              }
#else
              constexpr int nunits = 512 + (l == 0 ? 16 : 0);
              for (int rep_ = 0; rep_ < REP_ATT; ++rep_)
              for (int u = blockIdx.x; u < nunits; u += F.G) {
                  int b, h, qrow0, NT;
                  if (u < 512) { const int bh = u & 7, qb = u >> 3; b = bh >> 2; h = bh & 3; qrow0 = b * T + qb * 128; NT = (TC + T) / 64; }
                  else { const int v = u - 512, bh = v & 7, blk = v >> 3; b = bh >> 2; h = bh & 3; qrow0 = NL + b * TC + blk * 128; NT = TC / 64; }
                  att::attn_unit(F.wave, (const bf16_t*)(p.ws + WS_PROJ), (const char*)(p.ws + WS_KT) + (size_t)(b * NH + h) * 132 * 16384, (const char*)(p.ws + WS_VT) + (size_t)(b * NH + h) * 132 * 16384, (bf16_t*)(p.ws + WS_CONCAT), qrow0, NT, h, (LAS char*)(F.lds + RING_OFF), lam, 1.f - li, p.in[I_SUBLN] + l * 128);
              }
#endif
            }
#endif
            SEAM(base + 4);
        }
        if (IN(base + 5)) {
            pg8::Gemm g{(const bf16_t*)(p.ws + WS_CONCAT), (const bf16_t*)(p.ws + W_WOUT) + (size_t)l * DM * DM, NR, DM, DM, DM};
            pg8::Order S; S.init(NL / 256, DM / 256, F.G, (int)blockIdx.x);
            pg8::EpiResid E{l == 0 ? p.in[I_X] : p.out, l == 0 ? p.in[I_CTX] : (const float*)(p.ws + WS_XRC), p.out, (float*)(p.ws + WS_XRC), modv(p, l, 0, 2), modv(p, l, 2, 2)};
            if (REP_F0 > 1 && l == 0) { pg8::gemm_phase<pg8::EpiResid, pg8::Order, true, true>(F.lds + RING_OFF, g, S, E, F.wave); }
            pg8::gemm_phase<pg8::EpiResid, pg8::Order, true, true>(F.lds + RING_OFF, g, S, E, F.wave);
            if constexpr (l == 0) {
                pg8::Gemm g2{(const bf16_t*)(p.ws + WS_CONCAT), (const bf16_t*)(p.ws + W_WOUT), NR, DM, 256, DM};
                pg8::SplitOrder S2; S2.init(NL / 256, 2, DM / 256, DM / 256, F.G, (int)blockIdx.x);
                pg8::EpiPartial E2{(float*)(p.ws + WS_PART), NL / 256, NC};
                pg8::gemm_phase<pg8::EpiPartial, pg8::SplitOrder, true, true>(F.lds + RING_OFF, g2, S2, E2, F.wave);
            }
            SEAM(base + 5);
        }
        if (IN(base + 6)) { if constexpr (l == 0) norm_phase(p, F, 0, 1, NR); else router_phase(p, F); SEAM(base + 6); }
        if constexpr (l == 0) {
            if (IN(8)) {
                pg8::Gemm g{(const bf16_t*)(p.ws + WS_HBUF), (const bf16_t*)(p.ws + W_FGU), NR, 2 * DFF, DM, DM};
                pg8::Order S; S.init(NR / 256, 2 * DFF / 256, F.G, (int)blockIdx.x);
                pg8::EpiSwiglu E{(bf16_t*)(p.ws + WS_ACT)};
                { pg8::gemm_phase<pg8::EpiSwiglu, pg8::Order, true, true>(F.lds + RING_OFF, g, S, E, F.wave); if (REP_H0 > 1) { pg8::gemm_phase<pg8::EpiSwiglu, pg8::Order, true, true>(F.lds + RING_OFF, g, S, E, F.wave); } }
                SEAM(8);
            }
            if (IN(9)) {
                pg8::Gemm g{(const bf16_t*)(p.ws + WS_ACT), (const bf16_t*)(p.ws + W_FD), NR, DM, DFF, DFF};
                pg8::Order S; S.init(NL / 256, DM / 256, F.G, (int)blockIdx.x);
                pg8::EpiResid E{p.out, (const float*)(p.ws + WS_XRC), p.out, (float*)(p.ws + WS_XRC), modv(p, 0, 0, 5), modv(p, 0, 2, 5)};
                if (REP_I0 > 1) { pg8::EpiResid Ed{p.out, (const float*)(p.ws + WS_XRC), (float*)(p.ws + WS_H2S), (float*)(p.ws + WS_H2S) + (size_t)NL * DM, modv(p, 0, 0, 5), modv(p, 0, 2, 5)}; pg8::gemm_phase<pg8::EpiResid, pg8::Order, true, true>(F.lds + RING_OFF, g, S, Ed, F.wave); }
                pg8::gemm_phase<pg8::EpiResid, pg8::Order, true, true>(F.lds + RING_OFF, g, S, E, F.wave);
                {
                    pg8::Gemm g2{(const bf16_t*)(p.ws + WS_ACT), (const bf16_t*)(p.ws + W_FD), NR, DM, 256, DFF};
                    pg8::SplitOrder S2; S2.init(NL / 256, 2, DM / 256, DFF / 256, F.G, (int)blockIdx.x);
                    pg8::EpiPartial E2{(float*)(p.ws + WS_PART), NL / 256, NC};
                    pg8::gemm_phase<pg8::EpiPartial, pg8::SplitOrder, true, true>(F.lds + RING_OFF, g2, S2, E2, F.wave);
                }
                SEAM(9);
            }
        } else {
            if (IN(17)) {
#if SEAM_CVT
                moe_cvt_rest(p, F);
#endif
                for (int rep_ = 0; rep_ < REP_G2; ++rep_) gather_phase(p, F); SEAM(17); }
            if (IN(18)) {
                moe_table(F);
                pg8::Gemm g{(const bf16_t*)(p.ws + WS_H2S), (const bf16_t*)(p.ws + W_MGU), MP_MAX, 2 * DFF, DM / 2, DM / 2};
                pg8::Order S; moe_order(F, S, 2 * DFF / 256, (long)2 * DFF * DM);
                pg8::EpiSwiglu8 E{(unsigned char*)(p.ws + WS_ACTS)};
                { pg8::gemm_phase<pg8::EpiSwiglu8, pg8::Order, true, true, true>(F.lds + RING_OFF, g, S, E, F.wave); if (REP_H1 > 1) { pg8::gemm_phase<pg8::EpiSwiglu8, pg8::Order, true, true, true>(F.lds + RING_OFF, g, S, E, F.wave); } }
                SEAM(18);
            }
            if (IN(19)) {
                moe_table(F);
                pg8::Gemm g{(const bf16_t*)(p.ws + WS_ACTS), (const bf16_t*)(p.ws + W_MD), MP_MAX, DM, DFF / 2, DFF / 2};
                pg8::Order S; moe_order(F, S, DM / 256, (long)DM * DFF);
                pg8::EpiMoeDown E{(bf16_t*)(p.ws + WS_YBUF), (const float*)(p.ws + WS_ROUTE) + 6 * NL + MP_MAX, 1.f / (W8_SCALE * A8_SCALE)};
                { pg8::gemm_phase<pg8::EpiMoeDown, pg8::Order, true, true, true>(F.lds + RING_OFF, g, S, E, F.wave); if (REP_I1 > 1) { pg8::gemm_phase<pg8::EpiMoeDown, pg8::Order, true, true, true>(F.lds + RING_OFF, g, S, E, F.wave); } }
                SEAM(19);
            }
            if (IN(20)) { combine_phase(p, F); }
        }
}
struct MArgs { Params p; int ph_lo, ph_hi, li, pad; };
constexpr int N_PHASES = 21;
__global__ void __launch_bounds__(NWAVES * 64, 2) mega(MArgs args) {
    extern __shared__ __attribute__((aligned(16))) unsigned char lds_raw[];
    const Params& p = args.p;
    Ctx F;
    F.lds = (LAS unsigned char*)lds_raw; F.MISC = (volatile LAS unsigned*)(F.lds + MISC_OFF);
    F.wave = __builtin_amdgcn_readfirstlane((int)threadIdx.x >> 6);
    const int lane_ = lane_id(), tid_ = F.wave * 64 + lane_;
    F.G = gridDim.x; F.gw = blockIdx.x * NWAVES + F.wave; F.NGW = F.G * NWAVES;
    F.ctl = (unsigned*)(p.ws + WS_CTL);
    for (int u = tid_; u < (LDS_BYTES - MISC_OFF) / 4; u += NWAVES * 64) ((LAS unsigned*)(F.lds + MISC_OFF))[u] = 0u;
    __syncthreads();
    XcdBarrier bar = xcd_barrier_post(F.ctl + CW_BAR + args.li * XCD_BAR_WORDS, F.MISC + 8, tid_ == 0);
    const int lo = args.ph_lo, hi = args.ph_hi;

    if (IN(0)) { for (int rep_ = 0; rep_ < REP_P0; ++rep_) { if (rep_) __syncthreads(); p0_prologue(p, F); } SEAM(0); }
    layer_phases<0>(p, F, bar, lo, hi);
    layer_phases<1>(p, F, bar, lo, hi);
#undef IN
#undef SEAM
}

#ifndef FAST_MASK
#define FAST_MASK 0x1u
#endif
static void launch_naive_e(const Params& p, int l, bool ret, bool att, hipStream_t stream) {
    const int nrows_mix = l == 0 ? NR : NL;
    if (ret) k_ret_naive<<<nrows_mix * NH / 4, 256, 0, stream>>>(p, l, nrows_mix);
    if (att) k_attn_naive<<<nrows_mix * NH / 4, 256, 0, stream>>>(p, l, nrows_mix);
}
static void launch_naive(const Params& p, int ph, hipStream_t stream) {
    const int l = ph >= 10 ? 1 : 0, rel = ph == 0 ? -1 : (ph - 1 - 9 * l);
    const int nrows_mix = l == 0 ? NR : NL;
    if (ph == 0) { k_mod<<<(2 * 3 * 6144 + 255) / 256, 256, 0, stream>>>(p); return; }
    switch (rel) {
    case 0: k_norm<<<NR / 4, 256, 0, stream>>>(p, l, 0, NR); break;
    case 1: k_gemm_proj<<<dim3(DP / 64, NR / 4), dim3(64, 4), 0, stream>>>(p, l); break;
    case 2: k_qkrope<<<NR / 4, 256, 0, stream>>>(p, l); break;
    case 3: break;
    case 4: launch_naive_e(p, l, true, true, stream); break;
    case 5: k_gemm_out<<<dim3(DM / 64, nrows_mix / 4), dim3(64, 4), 0, stream>>>(p, l); break;
    case 6: k_norm<<<nrows_mix / 4, 256, 0, stream>>>(p, l, 1, nrows_mix); break;
    case 7: if (l == 0) k_ffn_gu<<<dim3(DFF / 64, NR / 4), dim3(64, 4), 0, stream>>>(p); break;
    case 8: if (l == 0) k_ffn_down<<<dim3(DM / 64, NR / 4), dim3(64, 4), 0, stream>>>(p); else k_moe_gu<<<dim3(DFF / 64, 2 * NL / 4), dim3(64, 4), 0, stream>>>(p); break;
    case 9: k_moe_down<<<dim3(DM / 64, NL / 4), dim3(64, 4), 0, stream>>>(p); break;
    default: break;
    }
}
extern "C" void kernel_launch(void* const* d_in, const int* in_sizes, int n_in, void* d_out, int out_size, void* d_ws, size_t ws_size, hipStream_t stream) {
    static int grid = 0;
    if (grid == 0) {
        if (n_in != 28 || out_size != NL * DM || ws_size < WS_END) { fprintf(stderr, "kernel_launch: unexpected shapes (n_in %d out %d ws %zu need %zu)\n", n_in, out_size, ws_size, (size_t)WS_END); grid = -1; return; }
        int dev = 0, cus = 0, per_cu = 0;
        if (hipGetDevice(&dev) != hipSuccess || hipDeviceGetAttribute(&cus, hipDeviceAttributeMultiprocessorCount, dev) != hipSuccess) { grid = -1; return; }
        if (hipFuncSetAttribute((const void*)mega, hipFuncAttributeMaxDynamicSharedMemorySize, LDS_BYTES) != hipSuccess) { fprintf(stderr, "kernel_launch: hipFuncSetAttribute failed\n"); grid = -1; return; }
        if (hipOccupancyMaxActiveBlocksPerMultiprocessor(&per_cu, (const void*)mega, NWAVES * 64, LDS_BYTES) != hipSuccess || per_cu < 1) { fprintf(stderr, "kernel_launch: occupancy query says %d\n", per_cu); (void)hipGetLastError(); grid = -1; return; }
        grid = cus;
    }
    if (grid < 0) return;
    (void)hipMemsetAsync((char*)d_ws + WS_CTL, 0, CTL_ZERO_BYTES, stream);
    MArgs a{};
    for (int i = 0; i < 28; ++i) a.p.in[i] = (const float*)d_in[i];
    a.p.out = (float*)d_out; a.p.ws = (unsigned char*)d_ws;
    const unsigned mask = FAST_MASK;
    int li = 0, ph = 0;
    while (ph < N_PHASES) {
        if ((mask >> ph) & 1u) { int e = ph; bool cutE = false;
            while (e < N_PHASES && ((mask >> e) & 1u)) { const bool isE = (e == 5 || e == 14); ++e; if (isE && !(FAST_ATT && FAST_RET)) { cutE = true; break; } }
            a.ph_lo = ph; a.ph_hi = e; a.li = li++;
            hipLaunchKernelGGL(mega, dim3(grid), dim3(NWAVES * 64), LDS_BYTES, stream, a);
            if (cutE) launch_naive_e(a.p, e - 1 == 5 ? 0 : 1, !FAST_RET, !FAST_ATT, stream);
            ph = e; }
        else { launch_naive(a.p, ph, stream); ++ph; }
    }
}
```

```cpp
#include <hip/hip_runtime.h>
#include <cstdint>
#include <cstdio>
#define FAST_MASK 0x1fffffu
#define FAST_ATT 1
#define FAST_RET 1
#define ATT_PRIO 1
#define EXP_TREE 1

constexpr int NB = 2, T = 8192, DM = 1024, TC = 256;
constexpr int NL = NB * T;
constexpr int NC = NB * TC;
constexpr int NR = NL + NC;
constexpr int DP = 3584, DFF = 2816, NE = 8, NH = 4;
constexpr float EPS = 1e-6f;
constexpr int C_RQ = 0, C_RK = 512, C_RV = 1024, C_RG = 1536, C_DQ = 2048, C_DK = 2560, C_DV = 3072;
constexpr int MP_MAX = 2 * NL + NE * 256;

typedef unsigned short bf16_t;
__device__ __forceinline__ float bf2f(bf16_t v) { return __uint_as_float(((unsigned)v) << 16); }
__device__ __forceinline__ bf16_t f2bf(float f) { unsigned u = __float_as_uint(f); u += 0x7fffu + ((u >> 16) & 1u); return (bf16_t)(u >> 16); }
typedef float f32x2_t __attribute__((ext_vector_type(2)));
typedef __bf16 bf16x2_t __attribute__((ext_vector_type(2)));
__device__ __forceinline__ unsigned pk2(float lo, float hi) { const f32x2_t v = {lo, hi}; const bf16x2_t b = __builtin_convertvector(v, bf16x2_t); return __builtin_bit_cast(unsigned, b); }
__device__ __forceinline__ unsigned pk4_fp8(float a, float b, float c, float d) {
    a = __builtin_amdgcn_fmed3f(a, -448.f, 448.f); b = __builtin_amdgcn_fmed3f(b, -448.f, 448.f); c = __builtin_amdgcn_fmed3f(c, -448.f, 448.f); d = __builtin_amdgcn_fmed3f(d, -448.f, 448.f);
    int r = 0; r = __builtin_amdgcn_cvt_pk_fp8_f32(a, b, r, false); r = __builtin_amdgcn_cvt_pk_fp8_f32(c, d, r, true); return (unsigned)r;
}
constexpr float W8_SCALE = 64.f, A8_SCALE = 8.f;
__device__ __forceinline__ float wave_sum(float v) {
#pragma unroll
    for (int o = 1; o < 64; o <<= 1) v += __shfl_xor(v, o);
    return v;
}
__device__ __forceinline__ int lane_id() { int l = (int)__builtin_amdgcn_mbcnt_hi(~0u, __builtin_amdgcn_mbcnt_lo(~0u, 0u)); asm volatile("" : "+v"(l)); return l; }
__device__ __forceinline__ float siluf(float v) { return v / (1.f + __expf(-v)); }

constexpr size_t MiB = 1u << 20;
constexpr size_t WS_CTL = 0, CTL_ZERO_BYTES = 1 * MiB;
constexpr size_t WS_MODV = 1 * MiB;
constexpr size_t WS_ROUTE = 2 * MiB;
constexpr size_t WS_XRC = 3 * MiB;
constexpr size_t WS_W = 6 * MiB;
constexpr size_t W_WIN = WS_W;
constexpr size_t W_WOUT = W_WIN + (size_t)2 * DP * DM * 2;
constexpr size_t W_FGU = W_WOUT + (size_t)2 * DM * DM * 2;
constexpr size_t W_FD = W_FGU + (size_t)2 * DFF * DM * 2;
constexpr size_t W_MGU = W_FD + (size_t)DM * DFF * 2;
constexpr size_t W_MD = W_MGU + (size_t)NE * 2 * DFF * DM * 2;
constexpr size_t W_END = W_MD + (size_t)NE * DM * DFF * 2;
constexpr size_t WS_HBUF = 173 * MiB;
constexpr size_t WS_PROJ = 206 * MiB;
constexpr size_t WS_CONCAT = 322 * MiB;
constexpr size_t WS_ACT = 206 * MiB;
constexpr size_t WS_ACTS = 173 * MiB;
constexpr size_t WS_H2S = 361 * MiB;
constexpr size_t WS_KT = 394 * MiB, WS_VT = WS_KT + (size_t)NB * NH * 132 * 16384;
static_assert(WS_VT + (size_t)NB * NH * 132 * 16384 <= 429 * MiB && WS_H2S + (size_t)NB * NH * 2 * 66 * 32768 <= WS_KT, "K/V tile images");
constexpr size_t WS_YBUF = WS_H2S, WS_CS = WS_H2S, WS_PART = WS_H2S;
constexpr size_t WS_END = 430 * MiB;
static_assert(W_END <= WS_HBUF && WS_ACTS + (size_t)MP_MAX * DFF * 2 <= WS_H2S && WS_H2S + (size_t)MP_MAX * DM * 2 <= WS_END && WS_ACT + (size_t)2 * NL * DFF * 2 <= WS_END, "ws map");
constexpr int CW_BAR = 4096;
constexpr int CW_CNT = 200000;

struct Params {
    const float* in[28];
    float* out;
    unsigned char* ws;
};
enum { I_X = 0, I_C, I_CTX, I_CCTX, I_ADAW, I_ADAB, I_N1G, I_N2G, I_WIN, I_DECF, I_DECB, I_GNG, I_QNG, I_KNG, I_LQ1, I_LK1, I_LQ2, I_LK2, I_SUBLN, I_WOUT,
       I_FWG, I_FWU, I_FWD, I_RW, I_RB, I_MWG, I_MWU, I_MWD };

__device__ __forceinline__ int rowtype(int m) { return m < NL ? m / T : 2; }
__device__ __forceinline__ const float* modv(const Params& p, int l, int rt, int i) { return (const float*)(p.ws + WS_MODV) + ((size_t)(l * 3 + rt) * 6 + i) * DM; }
__device__ __forceinline__ float* xr_row(const Params& p, int m) { return m < NL ? p.out + (size_t)m * DM : (float*)(p.ws + WS_XRC) + (size_t)(m - NL) * DM; }
__device__ __forceinline__ float lam_init_of(int l) { return l == 0 ? 0.2f : (0.8f - 0.6f * 0.74081822068171788f); }

#ifndef SEAM_CVT
#define SEAM_CVT 1
#endif
#ifndef ATT_UNIT
#define ATT_UNIT attn_unit3q
#endif
#ifndef FAST_ATT
#define FAST_ATT 0
#endif
#ifndef FAST_RET
#define FAST_RET 0
#endif
#ifndef ATT_V3
#define ATT_V3 1
#endif
__global__ void k_mod(Params p) {
    const int idx = blockIdx.x * blockDim.x + threadIdx.x;
    if (idx >= 2 * 3 * 6144) return;
    const int n = idx % 6144, rt = (idx / 6144) % 3, l = idx / (6144 * 3);
    const float* cv = rt < 2 ? p.in[I_C] + rt * DM : p.in[I_CCTX];
    const float* W = p.in[I_ADAW] + (size_t)l * DM * 6144;
    float acc = 0.f;
    for (int k = 0; k < DM; ++k) acc += siluf(cv[k]) * W[(size_t)k * 6144 + n];
    ((float*)(p.ws + WS_MODV))[(size_t)(l * 3 + rt) * 6144 + n] = acc + p.in[I_ADAB][l * 6144 + n];
}

__global__ void k_norm(Params p, int l, int which, int nrows) {
    const int m = blockIdx.x * (blockDim.x / 64) + (threadIdx.x >> 6), lane = threadIdx.x & 63;
    if (m >= nrows) return;
    const float* xrow;
    if (l == 0 && which == 0) xrow = m < NL ? p.in[I_X] + (size_t)m * DM : p.in[I_CTX] + (size_t)(m - NL) * DM;
    else xrow = xr_row(p, m);
    const int rt = rowtype(m);
    const float* g = p.in[which ? I_N2G : I_N1G] + l * DM;
    const float* sh = modv(p, l, rt, which ? 3 : 0);
    const float* sc = modv(p, l, rt, which ? 4 : 1);
    float v[16]; float ss = 0.f;
#pragma unroll
    for (int j = 0; j < 4; ++j) { const float4 t = *(const float4*)(xrow + 256 * j + 4 * lane); v[4 * j] = t.x; v[4 * j + 1] = t.y; v[4 * j + 2] = t.z; v[4 * j + 3] = t.w; ss += t.x * t.x + t.y * t.y + t.z * t.z + t.w * t.w; }
    const float r = rsqrtf(wave_sum(ss) * (1.f / DM) + EPS);
    bf16_t* hb = (bf16_t*)(p.ws + WS_HBUF) + (size_t)m * DM;
#pragma unroll
    for (int j = 0; j < 4; ++j)
#pragma unroll
        for (int q = 0; q < 4; ++q) { const int col = 256 * j + 4 * lane + q; const float y = v[4 * j + q] * r * g[col]; v[4 * j + q] = y * (1.f + sc[col]) + sh[col]; hb[col] = f2bf(v[4 * j + q]); }
    if (l == 1 && which == 1) {
        const float* rw = p.in[I_RW]; float lg[8];
#pragma unroll
        for (int e = 0; e < 8; ++e) { float a = 0.f;
#pragma unroll
            for (int j = 0; j < 4; ++j)
#pragma unroll
                for (int q = 0; q < 4; ++q) a += v[4 * j + q] * rw[(size_t)(256 * j + 4 * lane + q) * 8 + e];
            lg[e] = wave_sum(a) + p.in[I_RB][e]; }
        int i1 = 0; float v1 = lg[0];
#pragma unroll
        for (int e = 1; e < 8; ++e) if (lg[e] > v1) { v1 = lg[e]; i1 = e; }
        int i2 = -1; float v2 = -3.4e38f;
#pragma unroll
        for (int e = 0; e < 8; ++e) if (e != i1 && lg[e] > v2) { v2 = lg[e]; i2 = e; }
        const float w1 = 1.f / (1.f + __expf(v2 - v1));
        if (lane == 0) { int* te = (int*)(p.ws + WS_ROUTE); float* tw = (float*)(p.ws + WS_ROUTE) + 2 * NL; te[2 * m] = i1; te[2 * m + 1] = i2; tw[2 * m] = w1; tw[2 * m + 1] = 1.f - w1; }
    }
}

__global__ void k_gemm_proj(Params p, int l) {
    const int n = blockIdx.x * 64 + threadIdx.x, m = blockIdx.y * 4 + threadIdx.y;
    const bf16_t* a = (const bf16_t*)(p.ws + WS_HBUF) + (size_t)m * DM;
    const float* W = p.in[I_WIN] + (size_t)l * DM * DP + n;
    float acc = 0.f;
#pragma unroll 8
    for (int k = 0; k < DM; ++k) acc += bf2f(a[k]) * W[(size_t)k * DP];
    if (n >= C_RK && n < C_RV) acc *= 0.08838834764831845f;
    ((bf16_t*)(p.ws + WS_PROJ))[(size_t)m * DP + n] = f2bf(acc);
}

__global__ void k_qkrope(Params p, int l) {
    const int m = blockIdx.x * (blockDim.x / 64) + (threadIdx.x >> 6), lane = threadIdx.x & 63;
    if (m >= NR) return;
    bf16_t* row = (bf16_t*)(p.ws + WS_PROJ) + (size_t)m * DP;
    const bool lat = m < NL; const int t = m % T;
    const int j = lane & 31; const float pos = (float)((j < 16) ? (t / 64) : (t % 64));
    const float inv_freq = exp2f(-(float)(j & 15) * (13.287712379549449f / 16.f));
    const float ang = pos * inv_freq; const float cs = __cosf(ang), sn = __sinf(ang);
    for (int part = 0; part < 2; ++part) {
        const float* g = p.in[part ? I_KNG : I_QNG] + l * 64;
        for (int hc = 0; hc < 8; ++hc) {
            bf16_t* q = row + (part ? C_DK : C_DQ) + hc * 64;
            const float v = bf2f(q[lane]);
            const float r = rsqrtf(wave_sum(v * v) * (1.f / 64.f) + EPS);
            float y = v * r * g[lane];
            if (lat) { const float o = __shfl_xor(y, 32); y = lane < 32 ? y * cs - o * sn : y * cs + o * sn; }
            if (part == 0) y *= 0.18033688011112042f;
            q[lane] = f2bf(y);
        }
    }
}

__global__ void k_ret_naive(Params p, int l, int nrows) {
    const int w = blockIdx.x * (blockDim.x / 64) + (threadIdx.x >> 6), lane = threadIdx.x & 63;
    if (w >= nrows * NH) return;
    const int m = w / NH, h = w % NH;
    const bf16_t* proj = (const bf16_t*)(p.ws + WS_PROJ);
    const float df = p.in[I_DECF][l * NH + h], db = p.in[I_DECB][l * NH + h];
    const float lgf = -log1pf(__expf(-df)), lgb = -log1pf(__expf(-db));
    const bf16_t* qrow = proj + (size_t)m * DP + C_RQ + h * 128 + 2 * lane;
    const float q0 = bf2f(qrow[0]), q1 = bf2f(qrow[1]);
    float o0 = 0.f, o1 = 0.f;
    if (m < NL) {
        const int b = m / T, t = m % T;
        for (int s = 0; s < T; ++s) {
            const bf16_t* kr = proj + (size_t)(b * T + s) * DP + h * 128 + 2 * lane;
            const float dot = wave_sum(q0 * bf2f(kr[C_RK]) + q1 * bf2f(kr[C_RK + 1]));
            const float wgt = s < t ? __expf(lgf * (float)(t - s)) : (s == t ? 2.f : __expf(lgb * (float)(s - t)));
            o0 += wgt * dot * bf2f(kr[C_RV]); o1 += wgt * dot * bf2f(kr[C_RV + 1]);
        }
        for (int i = 0; i < TC; ++i) {
            const bf16_t* kr = proj + (size_t)(NL + b * TC + i) * DP + h * 128 + 2 * lane;
            const float dot = wave_sum(q0 * bf2f(kr[C_RK]) + q1 * bf2f(kr[C_RK + 1]));
            const float wgt = __expf(lgf * (float)(t + TC - i)) + __expf(lgb * (float)(T - t + i));
            o0 += wgt * dot * bf2f(kr[C_RV]); o1 += wgt * dot * bf2f(kr[C_RV + 1]);
        }
    } else {
        const int b = (m - NL) / TC, t = (m - NL) % TC;
        for (int s = 0; s < TC; ++s) {
            const bf16_t* kr = proj + (size_t)(NL + b * TC + s) * DP + h * 128 + 2 * lane;
            const float dot = wave_sum(q0 * bf2f(kr[C_RK]) + q1 * bf2f(kr[C_RK + 1]));
            const float wgt = s < t ? __expf(lgf * (float)(t - s)) : (s == t ? 2.f : __expf(lgb * (float)(s - t)));
            o0 += wgt * dot * bf2f(kr[C_RV]); o1 += wgt * dot * bf2f(kr[C_RV + 1]);
        }
    }
    const float mu = wave_sum(o0 + o1) * (1.f / 128.f);
    const float d0 = o0 - mu, d1 = o1 - mu;
    const float r = rsqrtf(wave_sum(d0 * d0 + d1 * d1) * (1.f / 128.f) + EPS);
    const float* gn = p.in[I_GNG] + l * 512 + h * 128 + 2 * lane;
    const bf16_t* gr = proj + (size_t)m * DP + C_RG + h * 128 + 2 * lane;
    bf16_t* cc = (bf16_t*)(p.ws + WS_CONCAT) + (size_t)m * DM + h * 128 + 2 * lane;
    cc[0] = f2bf(siluf(bf2f(gr[0])) * d0 * r * gn[0]);
    cc[1] = f2bf(siluf(bf2f(gr[1])) * d1 * r * gn[1]);
}

__global__ void k_attn_naive(Params p, int l, int nrows) {
    const int w = blockIdx.x * (blockDim.x / 64) + (threadIdx.x >> 6), lane = threadIdx.x & 63;
    if (w >= nrows * NH) return;
    const int m = w / NH, h = w % NH;
    const bf16_t* proj = (const bf16_t*)(p.ws + WS_PROJ);
    const bool lat = m < NL; const int b = lat ? m / T : (m - NL) / TC;
    float O[2][2];
    for (int c = 0; c < 2; ++c) {
        const float q = bf2f(proj[(size_t)m * DP + C_DQ + h * 128 + c * 64 + lane]);
        float mx = -1e30f, ls = 0.f, o0 = 0.f, o1 = 0.f;
        const int nk = lat ? TC + T : TC;
        for (int s = 0; s < nk; ++s) {
            const int mk = s < TC ? NL + b * TC + s : b * T + (s - TC);
            const bf16_t* kr = proj + (size_t)mk * DP + h * 128;
            const float sc = wave_sum(q * bf2f(kr[C_DK + c * 64 + lane]));
            const float mn = fmaxf(mx, sc), al = exp2f(mx - mn), pp = exp2f(sc - mn);
            ls = ls * al + pp; o0 = o0 * al + pp * bf2f(kr[C_DV + 2 * lane]); o1 = o1 * al + pp * bf2f(kr[C_DV + 2 * lane + 1]); mx = mn;
        }
        O[c][0] = o0 / ls; O[c][1] = o1 / ls;
    }
    float s1 = 0.f, s2 = 0.f;
    { const float a = p.in[I_LQ1][l * 64 + lane] * p.in[I_LK1][l * 64 + lane], bq = p.in[I_LQ2][l * 64 + lane] * p.in[I_LK2][l * 64 + lane]; s1 = wave_sum(a); s2 = wave_sum(bq); }
    const float li = lam_init_of(l), lam = __expf(s1) - __expf(s2) + li;
    const float d0 = O[0][0] - lam * O[1][0], d1 = O[0][1] - lam * O[1][1];
    const float r = rsqrtf(wave_sum(d0 * d0 + d1 * d1) * (1.f / 128.f) + EPS);
    const float* sg = p.in[I_SUBLN] + l * 128 + 2 * lane;
    bf16_t* cc = (bf16_t*)(p.ws + WS_CONCAT) + (size_t)m * DM + 512 + h * 128 + 2 * lane;
    cc[0] = f2bf(d0 * r * sg[0] * (1.f - li)); cc[1] = f2bf(d1 * r * sg[1] * (1.f - li));
}

__global__ void k_gemm_out(Params p, int l) {
    const int n = blockIdx.x * 64 + threadIdx.x, m = blockIdx.y * 4 + threadIdx.y;
    const bf16_t* a = (const bf16_t*)(p.ws + WS_CONCAT) + (size_t)m * DM;
    const float* W = p.in[I_WOUT] + (size_t)l * DM * DM + n;
    float acc = 0.f;
#pragma unroll 8
    for (int k = 0; k < DM; ++k) acc += bf2f(a[k]) * W[(size_t)k * DM];
    const float xin = l == 0 ? (m < NL ? p.in[I_X][(size_t)m * DM + n] : p.in[I_CTX][(size_t)(m - NL) * DM + n]) : xr_row(p, m)[n];
    xr_row(p, m)[n] = xin + modv(p, l, rowtype(m), 2)[n] * acc;
}

__global__ void k_ffn_gu(Params p) {
    const int j = blockIdx.x * 64 + threadIdx.x, m = blockIdx.y * 4 + threadIdx.y;
    const bf16_t* a = (const bf16_t*)(p.ws + WS_HBUF) + (size_t)m * DM;
    const float* Wg = p.in[I_FWG] + j; const float* Wu = p.in[I_FWU] + j;
    float ag = 0.f, au = 0.f;
#pragma unroll 8
    for (int k = 0; k < DM; ++k) { const float x = bf2f(a[k]); ag += x * Wg[(size_t)k * DFF]; au += x * Wu[(size_t)k * DFF]; }
    ((bf16_t*)(p.ws + WS_ACT))[(size_t)m * DFF + j] = f2bf(siluf(ag) * au);
}
__global__ void k_ffn_down(Params p) {
    const int n = blockIdx.x * 64 + threadIdx.x, m = blockIdx.y * 4 + threadIdx.y;
    const bf16_t* a = (const bf16_t*)(p.ws + WS_ACT) + (size_t)m * DFF;
    const float* W = p.in[I_FWD] + n;
    float acc = 0.f;
#pragma unroll 8
    for (int k = 0; k < DFF; ++k) acc += bf2f(a[k]) * W[(size_t)k * DM];
    xr_row(p, m)[n] += modv(p, 0, rowtype(m), 5)[n] * acc;
}
__global__ void k_moe_gu(Params p) {
    const int j = blockIdx.x * 64 + threadIdx.x, ts = blockIdx.y * 4 + threadIdx.y;
    const int t = ts >> 1; const int e = ((const int*)(p.ws + WS_ROUTE))[ts];
    const bf16_t* a = (const bf16_t*)(p.ws + WS_HBUF) + (size_t)t * DM;
    const float* Wg = p.in[I_MWG] + (size_t)e * DM * DFF + j; const float* Wu = p.in[I_MWU] + (size_t)e * DM * DFF + j;
    float ag = 0.f, au = 0.f;
#pragma unroll 8
    for (int k = 0; k < DM; ++k) { const float x = bf2f(a[k]); ag += x * Wg[(size_t)k * DFF]; au += x * Wu[(size_t)k * DFF]; }
    ((bf16_t*)(p.ws + WS_ACT))[(size_t)ts * DFF + j] = f2bf(siluf(ag) * au);
}
__global__ void k_moe_down(Params p) {
    const int n = blockIdx.x * 64 + threadIdx.x, t = blockIdx.y * 4 + threadIdx.y;
    const int* te = (const int*)(p.ws + WS_ROUTE); const float* tw = (const float*)(p.ws + WS_ROUTE) + 2 * NL;
    float y = 0.f;
    for (int s = 0; s < 2; ++s) {
        const bf16_t* a = (const bf16_t*)(p.ws + WS_ACT) + (size_t)(2 * t + s) * DFF;
        const float* W = p.in[I_MWD] + (size_t)te[2 * t + s] * DFF * DM + n;
        float acc = 0.f;
#pragma unroll 8
        for (int k = 0; k < DFF; ++k) acc += bf2f(a[k]) * W[(size_t)k * DM];
        y += tw[2 * t + s] * acc;
    }
    p.out[(size_t)t * DM + n] += modv(p, 1, t / T, 5)[n] * y;
}


typedef unsigned v2u __attribute__((ext_vector_type(2)));
namespace pg8 {
#define PG8_LAS __attribute__((address_space(3)))
typedef unsigned short bf16_t;
typedef short bf16x8 __attribute__((ext_vector_type(8)));
typedef float f32x4 __attribute__((ext_vector_type(4)));
typedef unsigned u32x4 __attribute__((ext_vector_type(4)));
typedef int i32x4 __attribute__((ext_vector_type(4)));
typedef int i32x8 __attribute__((ext_vector_type(8)));
constexpr int BM = 256, BK = 64, HALF = 128, HTB = HALF * BK * 2  , STAGE_BYTES = 8 * HTB, NXCD = 8, WGM = 8;

__host__ __device__ __forceinline__ int lds_byte(int r, int c) { const int st = (r >> 4) * 2 + (c >> 5), rr = r & 15, cc = c & 31, ob = rr * 64 + cc * 2; return st * 1024 + (ob ^ (((ob >> 9) & 1) << 5)); }
__host__ __device__ __forceinline__ void stage_rc(int b, int& R, int& C) { const int st = b / 1024, sb = b % 1024, swz = sb ^ (((sb >> 9) & 1) << 5); R = (st >> 1) * 16 + swz / 64; C = (st & 1) * 32 + (swz % 64) / 2; }
__host__ __device__ __forceinline__ int perm32(int rho) { const int n = rho >> 4, i = rho & 15; return 8 * (i >> 2) + 4 * n + (i & 3); }

struct Unit { int pm, pn; long bofs, kofs; };
struct Gemm { const bf16_t* A; const bf16_t* Bt; int M, N, K, ld; };

struct Order {
    int nM, nN, nwg, G, c;
    int e1, e2, e3, e4, e5, e6, e7; long estride;
    __device__ __forceinline__ void init(int nM_, int nN_, int G_, int c_) { nM = nM_; nN = nN_; nwg = nM * nN; G = G_; c = c_; estride = 0; e1 = e2 = e3 = e4 = e5 = e6 = e7 = 0; }
    __device__ __forceinline__ bool next(int i, Unit& u) const {
        const long L = (long)i * G + c; if (L >= nwg) return false;
        int wgid = (int)L; { const int q = nwg / NXCD, r = nwg % NXCD, xcd = wgid % NXCD, off = wgid / NXCD; wgid = (xcd < r ? xcd * (q + 1) : r * (q + 1) + (xcd - r) * q) + off; }
        const int nig = WGM * nN, gid = wgid / nig, fm = gid * WGM, gsz = (nM - fm) < WGM ? (nM - fm) : WGM;
        u.pm = fm + ((wgid % nig) % gsz); u.pn = (wgid % nig) / gsz;
        const int e = (u.pm >= e1) + (u.pm >= e2) + (u.pm >= e3) + (u.pm >= e4) + (u.pm >= e5) + (u.pm >= e6) + (u.pm >= e7);
        u.bofs = estride ? (long)e * estride : 0; u.kofs = 0;
        return true;
    }
    __device__ __forceinline__ void a_ready(const Unit&) const {}
    __device__ __forceinline__ void done(const Unit&) const {}
};

struct SplitOrder {
    int nN, ns, nwg, G, c, pm0;
    __device__ __forceinline__ void init(int pm0_, int npan, int nN_, int ns_, int G_, int c_) { pm0 = pm0_; nN = nN_; ns = ns_; nwg = npan * nN * ns; G = G_; c = c_; }
    __device__ __forceinline__ bool next(int i, Unit& u) const {
        const int L = i * G + c; if (L >= nwg) return false;
        const int ks = L % ns, rest = L / ns; u.pn = rest % nN; u.pm = pm0 + rest / nN; u.bofs = 0; u.kofs = (long)ks * 256 * 2; return true;
    }
    __device__ __forceinline__ void a_ready(const Unit&) const {}
    __device__ __forceinline__ void done(const Unit&) const {}
};
__device__ __forceinline__ unsigned cvt_pk_bf16(float lo, float hi) { unsigned r; asm volatile("v_cvt_pk_bf16_f32 %0, %1, %2" : "=v"(r) : "v"(lo), "v"(hi)); return r; }
__device__ __forceinline__ float silu_fast(float x) { return x * __builtin_amdgcn_rcpf(1.f + __builtin_amdgcn_exp2f(-1.4426950408889634f * x)); }

struct EpiProj {
    static constexpr bool PERM = true, AFTER_DRAIN = false;
    bf16_t* O;
    __device__ __forceinline__ void operator()(const f32x4 (&acc)[2][2][4][2], const Unit& u, int wr, int wc, int fr, int fq) const {
        const int row0 = u.pm * BM + wr * 64 + fr, col0 = u.pn * BM + wc * 32 + 8 * fq;
        const float sc = (u.pn == 2 || u.pn == 3) ? 0.08838834764831845f : 1.f;
#pragma unroll
        for (int ai = 0; ai < 2; ++ai)
#pragma unroll
            for (int m = 0; m < 4; ++m) { bf16_t* rowp = O + (size_t)(row0 + ai * HALF + m * 16) * DP + col0;
#pragma unroll
                for (int bj = 0; bj < 2; ++bj) { const f32x4 v0 = acc[ai][bj][m][0] * sc, v1 = acc[ai][bj][m][1] * sc;
                    u32x4 w; w.x = cvt_pk_bf16(v0[0], v0[1]); w.y = cvt_pk_bf16(v0[2], v0[3]); w.z = cvt_pk_bf16(v1[0], v1[1]); w.w = cvt_pk_bf16(v1[2], v1[3]);
                    *(u32x4*)(rowp + bj * HALF) = w; } }
    }
};
struct EpiResid {
    static constexpr bool PERM = false, AFTER_DRAIN = false;
    const float* base_lat; const float* base_ctx; float* out_lat; float* out_ctx; const float* gl; const float* gc;
    __device__ __forceinline__ void operator()(const f32x4 (&acc)[2][2][4][2], const Unit& u, int wr, int wc, int fr, int fq) const {
        const bool lat = u.pm < NL / BM;
        const int row0 = (lat ? u.pm * BM : u.pm * BM - NL) + wr * 64 + fr, col0 = u.pn * BM + wc * 32 + 4 * fq;
        const float* base = lat ? base_lat : base_ctx; float* out = lat ? out_lat : out_ctx;
        const float* gate = lat ? gl + (size_t)(u.pm / (T / BM)) * 6 * DM : gc;
        f32x4 gv[2][2];
#pragma unroll
        for (int bj = 0; bj < 2; ++bj)
#pragma unroll
            for (int n = 0; n < 2; ++n) gv[bj][n] = *(const f32x4*)(gate + col0 + bj * HALF + n * 16);
#pragma unroll
        for (int ai = 0; ai < 2; ++ai)
#pragma unroll
            for (int m = 0; m < 4; ++m) { const size_t off = (size_t)(row0 + ai * HALF + m * 16) * DM + col0;
#pragma unroll
                for (int bj = 0; bj < 2; ++bj)
#pragma unroll
                    for (int n = 0; n < 2; ++n) { const f32x4 bs = *(const f32x4*)(base + off + bj * HALF + n * 16); *(f32x4*)(out + off + bj * HALF + n * 16) = bs + gv[bj][n] * acc[ai][bj][m][n]; }
                asm volatile("" ::: "memory"); }
    }
};
struct EpiPartial {
    static constexpr bool PERM = false, AFTER_DRAIN = false;
    float* part; int pm0, nrows;
    __device__ __forceinline__ void operator()(const f32x4 (&acc)[2][2][4][2], const Unit& u, int wr, int wc, int fr, int fq) const {
        const int row0 = (u.pm - pm0) * BM + wr * 64 + fr, col0 = u.pn * BM + wc * 32 + 4 * fq;
        float* base = part + (size_t)(u.kofs / 512) * nrows * DM;
#pragma unroll
        for (int ai = 0; ai < 2; ++ai)
#pragma unroll
            for (int m = 0; m < 4; ++m) { float* rowp = base + (size_t)(row0 + ai * HALF + m * 16) * DM + col0;
#pragma unroll
                for (int bj = 0; bj < 2; ++bj)
#pragma unroll
                    for (int n = 0; n < 2; ++n) *(f32x4*)(rowp + bj * HALF + n * 16) = acc[ai][bj][m][n]; }
    }
};
struct EpiSwiglu {
    static constexpr bool PERM = true, AFTER_DRAIN = false;
    bf16_t* O;
    __device__ __forceinline__ void operator()(const f32x4 (&acc)[2][2][4][2], const Unit& u, int wr, int wc, int fr, int fq) const {
        const int row0 = u.pm * BM + wr * 64 + fr, col0 = u.pn * HALF + wc * 32 + 8 * fq;
#pragma unroll
        for (int ai = 0; ai < 2; ++ai)
#pragma unroll
            for (int m = 0; m < 4; ++m) { bf16_t* rowp = O + (size_t)(row0 + ai * HALF + m * 16) * DFF + col0;
                const f32x4 g0 = acc[ai][0][m][0], g1 = acc[ai][0][m][1], u0 = acc[ai][1][m][0], u1 = acc[ai][1][m][1];
                u32x4 w; w.x = cvt_pk_bf16(silu_fast(g0[0]) * u0[0], silu_fast(g0[1]) * u0[1]); w.y = cvt_pk_bf16(silu_fast(g0[2]) * u0[2], silu_fast(g0[3]) * u0[3]);
                w.z = cvt_pk_bf16(silu_fast(g1[0]) * u1[0], silu_fast(g1[1]) * u1[1]); w.w = cvt_pk_bf16(silu_fast(g1[2]) * u1[2], silu_fast(g1[3]) * u1[3]);
                *(u32x4*)rowp = w; }
    }
};
struct EpiSwiglu8 {
    static constexpr bool PERM = true, AFTER_DRAIN = false;
    unsigned char* O;
    __device__ __forceinline__ void operator()(const f32x4 (&acc)[2][2][4][2], const Unit& u, int wr, int wc, int fr, int fq) const {
        const int row0 = u.pm * BM + wr * 64 + fr, col0 = u.pn * HALF + wc * 32 + 8 * fq;
        constexpr float WI = 1.f / W8_SCALE;
#pragma unroll
        for (int ai = 0; ai < 2; ++ai)
#pragma unroll
            for (int m = 0; m < 4; ++m) { unsigned char* rowp = O + (size_t)(row0 + ai * HALF + m * 16) * DFF + col0;
                const f32x4 g0 = acc[ai][0][m][0] * WI, g1 = acc[ai][0][m][1] * WI, u0 = acc[ai][1][m][0] * (WI * A8_SCALE), u1 = acc[ai][1][m][1] * (WI * A8_SCALE);
                v2u w; w.x = pk4_fp8(silu_fast(g0[0]) * u0[0], silu_fast(g0[1]) * u0[1], silu_fast(g0[2]) * u0[2], silu_fast(g0[3]) * u0[3]);
                w.y = pk4_fp8(silu_fast(g1[0]) * u1[0], silu_fast(g1[1]) * u1[1], silu_fast(g1[2]) * u1[2], silu_fast(g1[3]) * u1[3]);
                *(v2u*)rowp = w; }
    }
};
struct EpiMoeDown {
    static constexpr bool PERM = true, AFTER_DRAIN = false;
    bf16_t* O; const float* rgate; float scale;
    __device__ __forceinline__ void operator()(const f32x4 (&acc)[2][2][4][2], const Unit& u, int wr, int wc, int fr, int fq) const {
        const int row0 = u.pm * BM + wr * 64 + fr, col0 = u.pn * BM + wc * 32 + 8 * fq;
#pragma unroll
        for (int ai = 0; ai < 2; ++ai)
#pragma unroll
            for (int m = 0; m < 4; ++m) { const int row = row0 + ai * HALF + m * 16; const float sc = rgate[row] * scale; bf16_t* rowp = O + (size_t)row * DM + col0;
#pragma unroll
                for (int bj = 0; bj < 2; ++bj) { const f32x4 v0 = acc[ai][bj][m][0] * sc, v1 = acc[ai][bj][m][1] * sc;
                    u32x4 w; w.x = cvt_pk_bf16(v0[0], v0[1]); w.y = cvt_pk_bf16(v0[2], v0[3]); w.z = cvt_pk_bf16(v1[0], v1[1]); w.w = cvt_pk_bf16(v1[2], v1[3]);
                    *(u32x4*)(rowp + bj * HALF) = w; } }
    }
};

template <class Epi, class Sched, bool ALIGN_EPI = false, bool SP2 = false, bool F8 = false>
__device__ __forceinline__ void gemm_phase(PG8_LAS unsigned char* lds, const Gemm g, const Sched& S, const Epi& E, const int wid  ) {
    const int lane = lane_id(), tid = wid * 64 + lane, wr = wid >> 2, wc = wid & 3, fr = lane & 15, fq = lane >> 4;
    const int K = g.ld, nt = g.K / BK;
    unsigned voffA[2], voffB[2];
#pragma unroll
    for (int i = 0; i < 2; ++i) { int R, C; stage_rc(tid * 16 + i * 8192, R, C); const int Rb = Epi::PERM ? ((R & ~31) + perm32(R & 31)) : R;
        voffA[i] = (unsigned)(R * K + C) * 2u; voffB[i] = (unsigned)(Rb * K + C) * 2u; }
    const size_t kstep = (size_t)(BK * 2);
    const size_t hstep = (size_t)HALF * K * 2;
    const size_t tstep = 2 * hstep;
    const unsigned ldsw = (unsigned)wid * 1024u;
    const int aoff = lds_byte(wr * 64 + fr, fq * 8), boff = lds_byte(wc * 32 + fr, fq * 8);
#define PG8_SA(b, h) (((b) * 2 + (h)) * HTB)
#define PG8_SB(b, h) ((4 + (b) * 2 + (h)) * HTB)
#define PG8_STAGE(bufoff, gbase, voff) do { _Pragma("unroll") for (int _i = 0; _i < 2; ++_i) \
        __builtin_amdgcn_global_load_lds((const unsigned*)((const char*)(gbase) + (voff)[_i]), (PG8_LAS unsigned*)(lds + (bufoff) + ldsw + _i * 8192), 16, 0, 0); } while (0)
#define PG8_LD8(addr) __builtin_shufflevector(*(const PG8_LAS i32x4*)(addr), *(const PG8_LAS i32x4*)((addr) + 1024), 0, 1, 2, 3, 4, 5, 6, 7)
#define PG8_LDA(dst, dst8, b, h) do { if constexpr (F8) { _Pragma("unroll") for (int m = 0; m < 4; ++m) dst8[m] = PG8_LD8(lds + PG8_SA(b, h) + aoff + m * 2048); } \
        else { _Pragma("unroll") for (int m = 0; m < 4; ++m) _Pragma("unroll") for (int k = 0; k < 2; ++k) dst[m][k] = *(const PG8_LAS bf16x8*)(lds + PG8_SA(b, h) + aoff + m * 2048 + k * 1024); } } while (0)
#define PG8_LDB(dst, dst8, b, h) do { if constexpr (F8) { _Pragma("unroll") for (int n = 0; n < 2; ++n) dst8[n] = PG8_LD8(lds + PG8_SB(b, h) + boff + n * 2048); } \
        else { _Pragma("unroll") for (int n = 0; n < 2; ++n) _Pragma("unroll") for (int k = 0; k < 2; ++k) dst[n][k] = *(const PG8_LAS bf16x8*)(lds + PG8_SB(b, h) + boff + n * 2048 + k * 1024); } } while (0)
#define PG8_MMA(ai, bj, At, At8, Bt, Bt8) do { __builtin_amdgcn_s_setprio(1); \
        if constexpr (F8) { _Pragma("unroll") for (int m = 0; m < 4; ++m) _Pragma("unroll") for (int n = 0; n < 2; ++n) \
            asm volatile("v_mfma_scale_f32_16x16x128_f8f6f4 %0, %1, %2, %0, %3, %3 op_sel_hi:[0,0,0]" : "+v"(acc[ai][bj][m][n]) : "v"(Bt8[n]), "v"(At8[m]), "v"(sc8_)); } \
        else { _Pragma("unroll") for (int m = 0; m < 4; ++m) _Pragma("unroll") for (int n = 0; n < 2; ++n) _Pragma("unroll") for (int k = 0; k < 2; ++k) \
            acc[ai][bj][m][n] = __builtin_amdgcn_mfma_f32_16x16x32_bf16(Bt[n][k], At[m][k], acc[ai][bj][m][n], 0, 0, 0); } \
        __builtin_amdgcn_s_setprio(0); } while (0)
#define PG8_WAIT_V(n) asm volatile("s_waitcnt vmcnt(" #n ")" ::: "memory")
#define PG8_WAIT_L(n) asm volatile("s_waitcnt lgkmcnt(" #n ")" ::: "memory")
#define PG8_BAR __builtin_amdgcn_s_barrier()
#define PG8_SCHED __builtin_amdgcn_sched_barrier(0)
#define PG8_SCHED8 do { if constexpr (F8) __builtin_amdgcn_sched_barrier(0); } while (0)
    Unit cur, nxt; int ui = 0;
    if (!S.next(0, cur)) return;
    constexpr float zero_ = 0.f;
    const int sc8_ = 0x7f7f7f7f;
    f32x4 acc[2][2][4][2];
#pragma unroll
    for (int a = 0; a < 2; ++a)
#pragma unroll
        for (int b = 0; b < 2; ++b)
#pragma unroll
            for (int m = 0; m < 4; ++m)
#pragma unroll
                for (int n = 0; n < 2; ++n) acc[a][b][m][n] = (f32x4){zero_, zero_, zero_, zero_};
    bf16x8 At[4][2], B0[2][2], B1[2][2];
    i32x8 At8[4], B08[2], B18[2];
    const char* cA = (const char*)g.A + cur.kofs + (size_t)cur.pm * tstep; const char* cB = (const char*)g.Bt + cur.bofs + cur.kofs + (size_t)cur.pn * tstep;
    S.a_ready(cur);
    if constexpr (SP2) {
        PG8_STAGE(PG8_SB(0, 0), cB, voffB); PG8_STAGE(PG8_SB(0, 1), cB + hstep, voffB); PG8_STAGE(PG8_SA(0, 0), cA, voffA); PG8_STAGE(PG8_SA(0, 1), cA + hstep, voffA);
        if (wr == 1) PG8_BAR;
        PG8_WAIT_V(2); PG8_BAR;
        PG8_STAGE(PG8_SB(1, 0), cB + kstep, voffB); PG8_STAGE(PG8_SA(1, 0), cA + kstep, voffA); PG8_STAGE(PG8_SB(1, 1), cB + hstep + kstep, voffB);
        PG8_WAIT_V(6); PG8_BAR;
    } else {
        PG8_STAGE(PG8_SB(0, 0), cB, voffB); PG8_STAGE(PG8_SA(0, 0), cA, voffA); PG8_STAGE(PG8_SB(0, 1), cB + hstep, voffB); PG8_STAGE(PG8_SA(0, 1), cA + hstep, voffA);
        if (wr == 1) PG8_BAR;
        PG8_WAIT_V(4); PG8_BAR;
        PG8_STAGE(PG8_SB(1, 0), cB + kstep, voffB); PG8_STAGE(PG8_SA(1, 0), cA + kstep, voffA); PG8_STAGE(PG8_SB(1, 1), cB + hstep + kstep, voffB);
        PG8_WAIT_V(6); PG8_BAR;
    }
    for (;;) {
        const bool has_next = S.next(ui + 1, nxt);
        const char* nA = has_next ? (const char*)g.A + nxt.kofs + (size_t)nxt.pm * tstep : cA; const char* nB = has_next ? (const char*)g.Bt + nxt.bofs + nxt.kofs + (size_t)nxt.pn * tstep : cB;
#pragma clang loop unroll(disable)
        for (int t = 0; t < nt; t += 2) {
            const bool last = (t == nt - 2);
            const char* a1 = cA + (size_t)(t + 1) * kstep;
            const char* a2 = last ? nA : cA + (size_t)(t + 2) * kstep; const char* b2 = last ? nB : cB + (size_t)(t + 2) * kstep;
            const char* a3 = a2 + kstep; const char* b3 = b2 + kstep;
            if (last && has_next) S.a_ready(nxt);
            if constexpr (SP2) {
            PG8_LDB(B0, B08, 0, 0); PG8_LDB(B1, B18, 0, 1); PG8_SCHED; PG8_LDA(At, At8, 0, 0); PG8_STAGE(PG8_SA(1, 1), a1 + hstep, voffA);
            PG8_WAIT_V(8); PG8_WAIT_L(0); PG8_BAR; PG8_SCHED8; PG8_MMA(0, 0, At, At8, B0, B08); PG8_MMA(0, 1, At, At8, B1, B18); PG8_SCHED8; PG8_BAR; PG8_SCHED;
            PG8_LDA(At, At8, 0, 1); PG8_STAGE(PG8_SB(0, 0), b2, voffB); PG8_STAGE(PG8_SB(0, 1), b2 + hstep, voffB); PG8_STAGE(PG8_SA(0, 0), a2, voffA);
            PG8_WAIT_V(8); PG8_WAIT_L(0); PG8_BAR; PG8_SCHED8; PG8_MMA(1, 0, At, At8, B0, B08); PG8_MMA(1, 1, At, At8, B1, B18); PG8_SCHED8; PG8_BAR; PG8_SCHED;
            PG8_LDB(B0, B08, 1, 0); PG8_LDB(B1, B18, 1, 1); PG8_SCHED; PG8_LDA(At, At8, 1, 0); PG8_STAGE(PG8_SA(0, 1), a2 + hstep, voffA);
            PG8_WAIT_V(8); PG8_WAIT_L(0); PG8_BAR; PG8_SCHED8; PG8_MMA(0, 0, At, At8, B0, B08); PG8_MMA(0, 1, At, At8, B1, B18); PG8_SCHED8; PG8_BAR; PG8_SCHED;
            PG8_LDA(At, At8, 1, 1); PG8_STAGE(PG8_SB(1, 0), b3, voffB); PG8_STAGE(PG8_SB(1, 1), b3 + hstep, voffB); PG8_STAGE(PG8_SA(1, 0), a3, voffA);
            PG8_WAIT_V(8); PG8_WAIT_L(0); PG8_BAR; PG8_SCHED8; PG8_MMA(1, 0, At, At8, B0, B08); PG8_MMA(1, 1, At, At8, B1, B18); PG8_SCHED8; PG8_BAR; PG8_SCHED;
            } else {
            PG8_LDB(B0, B08, 0, 0); PG8_SCHED; PG8_LDA(At, At8, 0, 0); PG8_STAGE(PG8_SA(1, 1), a1 + hstep, voffA);
            PG8_WAIT_L(8); PG8_BAR; PG8_WAIT_L(0); PG8_MMA(0, 0, At, At8, B0, B08); PG8_BAR; PG8_SCHED;
            PG8_LDB(B1, B18, 0, 1); PG8_STAGE(PG8_SB(0, 0), b2, voffB);
            PG8_BAR; PG8_WAIT_L(0); PG8_MMA(0, 1, At, At8, B1, B18); PG8_BAR;
            PG8_LDA(At, At8, 0, 1); PG8_STAGE(PG8_SA(0, 0), a2, voffA);
            PG8_BAR; PG8_WAIT_L(0); PG8_MMA(1, 0, At, At8, B0, B08); PG8_BAR; PG8_SCHED;
            PG8_STAGE(PG8_SB(0, 1), b2 + hstep, voffB);
            PG8_WAIT_V(6); PG8_BAR; PG8_MMA(1, 1, At, At8, B1, B18); PG8_BAR;
            PG8_LDB(B0, B08, 1, 0); PG8_SCHED; PG8_LDA(At, At8, 1, 0); PG8_STAGE(PG8_SA(0, 1), a2 + hstep, voffA);
            PG8_WAIT_L(8); PG8_BAR; PG8_WAIT_L(0); PG8_MMA(0, 0, At, At8, B0, B08); PG8_BAR; PG8_SCHED;
            PG8_LDB(B1, B18, 1, 1); PG8_STAGE(PG8_SB(1, 0), b3, voffB);
            PG8_BAR; PG8_WAIT_L(0); PG8_MMA(0, 1, At, At8, B1, B18); PG8_BAR;
            PG8_LDA(At, At8, 1, 1); PG8_STAGE(PG8_SA(1, 0), a3, voffA);
            PG8_BAR; PG8_WAIT_L(0); PG8_MMA(1, 0, At, At8, B0, B08); PG8_BAR; PG8_SCHED;
            PG8_STAGE(PG8_SB(1, 1), b3 + hstep, voffB);
            PG8_WAIT_V(6); PG8_BAR; PG8_MMA(1, 1, At, At8, B1, B18); PG8_BAR;
            }
        }
        if constexpr (ALIGN_EPI) { if (wr == 0) PG8_BAR; }
        if constexpr (F8) asm volatile("s_nop 15\n\ts_nop 15" ::: "memory");
        if constexpr (!Epi::AFTER_DRAIN) { E(acc, cur, wr, wc, fr, fq); S.done(cur); }
        if (!has_next) break;
#pragma unroll
        for (int a = 0; a < 2; ++a)
#pragma unroll
            for (int b = 0; b < 2; ++b)
#pragma unroll
                for (int m = 0; m < 4; ++m)
#pragma unroll
                    for (int n = 0; n < 2; ++n) acc[a][b][m][n] = (f32x4){zero_, zero_, zero_, zero_};
        cur = nxt; cA = nA; cB = nB; ++ui;
        if constexpr (ALIGN_EPI) { if (wr == 1) PG8_BAR; }
    }
    PG8_WAIT_V(0);
    if constexpr (!ALIGN_EPI) { if (wr == 0) PG8_BAR; }
    PG8_BAR;
    if constexpr (Epi::AFTER_DRAIN) { E.fused(acc, cur, wr, wc, fr, fq, lds, wid, lane); S.done(cur); }
#undef PG8_SA
#undef PG8_SB
#undef PG8_STAGE
#undef PG8_LDA
#undef PG8_LDB
#undef PG8_MMA
#undef PG8_LD8
#undef PG8_WAIT_V
#undef PG8_WAIT_L
#undef PG8_BAR
#undef PG8_SCHED
#undef PG8_SCHED8
}

}

#define GAS __attribute__((address_space(1)))
#define LAS __attribute__((address_space(3)))
typedef unsigned v4u __attribute__((ext_vector_type(4)));
typedef float f32x4 __attribute__((ext_vector_type(4)));
#define LDS_WAIT() asm volatile("s_waitcnt lgkmcnt(0)" ::: "memory")
#define VM_WAIT() asm volatile("s_waitcnt vmcnt(0)" ::: "memory")

#define XB_TMO      128
#define XB_XCNT(j)  (256  + 64 * (j))
#define XB_XSUB(j)  (1280 + 64 * (j))
#define XB_XGEN(j)  (2304 + 64 * (j))
#define XB_TOP      3328
#define XB_TOPGEN   3392
#define XCD_BAR_WORDS 3456
#define XB_SPIN_CAP (1u << 18)

__device__ __forceinline__ unsigned xb_ld(unsigned* p)              { return __hip_atomic_load(p, __ATOMIC_RELAXED, __HIP_MEMORY_SCOPE_AGENT); }
__device__ __forceinline__ unsigned xb_add(unsigned* p, unsigned v) { return __hip_atomic_fetch_add(p, v, __ATOMIC_RELAXED, __HIP_MEMORY_SCOPE_AGENT); }
__device__ __forceinline__ unsigned xb_xcc_id() { return (unsigned)__builtin_amdgcn_s_getreg((3 << 11) | 20) & 0xFu; }
#define XB_SPIN(cond, bar) do { unsigned _sp = 0; while (cond) { __builtin_amdgcn_s_sleep(1); \
    if ((++_sp & 255u) == 0u) { if (xb_ld(&(bar)[XB_TMO])) break; if (_sp > XB_SPIN_CAP) { atomicAdd(&(bar)[XB_TMO], 1u); break; } } } } while (0)

struct XcdBarrier {
    unsigned* bar; unsigned x;
    volatile LAS unsigned* st;
};

__device__ __forceinline__ XcdBarrier xcd_barrier_post(unsigned* bar, volatile LAS unsigned* st, bool t0) {
    XcdBarrier b; b.bar = bar; b.x = xb_xcc_id(); b.st = st;
    if (t0) (void)xb_add(&bar[XB_XCNT(b.x)], 1u);
    return b;
}
__device__ __forceinline__ void xcd_barrier_complete(unsigned* bar, unsigned x, unsigned& nloc, unsigned& nx) {
    const unsigned G = gridDim.x * gridDim.y * gridDim.z;
    unsigned sum, cnt, mine, sp = 0u;
    for (;;) {
        sum = 0u; cnt = 0u; mine = 0u;
#pragma unroll
        for (unsigned j = 0; j < 16; ++j) { const unsigned c = xb_ld(&bar[XB_XCNT(j)]); sum += c; cnt += (c > 0u) ? 1u : 0u; mine = (j == x) ? c : mine; }
        if (sum == G) break;
        __builtin_amdgcn_s_sleep(1);
        if ((++sp & 255u) == 0u) { if (xb_ld(&bar[XB_TMO])) break; if (sp > XB_SPIN_CAP) { atomicAdd(&bar[XB_TMO], 1u); break; } }
    }
    nloc = mine > 0u ? mine : 1u; nx = cnt > 0u ? cnt : 1u;
}

__device__ __forceinline__ void xcd_barrier(const XcdBarrier& b, bool t0) {
    asm volatile("s_waitcnt vmcnt(0)" ::: "memory");
    __syncthreads();
    if (t0) {
        unsigned* bar = b.bar;
        __builtin_amdgcn_s_waitcnt(0);
        unsigned nloc = b.st[0], nx = b.st[1];
        if (nloc == 0u) { xcd_barrier_complete(bar, b.x, nloc, nx); b.st[0] = nloc; b.st[1] = nx; }
        const unsigned old = xb_add(&bar[XB_XSUB(b.x)], 1u);
        const unsigned gen = old / nloc;
        if (old + 1u == (gen + 1u) * nloc) {
            __builtin_amdgcn_fence(__ATOMIC_RELEASE, "agent");
            asm volatile("s_waitcnt vmcnt(0)" ::: "memory");
            const unsigned og = xb_add(&bar[XB_TOP], 1u);
            const unsigned tg = og / nx;
            if (og + 1u == (tg + 1u) * nx) xb_add(&bar[XB_TOPGEN], 1u);
            else XB_SPIN(xb_ld(&bar[XB_TOPGEN]) == tg, bar);
            __builtin_amdgcn_fence(__ATOMIC_ACQUIRE, "agent");
            xb_add(&bar[XB_XGEN(b.x)], 1u);
            asm volatile("s_waitcnt vmcnt(0)" ::: "memory");
        } else {
            XB_SPIN(xb_ld(&bar[XB_XGEN(b.x)]) == gen, bar);
            __builtin_amdgcn_fence(__ATOMIC_ACQUIRE, "agent");
            asm volatile("s_waitcnt vmcnt(0)" ::: "memory");
        }
    }
    __syncthreads();
}

struct XcdToken { unsigned gen, tg; int role; };
__device__ __forceinline__ XcdToken xcd_barrier_arrive(const XcdBarrier& b, bool t0) {
    XcdToken k; k.gen = 0u; k.tg = 0u; k.role = 0;
    asm volatile("s_waitcnt vmcnt(0)" ::: "memory");
    __syncthreads();
    if (t0) {
        unsigned* bar = b.bar;
        __builtin_amdgcn_s_waitcnt(0);
        unsigned nloc = b.st[0], nx = b.st[1];
        if (nloc == 0u) { xcd_barrier_complete(bar, b.x, nloc, nx); b.st[0] = nloc; b.st[1] = nx; }
        const unsigned old = xb_add(&bar[XB_XSUB(b.x)], 1u);
        k.gen = old / nloc;
        if (old + 1u == (k.gen + 1u) * nloc) {
            __builtin_amdgcn_fence(__ATOMIC_RELEASE, "agent");
            asm volatile("s_waitcnt vmcnt(0)" ::: "memory");
            const unsigned og = xb_add(&bar[XB_TOP], 1u);
            k.tg = og / nx;
            if (og + 1u == (k.tg + 1u) * nx) { xb_add(&bar[XB_TOPGEN], 1u); k.role = 2; } else k.role = 1;
        }
    }
    return k;
}
__device__ __forceinline__ void xcd_barrier_wait(const XcdBarrier& b, const XcdToken& k, bool t0) {
    if (t0) {
        unsigned* bar = b.bar;
        if (k.role) {
            if (k.role == 1) XB_SPIN(xb_ld(&bar[XB_TOPGEN]) == k.tg, bar);
            __builtin_amdgcn_fence(__ATOMIC_ACQUIRE, "agent");
            xb_add(&bar[XB_XGEN(b.x)], 1u);
            asm volatile("s_waitcnt vmcnt(0)" ::: "memory");
        } else {
            XB_SPIN(xb_ld(&bar[XB_XGEN(b.x)]) == k.gen, bar);
            __builtin_amdgcn_fence(__ATOMIC_ACQUIRE, "agent");
            asm volatile("s_waitcnt vmcnt(0)" ::: "memory");
        }
    }
    __syncthreads();
}

constexpr int RING_OFF = 0, RING_BYTES = 131072;
constexpr int MISC_OFF = 143360;
constexpr int LDS_BYTES = 147456;
constexpr int NWAVES = 8;

struct Ctx { LAS unsigned char* lds; volatile LAS unsigned* MISC; unsigned* ctl; int wave, G, gw, NGW; };

__device__ __forceinline__ void cvt_item(const float* W, int K, int N, bf16_t* WT, int mode, LAS float* scr, int item, int lane) {
    const int kblk = K / 64, nb = item / kblk, kb = item % kblk, k0 = 64 * kb, n0 = 64 * nb;
    f32x4 ld[16];
#pragma unroll
    for (int i = 0; i < 16; ++i) { const int kk = 4 * i + (lane >> 4), c4 = 4 * (lane & 15); ld[i] = __builtin_nontemporal_load((const f32x4*)(W + (size_t)(k0 + kk) * N + n0 + c4));     }
#pragma unroll
    for (int i = 0; i < 16; ++i) { const int kk = 4 * i + (lane >> 4), c4 = 4 * (lane & 15);
        LAS float* s = scr + kk * 65 + c4; s[0] = ld[i][0]; s[1] = ld[i][1]; s[2] = ld[i][2]; s[3] = ld[i][3]; }
    LDS_WAIT(); asm volatile("" ::: "memory");
    const int c = lane >> 3;
#pragma unroll
    for (int j = 0; j < 8; ++j) { const int n = (lane & 7) + 8 * j; const LAS float* s = scr + (8 * c) * 65 + n;
        v4u o; o.x = pk2(s[0 * 65], s[1 * 65]); o.y = pk2(s[2 * 65], s[3 * 65]); o.z = pk2(s[4 * 65], s[5 * 65]); o.w = pk2(s[6 * 65], s[7 * 65]);
        const int nn = n0 + n; const int drow = mode == 0 ? nn : (nn / 128) * 256 + (mode - 1) * 128 + (nn % 128);
        *(v4u*)(WT + (size_t)drow * K + k0 + 8 * c) = o; }
    LDS_WAIT(); asm volatile("" ::: "memory");
}
__device__ __forceinline__ void cvt_item8(const float* W, int K, int N, unsigned char* WT, int mode, LAS float* scr, int item, int lane) {
    const int kblk = K / 64, nb = item / kblk, kb = item % kblk, k0 = 64 * kb, n0 = 64 * nb;
    f32x4 ld[16];
#pragma unroll
    for (int i = 0; i < 16; ++i) { const int kk = 4 * i + (lane >> 4), c4 = 4 * (lane & 15); ld[i] = __builtin_nontemporal_load((const f32x4*)(W + (size_t)(k0 + kk) * N + n0 + c4));     }
#pragma unroll
    for (int i = 0; i < 16; ++i) { const int kk = 4 * i + (lane >> 4), c4 = 4 * (lane & 15);
        LAS float* s = scr + kk * 65 + c4; s[0] = ld[i][0]; s[1] = ld[i][1]; s[2] = ld[i][2]; s[3] = ld[i][3]; }
    LDS_WAIT(); asm volatile("" ::: "memory");
    const int c = lane >> 3;
#pragma unroll
    for (int j = 0; j < 8; ++j) { const int n = (lane & 7) + 8 * j; const LAS float* s = scr + (8 * c) * 65 + n;
        v2u o; o.x = pk4_fp8(s[0 * 65] * W8_SCALE, s[1 * 65] * W8_SCALE, s[2 * 65] * W8_SCALE, s[3 * 65] * W8_SCALE); o.y = pk4_fp8(s[4 * 65] * W8_SCALE, s[5 * 65] * W8_SCALE, s[6 * 65] * W8_SCALE, s[7 * 65] * W8_SCALE);
        const int nn = n0 + n; const int drow = mode == 0 ? nn : (nn / 128) * 256 + (mode - 1) * 128 + (nn % 128);
        *(v2u*)(WT + (size_t)drow * K + k0 + 8 * c) = o; }
    LDS_WAIT(); asm volatile("" ::: "memory");
}
constexpr int MOE_S_F = 16 * 44, MOE_ITEMS = 24 * MOE_S_F;
__device__ __forceinline__ void moe_cvt_item(const Params& p, int r, LAS float* scr, int lane_) {
    constexpr int S_F = MOE_S_F;
    if (r < 8 * S_F) { const int e = r / S_F; cvt_item8(p.in[I_MWG] + (size_t)e * DM * DFF, DM, DFF, (unsigned char*)(p.ws + W_MGU) + (size_t)e * 2 * DFF * DM, 1, scr, r % S_F, lane_); return; } r -= 8 * S_F;
    if (r < 8 * S_F) { const int e = r / S_F; cvt_item8(p.in[I_MWU] + (size_t)e * DM * DFF, DM, DFF, (unsigned char*)(p.ws + W_MGU) + (size_t)e * 2 * DFF * DM, 2, scr, r % S_F, lane_); return; } r -= 8 * S_F;
    { const int e = r / S_F; cvt_item8(p.in[I_MWD] + (size_t)e * DFF * DM, DFF, DM, (unsigned char*)(p.ws + W_MD) + (size_t)e * DM * DFF, 0, scr, r % S_F, lane_); }
}
#if SEAM_CVT
constexpr int SEAM_CVT_SEAMS = 17;
__device__ __forceinline__ void seam_fill(const Params& p, Ctx& F, int s) {
    if (s >= SEAM_CVT_SEAMS || (F.wave & 1) != (s & 1)) return;
    const int it = s * (F.G * 4) + (int)blockIdx.x * 4 + (F.wave >> 1);
    if (it < MOE_ITEMS) moe_cvt_item(p, it, (LAS float*)(F.lds + RING_OFF) + F.wave * (64 * 65), lane_id());
}
__device__ __forceinline__ void moe_cvt_rest(const Params& p, Ctx& F) {
    for (int it = SEAM_CVT_SEAMS * (F.G * 4) + F.gw; it < MOE_ITEMS; it += F.NGW) moe_cvt_item(p, it, (LAS float*)(F.lds + RING_OFF) + F.wave * (64 * 65), lane_id());
}
#endif
__device__ __forceinline__ void p0_prologue(const Params& p, Ctx& F) {
    const int lane_ = lane_id(), tid_ = F.wave * 64 + lane_;
    LAS float* fl = (LAS float*)(F.lds + RING_OFF);
    for (int it = blockIdx.x; it < 192; it += F.G) {
        const int l = it / 96, n = (it % 96) * 64 + lane_;
        LAS float* sv = fl;
        LAS float* red = fl + 3 * 1024;
        for (int i = tid_; i < 3 * 1024; i += 512) { const int rt = i >> 10, k = i & 1023; const float v = rt < 2 ? p.in[I_C][rt * DM + k] : p.in[I_CCTX][k]; sv[i] = siluf(v); }
        __syncthreads();
        const float* W = p.in[I_ADAW] + (size_t)l * DM * 6144 + n;
        float a0 = 0.f, a1 = 0.f, a2 = 0.f;
        for (int kb = 0; kb < 128; kb += 32) {
            float wv[32];
#pragma unroll
            for (int j = 0; j < 32; ++j) wv[j] = W[(size_t)(F.wave * 128 + kb + j) * 6144];
#pragma unroll
            for (int j = 0; j < 32; ++j) { const int k = F.wave * 128 + kb + j; a0 += sv[k] * wv[j]; a1 += sv[1024 + k] * wv[j]; a2 += sv[2048 + k] * wv[j]; }
        }
        red[(F.wave * 3 + 0) * 64 + lane_] = a0; red[(F.wave * 3 + 1) * 64 + lane_] = a1; red[(F.wave * 3 + 2) * 64 + lane_] = a2;
        __syncthreads();
        if (tid_ < 192) { const int rt = tid_ >> 6, ln = tid_ & 63; float s = 0.f;
#pragma unroll
            for (int w = 0; w < 8; ++w) s += red[(w * 3 + rt) * 64 + ln];
            const int nn = (it % 96) * 64 + ln;
            ((float*)(p.ws + WS_MODV))[(size_t)(l * 3 + rt) * 6144 + nn] = s + p.in[I_ADAB][l * 6144 + nn]; }
        __syncthreads();
    }
    LAS float* scr = (LAS float*)(F.lds + RING_OFF) + F.wave * (64 * 65);
    constexpr int S_WIN = 16 * 56, S_WOUT = 16 * 16, S_F = 16 * 44;
    constexpr int NITEMS = 2 * S_WIN + 2 * S_WOUT + 3 * S_F + (SEAM_CVT ? 0 : 24 * S_F);
    static_assert(NITEMS + (SEAM_CVT ? 24 * S_F : 0) == 21312, "items");
    for (int it = F.gw; it < NITEMS; it += F.NGW) {
        int r = it;
        if (r < 2 * S_WIN) { const int l = r / S_WIN; cvt_item(p.in[I_WIN] + (size_t)l * DM * DP, DM, DP, (bf16_t*)(p.ws + W_WIN) + (size_t)l * DP * DM, 0, scr, r % S_WIN, lane_); continue; } r -= 2 * S_WIN;
        if (r < 2 * S_WOUT) { const int l = r / S_WOUT; cvt_item(p.in[I_WOUT] + (size_t)l * DM * DM, DM, DM, (bf16_t*)(p.ws + W_WOUT) + (size_t)l * DM * DM, 0, scr, r % S_WOUT, lane_); continue; } r -= 2 * S_WOUT;
        if (r < S_F) { cvt_item(p.in[I_FWG], DM, DFF, (bf16_t*)(p.ws + W_FGU), 1, scr, r, lane_); continue; } r -= S_F;
        if (r < S_F) { cvt_item(p.in[I_FWU], DM, DFF, (bf16_t*)(p.ws + W_FGU), 2, scr, r, lane_); continue; } r -= S_F;
        if (r < S_F) { cvt_item(p.in[I_FWD], DFF, DM, (bf16_t*)(p.ws + W_FD), 0, scr, r, lane_); continue; } r -= S_F;
        moe_cvt_item(p, r, scr, lane_);
    }
}

__device__ __forceinline__ void norm_phase(const Params& p, Ctx& F, int l, int which, int nrows) {
    const int lane_ = lane_id(), tid_ = F.wave * 64 + lane_;
    const float* g = p.in[which ? I_N2G : I_N1G] + l * DM;
    for (int m = F.gw; m < nrows; m += F.NGW) {
        const float* xrow;
        if (l == 0 && which == 0) xrow = m < NL ? p.in[I_X] + (size_t)m * DM : p.in[I_CTX] + (size_t)(m - NL) * DM;
        else xrow = xr_row(p, m);
        const int rt = rowtype(m);
        const float* sh = modv(p, l, rt, which ? 3 : 0); const float* sc = modv(p, l, rt, which ? 4 : 1);
        f32x4 v[4]; float ss = 0.f;
        if (m >= NL && !(l == 0 && which == 0)) {
            const int nsl = which ? DM / 256 : DFF / 256; const float* gate = modv(p, 0, 2, which ? 2 : 5);
            const float* base = (l == 0) ? p.in[I_CTX] + (size_t)(m - NL) * DM : xrow;
            const float* part = (const float*)(p.ws + WS_PART) + (size_t)(m - NL) * DM;
#pragma unroll
            for (int j = 0; j < 4; ++j) { const int col = 256 * j + 4 * lane_; f32x4 a = {0.f, 0.f, 0.f, 0.f};
                for (int sl = 0; sl < nsl; ++sl) a += *(const f32x4*)(part + (size_t)sl * NC * DM + col);
                v[j] = *(const f32x4*)(base + col) + *(const f32x4*)(gate + col) * a;
                *(f32x4*)((float*)(p.ws + WS_XRC) + (size_t)(m - NL) * DM + col) = v[j];
                ss += (v[j][0] * v[j][0] + v[j][1] * v[j][1]) + (v[j][2] * v[j][2] + v[j][3] * v[j][3]); }
        } else
#pragma unroll
        for (int j = 0; j < 4; ++j) { v[j] = *(const f32x4*)(xrow + 256 * j + 4 * lane_); ss += (v[j][0] * v[j][0] + v[j][1] * v[j][1]) + (v[j][2] * v[j][2] + v[j][3] * v[j][3]); }
        const float r = rsqrtf(wave_sum(ss) * (1.f / DM) + EPS);
        bf16_t* hb = (bf16_t*)(p.ws + WS_HBUF) + (size_t)m * DM;
#pragma unroll
        for (int j = 0; j < 4; ++j) { const int col = 256 * j + 4 * lane_;
            const f32x4 gg = *(const f32x4*)(g + col), s4 = *(const f32x4*)(sc + col), h4 = *(const f32x4*)(sh + col);
            const f32x4 y = v[j] * r * gg * (1.f + s4) + h4;
            v2u o; o.x = pk2(y[0], y[1]); o.y = pk2(y[2], y[3]); *(v2u*)(hb + col) = o; }
    }
}


__device__ __forceinline__ void router_phase(const Params& p, Ctx& F) {
    const int lane_ = lane_id(), tid_ = F.wave * 64 + lane_;
    LAS int* lcnt = (LAS int*)(F.lds + RING_OFF);
    LAS int* gbase = lcnt + 8;
    LAS int* ent_e = lcnt + 16;
    LAS int* ent_pos = lcnt + 16 + 128;
    const float* g = p.in[I_N2G] + DM; const float* rw = p.in[I_RW];
    int* tok_e = (int*)(p.ws + WS_ROUTE); float* tok_w = (float*)(p.ws + WS_ROUTE) + 2 * NL; int* tok_pos = (int*)(p.ws + WS_ROUTE) + 4 * NL;
    f32x4 rwa[4][4], rwb[4][4];
#pragma unroll
    for (int j = 0; j < 4; ++j)
#pragma unroll
        for (int q = 0; q < 4; ++q) { const int col = 256 * j + 4 * lane_ + q; rwa[j][q] = *(const f32x4*)(rw + (size_t)col * 8); rwb[j][q] = *(const f32x4*)(rw + (size_t)col * 8 + 4); }
    const int myexp = ((lane_ >> 5) & 1) * 4 + ((lane_ >> 4) & 1) * 2 + ((lane_ >> 3) & 1);
    for (int ch = blockIdx.x; ch < NL / 64; ch += F.G) {
        if (tid_ < 8) lcnt[tid_] = 0;
        __syncthreads();
        const int rt = (ch * 64) / T;
        const float* sh = modv(p, 1, rt, 3); const float* sc = modv(p, 1, rt, 4);
        f32x4 gs[4], hs[4]; float bsum;
        { float bb[8] = {0.f, 0.f, 0.f, 0.f, 0.f, 0.f, 0.f, 0.f};
#pragma unroll
          for (int j = 0; j < 4; ++j) { const int col = 256 * j + 4 * lane_; gs[j] = *(const f32x4*)(g + col) * (1.f + *(const f32x4*)(sc + col)); hs[j] = *(const f32x4*)(sh + col);
#pragma unroll
            for (int q = 0; q < 4; ++q) { bb[0] += hs[j][q] * rwa[j][q][0]; bb[1] += hs[j][q] * rwa[j][q][1]; bb[2] += hs[j][q] * rwa[j][q][2]; bb[3] += hs[j][q] * rwa[j][q][3];
                                          bb[4] += hs[j][q] * rwb[j][q][0]; bb[5] += hs[j][q] * rwb[j][q][1]; bb[6] += hs[j][q] * rwb[j][q][2]; bb[7] += hs[j][q] * rwb[j][q][3]; } }
          float c4[4];
#pragma unroll
          for (int k = 0; k < 4; ++k) { const float keep = (lane_ & 32) ? bb[k + 4] : bb[k], give = (lane_ & 32) ? bb[k] : bb[k + 4]; c4[k] = keep + __shfl_xor(give, 32); }
          float c2[2];
#pragma unroll
          for (int k = 0; k < 2; ++k) { const float keep = (lane_ & 16) ? c4[k + 2] : c4[k], give = (lane_ & 16) ? c4[k] : c4[k + 2]; c2[k] = keep + __shfl_xor(give, 16); }
          float c1 = ((lane_ & 8) ? c2[1] : c2[0]) + __shfl_xor((lane_ & 8) ? c2[0] : c2[1], 8);
          c1 += __shfl_xor(c1, 4); c1 += __shfl_xor(c1, 2); c1 += __shfl_xor(c1, 1);
          bsum = c1 + p.in[I_RB][myexp]; }
        for (int i = 0; i < 8; ++i) {
            const int ti = F.wave * 8 + i, m = ch * 64 + ti;
            const float* xrow = p.out + (size_t)m * DM;
            f32x4 v[4]; float ss = 0.f; float aa[8] = {0.f, 0.f, 0.f, 0.f, 0.f, 0.f, 0.f, 0.f};
#pragma unroll
            for (int j = 0; j < 4; ++j) { v[j] = *(const f32x4*)(xrow + 256 * j + 4 * lane_); ss += (v[j][0] * v[j][0] + v[j][1] * v[j][1]) + (v[j][2] * v[j][2] + v[j][3] * v[j][3]); }
#pragma unroll
            for (int j = 0; j < 4; ++j) { v[j] = v[j] * gs[j];
#pragma unroll
                for (int q = 0; q < 4; ++q) { aa[0] += v[j][q] * rwa[j][q][0]; aa[1] += v[j][q] * rwa[j][q][1]; aa[2] += v[j][q] * rwa[j][q][2]; aa[3] += v[j][q] * rwa[j][q][3];
                                              aa[4] += v[j][q] * rwb[j][q][0]; aa[5] += v[j][q] * rwb[j][q][1]; aa[6] += v[j][q] * rwb[j][q][2]; aa[7] += v[j][q] * rwb[j][q][3]; } }
            float c4[4];
#pragma unroll
            for (int k = 0; k < 4; ++k) { const float keep = (lane_ & 32) ? aa[k + 4] : aa[k], give = (lane_ & 32) ? aa[k] : aa[k + 4]; c4[k] = keep + __shfl_xor(give, 32); }
            float c2[2];
#pragma unroll
            for (int k = 0; k < 2; ++k) { const float keep = (lane_ & 16) ? c4[k + 2] : c4[k], give = (lane_ & 16) ? c4[k] : c4[k + 2]; c2[k] = keep + __shfl_xor(give, 16); }
            float c1 = ((lane_ & 8) ? c2[1] : c2[0]) + __shfl_xor((lane_ & 8) ? c2[0] : c2[1], 8);
            c1 += __shfl_xor(c1, 4); c1 += __shfl_xor(c1, 2); c1 += __shfl_xor(c1, 1);
            const float r = rsqrtf(wave_sum(ss) * (1.f / DM) + EPS);
            const float mylogit = r * c1 + bsum;
#define RLF(L) __uint_as_float((unsigned)__builtin_amdgcn_readlane((int)__float_as_uint(mylogit), L))
            const float lg0 = RLF(0), lg1 = RLF(8), lg2 = RLF(16), lg3 = RLF(24), lg4 = RLF(32), lg5 = RLF(40), lg6 = RLF(48), lg7 = RLF(56);
#undef RLF
            unsigned char* hb = (unsigned char*)(p.ws + WS_HBUF) + (size_t)m * DM;
#pragma unroll
            for (int j = 0; j < 4; ++j) { const f32x4 y = v[j] * r + hs[j]; *(unsigned*)(hb + 256 * j + 4 * lane_) = pk4_fp8(y[0], y[1], y[2], y[3]); }
            int i1 = 0; float v1 = lg0;
            if (lg1 > v1) { v1 = lg1; i1 = 1; } if (lg2 > v1) { v1 = lg2; i1 = 2; } if (lg3 > v1) { v1 = lg3; i1 = 3; }
            if (lg4 > v1) { v1 = lg4; i1 = 4; } if (lg5 > v1) { v1 = lg5; i1 = 5; } if (lg6 > v1) { v1 = lg6; i1 = 6; } if (lg7 > v1) { v1 = lg7; i1 = 7; }
            int i2 = -1; float v2 = -3.4e38f;
            if (i1 != 0 && lg0 > v2) { v2 = lg0; i2 = 0; } if (i1 != 1 && lg1 > v2) { v2 = lg1; i2 = 1; } if (i1 != 2 && lg2 > v2) { v2 = lg2; i2 = 2; } if (i1 != 3 && lg3 > v2) { v2 = lg3; i2 = 3; }
            if (i1 != 4 && lg4 > v2) { v2 = lg4; i2 = 4; } if (i1 != 5 && lg5 > v2) { v2 = lg5; i2 = 5; } if (i1 != 6 && lg6 > v2) { v2 = lg6; i2 = 6; } if (i1 != 7 && lg7 > v2) { v2 = lg7; i2 = 7; }
            const float w1 = 1.f / (1.f + __expf(v2 - v1));
            if (lane_ == 0) {
                const int p1 = __hip_atomic_fetch_add(lcnt + i1, 1, __ATOMIC_RELAXED, __HIP_MEMORY_SCOPE_WORKGROUP);
                const int p2 = __hip_atomic_fetch_add(lcnt + i2, 1, __ATOMIC_RELAXED, __HIP_MEMORY_SCOPE_WORKGROUP);
                ent_e[2 * ti] = i1; ent_e[2 * ti + 1] = i2; ent_pos[2 * ti] = p1; ent_pos[2 * ti + 1] = p2;
                tok_e[2 * m] = i1; tok_e[2 * m + 1] = i2; tok_w[2 * m] = w1; tok_w[2 * m + 1] = 1.f - w1; }
        }
        __syncthreads();
        if (tid_ < 8) gbase[tid_] = (int)__hip_atomic_fetch_add(F.ctl + CW_CNT + 64 * tid_, (unsigned)lcnt[tid_], __ATOMIC_RELAXED, __HIP_MEMORY_SCOPE_AGENT);
        __syncthreads();
        if (tid_ < 128) tok_pos[ch * 128 + tid_] = gbase[ent_e[tid_]] + ent_pos[tid_];
        __syncthreads();
    }
}
__device__ __forceinline__ void moe_table(Ctx& F) {
    const int lane_ = lane_id(), tid_ = F.wave * 64 + lane_;
    volatile LAS unsigned* tb = F.MISC + 32;
    if (tid_ == 0) { unsigned acc = 0;
        for (int e = 0; e < 8; ++e) { const unsigned c = __hip_atomic_load(F.ctl + CW_CNT + 64 * e, __ATOMIC_RELAXED, __HIP_MEMORY_SCOPE_AGENT); tb[e] = acc; tb[16 + e] = c; acc += (c + 255u) / 256u * 256u; }
        tb[8] = acc; }
    __syncthreads();
}
__device__ __forceinline__ void moe_order(Ctx& F, pg8::Order& S, int nN, long estride) {
    volatile LAS unsigned* tb = F.MISC + 32;
#define RFL(x) __builtin_amdgcn_readfirstlane((int)(x))
    S.init(RFL(tb[8] / 256u), nN, F.G, (int)blockIdx.x);
    S.e1 = RFL(tb[1] / 256u); S.e2 = RFL(tb[2] / 256u); S.e3 = RFL(tb[3] / 256u); S.e4 = RFL(tb[4] / 256u); S.e5 = RFL(tb[5] / 256u); S.e6 = RFL(tb[6] / 256u); S.e7 = RFL(tb[7] / 256u);
#undef RFL
    S.estride = estride;
}
__device__ __forceinline__ void gather_phase(const Params& p, Ctx& F) {
    const int lane_ = lane_id(), tid_ = F.wave * 64 + lane_;
    moe_table(F);
    volatile LAS unsigned* tb = F.MISC + 32;
    const int* tok_e = (const int*)(p.ws + WS_ROUTE); const float* tok_w = (const float*)(p.ws + WS_ROUTE) + 2 * NL; const int* tok_pos = (const int*)(p.ws + WS_ROUTE) + 4 * NL;
    int* row_tok = (int*)(p.ws + WS_ROUTE) + 6 * NL; float* row_gate = (float*)(p.ws + WS_ROUTE) + 6 * NL + MP_MAX;
    const unsigned char* hb = (const unsigned char*)(p.ws + WS_HBUF); unsigned char* h2s = (unsigned char*)(p.ws + WS_H2S);
    for (int it = F.gw; it < 2 * NL; it += F.NGW) {
        const int t = it >> 1, e = tok_e[it], r = (int)tb[e] + tok_pos[it];
        *((v4u*)(h2s + (size_t)r * DM) + lane_) = *((const v4u*)(hb + (size_t)t * DM) + lane_);
        if (lane_ == 0) { row_tok[r] = t; row_gate[r] = tok_w[it]; }
    }
    for (int i = F.gw; i < NE * 256; i += F.NGW) {
        const int e = i >> 8, j = i & 255, r = (int)tb[e] + (int)tb[16 + e] + j;
        if (r < (int)tb[e + 1]) { const v4u z = {0u, 0u, 0u, 0u}; *((v4u*)(h2s + (size_t)r * DM) + lane_) = z; if (lane_ == 0) { row_tok[r] = -1; row_gate[r] = 0.f; } }
    }
}
__device__ __forceinline__ void combine_phase(const Params& p, Ctx& F) {
    const int lane_ = lane_id(), tid_ = F.wave * 64 + lane_;
    moe_table(F);
    volatile LAS unsigned* tb = F.MISC + 32;
    const int* tok_e = (const int*)(p.ws + WS_ROUTE); const int* tok_pos = (const int*)(p.ws + WS_ROUTE) + 4 * NL;
    const bf16_t* yb = (const bf16_t*)(p.ws + WS_YBUF);
    for (int t = F.gw; t < NL; t += F.NGW) {
        const int r0 = (int)tb[tok_e[2 * t]] + tok_pos[2 * t], r1 = (int)tb[tok_e[2 * t + 1]] + tok_pos[2 * t + 1];
        const float* g5 = modv(p, 1, t / T, 5);
        float* orow = p.out + (size_t)t * DM;
#pragma unroll
        for (int j = 0; j < 4; ++j) { const int col = 256 * j + 4 * lane_;
            const v2u a = *(const v2u*)(yb + (size_t)r0 * DM + col), b = *(const v2u*)(yb + (size_t)r1 * DM + col);
            f32x4 y; y[0] = __uint_as_float(a.x << 16) + __uint_as_float(b.x << 16); y[1] = __uint_as_float(a.x & 0xffff0000u) + __uint_as_float(b.x & 0xffff0000u);
            y[2] = __uint_as_float(a.y << 16) + __uint_as_float(b.y << 16); y[3] = __uint_as_float(a.y & 0xffff0000u) + __uint_as_float(b.y & 0xffff0000u);
            const f32x4 x = *(const f32x4*)(orow + col), gg = *(const f32x4*)(g5 + col);
            *(f32x4*)(orow + col) = x + gg * y; }
    }
}

namespace att {
#ifndef EXP_TREE
#define EXP_TREE 0
#endif
constexpr float THR = 8.f;
constexpr int KVBLK = 64;
constexpr int SHM_V = KVBLK * 128 * 2, SHM_K = KVBLK * 128 * 2;
using bf16x8 = __attribute__((ext_vector_type(8))) short;
using s16x4  = __attribute__((ext_vector_type(4))) short;
using f32x16 = __attribute__((ext_vector_type(16))) float;
using f32x8  = __attribute__((ext_vector_type(8))) float;
using u32x4  = __attribute__((ext_vector_type(4))) unsigned;
using f32x4v = __attribute__((ext_vector_type(4))) float;
#define KSWZ(row, colB) ((row) * 256 + ((colB) ^ (((row) & 7) << 4)))
#define SBAR() __builtin_amdgcn_sched_barrier(0)
__device__ __forceinline__ int crow(int r, int hi) { return (r & 3) + 8 * (r >> 2) + 4 * hi; }
__device__ __forceinline__ unsigned cvtpk(float lo, float hi) {
  unsigned r; asm volatile("v_cvt_pk_bf16_f32 %0, %1, %2" : "=v"(r) : "v"(lo), "v"(hi)); return r;
}
__device__ __forceinline__ void partialSM(f32x16& p0, f32x16& p1, float& m_reg, float& mn, float& alpha) {
  constexpr float C = 1.4426950408889634f;
  float pmax = p0[0]; for (int r = 1; r < 16; ++r) pmax = fmaxf(pmax, p0[r]); for (int r = 0; r < 16; ++r) pmax = fmaxf(pmax, p1[r]);
  { auto rr = __builtin_amdgcn_permlane32_swap(__float_as_uint(pmax), __float_as_uint(pmax), false, false);
    pmax = fmaxf(__uint_as_float(rr[0]), __uint_as_float(rr[1])); }
  if (__builtin_expect(__all(pmax - m_reg <= THR), 1)) { mn = m_reg; alpha = 1.f; }
  else { mn = fmaxf(m_reg, pmax); alpha = __builtin_amdgcn_exp2f((m_reg - mn) * C); m_reg = mn; }
  float mnC = -mn * C;
  for (int r = 0; r < 16; ++r) p0[r] = fmaf(p0[r], C, mnC); for (int r = 0; r < 16; ++r) p1[r] = fmaf(p1[r], C, mnC);
  for (int r = 0; r < 16; ++r) p0[r] = __builtin_amdgcn_exp2f(p0[r]);
}
__device__ __forceinline__ void finishSM(f32x16& p0, f32x16& p1, float alpha, float& l_reg, bf16x8& pa0, bf16x8& pa1, bf16x8& pa2, bf16x8& pa3) {
  for (int r = 0; r < 16; ++r) p1[r] = __builtin_amdgcn_exp2f(p1[r]);
  float ps = 0; for (int r = 0; r < 16; ++r) ps += p0[r]; for (int r = 0; r < 16; ++r) ps += p1[r];
  { auto rr = __builtin_amdgcn_permlane32_swap(__float_as_uint(ps), __float_as_uint(ps), false, false);
    ps = __uint_as_float(rr[0]) + __uint_as_float(rr[1]); }
  l_reg = l_reg * alpha + ps;
#define PK4(P, BASE, OUT) do { unsigned a0 = cvtpk(P[BASE + 0], P[BASE + 1]), a1 = cvtpk(P[BASE + 2], P[BASE + 3]);   \
    unsigned b0 = cvtpk(P[BASE + 4], P[BASE + 5]), b1 = cvtpk(P[BASE + 6], P[BASE + 7]);                              \
    auto r0 = __builtin_amdgcn_permlane32_swap(a0, b0, false, false); auto r1 = __builtin_amdgcn_permlane32_swap(a1, b1, false, false); \
    u32x4 w = {r0[0], r1[0], r0[1], r1[1]}; OUT = *reinterpret_cast<bf16x8*>(&w); } while (0)
  PK4(p0, 0, pa0); PK4(p0, 8, pa1); PK4(p1, 0, pa2); PK4(p1, 8, pa3);
#undef PK4
}
template <int ND0>
__device__ __forceinline__ void qkt(f32x16& p0, f32x16& p1, const LAS char* Ks, const bf16x8* qr, int r32, int hi, int dbase) {
  p0 = f32x16{}; p1 = f32x16{};
#pragma unroll
  for (int d0 = 0; d0 < ND0; ++d0) { int cb = ((dbase + d0) * 16 + hi * 8) * 2;
    bf16x8 b0 = *reinterpret_cast<const LAS bf16x8*>(Ks + KSWZ(r32, cb));
    bf16x8 b1 = *reinterpret_cast<const LAS bf16x8*>(Ks + KSWZ(32 + r32, cb));
    p0 = __builtin_amdgcn_mfma_f32_32x32x16_bf16(b0, qr[d0], p0, 0, 0, 0);
    p1 = __builtin_amdgcn_mfma_f32_32x32x16_bf16(b1, qr[d0], p1, 0, 0, 0); }
}
__device__ __forceinline__ int v_st(int k, int c) { const int kk = (k & ~0xC) | ((k & 4) << 1) | ((k & 8) >> 1); return ((kk >> 3) * 4 + (c >> 5)) * 512 + ((kk & 7) * 32 + (c & 31)) * 2; }
__device__ __forceinline__ int v_st_lin(int k, int c) { return ((k >> 3) * 4 + (c >> 5)) * 512 + ((k & 7) * 32 + (c & 31)) * 2; }
__device__ __forceinline__ int v_rd_base(int lane) { return ((lane & 3) << 3) | (((lane >> 2) & 3) << 6) | (((lane >> 4) & 1) << 5) | (((lane >> 5) & 1) << 8); }
constexpr int v_rd_off(int d0, int ks, int half) { return d0 * 512 + ks * 4096 + half * 2048; }
template <int OFF> __device__ __forceinline__ s16x4 tr_read(int vb) {
  s16x4 r; asm volatile("ds_read_b64_tr_b16 %0, %1 offset:%2" : "=&v"(r) : "v"(vb), "i"(OFF) : "memory"); return r;
}
template <int D0> __device__ __forceinline__ void pv_one(f32x16& od, int vb, bf16x8 pa0, bf16x8 pa1, bf16x8 pa2, bf16x8 pa3) {
  const s16x4 l0 = tr_read<v_rd_off(D0, 0, 0)>(vb), h0 = tr_read<v_rd_off(D0, 0, 1)>(vb), l1 = tr_read<v_rd_off(D0, 1, 0)>(vb), h1 = tr_read<v_rd_off(D0, 1, 1)>(vb);
  const s16x4 l2 = tr_read<v_rd_off(D0, 2, 0)>(vb), h2 = tr_read<v_rd_off(D0, 2, 1)>(vb), l3 = tr_read<v_rd_off(D0, 3, 0)>(vb), h3 = tr_read<v_rd_off(D0, 3, 1)>(vb);
#if defined(DUMMY_TR) && DUMMY_TR
  { s16x4 dd; for (int i = 0; i < DUMMY_TR; ++i) asm volatile("ds_read_b64_tr_b16 %0, %1 offset:%2" : "=&v"(dd) : "v"(vb), "i"(v_rd_off(D0, 0, 0)) : "memory"); }
#endif
#if defined(DUMMY_MFMA) && DUMMY_MFMA
  { f32x4v dm = {0.f, 0.f, 0.f, 0.f}; for (int i = 0; i < DUMMY_MFMA; ++i) asm volatile("v_mfma_f32_16x16x32_bf16 %0, %1, %2, %0" : "+v"(dm) : "v"(pa0), "v"(pa1)); }
#endif
  asm volatile("s_waitcnt lgkmcnt(0)" ::: "memory"); SBAR();
#define PK(L, H) (bf16x8){L[0], L[1], L[2], L[3], H[0], H[1], H[2], H[3]}
  od = __builtin_amdgcn_mfma_f32_32x32x16_bf16(pa0, PK(l0, h0), od, 0, 0, 0);
  od = __builtin_amdgcn_mfma_f32_32x32x16_bf16(pa1, PK(l1, h1), od, 0, 0, 0);
  od = __builtin_amdgcn_mfma_f32_32x32x16_bf16(pa2, PK(l2, h2), od, 0, 0, 0);
  od = __builtin_amdgcn_mfma_f32_32x32x16_bf16(pa3, PK(l3, h3), od, 0, 0, 0);
#undef PK
}
__device__ __forceinline__ void pv_d0(f32x16* o, int vb, bf16x8 pa0, bf16x8 pa1, bf16x8 pa2, bf16x8 pa3) {
  pv_one<0>(o[0], vb, pa0, pa1, pa2, pa3); pv_one<1>(o[1], vb, pa0, pa1, pa2, pa3); pv_one<2>(o[2], vb, pa0, pa1, pa2, pa3); pv_one<3>(o[3], vb, pa0, pa1, pa2, pa3);
}

#ifndef DUMMY_EXP
#define DUMMY_EXP 0
#endif
#ifndef DUMMY_TR
#define DUMMY_TR 0
#endif
#ifndef DUMMY_MFMA
#define DUMMY_MFMA 0
#endif
__device__ __forceinline__ void dummy_exp(float x) { float d; for (int i = 0; i < DUMMY_EXP; ++i) asm volatile("v_exp_f32 %0, %1" : "=v"(d) : "v"(x)); }
__device__ __forceinline__ void expA(f32x16& p0) {
#pragma unroll
  for (int r = 0; r < 16; ++r) { dummy_exp(p0[r]); p0[r] = __builtin_amdgcn_exp2f(p0[r]); }
}
__device__ __forceinline__ void expB_sum_pack(f32x16& p0, f32x16& p1, float& l_reg, bf16x8& pa0, bf16x8& pa1, bf16x8& pa2, bf16x8& pa3) {
#pragma unroll
  for (int r = 0; r < 16; ++r) { dummy_exp(p1[r]); p1[r] = __builtin_amdgcn_exp2f(p1[r]); }
  float ps = 0;
#pragma unroll
  for (int r = 0; r < 16; ++r) ps += p0[r];
#pragma unroll
  for (int r = 0; r < 16; ++r) ps += p1[r];
  { auto rr = __builtin_amdgcn_permlane32_swap(__float_as_uint(ps), __float_as_uint(ps), false, false);
    ps = __uint_as_float(rr[0]) + __uint_as_float(rr[1]); }
  l_reg += ps;
#define PK4(P, BASE, OUT) do { unsigned a0 = cvtpk(P[BASE + 0], P[BASE + 1]), a1 = cvtpk(P[BASE + 2], P[BASE + 3]);   \
    unsigned b0 = cvtpk(P[BASE + 4], P[BASE + 5]), b1 = cvtpk(P[BASE + 6], P[BASE + 7]);                              \
    auto r0 = __builtin_amdgcn_permlane32_swap(a0, b0, false, false); auto r1 = __builtin_amdgcn_permlane32_swap(a1, b1, false, false); \
    u32x4 w = {r0[0], r1[0], r0[1], r1[1]}; OUT = *reinterpret_cast<bf16x8*>(&w); } while (0)
  PK4(p0, 0, pa0); PK4(p0, 8, pa1); PK4(p1, 0, pa2); PK4(p1, 8, pa3);
#undef PK4
}
__device__ __forceinline__ bf16x8 ld8(const bf16_t* p) { return *reinterpret_cast<const bf16x8*>(p); }

constexpr int TP = 132;
__device__ __forceinline__ void tile_to_rows(const f32x16 (&o)[4], LAS float* scr, int r32, int hi, float (&v)[64]) {
#pragma unroll
  for (int d0 = 0; d0 < 4; ++d0)
#pragma unroll
    for (int r = 0; r < 16; ++r) scr[crow(r, hi) * TP + 32 * d0 + r32] = o[d0][r];
  asm volatile("s_waitcnt lgkmcnt(0)" ::: "memory");
#pragma unroll
  for (int i = 0; i < 16; ++i) { const f32x4v t = *(const LAS f32x4v*)(scr + r32 * TP + 64 * hi + 4 * i); v[4 * i] = t[0]; v[4 * i + 1] = t[1]; v[4 * i + 2] = t[2]; v[4 * i + 3] = t[3]; }
}
__device__ __forceinline__ float pair_sum(float x) {
  auto rr = __builtin_amdgcn_permlane32_swap(__float_as_uint(x), __float_as_uint(x), false, false); return __uint_as_float(rr[0]) + __uint_as_float(rr[1]);
}


#define PVX_RD2(L0, H0, D0, KS) do { L0 = tr_read<v_rd_off(D0, KS, 0)>(vb); H0 = tr_read<v_rd_off(D0, KS, 1)>(vb); } while (0)
#define PVX_PK(L, H) (bf16x8){L[0], L[1], L[2], L[3], H[0], H[1], H[2], H[3]}
#define PVX_E(i) do { if (DOEXP) { pn[i] = __builtin_amdgcn_exp2f(pn[i]); psn += pn[i]; } } while (0)
#define PVX_W(n) asm volatile("s_waitcnt lgkmcnt(" #n ")" ::: "memory")
#define PVX_BLOCK(D0, E0) do { \
    PVX_W(6); SBAR(); o[D0] = __builtin_amdgcn_mfma_f32_32x32x16_bf16(pa0, PVX_PK(fl0, fh0), o[D0], 0, 0, 0); PVX_E(E0 + 0); PVX_RD2(fl0, fh0, D0 + 1, 0); SBAR(); \
    PVX_W(6); SBAR(); o[D0] = __builtin_amdgcn_mfma_f32_32x32x16_bf16(pa1, PVX_PK(fl1, fh1), o[D0], 0, 0, 0); PVX_E(E0 + 1); PVX_RD2(fl1, fh1, D0 + 1, 1); SBAR(); \
    PVX_W(6); SBAR(); o[D0] = __builtin_amdgcn_mfma_f32_32x32x16_bf16(pa2, PVX_PK(fl2, fh2), o[D0], 0, 0, 0); PVX_E(E0 + 2); PVX_RD2(fl2, fh2, D0 + 1, 2); SBAR(); \
    PVX_W(6); SBAR(); o[D0] = __builtin_amdgcn_mfma_f32_32x32x16_bf16(pa3, PVX_PK(fl3, fh3), o[D0], 0, 0, 0); PVX_E(E0 + 3); PVX_RD2(fl3, fh3, D0 + 1, 3); SBAR(); } while (0)
template <bool DOEXP>
__device__ __forceinline__ void pv_exp(f32x16* o, int vb, bf16x8 pa0, bf16x8 pa1, bf16x8 pa2, bf16x8 pa3, f32x16& pn, float& psn) {
  s16x4 fl0, fh0, fl1, fh1, fl2, fh2, fl3, fh3;
  asm volatile("s_waitcnt lgkmcnt(0)" ::: "memory");
  PVX_RD2(fl0, fh0, 0, 0); PVX_RD2(fl1, fh1, 0, 1); PVX_RD2(fl2, fh2, 0, 2); PVX_RD2(fl3, fh3, 0, 3);
  PVX_BLOCK(0, 0); PVX_BLOCK(1, 4); PVX_BLOCK(2, 8);
  PVX_W(6); SBAR(); o[3] = __builtin_amdgcn_mfma_f32_32x32x16_bf16(pa0, PVX_PK(fl0, fh0), o[3], 0, 0, 0); PVX_E(12); SBAR();
  PVX_W(4); SBAR(); o[3] = __builtin_amdgcn_mfma_f32_32x32x16_bf16(pa1, PVX_PK(fl1, fh1), o[3], 0, 0, 0); PVX_E(13); SBAR();
  PVX_W(2); SBAR(); o[3] = __builtin_amdgcn_mfma_f32_32x32x16_bf16(pa2, PVX_PK(fl2, fh2), o[3], 0, 0, 0); PVX_E(14); SBAR();
  PVX_W(0); SBAR(); o[3] = __builtin_amdgcn_mfma_f32_32x32x16_bf16(pa3, PVX_PK(fl3, fh3), o[3], 0, 0, 0); PVX_E(15); SBAR();
}
__device__ __forceinline__ void expB_sum_pack2(f32x16& p0, f32x16& p1, float ps, float& l_reg, bf16x8& pa0, bf16x8& pa1, bf16x8& pa2, bf16x8& pa3) {
#pragma unroll
  for (int r = 0; r < 16; ++r) { p1[r] = __builtin_amdgcn_exp2f(p1[r]); ps += p1[r]; }
  { auto rr = __builtin_amdgcn_permlane32_swap(__float_as_uint(ps), __float_as_uint(ps), false, false);
    ps = __uint_as_float(rr[0]) + __uint_as_float(rr[1]); }
  l_reg += ps;
#define PK4(P, BASE, OUT) do { unsigned a0 = cvtpk(P[BASE + 0], P[BASE + 1]), a1 = cvtpk(P[BASE + 2], P[BASE + 3]);   \
    unsigned b0 = cvtpk(P[BASE + 4], P[BASE + 5]), b1 = cvtpk(P[BASE + 6], P[BASE + 7]);                              \
    auto r0 = __builtin_amdgcn_permlane32_swap(a0, b0, false, false); auto r1 = __builtin_amdgcn_permlane32_swap(a1, b1, false, false); \
    u32x4 w = {r0[0], r1[0], r0[1], r1[1]}; OUT = *reinterpret_cast<bf16x8*>(&w); } while (0)
  PK4(p0, 0, pa0); PK4(p0, 8, pa1); PK4(p1, 0, pa2); PK4(p1, 8, pa3);
#undef PK4
}
__device__ __forceinline__ float exp_sum16(f32x16& p0) { float ps = 0.f;
#pragma unroll
  for (int r = 0; r < 16; ++r) { p0[r] = __builtin_amdgcn_exp2f(p0[r]); ps += p0[r]; }
  return ps; }

__device__ __forceinline__ void attn_unit(const int wid, const bf16_t* __restrict__ proj, const char* __restrict__ Kt_bh, const char* __restrict__ Vt_bh, bf16_t* __restrict__ concat, int qrow0, int NT, int h,
                                          LAS char* lds, float lam, float omli, const float* __restrict__ subln) {
  const int lane = lane_id(), tid = wid * 64 + lane, r32 = lane & 31, hi = lane >> 5, rg = wid & 3, c = wid >> 2;
  LAS char* V_lds = lds; LAS char* K_lds = lds + 4 * SHM_V;
  LAS float* li_l = (LAS float*)(lds + 4 * SHM_V + 4 * SHM_K) + wid * 64;
  float l_reg = 0; f32x16 o[4] = {}; bf16x8 qr[4];
  const bf16_t* Qw = proj + (size_t)(qrow0 + rg * 32 + r32) * DP + C_DQ + h * 128 + c * 64 + hi * 8;
#pragma unroll
  for (int d0 = 0; d0 < 4; ++d0) qr[d0] = ld8(Qw + d0 * 16);
  const int vb0 = (int)(uintptr_t)V_lds + v_rd_base(lane);
  const char* kg0 = Kt_bh + wid * 2048 + lane * 16; const char* vg0 = Vt_bh + wid * 2048 + lane * 16;
#define DMA_TILE(tile, slot) do { const size_t to_ = (size_t)(tile) * 16384; \
    __builtin_amdgcn_global_load_lds((const unsigned*)(kg0 + to_), (LAS unsigned*)(K_lds + (slot) * SHM_K + wid * 2048), 16, 0, 0); \
    __builtin_amdgcn_global_load_lds((const unsigned*)(kg0 + to_ + 1024), (LAS unsigned*)(K_lds + (slot) * SHM_K + wid * 2048 + 1024), 16, 0, 0); \
    __builtin_amdgcn_global_load_lds((const unsigned*)(vg0 + to_), (LAS unsigned*)(V_lds + (slot) * SHM_V + wid * 2048), 16, 0, 0); \
    __builtin_amdgcn_global_load_lds((const unsigned*)(vg0 + to_ + 1024), (LAS unsigned*)(V_lds + (slot) * SHM_V + wid * 2048 + 1024), 16, 0, 0); } while (0)
#define BAR() do { asm volatile("s_waitcnt vmcnt(0) lgkmcnt(0)" ::: "memory"); __builtin_amdgcn_s_barrier(); asm volatile("" ::: "memory"); } while (0)
#define STAGE(b) do { if ((b) + 3 < NT) DMA_TILE((b) + 3, ((b) + 3) & 3); } while (0)
#define STAGES(b, slot) do { if ((b) + 3 < NT) DMA_TILE((b) + 3, slot); } while (0)
#define QKT(P0, P1, t) qkt<4>(P0, P1, K_lds + ((t) & 3) * SHM_K, qr, r32, hi, 4 * c)
#define QKTS(P0, P1, slot) qkt<4>(P0, P1, K_lds + (slot) * SHM_K, qr, r32, hi, 4 * c)
#define PV(t) pv_d0(o, vb0 + ((t) & 3) * SHM_V, pa0, pa1, pa2, pa3)
  f32x16 pA0, pA1, pB0, pB1; bf16x8 pa0, pa1, pa2, pa3; float psA = 0.f, psB = 0.f;
#define PVE(t, PN, PSN) do { PSN = 0.f; pv_exp<true>(o, vb0 + ((t) & 3) * SHM_V, pa0, pa1, pa2, pa3, PN, PSN); } while (0)
#define PVES(slot, PN, PSN) do { PSN = 0.f; pv_exp<true>(o, vb0 + (slot) * SHM_V, pa0, pa1, pa2, pa3, PN, PSN); } while (0)
#define PVL(t) do { float d_ = 0.f; pv_exp<false>(o, vb0 + ((t) & 3) * SHM_V, pa0, pa1, pa2, pa3, pA0, d_); } while (0)
  DMA_TILE(0, 0); DMA_TILE(1, 1); DMA_TILE(2, 2);
  BAR();
  QKT(pA0, pA1, 0); psA = exp_sum16(pA0);
  for (int t = 0; t < NT; t += 4) {
    if (c == 0) { BAR(); STAGES(t, 3); } SBAR();
    QKTS(pB0, pB1, 1); expB_sum_pack2(pA0, pA1, psA, l_reg, pa0, pa1, pa2, pa3); SBAR();
    if (c == 1) { BAR(); STAGES(t, 3); } SBAR();
    PVES(0, pB0, psB); SBAR();
    if (c == 0) { BAR(); STAGES(t + 1, 0); } SBAR();
    QKTS(pA0, pA1, 2); expB_sum_pack2(pB0, pB1, psB, l_reg, pa0, pa1, pa2, pa3); SBAR();
    if (c == 1) { BAR(); STAGES(t + 1, 0); } SBAR();
    PVES(1, pA0, psA); SBAR();
    if (c == 0) { BAR(); STAGES(t + 2, 1); } SBAR();
    QKTS(pB0, pB1, 3); expB_sum_pack2(pA0, pA1, psA, l_reg, pa0, pa1, pa2, pa3); SBAR();
    if (c == 1) { BAR(); STAGES(t + 2, 1); } SBAR();
    PVES(2, pB0, psB); SBAR();
    if (c == 0) { BAR(); STAGES(t + 3, 2); } SBAR();
    if (t + 4 < NT) QKTS(pA0, pA1, 0);
    expB_sum_pack2(pB0, pB1, psB, l_reg, pa0, pa1, pa2, pa3); SBAR();
    if (c == 1) { BAR(); STAGES(t + 3, 2); } SBAR();
    PVES(3, pA0, psA);
    SBAR();
  }
#undef PVE
#undef PVES
#undef QKTS
#undef STAGES
#undef PVL
  if (hi == 0) li_l[r32] = l_reg; asm volatile("s_waitcnt lgkmcnt(0)" ::: "memory");
#pragma unroll
  for (int r = 0; r < 16; ++r) { const float rl = __builtin_amdgcn_rcpf(li_l[crow(r, hi)]);
#pragma unroll
    for (int d0 = 0; d0 < 4; ++d0) o[d0][r] *= rl; }
  __syncthreads();
  LAS float* xch = (LAS float*)lds + rg * 4096;
  if (c == 1) {
#pragma unroll
    for (int d0 = 0; d0 < 4; ++d0)
#pragma unroll
      for (int r = 0; r < 16; ++r) xch[(d0 * 16 + r) * 64 + lane] = o[d0][r];
  }
  __syncthreads();
  if (c == 0) {
#pragma unroll
    for (int r = 0; r < 16; ++r) { float s = 0.f;
#pragma unroll
      for (int d0 = 0; d0 < 4; ++d0) { const float d = o[d0][r] - lam * xch[(d0 * 16 + r) * 64 + lane]; o[d0][r] = d; s += d * d; }
      s += __shfl_xor(s, 1); s += __shfl_xor(s, 2); s += __shfl_xor(s, 4); s += __shfl_xor(s, 8); s += __shfl_xor(s, 16);
      const float rr = rsqrtf(s * (1.f / 128.f) + EPS) * omli;
      bf16_t* orow = concat + (size_t)(qrow0 + rg * 32 + crow(r, hi)) * DM + 512 + h * 128 + r32;
#pragma unroll
      for (int d0 = 0; d0 < 4; ++d0) orow[d0 * 32] = f2bf(o[d0][r] * rr * subln[d0 * 32 + r32]); }
  }
  __syncthreads();
#undef DMA_TILE
#undef BAR
#undef STAGE
#undef QKT
#undef PV
}


typedef float f32x2 __attribute__((ext_vector_type(2)));
__device__ __forceinline__ void exp_half(f32x16& ph, f32x2& lacc) {
#if EXP_TREE
  f32x2 e[8];
#pragma unroll
  for (int r = 0; r < 16; r += 2) { ph[r] = __builtin_amdgcn_exp2f(ph[r]); ph[r + 1] = __builtin_amdgcn_exp2f(ph[r + 1]); e[r >> 1] = f32x2{ph[r], ph[r + 1]}; }
  lacc += ((e[0] + e[1]) + (e[2] + e[3])) + ((e[4] + e[5]) + (e[6] + e[7]));
#else
#pragma unroll
  for (int r = 0; r < 16; r += 2) { ph[r] = __builtin_amdgcn_exp2f(ph[r]); ph[r + 1] = __builtin_amdgcn_exp2f(ph[r + 1]); const f32x2 e = {ph[r], ph[r + 1]}; lacc += e; }
#endif
}
__device__ __forceinline__ void pack_half(const f32x16& ph, bf16x8& x0, bf16x8& x1) {
  { u32x4 w = {cvtpk(ph[0], ph[1]), cvtpk(ph[2], ph[3]), cvtpk(ph[4], ph[5]), cvtpk(ph[6], ph[7])}; x0 = *reinterpret_cast<bf16x8*>(&w); }
  { u32x4 w = {cvtpk(ph[8], ph[9]), cvtpk(ph[10], ph[11]), cvtpk(ph[12], ph[13]), cvtpk(ph[14], ph[15])}; x1 = *reinterpret_cast<bf16x8*>(&w); }
}

template <int D0> __device__ __forceinline__ void pv2_block(f32x16& oa, f32x16& ob, int vb, s16x4& fl0, s16x4& fh0, s16x4& fl1, s16x4& fh1, s16x4& fl2, s16x4& fh2, s16x4& fl3, s16x4& fh3,
                                                           bf16x8 a0, bf16x8 a1, bf16x8 a2, bf16x8 a3, bf16x8 b0, bf16x8 b1, bf16x8 b2, bf16x8 b3) {
#define PV2_STEP(A, B, FL, FH, KS, WN) do { asm volatile("s_waitcnt lgkmcnt(" #WN ")" ::: "memory"); SBAR(); \
    oa = __builtin_amdgcn_mfma_f32_32x32x16_bf16(A, PVX_PK(FL, FH), oa, 0, 0, 0); ob = __builtin_amdgcn_mfma_f32_32x32x16_bf16(B, PVX_PK(FL, FH), ob, 0, 0, 0); \
    if (D0 < 3) { FL = tr_read<v_rd_off((D0 + 1) & 3, KS, 0)>(vb); FH = tr_read<v_rd_off((D0 + 1) & 3, KS, 1)>(vb); } SBAR(); } while (0)
  if (D0 < 3) { PV2_STEP(a0, b0, fl0, fh0, 0, 6); PV2_STEP(a1, b1, fl1, fh1, 1, 6); PV2_STEP(a2, b2, fl2, fh2, 2, 6); PV2_STEP(a3, b3, fl3, fh3, 3, 6); }
  else        { PV2_STEP(a0, b0, fl0, fh0, 0, 6); PV2_STEP(a1, b1, fl1, fh1, 1, 4); PV2_STEP(a2, b2, fl2, fh2, 2, 2); PV2_STEP(a3, b3, fl3, fh3, 3, 0); }
#undef PV2_STEP
}
__device__ __forceinline__ void attn_unit3p(const int wid, const bf16_t* __restrict__ proj, const char* __restrict__ Kt_bh, const char* __restrict__ Vt_bh, bf16_t* __restrict__ concat, int qrow0, int NT, int h,
                                            LAS char* lds, float lam, float omli, const float* __restrict__ subln) {
  const int lane = lane_id(), r32 = lane & 31, hi = lane >> 5;
  LAS char* V_lds = lds; LAS char* K_lds = lds + 2 * SHM_V; LAS char* Qw = lds + 65536 + wid * 8192;
  LAS float* li_l = (LAS float*)(lds + 131072) + wid * 64;
  f32x2 l0v = {0.f, 0.f}, l1v = {0.f, 0.f}; f32x16 o0[4] = {}, o1[4] = {};
  const int vb0 = (int)(uintptr_t)V_lds + v_rd_base(lane);
  const char* kg0 = Kt_bh + wid * 2048 + lane * 16; const char* vg0 = Vt_bh + wid * 2048 + lane * 16;
#define DMA_TILE(tile, slot) do { const size_t to_ = (size_t)(tile) * 16384; \
    __builtin_amdgcn_global_load_lds((const unsigned*)(kg0 + to_), (LAS unsigned*)(K_lds + (slot) * SHM_K + wid * 2048), 16, 0, 0); \
    __builtin_amdgcn_global_load_lds((const unsigned*)(kg0 + to_ + 1024), (LAS unsigned*)(K_lds + (slot) * SHM_K + wid * 2048 + 1024), 16, 0, 0); \
    __builtin_amdgcn_global_load_lds((const unsigned*)(vg0 + to_), (LAS unsigned*)(V_lds + (slot) * SHM_V + wid * 2048), 16, 0, 0); \
    __builtin_amdgcn_global_load_lds((const unsigned*)(vg0 + to_ + 1024), (LAS unsigned*)(V_lds + (slot) * SHM_V + wid * 2048 + 1024), 16, 0, 0); } while (0)
#define BAR() do { asm volatile("s_waitcnt vmcnt(0) lgkmcnt(0)" ::: "memory"); __builtin_amdgcn_s_barrier(); asm volatile("" ::: "memory"); } while (0)
  bf16x8 qf00, qf01, qf02, qf03, qf10, qf11, qf12, qf13;
  { const bf16_t* qg = proj + (size_t)(qrow0 + wid * 32 + r32) * DP + C_DQ + h * 128 + hi * 8;
    qf00 = ld8(qg); qf01 = ld8(qg + 16); qf02 = ld8(qg + 32); qf03 = ld8(qg + 48); qf10 = ld8(qg + 64); qf11 = ld8(qg + 80); qf12 = ld8(qg + 96); qf13 = ld8(qg + 112); }
  DMA_TILE(0, 0);
  bf16x8 a0, a1, a2, a3, b0, b1, b2, b3;
  int sw0 = KSWZ(r32, (0 * 16 + hi * 8) * 2), sw1 = KSWZ(r32, (1 * 16 + hi * 8) * 2), sw2 = KSWZ(r32, (2 * 16 + hi * 8) * 2), sw3 = KSWZ(r32, (3 * 16 + hi * 8) * 2);
  int kad0_ = (int)(uintptr_t)K_lds + sw0, kad1_ = (int)(uintptr_t)K_lds + sw1, kad2_ = (int)(uintptr_t)K_lds + sw2, kad3_ = (int)(uintptr_t)K_lds + sw3;
  asm volatile("" : "+v"(kad0_), "+v"(kad1_), "+v"(kad2_), "+v"(kad3_));
  LAS char* const kad0 = (LAS char*)(uintptr_t)kad0_; LAS char* const kad1 = (LAS char*)(uintptr_t)kad1_; LAS char* const kad2 = (LAS char*)(uintptr_t)kad2_; LAS char* const kad3 = (LAS char*)(uintptr_t)kad3_;
#define QK2(P0, P1, so, cc) do { P0 = f32x16{}; P1 = f32x16{}; _Pragma("unroll") for (int d0 = 0; d0 < 4; ++d0) { const int cb = ((4 * (cc) + d0) * 16 + hi * 8) * 2; \
    const bf16x8 ka_ = *reinterpret_cast<const LAS bf16x8*>(K_lds + (so) * SHM_K + KSWZ(r32, cb)), kb_ = *reinterpret_cast<const LAS bf16x8*>(K_lds + (so) * SHM_K + KSWZ(32 + r32, cb)); \
    const bf16x8 q_ = *reinterpret_cast<const LAS bf16x8*>(Qw + KSWZ(r32, cb)); \
    P0 = __builtin_amdgcn_mfma_f32_32x32x16_bf16(ka_, q_, P0, 0, 0, 0); P1 = __builtin_amdgcn_mfma_f32_32x32x16_bf16(kb_, q_, P1, 0, 0, 0); } } while (0)
#define QKA(PH, so, cc, koff) do { PH = f32x16{}; \
    { const bf16x8 k_ = *reinterpret_cast<const LAS bf16x8*>(kad0 + ((so) * SHM_K + (koff) * 256 + 128 * (cc))); PH = __builtin_amdgcn_mfma_f32_32x32x16_bf16(k_, (cc) ? qf10 : qf00, PH, 0, 0, 0); } \
    { const bf16x8 k_ = *reinterpret_cast<const LAS bf16x8*>(kad1 + ((so) * SHM_K + (koff) * 256 + 128 * (cc))); PH = __builtin_amdgcn_mfma_f32_32x32x16_bf16(k_, (cc) ? qf11 : qf01, PH, 0, 0, 0); } } while (0)
#define QKB(PH, so, cc, koff) do { \
    { const bf16x8 k_ = *reinterpret_cast<const LAS bf16x8*>(kad2 + ((so) * SHM_K + (koff) * 256 + 128 * (cc))); PH = __builtin_amdgcn_mfma_f32_32x32x16_bf16(k_, (cc) ? qf12 : qf02, PH, 0, 0, 0); } \
    { const bf16x8 k_ = *reinterpret_cast<const LAS bf16x8*>(kad3 + ((so) * SHM_K + (koff) * 256 + 128 * (cc))); PH = __builtin_amdgcn_mfma_f32_32x32x16_bf16(k_, (cc) ? qf13 : qf03, PH, 0, 0, 0); } } while (0)
#define QKH(PH, so, cc, koff) do { QKA(PH, so, cc, koff); QKB(PH, so, cc, koff); } while (0)
#define SGB(m, n) __builtin_amdgcn_sched_group_barrier(m, n, 0)
#define STEP(PN, so, cc, koff, PO, LV, X0, X1) do { \
    QKA(PN, so, cc, koff); exp_half(PO, LV); SGB(0x100, 2); SGB(0x8, 1); SGB(0x2, 12); SGB(0x8, 1); SGB(0x2, 12); SBAR(); asm volatile("" : "+v"(LV)); SBAR(); \
    QKB(PN, so, cc, koff); pack_half(PO, X0, X1); SGB(0x100, 2); SGB(0x8, 1); SGB(0x2, 4); SGB(0x8, 1); SGB(0x2, 4); MBAR(PN); } while (0)
#define MBAR(X) do { SBAR(); asm volatile("" : "+v"(X) :: "memory"); SBAR(); } while (0)
#define TILE(t, so) do { BAR(); if ((t) + 1 < NT) DMA_TILE((t) + 1, 1 - (so)); SBAR(); \
    { f32x16 p0, p1; \
      QKH(p0, so, 0, 0); MBAR(p0); \
      STEP(p1, so, 0, 32, p0, l0v, a0, a1); \
      STEP(p0, so, 1, 0, p1, l0v, a2, a3); \
      STEP(p1, so, 1, 32, p0, l1v, b0, b1); \
      exp_half(p1, l1v); SBAR(); asm volatile("" : "+v"(l1v)); SBAR(); pack_half(p1, b2, b3); } SBAR(); \
    { const int vb = vb0 + (so) * SHM_V; s16x4 fl0, fh0, fl1, fh1, fl2, fh2, fl3, fh3; \
      asm volatile("s_waitcnt lgkmcnt(0)" ::: "memory"); \
      PVX_RD2(fl0, fh0, 0, 0); PVX_RD2(fl1, fh1, 0, 1); PVX_RD2(fl2, fh2, 0, 2); PVX_RD2(fl3, fh3, 0, 3); \
      pv2_block<0>(o0[0], o1[0], vb, fl0, fh0, fl1, fh1, fl2, fh2, fl3, fh3, a0, a1, a2, a3, b0, b1, b2, b3); \
      pv2_block<1>(o0[1], o1[1], vb, fl0, fh0, fl1, fh1, fl2, fh2, fl3, fh3, a0, a1, a2, a3, b0, b1, b2, b3); \
      pv2_block<2>(o0[2], o1[2], vb, fl0, fh0, fl1, fh1, fl2, fh2, fl3, fh3, a0, a1, a2, a3, b0, b1, b2, b3); \
      pv2_block<3>(o0[3], o1[3], vb, fl0, fh0, fl1, fh1, fl2, fh2, fl3, fh3, a0, a1, a2, a3, b0, b1, b2, b3); } SBAR(); } while (0)
  for (int t = 0; t < NT; t += 2) { TILE(t, 0); TILE(t + 1, 1); }
  const float l0 = pair_sum(l0v[0] + l0v[1]), l1 = pair_sum(l1v[0] + l1v[1]);
  if (hi == 0) { li_l[r32] = l0; li_l[32 + r32] = l1; } asm volatile("s_waitcnt lgkmcnt(0)" ::: "memory");
#pragma unroll
  for (int r = 0; r < 16; ++r) { const float ra = __builtin_amdgcn_rcpf(li_l[crow(r, hi)]), rb = lam * __builtin_amdgcn_rcpf(li_l[32 + crow(r, hi)]);
    float s = 0.f;
#pragma unroll
    for (int d0 = 0; d0 < 4; ++d0) { const float d = o0[d0][r] * ra - o1[d0][r] * rb; o0[d0][r] = d; s += d * d; }
    s += __shfl_xor(s, 1); s += __shfl_xor(s, 2); s += __shfl_xor(s, 4); s += __shfl_xor(s, 8); s += __shfl_xor(s, 16);
    const float rr = rsqrtf(s * (1.f / 128.f) + EPS) * omli;
    bf16_t* orow = concat + (size_t)(qrow0 + wid * 32 + crow(r, hi)) * DM + 512 + h * 128 + r32;
#pragma unroll
    for (int d0 = 0; d0 < 4; ++d0) orow[d0 * 32] = f2bf(o0[d0][r] * rr * subln[d0 * 32 + r32]); }
  asm volatile("s_waitcnt vmcnt(0) lgkmcnt(0)" ::: "memory"); __syncthreads();
#undef DMA_TILE
#undef BAR
#undef QK2
#undef QKH
#undef QKA
#undef QKB
#undef TILE
#undef STEP
#undef MBAR
#undef SGB
}

#ifndef EXP_TREE
#define EXP_TREE 0
#endif
#ifndef ATT_PRIO
#define ATT_PRIO 0
#endif
__device__ __forceinline__ void attn_unit3q(const int wid, const bf16_t* __restrict__ proj, const char* __restrict__ Kt_bh, const char* __restrict__ Vt_bh, bf16_t* __restrict__ concat, int qrow0, int NT, int h,
                                            LAS char* lds, float lam, float omli, const float* __restrict__ subln) {
  const int lane = lane_id(), r32 = lane & 31, hi = lane >> 5, rg = wid & 3, c = wid >> 2;
  LAS char* V_lds = lds; LAS char* K_lds = lds + 2 * SHM_V;
  LAS float* li_l = (LAS float*)(lds + 131072) + wid * 64;
  f32x2 l0v = {0.f, 0.f}, l1v = {0.f, 0.f}; f32x16 o0[4] = {}, o1[4] = {};
  const int vb0 = (int)(uintptr_t)V_lds + v_rd_base(lane);
  const char* kg0 = Kt_bh + wid * 2048 + lane * 16; const char* vg0 = Vt_bh + wid * 2048 + lane * 16;
#define DMA_TILE(tile, slot) do { const size_t to_ = (size_t)(tile) * 16384; \
    __builtin_amdgcn_global_load_lds((const unsigned*)(kg0 + to_), (LAS unsigned*)(K_lds + (slot) * SHM_K + wid * 2048), 16, 0, 0); \
    __builtin_amdgcn_global_load_lds((const unsigned*)(kg0 + to_ + 1024), (LAS unsigned*)(K_lds + (slot) * SHM_K + wid * 2048 + 1024), 16, 0, 0); \
    __builtin_amdgcn_global_load_lds((const unsigned*)(vg0 + to_), (LAS unsigned*)(V_lds + (slot) * SHM_V + wid * 2048), 16, 0, 0); \
    __builtin_amdgcn_global_load_lds((const unsigned*)(vg0 + to_ + 1024), (LAS unsigned*)(V_lds + (slot) * SHM_V + wid * 2048 + 1024), 16, 0, 0); } while (0)
#define BAR() do { asm volatile("s_waitcnt vmcnt(0) lgkmcnt(0)" ::: "memory"); __builtin_amdgcn_s_barrier(); asm volatile("" ::: "memory"); } while (0)
  bf16x8 qf00, qf01, qf02, qf03, qf10, qf11, qf12, qf13;
  { const bf16_t* qg = proj + (size_t)(qrow0 + rg * 64 + r32) * DP + C_DQ + h * 128 + c * 64 + hi * 8;
    qf00 = ld8(qg); qf01 = ld8(qg + 16); qf02 = ld8(qg + 32); qf03 = ld8(qg + 48); qg += (size_t)32 * DP;
    qf10 = ld8(qg); qf11 = ld8(qg + 16); qf12 = ld8(qg + 32); qf13 = ld8(qg + 48); }
  DMA_TILE(0, 0);
  bf16x8 a0, a1, a2, a3, b0, b1, b2, b3;
  int kad0_ = (int)(uintptr_t)K_lds + KSWZ(r32, (0 * 16 + hi * 8) * 2) + 128 * c, kad1_ = (int)(uintptr_t)K_lds + KSWZ(r32, (1 * 16 + hi * 8) * 2) + 128 * c;
  int kad2_ = (int)(uintptr_t)K_lds + KSWZ(r32, (2 * 16 + hi * 8) * 2) + 128 * c, kad3_ = (int)(uintptr_t)K_lds + KSWZ(r32, (3 * 16 + hi * 8) * 2) + 128 * c;
  asm volatile("" : "+v"(kad0_), "+v"(kad1_), "+v"(kad2_), "+v"(kad3_));
  LAS char* const kad0 = (LAS char*)(uintptr_t)kad0_; LAS char* const kad1 = (LAS char*)(uintptr_t)kad1_; LAS char* const kad2 = (LAS char*)(uintptr_t)kad2_; LAS char* const kad3 = (LAS char*)(uintptr_t)kad3_;
#define QKA(PH, so, rb, koff, LK) do { PH = f32x16{}; \
    { if (LK) kf0 = *reinterpret_cast<const LAS bf16x8*>(kad0 + ((so) * SHM_K + (koff) * 256)); PH = __builtin_amdgcn_mfma_f32_32x32x16_bf16(kf0, (rb) ? qf10 : qf00, PH, 0, 0, 0); } \
    { if (LK) kf1 = *reinterpret_cast<const LAS bf16x8*>(kad1 + ((so) * SHM_K + (koff) * 256)); PH = __builtin_amdgcn_mfma_f32_32x32x16_bf16(kf1, (rb) ? qf11 : qf01, PH, 0, 0, 0); } } while (0)
#define QKB(PH, so, rb, koff, LK) do { \
    { if (LK) kf2 = *reinterpret_cast<const LAS bf16x8*>(kad2 + ((so) * SHM_K + (koff) * 256)); PH = __builtin_amdgcn_mfma_f32_32x32x16_bf16(kf2, (rb) ? qf12 : qf02, PH, 0, 0, 0); } \
    { if (LK) kf3 = *reinterpret_cast<const LAS bf16x8*>(kad3 + ((so) * SHM_K + (koff) * 256)); PH = __builtin_amdgcn_mfma_f32_32x32x16_bf16(kf3, (rb) ? qf13 : qf03, PH, 0, 0, 0); } } while (0)
#define SGB(m, n) __builtin_amdgcn_sched_group_barrier(m, n, 0)
#define MBAR(X) do { SBAR(); asm volatile("" : "+v"(X) :: "memory"); SBAR(); } while (0)
#define STEP(PN, so, rb, koff, LK, PO, LV, X0, X1) do { \
    QKA(PN, so, rb, koff, LK); exp_half(PO, LV); if (LK) SGB(0x100, 2); SGB(0x8, 1); SGB(0x2, 12); SGB(0x8, 1); SGB(0x2, 12); SBAR(); asm volatile("" : "+v"(LV)); SBAR(); \
    QKB(PN, so, rb, koff, LK); pack_half(PO, X0, X1); if (LK) SGB(0x100, 2); SGB(0x8, 1); SGB(0x2, 4); SGB(0x8, 1); SGB(0x2, 4); MBAR(PN); } while (0)
#define TILE(t, so) do { BAR(); if ((t) + 1 < NT) DMA_TILE((t) + 1, 1 - (so)); SBAR(); \
    const int vb = vb0 + (so) * SHM_V; s16x4 fl0, fh0, fl1, fh1, fl2, fh2, fl3, fh3; \
    { f32x16 p0, p1; bf16x8 kf0, kf1, kf2, kf3; \
      QKA(p0, so, 0, 0, 1); QKB(p0, so, 0, 0, 1); MBAR(p0); \
      STEP(p1, so, 1, 0, 0, p0, l0v, a0, a1); \
      STEP(p0, so, 0, 32, 1, p1, l1v, b0, b1); \
      STEP(p1, so, 1, 32, 0, p0, l0v, a2, a3); \
      SBAR(); PVX_RD2(fl0, fh0, 0, 0); PVX_RD2(fl1, fh1, 0, 1); PVX_RD2(fl2, fh2, 0, 2); PVX_RD2(fl3, fh3, 0, 3); SBAR();     \
      exp_half(p1, l1v); SBAR(); asm volatile("" : "+v"(l1v)); SBAR(); pack_half(p1, b2, b3); } SBAR(); \
    { \
      pv2_block<0>(o0[0], o1[0], vb, fl0, fh0, fl1, fh1, fl2, fh2, fl3, fh3, a0, a1, a2, a3, b0, b1, b2, b3); \
      pv2_block<1>(o0[1], o1[1], vb, fl0, fh0, fl1, fh1, fl2, fh2, fl3, fh3, a0, a1, a2, a3, b0, b1, b2, b3); \
      pv2_block<2>(o0[2], o1[2], vb, fl0, fh0, fl1, fh1, fl2, fh2, fl3, fh3, a0, a1, a2, a3, b0, b1, b2, b3); \
      pv2_block<3>(o0[3], o1[3], vb, fl0, fh0, fl1, fh1, fl2, fh2, fl3, fh3, a0, a1, a2, a3, b0, b1, b2, b3); } SBAR(); } while (0)
#if ATT_PRIO
  if (wid >= 4) __builtin_amdgcn_s_setprio(1);
#endif
  for (int t = 0; t < NT; t += 2) { TILE(t, 0); TILE(t + 1, 1); }
#if ATT_PRIO
  __builtin_amdgcn_s_setprio(0);
#endif
  const float l0 = pair_sum(l0v[0] + l0v[1]), l1 = pair_sum(l1v[0] + l1v[1]);
  if (hi == 0) { li_l[r32] = l0; li_l[32 + r32] = l1; }
  asm volatile("s_waitcnt vmcnt(0) lgkmcnt(0)" ::: "memory"); __syncthreads();
  LAS float* xw = (LAS float*)(lds + (rg * 2 + c) * 16384) + lane; const LAS float* xr = (const LAS float*)(lds + (rg * 2 + (1 - c)) * 16384) + lane;
  const float sgn = c ? lam : 1.f;
#define SEND(OX, LOFF) do { _Pragma("unroll") for (int r = 0; r < 16; ++r) { const float rl = sgn * __builtin_amdgcn_rcpf(li_l[(LOFF) + crow(r, hi)]); \
    _Pragma("unroll") for (int d0 = 0; d0 < 4; ++d0) xw[(d0 * 16 + r) * 64] = OX[d0][r] * rl; } } while (0)
  if (c == 0) SEND(o1, 32); else SEND(o0, 0);
  asm volatile("s_waitcnt lgkmcnt(0)" ::: "memory"); __syncthreads();
#define FINISH(OX, LOFF, RB) do { _Pragma("unroll") for (int r = 0; r < 16; ++r) { const float rl = sgn * __builtin_amdgcn_rcpf(li_l[(LOFF) + crow(r, hi)]); float s = 0.f; \
    _Pragma("unroll") for (int d0 = 0; d0 < 4; ++d0) { const float own = OX[d0][r] * rl, oth = xr[(d0 * 16 + r) * 64]; const float d = c ? oth - own : own - oth; OX[d0][r] = d; s += d * d; } \
    s += __shfl_xor(s, 1); s += __shfl_xor(s, 2); s += __shfl_xor(s, 4); s += __shfl_xor(s, 8); s += __shfl_xor(s, 16); \
    const float rr = rsqrtf(s * (1.f / 128.f) + EPS) * omli; \
    bf16_t* orow = concat + (size_t)(qrow0 + rg * 64 + (RB) * 32 + crow(r, hi)) * DM + 512 + h * 128 + r32; \
    _Pragma("unroll") for (int d0 = 0; d0 < 4; ++d0) orow[d0 * 32] = f2bf(OX[d0][r] * rr * subln[d0 * 32 + r32]); } } while (0)
  if (c == 0) FINISH(o0, 0, 0); else FINISH(o1, 32, 1);
  asm volatile("s_waitcnt vmcnt(0) lgkmcnt(0)" ::: "memory"); __syncthreads();
#undef SEND
#undef FINISH
#undef DMA_TILE
#undef BAR
#undef QKA
#undef QKB
#undef TILE
#undef STEP
#undef MBAR
#undef SGB
}

__device__ __forceinline__ bf16x8 scale8(bf16x8 v, float s) {
  u32x4 w;
#pragma unroll
  for (int i = 0; i < 4; ++i) { const float a = __uint_as_float(((unsigned)(unsigned short)v[2 * i]) << 16) * s, b = __uint_as_float(((unsigned)(unsigned short)v[2 * i + 1]) << 16) * s; w[i] = cvtpk(a, b); }
  return *reinterpret_cast<bf16x8*>(&w);
}
template <int KS> __device__ __forceinline__ void trfrag_issue(int vb, s16x4& l, s16x4& h) { l = tr_read<v_rd_off(0, KS, 0)>(vb); h = tr_read<v_rd_off(0, KS, 1)>(vb); }
#define PKF(L, H) (bf16x8){L[0], L[1], L[2], L[3], H[0], H[1], H[2], H[3]}
template <int KS> __device__ __forceinline__ void cs_step(f32x16* acc, int kb, int vv) {
  s16x4 al, ah, b0l, b0h, b1l, b1h, b2l, b2h, b3l, b3h;
  trfrag_issue<KS>(kb, al, ah); trfrag_issue<KS>(vv, b0l, b0h); trfrag_issue<KS>(vv + 512, b1l, b1h); trfrag_issue<KS>(vv + 1024, b2l, b2h); trfrag_issue<KS>(vv + 1536, b3l, b3h);
  asm volatile("s_waitcnt lgkmcnt(0)" ::: "memory"); SBAR();
  const bf16x8 a = PKF(al, ah);
  acc[0] = __builtin_amdgcn_mfma_f32_32x32x16_bf16(a, PKF(b0l, b0h), acc[0], 0, 0, 0);
  acc[1] = __builtin_amdgcn_mfma_f32_32x32x16_bf16(a, PKF(b1l, b1h), acc[1], 0, 0, 0);
  acc[2] = __builtin_amdgcn_mfma_f32_32x32x16_bf16(a, PKF(b2l, b2h), acc[2], 0, 0, 0);
  acc[3] = __builtin_amdgcn_mfma_f32_32x32x16_bf16(a, PKF(b3l, b3h), acc[3], 0, 0, 0);
}
__device__ __forceinline__ void chunk_state_unit(const int wid, const bf16_t* __restrict__ proj, bf16_t* __restrict__ csf, bf16_t* __restrict__ csb, int rowbase, int h, float lgf2, float lgb2, LAS char* lds) {
  const int lane = lane_id(), tid = wid * 64 + lane, r32 = lane & 31, hi = lane >> 5;
  const int sr = tid >> 4, sc = (tid & 15) * 8;
  { bf16x8 kv[4], vv[4];
#pragma unroll
    for (int g = 0; g < 4; ++g) { const bf16_t* rp = proj + (size_t)(rowbase + 32 * g + sr) * DP + h * 128 + sc; kv[g] = ld8(rp + C_RK); vv[g] = ld8(rp + C_RV); }
#pragma unroll
    for (int g = 0; g < 4; ++g) { const int row = 32 * g + sr;
      const float wf = __builtin_amdgcn_exp2f(lgf2 * (float)(127 - row)), wb = __builtin_amdgcn_exp2f(lgb2 * (float)row);
      const int off = (row >> 6) * 16384 + v_st(row & 63, sc);
      *(LAS bf16x8*)(lds + off) = vv[g]; *(LAS bf16x8*)(lds + 32768 + off) = scale8(kv[g], wf); *(LAS bf16x8*)(lds + 65536 + off) = scale8(kv[g], wb); } }
  __syncthreads();
  const int dir = wid >> 2, ib = wid & 3;
  const int vbK = (int)(uintptr_t)(lds + 32768 + dir * 32768) + v_rd_base(lane) + ib * 512, vbV = (int)(uintptr_t)lds + v_rd_base(lane);
  f32x16 acc[4] = {};
  cs_step<0>(acc, vbK, vbV); cs_step<1>(acc, vbK, vbV); cs_step<2>(acc, vbK, vbV); cs_step<3>(acc, vbK, vbV);
  cs_step<0>(acc, vbK + 16384, vbV + 16384); cs_step<1>(acc, vbK + 16384, vbV + 16384); cs_step<2>(acc, vbK + 16384, vbV + 16384); cs_step<3>(acc, vbK + 16384, vbV + 16384);
  bf16_t* outp = (dir ? csb : csf) + r32;
#pragma unroll
  for (int r = 0; r < 16; ++r) { bf16_t* orow = outp + (size_t)(32 * ib + crow(r, hi)) * 128;
#pragma unroll
    for (int jb = 0; jb < 4; ++jb) orow[32 * jb] = f2bf(acc[jb][r]); }
  __syncthreads();
}
__device__ __forceinline__ void pack_p(const f32x16& p0, const f32x16& p1, bf16x8& pa0, bf16x8& pa1, bf16x8& pa2, bf16x8& pa3) {
#define PK4(P, BASE, OUT) do { unsigned a0 = cvtpk(P[BASE + 0], P[BASE + 1]), a1 = cvtpk(P[BASE + 2], P[BASE + 3]);   \
    unsigned b0 = cvtpk(P[BASE + 4], P[BASE + 5]), b1 = cvtpk(P[BASE + 6], P[BASE + 7]);                              \
    auto r0 = __builtin_amdgcn_permlane32_swap(a0, b0, false, false); auto r1 = __builtin_amdgcn_permlane32_swap(a1, b1, false, false); \
    u32x4 w = {r0[0], r1[0], r0[1], r1[1]}; OUT = *reinterpret_cast<bf16x8*>(&w); } while (0)
  PK4(p0, 0, pa0); PK4(p0, 8, pa1); PK4(p1, 0, pa2); PK4(p1, 8, pa3);
#undef PK4
}
__device__ __forceinline__ float decay_w(int d, float lgf2, float lgb2) {
  const float e = __builtin_amdgcn_exp2f(d < 0 ? lgf2 * (float)(-d) : lgb2 * (float)d); return d == 0 ? 2.f : e;
}
__device__ __forceinline__ void ret_out_unit(const int wid, const bf16_t* __restrict__ proj, bf16_t* __restrict__ concat, const bf16_t* __restrict__ spA, const bf16_t* __restrict__ spB, size_t dstride,
                                             int rowA, int rowB, int h, float lgf2, float lgb2, const float* __restrict__ gn, LAS char* lds) {
  const int lane = lane_id(), tid = wid * 64 + lane, r32 = lane & 31, hi = lane >> 5, rg = wid & 3, ch = wid >> 2;
  const int sr = tid >> 4, sc = (tid & 15) * 8;
  const int rowbase = ch ? rowB : rowA;
  { bf16x8 kv[8], vv[8];
#pragma unroll
    for (int c2 = 0; c2 < 2; ++c2)
#pragma unroll
      for (int g = 0; g < 4; ++g) { const bf16_t* rp = proj + (size_t)((c2 ? rowB : rowA) + 32 * g + sr) * DP + h * 128 + sc; kv[c2 * 4 + g] = ld8(rp + C_RK); vv[c2 * 4 + g] = ld8(rp + C_RV); }
#pragma unroll
    for (int c2 = 0; c2 < 2; ++c2)
#pragma unroll
      for (int g = 0; g < 4; ++g) { const int row = 32 * g + sr;
        *(LAS bf16x8*)(lds + c2 * 65536 + (row >> 6) * 16384 + KSWZ(row & 63, sc * 2)) = kv[c2 * 4 + g];
        *(LAS bf16x8*)(lds + c2 * 65536 + 32768 + (row >> 6) * 16384 + v_st(row & 63, sc)) = vv[c2 * 4 + g]; } }
  bf16x8 qr[8];
  const bf16_t* Qw = proj + (size_t)(rowbase + rg * 32 + r32) * DP + C_RQ + h * 128 + hi * 8;
#pragma unroll
  for (int d0 = 0; d0 < 8; ++d0) qr[d0] = ld8(Qw + d0 * 16);
  __syncthreads();
  const int m = rg * 32 + r32;
  LAS char* myreg = lds + ch * 65536;
  const int vb = (int)(uintptr_t)myreg + v_rd_base(lane);
  f32x16 o[4] = {}; f32x16 p0, p1; bf16x8 pa0, pa1, pa2, pa3;
#pragma unroll
  for (int kt = 0; kt < 2; ++kt) {
    qkt<8>(p0, p1, myreg + kt * 16384, qr, r32, hi, 0);
    int mm = m - 4 * hi; asm volatile("" : "+v"(mm));
#pragma unroll
    for (int r = 0; r < 16; ++r) { const int s0 = 64 * kt + (r & 3) + 8 * (r >> 2); p0[r] *= decay_w(s0 - mm, lgf2, lgb2); p1[r] *= decay_w(s0 + 32 - mm, lgf2, lgb2); }
    pack_p(p0, p1, pa0, pa1, pa2, pa3);
    pv_d0(o, vb + 32768 + kt * 16384, pa0, pa1, pa2, pa3);
  }
  __syncthreads();
  { bf16x8 sv[16];
#pragma unroll
    for (int c2 = 0; c2 < 2; ++c2)
#pragma unroll
      for (int d = 0; d < 2; ++d)
#pragma unroll
        for (int g = 0; g < 4; ++g) sv[(c2 * 2 + d) * 4 + g] = ld8((c2 ? spB : spA) + (size_t)d * dstride + (size_t)(32 * g + sr) * 128 + sc);
#pragma unroll
    for (int c2 = 0; c2 < 2; ++c2)
#pragma unroll
      for (int d = 0; d < 2; ++d)
#pragma unroll
        for (int g = 0; g < 4; ++g) { const int row = 32 * g + sr;
          *(LAS bf16x8*)(lds + c2 * 65536 + d * 32768 + (row >> 6) * 16384 + v_st(row & 63, sc)) = sv[(c2 * 2 + d) * 4 + g]; } }
  const float xf = __builtin_amdgcn_exp2f(lgf2 * (float)(m + 1)), xb = __builtin_amdgcn_exp2f(lgb2 * (float)(128 - m));
  __syncthreads();
#pragma unroll
  for (int d = 0; d < 2; ++d) { const float xs = d ? xb : xf;
#pragma unroll
    for (int sub = 0; sub < 2; ++sub) {
      const bf16x8 a0 = scale8(qr[4 * sub + 0], xs), a1 = scale8(qr[4 * sub + 1], xs), a2 = scale8(qr[4 * sub + 2], xs), a3 = scale8(qr[4 * sub + 3], xs);
      pv_d0(o, vb + d * 32768 + sub * 16384, a0, a1, a2, a3); } }
#pragma unroll
  for (int r = 0; r < 16; ++r) {
    float s = (o[0][r] + o[1][r]) + (o[2][r] + o[3][r]);
    s += __shfl_xor(s, 1); s += __shfl_xor(s, 2); s += __shfl_xor(s, 4); s += __shfl_xor(s, 8); s += __shfl_xor(s, 16);
    const float mu = s * (1.f / 128.f);
    float q = 0.f;
#pragma unroll
    for (int d0 = 0; d0 < 4; ++d0) { const float dd = o[d0][r] - mu; o[d0][r] = dd; q += dd * dd; }
    q += __shfl_xor(q, 1); q += __shfl_xor(q, 2); q += __shfl_xor(q, 4); q += __shfl_xor(q, 8); q += __shfl_xor(q, 16);
    const float rr = rsqrtf(q * (1.f / 128.f) + EPS);
    const size_t grow = (size_t)(rowbase + rg * 32 + crow(r, hi));
    const bf16_t* gp = proj + grow * DP + C_RG + h * 128 + r32; bf16_t* op = concat + grow * DM + h * 128 + r32;
#pragma unroll
    for (int d0 = 0; d0 < 4; ++d0) { const float gv = bf2f(gp[32 * d0]); op[32 * d0] = f2bf(o[d0][r] * rr * gn[32 * d0 + r32] * (gv * __builtin_amdgcn_rcpf(1.f + __builtin_amdgcn_exp2f(-1.4426950408889634f * gv)))); }
  }
  __syncthreads();
}

}


__device__ __forceinline__ float log2_sigmoid(float x) { return -log1pf(__expf(-x)) * 1.4426950408889634f; }
__device__ __forceinline__ bf16_t* cs_ptr(const Params& p, int b, int h, int dir, int j) { return (bf16_t*)(p.ws + WS_CS) + ((size_t)((b * NH + h) * 2 + dir) * 66 + j) * 16384; }
__device__ __forceinline__ void qkrope_phase(const Params& p, Ctx& F, int l) {
    const int lane = lane_id();
    float gq[8], gk[8], fr[8];
#pragma unroll
    for (int i = 0; i < 8; ++i) { gq[i] = p.in[I_QNG][l * 64 + 8 * (lane & 7) + i] * 0.18033688011112042f;
        gk[i] = p.in[I_KNG][l * 64 + 8 * (lane & 7) + i];
        fr[i] = exp2f(-(float)(8 * (lane & 1) + i) * (13.287712379549449f / 16.f)) * 0.15915494309189535f; }
    const bool lowhalf = (lane & 4) == 0;
    for (int m = F.gw; m < NR; m += F.NGW) {
        bf16_t* row = (bf16_t*)(p.ws + WS_PROJ) + (size_t)m * DP;
        v4u* qp = (v4u*)(row + C_DQ) + lane; const v4u* kp = (const v4u*)(row + C_DK) + lane;
        const v4u qv = *qp, kv = *kp, vv = *((const v4u*)(row + C_DV) + lane);
        float q[8], k[8];
#pragma unroll
        for (int i = 0; i < 4; ++i) { q[2 * i] = __uint_as_float(qv[i] << 16); q[2 * i + 1] = __uint_as_float(qv[i] & 0xffff0000u); k[2 * i] = __uint_as_float(kv[i] << 16); k[2 * i + 1] = __uint_as_float(kv[i] & 0xffff0000u); }
        float sq = 0.f, sk = 0.f;
#pragma unroll
        for (int i = 0; i < 8; ++i) { sq += q[i] * q[i]; sk += k[i] * k[i]; }
        sq += __shfl_xor(sq, 1); sq += __shfl_xor(sq, 2); sq += __shfl_xor(sq, 4);
        sk += __shfl_xor(sk, 1); sk += __shfl_xor(sk, 2); sk += __shfl_xor(sk, 4);
        const float rq = rsqrtf(sq * (1.f / 64.f) + EPS), rk = rsqrtf(sk * (1.f / 64.f) + EPS);
#pragma unroll
        for (int i = 0; i < 8; ++i) { q[i] *= rq * gq[i]; k[i] *= rk * gk[i]; }
        if (m < NL) {
            const int t = m % T; const float pos = (float)((lane & 2) ? (t % 64) : (t / 64));
#pragma unroll
            for (int i = 0; i < 8; ++i) {
                const float rev = pos * fr[i]; const float cs = __builtin_amdgcn_cosf(rev), sn = __builtin_amdgcn_sinf(rev);
                const float oq = __shfl_xor(q[i], 4), ok = __shfl_xor(k[i], 4);
                q[i] = lowhalf ? q[i] * cs - oq * sn : q[i] * cs + oq * sn;
                k[i] = lowhalf ? k[i] * cs - ok * sn : k[i] * cs + ok * sn;
            }
        }
        v4u qo, ko;
#pragma unroll
        for (int i = 0; i < 4; ++i) { qo[i] = pk2(q[2 * i], q[2 * i + 1]); ko[i] = pk2(k[2 * i], k[2 * i + 1]); }
        *qp = qo;
        { const int bb = m < NL ? m / T : (m - NL) / TC, kidx = m < NL ? TC + (m % T) : (m - NL) % TC, tile = kidx >> 6, r = kidx & 63, hh = lane >> 4, ci = lane & 15;
          const size_t blk = ((size_t)(bb * NH + hh) * 132 + tile) * 16384;
          *(v4u*)(p.ws + WS_KT + blk + KSWZ(r, 16 * ci)) = ko;
#if FAST_ATT
          *(v4u*)(p.ws + WS_VT + blk + att::v_st_lin(r, 8 * ci)) = vv; }
#else
          *(v4u*)(p.ws + WS_VT + blk + att::v_st(r, 8 * ci)) = vv; }
#endif
    }
}
__device__ __forceinline__ void scan_phase(const Params& p, Ctx& F, int l) {
    const int lane_ = lane_id(), tid_ = F.wave * 64 + lane_;
    unsigned* cs = (unsigned*)(p.ws + WS_CS);
    for (int i = blockIdx.x * (NWAVES * 64) + tid_; i < 16 * 8192; i += F.G * NWAVES * 64) {
        const int combo = i >> 13, e2 = i & 8191, dir = combo & 1, h = (combo >> 1) & 3;
        const float lg2 = log2_sigmoid(dir ? p.in[I_DECB][l * NH + h] : p.in[I_DECF][l * NH + h]);
        const float decay = exp2f(lg2 * 128.f);
        unsigned* base = cs + (size_t)combo * 66 * 8192 + e2;
        float s0 = 0.f, s1 = 0.f;
#pragma unroll 1
        for (int jj = 0; jj < 66; jj += 22) {
            unsigned tv[22];
#pragma unroll
            for (int k = 0; k < 22; ++k) { const int q = jj + k, idx = dir ? (q < 2 ? 1 - q : 67 - q) : q; tv[k] = base[(size_t)idx * 8192]; }
#pragma unroll
            for (int k = 0; k < 22; ++k) { const int q = jj + k, idx = dir ? (q < 2 ? 1 - q : 67 - q) : q;
                base[(size_t)idx * 8192] = pk2(s0, s1);
                s0 = decay * s0 + __uint_as_float(tv[k] << 16); s1 = decay * s1 + __uint_as_float(tv[k] & 0xffff0000u); }
        }
    }
}

#define IN(k) (lo <= (k) && (k) < hi)
#if SEAM_CVT
#define SEAM(k) do { if (IN(k) && IN((k) + 1)) { const bool t0_ = F.wave == 0 && lane_id() == 0; const XcdToken tk_ = xcd_barrier_arrive(bar, t0_); seam_fill(p, F, (k)); xcd_barrier_wait(bar, tk_, t0_); } } while (0)
#else
#define SEAM(k) do { if (IN(k) && IN((k) + 1)) xcd_barrier(bar, F.wave == 0 && lane_id() == 0); } while (0)
#endif
#ifndef REP_ATT
#define REP_ATT 1
#endif
#ifndef REP_RET
#define REP_RET 1
#endif
#ifndef REP_B
#define REP_B 1
#endif
#ifndef REP_H0
#define REP_H0 1
#endif
#ifndef REP_H1
#define REP_H1 1
#endif
#ifndef REP_I1
#define REP_I1 1
#endif
#ifndef REP_P0
#define REP_P0 1
#endif
#ifndef REP_CS
#define REP_CS 1
#endif
#ifndef REP_A
#define REP_A 1
#endif
#ifndef REP_I0
#define REP_I0 1
#endif
#ifndef REP_F0
#define REP_F0 1
#endif
#ifndef REP_G2
#define REP_G2 1
#endif
#ifndef REP_BAR
#define REP_BAR 0
#endif
template <int l>
__device__ __forceinline__ void layer_phases(const Params& p, Ctx& F, const XcdBarrier& bar, const int lo, const int hi) {
    constexpr int base = 1 + 9 * l;

        if (IN(base + 0)) { for (int rep_ = 0; rep_ < REP_A; ++rep_) norm_phase(p, F, l, 0, NR); for (int rep_ = 0; rep_ < REP_BAR; ++rep_) xcd_barrier(bar, F.wave == 0 && lane_id() == 0); SEAM(base + 0); }
        if (IN(base + 1)) {
            pg8::Gemm g{(const bf16_t*)(p.ws + WS_HBUF), (const bf16_t*)(p.ws + W_WIN) + (size_t)l * DP * DM, NR, DP, DM, DM};
            pg8::Order S; S.init(NR / 256, DP / 256, F.G, (int)blockIdx.x);
            pg8::EpiProj E{(bf16_t*)(p.ws + WS_PROJ)};
            { pg8::gemm_phase<pg8::EpiProj, pg8::Order, true, true>(F.lds + RING_OFF, g, S, E, F.wave); if (REP_B > 1) { pg8::gemm_phase<pg8::EpiProj, pg8::Order, true, true>(F.lds + RING_OFF, g, S, E, F.wave); } }
            SEAM(base + 1);
        }
        if (IN(base + 2)) {
            qkrope_phase(p, F, l);
            for (int rep_ = 0; rep_ < REP_CS; ++rep_)
            for (int u = blockIdx.x; u < 8 * 66; u += F.G) {
                const int bh = u & 7, j = u >> 3, b = bh >> 2, h = bh & 3;
                const int rowbase = j < 2 ? NL + b * TC + 128 * j : b * T + 128 * (j - 2);
                att::chunk_state_unit(F.wave, (const bf16_t*)(p.ws + WS_PROJ), cs_ptr(p, b, h, 0, j), cs_ptr(p, b, h, 1, j), rowbase, h,
                                      log2_sigmoid(p.in[I_DECF][l * NH + h]), log2_sigmoid(p.in[I_DECB][l * NH + h]), (LAS char*)(F.lds + RING_OFF));
            }
            SEAM(base + 2);
        }
        if (IN(base + 3)) { scan_phase(p, F, l); SEAM(base + 3); }
        if (IN(base + 4)) {
#if FAST_RET
            for (int rep_ = 0; rep_ < REP_RET; ++rep_)
            for (int u = blockIdx.x; u < (l == 0 ? 8 * 33 : 8 * 32); u += F.G) {
                const int bh = u & 7, jp = (u >> 3) + (l == 0 ? 0 : 1), b = bh >> 2, h = bh & 3;
                const int rowA = jp == 0 ? NL + b * TC : b * T + 128 * (2 * jp - 2);
                att::ret_out_unit(F.wave, (const bf16_t*)(p.ws + WS_PROJ), (bf16_t*)(p.ws + WS_CONCAT), cs_ptr(p, b, h, 0, 2 * jp), cs_ptr(p, b, h, 0, 2 * jp + 1), (size_t)66 * 16384,
                                  rowA, rowA + 128, h, log2_sigmoid(p.in[I_DECF][l * NH + h]), log2_sigmoid(p.in[I_DECB][l * NH + h]), p.in[I_GNG] + l * 512 + h * 128, (LAS char*)(F.lds + RING_OFF));
            }
#endif
#if FAST_ATT
            { const int lane_ = lane_id();
              const float s1 = wave_sum(p.in[I_LQ1][l * 64 + lane_] * p.in[I_LK1][l * 64 + lane_]), s2 = wave_sum(p.in[I_LQ2][l * 64 + lane_] * p.in[I_LK2][l * 64 + lane_]);
              const float li = lam_init_of(l), lam = __expf(s1) - __expf(s2) + li;
#if ATT_V3
              constexpr int nunits = 256 + (l == 0 ? 8 : 0);
              for (int rep_ = 0; rep_ < REP_ATT; ++rep_)
              for (int w = ((int)blockIdx.x + F.G - (8 % F.G)) % F.G; w < nunits; w += F.G) {
                  const int u = w < 256 ? ((w + 8) & 255) : w;
                  int b, h, qrow0, NT;
                  if (u < 256) { const int bh = u & 7, qb = u >> 3; b = bh >> 2; h = bh & 3; qrow0 = b * T + qb * 256; NT = (TC + T) / 64; }
                  else { const int bh = u - 256; b = bh >> 2; h = bh & 3; qrow0 = NL + b * TC; NT = TC / 64; }
                  att::ATT_UNIT(F.wave, (const bf16_t*)(p.ws + WS_PROJ), (const char*)(p.ws + WS_KT) + (size_t)(b * NH + h) * 132 * 16384, (const char*)(p.ws + WS_VT) + (size_t)(b * NH + h) * 132 * 16384, (bf16_t*)(p.ws + WS_CONCAT), qrow0, NT, h, (LAS char*)(F.lds + RING_OFF), lam, 1.f - li, p.in[I_SUBLN] + l * 128);
              }
#else
              constexpr int nunits = 512 + (l == 0 ? 16 : 0);
              for (int rep_ = 0; rep_ < REP_ATT; ++rep_)
              for (int u = blockIdx.x; u < nunits; u += F.G) {
                  int b, h, qrow0, NT;
                  if (u < 512) { const int bh = u & 7, qb = u >> 3; b = bh >> 2; h = bh & 3; qrow0 = b * T + qb * 128; NT = (TC + T) / 64; }
                  else { const int v = u - 512, bh = v & 7, blk = v >> 3; b = bh >> 2; h = bh & 3; qrow0 = NL + b * TC + blk * 128; NT = TC / 64; }
                  att::attn_unit(F.wave, (const bf16_t*)(p.ws + WS_PROJ), (const char*)(p.ws + WS_KT) + (size_t)(b * NH + h) * 132 * 16384, (const char*)(p.ws + WS_VT) + (size_t)(b * NH + h) * 132 * 16384, (bf16_t*)(p.ws + WS_CONCAT), qrow0, NT, h, (LAS char*)(F.lds + RING_OFF), lam, 1.f - li, p.in[I_SUBLN] + l * 128);
              }
#endif
            }
#endif
            SEAM(base + 4);
        }
        if (IN(base + 5)) {
            pg8::Gemm g{(const bf16_t*)(p.ws + WS_CONCAT), (const bf16_t*)(p.ws + W_WOUT) + (size_t)l * DM * DM, NR, DM, DM, DM};
            pg8::Order S; S.init(NL / 256, DM / 256, F.G, (int)blockIdx.x);
            pg8::EpiResid E{l == 0 ? p.in[I_X] : p.out, l == 0 ? p.in[I_CTX] : (const float*)(p.ws + WS_XRC), p.out, (float*)(p.ws + WS_XRC), modv(p, l, 0, 2), modv(p, l, 2, 2)};
            if (REP_F0 > 1 && l == 0) { pg8::gemm_phase<pg8::EpiResid, pg8::Order, true, true>(F.lds + RING_OFF, g, S, E, F.wave); }
            pg8::gemm_phase<pg8::EpiResid, pg8::Order, true, true>(F.lds + RING_OFF, g, S, E, F.wave);
            if constexpr (l == 0) {
                pg8::Gemm g2{(const bf16_t*)(p.ws + WS_CONCAT), (const bf16_t*)(p.ws + W_WOUT), NR, DM, 256, DM};
                pg8::SplitOrder S2; S2.init(NL / 256, 2, DM / 256, DM / 256, F.G, (int)blockIdx.x);
                pg8::EpiPartial E2{(float*)(p.ws + WS_PART), NL / 256, NC};
                pg8::gemm_phase<pg8::EpiPartial, pg8::SplitOrder, true, true>(F.lds + RING_OFF, g2, S2, E2, F.wave);
            }
            SEAM(base + 5);
        }
        if (IN(base + 6)) { if constexpr (l == 0) norm_phase(p, F, 0, 1, NR); else router_phase(p, F); SEAM(base + 6); }
        if constexpr (l == 0) {
            if (IN(8)) {
                pg8::Gemm g{(const bf16_t*)(p.ws + WS_HBUF), (const bf16_t*)(p.ws + W_FGU), NR, 2 * DFF, DM, DM};
                pg8::Order S; S.init(NR / 256, 2 * DFF / 256, F.G, (int)blockIdx.x);
                pg8::EpiSwiglu E{(bf16_t*)(p.ws + WS_ACT)};
                { pg8::gemm_phase<pg8::EpiSwiglu, pg8::Order, true, true>(F.lds + RING_OFF, g, S, E, F.wave); if (REP_H0 > 1) { pg8::gemm_phase<pg8::EpiSwiglu, pg8::Order, true, true>(F.lds + RING_OFF, g, S, E, F.wave); } }
                SEAM(8);
            }
            if (IN(9)) {
                pg8::Gemm g{(const bf16_t*)(p.ws + WS_ACT), (const bf16_t*)(p.ws + W_FD), NR, DM, DFF, DFF};
                pg8::Order S; S.init(NL / 256, DM / 256, F.G, (int)blockIdx.x);
                pg8::EpiResid E{p.out, (const float*)(p.ws + WS_XRC), p.out, (float*)(p.ws + WS_XRC), modv(p, 0, 0, 5), modv(p, 0, 2, 5)};
                if (REP_I0 > 1) { pg8::EpiResid Ed{p.out, (const float*)(p.ws + WS_XRC), (float*)(p.ws + WS_H2S), (float*)(p.ws + WS_H2S) + (size_t)NL * DM, modv(p, 0, 0, 5), modv(p, 0, 2, 5)}; pg8::gemm_phase<pg8::EpiResid, pg8::Order, true, true>(F.lds + RING_OFF, g, S, Ed, F.wave); }
                pg8::gemm_phase<pg8::EpiResid, pg8::Order, true, true>(F.lds + RING_OFF, g, S, E, F.wave);
                {
                    pg8::Gemm g2{(const bf16_t*)(p.ws + WS_ACT), (const bf16_t*)(p.ws + W_FD), NR, DM, 256, DFF};
                    pg8::SplitOrder S2; S2.init(NL / 256, 2, DM / 256, DFF / 256, F.G, (int)blockIdx.x);
                    pg8::EpiPartial E2{(float*)(p.ws + WS_PART), NL / 256, NC};
                    pg8::gemm_phase<pg8::EpiPartial, pg8::SplitOrder, true, true>(F.lds + RING_OFF, g2, S2, E2, F.wave);
                }
                SEAM(9);
            }
        } else {
            if (IN(17)) {
#if SEAM_CVT
                moe_cvt_rest(p, F);
#endif
                for (int rep_ = 0; rep_ < REP_G2; ++rep_) gather_phase(p, F); SEAM(17); }
            if (IN(18)) {
                moe_table(F);
                pg8::Gemm g{(const bf16_t*)(p.ws + WS_H2S), (const bf16_t*)(p.ws + W_MGU), MP_MAX, 2 * DFF, DM / 2, DM / 2};
                pg8::Order S; moe_order(F, S, 2 * DFF / 256, (long)2 * DFF * DM);
                pg8::EpiSwiglu8 E{(unsigned char*)(p.ws + WS_ACTS)};
                { pg8::gemm_phase<pg8::EpiSwiglu8, pg8::Order, true, true, true>(F.lds + RING_OFF, g, S, E, F.wave); if (REP_H1 > 1) { pg8::gemm_phase<pg8::EpiSwiglu8, pg8::Order, true, true, true>(F.lds + RING_OFF, g, S, E, F.wave); } }
                SEAM(18);
            }
            if (IN(19)) {
                moe_table(F);
                pg8::Gemm g{(const bf16_t*)(p.ws + WS_ACTS), (const bf16_t*)(p.ws + W_MD), MP_MAX, DM, DFF / 2, DFF / 2};
                pg8::Order S; moe_order(F, S, DM / 256, (long)DM * DFF);
                pg8::EpiMoeDown E{(bf16_t*)(p.ws + WS_YBUF), (const float*)(p.ws + WS_ROUTE) + 6 * NL + MP_MAX, 1.f / (W8_SCALE * A8_SCALE)};
                { pg8::gemm_phase<pg8::EpiMoeDown, pg8::Order, true, true, true>(F.lds + RING_OFF, g, S, E, F.wave); if (REP_I1 > 1) { pg8::gemm_phase<pg8::EpiMoeDown, pg8::Order, true, true, true>(F.lds + RING_OFF, g, S, E, F.wave); } }
                SEAM(19);
            }
            if (IN(20)) { combine_phase(p, F); }
        }
}
struct MArgs { Params p; int ph_lo, ph_hi, li, pad; };
constexpr int N_PHASES = 21;
__global__ void __launch_bounds__(NWAVES * 64, 2) mega(MArgs args) {
    extern __shared__ __attribute__((aligned(16))) unsigned char lds_raw[];
    const Params& p = args.p;
    Ctx F;
    F.lds = (LAS unsigned char*)lds_raw; F.MISC = (volatile LAS unsigned*)(F.lds + MISC_OFF);
    F.wave = __builtin_amdgcn_readfirstlane((int)threadIdx.x >> 6);
    const int lane_ = lane_id(), tid_ = F.wave * 64 + lane_;
    F.G = gridDim.x; F.gw = blockIdx.x * NWAVES + F.wave; F.NGW = F.G * NWAVES;
    F.ctl = (unsigned*)(p.ws + WS_CTL);
    for (int u = tid_; u < (LDS_BYTES - MISC_OFF) / 4; u += NWAVES * 64) ((LAS unsigned*)(F.lds + MISC_OFF))[u] = 0u;
    __syncthreads();
    XcdBarrier bar = xcd_barrier_post(F.ctl + CW_BAR + args.li * XCD_BAR_WORDS, F.MISC + 8, tid_ == 0);
    const int lo = args.ph_lo, hi = args.ph_hi;

    if (IN(0)) { for (int rep_ = 0; rep_ < REP_P0; ++rep_) { if (rep_) __syncthreads(); p0_prologue(p, F); } SEAM(0); }
    layer_phases<0>(p, F, bar, lo, hi);
    layer_phases<1>(p, F, bar, lo, hi);
#undef IN
#undef SEAM
}

#ifndef FAST_MASK
#define FAST_MASK 0x1u
#endif
static void launch_naive_e(const Params& p, int l, bool ret, bool att, hipStream_t stream) {
    const int nrows_mix = l == 0 ? NR : NL;
    if (ret) k_ret_naive<<<nrows_mix * NH / 4, 256, 0, stream>>>(p, l, nrows_mix);
    if (att) k_attn_naive<<<nrows_mix * NH / 4, 256, 0, stream>>>(p, l, nrows_mix);
}
static void launch_naive(const Params& p, int ph, hipStream_t stream) {
    const int l = ph >= 10 ? 1 : 0, rel = ph == 0 ? -1 : (ph - 1 - 9 * l);
    const int nrows_mix = l == 0 ? NR : NL;
    if (ph == 0) { k_mod<<<(2 * 3 * 6144 + 255) / 256, 256, 0, stream>>>(p); return; }
    switch (rel) {
    case 0: k_norm<<<NR / 4, 256, 0, stream>>>(p, l, 0, NR); break;
    case 1: k_gemm_proj<<<dim3(DP / 64, NR / 4), dim3(64, 4), 0, stream>>>(p, l); break;
    case 2: k_qkrope<<<NR / 4, 256, 0, stream>>>(p, l); break;
    case 3: break;
    case 4: launch_naive_e(p, l, true, true, stream); break;
    case 5: k_gemm_out<<<dim3(DM / 64, nrows_mix / 4), dim3(64, 4), 0, stream>>>(p, l); break;
    case 6: k_norm<<<nrows_mix / 4, 256, 0, stream>>>(p, l, 1, nrows_mix); break;
    case 7: if (l == 0) k_ffn_gu<<<dim3(DFF / 64, NR / 4), dim3(64, 4), 0, stream>>>(p); break;
    case 8: if (l == 0) k_ffn_down<<<dim3(DM / 64, NR / 4), dim3(64, 4), 0, stream>>>(p); else k_moe_gu<<<dim3(DFF / 64, 2 * NL / 4), dim3(64, 4), 0, stream>>>(p); break;
    case 9: k_moe_down<<<dim3(DM / 64, NL / 4), dim3(64, 4), 0, stream>>>(p); break;
    default: break;
    }
}
extern "C" void kernel_launch(void* const* d_in, const int* in_sizes, int n_in, void* d_out, int out_size, void* d_ws, size_t ws_size, hipStream_t stream) {
    static int grid = 0;
    if (grid == 0) {
        if (n_in != 28 || out_size != NL * DM || ws_size < WS_END) { fprintf(stderr, "kernel_launch: unexpected shapes (n_in %d out %d ws %zu need %zu)\n", n_in, out_size, ws_size, (size_t)WS_END); grid = -1; return; }
        int dev = 0, cus = 0, per_cu = 0;
        if (hipGetDevice(&dev) != hipSuccess || hipDeviceGetAttribute(&cus, hipDeviceAttributeMultiprocessorCount, dev) != hipSuccess) { grid = -1; return; }
        if (hipFuncSetAttribute((const void*)mega, hipFuncAttributeMaxDynamicSharedMemorySize, LDS_BYTES) != hipSuccess) { fprintf(stderr, "kernel_launch: hipFuncSetAttribute failed\n"); grid = -1; return; }
        if (hipOccupancyMaxActiveBlocksPerMultiprocessor(&per_cu, (const void*)mega, NWAVES * 64, LDS_BYTES) != hipSuccess || per_cu < 1) { fprintf(stderr, "kernel_launch: occupancy query says %d\n", per_cu); (void)hipGetLastError(); grid = -1; return; }
        grid = cus;
    }
    if (grid < 0) return;
    (void)hipMemsetAsync((char*)d_ws + WS_CTL, 0, CTL_ZERO_BYTES, stream);
    MArgs a{};
    for (int i = 0; i < 28; ++i) a.p.in[i] = (const float*)d_in[i];
    a.p.out = (float*)d_out; a.p.ws = (unsigned char*)d_ws;
    const unsigned mask = FAST_MASK;
    int li = 0, ph = 0;
    while (ph < N_PHASES) {
        if ((mask >> ph) & 1u) { int e = ph; bool cutE = false;
            while (e < N_PHASES && ((mask >> e) & 1u)) { const bool isE = (e == 5 || e == 14); ++e; if (isE && !(FAST_ATT && FAST_RET)) { cutE = true; break; } }
            a.ph_lo = ph; a.ph_hi = e; a.li = li++;
            hipLaunchKernelGGL(mega, dim3(grid), dim3(NWAVES * 64), LDS_BYTES, stream, a);
            if (cutE) launch_naive_e(a.p, e - 1 == 5 ? 0 : 1, !FAST_RET, !FAST_ATT, stream);
            ph = e; }
        else { launch_naive(a.p, ph, stream); ++ph; }
    }
}
```

```cpp
#include <hip/hip_runtime.h>
#include <cstdint>
#include <cstdio>
#define FAST_MASK 0x1fffffu
#define FAST_ATT 1
#define FAST_RET 1

constexpr int NB = 2, T = 8192, DM = 1024, TC = 256;
constexpr int NL = NB * T;
constexpr int NC = NB * TC;
constexpr int NR = NL + NC;
constexpr int DP = 3584, DFF = 2816, NE = 8, NH = 4;
constexpr float EPS = 1e-6f;
constexpr int C_RQ = 0, C_RK = 512, C_RV = 1024, C_RG = 1536, C_DQ = 2048, C_DK = 2560, C_DV = 3072;
constexpr int MP_MAX = 2 * NL + NE * 256;

typedef unsigned short bf16_t;
__device__ __forceinline__ float bf2f(bf16_t v) { return __uint_as_float(((unsigned)v) << 16); }
__device__ __forceinline__ bf16_t f2bf(float f) { unsigned u = __float_as_uint(f); u += 0x7fffu + ((u >> 16) & 1u); return (bf16_t)(u >> 16); }
typedef float f32x2_t __attribute__((ext_vector_type(2)));
typedef __bf16 bf16x2_t __attribute__((ext_vector_type(2)));
__device__ __forceinline__ unsigned pk2(float lo, float hi) { const f32x2_t v = {lo, hi}; const bf16x2_t b = __builtin_convertvector(v, bf16x2_t); return __builtin_bit_cast(unsigned, b); }
__device__ __forceinline__ unsigned pk4_fp8(float a, float b, float c, float d) {
    a = __builtin_amdgcn_fmed3f(a, -448.f, 448.f); b = __builtin_amdgcn_fmed3f(b, -448.f, 448.f); c = __builtin_amdgcn_fmed3f(c, -448.f, 448.f); d = __builtin_amdgcn_fmed3f(d, -448.f, 448.f);
    int r = 0; r = __builtin_amdgcn_cvt_pk_fp8_f32(a, b, r, false); r = __builtin_amdgcn_cvt_pk_fp8_f32(c, d, r, true); return (unsigned)r;
}
constexpr float W8_SCALE = 64.f, A8_SCALE = 8.f;
__device__ __forceinline__ float wave_sum(float v) {
#pragma unroll
    for (int o = 1; o < 64; o <<= 1) v += __shfl_xor(v, o);
    return v;
}
__device__ __forceinline__ int lane_id() { int l = (int)__builtin_amdgcn_mbcnt_hi(~0u, __builtin_amdgcn_mbcnt_lo(~0u, 0u)); asm volatile("" : "+v"(l)); return l; }
__device__ __forceinline__ float siluf(float v) { return v / (1.f + __expf(-v)); }

constexpr size_t MiB = 1u << 20;
constexpr size_t WS_CTL = 0, CTL_ZERO_BYTES = 1 * MiB;
constexpr size_t WS_MODV = 1 * MiB;
constexpr size_t WS_ROUTE = 2 * MiB;
constexpr size_t WS_XRC = 3 * MiB;
constexpr size_t WS_W = 6 * MiB;
constexpr size_t W_WIN = WS_W;
constexpr size_t W_WOUT = W_WIN + (size_t)2 * DP * DM * 2;
constexpr size_t W_FGU = W_WOUT + (size_t)2 * DM * DM * 2;
constexpr size_t W_FD = W_FGU + (size_t)2 * DFF * DM * 2;
constexpr size_t W_MGU = W_FD + (size_t)DM * DFF * 2;
constexpr size_t W_MD = W_MGU + (size_t)NE * 2 * DFF * DM * 2;
constexpr size_t W_END = W_MD + (size_t)NE * DM * DFF * 2;
constexpr size_t WS_HBUF = 173 * MiB;
constexpr size_t WS_PROJ = 206 * MiB;
constexpr size_t WS_CONCAT = 322 * MiB;
constexpr size_t WS_ACT = 206 * MiB;
constexpr size_t WS_ACTS = 173 * MiB;
constexpr size_t WS_H2S = 361 * MiB;
constexpr size_t WS_KT = 394 * MiB, WS_VT = WS_KT + (size_t)NB * NH * 132 * 16384;
static_assert(WS_VT + (size_t)NB * NH * 132 * 16384 <= 429 * MiB && WS_H2S + (size_t)NB * NH * 2 * 66 * 32768 <= WS_KT, "K/V tile images");
constexpr size_t WS_YBUF = WS_H2S, WS_CS = WS_H2S, WS_PART = WS_H2S;
constexpr size_t WS_END = 430 * MiB;
static_assert(W_END <= WS_HBUF && WS_ACTS + (size_t)MP_MAX * DFF * 2 <= WS_H2S && WS_H2S + (size_t)MP_MAX * DM * 2 <= WS_END && WS_ACT + (size_t)2 * NL * DFF * 2 <= WS_END, "ws map");
constexpr int CW_BAR = 4096;
constexpr int CW_CNT = 200000;

struct Params {
    const float* in[28];
    float* out;
    unsigned char* ws;
};
enum { I_X = 0, I_C, I_CTX, I_CCTX, I_ADAW, I_ADAB, I_N1G, I_N2G, I_WIN, I_DECF, I_DECB, I_GNG, I_QNG, I_KNG, I_LQ1, I_LK1, I_LQ2, I_LK2, I_SUBLN, I_WOUT,
       I_FWG, I_FWU, I_FWD, I_RW, I_RB, I_MWG, I_MWU, I_MWD };

__device__ __forceinline__ int rowtype(int m) { return m < NL ? m / T : 2; }
__device__ __forceinline__ const float* modv(const Params& p, int l, int rt, int i) { return (const float*)(p.ws + WS_MODV) + ((size_t)(l * 3 + rt) * 6 + i) * DM; }
__device__ __forceinline__ float* xr_row(const Params& p, int m) { return m < NL ? p.out + (size_t)m * DM : (float*)(p.ws + WS_XRC) + (size_t)(m - NL) * DM; }
__device__ __forceinline__ float lam_init_of(int l) { return l == 0 ? 0.2f : (0.8f - 0.6f * 0.74081822068171788f); }

#ifndef SEAM_CVT
#define SEAM_CVT 1
#endif
#ifndef ATT_UNIT
#define ATT_UNIT attn_unit3q
#endif
#ifndef FAST_ATT
#define FAST_ATT 0
#endif
#ifndef FAST_RET
#define FAST_RET 0
#endif
#ifndef ATT_V3
#define ATT_V3 1
#endif
__global__ void k_mod(Params p) {
    const int idx = blockIdx.x * blockDim.x + threadIdx.x;
    if (idx >= 2 * 3 * 6144) return;
    const int n = idx % 6144, rt = (idx / 6144) % 3, l = idx / (6144 * 3);
    const float* cv = rt < 2 ? p.in[I_C] + rt * DM : p.in[I_CCTX];
    const float* W = p.in[I_ADAW] + (size_t)l * DM * 6144;
    float acc = 0.f;
    for (int k = 0; k < DM; ++k) acc += siluf(cv[k]) * W[(size_t)k * 6144 + n];
    ((float*)(p.ws + WS_MODV))[(size_t)(l * 3 + rt) * 6144 + n] = acc + p.in[I_ADAB][l * 6144 + n];
}

__global__ void k_norm(Params p, int l, int which, int nrows) {
    const int m = blockIdx.x * (blockDim.x / 64) + (threadIdx.x >> 6), lane = threadIdx.x & 63;
    if (m >= nrows) return;
    const float* xrow;
    if (l == 0 && which == 0) xrow = m < NL ? p.in[I_X] + (size_t)m * DM : p.in[I_CTX] + (size_t)(m - NL) * DM;
    else xrow = xr_row(p, m);
    const int rt = rowtype(m);
    const float* g = p.in[which ? I_N2G : I_N1G] + l * DM;
    const float* sh = modv(p, l, rt, which ? 3 : 0);
    const float* sc = modv(p, l, rt, which ? 4 : 1);
    float v[16]; float ss = 0.f;
#pragma unroll
    for (int j = 0; j < 4; ++j) { const float4 t = *(const float4*)(xrow + 256 * j + 4 * lane); v[4 * j] = t.x; v[4 * j + 1] = t.y; v[4 * j + 2] = t.z; v[4 * j + 3] = t.w; ss += t.x * t.x + t.y * t.y + t.z * t.z + t.w * t.w; }
    const float r = rsqrtf(wave_sum(ss) * (1.f / DM) + EPS);
    bf16_t* hb = (bf16_t*)(p.ws + WS_HBUF) + (size_t)m * DM;
#pragma unroll
    for (int j = 0; j < 4; ++j)
#pragma unroll
        for (int q = 0; q < 4; ++q) { const int col = 256 * j + 4 * lane + q; const float y = v[4 * j + q] * r * g[col]; v[4 * j + q] = y * (1.f + sc[col]) + sh[col]; hb[col] = f2bf(v[4 * j + q]); }
    if (l == 1 && which == 1) {
        const float* rw = p.in[I_RW]; float lg[8];
#pragma unroll
        for (int e = 0; e < 8; ++e) { float a = 0.f;
#pragma unroll
            for (int j = 0; j < 4; ++j)
#pragma unroll
                for (int q = 0; q < 4; ++q) a += v[4 * j + q] * rw[(size_t)(256 * j + 4 * lane + q) * 8 + e];
            lg[e] = wave_sum(a) + p.in[I_RB][e]; }
        int i1 = 0; float v1 = lg[0];
#pragma unroll
        for (int e = 1; e < 8; ++e) if (lg[e] > v1) { v1 = lg[e]; i1 = e; }
        int i2 = -1; float v2 = -3.4e38f;
#pragma unroll
        for (int e = 0; e < 8; ++e) if (e != i1 && lg[e] > v2) { v2 = lg[e]; i2 = e; }
        const float w1 = 1.f / (1.f + __expf(v2 - v1));
        if (lane == 0) { int* te = (int*)(p.ws + WS_ROUTE); float* tw = (float*)(p.ws + WS_ROUTE) + 2 * NL; te[2 * m] = i1; te[2 * m + 1] = i2; tw[2 * m] = w1; tw[2 * m + 1] = 1.f - w1; }
    }
}

__global__ void k_gemm_proj(Params p, int l) {
    const int n = blockIdx.x * 64 + threadIdx.x, m = blockIdx.y * 4 + threadIdx.y;
    const bf16_t* a = (const bf16_t*)(p.ws + WS_HBUF) + (size_t)m * DM;
    const float* W = p.in[I_WIN] + (size_t)l * DM * DP + n;
    float acc = 0.f;
#pragma unroll 8
    for (int k = 0; k < DM; ++k) acc += bf2f(a[k]) * W[(size_t)k * DP];
    if (n >= C_RK && n < C_RV) acc *= 0.08838834764831845f;
    ((bf16_t*)(p.ws + WS_PROJ))[(size_t)m * DP + n] = f2bf(acc);
}

__global__ void k_qkrope(Params p, int l) {
    const int m = blockIdx.x * (blockDim.x / 64) + (threadIdx.x >> 6), lane = threadIdx.x & 63;
    if (m >= NR) return;
    bf16_t* row = (bf16_t*)(p.ws + WS_PROJ) + (size_t)m * DP;
    const bool lat = m < NL; const int t = m % T;
    const int j = lane & 31; const float pos = (float)((j < 16) ? (t / 64) : (t % 64));
    const float inv_freq = exp2f(-(float)(j & 15) * (13.287712379549449f / 16.f));
    const float ang = pos * inv_freq; const float cs = __cosf(ang), sn = __sinf(ang);
    for (int part = 0; part < 2; ++part) {
        const float* g = p.in[part ? I_KNG : I_QNG] + l * 64;
        for (int hc = 0; hc < 8; ++hc) {
            bf16_t* q = row + (part ? C_DK : C_DQ) + hc * 64;
            const float v = bf2f(q[lane]);
            const float r = rsqrtf(wave_sum(v * v) * (1.f / 64.f) + EPS);
            float y = v * r * g[lane];
            if (lat) { const float o = __shfl_xor(y, 32); y = lane < 32 ? y * cs - o * sn : y * cs + o * sn; }
            if (part == 0) y *= 0.18033688011112042f;
            q[lane] = f2bf(y);
        }
    }
}

__global__ void k_ret_naive(Params p, int l, int nrows) {
    const int w = blockIdx.x * (blockDim.x / 64) + (threadIdx.x >> 6), lane = threadIdx.x & 63;
    if (w >= nrows * NH) return;
    const int m = w / NH, h = w % NH;
    const bf16_t* proj = (const bf16_t*)(p.ws + WS_PROJ);
    const float df = p.in[I_DECF][l * NH + h], db = p.in[I_DECB][l * NH + h];
    const float lgf = -log1pf(__expf(-df)), lgb = -log1pf(__expf(-db));
    const bf16_t* qrow = proj + (size_t)m * DP + C_RQ + h * 128 + 2 * lane;
    const float q0 = bf2f(qrow[0]), q1 = bf2f(qrow[1]);
    float o0 = 0.f, o1 = 0.f;
    if (m < NL) {
        const int b = m / T, t = m % T;
        for (int s = 0; s < T; ++s) {
            const bf16_t* kr = proj + (size_t)(b * T + s) * DP + h * 128 + 2 * lane;
            const float dot = wave_sum(q0 * bf2f(kr[C_RK]) + q1 * bf2f(kr[C_RK + 1]));
            const float wgt = s < t ? __expf(lgf * (float)(t - s)) : (s == t ? 2.f : __expf(lgb * (float)(s - t)));
            o0 += wgt * dot * bf2f(kr[C_RV]); o1 += wgt * dot * bf2f(kr[C_RV + 1]);
        }
        for (int i = 0; i < TC; ++i) {
            const bf16_t* kr = proj + (size_t)(NL + b * TC + i) * DP + h * 128 + 2 * lane;
            const float dot = wave_sum(q0 * bf2f(kr[C_RK]) + q1 * bf2f(kr[C_RK + 1]));
            const float wgt = __expf(lgf * (float)(t + TC - i)) + __expf(lgb * (float)(T - t + i));
            o0 += wgt * dot * bf2f(kr[C_RV]); o1 += wgt * dot * bf2f(kr[C_RV + 1]);
        }
    } else {
        const int b = (m - NL) / TC, t = (m - NL) % TC;
        for (int s = 0; s < TC; ++s) {
            const bf16_t* kr = proj + (size_t)(NL + b * TC + s) * DP + h * 128 + 2 * lane;
            const float dot = wave_sum(q0 * bf2f(kr[C_RK]) + q1 * bf2f(kr[C_RK + 1]));
            const float wgt = s < t ? __expf(lgf * (float)(t - s)) : (s == t ? 2.f : __expf(lgb * (float)(s - t)));
            o0 += wgt * dot * bf2f(kr[C_RV]); o1 += wgt * dot * bf2f(kr[C_RV + 1]);
        }
    }
    const float mu = wave_sum(o0 + o1) * (1.f / 128.f);
    const float d0 = o0 - mu, d1 = o1 - mu;
    const float r = rsqrtf(wave_sum(d0 * d0 + d1 * d1) * (1.f / 128.f) + EPS);
    const float* gn = p.in[I_GNG] + l * 512 + h * 128 + 2 * lane;
    const bf16_t* gr = proj + (size_t)m * DP + C_RG + h * 128 + 2 * lane;
    bf16_t* cc = (bf16_t*)(p.ws + WS_CONCAT) + (size_t)m * DM + h * 128 + 2 * lane;
    cc[0] = f2bf(siluf(bf2f(gr[0])) * d0 * r * gn[0]);
    cc[1] = f2bf(siluf(bf2f(gr[1])) * d1 * r * gn[1]);
}

__global__ void k_attn_naive(Params p, int l, int nrows) {
    const int w = blockIdx.x * (blockDim.x / 64) + (threadIdx.x >> 6), lane = threadIdx.x & 63;
    if (w >= nrows * NH) return;
    const int m = w / NH, h = w % NH;
    const bf16_t* proj = (const bf16_t*)(p.ws + WS_PROJ);
    const bool lat = m < NL; const int b = lat ? m / T : (m - NL) / TC;
    float O[2][2];
    for (int c = 0; c < 2; ++c) {
        const float q = bf2f(proj[(size_t)m * DP + C_DQ + h * 128 + c * 64 + lane]);
        float mx = -1e30f, ls = 0.f, o0 = 0.f, o1 = 0.f;
        const int nk = lat ? TC + T : TC;
        for (int s = 0; s < nk; ++s) {
            const int mk = s < TC ? NL + b * TC + s : b * T + (s - TC);
            const bf16_t* kr = proj + (size_t)mk * DP + h * 128;
            const float sc = wave_sum(q * bf2f(kr[C_DK + c * 64 + lane]));
            const float mn = fmaxf(mx, sc), al = exp2f(mx - mn), pp = exp2f(sc - mn);
            ls = ls * al + pp; o0 = o0 * al + pp * bf2f(kr[C_DV + 2 * lane]); o1 = o1 * al + pp * bf2f(kr[C_DV + 2 * lane + 1]); mx = mn;
        }
        O[c][0] = o0 / ls; O[c][1] = o1 / ls;
    }
    float s1 = 0.f, s2 = 0.f;
    { const float a = p.in[I_LQ1][l * 64 + lane] * p.in[I_LK1][l * 64 + lane], bq = p.in[I_LQ2][l * 64 + lane] * p.in[I_LK2][l * 64 + lane]; s1 = wave_sum(a); s2 = wave_sum(bq); }
    const float li = lam_init_of(l), lam = __expf(s1) - __expf(s2) + li;
    const float d0 = O[0][0] - lam * O[1][0], d1 = O[0][1] - lam * O[1][1];
    const float r = rsqrtf(wave_sum(d0 * d0 + d1 * d1) * (1.f / 128.f) + EPS);
    const float* sg = p.in[I_SUBLN] + l * 128 + 2 * lane;
    bf16_t* cc = (bf16_t*)(p.ws + WS_CONCAT) + (size_t)m * DM + 512 + h * 128 + 2 * lane;
    cc[0] = f2bf(d0 * r * sg[0] * (1.f - li)); cc[1] = f2bf(d1 * r * sg[1] * (1.f - li));
}

__global__ void k_gemm_out(Params p, int l) {
    const int n = blockIdx.x * 64 + threadIdx.x, m = blockIdx.y * 4 + threadIdx.y;
    const bf16_t* a = (const bf16_t*)(p.ws + WS_CONCAT) + (size_t)m * DM;
    const float* W = p.in[I_WOUT] + (size_t)l * DM * DM + n;
    float acc = 0.f;
#pragma unroll 8
    for (int k = 0; k < DM; ++k) acc += bf2f(a[k]) * W[(size_t)k * DM];
    const float xin = l == 0 ? (m < NL ? p.in[I_X][(size_t)m * DM + n] : p.in[I_CTX][(size_t)(m - NL) * DM + n]) : xr_row(p, m)[n];
    xr_row(p, m)[n] = xin + modv(p, l, rowtype(m), 2)[n] * acc;
}

__global__ void k_ffn_gu(Params p) {
    const int j = blockIdx.x * 64 + threadIdx.x, m = blockIdx.y * 4 + threadIdx.y;
    const bf16_t* a = (const bf16_t*)(p.ws + WS_HBUF) + (size_t)m * DM;
    const float* Wg = p.in[I_FWG] + j; const float* Wu = p.in[I_FWU] + j;
    float ag = 0.f, au = 0.f;
#pragma unroll 8
    for (int k = 0; k < DM; ++k) { const float x = bf2f(a[k]); ag += x * Wg[(size_t)k * DFF]; au += x * Wu[(size_t)k * DFF]; }
    ((bf16_t*)(p.ws + WS_ACT))[(size_t)m * DFF + j] = f2bf(siluf(ag) * au);
}
__global__ void k_ffn_down(Params p) {
    const int n = blockIdx.x * 64 + threadIdx.x, m = blockIdx.y * 4 + threadIdx.y;
    const bf16_t* a = (const bf16_t*)(p.ws + WS_ACT) + (size_t)m * DFF;
    const float* W = p.in[I_FWD] + n;
    float acc = 0.f;
#pragma unroll 8
    for (int k = 0; k < DFF; ++k) acc += bf2f(a[k]) * W[(size_t)k * DM];
    xr_row(p, m)[n] += modv(p, 0, rowtype(m), 5)[n] * acc;
}
__global__ void k_moe_gu(Params p) {
    const int j = blockIdx.x * 64 + threadIdx.x, ts = blockIdx.y * 4 + threadIdx.y;
    const int t = ts >> 1; const int e = ((const int*)(p.ws + WS_ROUTE))[ts];
    const bf16_t* a = (const bf16_t*)(p.ws + WS_HBUF) + (size_t)t * DM;
    const float* Wg = p.in[I_MWG] + (size_t)e * DM * DFF + j; const float* Wu = p.in[I_MWU] + (size_t)e * DM * DFF + j;
    float ag = 0.f, au = 0.f;
#pragma unroll 8
    for (int k = 0; k < DM; ++k) { const float x = bf2f(a[k]); ag += x * Wg[(size_t)k * DFF]; au += x * Wu[(size_t)k * DFF]; }
    ((bf16_t*)(p.ws + WS_ACT))[(size_t)ts * DFF + j] = f2bf(siluf(ag) * au);
}
__global__ void k_moe_down(Params p) {
    const int n = blockIdx.x * 64 + threadIdx.x, t = blockIdx.y * 4 + threadIdx.y;
    const int* te = (const int*)(p.ws + WS_ROUTE); const float* tw = (const float*)(p.ws + WS_ROUTE) + 2 * NL;
    float y = 0.f;
    for (int s = 0; s < 2; ++s) {
        const bf16_t* a = (const bf16_t*)(p.ws + WS_ACT) + (size_t)(2 * t + s) * DFF;
        const float* W = p.in[I_MWD] + (size_t)te[2 * t + s] * DFF * DM + n;
        float acc = 0.f;
#pragma unroll 8
        for (int k = 0; k < DFF; ++k) acc += bf2f(a[k]) * W[(size_t)k * DM];
        y += tw[2 * t + s] * acc;
    }
    p.out[(size_t)t * DM + n] += modv(p, 1, t / T, 5)[n] * y;
}


typedef unsigned v2u __attribute__((ext_vector_type(2)));
namespace pg8 {
#define PG8_LAS __attribute__((address_space(3)))
typedef unsigned short bf16_t;
typedef short bf16x8 __attribute__((ext_vector_type(8)));
typedef float f32x4 __attribute__((ext_vector_type(4)));
typedef unsigned u32x4 __attribute__((ext_vector_type(4)));
typedef int i32x4 __attribute__((ext_vector_type(4)));
typedef int i32x8 __attribute__((ext_vector_type(8)));
constexpr int BM = 256, BK = 64, HALF = 128, HTB = HALF * BK * 2  , STAGE_BYTES = 8 * HTB, NXCD = 8, WGM = 8;

__host__ __device__ __forceinline__ int lds_byte(int r, int c) { const int st = (r >> 4) * 2 + (c >> 5), rr = r & 15, cc = c & 31, ob = rr * 64 + cc * 2; return st * 1024 + (ob ^ (((ob >> 9) & 1) << 5)); }
__host__ __device__ __forceinline__ void stage_rc(int b, int& R, int& C) { const int st = b / 1024, sb = b % 1024, swz = sb ^ (((sb >> 9) & 1) << 5); R = (st >> 1) * 16 + swz / 64; C = (st & 1) * 32 + (swz % 64) / 2; }
__host__ __device__ __forceinline__ int perm32(int rho) { const int n = rho >> 4, i = rho & 15; return 8 * (i >> 2) + 4 * n + (i & 3); }

struct Unit { int pm, pn; long bofs, kofs; };
struct Gemm { const bf16_t* A; const bf16_t* Bt; int M, N, K, ld; };

struct Order {
    int nM, nN, nwg, G, c;
    int e1, e2, e3, e4, e5, e6, e7; long estride;
    __device__ __forceinline__ void init(int nM_, int nN_, int G_, int c_) { nM = nM_; nN = nN_; nwg = nM * nN; G = G_; c = c_; estride = 0; e1 = e2 = e3 = e4 = e5 = e6 = e7 = 0; }
    __device__ __forceinline__ bool next(int i, Unit& u) const {
        const long L = (long)i * G + c; if (L >= nwg) return false;
        int wgid = (int)L; { const int q = nwg / NXCD, r = nwg % NXCD, xcd = wgid % NXCD, off = wgid / NXCD; wgid = (xcd < r ? xcd * (q + 1) : r * (q + 1) + (xcd - r) * q) + off; }
        const int nig = WGM * nN, gid = wgid / nig, fm = gid * WGM, gsz = (nM - fm) < WGM ? (nM - fm) : WGM;
        u.pm = fm + ((wgid % nig) % gsz); u.pn = (wgid % nig) / gsz;
        const int e = (u.pm >= e1) + (u.pm >= e2) + (u.pm >= e3) + (u.pm >= e4) + (u.pm >= e5) + (u.pm >= e6) + (u.pm >= e7);
        u.bofs = estride ? (long)e * estride : 0; u.kofs = 0;
        return true;
    }
    __device__ __forceinline__ void a_ready(const Unit&) const {}
    __device__ __forceinline__ void done(const Unit&) const {}
};

struct SplitOrder {
    int nN, ns, nwg, G, c, pm0;
    __device__ __forceinline__ void init(int pm0_, int npan, int nN_, int ns_, int G_, int c_) { pm0 = pm0_; nN = nN_; ns = ns_; nwg = npan * nN * ns; G = G_; c = c_; }
    __device__ __forceinline__ bool next(int i, Unit& u) const {
        const int L = i * G + c; if (L >= nwg) return false;
        const int ks = L % ns, rest = L / ns; u.pn = rest % nN; u.pm = pm0 + rest / nN; u.bofs = 0; u.kofs = (long)ks * 256 * 2; return true;
    }
    __device__ __forceinline__ void a_ready(const Unit&) const {}
    __device__ __forceinline__ void done(const Unit&) const {}
};
__device__ __forceinline__ unsigned cvt_pk_bf16(float lo, float hi) { unsigned r; asm volatile("v_cvt_pk_bf16_f32 %0, %1, %2" : "=v"(r) : "v"(lo), "v"(hi)); return r; }
__device__ __forceinline__ float silu_fast(float x) { return x * __builtin_amdgcn_rcpf(1.f + __builtin_amdgcn_exp2f(-1.4426950408889634f * x)); }

struct EpiProj {
    static constexpr bool PERM = true, AFTER_DRAIN = false;
    bf16_t* O; char* VT;
    __device__ __forceinline__ void operator()(const f32x4 (&acc)[2][2][4][2], const Unit& u, int wr, int wc, int fr, int fq) const {
        const int row0 = u.pm * BM + wr * 64 + fr, col0 = u.pn * BM + wc * 32 + 8 * fq;
#if FAST_ATT
        if (u.pn >= C_DV / BM) {
#pragma unroll
            for (int ai = 0; ai < 2; ++ai)
#pragma unroll
                for (int m = 0; m < 4; ++m) { const int row = row0 + ai * HALF + m * 16;
                    const int bb = row < NL ? row / T : (row - NL) / TC, kidx = row < NL ? TC + (row % T) : (row - NL) % TC, key = kidx & 63;
                    const int pos = (key & ~0xC) | ((key & 4) << 1) | ((key & 8) >> 1), ch = pos >> 3;
#pragma unroll
                    for (int bj = 0; bj < 2; ++bj) { const int hh = 2 * (u.pn - C_DV / BM) + bj;
                        char* tp = VT + ((size_t)(bb * NH + hh) * 132 + (kidx >> 6)) * 16384 + (wc * 32 + 8 * fq) * 128 + (pos & 7) * 2;
#pragma unroll
                        for (int n = 0; n < 2; ++n) { const f32x4 v = acc[ai][bj][m][n];
                            const unsigned w0 = cvt_pk_bf16(v[0], v[1]), w1 = cvt_pk_bf16(v[2], v[3]);
                            char* q0 = tp + (4 * n) * 128 + (((ch & 4) | ((ch & 3) ^ (2 * n))) << 4); char* q1 = tp + (4 * n) * 128 + (((ch & 4) | ((ch & 3) ^ (2 * n + 1))) << 4);
                            *(unsigned short*)(q0) = (unsigned short)w0; *(unsigned short*)(q0 + 128) = (unsigned short)(w0 >> 16);
                            *(unsigned short*)(q1 + 256) = (unsigned short)w1; *(unsigned short*)(q1 + 384) = (unsigned short)(w1 >> 16); } } }
            return;
        }
#endif
        const float sc = (u.pn == 2 || u.pn == 3) ? 0.08838834764831845f : 1.f;
#pragma unroll
        for (int ai = 0; ai < 2; ++ai)
#pragma unroll
            for (int m = 0; m < 4; ++m) { bf16_t* rowp = O + (size_t)(row0 + ai * HALF + m * 16) * DP + col0;
#pragma unroll
                for (int bj = 0; bj < 2; ++bj) { const f32x4 v0 = acc[ai][bj][m][0] * sc, v1 = acc[ai][bj][m][1] * sc;
                    u32x4 w; w.x = cvt_pk_bf16(v0[0], v0[1]); w.y = cvt_pk_bf16(v0[2], v0[3]); w.z = cvt_pk_bf16(v1[0], v1[1]); w.w = cvt_pk_bf16(v1[2], v1[3]);
                    *(u32x4*)(rowp + bj * HALF) = w; } }
    }
};
struct EpiResid {
    static constexpr bool PERM = false, AFTER_DRAIN = false;
    const float* base_lat; const float* base_ctx; float* out_lat; float* out_ctx; const float* gl; const float* gc;
    __device__ __forceinline__ void operator()(const f32x4 (&acc)[2][2][4][2], const Unit& u, int wr, int wc, int fr, int fq) const {
        const bool lat = u.pm < NL / BM;
        const int row0 = (lat ? u.pm * BM : u.pm * BM - NL) + wr * 64 + fr, col0 = u.pn * BM + wc * 32 + 4 * fq;
        const float* base = lat ? base_lat : base_ctx; float* out = lat ? out_lat : out_ctx;
        const float* gate = lat ? gl + (size_t)(u.pm / (T / BM)) * 6 * DM : gc;
        f32x4 gv[2][2];
#pragma unroll
        for (int bj = 0; bj < 2; ++bj)
#pragma unroll
            for (int n = 0; n < 2; ++n) gv[bj][n] = *(const f32x4*)(gate + col0 + bj * HALF + n * 16);
#pragma unroll
        for (int ai = 0; ai < 2; ++ai)
#pragma unroll
            for (int m = 0; m < 4; ++m) { const size_t off = (size_t)(row0 + ai * HALF + m * 16) * DM + col0;
#pragma unroll
                for (int bj = 0; bj < 2; ++bj)
#pragma unroll
                    for (int n = 0; n < 2; ++n) { const f32x4 bs = *(const f32x4*)(base + off + bj * HALF + n * 16); *(f32x4*)(out + off + bj * HALF + n * 16) = bs + gv[bj][n] * acc[ai][bj][m][n]; }
                asm volatile("" ::: "memory"); }
    }
};
struct EpiPartial {
    static constexpr bool PERM = false, AFTER_DRAIN = false;
    float* part; int pm0, nrows;
    __device__ __forceinline__ void operator()(const f32x4 (&acc)[2][2][4][2], const Unit& u, int wr, int wc, int fr, int fq) const {
        const int row0 = (u.pm - pm0) * BM + wr * 64 + fr, col0 = u.pn * BM + wc * 32 + 4 * fq;
        float* base = part + (size_t)(u.kofs / 512) * nrows * DM;
#pragma unroll
        for (int ai = 0; ai < 2; ++ai)
#pragma unroll
            for (int m = 0; m < 4; ++m) { float* rowp = base + (size_t)(row0 + ai * HALF + m * 16) * DM + col0;
#pragma unroll
                for (int bj = 0; bj < 2; ++bj)
#pragma unroll
                    for (int n = 0; n < 2; ++n) *(f32x4*)(rowp + bj * HALF + n * 16) = acc[ai][bj][m][n]; }
    }
};
struct EpiSwiglu {
    static constexpr bool PERM = true, AFTER_DRAIN = false;
    bf16_t* O;
    __device__ __forceinline__ void operator()(const f32x4 (&acc)[2][2][4][2], const Unit& u, int wr, int wc, int fr, int fq) const {
        const int row0 = u.pm * BM + wr * 64 + fr, col0 = u.pn * HALF + wc * 32 + 8 * fq;
#pragma unroll
        for (int ai = 0; ai < 2; ++ai)
#pragma unroll
            for (int m = 0; m < 4; ++m) { bf16_t* rowp = O + (size_t)(row0 + ai * HALF + m * 16) * DFF + col0;
                const f32x4 g0 = acc[ai][0][m][0], g1 = acc[ai][0][m][1], u0 = acc[ai][1][m][0], u1 = acc[ai][1][m][1];
                u32x4 w; w.x = cvt_pk_bf16(silu_fast(g0[0]) * u0[0], silu_fast(g0[1]) * u0[1]); w.y = cvt_pk_bf16(silu_fast(g0[2]) * u0[2], silu_fast(g0[3]) * u0[3]);
                w.z = cvt_pk_bf16(silu_fast(g1[0]) * u1[0], silu_fast(g1[1]) * u1[1]); w.w = cvt_pk_bf16(silu_fast(g1[2]) * u1[2], silu_fast(g1[3]) * u1[3]);
                *(u32x4*)rowp = w; }
    }
};
struct EpiSwiglu8 {
    static constexpr bool PERM = true, AFTER_DRAIN = false;
    unsigned char* O;
    __device__ __forceinline__ void operator()(const f32x4 (&acc)[2][2][4][2], const Unit& u, int wr, int wc, int fr, int fq) const {
        const int row0 = u.pm * BM + wr * 64 + fr, col0 = u.pn * HALF + wc * 32 + 8 * fq;
        constexpr float WI = 1.f / W8_SCALE;
#pragma unroll
        for (int ai = 0; ai < 2; ++ai)
#pragma unroll
            for (int m = 0; m < 4; ++m) { unsigned char* rowp = O + (size_t)(row0 + ai * HALF + m * 16) * DFF + col0;
                const f32x4 g0 = acc[ai][0][m][0] * WI, g1 = acc[ai][0][m][1] * WI, u0 = acc[ai][1][m][0] * (WI * A8_SCALE), u1 = acc[ai][1][m][1] * (WI * A8_SCALE);
                v2u w; w.x = pk4_fp8(silu_fast(g0[0]) * u0[0], silu_fast(g0[1]) * u0[1], silu_fast(g0[2]) * u0[2], silu_fast(g0[3]) * u0[3]);
                w.y = pk4_fp8(silu_fast(g1[0]) * u1[0], silu_fast(g1[1]) * u1[1], silu_fast(g1[2]) * u1[2], silu_fast(g1[3]) * u1[3]);
                *(v2u*)rowp = w; }
    }
};
struct EpiMoeDown {
    static constexpr bool PERM = true, AFTER_DRAIN = false;
    bf16_t* O; const float* rgate; float scale;
    __device__ __forceinline__ void operator()(const f32x4 (&acc)[2][2][4][2], const Unit& u, int wr, int wc, int fr, int fq) const {
        const int row0 = u.pm * BM + wr * 64 + fr, col0 = u.pn * BM + wc * 32 + 8 * fq;
#pragma unroll
        for (int ai = 0; ai < 2; ++ai)
#pragma unroll
            for (int m = 0; m < 4; ++m) { const int row = row0 + ai * HALF + m * 16; const float sc = rgate[row] * scale; bf16_t* rowp = O + (size_t)row * DM + col0;
#pragma unroll
                for (int bj = 0; bj < 2; ++bj) { const f32x4 v0 = acc[ai][bj][m][0] * sc, v1 = acc[ai][bj][m][1] * sc;
                    u32x4 w; w.x = cvt_pk_bf16(v0[0], v0[1]); w.y = cvt_pk_bf16(v0[2], v0[3]); w.z = cvt_pk_bf16(v1[0], v1[1]); w.w = cvt_pk_bf16(v1[2], v1[3]);
                    *(u32x4*)(rowp + bj * HALF) = w; } }
    }
};

template <class Epi, class Sched, bool ALIGN_EPI = false, bool SP2 = false, bool F8 = false>
__device__ __forceinline__ void gemm_phase(PG8_LAS unsigned char* lds, const Gemm g, const Sched& S, const Epi& E, const int wid  ) {
    const int lane = lane_id(), tid = wid * 64 + lane, wr = wid >> 2, wc = wid & 3, fr = lane & 15, fq = lane >> 4;
    const int K = g.ld, nt = g.K / BK;
    unsigned voffA[2], voffB[2];
#pragma unroll
    for (int i = 0; i < 2; ++i) { int R, C; stage_rc(tid * 16 + i * 8192, R, C); const int Rb = Epi::PERM ? ((R & ~31) + perm32(R & 31)) : R;
        voffA[i] = (unsigned)(R * K + C) * 2u; voffB[i] = (unsigned)(Rb * K + C) * 2u; }
    const size_t kstep = (size_t)(BK * 2);
    const size_t hstep = (size_t)HALF * K * 2;
    const size_t tstep = 2 * hstep;
    const unsigned ldsw = (unsigned)wid * 1024u;
    const int aoff = lds_byte(wr * 64 + fr, fq * 8), boff = lds_byte(wc * 32 + fr, fq * 8);
#define PG8_SA(b, h) (((b) * 2 + (h)) * HTB)
#define PG8_SB(b, h) ((4 + (b) * 2 + (h)) * HTB)
#define PG8_STAGE(bufoff, gbase, voff) do { _Pragma("unroll") for (int _i = 0; _i < 2; ++_i) \
        __builtin_amdgcn_global_load_lds((const unsigned*)((const char*)(gbase) + (voff)[_i]), (PG8_LAS unsigned*)(lds + (bufoff) + ldsw + _i * 8192), 16, 0, 0); } while (0)
#define PG8_LD8(addr) __builtin_shufflevector(*(const PG8_LAS i32x4*)(addr), *(const PG8_LAS i32x4*)((addr) + 1024), 0, 1, 2, 3, 4, 5, 6, 7)
#define PG8_LDA(dst, dst8, b, h) do { if constexpr (F8) { _Pragma("unroll") for (int m = 0; m < 4; ++m) dst8[m] = PG8_LD8(lds + PG8_SA(b, h) + aoff + m * 2048); } \
        else { _Pragma("unroll") for (int m = 0; m < 4; ++m) _Pragma("unroll") for (int k = 0; k < 2; ++k) dst[m][k] = *(const PG8_LAS bf16x8*)(lds + PG8_SA(b, h) + aoff + m * 2048 + k * 1024); } } while (0)
#define PG8_LDB(dst, dst8, b, h) do { if constexpr (F8) { _Pragma("unroll") for (int n = 0; n < 2; ++n) dst8[n] = PG8_LD8(lds + PG8_SB(b, h) + boff + n * 2048); } \
        else { _Pragma("unroll") for (int n = 0; n < 2; ++n) _Pragma("unroll") for (int k = 0; k < 2; ++k) dst[n][k] = *(const PG8_LAS bf16x8*)(lds + PG8_SB(b, h) + boff + n * 2048 + k * 1024); } } while (0)
#define PG8_MMA(ai, bj, At, At8, Bt, Bt8) do { __builtin_amdgcn_s_setprio(1); \
        if constexpr (F8) { _Pragma("unroll") for (int m = 0; m < 4; ++m) _Pragma("unroll") for (int n = 0; n < 2; ++n) \
            asm volatile("v_mfma_scale_f32_16x16x128_f8f6f4 %0, %1, %2, %0, %3, %3 op_sel_hi:[0,0,0]" : "+v"(acc[ai][bj][m][n]) : "v"(Bt8[n]), "v"(At8[m]), "v"(sc8_)); } \
        else { _Pragma("unroll") for (int m = 0; m < 4; ++m) _Pragma("unroll") for (int n = 0; n < 2; ++n) _Pragma("unroll") for (int k = 0; k < 2; ++k) \
            acc[ai][bj][m][n] = __builtin_amdgcn_mfma_f32_16x16x32_bf16(Bt[n][k], At[m][k], acc[ai][bj][m][n], 0, 0, 0); } \
        __builtin_amdgcn_s_setprio(0); } while (0)
#define PG8_WAIT_V(n) asm volatile("s_waitcnt vmcnt(" #n ")" ::: "memory")
#define PG8_WAIT_L(n) asm volatile("s_waitcnt lgkmcnt(" #n ")" ::: "memory")
#define PG8_BAR __builtin_amdgcn_s_barrier()
#define PG8_SCHED __builtin_amdgcn_sched_barrier(0)
#define PG8_SCHED8 do { if constexpr (F8) __builtin_amdgcn_sched_barrier(0); } while (0)
    Unit cur, nxt; int ui = 0;
    if (!S.next(0, cur)) return;
    constexpr float zero_ = 0.f;
    const int sc8_ = 0x7f7f7f7f;
    f32x4 acc[2][2][4][2];
#pragma unroll
    for (int a = 0; a < 2; ++a)
#pragma unroll
        for (int b = 0; b < 2; ++b)
#pragma unroll
            for (int m = 0; m < 4; ++m)
#pragma unroll
                for (int n = 0; n < 2; ++n) acc[a][b][m][n] = (f32x4){zero_, zero_, zero_, zero_};
    bf16x8 At[4][2], B0[2][2], B1[2][2];
    i32x8 At8[4], B08[2], B18[2];
    const char* cA = (const char*)g.A + cur.kofs + (size_t)cur.pm * tstep; const char* cB = (const char*)g.Bt + cur.bofs + cur.kofs + (size_t)cur.pn * tstep;
    S.a_ready(cur);
    if constexpr (SP2) {
        PG8_STAGE(PG8_SB(0, 0), cB, voffB); PG8_STAGE(PG8_SB(0, 1), cB + hstep, voffB); PG8_STAGE(PG8_SA(0, 0), cA, voffA); PG8_STAGE(PG8_SA(0, 1), cA + hstep, voffA);
        if (wr == 1) PG8_BAR;
        PG8_WAIT_V(2); PG8_BAR;
        PG8_STAGE(PG8_SB(1, 0), cB + kstep, voffB); PG8_STAGE(PG8_SA(1, 0), cA + kstep, voffA); PG8_STAGE(PG8_SB(1, 1), cB + hstep + kstep, voffB);
        PG8_WAIT_V(6); PG8_BAR;
    } else {
        PG8_STAGE(PG8_SB(0, 0), cB, voffB); PG8_STAGE(PG8_SA(0, 0), cA, voffA); PG8_STAGE(PG8_SB(0, 1), cB + hstep, voffB); PG8_STAGE(PG8_SA(0, 1), cA + hstep, voffA);
        if (wr == 1) PG8_BAR;
        PG8_WAIT_V(4); PG8_BAR;
        PG8_STAGE(PG8_SB(1, 0), cB + kstep, voffB); PG8_STAGE(PG8_SA(1, 0), cA + kstep, voffA); PG8_STAGE(PG8_SB(1, 1), cB + hstep + kstep, voffB);
        PG8_WAIT_V(6); PG8_BAR;
    }
    for (;;) {
        const bool has_next = S.next(ui + 1, nxt);
        const char* nA = has_next ? (const char*)g.A + nxt.kofs + (size_t)nxt.pm * tstep : cA; const char* nB = has_next ? (const char*)g.Bt + nxt.bofs + nxt.kofs + (size_t)nxt.pn * tstep : cB;
#pragma clang loop unroll(disable)
        for (int t = 0; t < nt; t += 2) {
            const bool last = (t == nt - 2);
            const char* a1 = cA + (size_t)(t + 1) * kstep;
            const char* a2 = last ? nA : cA + (size_t)(t + 2) * kstep; const char* b2 = last ? nB : cB + (size_t)(t + 2) * kstep;
            const char* a3 = a2 + kstep; const char* b3 = b2 + kstep;
            if (last && has_next) S.a_ready(nxt);
            if constexpr (SP2) {
            PG8_LDB(B0, B08, 0, 0); PG8_LDB(B1, B18, 0, 1); PG8_SCHED; PG8_LDA(At, At8, 0, 0); PG8_STAGE(PG8_SA(1, 1), a1 + hstep, voffA);
            PG8_WAIT_V(8); PG8_WAIT_L(0); PG8_BAR; PG8_SCHED8; PG8_MMA(0, 0, At, At8, B0, B08); PG8_MMA(0, 1, At, At8, B1, B18); PG8_SCHED8; PG8_BAR; PG8_SCHED;
            PG8_LDA(At, At8, 0, 1); PG8_STAGE(PG8_SB(0, 0), b2, voffB); PG8_STAGE(PG8_SB(0, 1), b2 + hstep, voffB); PG8_STAGE(PG8_SA(0, 0), a2, voffA);
            PG8_WAIT_V(8); PG8_WAIT_L(0); PG8_BAR; PG8_SCHED8; PG8_MMA(1, 0, At, At8, B0, B08); PG8_MMA(1, 1, At, At8, B1, B18); PG8_SCHED8; PG8_BAR; PG8_SCHED;
            PG8_LDB(B0, B08, 1, 0); PG8_LDB(B1, B18, 1, 1); PG8_SCHED; PG8_LDA(At, At8, 1, 0); PG8_STAGE(PG8_SA(0, 1), a2 + hstep, voffA);
            PG8_WAIT_V(8); PG8_WAIT_L(0); PG8_BAR; PG8_SCHED8; PG8_MMA(0, 0, At, At8, B0, B08); PG8_MMA(0, 1, At, At8, B1, B18); PG8_SCHED8; PG8_BAR; PG8_SCHED;
            PG8_LDA(At, At8, 1, 1); PG8_STAGE(PG8_SB(1, 0), b3, voffB); PG8_STAGE(PG8_SB(1, 1), b3 + hstep, voffB); PG8_STAGE(PG8_SA(1, 0), a3, voffA);
            PG8_WAIT_V(8); PG8_WAIT_L(0); PG8_BAR; PG8_SCHED8; PG8_MMA(1, 0, At, At8, B0, B08); PG8_MMA(1, 1, At, At8, B1, B18); PG8_SCHED8; PG8_BAR; PG8_SCHED;
            } else {
            PG8_LDB(B0, B08, 0, 0); PG8_SCHED; PG8_LDA(At, At8, 0, 0); PG8_STAGE(PG8_SA(1, 1), a1 + hstep, voffA);
            PG8_WAIT_L(8); PG8_BAR; PG8_WAIT_L(0); PG8_MMA(0, 0, At, At8, B0, B08); PG8_BAR; PG8_SCHED;
            PG8_LDB(B1, B18, 0, 1); PG8_STAGE(PG8_SB(0, 0), b2, voffB);
            PG8_BAR; PG8_WAIT_L(0); PG8_MMA(0, 1, At, At8, B1, B18); PG8_BAR;
            PG8_LDA(At, At8, 0, 1); PG8_STAGE(PG8_SA(0, 0), a2, voffA);
            PG8_BAR; PG8_WAIT_L(0); PG8_MMA(1, 0, At, At8, B0, B08); PG8_BAR; PG8_SCHED;
            PG8_STAGE(PG8_SB(0, 1), b2 + hstep, voffB);
            PG8_WAIT_V(6); PG8_BAR; PG8_MMA(1, 1, At, At8, B1, B18); PG8_BAR;
            PG8_LDB(B0, B08, 1, 0); PG8_SCHED; PG8_LDA(At, At8, 1, 0); PG8_STAGE(PG8_SA(0, 1), a2 + hstep, voffA);
            PG8_WAIT_L(8); PG8_BAR; PG8_WAIT_L(0); PG8_MMA(0, 0, At, At8, B0, B08); PG8_BAR; PG8_SCHED;
            PG8_LDB(B1, B18, 1, 1); PG8_STAGE(PG8_SB(1, 0), b3, voffB);
            PG8_BAR; PG8_WAIT_L(0); PG8_MMA(0, 1, At, At8, B1, B18); PG8_BAR;
            PG8_LDA(At, At8, 1, 1); PG8_STAGE(PG8_SA(1, 0), a3, voffA);
            PG8_BAR; PG8_WAIT_L(0); PG8_MMA(1, 0, At, At8, B0, B08); PG8_BAR; PG8_SCHED;
            PG8_STAGE(PG8_SB(1, 1), b3 + hstep, voffB);
            PG8_WAIT_V(6); PG8_BAR; PG8_MMA(1, 1, At, At8, B1, B18); PG8_BAR;
            }
        }
        if constexpr (ALIGN_EPI) { if (wr == 0) PG8_BAR; }
        if constexpr (F8) asm volatile("s_nop 15\n\ts_nop 15" ::: "memory");
        if constexpr (!Epi::AFTER_DRAIN) { E(acc, cur, wr, wc, fr, fq); S.done(cur); }
        if (!has_next) break;
#pragma unroll
        for (int a = 0; a < 2; ++a)
#pragma unroll
            for (int b = 0; b < 2; ++b)
#pragma unroll
                for (int m = 0; m < 4; ++m)
#pragma unroll
                    for (int n = 0; n < 2; ++n) acc[a][b][m][n] = (f32x4){zero_, zero_, zero_, zero_};
        cur = nxt; cA = nA; cB = nB; ++ui;
        if constexpr (ALIGN_EPI) { if (wr == 1) PG8_BAR; }
    }
    PG8_WAIT_V(0);
    if constexpr (!ALIGN_EPI) { if (wr == 0) PG8_BAR; }
    PG8_BAR;
    if constexpr (Epi::AFTER_DRAIN) { E.fused(acc, cur, wr, wc, fr, fq, lds, wid, lane); S.done(cur); }
#undef PG8_SA
#undef PG8_SB
#undef PG8_STAGE
#undef PG8_LDA
#undef PG8_LDB
#undef PG8_MMA
#undef PG8_LD8
#undef PG8_WAIT_V
#undef PG8_WAIT_L
#undef PG8_BAR
#undef PG8_SCHED
#undef PG8_SCHED8
}

}

#define GAS __attribute__((address_space(1)))
#define LAS __attribute__((address_space(3)))
typedef unsigned v4u __attribute__((ext_vector_type(4)));
typedef float f32x4 __attribute__((ext_vector_type(4)));
#define LDS_WAIT() asm volatile("s_waitcnt lgkmcnt(0)" ::: "memory")
#define VM_WAIT() asm volatile("s_waitcnt vmcnt(0)" ::: "memory")

#define XB_TMO      128
#define XB_XCNT(j)  (256  + 64 * (j))
#define XB_XSUB(j)  (1280 + 64 * (j))
#define XB_XGEN(j)  (2304 + 64 * (j))
#define XB_TOP      3328
#define XB_TOPGEN   3392
#define XCD_BAR_WORDS 3456
#define XB_SPIN_CAP (1u << 18)

__device__ __forceinline__ unsigned xb_ld(unsigned* p)              { return __hip_atomic_load(p, __ATOMIC_RELAXED, __HIP_MEMORY_SCOPE_AGENT); }
__device__ __forceinline__ unsigned xb_add(unsigned* p, unsigned v) { return __hip_atomic_fetch_add(p, v, __ATOMIC_RELAXED, __HIP_MEMORY_SCOPE_AGENT); }
__device__ __forceinline__ unsigned xb_xcc_id() { return (unsigned)__builtin_amdgcn_s_getreg((3 << 11) | 20) & 0xFu; }
#define XB_SPIN(cond, bar) do { unsigned _sp = 0; while (cond) { __builtin_amdgcn_s_sleep(1); \
    if ((++_sp & 255u) == 0u) { if (xb_ld(&(bar)[XB_TMO])) break; if (_sp > XB_SPIN_CAP) { atomicAdd(&(bar)[XB_TMO], 1u); break; } } } } while (0)

struct XcdBarrier {
    unsigned* bar; unsigned x;
    volatile LAS unsigned* st;
};

__device__ __forceinline__ XcdBarrier xcd_barrier_post(unsigned* bar, volatile LAS unsigned* st, bool t0) {
    XcdBarrier b; b.bar = bar; b.x = xb_xcc_id(); b.st = st;
    if (t0) (void)xb_add(&bar[XB_XCNT(b.x)], 1u);
    return b;
}
__device__ __forceinline__ void xcd_barrier_complete(unsigned* bar, unsigned x, unsigned& nloc, unsigned& nx) {
    const unsigned G = gridDim.x * gridDim.y * gridDim.z;
    unsigned sum, cnt, mine, sp = 0u;
    for (;;) {
        sum = 0u; cnt = 0u; mine = 0u;
#pragma unroll
        for (unsigned j = 0; j < 16; ++j) { const unsigned c = xb_ld(&bar[XB_XCNT(j)]); sum += c; cnt += (c > 0u) ? 1u : 0u; mine = (j == x) ? c : mine; }
        if (sum == G) break;
        __builtin_amdgcn_s_sleep(1);
        if ((++sp & 255u) == 0u) { if (xb_ld(&bar[XB_TMO])) break; if (sp > XB_SPIN_CAP) { atomicAdd(&bar[XB_TMO], 1u); break; } }
    }
    nloc = mine > 0u ? mine : 1u; nx = cnt > 0u ? cnt : 1u;
}

__device__ __forceinline__ void xcd_barrier(const XcdBarrier& b, bool t0) {
    asm volatile("s_waitcnt vmcnt(0)" ::: "memory");
    __syncthreads();
    if (t0) {
        unsigned* bar = b.bar;
        __builtin_amdgcn_s_waitcnt(0);
        unsigned nloc = b.st[0], nx = b.st[1];
        if (nloc == 0u) { xcd_barrier_complete(bar, b.x, nloc, nx); b.st[0] = nloc; b.st[1] = nx; }
        const unsigned old = xb_add(&bar[XB_XSUB(b.x)], 1u);
        const unsigned gen = old / nloc;
        if (old + 1u == (gen + 1u) * nloc) {
            __builtin_amdgcn_fence(__ATOMIC_RELEASE, "agent");
            asm volatile("s_waitcnt vmcnt(0)" ::: "memory");
            const unsigned og = xb_add(&bar[XB_TOP], 1u);
            const unsigned tg = og / nx;
            if (og + 1u == (tg + 1u) * nx) xb_add(&bar[XB_TOPGEN], 1u);
            else XB_SPIN(xb_ld(&bar[XB_TOPGEN]) == tg, bar);
            __builtin_amdgcn_fence(__ATOMIC_ACQUIRE, "agent");
            xb_add(&bar[XB_XGEN(b.x)], 1u);
            asm volatile("s_waitcnt vmcnt(0)" ::: "memory");
        } else {
            XB_SPIN(xb_ld(&bar[XB_XGEN(b.x)]) == gen, bar);
            __builtin_amdgcn_fence(__ATOMIC_ACQUIRE, "agent");
            asm volatile("s_waitcnt vmcnt(0)" ::: "memory");
        }
    }
    __syncthreads();
}

struct XcdToken { unsigned gen, tg; int role; };
__device__ __forceinline__ XcdToken xcd_barrier_arrive(const XcdBarrier& b, bool t0) {
    XcdToken k; k.gen = 0u; k.tg = 0u; k.role = 0;
    asm volatile("s_waitcnt vmcnt(0)" ::: "memory");
    __syncthreads();
    if (t0) {
        unsigned* bar = b.bar;
        __builtin_amdgcn_s_waitcnt(0);
        unsigned nloc = b.st[0], nx = b.st[1];
        if (nloc == 0u) { xcd_barrier_complete(bar, b.x, nloc, nx); b.st[0] = nloc; b.st[1] = nx; }
        const unsigned old = xb_add(&bar[XB_XSUB(b.x)], 1u);
        k.gen = old / nloc;
        if (old + 1u == (k.gen + 1u) * nloc) {
            __builtin_amdgcn_fence(__ATOMIC_RELEASE, "agent");
            asm volatile("s_waitcnt vmcnt(0)" ::: "memory");
            const unsigned og = xb_add(&bar[XB_TOP], 1u);
            k.tg = og / nx;
            if (og + 1u == (k.tg + 1u) * nx) { xb_add(&bar[XB_TOPGEN], 1u); k.role = 2; } else k.role = 1;
        }
    }
    return k;
}
__device__ __forceinline__ void xcd_barrier_wait(const XcdBarrier& b, const XcdToken& k, bool t0) {
    if (t0) {
        unsigned* bar = b.bar;
        if (k.role) {
            if (k.role == 1) XB_SPIN(xb_ld(&bar[XB_TOPGEN]) == k.tg, bar);
            __builtin_amdgcn_fence(__ATOMIC_ACQUIRE, "agent");
            xb_add(&bar[XB_XGEN(b.x)], 1u);
            asm volatile("s_waitcnt vmcnt(0)" ::: "memory");
        } else {
            XB_SPIN(xb_ld(&bar[XB_XGEN(b.x)]) == k.gen, bar);
            __builtin_amdgcn_fence(__ATOMIC_ACQUIRE, "agent");
            asm volatile("s_waitcnt vmcnt(0)" ::: "memory");
        }
    }
    __syncthreads();
}

constexpr int RING_OFF = 0, RING_BYTES = 131072;
constexpr int MISC_OFF = 143360;
constexpr int LDS_BYTES = 147456;
constexpr int NWAVES = 8;

struct Ctx { LAS unsigned char* lds; volatile LAS unsigned* MISC; unsigned* ctl; int wave, G, gw, NGW; };

__device__ __forceinline__ void cvt_item(const float* W, int K, int N, bf16_t* WT, int mode, LAS float* scr, int item, int lane) {
    const int kblk = K / 64, nb = item / kblk, kb = item % kblk, k0 = 64 * kb, n0 = 64 * nb;
    f32x4 ld[16];
#pragma unroll
    for (int i = 0; i < 16; ++i) { const int kk = 4 * i + (lane >> 4), c4 = 4 * (lane & 15); ld[i] = __builtin_nontemporal_load((const f32x4*)(W + (size_t)(k0 + kk) * N + n0 + c4));     }
#pragma unroll
    for (int i = 0; i < 16; ++i) { const int kk = 4 * i + (lane >> 4), c4 = 4 * (lane & 15);
        LAS float* s = scr + kk * 65 + c4; s[0] = ld[i][0]; s[1] = ld[i][1]; s[2] = ld[i][2]; s[3] = ld[i][3]; }
    LDS_WAIT(); asm volatile("" ::: "memory");
    const int c = lane >> 3;
#pragma unroll
    for (int j = 0; j < 8; ++j) { const int n = (lane & 7) + 8 * j; const LAS float* s = scr + (8 * c) * 65 + n;
        v4u o; o.x = pk2(s[0 * 65], s[1 * 65]); o.y = pk2(s[2 * 65], s[3 * 65]); o.z = pk2(s[4 * 65], s[5 * 65]); o.w = pk2(s[6 * 65], s[7 * 65]);
        const int nn = n0 + n; const int drow = mode == 0 ? nn : (nn / 128) * 256 + (mode - 1) * 128 + (nn % 128);
        *(v4u*)(WT + (size_t)drow * K + k0 + 8 * c) = o; }
    LDS_WAIT(); asm volatile("" ::: "memory");
}
__device__ __forceinline__ void cvt_item8(const float* W, int K, int N, unsigned char* WT, int mode, LAS float* scr, int item, int lane) {
    const int kblk = K / 64, nb = item / kblk, kb = item % kblk, k0 = 64 * kb, n0 = 64 * nb;
    f32x4 ld[16];
#pragma unroll
    for (int i = 0; i < 16; ++i) { const int kk = 4 * i + (lane >> 4), c4 = 4 * (lane & 15); ld[i] = __builtin_nontemporal_load((const f32x4*)(W + (size_t)(k0 + kk) * N + n0 + c4));     }
#pragma unroll
    for (int i = 0; i < 16; ++i) { const int kk = 4 * i + (lane >> 4), c4 = 4 * (lane & 15);
        LAS float* s = scr + kk * 65 + c4; s[0] = ld[i][0]; s[1] = ld[i][1]; s[2] = ld[i][2]; s[3] = ld[i][3]; }
    LDS_WAIT(); asm volatile("" ::: "memory");
    const int c = lane >> 3;
#pragma unroll
    for (int j = 0; j < 8; ++j) { const int n = (lane & 7) + 8 * j; const LAS float* s = scr + (8 * c) * 65 + n;
        v2u o; o.x = pk4_fp8(s[0 * 65] * W8_SCALE, s[1 * 65] * W8_SCALE, s[2 * 65] * W8_SCALE, s[3 * 65] * W8_SCALE); o.y = pk4_fp8(s[4 * 65] * W8_SCALE, s[5 * 65] * W8_SCALE, s[6 * 65] * W8_SCALE, s[7 * 65] * W8_SCALE);
        const int nn = n0 + n; const int drow = mode == 0 ? nn : (nn / 128) * 256 + (mode - 1) * 128 + (nn % 128);
        *(v2u*)(WT + (size_t)drow * K + k0 + 8 * c) = o; }
    LDS_WAIT(); asm volatile("" ::: "memory");
}
constexpr int MOE_S_F = 16 * 44, MOE_ITEMS = 24 * MOE_S_F;
__device__ __forceinline__ void moe_cvt_item(const Params& p, int r, LAS float* scr, int lane_) {
    constexpr int S_F = MOE_S_F;
    if (r < 8 * S_F) { const int e = r / S_F; cvt_item8(p.in[I_MWG] + (size_t)e * DM * DFF, DM, DFF, (unsigned char*)(p.ws + W_MGU) + (size_t)e * 2 * DFF * DM, 1, scr, r % S_F, lane_); return; } r -= 8 * S_F;
    if (r < 8 * S_F) { const int e = r / S_F; cvt_item8(p.in[I_MWU] + (size_t)e * DM * DFF, DM, DFF, (unsigned char*)(p.ws + W_MGU) + (size_t)e * 2 * DFF * DM, 2, scr, r % S_F, lane_); return; } r -= 8 * S_F;
    { const int e = r / S_F; cvt_item8(p.in[I_MWD] + (size_t)e * DFF * DM, DFF, DM, (unsigned char*)(p.ws + W_MD) + (size_t)e * DM * DFF, 0, scr, r % S_F, lane_); }
}
#if SEAM_CVT
constexpr int SEAM_CVT_SEAMS = 17;
__device__ __forceinline__ void seam_fill(const Params& p, Ctx& F, int s) {
    if (s >= SEAM_CVT_SEAMS || (F.wave & 1) != (s & 1)) return;
    const int it = s * (F.G * 4) + (int)blockIdx.x * 4 + (F.wave >> 1);
    if (it < MOE_ITEMS) moe_cvt_item(p, it, (LAS float*)(F.lds + RING_OFF) + F.wave * (64 * 65), lane_id());
}
__device__ __forceinline__ void moe_cvt_rest(const Params& p, Ctx& F) {
    for (int it = SEAM_CVT_SEAMS * (F.G * 4) + F.gw; it < MOE_ITEMS; it += F.NGW) moe_cvt_item(p, it, (LAS float*)(F.lds + RING_OFF) + F.wave * (64 * 65), lane_id());
}
#endif
__device__ __forceinline__ void p0_prologue(const Params& p, Ctx& F) {
    const int lane_ = lane_id(), tid_ = F.wave * 64 + lane_;
    LAS float* fl = (LAS float*)(F.lds + RING_OFF);
    for (int it = blockIdx.x; it < 192; it += F.G) {
        const int l = it / 96, n = (it % 96) * 64 + lane_;
        LAS float* sv = fl;
        LAS float* red = fl + 3 * 1024;
        for (int i = tid_; i < 3 * 1024; i += 512) { const int rt = i >> 10, k = i & 1023; const float v = rt < 2 ? p.in[I_C][rt * DM + k] : p.in[I_CCTX][k]; sv[i] = siluf(v); }
        __syncthreads();
        const float* W = p.in[I_ADAW] + (size_t)l * DM * 6144 + n;
        float a0 = 0.f, a1 = 0.f, a2 = 0.f;
        for (int kb = 0; kb < 128; kb += 32) {
            float wv[32];
#pragma unroll
            for (int j = 0; j < 32; ++j) wv[j] = W[(size_t)(F.wave * 128 + kb + j) * 6144];
#pragma unroll
            for (int j = 0; j < 32; ++j) { const int k = F.wave * 128 + kb + j; a0 += sv[k] * wv[j]; a1 += sv[1024 + k] * wv[j]; a2 += sv[2048 + k] * wv[j]; }
        }
        red[(F.wave * 3 + 0) * 64 + lane_] = a0; red[(F.wave * 3 + 1) * 64 + lane_] = a1; red[(F.wave * 3 + 2) * 64 + lane_] = a2;
        __syncthreads();
        if (tid_ < 192) { const int rt = tid_ >> 6, ln = tid_ & 63; float s = 0.f;
#pragma unroll
            for (int w = 0; w < 8; ++w) s += red[(w * 3 + rt) * 64 + ln];
            const int nn = (it % 96) * 64 + ln;
            ((float*)(p.ws + WS_MODV))[(size_t)(l * 3 + rt) * 6144 + nn] = s + p.in[I_ADAB][l * 6144 + nn]; }
        __syncthreads();
    }
    LAS float* scr = (LAS float*)(F.lds + RING_OFF) + F.wave * (64 * 65);
    constexpr int S_WIN = 16 * 56, S_WOUT = 16 * 16, S_F = 16 * 44;
    constexpr int NITEMS = 2 * S_WIN + 2 * S_WOUT + 3 * S_F + (SEAM_CVT ? 0 : 24 * S_F);
    static_assert(NITEMS + (SEAM_CVT ? 24 * S_F : 0) == 21312, "items");
    for (int it = F.gw; it < NITEMS; it += F.NGW) {
        int r = it;
        if (r < 2 * S_WIN) { const int l = r / S_WIN; cvt_item(p.in[I_WIN] + (size_t)l * DM * DP, DM, DP, (bf16_t*)(p.ws + W_WIN) + (size_t)l * DP * DM, 0, scr, r % S_WIN, lane_); continue; } r -= 2 * S_WIN;
        if (r < 2 * S_WOUT) { const int l = r / S_WOUT; cvt_item(p.in[I_WOUT] + (size_t)l * DM * DM, DM, DM, (bf16_t*)(p.ws + W_WOUT) + (size_t)l * DM * DM, 0, scr, r % S_WOUT, lane_); continue; } r -= 2 * S_WOUT;
        if (r < S_F) { cvt_item(p.in[I_FWG], DM, DFF, (bf16_t*)(p.ws + W_FGU), 1, scr, r, lane_); continue; } r -= S_F;
        if (r < S_F) { cvt_item(p.in[I_FWU], DM, DFF, (bf16_t*)(p.ws + W_FGU), 2, scr, r, lane_); continue; } r -= S_F;
        if (r < S_F) { cvt_item(p.in[I_FWD], DFF, DM, (bf16_t*)(p.ws + W_FD), 0, scr, r, lane_); continue; } r -= S_F;
        moe_cvt_item(p, r, scr, lane_);
    }
}

__device__ __forceinline__ void norm_phase(const Params& p, Ctx& F, int l, int which, int nrows) {
    const int lane_ = lane_id(), tid_ = F.wave * 64 + lane_;
    const float* g = p.in[which ? I_N2G : I_N1G] + l * DM;
    for (int m = F.gw; m < nrows; m += F.NGW) {
        const float* xrow;
        if (l == 0 && which == 0) xrow = m < NL ? p.in[I_X] + (size_t)m * DM : p.in[I_CTX] + (size_t)(m - NL) * DM;
        else xrow = xr_row(p, m);
        const int rt = rowtype(m);
        const float* sh = modv(p, l, rt, which ? 3 : 0); const float* sc = modv(p, l, rt, which ? 4 : 1);
        f32x4 v[4]; float ss = 0.f;
        if (m >= NL && !(l == 0 && which == 0)) {
            const int nsl = which ? DM / 256 : DFF / 256; const float* gate = modv(p, 0, 2, which ? 2 : 5);
            const float* base = (l == 0) ? p.in[I_CTX] + (size_t)(m - NL) * DM : xrow;
            const float* part = (const float*)(p.ws + WS_PART) + (size_t)(m - NL) * DM;
#pragma unroll
            for (int j = 0; j < 4; ++j) { const int col = 256 * j + 4 * lane_; f32x4 a = {0.f, 0.f, 0.f, 0.f};
                for (int sl = 0; sl < nsl; ++sl) a += *(const f32x4*)(part + (size_t)sl * NC * DM + col);
                v[j] = *(const f32x4*)(base + col) + *(const f32x4*)(gate + col) * a;
                *(f32x4*)((float*)(p.ws + WS_XRC) + (size_t)(m - NL) * DM + col) = v[j];
                ss += (v[j][0] * v[j][0] + v[j][1] * v[j][1]) + (v[j][2] * v[j][2] + v[j][3] * v[j][3]); }
        } else
#pragma unroll
        for (int j = 0; j < 4; ++j) { v[j] = *(const f32x4*)(xrow + 256 * j + 4 * lane_); ss += (v[j][0] * v[j][0] + v[j][1] * v[j][1]) + (v[j][2] * v[j][2] + v[j][3] * v[j][3]); }
        const float r = rsqrtf(wave_sum(ss) * (1.f / DM) + EPS);
        bf16_t* hb = (bf16_t*)(p.ws + WS_HBUF) + (size_t)m * DM;
#pragma unroll
        for (int j = 0; j < 4; ++j) { const int col = 256 * j + 4 * lane_;
            const f32x4 gg = *(const f32x4*)(g + col), s4 = *(const f32x4*)(sc + col), h4 = *(const f32x4*)(sh + col);
            const f32x4 y = v[j] * r * gg * (1.f + s4) + h4;
            v2u o; o.x = pk2(y[0], y[1]); o.y = pk2(y[2], y[3]); *(v2u*)(hb + col) = o; }
    }
}


__device__ __forceinline__ void router_phase(const Params& p, Ctx& F) {
    const int lane_ = lane_id(), tid_ = F.wave * 64 + lane_;
    LAS int* lcnt = (LAS int*)(F.lds + RING_OFF);
    LAS int* gbase = lcnt + 8;
    LAS int* ent_e = lcnt + 16;
    LAS int* ent_pos = lcnt + 16 + 128;
    const float* g = p.in[I_N2G] + DM; const float* rw = p.in[I_RW];
    int* tok_e = (int*)(p.ws + WS_ROUTE); float* tok_w = (float*)(p.ws + WS_ROUTE) + 2 * NL; int* tok_pos = (int*)(p.ws + WS_ROUTE) + 4 * NL;
    f32x4 rwa[4][4], rwb[4][4];
#pragma unroll
    for (int j = 0; j < 4; ++j)
#pragma unroll
        for (int q = 0; q < 4; ++q) { const int col = 256 * j + 4 * lane_ + q; rwa[j][q] = *(const f32x4*)(rw + (size_t)col * 8); rwb[j][q] = *(const f32x4*)(rw + (size_t)col * 8 + 4); }
    const int myexp = ((lane_ >> 5) & 1) * 4 + ((lane_ >> 4) & 1) * 2 + ((lane_ >> 3) & 1);
    for (int ch = blockIdx.x; ch < NL / 64; ch += F.G) {
        if (tid_ < 8) lcnt[tid_] = 0;
        __syncthreads();
        const int rt = (ch * 64) / T;
        const float* sh = modv(p, 1, rt, 3); const float* sc = modv(p, 1, rt, 4);
        f32x4 gs[4], hs[4]; float bsum;
        { float bb[8] = {0.f, 0.f, 0.f, 0.f, 0.f, 0.f, 0.f, 0.f};
#pragma unroll
          for (int j = 0; j < 4; ++j) { const int col = 256 * j + 4 * lane_; gs[j] = *(const f32x4*)(g + col) * (1.f + *(const f32x4*)(sc + col)); hs[j] = *(const f32x4*)(sh + col);
#pragma unroll
            for (int q = 0; q < 4; ++q) { bb[0] += hs[j][q] * rwa[j][q][0]; bb[1] += hs[j][q] * rwa[j][q][1]; bb[2] += hs[j][q] * rwa[j][q][2]; bb[3] += hs[j][q] * rwa[j][q][3];
                                          bb[4] += hs[j][q] * rwb[j][q][0]; bb[5] += hs[j][q] * rwb[j][q][1]; bb[6] += hs[j][q] * rwb[j][q][2]; bb[7] += hs[j][q] * rwb[j][q][3]; } }
          float c4[4];
#pragma unroll
          for (int k = 0; k < 4; ++k) { const float keep = (lane_ & 32) ? bb[k + 4] : bb[k], give = (lane_ & 32) ? bb[k] : bb[k + 4]; c4[k] = keep + __shfl_xor(give, 32); }
          float c2[2];
#pragma unroll
          for (int k = 0; k < 2; ++k) { const float keep = (lane_ & 16) ? c4[k + 2] : c4[k], give = (lane_ & 16) ? c4[k] : c4[k + 2]; c2[k] = keep + __shfl_xor(give, 16); }
          float c1 = ((lane_ & 8) ? c2[1] : c2[0]) + __shfl_xor((lane_ & 8) ? c2[0] : c2[1], 8);
          c1 += __shfl_xor(c1, 4); c1 += __shfl_xor(c1, 2); c1 += __shfl_xor(c1, 1);
          bsum = c1 + p.in[I_RB][myexp]; }
        for (int i = 0; i < 8; ++i) {
            const int ti = F.wave * 8 + i, m = ch * 64 + ti;
            const float* xrow = p.out + (size_t)m * DM;
            f32x4 v[4]; float ss = 0.f; float aa[8] = {0.f, 0.f, 0.f, 0.f, 0.f, 0.f, 0.f, 0.f};
#pragma unroll
            for (int j = 0; j < 4; ++j) { v[j] = *(const f32x4*)(xrow + 256 * j + 4 * lane_); ss += (v[j][0] * v[j][0] + v[j][1] * v[j][1]) + (v[j][2] * v[j][2] + v[j][3] * v[j][3]); }
#pragma unroll
            for (int j = 0; j < 4; ++j) { v[j] = v[j] * gs[j];
#pragma unroll
                for (int q = 0; q < 4; ++q) { aa[0] += v[j][q] * rwa[j][q][0]; aa[1] += v[j][q] * rwa[j][q][1]; aa[2] += v[j][q] * rwa[j][q][2]; aa[3] += v[j][q] * rwa[j][q][3];
                                              aa[4] += v[j][q] * rwb[j][q][0]; aa[5] += v[j][q] * rwb[j][q][1]; aa[6] += v[j][q] * rwb[j][q][2]; aa[7] += v[j][q] * rwb[j][q][3]; } }
            float c4[4];
#pragma unroll
            for (int k = 0; k < 4; ++k) { const float keep = (lane_ & 32) ? aa[k + 4] : aa[k], give = (lane_ & 32) ? aa[k] : aa[k + 4]; c4[k] = keep + __shfl_xor(give, 32); }
            float c2[2];
#pragma unroll
            for (int k = 0; k < 2; ++k) { const float keep = (lane_ & 16) ? c4[k + 2] : c4[k], give = (lane_ & 16) ? c4[k] : c4[k + 2]; c2[k] = keep + __shfl_xor(give, 16); }
            float c1 = ((lane_ & 8) ? c2[1] : c2[0]) + __shfl_xor((lane_ & 8) ? c2[0] : c2[1], 8);
            c1 += __shfl_xor(c1, 4); c1 += __shfl_xor(c1, 2); c1 += __shfl_xor(c1, 1);
            const float r = rsqrtf(wave_sum(ss) * (1.f / DM) + EPS);
            const float mylogit = r * c1 + bsum;
#define RLF(L) __uint_as_float((unsigned)__builtin_amdgcn_readlane((int)__float_as_uint(mylogit), L))
            const float lg0 = RLF(0), lg1 = RLF(8), lg2 = RLF(16), lg3 = RLF(24), lg4 = RLF(32), lg5 = RLF(40), lg6 = RLF(48), lg7 = RLF(56);
#undef RLF
            unsigned char* hb = (unsigned char*)(p.ws + WS_HBUF) + (size_t)m * DM;
#pragma unroll
            for (int j = 0; j < 4; ++j) { const f32x4 y = v[j] * r + hs[j]; *(unsigned*)(hb + 256 * j + 4 * lane_) = pk4_fp8(y[0], y[1], y[2], y[3]); }
            int i1 = 0; float v1 = lg0;
            if (lg1 > v1) { v1 = lg1; i1 = 1; } if (lg2 > v1) { v1 = lg2; i1 = 2; } if (lg3 > v1) { v1 = lg3; i1 = 3; }
            if (lg4 > v1) { v1 = lg4; i1 = 4; } if (lg5 > v1) { v1 = lg5; i1 = 5; } if (lg6 > v1) { v1 = lg6; i1 = 6; } if (lg7 > v1) { v1 = lg7; i1 = 7; }
            int i2 = -1; float v2 = -3.4e38f;
            if (i1 != 0 && lg0 > v2) { v2 = lg0; i2 = 0; } if (i1 != 1 && lg1 > v2) { v2 = lg1; i2 = 1; } if (i1 != 2 && lg2 > v2) { v2 = lg2; i2 = 2; } if (i1 != 3 && lg3 > v2) { v2 = lg3; i2 = 3; }
            if (i1 != 4 && lg4 > v2) { v2 = lg4; i2 = 4; } if (i1 != 5 && lg5 > v2) { v2 = lg5; i2 = 5; } if (i1 != 6 && lg6 > v2) { v2 = lg6; i2 = 6; } if (i1 != 7 && lg7 > v2) { v2 = lg7; i2 = 7; }
            const float w1 = 1.f / (1.f + __expf(v2 - v1));
            if (lane_ == 0) {
                const int p1 = __hip_atomic_fetch_add(lcnt + i1, 1, __ATOMIC_RELAXED, __HIP_MEMORY_SCOPE_WORKGROUP);
                const int p2 = __hip_atomic_fetch_add(lcnt + i2, 1, __ATOMIC_RELAXED, __HIP_MEMORY_SCOPE_WORKGROUP);
                ent_e[2 * ti] = i1; ent_e[2 * ti + 1] = i2; ent_pos[2 * ti] = p1; ent_pos[2 * ti + 1] = p2;
                tok_e[2 * m] = i1; tok_e[2 * m + 1] = i2; tok_w[2 * m] = w1; tok_w[2 * m + 1] = 1.f - w1; }
        }
        __syncthreads();
        if (tid_ < 8) gbase[tid_] = (int)__hip_atomic_fetch_add(F.ctl + CW_CNT + 64 * tid_, (unsigned)lcnt[tid_], __ATOMIC_RELAXED, __HIP_MEMORY_SCOPE_AGENT);
        __syncthreads();
        if (tid_ < 128) tok_pos[ch * 128 + tid_] = gbase[ent_e[tid_]] + ent_pos[tid_];
        __syncthreads();
    }
}
__device__ __forceinline__ void moe_table(Ctx& F) {
    const int lane_ = lane_id(), tid_ = F.wave * 64 + lane_;
    volatile LAS unsigned* tb = F.MISC + 32;
    if (tid_ == 0) { unsigned acc = 0;
        for (int e = 0; e < 8; ++e) { const unsigned c = __hip_atomic_load(F.ctl + CW_CNT + 64 * e, __ATOMIC_RELAXED, __HIP_MEMORY_SCOPE_AGENT); tb[e] = acc; tb[16 + e] = c; acc += (c + 255u) / 256u * 256u; }
        tb[8] = acc; }
    __syncthreads();
}
__device__ __forceinline__ void moe_order(Ctx& F, pg8::Order& S, int nN, long estride) {
    volatile LAS unsigned* tb = F.MISC + 32;
#define RFL(x) __builtin_amdgcn_readfirstlane((int)(x))
    S.init(RFL(tb[8] / 256u), nN, F.G, (int)blockIdx.x);
    S.e1 = RFL(tb[1] / 256u); S.e2 = RFL(tb[2] / 256u); S.e3 = RFL(tb[3] / 256u); S.e4 = RFL(tb[4] / 256u); S.e5 = RFL(tb[5] / 256u); S.e6 = RFL(tb[6] / 256u); S.e7 = RFL(tb[7] / 256u);
#undef RFL
    S.estride = estride;
}
__device__ __forceinline__ void gather_phase(const Params& p, Ctx& F) {
    const int lane_ = lane_id(), tid_ = F.wave * 64 + lane_;
    moe_table(F);
    volatile LAS unsigned* tb = F.MISC + 32;
    const int* tok_e = (const int*)(p.ws + WS_ROUTE); const float* tok_w = (const float*)(p.ws + WS_ROUTE) + 2 * NL; const int* tok_pos = (const int*)(p.ws + WS_ROUTE) + 4 * NL;
    int* row_tok = (int*)(p.ws + WS_ROUTE) + 6 * NL; float* row_gate = (float*)(p.ws + WS_ROUTE) + 6 * NL + MP_MAX;
    const unsigned char* hb = (const unsigned char*)(p.ws + WS_HBUF); unsigned char* h2s = (unsigned char*)(p.ws + WS_H2S);
    for (int it = F.gw; it < 2 * NL; it += F.NGW) {
        const int t = it >> 1, e = tok_e[it], r = (int)tb[e] + tok_pos[it];
        *((v4u*)(h2s + (size_t)r * DM) + lane_) = *((const v4u*)(hb + (size_t)t * DM) + lane_);
        if (lane_ == 0) { row_tok[r] = t; row_gate[r] = tok_w[it]; }
    }
    for (int i = F.gw; i < NE * 256; i += F.NGW) {
        const int e = i >> 8, j = i & 255, r = (int)tb[e] + (int)tb[16 + e] + j;
        if (r < (int)tb[e + 1]) { const v4u z = {0u, 0u, 0u, 0u}; *((v4u*)(h2s + (size_t)r * DM) + lane_) = z; if (lane_ == 0) { row_tok[r] = -1; row_gate[r] = 0.f; } }
    }
}
__device__ __forceinline__ void combine_phase(const Params& p, Ctx& F) {
    const int lane_ = lane_id(), tid_ = F.wave * 64 + lane_;
    moe_table(F);
    volatile LAS unsigned* tb = F.MISC + 32;
    const int* tok_e = (const int*)(p.ws + WS_ROUTE); const int* tok_pos = (const int*)(p.ws + WS_ROUTE) + 4 * NL;
    const bf16_t* yb = (const bf16_t*)(p.ws + WS_YBUF);
    for (int t = F.gw; t < NL; t += F.NGW) {
        const int r0 = (int)tb[tok_e[2 * t]] + tok_pos[2 * t], r1 = (int)tb[tok_e[2 * t + 1]] + tok_pos[2 * t + 1];
        const float* g5 = modv(p, 1, t / T, 5);
        float* orow = p.out + (size_t)t * DM;
#pragma unroll
        for (int j = 0; j < 4; ++j) { const int col = 256 * j + 4 * lane_;
            const v2u a = *(const v2u*)(yb + (size_t)r0 * DM + col), b = *(const v2u*)(yb + (size_t)r1 * DM + col);
            f32x4 y; y[0] = __uint_as_float(a.x << 16) + __uint_as_float(b.x << 16); y[1] = __uint_as_float(a.x & 0xffff0000u) + __uint_as_float(b.x & 0xffff0000u);
            y[2] = __uint_as_float(a.y << 16) + __uint_as_float(b.y << 16); y[3] = __uint_as_float(a.y & 0xffff0000u) + __uint_as_float(b.y & 0xffff0000u);
            const f32x4 x = *(const f32x4*)(orow + col), gg = *(const f32x4*)(g5 + col);
            *(f32x4*)(orow + col) = x + gg * y; }
    }
}

namespace att {
#ifndef EXP_TREE
#define EXP_TREE 1
#endif
constexpr float THR = 8.f;
constexpr int KVBLK = 64;
constexpr int SHM_V = KVBLK * 128 * 2, SHM_K = KVBLK * 128 * 2;
using bf16x8 = __attribute__((ext_vector_type(8))) short;
using s16x4  = __attribute__((ext_vector_type(4))) short;
using f32x16 = __attribute__((ext_vector_type(16))) float;
using f32x8  = __attribute__((ext_vector_type(8))) float;
using u32x4  = __attribute__((ext_vector_type(4))) unsigned;
using f32x4v = __attribute__((ext_vector_type(4))) float;
#define KSWZ(row, colB) ((row) * 256 + ((colB) ^ (((row) & 7) << 4)))
#define SBAR() __builtin_amdgcn_sched_barrier(0)
__device__ __forceinline__ int crow(int r, int hi) { return (r & 3) + 8 * (r >> 2) + 4 * hi; }
__device__ __forceinline__ unsigned cvtpk(float lo, float hi) {
  unsigned r; asm volatile("v_cvt_pk_bf16_f32 %0, %1, %2" : "=v"(r) : "v"(lo), "v"(hi)); return r;
}
__device__ __forceinline__ void partialSM(f32x16& p0, f32x16& p1, float& m_reg, float& mn, float& alpha) {
  constexpr float C = 1.4426950408889634f;
  float pmax = p0[0]; for (int r = 1; r < 16; ++r) pmax = fmaxf(pmax, p0[r]); for (int r = 0; r < 16; ++r) pmax = fmaxf(pmax, p1[r]);
  { auto rr = __builtin_amdgcn_permlane32_swap(__float_as_uint(pmax), __float_as_uint(pmax), false, false);
    pmax = fmaxf(__uint_as_float(rr[0]), __uint_as_float(rr[1])); }
  if (__builtin_expect(__all(pmax - m_reg <= THR), 1)) { mn = m_reg; alpha = 1.f; }
  else { mn = fmaxf(m_reg, pmax); alpha = __builtin_amdgcn_exp2f((m_reg - mn) * C); m_reg = mn; }
  float mnC = -mn * C;
  for (int r = 0; r < 16; ++r) p0[r] = fmaf(p0[r], C, mnC); for (int r = 0; r < 16; ++r) p1[r] = fmaf(p1[r], C, mnC);
  for (int r = 0; r < 16; ++r) p0[r] = __builtin_amdgcn_exp2f(p0[r]);
}
__device__ __forceinline__ void finishSM(f32x16& p0, f32x16& p1, float alpha, float& l_reg, bf16x8& pa0, bf16x8& pa1, bf16x8& pa2, bf16x8& pa3) {
  for (int r = 0; r < 16; ++r) p1[r] = __builtin_amdgcn_exp2f(p1[r]);
  float ps = 0; for (int r = 0; r < 16; ++r) ps += p0[r]; for (int r = 0; r < 16; ++r) ps += p1[r];
  { auto rr = __builtin_amdgcn_permlane32_swap(__float_as_uint(ps), __float_as_uint(ps), false, false);
    ps = __uint_as_float(rr[0]) + __uint_as_float(rr[1]); }
  l_reg = l_reg * alpha + ps;
#define PK4(P, BASE, OUT) do { unsigned a0 = cvtpk(P[BASE + 0], P[BASE + 1]), a1 = cvtpk(P[BASE + 2], P[BASE + 3]);   \
    unsigned b0 = cvtpk(P[BASE + 4], P[BASE + 5]), b1 = cvtpk(P[BASE + 6], P[BASE + 7]);                              \
    auto r0 = __builtin_amdgcn_permlane32_swap(a0, b0, false, false); auto r1 = __builtin_amdgcn_permlane32_swap(a1, b1, false, false); \
    u32x4 w = {r0[0], r1[0], r0[1], r1[1]}; OUT = *reinterpret_cast<bf16x8*>(&w); } while (0)
  PK4(p0, 0, pa0); PK4(p0, 8, pa1); PK4(p1, 0, pa2); PK4(p1, 8, pa3);
#undef PK4
}
template <int ND0>
__device__ __forceinline__ void qkt(f32x16& p0, f32x16& p1, const LAS char* Ks, const bf16x8* qr, int r32, int hi, int dbase) {
  p0 = f32x16{}; p1 = f32x16{};
#pragma unroll
  for (int d0 = 0; d0 < ND0; ++d0) { int cb = ((dbase + d0) * 16 + hi * 8) * 2;
    bf16x8 b0 = *reinterpret_cast<const LAS bf16x8*>(Ks + KSWZ(r32, cb));
    bf16x8 b1 = *reinterpret_cast<const LAS bf16x8*>(Ks + KSWZ(32 + r32, cb));
    p0 = __builtin_amdgcn_mfma_f32_32x32x16_bf16(b0, qr[d0], p0, 0, 0, 0);
    p1 = __builtin_amdgcn_mfma_f32_32x32x16_bf16(b1, qr[d0], p1, 0, 0, 0); }
}
__device__ __forceinline__ int v_st(int k, int c) { const int kk = (k & ~0xC) | ((k & 4) << 1) | ((k & 8) >> 1); return ((kk >> 3) * 4 + (c >> 5)) * 512 + ((kk & 7) * 32 + (c & 31)) * 2; }
__device__ __forceinline__ int v_st_lin(int k, int c) { return ((k >> 3) * 4 + (c >> 5)) * 512 + ((k & 7) * 32 + (c & 31)) * 2; }
__device__ __forceinline__ int vt_off(int dv, int key) {
  const int pos = (key & ~0xC) | ((key & 4) << 1) | ((key & 8) >> 1), ch = pos >> 3;
  return dv * 128 + (((ch & 4) | ((ch & 3) ^ ((dv >> 1) & 3))) << 4) + (pos & 7) * 2;
}
__device__ __forceinline__ int v_rd_base(int lane) { return ((lane & 3) << 3) | (((lane >> 2) & 3) << 6) | (((lane >> 4) & 1) << 5) | (((lane >> 5) & 1) << 8); }
constexpr int v_rd_off(int d0, int ks, int half) { return d0 * 512 + ks * 4096 + half * 2048; }
template <int OFF> __device__ __forceinline__ s16x4 tr_read(int vb) {
  s16x4 r; asm volatile("ds_read_b64_tr_b16 %0, %1 offset:%2" : "=&v"(r) : "v"(vb), "i"(OFF) : "memory"); return r;
}
template <int D0> __device__ __forceinline__ void pv_one(f32x16& od, int vb, bf16x8 pa0, bf16x8 pa1, bf16x8 pa2, bf16x8 pa3) {
  const s16x4 l0 = tr_read<v_rd_off(D0, 0, 0)>(vb), h0 = tr_read<v_rd_off(D0, 0, 1)>(vb), l1 = tr_read<v_rd_off(D0, 1, 0)>(vb), h1 = tr_read<v_rd_off(D0, 1, 1)>(vb);
  const s16x4 l2 = tr_read<v_rd_off(D0, 2, 0)>(vb), h2 = tr_read<v_rd_off(D0, 2, 1)>(vb), l3 = tr_read<v_rd_off(D0, 3, 0)>(vb), h3 = tr_read<v_rd_off(D0, 3, 1)>(vb);
#if defined(DUMMY_TR) && DUMMY_TR
  { s16x4 dd; for (int i = 0; i < DUMMY_TR; ++i) asm volatile("ds_read_b64_tr_b16 %0, %1 offset:%2" : "=&v"(dd) : "v"(vb), "i"(v_rd_off(D0, 0, 0)) : "memory"); }
#endif
#if defined(DUMMY_MFMA) && DUMMY_MFMA
  { f32x4v dm = {0.f, 0.f, 0.f, 0.f}; for (int i = 0; i < DUMMY_MFMA; ++i) asm volatile("v_mfma_f32_16x16x32_bf16 %0, %1, %2, %0" : "+v"(dm) : "v"(pa0), "v"(pa1)); }
#endif
  asm volatile("s_waitcnt lgkmcnt(0)" ::: "memory"); SBAR();
#define PK(L, H) (bf16x8){L[0], L[1], L[2], L[3], H[0], H[1], H[2], H[3]}
  od = __builtin_amdgcn_mfma_f32_32x32x16_bf16(pa0, PK(l0, h0), od, 0, 0, 0);
  od = __builtin_amdgcn_mfma_f32_32x32x16_bf16(pa1, PK(l1, h1), od, 0, 0, 0);
  od = __builtin_amdgcn_mfma_f32_32x32x16_bf16(pa2, PK(l2, h2), od, 0, 0, 0);
  od = __builtin_amdgcn_mfma_f32_32x32x16_bf16(pa3, PK(l3, h3), od, 0, 0, 0);
#undef PK
}
__device__ __forceinline__ void pv_d0(f32x16* o, int vb, bf16x8 pa0, bf16x8 pa1, bf16x8 pa2, bf16x8 pa3) {
  pv_one<0>(o[0], vb, pa0, pa1, pa2, pa3); pv_one<1>(o[1], vb, pa0, pa1, pa2, pa3); pv_one<2>(o[2], vb, pa0, pa1, pa2, pa3); pv_one<3>(o[3], vb, pa0, pa1, pa2, pa3);
}

#ifndef DUMMY_EXP
#define DUMMY_EXP 0
#endif
#ifndef DUMMY_TR
#define DUMMY_TR 0
#endif
#ifndef DUMMY_MFMA
#define DUMMY_MFMA 0
#endif
__device__ __forceinline__ void dummy_exp(float x) { float d; for (int i = 0; i < DUMMY_EXP; ++i) asm volatile("v_exp_f32 %0, %1" : "=v"(d) : "v"(x)); }
__device__ __forceinline__ void expA(f32x16& p0) {
#pragma unroll
  for (int r = 0; r < 16; ++r) { dummy_exp(p0[r]); p0[r] = __builtin_amdgcn_exp2f(p0[r]); }
}
__device__ __forceinline__ void expB_sum_pack(f32x16& p0, f32x16& p1, float& l_reg, bf16x8& pa0, bf16x8& pa1, bf16x8& pa2, bf16x8& pa3) {
#pragma unroll
  for (int r = 0; r < 16; ++r) { dummy_exp(p1[r]); p1[r] = __builtin_amdgcn_exp2f(p1[r]); }
  float ps = 0;
#pragma unroll
  for (int r = 0; r < 16; ++r) ps += p0[r];
#pragma unroll
  for (int r = 0; r < 16; ++r) ps += p1[r];
  { auto rr = __builtin_amdgcn_permlane32_swap(__float_as_uint(ps), __float_as_uint(ps), false, false);
    ps = __uint_as_float(rr[0]) + __uint_as_float(rr[1]); }
  l_reg += ps;
#define PK4(P, BASE, OUT) do { unsigned a0 = cvtpk(P[BASE + 0], P[BASE + 1]), a1 = cvtpk(P[BASE + 2], P[BASE + 3]);   \
    unsigned b0 = cvtpk(P[BASE + 4], P[BASE + 5]), b1 = cvtpk(P[BASE + 6], P[BASE + 7]);                              \
    auto r0 = __builtin_amdgcn_permlane32_swap(a0, b0, false, false); auto r1 = __builtin_amdgcn_permlane32_swap(a1, b1, false, false); \
    u32x4 w = {r0[0], r1[0], r0[1], r1[1]}; OUT = *reinterpret_cast<bf16x8*>(&w); } while (0)
  PK4(p0, 0, pa0); PK4(p0, 8, pa1); PK4(p1, 0, pa2); PK4(p1, 8, pa3);
#undef PK4
}
__device__ __forceinline__ bf16x8 ld8(const bf16_t* p) { return *reinterpret_cast<const bf16x8*>(p); }

constexpr int TP = 132;
__device__ __forceinline__ void tile_to_rows(const f32x16 (&o)[4], LAS float* scr, int r32, int hi, float (&v)[64]) {
#pragma unroll
  for (int d0 = 0; d0 < 4; ++d0)
#pragma unroll
    for (int r = 0; r < 16; ++r) scr[crow(r, hi) * TP + 32 * d0 + r32] = o[d0][r];
  asm volatile("s_waitcnt lgkmcnt(0)" ::: "memory");
#pragma unroll
  for (int i = 0; i < 16; ++i) { const f32x4v t = *(const LAS f32x4v*)(scr + r32 * TP + 64 * hi + 4 * i); v[4 * i] = t[0]; v[4 * i + 1] = t[1]; v[4 * i + 2] = t[2]; v[4 * i + 3] = t[3]; }
}
__device__ __forceinline__ float pair_sum(float x) {
  auto rr = __builtin_amdgcn_permlane32_swap(__float_as_uint(x), __float_as_uint(x), false, false); return __uint_as_float(rr[0]) + __uint_as_float(rr[1]);
}


#define PVX_RD2(L0, H0, D0, KS) do { L0 = tr_read<v_rd_off(D0, KS, 0)>(vb); H0 = tr_read<v_rd_off(D0, KS, 1)>(vb); } while (0)
#define PVX_PK(L, H) (bf16x8){L[0], L[1], L[2], L[3], H[0], H[1], H[2], H[3]}
#define PVX_E(i) do { if (DOEXP) { pn[i] = __builtin_amdgcn_exp2f(pn[i]); psn += pn[i]; } } while (0)
#define PVX_W(n) asm volatile("s_waitcnt lgkmcnt(" #n ")" ::: "memory")
#define PVX_BLOCK(D0, E0) do { \
    PVX_W(6); SBAR(); o[D0] = __builtin_amdgcn_mfma_f32_32x32x16_bf16(pa0, PVX_PK(fl0, fh0), o[D0], 0, 0, 0); PVX_E(E0 + 0); PVX_RD2(fl0, fh0, D0 + 1, 0); SBAR(); \
    PVX_W(6); SBAR(); o[D0] = __builtin_amdgcn_mfma_f32_32x32x16_bf16(pa1, PVX_PK(fl1, fh1), o[D0], 0, 0, 0); PVX_E(E0 + 1); PVX_RD2(fl1, fh1, D0 + 1, 1); SBAR(); \
    PVX_W(6); SBAR(); o[D0] = __builtin_amdgcn_mfma_f32_32x32x16_bf16(pa2, PVX_PK(fl2, fh2), o[D0], 0, 0, 0); PVX_E(E0 + 2); PVX_RD2(fl2, fh2, D0 + 1, 2); SBAR(); \
    PVX_W(6); SBAR(); o[D0] = __builtin_amdgcn_mfma_f32_32x32x16_bf16(pa3, PVX_PK(fl3, fh3), o[D0], 0, 0, 0); PVX_E(E0 + 3); PVX_RD2(fl3, fh3, D0 + 1, 3); SBAR(); } while (0)
template <bool DOEXP>
__device__ __forceinline__ void pv_exp(f32x16* o, int vb, bf16x8 pa0, bf16x8 pa1, bf16x8 pa2, bf16x8 pa3, f32x16& pn, float& psn) {
  s16x4 fl0, fh0, fl1, fh1, fl2, fh2, fl3, fh3;
  asm volatile("s_waitcnt lgkmcnt(0)" ::: "memory");
  PVX_RD2(fl0, fh0, 0, 0); PVX_RD2(fl1, fh1, 0, 1); PVX_RD2(fl2, fh2, 0, 2); PVX_RD2(fl3, fh3, 0, 3);
  PVX_BLOCK(0, 0); PVX_BLOCK(1, 4); PVX_BLOCK(2, 8);
  PVX_W(6); SBAR(); o[3] = __builtin_amdgcn_mfma_f32_32x32x16_bf16(pa0, PVX_PK(fl0, fh0), o[3], 0, 0, 0); PVX_E(12); SBAR();
  PVX_W(4); SBAR(); o[3] = __builtin_amdgcn_mfma_f32_32x32x16_bf16(pa1, PVX_PK(fl1, fh1), o[3], 0, 0, 0); PVX_E(13); SBAR();
  PVX_W(2); SBAR(); o[3] = __builtin_amdgcn_mfma_f32_32x32x16_bf16(pa2, PVX_PK(fl2, fh2), o[3], 0, 0, 0); PVX_E(14); SBAR();
  PVX_W(0); SBAR(); o[3] = __builtin_amdgcn_mfma_f32_32x32x16_bf16(pa3, PVX_PK(fl3, fh3), o[3], 0, 0, 0); PVX_E(15); SBAR();
}
__device__ __forceinline__ void expB_sum_pack2(f32x16& p0, f32x16& p1, float ps, float& l_reg, bf16x8& pa0, bf16x8& pa1, bf16x8& pa2, bf16x8& pa3) {
#pragma unroll
  for (int r = 0; r < 16; ++r) { p1[r] = __builtin_amdgcn_exp2f(p1[r]); ps += p1[r]; }
  { auto rr = __builtin_amdgcn_permlane32_swap(__float_as_uint(ps), __float_as_uint(ps), false, false);
    ps = __uint_as_float(rr[0]) + __uint_as_float(rr[1]); }
  l_reg += ps;
#define PK4(P, BASE, OUT) do { unsigned a0 = cvtpk(P[BASE + 0], P[BASE + 1]), a1 = cvtpk(P[BASE + 2], P[BASE + 3]);   \
    unsigned b0 = cvtpk(P[BASE + 4], P[BASE + 5]), b1 = cvtpk(P[BASE + 6], P[BASE + 7]);                              \
    auto r0 = __builtin_amdgcn_permlane32_swap(a0, b0, false, false); auto r1 = __builtin_amdgcn_permlane32_swap(a1, b1, false, false); \
    u32x4 w = {r0[0], r1[0], r0[1], r1[1]}; OUT = *reinterpret_cast<bf16x8*>(&w); } while (0)
  PK4(p0, 0, pa0); PK4(p0, 8, pa1); PK4(p1, 0, pa2); PK4(p1, 8, pa3);
#undef PK4
}
__device__ __forceinline__ float exp_sum16(f32x16& p0) { float ps = 0.f;
#pragma unroll
  for (int r = 0; r < 16; ++r) { p0[r] = __builtin_amdgcn_exp2f(p0[r]); ps += p0[r]; }
  return ps; }

__device__ __forceinline__ void attn_unit(const int wid, const bf16_t* __restrict__ proj, const char* __restrict__ Kt_bh, const char* __restrict__ Vt_bh, bf16_t* __restrict__ concat, int qrow0, int NT, int h,
                                          LAS char* lds, float lam, float omli, const float* __restrict__ subln) {
  const int lane = lane_id(), tid = wid * 64 + lane, r32 = lane & 31, hi = lane >> 5, rg = wid & 3, c = wid >> 2;
  LAS char* V_lds = lds; LAS char* K_lds = lds + 4 * SHM_V;
  LAS float* li_l = (LAS float*)(lds + 4 * SHM_V + 4 * SHM_K) + wid * 64;
  float l_reg = 0; f32x16 o[4] = {}; bf16x8 qr[4];
  const bf16_t* Qw = proj + (size_t)(qrow0 + rg * 32 + r32) * DP + C_DQ + h * 128 + c * 64 + hi * 8;
#pragma unroll
  for (int d0 = 0; d0 < 4; ++d0) qr[d0] = ld8(Qw + d0 * 16);
  const int vb0 = (int)(uintptr_t)V_lds + v_rd_base(lane);
  const char* kg0 = Kt_bh + wid * 2048 + lane * 16; const char* vg0 = Vt_bh + wid * 2048 + lane * 16;
#define DMA_TILE(tile, slot) do { const size_t to_ = (size_t)(tile) * 16384; \
    __builtin_amdgcn_global_load_lds((const unsigned*)(kg0 + to_), (LAS unsigned*)(K_lds + (slot) * SHM_K + wid * 2048), 16, 0, 0); \
    __builtin_amdgcn_global_load_lds((const unsigned*)(kg0 + to_ + 1024), (LAS unsigned*)(K_lds + (slot) * SHM_K + wid * 2048 + 1024), 16, 0, 0); \
    __builtin_amdgcn_global_load_lds((const unsigned*)(vg0 + to_), (LAS unsigned*)(V_lds + (slot) * SHM_V + wid * 2048), 16, 0, 0); \
    __builtin_amdgcn_global_load_lds((const unsigned*)(vg0 + to_ + 1024), (LAS unsigned*)(V_lds + (slot) * SHM_V + wid * 2048 + 1024), 16, 0, 0); } while (0)
#define BAR() do { asm volatile("s_waitcnt vmcnt(0) lgkmcnt(0)" ::: "memory"); __builtin_amdgcn_s_barrier(); asm volatile("" ::: "memory"); } while (0)
#define STAGE(b) do { if ((b) + 3 < NT) DMA_TILE((b) + 3, ((b) + 3) & 3); } while (0)
#define STAGES(b, slot) do { if ((b) + 3 < NT) DMA_TILE((b) + 3, slot); } while (0)
#define QKT(P0, P1, t) qkt<4>(P0, P1, K_lds + ((t) & 3) * SHM_K, qr, r32, hi, 4 * c)
#define QKTS(P0, P1, slot) qkt<4>(P0, P1, K_lds + (slot) * SHM_K, qr, r32, hi, 4 * c)
#define PV(t) pv_d0(o, vb0 + ((t) & 3) * SHM_V, pa0, pa1, pa2, pa3)
  f32x16 pA0, pA1, pB0, pB1; bf16x8 pa0, pa1, pa2, pa3; float psA = 0.f, psB = 0.f;
#define PVE(t, PN, PSN) do { PSN = 0.f; pv_exp<true>(o, vb0 + ((t) & 3) * SHM_V, pa0, pa1, pa2, pa3, PN, PSN); } while (0)
#define PVES(slot, PN, PSN) do { PSN = 0.f; pv_exp<true>(o, vb0 + (slot) * SHM_V, pa0, pa1, pa2, pa3, PN, PSN); } while (0)
#define PVL(t) do { float d_ = 0.f; pv_exp<false>(o, vb0 + ((t) & 3) * SHM_V, pa0, pa1, pa2, pa3, pA0, d_); } while (0)
  DMA_TILE(0, 0); DMA_TILE(1, 1); DMA_TILE(2, 2);
  BAR();
  QKT(pA0, pA1, 0); psA = exp_sum16(pA0);
  for (int t = 0; t < NT; t += 4) {
    if (c == 0) { BAR(); STAGES(t, 3); } SBAR();
    QKTS(pB0, pB1, 1); expB_sum_pack2(pA0, pA1, psA, l_reg, pa0, pa1, pa2, pa3); SBAR();
    if (c == 1) { BAR(); STAGES(t, 3); } SBAR();
    PVES(0, pB0, psB); SBAR();
    if (c == 0) { BAR(); STAGES(t + 1, 0); } SBAR();
    QKTS(pA0, pA1, 2); expB_sum_pack2(pB0, pB1, psB, l_reg, pa0, pa1, pa2, pa3); SBAR();
    if (c == 1) { BAR(); STAGES(t + 1, 0); } SBAR();
    PVES(1, pA0, psA); SBAR();
    if (c == 0) { BAR(); STAGES(t + 2, 1); } SBAR();
    QKTS(pB0, pB1, 3); expB_sum_pack2(pA0, pA1, psA, l_reg, pa0, pa1, pa2, pa3); SBAR();
    if (c == 1) { BAR(); STAGES(t + 2, 1); } SBAR();
    PVES(2, pB0, psB); SBAR();
    if (c == 0) { BAR(); STAGES(t + 3, 2); } SBAR();
    if (t + 4 < NT) QKTS(pA0, pA1, 0);
    expB_sum_pack2(pB0, pB1, psB, l_reg, pa0, pa1, pa2, pa3); SBAR();
    if (c == 1) { BAR(); STAGES(t + 3, 2); } SBAR();
    PVES(3, pA0, psA);
    SBAR();
  }
#undef PVE
#undef PVES
#undef QKTS
#undef STAGES
#undef PVL
  if (hi == 0) li_l[r32] = l_reg; asm volatile("s_waitcnt lgkmcnt(0)" ::: "memory");
#pragma unroll
  for (int r = 0; r < 16; ++r) { const float rl = __builtin_amdgcn_rcpf(li_l[crow(r, hi)]);
#pragma unroll
    for (int d0 = 0; d0 < 4; ++d0) o[d0][r] *= rl; }
  __syncthreads();
  LAS float* xch = (LAS float*)lds + rg * 4096;
  if (c == 1) {
#pragma unroll
    for (int d0 = 0; d0 < 4; ++d0)
#pragma unroll
      for (int r = 0; r < 16; ++r) xch[(d0 * 16 + r) * 64 + lane] = o[d0][r];
  }
  __syncthreads();
  if (c == 0) {
#pragma unroll
    for (int r = 0; r < 16; ++r) { float s = 0.f;
#pragma unroll
      for (int d0 = 0; d0 < 4; ++d0) { const float d = o[d0][r] - lam * xch[(d0 * 16 + r) * 64 + lane]; o[d0][r] = d; s += d * d; }
      s += __shfl_xor(s, 1); s += __shfl_xor(s, 2); s += __shfl_xor(s, 4); s += __shfl_xor(s, 8); s += __shfl_xor(s, 16);
      const float rr = rsqrtf(s * (1.f / 128.f) + EPS) * omli;
      bf16_t* orow = concat + (size_t)(qrow0 + rg * 32 + crow(r, hi)) * DM + 512 + h * 128 + r32;
#pragma unroll
      for (int d0 = 0; d0 < 4; ++d0) orow[d0 * 32] = f2bf(o[d0][r] * rr * subln[d0 * 32 + r32]); }
  }
  __syncthreads();
#undef DMA_TILE
#undef BAR
#undef STAGE
#undef QKT
#undef PV
}


typedef float f32x2 __attribute__((ext_vector_type(2)));
__device__ __forceinline__ void exp_half(f32x16& ph, f32x2& lacc) {
#if EXP_TREE
  f32x2 e[8];
#pragma unroll
  for (int r = 0; r < 16; r += 2) { ph[r] = __builtin_amdgcn_exp2f(ph[r]); ph[r + 1] = __builtin_amdgcn_exp2f(ph[r + 1]); e[r >> 1] = f32x2{ph[r], ph[r + 1]}; }
  lacc += ((e[0] + e[1]) + (e[2] + e[3])) + ((e[4] + e[5]) + (e[6] + e[7]));
#else
#pragma unroll
  for (int r = 0; r < 16; r += 2) { ph[r] = __builtin_amdgcn_exp2f(ph[r]); ph[r + 1] = __builtin_amdgcn_exp2f(ph[r + 1]); const f32x2 e = {ph[r], ph[r + 1]}; lacc += e; }
#endif
}
__device__ __forceinline__ void pack_half(const f32x16& ph, bf16x8& x0, bf16x8& x1) {
  { u32x4 w = {cvtpk(ph[0], ph[1]), cvtpk(ph[2], ph[3]), cvtpk(ph[4], ph[5]), cvtpk(ph[6], ph[7])}; x0 = *reinterpret_cast<bf16x8*>(&w); }
  { u32x4 w = {cvtpk(ph[8], ph[9]), cvtpk(ph[10], ph[11]), cvtpk(ph[12], ph[13]), cvtpk(ph[14], ph[15])}; x1 = *reinterpret_cast<bf16x8*>(&w); }
}

template <int D0> __device__ __forceinline__ void pv2_block(f32x16& oa, f32x16& ob, int vb, s16x4& fl0, s16x4& fh0, s16x4& fl1, s16x4& fh1, s16x4& fl2, s16x4& fh2, s16x4& fl3, s16x4& fh3,
                                                           bf16x8 a0, bf16x8 a1, bf16x8 a2, bf16x8 a3, bf16x8 b0, bf16x8 b1, bf16x8 b2, bf16x8 b3) {
#define PV2_STEP(A, B, FL, FH, KS, WN) do { asm volatile("s_waitcnt lgkmcnt(" #WN ")" ::: "memory"); SBAR(); \
    oa = __builtin_amdgcn_mfma_f32_32x32x16_bf16(A, PVX_PK(FL, FH), oa, 0, 0, 0); ob = __builtin_amdgcn_mfma_f32_32x32x16_bf16(B, PVX_PK(FL, FH), ob, 0, 0, 0); \
    if (D0 < 3) { FL = tr_read<v_rd_off((D0 + 1) & 3, KS, 0)>(vb); FH = tr_read<v_rd_off((D0 + 1) & 3, KS, 1)>(vb); } SBAR(); } while (0)
  if (D0 < 3) { PV2_STEP(a0, b0, fl0, fh0, 0, 6); PV2_STEP(a1, b1, fl1, fh1, 1, 6); PV2_STEP(a2, b2, fl2, fh2, 2, 6); PV2_STEP(a3, b3, fl3, fh3, 3, 6); }
  else        { PV2_STEP(a0, b0, fl0, fh0, 0, 6); PV2_STEP(a1, b1, fl1, fh1, 1, 4); PV2_STEP(a2, b2, fl2, fh2, 2, 2); PV2_STEP(a3, b3, fl3, fh3, 3, 0); }
#undef PV2_STEP
}
__device__ __forceinline__ void attn_unit3p(const int wid, const bf16_t* __restrict__ proj, const char* __restrict__ Kt_bh, const char* __restrict__ Vt_bh, bf16_t* __restrict__ concat, int qrow0, int NT, int h,
                                            LAS char* lds, float lam, float omli, const float* __restrict__ subln) {
  const int lane = lane_id(), r32 = lane & 31, hi = lane >> 5;
  LAS char* V_lds = lds; LAS char* K_lds = lds + 2 * SHM_V; LAS char* Qw = lds + 65536 + wid * 8192;
  LAS float* li_l = (LAS float*)(lds + 131072) + wid * 64;
  f32x2 l0v = {0.f, 0.f}, l1v = {0.f, 0.f}; f32x16 o0[4] = {}, o1[4] = {};
  const int vb0 = (int)(uintptr_t)V_lds + v_rd_base(lane);
  const char* kg0 = Kt_bh + wid * 2048 + lane * 16; const char* vg0 = Vt_bh + wid * 2048 + lane * 16;
#define DMA_TILE(tile, slot) do { const size_t to_ = (size_t)(tile) * 16384; \
    __builtin_amdgcn_global_load_lds((const unsigned*)(kg0 + to_), (LAS unsigned*)(K_lds + (slot) * SHM_K + wid * 2048), 16, 0, 0); \
    __builtin_amdgcn_global_load_lds((const unsigned*)(kg0 + to_ + 1024), (LAS unsigned*)(K_lds + (slot) * SHM_K + wid * 2048 + 1024), 16, 0, 0); \
    __builtin_amdgcn_global_load_lds((const unsigned*)(vg0 + to_), (LAS unsigned*)(V_lds + (slot) * SHM_V + wid * 2048), 16, 0, 0); \
    __builtin_amdgcn_global_load_lds((const unsigned*)(vg0 + to_ + 1024), (LAS unsigned*)(V_lds + (slot) * SHM_V + wid * 2048 + 1024), 16, 0, 0); } while (0)
#define BAR() do { asm volatile("s_waitcnt vmcnt(0) lgkmcnt(0)" ::: "memory"); __builtin_amdgcn_s_barrier(); asm volatile("" ::: "memory"); } while (0)
  bf16x8 qf00, qf01, qf02, qf03, qf10, qf11, qf12, qf13;
  { const bf16_t* qg = proj + (size_t)(qrow0 + wid * 32 + r32) * DP + C_DQ + h * 128 + hi * 8;
    qf00 = ld8(qg); qf01 = ld8(qg + 16); qf02 = ld8(qg + 32); qf03 = ld8(qg + 48); qf10 = ld8(qg + 64); qf11 = ld8(qg + 80); qf12 = ld8(qg + 96); qf13 = ld8(qg + 112); }
  DMA_TILE(0, 0);
  bf16x8 a0, a1, a2, a3, b0, b1, b2, b3;
  int sw0 = KSWZ(r32, (0 * 16 + hi * 8) * 2), sw1 = KSWZ(r32, (1 * 16 + hi * 8) * 2), sw2 = KSWZ(r32, (2 * 16 + hi * 8) * 2), sw3 = KSWZ(r32, (3 * 16 + hi * 8) * 2);
  int kad0_ = (int)(uintptr_t)K_lds + sw0, kad1_ = (int)(uintptr_t)K_lds + sw1, kad2_ = (int)(uintptr_t)K_lds + sw2, kad3_ = (int)(uintptr_t)K_lds + sw3;
  asm volatile("" : "+v"(kad0_), "+v"(kad1_), "+v"(kad2_), "+v"(kad3_));
  LAS char* const kad0 = (LAS char*)(uintptr_t)kad0_; LAS char* const kad1 = (LAS char*)(uintptr_t)kad1_; LAS char* const kad2 = (LAS char*)(uintptr_t)kad2_; LAS char* const kad3 = (LAS char*)(uintptr_t)kad3_;
#define QK2(P0, P1, so, cc) do { P0 = f32x16{}; P1 = f32x16{}; _Pragma("unroll") for (int d0 = 0; d0 < 4; ++d0) { const int cb = ((4 * (cc) + d0) * 16 + hi * 8) * 2; \
    const bf16x8 ka_ = *reinterpret_cast<const LAS bf16x8*>(K_lds + (so) * SHM_K + KSWZ(r32, cb)), kb_ = *reinterpret_cast<const LAS bf16x8*>(K_lds + (so) * SHM_K + KSWZ(32 + r32, cb)); \
    const bf16x8 q_ = *reinterpret_cast<const LAS bf16x8*>(Qw + KSWZ(r32, cb)); \
    P0 = __builtin_amdgcn_mfma_f32_32x32x16_bf16(ka_, q_, P0, 0, 0, 0); P1 = __builtin_amdgcn_mfma_f32_32x32x16_bf16(kb_, q_, P1, 0, 0, 0); } } while (0)
#define QKA(PH, so, cc, koff) do { PH = f32x16{}; \
    { const bf16x8 k_ = *reinterpret_cast<const LAS bf16x8*>(kad0 + ((so) * SHM_K + (koff) * 256 + 128 * (cc))); PH = __builtin_amdgcn_mfma_f32_32x32x16_bf16(k_, (cc) ? qf10 : qf00, PH, 0, 0, 0); } \
    { const bf16x8 k_ = *reinterpret_cast<const LAS bf16x8*>(kad1 + ((so) * SHM_K + (koff) * 256 + 128 * (cc))); PH = __builtin_amdgcn_mfma_f32_32x32x16_bf16(k_, (cc) ? qf11 : qf01, PH, 0, 0, 0); } } while (0)
#define QKB(PH, so, cc, koff) do { \
    { const bf16x8 k_ = *reinterpret_cast<const LAS bf16x8*>(kad2 + ((so) * SHM_K + (koff) * 256 + 128 * (cc))); PH = __builtin_amdgcn_mfma_f32_32x32x16_bf16(k_, (cc) ? qf12 : qf02, PH, 0, 0, 0); } \
    { const bf16x8 k_ = *reinterpret_cast<const LAS bf16x8*>(kad3 + ((so) * SHM_K + (koff) * 256 + 128 * (cc))); PH = __builtin_amdgcn_mfma_f32_32x32x16_bf16(k_, (cc) ? qf13 : qf03, PH, 0, 0, 0); } } while (0)
#define QKH(PH, so, cc, koff) do { QKA(PH, so, cc, koff); QKB(PH, so, cc, koff); } while (0)
#define SGB(m, n) __builtin_amdgcn_sched_group_barrier(m, n, 0)
#define STEP(PN, so, cc, koff, PO, LV, X0, X1) do { \
    QKA(PN, so, cc, koff); exp_half(PO, LV); SGB(0x100, 2); SGB(0x8, 1); SGB(0x2, 12); SGB(0x8, 1); SGB(0x2, 12); SBAR(); asm volatile("" : "+v"(LV)); SBAR(); \
    QKB(PN, so, cc, koff); pack_half(PO, X0, X1); SGB(0x100, 2); SGB(0x8, 1); SGB(0x2, 4); SGB(0x8, 1); SGB(0x2, 4); MBAR(PN); } while (0)
#define MBAR(X) do { SBAR(); asm volatile("" : "+v"(X) :: "memory"); SBAR(); } while (0)
#define TILE(t, so) do { BAR(); if ((t) + 1 < NT) DMA_TILE((t) + 1, 1 - (so)); SBAR(); \
    { f32x16 p0, p1; \
      QKH(p0, so, 0, 0); MBAR(p0); \
      STEP(p1, so, 0, 32, p0, l0v, a0, a1); \
      STEP(p0, so, 1, 0, p1, l0v, a2, a3); \
      STEP(p1, so, 1, 32, p0, l1v, b0, b1); \
      exp_half(p1, l1v); SBAR(); asm volatile("" : "+v"(l1v)); SBAR(); pack_half(p1, b2, b3); } SBAR(); \
    { const int vb = vb0 + (so) * SHM_V; s16x4 fl0, fh0, fl1, fh1, fl2, fh2, fl3, fh3; \
      asm volatile("s_waitcnt lgkmcnt(0)" ::: "memory"); \
      PVX_RD2(fl0, fh0, 0, 0); PVX_RD2(fl1, fh1, 0, 1); PVX_RD2(fl2, fh2, 0, 2); PVX_RD2(fl3, fh3, 0, 3); \
      pv2_block<0>(o0[0], o1[0], vb, fl0, fh0, fl1, fh1, fl2, fh2, fl3, fh3, a0, a1, a2, a3, b0, b1, b2, b3); \
      pv2_block<1>(o0[1], o1[1], vb, fl0, fh0, fl1, fh1, fl2, fh2, fl3, fh3, a0, a1, a2, a3, b0, b1, b2, b3); \
      pv2_block<2>(o0[2], o1[2], vb, fl0, fh0, fl1, fh1, fl2, fh2, fl3, fh3, a0, a1, a2, a3, b0, b1, b2, b3); \
      pv2_block<3>(o0[3], o1[3], vb, fl0, fh0, fl1, fh1, fl2, fh2, fl3, fh3, a0, a1, a2, a3, b0, b1, b2, b3); } SBAR(); } while (0)
  for (int t = 0; t < NT; t += 2) { TILE(t, 0); TILE(t + 1, 1); }
  const float l0 = pair_sum(l0v[0] + l0v[1]), l1 = pair_sum(l1v[0] + l1v[1]);
  if (hi == 0) { li_l[r32] = l0; li_l[32 + r32] = l1; } asm volatile("s_waitcnt lgkmcnt(0)" ::: "memory");
#pragma unroll
  for (int r = 0; r < 16; ++r) { const float ra = __builtin_amdgcn_rcpf(li_l[crow(r, hi)]), rb = lam * __builtin_amdgcn_rcpf(li_l[32 + crow(r, hi)]);
    float s = 0.f;
#pragma unroll
    for (int d0 = 0; d0 < 4; ++d0) { const float d = o0[d0][r] * ra - o1[d0][r] * rb; o0[d0][r] = d; s += d * d; }
    s += __shfl_xor(s, 1); s += __shfl_xor(s, 2); s += __shfl_xor(s, 4); s += __shfl_xor(s, 8); s += __shfl_xor(s, 16);
    const float rr = rsqrtf(s * (1.f / 128.f) + EPS) * omli;
    bf16_t* orow = concat + (size_t)(qrow0 + wid * 32 + crow(r, hi)) * DM + 512 + h * 128 + r32;
#pragma unroll
    for (int d0 = 0; d0 < 4; ++d0) orow[d0 * 32] = f2bf(o0[d0][r] * rr * subln[d0 * 32 + r32]); }
  asm volatile("s_waitcnt vmcnt(0) lgkmcnt(0)" ::: "memory"); __syncthreads();
#undef DMA_TILE
#undef BAR
#undef QK2
#undef QKH
#undef QKA
#undef QKB
#undef TILE
#undef STEP
#undef MBAR
#undef SGB
}

#ifndef EXP_TREE
#define EXP_TREE 1
#endif
#ifndef ATT_PRIO
#define ATT_PRIO 1
#endif
template <int OFF> __device__ __forceinline__ bf16x8 ldsb128(int addr) { bf16x8 r; asm volatile("ds_read_b128 %0, %1 offset:%2" : "=&v"(r) : "v"(addr), "i"(OFF) : "memory"); return r; }
constexpr int vt_rd_off(int so, int d0, int ks) { return so * 16384 + d0 * 4096 + (ks >> 1) * 64; }
template <int SO, int D0> __device__ __forceinline__ void pvt_block(f32x16& oa, f32x16& ob, int va0, int va1, bf16x8& f0, bf16x8& f1, bf16x8& f2, bf16x8& f3,
                                                                   bf16x8 a0, bf16x8 a1, bf16x8 a2, bf16x8 a3, bf16x8 b0, bf16x8 b1, bf16x8 b2, bf16x8 b3) {
#define PVT_STEP(A, B, F, KS, WN) do { asm volatile("s_waitcnt lgkmcnt(" #WN ")" ::: "memory"); SBAR(); \
    oa = __builtin_amdgcn_mfma_f32_32x32x16_bf16(A, F, oa, 0, 0, 0); ob = __builtin_amdgcn_mfma_f32_32x32x16_bf16(B, F, ob, 0, 0, 0); \
    if (D0 < 3) F = ldsb128<vt_rd_off(SO, (D0 + 1) & 3, KS)>((KS & 1) ? va1 : va0); SBAR(); } while (0)
  if (D0 < 3) { PVT_STEP(a0, b0, f0, 0, 3); PVT_STEP(a1, b1, f1, 1, 3); PVT_STEP(a2, b2, f2, 2, 3); PVT_STEP(a3, b3, f3, 3, 3); }
  else        { PVT_STEP(a0, b0, f0, 0, 3); PVT_STEP(a1, b1, f1, 1, 2); PVT_STEP(a2, b2, f2, 2, 1); PVT_STEP(a3, b3, f3, 3, 0); }
#undef PVT_STEP
}
__device__ __forceinline__ void attn_unit3q(const int wid, const bf16_t* __restrict__ proj, const char* __restrict__ Kt_bh, const char* __restrict__ Vt_bh, bf16_t* __restrict__ concat, int qrow0, int NT, int h,
                                            LAS char* lds, float lam, float omli, const float* __restrict__ subln) {
  const int lane = lane_id(), r32 = lane & 31, hi = lane >> 5, rg = wid & 3, c = wid >> 2;
  LAS char* V_lds = lds; LAS char* K_lds = lds + 2 * SHM_V;
  LAS float* li_l = (LAS float*)(lds + 131072) + wid * 64;
  f32x2 l0v = {0.f, 0.f}, l1v = {0.f, 0.f}; f32x16 o0[4] = {}, o1[4] = {};
  int va0 = (int)(uintptr_t)V_lds + r32 * 128 + ((hi ^ ((r32 >> 1) & 3)) << 4), va1 = (int)(uintptr_t)V_lds + r32 * 128 + (((2 + hi) ^ ((r32 >> 1) & 3)) << 4);
  asm volatile("" : "+v"(va0), "+v"(va1));
  const char* kg0 = Kt_bh + wid * 2048 + lane * 16; const char* vg0 = Vt_bh + wid * 2048 + lane * 16;
#define DMA_TILE(tile, slot) do { const size_t to_ = (size_t)(tile) * 16384; \
    __builtin_amdgcn_global_load_lds((const unsigned*)(kg0 + to_), (LAS unsigned*)(K_lds + (slot) * SHM_K + wid * 2048), 16, 0, 0); \
    __builtin_amdgcn_global_load_lds((const unsigned*)(kg0 + to_ + 1024), (LAS unsigned*)(K_lds + (slot) * SHM_K + wid * 2048 + 1024), 16, 0, 0); \
    __builtin_amdgcn_global_load_lds((const unsigned*)(vg0 + to_), (LAS unsigned*)(V_lds + (slot) * SHM_V + wid * 2048), 16, 0, 0); \
    __builtin_amdgcn_global_load_lds((const unsigned*)(vg0 + to_ + 1024), (LAS unsigned*)(V_lds + (slot) * SHM_V + wid * 2048 + 1024), 16, 0, 0); } while (0)
#define BAR() do { asm volatile("s_waitcnt vmcnt(0) lgkmcnt(0)" ::: "memory"); __builtin_amdgcn_s_barrier(); asm volatile("" ::: "memory"); } while (0)
  bf16x8 qf00, qf01, qf02, qf03, qf10, qf11, qf12, qf13;
  { const bf16_t* qg = proj + (size_t)(qrow0 + rg * 64 + r32) * DP + C_DQ + h * 128 + c * 64 + hi * 8;
    qf00 = ld8(qg); qf01 = ld8(qg + 16); qf02 = ld8(qg + 32); qf03 = ld8(qg + 48); qg += (size_t)32 * DP;
    qf10 = ld8(qg); qf11 = ld8(qg + 16); qf12 = ld8(qg + 32); qf13 = ld8(qg + 48); }
  DMA_TILE(0, 0);
  bf16x8 a0, a1, a2, a3, b0, b1, b2, b3;
  int kad0_ = (int)(uintptr_t)K_lds + KSWZ(r32, (0 * 16 + hi * 8) * 2) + 128 * c, kad1_ = (int)(uintptr_t)K_lds + KSWZ(r32, (1 * 16 + hi * 8) * 2) + 128 * c;
  int kad2_ = (int)(uintptr_t)K_lds + KSWZ(r32, (2 * 16 + hi * 8) * 2) + 128 * c, kad3_ = (int)(uintptr_t)K_lds + KSWZ(r32, (3 * 16 + hi * 8) * 2) + 128 * c;
  asm volatile("" : "+v"(kad0_), "+v"(kad1_), "+v"(kad2_), "+v"(kad3_));
  LAS char* const kad0 = (LAS char*)(uintptr_t)kad0_; LAS char* const kad1 = (LAS char*)(uintptr_t)kad1_; LAS char* const kad2 = (LAS char*)(uintptr_t)kad2_; LAS char* const kad3 = (LAS char*)(uintptr_t)kad3_;
#define QKA(PH, so, rb, koff, LK) do { PH = f32x16{}; \
    { if (LK) kf0 = *reinterpret_cast<const LAS bf16x8*>(kad0 + ((so) * SHM_K + (koff) * 256)); PH = __builtin_amdgcn_mfma_f32_32x32x16_bf16(kf0, (rb) ? qf10 : qf00, PH, 0, 0, 0); } \
    { if (LK) kf1 = *reinterpret_cast<const LAS bf16x8*>(kad1 + ((so) * SHM_K + (koff) * 256)); PH = __builtin_amdgcn_mfma_f32_32x32x16_bf16(kf1, (rb) ? qf11 : qf01, PH, 0, 0, 0); } } while (0)
#define QKB(PH, so, rb, koff, LK) do { \
    { if (LK) kf2 = *reinterpret_cast<const LAS bf16x8*>(kad2 + ((so) * SHM_K + (koff) * 256)); PH = __builtin_amdgcn_mfma_f32_32x32x16_bf16(kf2, (rb) ? qf12 : qf02, PH, 0, 0, 0); } \
    { if (LK) kf3 = *reinterpret_cast<const LAS bf16x8*>(kad3 + ((so) * SHM_K + (koff) * 256)); PH = __builtin_amdgcn_mfma_f32_32x32x16_bf16(kf3, (rb) ? qf13 : qf03, PH, 0, 0, 0); } } while (0)
#define SGB(m, n) __builtin_amdgcn_sched_group_barrier(m, n, 0)
#define MBAR(X) do { SBAR(); asm volatile("" : "+v"(X) :: "memory"); SBAR(); } while (0)
#define STEP(PN, so, rb, koff, LK, PO, LV, X0, X1) do { \
    QKA(PN, so, rb, koff, LK); exp_half(PO, LV); if (LK) SGB(0x100, 2); SGB(0x8, 1); SGB(0x2, 12); SGB(0x8, 1); SGB(0x2, 12); SBAR(); asm volatile("" : "+v"(LV)); SBAR(); \
    QKB(PN, so, rb, koff, LK); pack_half(PO, X0, X1); if (LK) SGB(0x100, 2); SGB(0x8, 1); SGB(0x2, 4); SGB(0x8, 1); SGB(0x2, 4); MBAR(PN); } while (0)
#define TILE(t, so) do { BAR(); if ((t) + 1 < NT) DMA_TILE((t) + 1, 1 - (so)); SBAR(); \
    bf16x8 vf0, vf1, vf2, vf3; \
    { f32x16 p0, p1; bf16x8 kf0, kf1, kf2, kf3; \
      QKA(p0, so, 0, 0, 1); QKB(p0, so, 0, 0, 1); MBAR(p0); \
      STEP(p1, so, 1, 0, 0, p0, l0v, a0, a1); \
      STEP(p0, so, 0, 32, 1, p1, l1v, b0, b1); \
      STEP(p1, so, 1, 32, 0, p0, l0v, a2, a3); \
      SBAR(); vf0 = ldsb128<vt_rd_off(so, 0, 0)>(va0); vf1 = ldsb128<vt_rd_off(so, 0, 1)>(va1); vf2 = ldsb128<vt_rd_off(so, 0, 2)>(va0); vf3 = ldsb128<vt_rd_off(so, 0, 3)>(va1); SBAR();     \
      exp_half(p1, l1v); SBAR(); asm volatile("" : "+v"(l1v)); SBAR(); pack_half(p1, b2, b3); } SBAR(); \
    { \
      pvt_block<so, 0>(o0[0], o1[0], va0, va1, vf0, vf1, vf2, vf3, a0, a1, a2, a3, b0, b1, b2, b3); \
      pvt_block<so, 1>(o0[1], o1[1], va0, va1, vf0, vf1, vf2, vf3, a0, a1, a2, a3, b0, b1, b2, b3); \
      pvt_block<so, 2>(o0[2], o1[2], va0, va1, vf0, vf1, vf2, vf3, a0, a1, a2, a3, b0, b1, b2, b3); \
      pvt_block<so, 3>(o0[3], o1[3], va0, va1, vf0, vf1, vf2, vf3, a0, a1, a2, a3, b0, b1, b2, b3); } SBAR(); } while (0)
#if ATT_PRIO
  if (wid >= 4) __builtin_amdgcn_s_setprio(1);
#endif
  for (int t = 0; t < NT; t += 2) { TILE(t, 0); TILE(t + 1, 1); }
#if ATT_PRIO
  __builtin_amdgcn_s_setprio(0);
#endif
  const float l0 = pair_sum(l0v[0] + l0v[1]), l1 = pair_sum(l1v[0] + l1v[1]);
  if (hi == 0) { li_l[r32] = l0; li_l[32 + r32] = l1; }
  asm volatile("s_waitcnt vmcnt(0) lgkmcnt(0)" ::: "memory"); __syncthreads();
  LAS float* xw = (LAS float*)(lds + (rg * 2 + c) * 16384) + lane; const LAS float* xr = (const LAS float*)(lds + (rg * 2 + (1 - c)) * 16384) + lane;
  const float sgn = c ? lam : 1.f;
#define SEND(OX, LOFF) do { _Pragma("unroll") for (int r = 0; r < 16; ++r) { const float rl = sgn * __builtin_amdgcn_rcpf(li_l[(LOFF) + crow(r, hi)]); \
    _Pragma("unroll") for (int d0 = 0; d0 < 4; ++d0) xw[(d0 * 16 + r) * 64] = OX[d0][r] * rl; } } while (0)
  if (c == 0) SEND(o1, 32); else SEND(o0, 0);
  asm volatile("s_waitcnt lgkmcnt(0)" ::: "memory"); __syncthreads();
#define FINISH(OX, LOFF, RB) do { _Pragma("unroll") for (int r = 0; r < 16; ++r) { const float rl = sgn * __builtin_amdgcn_rcpf(li_l[(LOFF) + crow(r, hi)]); float s = 0.f; \
    _Pragma("unroll") for (int d0 = 0; d0 < 4; ++d0) { const float own = OX[d0][r] * rl, oth = xr[(d0 * 16 + r) * 64]; const float d = c ? oth - own : own - oth; OX[d0][r] = d; s += d * d; } \
    s += __shfl_xor(s, 1); s += __shfl_xor(s, 2); s += __shfl_xor(s, 4); s += __shfl_xor(s, 8); s += __shfl_xor(s, 16); \
    const float rr = rsqrtf(s * (1.f / 128.f) + EPS) * omli; \
    bf16_t* orow = concat + (size_t)(qrow0 + rg * 64 + (RB) * 32 + crow(r, hi)) * DM + 512 + h * 128 + r32; \
    _Pragma("unroll") for (int d0 = 0; d0 < 4; ++d0) orow[d0 * 32] = f2bf(OX[d0][r] * rr * subln[d0 * 32 + r32]); } } while (0)
  if (c == 0) FINISH(o0, 0, 0); else FINISH(o1, 32, 1);
  asm volatile("s_waitcnt vmcnt(0) lgkmcnt(0)" ::: "memory"); __syncthreads();
#undef SEND
#undef FINISH
#undef DMA_TILE
#undef BAR
#undef QKA
#undef QKB
#undef TILE
#undef STEP
#undef MBAR
#undef SGB
}

__device__ __forceinline__ bf16x8 scale8(bf16x8 v, float s) {
  u32x4 w;
#pragma unroll
  for (int i = 0; i < 4; ++i) { const float a = __uint_as_float(((unsigned)(unsigned short)v[2 * i]) << 16) * s, b = __uint_as_float(((unsigned)(unsigned short)v[2 * i + 1]) << 16) * s; w[i] = cvtpk(a, b); }
  return *reinterpret_cast<bf16x8*>(&w);
}
template <int KS> __device__ __forceinline__ void trfrag_issue(int vb, s16x4& l, s16x4& h) { l = tr_read<v_rd_off(0, KS, 0)>(vb); h = tr_read<v_rd_off(0, KS, 1)>(vb); }
#define PKF(L, H) (bf16x8){L[0], L[1], L[2], L[3], H[0], H[1], H[2], H[3]}
template <int KS> __device__ __forceinline__ void cs_step(f32x16* acc, int kb, int vv) {
  s16x4 al, ah, b0l, b0h, b1l, b1h, b2l, b2h, b3l, b3h;
  trfrag_issue<KS>(kb, al, ah); trfrag_issue<KS>(vv, b0l, b0h); trfrag_issue<KS>(vv + 512, b1l, b1h); trfrag_issue<KS>(vv + 1024, b2l, b2h); trfrag_issue<KS>(vv + 1536, b3l, b3h);
  asm volatile("s_waitcnt lgkmcnt(0)" ::: "memory"); SBAR();
  const bf16x8 a = PKF(al, ah);
  acc[0] = __builtin_amdgcn_mfma_f32_32x32x16_bf16(a, PKF(b0l, b0h), acc[0], 0, 0, 0);
  acc[1] = __builtin_amdgcn_mfma_f32_32x32x16_bf16(a, PKF(b1l, b1h), acc[1], 0, 0, 0);
  acc[2] = __builtin_amdgcn_mfma_f32_32x32x16_bf16(a, PKF(b2l, b2h), acc[2], 0, 0, 0);
  acc[3] = __builtin_amdgcn_mfma_f32_32x32x16_bf16(a, PKF(b3l, b3h), acc[3], 0, 0, 0);
}
__device__ __forceinline__ void chunk_state_unit(const int wid, const bf16_t* __restrict__ proj, bf16_t* __restrict__ csf, bf16_t* __restrict__ csb, int rowbase, int h, float lgf2, float lgb2, LAS char* lds) {
  const int lane = lane_id(), tid = wid * 64 + lane, r32 = lane & 31, hi = lane >> 5;
  const int sr = tid >> 4, sc = (tid & 15) * 8;
  { bf16x8 kv[4], vv[4];
#pragma unroll
    for (int g = 0; g < 4; ++g) { const bf16_t* rp = proj + (size_t)(rowbase + 32 * g + sr) * DP + h * 128 + sc; kv[g] = ld8(rp + C_RK); vv[g] = ld8(rp + C_RV); }
#pragma unroll
    for (int g = 0; g < 4; ++g) { const int row = 32 * g + sr;
      const float wf = __builtin_amdgcn_exp2f(lgf2 * (float)(127 - row)), wb = __builtin_amdgcn_exp2f(lgb2 * (float)row);
      const int off = (row >> 6) * 16384 + v_st(row & 63, sc);
      *(LAS bf16x8*)(lds + off) = vv[g]; *(LAS bf16x8*)(lds + 32768 + off) = scale8(kv[g], wf); *(LAS bf16x8*)(lds + 65536 + off) = scale8(kv[g], wb); } }
  __syncthreads();
  const int dir = wid >> 2, ib = wid & 3;
  const int vbK = (int)(uintptr_t)(lds + 32768 + dir * 32768) + v_rd_base(lane) + ib * 512, vbV = (int)(uintptr_t)lds + v_rd_base(lane);
  f32x16 acc[4] = {};
  cs_step<0>(acc, vbK, vbV); cs_step<1>(acc, vbK, vbV); cs_step<2>(acc, vbK, vbV); cs_step<3>(acc, vbK, vbV);
  cs_step<0>(acc, vbK + 16384, vbV + 16384); cs_step<1>(acc, vbK + 16384, vbV + 16384); cs_step<2>(acc, vbK + 16384, vbV + 16384); cs_step<3>(acc, vbK + 16384, vbV + 16384);
  bf16_t* outp = (dir ? csb : csf) + r32;
#pragma unroll
  for (int r = 0; r < 16; ++r) { bf16_t* orow = outp + (size_t)(32 * ib + crow(r, hi)) * 128;
#pragma unroll
    for (int jb = 0; jb < 4; ++jb) orow[32 * jb] = f2bf(acc[jb][r]); }
  __syncthreads();
}
__device__ __forceinline__ void pack_p(const f32x16& p0, const f32x16& p1, bf16x8& pa0, bf16x8& pa1, bf16x8& pa2, bf16x8& pa3) {
#define PK4(P, BASE, OUT) do { unsigned a0 = cvtpk(P[BASE + 0], P[BASE + 1]), a1 = cvtpk(P[BASE + 2], P[BASE + 3]);   \
    unsigned b0 = cvtpk(P[BASE + 4], P[BASE + 5]), b1 = cvtpk(P[BASE + 6], P[BASE + 7]);                              \
    auto r0 = __builtin_amdgcn_permlane32_swap(a0, b0, false, false); auto r1 = __builtin_amdgcn_permlane32_swap(a1, b1, false, false); \
    u32x4 w = {r0[0], r1[0], r0[1], r1[1]}; OUT = *reinterpret_cast<bf16x8*>(&w); } while (0)
  PK4(p0, 0, pa0); PK4(p0, 8, pa1); PK4(p1, 0, pa2); PK4(p1, 8, pa3);
#undef PK4
}
__device__ __forceinline__ float decay_w(int d, float lgf2, float lgb2) {
  const float e = __builtin_amdgcn_exp2f(d < 0 ? lgf2 * (float)(-d) : lgb2 * (float)d); return d == 0 ? 2.f : e;
}
__device__ __forceinline__ void ret_out_unit(const int wid, const bf16_t* __restrict__ proj, bf16_t* __restrict__ concat, const bf16_t* __restrict__ spA, const bf16_t* __restrict__ spB, size_t dstride,
                                             int rowA, int rowB, int h, float lgf2, float lgb2, const float* __restrict__ gn, LAS char* lds) {
  const int lane = lane_id(), tid = wid * 64 + lane, r32 = lane & 31, hi = lane >> 5, rg = wid & 3, ch = wid >> 2;
  const int sr = tid >> 4, sc = (tid & 15) * 8;
  const int rowbase = ch ? rowB : rowA;
  { bf16x8 kv[8], vv[8];
#pragma unroll
    for (int c2 = 0; c2 < 2; ++c2)
#pragma unroll
      for (int g = 0; g < 4; ++g) { const bf16_t* rp = proj + (size_t)((c2 ? rowB : rowA) + 32 * g + sr) * DP + h * 128 + sc; kv[c2 * 4 + g] = ld8(rp + C_RK); vv[c2 * 4 + g] = ld8(rp + C_RV); }
#pragma unroll
    for (int c2 = 0; c2 < 2; ++c2)
#pragma unroll
      for (int g = 0; g < 4; ++g) { const int row = 32 * g + sr;
        *(LAS bf16x8*)(lds + c2 * 65536 + (row >> 6) * 16384 + KSWZ(row & 63, sc * 2)) = kv[c2 * 4 + g];
        *(LAS bf16x8*)(lds + c2 * 65536 + 32768 + (row >> 6) * 16384 + v_st(row & 63, sc)) = vv[c2 * 4 + g]; } }
  bf16x8 qr[8];
  const bf16_t* Qw = proj + (size_t)(rowbase + rg * 32 + r32) * DP + C_RQ + h * 128 + hi * 8;
#pragma unroll
  for (int d0 = 0; d0 < 8; ++d0) qr[d0] = ld8(Qw + d0 * 16);
  __syncthreads();
  const int m = rg * 32 + r32;
  LAS char* myreg = lds + ch * 65536;
  const int vb = (int)(uintptr_t)myreg + v_rd_base(lane);
  f32x16 o[4] = {}; f32x16 p0, p1; bf16x8 pa0, pa1, pa2, pa3;
#pragma unroll
  for (int kt = 0; kt < 2; ++kt) {
    qkt<8>(p0, p1, myreg + kt * 16384, qr, r32, hi, 0);
    int mm = m - 4 * hi; asm volatile("" : "+v"(mm));
#pragma unroll
    for (int r = 0; r < 16; ++r) { const int s0 = 64 * kt + (r & 3) + 8 * (r >> 2); p0[r] *= decay_w(s0 - mm, lgf2, lgb2); p1[r] *= decay_w(s0 + 32 - mm, lgf2, lgb2); }
    pack_p(p0, p1, pa0, pa1, pa2, pa3);
    pv_d0(o, vb + 32768 + kt * 16384, pa0, pa1, pa2, pa3);
  }
  __syncthreads();
  { bf16x8 sv[16];
#pragma unroll
    for (int c2 = 0; c2 < 2; ++c2)
#pragma unroll
      for (int d = 0; d < 2; ++d)
#pragma unroll
        for (int g = 0; g < 4; ++g) sv[(c2 * 2 + d) * 4 + g] = ld8((c2 ? spB : spA) + (size_t)d * dstride + (size_t)(32 * g + sr) * 128 + sc);
#pragma unroll
    for (int c2 = 0; c2 < 2; ++c2)
#pragma unroll
      for (int d = 0; d < 2; ++d)
#pragma unroll
        for (int g = 0; g < 4; ++g) { const int row = 32 * g + sr;
          *(LAS bf16x8*)(lds + c2 * 65536 + d * 32768 + (row >> 6) * 16384 + v_st(row & 63, sc)) = sv[(c2 * 2 + d) * 4 + g]; } }
  const float xf = __builtin_amdgcn_exp2f(lgf2 * (float)(m + 1)), xb = __builtin_amdgcn_exp2f(lgb2 * (float)(128 - m));
  __syncthreads();
#pragma unroll
  for (int d = 0; d < 2; ++d) { const float xs = d ? xb : xf;
#pragma unroll
    for (int sub = 0; sub < 2; ++sub) {
      const bf16x8 a0 = scale8(qr[4 * sub + 0], xs), a1 = scale8(qr[4 * sub + 1], xs), a2 = scale8(qr[4 * sub + 2], xs), a3 = scale8(qr[4 * sub + 3], xs);
      pv_d0(o, vb + d * 32768 + sub * 16384, a0, a1, a2, a3); } }
#pragma unroll
  for (int r = 0; r < 16; ++r) {
    float s = (o[0][r] + o[1][r]) + (o[2][r] + o[3][r]);
    s += __shfl_xor(s, 1); s += __shfl_xor(s, 2); s += __shfl_xor(s, 4); s += __shfl_xor(s, 8); s += __shfl_xor(s, 16);
    const float mu = s * (1.f / 128.f);
    float q = 0.f;
#pragma unroll
    for (int d0 = 0; d0 < 4; ++d0) { const float dd = o[d0][r] - mu; o[d0][r] = dd; q += dd * dd; }
    q += __shfl_xor(q, 1); q += __shfl_xor(q, 2); q += __shfl_xor(q, 4); q += __shfl_xor(q, 8); q += __shfl_xor(q, 16);
    const float rr = rsqrtf(q * (1.f / 128.f) + EPS);
    const size_t grow = (size_t)(rowbase + rg * 32 + crow(r, hi));
    const bf16_t* gp = proj + grow * DP + C_RG + h * 128 + r32; bf16_t* op = concat + grow * DM + h * 128 + r32;
#pragma unroll
    for (int d0 = 0; d0 < 4; ++d0) { const float gv = bf2f(gp[32 * d0]); op[32 * d0] = f2bf(o[d0][r] * rr * gn[32 * d0 + r32] * (gv * __builtin_amdgcn_rcpf(1.f + __builtin_amdgcn_exp2f(-1.4426950408889634f * gv)))); }
  }
  __syncthreads();
}

}


__device__ __forceinline__ float log2_sigmoid(float x) { return -log1pf(__expf(-x)) * 1.4426950408889634f; }
__device__ __forceinline__ bf16_t* cs_ptr(const Params& p, int b, int h, int dir, int j) { return (bf16_t*)(p.ws + WS_CS) + ((size_t)((b * NH + h) * 2 + dir) * 66 + j) * 16384; }
__device__ __forceinline__ void qkrope_phase(const Params& p, Ctx& F, int l) {
    const int lane = lane_id();
    float gq[8], gk[8], fr[8];
#pragma unroll
    for (int i = 0; i < 8; ++i) { gq[i] = p.in[I_QNG][l * 64 + 8 * (lane & 7) + i] * 0.18033688011112042f;
        gk[i] = p.in[I_KNG][l * 64 + 8 * (lane & 7) + i];
        fr[i] = exp2f(-(float)(8 * (lane & 1) + i) * (13.287712379549449f / 16.f)) * 0.15915494309189535f; }
    const bool lowhalf = (lane & 4) == 0;
    for (int m = F.gw; m < NR; m += F.NGW) {
        bf16_t* row = (bf16_t*)(p.ws + WS_PROJ) + (size_t)m * DP;
        v4u* qp = (v4u*)(row + C_DQ) + lane; const v4u* kp = (const v4u*)(row + C_DK) + lane;
#if FAST_ATT
        const v4u qv = *qp, kv = *kp;
#else
        const v4u qv = *qp, kv = *kp, vv = *((const v4u*)(row + C_DV) + lane);
#endif
        float q[8], k[8];
#pragma unroll
        for (int i = 0; i < 4; ++i) { q[2 * i] = __uint_as_float(qv[i] << 16); q[2 * i + 1] = __uint_as_float(qv[i] & 0xffff0000u); k[2 * i] = __uint_as_float(kv[i] << 16); k[2 * i + 1] = __uint_as_float(kv[i] & 0xffff0000u); }
        float sq = 0.f, sk = 0.f;
#pragma unroll
        for (int i = 0; i < 8; ++i) { sq += q[i] * q[i]; sk += k[i] * k[i]; }
        sq += __shfl_xor(sq, 1); sq += __shfl_xor(sq, 2); sq += __shfl_xor(sq, 4);
        sk += __shfl_xor(sk, 1); sk += __shfl_xor(sk, 2); sk += __shfl_xor(sk, 4);
        const float rq = rsqrtf(sq * (1.f / 64.f) + EPS), rk = rsqrtf(sk * (1.f / 64.f) + EPS);
#pragma unroll
        for (int i = 0; i < 8; ++i) { q[i] *= rq * gq[i]; k[i] *= rk * gk[i]; }
        if (m < NL) {
            const int t = m % T; const float pos = (float)((lane & 2) ? (t % 64) : (t / 64));
#pragma unroll
            for (int i = 0; i < 8; ++i) {
                const float rev = pos * fr[i]; const float cs = __builtin_amdgcn_cosf(rev), sn = __builtin_amdgcn_sinf(rev);
                const float oq = __shfl_xor(q[i], 4), ok = __shfl_xor(k[i], 4);
                q[i] = lowhalf ? q[i] * cs - oq * sn : q[i] * cs + oq * sn;
                k[i] = lowhalf ? k[i] * cs - ok * sn : k[i] * cs + ok * sn;
            }
        }
        v4u qo, ko;
#pragma unroll
        for (int i = 0; i < 4; ++i) { qo[i] = pk2(q[2 * i], q[2 * i + 1]); ko[i] = pk2(k[2 * i], k[2 * i + 1]); }
        *qp = qo;
        { const int bb = m < NL ? m / T : (m - NL) / TC, kidx = m < NL ? TC + (m % T) : (m - NL) % TC, tile = kidx >> 6, r = kidx & 63, hh = lane >> 4, ci = lane & 15;
          const size_t blk = ((size_t)(bb * NH + hh) * 132 + tile) * 16384;
          *(v4u*)(p.ws + WS_KT + blk + KSWZ(r, 16 * ci)) = ko;
#if FAST_ATT
          }
#else
          *(v4u*)(p.ws + WS_VT + blk + att::v_st(r, 8 * ci)) = vv; }
#endif
    }
}
__device__ __forceinline__ void scan_phase(const Params& p, Ctx& F, int l) {
    const int lane_ = lane_id(), tid_ = F.wave * 64 + lane_;
    unsigned* cs = (unsigned*)(p.ws + WS_CS);
    for (int i = blockIdx.x * (NWAVES * 64) + tid_; i < 16 * 8192; i += F.G * NWAVES * 64) {
        const int combo = i >> 13, e2 = i & 8191, dir = combo & 1, h = (combo >> 1) & 3;
        const float lg2 = log2_sigmoid(dir ? p.in[I_DECB][l * NH + h] : p.in[I_DECF][l * NH + h]);
        const float decay = exp2f(lg2 * 128.f);
        unsigned* base = cs + (size_t)combo * 66 * 8192 + e2;
        float s0 = 0.f, s1 = 0.f;
#pragma unroll 1
        for (int jj = 0; jj < 66; jj += 22) {
            unsigned tv[22];
#pragma unroll
            for (int k = 0; k < 22; ++k) { const int q = jj + k, idx = dir ? (q < 2 ? 1 - q : 67 - q) : q; tv[k] = base[(size_t)idx * 8192]; }
#pragma unroll
            for (int k = 0; k < 22; ++k) { const int q = jj + k, idx = dir ? (q < 2 ? 1 - q : 67 - q) : q;
                base[(size_t)idx * 8192] = pk2(s0, s1);
                s0 = decay * s0 + __uint_as_float(tv[k] << 16); s1 = decay * s1 + __uint_as_float(tv[k] & 0xffff0000u); }
        }
    }
}

#define IN(k) (lo <= (k) && (k) < hi)
#if SEAM_CVT
#define SEAM(k) do { if (IN(k) && IN((k) + 1)) { const bool t0_ = F.wave == 0 && lane_id() == 0; const XcdToken tk_ = xcd_barrier_arrive(bar, t0_); seam_fill(p, F, (k)); xcd_barrier_wait(bar, tk_, t0_); } } while (0)
#else
#define SEAM(k) do { if (IN(k) && IN((k) + 1)) xcd_barrier(bar, F.wave == 0 && lane_id() == 0); } while (0)
#endif
#ifndef REP_ATT
#define REP_ATT 1
#endif
#ifndef REP_RET
#define REP_RET 1
#endif
#ifndef REP_B
#define REP_B 1
#endif
#ifndef REP_H0
#define REP_H0 1
#endif
#ifndef REP_H1
#define REP_H1 1
#endif
#ifndef REP_I1
#define REP_I1 1
#endif
#ifndef REP_P0
#define REP_P0 1
#endif
#ifndef REP_CS
#define REP_CS 1
#endif
#ifndef REP_A
#define REP_A 1
#endif
#ifndef REP_I0
#define REP_I0 1
#endif
#ifndef REP_F0
#define REP_F0 1
#endif
#ifndef REP_G2
#define REP_G2 1
#endif
#ifndef REP_BAR
#define REP_BAR 0
#endif
template <int l>
__device__ __forceinline__ void layer_phases(const Params& p, Ctx& F, const XcdBarrier& bar, const int lo, const int hi) {
    constexpr int base = 1 + 9 * l;

        if (IN(base + 0)) { for (int rep_ = 0; rep_ < REP_A; ++rep_) norm_phase(p, F, l, 0, NR); for (int rep_ = 0; rep_ < REP_BAR; ++rep_) xcd_barrier(bar, F.wave == 0 && lane_id() == 0); SEAM(base + 0); }
        if (IN(base + 1)) {
            pg8::Gemm g{(const bf16_t*)(p.ws + WS_HBUF), (const bf16_t*)(p.ws + W_WIN) + (size_t)l * DP * DM, NR, DP, DM, DM};
            pg8::Order S; S.init(NR / 256, DP / 256, F.G, (int)blockIdx.x);
            pg8::EpiProj E{(bf16_t*)(p.ws + WS_PROJ), (char*)(p.ws + WS_VT)};
            { pg8::gemm_phase<pg8::EpiProj, pg8::Order, true, true>(F.lds + RING_OFF, g, S, E, F.wave); if (REP_B > 1) { pg8::gemm_phase<pg8::EpiProj, pg8::Order, true, true>(F.lds + RING_OFF, g, S, E, F.wave); } }
            SEAM(base + 1);
        }
        if (IN(base + 2)) {
            qkrope_phase(p, F, l);
            for (int rep_ = 0; rep_ < REP_CS; ++rep_)
            for (int u = blockIdx.x; u < 8 * 66; u += F.G) {
                const int bh = u & 7, j = u >> 3, b = bh >> 2, h = bh & 3;
                const int rowbase = j < 2 ? NL + b * TC + 128 * j : b * T + 128 * (j - 2);
                att::chunk_state_unit(F.wave, (const bf16_t*)(p.ws + WS_PROJ), cs_ptr(p, b, h, 0, j), cs_ptr(p, b, h, 1, j), rowbase, h,
                                      log2_sigmoid(p.in[I_DECF][l * NH + h]), log2_sigmoid(p.in[I_DECB][l * NH + h]), (LAS char*)(F.lds + RING_OFF));
            }
            SEAM(base + 2);
        }
        if (IN(base + 3)) { scan_phase(p, F, l); SEAM(base + 3); }
        if (IN(base + 4)) {
#if FAST_RET
            for (int rep_ = 0; rep_ < REP_RET; ++rep_)
            for (int u = blockIdx.x; u < (l == 0 ? 8 * 33 : 8 * 32); u += F.G) {
                const int bh = u & 7, jp = (u >> 3) + (l == 0 ? 0 : 1), b = bh >> 2, h = bh & 3;
                const int rowA = jp == 0 ? NL + b * TC : b * T + 128 * (2 * jp - 2);
                att::ret_out_unit(F.wave, (const bf16_t*)(p.ws + WS_PROJ), (bf16_t*)(p.ws + WS_CONCAT), cs_ptr(p, b, h, 0, 2 * jp), cs_ptr(p, b, h, 0, 2 * jp + 1), (size_t)66 * 16384,
                                  rowA, rowA + 128, h, log2_sigmoid(p.in[I_DECF][l * NH + h]), log2_sigmoid(p.in[I_DECB][l * NH + h]), p.in[I_GNG] + l * 512 + h * 128, (LAS char*)(F.lds + RING_OFF));
            }
#endif
#if FAST_ATT
            { const int lane_ = lane_id();
              const float s1 = wave_sum(p.in[I_LQ1][l * 64 + lane_] * p.in[I_LK1][l * 64 + lane_]), s2 = wave_sum(p.in[I_LQ2][l * 64 + lane_] * p.in[I_LK2][l * 64 + lane_]);
              const float li = lam_init_of(l), lam = __expf(s1) - __expf(s2) + li;
#if ATT_V3
              constexpr int nunits = 256 + (l == 0 ? 8 : 0);
              for (int rep_ = 0; rep_ < REP_ATT; ++rep_)
              for (int w = ((int)blockIdx.x + F.G - (8 % F.G)) % F.G; w < nunits; w += F.G) {
                  const int u = w < 256 ? ((w + 8) & 255) : w;
                  int b, h, qrow0, NT;
                  if (u < 256) { const int bh = u & 7, qb = u >> 3; b = bh >> 2; h = bh & 3; qrow0 = b * T + qb * 256; NT = (TC + T) / 64; }
                  else { const int bh = u - 256; b = bh >> 2; h = bh & 3; qrow0 = NL + b * TC; NT = TC / 64; }
                  att::ATT_UNIT(F.wave, (const bf16_t*)(p.ws + WS_PROJ), (const char*)(p.ws + WS_KT) + (size_t)(b * NH + h) * 132 * 16384, (const char*)(p.ws + WS_VT) + (size_t)(b * NH + h) * 132 * 16384, (bf16_t*)(p.ws + WS_CONCAT), qrow0, NT, h, (LAS char*)(F.lds + RING_OFF), lam, 1.f - li, p.in[I_SUBLN] + l * 128);
              }
#else
              constexpr int nunits = 512 + (l == 0 ? 16 : 0);
              for (int rep_ = 0; rep_ < REP_ATT; ++rep_)
              for (int u = blockIdx.x; u < nunits; u += F.G) {
                  int b, h, qrow0, NT;
                  if (u < 512) { const int bh = u & 7, qb = u >> 3; b = bh >> 2; h = bh & 3; qrow0 = b * T + qb * 128; NT = (TC + T) / 64; }
                  else { const int v = u - 512, bh = v & 7, blk = v >> 3; b = bh >> 2; h = bh & 3; qrow0 = NL + b * TC + blk * 128; NT = TC / 64; }
                  att::attn_unit(F.wave, (const bf16_t*)(p.ws + WS_PROJ), (const char*)(p.ws + WS_KT) + (size_t)(b * NH + h) * 132 * 16384, (const char*)(p.ws + WS_VT) + (size_t)(b * NH + h) * 132 * 16384, (bf16_t*)(p.ws + WS_CONCAT), qrow0, NT, h, (LAS char*)(F.lds + RING_OFF), lam, 1.f - li, p.in[I_SUBLN] + l * 128);
              }
#endif
            }
#endif
            SEAM(base + 4);
        }
        if (IN(base + 5)) {
            pg8::Gemm g{(const bf16_t*)(p.ws + WS_CONCAT), (const bf16_t*)(p.ws + W_WOUT) + (size_t)l * DM * DM, NR, DM, DM, DM};
            pg8::Order S; S.init(NL / 256, DM / 256, F.G, (int)blockIdx.x);
            pg8::EpiResid E{l == 0 ? p.in[I_X] : p.out, l == 0 ? p.in[I_CTX] : (const float*)(p.ws + WS_XRC), p.out, (float*)(p.ws + WS_XRC), modv(p, l, 0, 2), modv(p, l, 2, 2)};
            if (REP_F0 > 1 && l == 0) { pg8::gemm_phase<pg8::EpiResid, pg8::Order, true, true>(F.lds + RING_OFF, g, S, E, F.wave); }
            pg8::gemm_phase<pg8::EpiResid, pg8::Order, true, true>(F.lds + RING_OFF, g, S, E, F.wave);
            if constexpr (l == 0) {
                pg8::Gemm g2{(const bf16_t*)(p.ws + WS_CONCAT), (const bf16_t*)(p.ws + W_WOUT), NR, DM, 256, DM};
                pg8::SplitOrder S2; S2.init(NL / 256, 2, DM / 256, DM / 256, F.G, (int)blockIdx.x);
                pg8::EpiPartial E2{(float*)(p.ws + WS_PART), NL / 256, NC};
                pg8::gemm_phase<pg8::EpiPartial, pg8::SplitOrder, true, true>(F.lds + RING_OFF, g2, S2, E2, F.wave);
            }
            SEAM(base + 5);
        }
        if (IN(base + 6)) { if constexpr (l == 0) norm_phase(p, F, 0, 1, NR); else router_phase(p, F); SEAM(base + 6); }
        if constexpr (l == 0) {
            if (IN(8)) {
                pg8::Gemm g{(const bf16_t*)(p.ws + WS_HBUF), (const bf16_t*)(p.ws + W_FGU), NR, 2 * DFF, DM, DM};
                pg8::Order S; S.init(NR / 256, 2 * DFF / 256, F.G, (int)blockIdx.x);
                pg8::EpiSwiglu E{(bf16_t*)(p.ws + WS_ACT)};
                { pg8::gemm_phase<pg8::EpiSwiglu, pg8::Order, true, true>(F.lds + RING_OFF, g, S, E, F.wave); if (REP_H0 > 1) { pg8::gemm_phase<pg8::EpiSwiglu, pg8::Order, true, true>(F.lds + RING_OFF, g, S, E, F.wave); } }
                SEAM(8);
            }
            if (IN(9)) {
                pg8::Gemm g{(const bf16_t*)(p.ws + WS_ACT), (const bf16_t*)(p.ws + W_FD), NR, DM, DFF, DFF};
                pg8::Order S; S.init(NL / 256, DM / 256, F.G, (int)blockIdx.x);
                pg8::EpiResid E{p.out, (const float*)(p.ws + WS_XRC), p.out, (float*)(p.ws + WS_XRC), modv(p, 0, 0, 5), modv(p, 0, 2, 5)};
                if (REP_I0 > 1) { pg8::EpiResid Ed{p.out, (const float*)(p.ws + WS_XRC), (float*)(p.ws + WS_H2S), (float*)(p.ws + WS_H2S) + (size_t)NL * DM, modv(p, 0, 0, 5), modv(p, 0, 2, 5)}; pg8::gemm_phase<pg8::EpiResid, pg8::Order, true, true>(F.lds + RING_OFF, g, S, Ed, F.wave); }
                pg8::gemm_phase<pg8::EpiResid, pg8::Order, true, true>(F.lds + RING_OFF, g, S, E, F.wave);
                {
                    pg8::Gemm g2{(const bf16_t*)(p.ws + WS_ACT), (const bf16_t*)(p.ws + W_FD), NR, DM, 256, DFF};
                    pg8::SplitOrder S2; S2.init(NL / 256, 2, DM / 256, DFF / 256, F.G, (int)blockIdx.x);
                    pg8::EpiPartial E2{(float*)(p.ws + WS_PART), NL / 256, NC};
                    pg8::gemm_phase<pg8::EpiPartial, pg8::SplitOrder, true, true>(F.lds + RING_OFF, g2, S2, E2, F.wave);
                }
                SEAM(9);
            }
        } else {
            if (IN(17)) {
#if SEAM_CVT
                moe_cvt_rest(p, F);
#endif
                for (int rep_ = 0; rep_ < REP_G2; ++rep_) gather_phase(p, F); SEAM(17); }
            if (IN(18)) {
                moe_table(F);
                pg8::Gemm g{(const bf16_t*)(p.ws + WS_H2S), (const bf16_t*)(p.ws + W_MGU), MP_MAX, 2 * DFF, DM / 2, DM / 2};
                pg8::Order S; moe_order(F, S, 2 * DFF / 256, (long)2 * DFF * DM);
                pg8::EpiSwiglu8 E{(unsigned char*)(p.ws + WS_ACTS)};
                { pg8::gemm_phase<pg8::EpiSwiglu8, pg8::Order, true, true, true>(F.lds + RING_OFF, g, S, E, F.wave); if (REP_H1 > 1) { pg8::gemm_phase<pg8::EpiSwiglu8, pg8::Order, true, true, true>(F.lds + RING_OFF, g, S, E, F.wave); } }
                SEAM(18);
            }
            if (IN(19)) {
                moe_table(F);
                pg8::Gemm g{(const bf16_t*)(p.ws + WS_ACTS), (const bf16_t*)(p.ws + W_MD), MP_MAX, DM, DFF / 2, DFF / 2};
                pg8::Order S; moe_order(F, S, DM / 256, (long)DM * DFF);
                pg8::EpiMoeDown E{(bf16_t*)(p.ws + WS_YBUF), (const float*)(p.ws + WS_ROUTE) + 6 * NL + MP_MAX, 1.f / (W8_SCALE * A8_SCALE)};
                { pg8::gemm_phase<pg8::EpiMoeDown, pg8::Order, true, true, true>(F.lds + RING_OFF, g, S, E, F.wave); if (REP_I1 > 1) { pg8::gemm_phase<pg8::EpiMoeDown, pg8::Order, true, true, true>(F.lds + RING_OFF, g, S, E, F.wave); } }
                SEAM(19);
            }
            if (IN(20)) { combine_phase(p, F); }
        }
}
struct MArgs { Params p; int ph_lo, ph_hi, li, pad; };
constexpr int N_PHASES = 21;
__global__ void __launch_bounds__(NWAVES * 64, 2) mega(MArgs args) {
    extern __shared__ __attribute__((aligned(16))) unsigned char lds_raw[];
    const Params& p = args.p;
    Ctx F;
    F.lds = (LAS unsigned char*)lds_raw; F.MISC = (volatile LAS unsigned*)(F.lds + MISC_OFF);
    F.wave = __builtin_amdgcn_readfirstlane((int)threadIdx.x >> 6);
    const int lane_ = lane_id(), tid_ = F.wave * 64 + lane_;
    F.G = gridDim.x; F.gw = blockIdx.x * NWAVES + F.wave; F.NGW = F.G * NWAVES;
    F.ctl = (unsigned*)(p.ws + WS_CTL);
    for (int u = tid_; u < (LDS_BYTES - MISC_OFF) / 4; u += NWAVES * 64) ((LAS unsigned*)(F.lds + MISC_OFF))[u] = 0u;
    __syncthreads();
    XcdBarrier bar = xcd_barrier_post(F.ctl + CW_BAR + args.li * XCD_BAR_WORDS, F.MISC + 8, tid_ == 0);
    const int lo = args.ph_lo, hi = args.ph_hi;

    if (IN(0)) { for (int rep_ = 0; rep_ < REP_P0; ++rep_) { if (rep_) __syncthreads(); p0_prologue(p, F); } SEAM(0); }
    layer_phases<0>(p, F, bar, lo, hi);
    layer_phases<1>(p, F, bar, lo, hi);
#undef IN
#undef SEAM
}

#ifndef FAST_MASK
#define FAST_MASK 0x1u
#endif
static void launch_naive_e(const Params& p, int l, bool ret, bool att, hipStream_t stream) {
    const int nrows_mix = l == 0 ? NR : NL;
    if (ret) k_ret_naive<<<nrows_mix * NH / 4, 256, 0, stream>>>(p, l, nrows_mix);
    if (att) k_attn_naive<<<nrows_mix * NH / 4, 256, 0, stream>>>(p, l, nrows_mix);
}
static void launch_naive(const Params& p, int ph, hipStream_t stream) {
    const int l = ph >= 10 ? 1 : 0, rel = ph == 0 ? -1 : (ph - 1 - 9 * l);
    const int nrows_mix = l == 0 ? NR : NL;
    if (ph == 0) { k_mod<<<(2 * 3 * 6144 + 255) / 256, 256, 0, stream>>>(p); return; }
    switch (rel) {
    case 0: k_norm<<<NR / 4, 256, 0, stream>>>(p, l, 0, NR); break;
    case 1: k_gemm_proj<<<dim3(DP / 64, NR / 4), dim3(64, 4), 0, stream>>>(p, l); break;
    case 2: k_qkrope<<<NR / 4, 256, 0, stream>>>(p, l); break;
    case 3: break;
    case 4: launch_naive_e(p, l, true, true, stream); break;
    case 5: k_gemm_out<<<dim3(DM / 64, nrows_mix / 4), dim3(64, 4), 0, stream>>>(p, l); break;
    case 6: k_norm<<<nrows_mix / 4, 256, 0, stream>>>(p, l, 1, nrows_mix); break;
    case 7: if (l == 0) k_ffn_gu<<<dim3(DFF / 64, NR / 4), dim3(64, 4), 0, stream>>>(p); break;
    case 8: if (l == 0) k_ffn_down<<<dim3(DM / 64, NR / 4), dim3(64, 4), 0, stream>>>(p); else k_moe_gu<<<dim3(DFF / 64, 2 * NL / 4), dim3(64, 4), 0, stream>>>(p); break;
    case 9: k_moe_down<<<dim3(DM / 64, NL / 4), dim3(64, 4), 0, stream>>>(p); break;
    default: break;
    }
}
extern "C" void kernel_launch(void* const* d_in, const int* in_sizes, int n_in, void* d_out, int out_size, void* d_ws, size_t ws_size, hipStream_t stream) {
    static int grid = 0;
    if (grid == 0) {
        if (n_in != 28 || out_size != NL * DM || ws_size < WS_END) { fprintf(stderr, "kernel_launch: unexpected shapes (n_in %d out %d ws %zu need %zu)\n", n_in, out_size, ws_size, (size_t)WS_END); grid = -1; return; }
        int dev = 0, cus = 0, per_cu = 0;
        if (hipGetDevice(&dev) != hipSuccess || hipDeviceGetAttribute(&cus, hipDeviceAttributeMultiprocessorCount, dev) != hipSuccess) { grid = -1; return; }
        if (hipFuncSetAttribute((const void*)mega, hipFuncAttributeMaxDynamicSharedMemorySize, LDS_BYTES) != hipSuccess) { fprintf(stderr, "kernel_launch: hipFuncSetAttribute failed\n"); grid = -1; return; }
        if (hipOccupancyMaxActiveBlocksPerMultiprocessor(&per_cu, (const void*)mega, NWAVES * 64, LDS_BYTES) != hipSuccess || per_cu < 1) { fprintf(stderr, "kernel_launch: occupancy query says %d\n", per_cu); (void)hipGetLastError(); grid = -1; return; }
        grid = cus;
    }
    if (grid < 0) return;
    (void)hipMemsetAsync((char*)d_ws + WS_CTL, 0, CTL_ZERO_BYTES, stream);
    MArgs a{};
    for (int i = 0; i < 28; ++i) a.p.in[i] = (const float*)d_in[i];
    a.p.out = (float*)d_out; a.p.ws = (unsigned char*)d_ws;
    const unsigned mask = FAST_MASK;
    int li = 0, ph = 0;
    while (ph < N_PHASES) {
        if ((mask >> ph) & 1u) { int e = ph; bool cutE = false;
            while (e < N_PHASES && ((mask >> e) & 1u)) { const bool isE = (e == 5 || e == 14); ++e; if (isE && !(FAST_ATT && FAST_RET)) { cutE = true; break; } }
            a.ph_lo = ph; a.ph_hi = e; a.li = li++;
            hipLaunchKernelGGL(mega, dim3(grid), dim3(NWAVES * 64), LDS_BYTES, stream, a);
            if (cutE) launch_naive_e(a.p, e - 1 == 5 ? 0 : 1, !FAST_RET, !FAST_ATT, stream);
            ph = e; }
        else { launch_naive(a.p, ph, stream); ++ph; }
    }
}
```

```cpp
#include <hip/hip_runtime.h>
#include <cstdint>
#include <cstdio>
#define FAST_MASK 0x1fffffu
#define FAST_ATT 1
#define FAST_RET 1

constexpr int NB = 2, T = 8192, DM = 1024, TC = 256;
constexpr int NL = NB * T;
constexpr int NC = NB * TC;
constexpr int NR = NL + NC;
constexpr int DP = 3584, DFF = 2816, NE = 8, NH = 4;
constexpr float EPS = 1e-6f;
constexpr int C_RQ = 0, C_RK = 512, C_RV = 1024, C_RG = 1536, C_DQ = 2048, C_DK = 2560, C_DV = 3072;
constexpr int MP_MAX = 2 * NL + NE * 256;

typedef unsigned short bf16_t;
__device__ __forceinline__ float bf2f(bf16_t v) { return __uint_as_float(((unsigned)v) << 16); }
__device__ __forceinline__ bf16_t f2bf(float f) { unsigned u = __float_as_uint(f); u += 0x7fffu + ((u >> 16) & 1u); return (bf16_t)(u >> 16); }
typedef float f32x2_t __attribute__((ext_vector_type(2)));
typedef __bf16 bf16x2_t __attribute__((ext_vector_type(2)));
__device__ __forceinline__ unsigned pk2(float lo, float hi) { const f32x2_t v = {lo, hi}; const bf16x2_t b = __builtin_convertvector(v, bf16x2_t); return __builtin_bit_cast(unsigned, b); }
__device__ __forceinline__ unsigned pk4_fp8(float a, float b, float c, float d) {
    a = __builtin_amdgcn_fmed3f(a, -448.f, 448.f); b = __builtin_amdgcn_fmed3f(b, -448.f, 448.f); c = __builtin_amdgcn_fmed3f(c, -448.f, 448.f); d = __builtin_amdgcn_fmed3f(d, -448.f, 448.f);
    int r = 0; r = __builtin_amdgcn_cvt_pk_fp8_f32(a, b, r, false); r = __builtin_amdgcn_cvt_pk_fp8_f32(c, d, r, true); return (unsigned)r;
}
constexpr float W8_SCALE = 64.f, A8_SCALE = 8.f;
__device__ __forceinline__ float wave_sum(float v) {
#pragma unroll
    for (int o = 1; o < 64; o <<= 1) v += __shfl_xor(v, o);
    return v;
}
__device__ __forceinline__ int lane_id() { int l = (int)__builtin_amdgcn_mbcnt_hi(~0u, __builtin_amdgcn_mbcnt_lo(~0u, 0u)); asm volatile("" : "+v"(l)); return l; }
__device__ __forceinline__ float siluf(float v) { return v / (1.f + __expf(-v)); }

constexpr size_t MiB = 1u << 20;
constexpr size_t WS_CTL = 0, CTL_ZERO_BYTES = 1 * MiB;
constexpr size_t WS_MODV = 1 * MiB;
constexpr size_t WS_ROUTE = 2 * MiB;
constexpr size_t WS_XRC = 3 * MiB;
constexpr size_t WS_W = 6 * MiB;
constexpr size_t W_WIN = WS_W;
constexpr size_t W_WOUT = W_WIN + (size_t)2 * DP * DM * 2;
constexpr size_t W_FGU = W_WOUT + (size_t)2 * DM * DM * 2;
constexpr size_t W_FD = W_FGU + (size_t)2 * DFF * DM * 2;
constexpr size_t W_MGU = W_FD + (size_t)DM * DFF * 2;
constexpr size_t W_MD = W_MGU + (size_t)NE * 2 * DFF * DM * 2;
constexpr size_t W_END = W_MD + (size_t)NE * DM * DFF * 2;
constexpr size_t WS_HBUF = 173 * MiB;
constexpr size_t WS_PROJ = 206 * MiB;
constexpr size_t WS_CONCAT = 322 * MiB;
constexpr size_t WS_ACT = 206 * MiB;
constexpr size_t WS_ACTS = 173 * MiB;
constexpr size_t WS_H2S = 361 * MiB;
constexpr size_t WS_KT = 394 * MiB, WS_VT = WS_KT + (size_t)NB * NH * 132 * 16384;
static_assert(WS_VT + (size_t)NB * NH * 132 * 16384 <= 429 * MiB && WS_H2S + (size_t)NB * NH * 2 * 66 * 32768 <= WS_KT, "K/V tile images");
constexpr size_t WS_YBUF = WS_H2S, WS_CS = WS_H2S, WS_PART = WS_H2S;
constexpr size_t WS_END = 430 * MiB;
static_assert(W_END <= WS_HBUF && WS_ACTS + (size_t)MP_MAX * DFF * 2 <= WS_H2S && WS_H2S + (size_t)MP_MAX * DM * 2 <= WS_END && WS_ACT + (size_t)2 * NL * DFF * 2 <= WS_END, "ws map");
constexpr int CW_BAR = 4096;
constexpr int CW_CNT = 200000;

struct Params {
    const float* in[28];
    float* out;
    unsigned char* ws;
};
enum { I_X = 0, I_C, I_CTX, I_CCTX, I_ADAW, I_ADAB, I_N1G, I_N2G, I_WIN, I_DECF, I_DECB, I_GNG, I_QNG, I_KNG, I_LQ1, I_LK1, I_LQ2, I_LK2, I_SUBLN, I_WOUT,
       I_FWG, I_FWU, I_FWD, I_RW, I_RB, I_MWG, I_MWU, I_MWD };

__device__ __forceinline__ int rowtype(int m) { return m < NL ? m / T : 2; }
__device__ __forceinline__ const float* modv(const Params& p, int l, int rt, int i) { return (const float*)(p.ws + WS_MODV) + ((size_t)(l * 3 + rt) * 6 + i) * DM; }
__device__ __forceinline__ float* xr_row(const Params& p, int m) { return m < NL ? p.out + (size_t)m * DM : (float*)(p.ws + WS_XRC) + (size_t)(m - NL) * DM; }
__device__ __forceinline__ float lam_init_of(int l) { return l == 0 ? 0.2f : (0.8f - 0.6f * 0.74081822068171788f); }

#ifndef SEAM_CVT
#define SEAM_CVT 1
#endif
#ifndef ATT_UNIT
#define ATT_UNIT attn_unit3q
#endif
#ifndef FAST_ATT
#define FAST_ATT 0
#endif
#ifndef FAST_RET
#define FAST_RET 0
#endif
#ifndef ATT_V3
#define ATT_V3 1
#endif
__global__ void k_mod(Params p) {
    const int idx = blockIdx.x * blockDim.x + threadIdx.x;
    if (idx >= 2 * 3 * 6144) return;
    const int n = idx % 6144, rt = (idx / 6144) % 3, l = idx / (6144 * 3);
    const float* cv = rt < 2 ? p.in[I_C] + rt * DM : p.in[I_CCTX];
    const float* W = p.in[I_ADAW] + (size_t)l * DM * 6144;
    float acc = 0.f;
    for (int k = 0; k < DM; ++k) acc += siluf(cv[k]) * W[(size_t)k * 6144 + n];
    ((float*)(p.ws + WS_MODV))[(size_t)(l * 3 + rt) * 6144 + n] = acc + p.in[I_ADAB][l * 6144 + n];
}

__global__ void k_norm(Params p, int l, int which, int nrows) {
    const int m = blockIdx.x * (blockDim.x / 64) + (threadIdx.x >> 6), lane = threadIdx.x & 63;
    if (m >= nrows) return;
    const float* xrow;
    if (l == 0 && which == 0) xrow = m < NL ? p.in[I_X] + (size_t)m * DM : p.in[I_CTX] + (size_t)(m - NL) * DM;
    else xrow = xr_row(p, m);
    const int rt = rowtype(m);
    const float* g = p.in[which ? I_N2G : I_N1G] + l * DM;
    const float* sh = modv(p, l, rt, which ? 3 : 0);
    const float* sc = modv(p, l, rt, which ? 4 : 1);
    float v[16]; float ss = 0.f;
#pragma unroll
    for (int j = 0; j < 4; ++j) { const float4 t = *(const float4*)(xrow + 256 * j + 4 * lane); v[4 * j] = t.x; v[4 * j + 1] = t.y; v[4 * j + 2] = t.z; v[4 * j + 3] = t.w; ss += t.x * t.x + t.y * t.y + t.z * t.z + t.w * t.w; }
    const float r = rsqrtf(wave_sum(ss) * (1.f / DM) + EPS);
    bf16_t* hb = (bf16_t*)(p.ws + WS_HBUF) + (size_t)m * DM;
#pragma unroll
    for (int j = 0; j < 4; ++j)
#pragma unroll
        for (int q = 0; q < 4; ++q) { const int col = 256 * j + 4 * lane + q; const float y = v[4 * j + q] * r * g[col]; v[4 * j + q] = y * (1.f + sc[col]) + sh[col]; hb[col] = f2bf(v[4 * j + q]); }
    if (l == 1 && which == 1) {
        const float* rw = p.in[I_RW]; float lg[8];
#pragma unroll
        for (int e = 0; e < 8; ++e) { float a = 0.f;
#pragma unroll
            for (int j = 0; j < 4; ++j)
#pragma unroll
                for (int q = 0; q < 4; ++q) a += v[4 * j + q] * rw[(size_t)(256 * j + 4 * lane + q) * 8 + e];
            lg[e] = wave_sum(a) + p.in[I_RB][e]; }
        int i1 = 0; float v1 = lg[0];
#pragma unroll
        for (int e = 1; e < 8; ++e) if (lg[e] > v1) { v1 = lg[e]; i1 = e; }
        int i2 = -1; float v2 = -3.4e38f;
#pragma unroll
        for (int e = 0; e < 8; ++e) if (e != i1 && lg[e] > v2) { v2 = lg[e]; i2 = e; }
        const float w1 = 1.f / (1.f + __expf(v2 - v1));
        if (lane == 0) { int* te = (int*)(p.ws + WS_ROUTE); float* tw = (float*)(p.ws + WS_ROUTE) + 2 * NL; te[2 * m] = i1; te[2 * m + 1] = i2; tw[2 * m] = w1; tw[2 * m + 1] = 1.f - w1; }
    }
}

__global__ void k_gemm_proj(Params p, int l) {
    const int n = blockIdx.x * 64 + threadIdx.x, m = blockIdx.y * 4 + threadIdx.y;
    const bf16_t* a = (const bf16_t*)(p.ws + WS_HBUF) + (size_t)m * DM;
    const float* W = p.in[I_WIN] + (size_t)l * DM * DP + n;
    float acc = 0.f;
#pragma unroll 8
    for (int k = 0; k < DM; ++k) acc += bf2f(a[k]) * W[(size_t)k * DP];
    if (n >= C_RK && n < C_RV) acc *= 0.08838834764831845f;
    ((bf16_t*)(p.ws + WS_PROJ))[(size_t)m * DP + n] = f2bf(acc);
}

__global__ void k_qkrope(Params p, int l) {
    const int m = blockIdx.x * (blockDim.x / 64) + (threadIdx.x >> 6), lane = threadIdx.x & 63;
    if (m >= NR) return;
    bf16_t* row = (bf16_t*)(p.ws + WS_PROJ) + (size_t)m * DP;
    const bool lat = m < NL; const int t = m % T;
    const int j = lane & 31; const float pos = (float)((j < 16) ? (t / 64) : (t % 64));
    const float inv_freq = exp2f(-(float)(j & 15) * (13.287712379549449f / 16.f));
    const float ang = pos * inv_freq; const float cs = __cosf(ang), sn = __sinf(ang);
    for (int part = 0; part < 2; ++part) {
        const float* g = p.in[part ? I_KNG : I_QNG] + l * 64;
        for (int hc = 0; hc < 8; ++hc) {
            bf16_t* q = row + (part ? C_DK : C_DQ) + hc * 64;
            const float v = bf2f(q[lane]);
            const float r = rsqrtf(wave_sum(v * v) * (1.f / 64.f) + EPS);
            float y = v * r * g[lane];
            if (lat) { const float o = __shfl_xor(y, 32); y = lane < 32 ? y * cs - o * sn : y * cs + o * sn; }
            if (part == 0) y *= 0.18033688011112042f;
            q[lane] = f2bf(y);
        }
    }
}

__global__ void k_ret_naive(Params p, int l, int nrows) {
    const int w = blockIdx.x * (blockDim.x / 64) + (threadIdx.x >> 6), lane = threadIdx.x & 63;
    if (w >= nrows * NH) return;
    const int m = w / NH, h = w % NH;
    const bf16_t* proj = (const bf16_t*)(p.ws + WS_PROJ);
    const float df = p.in[I_DECF][l * NH + h], db = p.in[I_DECB][l * NH + h];
    const float lgf = -log1pf(__expf(-df)), lgb = -log1pf(__expf(-db));
    const bf16_t* qrow = proj + (size_t)m * DP + C_RQ + h * 128 + 2 * lane;
    const float q0 = bf2f(qrow[0]), q1 = bf2f(qrow[1]);
    float o0 = 0.f, o1 = 0.f;
    if (m < NL) {
        const int b = m / T, t = m % T;
        for (int s = 0; s < T; ++s) {
            const bf16_t* kr = proj + (size_t)(b * T + s) * DP + h * 128 + 2 * lane;
            const float dot = wave_sum(q0 * bf2f(kr[C_RK]) + q1 * bf2f(kr[C_RK + 1]));
            const float wgt = s < t ? __expf(lgf * (float)(t - s)) : (s == t ? 2.f : __expf(lgb * (float)(s - t)));
            o0 += wgt * dot * bf2f(kr[C_RV]); o1 += wgt * dot * bf2f(kr[C_RV + 1]);
        }
        for (int i = 0; i < TC; ++i) {
            const bf16_t* kr = proj + (size_t)(NL + b * TC + i) * DP + h * 128 + 2 * lane;
            const float dot = wave_sum(q0 * bf2f(kr[C_RK]) + q1 * bf2f(kr[C_RK + 1]));
            const float wgt = __expf(lgf * (float)(t + TC - i)) + __expf(lgb * (float)(T - t + i));
            o0 += wgt * dot * bf2f(kr[C_RV]); o1 += wgt * dot * bf2f(kr[C_RV + 1]);
        }
    } else {
        const int b = (m - NL) / TC, t = (m - NL) % TC;
        for (int s = 0; s < TC; ++s) {
            const bf16_t* kr = proj + (size_t)(NL + b * TC + s) * DP + h * 128 + 2 * lane;
            const float dot = wave_sum(q0 * bf2f(kr[C_RK]) + q1 * bf2f(kr[C_RK + 1]));
            const float wgt = s < t ? __expf(lgf * (float)(t - s)) : (s == t ? 2.f : __expf(lgb * (float)(s - t)));
            o0 += wgt * dot * bf2f(kr[C_RV]); o1 += wgt * dot * bf2f(kr[C_RV + 1]);
        }
    }
    const float mu = wave_sum(o0 + o1) * (1.f / 128.f);
    const float d0 = o0 - mu, d1 = o1 - mu;
    const float r = rsqrtf(wave_sum(d0 * d0 + d1 * d1) * (1.f / 128.f) + EPS);
    const float* gn = p.in[I_GNG] + l * 512 + h * 128 + 2 * lane;
    const bf16_t* gr = proj + (size_t)m * DP + C_RG + h * 128 + 2 * lane;
    bf16_t* cc = (bf16_t*)(p.ws + WS_CONCAT) + (size_t)m * DM + h * 128 + 2 * lane;
    cc[0] = f2bf(siluf(bf2f(gr[0])) * d0 * r * gn[0]);
    cc[1] = f2bf(siluf(bf2f(gr[1])) * d1 * r * gn[1]);
}

__global__ void k_attn_naive(Params p, int l, int nrows) {
    const int w = blockIdx.x * (blockDim.x / 64) + (threadIdx.x >> 6), lane = threadIdx.x & 63;
    if (w >= nrows * NH) return;
    const int m = w / NH, h = w % NH;
    const bf16_t* proj = (const bf16_t*)(p.ws + WS_PROJ);
    const bool lat = m < NL; const int b = lat ? m / T : (m - NL) / TC;
    float O[2][2];
    for (int c = 0; c < 2; ++c) {
        const float q = bf2f(proj[(size_t)m * DP + C_DQ + h * 128 + c * 64 + lane]);
        float mx = -1e30f, ls = 0.f, o0 = 0.f, o1 = 0.f;
        const int nk = lat ? TC + T : TC;
        for (int s = 0; s < nk; ++s) {
            const int mk = s < TC ? NL + b * TC + s : b * T + (s - TC);
            const bf16_t* kr = proj + (size_t)mk * DP + h * 128;
            const float sc = wave_sum(q * bf2f(kr[C_DK + c * 64 + lane]));
            const float mn = fmaxf(mx, sc), al = exp2f(mx - mn), pp = exp2f(sc - mn);
            ls = ls * al + pp; o0 = o0 * al + pp * bf2f(kr[C_DV + 2 * lane]); o1 = o1 * al + pp * bf2f(kr[C_DV + 2 * lane + 1]); mx = mn;
        }
        O[c][0] = o0 / ls; O[c][1] = o1 / ls;
    }
    float s1 = 0.f, s2 = 0.f;
    { const float a = p.in[I_LQ1][l * 64 + lane] * p.in[I_LK1][l * 64 + lane], bq = p.in[I_LQ2][l * 64 + lane] * p.in[I_LK2][l * 64 + lane]; s1 = wave_sum(a); s2 = wave_sum(bq); }
    const float li = lam_init_of(l), lam = __expf(s1) - __expf(s2) + li;
    const float d0 = O[0][0] - lam * O[1][0], d1 = O[0][1] - lam * O[1][1];
    const float r = rsqrtf(wave_sum(d0 * d0 + d1 * d1) * (1.f / 128.f) + EPS);
    const float* sg = p.in[I_SUBLN] + l * 128 + 2 * lane;
    bf16_t* cc = (bf16_t*)(p.ws + WS_CONCAT) + (size_t)m * DM + 512 + h * 128 + 2 * lane;
    cc[0] = f2bf(d0 * r * sg[0] * (1.f - li)); cc[1] = f2bf(d1 * r * sg[1] * (1.f - li));
}

__global__ void k_gemm_out(Params p, int l) {
    const int n = blockIdx.x * 64 + threadIdx.x, m = blockIdx.y * 4 + threadIdx.y;
    const bf16_t* a = (const bf16_t*)(p.ws + WS_CONCAT) + (size_t)m * DM;
    const float* W = p.in[I_WOUT] + (size_t)l * DM * DM + n;
    float acc = 0.f;
#pragma unroll 8
    for (int k = 0; k < DM; ++k) acc += bf2f(a[k]) * W[(size_t)k * DM];
    const float xin = l == 0 ? (m < NL ? p.in[I_X][(size_t)m * DM + n] : p.in[I_CTX][(size_t)(m - NL) * DM + n]) : xr_row(p, m)[n];
    xr_row(p, m)[n] = xin + modv(p, l, rowtype(m), 2)[n] * acc;
}

__global__ void k_ffn_gu(Params p) {
    const int j = blockIdx.x * 64 + threadIdx.x, m = blockIdx.y * 4 + threadIdx.y;
    const bf16_t* a = (const bf16_t*)(p.ws + WS_HBUF) + (size_t)m * DM;
    const float* Wg = p.in[I_FWG] + j; const float* Wu = p.in[I_FWU] + j;
    float ag = 0.f, au = 0.f;
#pragma unroll 8
    for (int k = 0; k < DM; ++k) { const float x = bf2f(a[k]); ag += x * Wg[(size_t)k * DFF]; au += x * Wu[(size_t)k * DFF]; }
    ((bf16_t*)(p.ws + WS_ACT))[(size_t)m * DFF + j] = f2bf(siluf(ag) * au);
}
__global__ void k_ffn_down(Params p) {
    const int n = blockIdx.x * 64 + threadIdx.x, m = blockIdx.y * 4 + threadIdx.y;
    const bf16_t* a = (const bf16_t*)(p.ws + WS_ACT) + (size_t)m * DFF;
    const float* W = p.in[I_FWD] + n;
    float acc = 0.f;
#pragma unroll 8
    for (int k = 0; k < DFF; ++k) acc += bf2f(a[k]) * W[(size_t)k * DM];
    xr_row(p, m)[n] += modv(p, 0, rowtype(m), 5)[n] * acc;
}
__global__ void k_moe_gu(Params p) {
    const int j = blockIdx.x * 64 + threadIdx.x, ts = blockIdx.y * 4 + threadIdx.y;
    const int t = ts >> 1; const int e = ((const int*)(p.ws + WS_ROUTE))[ts];
    const bf16_t* a = (const bf16_t*)(p.ws + WS_HBUF) + (size_t)t * DM;
    const float* Wg = p.in[I_MWG] + (size_t)e * DM * DFF + j; const float* Wu = p.in[I_MWU] + (size_t)e * DM * DFF + j;
    float ag = 0.f, au = 0.f;
#pragma unroll 8
    for (int k = 0; k < DM; ++k) { const float x = bf2f(a[k]); ag += x * Wg[(size_t)k * DFF]; au += x * Wu[(size_t)k * DFF]; }
    ((bf16_t*)(p.ws + WS_ACT))[(size_t)ts * DFF + j] = f2bf(siluf(ag) * au);
}
__global__ void k_moe_down(Params p) {
    const int n = blockIdx.x * 64 + threadIdx.x, t = blockIdx.y * 4 + threadIdx.y;
    const int* te = (const int*)(p.ws + WS_ROUTE); const float* tw = (const float*)(p.ws + WS_ROUTE) + 2 * NL;
    float y = 0.f;
    for (int s = 0; s < 2; ++s) {
        const bf16_t* a = (const bf16_t*)(p.ws + WS_ACT) + (size_t)(2 * t + s) * DFF;
        const float* W = p.in[I_MWD] + (size_t)te[2 * t + s] * DFF * DM + n;
        float acc = 0.f;
#pragma unroll 8
        for (int k = 0; k < DFF; ++k) acc += bf2f(a[k]) * W[(size_t)k * DM];
        y += tw[2 * t + s] * acc;
    }
    p.out[(size_t)t * DM + n] += modv(p, 1, t / T, 5)[n] * y;
}


typedef unsigned v2u __attribute__((ext_vector_type(2)));
namespace pg8 {
#define PG8_LAS __attribute__((address_space(3)))
typedef unsigned short bf16_t;
typedef short bf16x8 __attribute__((ext_vector_type(8)));
typedef float f32x4 __attribute__((ext_vector_type(4)));
typedef unsigned u32x4 __attribute__((ext_vector_type(4)));
typedef int i32x4 __attribute__((ext_vector_type(4)));
typedef int i32x8 __attribute__((ext_vector_type(8)));
constexpr int BM = 256, BK = 64, HALF = 128, HTB = HALF * BK * 2  , STAGE_BYTES = 8 * HTB, NXCD = 8, WGM = 8;

__host__ __device__ __forceinline__ int lds_byte(int r, int c) { const int st = (r >> 4) * 2 + (c >> 5), rr = r & 15, cc = c & 31, ob = rr * 64 + cc * 2; return st * 1024 + (ob ^ (((ob >> 9) & 1) << 5)); }
__host__ __device__ __forceinline__ void stage_rc(int b, int& R, int& C) { const int st = b / 1024, sb = b % 1024, swz = sb ^ (((sb >> 9) & 1) << 5); R = (st >> 1) * 16 + swz / 64; C = (st & 1) * 32 + (swz % 64) / 2; }
__host__ __device__ __forceinline__ int perm32(int rho) { const int n = rho >> 4, i = rho & 15; return 8 * (i >> 2) + 4 * n + (i & 3); }

struct Unit { int pm, pn; long bofs, kofs; };
struct Gemm { const bf16_t* A; const bf16_t* Bt; int M, N, K, ld; };

struct Order {
    int nM, nN, nwg, G, c;
    int e1, e2, e3, e4, e5, e6, e7; long estride;
    __device__ __forceinline__ void init(int nM_, int nN_, int G_, int c_) { nM = nM_; nN = nN_; nwg = nM * nN; G = G_; c = c_; estride = 0; e1 = e2 = e3 = e4 = e5 = e6 = e7 = 0; }
    __device__ __forceinline__ bool next(int i, Unit& u) const {
        const long L = (long)i * G + c; if (L >= nwg) return false;
        int wgid = (int)L; { const int q = nwg / NXCD, r = nwg % NXCD, xcd = wgid % NXCD, off = wgid / NXCD; wgid = (xcd < r ? xcd * (q + 1) : r * (q + 1) + (xcd - r) * q) + off; }
        const int nig = WGM * nN, gid = wgid / nig, fm = gid * WGM, gsz = (nM - fm) < WGM ? (nM - fm) : WGM;
        u.pm = fm + ((wgid % nig) % gsz); u.pn = (wgid % nig) / gsz;
        const int e = (u.pm >= e1) + (u.pm >= e2) + (u.pm >= e3) + (u.pm >= e4) + (u.pm >= e5) + (u.pm >= e6) + (u.pm >= e7);
        u.bofs = estride ? (long)e * estride : 0; u.kofs = 0;
        return true;
    }
    __device__ __forceinline__ void a_ready(const Unit&) const {}
    __device__ __forceinline__ void done(const Unit&) const {}
};

struct SplitOrder {
    int nN, ns, nwg, G, c, pm0;
    __device__ __forceinline__ void init(int pm0_, int npan, int nN_, int ns_, int G_, int c_) { pm0 = pm0_; nN = nN_; ns = ns_; nwg = npan * nN * ns; G = G_; c = c_; }
    __device__ __forceinline__ bool next(int i, Unit& u) const {
        const int L = i * G + c; if (L >= nwg) return false;
        const int ks = L % ns, rest = L / ns; u.pn = rest % nN; u.pm = pm0 + rest / nN; u.bofs = 0; u.kofs = (long)ks * 256 * 2; return true;
    }
    __device__ __forceinline__ void a_ready(const Unit&) const {}
    __device__ __forceinline__ void done(const Unit&) const {}
};
__device__ __forceinline__ unsigned cvt_pk_bf16(float lo, float hi) { unsigned r; asm volatile("v_cvt_pk_bf16_f32 %0, %1, %2" : "=v"(r) : "v"(lo), "v"(hi)); return r; }
__device__ __forceinline__ float silu_fast(float x) { return x * __builtin_amdgcn_rcpf(1.f + __builtin_amdgcn_exp2f(-1.4426950408889634f * x)); }

struct EpiProj {
    static constexpr bool PERM = true, AFTER_DRAIN = false;
    bf16_t* O; char* VT;
    __device__ __forceinline__ void operator()(const f32x4 (&acc)[2][2][4][2], const Unit& u, int wr, int wc, int fr, int fq) const {
        const int row0 = u.pm * BM + wr * 64 + fr, col0 = u.pn * BM + wc * 32 + 8 * fq;
#if FAST_ATT
        if (u.pn >= C_DV / BM) {
#pragma unroll
            for (int ai = 0; ai < 2; ++ai)
#pragma unroll
                for (int m = 0; m < 4; ++m) { const int row = row0 + ai * HALF + m * 16;
                    const int bb = row < NL ? row / T : (row - NL) / TC, kidx = row < NL ? TC + (row % T) : (row - NL) % TC, key = kidx & 63;
                    const int pos = (key & ~0xC) | ((key & 4) << 1) | ((key & 8) >> 1), ch = pos >> 3;
#pragma unroll
                    for (int bj = 0; bj < 2; ++bj) { const int hh = 2 * (u.pn - C_DV / BM) + bj;
                        char* tp = VT + ((size_t)(bb * NH + hh) * 132 + (kidx >> 6)) * 16384 + (wc * 32 + 8 * fq) * 128 + (pos & 7) * 2;
#pragma unroll
                        for (int n = 0; n < 2; ++n) { const f32x4 v = acc[ai][bj][m][n];
                            const unsigned w0 = cvt_pk_bf16(v[0], v[1]), w1 = cvt_pk_bf16(v[2], v[3]);
                            char* q0 = tp + (4 * n) * 128 + (((ch & 4) | ((ch & 3) ^ (2 * n))) << 4); char* q1 = tp + (4 * n) * 128 + (((ch & 4) | ((ch & 3) ^ (2 * n + 1))) << 4);
                            *(unsigned short*)(q0) = (unsigned short)w0; *(unsigned short*)(q0 + 128) = (unsigned short)(w0 >> 16);
                            *(unsigned short*)(q1 + 256) = (unsigned short)w1; *(unsigned short*)(q1 + 384) = (unsigned short)(w1 >> 16); } } }
            return;
        }
#endif
        const float sc = (u.pn == 2 || u.pn == 3) ? 0.08838834764831845f : 1.f;
#pragma unroll
        for (int ai = 0; ai < 2; ++ai)
#pragma unroll
            for (int m = 0; m < 4; ++m) { bf16_t* rowp = O + (size_t)(row0 + ai * HALF + m * 16) * DP + col0;
#pragma unroll
                for (int bj = 0; bj < 2; ++bj) { const f32x4 v0 = acc[ai][bj][m][0] * sc, v1 = acc[ai][bj][m][1] * sc;
                    u32x4 w; w.x = cvt_pk_bf16(v0[0], v0[1]); w.y = cvt_pk_bf16(v0[2], v0[3]); w.z = cvt_pk_bf16(v1[0], v1[1]); w.w = cvt_pk_bf16(v1[2], v1[3]);
                    *(u32x4*)(rowp + bj * HALF) = w; } }
    }
};
struct EpiResid {
    static constexpr bool PERM = false, AFTER_DRAIN = false;
    const float* base_lat; const float* base_ctx; float* out_lat; float* out_ctx; const float* gl; const float* gc;
    __device__ __forceinline__ void operator()(const f32x4 (&acc)[2][2][4][2], const Unit& u, int wr, int wc, int fr, int fq) const {
        const bool lat = u.pm < NL / BM;
        const int row0 = (lat ? u.pm * BM : u.pm * BM - NL) + wr * 64 + fr, col0 = u.pn * BM + wc * 32 + 4 * fq;
        const float* base = lat ? base_lat : base_ctx; float* out = lat ? out_lat : out_ctx;
        const float* gate = lat ? gl + (size_t)(u.pm / (T / BM)) * 6 * DM : gc;
        f32x4 gv[2][2];
#pragma unroll
        for (int bj = 0; bj < 2; ++bj)
#pragma unroll
            for (int n = 0; n < 2; ++n) gv[bj][n] = *(const f32x4*)(gate + col0 + bj * HALF + n * 16);
#pragma unroll
        for (int ai = 0; ai < 2; ++ai)
#pragma unroll
            for (int m = 0; m < 4; ++m) { const size_t off = (size_t)(row0 + ai * HALF + m * 16) * DM + col0;
#pragma unroll
                for (int bj = 0; bj < 2; ++bj)
#pragma unroll
                    for (int n = 0; n < 2; ++n) { const f32x4 bs = *(const f32x4*)(base + off + bj * HALF + n * 16); *(f32x4*)(out + off + bj * HALF + n * 16) = bs + gv[bj][n] * acc[ai][bj][m][n]; }
                asm volatile("" ::: "memory"); }
    }
};
struct EpiPartial {
    static constexpr bool PERM = false, AFTER_DRAIN = false;
    float* part; int pm0, nrows;
    __device__ __forceinline__ void operator()(const f32x4 (&acc)[2][2][4][2], const Unit& u, int wr, int wc, int fr, int fq) const {
        const int row0 = (u.pm - pm0) * BM + wr * 64 + fr, col0 = u.pn * BM + wc * 32 + 4 * fq;
        float* base = part + (size_t)(u.kofs / 512) * nrows * DM;
#pragma unroll
        for (int ai = 0; ai < 2; ++ai)
#pragma unroll
            for (int m = 0; m < 4; ++m) { float* rowp = base + (size_t)(row0 + ai * HALF + m * 16) * DM + col0;
#pragma unroll
                for (int bj = 0; bj < 2; ++bj)
#pragma unroll
                    for (int n = 0; n < 2; ++n) *(f32x4*)(rowp + bj * HALF + n * 16) = acc[ai][bj][m][n]; }
    }
};
struct EpiSwiglu {
    static constexpr bool PERM = true, AFTER_DRAIN = false;
    bf16_t* O;
    __device__ __forceinline__ void operator()(const f32x4 (&acc)[2][2][4][2], const Unit& u, int wr, int wc, int fr, int fq) const {
        const int row0 = u.pm * BM + wr * 64 + fr, col0 = u.pn * HALF + wc * 32 + 8 * fq;
#pragma unroll
        for (int ai = 0; ai < 2; ++ai)
#pragma unroll
            for (int m = 0; m < 4; ++m) { bf16_t* rowp = O + (size_t)(row0 + ai * HALF + m * 16) * DFF + col0;
                const f32x4 g0 = acc[ai][0][m][0], g1 = acc[ai][0][m][1], u0 = acc[ai][1][m][0], u1 = acc[ai][1][m][1];
                u32x4 w; w.x = cvt_pk_bf16(silu_fast(g0[0]) * u0[0], silu_fast(g0[1]) * u0[1]); w.y = cvt_pk_bf16(silu_fast(g0[2]) * u0[2], silu_fast(g0[3]) * u0[3]);
                w.z = cvt_pk_bf16(silu_fast(g1[0]) * u1[0], silu_fast(g1[1]) * u1[1]); w.w = cvt_pk_bf16(silu_fast(g1[2]) * u1[2], silu_fast(g1[3]) * u1[3]);
                *(u32x4*)rowp = w; }
    }
};
struct EpiSwiglu8 {
    static constexpr bool PERM = true, AFTER_DRAIN = false;
    unsigned char* O;
    __device__ __forceinline__ void operator()(const f32x4 (&acc)[2][2][4][2], const Unit& u, int wr, int wc, int fr, int fq) const {
        const int row0 = u.pm * BM + wr * 64 + fr, col0 = u.pn * HALF + wc * 32 + 8 * fq;
        constexpr float WI = 1.f / W8_SCALE;
#pragma unroll
        for (int ai = 0; ai < 2; ++ai)
#pragma unroll
            for (int m = 0; m < 4; ++m) { unsigned char* rowp = O + (size_t)(row0 + ai * HALF + m * 16) * DFF + col0;
                const f32x4 g0 = acc[ai][0][m][0] * WI, g1 = acc[ai][0][m][1] * WI, u0 = acc[ai][1][m][0] * (WI * A8_SCALE), u1 = acc[ai][1][m][1] * (WI * A8_SCALE);
                v2u w; w.x = pk4_fp8(silu_fast(g0[0]) * u0[0], silu_fast(g0[1]) * u0[1], silu_fast(g0[2]) * u0[2], silu_fast(g0[3]) * u0[3]);
                w.y = pk4_fp8(silu_fast(g1[0]) * u1[0], silu_fast(g1[1]) * u1[1], silu_fast(g1[2]) * u1[2], silu_fast(g1[3]) * u1[3]);
                *(v2u*)rowp = w; }
    }
};
struct EpiMoeDown {
    static constexpr bool PERM = true, AFTER_DRAIN = false;
    bf16_t* O; const float* rgate; float scale;
    __device__ __forceinline__ void operator()(const f32x4 (&acc)[2][2][4][2], const Unit& u, int wr, int wc, int fr, int fq) const {
        const int row0 = u.pm * BM + wr * 64 + fr, col0 = u.pn * BM + wc * 32 + 8 * fq;
#pragma unroll
        for (int ai = 0; ai < 2; ++ai)
#pragma unroll
            for (int m = 0; m < 4; ++m) { const int row = row0 + ai * HALF + m * 16; const float sc = rgate[row] * scale; bf16_t* rowp = O + (size_t)row * DM + col0;
#pragma unroll
                for (int bj = 0; bj < 2; ++bj) { const f32x4 v0 = acc[ai][bj][m][0] * sc, v1 = acc[ai][bj][m][1] * sc;
                    u32x4 w; w.x = cvt_pk_bf16(v0[0], v0[1]); w.y = cvt_pk_bf16(v0[2], v0[3]); w.z = cvt_pk_bf16(v1[0], v1[1]); w.w = cvt_pk_bf16(v1[2], v1[3]);
                    *(u32x4*)(rowp + bj * HALF) = w; } }
    }
};

template <class Epi, class Sched, bool ALIGN_EPI = false, bool SP2 = false, bool F8 = false>
__device__ __forceinline__ void gemm_phase(PG8_LAS unsigned char* lds, const Gemm g, const Sched& S, const Epi& E, const int wid  ) {
    const int lane = lane_id(), tid = wid * 64 + lane, wr = wid >> 2, wc = wid & 3, fr = lane & 15, fq = lane >> 4;
    const int K = g.ld, nt = g.K / BK;
    unsigned voffA[2], voffB[2];
#pragma unroll
    for (int i = 0; i < 2; ++i) { int R, C; stage_rc(tid * 16 + i * 8192, R, C); const int Rb = Epi::PERM ? ((R & ~31) + perm32(R & 31)) : R;
        voffA[i] = (unsigned)(R * K + C) * 2u; voffB[i] = (unsigned)(Rb * K + C) * 2u; }
    const size_t kstep = (size_t)(BK * 2);
    const size_t hstep = (size_t)HALF * K * 2;
    const size_t tstep = 2 * hstep;
    const unsigned ldsw = (unsigned)wid * 1024u;
    const int aoff = lds_byte(wr * 64 + fr, fq * 8), boff = lds_byte(wc * 32 + fr, fq * 8);
#define PG8_SA(b, h) (((b) * 2 + (h)) * HTB)
#define PG8_SB(b, h) ((4 + (b) * 2 + (h)) * HTB)
#define PG8_STAGE(bufoff, gbase, voff) do { _Pragma("unroll") for (int _i = 0; _i < 2; ++_i) \
        __builtin_amdgcn_global_load_lds((const unsigned*)((const char*)(gbase) + (voff)[_i]), (PG8_LAS unsigned*)(lds + (bufoff) + ldsw + _i * 8192), 16, 0, 0); } while (0)
#define PG8_LD8(addr) __builtin_shufflevector(*(const PG8_LAS i32x4*)(addr), *(const PG8_LAS i32x4*)((addr) + 1024), 0, 1, 2, 3, 4, 5, 6, 7)
#define PG8_LDA(dst, dst8, b, h) do { if constexpr (F8) { _Pragma("unroll") for (int m = 0; m < 4; ++m) dst8[m] = PG8_LD8(lds + PG8_SA(b, h) + aoff + m * 2048); } \
        else { _Pragma("unroll") for (int m = 0; m < 4; ++m) _Pragma("unroll") for (int k = 0; k < 2; ++k) dst[m][k] = *(const PG8_LAS bf16x8*)(lds + PG8_SA(b, h) + aoff + m * 2048 + k * 1024); } } while (0)
#define PG8_LDB(dst, dst8, b, h) do { if constexpr (F8) { _Pragma("unroll") for (int n = 0; n < 2; ++n) dst8[n] = PG8_LD8(lds + PG8_SB(b, h) + boff + n * 2048); } \
        else { _Pragma("unroll") for (int n = 0; n < 2; ++n) _Pragma("unroll") for (int k = 0; k < 2; ++k) dst[n][k] = *(const PG8_LAS bf16x8*)(lds + PG8_SB(b, h) + boff + n * 2048 + k * 1024); } } while (0)
#define PG8_MMA(ai, bj, At, At8, Bt, Bt8) do { __builtin_amdgcn_s_setprio(1); \
        if constexpr (F8) { _Pragma("unroll") for (int m = 0; m < 4; ++m) _Pragma("unroll") for (int n = 0; n < 2; ++n) \
            asm volatile("v_mfma_scale_f32_16x16x128_f8f6f4 %0, %1, %2, %0, %3, %3 op_sel_hi:[0,0,0]" : "+v"(acc[ai][bj][m][n]) : "v"(Bt8[n]), "v"(At8[m]), "v"(sc8_)); } \
        else { _Pragma("unroll") for (int m = 0; m < 4; ++m) _Pragma("unroll") for (int n = 0; n < 2; ++n) _Pragma("unroll") for (int k = 0; k < 2; ++k) \
            acc[ai][bj][m][n] = __builtin_amdgcn_mfma_f32_16x16x32_bf16(Bt[n][k], At[m][k], acc[ai][bj][m][n], 0, 0, 0); } \
        __builtin_amdgcn_s_setprio(0); } while (0)
#define PG8_WAIT_V(n) asm volatile("s_waitcnt vmcnt(" #n ")" ::: "memory")
#define PG8_WAIT_L(n) asm volatile("s_waitcnt lgkmcnt(" #n ")" ::: "memory")
#define PG8_BAR __builtin_amdgcn_s_barrier()
#define PG8_SCHED __builtin_amdgcn_sched_barrier(0)
#define PG8_SCHED8 do { if constexpr (F8) __builtin_amdgcn_sched_barrier(0); } while (0)
    Unit cur, nxt; int ui = 0;
    if (!S.next(0, cur)) return;
    constexpr float zero_ = 0.f;
    const int sc8_ = 0x7f7f7f7f;
    f32x4 acc[2][2][4][2];
#pragma unroll
    for (int a = 0; a < 2; ++a)
#pragma unroll
        for (int b = 0; b < 2; ++b)
#pragma unroll
            for (int m = 0; m < 4; ++m)
#pragma unroll
                for (int n = 0; n < 2; ++n) acc[a][b][m][n] = (f32x4){zero_, zero_, zero_, zero_};
    bf16x8 At[4][2], B0[2][2], B1[2][2];
    i32x8 At8[4], B08[2], B18[2];
    const char* cA = (const char*)g.A + cur.kofs + (size_t)cur.pm * tstep; const char* cB = (const char*)g.Bt + cur.bofs + cur.kofs + (size_t)cur.pn * tstep;
    S.a_ready(cur);
    if constexpr (SP2) {
        PG8_STAGE(PG8_SB(0, 0), cB, voffB); PG8_STAGE(PG8_SB(0, 1), cB + hstep, voffB); PG8_STAGE(PG8_SA(0, 0), cA, voffA); PG8_STAGE(PG8_SA(0, 1), cA + hstep, voffA);
        if (wr == 1) PG8_BAR;
        PG8_WAIT_V(2); PG8_BAR;
        PG8_STAGE(PG8_SB(1, 0), cB + kstep, voffB); PG8_STAGE(PG8_SA(1, 0), cA + kstep, voffA); PG8_STAGE(PG8_SB(1, 1), cB + hstep + kstep, voffB);
        PG8_WAIT_V(6); PG8_BAR;
    } else {
        PG8_STAGE(PG8_SB(0, 0), cB, voffB); PG8_STAGE(PG8_SA(0, 0), cA, voffA); PG8_STAGE(PG8_SB(0, 1), cB + hstep, voffB); PG8_STAGE(PG8_SA(0, 1), cA + hstep, voffA);
        if (wr == 1) PG8_BAR;
        PG8_WAIT_V(4); PG8_BAR;
        PG8_STAGE(PG8_SB(1, 0), cB + kstep, voffB); PG8_STAGE(PG8_SA(1, 0), cA + kstep, voffA); PG8_STAGE(PG8_SB(1, 1), cB + hstep + kstep, voffB);
        PG8_WAIT_V(6); PG8_BAR;
    }
    for (;;) {
        const bool has_next = S.next(ui + 1, nxt);
        const char* nA = has_next ? (const char*)g.A + nxt.kofs + (size_t)nxt.pm * tstep : cA; const char* nB = has_next ? (const char*)g.Bt + nxt.bofs + nxt.kofs + (size_t)nxt.pn * tstep : cB;
#pragma clang loop unroll(disable)
        for (int t = 0; t < nt; t += 2) {
            const bool last = (t == nt - 2);
            const char* a1 = cA + (size_t)(t + 1) * kstep;
            const char* a2 = last ? nA : cA + (size_t)(t + 2) * kstep; const char* b2 = last ? nB : cB + (size_t)(t + 2) * kstep;
            const char* a3 = a2 + kstep; const char* b3 = b2 + kstep;
            if (last && has_next) S.a_ready(nxt);
            if constexpr (SP2) {
            PG8_LDB(B0, B08, 0, 0); PG8_LDB(B1, B18, 0, 1); PG8_SCHED; PG8_LDA(At, At8, 0, 0); PG8_STAGE(PG8_SA(1, 1), a1 + hstep, voffA);
            PG8_WAIT_V(8); PG8_WAIT_L(0); PG8_BAR; PG8_SCHED8; PG8_MMA(0, 0, At, At8, B0, B08); PG8_MMA(0, 1, At, At8, B1, B18); PG8_SCHED8; PG8_BAR; PG8_SCHED;
            PG8_LDA(At, At8, 0, 1); PG8_STAGE(PG8_SB(0, 0), b2, voffB); PG8_STAGE(PG8_SB(0, 1), b2 + hstep, voffB); PG8_STAGE(PG8_SA(0, 0), a2, voffA);
            PG8_WAIT_V(8); PG8_WAIT_L(0); PG8_BAR; PG8_SCHED8; PG8_MMA(1, 0, At, At8, B0, B08); PG8_MMA(1, 1, At, At8, B1, B18); PG8_SCHED8; PG8_BAR; PG8_SCHED;
            PG8_LDB(B0, B08, 1, 0); PG8_LDB(B1, B18, 1, 1); PG8_SCHED; PG8_LDA(At, At8, 1, 0); PG8_STAGE(PG8_SA(0, 1), a2 + hstep, voffA);
            PG8_WAIT_V(8); PG8_WAIT_L(0); PG8_BAR; PG8_SCHED8; PG8_MMA(0, 0, At, At8, B0, B08); PG8_MMA(0, 1, At, At8, B1, B18); PG8_SCHED8; PG8_BAR; PG8_SCHED;
            PG8_LDA(At, At8, 1, 1); PG8_STAGE(PG8_SB(1, 0), b3, voffB); PG8_STAGE(PG8_SB(1, 1), b3 + hstep, voffB); PG8_STAGE(PG8_SA(1, 0), a3, voffA);
            PG8_WAIT_V(8); PG8_WAIT_L(0); PG8_BAR; PG8_SCHED8; PG8_MMA(1, 0, At, At8, B0, B08); PG8_MMA(1, 1, At, At8, B1, B18); PG8_SCHED8; PG8_BAR; PG8_SCHED;
            } else {
            PG8_LDB(B0, B08, 0, 0); PG8_SCHED; PG8_LDA(At, At8, 0, 0); PG8_STAGE(PG8_SA(1, 1), a1 + hstep, voffA);
            PG8_WAIT_L(8); PG8_BAR; PG8_WAIT_L(0); PG8_MMA(0, 0, At, At8, B0, B08); PG8_BAR; PG8_SCHED;
            PG8_LDB(B1, B18, 0, 1); PG8_STAGE(PG8_SB(0, 0), b2, voffB);
            PG8_BAR; PG8_WAIT_L(0); PG8_MMA(0, 1, At, At8, B1, B18); PG8_BAR;
            PG8_LDA(At, At8, 0, 1); PG8_STAGE(PG8_SA(0, 0), a2, voffA);
            PG8_BAR; PG8_WAIT_L(0); PG8_MMA(1, 0, At, At8, B0, B08); PG8_BAR; PG8_SCHED;
            PG8_STAGE(PG8_SB(0, 1), b2 + hstep, voffB);
            PG8_WAIT_V(6); PG8_BAR; PG8_MMA(1, 1, At, At8, B1, B18); PG8_BAR;
            PG8_LDB(B0, B08, 1, 0); PG8_SCHED; PG8_LDA(At, At8, 1, 0); PG8_STAGE(PG8_SA(0, 1), a2 + hstep, voffA);
            PG8_WAIT_L(8); PG8_BAR; PG8_WAIT_L(0); PG8_MMA(0, 0, At, At8, B0, B08); PG8_BAR; PG8_SCHED;
            PG8_LDB(B1, B18, 1, 1); PG8_STAGE(PG8_SB(1, 0), b3, voffB);
            PG8_BAR; PG8_WAIT_L(0); PG8_MMA(0, 1, At, At8, B1, B18); PG8_BAR;
            PG8_LDA(At, At8, 1, 1); PG8_STAGE(PG8_SA(1, 0), a3, voffA);
            PG8_BAR; PG8_WAIT_L(0); PG8_MMA(1, 0, At, At8, B0, B08); PG8_BAR; PG8_SCHED;
            PG8_STAGE(PG8_SB(1, 1), b3 + hstep, voffB);
            PG8_WAIT_V(6); PG8_BAR; PG8_MMA(1, 1, At, At8, B1, B18); PG8_BAR;
            }
        }
        if constexpr (ALIGN_EPI) { if (wr == 0) PG8_BAR; }
        if constexpr (F8) asm volatile("s_nop 15\n\ts_nop 15" ::: "memory");
        if constexpr (!Epi::AFTER_DRAIN) { E(acc, cur, wr, wc, fr, fq); S.done(cur); }
        if (!has_next) break;
#pragma unroll
        for (int a = 0; a < 2; ++a)
#pragma unroll
            for (int b = 0; b < 2; ++b)
#pragma unroll
                for (int m = 0; m < 4; ++m)
#pragma unroll
                    for (int n = 0; n < 2; ++n) acc[a][b][m][n] = (f32x4){zero_, zero_, zero_, zero_};
        cur = nxt; cA = nA; cB = nB; ++ui;
        if constexpr (ALIGN_EPI) { if (wr == 1) PG8_BAR; }
    }
    PG8_WAIT_V(0);
    if constexpr (!ALIGN_EPI) { if (wr == 0) PG8_BAR; }
    PG8_BAR;
    if constexpr (Epi::AFTER_DRAIN) { E.fused(acc, cur, wr, wc, fr, fq, lds, wid, lane); S.done(cur); }
#undef PG8_SA
#undef PG8_SB
#undef PG8_STAGE
#undef PG8_LDA
#undef PG8_LDB
#undef PG8_MMA
#undef PG8_LD8
#undef PG8_WAIT_V
#undef PG8_WAIT_L
#undef PG8_BAR
#undef PG8_SCHED
#undef PG8_SCHED8
}

}

#define GAS __attribute__((address_space(1)))
#define LAS __attribute__((address_space(3)))
typedef unsigned v4u __attribute__((ext_vector_type(4)));
typedef float f32x4 __attribute__((ext_vector_type(4)));
#define LDS_WAIT() asm volatile("s_waitcnt lgkmcnt(0)" ::: "memory")
#define VM_WAIT() asm volatile("s_waitcnt vmcnt(0)" ::: "memory")

#define XB_TMO      128
#define XB_XCNT(j)  (256  + 64 * (j))
#define XB_XSUB(j)  (1280 + 64 * (j))
#define XB_XGEN(j)  (2304 + 64 * (j))
#define XB_TOP      3328
#define XB_TOPGEN   3392
#define XCD_BAR_WORDS 3456
#define XB_SPIN_CAP (1u << 18)

__device__ __forceinline__ unsigned xb_ld(unsigned* p)              { return __hip_atomic_load(p, __ATOMIC_RELAXED, __HIP_MEMORY_SCOPE_AGENT); }
__device__ __forceinline__ unsigned xb_add(unsigned* p, unsigned v) { return __hip_atomic_fetch_add(p, v, __ATOMIC_RELAXED, __HIP_MEMORY_SCOPE_AGENT); }
__device__ __forceinline__ unsigned xb_xcc_id() { return (unsigned)__builtin_amdgcn_s_getreg((3 << 11) | 20) & 0xFu; }
#define XB_SPIN(cond, bar) do { unsigned _sp = 0; while (cond) { __builtin_amdgcn_s_sleep(1); \
    if ((++_sp & 255u) == 0u) { if (xb_ld(&(bar)[XB_TMO])) break; if (_sp > XB_SPIN_CAP) { atomicAdd(&(bar)[XB_TMO], 1u); break; } } } } while (0)

struct XcdBarrier {
    unsigned* bar; unsigned x;
    volatile LAS unsigned* st;
};

__device__ __forceinline__ XcdBarrier xcd_barrier_post(unsigned* bar, volatile LAS unsigned* st, bool t0) {
    XcdBarrier b; b.bar = bar; b.x = xb_xcc_id(); b.st = st;
    if (t0) (void)xb_add(&bar[XB_XCNT(b.x)], 1u);
    return b;
}
__device__ __forceinline__ void xcd_barrier_complete(unsigned* bar, unsigned x, unsigned& nloc, unsigned& nx) {
    const unsigned G = gridDim.x * gridDim.y * gridDim.z;
    unsigned sum, cnt, mine, sp = 0u;
    for (;;) {
        sum = 0u; cnt = 0u; mine = 0u;
#pragma unroll
        for (unsigned j = 0; j < 16; ++j) { const unsigned c = xb_ld(&bar[XB_XCNT(j)]); sum += c; cnt += (c > 0u) ? 1u : 0u; mine = (j == x) ? c : mine; }
        if (sum == G) break;
        __builtin_amdgcn_s_sleep(1);
        if ((++sp & 255u) == 0u) { if (xb_ld(&bar[XB_TMO])) break; if (sp > XB_SPIN_CAP) { atomicAdd(&bar[XB_TMO], 1u); break; } }
    }
    nloc = mine > 0u ? mine : 1u; nx = cnt > 0u ? cnt : 1u;
}

__device__ __forceinline__ void xcd_barrier(const XcdBarrier& b, bool t0) {
    asm volatile("s_waitcnt vmcnt(0)" ::: "memory");
    __syncthreads();
    if (t0) {
        unsigned* bar = b.bar;
        __builtin_amdgcn_s_waitcnt(0);
        unsigned nloc = b.st[0], nx = b.st[1];
        if (nloc == 0u) { xcd_barrier_complete(bar, b.x, nloc, nx); b.st[0] = nloc; b.st[1] = nx; }
        const unsigned old = xb_add(&bar[XB_XSUB(b.x)], 1u);
        const unsigned gen = old / nloc;
        if (old + 1u == (gen + 1u) * nloc) {
            __builtin_amdgcn_fence(__ATOMIC_RELEASE, "agent");
            asm volatile("s_waitcnt vmcnt(0)" ::: "memory");
            const unsigned og = xb_add(&bar[XB_TOP], 1u);
            const unsigned tg = og / nx;
            if (og + 1u == (tg + 1u) * nx) xb_add(&bar[XB_TOPGEN], 1u);
            else XB_SPIN(xb_ld(&bar[XB_TOPGEN]) == tg, bar);
            __builtin_amdgcn_fence(__ATOMIC_ACQUIRE, "agent");
            xb_add(&bar[XB_XGEN(b.x)], 1u);
            asm volatile("s_waitcnt vmcnt(0)" ::: "memory");
        } else {
            XB_SPIN(xb_ld(&bar[XB_XGEN(b.x)]) == gen, bar);
            __builtin_amdgcn_fence(__ATOMIC_ACQUIRE, "agent");
            asm volatile("s_waitcnt vmcnt(0)" ::: "memory");
        }
    }
    __syncthreads();
}

struct XcdToken { unsigned gen, tg; int role; };
__device__ __forceinline__ XcdToken xcd_barrier_arrive(const XcdBarrier& b, bool t0) {
    XcdToken k; k.gen = 0u; k.tg = 0u; k.role = 0;
    asm volatile("s_waitcnt vmcnt(0)" ::: "memory");
    __syncthreads();
    if (t0) {
        unsigned* bar = b.bar;
        __builtin_amdgcn_s_waitcnt(0);
        unsigned nloc = b.st[0], nx = b.st[1];
        if (nloc == 0u) { xcd_barrier_complete(bar, b.x, nloc, nx); b.st[0] = nloc; b.st[1] = nx; }
        const unsigned old = xb_add(&bar[XB_XSUB(b.x)], 1u);
        k.gen = old / nloc;
        if (old + 1u == (k.gen + 1u) * nloc) {
            __builtin_amdgcn_fence(__ATOMIC_RELEASE, "agent");
            asm volatile("s_waitcnt vmcnt(0)" ::: "memory");
            const unsigned og = xb_add(&bar[XB_TOP], 1u);
            k.tg = og / nx;
            if (og + 1u == (k.tg + 1u) * nx) { xb_add(&bar[XB_TOPGEN], 1u); k.role = 2; } else k.role = 1;
        }
    }
    return k;
}
__device__ __forceinline__ void xcd_barrier_wait(const XcdBarrier& b, const XcdToken& k, bool t0) {
    if (t0) {
        unsigned* bar = b.bar;
        if (k.role) {
            if (k.role == 1) XB_SPIN(xb_ld(&bar[XB_TOPGEN]) == k.tg, bar);
            __builtin_amdgcn_fence(__ATOMIC_ACQUIRE, "agent");
            xb_add(&bar[XB_XGEN(b.x)], 1u);
            asm volatile("s_waitcnt vmcnt(0)" ::: "memory");
        } else {
            XB_SPIN(xb_ld(&bar[XB_XGEN(b.x)]) == k.gen, bar);
            __builtin_amdgcn_fence(__ATOMIC_ACQUIRE, "agent");
            asm volatile("s_waitcnt vmcnt(0)" ::: "memory");
        }
    }
    __syncthreads();
}

constexpr int RING_OFF = 0, RING_BYTES = 131072;
constexpr int MISC_OFF = 143360;
constexpr int LDS_BYTES = 147456;
constexpr int NWAVES = 8;

struct Ctx { LAS unsigned char* lds; volatile LAS unsigned* MISC; unsigned* ctl; int wave, G, gw, NGW; };

__device__ __forceinline__ void cvt_item(const float* W, int K, int N, bf16_t* WT, int mode, LAS float* scr, int item, int lane) {
    const int kblk = K / 64, nb = item / kblk, kb = item % kblk, k0 = 64 * kb, n0 = 64 * nb;
    f32x4 ld[16];
#pragma unroll
    for (int i = 0; i < 16; ++i) { const int kk = 4 * i + (lane >> 4), c4 = 4 * (lane & 15); ld[i] = __builtin_nontemporal_load((const f32x4*)(W + (size_t)(k0 + kk) * N + n0 + c4));     }
#pragma unroll
    for (int i = 0; i < 16; ++i) { const int kk = 4 * i + (lane >> 4), c4 = 4 * (lane & 15);
        LAS float* s = scr + kk * 65 + c4; s[0] = ld[i][0]; s[1] = ld[i][1]; s[2] = ld[i][2]; s[3] = ld[i][3]; }
    LDS_WAIT(); asm volatile("" ::: "memory");
    const int c = lane >> 3;
#pragma unroll
    for (int j = 0; j < 8; ++j) { const int n = (lane & 7) + 8 * j; const LAS float* s = scr + (8 * c) * 65 + n;
        v4u o; o.x = pk2(s[0 * 65], s[1 * 65]); o.y = pk2(s[2 * 65], s[3 * 65]); o.z = pk2(s[4 * 65], s[5 * 65]); o.w = pk2(s[6 * 65], s[7 * 65]);
        const int nn = n0 + n; const int drow = mode == 0 ? nn : (nn / 128) * 256 + (mode - 1) * 128 + (nn % 128);
        *(v4u*)(WT + (size_t)drow * K + k0 + 8 * c) = o; }
    LDS_WAIT(); asm volatile("" ::: "memory");
}
__device__ __forceinline__ void cvt_item8(const float* W, int K, int N, unsigned char* WT, int mode, LAS float* scr, int item, int lane) {
    const int kblk = K / 64, nb = item / kblk, kb = item % kblk, k0 = 64 * kb, n0 = 64 * nb;
    f32x4 ld[16];
#pragma unroll
    for (int i = 0; i < 16; ++i) { const int kk = 4 * i + (lane >> 4), c4 = 4 * (lane & 15); ld[i] = __builtin_nontemporal_load((const f32x4*)(W + (size_t)(k0 + kk) * N + n0 + c4));     }
#pragma unroll
    for (int i = 0; i < 16; ++i) { const int kk = 4 * i + (lane >> 4), c4 = 4 * (lane & 15);
        LAS float* s = scr + kk * 65 + c4; s[0] = ld[i][0]; s[1] = ld[i][1]; s[2] = ld[i][2]; s[3] = ld[i][3]; }
    LDS_WAIT(); asm volatile("" ::: "memory");
    const int c = lane >> 3;
#pragma unroll
    for (int j = 0; j < 8; ++j) { const int n = (lane & 7) + 8 * j; const LAS float* s = scr + (8 * c) * 65 + n;
        v2u o; o.x = pk4_fp8(s[0 * 65] * W8_SCALE, s[1 * 65] * W8_SCALE, s[2 * 65] * W8_SCALE, s[3 * 65] * W8_SCALE); o.y = pk4_fp8(s[4 * 65] * W8_SCALE, s[5 * 65] * W8_SCALE, s[6 * 65] * W8_SCALE, s[7 * 65] * W8_SCALE);
        const int nn = n0 + n; const int drow = mode == 0 ? nn : (nn / 128) * 256 + (mode - 1) * 128 + (nn % 128);
        *(v2u*)(WT + (size_t)drow * K + k0 + 8 * c) = o; }
    LDS_WAIT(); asm volatile("" ::: "memory");
}
constexpr int MOE_S_F = 16 * 44, MOE_ITEMS = 24 * MOE_S_F;
__device__ __forceinline__ void moe_cvt_item(const Params& p, int r, LAS float* scr, int lane_) {
    constexpr int S_F = MOE_S_F;
    if (r < 8 * S_F) { const int e = r / S_F; cvt_item8(p.in[I_MWG] + (size_t)e * DM * DFF, DM, DFF, (unsigned char*)(p.ws + W_MGU) + (size_t)e * 2 * DFF * DM, 1, scr, r % S_F, lane_); return; } r -= 8 * S_F;
    if (r < 8 * S_F) { const int e = r / S_F; cvt_item8(p.in[I_MWU] + (size_t)e * DM * DFF, DM, DFF, (unsigned char*)(p.ws + W_MGU) + (size_t)e * 2 * DFF * DM, 2, scr, r % S_F, lane_); return; } r -= 8 * S_F;
    { const int e = r / S_F; cvt_item8(p.in[I_MWD] + (size_t)e * DFF * DM, DFF, DM, (unsigned char*)(p.ws + W_MD) + (size_t)e * DM * DFF, 0, scr, r % S_F, lane_); }
}
#if SEAM_CVT
constexpr int SEAM_CVT_SEAMS = 17;
__device__ __forceinline__ void seam_fill(const Params& p, Ctx& F, int s) {
    if (s >= SEAM_CVT_SEAMS || (F.wave & 1) != (s & 1)) return;
    const int it = s * (F.G * 4) + (int)blockIdx.x * 4 + (F.wave >> 1);
    if (it < MOE_ITEMS) moe_cvt_item(p, it, (LAS float*)(F.lds + RING_OFF) + F.wave * (64 * 65), lane_id());
}
__device__ __forceinline__ void moe_cvt_rest(const Params& p, Ctx& F) {
    for (int it = SEAM_CVT_SEAMS * (F.G * 4) + F.gw; it < MOE_ITEMS; it += F.NGW) moe_cvt_item(p, it, (LAS float*)(F.lds + RING_OFF) + F.wave * (64 * 65), lane_id());
}
#endif
__device__ __forceinline__ void p0_prologue(const Params& p, Ctx& F) {
    const int lane_ = lane_id(), tid_ = F.wave * 64 + lane_;
    LAS float* fl = (LAS float*)(F.lds + RING_OFF);
    for (int it = blockIdx.x; it < 192; it += F.G) {
        const int l = it / 96, n = (it % 96) * 64 + lane_;
        LAS float* sv = fl;
        LAS float* red = fl + 3 * 1024;
        for (int i = tid_; i < 3 * 1024; i += 512) { const int rt = i >> 10, k = i & 1023; const float v = rt < 2 ? p.in[I_C][rt * DM + k] : p.in[I_CCTX][k]; sv[i] = siluf(v); }
        __syncthreads();
        const float* W = p.in[I_ADAW] + (size_t)l * DM * 6144 + n;
        float a0 = 0.f, a1 = 0.f, a2 = 0.f;
        for (int kb = 0; kb < 128; kb += 32) {
            float wv[32];
#pragma unroll
            for (int j = 0; j < 32; ++j) wv[j] = W[(size_t)(F.wave * 128 + kb + j) * 6144];
#pragma unroll
            for (int j = 0; j < 32; ++j) { const int k = F.wave * 128 + kb + j; a0 += sv[k] * wv[j]; a1 += sv[1024 + k] * wv[j]; a2 += sv[2048 + k] * wv[j]; }
        }
        red[(F.wave * 3 + 0) * 64 + lane_] = a0; red[(F.wave * 3 + 1) * 64 + lane_] = a1; red[(F.wave * 3 + 2) * 64 + lane_] = a2;
        __syncthreads();
        if (tid_ < 192) { const int rt = tid_ >> 6, ln = tid_ & 63; float s = 0.f;
#pragma unroll
            for (int w = 0; w < 8; ++w) s += red[(w * 3 + rt) * 64 + ln];
            const int nn = (it % 96) * 64 + ln;
            ((float*)(p.ws + WS_MODV))[(size_t)(l * 3 + rt) * 6144 + nn] = s + p.in[I_ADAB][l * 6144 + nn]; }
        __syncthreads();
    }
    LAS float* scr = (LAS float*)(F.lds + RING_OFF) + F.wave * (64 * 65);
    constexpr int S_WIN = 16 * 56, S_WOUT = 16 * 16, S_F = 16 * 44;
    constexpr int NITEMS = 2 * S_WIN + 2 * S_WOUT + 3 * S_F + (SEAM_CVT ? 0 : 24 * S_F);
    static_assert(NITEMS + (SEAM_CVT ? 24 * S_F : 0) == 21312, "items");
    for (int it = F.gw; it < NITEMS; it += F.NGW) {
        int r = it;
        if (r < 2 * S_WIN) { const int l = r / S_WIN; cvt_item(p.in[I_WIN] + (size_t)l * DM * DP, DM, DP, (bf16_t*)(p.ws + W_WIN) + (size_t)l * DP * DM, 0, scr, r % S_WIN, lane_); continue; } r -= 2 * S_WIN;
        if (r < 2 * S_WOUT) { const int l = r / S_WOUT; cvt_item(p.in[I_WOUT] + (size_t)l * DM * DM, DM, DM, (bf16_t*)(p.ws + W_WOUT) + (size_t)l * DM * DM, 0, scr, r % S_WOUT, lane_); continue; } r -= 2 * S_WOUT;
        if (r < S_F) { cvt_item(p.in[I_FWG], DM, DFF, (bf16_t*)(p.ws + W_FGU), 1, scr, r, lane_); continue; } r -= S_F;
        if (r < S_F) { cvt_item(p.in[I_FWU], DM, DFF, (bf16_t*)(p.ws + W_FGU), 2, scr, r, lane_); continue; } r -= S_F;
        if (r < S_F) { cvt_item(p.in[I_FWD], DFF, DM, (bf16_t*)(p.ws + W_FD), 0, scr, r, lane_); continue; } r -= S_F;
        moe_cvt_item(p, r, scr, lane_);
    }
}

__device__ __forceinline__ void norm_phase(const Params& p, Ctx& F, int l, int which, int nrows) {
    const int lane_ = lane_id(), tid_ = F.wave * 64 + lane_;
    const float* g = p.in[which ? I_N2G : I_N1G] + l * DM;
    for (int m = F.gw; m < nrows; m += F.NGW) {
        const float* xrow;
        if (l == 0 && which == 0) xrow = m < NL ? p.in[I_X] + (size_t)m * DM : p.in[I_CTX] + (size_t)(m - NL) * DM;
        else xrow = xr_row(p, m);
        const int rt = rowtype(m);
        const float* sh = modv(p, l, rt, which ? 3 : 0); const float* sc = modv(p, l, rt, which ? 4 : 1);
        f32x4 v[4]; float ss = 0.f;
        if (m >= NL && !(l == 0 && which == 0)) {
            const int nsl = which ? DM / 256 : DFF / 256; const float* gate = modv(p, 0, 2, which ? 2 : 5);
            const float* base = (l == 0) ? p.in[I_CTX] + (size_t)(m - NL) * DM : xrow;
            const float* part = (const float*)(p.ws + WS_PART) + (size_t)(m - NL) * DM;
#pragma unroll
            for (int j = 0; j < 4; ++j) { const int col = 256 * j + 4 * lane_; f32x4 a = {0.f, 0.f, 0.f, 0.f};
                for (int sl = 0; sl < nsl; ++sl) a += *(const f32x4*)(part + (size_t)sl * NC * DM + col);
                v[j] = *(const f32x4*)(base + col) + *(const f32x4*)(gate + col) * a;
                *(f32x4*)((float*)(p.ws + WS_XRC) + (size_t)(m - NL) * DM + col) = v[j];
                ss += (v[j][0] * v[j][0] + v[j][1] * v[j][1]) + (v[j][2] * v[j][2] + v[j][3] * v[j][3]); }
        } else
#pragma unroll
        for (int j = 0; j < 4; ++j) { v[j] = *(const f32x4*)(xrow + 256 * j + 4 * lane_); ss += (v[j][0] * v[j][0] + v[j][1] * v[j][1]) + (v[j][2] * v[j][2] + v[j][3] * v[j][3]); }
        const float r = rsqrtf(wave_sum(ss) * (1.f / DM) + EPS);
        bf16_t* hb = (bf16_t*)(p.ws + WS_HBUF) + (size_t)m * DM;
#pragma unroll
        for (int j = 0; j < 4; ++j) { const int col = 256 * j + 4 * lane_;
            const f32x4 gg = *(const f32x4*)(g + col), s4 = *(const f32x4*)(sc + col), h4 = *(const f32x4*)(sh + col);
            const f32x4 y = v[j] * r * gg * (1.f + s4) + h4;
            v2u o; o.x = pk2(y[0], y[1]); o.y = pk2(y[2], y[3]); *(v2u*)(hb + col) = o; }
    }
}


__device__ __forceinline__ void router_phase(const Params& p, Ctx& F) {
    const int lane_ = lane_id(), tid_ = F.wave * 64 + lane_;
    LAS int* lcnt = (LAS int*)(F.lds + RING_OFF);
    LAS int* gbase = lcnt + 8;
    LAS int* ent_e = lcnt + 16;
    LAS int* ent_pos = lcnt + 16 + 128;
    const float* g = p.in[I_N2G] + DM; const float* rw = p.in[I_RW];
    int* tok_e = (int*)(p.ws + WS_ROUTE); float* tok_w = (float*)(p.ws + WS_ROUTE) + 2 * NL; int* tok_pos = (int*)(p.ws + WS_ROUTE) + 4 * NL;
    f32x4 rwa[4][4], rwb[4][4];
#pragma unroll
    for (int j = 0; j < 4; ++j)
#pragma unroll
        for (int q = 0; q < 4; ++q) { const int col = 256 * j + 4 * lane_ + q; rwa[j][q] = *(const f32x4*)(rw + (size_t)col * 8); rwb[j][q] = *(const f32x4*)(rw + (size_t)col * 8 + 4); }
    const int myexp = ((lane_ >> 5) & 1) * 4 + ((lane_ >> 4) & 1) * 2 + ((lane_ >> 3) & 1);
    for (int ch = blockIdx.x; ch < NL / 64; ch += F.G) {
        if (tid_ < 8) lcnt[tid_] = 0;
        __syncthreads();
        const int rt = (ch * 64) / T;
        const float* sh = modv(p, 1, rt, 3); const float* sc = modv(p, 1, rt, 4);
        f32x4 gs[4], hs[4]; float bsum;
        { float bb[8] = {0.f, 0.f, 0.f, 0.f, 0.f, 0.f, 0.f, 0.f};
#pragma unroll
          for (int j = 0; j < 4; ++j) { const int col = 256 * j + 4 * lane_; gs[j] = *(const f32x4*)(g + col) * (1.f + *(const f32x4*)(sc + col)); hs[j] = *(const f32x4*)(sh + col);
#pragma unroll
            for (int q = 0; q < 4; ++q) { bb[0] += hs[j][q] * rwa[j][q][0]; bb[1] += hs[j][q] * rwa[j][q][1]; bb[2] += hs[j][q] * rwa[j][q][2]; bb[3] += hs[j][q] * rwa[j][q][3];
                                          bb[4] += hs[j][q] * rwb[j][q][0]; bb[5] += hs[j][q] * rwb[j][q][1]; bb[6] += hs[j][q] * rwb[j][q][2]; bb[7] += hs[j][q] * rwb[j][q][3]; } }
          float c4[4];
#pragma unroll
          for (int k = 0; k < 4; ++k) { const float keep = (lane_ & 32) ? bb[k + 4] : bb[k], give = (lane_ & 32) ? bb[k] : bb[k + 4]; c4[k] = keep + __shfl_xor(give, 32); }
          float c2[2];
#pragma unroll
          for (int k = 0; k < 2; ++k) { const float keep = (lane_ & 16) ? c4[k + 2] : c4[k], give = (lane_ & 16) ? c4[k] : c4[k + 2]; c2[k] = keep + __shfl_xor(give, 16); }
          float c1 = ((lane_ & 8) ? c2[1] : c2[0]) + __shfl_xor((lane_ & 8) ? c2[0] : c2[1], 8);
          c1 += __shfl_xor(c1, 4); c1 += __shfl_xor(c1, 2); c1 += __shfl_xor(c1, 1);
          bsum = c1 + p.in[I_RB][myexp]; }
        for (int i = 0; i < 8; ++i) {
            const int ti = F.wave * 8 + i, m = ch * 64 + ti;
            const float* xrow = p.out + (size_t)m * DM;
            f32x4 v[4]; float ss = 0.f; float aa[8] = {0.f, 0.f, 0.f, 0.f, 0.f, 0.f, 0.f, 0.f};
#pragma unroll
            for (int j = 0; j < 4; ++j) { v[j] = *(const f32x4*)(xrow + 256 * j + 4 * lane_); ss += (v[j][0] * v[j][0] + v[j][1] * v[j][1]) + (v[j][2] * v[j][2] + v[j][3] * v[j][3]); }
#pragma unroll
            for (int j = 0; j < 4; ++j) { v[j] = v[j] * gs[j];
#pragma unroll
                for (int q = 0; q < 4; ++q) { aa[0] += v[j][q] * rwa[j][q][0]; aa[1] += v[j][q] * rwa[j][q][1]; aa[2] += v[j][q] * rwa[j][q][2]; aa[3] += v[j][q] * rwa[j][q][3];
                                              aa[4] += v[j][q] * rwb[j][q][0]; aa[5] += v[j][q] * rwb[j][q][1]; aa[6] += v[j][q] * rwb[j][q][2]; aa[7] += v[j][q] * rwb[j][q][3]; } }
            float c4[4];
#pragma unroll
            for (int k = 0; k < 4; ++k) { const float keep = (lane_ & 32) ? aa[k + 4] : aa[k], give = (lane_ & 32) ? aa[k] : aa[k + 4]; c4[k] = keep + __shfl_xor(give, 32); }
            float c2[2];
#pragma unroll
            for (int k = 0; k < 2; ++k) { const float keep = (lane_ & 16) ? c4[k + 2] : c4[k], give = (lane_ & 16) ? c4[k] : c4[k + 2]; c2[k] = keep + __shfl_xor(give, 16); }
            float c1 = ((lane_ & 8) ? c2[1] : c2[0]) + __shfl_xor((lane_ & 8) ? c2[0] : c2[1], 8);
            c1 += __shfl_xor(c1, 4); c1 += __shfl_xor(c1, 2); c1 += __shfl_xor(c1, 1);
            const float r = rsqrtf(wave_sum(ss) * (1.f / DM) + EPS);
            const float mylogit = r * c1 + bsum;
#define RLF(L) __uint_as_float((unsigned)__builtin_amdgcn_readlane((int)__float_as_uint(mylogit), L))
            const float lg0 = RLF(0), lg1 = RLF(8), lg2 = RLF(16), lg3 = RLF(24), lg4 = RLF(32), lg5 = RLF(40), lg6 = RLF(48), lg7 = RLF(56);
#undef RLF
            unsigned char* hb = (unsigned char*)(p.ws + WS_HBUF) + (size_t)m * DM;
#pragma unroll
            for (int j = 0; j < 4; ++j) { const f32x4 y = v[j] * r + hs[j]; *(unsigned*)(hb + 256 * j + 4 * lane_) = pk4_fp8(y[0], y[1], y[2], y[3]); }
            int i1 = 0; float v1 = lg0;
            if (lg1 > v1) { v1 = lg1; i1 = 1; } if (lg2 > v1) { v1 = lg2; i1 = 2; } if (lg3 > v1) { v1 = lg3; i1 = 3; }
            if (lg4 > v1) { v1 = lg4; i1 = 4; } if (lg5 > v1) { v1 = lg5; i1 = 5; } if (lg6 > v1) { v1 = lg6; i1 = 6; } if (lg7 > v1) { v1 = lg7; i1 = 7; }
            int i2 = -1; float v2 = -3.4e38f;
            if (i1 != 0 && lg0 > v2) { v2 = lg0; i2 = 0; } if (i1 != 1 && lg1 > v2) { v2 = lg1; i2 = 1; } if (i1 != 2 && lg2 > v2) { v2 = lg2; i2 = 2; } if (i1 != 3 && lg3 > v2) { v2 = lg3; i2 = 3; }
            if (i1 != 4 && lg4 > v2) { v2 = lg4; i2 = 4; } if (i1 != 5 && lg5 > v2) { v2 = lg5; i2 = 5; } if (i1 != 6 && lg6 > v2) { v2 = lg6; i2 = 6; } if (i1 != 7 && lg7 > v2) { v2 = lg7; i2 = 7; }
            const float w1 = 1.f / (1.f + __expf(v2 - v1));
            if (lane_ == 0) {
                const int p1 = __hip_atomic_fetch_add(lcnt + i1, 1, __ATOMIC_RELAXED, __HIP_MEMORY_SCOPE_WORKGROUP);
                const int p2 = __hip_atomic_fetch_add(lcnt + i2, 1, __ATOMIC_RELAXED, __HIP_MEMORY_SCOPE_WORKGROUP);
                ent_e[2 * ti] = i1; ent_e[2 * ti + 1] = i2; ent_pos[2 * ti] = p1; ent_pos[2 * ti + 1] = p2;
                tok_e[2 * m] = i1; tok_e[2 * m + 1] = i2; tok_w[2 * m] = w1; tok_w[2 * m + 1] = 1.f - w1; }
        }
        __syncthreads();
        if (tid_ < 8) gbase[tid_] = (int)__hip_atomic_fetch_add(F.ctl + CW_CNT + 64 * tid_, (unsigned)lcnt[tid_], __ATOMIC_RELAXED, __HIP_MEMORY_SCOPE_AGENT);
        __syncthreads();
        if (tid_ < 128) tok_pos[ch * 128 + tid_] = gbase[ent_e[tid_]] + ent_pos[tid_];
        __syncthreads();
    }
}
__device__ __forceinline__ void moe_table(Ctx& F) {
    const int lane_ = lane_id(), tid_ = F.wave * 64 + lane_;
    volatile LAS unsigned* tb = F.MISC + 32;
    if (tid_ == 0) { unsigned acc = 0;
        for (int e = 0; e < 8; ++e) { const unsigned c = __hip_atomic_load(F.ctl + CW_CNT + 64 * e, __ATOMIC_RELAXED, __HIP_MEMORY_SCOPE_AGENT); tb[e] = acc; tb[16 + e] = c; acc += (c + 255u) / 256u * 256u; }
        tb[8] = acc; }
    __syncthreads();
}
__device__ __forceinline__ void moe_order(Ctx& F, pg8::Order& S, int nN, long estride) {
    volatile LAS unsigned* tb = F.MISC + 32;
#define RFL(x) __builtin_amdgcn_readfirstlane((int)(x))
    S.init(RFL(tb[8] / 256u), nN, F.G, (int)blockIdx.x);
    S.e1 = RFL(tb[1] / 256u); S.e2 = RFL(tb[2] / 256u); S.e3 = RFL(tb[3] / 256u); S.e4 = RFL(tb[4] / 256u); S.e5 = RFL(tb[5] / 256u); S.e6 = RFL(tb[6] / 256u); S.e7 = RFL(tb[7] / 256u);
#undef RFL
    S.estride = estride;
}
__device__ __forceinline__ void gather_phase(const Params& p, Ctx& F) {
    const int lane_ = lane_id(), tid_ = F.wave * 64 + lane_;
    moe_table(F);
    volatile LAS unsigned* tb = F.MISC + 32;
    const int* tok_e = (const int*)(p.ws + WS_ROUTE); const float* tok_w = (const float*)(p.ws + WS_ROUTE) + 2 * NL; const int* tok_pos = (const int*)(p.ws + WS_ROUTE) + 4 * NL;
    int* row_tok = (int*)(p.ws + WS_ROUTE) + 6 * NL; float* row_gate = (float*)(p.ws + WS_ROUTE) + 6 * NL + MP_MAX;
    const unsigned char* hb = (const unsigned char*)(p.ws + WS_HBUF); unsigned char* h2s = (unsigned char*)(p.ws + WS_H2S);
    for (int it = F.gw; it < 2 * NL; it += F.NGW) {
        const int t = it >> 1, e = tok_e[it], r = (int)tb[e] + tok_pos[it];
        *((v4u*)(h2s + (size_t)r * DM) + lane_) = *((const v4u*)(hb + (size_t)t * DM) + lane_);
        if (lane_ == 0) { row_tok[r] = t; row_gate[r] = tok_w[it]; }
    }
    for (int i = F.gw; i < NE * 256; i += F.NGW) {
        const int e = i >> 8, j = i & 255, r = (int)tb[e] + (int)tb[16 + e] + j;
        if (r < (int)tb[e + 1]) { const v4u z = {0u, 0u, 0u, 0u}; *((v4u*)(h2s + (size_t)r * DM) + lane_) = z; if (lane_ == 0) { row_tok[r] = -1; row_gate[r] = 0.f; } }
    }
}
__device__ __forceinline__ void combine_phase(const Params& p, Ctx& F) {
    const int lane_ = lane_id(), tid_ = F.wave * 64 + lane_;
    moe_table(F);
    volatile LAS unsigned* tb = F.MISC + 32;
    const int* tok_e = (const int*)(p.ws + WS_ROUTE); const int* tok_pos = (const int*)(p.ws + WS_ROUTE) + 4 * NL;
    const bf16_t* yb = (const bf16_t*)(p.ws + WS_YBUF);
    for (int t = F.gw; t < NL; t += F.NGW) {
        const int r0 = (int)tb[tok_e[2 * t]] + tok_pos[2 * t], r1 = (int)tb[tok_e[2 * t + 1]] + tok_pos[2 * t + 1];
        const float* g5 = modv(p, 1, t / T, 5);
        float* orow = p.out + (size_t)t * DM;
#pragma unroll
        for (int j = 0; j < 4; ++j) { const int col = 256 * j + 4 * lane_;
            const v2u a = *(const v2u*)(yb + (size_t)r0 * DM + col), b = *(const v2u*)(yb + (size_t)r1 * DM + col);
            f32x4 y; y[0] = __uint_as_float(a.x << 16) + __uint_as_float(b.x << 16); y[1] = __uint_as_float(a.x & 0xffff0000u) + __uint_as_float(b.x & 0xffff0000u);
            y[2] = __uint_as_float(a.y << 16) + __uint_as_float(b.y << 16); y[3] = __uint_as_float(a.y & 0xffff0000u) + __uint_as_float(b.y & 0xffff0000u);
            const f32x4 x = *(const f32x4*)(orow + col), gg = *(const f32x4*)(g5 + col);
            *(f32x4*)(orow + col) = x + gg * y; }
    }
}

namespace att {
#ifndef EXP_TREE
#define EXP_TREE 1
#endif
constexpr float THR = 8.f;
constexpr int KVBLK = 64;
constexpr int SHM_V = KVBLK * 128 * 2, SHM_K = KVBLK * 128 * 2;
using bf16x8 = __attribute__((ext_vector_type(8))) short;
using s16x4  = __attribute__((ext_vector_type(4))) short;
using f32x16 = __attribute__((ext_vector_type(16))) float;
using f32x8  = __attribute__((ext_vector_type(8))) float;
using u32x4  = __attribute__((ext_vector_type(4))) unsigned;
using f32x4v = __attribute__((ext_vector_type(4))) float;
#define KSWZ(row, colB) ((row) * 256 + ((colB) ^ (((row) & 7) << 4)))
#define SBAR() __builtin_amdgcn_sched_barrier(0)
__device__ __forceinline__ int crow(int r, int hi) { return (r & 3) + 8 * (r >> 2) + 4 * hi; }
__device__ __forceinline__ unsigned cvtpk(float lo, float hi) {
  unsigned r; asm volatile("v_cvt_pk_bf16_f32 %0, %1, %2" : "=v"(r) : "v"(lo), "v"(hi)); return r;
}
__device__ __forceinline__ void partialSM(f32x16& p0, f32x16& p1, float& m_reg, float& mn, float& alpha) {
  constexpr float C = 1.4426950408889634f;
  float pmax = p0[0]; for (int r = 1; r < 16; ++r) pmax = fmaxf(pmax, p0[r]); for (int r = 0; r < 16; ++r) pmax = fmaxf(pmax, p1[r]);
  { auto rr = __builtin_amdgcn_permlane32_swap(__float_as_uint(pmax), __float_as_uint(pmax), false, false);
    pmax = fmaxf(__uint_as_float(rr[0]), __uint_as_float(rr[1])); }
  if (__builtin_expect(__all(pmax - m_reg <= THR), 1)) { mn = m_reg; alpha = 1.f; }
  else { mn = fmaxf(m_reg, pmax); alpha = __builtin_amdgcn_exp2f((m_reg - mn) * C); m_reg = mn; }
  float mnC = -mn * C;
  for (int r = 0; r < 16; ++r) p0[r] = fmaf(p0[r], C, mnC); for (int r = 0; r < 16; ++r) p1[r] = fmaf(p1[r], C, mnC);
  for (int r = 0; r < 16; ++r) p0[r] = __builtin_amdgcn_exp2f(p0[r]);
}
__device__ __forceinline__ void finishSM(f32x16& p0, f32x16& p1, float alpha, float& l_reg, bf16x8& pa0, bf16x8& pa1, bf16x8& pa2, bf16x8& pa3) {
  for (int r = 0; r < 16; ++r) p1[r] = __builtin_amdgcn_exp2f(p1[r]);
  float ps = 0; for (int r = 0; r < 16; ++r) ps += p0[r]; for (int r = 0; r < 16; ++r) ps += p1[r];
  { auto rr = __builtin_amdgcn_permlane32_swap(__float_as_uint(ps), __float_as_uint(ps), false, false);
    ps = __uint_as_float(rr[0]) + __uint_as_float(rr[1]); }
  l_reg = l_reg * alpha + ps;
#define PK4(P, BASE, OUT) do { unsigned a0 = cvtpk(P[BASE + 0], P[BASE + 1]), a1 = cvtpk(P[BASE + 2], P[BASE + 3]);   \
    unsigned b0 = cvtpk(P[BASE + 4], P[BASE + 5]), b1 = cvtpk(P[BASE + 6], P[BASE + 7]);                              \
    auto r0 = __builtin_amdgcn_permlane32_swap(a0, b0, false, false); auto r1 = __builtin_amdgcn_permlane32_swap(a1, b1, false, false); \
    u32x4 w = {r0[0], r1[0], r0[1], r1[1]}; OUT = *reinterpret_cast<bf16x8*>(&w); } while (0)
  PK4(p0, 0, pa0); PK4(p0, 8, pa1); PK4(p1, 0, pa2); PK4(p1, 8, pa3);
#undef PK4
}
template <int ND0>
__device__ __forceinline__ void qkt(f32x16& p0, f32x16& p1, const LAS char* Ks, const bf16x8* qr, int r32, int hi, int dbase) {
  p0 = f32x16{}; p1 = f32x16{};
#pragma unroll
  for (int d0 = 0; d0 < ND0; ++d0) { int cb = ((dbase + d0) * 16 + hi * 8) * 2;
    bf16x8 b0 = *reinterpret_cast<const LAS bf16x8*>(Ks + KSWZ(r32, cb));
    bf16x8 b1 = *reinterpret_cast<const LAS bf16x8*>(Ks + KSWZ(32 + r32, cb));
    p0 = __builtin_amdgcn_mfma_f32_32x32x16_bf16(b0, qr[d0], p0, 0, 0, 0);
    p1 = __builtin_amdgcn_mfma_f32_32x32x16_bf16(b1, qr[d0], p1, 0, 0, 0); }
}
__device__ __forceinline__ int v_st(int k, int c) { const int kk = (k & ~0xC) | ((k & 4) << 1) | ((k & 8) >> 1); return ((kk >> 3) * 4 + (c >> 5)) * 512 + ((kk & 7) * 32 + (c & 31)) * 2; }
__device__ __forceinline__ int v_st_lin(int k, int c) { return ((k >> 3) * 4 + (c >> 5)) * 512 + ((k & 7) * 32 + (c & 31)) * 2; }
__device__ __forceinline__ int vt_off(int dv, int key) {
  const int pos = (key & ~0xC) | ((key & 4) << 1) | ((key & 8) >> 1), ch = pos >> 3;
  return dv * 128 + (((ch & 4) | ((ch & 3) ^ ((dv >> 1) & 3))) << 4) + (pos & 7) * 2;
}
__device__ __forceinline__ int v_rd_base(int lane) { return ((lane & 3) << 3) | (((lane >> 2) & 3) << 6) | (((lane >> 4) & 1) << 5) | (((lane >> 5) & 1) << 8); }
constexpr int v_rd_off(int d0, int ks, int half) { return d0 * 512 + ks * 4096 + half * 2048; }
template <int OFF> __device__ __forceinline__ s16x4 tr_read(int vb) {
  s16x4 r; asm volatile("ds_read_b64_tr_b16 %0, %1 offset:%2" : "=&v"(r) : "v"(vb), "i"(OFF) : "memory"); return r;
}
template <int D0> __device__ __forceinline__ void pv_one(f32x16& od, int vb, bf16x8 pa0, bf16x8 pa1, bf16x8 pa2, bf16x8 pa3) {
  const s16x4 l0 = tr_read<v_rd_off(D0, 0, 0)>(vb), h0 = tr_read<v_rd_off(D0, 0, 1)>(vb), l1 = tr_read<v_rd_off(D0, 1, 0)>(vb), h1 = tr_read<v_rd_off(D0, 1, 1)>(vb);
  const s16x4 l2 = tr_read<v_rd_off(D0, 2, 0)>(vb), h2 = tr_read<v_rd_off(D0, 2, 1)>(vb), l3 = tr_read<v_rd_off(D0, 3, 0)>(vb), h3 = tr_read<v_rd_off(D0, 3, 1)>(vb);
#if defined(DUMMY_TR) && DUMMY_TR
  { s16x4 dd; for (int i = 0; i < DUMMY_TR; ++i) asm volatile("ds_read_b64_tr_b16 %0, %1 offset:%2" : "=&v"(dd) : "v"(vb), "i"(v_rd_off(D0, 0, 0)) : "memory"); }
#endif
#if defined(DUMMY_MFMA) && DUMMY_MFMA
  { f32x4v dm = {0.f, 0.f, 0.f, 0.f}; for (int i = 0; i < DUMMY_MFMA; ++i) asm volatile("v_mfma_f32_16x16x32_bf16 %0, %1, %2, %0" : "+v"(dm) : "v"(pa0), "v"(pa1)); }
#endif
  asm volatile("s_waitcnt lgkmcnt(0)" ::: "memory"); SBAR();
#define PK(L, H) (bf16x8){L[0], L[1], L[2], L[3], H[0], H[1], H[2], H[3]}
  od = __builtin_amdgcn_mfma_f32_32x32x16_bf16(pa0, PK(l0, h0), od, 0, 0, 0);
  od = __builtin_amdgcn_mfma_f32_32x32x16_bf16(pa1, PK(l1, h1), od, 0, 0, 0);
  od = __builtin_amdgcn_mfma_f32_32x32x16_bf16(pa2, PK(l2, h2), od, 0, 0, 0);
  od = __builtin_amdgcn_mfma_f32_32x32x16_bf16(pa3, PK(l3, h3), od, 0, 0, 0);
#undef PK
}
__device__ __forceinline__ void pv_d0(f32x16* o, int vb, bf16x8 pa0, bf16x8 pa1, bf16x8 pa2, bf16x8 pa3) {
  pv_one<0>(o[0], vb, pa0, pa1, pa2, pa3); pv_one<1>(o[1], vb, pa0, pa1, pa2, pa3); pv_one<2>(o[2], vb, pa0, pa1, pa2, pa3); pv_one<3>(o[3], vb, pa0, pa1, pa2, pa3);
}

#ifndef DUMMY_EXP
#define DUMMY_EXP 0
#endif
#ifndef DUMMY_TR
#define DUMMY_TR 0
#endif
#ifndef DUMMY_MFMA
#define DUMMY_MFMA 0
#endif
__device__ __forceinline__ void dummy_exp(float x) { float d; for (int i = 0; i < DUMMY_EXP; ++i) asm volatile("v_exp_f32 %0, %1" : "=v"(d) : "v"(x)); }
__device__ __forceinline__ void expA(f32x16& p0) {
#pragma unroll
  for (int r = 0; r < 16; ++r) { dummy_exp(p0[r]); p0[r] = __builtin_amdgcn_exp2f(p0[r]); }
}
__device__ __forceinline__ void expB_sum_pack(f32x16& p0, f32x16& p1, float& l_reg, bf16x8& pa0, bf16x8& pa1, bf16x8& pa2, bf16x8& pa3) {
#pragma unroll
  for (int r = 0; r < 16; ++r) { dummy_exp(p1[r]); p1[r] = __builtin_amdgcn_exp2f(p1[r]); }
  float ps = 0;
#pragma unroll
  for (int r = 0; r < 16; ++r) ps += p0[r];
#pragma unroll
  for (int r = 0; r < 16; ++r) ps += p1[r];
  { auto rr = __builtin_amdgcn_permlane32_swap(__float_as_uint(ps), __float_as_uint(ps), false, false);
    ps = __uint_as_float(rr[0]) + __uint_as_float(rr[1]); }
  l_reg += ps;
#define PK4(P, BASE, OUT) do { unsigned a0 = cvtpk(P[BASE + 0], P[BASE + 1]), a1 = cvtpk(P[BASE + 2], P[BASE + 3]);   \
    unsigned b0 = cvtpk(P[BASE + 4], P[BASE + 5]), b1 = cvtpk(P[BASE + 6], P[BASE + 7]);                              \
    auto r0 = __builtin_amdgcn_permlane32_swap(a0, b0, false, false); auto r1 = __builtin_amdgcn_permlane32_swap(a1, b1, false, false); \
    u32x4 w = {r0[0], r1[0], r0[1], r1[1]}; OUT = *reinterpret_cast<bf16x8*>(&w); } while (0)
  PK4(p0, 0, pa0); PK4(p0, 8, pa1); PK4(p1, 0, pa2); PK4(p1, 8, pa3);
#undef PK4
}
__device__ __forceinline__ bf16x8 ld8(const bf16_t* p) { return *reinterpret_cast<const bf16x8*>(p); }

constexpr int TP = 132;
__device__ __forceinline__ void tile_to_rows(const f32x16 (&o)[4], LAS float* scr, int r32, int hi, float (&v)[64]) {
#pragma unroll
  for (int d0 = 0; d0 < 4; ++d0)
#pragma unroll
    for (int r = 0; r < 16; ++r) scr[crow(r, hi) * TP + 32 * d0 + r32] = o[d0][r];
  asm volatile("s_waitcnt lgkmcnt(0)" ::: "memory");
#pragma unroll
  for (int i = 0; i < 16; ++i) { const f32x4v t = *(const LAS f32x4v*)(scr + r32 * TP + 64 * hi + 4 * i); v[4 * i] = t[0]; v[4 * i + 1] = t[1]; v[4 * i + 2] = t[2]; v[4 * i + 3] = t[3]; }
}
__device__ __forceinline__ float pair_sum(float x) {
  auto rr = __builtin_amdgcn_permlane32_swap(__float_as_uint(x), __float_as_uint(x), false, false); return __uint_as_float(rr[0]) + __uint_as_float(rr[1]);
}


#define PVX_RD2(L0, H0, D0, KS) do { L0 = tr_read<v_rd_off(D0, KS, 0)>(vb); H0 = tr_read<v_rd_off(D0, KS, 1)>(vb); } while (0)
#define PVX_PK(L, H) (bf16x8){L[0], L[1], L[2], L[3], H[0], H[1], H[2], H[3]}
#define PVX_E(i) do { if (DOEXP) { pn[i] = __builtin_amdgcn_exp2f(pn[i]); psn += pn[i]; } } while (0)
#define PVX_W(n) asm volatile("s_waitcnt lgkmcnt(" #n ")" ::: "memory")
#define PVX_BLOCK(D0, E0) do { \
    PVX_W(6); SBAR(); o[D0] = __builtin_amdgcn_mfma_f32_32x32x16_bf16(pa0, PVX_PK(fl0, fh0), o[D0], 0, 0, 0); PVX_E(E0 + 0); PVX_RD2(fl0, fh0, D0 + 1, 0); SBAR(); \
    PVX_W(6); SBAR(); o[D0] = __builtin_amdgcn_mfma_f32_32x32x16_bf16(pa1, PVX_PK(fl1, fh1), o[D0], 0, 0, 0); PVX_E(E0 + 1); PVX_RD2(fl1, fh1, D0 + 1, 1); SBAR(); \
    PVX_W(6); SBAR(); o[D0] = __builtin_amdgcn_mfma_f32_32x32x16_bf16(pa2, PVX_PK(fl2, fh2), o[D0], 0, 0, 0); PVX_E(E0 + 2); PVX_RD2(fl2, fh2, D0 + 1, 2); SBAR(); \
    PVX_W(6); SBAR(); o[D0] = __builtin_amdgcn_mfma_f32_32x32x16_bf16(pa3, PVX_PK(fl3, fh3), o[D0], 0, 0, 0); PVX_E(E0 + 3); PVX_RD2(fl3, fh3, D0 + 1, 3); SBAR(); } while (0)
template <bool DOEXP>
__device__ __forceinline__ void pv_exp(f32x16* o, int vb, bf16x8 pa0, bf16x8 pa1, bf16x8 pa2, bf16x8 pa3, f32x16& pn, float& psn) {
  s16x4 fl0, fh0, fl1, fh1, fl2, fh2, fl3, fh3;
  asm volatile("s_waitcnt lgkmcnt(0)" ::: "memory");
  PVX_RD2(fl0, fh0, 0, 0); PVX_RD2(fl1, fh1, 0, 1); PVX_RD2(fl2, fh2, 0, 2); PVX_RD2(fl3, fh3, 0, 3);
  PVX_BLOCK(0, 0); PVX_BLOCK(1, 4); PVX_BLOCK(2, 8);
  PVX_W(6); SBAR(); o[3] = __builtin_amdgcn_mfma_f32_32x32x16_bf16(pa0, PVX_PK(fl0, fh0), o[3], 0, 0, 0); PVX_E(12); SBAR();
  PVX_W(4); SBAR(); o[3] = __builtin_amdgcn_mfma_f32_32x32x16_bf16(pa1, PVX_PK(fl1, fh1), o[3], 0, 0, 0); PVX_E(13); SBAR();
  PVX_W(2); SBAR(); o[3] = __builtin_amdgcn_mfma_f32_32x32x16_bf16(pa2, PVX_PK(fl2, fh2), o[3], 0, 0, 0); PVX_E(14); SBAR();
  PVX_W(0); SBAR(); o[3] = __builtin_amdgcn_mfma_f32_32x32x16_bf16(pa3, PVX_PK(fl3, fh3), o[3], 0, 0, 0); PVX_E(15); SBAR();
}
__device__ __forceinline__ void expB_sum_pack2(f32x16& p0, f32x16& p1, float ps, float& l_reg, bf16x8& pa0, bf16x8& pa1, bf16x8& pa2, bf16x8& pa3) {
#pragma unroll
  for (int r = 0; r < 16; ++r) { p1[r] = __builtin_amdgcn_exp2f(p1[r]); ps += p1[r]; }
  { auto rr = __builtin_amdgcn_permlane32_swap(__float_as_uint(ps), __float_as_uint(ps), false, false);
    ps = __uint_as_float(rr[0]) + __uint_as_float(rr[1]); }
  l_reg += ps;
#define PK4(P, BASE, OUT) do { unsigned a0 = cvtpk(P[BASE + 0], P[BASE + 1]), a1 = cvtpk(P[BASE + 2], P[BASE + 3]);   \
    unsigned b0 = cvtpk(P[BASE + 4], P[BASE + 5]), b1 = cvtpk(P[BASE + 6], P[BASE + 7]);                              \
    auto r0 = __builtin_amdgcn_permlane32_swap(a0, b0, false, false); auto r1 = __builtin_amdgcn_permlane32_swap(a1, b1, false, false); \
    u32x4 w = {r0[0], r1[0], r0[1], r1[1]}; OUT = *reinterpret_cast<bf16x8*>(&w); } while (0)
  PK4(p0, 0, pa0); PK4(p0, 8, pa1); PK4(p1, 0, pa2); PK4(p1, 8, pa3);
#undef PK4
}
__device__ __forceinline__ float exp_sum16(f32x16& p0) { float ps = 0.f;
#pragma unroll
  for (int r = 0; r < 16; ++r) { p0[r] = __builtin_amdgcn_exp2f(p0[r]); ps += p0[r]; }
  return ps; }

__device__ __forceinline__ void attn_unit(const int wid, const bf16_t* __restrict__ proj, const char* __restrict__ Kt_bh, const char* __restrict__ Vt_bh, bf16_t* __restrict__ concat, int qrow0, int NT, int h,
                                          LAS char* lds, float lam, float omli, const float* __restrict__ subln) {
  const int lane = lane_id(), tid = wid * 64 + lane, r32 = lane & 31, hi = lane >> 5, rg = wid & 3, c = wid >> 2;
  LAS char* V_lds = lds; LAS char* K_lds = lds + 4 * SHM_V;
  LAS float* li_l = (LAS float*)(lds + 4 * SHM_V + 4 * SHM_K) + wid * 64;
  float l_reg = 0; f32x16 o[4] = {}; bf16x8 qr[4];
  const bf16_t* Qw = proj + (size_t)(qrow0 + rg * 32 + r32) * DP + C_DQ + h * 128 + c * 64 + hi * 8;
#pragma unroll
  for (int d0 = 0; d0 < 4; ++d0) qr[d0] = ld8(Qw + d0 * 16);
  const int vb0 = (int)(uintptr_t)V_lds + v_rd_base(lane);
  const char* kg0 = Kt_bh + wid * 2048 + lane * 16; const char* vg0 = Vt_bh + wid * 2048 + lane * 16;
#define DMA_TILE(tile, slot) do { const size_t to_ = (size_t)(tile) * 16384; \
    __builtin_amdgcn_global_load_lds((const unsigned*)(kg0 + to_), (LAS unsigned*)(K_lds + (slot) * SHM_K + wid * 2048), 16, 0, 0); \
    __builtin_amdgcn_global_load_lds((const unsigned*)(kg0 + to_ + 1024), (LAS unsigned*)(K_lds + (slot) * SHM_K + wid * 2048 + 1024), 16, 0, 0); \
    __builtin_amdgcn_global_load_lds((const unsigned*)(vg0 + to_), (LAS unsigned*)(V_lds + (slot) * SHM_V + wid * 2048), 16, 0, 0); \
    __builtin_amdgcn_global_load_lds((const unsigned*)(vg0 + to_ + 1024), (LAS unsigned*)(V_lds + (slot) * SHM_V + wid * 2048 + 1024), 16, 0, 0); } while (0)
#define BAR() do { asm volatile("s_waitcnt vmcnt(0) lgkmcnt(0)" ::: "memory"); __builtin_amdgcn_s_barrier(); asm volatile("" ::: "memory"); } while (0)
#define STAGE(b) do { if ((b) + 3 < NT) DMA_TILE((b) + 3, ((b) + 3) & 3); } while (0)
#define STAGES(b, slot) do { if ((b) + 3 < NT) DMA_TILE((b) + 3, slot); } while (0)
#define QKT(P0, P1, t) qkt<4>(P0, P1, K_lds + ((t) & 3) * SHM_K, qr, r32, hi, 4 * c)
#define QKTS(P0, P1, slot) qkt<4>(P0, P1, K_lds + (slot) * SHM_K, qr, r32, hi, 4 * c)
#define PV(t) pv_d0(o, vb0 + ((t) & 3) * SHM_V, pa0, pa1, pa2, pa3)
  f32x16 pA0, pA1, pB0, pB1; bf16x8 pa0, pa1, pa2, pa3; float psA = 0.f, psB = 0.f;
#define PVE(t, PN, PSN) do { PSN = 0.f; pv_exp<true>(o, vb0 + ((t) & 3) * SHM_V, pa0, pa1, pa2, pa3, PN, PSN); } while (0)
#define PVES(slot, PN, PSN) do { PSN = 0.f; pv_exp<true>(o, vb0 + (slot) * SHM_V, pa0, pa1, pa2, pa3, PN, PSN); } while (0)
#define PVL(t) do { float d_ = 0.f; pv_exp<false>(o, vb0 + ((t) & 3) * SHM_V, pa0, pa1, pa2, pa3, pA0, d_); } while (0)
  DMA_TILE(0, 0); DMA_TILE(1, 1); DMA_TILE(2, 2);
  BAR();
  QKT(pA0, pA1, 0); psA = exp_sum16(pA0);
  for (int t = 0; t < NT; t += 4) {
    if (c == 0) { BAR(); STAGES(t, 3); } SBAR();
    QKTS(pB0, pB1, 1); expB_sum_pack2(pA0, pA1, psA, l_reg, pa0, pa1, pa2, pa3); SBAR();
    if (c == 1) { BAR(); STAGES(t, 3); } SBAR();
    PVES(0, pB0, psB); SBAR();
    if (c == 0) { BAR(); STAGES(t + 1, 0); } SBAR();
    QKTS(pA0, pA1, 2); expB_sum_pack2(pB0, pB1, psB, l_reg, pa0, pa1, pa2, pa3); SBAR();
    if (c == 1) { BAR(); STAGES(t + 1, 0); } SBAR();
    PVES(1, pA0, psA); SBAR();
    if (c == 0) { BAR(); STAGES(t + 2, 1); } SBAR();
    QKTS(pB0, pB1, 3); expB_sum_pack2(pA0, pA1, psA, l_reg, pa0, pa1, pa2, pa3); SBAR();
    if (c == 1) { BAR(); STAGES(t + 2, 1); } SBAR();
    PVES(2, pB0, psB); SBAR();
    if (c == 0) { BAR(); STAGES(t + 3, 2); } SBAR();
    if (t + 4 < NT) QKTS(pA0, pA1, 0);
    expB_sum_pack2(pB0, pB1, psB, l_reg, pa0, pa1, pa2, pa3); SBAR();
    if (c == 1) { BAR(); STAGES(t + 3, 2); } SBAR();
    PVES(3, pA0, psA);
    SBAR();
  }
#undef PVE
#undef PVES
#undef QKTS
#undef STAGES
#undef PVL
  if (hi == 0) li_l[r32] = l_reg; asm volatile("s_waitcnt lgkmcnt(0)" ::: "memory");
#pragma unroll
  for (int r = 0; r < 16; ++r) { const float rl = __builtin_amdgcn_rcpf(li_l[crow(r, hi)]);
#pragma unroll
    for (int d0 = 0; d0 < 4; ++d0) o[d0][r] *= rl; }
  __syncthreads();
  LAS float* xch = (LAS float*)lds + rg * 4096;
  if (c == 1) {
#pragma unroll
    for (int d0 = 0; d0 < 4; ++d0)
#pragma unroll
      for (int r = 0; r < 16; ++r) xch[(d0 * 16 + r) * 64 + lane] = o[d0][r];
  }
  __syncthreads();
  if (c == 0) {
#pragma unroll
    for (int r = 0; r < 16; ++r) { float s = 0.f;
#pragma unroll
      for (int d0 = 0; d0 < 4; ++d0) { const float d = o[d0][r] - lam * xch[(d0 * 16 + r) * 64 + lane]; o[d0][r] = d; s += d * d; }
      s += __shfl_xor(s, 1); s += __shfl_xor(s, 2); s += __shfl_xor(s, 4); s += __shfl_xor(s, 8); s += __shfl_xor(s, 16);
      const float rr = rsqrtf(s * (1.f / 128.f) + EPS) * omli;
      bf16_t* orow = concat + (size_t)(qrow0 + rg * 32 + crow(r, hi)) * DM + 512 + h * 128 + r32;
#pragma unroll
      for (int d0 = 0; d0 < 4; ++d0) orow[d0 * 32] = f2bf(o[d0][r] * rr * subln[d0 * 32 + r32]); }
  }
  __syncthreads();
#undef DMA_TILE
#undef BAR
#undef STAGE
#undef QKT
#undef PV
}


typedef float f32x2 __attribute__((ext_vector_type(2)));
__device__ __forceinline__ void exp_half(f32x16& ph, f32x2& lacc) {
#if EXP_TREE
  f32x2 e[8];
#pragma unroll
  for (int r = 0; r < 16; r += 2) { ph[r] = __builtin_amdgcn_exp2f(ph[r]); ph[r + 1] = __builtin_amdgcn_exp2f(ph[r + 1]); e[r >> 1] = f32x2{ph[r], ph[r + 1]}; }
  lacc += ((e[0] + e[1]) + (e[2] + e[3])) + ((e[4] + e[5]) + (e[6] + e[7]));
#else
#pragma unroll
  for (int r = 0; r < 16; r += 2) { ph[r] = __builtin_amdgcn_exp2f(ph[r]); ph[r + 1] = __builtin_amdgcn_exp2f(ph[r + 1]); const f32x2 e = {ph[r], ph[r + 1]}; lacc += e; }
#endif
}
__device__ __forceinline__ void pack_half(const f32x16& ph, bf16x8& x0, bf16x8& x1) {
  { u32x4 w = {cvtpk(ph[0], ph[1]), cvtpk(ph[2], ph[3]), cvtpk(ph[4], ph[5]), cvtpk(ph[6], ph[7])}; x0 = *reinterpret_cast<bf16x8*>(&w); }
  { u32x4 w = {cvtpk(ph[8], ph[9]), cvtpk(ph[10], ph[11]), cvtpk(ph[12], ph[13]), cvtpk(ph[14], ph[15])}; x1 = *reinterpret_cast<bf16x8*>(&w); }
}

template <int D0> __device__ __forceinline__ void pv2_block(f32x16& oa, f32x16& ob, int vb, s16x4& fl0, s16x4& fh0, s16x4& fl1, s16x4& fh1, s16x4& fl2, s16x4& fh2, s16x4& fl3, s16x4& fh3,
                                                           bf16x8 a0, bf16x8 a1, bf16x8 a2, bf16x8 a3, bf16x8 b0, bf16x8 b1, bf16x8 b2, bf16x8 b3) {
#define PV2_STEP(A, B, FL, FH, KS, WN) do { asm volatile("s_waitcnt lgkmcnt(" #WN ")" ::: "memory"); SBAR(); \
    oa = __builtin_amdgcn_mfma_f32_32x32x16_bf16(A, PVX_PK(FL, FH), oa, 0, 0, 0); ob = __builtin_amdgcn_mfma_f32_32x32x16_bf16(B, PVX_PK(FL, FH), ob, 0, 0, 0); \
    if (D0 < 3) { FL = tr_read<v_rd_off((D0 + 1) & 3, KS, 0)>(vb); FH = tr_read<v_rd_off((D0 + 1) & 3, KS, 1)>(vb); } SBAR(); } while (0)
  if (D0 < 3) { PV2_STEP(a0, b0, fl0, fh0, 0, 6); PV2_STEP(a1, b1, fl1, fh1, 1, 6); PV2_STEP(a2, b2, fl2, fh2, 2, 6); PV2_STEP(a3, b3, fl3, fh3, 3, 6); }
  else        { PV2_STEP(a0, b0, fl0, fh0, 0, 6); PV2_STEP(a1, b1, fl1, fh1, 1, 4); PV2_STEP(a2, b2, fl2, fh2, 2, 2); PV2_STEP(a3, b3, fl3, fh3, 3, 0); }
#undef PV2_STEP
}
__device__ __forceinline__ void attn_unit3p(const int wid, const bf16_t* __restrict__ proj, const char* __restrict__ Kt_bh, const char* __restrict__ Vt_bh, bf16_t* __restrict__ concat, int qrow0, int NT, int h,
                                            LAS char* lds, float lam, float omli, const float* __restrict__ subln) {
  const int lane = lane_id(), r32 = lane & 31, hi = lane >> 5;
  LAS char* V_lds = lds; LAS char* K_lds = lds + 2 * SHM_V; LAS char* Qw = lds + 65536 + wid * 8192;
  LAS float* li_l = (LAS float*)(lds + 131072) + wid * 64;
  f32x2 l0v = {0.f, 0.f}, l1v = {0.f, 0.f}; f32x16 o0[4] = {}, o1[4] = {};
  const int vb0 = (int)(uintptr_t)V_lds + v_rd_base(lane);
  const char* kg0 = Kt_bh + wid * 2048 + lane * 16; const char* vg0 = Vt_bh + wid * 2048 + lane * 16;
#define DMA_TILE(tile, slot) do { const size_t to_ = (size_t)(tile) * 16384; \
    __builtin_amdgcn_global_load_lds((const unsigned*)(kg0 + to_), (LAS unsigned*)(K_lds + (slot) * SHM_K + wid * 2048), 16, 0, 0); \
    __builtin_amdgcn_global_load_lds((const unsigned*)(kg0 + to_ + 1024), (LAS unsigned*)(K_lds + (slot) * SHM_K + wid * 2048 + 1024), 16, 0, 0); \
    __builtin_amdgcn_global_load_lds((const unsigned*)(vg0 + to_), (LAS unsigned*)(V_lds + (slot) * SHM_V + wid * 2048), 16, 0, 0); \
    __builtin_amdgcn_global_load_lds((const unsigned*)(vg0 + to_ + 1024), (LAS unsigned*)(V_lds + (slot) * SHM_V + wid * 2048 + 1024), 16, 0, 0); } while (0)
#define BAR() do { asm volatile("s_waitcnt vmcnt(0) lgkmcnt(0)" ::: "memory"); __builtin_amdgcn_s_barrier(); asm volatile("" ::: "memory"); } while (0)
  bf16x8 qf00, qf01, qf02, qf03, qf10, qf11, qf12, qf13;
  { const bf16_t* qg = proj + (size_t)(qrow0 + wid * 32 + r32) * DP + C_DQ + h * 128 + hi * 8;
    qf00 = ld8(qg); qf01 = ld8(qg + 16); qf02 = ld8(qg + 32); qf03 = ld8(qg + 48); qf10 = ld8(qg + 64); qf11 = ld8(qg + 80); qf12 = ld8(qg + 96); qf13 = ld8(qg + 112); }
  DMA_TILE(0, 0);
  bf16x8 a0, a1, a2, a3, b0, b1, b2, b3;
  int sw0 = KSWZ(r32, (0 * 16 + hi * 8) * 2), sw1 = KSWZ(r32, (1 * 16 + hi * 8) * 2), sw2 = KSWZ(r32, (2 * 16 + hi * 8) * 2), sw3 = KSWZ(r32, (3 * 16 + hi * 8) * 2);
  int kad0_ = (int)(uintptr_t)K_lds + sw0, kad1_ = (int)(uintptr_t)K_lds + sw1, kad2_ = (int)(uintptr_t)K_lds + sw2, kad3_ = (int)(uintptr_t)K_lds + sw3;
  asm volatile("" : "+v"(kad0_), "+v"(kad1_), "+v"(kad2_), "+v"(kad3_));
  LAS char* const kad0 = (LAS char*)(uintptr_t)kad0_; LAS char* const kad1 = (LAS char*)(uintptr_t)kad1_; LAS char* const kad2 = (LAS char*)(uintptr_t)kad2_; LAS char* const kad3 = (LAS char*)(uintptr_t)kad3_;
#define QK2(P0, P1, so, cc) do { P0 = f32x16{}; P1 = f32x16{}; _Pragma("unroll") for (int d0 = 0; d0 < 4; ++d0) { const int cb = ((4 * (cc) + d0) * 16 + hi * 8) * 2; \
    const bf16x8 ka_ = *reinterpret_cast<const LAS bf16x8*>(K_lds + (so) * SHM_K + KSWZ(r32, cb)), kb_ = *reinterpret_cast<const LAS bf16x8*>(K_lds + (so) * SHM_K + KSWZ(32 + r32, cb)); \
    const bf16x8 q_ = *reinterpret_cast<const LAS bf16x8*>(Qw + KSWZ(r32, cb)); \
    P0 = __builtin_amdgcn_mfma_f32_32x32x16_bf16(ka_, q_, P0, 0, 0, 0); P1 = __builtin_amdgcn_mfma_f32_32x32x16_bf16(kb_, q_, P1, 0, 0, 0); } } while (0)
#define QKA(PH, so, cc, koff) do { PH = f32x16{}; \
    { const bf16x8 k_ = *reinterpret_cast<const LAS bf16x8*>(kad0 + ((so) * SHM_K + (koff) * 256 + 128 * (cc))); PH = __builtin_amdgcn_mfma_f32_32x32x16_bf16(k_, (cc) ? qf10 : qf00, PH, 0, 0, 0); } \
    { const bf16x8 k_ = *reinterpret_cast<const LAS bf16x8*>(kad1 + ((so) * SHM_K + (koff) * 256 + 128 * (cc))); PH = __builtin_amdgcn_mfma_f32_32x32x16_bf16(k_, (cc) ? qf11 : qf01, PH, 0, 0, 0); } } while (0)
#define QKB(PH, so, cc, koff) do { \
    { const bf16x8 k_ = *reinterpret_cast<const LAS bf16x8*>(kad2 + ((so) * SHM_K + (koff) * 256 + 128 * (cc))); PH = __builtin_amdgcn_mfma_f32_32x32x16_bf16(k_, (cc) ? qf12 : qf02, PH, 0, 0, 0); } \
    { const bf16x8 k_ = *reinterpret_cast<const LAS bf16x8*>(kad3 + ((so) * SHM_K + (koff) * 256 + 128 * (cc))); PH = __builtin_amdgcn_mfma_f32_32x32x16_bf16(k_, (cc) ? qf13 : qf03, PH, 0, 0, 0); } } while (0)
#define QKH(PH, so, cc, koff) do { QKA(PH, so, cc, koff); QKB(PH, so, cc, koff); } while (0)
#define SGB(m, n) __builtin_amdgcn_sched_group_barrier(m, n, 0)
#define STEP(PN, so, cc, koff, PO, LV, X0, X1) do { \
    QKA(PN, so, cc, koff); exp_half(PO, LV); SGB(0x100, 2); SGB(0x8, 1); SGB(0x2, 12); SGB(0x8, 1); SGB(0x2, 12); SBAR(); asm volatile("" : "+v"(LV)); SBAR(); \
    QKB(PN, so, cc, koff); pack_half(PO, X0, X1); SGB(0x100, 2); SGB(0x8, 1); SGB(0x2, 4); SGB(0x8, 1); SGB(0x2, 4); MBAR(PN); } while (0)
#define MBAR(X) do { SBAR(); asm volatile("" : "+v"(X) :: "memory"); SBAR(); } while (0)
#define TILE(t, so) do { BAR(); if ((t) + 1 < NT) DMA_TILE((t) + 1, 1 - (so)); SBAR(); \
    { f32x16 p0, p1; \
      QKH(p0, so, 0, 0); MBAR(p0); \
      STEP(p1, so, 0, 32, p0, l0v, a0, a1); \
      STEP(p0, so, 1, 0, p1, l0v, a2, a3); \
      STEP(p1, so, 1, 32, p0, l1v, b0, b1); \
      exp_half(p1, l1v); SBAR(); asm volatile("" : "+v"(l1v)); SBAR(); pack_half(p1, b2, b3); } SBAR(); \
    { const int vb = vb0 + (so) * SHM_V; s16x4 fl0, fh0, fl1, fh1, fl2, fh2, fl3, fh3; \
      asm volatile("s_waitcnt lgkmcnt(0)" ::: "memory"); \
      PVX_RD2(fl0, fh0, 0, 0); PVX_RD2(fl1, fh1, 0, 1); PVX_RD2(fl2, fh2, 0, 2); PVX_RD2(fl3, fh3, 0, 3); \
      pv2_block<0>(o0[0], o1[0], vb, fl0, fh0, fl1, fh1, fl2, fh2, fl3, fh3, a0, a1, a2, a3, b0, b1, b2, b3); \
      pv2_block<1>(o0[1], o1[1], vb, fl0, fh0, fl1, fh1, fl2, fh2, fl3, fh3, a0, a1, a2, a3, b0, b1, b2, b3); \
      pv2_block<2>(o0[2], o1[2], vb, fl0, fh0, fl1, fh1, fl2, fh2, fl3, fh3, a0, a1, a2, a3, b0, b1, b2, b3); \
      pv2_block<3>(o0[3], o1[3], vb, fl0, fh0, fl1, fh1, fl2, fh2, fl3, fh3, a0, a1, a2, a3, b0, b1, b2, b3); } SBAR(); } while (0)
  for (int t = 0; t < NT; t += 2) { TILE(t, 0); TILE(t + 1, 1); }
  const float l0 = pair_sum(l0v[0] + l0v[1]), l1 = pair_sum(l1v[0] + l1v[1]);
  if (hi == 0) { li_l[r32] = l0; li_l[32 + r32] = l1; } asm volatile("s_waitcnt lgkmcnt(0)" ::: "memory");
#pragma unroll
  for (int r = 0; r < 16; ++r) { const float ra = __builtin_amdgcn_rcpf(li_l[crow(r, hi)]), rb = lam * __builtin_amdgcn_rcpf(li_l[32 + crow(r, hi)]);
    float s = 0.f;
#pragma unroll
    for (int d0 = 0; d0 < 4; ++d0) { const float d = o0[d0][r] * ra - o1[d0][r] * rb; o0[d0][r] = d; s += d * d; }
    s += __shfl_xor(s, 1); s += __shfl_xor(s, 2); s += __shfl_xor(s, 4); s += __shfl_xor(s, 8); s += __shfl_xor(s, 16);
    const float rr = rsqrtf(s * (1.f / 128.f) + EPS) * omli;
    bf16_t* orow = concat + (size_t)(qrow0 + wid * 32 + crow(r, hi)) * DM + 512 + h * 128 + r32;
#pragma unroll
    for (int d0 = 0; d0 < 4; ++d0) orow[d0 * 32] = f2bf(o0[d0][r] * rr * subln[d0 * 32 + r32]); }
  asm volatile("s_waitcnt vmcnt(0) lgkmcnt(0)" ::: "memory"); __syncthreads();
#undef DMA_TILE
#undef BAR
#undef QK2
#undef QKH
#undef QKA
#undef QKB
#undef TILE
#undef STEP
#undef MBAR
#undef SGB
}

#ifndef EXP_TREE
#define EXP_TREE 1
#endif
#ifndef ATT_PRIO
#define ATT_PRIO 1
#endif
template <int OFF> __device__ __forceinline__ bf16x8 ldsb128(int addr) { bf16x8 r; asm volatile("ds_read_b128 %0, %1 offset:%2" : "=&v"(r) : "v"(addr), "i"(OFF) : "memory"); return r; }
constexpr int vt_rd_off(int so, int d0, int ks) { return so * 16384 + d0 * 4096 + (ks >> 1) * 64; }
template <int SO, int D0> __device__ __forceinline__ void pvt_block(f32x16& oa, f32x16& ob, int va0, int va1, bf16x8& f0, bf16x8& f1, bf16x8& f2, bf16x8& f3,
                                                                   bf16x8 a0, bf16x8 a1, bf16x8 a2, bf16x8 a3, bf16x8 b0, bf16x8 b1, bf16x8 b2, bf16x8 b3) {
#define PVT_STEP(A, B, F, KS, WN) do { asm volatile("s_waitcnt lgkmcnt(" #WN ")" ::: "memory"); SBAR(); \
    oa = __builtin_amdgcn_mfma_f32_32x32x16_bf16(A, F, oa, 0, 0, 0); ob = __builtin_amdgcn_mfma_f32_32x32x16_bf16(B, F, ob, 0, 0, 0); \
    if (D0 < 3) F = ldsb128<vt_rd_off(SO, (D0 + 1) & 3, KS)>((KS & 1) ? va1 : va0); SBAR(); } while (0)
  if (D0 < 3) { PVT_STEP(a0, b0, f0, 0, 3); PVT_STEP(a1, b1, f1, 1, 3); PVT_STEP(a2, b2, f2, 2, 3); PVT_STEP(a3, b3, f3, 3, 3); }
  else        { PVT_STEP(a0, b0, f0, 0, 3); PVT_STEP(a1, b1, f1, 1, 2); PVT_STEP(a2, b2, f2, 2, 1); PVT_STEP(a3, b3, f3, 3, 0); }
#undef PVT_STEP
}
__device__ __forceinline__ void attn_unit3q(const int wid, const bf16_t* __restrict__ proj, const char* __restrict__ Kt_bh, const char* __restrict__ Vt_bh, bf16_t* __restrict__ concat, int qrow0, int NT, int h,
                                            LAS char* lds, float lam, float omli, const float* __restrict__ subln) {
  const int lane = lane_id(), r32 = lane & 31, hi = lane >> 5, rg = wid & 3, c = wid >> 2;
  LAS char* V_lds = lds; LAS char* K_lds = lds + 2 * SHM_V;
  LAS float* li_l = (LAS float*)(lds + 131072) + wid * 64;
  f32x2 l0v = {0.f, 0.f}, l1v = {0.f, 0.f}; f32x16 o0[4] = {}, o1[4] = {};
  int va0 = (int)(uintptr_t)V_lds + r32 * 128 + ((hi ^ ((r32 >> 1) & 3)) << 4), va1 = (int)(uintptr_t)V_lds + r32 * 128 + (((2 + hi) ^ ((r32 >> 1) & 3)) << 4);
  asm volatile("" : "+v"(va0), "+v"(va1));
  const char* kg0 = Kt_bh + wid * 2048 + lane * 16; const char* vg0 = Vt_bh + wid * 2048 + lane * 16;
#define DMA_TILE(tile, slot) do { const size_t to_ = (size_t)(tile) * 16384; \
    __builtin_amdgcn_global_load_lds((const unsigned*)(kg0 + to_), (LAS unsigned*)(K_lds + (slot) * SHM_K + wid * 2048), 16, 0, 0); \
    __builtin_amdgcn_global_load_lds((const unsigned*)(kg0 + to_ + 1024), (LAS unsigned*)(K_lds + (slot) * SHM_K + wid * 2048 + 1024), 16, 0, 0); \
    __builtin_amdgcn_global_load_lds((const unsigned*)(vg0 + to_), (LAS unsigned*)(V_lds + (slot) * SHM_V + wid * 2048), 16, 0, 0); \
    __builtin_amdgcn_global_load_lds((const unsigned*)(vg0 + to_ + 1024), (LAS unsigned*)(V_lds + (slot) * SHM_V + wid * 2048 + 1024), 16, 0, 0); } while (0)
#define BAR() do { asm volatile("s_waitcnt vmcnt(0) lgkmcnt(0)" ::: "memory"); __builtin_amdgcn_s_barrier(); asm volatile("" ::: "memory"); } while (0)
  bf16x8 qf00, qf01, qf02, qf03, qf10, qf11, qf12, qf13;
  { const bf16_t* qg = proj + (size_t)(qrow0 + rg * 64 + r32) * DP + C_DQ + h * 128 + c * 64 + hi * 8;
    qf00 = ld8(qg); qf01 = ld8(qg + 16); qf02 = ld8(qg + 32); qf03 = ld8(qg + 48); qg += (size_t)32 * DP;
    qf10 = ld8(qg); qf11 = ld8(qg + 16); qf12 = ld8(qg + 32); qf13 = ld8(qg + 48); }
  DMA_TILE(0, 0);
  bf16x8 a0, a1, a2, a3, b0, b1, b2, b3;
  int kad0_ = (int)(uintptr_t)K_lds + KSWZ(r32, (0 * 16 + hi * 8) * 2) + 128 * c, kad1_ = (int)(uintptr_t)K_lds + KSWZ(r32, (1 * 16 + hi * 8) * 2) + 128 * c;
  int kad2_ = (int)(uintptr_t)K_lds + KSWZ(r32, (2 * 16 + hi * 8) * 2) + 128 * c, kad3_ = (int)(uintptr_t)K_lds + KSWZ(r32, (3 * 16 + hi * 8) * 2) + 128 * c;
  asm volatile("" : "+v"(kad0_), "+v"(kad1_), "+v"(kad2_), "+v"(kad3_));
  LAS char* const kad0 = (LAS char*)(uintptr_t)kad0_; LAS char* const kad1 = (LAS char*)(uintptr_t)kad1_; LAS char* const kad2 = (LAS char*)(uintptr_t)kad2_; LAS char* const kad3 = (LAS char*)(uintptr_t)kad3_;
#define QKA(PH, so, rb, koff, LK) do { PH = f32x16{}; \
    { if (LK) kf0 = *reinterpret_cast<const LAS bf16x8*>(kad0 + ((so) * SHM_K + (koff) * 256)); PH = __builtin_amdgcn_mfma_f32_32x32x16_bf16(kf0, (rb) ? qf10 : qf00, PH, 0, 0, 0); } \
    { if (LK) kf1 = *reinterpret_cast<const LAS bf16x8*>(kad1 + ((so) * SHM_K + (koff) * 256)); PH = __builtin_amdgcn_mfma_f32_32x32x16_bf16(kf1, (rb) ? qf11 : qf01, PH, 0, 0, 0); } } while (0)
#define QKB(PH, so, rb, koff, LK) do { \
    { if (LK) kf2 = *reinterpret_cast<const LAS bf16x8*>(kad2 + ((so) * SHM_K + (koff) * 256)); PH = __builtin_amdgcn_mfma_f32_32x32x16_bf16(kf2, (rb) ? qf12 : qf02, PH, 0, 0, 0); } \
    { if (LK) kf3 = *reinterpret_cast<const LAS bf16x8*>(kad3 + ((so) * SHM_K + (koff) * 256)); PH = __builtin_amdgcn_mfma_f32_32x32x16_bf16(kf3, (rb) ? qf13 : qf03, PH, 0, 0, 0); } } while (0)
#define SGB(m, n) __builtin_amdgcn_sched_group_barrier(m, n, 0)
#define MBAR(X) do { SBAR(); asm volatile("" : "+v"(X) :: "memory"); SBAR(); } while (0)
#define STEP(PN, so, rb, koff, LK, PO, LV, X0, X1) do { \
    QKA(PN, so, rb, koff, LK); exp_half(PO, LV); if (LK) SGB(0x100, 2); SGB(0x8, 1); SGB(0x2, 12); SGB(0x8, 1); SGB(0x2, 12); SBAR(); asm volatile("" : "+v"(LV)); SBAR(); \
    QKB(PN, so, rb, koff, LK); pack_half(PO, X0, X1); if (LK) SGB(0x100, 2); SGB(0x8, 1); SGB(0x2, 4); SGB(0x8, 1); SGB(0x2, 4); MBAR(PN); } while (0)
#define PVS(OA, OB, A, B, F, WN, so, ND0, NKS) do { asm volatile("s_waitcnt lgkmcnt(" #WN ")" ::: "memory"); SBAR(); \
    OA = __builtin_amdgcn_mfma_f32_32x32x16_bf16(A, F, OA, 0, 0, 0); OB = __builtin_amdgcn_mfma_f32_32x32x16_bf16(B, F, OB, 0, 0, 0); \
    if ((ND0) >= 0) F = ldsb128<vt_rd_off(so, (ND0) < 0 ? 0 : (ND0), NKS)>(((NKS) & 1) ? va1 : va0); SBAR(); } while (0)
#define EXQ(PH, LV, R0) do { PH[(R0)] = __builtin_amdgcn_exp2f(PH[(R0)]); PH[(R0) + 1] = __builtin_amdgcn_exp2f(PH[(R0) + 1]); PH[(R0) + 2] = __builtin_amdgcn_exp2f(PH[(R0) + 2]); PH[(R0) + 3] = __builtin_amdgcn_exp2f(PH[(R0) + 3]); \
    LV += f32x2{PH[(R0)], PH[(R0) + 1]} + f32x2{PH[(R0) + 2], PH[(R0) + 3]}; SBAR(); } while (0)
#define PKQ(PH, R0, X) do { u32x4 w_ = {cvtpk(PH[(R0)], PH[(R0) + 1]), cvtpk(PH[(R0) + 2], PH[(R0) + 3]), cvtpk(PH[(R0) + 4], PH[(R0) + 5]), cvtpk(PH[(R0) + 6], PH[(R0) + 7])}; X = *reinterpret_cast<bf16x8*>(&w_); SBAR(); } while (0)
#define TILE(t, so) do { BAR(); if ((t) + 1 < NT) DMA_TILE((t) + 1, 1 - (so)); SBAR(); \
    bf16x8 vf0, vf1, vf2, vf3; \
    { f32x16 p0, p1; bf16x8 kf0, kf1, kf2, kf3; \
      QKA(p0, so, 0, 0, 1); QKB(p0, so, 0, 0, 1); MBAR(p0); \
      STEP(p1, so, 1, 0, 0, p0, l0v, a0, a1); \
      STEP(p0, so, 0, 32, 1, p1, l1v, b0, b1); \
      STEP(p1, so, 1, 32, 0, p0, l0v, a2, a3); \
      SBAR(); vf0 = ldsb128<vt_rd_off(so, 0, 0)>(va0); vf1 = ldsb128<vt_rd_off(so, 0, 1)>(va1); vf2 = ldsb128<vt_rd_off(so, 1, 0)>(va0); vf3 = ldsb128<vt_rd_off(so, 1, 1)>(va1); SBAR(); \
        \
        \
      PVS(o0[0], o1[0], a0, b0, vf0, 3, so, 2, 0); EXQ(p1, l1v, 0); \
      PVS(o0[0], o1[0], a1, b1, vf1, 3, so, 2, 1); EXQ(p1, l1v, 4); \
      PVS(o0[1], o1[1], a0, b0, vf2, 3, so, 3, 0); EXQ(p1, l1v, 8); \
      PVS(o0[1], o1[1], a1, b1, vf3, 3, so, 3, 1); EXQ(p1, l1v, 12); \
      PVS(o0[2], o1[2], a0, b0, vf0, 3, so, 0, 2); PKQ(p1, 0, b2); \
      PVS(o0[2], o1[2], a1, b1, vf1, 3, so, 0, 3); PKQ(p1, 8, b3); \
      PVS(o0[3], o1[3], a0, b0, vf2, 3, so, 1, 2); \
      PVS(o0[3], o1[3], a1, b1, vf3, 3, so, 1, 3); } SBAR(); \
    { \
      PVS(o0[0], o1[0], a2, b2, vf0, 3, so, 2, 2); PVS(o0[0], o1[0], a3, b3, vf1, 3, so, 2, 3); \
      PVS(o0[1], o1[1], a2, b2, vf2, 3, so, 3, 2); PVS(o0[1], o1[1], a3, b3, vf3, 3, so, 3, 3); \
      PVS(o0[2], o1[2], a2, b2, vf0, 3, so, -1, 0); PVS(o0[2], o1[2], a3, b3, vf1, 2, so, -1, 0); \
      PVS(o0[3], o1[3], a2, b2, vf2, 1, so, -1, 0); PVS(o0[3], o1[3], a3, b3, vf3, 0, so, -1, 0); } SBAR(); } while (0)
#if ATT_PRIO
  if (wid >= 4) __builtin_amdgcn_s_setprio(1);
#endif
  for (int t = 0; t < NT; t += 2) { TILE(t, 0); TILE(t + 1, 1); }
#if ATT_PRIO
  __builtin_amdgcn_s_setprio(0);
#endif
  const float l0 = pair_sum(l0v[0] + l0v[1]), l1 = pair_sum(l1v[0] + l1v[1]);
  if (hi == 0) { li_l[r32] = l0; li_l[32 + r32] = l1; }
  asm volatile("s_waitcnt vmcnt(0) lgkmcnt(0)" ::: "memory"); __syncthreads();
  LAS float* xw = (LAS float*)(lds + (rg * 2 + c) * 16384) + lane; const LAS float* xr = (const LAS float*)(lds + (rg * 2 + (1 - c)) * 16384) + lane;
  const float sgn = c ? lam : 1.f;
#define SEND(OX, LOFF) do { _Pragma("unroll") for (int r = 0; r < 16; ++r) { const float rl = sgn * __builtin_amdgcn_rcpf(li_l[(LOFF) + crow(r, hi)]); \
    _Pragma("unroll") for (int d0 = 0; d0 < 4; ++d0) xw[(d0 * 16 + r) * 64] = OX[d0][r] * rl; } } while (0)
  if (c == 0) SEND(o1, 32); else SEND(o0, 0);
  asm volatile("s_waitcnt lgkmcnt(0)" ::: "memory"); __syncthreads();
#define FINISH(OX, LOFF, RB) do { _Pragma("unroll") for (int r = 0; r < 16; ++r) { const float rl = sgn * __builtin_amdgcn_rcpf(li_l[(LOFF) + crow(r, hi)]); float s = 0.f; \
    _Pragma("unroll") for (int d0 = 0; d0 < 4; ++d0) { const float own = OX[d0][r] * rl, oth = xr[(d0 * 16 + r) * 64]; const float d = c ? oth - own : own - oth; OX[d0][r] = d; s += d * d; } \
    s += __shfl_xor(s, 1); s += __shfl_xor(s, 2); s += __shfl_xor(s, 4); s += __shfl_xor(s, 8); s += __shfl_xor(s, 16); \
    const float rr = rsqrtf(s * (1.f / 128.f) + EPS) * omli; \
    bf16_t* orow = concat + (size_t)(qrow0 + rg * 64 + (RB) * 32 + crow(r, hi)) * DM + 512 + h * 128 + r32; \
    _Pragma("unroll") for (int d0 = 0; d0 < 4; ++d0) orow[d0 * 32] = f2bf(OX[d0][r] * rr * subln[d0 * 32 + r32]); } } while (0)
  if (c == 0) FINISH(o0, 0, 0); else FINISH(o1, 32, 1);
  asm volatile("s_waitcnt vmcnt(0) lgkmcnt(0)" ::: "memory"); __syncthreads();
#undef SEND
#undef FINISH
#undef DMA_TILE
#undef BAR
#undef QKA
#undef QKB
#undef TILE
#undef PVS
#undef EXQ
#undef PKQ
#undef STEP
#undef MBAR
#undef SGB
}

__device__ __forceinline__ bf16x8 scale8(bf16x8 v, float s) {
  u32x4 w;
#pragma unroll
  for (int i = 0; i < 4; ++i) { const float a = __uint_as_float(((unsigned)(unsigned short)v[2 * i]) << 16) * s, b = __uint_as_float(((unsigned)(unsigned short)v[2 * i + 1]) << 16) * s; w[i] = cvtpk(a, b); }
  return *reinterpret_cast<bf16x8*>(&w);
}
template <int KS> __device__ __forceinline__ void trfrag_issue(int vb, s16x4& l, s16x4& h) { l = tr_read<v_rd_off(0, KS, 0)>(vb); h = tr_read<v_rd_off(0, KS, 1)>(vb); }
#define PKF(L, H) (bf16x8){L[0], L[1], L[2], L[3], H[0], H[1], H[2], H[3]}
template <int KS> __device__ __forceinline__ void cs_step(f32x16* acc, int kb, int vv) {
  s16x4 al, ah, b0l, b0h, b1l, b1h, b2l, b2h, b3l, b3h;
  trfrag_issue<KS>(kb, al, ah); trfrag_issue<KS>(vv, b0l, b0h); trfrag_issue<KS>(vv + 512, b1l, b1h); trfrag_issue<KS>(vv + 1024, b2l, b2h); trfrag_issue<KS>(vv + 1536, b3l, b3h);
  asm volatile("s_waitcnt lgkmcnt(0)" ::: "memory"); SBAR();
  const bf16x8 a = PKF(al, ah);
  acc[0] = __builtin_amdgcn_mfma_f32_32x32x16_bf16(a, PKF(b0l, b0h), acc[0], 0, 0, 0);
  acc[1] = __builtin_amdgcn_mfma_f32_32x32x16_bf16(a, PKF(b1l, b1h), acc[1], 0, 0, 0);
  acc[2] = __builtin_amdgcn_mfma_f32_32x32x16_bf16(a, PKF(b2l, b2h), acc[2], 0, 0, 0);
  acc[3] = __builtin_amdgcn_mfma_f32_32x32x16_bf16(a, PKF(b3l, b3h), acc[3], 0, 0, 0);
}
__device__ __forceinline__ void chunk_state_unit(const int wid, const bf16_t* __restrict__ proj, bf16_t* __restrict__ csf, bf16_t* __restrict__ csb, int rowbase, int h, float lgf2, float lgb2, LAS char* lds) {
  const int lane = lane_id(), tid = wid * 64 + lane, r32 = lane & 31, hi = lane >> 5;
  const int sr = tid >> 4, sc = (tid & 15) * 8;
  { bf16x8 kv[4], vv[4];
#pragma unroll
    for (int g = 0; g < 4; ++g) { const bf16_t* rp = proj + (size_t)(rowbase + 32 * g + sr) * DP + h * 128 + sc; kv[g] = ld8(rp + C_RK); vv[g] = ld8(rp + C_RV); }
#pragma unroll
    for (int g = 0; g < 4; ++g) { const int row = 32 * g + sr;
      const float wf = __builtin_amdgcn_exp2f(lgf2 * (float)(127 - row)), wb = __builtin_amdgcn_exp2f(lgb2 * (float)row);
      const int off = (row >> 6) * 16384 + v_st(row & 63, sc);
      *(LAS bf16x8*)(lds + off) = vv[g]; *(LAS bf16x8*)(lds + 32768 + off) = scale8(kv[g], wf); *(LAS bf16x8*)(lds + 65536 + off) = scale8(kv[g], wb); } }
  __syncthreads();
  const int dir = wid >> 2, ib = wid & 3;
  const int vbK = (int)(uintptr_t)(lds + 32768 + dir * 32768) + v_rd_base(lane) + ib * 512, vbV = (int)(uintptr_t)lds + v_rd_base(lane);
  f32x16 acc[4] = {};
  cs_step<0>(acc, vbK, vbV); cs_step<1>(acc, vbK, vbV); cs_step<2>(acc, vbK, vbV); cs_step<3>(acc, vbK, vbV);
  cs_step<0>(acc, vbK + 16384, vbV + 16384); cs_step<1>(acc, vbK + 16384, vbV + 16384); cs_step<2>(acc, vbK + 16384, vbV + 16384); cs_step<3>(acc, vbK + 16384, vbV + 16384);
  bf16_t* outp = (dir ? csb : csf) + r32;
#pragma unroll
  for (int r = 0; r < 16; ++r) { bf16_t* orow = outp + (size_t)(32 * ib + crow(r, hi)) * 128;
#pragma unroll
    for (int jb = 0; jb < 4; ++jb) orow[32 * jb] = f2bf(acc[jb][r]); }
  __syncthreads();
}
__device__ __forceinline__ void pack_p(const f32x16& p0, const f32x16& p1, bf16x8& pa0, bf16x8& pa1, bf16x8& pa2, bf16x8& pa3) {
#define PK4(P, BASE, OUT) do { unsigned a0 = cvtpk(P[BASE + 0], P[BASE + 1]), a1 = cvtpk(P[BASE + 2], P[BASE + 3]);   \
    unsigned b0 = cvtpk(P[BASE + 4], P[BASE + 5]), b1 = cvtpk(P[BASE + 6], P[BASE + 7]);                              \
    auto r0 = __builtin_amdgcn_permlane32_swap(a0, b0, false, false); auto r1 = __builtin_amdgcn_permlane32_swap(a1, b1, false, false); \
    u32x4 w = {r0[0], r1[0], r0[1], r1[1]}; OUT = *reinterpret_cast<bf16x8*>(&w); } while (0)
  PK4(p0, 0, pa0); PK4(p0, 8, pa1); PK4(p1, 0, pa2); PK4(p1, 8, pa3);
#undef PK4
}
__device__ __forceinline__ float decay_w(int d, float lgf2, float lgb2) {
  const float e = __builtin_amdgcn_exp2f(d < 0 ? lgf2 * (float)(-d) : lgb2 * (float)d); return d == 0 ? 2.f : e;
}
__device__ __forceinline__ void ret_out_unit(const int wid, const bf16_t* __restrict__ proj, bf16_t* __restrict__ concat, const bf16_t* __restrict__ spA, const bf16_t* __restrict__ spB, size_t dstride,
                                             int rowA, int rowB, int h, float lgf2, float lgb2, const float* __restrict__ gn, LAS char* lds) {
  const int lane = lane_id(), tid = wid * 64 + lane, r32 = lane & 31, hi = lane >> 5, rg = wid & 3, ch = wid >> 2;
  const int sr = tid >> 4, sc = (tid & 15) * 8;
  const int rowbase = ch ? rowB : rowA;
  { bf16x8 kv[8], vv[8];
#pragma unroll
    for (int c2 = 0; c2 < 2; ++c2)
#pragma unroll
      for (int g = 0; g < 4; ++g) { const bf16_t* rp = proj + (size_t)((c2 ? rowB : rowA) + 32 * g + sr) * DP + h * 128 + sc; kv[c2 * 4 + g] = ld8(rp + C_RK); vv[c2 * 4 + g] = ld8(rp + C_RV); }
#pragma unroll
    for (int c2 = 0; c2 < 2; ++c2)
#pragma unroll
      for (int g = 0; g < 4; ++g) { const int row = 32 * g + sr;
        *(LAS bf16x8*)(lds + c2 * 65536 + (row >> 6) * 16384 + KSWZ(row & 63, sc * 2)) = kv[c2 * 4 + g];
        *(LAS bf16x8*)(lds + c2 * 65536 + 32768 + (row >> 6) * 16384 + v_st(row & 63, sc)) = vv[c2 * 4 + g]; } }
  bf16x8 qr[8];
  const bf16_t* Qw = proj + (size_t)(rowbase + rg * 32 + r32) * DP + C_RQ + h * 128 + hi * 8;
#pragma unroll
  for (int d0 = 0; d0 < 8; ++d0) qr[d0] = ld8(Qw + d0 * 16);
  __syncthreads();
  const int m = rg * 32 + r32;
  LAS char* myreg = lds + ch * 65536;
  const int vb = (int)(uintptr_t)myreg + v_rd_base(lane);
  f32x16 o[4] = {}; f32x16 p0, p1; bf16x8 pa0, pa1, pa2, pa3;
#pragma unroll
  for (int kt = 0; kt < 2; ++kt) {
    qkt<8>(p0, p1, myreg + kt * 16384, qr, r32, hi, 0);
    int mm = m - 4 * hi; asm volatile("" : "+v"(mm));
#pragma unroll
    for (int r = 0; r < 16; ++r) { const int s0 = 64 * kt + (r & 3) + 8 * (r >> 2); p0[r] *= decay_w(s0 - mm, lgf2, lgb2); p1[r] *= decay_w(s0 + 32 - mm, lgf2, lgb2); }
    pack_p(p0, p1, pa0, pa1, pa2, pa3);
    pv_d0(o, vb + 32768 + kt * 16384, pa0, pa1, pa2, pa3);
  }
  __syncthreads();
  { bf16x8 sv[16];
#pragma unroll
    for (int c2 = 0; c2 < 2; ++c2)
#pragma unroll
      for (int d = 0; d < 2; ++d)
#pragma unroll
        for (int g = 0; g < 4; ++g) sv[(c2 * 2 + d) * 4 + g] = ld8((c2 ? spB : spA) + (size_t)d * dstride + (size_t)(32 * g + sr) * 128 + sc);
#pragma unroll
    for (int c2 = 0; c2 < 2; ++c2)
#pragma unroll
      for (int d = 0; d < 2; ++d)
#pragma unroll
        for (int g = 0; g < 4; ++g) { const int row = 32 * g + sr;
          *(LAS bf16x8*)(lds + c2 * 65536 + d * 32768 + (row >> 6) * 16384 + v_st(row & 63, sc)) = sv[(c2 * 2 + d) * 4 + g]; } }
  const float xf = __builtin_amdgcn_exp2f(lgf2 * (float)(m + 1)), xb = __builtin_amdgcn_exp2f(lgb2 * (float)(128 - m));
  __syncthreads();
#pragma unroll
  for (int d = 0; d < 2; ++d) { const float xs = d ? xb : xf;
#pragma unroll
    for (int sub = 0; sub < 2; ++sub) {
      const bf16x8 a0 = scale8(qr[4 * sub + 0], xs), a1 = scale8(qr[4 * sub + 1], xs), a2 = scale8(qr[4 * sub + 2], xs), a3 = scale8(qr[4 * sub + 3], xs);
      pv_d0(o, vb + d * 32768 + sub * 16384, a0, a1, a2, a3); } }
#pragma unroll
  for (int r = 0; r < 16; ++r) {
    float s = (o[0][r] + o[1][r]) + (o[2][r] + o[3][r]);
    s += __shfl_xor(s, 1); s += __shfl_xor(s, 2); s += __shfl_xor(s, 4); s += __shfl_xor(s, 8); s += __shfl_xor(s, 16);
    const float mu = s * (1.f / 128.f);
    float q = 0.f;
#pragma unroll
    for (int d0 = 0; d0 < 4; ++d0) { const float dd = o[d0][r] - mu; o[d0][r] = dd; q += dd * dd; }
    q += __shfl_xor(q, 1); q += __shfl_xor(q, 2); q += __shfl_xor(q, 4); q += __shfl_xor(q, 8); q += __shfl_xor(q, 16);
    const float rr = rsqrtf(q * (1.f / 128.f) + EPS);
    const size_t grow = (size_t)(rowbase + rg * 32 + crow(r, hi));
    const bf16_t* gp = proj + grow * DP + C_RG + h * 128 + r32; bf16_t* op = concat + grow * DM + h * 128 + r32;
#pragma unroll
    for (int d0 = 0; d0 < 4; ++d0) { const float gv = bf2f(gp[32 * d0]); op[32 * d0] = f2bf(o[d0][r] * rr * gn[32 * d0 + r32] * (gv * __builtin_amdgcn_rcpf(1.f + __builtin_amdgcn_exp2f(-1.4426950408889634f * gv)))); }
  }
  __syncthreads();
}

}


__device__ __forceinline__ float log2_sigmoid(float x) { return -log1pf(__expf(-x)) * 1.4426950408889634f; }
__device__ __forceinline__ bf16_t* cs_ptr(const Params& p, int b, int h, int dir, int j) { return (bf16_t*)(p.ws + WS_CS) + ((size_t)((b * NH + h) * 2 + dir) * 66 + j) * 16384; }
__device__ __forceinline__ void qkrope_phase(const Params& p, Ctx& F, int l) {
    const int lane = lane_id();
    float gq[8], gk[8], fr[8];
#pragma unroll
    for (int i = 0; i < 8; ++i) { gq[i] = p.in[I_QNG][l * 64 + 8 * (lane & 7) + i] * 0.18033688011112042f;
        gk[i] = p.in[I_KNG][l * 64 + 8 * (lane & 7) + i];
        fr[i] = exp2f(-(float)(8 * (lane & 1) + i) * (13.287712379549449f / 16.f)) * 0.15915494309189535f; }
    const bool lowhalf = (lane & 4) == 0;
    for (int m = F.gw; m < NR; m += F.NGW) {
        bf16_t* row = (bf16_t*)(p.ws + WS_PROJ) + (size_t)m * DP;
        v4u* qp = (v4u*)(row + C_DQ) + lane; const v4u* kp = (const v4u*)(row + C_DK) + lane;
#if FAST_ATT
        const v4u qv = *qp, kv = *kp;
#else
        const v4u qv = *qp, kv = *kp, vv = *((const v4u*)(row + C_DV) + lane);
#endif
        float q[8], k[8];
#pragma unroll
        for (int i = 0; i < 4; ++i) { q[2 * i] = __uint_as_float(qv[i] << 16); q[2 * i + 1] = __uint_as_float(qv[i] & 0xffff0000u); k[2 * i] = __uint_as_float(kv[i] << 16); k[2 * i + 1] = __uint_as_float(kv[i] & 0xffff0000u); }
        float sq = 0.f, sk = 0.f;
#pragma unroll
        for (int i = 0; i < 8; ++i) { sq += q[i] * q[i]; sk += k[i] * k[i]; }
        sq += __shfl_xor(sq, 1); sq += __shfl_xor(sq, 2); sq += __shfl_xor(sq, 4);
        sk += __shfl_xor(sk, 1); sk += __shfl_xor(sk, 2); sk += __shfl_xor(sk, 4);
        const float rq = rsqrtf(sq * (1.f / 64.f) + EPS), rk = rsqrtf(sk * (1.f / 64.f) + EPS);
#pragma unroll
        for (int i = 0; i < 8; ++i) { q[i] *= rq * gq[i]; k[i] *= rk * gk[i]; }
        if (m < NL) {
            const int t = m % T; const float pos = (float)((lane & 2) ? (t % 64) : (t / 64));
#pragma unroll
            for (int i = 0; i < 8; ++i) {
                const float rev = pos * fr[i]; const float cs = __builtin_amdgcn_cosf(rev), sn = __builtin_amdgcn_sinf(rev);
                const float oq = __shfl_xor(q[i], 4), ok = __shfl_xor(k[i], 4);
                q[i] = lowhalf ? q[i] * cs - oq * sn : q[i] * cs + oq * sn;
                k[i] = lowhalf ? k[i] * cs - ok * sn : k[i] * cs + ok * sn;
            }
        }
        v4u qo, ko;
#pragma unroll
        for (int i = 0; i < 4; ++i) { qo[i] = pk2(q[2 * i], q[2 * i + 1]); ko[i] = pk2(k[2 * i], k[2 * i + 1]); }
        *qp = qo;
        { const int bb = m < NL ? m / T : (m - NL) / TC, kidx = m < NL ? TC + (m % T) : (m - NL) % TC, tile = kidx >> 6, r = kidx & 63, hh = lane >> 4, ci = lane & 15;
          const size_t blk = ((size_t)(bb * NH + hh) * 132 + tile) * 16384;
          *(v4u*)(p.ws + WS_KT + blk + KSWZ(r, 16 * ci)) = ko;
#if FAST_ATT
          }
#else
          *(v4u*)(p.ws + WS_VT + blk + att::v_st(r, 8 * ci)) = vv; }
#endif
    }
}
__device__ __forceinline__ void scan_phase(const Params& p, Ctx& F, int l) {
    const int lane_ = lane_id(), tid_ = F.wave * 64 + lane_;
    unsigned* cs = (unsigned*)(p.ws + WS_CS);
    for (int i = blockIdx.x * (NWAVES * 64) + tid_; i < 16 * 8192; i += F.G * NWAVES * 64) {
        const int combo = i >> 13, e2 = i & 8191, dir = combo & 1, h = (combo >> 1) & 3;
        const float lg2 = log2_sigmoid(dir ? p.in[I_DECB][l * NH + h] : p.in[I_DECF][l * NH + h]);
        const float decay = exp2f(lg2 * 128.f);
        unsigned* base = cs + (size_t)combo * 66 * 8192 + e2;
        float s0 = 0.f, s1 = 0.f;
#pragma unroll 1
        for (int jj = 0; jj < 66; jj += 22) {
            unsigned tv[22];
#pragma unroll
            for (int k = 0; k < 22; ++k) { const int q = jj + k, idx = dir ? (q < 2 ? 1 - q : 67 - q) : q; tv[k] = base[(size_t)idx * 8192]; }
#pragma unroll
            for (int k = 0; k < 22; ++k) { const int q = jj + k, idx = dir ? (q < 2 ? 1 - q : 67 - q) : q;
                base[(size_t)idx * 8192] = pk2(s0, s1);
                s0 = decay * s0 + __uint_as_float(tv[k] << 16); s1 = decay * s1 + __uint_as_float(tv[k] & 0xffff0000u); }
        }
    }
}

#define IN(k) (lo <= (k) && (k) < hi)
#if SEAM_CVT
#define SEAM(k) do { if (IN(k) && IN((k) + 1)) { const bool t0_ = F.wave == 0 && lane_id() == 0; const XcdToken tk_ = xcd_barrier_arrive(bar, t0_); seam_fill(p, F, (k)); xcd_barrier_wait(bar, tk_, t0_); } } while (0)
#else
#define SEAM(k) do { if (IN(k) && IN((k) + 1)) xcd_barrier(bar, F.wave == 0 && lane_id() == 0); } while (0)
#endif
#ifndef REP_ATT
#define REP_ATT 1
#endif
#ifndef REP_RET
#define REP_RET 1
#endif
#ifndef REP_B
#define REP_B 1
#endif
#ifndef REP_H0
#define REP_H0 1
#endif
#ifndef REP_H1
#define REP_H1 1
#endif
#ifndef REP_I1
#define REP_I1 1
#endif
#ifndef REP_P0
#define REP_P0 1
#endif
#ifndef REP_CS
#define REP_CS 1
#endif
#ifndef REP_A
#define REP_A 1
#endif
#ifndef REP_I0
#define REP_I0 1
#endif
#ifndef REP_F0
#define REP_F0 1
#endif
#ifndef REP_G2
#define REP_G2 1
#endif
#ifndef REP_BAR
#define REP_BAR 0
#endif
template <int l>
__device__ __forceinline__ void layer_phases(const Params& p, Ctx& F, const XcdBarrier& bar, const int lo, const int hi) {
    constexpr int base = 1 + 9 * l;

        if (IN(base + 0)) { for (int rep_ = 0; rep_ < REP_A; ++rep_) norm_phase(p, F, l, 0, NR); for (int rep_ = 0; rep_ < REP_BAR; ++rep_) xcd_barrier(bar, F.wave == 0 && lane_id() == 0); SEAM(base + 0); }
        if (IN(base + 1)) {
            pg8::Gemm g{(const bf16_t*)(p.ws + WS_HBUF), (const bf16_t*)(p.ws + W_WIN) + (size_t)l * DP * DM, NR, DP, DM, DM};
            pg8::Order S; S.init(NR / 256, DP / 256, F.G, (int)blockIdx.x);
            pg8::EpiProj E{(bf16_t*)(p.ws + WS_PROJ), (char*)(p.ws + WS_VT)};
            { pg8::gemm_phase<pg8::EpiProj, pg8::Order, true, true>(F.lds + RING_OFF, g, S, E, F.wave); if (REP_B > 1) { pg8::gemm_phase<pg8::EpiProj, pg8::Order, true, true>(F.lds + RING_OFF, g, S, E, F.wave); } }
            SEAM(base + 1);
        }
        if (IN(base + 2)) {
            qkrope_phase(p, F, l);
            for (int rep_ = 0; rep_ < REP_CS; ++rep_)
            for (int u = blockIdx.x; u < 8 * 66; u += F.G) {
                const int bh = u & 7, j = u >> 3, b = bh >> 2, h = bh & 3;
                const int rowbase = j < 2 ? NL + b * TC + 128 * j : b * T + 128 * (j - 2);
                att::chunk_state_unit(F.wave, (const bf16_t*)(p.ws + WS_PROJ), cs_ptr(p, b, h, 0, j), cs_ptr(p, b, h, 1, j), rowbase, h,
                                      log2_sigmoid(p.in[I_DECF][l * NH + h]), log2_sigmoid(p.in[I_DECB][l * NH + h]), (LAS char*)(F.lds + RING_OFF));
            }
            SEAM(base + 2);
        }
        if (IN(base + 3)) { scan_phase(p, F, l); SEAM(base + 3); }
        if (IN(base + 4)) {
#if FAST_RET
            for (int rep_ = 0; rep_ < REP_RET; ++rep_)
            for (int u = blockIdx.x; u < (l == 0 ? 8 * 33 : 8 * 32); u += F.G) {
                const int bh = u & 7, jp = (u >> 3) + (l == 0 ? 0 : 1), b = bh >> 2, h = bh & 3;
                const int rowA = jp == 0 ? NL + b * TC : b * T + 128 * (2 * jp - 2);
                att::ret_out_unit(F.wave, (const bf16_t*)(p.ws + WS_PROJ), (bf16_t*)(p.ws + WS_CONCAT), cs_ptr(p, b, h, 0, 2 * jp), cs_ptr(p, b, h, 0, 2 * jp + 1), (size_t)66 * 16384,
                                  rowA, rowA + 128, h, log2_sigmoid(p.in[I_DECF][l * NH + h]), log2_sigmoid(p.in[I_DECB][l * NH + h]), p.in[I_GNG] + l * 512 + h * 128, (LAS char*)(F.lds + RING_OFF));
            }
#endif
#if FAST_ATT
            { const int lane_ = lane_id();
              const float s1 = wave_sum(p.in[I_LQ1][l * 64 + lane_] * p.in[I_LK1][l * 64 + lane_]), s2 = wave_sum(p.in[I_LQ2][l * 64 + lane_] * p.in[I_LK2][l * 64 + lane_]);
              const float li = lam_init_of(l), lam = __expf(s1) - __expf(s2) + li;
#if ATT_V3
              constexpr int nunits = 256 + (l == 0 ? 8 : 0);
              for (int rep_ = 0; rep_ < REP_ATT; ++rep_)
              for (int w = ((int)blockIdx.x + F.G - (8 % F.G)) % F.G; w < nunits; w += F.G) {
                  const int u = w < 256 ? ((w + 8) & 255) : w;
                  int b, h, qrow0, NT;
                  if (u < 256) { const int bh = u & 7, qb = u >> 3; b = bh >> 2; h = bh & 3; qrow0 = b * T + qb * 256; NT = (TC + T) / 64; }
                  else { const int bh = u - 256; b = bh >> 2; h = bh & 3; qrow0 = NL + b * TC; NT = TC / 64; }
                  att::ATT_UNIT(F.wave, (const bf16_t*)(p.ws + WS_PROJ), (const char*)(p.ws + WS_KT) + (size_t)(b * NH + h) * 132 * 16384, (const char*)(p.ws + WS_VT) + (size_t)(b * NH + h) * 132 * 16384, (bf16_t*)(p.ws + WS_CONCAT), qrow0, NT, h, (LAS char*)(F.lds + RING_OFF), lam, 1.f - li, p.in[I_SUBLN] + l * 128);
              }
#else
              constexpr int nunits = 512 + (l == 0 ? 16 : 0);
              for (int rep_ = 0; rep_ < REP_ATT; ++rep_)
              for (int u = blockIdx.x; u < nunits; u += F.G) {
                  int b, h, qrow0, NT;
                  if (u < 512) { const int bh = u & 7, qb = u >> 3; b = bh >> 2; h = bh & 3; qrow0 = b * T + qb * 128; NT = (TC + T) / 64; }
                  else { const int v = u - 512, bh = v & 7, blk = v >> 3; b = bh >> 2; h = bh & 3; qrow0 = NL + b * TC + blk * 128; NT = TC / 64; }
                  att::attn_unit(F.wave, (const bf16_t*)(p.ws + WS_PROJ), (const char*)(p.ws + WS_KT) + (size_t)(b * NH + h) * 132 * 16384, (const char*)(p.ws + WS_VT) + (size_t)(b * NH + h) * 132 * 16384, (bf16_t*)(p.ws + WS_CONCAT), qrow0, NT, h, (LAS char*)(F.lds + RING_OFF), lam, 1.f - li, p.in[I_SUBLN] + l * 128);
              }
#endif
            }
#endif
            SEAM(base + 4);
        }
        if (IN(base + 5)) {
            pg8::Gemm g{(const bf16_t*)(p.ws + WS_CONCAT), (const bf16_t*)(p.ws + W_WOUT) + (size_t)l * DM * DM, NR, DM, DM, DM};
            pg8::Order S; S.init(NL / 256, DM / 256, F.G, (int)blockIdx.x);
            pg8::EpiResid E{l == 0 ? p.in[I_X] : p.out, l == 0 ? p.in[I_CTX] : (const float*)(p.ws + WS_XRC), p.out, (float*)(p.ws + WS_XRC), modv(p, l, 0, 2), modv(p, l, 2, 2)};
            if (REP_F0 > 1 && l == 0) { pg8::gemm_phase<pg8::EpiResid, pg8::Order, true, true>(F.lds + RING_OFF, g, S, E, F.wave); }
            pg8::gemm_phase<pg8::EpiResid, pg8::Order, true, true>(F.lds + RING_OFF, g, S, E, F.wave);
            if constexpr (l == 0) {
                pg8::Gemm g2{(const bf16_t*)(p.ws + WS_CONCAT), (const bf16_t*)(p.ws + W_WOUT), NR, DM, 256, DM};
                pg8::SplitOrder S2; S2.init(NL / 256, 2, DM / 256, DM / 256, F.G, (int)blockIdx.x);
                pg8::EpiPartial E2{(float*)(p.ws + WS_PART), NL / 256, NC};
                pg8::gemm_phase<pg8::EpiPartial, pg8::SplitOrder, true, true>(F.lds + RING_OFF, g2, S2, E2, F.wave);
            }
            SEAM(base + 5);
        }
        if (IN(base + 6)) { if constexpr (l == 0) norm_phase(p, F, 0, 1, NR); else router_phase(p, F); SEAM(base + 6); }
        if constexpr (l == 0) {
            if (IN(8)) {
                pg8::Gemm g{(const bf16_t*)(p.ws + WS_HBUF), (const bf16_t*)(p.ws + W_FGU), NR, 2 * DFF, DM, DM};
                pg8::Order S; S.init(NR / 256, 2 * DFF / 256, F.G, (int)blockIdx.x);
                pg8::EpiSwiglu E{(bf16_t*)(p.ws + WS_ACT)};
                { pg8::gemm_phase<pg8::EpiSwiglu, pg8::Order, true, true>(F.lds + RING_OFF, g, S, E, F.wave); if (REP_H0 > 1) { pg8::gemm_phase<pg8::EpiSwiglu, pg8::Order, true, true>(F.lds + RING_OFF, g, S, E, F.wave); } }
                SEAM(8);
            }
            if (IN(9)) {
                pg8::Gemm g{(const bf16_t*)(p.ws + WS_ACT), (const bf16_t*)(p.ws + W_FD), NR, DM, DFF, DFF};
                pg8::Order S; S.init(NL / 256, DM / 256, F.G, (int)blockIdx.x);
                pg8::EpiResid E{p.out, (const float*)(p.ws + WS_XRC), p.out, (float*)(p.ws + WS_XRC), modv(p, 0, 0, 5), modv(p, 0, 2, 5)};
                if (REP_I0 > 1) { pg8::EpiResid Ed{p.out, (const float*)(p.ws + WS_XRC), (float*)(p.ws + WS_H2S), (float*)(p.ws + WS_H2S) + (size_t)NL * DM, modv(p, 0, 0, 5), modv(p, 0, 2, 5)}; pg8::gemm_phase<pg8::EpiResid, pg8::Order, true, true>(F.lds + RING_OFF, g, S, Ed, F.wave); }
                pg8::gemm_phase<pg8::EpiResid, pg8::Order, true, true>(F.lds + RING_OFF, g, S, E, F.wave);
                {
                    pg8::Gemm g2{(const bf16_t*)(p.ws + WS_ACT), (const bf16_t*)(p.ws + W_FD), NR, DM, 256, DFF};
                    pg8::SplitOrder S2; S2.init(NL / 256, 2, DM / 256, DFF / 256, F.G, (int)blockIdx.x);
                    pg8::EpiPartial E2{(float*)(p.ws + WS_PART), NL / 256, NC};
                    pg8::gemm_phase<pg8::EpiPartial, pg8::SplitOrder, true, true>(F.lds + RING_OFF, g2, S2, E2, F.wave);
                }
                SEAM(9);
            }
        } else {
            if (IN(17)) {
#if SEAM_CVT
                moe_cvt_rest(p, F);
#endif
                for (int rep_ = 0; rep_ < REP_G2; ++rep_) gather_phase(p, F); SEAM(17); }
            if (IN(18)) {
                moe_table(F);
                pg8::Gemm g{(const bf16_t*)(p.ws + WS_H2S), (const bf16_t*)(p.ws + W_MGU), MP_MAX, 2 * DFF, DM / 2, DM / 2};
                pg8::Order S; moe_order(F, S, 2 * DFF / 256, (long)2 * DFF * DM);
                pg8::EpiSwiglu8 E{(unsigned char*)(p.ws + WS_ACTS)};
                { pg8::gemm_phase<pg8::EpiSwiglu8, pg8::Order, true, true, true>(F.lds + RING_OFF, g, S, E, F.wave); if (REP_H1 > 1) { pg8::gemm_phase<pg8::EpiSwiglu8, pg8::Order, true, true, true>(F.lds + RING_OFF, g, S, E, F.wave); } }
                SEAM(18);
            }
            if (IN(19)) {
                moe_table(F);
                pg8::Gemm g{(const bf16_t*)(p.ws + WS_ACTS), (const bf16_t*)(p.ws + W_MD), MP_MAX, DM, DFF / 2, DFF / 2};
                pg8::Order S; moe_order(F, S, DM / 256, (long)DM * DFF);
                pg8::EpiMoeDown E{(bf16_t*)(p.ws + WS_YBUF), (const float*)(p.ws + WS_ROUTE) + 6 * NL + MP_MAX, 1.f / (W8_SCALE * A8_SCALE)};
                { pg8::gemm_phase<pg8::EpiMoeDown, pg8::Order, true, true, true>(F.lds + RING_OFF, g, S, E, F.wave); if (REP_I1 > 1) { pg8::gemm_phase<pg8::EpiMoeDown, pg8::Order, true, true, true>(F.lds + RING_OFF, g, S, E, F.wave); } }
                SEAM(19);
            }
            if (IN(20)) { combine_phase(p, F); }
        }
}
struct MArgs { Params p; int ph_lo, ph_hi, li, pad; };
constexpr int N_PHASES = 21;
__global__ void __launch_bounds__(NWAVES * 64, 2) mega(MArgs args) {
    extern __shared__ __attribute__((aligned(16))) unsigned char lds_raw[];
    const Params& p = args.p;
    Ctx F;
    F.lds = (LAS unsigned char*)lds_raw; F.MISC = (volatile LAS unsigned*)(F.lds + MISC_OFF);
    F.wave = __builtin_amdgcn_readfirstlane((int)threadIdx.x >> 6);
    const int lane_ = lane_id(), tid_ = F.wave * 64 + lane_;
    F.G = gridDim.x; F.gw = blockIdx.x * NWAVES + F.wave; F.NGW = F.G * NWAVES;
    F.ctl = (unsigned*)(p.ws + WS_CTL);
    for (int u = tid_; u < (LDS_BYTES - MISC_OFF) / 4; u += NWAVES * 64) ((LAS unsigned*)(F.lds + MISC_OFF))[u] = 0u;
    __syncthreads();
    XcdBarrier bar = xcd_barrier_post(F.ctl + CW_BAR + args.li * XCD_BAR_WORDS, F.MISC + 8, tid_ == 0);
    const int lo = args.ph_lo, hi = args.ph_hi;

    if (IN(0)) { for (int rep_ = 0; rep_ < REP_P0; ++rep_) { if (rep_) __syncthreads(); p0_prologue(p, F); } SEAM(0); }
    layer_phases<0>(p, F, bar, lo, hi);
    layer_phases<1>(p, F, bar, lo, hi);
#undef IN
#undef SEAM
}

#ifndef FAST_MASK
#define FAST_MASK 0x1u
#endif
static void launch_naive_e(const Params& p, int l, bool ret, bool att, hipStream_t stream) {
    const int nrows_mix = l == 0 ? NR : NL;
    if (ret) k_ret_naive<<<nrows_mix * NH / 4, 256, 0, stream>>>(p, l, nrows_mix);
    if (att) k_attn_naive<<<nrows_mix * NH / 4, 256, 0, stream>>>(p, l, nrows_mix);
}
static void launch_naive(const Params& p, int ph, hipStream_t stream) {
    const int l = ph >= 10 ? 1 : 0, rel = ph == 0 ? -1 : (ph - 1 - 9 * l);
    const int nrows_mix = l == 0 ? NR : NL;
    if (ph == 0) { k_mod<<<(2 * 3 * 6144 + 255) / 256, 256, 0, stream>>>(p); return; }
    switch (rel) {
    case 0: k_norm<<<NR / 4, 256, 0, stream>>>(p, l, 0, NR); break;
    case 1: k_gemm_proj<<<dim3(DP / 64, NR / 4), dim3(64, 4), 0, stream>>>(p, l); break;
    case 2: k_qkrope<<<NR / 4, 256, 0, stream>>>(p, l); break;
    case 3: break;
    case 4: launch_naive_e(p, l, true, true, stream); break;
    case 5: k_gemm_out<<<dim3(DM / 64, nrows_mix / 4), dim3(64, 4), 0, stream>>>(p, l); break;
    case 6: k_norm<<<nrows_mix / 4, 256, 0, stream>>>(p, l, 1, nrows_mix); break;
    case 7: if (l == 0) k_ffn_gu<<<dim3(DFF / 64, NR / 4), dim3(64, 4), 0, stream>>>(p); break;
    case 8: if (l == 0) k_ffn_down<<<dim3(DM / 64, NR / 4), dim3(64, 4), 0, stream>>>(p); else k_moe_gu<<<dim3(DFF / 64, 2 * NL / 4), dim3(64, 4), 0, stream>>>(p); break;
    case 9: k_moe_down<<<dim3(DM / 64, NL / 4), dim3(64, 4), 0, stream>>>(p); break;
    default: break;
    }
}
extern "C" void kernel_launch(void* const* d_in, const int* in_sizes, int n_in, void* d_out, int out_size, void* d_ws, size_t ws_size, hipStream_t stream) {
    static int grid = 0;
    if (grid == 0) {
        if (n_in != 28 || out_size != NL * DM || ws_size < WS_END) { fprintf(stderr, "kernel_launch: unexpected shapes (n_in %d out %d ws %zu need %zu)\n", n_in, out_size, ws_size, (size_t)WS_END); grid = -1; return; }
        int dev = 0, cus = 0, per_cu = 0;
        if (hipGetDevice(&dev) != hipSuccess || hipDeviceGetAttribute(&cus, hipDeviceAttributeMultiprocessorCount, dev) != hipSuccess) { grid = -1; return; }
        if (hipFuncSetAttribute((const void*)mega, hipFuncAttributeMaxDynamicSharedMemorySize, LDS_BYTES) != hipSuccess) { fprintf(stderr, "kernel_launch: hipFuncSetAttribute failed\n"); grid = -1; return; }
        if (hipOccupancyMaxActiveBlocksPerMultiprocessor(&per_cu, (const void*)mega, NWAVES * 64, LDS_BYTES) != hipSuccess || per_cu < 1) { fprintf(stderr, "kernel_launch: occupancy query says %d\n", per_cu); (void)hipGetLastError(); grid = -1; return; }
        grid = cus;
    }
    if (grid < 0) return;
    (void)hipMemsetAsync((char*)d_ws + WS_CTL, 0, CTL_ZERO_BYTES, stream);
    MArgs a{};
    for (int i = 0; i < 28; ++i) a.p.in[i] = (const float*)d_in[i];
    a.p.out = (float*)d_out; a.p.ws = (unsigned char*)d_ws;
    const unsigned mask = FAST_MASK;
    int li = 0, ph = 0;
    while (ph < N_PHASES) {
        if ((mask >> ph) & 1u) { int e = ph; bool cutE = false;
            while (e < N_PHASES && ((mask >> e) & 1u)) { const bool isE = (e == 5 || e == 14); ++e; if (isE && !(FAST_ATT && FAST_RET)) { cutE = true; break; } }
            a.ph_lo = ph; a.ph_hi = e; a.li = li++;
            hipLaunchKernelGGL(mega, dim3(grid), dim3(NWAVES * 64), LDS_BYTES, stream, a);
            if (cutE) launch_naive_e(a.p, e - 1 == 5 ? 0 : 1, !FAST_RET, !FAST_ATT, stream);
            ph = e; }
        else { launch_naive(a.p, ph, stream); ++ph; }
    }
}
```

```cpp
#include <hip/hip_runtime.h>
#include <cstdint>
#include <cstdio>
#define FAST_MASK 0x1fffffu
#define FAST_ATT 1
#define FAST_RET 1

constexpr int NB = 2, T = 8192, DM = 1024, TC = 256;
constexpr int NL = NB * T;
constexpr int NC = NB * TC;
constexpr int NR = NL + NC;
constexpr int DP = 3584, DFF = 2816, NE = 8, NH = 4;
constexpr float EPS = 1e-6f;
constexpr int C_RQ = 0, C_RK = 512, C_RV = 1024, C_RG = 1536, C_DQ = 2048, C_DK = 2560, C_DV = 3072;
constexpr int MP_MAX = 2 * NL + NE * 256;

typedef unsigned short bf16_t;
__device__ __forceinline__ float bf2f(bf16_t v) { return __uint_as_float(((unsigned)v) << 16); }
__device__ __forceinline__ bf16_t f2bf(float f) { unsigned u = __float_as_uint(f); u += 0x7fffu + ((u >> 16) & 1u); return (bf16_t)(u >> 16); }
typedef float f32x2_t __attribute__((ext_vector_type(2)));
typedef __bf16 bf16x2_t __attribute__((ext_vector_type(2)));
__device__ __forceinline__ unsigned pk2(float lo, float hi) { const f32x2_t v = {lo, hi}; const bf16x2_t b = __builtin_convertvector(v, bf16x2_t); return __builtin_bit_cast(unsigned, b); }
__device__ __forceinline__ unsigned pk4_fp8(float a, float b, float c, float d) {
    a = __builtin_amdgcn_fmed3f(a, -448.f, 448.f); b = __builtin_amdgcn_fmed3f(b, -448.f, 448.f); c = __builtin_amdgcn_fmed3f(c, -448.f, 448.f); d = __builtin_amdgcn_fmed3f(d, -448.f, 448.f);
    int r = 0; r = __builtin_amdgcn_cvt_pk_fp8_f32(a, b, r, false); r = __builtin_amdgcn_cvt_pk_fp8_f32(c, d, r, true); return (unsigned)r;
}
constexpr float W8_SCALE = 64.f, A8_SCALE = 8.f;
__device__ __forceinline__ float wave_sum(float v) {
#pragma unroll
    for (int o = 1; o < 64; o <<= 1) v += __shfl_xor(v, o);
    return v;
}
__device__ __forceinline__ int lane_id() { int l = (int)__builtin_amdgcn_mbcnt_hi(~0u, __builtin_amdgcn_mbcnt_lo(~0u, 0u)); asm volatile("" : "+v"(l)); return l; }
__device__ __forceinline__ float siluf(float v) { return v / (1.f + __expf(-v)); }

constexpr size_t MiB = 1u << 20;
constexpr size_t WS_CTL = 0, CTL_ZERO_BYTES = 1 * MiB;
constexpr size_t WS_MODV = 1 * MiB;
constexpr size_t WS_ROUTE = 2 * MiB;
constexpr size_t WS_XRC = 3 * MiB;
constexpr size_t WS_W = 6 * MiB;
constexpr size_t W_WIN = WS_W;
constexpr size_t W_WOUT = W_WIN + (size_t)2 * DP * DM * 2;
constexpr size_t W_FGU = W_WOUT + (size_t)2 * DM * DM * 2;
constexpr size_t W_FD = W_FGU + (size_t)2 * DFF * DM * 2;
constexpr size_t W_MGU = W_FD + (size_t)DM * DFF * 2;
constexpr size_t W_MD = W_MGU + (size_t)NE * 2 * DFF * DM * 2;
constexpr size_t W_END = W_MD + (size_t)NE * DM * DFF * 2;
constexpr size_t WS_HBUF = 173 * MiB;
constexpr size_t WS_PROJ = 206 * MiB;
constexpr size_t WS_CONCAT = 322 * MiB;
constexpr size_t WS_ACT = 206 * MiB;
constexpr size_t WS_ACTS = 173 * MiB;
constexpr size_t WS_H2S = 361 * MiB;
constexpr size_t WS_KT = 394 * MiB, WS_VT = WS_KT + (size_t)NB * NH * 132 * 16384;
static_assert(WS_VT + (size_t)NB * NH * 132 * 16384 <= 429 * MiB && WS_H2S + (size_t)NB * NH * 2 * 66 * 32768 <= WS_KT, "K/V tile images");
constexpr size_t WS_YBUF = WS_H2S, WS_CS = WS_H2S, WS_PART = WS_H2S;
constexpr size_t WS_END = 430 * MiB;
static_assert(W_END <= WS_HBUF && WS_ACTS + (size_t)MP_MAX * DFF * 2 <= WS_H2S && WS_H2S + (size_t)MP_MAX * DM * 2 <= WS_END && WS_ACT + (size_t)2 * NL * DFF * 2 <= WS_END, "ws map");
constexpr int CW_BAR = 4096;
constexpr int CW_CNT = 200000;

struct Params {
    const float* in[28];
    float* out;
    unsigned char* ws;
};
enum { I_X = 0, I_C, I_CTX, I_CCTX, I_ADAW, I_ADAB, I_N1G, I_N2G, I_WIN, I_DECF, I_DECB, I_GNG, I_QNG, I_KNG, I_LQ1, I_LK1, I_LQ2, I_LK2, I_SUBLN, I_WOUT,
       I_FWG, I_FWU, I_FWD, I_RW, I_RB, I_MWG, I_MWU, I_MWD };

__device__ __forceinline__ int rowtype(int m) { return m < NL ? m / T : 2; }
__device__ __forceinline__ const float* modv(const Params& p, int l, int rt, int i) { return (const float*)(p.ws + WS_MODV) + ((size_t)(l * 3 + rt) * 6 + i) * DM; }
__device__ __forceinline__ float* xr_row(const Params& p, int m) { return m < NL ? p.out + (size_t)m * DM : (float*)(p.ws + WS_XRC) + (size_t)(m - NL) * DM; }
__device__ __forceinline__ float lam_init_of(int l) { return l == 0 ? 0.2f : (0.8f - 0.6f * 0.74081822068171788f); }

#ifndef SEAM_CVT
#define SEAM_CVT 1
#endif
#ifndef ATT_UNIT
#define ATT_UNIT attn_unit3q
#endif
#ifndef FAST_ATT
#define FAST_ATT 0
#endif
#ifndef FAST_RET
#define FAST_RET 0
#endif
#ifndef ATT_V3
#define ATT_V3 1
#endif
__global__ void k_mod(Params p) {
    const int idx = blockIdx.x * blockDim.x + threadIdx.x;
    if (idx >= 2 * 3 * 6144) return;
    const int n = idx % 6144, rt = (idx / 6144) % 3, l = idx / (6144 * 3);
    const float* cv = rt < 2 ? p.in[I_C] + rt * DM : p.in[I_CCTX];
    const float* W = p.in[I_ADAW] + (size_t)l * DM * 6144;
    float acc = 0.f;
    for (int k = 0; k < DM; ++k) acc += siluf(cv[k]) * W[(size_t)k * 6144 + n];
    ((float*)(p.ws + WS_MODV))[(size_t)(l * 3 + rt) * 6144 + n] = acc + p.in[I_ADAB][l * 6144 + n];
}

__global__ void k_norm(Params p, int l, int which, int nrows) {
    const int m = blockIdx.x * (blockDim.x / 64) + (threadIdx.x >> 6), lane = threadIdx.x & 63;
    if (m >= nrows) return;
    const float* xrow;
    if (l == 0 && which == 0) xrow = m < NL ? p.in[I_X] + (size_t)m * DM : p.in[I_CTX] + (size_t)(m - NL) * DM;
    else xrow = xr_row(p, m);
    const int rt = rowtype(m);
    const float* g = p.in[which ? I_N2G : I_N1G] + l * DM;
    const float* sh = modv(p, l, rt, which ? 3 : 0);
    const float* sc = modv(p, l, rt, which ? 4 : 1);
    float v[16]; float ss = 0.f;
#pragma unroll
    for (int j = 0; j < 4; ++j) { const float4 t = *(const float4*)(xrow + 256 * j + 4 * lane); v[4 * j] = t.x; v[4 * j + 1] = t.y; v[4 * j + 2] = t.z; v[4 * j + 3] = t.w; ss += t.x * t.x + t.y * t.y + t.z * t.z + t.w * t.w; }
    const float r = rsqrtf(wave_sum(ss) * (1.f / DM) + EPS);
    bf16_t* hb = (bf16_t*)(p.ws + WS_HBUF) + (size_t)m * DM;
#pragma unroll
    for (int j = 0; j < 4; ++j)
#pragma unroll
        for (int q = 0; q < 4; ++q) { const int col = 256 * j + 4 * lane + q; const float y = v[4 * j + q] * r * g[col]; v[4 * j + q] = y * (1.f + sc[col]) + sh[col]; hb[col] = f2bf(v[4 * j + q]); }
    if (l == 1 && which == 1) {
        const float* rw = p.in[I_RW]; float lg[8];
#pragma unroll
        for (int e = 0; e < 8; ++e) { float a = 0.f;
#pragma unroll
            for (int j = 0; j < 4; ++j)
#pragma unroll
                for (int q = 0; q < 4; ++q) a += v[4 * j + q] * rw[(size_t)(256 * j + 4 * lane + q) * 8 + e];
            lg[e] = wave_sum(a) + p.in[I_RB][e]; }
        int i1 = 0; float v1 = lg[0];
#pragma unroll
        for (int e = 1; e < 8; ++e) if (lg[e] > v1) { v1 = lg[e]; i1 = e; }
        int i2 = -1; float v2 = -3.4e38f;
#pragma unroll
        for (int e = 0; e < 8; ++e) if (e != i1 && lg[e] > v2) { v2 = lg[e]; i2 = e; }
        const float w1 = 1.f / (1.f + __expf(v2 - v1));
        if (lane == 0) { int* te = (int*)(p.ws + WS_ROUTE); float* tw = (float*)(p.ws + WS_ROUTE) + 2 * NL; te[2 * m] = i1; te[2 * m + 1] = i2; tw[2 * m] = w1; tw[2 * m + 1] = 1.f - w1; }
    }
}

__global__ void k_gemm_proj(Params p, int l) {
    const int n = blockIdx.x * 64 + threadIdx.x, m = blockIdx.y * 4 + threadIdx.y;
    const bf16_t* a = (const bf16_t*)(p.ws + WS_HBUF) + (size_t)m * DM;
    const float* W = p.in[I_WIN] + (size_t)l * DM * DP + n;
    float acc = 0.f;
#pragma unroll 8
    for (int k = 0; k < DM; ++k) acc += bf2f(a[k]) * W[(size_t)k * DP];
    if (n >= C_RK && n < C_RV) acc *= 0.08838834764831845f;
    ((bf16_t*)(p.ws + WS_PROJ))[(size_t)m * DP + n] = f2bf(acc);
}

__global__ void k_qkrope(Params p, int l) {
    const int m = blockIdx.x * (blockDim.x / 64) + (threadIdx.x >> 6), lane = threadIdx.x & 63;
    if (m >= NR) return;
    bf16_t* row = (bf16_t*)(p.ws + WS_PROJ) + (size_t)m * DP;
    const bool lat = m < NL; const int t = m % T;
    const int j = lane & 31; const float pos = (float)((j < 16) ? (t / 64) : (t % 64));
    const float inv_freq = exp2f(-(float)(j & 15) * (13.287712379549449f / 16.f));
    const float ang = pos * inv_freq; const float cs = __cosf(ang), sn = __sinf(ang);
    for (int part = 0; part < 2; ++part) {
        const float* g = p.in[part ? I_KNG : I_QNG] + l * 64;
        for (int hc = 0; hc < 8; ++hc) {
            bf16_t* q = row + (part ? C_DK : C_DQ) + hc * 64;
            const float v = bf2f(q[lane]);
            const float r = rsqrtf(wave_sum(v * v) * (1.f / 64.f) + EPS);
            float y = v * r * g[lane];
            if (lat) { const float o = __shfl_xor(y, 32); y = lane < 32 ? y * cs - o * sn : y * cs + o * sn; }
            if (part == 0) y *= 0.18033688011112042f;
            q[lane] = f2bf(y);
        }
    }
}

__global__ void k_ret_naive(Params p, int l, int nrows) {
    const int w = blockIdx.x * (blockDim.x / 64) + (threadIdx.x >> 6), lane = threadIdx.x & 63;
    if (w >= nrows * NH) return;
    const int m = w / NH, h = w % NH;
    const bf16_t* proj = (const bf16_t*)(p.ws + WS_PROJ);
    const float df = p.in[I_DECF][l * NH + h], db = p.in[I_DECB][l * NH + h];
    const float lgf = -log1pf(__expf(-df)), lgb = -log1pf(__expf(-db));
    const bf16_t* qrow = proj + (size_t)m * DP + C_RQ + h * 128 + 2 * lane;
    const float q0 = bf2f(qrow[0]), q1 = bf2f(qrow[1]);
    float o0 = 0.f, o1 = 0.f;
    if (m < NL) {
        const int b = m / T, t = m % T;
        for (int s = 0; s < T; ++s) {
            const bf16_t* kr = proj + (size_t)(b * T + s) * DP + h * 128 + 2 * lane;
            const float dot = wave_sum(q0 * bf2f(kr[C_RK]) + q1 * bf2f(kr[C_RK + 1]));
            const float wgt = s < t ? __expf(lgf * (float)(t - s)) : (s == t ? 2.f : __expf(lgb * (float)(s - t)));
            o0 += wgt * dot * bf2f(kr[C_RV]); o1 += wgt * dot * bf2f(kr[C_RV + 1]);
        }
        for (int i = 0; i < TC; ++i) {
            const bf16_t* kr = proj + (size_t)(NL + b * TC + i) * DP + h * 128 + 2 * lane;
            const float dot = wave_sum(q0 * bf2f(kr[C_RK]) + q1 * bf2f(kr[C_RK + 1]));
            const float wgt = __expf(lgf * (float)(t + TC - i)) + __expf(lgb * (float)(T - t + i));
            o0 += wgt * dot * bf2f(kr[C_RV]); o1 += wgt * dot * bf2f(kr[C_RV + 1]);
        }
    } else {
        const int b = (m - NL) / TC, t = (m - NL) % TC;
        for (int s = 0; s < TC; ++s) {
            const bf16_t* kr = proj + (size_t)(NL + b * TC + s) * DP + h * 128 + 2 * lane;
            const float dot = wave_sum(q0 * bf2f(kr[C_RK]) + q1 * bf2f(kr[C_RK + 1]));
            const float wgt = s < t ? __expf(lgf * (float)(t - s)) : (s == t ? 2.f : __expf(lgb * (float)(s - t)));
            o0 += wgt * dot * bf2f(kr[C_RV]); o1 += wgt * dot * bf2f(kr[C_RV + 1]);
        }
    }
    const float mu = wave_sum(o0 + o1) * (1.f / 128.f);
    const float d0 = o0 - mu, d1 = o1 - mu;
    const float r = rsqrtf(wave_sum(d0 * d0 + d1 * d1) * (1.f / 128.f) + EPS);
    const float* gn = p.in[I_GNG] + l * 512 + h * 128 + 2 * lane;
    const bf16_t* gr = proj + (size_t)m * DP + C_RG + h * 128 + 2 * lane;
    bf16_t* cc = (bf16_t*)(p.ws + WS_CONCAT) + (size_t)m * DM + h * 128 + 2 * lane;
    cc[0] = f2bf(siluf(bf2f(gr[0])) * d0 * r * gn[0]);
    cc[1] = f2bf(siluf(bf2f(gr[1])) * d1 * r * gn[1]);
}

__global__ void k_attn_naive(Params p, int l, int nrows) {
    const int w = blockIdx.x * (blockDim.x / 64) + (threadIdx.x >> 6), lane = threadIdx.x & 63;
    if (w >= nrows * NH) return;
    const int m = w / NH, h = w % NH;
    const bf16_t* proj = (const bf16_t*)(p.ws + WS_PROJ);
    const bool lat = m < NL; const int b = lat ? m / T : (m - NL) / TC;
    float O[2][2];
    for (int c = 0; c < 2; ++c) {
        const float q = bf2f(proj[(size_t)m * DP + C_DQ + h * 128 + c * 64 + lane]);
        float mx = -1e30f, ls = 0.f, o0 = 0.f, o1 = 0.f;
        const int nk = lat ? TC + T : TC;
        for (int s = 0; s < nk; ++s) {
            const int mk = s < TC ? NL + b * TC + s : b * T + (s - TC);
            const bf16_t* kr = proj + (size_t)mk * DP + h * 128;
            const float sc = wave_sum(q * bf2f(kr[C_DK + c * 64 + lane]));
            const float mn = fmaxf(mx, sc), al = exp2f(mx - mn), pp = exp2f(sc - mn);
            ls = ls * al + pp; o0 = o0 * al + pp * bf2f(kr[C_DV + 2 * lane]); o1 = o1 * al + pp * bf2f(kr[C_DV + 2 * lane + 1]); mx = mn;
        }
        O[c][0] = o0 / ls; O[c][1] = o1 / ls;
    }
    float s1 = 0.f, s2 = 0.f;
    { const float a = p.in[I_LQ1][l * 64 + lane] * p.in[I_LK1][l * 64 + lane], bq = p.in[I_LQ2][l * 64 + lane] * p.in[I_LK2][l * 64 + lane]; s1 = wave_sum(a); s2 = wave_sum(bq); }
    const float li = lam_init_of(l), lam = __expf(s1) - __expf(s2) + li;
    const float d0 = O[0][0] - lam * O[1][0], d1 = O[0][1] - lam * O[1][1];
    const float r = rsqrtf(wave_sum(d0 * d0 + d1 * d1) * (1.f / 128.f) + EPS);
    const float* sg = p.in[I_SUBLN] + l * 128 + 2 * lane;
    bf16_t* cc = (bf16_t*)(p.ws + WS_CONCAT) + (size_t)m * DM + 512 + h * 128 + 2 * lane;
    cc[0] = f2bf(d0 * r * sg[0] * (1.f - li)); cc[1] = f2bf(d1 * r * sg[1] * (1.f - li));
}

__global__ void k_gemm_out(Params p, int l) {
    const int n = blockIdx.x * 64 + threadIdx.x, m = blockIdx.y * 4 + threadIdx.y;
    const bf16_t* a = (const bf16_t*)(p.ws + WS_CONCAT) + (size_t)m * DM;
    const float* W = p.in[I_WOUT] + (size_t)l * DM * DM + n;
    float acc = 0.f;
#pragma unroll 8
    for (int k = 0; k < DM; ++k) acc += bf2f(a[k]) * W[(size_t)k * DM];
    const float xin = l == 0 ? (m < NL ? p.in[I_X][(size_t)m * DM + n] : p.in[I_CTX][(size_t)(m - NL) * DM + n]) : xr_row(p, m)[n];
    xr_row(p, m)[n] = xin + modv(p, l, rowtype(m), 2)[n] * acc;
}

__global__ void k_ffn_gu(Params p) {
    const int j = blockIdx.x * 64 + threadIdx.x, m = blockIdx.y * 4 + threadIdx.y;
    const bf16_t* a = (const bf16_t*)(p.ws + WS_HBUF) + (size_t)m * DM;
    const float* Wg = p.in[I_FWG] + j; const float* Wu = p.in[I_FWU] + j;
    float ag = 0.f, au = 0.f;
#pragma unroll 8
    for (int k = 0; k < DM; ++k) { const float x = bf2f(a[k]); ag += x * Wg[(size_t)k * DFF]; au += x * Wu[(size_t)k * DFF]; }
    ((bf16_t*)(p.ws + WS_ACT))[(size_t)m * DFF + j] = f2bf(siluf(ag) * au);
}
__global__ void k_ffn_down(Params p) {
    const int n = blockIdx.x * 64 + threadIdx.x, m = blockIdx.y * 4 + threadIdx.y;
    const bf16_t* a = (const bf16_t*)(p.ws + WS_ACT) + (size_t)m * DFF;
    const float* W = p.in[I_FWD] + n;
    float acc = 0.f;
#pragma unroll 8
    for (int k = 0; k < DFF; ++k) acc += bf2f(a[k]) * W[(size_t)k * DM];
    xr_row(p, m)[n] += modv(p, 0, rowtype(m), 5)[n] * acc;
}
__global__ void k_moe_gu(Params p) {
    const int j = blockIdx.x * 64 + threadIdx.x, ts = blockIdx.y * 4 + threadIdx.y;
    const int t = ts >> 1; const int e = ((const int*)(p.ws + WS_ROUTE))[ts];
    const bf16_t* a = (const bf16_t*)(p.ws + WS_HBUF) + (size_t)t * DM;
    const float* Wg = p.in[I_MWG] + (size_t)e * DM * DFF + j; const float* Wu = p.in[I_MWU] + (size_t)e * DM * DFF + j;
    float ag = 0.f, au = 0.f;
#pragma unroll 8
    for (int k = 0; k < DM; ++k) { const float x = bf2f(a[k]); ag += x * Wg[(size_t)k * DFF]; au += x * Wu[(size_t)k * DFF]; }
    ((bf16_t*)(p.ws + WS_ACT))[(size_t)ts * DFF + j] = f2bf(siluf(ag) * au);
}
__global__ void k_moe_down(Params p) {
    const int n = blockIdx.x * 64 + threadIdx.x, t = blockIdx.y * 4 + threadIdx.y;
    const int* te = (const int*)(p.ws + WS_ROUTE); const float* tw = (const float*)(p.ws + WS_ROUTE) + 2 * NL;
    float y = 0.f;
    for (int s = 0; s < 2; ++s) {
        const bf16_t* a = (const bf16_t*)(p.ws + WS_ACT) + (size_t)(2 * t + s) * DFF;
        const float* W = p.in[I_MWD] + (size_t)te[2 * t + s] * DFF * DM + n;
        float acc = 0.f;
#pragma unroll 8
        for (int k = 0; k < DFF; ++k) acc += bf2f(a[k]) * W[(size_t)k * DM];
        y += tw[2 * t + s] * acc;
    }
    p.out[(size_t)t * DM + n] += modv(p, 1, t / T, 5)[n] * y;
}


typedef unsigned v2u __attribute__((ext_vector_type(2)));
namespace pg8 {
#define PG8_LAS __attribute__((address_space(3)))
typedef unsigned short bf16_t;
typedef short bf16x8 __attribute__((ext_vector_type(8)));
typedef float f32x4 __attribute__((ext_vector_type(4)));
typedef unsigned u32x4 __attribute__((ext_vector_type(4)));
typedef int i32x4 __attribute__((ext_vector_type(4)));
typedef int i32x8 __attribute__((ext_vector_type(8)));
constexpr int BM = 256, BK = 64, HALF = 128, HTB = HALF * BK * 2  , STAGE_BYTES = 8 * HTB, NXCD = 8, WGM = 8;

__host__ __device__ __forceinline__ int lds_byte(int r, int c) { const int st = (r >> 4) * 2 + (c >> 5), rr = r & 15, cc = c & 31, ob = rr * 64 + cc * 2; return st * 1024 + (ob ^ (((ob >> 9) & 1) << 5)); }
__host__ __device__ __forceinline__ void stage_rc(int b, int& R, int& C) { const int st = b / 1024, sb = b % 1024, swz = sb ^ (((sb >> 9) & 1) << 5); R = (st >> 1) * 16 + swz / 64; C = (st & 1) * 32 + (swz % 64) / 2; }
__host__ __device__ __forceinline__ int perm32(int rho) { const int n = rho >> 4, i = rho & 15; return 8 * (i >> 2) + 4 * n + (i & 3); }

struct Unit { int pm, pn; long bofs, kofs; };
struct Gemm { const bf16_t* A; const bf16_t* Bt; int M, N, K, ld; };

struct Order {
    int nM, nN, nwg, G, c;
    int e1, e2, e3, e4, e5, e6, e7; long estride;
    __device__ __forceinline__ void init(int nM_, int nN_, int G_, int c_) { nM = nM_; nN = nN_; nwg = nM * nN; G = G_; c = c_; estride = 0; e1 = e2 = e3 = e4 = e5 = e6 = e7 = 0; }
    __device__ __forceinline__ bool next(int i, Unit& u) const {
        const long L = (long)i * G + c; if (L >= nwg) return false;
        int wgid = (int)L; { const int q = nwg / NXCD, r = nwg % NXCD, xcd = wgid % NXCD, off = wgid / NXCD; wgid = (xcd < r ? xcd * (q + 1) : r * (q + 1) + (xcd - r) * q) + off; }
        const int nig = WGM * nN, gid = wgid / nig, fm = gid * WGM, gsz = (nM - fm) < WGM ? (nM - fm) : WGM;
        u.pm = fm + ((wgid % nig) % gsz); u.pn = (wgid % nig) / gsz;
        const int e = (u.pm >= e1) + (u.pm >= e2) + (u.pm >= e3) + (u.pm >= e4) + (u.pm >= e5) + (u.pm >= e6) + (u.pm >= e7);
        u.bofs = estride ? (long)e * estride : 0; u.kofs = 0;
        return true;
    }
    __device__ __forceinline__ void a_ready(const Unit&) const {}
    __device__ __forceinline__ void done(const Unit&) const {}
};

struct SplitOrder {
    int nN, ns, nwg, G, c, pm0;
    __device__ __forceinline__ void init(int pm0_, int npan, int nN_, int ns_, int G_, int c_) { pm0 = pm0_; nN = nN_; ns = ns_; nwg = npan * nN * ns; G = G_; c = c_; }
    __device__ __forceinline__ bool next(int i, Unit& u) const {
        const int L = i * G + c; if (L >= nwg) return false;
        const int ks = L % ns, rest = L / ns; u.pn = rest % nN; u.pm = pm0 + rest / nN; u.bofs = 0; u.kofs = (long)ks * 256 * 2; return true;
    }
    __device__ __forceinline__ void a_ready(const Unit&) const {}
    __device__ __forceinline__ void done(const Unit&) const {}
};
__device__ __forceinline__ unsigned cvt_pk_bf16(float lo, float hi) { unsigned r; asm volatile("v_cvt_pk_bf16_f32 %0, %1, %2" : "=v"(r) : "v"(lo), "v"(hi)); return r; }
__device__ __forceinline__ float silu_fast(float x) { return x * __builtin_amdgcn_rcpf(1.f + __builtin_amdgcn_exp2f(-1.4426950408889634f * x)); }

struct EpiProj {
    static constexpr bool PERM = true, AFTER_DRAIN = false;
    bf16_t* O; char* VT;
    __device__ __forceinline__ void operator()(const f32x4 (&acc)[2][2][4][2], const Unit& u, int wr, int wc, int fr, int fq) const {
        const int row0 = u.pm * BM + wr * 64 + fr, col0 = u.pn * BM + wc * 32 + 8 * fq;
#if FAST_ATT
        if (u.pn >= C_DV / BM) {
#pragma unroll
            for (int ai = 0; ai < 2; ++ai)
#pragma unroll
                for (int m = 0; m < 4; ++m) { const int row = row0 + ai * HALF + m * 16;
                    const int bb = row < NL ? row / T : (row - NL) / TC, kidx = row < NL ? TC + (row % T) : (row - NL) % TC, key = kidx & 63;
                    const int pos = (key & ~0xC) | ((key & 4) << 1) | ((key & 8) >> 1), ch = pos >> 3;
#pragma unroll
                    for (int bj = 0; bj < 2; ++bj) { const int hh = 2 * (u.pn - C_DV / BM) + bj;
                        char* tp = VT + ((size_t)(bb * NH + hh) * 132 + (kidx >> 6)) * 16384 + (wc * 32 + 8 * fq) * 128 + (pos & 7) * 2;
#pragma unroll
                        for (int n = 0; n < 2; ++n) { const f32x4 v = acc[ai][bj][m][n];
                            const unsigned w0 = cvt_pk_bf16(v[0], v[1]), w1 = cvt_pk_bf16(v[2], v[3]);
                            char* q0 = tp + (4 * n) * 128 + (((ch & 4) | ((ch & 3) ^ (2 * n))) << 4); char* q1 = tp + (4 * n) * 128 + (((ch & 4) | ((ch & 3) ^ (2 * n + 1))) << 4);
                            *(unsigned short*)(q0) = (unsigned short)w0; *(unsigned short*)(q0 + 128) = (unsigned short)(w0 >> 16);
                            *(unsigned short*)(q1 + 256) = (unsigned short)w1; *(unsigned short*)(q1 + 384) = (unsigned short)(w1 >> 16); } } }
            return;
        }
#endif
        const float sc = (u.pn == 2 || u.pn == 3) ? 0.08838834764831845f : 1.f;
#pragma unroll
        for (int ai = 0; ai < 2; ++ai)
#pragma unroll
            for (int m = 0; m < 4; ++m) { bf16_t* rowp = O + (size_t)(row0 + ai * HALF + m * 16) * DP + col0;
#pragma unroll
                for (int bj = 0; bj < 2; ++bj) { const f32x4 v0 = acc[ai][bj][m][0] * sc, v1 = acc[ai][bj][m][1] * sc;
                    u32x4 w; w.x = cvt_pk_bf16(v0[0], v0[1]); w.y = cvt_pk_bf16(v0[2], v0[3]); w.z = cvt_pk_bf16(v1[0], v1[1]); w.w = cvt_pk_bf16(v1[2], v1[3]);
                    *(u32x4*)(rowp + bj * HALF) = w; } }
    }
};
struct EpiResid {
    static constexpr bool PERM = false, AFTER_DRAIN = false;
    const float* base_lat; const float* base_ctx; float* out_lat; float* out_ctx; const float* gl; const float* gc;
    __device__ __forceinline__ void operator()(const f32x4 (&acc)[2][2][4][2], const Unit& u, int wr, int wc, int fr, int fq) const {
        const bool lat = u.pm < NL / BM;
        const int row0 = (lat ? u.pm * BM : u.pm * BM - NL) + wr * 64 + fr, col0 = u.pn * BM + wc * 32 + 4 * fq;
        const float* base = lat ? base_lat : base_ctx; float* out = lat ? out_lat : out_ctx;
        const float* gate = lat ? gl + (size_t)(u.pm / (T / BM)) * 6 * DM : gc;
        f32x4 gv[2][2];
#pragma unroll
        for (int bj = 0; bj < 2; ++bj)
#pragma unroll
            for (int n = 0; n < 2; ++n) gv[bj][n] = *(const f32x4*)(gate + col0 + bj * HALF + n * 16);
#pragma unroll
        for (int ai = 0; ai < 2; ++ai)
#pragma unroll
            for (int m = 0; m < 4; ++m) { const size_t off = (size_t)(row0 + ai * HALF + m * 16) * DM + col0;
#pragma unroll
                for (int bj = 0; bj < 2; ++bj)
#pragma unroll
                    for (int n = 0; n < 2; ++n) { const f32x4 bs = *(const f32x4*)(base + off + bj * HALF + n * 16); *(f32x4*)(out + off + bj * HALF + n * 16) = bs + gv[bj][n] * acc[ai][bj][m][n]; }
                asm volatile("" ::: "memory"); }
    }
};
struct EpiPartial {
    static constexpr bool PERM = false, AFTER_DRAIN = false;
    float* part; int pm0, nrows;
    __device__ __forceinline__ void operator()(const f32x4 (&acc)[2][2][4][2], const Unit& u, int wr, int wc, int fr, int fq) const {
        const int row0 = (u.pm - pm0) * BM + wr * 64 + fr, col0 = u.pn * BM + wc * 32 + 4 * fq;
        float* base = part + (size_t)(u.kofs / 512) * nrows * DM;
#pragma unroll
        for (int ai = 0; ai < 2; ++ai)
#pragma unroll
            for (int m = 0; m < 4; ++m) { float* rowp = base + (size_t)(row0 + ai * HALF + m * 16) * DM + col0;
#pragma unroll
                for (int bj = 0; bj < 2; ++bj)
#pragma unroll
                    for (int n = 0; n < 2; ++n) *(f32x4*)(rowp + bj * HALF + n * 16) = acc[ai][bj][m][n]; }
    }
};
struct EpiSwiglu {
    static constexpr bool PERM = true, AFTER_DRAIN = false;
    bf16_t* O;
    __device__ __forceinline__ void operator()(const f32x4 (&acc)[2][2][4][2], const Unit& u, int wr, int wc, int fr, int fq) const {
        const int row0 = u.pm * BM + wr * 64 + fr, col0 = u.pn * HALF + wc * 32 + 8 * fq;
#pragma unroll
        for (int ai = 0; ai < 2; ++ai)
#pragma unroll
            for (int m = 0; m < 4; ++m) { bf16_t* rowp = O + (size_t)(row0 + ai * HALF + m * 16) * DFF + col0;
                const f32x4 g0 = acc[ai][0][m][0], g1 = acc[ai][0][m][1], u0 = acc[ai][1][m][0], u1 = acc[ai][1][m][1];
                u32x4 w; w.x = cvt_pk_bf16(silu_fast(g0[0]) * u0[0], silu_fast(g0[1]) * u0[1]); w.y = cvt_pk_bf16(silu_fast(g0[2]) * u0[2], silu_fast(g0[3]) * u0[3]);
                w.z = cvt_pk_bf16(silu_fast(g1[0]) * u1[0], silu_fast(g1[1]) * u1[1]); w.w = cvt_pk_bf16(silu_fast(g1[2]) * u1[2], silu_fast(g1[3]) * u1[3]);
                *(u32x4*)rowp = w; }
    }
};
struct EpiSwiglu8 {
    static constexpr bool PERM = true, AFTER_DRAIN = false;
    unsigned char* O;
    __device__ __forceinline__ void operator()(const f32x4 (&acc)[2][2][4][2], const Unit& u, int wr, int wc, int fr, int fq) const {
        const int row0 = u.pm * BM + wr * 64 + fr, col0 = u.pn * HALF + wc * 32 + 8 * fq;
        constexpr float WI = 1.f / W8_SCALE;
#pragma unroll
        for (int ai = 0; ai < 2; ++ai)
#pragma unroll
            for (int m = 0; m < 4; ++m) { unsigned char* rowp = O + (size_t)(row0 + ai * HALF + m * 16) * DFF + col0;
                const f32x4 g0 = acc[ai][0][m][0] * WI, g1 = acc[ai][0][m][1] * WI, u0 = acc[ai][1][m][0] * (WI * A8_SCALE), u1 = acc[ai][1][m][1] * (WI * A8_SCALE);
                v2u w; w.x = pk4_fp8(silu_fast(g0[0]) * u0[0], silu_fast(g0[1]) * u0[1], silu_fast(g0[2]) * u0[2], silu_fast(g0[3]) * u0[3]);
                w.y = pk4_fp8(silu_fast(g1[0]) * u1[0], silu_fast(g1[1]) * u1[1], silu_fast(g1[2]) * u1[2], silu_fast(g1[3]) * u1[3]);
                *(v2u*)rowp = w; }
    }
};
struct EpiMoeDown {
    static constexpr bool PERM = true, AFTER_DRAIN = false;
    bf16_t* O; const float* rgate; float scale;
    __device__ __forceinline__ void operator()(const f32x4 (&acc)[2][2][4][2], const Unit& u, int wr, int wc, int fr, int fq) const {
        const int row0 = u.pm * BM + wr * 64 + fr, col0 = u.pn * BM + wc * 32 + 8 * fq;
#pragma unroll
        for (int ai = 0; ai < 2; ++ai)
#pragma unroll
            for (int m = 0; m < 4; ++m) { const int row = row0 + ai * HALF + m * 16; const float sc = rgate[row] * scale; bf16_t* rowp = O + (size_t)row * DM + col0;
#pragma unroll
                for (int bj = 0; bj < 2; ++bj) { const f32x4 v0 = acc[ai][bj][m][0] * sc, v1 = acc[ai][bj][m][1] * sc;
                    u32x4 w; w.x = cvt_pk_bf16(v0[0], v0[1]); w.y = cvt_pk_bf16(v0[2], v0[3]); w.z = cvt_pk_bf16(v1[0], v1[1]); w.w = cvt_pk_bf16(v1[2], v1[3]);
                    *(u32x4*)(rowp + bj * HALF) = w; } }
    }
};

template <class Epi, class Sched, bool ALIGN_EPI = false, bool SP2 = false, bool F8 = false>
__device__ __forceinline__ void gemm_phase(PG8_LAS unsigned char* lds, const Gemm g, const Sched& S, const Epi& E, const int wid  ) {
    const int lane = lane_id(), tid = wid * 64 + lane, wr = wid >> 2, wc = wid & 3, fr = lane & 15, fq = lane >> 4;
    const int K = g.ld, nt = g.K / BK;
    unsigned voffA[2], voffB[2];
#pragma unroll
    for (int i = 0; i < 2; ++i) { int R, C; stage_rc(tid * 16 + i * 8192, R, C); const int Rb = Epi::PERM ? ((R & ~31) + perm32(R & 31)) : R;
        voffA[i] = (unsigned)(R * K + C) * 2u; voffB[i] = (unsigned)(Rb * K + C) * 2u; }
    const size_t kstep = (size_t)(BK * 2);
    const size_t hstep = (size_t)HALF * K * 2;
    const size_t tstep = 2 * hstep;
    const unsigned ldsw = (unsigned)wid * 1024u;
    const int aoff = lds_byte(wr * 64 + fr, fq * 8), boff = lds_byte(wc * 32 + fr, fq * 8);
#define PG8_SA(b, h) (((b) * 2 + (h)) * HTB)
#define PG8_SB(b, h) ((4 + (b) * 2 + (h)) * HTB)
#define PG8_STAGE(bufoff, gbase, voff) do { _Pragma("unroll") for (int _i = 0; _i < 2; ++_i) \
        __builtin_amdgcn_global_load_lds((const unsigned*)((const char*)(gbase) + (voff)[_i]), (PG8_LAS unsigned*)(lds + (bufoff) + ldsw + _i * 8192), 16, 0, 0); } while (0)
#define PG8_LD8(addr) __builtin_shufflevector(*(const PG8_LAS i32x4*)(addr), *(const PG8_LAS i32x4*)((addr) + 1024), 0, 1, 2, 3, 4, 5, 6, 7)
#define PG8_LDA(dst, dst8, b, h) do { if constexpr (F8) { _Pragma("unroll") for (int m = 0; m < 4; ++m) dst8[m] = PG8_LD8(lds + PG8_SA(b, h) + aoff + m * 2048); } \
        else { _Pragma("unroll") for (int m = 0; m < 4; ++m) _Pragma("unroll") for (int k = 0; k < 2; ++k) dst[m][k] = *(const PG8_LAS bf16x8*)(lds + PG8_SA(b, h) + aoff + m * 2048 + k * 1024); } } while (0)
#define PG8_LDB(dst, dst8, b, h) do { if constexpr (F8) { _Pragma("unroll") for (int n = 0; n < 2; ++n) dst8[n] = PG8_LD8(lds + PG8_SB(b, h) + boff + n * 2048); } \
        else { _Pragma("unroll") for (int n = 0; n < 2; ++n) _Pragma("unroll") for (int k = 0; k < 2; ++k) dst[n][k] = *(const PG8_LAS bf16x8*)(lds + PG8_SB(b, h) + boff + n * 2048 + k * 1024); } } while (0)
#define PG8_MMA(ai, bj, At, At8, Bt, Bt8) do { __builtin_amdgcn_s_setprio(1); \
        if constexpr (F8) { _Pragma("unroll") for (int m = 0; m < 4; ++m) _Pragma("unroll") for (int n = 0; n < 2; ++n) \
            asm volatile("v_mfma_scale_f32_16x16x128_f8f6f4 %0, %1, %2, %0, %3, %3 op_sel_hi:[0,0,0]" : "+v"(acc[ai][bj][m][n]) : "v"(Bt8[n]), "v"(At8[m]), "v"(sc8_)); } \
        else { _Pragma("unroll") for (int m = 0; m < 4; ++m) _Pragma("unroll") for (int n = 0; n < 2; ++n) _Pragma("unroll") for (int k = 0; k < 2; ++k) \
            acc[ai][bj][m][n] = __builtin_amdgcn_mfma_f32_16x16x32_bf16(Bt[n][k], At[m][k], acc[ai][bj][m][n], 0, 0, 0); } \
        __builtin_amdgcn_s_setprio(0); } while (0)
#define PG8_WAIT_V(n) asm volatile("s_waitcnt vmcnt(" #n ")" ::: "memory")
#define PG8_WAIT_L(n) asm volatile("s_waitcnt lgkmcnt(" #n ")" ::: "memory")
#define PG8_BAR __builtin_amdgcn_s_barrier()
#define PG8_SCHED __builtin_amdgcn_sched_barrier(0)
#define PG8_SCHED8 do { if constexpr (F8) __builtin_amdgcn_sched_barrier(0); } while (0)
    Unit cur, nxt; int ui = 0;
    if (!S.next(0, cur)) return;
    constexpr float zero_ = 0.f;
    const int sc8_ = 0x7f7f7f7f;
    f32x4 acc[2][2][4][2];
#pragma unroll
    for (int a = 0; a < 2; ++a)
#pragma unroll
        for (int b = 0; b < 2; ++b)
#pragma unroll
            for (int m = 0; m < 4; ++m)
#pragma unroll
                for (int n = 0; n < 2; ++n) acc[a][b][m][n] = (f32x4){zero_, zero_, zero_, zero_};
    bf16x8 At[4][2], B0[2][2], B1[2][2];
    i32x8 At8[4], B08[2], B18[2];
    const char* cA = (const char*)g.A + cur.kofs + (size_t)cur.pm * tstep; const char* cB = (const char*)g.Bt + cur.bofs + cur.kofs + (size_t)cur.pn * tstep;
    S.a_ready(cur);
    if constexpr (SP2) {
        PG8_STAGE(PG8_SB(0, 0), cB, voffB); PG8_STAGE(PG8_SB(0, 1), cB + hstep, voffB); PG8_STAGE(PG8_SA(0, 0), cA, voffA); PG8_STAGE(PG8_SA(0, 1), cA + hstep, voffA);
        if (wr == 1) PG8_BAR;
        PG8_WAIT_V(2); PG8_BAR;
        PG8_STAGE(PG8_SB(1, 0), cB + kstep, voffB); PG8_STAGE(PG8_SA(1, 0), cA + kstep, voffA); PG8_STAGE(PG8_SB(1, 1), cB + hstep + kstep, voffB);
        PG8_WAIT_V(6); PG8_BAR;
    } else {
        PG8_STAGE(PG8_SB(0, 0), cB, voffB); PG8_STAGE(PG8_SA(0, 0), cA, voffA); PG8_STAGE(PG8_SB(0, 1), cB + hstep, voffB); PG8_STAGE(PG8_SA(0, 1), cA + hstep, voffA);
        if (wr == 1) PG8_BAR;
        PG8_WAIT_V(4); PG8_BAR;
        PG8_STAGE(PG8_SB(1, 0), cB + kstep, voffB); PG8_STAGE(PG8_SA(1, 0), cA + kstep, voffA); PG8_STAGE(PG8_SB(1, 1), cB + hstep + kstep, voffB);
        PG8_WAIT_V(6); PG8_BAR;
    }
    for (;;) {
        const bool has_next = S.next(ui + 1, nxt);
        const char* nA = has_next ? (const char*)g.A + nxt.kofs + (size_t)nxt.pm * tstep : cA; const char* nB = has_next ? (const char*)g.Bt + nxt.bofs + nxt.kofs + (size_t)nxt.pn * tstep : cB;
#pragma clang loop unroll(disable)
        for (int t = 0; t < nt; t += 2) {
            const bool last = (t == nt - 2);
            const char* a1 = cA + (size_t)(t + 1) * kstep;
            const char* a2 = last ? nA : cA + (size_t)(t + 2) * kstep; const char* b2 = last ? nB : cB + (size_t)(t + 2) * kstep;
            const char* a3 = a2 + kstep; const char* b3 = b2 + kstep;
            if (last && has_next) S.a_ready(nxt);
            if constexpr (SP2) {
            PG8_LDB(B0, B08, 0, 0); PG8_LDB(B1, B18, 0, 1); PG8_SCHED; PG8_LDA(At, At8, 0, 0); PG8_STAGE(PG8_SA(1, 1), a1 + hstep, voffA);
            PG8_WAIT_V(8); PG8_WAIT_L(0); PG8_BAR; PG8_SCHED8; PG8_MMA(0, 0, At, At8, B0, B08); PG8_MMA(0, 1, At, At8, B1, B18); PG8_SCHED8; PG8_BAR; PG8_SCHED;
            PG8_LDA(At, At8, 0, 1); PG8_STAGE(PG8_SB(0, 0), b2, voffB); PG8_STAGE(PG8_SB(0, 1), b2 + hstep, voffB); PG8_STAGE(PG8_SA(0, 0), a2, voffA);
            PG8_WAIT_V(8); PG8_WAIT_L(0); PG8_BAR; PG8_SCHED8; PG8_MMA(1, 0, At, At8, B0, B08); PG8_MMA(1, 1, At, At8, B1, B18); PG8_SCHED8; PG8_BAR; PG8_SCHED;
            PG8_LDB(B0, B08, 1, 0); PG8_LDB(B1, B18, 1, 1); PG8_SCHED; PG8_LDA(At, At8, 1, 0); PG8_STAGE(PG8_SA(0, 1), a2 + hstep, voffA);
            PG8_WAIT_V(8); PG8_WAIT_L(0); PG8_BAR; PG8_SCHED8; PG8_MMA(0, 0, At, At8, B0, B08); PG8_MMA(0, 1, At, At8, B1, B18); PG8_SCHED8; PG8_BAR; PG8_SCHED;
            PG8_LDA(At, At8, 1, 1); PG8_STAGE(PG8_SB(1, 0), b3, voffB); PG8_STAGE(PG8_SB(1, 1), b3 + hstep, voffB); PG8_STAGE(PG8_SA(1, 0), a3, voffA);
            PG8_WAIT_V(8); PG8_WAIT_L(0); PG8_BAR; PG8_SCHED8; PG8_MMA(1, 0, At, At8, B0, B08); PG8_MMA(1, 1, At, At8, B1, B18); PG8_SCHED8; PG8_BAR; PG8_SCHED;
            } else {
            PG8_LDB(B0, B08, 0, 0); PG8_SCHED; PG8_LDA(At, At8, 0, 0); PG8_STAGE(PG8_SA(1, 1), a1 + hstep, voffA);
            PG8_WAIT_L(8); PG8_BAR; PG8_WAIT_L(0); PG8_MMA(0, 0, At, At8, B0, B08); PG8_BAR; PG8_SCHED;
            PG8_LDB(B1, B18, 0, 1); PG8_STAGE(PG8_SB(0, 0), b2, voffB);
            PG8_BAR; PG8_WAIT_L(0); PG8_MMA(0, 1, At, At8, B1, B18); PG8_BAR;
            PG8_LDA(At, At8, 0, 1); PG8_STAGE(PG8_SA(0, 0), a2, voffA);
            PG8_BAR; PG8_WAIT_L(0); PG8_MMA(1, 0, At, At8, B0, B08); PG8_BAR; PG8_SCHED;
            PG8_STAGE(PG8_SB(0, 1), b2 + hstep, voffB);
            PG8_WAIT_V(6); PG8_BAR; PG8_MMA(1, 1, At, At8, B1, B18); PG8_BAR;
            PG8_LDB(B0, B08, 1, 0); PG8_SCHED; PG8_LDA(At, At8, 1, 0); PG8_STAGE(PG8_SA(0, 1), a2 + hstep, voffA);
            PG8_WAIT_L(8); PG8_BAR; PG8_WAIT_L(0); PG8_MMA(0, 0, At, At8, B0, B08); PG8_BAR; PG8_SCHED;
            PG8_LDB(B1, B18, 1, 1); PG8_STAGE(PG8_SB(1, 0), b3, voffB);
            PG8_BAR; PG8_WAIT_L(0); PG8_MMA(0, 1, At, At8, B1, B18); PG8_BAR;
            PG8_LDA(At, At8, 1, 1); PG8_STAGE(PG8_SA(1, 0), a3, voffA);
            PG8_BAR; PG8_WAIT_L(0); PG8_MMA(1, 0, At, At8, B0, B08); PG8_BAR; PG8_SCHED;
            PG8_STAGE(PG8_SB(1, 1), b3 + hstep, voffB);
            PG8_WAIT_V(6); PG8_BAR; PG8_MMA(1, 1, At, At8, B1, B18); PG8_BAR;
            }
        }
        if constexpr (ALIGN_EPI) { if (wr == 0) PG8_BAR; }
        if constexpr (F8) asm volatile("s_nop 15\n\ts_nop 15" ::: "memory");
        if constexpr (!Epi::AFTER_DRAIN) { E(acc, cur, wr, wc, fr, fq); S.done(cur); }
        if (!has_next) break;
#pragma unroll
        for (int a = 0; a < 2; ++a)
#pragma unroll
            for (int b = 0; b < 2; ++b)
#pragma unroll
                for (int m = 0; m < 4; ++m)
#pragma unroll
                    for (int n = 0; n < 2; ++n) acc[a][b][m][n] = (f32x4){zero_, zero_, zero_, zero_};
        cur = nxt; cA = nA; cB = nB; ++ui;
        if constexpr (ALIGN_EPI) { if (wr == 1) PG8_BAR; }
    }
    PG8_WAIT_V(0);
    if constexpr (!ALIGN_EPI) { if (wr == 0) PG8_BAR; }
    PG8_BAR;
    if constexpr (Epi::AFTER_DRAIN) { E.fused(acc, cur, wr, wc, fr, fq, lds, wid, lane); S.done(cur); }
#undef PG8_SA
#undef PG8_SB
#undef PG8_STAGE
#undef PG8_LDA
#undef PG8_LDB
#undef PG8_MMA
#undef PG8_LD8
#undef PG8_WAIT_V
#undef PG8_WAIT_L
#undef PG8_BAR
#undef PG8_SCHED
#undef PG8_SCHED8
}

}

#define GAS __attribute__((address_space(1)))
#define LAS __attribute__((address_space(3)))
typedef unsigned v4u __attribute__((ext_vector_type(4)));
typedef float f32x4 __attribute__((ext_vector_type(4)));
#define LDS_WAIT() asm volatile("s_waitcnt lgkmcnt(0)" ::: "memory")
#define VM_WAIT() asm volatile("s_waitcnt vmcnt(0)" ::: "memory")

#define XB_TMO      128
#define XB_XCNT(j)  (256  + 64 * (j))
#define XB_XSUB(j)  (1280 + 64 * (j))
#define XB_XGEN(j)  (2304 + 64 * (j))
#define XB_TOP      3328
#define XB_TOPGEN   3392
#define XCD_BAR_WORDS 3456
#define XB_SPIN_CAP (1u << 18)

__device__ __forceinline__ unsigned xb_ld(unsigned* p)              { return __hip_atomic_load(p, __ATOMIC_RELAXED, __HIP_MEMORY_SCOPE_AGENT); }
__device__ __forceinline__ unsigned xb_add(unsigned* p, unsigned v) { return __hip_atomic_fetch_add(p, v, __ATOMIC_RELAXED, __HIP_MEMORY_SCOPE_AGENT); }
__device__ __forceinline__ unsigned xb_xcc_id() { return (unsigned)__builtin_amdgcn_s_getreg((3 << 11) | 20) & 0xFu; }
#define XB_SPIN(cond, bar) do { unsigned _sp = 0; while (cond) { __builtin_amdgcn_s_sleep(1); \
    if ((++_sp & 255u) == 0u) { if (xb_ld(&(bar)[XB_TMO])) break; if (_sp > XB_SPIN_CAP) { atomicAdd(&(bar)[XB_TMO], 1u); break; } } } } while (0)

struct XcdBarrier {
    unsigned* bar; unsigned x;
    volatile LAS unsigned* st;
};

__device__ __forceinline__ XcdBarrier xcd_barrier_post(unsigned* bar, volatile LAS unsigned* st, bool t0) {
    XcdBarrier b; b.bar = bar; b.x = xb_xcc_id(); b.st = st;
    if (t0) (void)xb_add(&bar[XB_XCNT(b.x)], 1u);
    return b;
}
__device__ __forceinline__ void xcd_barrier_complete(unsigned* bar, unsigned x, unsigned& nloc, unsigned& nx) {
    const unsigned G = gridDim.x * gridDim.y * gridDim.z;
    unsigned sum, cnt, mine, sp = 0u;
    for (;;) {
        sum = 0u; cnt = 0u; mine = 0u;
#pragma unroll
        for (unsigned j = 0; j < 16; ++j) { const unsigned c = xb_ld(&bar[XB_XCNT(j)]); sum += c; cnt += (c > 0u) ? 1u : 0u; mine = (j == x) ? c : mine; }
        if (sum == G) break;
        __builtin_amdgcn_s_sleep(1);
        if ((++sp & 255u) == 0u) { if (xb_ld(&bar[XB_TMO])) break; if (sp > XB_SPIN_CAP) { atomicAdd(&bar[XB_TMO], 1u); break; } }
    }
    nloc = mine > 0u ? mine : 1u; nx = cnt > 0u ? cnt : 1u;
}

__device__ __forceinline__ void xcd_barrier(const XcdBarrier& b, bool t0) {
    asm volatile("s_waitcnt vmcnt(0)" ::: "memory");
    __syncthreads();
    if (t0) {
        unsigned* bar = b.bar;
        __builtin_amdgcn_s_waitcnt(0);
        unsigned nloc = b.st[0], nx = b.st[1];
        if (nloc == 0u) { xcd_barrier_complete(bar, b.x, nloc, nx); b.st[0] = nloc; b.st[1] = nx; }
        const unsigned old = xb_add(&bar[XB_XSUB(b.x)], 1u);
        const unsigned gen = old / nloc;
        if (old + 1u == (gen + 1u) * nloc) {
            __builtin_amdgcn_fence(__ATOMIC_RELEASE, "agent");
            asm volatile("s_waitcnt vmcnt(0)" ::: "memory");
            const unsigned og = xb_add(&bar[XB_TOP], 1u);
            const unsigned tg = og / nx;
            if (og + 1u == (tg + 1u) * nx) xb_add(&bar[XB_TOPGEN], 1u);
            else XB_SPIN(xb_ld(&bar[XB_TOPGEN]) == tg, bar);
            __builtin_amdgcn_fence(__ATOMIC_ACQUIRE, "agent");
            xb_add(&bar[XB_XGEN(b.x)], 1u);
            asm volatile("s_waitcnt vmcnt(0)" ::: "memory");
        } else {
            XB_SPIN(xb_ld(&bar[XB_XGEN(b.x)]) == gen, bar);
            __builtin_amdgcn_fence(__ATOMIC_ACQUIRE, "agent");
            asm volatile("s_waitcnt vmcnt(0)" ::: "memory");
        }
    }
    __syncthreads();
}

struct XcdToken { unsigned gen, tg; int role; };
__device__ __forceinline__ XcdToken xcd_barrier_arrive(const XcdBarrier& b, bool t0) {
    XcdToken k; k.gen = 0u; k.tg = 0u; k.role = 0;
    asm volatile("s_waitcnt vmcnt(0)" ::: "memory");
    __syncthreads();
    if (t0) {
        unsigned* bar = b.bar;
        __builtin_amdgcn_s_waitcnt(0);
        unsigned nloc = b.st[0], nx = b.st[1];
        if (nloc == 0u) { xcd_barrier_complete(bar, b.x, nloc, nx); b.st[0] = nloc; b.st[1] = nx; }
        const unsigned old = xb_add(&bar[XB_XSUB(b.x)], 1u);
        k.gen = old / nloc;
        if (old + 1u == (k.gen + 1u) * nloc) {
            __builtin_amdgcn_fence(__ATOMIC_RELEASE, "agent");
            asm volatile("s_waitcnt vmcnt(0)" ::: "memory");
            const unsigned og = xb_add(&bar[XB_TOP], 1u);
            k.tg = og / nx;
            if (og + 1u == (k.tg + 1u) * nx) { xb_add(&bar[XB_TOPGEN], 1u); k.role = 2; } else k.role = 1;
        }
    }
    return k;
}
__device__ __forceinline__ void xcd_barrier_wait(const XcdBarrier& b, const XcdToken& k, bool t0) {
    if (t0) {
        unsigned* bar = b.bar;
        if (k.role) {
            if (k.role == 1) XB_SPIN(xb_ld(&bar[XB_TOPGEN]) == k.tg, bar);
            __builtin_amdgcn_fence(__ATOMIC_ACQUIRE, "agent");
            xb_add(&bar[XB_XGEN(b.x)], 1u);
            asm volatile("s_waitcnt vmcnt(0)" ::: "memory");
        } else {
            XB_SPIN(xb_ld(&bar[XB_XGEN(b.x)]) == k.gen, bar);
            __builtin_amdgcn_fence(__ATOMIC_ACQUIRE, "agent");
            asm volatile("s_waitcnt vmcnt(0)" ::: "memory");
        }
    }
    __syncthreads();
}

constexpr int RING_OFF = 0, RING_BYTES = 131072;
constexpr int MISC_OFF = 143360;
constexpr int LDS_BYTES = 147456;
constexpr int NWAVES = 8;

struct Ctx { LAS unsigned char* lds; volatile LAS unsigned* MISC; unsigned* ctl; int wave, G, gw, NGW; };

__device__ __forceinline__ void cvt_item(const float* W, int K, int N, bf16_t* WT, int mode, LAS float* scr, int item, int lane) {
    const int kblk = K / 64, nb = item / kblk, kb = item % kblk, k0 = 64 * kb, n0 = 64 * nb;
    f32x4 ld[16];
#pragma unroll
    for (int i = 0; i < 16; ++i) { const int kk = 4 * i + (lane >> 4), c4 = 4 * (lane & 15); ld[i] = __builtin_nontemporal_load((const f32x4*)(W + (size_t)(k0 + kk) * N + n0 + c4));     }
#pragma unroll
    for (int i = 0; i < 16; ++i) { const int kk = 4 * i + (lane >> 4), c4 = 4 * (lane & 15);
        LAS float* s = scr + kk * 65 + c4; s[0] = ld[i][0]; s[1] = ld[i][1]; s[2] = ld[i][2]; s[3] = ld[i][3]; }
    LDS_WAIT(); asm volatile("" ::: "memory");
    const int c = lane >> 3;
#pragma unroll
    for (int j = 0; j < 8; ++j) { const int n = (lane & 7) + 8 * j; const LAS float* s = scr + (8 * c) * 65 + n;
        v4u o; o.x = pk2(s[0 * 65], s[1 * 65]); o.y = pk2(s[2 * 65], s[3 * 65]); o.z = pk2(s[4 * 65], s[5 * 65]); o.w = pk2(s[6 * 65], s[7 * 65]);
        const int nn = n0 + n; const int drow = mode == 0 ? nn : (nn / 128) * 256 + (mode - 1) * 128 + (nn % 128);
        *(v4u*)(WT + (size_t)drow * K + k0 + 8 * c) = o; }
    LDS_WAIT(); asm volatile("" ::: "memory");
}
__device__ __forceinline__ void cvt_item8(const float* W, int K, int N, unsigned char* WT, int mode, LAS float* scr, int item, int lane) {
    const int kblk = K / 64, nb = item / kblk, kb = item % kblk, k0 = 64 * kb, n0 = 64 * nb;
    f32x4 ld[16];
#pragma unroll
    for (int i = 0; i < 16; ++i) { const int kk = 4 * i + (lane >> 4), c4 = 4 * (lane & 15); ld[i] = __builtin_nontemporal_load((const f32x4*)(W + (size_t)(k0 + kk) * N + n0 + c4));     }
#pragma unroll
    for (int i = 0; i < 16; ++i) { const int kk = 4 * i + (lane >> 4), c4 = 4 * (lane & 15);
        LAS float* s = scr + kk * 65 + c4; s[0] = ld[i][0]; s[1] = ld[i][1]; s[2] = ld[i][2]; s[3] = ld[i][3]; }
    LDS_WAIT(); asm volatile("" ::: "memory");
    const int c = lane >> 3;
#pragma unroll
    for (int j = 0; j < 8; ++j) { const int n = (lane & 7) + 8 * j; const LAS float* s = scr + (8 * c) * 65 + n;
        v2u o; o.x = pk4_fp8(s[0 * 65] * W8_SCALE, s[1 * 65] * W8_SCALE, s[2 * 65] * W8_SCALE, s[3 * 65] * W8_SCALE); o.y = pk4_fp8(s[4 * 65] * W8_SCALE, s[5 * 65] * W8_SCALE, s[6 * 65] * W8_SCALE, s[7 * 65] * W8_SCALE);
        const int nn = n0 + n; const int drow = mode == 0 ? nn : (nn / 128) * 256 + (mode - 1) * 128 + (nn % 128);
        *(v2u*)(WT + (size_t)drow * K + k0 + 8 * c) = o; }
    LDS_WAIT(); asm volatile("" ::: "memory");
}
constexpr int MOE_S_F = 16 * 44, MOE_ITEMS = 24 * MOE_S_F;
__device__ __forceinline__ void moe_cvt_item(const Params& p, int r, LAS float* scr, int lane_) {
    constexpr int S_F = MOE_S_F;
    if (r < 8 * S_F) { const int e = r / S_F; cvt_item8(p.in[I_MWG] + (size_t)e * DM * DFF, DM, DFF, (unsigned char*)(p.ws + W_MGU) + (size_t)e * 2 * DFF * DM, 1, scr, r % S_F, lane_); return; } r -= 8 * S_F;
    if (r < 8 * S_F) { const int e = r / S_F; cvt_item8(p.in[I_MWU] + (size_t)e * DM * DFF, DM, DFF, (unsigned char*)(p.ws + W_MGU) + (size_t)e * 2 * DFF * DM, 2, scr, r % S_F, lane_); return; } r -= 8 * S_F;
    { const int e = r / S_F; cvt_item8(p.in[I_MWD] + (size_t)e * DFF * DM, DFF, DM, (unsigned char*)(p.ws + W_MD) + (size_t)e * DM * DFF, 0, scr, r % S_F, lane_); }
}
#if SEAM_CVT
constexpr int SEAM_CVT_SEAMS = 17;
__device__ __forceinline__ void seam_fill(const Params& p, Ctx& F, int s) {
    if (s >= SEAM_CVT_SEAMS || (F.wave & 1) != (s & 1)) return;
    const int it = s * (F.G * 4) + (int)blockIdx.x * 4 + (F.wave >> 1);
    if (it < MOE_ITEMS) moe_cvt_item(p, it, (LAS float*)(F.lds + RING_OFF) + F.wave * (64 * 65), lane_id());
}
__device__ __forceinline__ void moe_cvt_rest(const Params& p, Ctx& F) {
    for (int it = SEAM_CVT_SEAMS * (F.G * 4) + F.gw; it < MOE_ITEMS; it += F.NGW) moe_cvt_item(p, it, (LAS float*)(F.lds + RING_OFF) + F.wave * (64 * 65), lane_id());
}
#endif
__device__ __forceinline__ void p0_prologue(const Params& p, Ctx& F) {
    const int lane_ = lane_id(), tid_ = F.wave * 64 + lane_;
    LAS float* fl = (LAS float*)(F.lds + RING_OFF);
    for (int it = blockIdx.x; it < 192; it += F.G) {
        const int l = it / 96, n = (it % 96) * 64 + lane_;
        LAS float* sv = fl;
        LAS float* red = fl + 3 * 1024;
        for (int i = tid_; i < 3 * 1024; i += 512) { const int rt = i >> 10, k = i & 1023; const float v = rt < 2 ? p.in[I_C][rt * DM + k] : p.in[I_CCTX][k]; sv[i] = siluf(v); }
        __syncthreads();
        const float* W = p.in[I_ADAW] + (size_t)l * DM * 6144 + n;
        float a0 = 0.f, a1 = 0.f, a2 = 0.f;
        for (int kb = 0; kb < 128; kb += 32) {
            float wv[32];
#pragma unroll
            for (int j = 0; j < 32; ++j) wv[j] = W[(size_t)(F.wave * 128 + kb + j) * 6144];
#pragma unroll
            for (int j = 0; j < 32; ++j) { const int k = F.wave * 128 + kb + j; a0 += sv[k] * wv[j]; a1 += sv[1024 + k] * wv[j]; a2 += sv[2048 + k] * wv[j]; }
        }
        red[(F.wave * 3 + 0) * 64 + lane_] = a0; red[(F.wave * 3 + 1) * 64 + lane_] = a1; red[(F.wave * 3 + 2) * 64 + lane_] = a2;
        __syncthreads();
        if (tid_ < 192) { const int rt = tid_ >> 6, ln = tid_ & 63; float s = 0.f;
#pragma unroll
            for (int w = 0; w < 8; ++w) s += red[(w * 3 + rt) * 64 + ln];
            const int nn = (it % 96) * 64 + ln;
            ((float*)(p.ws + WS_MODV))[(size_t)(l * 3 + rt) * 6144 + nn] = s + p.in[I_ADAB][l * 6144 + nn]; }
        __syncthreads();
    }
    LAS float* scr = (LAS float*)(F.lds + RING_OFF) + F.wave * (64 * 65);
    constexpr int S_WIN = 16 * 56, S_WOUT = 16 * 16, S_F = 16 * 44;
    constexpr int NITEMS = 2 * S_WIN + 2 * S_WOUT + 3 * S_F + (SEAM_CVT ? 0 : 24 * S_F);
    static_assert(NITEMS + (SEAM_CVT ? 24 * S_F : 0) == 21312, "items");
    for (int it = F.gw; it < NITEMS; it += F.NGW) {
        int r = it;
        if (r < 2 * S_WIN) { const int l = r / S_WIN; cvt_item(p.in[I_WIN] + (size_t)l * DM * DP, DM, DP, (bf16_t*)(p.ws + W_WIN) + (size_t)l * DP * DM, 0, scr, r % S_WIN, lane_); continue; } r -= 2 * S_WIN;
        if (r < 2 * S_WOUT) { const int l = r / S_WOUT; cvt_item(p.in[I_WOUT] + (size_t)l * DM * DM, DM, DM, (bf16_t*)(p.ws + W_WOUT) + (size_t)l * DM * DM, 0, scr, r % S_WOUT, lane_); continue; } r -= 2 * S_WOUT;
        if (r < S_F) { cvt_item(p.in[I_FWG], DM, DFF, (bf16_t*)(p.ws + W_FGU), 1, scr, r, lane_); continue; } r -= S_F;
        if (r < S_F) { cvt_item(p.in[I_FWU], DM, DFF, (bf16_t*)(p.ws + W_FGU), 2, scr, r, lane_); continue; } r -= S_F;
        if (r < S_F) { cvt_item(p.in[I_FWD], DFF, DM, (bf16_t*)(p.ws + W_FD), 0, scr, r, lane_); continue; } r -= S_F;
        moe_cvt_item(p, r, scr, lane_);
    }
}

__device__ __forceinline__ void norm_phase(const Params& p, Ctx& F, int l, int which, int nrows) {
    const int lane_ = lane_id(), tid_ = F.wave * 64 + lane_;
    const float* g = p.in[which ? I_N2G : I_N1G] + l * DM;
    for (int m = F.gw; m < nrows; m += F.NGW) {
        const float* xrow;
        if (l == 0 && which == 0) xrow = m < NL ? p.in[I_X] + (size_t)m * DM : p.in[I_CTX] + (size_t)(m - NL) * DM;
        else xrow = xr_row(p, m);
        const int rt = rowtype(m);
        const float* sh = modv(p, l, rt, which ? 3 : 0); const float* sc = modv(p, l, rt, which ? 4 : 1);
        f32x4 v[4]; float ss = 0.f;
        if (m >= NL && !(l == 0 && which == 0)) {
            const int nsl = which ? DM / 256 : DFF / 256; const float* gate = modv(p, 0, 2, which ? 2 : 5);
            const float* base = (l == 0) ? p.in[I_CTX] + (size_t)(m - NL) * DM : xrow;
            const float* part = (const float*)(p.ws + WS_PART) + (size_t)(m - NL) * DM;
#pragma unroll
            for (int j = 0; j < 4; ++j) { const int col = 256 * j + 4 * lane_; f32x4 a = {0.f, 0.f, 0.f, 0.f};
                for (int sl = 0; sl < nsl; ++sl) a += *(const f32x4*)(part + (size_t)sl * NC * DM + col);
                v[j] = *(const f32x4*)(base + col) + *(const f32x4*)(gate + col) * a;
                *(f32x4*)((float*)(p.ws + WS_XRC) + (size_t)(m - NL) * DM + col) = v[j];
                ss += (v[j][0] * v[j][0] + v[j][1] * v[j][1]) + (v[j][2] * v[j][2] + v[j][3] * v[j][3]); }
        } else
#pragma unroll
        for (int j = 0; j < 4; ++j) { v[j] = *(const f32x4*)(xrow + 256 * j + 4 * lane_); ss += (v[j][0] * v[j][0] + v[j][1] * v[j][1]) + (v[j][2] * v[j][2] + v[j][3] * v[j][3]); }
        const float r = rsqrtf(wave_sum(ss) * (1.f / DM) + EPS);
        bf16_t* hb = (bf16_t*)(p.ws + WS_HBUF) + (size_t)m * DM;
#pragma unroll
        for (int j = 0; j < 4; ++j) { const int col = 256 * j + 4 * lane_;
            const f32x4 gg = *(const f32x4*)(g + col), s4 = *(const f32x4*)(sc + col), h4 = *(const f32x4*)(sh + col);
            const f32x4 y = v[j] * r * gg * (1.f + s4) + h4;
            v2u o; o.x = pk2(y[0], y[1]); o.y = pk2(y[2], y[3]); *(v2u*)(hb + col) = o; }
    }
}


__device__ __forceinline__ void router_phase(const Params& p, Ctx& F) {
    const int lane_ = lane_id(), tid_ = F.wave * 64 + lane_;
    LAS int* lcnt = (LAS int*)(F.lds + RING_OFF);
    LAS int* gbase = lcnt + 8;
    LAS int* ent_e = lcnt + 16;
    LAS int* ent_pos = lcnt + 16 + 128;
    const float* g = p.in[I_N2G] + DM; const float* rw = p.in[I_RW];
    int* tok_e = (int*)(p.ws + WS_ROUTE); float* tok_w = (float*)(p.ws + WS_ROUTE) + 2 * NL; int* tok_pos = (int*)(p.ws + WS_ROUTE) + 4 * NL;
    f32x4 rwa[4][4], rwb[4][4];
#pragma unroll
    for (int j = 0; j < 4; ++j)
#pragma unroll
        for (int q = 0; q < 4; ++q) { const int col = 256 * j + 4 * lane_ + q; rwa[j][q] = *(const f32x4*)(rw + (size_t)col * 8); rwb[j][q] = *(const f32x4*)(rw + (size_t)col * 8 + 4); }
    const int myexp = ((lane_ >> 5) & 1) * 4 + ((lane_ >> 4) & 1) * 2 + ((lane_ >> 3) & 1);
    for (int ch = blockIdx.x; ch < NL / 64; ch += F.G) {
        if (tid_ < 8) lcnt[tid_] = 0;
        __syncthreads();
        const int rt = (ch * 64) / T;
        const float* sh = modv(p, 1, rt, 3); const float* sc = modv(p, 1, rt, 4);
        f32x4 gs[4], hs[4]; float bsum;
        { float bb[8] = {0.f, 0.f, 0.f, 0.f, 0.f, 0.f, 0.f, 0.f};
#pragma unroll
          for (int j = 0; j < 4; ++j) { const int col = 256 * j + 4 * lane_; gs[j] = *(const f32x4*)(g + col) * (1.f + *(const f32x4*)(sc + col)); hs[j] = *(const f32x4*)(sh + col);
#pragma unroll
            for (int q = 0; q < 4; ++q) { bb[0] += hs[j][q] * rwa[j][q][0]; bb[1] += hs[j][q] * rwa[j][q][1]; bb[2] += hs[j][q] * rwa[j][q][2]; bb[3] += hs[j][q] * rwa[j][q][3];
                                          bb[4] += hs[j][q] * rwb[j][q][0]; bb[5] += hs[j][q] * rwb[j][q][1]; bb[6] += hs[j][q] * rwb[j][q][2]; bb[7] += hs[j][q] * rwb[j][q][3]; } }
          float c4[4];
#pragma unroll
          for (int k = 0; k < 4; ++k) { const float keep = (lane_ & 32) ? bb[k + 4] : bb[k], give = (lane_ & 32) ? bb[k] : bb[k + 4]; c4[k] = keep + __shfl_xor(give, 32); }
          float c2[2];
#pragma unroll
          for (int k = 0; k < 2; ++k) { const float keep = (lane_ & 16) ? c4[k + 2] : c4[k], give = (lane_ & 16) ? c4[k] : c4[k + 2]; c2[k] = keep + __shfl_xor(give, 16); }
          float c1 = ((lane_ & 8) ? c2[1] : c2[0]) + __shfl_xor((lane_ & 8) ? c2[0] : c2[1], 8);
          c1 += __shfl_xor(c1, 4); c1 += __shfl_xor(c1, 2); c1 += __shfl_xor(c1, 1);
          bsum = c1 + p.in[I_RB][myexp]; }
        for (int i = 0; i < 8; ++i) {
            const int ti = F.wave * 8 + i, m = ch * 64 + ti;
            const float* xrow = p.out + (size_t)m * DM;
            f32x4 v[4]; float ss = 0.f; float aa[8] = {0.f, 0.f, 0.f, 0.f, 0.f, 0.f, 0.f, 0.f};
#pragma unroll
            for (int j = 0; j < 4; ++j) { v[j] = *(const f32x4*)(xrow + 256 * j + 4 * lane_); ss += (v[j][0] * v[j][0] + v[j][1] * v[j][1]) + (v[j][2] * v[j][2] + v[j][3] * v[j][3]); }
#pragma unroll
            for (int j = 0; j < 4; ++j) { v[j] = v[j] * gs[j];
#pragma unroll
                for (int q = 0; q < 4; ++q) { aa[0] += v[j][q] * rwa[j][q][0]; aa[1] += v[j][q] * rwa[j][q][1]; aa[2] += v[j][q] * rwa[j][q][2]; aa[3] += v[j][q] * rwa[j][q][3];
                                              aa[4] += v[j][q] * rwb[j][q][0]; aa[5] += v[j][q] * rwb[j][q][1]; aa[6] += v[j][q] * rwb[j][q][2]; aa[7] += v[j][q] * rwb[j][q][3]; } }
            float c4[4];
#pragma unroll
            for (int k = 0; k < 4; ++k) { const float keep = (lane_ & 32) ? aa[k + 4] : aa[k], give = (lane_ & 32) ? aa[k] : aa[k + 4]; c4[k] = keep + __shfl_xor(give, 32); }
            float c2[2];
#pragma unroll
            for (int k = 0; k < 2; ++k) { const float keep = (lane_ & 16) ? c4[k + 2] : c4[k], give = (lane_ & 16) ? c4[k] : c4[k + 2]; c2[k] = keep + __shfl_xor(give, 16); }
            float c1 = ((lane_ & 8) ? c2[1] : c2[0]) + __shfl_xor((lane_ & 8) ? c2[0] : c2[1], 8);
            c1 += __shfl_xor(c1, 4); c1 += __shfl_xor(c1, 2); c1 += __shfl_xor(c1, 1);
            const float r = rsqrtf(wave_sum(ss) * (1.f / DM) + EPS);
            const float mylogit = r * c1 + bsum;
#define RLF(L) __uint_as_float((unsigned)__builtin_amdgcn_readlane((int)__float_as_uint(mylogit), L))
            const float lg0 = RLF(0), lg1 = RLF(8), lg2 = RLF(16), lg3 = RLF(24), lg4 = RLF(32), lg5 = RLF(40), lg6 = RLF(48), lg7 = RLF(56);
#undef RLF
            unsigned char* hb = (unsigned char*)(p.ws + WS_HBUF) + (size_t)m * DM;
#pragma unroll
            for (int j = 0; j < 4; ++j) { const f32x4 y = v[j] * r + hs[j]; *(unsigned*)(hb + 256 * j + 4 * lane_) = pk4_fp8(y[0], y[1], y[2], y[3]); }
            int i1 = 0; float v1 = lg0;
            if (lg1 > v1) { v1 = lg1; i1 = 1; } if (lg2 > v1) { v1 = lg2; i1 = 2; } if (lg3 > v1) { v1 = lg3; i1 = 3; }
            if (lg4 > v1) { v1 = lg4; i1 = 4; } if (lg5 > v1) { v1 = lg5; i1 = 5; } if (lg6 > v1) { v1 = lg6; i1 = 6; } if (lg7 > v1) { v1 = lg7; i1 = 7; }
            int i2 = -1; float v2 = -3.4e38f;
            if (i1 != 0 && lg0 > v2) { v2 = lg0; i2 = 0; } if (i1 != 1 && lg1 > v2) { v2 = lg1; i2 = 1; } if (i1 != 2 && lg2 > v2) { v2 = lg2; i2 = 2; } if (i1 != 3 && lg3 > v2) { v2 = lg3; i2 = 3; }
            if (i1 != 4 && lg4 > v2) { v2 = lg4; i2 = 4; } if (i1 != 5 && lg5 > v2) { v2 = lg5; i2 = 5; } if (i1 != 6 && lg6 > v2) { v2 = lg6; i2 = 6; } if (i1 != 7 && lg7 > v2) { v2 = lg7; i2 = 7; }
            const float w1 = 1.f / (1.f + __expf(v2 - v1));
            if (lane_ == 0) {
                const int p1 = __hip_atomic_fetch_add(lcnt + i1, 1, __ATOMIC_RELAXED, __HIP_MEMORY_SCOPE_WORKGROUP);
                const int p2 = __hip_atomic_fetch_add(lcnt + i2, 1, __ATOMIC_RELAXED, __HIP_MEMORY_SCOPE_WORKGROUP);
                ent_e[2 * ti] = i1; ent_e[2 * ti + 1] = i2; ent_pos[2 * ti] = p1; ent_pos[2 * ti + 1] = p2;
                tok_e[2 * m] = i1; tok_e[2 * m + 1] = i2; tok_w[2 * m] = w1; tok_w[2 * m + 1] = 1.f - w1; }
        }
        __syncthreads();
        if (tid_ < 8) gbase[tid_] = (int)__hip_atomic_fetch_add(F.ctl + CW_CNT + 64 * tid_, (unsigned)lcnt[tid_], __ATOMIC_RELAXED, __HIP_MEMORY_SCOPE_AGENT);
        __syncthreads();
        if (tid_ < 128) tok_pos[ch * 128 + tid_] = gbase[ent_e[tid_]] + ent_pos[tid_];
        __syncthreads();
    }
}
__device__ __forceinline__ void moe_table(Ctx& F) {
    const int lane_ = lane_id(), tid_ = F.wave * 64 + lane_;
    volatile LAS unsigned* tb = F.MISC + 32;
    if (tid_ == 0) { unsigned acc = 0;
        for (int e = 0; e < 8; ++e) { const unsigned c = __hip_atomic_load(F.ctl + CW_CNT + 64 * e, __ATOMIC_RELAXED, __HIP_MEMORY_SCOPE_AGENT); tb[e] = acc; tb[16 + e] = c; acc += (c + 255u) / 256u * 256u; }
        tb[8] = acc; }
    __syncthreads();
}
__device__ __forceinline__ void moe_order(Ctx& F, pg8::Order& S, int nN, long estride) {
    volatile LAS unsigned* tb = F.MISC + 32;
#define RFL(x) __builtin_amdgcn_readfirstlane((int)(x))
    S.init(RFL(tb[8] / 256u), nN, F.G, (int)blockIdx.x);
    S.e1 = RFL(tb[1] / 256u); S.e2 = RFL(tb[2] / 256u); S.e3 = RFL(tb[3] / 256u); S.e4 = RFL(tb[4] / 256u); S.e5 = RFL(tb[5] / 256u); S.e6 = RFL(tb[6] / 256u); S.e7 = RFL(tb[7] / 256u);
#undef RFL
    S.estride = estride;
}
__device__ __forceinline__ void gather_phase(const Params& p, Ctx& F) {
    const int lane_ = lane_id(), tid_ = F.wave * 64 + lane_;
    moe_table(F);
    volatile LAS unsigned* tb = F.MISC + 32;
    const int* tok_e = (const int*)(p.ws + WS_ROUTE); const float* tok_w = (const float*)(p.ws + WS_ROUTE) + 2 * NL; const int* tok_pos = (const int*)(p.ws + WS_ROUTE) + 4 * NL;
    int* row_tok = (int*)(p.ws + WS_ROUTE) + 6 * NL; float* row_gate = (float*)(p.ws + WS_ROUTE) + 6 * NL + MP_MAX;
    const unsigned char* hb = (const unsigned char*)(p.ws + WS_HBUF); unsigned char* h2s = (unsigned char*)(p.ws + WS_H2S);
    for (int it = F.gw; it < 2 * NL; it += F.NGW) {
        const int t = it >> 1, e = tok_e[it], r = (int)tb[e] + tok_pos[it];
        *((v4u*)(h2s + (size_t)r * DM) + lane_) = *((const v4u*)(hb + (size_t)t * DM) + lane_);
        if (lane_ == 0) { row_tok[r] = t; row_gate[r] = tok_w[it]; }
    }
    for (int i = F.gw; i < NE * 256; i += F.NGW) {
        const int e = i >> 8, j = i & 255, r = (int)tb[e] + (int)tb[16 + e] + j;
        if (r < (int)tb[e + 1]) { const v4u z = {0u, 0u, 0u, 0u}; *((v4u*)(h2s + (size_t)r * DM) + lane_) = z; if (lane_ == 0) { row_tok[r] = -1; row_gate[r] = 0.f; } }
    }
}
__device__ __forceinline__ void combine_phase(const Params& p, Ctx& F) {
    const int lane_ = lane_id(), tid_ = F.wave * 64 + lane_;
    moe_table(F);
    volatile LAS unsigned* tb = F.MISC + 32;
    const int* tok_e = (const int*)(p.ws + WS_ROUTE); const int* tok_pos = (const int*)(p.ws + WS_ROUTE) + 4 * NL;
    const bf16_t* yb = (const bf16_t*)(p.ws + WS_YBUF);
    for (int t = F.gw; t < NL; t += F.NGW) {
        const int r0 = (int)tb[tok_e[2 * t]] + tok_pos[2 * t], r1 = (int)tb[tok_e[2 * t + 1]] + tok_pos[2 * t + 1];
        const float* g5 = modv(p, 1, t / T, 5);
        float* orow = p.out + (size_t)t * DM;
#pragma unroll
        for (int j = 0; j < 4; ++j) { const int col = 256 * j + 4 * lane_;
            const v2u a = *(const v2u*)(yb + (size_t)r0 * DM + col), b = *(const v2u*)(yb + (size_t)r1 * DM + col);
            f32x4 y; y[0] = __uint_as_float(a.x << 16) + __uint_as_float(b.x << 16); y[1] = __uint_as_float(a.x & 0xffff0000u) + __uint_as_float(b.x & 0xffff0000u);
            y[2] = __uint_as_float(a.y << 16) + __uint_as_float(b.y << 16); y[3] = __uint_as_float(a.y & 0xffff0000u) + __uint_as_float(b.y & 0xffff0000u);
            const f32x4 x = *(const f32x4*)(orow + col), gg = *(const f32x4*)(g5 + col);
            *(f32x4*)(orow + col) = x + gg * y; }
    }
}

namespace att {
#ifndef EXP_TREE
#define EXP_TREE 1
#endif
constexpr float THR = 8.f;
constexpr int KVBLK = 64;
constexpr int SHM_V = KVBLK * 128 * 2, SHM_K = KVBLK * 128 * 2;
using bf16x8 = __attribute__((ext_vector_type(8))) short;
using s16x4  = __attribute__((ext_vector_type(4))) short;
using f32x16 = __attribute__((ext_vector_type(16))) float;
using f32x8  = __attribute__((ext_vector_type(8))) float;
using u32x4  = __attribute__((ext_vector_type(4))) unsigned;
using f32x4v = __attribute__((ext_vector_type(4))) float;
#define KSWZ(row, colB) ((row) * 256 + ((colB) ^ (((row) & 7) << 4)))
#define SBAR() __builtin_amdgcn_sched_barrier(0)
__device__ __forceinline__ int crow(int r, int hi) { return (r & 3) + 8 * (r >> 2) + 4 * hi; }
__device__ __forceinline__ unsigned cvtpk(float lo, float hi) {
  unsigned r; asm volatile("v_cvt_pk_bf16_f32 %0, %1, %2" : "=v"(r) : "v"(lo), "v"(hi)); return r;
}
__device__ __forceinline__ void partialSM(f32x16& p0, f32x16& p1, float& m_reg, float& mn, float& alpha) {
  constexpr float C = 1.4426950408889634f;
  float pmax = p0[0]; for (int r = 1; r < 16; ++r) pmax = fmaxf(pmax, p0[r]); for (int r = 0; r < 16; ++r) pmax = fmaxf(pmax, p1[r]);
  { auto rr = __builtin_amdgcn_permlane32_swap(__float_as_uint(pmax), __float_as_uint(pmax), false, false);
    pmax = fmaxf(__uint_as_float(rr[0]), __uint_as_float(rr[1])); }
  if (__builtin_expect(__all(pmax - m_reg <= THR), 1)) { mn = m_reg; alpha = 1.f; }
  else { mn = fmaxf(m_reg, pmax); alpha = __builtin_amdgcn_exp2f((m_reg - mn) * C); m_reg = mn; }
  float mnC = -mn * C;
  for (int r = 0; r < 16; ++r) p0[r] = fmaf(p0[r], C, mnC); for (int r = 0; r < 16; ++r) p1[r] = fmaf(p1[r], C, mnC);
  for (int r = 0; r < 16; ++r) p0[r] = __builtin_amdgcn_exp2f(p0[r]);
}
__device__ __forceinline__ void finishSM(f32x16& p0, f32x16& p1, float alpha, float& l_reg, bf16x8& pa0, bf16x8& pa1, bf16x8& pa2, bf16x8& pa3) {
  for (int r = 0; r < 16; ++r) p1[r] = __builtin_amdgcn_exp2f(p1[r]);
  float ps = 0; for (int r = 0; r < 16; ++r) ps += p0[r]; for (int r = 0; r < 16; ++r) ps += p1[r];
  { auto rr = __builtin_amdgcn_permlane32_swap(__float_as_uint(ps), __float_as_uint(ps), false, false);
    ps = __uint_as_float(rr[0]) + __uint_as_float(rr[1]); }
  l_reg = l_reg * alpha + ps;
#define PK4(P, BASE, OUT) do { unsigned a0 = cvtpk(P[BASE + 0], P[BASE + 1]), a1 = cvtpk(P[BASE + 2], P[BASE + 3]);   \
    unsigned b0 = cvtpk(P[BASE + 4], P[BASE + 5]), b1 = cvtpk(P[BASE + 6], P[BASE + 7]);                              \
    auto r0 = __builtin_amdgcn_permlane32_swap(a0, b0, false, false); auto r1 = __builtin_amdgcn_permlane32_swap(a1, b1, false, false); \
    u32x4 w = {r0[0], r1[0], r0[1], r1[1]}; OUT = *reinterpret_cast<bf16x8*>(&w); } while (0)
  PK4(p0, 0, pa0); PK4(p0, 8, pa1); PK4(p1, 0, pa2); PK4(p1, 8, pa3);
#undef PK4
}
template <int ND0>
__device__ __forceinline__ void qkt(f32x16& p0, f32x16& p1, const LAS char* Ks, const bf16x8* qr, int r32, int hi, int dbase) {
  p0 = f32x16{}; p1 = f32x16{};
#pragma unroll
  for (int d0 = 0; d0 < ND0; ++d0) { int cb = ((dbase + d0) * 16 + hi * 8) * 2;
    bf16x8 b0 = *reinterpret_cast<const LAS bf16x8*>(Ks + KSWZ(r32, cb));
    bf16x8 b1 = *reinterpret_cast<const LAS bf16x8*>(Ks + KSWZ(32 + r32, cb));
    p0 = __builtin_amdgcn_mfma_f32_32x32x16_bf16(b0, qr[d0], p0, 0, 0, 0);
    p1 = __builtin_amdgcn_mfma_f32_32x32x16_bf16(b1, qr[d0], p1, 0, 0, 0); }
}
__device__ __forceinline__ int v_st(int k, int c) { const int kk = (k & ~0xC) | ((k & 4) << 1) | ((k & 8) >> 1); return ((kk >> 3) * 4 + (c >> 5)) * 512 + ((kk & 7) * 32 + (c & 31)) * 2; }
__device__ __forceinline__ int v_st_lin(int k, int c) { return ((k >> 3) * 4 + (c >> 5)) * 512 + ((k & 7) * 32 + (c & 31)) * 2; }
__device__ __forceinline__ int vt_off(int dv, int key) {
  const int pos = (key & ~0xC) | ((key & 4) << 1) | ((key & 8) >> 1), ch = pos >> 3;
  return dv * 128 + (((ch & 4) | ((ch & 3) ^ ((dv >> 1) & 3))) << 4) + (pos & 7) * 2;
}
__device__ __forceinline__ int v_rd_base(int lane) { return ((lane & 3) << 3) | (((lane >> 2) & 3) << 6) | (((lane >> 4) & 1) << 5) | (((lane >> 5) & 1) << 8); }
constexpr int v_rd_off(int d0, int ks, int half) { return d0 * 512 + ks * 4096 + half * 2048; }
template <int OFF> __device__ __forceinline__ s16x4 tr_read(int vb) {
  s16x4 r; asm volatile("ds_read_b64_tr_b16 %0, %1 offset:%2" : "=&v"(r) : "v"(vb), "i"(OFF) : "memory"); return r;
}
template <int D0> __device__ __forceinline__ void pv_one(f32x16& od, int vb, bf16x8 pa0, bf16x8 pa1, bf16x8 pa2, bf16x8 pa3) {
  const s16x4 l0 = tr_read<v_rd_off(D0, 0, 0)>(vb), h0 = tr_read<v_rd_off(D0, 0, 1)>(vb), l1 = tr_read<v_rd_off(D0, 1, 0)>(vb), h1 = tr_read<v_rd_off(D0, 1, 1)>(vb);
  const s16x4 l2 = tr_read<v_rd_off(D0, 2, 0)>(vb), h2 = tr_read<v_rd_off(D0, 2, 1)>(vb), l3 = tr_read<v_rd_off(D0, 3, 0)>(vb), h3 = tr_read<v_rd_off(D0, 3, 1)>(vb);
#if defined(DUMMY_TR) && DUMMY_TR
  { s16x4 dd; for (int i = 0; i < DUMMY_TR; ++i) asm volatile("ds_read_b64_tr_b16 %0, %1 offset:%2" : "=&v"(dd) : "v"(vb), "i"(v_rd_off(D0, 0, 0)) : "memory"); }
#endif
#if defined(DUMMY_MFMA) && DUMMY_MFMA
  { f32x4v dm = {0.f, 0.f, 0.f, 0.f}; for (int i = 0; i < DUMMY_MFMA; ++i) asm volatile("v_mfma_f32_16x16x32_bf16 %0, %1, %2, %0" : "+v"(dm) : "v"(pa0), "v"(pa1)); }
#endif
  asm volatile("s_waitcnt lgkmcnt(0)" ::: "memory"); SBAR();
#define PK(L, H) (bf16x8){L[0], L[1], L[2], L[3], H[0], H[1], H[2], H[3]}
  od = __builtin_amdgcn_mfma_f32_32x32x16_bf16(pa0, PK(l0, h0), od, 0, 0, 0);
  od = __builtin_amdgcn_mfma_f32_32x32x16_bf16(pa1, PK(l1, h1), od, 0, 0, 0);
  od = __builtin_amdgcn_mfma_f32_32x32x16_bf16(pa2, PK(l2, h2), od, 0, 0, 0);
  od = __builtin_amdgcn_mfma_f32_32x32x16_bf16(pa3, PK(l3, h3), od, 0, 0, 0);
#undef PK
}
__device__ __forceinline__ void pv_d0(f32x16* o, int vb, bf16x8 pa0, bf16x8 pa1, bf16x8 pa2, bf16x8 pa3) {
  pv_one<0>(o[0], vb, pa0, pa1, pa2, pa3); pv_one<1>(o[1], vb, pa0, pa1, pa2, pa3); pv_one<2>(o[2], vb, pa0, pa1, pa2, pa3); pv_one<3>(o[3], vb, pa0, pa1, pa2, pa3);
}

#ifndef DUMMY_EXP
#define DUMMY_EXP 0
#endif
#ifndef DUMMY_TR
#define DUMMY_TR 0
#endif
#ifndef DUMMY_MFMA
#define DUMMY_MFMA 0
#endif
__device__ __forceinline__ void dummy_exp(float x) { float d; for (int i = 0; i < DUMMY_EXP; ++i) asm volatile("v_exp_f32 %0, %1" : "=v"(d) : "v"(x)); }
__device__ __forceinline__ void expA(f32x16& p0) {
#pragma unroll
  for (int r = 0; r < 16; ++r) { dummy_exp(p0[r]); p0[r] = __builtin_amdgcn_exp2f(p0[r]); }
}
__device__ __forceinline__ void expB_sum_pack(f32x16& p0, f32x16& p1, float& l_reg, bf16x8& pa0, bf16x8& pa1, bf16x8& pa2, bf16x8& pa3) {
#pragma unroll
  for (int r = 0; r < 16; ++r) { dummy_exp(p1[r]); p1[r] = __builtin_amdgcn_exp2f(p1[r]); }
  float ps = 0;
#pragma unroll
  for (int r = 0; r < 16; ++r) ps += p0[r];
#pragma unroll
  for (int r = 0; r < 16; ++r) ps += p1[r];
  { auto rr = __builtin_amdgcn_permlane32_swap(__float_as_uint(ps), __float_as_uint(ps), false, false);
    ps = __uint_as_float(rr[0]) + __uint_as_float(rr[1]); }
  l_reg += ps;
#define PK4(P, BASE, OUT) do { unsigned a0 = cvtpk(P[BASE + 0], P[BASE + 1]), a1 = cvtpk(P[BASE + 2], P[BASE + 3]);   \
    unsigned b0 = cvtpk(P[BASE + 4], P[BASE + 5]), b1 = cvtpk(P[BASE + 6], P[BASE + 7]);                              \
    auto r0 = __builtin_amdgcn_permlane32_swap(a0, b0, false, false); auto r1 = __builtin_amdgcn_permlane32_swap(a1, b1, false, false); \
    u32x4 w = {r0[0], r1[0], r0[1], r1[1]}; OUT = *reinterpret_cast<bf16x8*>(&w); } while (0)
  PK4(p0, 0, pa0); PK4(p0, 8, pa1); PK4(p1, 0, pa2); PK4(p1, 8, pa3);
#undef PK4
}
__device__ __forceinline__ bf16x8 ld8(const bf16_t* p) { return *reinterpret_cast<const bf16x8*>(p); }

constexpr int TP = 132;
__device__ __forceinline__ void tile_to_rows(const f32x16 (&o)[4], LAS float* scr, int r32, int hi, float (&v)[64]) {
#pragma unroll
  for (int d0 = 0; d0 < 4; ++d0)
#pragma unroll
    for (int r = 0; r < 16; ++r) scr[crow(r, hi) * TP + 32 * d0 + r32] = o[d0][r];
  asm volatile("s_waitcnt lgkmcnt(0)" ::: "memory");
#pragma unroll
  for (int i = 0; i < 16; ++i) { const f32x4v t = *(const LAS f32x4v*)(scr + r32 * TP + 64 * hi + 4 * i); v[4 * i] = t[0]; v[4 * i + 1] = t[1]; v[4 * i + 2] = t[2]; v[4 * i + 3] = t[3]; }
}
__device__ __forceinline__ float pair_sum(float x) {
  auto rr = __builtin_amdgcn_permlane32_swap(__float_as_uint(x), __float_as_uint(x), false, false); return __uint_as_float(rr[0]) + __uint_as_float(rr[1]);
}


#define PVX_RD2(L0, H0, D0, KS) do { L0 = tr_read<v_rd_off(D0, KS, 0)>(vb); H0 = tr_read<v_rd_off(D0, KS, 1)>(vb); } while (0)
#define PVX_PK(L, H) (bf16x8){L[0], L[1], L[2], L[3], H[0], H[1], H[2], H[3]}
#define PVX_E(i) do { if (DOEXP) { pn[i] = __builtin_amdgcn_exp2f(pn[i]); psn += pn[i]; } } while (0)
#define PVX_W(n) asm volatile("s_waitcnt lgkmcnt(" #n ")" ::: "memory")
#define PVX_BLOCK(D0, E0) do { \
    PVX_W(6); SBAR(); o[D0] = __builtin_amdgcn_mfma_f32_32x32x16_bf16(pa0, PVX_PK(fl0, fh0), o[D0], 0, 0, 0); PVX_E(E0 + 0); PVX_RD2(fl0, fh0, D0 + 1, 0); SBAR(); \
    PVX_W(6); SBAR(); o[D0] = __builtin_amdgcn_mfma_f32_32x32x16_bf16(pa1, PVX_PK(fl1, fh1), o[D0], 0, 0, 0); PVX_E(E0 + 1); PVX_RD2(fl1, fh1, D0 + 1, 1); SBAR(); \
    PVX_W(6); SBAR(); o[D0] = __builtin_amdgcn_mfma_f32_32x32x16_bf16(pa2, PVX_PK(fl2, fh2), o[D0], 0, 0, 0); PVX_E(E0 + 2); PVX_RD2(fl2, fh2, D0 + 1, 2); SBAR(); \
    PVX_W(6); SBAR(); o[D0] = __builtin_amdgcn_mfma_f32_32x32x16_bf16(pa3, PVX_PK(fl3, fh3), o[D0], 0, 0, 0); PVX_E(E0 + 3); PVX_RD2(fl3, fh3, D0 + 1, 3); SBAR(); } while (0)
template <bool DOEXP>
__device__ __forceinline__ void pv_exp(f32x16* o, int vb, bf16x8 pa0, bf16x8 pa1, bf16x8 pa2, bf16x8 pa3, f32x16& pn, float& psn) {
  s16x4 fl0, fh0, fl1, fh1, fl2, fh2, fl3, fh3;
  asm volatile("s_waitcnt lgkmcnt(0)" ::: "memory");
  PVX_RD2(fl0, fh0, 0, 0); PVX_RD2(fl1, fh1, 0, 1); PVX_RD2(fl2, fh2, 0, 2); PVX_RD2(fl3, fh3, 0, 3);
  PVX_BLOCK(0, 0); PVX_BLOCK(1, 4); PVX_BLOCK(2, 8);
  PVX_W(6); SBAR(); o[3] = __builtin_amdgcn_mfma_f32_32x32x16_bf16(pa0, PVX_PK(fl0, fh0), o[3], 0, 0, 0); PVX_E(12); SBAR();
  PVX_W(4); SBAR(); o[3] = __builtin_amdgcn_mfma_f32_32x32x16_bf16(pa1, PVX_PK(fl1, fh1), o[3], 0, 0, 0); PVX_E(13); SBAR();
  PVX_W(2); SBAR(); o[3] = __builtin_amdgcn_mfma_f32_32x32x16_bf16(pa2, PVX_PK(fl2, fh2), o[3], 0, 0, 0); PVX_E(14); SBAR();
  PVX_W(0); SBAR(); o[3] = __builtin_amdgcn_mfma_f32_32x32x16_bf16(pa3, PVX_PK(fl3, fh3), o[3], 0, 0, 0); PVX_E(15); SBAR();
}
__device__ __forceinline__ void expB_sum_pack2(f32x16& p0, f32x16& p1, float ps, float& l_reg, bf16x8& pa0, bf16x8& pa1, bf16x8& pa2, bf16x8& pa3) {
#pragma unroll
  for (int r = 0; r < 16; ++r) { p1[r] = __builtin_amdgcn_exp2f(p1[r]); ps += p1[r]; }
  { auto rr = __builtin_amdgcn_permlane32_swap(__float_as_uint(ps), __float_as_uint(ps), false, false);
    ps = __uint_as_float(rr[0]) + __uint_as_float(rr[1]); }
  l_reg += ps;
#define PK4(P, BASE, OUT) do { unsigned a0 = cvtpk(P[BASE + 0], P[BASE + 1]), a1 = cvtpk(P[BASE + 2], P[BASE + 3]);   \
    unsigned b0 = cvtpk(P[BASE + 4], P[BASE + 5]), b1 = cvtpk(P[BASE + 6], P[BASE + 7]);                              \
    auto r0 = __builtin_amdgcn_permlane32_swap(a0, b0, false, false); auto r1 = __builtin_amdgcn_permlane32_swap(a1, b1, false, false); \
    u32x4 w = {r0[0], r1[0], r0[1], r1[1]}; OUT = *reinterpret_cast<bf16x8*>(&w); } while (0)
  PK4(p0, 0, pa0); PK4(p0, 8, pa1); PK4(p1, 0, pa2); PK4(p1, 8, pa3);
#undef PK4
}
__device__ __forceinline__ float exp_sum16(f32x16& p0) { float ps = 0.f;
#pragma unroll
  for (int r = 0; r < 16; ++r) { p0[r] = __builtin_amdgcn_exp2f(p0[r]); ps += p0[r]; }
  return ps; }

__device__ __forceinline__ void attn_unit(const int wid, const bf16_t* __restrict__ proj, const char* __restrict__ Kt_bh, const char* __restrict__ Vt_bh, bf16_t* __restrict__ concat, int qrow0, int NT, int h,
                                          LAS char* lds, float lam, float omli, const float* __restrict__ subln) {
  const int lane = lane_id(), tid = wid * 64 + lane, r32 = lane & 31, hi = lane >> 5, rg = wid & 3, c = wid >> 2;
  LAS char* V_lds = lds; LAS char* K_lds = lds + 4 * SHM_V;
  LAS float* li_l = (LAS float*)(lds + 4 * SHM_V + 4 * SHM_K) + wid * 64;
  float l_reg = 0; f32x16 o[4] = {}; bf16x8 qr[4];
  const bf16_t* Qw = proj + (size_t)(qrow0 + rg * 32 + r32) * DP + C_DQ + h * 128 + c * 64 + hi * 8;
#pragma unroll
  for (int d0 = 0; d0 < 4; ++d0) qr[d0] = ld8(Qw + d0 * 16);
  const int vb0 = (int)(uintptr_t)V_lds + v_rd_base(lane);
  const char* kg0 = Kt_bh + wid * 2048 + lane * 16; const char* vg0 = Vt_bh + wid * 2048 + lane * 16;
#define DMA_TILE(tile, slot) do { const size_t to_ = (size_t)(tile) * 16384; \
    __builtin_amdgcn_global_load_lds((const unsigned*)(kg0 + to_), (LAS unsigned*)(K_lds + (slot) * SHM_K + wid * 2048), 16, 0, 0); \
    __builtin_amdgcn_global_load_lds((const unsigned*)(kg0 + to_ + 1024), (LAS unsigned*)(K_lds + (slot) * SHM_K + wid * 2048 + 1024), 16, 0, 0); \
    __builtin_amdgcn_global_load_lds((const unsigned*)(vg0 + to_), (LAS unsigned*)(V_lds + (slot) * SHM_V + wid * 2048), 16, 0, 0); \
    __builtin_amdgcn_global_load_lds((const unsigned*)(vg0 + to_ + 1024), (LAS unsigned*)(V_lds + (slot) * SHM_V + wid * 2048 + 1024), 16, 0, 0); } while (0)
#define BAR() do { asm volatile("s_waitcnt vmcnt(0) lgkmcnt(0)" ::: "memory"); __builtin_amdgcn_s_barrier(); asm volatile("" ::: "memory"); } while (0)
#define STAGE(b) do { if ((b) + 3 < NT) DMA_TILE((b) + 3, ((b) + 3) & 3); } while (0)
#define STAGES(b, slot) do { if ((b) + 3 < NT) DMA_TILE((b) + 3, slot); } while (0)
#define QKT(P0, P1, t) qkt<4>(P0, P1, K_lds + ((t) & 3) * SHM_K, qr, r32, hi, 4 * c)
#define QKTS(P0, P1, slot) qkt<4>(P0, P1, K_lds + (slot) * SHM_K, qr, r32, hi, 4 * c)
#define PV(t) pv_d0(o, vb0 + ((t) & 3) * SHM_V, pa0, pa1, pa2, pa3)
  f32x16 pA0, pA1, pB0, pB1; bf16x8 pa0, pa1, pa2, pa3; float psA = 0.f, psB = 0.f;
#define PVE(t, PN, PSN) do { PSN = 0.f; pv_exp<true>(o, vb0 + ((t) & 3) * SHM_V, pa0, pa1, pa2, pa3, PN, PSN); } while (0)
#define PVES(slot, PN, PSN) do { PSN = 0.f; pv_exp<true>(o, vb0 + (slot) * SHM_V, pa0, pa1, pa2, pa3, PN, PSN); } while (0)
#define PVL(t) do { float d_ = 0.f; pv_exp<false>(o, vb0 + ((t) & 3) * SHM_V, pa0, pa1, pa2, pa3, pA0, d_); } while (0)
  DMA_TILE(0, 0); DMA_TILE(1, 1); DMA_TILE(2, 2);
  BAR();
  QKT(pA0, pA1, 0); psA = exp_sum16(pA0);
  for (int t = 0; t < NT; t += 4) {
    if (c == 0) { BAR(); STAGES(t, 3); } SBAR();
    QKTS(pB0, pB1, 1); expB_sum_pack2(pA0, pA1, psA, l_reg, pa0, pa1, pa2, pa3); SBAR();
    if (c == 1) { BAR(); STAGES(t, 3); } SBAR();
    PVES(0, pB0, psB); SBAR();
    if (c == 0) { BAR(); STAGES(t + 1, 0); } SBAR();
    QKTS(pA0, pA1, 2); expB_sum_pack2(pB0, pB1, psB, l_reg, pa0, pa1, pa2, pa3); SBAR();
    if (c == 1) { BAR(); STAGES(t + 1, 0); } SBAR();
    PVES(1, pA0, psA); SBAR();
    if (c == 0) { BAR(); STAGES(t + 2, 1); } SBAR();
    QKTS(pB0, pB1, 3); expB_sum_pack2(pA0, pA1, psA, l_reg, pa0, pa1, pa2, pa3); SBAR();
    if (c == 1) { BAR(); STAGES(t + 2, 1); } SBAR();
    PVES(2, pB0, psB); SBAR();
    if (c == 0) { BAR(); STAGES(t + 3, 2); } SBAR();
    if (t + 4 < NT) QKTS(pA0, pA1, 0);
    expB_sum_pack2(pB0, pB1, psB, l_reg, pa0, pa1, pa2, pa3); SBAR();
    if (c == 1) { BAR(); STAGES(t + 3, 2); } SBAR();
    PVES(3, pA0, psA);
    SBAR();
  }
#undef PVE
#undef PVES
#undef QKTS
#undef STAGES
#undef PVL
  if (hi == 0) li_l[r32] = l_reg; asm volatile("s_waitcnt lgkmcnt(0)" ::: "memory");
#pragma unroll
  for (int r = 0; r < 16; ++r) { const float rl = __builtin_amdgcn_rcpf(li_l[crow(r, hi)]);
#pragma unroll
    for (int d0 = 0; d0 < 4; ++d0) o[d0][r] *= rl; }
  __syncthreads();
  LAS float* xch = (LAS float*)lds + rg * 4096;
  if (c == 1) {
#pragma unroll
    for (int d0 = 0; d0 < 4; ++d0)
#pragma unroll
      for (int r = 0; r < 16; ++r) xch[(d0 * 16 + r) * 64 + lane] = o[d0][r];
  }
  __syncthreads();
  if (c == 0) {
#pragma unroll
    for (int r = 0; r < 16; ++r) { float s = 0.f;
#pragma unroll
      for (int d0 = 0; d0 < 4; ++d0) { const float d = o[d0][r] - lam * xch[(d0 * 16 + r) * 64 + lane]; o[d0][r] = d; s += d * d; }
      s += __shfl_xor(s, 1); s += __shfl_xor(s, 2); s += __shfl_xor(s, 4); s += __shfl_xor(s, 8); s += __shfl_xor(s, 16);
      const float rr = rsqrtf(s * (1.f / 128.f) + EPS) * omli;
      bf16_t* orow = concat + (size_t)(qrow0 + rg * 32 + crow(r, hi)) * DM + 512 + h * 128 + r32;
#pragma unroll
      for (int d0 = 0; d0 < 4; ++d0) orow[d0 * 32] = f2bf(o[d0][r] * rr * subln[d0 * 32 + r32]); }
  }
  __syncthreads();
#undef DMA_TILE
#undef BAR
#undef STAGE
#undef QKT
#undef PV
}


typedef float f32x2 __attribute__((ext_vector_type(2)));
__device__ __forceinline__ void exp_half(f32x16& ph, f32x2& lacc) {
#if EXP_TREE
  f32x2 e[8];
#pragma unroll
  for (int r = 0; r < 16; r += 2) { ph[r] = __builtin_amdgcn_exp2f(ph[r]); ph[r + 1] = __builtin_amdgcn_exp2f(ph[r + 1]); e[r >> 1] = f32x2{ph[r], ph[r + 1]}; }
  lacc += ((e[0] + e[1]) + (e[2] + e[3])) + ((e[4] + e[5]) + (e[6] + e[7]));
#else
#pragma unroll
  for (int r = 0; r < 16; r += 2) { ph[r] = __builtin_amdgcn_exp2f(ph[r]); ph[r + 1] = __builtin_amdgcn_exp2f(ph[r + 1]); const f32x2 e = {ph[r], ph[r + 1]}; lacc += e; }
#endif
}
__device__ __forceinline__ void pack_half(const f32x16& ph, bf16x8& x0, bf16x8& x1) {
  { u32x4 w = {cvtpk(ph[0], ph[1]), cvtpk(ph[2], ph[3]), cvtpk(ph[4], ph[5]), cvtpk(ph[6], ph[7])}; x0 = *reinterpret_cast<bf16x8*>(&w); }
  { u32x4 w = {cvtpk(ph[8], ph[9]), cvtpk(ph[10], ph[11]), cvtpk(ph[12], ph[13]), cvtpk(ph[14], ph[15])}; x1 = *reinterpret_cast<bf16x8*>(&w); }
}

template <int D0> __device__ __forceinline__ void pv2_block(f32x16& oa, f32x16& ob, int vb, s16x4& fl0, s16x4& fh0, s16x4& fl1, s16x4& fh1, s16x4& fl2, s16x4& fh2, s16x4& fl3, s16x4& fh3,
                                                           bf16x8 a0, bf16x8 a1, bf16x8 a2, bf16x8 a3, bf16x8 b0, bf16x8 b1, bf16x8 b2, bf16x8 b3) {
#define PV2_STEP(A, B, FL, FH, KS, WN) do { asm volatile("s_waitcnt lgkmcnt(" #WN ")" ::: "memory"); SBAR(); \
    oa = __builtin_amdgcn_mfma_f32_32x32x16_bf16(A, PVX_PK(FL, FH), oa, 0, 0, 0); ob = __builtin_amdgcn_mfma_f32_32x32x16_bf16(B, PVX_PK(FL, FH), ob, 0, 0, 0); \
    if (D0 < 3) { FL = tr_read<v_rd_off((D0 + 1) & 3, KS, 0)>(vb); FH = tr_read<v_rd_off((D0 + 1) & 3, KS, 1)>(vb); } SBAR(); } while (0)
  if (D0 < 3) { PV2_STEP(a0, b0, fl0, fh0, 0, 6); PV2_STEP(a1, b1, fl1, fh1, 1, 6); PV2_STEP(a2, b2, fl2, fh2, 2, 6); PV2_STEP(a3, b3, fl3, fh3, 3, 6); }
  else        { PV2_STEP(a0, b0, fl0, fh0, 0, 6); PV2_STEP(a1, b1, fl1, fh1, 1, 4); PV2_STEP(a2, b2, fl2, fh2, 2, 2); PV2_STEP(a3, b3, fl3, fh3, 3, 0); }
#undef PV2_STEP
}
__device__ __forceinline__ void attn_unit3p(const int wid, const bf16_t* __restrict__ proj, const char* __restrict__ Kt_bh, const char* __restrict__ Vt_bh, bf16_t* __restrict__ concat, int qrow0, int NT, int h,
                                            LAS char* lds, float lam, float omli, const float* __restrict__ subln) {
  const int lane = lane_id(), r32 = lane & 31, hi = lane >> 5;
  LAS char* V_lds = lds; LAS char* K_lds = lds + 2 * SHM_V; LAS char* Qw = lds + 65536 + wid * 8192;
  LAS float* li_l = (LAS float*)(lds + 131072) + wid * 64;
  f32x2 l0v = {0.f, 0.f}, l1v = {0.f, 0.f}; f32x16 o0[4] = {}, o1[4] = {};
  const int vb0 = (int)(uintptr_t)V_lds + v_rd_base(lane);
  const char* kg0 = Kt_bh + wid * 2048 + lane * 16; const char* vg0 = Vt_bh + wid * 2048 + lane * 16;
#define DMA_TILE(tile, slot) do { const size_t to_ = (size_t)(tile) * 16384; \
    __builtin_amdgcn_global_load_lds((const unsigned*)(kg0 + to_), (LAS unsigned*)(K_lds + (slot) * SHM_K + wid * 2048), 16, 0, 0); \
    __builtin_amdgcn_global_load_lds((const unsigned*)(kg0 + to_ + 1024), (LAS unsigned*)(K_lds + (slot) * SHM_K + wid * 2048 + 1024), 16, 0, 0); \
    __builtin_amdgcn_global_load_lds((const unsigned*)(vg0 + to_), (LAS unsigned*)(V_lds + (slot) * SHM_V + wid * 2048), 16, 0, 0); \
    __builtin_amdgcn_global_load_lds((const unsigned*)(vg0 + to_ + 1024), (LAS unsigned*)(V_lds + (slot) * SHM_V + wid * 2048 + 1024), 16, 0, 0); } while (0)
#define BAR() do { asm volatile("s_waitcnt vmcnt(0) lgkmcnt(0)" ::: "memory"); __builtin_amdgcn_s_barrier(); asm volatile("" ::: "memory"); } while (0)
  bf16x8 qf00, qf01, qf02, qf03, qf10, qf11, qf12, qf13;
  { const bf16_t* qg = proj + (size_t)(qrow0 + wid * 32 + r32) * DP + C_DQ + h * 128 + hi * 8;
    qf00 = ld8(qg); qf01 = ld8(qg + 16); qf02 = ld8(qg + 32); qf03 = ld8(qg + 48); qf10 = ld8(qg + 64); qf11 = ld8(qg + 80); qf12 = ld8(qg + 96); qf13 = ld8(qg + 112); }
  DMA_TILE(0, 0);
  bf16x8 a0, a1, a2, a3, b0, b1, b2, b3;
  int sw0 = KSWZ(r32, (0 * 16 + hi * 8) * 2), sw1 = KSWZ(r32, (1 * 16 + hi * 8) * 2), sw2 = KSWZ(r32, (2 * 16 + hi * 8) * 2), sw3 = KSWZ(r32, (3 * 16 + hi * 8) * 2);
  int kad0_ = (int)(uintptr_t)K_lds + sw0, kad1_ = (int)(uintptr_t)K_lds + sw1, kad2_ = (int)(uintptr_t)K_lds + sw2, kad3_ = (int)(uintptr_t)K_lds + sw3;
  asm volatile("" : "+v"(kad0_), "+v"(kad1_), "+v"(kad2_), "+v"(kad3_));
  LAS char* const kad0 = (LAS char*)(uintptr_t)kad0_; LAS char* const kad1 = (LAS char*)(uintptr_t)kad1_; LAS char* const kad2 = (LAS char*)(uintptr_t)kad2_; LAS char* const kad3 = (LAS char*)(uintptr_t)kad3_;
#define QK2(P0, P1, so, cc) do { P0 = f32x16{}; P1 = f32x16{}; _Pragma("unroll") for (int d0 = 0; d0 < 4; ++d0) { const int cb = ((4 * (cc) + d0) * 16 + hi * 8) * 2; \
    const bf16x8 ka_ = *reinterpret_cast<const LAS bf16x8*>(K_lds + (so) * SHM_K + KSWZ(r32, cb)), kb_ = *reinterpret_cast<const LAS bf16x8*>(K_lds + (so) * SHM_K + KSWZ(32 + r32, cb)); \
    const bf16x8 q_ = *reinterpret_cast<const LAS bf16x8*>(Qw + KSWZ(r32, cb)); \
    P0 = __builtin_amdgcn_mfma_f32_32x32x16_bf16(ka_, q_, P0, 0, 0, 0); P1 = __builtin_amdgcn_mfma_f32_32x32x16_bf16(kb_, q_, P1, 0, 0, 0); } } while (0)
#define QKA(PH, so, cc, koff) do { PH = f32x16{}; \
    { const bf16x8 k_ = *reinterpret_cast<const LAS bf16x8*>(kad0 + ((so) * SHM_K + (koff) * 256 + 128 * (cc))); PH = __builtin_amdgcn_mfma_f32_32x32x16_bf16(k_, (cc) ? qf10 : qf00, PH, 0, 0, 0); } \
    { const bf16x8 k_ = *reinterpret_cast<const LAS bf16x8*>(kad1 + ((so) * SHM_K + (koff) * 256 + 128 * (cc))); PH = __builtin_amdgcn_mfma_f32_32x32x16_bf16(k_, (cc) ? qf11 : qf01, PH, 0, 0, 0); } } while (0)
#define QKB(PH, so, cc, koff) do { \
    { const bf16x8 k_ = *reinterpret_cast<const LAS bf16x8*>(kad2 + ((so) * SHM_K + (koff) * 256 + 128 * (cc))); PH = __builtin_amdgcn_mfma_f32_32x32x16_bf16(k_, (cc) ? qf12 : qf02, PH, 0, 0, 0); } \
    { const bf16x8 k_ = *reinterpret_cast<const LAS bf16x8*>(kad3 + ((so) * SHM_K + (koff) * 256 + 128 * (cc))); PH = __builtin_amdgcn_mfma_f32_32x32x16_bf16(k_, (cc) ? qf13 : qf03, PH, 0, 0, 0); } } while (0)
#define QKH(PH, so, cc, koff) do { QKA(PH, so, cc, koff); QKB(PH, so, cc, koff); } while (0)
#define SGB(m, n) __builtin_amdgcn_sched_group_barrier(m, n, 0)
#define STEP(PN, so, cc, koff, PO, LV, X0, X1) do { \
    QKA(PN, so, cc, koff); exp_half(PO, LV); SGB(0x100, 2); SGB(0x8, 1); SGB(0x2, 12); SGB(0x8, 1); SGB(0x2, 12); SBAR(); asm volatile("" : "+v"(LV)); SBAR(); \
    QKB(PN, so, cc, koff); pack_half(PO, X0, X1); SGB(0x100, 2); SGB(0x8, 1); SGB(0x2, 4); SGB(0x8, 1); SGB(0x2, 4); MBAR(PN); } while (0)
#define MBAR(X) do { SBAR(); asm volatile("" : "+v"(X) :: "memory"); SBAR(); } while (0)
#define TILE(t, so) do { BAR(); if ((t) + 1 < NT) DMA_TILE((t) + 1, 1 - (so)); SBAR(); \
    { f32x16 p0, p1; \
      QKH(p0, so, 0, 0); MBAR(p0); \
      STEP(p1, so, 0, 32, p0, l0v, a0, a1); \
      STEP(p0, so, 1, 0, p1, l0v, a2, a3); \
      STEP(p1, so, 1, 32, p0, l1v, b0, b1); \
      exp_half(p1, l1v); SBAR(); asm volatile("" : "+v"(l1v)); SBAR(); pack_half(p1, b2, b3); } SBAR(); \
    { const int vb = vb0 + (so) * SHM_V; s16x4 fl0, fh0, fl1, fh1, fl2, fh2, fl3, fh3; \
      asm volatile("s_waitcnt lgkmcnt(0)" ::: "memory"); \
      PVX_RD2(fl0, fh0, 0, 0); PVX_RD2(fl1, fh1, 0, 1); PVX_RD2(fl2, fh2, 0, 2); PVX_RD2(fl3, fh3, 0, 3); \
      pv2_block<0>(o0[0], o1[0], vb, fl0, fh0, fl1, fh1, fl2, fh2, fl3, fh3, a0, a1, a2, a3, b0, b1, b2, b3); \
      pv2_block<1>(o0[1], o1[1], vb, fl0, fh0, fl1, fh1, fl2, fh2, fl3, fh3, a0, a1, a2, a3, b0, b1, b2, b3); \
      pv2_block<2>(o0[2], o1[2], vb, fl0, fh0, fl1, fh1, fl2, fh2, fl3, fh3, a0, a1, a2, a3, b0, b1, b2, b3); \
      pv2_block<3>(o0[3], o1[3], vb, fl0, fh0, fl1, fh1, fl2, fh2, fl3, fh3, a0, a1, a2, a3, b0, b1, b2, b3); } SBAR(); } while (0)
  for (int t = 0; t < NT; t += 2) { TILE(t, 0); TILE(t + 1, 1); }
  const float l0 = pair_sum(l0v[0] + l0v[1]), l1 = pair_sum(l1v[0] + l1v[1]);
  if (hi == 0) { li_l[r32] = l0; li_l[32 + r32] = l1; } asm volatile("s_waitcnt lgkmcnt(0)" ::: "memory");
#pragma unroll
  for (int r = 0; r < 16; ++r) { const float ra = __builtin_amdgcn_rcpf(li_l[crow(r, hi)]), rb = lam * __builtin_amdgcn_rcpf(li_l[32 + crow(r, hi)]);
    float s = 0.f;
#pragma unroll
    for (int d0 = 0; d0 < 4; ++d0) { const float d = o0[d0][r] * ra - o1[d0][r] * rb; o0[d0][r] = d; s += d * d; }
    s += __shfl_xor(s, 1); s += __shfl_xor(s, 2); s += __shfl_xor(s, 4); s += __shfl_xor(s, 8); s += __shfl_xor(s, 16);
    const float rr = rsqrtf(s * (1.f / 128.f) + EPS) * omli;
    bf16_t* orow = concat + (size_t)(qrow0 + wid * 32 + crow(r, hi)) * DM + 512 + h * 128 + r32;
#pragma unroll
    for (int d0 = 0; d0 < 4; ++d0) orow[d0 * 32] = f2bf(o0[d0][r] * rr * subln[d0 * 32 + r32]); }
  asm volatile("s_waitcnt vmcnt(0) lgkmcnt(0)" ::: "memory"); __syncthreads();
#undef DMA_TILE
#undef BAR
#undef QK2
#undef QKH
#undef QKA
#undef QKB
#undef TILE
#undef STEP
#undef MBAR
#undef SGB
}

#ifndef EXP_TREE
#define EXP_TREE 1
#endif
#ifndef ATT_PRIO
#define ATT_PRIO 1
#endif
template <int OFF> __device__ __forceinline__ bf16x8 ldsb128(int addr) { bf16x8 r; asm volatile("ds_read_b128 %0, %1 offset:%2" : "=&v"(r) : "v"(addr), "i"(OFF) : "memory"); return r; }
constexpr int vt_rd_off(int so, int d0, int ks) { return so * 16384 + d0 * 4096 + (ks >> 1) * 64; }
template <int SO, int D0> __device__ __forceinline__ void pvt_block(f32x16& oa, f32x16& ob, int va0, int va1, bf16x8& f0, bf16x8& f1, bf16x8& f2, bf16x8& f3,
                                                                   bf16x8 a0, bf16x8 a1, bf16x8 a2, bf16x8 a3, bf16x8 b0, bf16x8 b1, bf16x8 b2, bf16x8 b3) {
#define PVT_STEP(A, B, F, KS, WN) do { asm volatile("s_waitcnt lgkmcnt(" #WN ")" ::: "memory"); SBAR(); \
    oa = __builtin_amdgcn_mfma_f32_32x32x16_bf16(A, F, oa, 0, 0, 0); ob = __builtin_amdgcn_mfma_f32_32x32x16_bf16(B, F, ob, 0, 0, 0); \
    if (D0 < 3) F = ldsb128<vt_rd_off(SO, (D0 + 1) & 3, KS)>((KS & 1) ? va1 : va0); SBAR(); } while (0)
  if (D0 < 3) { PVT_STEP(a0, b0, f0, 0, 3); PVT_STEP(a1, b1, f1, 1, 3); PVT_STEP(a2, b2, f2, 2, 3); PVT_STEP(a3, b3, f3, 3, 3); }
  else        { PVT_STEP(a0, b0, f0, 0, 3); PVT_STEP(a1, b1, f1, 1, 2); PVT_STEP(a2, b2, f2, 2, 1); PVT_STEP(a3, b3, f3, 3, 0); }
#undef PVT_STEP
}
__device__ __forceinline__ void exp_only(f32x16& ph) {
#pragma unroll
  for (int r = 0; r < 16; ++r) ph[r] = __builtin_amdgcn_exp2f(ph[r]);
}
__device__ __forceinline__ void dot_ones(float& la, float& lb, bf16x8 x) {
  const u32x4 w = *reinterpret_cast<const u32x4*>(&x); const unsigned ones = 0x3F803F80u;
  asm volatile("v_dot2_f32_bf16 %0, %1, %2, %0" : "+v"(la) : "v"(w[0]), "v"(ones));
  asm volatile("v_dot2_f32_bf16 %0, %1, %2, %0" : "+v"(lb) : "v"(w[1]), "v"(ones));
  asm volatile("v_dot2_f32_bf16 %0, %1, %2, %0" : "+v"(la) : "v"(w[2]), "v"(ones));
  asm volatile("v_dot2_f32_bf16 %0, %1, %2, %0" : "+v"(lb) : "v"(w[3]), "v"(ones));
}
__device__ __forceinline__ void attn_unit3q(const int wid, const bf16_t* __restrict__ proj, const char* __restrict__ Kt_bh, const char* __restrict__ Vt_bh, bf16_t* __restrict__ concat, int qrow0, int NT, int h,
                                            LAS char* lds, float lam, float omli, const float* __restrict__ subln) {
  const int lane = lane_id(), r32 = lane & 31, hi = lane >> 5, rg = wid & 3, c = wid >> 2;
  LAS char* V_lds = lds; LAS char* K_lds = lds + 2 * SHM_V;
  LAS float* li_l = (LAS float*)(lds + 131072) + wid * 64;
  float l0a = 0.f, l0b = 0.f, l1a = 0.f, l1b = 0.f; f32x16 o0[4] = {}, o1[4] = {};
  int va0 = (int)(uintptr_t)V_lds + r32 * 128 + ((hi ^ ((r32 >> 1) & 3)) << 4), va1 = (int)(uintptr_t)V_lds + r32 * 128 + (((2 + hi) ^ ((r32 >> 1) & 3)) << 4);
  asm volatile("" : "+v"(va0), "+v"(va1));
  const char* kg0 = Kt_bh + wid * 2048 + lane * 16; const char* vg0 = Vt_bh + wid * 2048 + lane * 16;
#define DMA_TILE(tile, slot) do { const size_t to_ = (size_t)(tile) * 16384; \
    __builtin_amdgcn_global_load_lds((const unsigned*)(kg0 + to_), (LAS unsigned*)(K_lds + (slot) * SHM_K + wid * 2048), 16, 0, 0); \
    __builtin_amdgcn_global_load_lds((const unsigned*)(kg0 + to_ + 1024), (LAS unsigned*)(K_lds + (slot) * SHM_K + wid * 2048 + 1024), 16, 0, 0); \
    __builtin_amdgcn_global_load_lds((const unsigned*)(vg0 + to_), (LAS unsigned*)(V_lds + (slot) * SHM_V + wid * 2048), 16, 0, 0); \
    __builtin_amdgcn_global_load_lds((const unsigned*)(vg0 + to_ + 1024), (LAS unsigned*)(V_lds + (slot) * SHM_V + wid * 2048 + 1024), 16, 0, 0); } while (0)
#define BAR() do { asm volatile("s_waitcnt vmcnt(0) lgkmcnt(0)" ::: "memory"); __builtin_amdgcn_s_barrier(); asm volatile("" ::: "memory"); } while (0)
  bf16x8 qf00, qf01, qf02, qf03, qf10, qf11, qf12, qf13;
  { const bf16_t* qg = proj + (size_t)(qrow0 + rg * 64 + r32) * DP + C_DQ + h * 128 + c * 64 + hi * 8;
    qf00 = ld8(qg); qf01 = ld8(qg + 16); qf02 = ld8(qg + 32); qf03 = ld8(qg + 48); qg += (size_t)32 * DP;
    qf10 = ld8(qg); qf11 = ld8(qg + 16); qf12 = ld8(qg + 32); qf13 = ld8(qg + 48); }
  DMA_TILE(0, 0);
  bf16x8 a0, a1, a2, a3, b0, b1, b2, b3;
  int kad0_ = (int)(uintptr_t)K_lds + KSWZ(r32, (0 * 16 + hi * 8) * 2) + 128 * c, kad1_ = (int)(uintptr_t)K_lds + KSWZ(r32, (1 * 16 + hi * 8) * 2) + 128 * c;
  int kad2_ = (int)(uintptr_t)K_lds + KSWZ(r32, (2 * 16 + hi * 8) * 2) + 128 * c, kad3_ = (int)(uintptr_t)K_lds + KSWZ(r32, (3 * 16 + hi * 8) * 2) + 128 * c;
  asm volatile("" : "+v"(kad0_), "+v"(kad1_), "+v"(kad2_), "+v"(kad3_));
  LAS char* const kad0 = (LAS char*)(uintptr_t)kad0_; LAS char* const kad1 = (LAS char*)(uintptr_t)kad1_; LAS char* const kad2 = (LAS char*)(uintptr_t)kad2_; LAS char* const kad3 = (LAS char*)(uintptr_t)kad3_;
#define QKA(PH, so, rb, koff, LK) do { PH = f32x16{}; \
    { if (LK) kf0 = *reinterpret_cast<const LAS bf16x8*>(kad0 + ((so) * SHM_K + (koff) * 256)); PH = __builtin_amdgcn_mfma_f32_32x32x16_bf16(kf0, (rb) ? qf10 : qf00, PH, 0, 0, 0); } \
    { if (LK) kf1 = *reinterpret_cast<const LAS bf16x8*>(kad1 + ((so) * SHM_K + (koff) * 256)); PH = __builtin_amdgcn_mfma_f32_32x32x16_bf16(kf1, (rb) ? qf11 : qf01, PH, 0, 0, 0); } } while (0)
#define QKB(PH, so, rb, koff, LK) do { \
    { if (LK) kf2 = *reinterpret_cast<const LAS bf16x8*>(kad2 + ((so) * SHM_K + (koff) * 256)); PH = __builtin_amdgcn_mfma_f32_32x32x16_bf16(kf2, (rb) ? qf12 : qf02, PH, 0, 0, 0); } \
    { if (LK) kf3 = *reinterpret_cast<const LAS bf16x8*>(kad3 + ((so) * SHM_K + (koff) * 256)); PH = __builtin_amdgcn_mfma_f32_32x32x16_bf16(kf3, (rb) ? qf13 : qf03, PH, 0, 0, 0); } } while (0)
#define SGB(m, n) __builtin_amdgcn_sched_group_barrier(m, n, 0)
#define MBAR(X) do { SBAR(); asm volatile("" : "+v"(X) :: "memory"); SBAR(); } while (0)
#define STEP(PN, so, rb, koff, LK, PO, X0, X1) do { \
    QKA(PN, so, rb, koff, LK); exp_only(PO); if (LK) SGB(0x100, 2); SGB(0x8, 1); SGB(0x2, 8); SGB(0x8, 1); SGB(0x2, 8); SBAR(); \
    QKB(PN, so, rb, koff, LK); pack_half(PO, X0, X1); if (LK) SGB(0x100, 2); SGB(0x8, 1); SGB(0x2, 4); SGB(0x8, 1); SGB(0x2, 4); MBAR(PN); } while (0)
#define PVS(OA, OB, A, B, F, WN, so, ND0, NKS) do { asm volatile("s_waitcnt lgkmcnt(" #WN ")" ::: "memory"); SBAR(); \
    OA = __builtin_amdgcn_mfma_f32_32x32x16_bf16(A, F, OA, 0, 0, 0); OB = __builtin_amdgcn_mfma_f32_32x32x16_bf16(B, F, OB, 0, 0, 0); \
    if ((ND0) >= 0) F = ldsb128<vt_rd_off(so, (ND0) < 0 ? 0 : (ND0), NKS)>(((NKS) & 1) ? va1 : va0); SBAR(); } while (0)
#define EXQ(PH, R0) do { PH[(R0)] = __builtin_amdgcn_exp2f(PH[(R0)]); PH[(R0) + 1] = __builtin_amdgcn_exp2f(PH[(R0) + 1]); PH[(R0) + 2] = __builtin_amdgcn_exp2f(PH[(R0) + 2]); PH[(R0) + 3] = __builtin_amdgcn_exp2f(PH[(R0) + 3]); SBAR(); } while (0)
#define DOT(LA, LB, X) do { dot_ones(LA, LB, X); SBAR(); } while (0)
#define PKQ(PH, R0, X) do { u32x4 w_ = {cvtpk(PH[(R0)], PH[(R0) + 1]), cvtpk(PH[(R0) + 2], PH[(R0) + 3]), cvtpk(PH[(R0) + 4], PH[(R0) + 5]), cvtpk(PH[(R0) + 6], PH[(R0) + 7])}; X = *reinterpret_cast<bf16x8*>(&w_); SBAR(); } while (0)
#define TILE(t, so) do { BAR(); if ((t) + 1 < NT) DMA_TILE((t) + 1, 1 - (so)); SBAR(); \
    bf16x8 vf0, vf1, vf2, vf3; \
    { f32x16 p0, p1; bf16x8 kf0, kf1, kf2, kf3; \
      QKA(p0, so, 0, 0, 1); QKB(p0, so, 0, 0, 1); MBAR(p0); \
      STEP(p1, so, 1, 0, 0, p0, a0, a1); \
      STEP(p0, so, 0, 32, 1, p1, b0, b1); \
      STEP(p1, so, 1, 32, 0, p0, a2, a3); \
      SBAR(); vf0 = ldsb128<vt_rd_off(so, 0, 0)>(va0); vf1 = ldsb128<vt_rd_off(so, 0, 1)>(va1); vf2 = ldsb128<vt_rd_off(so, 1, 0)>(va0); vf3 = ldsb128<vt_rd_off(so, 1, 1)>(va1); SBAR(); \
        \
        \
      PVS(o0[0], o1[0], a0, b0, vf0, 3, so, 2, 0); EXQ(p1, 0); \
      PVS(o0[0], o1[0], a1, b1, vf1, 3, so, 2, 1); EXQ(p1, 4); \
      PVS(o0[1], o1[1], a0, b0, vf2, 3, so, 3, 0); EXQ(p1, 8); \
      PVS(o0[1], o1[1], a1, b1, vf3, 3, so, 3, 1); EXQ(p1, 12); \
      PVS(o0[2], o1[2], a0, b0, vf0, 3, so, 0, 2); PKQ(p1, 0, b2); \
      PVS(o0[2], o1[2], a1, b1, vf1, 3, so, 0, 3); PKQ(p1, 8, b3); \
      PVS(o0[3], o1[3], a0, b0, vf2, 3, so, 1, 2); DOT(l0a, l0b, a0); DOT(l1a, l1b, b0); \
      PVS(o0[3], o1[3], a1, b1, vf3, 3, so, 1, 3); DOT(l0a, l0b, a1); DOT(l1a, l1b, b1); } SBAR(); \
    { \
      PVS(o0[0], o1[0], a2, b2, vf0, 3, so, 2, 2); DOT(l0a, l0b, a2); PVS(o0[0], o1[0], a3, b3, vf1, 3, so, 2, 3); DOT(l0a, l0b, a3); \
      PVS(o0[1], o1[1], a2, b2, vf2, 3, so, 3, 2); DOT(l1a, l1b, b2); PVS(o0[1], o1[1], a3, b3, vf3, 3, so, 3, 3); DOT(l1a, l1b, b3); \
      PVS(o0[2], o1[2], a2, b2, vf0, 3, so, -1, 0); PVS(o0[2], o1[2], a3, b3, vf1, 2, so, -1, 0); \
      PVS(o0[3], o1[3], a2, b2, vf2, 1, so, -1, 0); PVS(o0[3], o1[3], a3, b3, vf3, 0, so, -1, 0); } SBAR(); } while (0)
#if ATT_PRIO
  if (wid >= 4) __builtin_amdgcn_s_setprio(1);
#endif
  for (int t = 0; t < NT; t += 2) { TILE(t, 0); TILE(t + 1, 1); }
#if ATT_PRIO
  __builtin_amdgcn_s_setprio(0);
#endif
  const float l0 = pair_sum(l0a + l0b), l1 = pair_sum(l1a + l1b);
  if (hi == 0) { li_l[r32] = l0; li_l[32 + r32] = l1; }
  asm volatile("s_waitcnt vmcnt(0) lgkmcnt(0)" ::: "memory"); __syncthreads();
  LAS float* xw = (LAS float*)(lds + (rg * 2 + c) * 16384) + lane; const LAS float* xr = (const LAS float*)(lds + (rg * 2 + (1 - c)) * 16384) + lane;
  const float sgn = c ? lam : 1.f;
#define SEND(OX, LOFF) do { _Pragma("unroll") for (int r = 0; r < 16; ++r) { const float rl = sgn * __builtin_amdgcn_rcpf(li_l[(LOFF) + crow(r, hi)]); \
    _Pragma("unroll") for (int d0 = 0; d0 < 4; ++d0) xw[(d0 * 16 + r) * 64] = OX[d0][r] * rl; } } while (0)
  if (c == 0) SEND(o1, 32); else SEND(o0, 0);
  asm volatile("s_waitcnt lgkmcnt(0)" ::: "memory"); __syncthreads();
#define FINISH(OX, LOFF, RB) do { _Pragma("unroll") for (int r = 0; r < 16; ++r) { const float rl = sgn * __builtin_amdgcn_rcpf(li_l[(LOFF) + crow(r, hi)]); float s = 0.f; \
    _Pragma("unroll") for (int d0 = 0; d0 < 4; ++d0) { const float own = OX[d0][r] * rl, oth = xr[(d0 * 16 + r) * 64]; const float d = c ? oth - own : own - oth; OX[d0][r] = d; s += d * d; } \
    s += __shfl_xor(s, 1); s += __shfl_xor(s, 2); s += __shfl_xor(s, 4); s += __shfl_xor(s, 8); s += __shfl_xor(s, 16); \
    const float rr = rsqrtf(s * (1.f / 128.f) + EPS) * omli; \
    bf16_t* orow = concat + (size_t)(qrow0 + rg * 64 + (RB) * 32 + crow(r, hi)) * DM + 512 + h * 128 + r32; \
    _Pragma("unroll") for (int d0 = 0; d0 < 4; ++d0) orow[d0 * 32] = f2bf(OX[d0][r] * rr * subln[d0 * 32 + r32]); } } while (0)
  if (c == 0) FINISH(o0, 0, 0); else FINISH(o1, 32, 1);
  asm volatile("s_waitcnt vmcnt(0) lgkmcnt(0)" ::: "memory"); __syncthreads();
#undef SEND
#undef FINISH
#undef DMA_TILE
#undef BAR
#undef QKA
#undef QKB
#undef TILE
#undef PVS
#undef EXQ
#undef DOT
#undef PKQ
#undef STEP
#undef MBAR
#undef SGB
}

__device__ __forceinline__ bf16x8 scale8(bf16x8 v, float s) {
  u32x4 w;
#pragma unroll
  for (int i = 0; i < 4; ++i) { const float a = __uint_as_float(((unsigned)(unsigned short)v[2 * i]) << 16) * s, b = __uint_as_float(((unsigned)(unsigned short)v[2 * i + 1]) << 16) * s; w[i] = cvtpk(a, b); }
  return *reinterpret_cast<bf16x8*>(&w);
}
template <int KS> __device__ __forceinline__ void trfrag_issue(int vb, s16x4& l, s16x4& h) { l = tr_read<v_rd_off(0, KS, 0)>(vb); h = tr_read<v_rd_off(0, KS, 1)>(vb); }
#define PKF(L, H) (bf16x8){L[0], L[1], L[2], L[3], H[0], H[1], H[2], H[3]}
template <int KS> __device__ __forceinline__ void cs_step(f32x16* acc, int kb, int vv) {
  s16x4 al, ah, b0l, b0h, b1l, b1h, b2l, b2h, b3l, b3h;
  trfrag_issue<KS>(kb, al, ah); trfrag_issue<KS>(vv, b0l, b0h); trfrag_issue<KS>(vv + 512, b1l, b1h); trfrag_issue<KS>(vv + 1024, b2l, b2h); trfrag_issue<KS>(vv + 1536, b3l, b3h);
  asm volatile("s_waitcnt lgkmcnt(0)" ::: "memory"); SBAR();
  const bf16x8 a = PKF(al, ah);
  acc[0] = __builtin_amdgcn_mfma_f32_32x32x16_bf16(a, PKF(b0l, b0h), acc[0], 0, 0, 0);
  acc[1] = __builtin_amdgcn_mfma_f32_32x32x16_bf16(a, PKF(b1l, b1h), acc[1], 0, 0, 0);
  acc[2] = __builtin_amdgcn_mfma_f32_32x32x16_bf16(a, PKF(b2l, b2h), acc[2], 0, 0, 0);
  acc[3] = __builtin_amdgcn_mfma_f32_32x32x16_bf16(a, PKF(b3l, b3h), acc[3], 0, 0, 0);
}
__device__ __forceinline__ void chunk_state_unit(const int wid, const bf16_t* __restrict__ proj, bf16_t* __restrict__ csf, bf16_t* __restrict__ csb, int rowbase, int h, float lgf2, float lgb2, LAS char* lds) {
  const int lane = lane_id(), tid = wid * 64 + lane, r32 = lane & 31, hi = lane >> 5;
  const int sr = tid >> 4, sc = (tid & 15) * 8;
  { bf16x8 kv[4], vv[4];
#pragma unroll
    for (int g = 0; g < 4; ++g) { const bf16_t* rp = proj + (size_t)(rowbase + 32 * g + sr) * DP + h * 128 + sc; kv[g] = ld8(rp + C_RK); vv[g] = ld8(rp + C_RV); }
#pragma unroll
    for (int g = 0; g < 4; ++g) { const int row = 32 * g + sr;
      const float wf = __builtin_amdgcn_exp2f(lgf2 * (float)(127 - row)), wb = __builtin_amdgcn_exp2f(lgb2 * (float)row);
      const int off = (row >> 6) * 16384 + v_st(row & 63, sc);
      *(LAS bf16x8*)(lds + off) = vv[g]; *(LAS bf16x8*)(lds + 32768 + off) = scale8(kv[g], wf); *(LAS bf16x8*)(lds + 65536 + off) = scale8(kv[g], wb); } }
  __syncthreads();
  const int dir = wid >> 2, ib = wid & 3;
  const int vbK = (int)(uintptr_t)(lds + 32768 + dir * 32768) + v_rd_base(lane) + ib * 512, vbV = (int)(uintptr_t)lds + v_rd_base(lane);
  f32x16 acc[4] = {};
  cs_step<0>(acc, vbK, vbV); cs_step<1>(acc, vbK, vbV); cs_step<2>(acc, vbK, vbV); cs_step<3>(acc, vbK, vbV);
  cs_step<0>(acc, vbK + 16384, vbV + 16384); cs_step<1>(acc, vbK + 16384, vbV + 16384); cs_step<2>(acc, vbK + 16384, vbV + 16384); cs_step<3>(acc, vbK + 16384, vbV + 16384);
  bf16_t* outp = (dir ? csb : csf) + r32;
#pragma unroll
  for (int r = 0; r < 16; ++r) { bf16_t* orow = outp + (size_t)(32 * ib + crow(r, hi)) * 128;
#pragma unroll
    for (int jb = 0; jb < 4; ++jb) orow[32 * jb] = f2bf(acc[jb][r]); }
  __syncthreads();
}
__device__ __forceinline__ void pack_p(const f32x16& p0, const f32x16& p1, bf16x8& pa0, bf16x8& pa1, bf16x8& pa2, bf16x8& pa3) {
#define PK4(P, BASE, OUT) do { unsigned a0 = cvtpk(P[BASE + 0], P[BASE + 1]), a1 = cvtpk(P[BASE + 2], P[BASE + 3]);   \
    unsigned b0 = cvtpk(P[BASE + 4], P[BASE + 5]), b1 = cvtpk(P[BASE + 6], P[BASE + 7]);                              \
    auto r0 = __builtin_amdgcn_permlane32_swap(a0, b0, false, false); auto r1 = __builtin_amdgcn_permlane32_swap(a1, b1, false, false); \
    u32x4 w = {r0[0], r1[0], r0[1], r1[1]}; OUT = *reinterpret_cast<bf16x8*>(&w); } while (0)
  PK4(p0, 0, pa0); PK4(p0, 8, pa1); PK4(p1, 0, pa2); PK4(p1, 8, pa3);
#undef PK4
}
__device__ __forceinline__ float decay_w(int d, float lgf2, float lgb2) {
  const float e = __builtin_amdgcn_exp2f(d < 0 ? lgf2 * (float)(-d) : lgb2 * (float)d); return d == 0 ? 2.f : e;
}
__device__ __forceinline__ void ret_out_unit(const int wid, const bf16_t* __restrict__ proj, bf16_t* __restrict__ concat, const bf16_t* __restrict__ spA, const bf16_t* __restrict__ spB, size_t dstride,
                                             int rowA, int rowB, int h, float lgf2, float lgb2, const float* __restrict__ gn, LAS char* lds) {
  const int lane = lane_id(), tid = wid * 64 + lane, r32 = lane & 31, hi = lane >> 5, rg = wid & 3, ch = wid >> 2;
  const int sr = tid >> 4, sc = (tid & 15) * 8;
  const int rowbase = ch ? rowB : rowA;
  { bf16x8 kv[8], vv[8];
#pragma unroll
    for (int c2 = 0; c2 < 2; ++c2)
#pragma unroll
      for (int g = 0; g < 4; ++g) { const bf16_t* rp = proj + (size_t)((c2 ? rowB : rowA) + 32 * g + sr) * DP + h * 128 + sc; kv[c2 * 4 + g] = ld8(rp + C_RK); vv[c2 * 4 + g] = ld8(rp + C_RV); }
#pragma unroll
    for (int c2 = 0; c2 < 2; ++c2)
#pragma unroll
      for (int g = 0; g < 4; ++g) { const int row = 32 * g + sr;
        *(LAS bf16x8*)(lds + c2 * 65536 + (row >> 6) * 16384 + KSWZ(row & 63, sc * 2)) = kv[c2 * 4 + g];
        *(LAS bf16x8*)(lds + c2 * 65536 + 32768 + (row >> 6) * 16384 + v_st(row & 63, sc)) = vv[c2 * 4 + g]; } }
  bf16x8 qr[8];
  const bf16_t* Qw = proj + (size_t)(rowbase + rg * 32 + r32) * DP + C_RQ + h * 128 + hi * 8;
#pragma unroll
  for (int d0 = 0; d0 < 8; ++d0) qr[d0] = ld8(Qw + d0 * 16);
  __syncthreads();
  const int m = rg * 32 + r32;
  LAS char* myreg = lds + ch * 65536;
  const int vb = (int)(uintptr_t)myreg + v_rd_base(lane);
  f32x16 o[4] = {}; f32x16 p0, p1; bf16x8 pa0, pa1, pa2, pa3;
#pragma unroll
  for (int kt = 0; kt < 2; ++kt) {
    qkt<8>(p0, p1, myreg + kt * 16384, qr, r32, hi, 0);
    int mm = m - 4 * hi; asm volatile("" : "+v"(mm));
#pragma unroll
    for (int r = 0; r < 16; ++r) { const int s0 = 64 * kt + (r & 3) + 8 * (r >> 2); p0[r] *= decay_w(s0 - mm, lgf2, lgb2); p1[r] *= decay_w(s0 + 32 - mm, lgf2, lgb2); }
    pack_p(p0, p1, pa0, pa1, pa2, pa3);
    pv_d0(o, vb + 32768 + kt * 16384, pa0, pa1, pa2, pa3);
  }
  __syncthreads();
  { bf16x8 sv[16];
#pragma unroll
    for (int c2 = 0; c2 < 2; ++c2)
#pragma unroll
      for (int d = 0; d < 2; ++d)
#pragma unroll
        for (int g = 0; g < 4; ++g) sv[(c2 * 2 + d) * 4 + g] = ld8((c2 ? spB : spA) + (size_t)d * dstride + (size_t)(32 * g + sr) * 128 + sc);
#pragma unroll
    for (int c2 = 0; c2 < 2; ++c2)
#pragma unroll
      for (int d = 0; d < 2; ++d)
#pragma unroll
        for (int g = 0; g < 4; ++g) { const int row = 32 * g + sr;
          *(LAS bf16x8*)(lds + c2 * 65536 + d * 32768 + (row >> 6) * 16384 + v_st(row & 63, sc)) = sv[(c2 * 2 + d) * 4 + g]; } }
  const float xf = __builtin_amdgcn_exp2f(lgf2 * (float)(m + 1)), xb = __builtin_amdgcn_exp2f(lgb2 * (float)(128 - m));
  __syncthreads();
#pragma unroll
  for (int d = 0; d < 2; ++d) { const float xs = d ? xb : xf;
#pragma unroll
    for (int sub = 0; sub < 2; ++sub) {
      const bf16x8 a0 = scale8(qr[4 * sub + 0], xs), a1 = scale8(qr[4 * sub + 1], xs), a2 = scale8(qr[4 * sub + 2], xs), a3 = scale8(qr[4 * sub + 3], xs);
      pv_d0(o, vb + d * 32768 + sub * 16384, a0, a1, a2, a3); } }
#pragma unroll
  for (int r = 0; r < 16; ++r) {
    float s = (o[0][r] + o[1][r]) + (o[2][r] + o[3][r]);
    s += __shfl_xor(s, 1); s += __shfl_xor(s, 2); s += __shfl_xor(s, 4); s += __shfl_xor(s, 8); s += __shfl_xor(s, 16);
    const float mu = s * (1.f / 128.f);
    float q = 0.f;
#pragma unroll
    for (int d0 = 0; d0 < 4; ++d0) { const float dd = o[d0][r] - mu; o[d0][r] = dd; q += dd * dd; }
    q += __shfl_xor(q, 1); q += __shfl_xor(q, 2); q += __shfl_xor(q, 4); q += __shfl_xor(q, 8); q += __shfl_xor(q, 16);
    const float rr = rsqrtf(q * (1.f / 128.f) + EPS);
    const size_t grow = (size_t)(rowbase + rg * 32 + crow(r, hi));
    const bf16_t* gp = proj + grow * DP + C_RG + h * 128 + r32; bf16_t* op = concat + grow * DM + h * 128 + r32;
#pragma unroll
    for (int d0 = 0; d0 < 4; ++d0) { const float gv = bf2f(gp[32 * d0]); op[32 * d0] = f2bf(o[d0][r] * rr * gn[32 * d0 + r32] * (gv * __builtin_amdgcn_rcpf(1.f + __builtin_amdgcn_exp2f(-1.4426950408889634f * gv)))); }
  }
  __syncthreads();
}

}


__device__ __forceinline__ float log2_sigmoid(float x) { return -log1pf(__expf(-x)) * 1.4426950408889634f; }
__device__ __forceinline__ bf16_t* cs_ptr(const Params& p, int b, int h, int dir, int j) { return (bf16_t*)(p.ws + WS_CS) + ((size_t)((b * NH + h) * 2 + dir) * 66 + j) * 16384; }
__device__ __forceinline__ void qkrope_phase(const Params& p, Ctx& F, int l) {
    const int lane = lane_id();
    float gq[8], gk[8], fr[8];
#pragma unroll
    for (int i = 0; i < 8; ++i) { gq[i] = p.in[I_QNG][l * 64 + 8 * (lane & 7) + i] * 0.18033688011112042f;
        gk[i] = p.in[I_KNG][l * 64 + 8 * (lane & 7) + i];
        fr[i] = exp2f(-(float)(8 * (lane & 1) + i) * (13.287712379549449f / 16.f)) * 0.15915494309189535f; }
    const bool lowhalf = (lane & 4) == 0;
    for (int m = F.gw; m < NR; m += F.NGW) {
        bf16_t* row = (bf16_t*)(p.ws + WS_PROJ) + (size_t)m * DP;
        v4u* qp = (v4u*)(row + C_DQ) + lane; const v4u* kp = (const v4u*)(row + C_DK) + lane;
#if FAST_ATT
        const v4u qv = *qp, kv = *kp;
#else
        const v4u qv = *qp, kv = *kp, vv = *((const v4u*)(row + C_DV) + lane);
#endif
        float q[8], k[8];
#pragma unroll
        for (int i = 0; i < 4; ++i) { q[2 * i] = __uint_as_float(qv[i] << 16); q[2 * i + 1] = __uint_as_float(qv[i] & 0xffff0000u); k[2 * i] = __uint_as_float(kv[i] << 16); k[2 * i + 1] = __uint_as_float(kv[i] & 0xffff0000u); }
        float sq = 0.f, sk = 0.f;
#pragma unroll
        for (int i = 0; i < 8; ++i) { sq += q[i] * q[i]; sk += k[i] * k[i]; }
        sq += __shfl_xor(sq, 1); sq += __shfl_xor(sq, 2); sq += __shfl_xor(sq, 4);
        sk += __shfl_xor(sk, 1); sk += __shfl_xor(sk, 2); sk += __shfl_xor(sk, 4);
        const float rq = rsqrtf(sq * (1.f / 64.f) + EPS), rk = rsqrtf(sk * (1.f / 64.f) + EPS);
#pragma unroll
        for (int i = 0; i < 8; ++i) { q[i] *= rq * gq[i]; k[i] *= rk * gk[i]; }
        if (m < NL) {
            const int t = m % T; const float pos = (float)((lane & 2) ? (t % 64) : (t / 64));
#pragma unroll
            for (int i = 0; i < 8; ++i) {
                const float rev = pos * fr[i]; const float cs = __builtin_amdgcn_cosf(rev), sn = __builtin_amdgcn_sinf(rev);
                const float oq = __shfl_xor(q[i], 4), ok = __shfl_xor(k[i], 4);
                q[i] = lowhalf ? q[i] * cs - oq * sn : q[i] * cs + oq * sn;
                k[i] = lowhalf ? k[i] * cs - ok * sn : k[i] * cs + ok * sn;
            }
        }
        v4u qo, ko;
#pragma unroll
        for (int i = 0; i < 4; ++i) { qo[i] = pk2(q[2 * i], q[2 * i + 1]); ko[i] = pk2(k[2 * i], k[2 * i + 1]); }
        *qp = qo;
        { const int bb = m < NL ? m / T : (m - NL) / TC, kidx = m < NL ? TC + (m % T) : (m - NL) % TC, tile = kidx >> 6, r = kidx & 63, hh = lane >> 4, ci = lane & 15;
          const size_t blk = ((size_t)(bb * NH + hh) * 132 + tile) * 16384;
          *(v4u*)(p.ws + WS_KT + blk + KSWZ(r, 16 * ci)) = ko;
#if FAST_ATT
          }
#else
          *(v4u*)(p.ws + WS_VT + blk + att::v_st(r, 8 * ci)) = vv; }
#endif
    }
}
__device__ __forceinline__ void scan_phase(const Params& p, Ctx& F, int l) {
    const int lane_ = lane_id(), tid_ = F.wave * 64 + lane_;
    unsigned* cs = (unsigned*)(p.ws + WS_CS);
    for (int i = blockIdx.x * (NWAVES * 64) + tid_; i < 16 * 8192; i += F.G * NWAVES * 64) {
        const int combo = i >> 13, e2 = i & 8191, dir = combo & 1, h = (combo >> 1) & 3;
        const float lg2 = log2_sigmoid(dir ? p.in[I_DECB][l * NH + h] : p.in[I_DECF][l * NH + h]);
        const float decay = exp2f(lg2 * 128.f);
        unsigned* base = cs + (size_t)combo * 66 * 8192 + e2;
        float s0 = 0.f, s1 = 0.f;
#pragma unroll 1
        for (int jj = 0; jj < 66; jj += 22) {
            unsigned tv[22];
#pragma unroll
            for (int k = 0; k < 22; ++k) { const int q = jj + k, idx = dir ? (q < 2 ? 1 - q : 67 - q) : q; tv[k] = base[(size_t)idx * 8192]; }
#pragma unroll
            for (int k = 0; k < 22; ++k) { const int q = jj + k, idx = dir ? (q < 2 ? 1 - q : 67 - q) : q;
                base[(size_t)idx * 8192] = pk2(s0, s1);
                s0 = decay * s0 + __uint_as_float(tv[k] << 16); s1 = decay * s1 + __uint_as_float(tv[k] & 0xffff0000u); }
        }
    }
}

#define IN(k) (lo <= (k) && (k) < hi)
#if SEAM_CVT
#define SEAM(k) do { if (IN(k) && IN((k) + 1)) { const bool t0_ = F.wave == 0 && lane_id() == 0; const XcdToken tk_ = xcd_barrier_arrive(bar, t0_); seam_fill(p, F, (k)); xcd_barrier_wait(bar, tk_, t0_); } } while (0)
#else
#define SEAM(k) do { if (IN(k) && IN((k) + 1)) xcd_barrier(bar, F.wave == 0 && lane_id() == 0); } while (0)
#endif
#ifndef REP_ATT
#define REP_ATT 1
#endif
#ifndef REP_RET
#define REP_RET 1
#endif
#ifndef REP_B
#define REP_B 1
#endif
#ifndef REP_H0
#define REP_H0 1
#endif
#ifndef REP_H1
#define REP_H1 1
#endif
#ifndef REP_I1
#define REP_I1 1
#endif
#ifndef REP_P0
#define REP_P0 1
#endif
#ifndef REP_CS
#define REP_CS 1
#endif
#ifndef REP_A
#define REP_A 1
#endif
#ifndef REP_I0
#define REP_I0 1
#endif
#ifndef REP_F0
#define REP_F0 1
#endif
#ifndef REP_G2
#define REP_G2 1
#endif
#ifndef REP_BAR
#define REP_BAR 0
#endif
template <int l>
__device__ __forceinline__ void layer_phases(const Params& p, Ctx& F, const XcdBarrier& bar, const int lo, const int hi) {
    constexpr int base = 1 + 9 * l;

        if (IN(base + 0)) { for (int rep_ = 0; rep_ < REP_A; ++rep_) norm_phase(p, F, l, 0, NR); for (int rep_ = 0; rep_ < REP_BAR; ++rep_) xcd_barrier(bar, F.wave == 0 && lane_id() == 0); SEAM(base + 0); }
        if (IN(base + 1)) {
            pg8::Gemm g{(const bf16_t*)(p.ws + WS_HBUF), (const bf16_t*)(p.ws + W_WIN) + (size_t)l * DP * DM, NR, DP, DM, DM};
            pg8::Order S; S.init(NR / 256, DP / 256, F.G, (int)blockIdx.x);
            pg8::EpiProj E{(bf16_t*)(p.ws + WS_PROJ), (char*)(p.ws + WS_VT)};
            { pg8::gemm_phase<pg8::EpiProj, pg8::Order, true, true>(F.lds + RING_OFF, g, S, E, F.wave); if (REP_B > 1) { pg8::gemm_phase<pg8::EpiProj, pg8::Order, true, true>(F.lds + RING_OFF, g, S, E, F.wave); } }
            SEAM(base + 1);
        }
        if (IN(base + 2)) {
            qkrope_phase(p, F, l);
            for (int rep_ = 0; rep_ < REP_CS; ++rep_)
            for (int u = blockIdx.x; u < 8 * 66; u += F.G) {
                const int bh = u & 7, j = u >> 3, b = bh >> 2, h = bh & 3;
                const int rowbase = j < 2 ? NL + b * TC + 128 * j : b * T + 128 * (j - 2);
                att::chunk_state_unit(F.wave, (const bf16_t*)(p.ws + WS_PROJ), cs_ptr(p, b, h, 0, j), cs_ptr(p, b, h, 1, j), rowbase, h,
                                      log2_sigmoid(p.in[I_DECF][l * NH + h]), log2_sigmoid(p.in[I_DECB][l * NH + h]), (LAS char*)(F.lds + RING_OFF));
            }
            SEAM(base + 2);
        }
        if (IN(base + 3)) { scan_phase(p, F, l); SEAM(base + 3); }
        if (IN(base + 4)) {
#if FAST_RET
            for (int rep_ = 0; rep_ < REP_RET; ++rep_)
            for (int u = blockIdx.x; u < (l == 0 ? 8 * 33 : 8 * 32); u += F.G) {
                const int bh = u & 7, jp = (u >> 3) + (l == 0 ? 0 : 1), b = bh >> 2, h = bh & 3;
                const int rowA = jp == 0 ? NL + b * TC : b * T + 128 * (2 * jp - 2);
                att::ret_out_unit(F.wave, (const bf16_t*)(p.ws + WS_PROJ), (bf16_t*)(p.ws + WS_CONCAT), cs_ptr(p, b, h, 0, 2 * jp), cs_ptr(p, b, h, 0, 2 * jp + 1), (size_t)66 * 16384,
                                  rowA, rowA + 128, h, log2_sigmoid(p.in[I_DECF][l * NH + h]), log2_sigmoid(p.in[I_DECB][l * NH + h]), p.in[I_GNG] + l * 512 + h * 128, (LAS char*)(F.lds + RING_OFF));
            }
#endif
#if FAST_ATT
            { const int lane_ = lane_id();
              const float s1 = wave_sum(p.in[I_LQ1][l * 64 + lane_] * p.in[I_LK1][l * 64 + lane_]), s2 = wave_sum(p.in[I_LQ2][l * 64 + lane_] * p.in[I_LK2][l * 64 + lane_]);
              const float li = lam_init_of(l), lam = __expf(s1) - __expf(s2) + li;
#if ATT_V3
              constexpr int nunits = 256 + (l == 0 ? 8 : 0);
              for (int rep_ = 0; rep_ < REP_ATT; ++rep_)
              for (int w = ((int)blockIdx.x + F.G - (8 % F.G)) % F.G; w < nunits; w += F.G) {
                  const int u = w < 256 ? ((w + 8) & 255) : w;
                  int b, h, qrow0, NT;
                  if (u < 256) { const int bh = u & 7, qb = u >> 3; b = bh >> 2; h = bh & 3; qrow0 = b * T + qb * 256; NT = (TC + T) / 64; }
                  else { const int bh = u - 256; b = bh >> 2; h = bh & 3; qrow0 = NL + b * TC; NT = TC / 64; }
                  att::ATT_UNIT(F.wave, (const bf16_t*)(p.ws + WS_PROJ), (const char*)(p.ws + WS_KT) + (size_t)(b * NH + h) * 132 * 16384, (const char*)(p.ws + WS_VT) + (size_t)(b * NH + h) * 132 * 16384, (bf16_t*)(p.ws + WS_CONCAT), qrow0, NT, h, (LAS char*)(F.lds + RING_OFF), lam, 1.f - li, p.in[I_SUBLN] + l * 128);
              }
#else
              constexpr int nunits = 512 + (l == 0 ? 16 : 0);
              for (int rep_ = 0; rep_ < REP_ATT; ++rep_)
              for (int u = blockIdx.x; u < nunits; u += F.G) {
                  int b, h, qrow0, NT;
                  if (u < 512) { const int bh = u & 7, qb = u >> 3; b = bh >> 2; h = bh & 3; qrow0 = b * T + qb * 128; NT = (TC + T) / 64; }
                  else { const int v = u - 512, bh = v & 7, blk = v >> 3; b = bh >> 2; h = bh & 3; qrow0 = NL + b * TC + blk * 128; NT = TC / 64; }
                  att::attn_unit(F.wave, (const bf16_t*)(p.ws + WS_PROJ), (const char*)(p.ws + WS_KT) + (size_t)(b * NH + h) * 132 * 16384, (const char*)(p.ws + WS_VT) + (size_t)(b * NH + h) * 132 * 16384, (bf16_t*)(p.ws + WS_CONCAT), qrow0, NT, h, (LAS char*)(F.lds + RING_OFF), lam, 1.f - li, p.in[I_SUBLN] + l * 128);
              }
#endif
            }
#endif
            SEAM(base + 4);
        }
        if (IN(base + 5)) {
            pg8::Gemm g{(const bf16_t*)(p.ws + WS_CONCAT), (const bf16_t*)(p.ws + W_WOUT) + (size_t)l * DM * DM, NR, DM, DM, DM};
            pg8::Order S; S.init(NL / 256, DM / 256, F.G, (int)blockIdx.x);
            pg8::EpiResid E{l == 0 ? p.in[I_X] : p.out, l == 0 ? p.in[I_CTX] : (const float*)(p.ws + WS_XRC), p.out, (float*)(p.ws + WS_XRC), modv(p, l, 0, 2), modv(p, l, 2, 2)};
            if (REP_F0 > 1 && l == 0) { pg8::gemm_phase<pg8::EpiResid, pg8::Order, true, true>(F.lds + RING_OFF, g, S, E, F.wave); }
            pg8::gemm_phase<pg8::EpiResid, pg8::Order, true, true>(F.lds + RING_OFF, g, S, E, F.wave);
            if constexpr (l == 0) {
                pg8::Gemm g2{(const bf16_t*)(p.ws + WS_CONCAT), (const bf16_t*)(p.ws + W_WOUT), NR, DM, 256, DM};
                pg8::SplitOrder S2; S2.init(NL / 256, 2, DM / 256, DM / 256, F.G, (int)blockIdx.x);
                pg8::EpiPartial E2{(float*)(p.ws + WS_PART), NL / 256, NC};
                pg8::gemm_phase<pg8::EpiPartial, pg8::SplitOrder, true, true>(F.lds + RING_OFF, g2, S2, E2, F.wave);
            }
            SEAM(base + 5);
        }
        if (IN(base + 6)) { if constexpr (l == 0) norm_phase(p, F, 0, 1, NR); else router_phase(p, F); SEAM(base + 6); }
        if constexpr (l == 0) {
            if (IN(8)) {
                pg8::Gemm g{(const bf16_t*)(p.ws + WS_HBUF), (const bf16_t*)(p.ws + W_FGU), NR, 2 * DFF, DM, DM};
                pg8::Order S; S.init(NR / 256, 2 * DFF / 256, F.G, (int)blockIdx.x);
                pg8::EpiSwiglu E{(bf16_t*)(p.ws + WS_ACT)};
                { pg8::gemm_phase<pg8::EpiSwiglu, pg8::Order, true, true>(F.lds + RING_OFF, g, S, E, F.wave); if (REP_H0 > 1) { pg8::gemm_phase<pg8::EpiSwiglu, pg8::Order, true, true>(F.lds + RING_OFF, g, S, E, F.wave); } }
                SEAM(8);
            }
            if (IN(9)) {
                pg8::Gemm g{(const bf16_t*)(p.ws + WS_ACT), (const bf16_t*)(p.ws + W_FD), NR, DM, DFF, DFF};
                pg8::Order S; S.init(NL / 256, DM / 256, F.G, (int)blockIdx.x);
                pg8::EpiResid E{p.out, (const float*)(p.ws + WS_XRC), p.out, (float*)(p.ws + WS_XRC), modv(p, 0, 0, 5), modv(p, 0, 2, 5)};
                if (REP_I0 > 1) { pg8::EpiResid Ed{p.out, (const float*)(p.ws + WS_XRC), (float*)(p.ws + WS_H2S), (float*)(p.ws + WS_H2S) + (size_t)NL * DM, modv(p, 0, 0, 5), modv(p, 0, 2, 5)}; pg8::gemm_phase<pg8::EpiResid, pg8::Order, true, true>(F.lds + RING_OFF, g, S, Ed, F.wave); }
                pg8::gemm_phase<pg8::EpiResid, pg8::Order, true, true>(F.lds + RING_OFF, g, S, E, F.wave);
                {
                    pg8::Gemm g2{(const bf16_t*)(p.ws + WS_ACT), (const bf16_t*)(p.ws + W_FD), NR, DM, 256, DFF};
                    pg8::SplitOrder S2; S2.init(NL / 256, 2, DM / 256, DFF / 256, F.G, (int)blockIdx.x);
                    pg8::EpiPartial E2{(float*)(p.ws + WS_PART), NL / 256, NC};
                    pg8::gemm_phase<pg8::EpiPartial, pg8::SplitOrder, true, true>(F.lds + RING_OFF, g2, S2, E2, F.wave);
                }
                SEAM(9);
            }
        } else {
            if (IN(17)) {
#if SEAM_CVT
                moe_cvt_rest(p, F);
#endif
                for (int rep_ = 0; rep_ < REP_G2; ++rep_) gather_phase(p, F); SEAM(17); }
            if (IN(18)) {
                moe_table(F);
                pg8::Gemm g{(const bf16_t*)(p.ws + WS_H2S), (const bf16_t*)(p.ws + W_MGU), MP_MAX, 2 * DFF, DM / 2, DM / 2};
                pg8::Order S; moe_order(F, S, 2 * DFF / 256, (long)2 * DFF * DM);
                pg8::EpiSwiglu8 E{(unsigned char*)(p.ws + WS_ACTS)};
                { pg8::gemm_phase<pg8::EpiSwiglu8, pg8::Order, true, true, true>(F.lds + RING_OFF, g, S, E, F.wave); if (REP_H1 > 1) { pg8::gemm_phase<pg8::EpiSwiglu8, pg8::Order, true, true, true>(F.lds + RING_OFF, g, S, E, F.wave); } }
                SEAM(18);
            }
            if (IN(19)) {
                moe_table(F);
                pg8::Gemm g{(const bf16_t*)(p.ws + WS_ACTS), (const bf16_t*)(p.ws + W_MD), MP_MAX, DM, DFF / 2, DFF / 2};
                pg8::Order S; moe_order(F, S, DM / 256, (long)DM * DFF);
                pg8::EpiMoeDown E{(bf16_t*)(p.ws + WS_YBUF), (const float*)(p.ws + WS_ROUTE) + 6 * NL + MP_MAX, 1.f / (W8_SCALE * A8_SCALE)};
                { pg8::gemm_phase<pg8::EpiMoeDown, pg8::Order, true, true, true>(F.lds + RING_OFF, g, S, E, F.wave); if (REP_I1 > 1) { pg8::gemm_phase<pg8::EpiMoeDown, pg8::Order, true, true, true>(F.lds + RING_OFF, g, S, E, F.wave); } }
                SEAM(19);
            }
            if (IN(20)) { combine_phase(p, F); }
        }
}
struct MArgs { Params p; int ph_lo, ph_hi, li, pad; };
constexpr int N_PHASES = 21;
__global__ void __launch_bounds__(NWAVES * 64, 2) mega(MArgs args) {
    extern __shared__ __attribute__((aligned(16))) unsigned char lds_raw[];
    const Params& p = args.p;
    Ctx F;
    F.lds = (LAS unsigned char*)lds_raw; F.MISC = (volatile LAS unsigned*)(F.lds + MISC_OFF);
    F.wave = __builtin_amdgcn_readfirstlane((int)threadIdx.x >> 6);
    const int lane_ = lane_id(), tid_ = F.wave * 64 + lane_;
    F.G = gridDim.x; F.gw = blockIdx.x * NWAVES + F.wave; F.NGW = F.G * NWAVES;
    F.ctl = (unsigned*)(p.ws + WS_CTL);
    for (int u = tid_; u < (LDS_BYTES - MISC_OFF) / 4; u += NWAVES * 64) ((LAS unsigned*)(F.lds + MISC_OFF))[u] = 0u;
    __syncthreads();
    XcdBarrier bar = xcd_barrier_post(F.ctl + CW_BAR + args.li * XCD_BAR_WORDS, F.MISC + 8, tid_ == 0);
    const int lo = args.ph_lo, hi = args.ph_hi;

    if (IN(0)) { for (int rep_ = 0; rep_ < REP_P0; ++rep_) { if (rep_) __syncthreads(); p0_prologue(p, F); } SEAM(0); }
    layer_phases<0>(p, F, bar, lo, hi);
    layer_phases<1>(p, F, bar, lo, hi);
#undef IN
#undef SEAM
}

#ifndef FAST_MASK
#define FAST_MASK 0x1u
#endif
static void launch_naive_e(const Params& p, int l, bool ret, bool att, hipStream_t stream) {
    const int nrows_mix = l == 0 ? NR : NL;
    if (ret) k_ret_naive<<<nrows_mix * NH / 4, 256, 0, stream>>>(p, l, nrows_mix);
    if (att) k_attn_naive<<<nrows_mix * NH / 4, 256, 0, stream>>>(p, l, nrows_mix);
}
static void launch_naive(const Params& p, int ph, hipStream_t stream) {
    const int l = ph >= 10 ? 1 : 0, rel = ph == 0 ? -1 : (ph - 1 - 9 * l);
    const int nrows_mix = l == 0 ? NR : NL;
    if (ph == 0) { k_mod<<<(2 * 3 * 6144 + 255) / 256, 256, 0, stream>>>(p); return; }
    switch (rel) {
    case 0: k_norm<<<NR / 4, 256, 0, stream>>>(p, l, 0, NR); break;
    case 1: k_gemm_proj<<<dim3(DP / 64, NR / 4), dim3(64, 4), 0, stream>>>(p, l); break;
    case 2: k_qkrope<<<NR / 4, 256, 0, stream>>>(p, l); break;
    case 3: break;
    case 4: launch_naive_e(p, l, true, true, stream); break;
    case 5: k_gemm_out<<<dim3(DM / 64, nrows_mix / 4), dim3(64, 4), 0, stream>>>(p, l); break;
    case 6: k_norm<<<nrows_mix / 4, 256, 0, stream>>>(p, l, 1, nrows_mix); break;
    case 7: if (l == 0) k_ffn_gu<<<dim3(DFF / 64, NR / 4), dim3(64, 4), 0, stream>>>(p); break;
    case 8: if (l == 0) k_ffn_down<<<dim3(DM / 64, NR / 4), dim3(64, 4), 0, stream>>>(p); else k_moe_gu<<<dim3(DFF / 64, 2 * NL / 4), dim3(64, 4), 0, stream>>>(p); break;
    case 9: k_moe_down<<<dim3(DM / 64, NL / 4), dim3(64, 4), 0, stream>>>(p); break;
    default: break;
    }
}
extern "C" void kernel_launch(void* const* d_in, const int* in_sizes, int n_in, void* d_out, int out_size, void* d_ws, size_t ws_size, hipStream_t stream) {
    static int grid = 0;
    if (grid == 0) {
        if (n_in != 28 || out_size != NL * DM || ws_size < WS_END) { fprintf(stderr, "kernel_launch: unexpected shapes (n_in %d out %d ws %zu need %zu)\n", n_in, out_size, ws_size, (size_t)WS_END); grid = -1; return; }
        int dev = 0, cus = 0, per_cu = 0;
        if (hipGetDevice(&dev) != hipSuccess || hipDeviceGetAttribute(&cus, hipDeviceAttributeMultiprocessorCount, dev) != hipSuccess) { grid = -1; return; }
        if (hipFuncSetAttribute((const void*)mega, hipFuncAttributeMaxDynamicSharedMemorySize, LDS_BYTES) != hipSuccess) { fprintf(stderr, "kernel_launch: hipFuncSetAttribute failed\n"); grid = -1; return; }
        if (hipOccupancyMaxActiveBlocksPerMultiprocessor(&per_cu, (const void*)mega, NWAVES * 64, LDS_BYTES) != hipSuccess || per_cu < 1) { fprintf(stderr, "kernel_launch: occupancy query says %d\n", per_cu); (void)hipGetLastError(); grid = -1; return; }
        grid = cus;
    }
    if (grid < 0) return;
    (void)hipMemsetAsync((char*)d_ws + WS_CTL, 0, CTL_ZERO_BYTES, stream);
    MArgs a{};
    for (int i = 0; i < 28; ++i) a.p.in[i] = (const float*)d_in[i];
    a.p.out = (float*)d_out; a.p.ws = (unsigned char*)d_ws;
    const unsigned mask = FAST_MASK;
    int li = 0, ph = 0;
    while (ph < N_PHASES) {
        if ((mask >> ph) & 1u) { int e = ph; bool cutE = false;
            while (e < N_PHASES && ((mask >> e) & 1u)) { const bool isE = (e == 5 || e == 14); ++e; if (isE && !(FAST_ATT && FAST_RET)) { cutE = true; break; } }
            a.ph_lo = ph; a.ph_hi = e; a.li = li++;
            hipLaunchKernelGGL(mega, dim3(grid), dim3(NWAVES * 64), LDS_BYTES, stream, a);
            if (cutE) launch_naive_e(a.p, e - 1 == 5 ? 0 : 1, !FAST_RET, !FAST_ATT, stream);
            ph = e; }
        else { launch_naive(a.p, ph, stream); ++ph; }
    }
}
```

```cpp
#include <hip/hip_runtime.h>
#include <cstdint>
#include <cstdio>
#define FAST_MASK 0x1fffffu
#define FAST_ATT 1
#define FAST_RET 1

constexpr int NB = 2, T = 8192, DM = 1024, TC = 256;
constexpr int NL = NB * T;
constexpr int NC = NB * TC;
constexpr int NR = NL + NC;
constexpr int DP = 3584, DFF = 2816, NE = 8, NH = 4;
constexpr float EPS = 1e-6f;
constexpr int C_RQ = 0, C_RK = 512, C_RV = 1024, C_RG = 1536, C_DQ = 2048, C_DK = 2560, C_DV = 3072;
constexpr int MP_MAX = 2 * NL + NE * 256;

typedef unsigned short bf16_t;
__device__ __forceinline__ float bf2f(bf16_t v) { return __uint_as_float(((unsigned)v) << 16); }
__device__ __forceinline__ bf16_t f2bf(float f) { unsigned u = __float_as_uint(f); u += 0x7fffu + ((u >> 16) & 1u); return (bf16_t)(u >> 16); }
typedef float f32x2_t __attribute__((ext_vector_type(2)));
typedef __bf16 bf16x2_t __attribute__((ext_vector_type(2)));
__device__ __forceinline__ unsigned pk2(float lo, float hi) { const f32x2_t v = {lo, hi}; const bf16x2_t b = __builtin_convertvector(v, bf16x2_t); return __builtin_bit_cast(unsigned, b); }
__device__ __forceinline__ unsigned pk4_fp8(float a, float b, float c, float d) {
    a = __builtin_amdgcn_fmed3f(a, -448.f, 448.f); b = __builtin_amdgcn_fmed3f(b, -448.f, 448.f); c = __builtin_amdgcn_fmed3f(c, -448.f, 448.f); d = __builtin_amdgcn_fmed3f(d, -448.f, 448.f);
    int r = 0; r = __builtin_amdgcn_cvt_pk_fp8_f32(a, b, r, false); r = __builtin_amdgcn_cvt_pk_fp8_f32(c, d, r, true); return (unsigned)r;
}
constexpr float W8_SCALE = 64.f, A8_SCALE = 8.f;
__device__ __forceinline__ float wave_sum(float v) {
#pragma unroll
    for (int o = 1; o < 64; o <<= 1) v += __shfl_xor(v, o);
    return v;
}
__device__ __forceinline__ int lane_id() { int l = (int)__builtin_amdgcn_mbcnt_hi(~0u, __builtin_amdgcn_mbcnt_lo(~0u, 0u)); asm volatile("" : "+v"(l)); return l; }
__device__ __forceinline__ float siluf(float v) { return v / (1.f + __expf(-v)); }

constexpr size_t MiB = 1u << 20;
constexpr size_t WS_CTL = 0, CTL_ZERO_BYTES = 1 * MiB;
constexpr size_t WS_MODV = 1 * MiB;
constexpr size_t WS_ROUTE = 2 * MiB;
constexpr size_t WS_XRC = 3 * MiB;
constexpr size_t WS_W = 6 * MiB;
constexpr size_t W_WIN = WS_W;
constexpr size_t W_WOUT = W_WIN + (size_t)2 * DP * DM * 2;
constexpr size_t W_FGU = W_WOUT + (size_t)2 * DM * DM * 2;
constexpr size_t W_FD = W_FGU + (size_t)2 * DFF * DM * 2;
constexpr size_t W_MGU = W_FD + (size_t)DM * DFF * 2;
constexpr size_t W_MD = W_MGU + (size_t)NE * 2 * DFF * DM * 2;
constexpr size_t W_END = W_MD + (size_t)NE * DM * DFF * 2;
constexpr size_t WS_HBUF = 173 * MiB;
constexpr size_t WS_PROJ = 206 * MiB;
constexpr size_t WS_CONCAT = 322 * MiB;
constexpr size_t WS_ACT = 206 * MiB;
constexpr size_t WS_ACTS = 173 * MiB;
constexpr size_t WS_H2S = 361 * MiB;
constexpr size_t WS_KT = 394 * MiB, WS_VT = WS_KT + (size_t)NB * NH * 132 * 16384;
static_assert(WS_VT + (size_t)NB * NH * 132 * 16384 <= 429 * MiB && WS_H2S + (size_t)NB * NH * 2 * 66 * 32768 <= WS_KT, "K/V tile images");
constexpr size_t WS_YBUF = WS_H2S, WS_CS = WS_H2S, WS_PART = WS_H2S;
constexpr size_t WS_END = 430 * MiB;
static_assert(W_END <= WS_HBUF && WS_ACTS + (size_t)MP_MAX * DFF * 2 <= WS_H2S && WS_H2S + (size_t)MP_MAX * DM * 2 <= WS_END && WS_ACT + (size_t)2 * NL * DFF * 2 <= WS_END, "ws map");
constexpr int CW_BAR = 4096;
constexpr int CW_CNT = 200000;

struct Params {
    const float* in[28];
    float* out;
    unsigned char* ws;
};
enum { I_X = 0, I_C, I_CTX, I_CCTX, I_ADAW, I_ADAB, I_N1G, I_N2G, I_WIN, I_DECF, I_DECB, I_GNG, I_QNG, I_KNG, I_LQ1, I_LK1, I_LQ2, I_LK2, I_SUBLN, I_WOUT,
       I_FWG, I_FWU, I_FWD, I_RW, I_RB, I_MWG, I_MWU, I_MWD };

__device__ __forceinline__ int rowtype(int m) { return m < NL ? m / T : 2; }
__device__ __forceinline__ const float* modv(const Params& p, int l, int rt, int i) { return (const float*)(p.ws + WS_MODV) + ((size_t)(l * 3 + rt) * 6 + i) * DM; }
__device__ __forceinline__ float* xr_row(const Params& p, int m) { return m < NL ? p.out + (size_t)m * DM : (float*)(p.ws + WS_XRC) + (size_t)(m - NL) * DM; }
__device__ __forceinline__ float lam_init_of(int l) { return l == 0 ? 0.2f : (0.8f - 0.6f * 0.74081822068171788f); }

#ifndef SEAM_CVT
#define SEAM_CVT 1
#endif
#ifndef ATT_UNIT
#define ATT_UNIT attn_unit3q
#endif
#ifndef FAST_ATT
#define FAST_ATT 0
#endif
#ifndef FAST_RET
#define FAST_RET 0
#endif
#ifndef ATT_V3
#define ATT_V3 1
#endif
__global__ void k_mod(Params p) {
    const int idx = blockIdx.x * blockDim.x + threadIdx.x;
    if (idx >= 2 * 3 * 6144) return;
    const int n = idx % 6144, rt = (idx / 6144) % 3, l = idx / (6144 * 3);
    const float* cv = rt < 2 ? p.in[I_C] + rt * DM : p.in[I_CCTX];
    const float* W = p.in[I_ADAW] + (size_t)l * DM * 6144;
    float acc = 0.f;
    for (int k = 0; k < DM; ++k) acc += siluf(cv[k]) * W[(size_t)k * 6144 + n];
    ((float*)(p.ws + WS_MODV))[(size_t)(l * 3 + rt) * 6144 + n] = acc + p.in[I_ADAB][l * 6144 + n];
}

__global__ void k_norm(Params p, int l, int which, int nrows) {
    const int m = blockIdx.x * (blockDim.x / 64) + (threadIdx.x >> 6), lane = threadIdx.x & 63;
    if (m >= nrows) return;
    const float* xrow;
    if (l == 0 && which == 0) xrow = m < NL ? p.in[I_X] + (size_t)m * DM : p.in[I_CTX] + (size_t)(m - NL) * DM;
    else xrow = xr_row(p, m);
    const int rt = rowtype(m);
    const float* g = p.in[which ? I_N2G : I_N1G] + l * DM;
    const float* sh = modv(p, l, rt, which ? 3 : 0);
    const float* sc = modv(p, l, rt, which ? 4 : 1);
    float v[16]; float ss = 0.f;
#pragma unroll
    for (int j = 0; j < 4; ++j) { const float4 t = *(const float4*)(xrow + 256 * j + 4 * lane); v[4 * j] = t.x; v[4 * j + 1] = t.y; v[4 * j + 2] = t.z; v[4 * j + 3] = t.w; ss += t.x * t.x + t.y * t.y + t.z * t.z + t.w * t.w; }
    const float r = rsqrtf(wave_sum(ss) * (1.f / DM) + EPS);
    bf16_t* hb = (bf16_t*)(p.ws + WS_HBUF) + (size_t)m * DM;
#pragma unroll
    for (int j = 0; j < 4; ++j)
#pragma unroll
        for (int q = 0; q < 4; ++q) { const int col = 256 * j + 4 * lane + q; const float y = v[4 * j + q] * r * g[col]; v[4 * j + q] = y * (1.f + sc[col]) + sh[col]; hb[col] = f2bf(v[4 * j + q]); }
    if (l == 1 && which == 1) {
        const float* rw = p.in[I_RW]; float lg[8];
#pragma unroll
        for (int e = 0; e < 8; ++e) { float a = 0.f;
#pragma unroll
            for (int j = 0; j < 4; ++j)
#pragma unroll
                for (int q = 0; q < 4; ++q) a += v[4 * j + q] * rw[(size_t)(256 * j + 4 * lane + q) * 8 + e];
            lg[e] = wave_sum(a) + p.in[I_RB][e]; }
        int i1 = 0; float v1 = lg[0];
#pragma unroll
        for (int e = 1; e < 8; ++e) if (lg[e] > v1) { v1 = lg[e]; i1 = e; }
        int i2 = -1; float v2 = -3.4e38f;
#pragma unroll
        for (int e = 0; e < 8; ++e) if (e != i1 && lg[e] > v2) { v2 = lg[e]; i2 = e; }
        const float w1 = 1.f / (1.f + __expf(v2 - v1));
        if (lane == 0) { int* te = (int*)(p.ws + WS_ROUTE); float* tw = (float*)(p.ws + WS_ROUTE) + 2 * NL; te[2 * m] = i1; te[2 * m + 1] = i2; tw[2 * m] = w1; tw[2 * m + 1] = 1.f - w1; }
    }
}

__global__ void k_gemm_proj(Params p, int l) {
    const int n = blockIdx.x * 64 + threadIdx.x, m = blockIdx.y * 4 + threadIdx.y;
    const bf16_t* a = (const bf16_t*)(p.ws + WS_HBUF) + (size_t)m * DM;
    const float* W = p.in[I_WIN] + (size_t)l * DM * DP + n;
    float acc = 0.f;
#pragma unroll 8
    for (int k = 0; k < DM; ++k) acc += bf2f(a[k]) * W[(size_t)k * DP];
    if (n >= C_RK && n < C_RV) acc *= 0.08838834764831845f;
    ((bf16_t*)(p.ws + WS_PROJ))[(size_t)m * DP + n] = f2bf(acc);
}

__global__ void k_qkrope(Params p, int l) {
    const int m = blockIdx.x * (blockDim.x / 64) + (threadIdx.x >> 6), lane = threadIdx.x & 63;
    if (m >= NR) return;
    bf16_t* row = (bf16_t*)(p.ws + WS_PROJ) + (size_t)m * DP;
    const bool lat = m < NL; const int t = m % T;
    const int j = lane & 31; const float pos = (float)((j < 16) ? (t / 64) : (t % 64));
    const float inv_freq = exp2f(-(float)(j & 15) * (13.287712379549449f / 16.f));
    const float ang = pos * inv_freq; const float cs = __cosf(ang), sn = __sinf(ang);
    for (int part = 0; part < 2; ++part) {
        const float* g = p.in[part ? I_KNG : I_QNG] + l * 64;
        for (int hc = 0; hc < 8; ++hc) {
            bf16_t* q = row + (part ? C_DK : C_DQ) + hc * 64;
            const float v = bf2f(q[lane]);
            const float r = rsqrtf(wave_sum(v * v) * (1.f / 64.f) + EPS);
            float y = v * r * g[lane];
            if (lat) { const float o = __shfl_xor(y, 32); y = lane < 32 ? y * cs - o * sn : y * cs + o * sn; }
            if (part == 0) y *= 0.18033688011112042f;
            q[lane] = f2bf(y);
        }
    }
}

__global__ void k_ret_naive(Params p, int l, int nrows) {
    const int w = blockIdx.x * (blockDim.x / 64) + (threadIdx.x >> 6), lane = threadIdx.x & 63;
    if (w >= nrows * NH) return;
    const int m = w / NH, h = w % NH;
    const bf16_t* proj = (const bf16_t*)(p.ws + WS_PROJ);
    const float df = p.in[I_DECF][l * NH + h], db = p.in[I_DECB][l * NH + h];
    const float lgf = -log1pf(__expf(-df)), lgb = -log1pf(__expf(-db));
    const bf16_t* qrow = proj + (size_t)m * DP + C_RQ + h * 128 + 2 * lane;
    const float q0 = bf2f(qrow[0]), q1 = bf2f(qrow[1]);
    float o0 = 0.f, o1 = 0.f;
    if (m < NL) {
        const int b = m / T, t = m % T;
        for (int s = 0; s < T; ++s) {
            const bf16_t* kr = proj + (size_t)(b * T + s) * DP + h * 128 + 2 * lane;
            const float dot = wave_sum(q0 * bf2f(kr[C_RK]) + q1 * bf2f(kr[C_RK + 1]));
            const float wgt = s < t ? __expf(lgf * (float)(t - s)) : (s == t ? 2.f : __expf(lgb * (float)(s - t)));
            o0 += wgt * dot * bf2f(kr[C_RV]); o1 += wgt * dot * bf2f(kr[C_RV + 1]);
        }
        for (int i = 0; i < TC; ++i) {
            const bf16_t* kr = proj + (size_t)(NL + b * TC + i) * DP + h * 128 + 2 * lane;
            const float dot = wave_sum(q0 * bf2f(kr[C_RK]) + q1 * bf2f(kr[C_RK + 1]));
            const float wgt = __expf(lgf * (float)(t + TC - i)) + __expf(lgb * (float)(T - t + i));
            o0 += wgt * dot * bf2f(kr[C_RV]); o1 += wgt * dot * bf2f(kr[C_RV + 1]);
        }
    } else {
        const int b = (m - NL) / TC, t = (m - NL) % TC;
        for (int s = 0; s < TC; ++s) {
            const bf16_t* kr = proj + (size_t)(NL + b * TC + s) * DP + h * 128 + 2 * lane;
            const float dot = wave_sum(q0 * bf2f(kr[C_RK]) + q1 * bf2f(kr[C_RK + 1]));
            const float wgt = s < t ? __expf(lgf * (float)(t - s)) : (s == t ? 2.f : __expf(lgb * (float)(s - t)));
            o0 += wgt * dot * bf2f(kr[C_RV]); o1 += wgt * dot * bf2f(kr[C_RV + 1]);
        }
    }
    const float mu = wave_sum(o0 + o1) * (1.f / 128.f);
    const float d0 = o0 - mu, d1 = o1 - mu;
    const float r = rsqrtf(wave_sum(d0 * d0 + d1 * d1) * (1.f / 128.f) + EPS);
    const float* gn = p.in[I_GNG] + l * 512 + h * 128 + 2 * lane;
    const bf16_t* gr = proj + (size_t)m * DP + C_RG + h * 128 + 2 * lane;
    bf16_t* cc = (bf16_t*)(p.ws + WS_CONCAT) + (size_t)m * DM + h * 128 + 2 * lane;
    cc[0] = f2bf(siluf(bf2f(gr[0])) * d0 * r * gn[0]);
    cc[1] = f2bf(siluf(bf2f(gr[1])) * d1 * r * gn[1]);
}

__global__ void k_attn_naive(Params p, int l, int nrows) {
    const int w = blockIdx.x * (blockDim.x / 64) + (threadIdx.x >> 6), lane = threadIdx.x & 63;
    if (w >= nrows * NH) return;
    const int m = w / NH, h = w % NH;
    const bf16_t* proj = (const bf16_t*)(p.ws + WS_PROJ);
    const bool lat = m < NL; const int b = lat ? m / T : (m - NL) / TC;
    float O[2][2];
    for (int c = 0; c < 2; ++c) {
        const float q = bf2f(proj[(size_t)m * DP + C_DQ + h * 128 + c * 64 + lane]);
        float mx = -1e30f, ls = 0.f, o0 = 0.f, o1 = 0.f;
        const int nk = lat ? TC + T : TC;
        for (int s = 0; s < nk; ++s) {
            const int mk = s < TC ? NL + b * TC + s : b * T + (s - TC);
            const bf16_t* kr = proj + (size_t)mk * DP + h * 128;
            const float sc = wave_sum(q * bf2f(kr[C_DK + c * 64 + lane]));
            const float mn = fmaxf(mx, sc), al = exp2f(mx - mn), pp = exp2f(sc - mn);
            ls = ls * al + pp; o0 = o0 * al + pp * bf2f(kr[C_DV + 2 * lane]); o1 = o1 * al + pp * bf2f(kr[C_DV + 2 * lane + 1]); mx = mn;
        }
        O[c][0] = o0 / ls; O[c][1] = o1 / ls;
    }
    float s1 = 0.f, s2 = 0.f;
    { const float a = p.in[I_LQ1][l * 64 + lane] * p.in[I_LK1][l * 64 + lane], bq = p.in[I_LQ2][l * 64 + lane] * p.in[I_LK2][l * 64 + lane]; s1 = wave_sum(a); s2 = wave_sum(bq); }
    const float li = lam_init_of(l), lam = __expf(s1) - __expf(s2) + li;
    const float d0 = O[0][0] - lam * O[1][0], d1 = O[0][1] - lam * O[1][1];
    const float r = rsqrtf(wave_sum(d0 * d0 + d1 * d1) * (1.f / 128.f) + EPS);
    const float* sg = p.in[I_SUBLN] + l * 128 + 2 * lane;
    bf16_t* cc = (bf16_t*)(p.ws + WS_CONCAT) + (size_t)m * DM + 512 + h * 128 + 2 * lane;
    cc[0] = f2bf(d0 * r * sg[0] * (1.f - li)); cc[1] = f2bf(d1 * r * sg[1] * (1.f - li));
}

__global__ void k_gemm_out(Params p, int l) {
    const int n = blockIdx.x * 64 + threadIdx.x, m = blockIdx.y * 4 + threadIdx.y;
    const bf16_t* a = (const bf16_t*)(p.ws + WS_CONCAT) + (size_t)m * DM;
    const float* W = p.in[I_WOUT] + (size_t)l * DM * DM + n;
    float acc = 0.f;
#pragma unroll 8
    for (int k = 0; k < DM; ++k) acc += bf2f(a[k]) * W[(size_t)k * DM];
    const float xin = l == 0 ? (m < NL ? p.in[I_X][(size_t)m * DM + n] : p.in[I_CTX][(size_t)(m - NL) * DM + n]) : xr_row(p, m)[n];
    xr_row(p, m)[n] = xin + modv(p, l, rowtype(m), 2)[n] * acc;
}

__global__ void k_ffn_gu(Params p) {
    const int j = blockIdx.x * 64 + threadIdx.x, m = blockIdx.y * 4 + threadIdx.y;
    const bf16_t* a = (const bf16_t*)(p.ws + WS_HBUF) + (size_t)m * DM;
    const float* Wg = p.in[I_FWG] + j; const float* Wu = p.in[I_FWU] + j;
    float ag = 0.f, au = 0.f;
#pragma unroll 8
    for (int k = 0; k < DM; ++k) { const float x = bf2f(a[k]); ag += x * Wg[(size_t)k * DFF]; au += x * Wu[(size_t)k * DFF]; }
    ((bf16_t*)(p.ws + WS_ACT))[(size_t)m * DFF + j] = f2bf(siluf(ag) * au);
}
__global__ void k_ffn_down(Params p) {
    const int n = blockIdx.x * 64 + threadIdx.x, m = blockIdx.y * 4 + threadIdx.y;
    const bf16_t* a = (const bf16_t*)(p.ws + WS_ACT) + (size_t)m * DFF;
    const float* W = p.in[I_FWD] + n;
    float acc = 0.f;
#pragma unroll 8
    for (int k = 0; k < DFF; ++k) acc += bf2f(a[k]) * W[(size_t)k * DM];
    xr_row(p, m)[n] += modv(p, 0, rowtype(m), 5)[n] * acc;
}
__global__ void k_moe_gu(Params p) {
    const int j = blockIdx.x * 64 + threadIdx.x, ts = blockIdx.y * 4 + threadIdx.y;
    const int t = ts >> 1; const int e = ((const int*)(p.ws + WS_ROUTE))[ts];
    const bf16_t* a = (const bf16_t*)(p.ws + WS_HBUF) + (size_t)t * DM;
    const float* Wg = p.in[I_MWG] + (size_t)e * DM * DFF + j; const float* Wu = p.in[I_MWU] + (size_t)e * DM * DFF + j;
    float ag = 0.f, au = 0.f;
#pragma unroll 8
    for (int k = 0; k < DM; ++k) { const float x = bf2f(a[k]); ag += x * Wg[(size_t)k * DFF]; au += x * Wu[(size_t)k * DFF]; }
    ((bf16_t*)(p.ws + WS_ACT))[(size_t)ts * DFF + j] = f2bf(siluf(ag) * au);
}
__global__ void k_moe_down(Params p) {
    const int n = blockIdx.x * 64 + threadIdx.x, t = blockIdx.y * 4 + threadIdx.y;
    const int* te = (const int*)(p.ws + WS_ROUTE); const float* tw = (const float*)(p.ws + WS_ROUTE) + 2 * NL;
    float y = 0.f;
    for (int s = 0; s < 2; ++s) {
        const bf16_t* a = (const bf16_t*)(p.ws + WS_ACT) + (size_t)(2 * t + s) * DFF;
        const float* W = p.in[I_MWD] + (size_t)te[2 * t + s] * DFF * DM + n;
        float acc = 0.f;
#pragma unroll 8
        for (int k = 0; k < DFF; ++k) acc += bf2f(a[k]) * W[(size_t)k * DM];
        y += tw[2 * t + s] * acc;
    }
    p.out[(size_t)t * DM + n] += modv(p, 1, t / T, 5)[n] * y;
}


typedef unsigned v2u __attribute__((ext_vector_type(2)));
namespace pg8 {
#define PG8_LAS __attribute__((address_space(3)))
typedef unsigned short bf16_t;
typedef short bf16x8 __attribute__((ext_vector_type(8)));
typedef float f32x4 __attribute__((ext_vector_type(4)));
typedef unsigned u32x4 __attribute__((ext_vector_type(4)));
typedef int i32x4 __attribute__((ext_vector_type(4)));
typedef int i32x8 __attribute__((ext_vector_type(8)));
constexpr int BM = 256, BK = 64, HALF = 128, HTB = HALF * BK * 2  , STAGE_BYTES = 8 * HTB, NXCD = 8, WGM = 4;

__host__ __device__ __forceinline__ int lds_byte(int r, int c) { const int st = (r >> 4) * 2 + (c >> 5), rr = r & 15, cc = c & 31, ob = rr * 64 + cc * 2; return st * 1024 + (ob ^ (((ob >> 9) & 1) << 5)); }
__host__ __device__ __forceinline__ void stage_rc(int b, int& R, int& C) { const int st = b / 1024, sb = b % 1024, swz = sb ^ (((sb >> 9) & 1) << 5); R = (st >> 1) * 16 + swz / 64; C = (st & 1) * 32 + (swz % 64) / 2; }
__host__ __device__ __forceinline__ int perm32(int rho) { const int n = rho >> 4, i = rho & 15; return 8 * (i >> 2) + 4 * n + (i & 3); }

struct Unit { int pm, pn; long bofs, kofs; };
struct Gemm { const bf16_t* A; const bf16_t* Bt; int M, N, K, ld; };

struct Order {
    int nM, nN, nwg, G, c;
    int e1, e2, e3, e4, e5, e6, e7; long estride;
    __device__ __forceinline__ void init(int nM_, int nN_, int G_, int c_) { nM = nM_; nN = nN_; nwg = nM * nN; G = G_; c = c_; estride = 0; e1 = e2 = e3 = e4 = e5 = e6 = e7 = 0; }
    __device__ __forceinline__ bool next(int i, Unit& u) const {
        const long L = (long)i * G + c; if (L >= nwg) return false;
        int wgid = (int)L; { const int q = nwg / NXCD, r = nwg % NXCD, xcd = wgid % NXCD, off = wgid / NXCD; wgid = (xcd < r ? xcd * (q + 1) : r * (q + 1) + (xcd - r) * q) + off; }
        const int nig = WGM * nN, gid = wgid / nig, fm = gid * WGM, gsz = (nM - fm) < WGM ? (nM - fm) : WGM;
        u.pm = fm + ((wgid % nig) % gsz); u.pn = (wgid % nig) / gsz;
        const int e = (u.pm >= e1) + (u.pm >= e2) + (u.pm >= e3) + (u.pm >= e4) + (u.pm >= e5) + (u.pm >= e6) + (u.pm >= e7);
        u.bofs = estride ? (long)e * estride : 0; u.kofs = 0;
        return true;
    }
    __device__ __forceinline__ void a_ready(const Unit&) const {}
    __device__ __forceinline__ void done(const Unit&) const {}
};

struct SplitOrder {
    int nN, ns, nwg, G, c, pm0;
    __device__ __forceinline__ void init(int pm0_, int npan, int nN_, int ns_, int G_, int c_) { pm0 = pm0_; nN = nN_; ns = ns_; nwg = npan * nN * ns; G = G_; c = c_; }
    __device__ __forceinline__ bool next(int i, Unit& u) const {
        const int L = i * G + c; if (L >= nwg) return false;
        const int ks = L % ns, rest = L / ns; u.pn = rest % nN; u.pm = pm0 + rest / nN; u.bofs = 0; u.kofs = (long)ks * 256 * 2; return true;
    }
    __device__ __forceinline__ void a_ready(const Unit&) const {}
    __device__ __forceinline__ void done(const Unit&) const {}
};
__device__ __forceinline__ unsigned cvt_pk_bf16(float lo, float hi) { unsigned r; asm volatile("v_cvt_pk_bf16_f32 %0, %1, %2" : "=v"(r) : "v"(lo), "v"(hi)); return r; }
__device__ __forceinline__ float silu_fast(float x) { return x * __builtin_amdgcn_rcpf(1.f + __builtin_amdgcn_exp2f(-1.4426950408889634f * x)); }

struct EpiProj {
    static constexpr bool PERM = true, AFTER_DRAIN = false;
    bf16_t* O; char* VT;
    __device__ __forceinline__ void operator()(const f32x4 (&acc)[2][2][4][2], const Unit& u, int wr, int wc, int fr, int fq) const {
        const int row0 = u.pm * BM + wr * 64 + fr, col0 = u.pn * BM + wc * 32 + 8 * fq;
#if FAST_ATT
        if (u.pn >= C_DV / BM) {
#pragma unroll
            for (int ai = 0; ai < 2; ++ai)
#pragma unroll
                for (int m = 0; m < 4; ++m) { const int row = row0 + ai * HALF + m * 16;
                    const int bb = row < NL ? row / T : (row - NL) / TC, kidx = row < NL ? TC + (row % T) : (row - NL) % TC, key = kidx & 63;
                    const int pos = (key & ~0xC) | ((key & 4) << 1) | ((key & 8) >> 1), ch = pos >> 3;
#pragma unroll
                    for (int bj = 0; bj < 2; ++bj) { const int hh = 2 * (u.pn - C_DV / BM) + bj;
                        char* tp = VT + ((size_t)(bb * NH + hh) * 132 + (kidx >> 6)) * 16384 + (wc * 32 + 8 * fq) * 128 + (pos & 7) * 2;
#pragma unroll
                        for (int n = 0; n < 2; ++n) { const f32x4 v = acc[ai][bj][m][n];
                            const unsigned w0 = cvt_pk_bf16(v[0], v[1]), w1 = cvt_pk_bf16(v[2], v[3]);
                            char* q0 = tp + (4 * n) * 128 + (((ch & 4) | ((ch & 3) ^ (2 * n))) << 4); char* q1 = tp + (4 * n) * 128 + (((ch & 4) | ((ch & 3) ^ (2 * n + 1))) << 4);
                            *(unsigned short*)(q0) = (unsigned short)w0; *(unsigned short*)(q0 + 128) = (unsigned short)(w0 >> 16);
                            *(unsigned short*)(q1 + 256) = (unsigned short)w1; *(unsigned short*)(q1 + 384) = (unsigned short)(w1 >> 16); } } }
            return;
        }
#endif
        const float sc = (u.pn == 2 || u.pn == 3) ? 0.08838834764831845f : 1.f;
#pragma unroll
        for (int ai = 0; ai < 2; ++ai)
#pragma unroll
            for (int m = 0; m < 4; ++m) { bf16_t* rowp = O + (size_t)(row0 + ai * HALF + m * 16) * DP + col0;
#pragma unroll
                for (int bj = 0; bj < 2; ++bj) { const f32x4 v0 = acc[ai][bj][m][0] * sc, v1 = acc[ai][bj][m][1] * sc;
                    u32x4 w; w.x = cvt_pk_bf16(v0[0], v0[1]); w.y = cvt_pk_bf16(v0[2], v0[3]); w.z = cvt_pk_bf16(v1[0], v1[1]); w.w = cvt_pk_bf16(v1[2], v1[3]);
                    *(u32x4*)(rowp + bj * HALF) = w; } }
    }
};
struct EpiResid {
    static constexpr bool PERM = false, AFTER_DRAIN = false;
    const float* base_lat; const float* base_ctx; float* out_lat; float* out_ctx; const float* gl; const float* gc;
    __device__ __forceinline__ void operator()(const f32x4 (&acc)[2][2][4][2], const Unit& u, int wr, int wc, int fr, int fq) const {
        const bool lat = u.pm < NL / BM;
        const int row0 = (lat ? u.pm * BM : u.pm * BM - NL) + wr * 64 + fr, col0 = u.pn * BM + wc * 32 + 4 * fq;
        const float* base = lat ? base_lat : base_ctx; float* out = lat ? out_lat : out_ctx;
        const float* gate = lat ? gl + (size_t)(u.pm / (T / BM)) * 6 * DM : gc;
        f32x4 gv[2][2];
#pragma unroll
        for (int bj = 0; bj < 2; ++bj)
#pragma unroll
            for (int n = 0; n < 2; ++n) gv[bj][n] = *(const f32x4*)(gate + col0 + bj * HALF + n * 16);
#pragma unroll
        for (int ai = 0; ai < 2; ++ai)
#pragma unroll
            for (int m = 0; m < 4; ++m) { const size_t off = (size_t)(row0 + ai * HALF + m * 16) * DM + col0;
#pragma unroll
                for (int bj = 0; bj < 2; ++bj)
#pragma unroll
                    for (int n = 0; n < 2; ++n) { const f32x4 bs = *(const f32x4*)(base + off + bj * HALF + n * 16); *(f32x4*)(out + off + bj * HALF + n * 16) = bs + gv[bj][n] * acc[ai][bj][m][n]; }
                asm volatile("" ::: "memory"); }
    }
};
struct EpiPartial {
    static constexpr bool PERM = false, AFTER_DRAIN = false;
    float* part; int pm0, nrows;
    __device__ __forceinline__ void operator()(const f32x4 (&acc)[2][2][4][2], const Unit& u, int wr, int wc, int fr, int fq) const {
        const int row0 = (u.pm - pm0) * BM + wr * 64 + fr, col0 = u.pn * BM + wc * 32 + 4 * fq;
        float* base = part + (size_t)(u.kofs / 512) * nrows * DM;
#pragma unroll
        for (int ai = 0; ai < 2; ++ai)
#pragma unroll
            for (int m = 0; m < 4; ++m) { float* rowp = base + (size_t)(row0 + ai * HALF + m * 16) * DM + col0;
#pragma unroll
                for (int bj = 0; bj < 2; ++bj)
#pragma unroll
                    for (int n = 0; n < 2; ++n) *(f32x4*)(rowp + bj * HALF + n * 16) = acc[ai][bj][m][n]; }
    }
};
struct EpiSwiglu {
    static constexpr bool PERM = true, AFTER_DRAIN = false;
    bf16_t* O;
    __device__ __forceinline__ void operator()(const f32x4 (&acc)[2][2][4][2], const Unit& u, int wr, int wc, int fr, int fq) const {
        const int row0 = u.pm * BM + wr * 64 + fr, col0 = u.pn * HALF + wc * 32 + 8 * fq;
#pragma unroll
        for (int ai = 0; ai < 2; ++ai)
#pragma unroll
            for (int m = 0; m < 4; ++m) { bf16_t* rowp = O + (size_t)(row0 + ai * HALF + m * 16) * DFF + col0;
                const f32x4 g0 = acc[ai][0][m][0], g1 = acc[ai][0][m][1], u0 = acc[ai][1][m][0], u1 = acc[ai][1][m][1];
                u32x4 w; w.x = cvt_pk_bf16(silu_fast(g0[0]) * u0[0], silu_fast(g0[1]) * u0[1]); w.y = cvt_pk_bf16(silu_fast(g0[2]) * u0[2], silu_fast(g0[3]) * u0[3]);
                w.z = cvt_pk_bf16(silu_fast(g1[0]) * u1[0], silu_fast(g1[1]) * u1[1]); w.w = cvt_pk_bf16(silu_fast(g1[2]) * u1[2], silu_fast(g1[3]) * u1[3]);
                *(u32x4*)rowp = w; }
    }
};
struct EpiSwiglu8 {
    static constexpr bool PERM = true, AFTER_DRAIN = false;
    unsigned char* O;
    __device__ __forceinline__ void operator()(const f32x4 (&acc)[2][2][4][2], const Unit& u, int wr, int wc, int fr, int fq) const {
        const int row0 = u.pm * BM + wr * 64 + fr, col0 = u.pn * HALF + wc * 32 + 8 * fq;
        constexpr float WI = 1.f / W8_SCALE;
#pragma unroll
        for (int ai = 0; ai < 2; ++ai)
#pragma unroll
            for (int m = 0; m < 4; ++m) { unsigned char* rowp = O + (size_t)(row0 + ai * HALF + m * 16) * DFF + col0;
                const f32x4 g0 = acc[ai][0][m][0] * WI, g1 = acc[ai][0][m][1] * WI, u0 = acc[ai][1][m][0] * (WI * A8_SCALE), u1 = acc[ai][1][m][1] * (WI * A8_SCALE);
                v2u w; w.x = pk4_fp8(silu_fast(g0[0]) * u0[0], silu_fast(g0[1]) * u0[1], silu_fast(g0[2]) * u0[2], silu_fast(g0[3]) * u0[3]);
                w.y = pk4_fp8(silu_fast(g1[0]) * u1[0], silu_fast(g1[1]) * u1[1], silu_fast(g1[2]) * u1[2], silu_fast(g1[3]) * u1[3]);
                *(v2u*)rowp = w; }
    }
};
struct EpiMoeDown {
    static constexpr bool PERM = true, AFTER_DRAIN = false;
    bf16_t* O; const float* rgate; float scale;
    __device__ __forceinline__ void operator()(const f32x4 (&acc)[2][2][4][2], const Unit& u, int wr, int wc, int fr, int fq) const {
        const int row0 = u.pm * BM + wr * 64 + fr, col0 = u.pn * BM + wc * 32 + 8 * fq;
#pragma unroll
        for (int ai = 0; ai < 2; ++ai)
#pragma unroll
            for (int m = 0; m < 4; ++m) { const int row = row0 + ai * HALF + m * 16; const float sc = rgate[row] * scale; bf16_t* rowp = O + (size_t)row * DM + col0;
#pragma unroll
                for (int bj = 0; bj < 2; ++bj) { const f32x4 v0 = acc[ai][bj][m][0] * sc, v1 = acc[ai][bj][m][1] * sc;
                    u32x4 w; w.x = cvt_pk_bf16(v0[0], v0[1]); w.y = cvt_pk_bf16(v0[2], v0[3]); w.z = cvt_pk_bf16(v1[0], v1[1]); w.w = cvt_pk_bf16(v1[2], v1[3]);
                    *(u32x4*)(rowp + bj * HALF) = w; } }
    }
};

template <class Epi, class Sched, bool ALIGN_EPI = false, bool SP2 = false, bool F8 = false>
__device__ __forceinline__ void gemm_phase(PG8_LAS unsigned char* lds, const Gemm g, const Sched& S, const Epi& E, const int wid  ) {
    const int lane = lane_id(), tid = wid * 64 + lane, wr = wid >> 2, wc = wid & 3, fr = lane & 15, fq = lane >> 4;
    const int K = g.ld, nt = g.K / BK;
    unsigned voffA[2], voffB[2];
#pragma unroll
    for (int i = 0; i < 2; ++i) { int R, C; stage_rc(tid * 16 + i * 8192, R, C); const int Rb = Epi::PERM ? ((R & ~31) + perm32(R & 31)) : R;
        voffA[i] = (unsigned)(R * K + C) * 2u; voffB[i] = (unsigned)(Rb * K + C) * 2u; }
    const size_t kstep = (size_t)(BK * 2);
    const size_t hstep = (size_t)HALF * K * 2;
    const size_t tstep = 2 * hstep;
    const unsigned ldsw = (unsigned)wid * 1024u;
    const int aoff = lds_byte(wr * 64 + fr, fq * 8), boff = lds_byte(wc * 32 + fr, fq * 8);
#define PG8_SA(b, h) (((b) * 2 + (h)) * HTB)
#define PG8_SB(b, h) ((4 + (b) * 2 + (h)) * HTB)
#define PG8_STAGE(bufoff, gbase, voff) do { _Pragma("unroll") for (int _i = 0; _i < 2; ++_i) \
        __builtin_amdgcn_global_load_lds((const unsigned*)((const char*)(gbase) + (voff)[_i]), (PG8_LAS unsigned*)(lds + (bufoff) + ldsw + _i * 8192), 16, 0, 0); } while (0)
#define PG8_LD8(addr) __builtin_shufflevector(*(const PG8_LAS i32x4*)(addr), *(const PG8_LAS i32x4*)((addr) + 1024), 0, 1, 2, 3, 4, 5, 6, 7)
#define PG8_LDA(dst, dst8, b, h) do { if constexpr (F8) { _Pragma("unroll") for (int m = 0; m < 4; ++m) dst8[m] = PG8_LD8(lds + PG8_SA(b, h) + aoff + m * 2048); } \
        else { _Pragma("unroll") for (int m = 0; m < 4; ++m) _Pragma("unroll") for (int k = 0; k < 2; ++k) dst[m][k] = *(const PG8_LAS bf16x8*)(lds + PG8_SA(b, h) + aoff + m * 2048 + k * 1024); } } while (0)
#define PG8_LDB(dst, dst8, b, h) do { if constexpr (F8) { _Pragma("unroll") for (int n = 0; n < 2; ++n) dst8[n] = PG8_LD8(lds + PG8_SB(b, h) + boff + n * 2048); } \
        else { _Pragma("unroll") for (int n = 0; n < 2; ++n) _Pragma("unroll") for (int k = 0; k < 2; ++k) dst[n][k] = *(const PG8_LAS bf16x8*)(lds + PG8_SB(b, h) + boff + n * 2048 + k * 1024); } } while (0)
#define PG8_MMA(ai, bj, At, At8, Bt, Bt8) do { __builtin_amdgcn_s_setprio(1); \
        if constexpr (F8) { _Pragma("unroll") for (int m = 0; m < 4; ++m) _Pragma("unroll") for (int n = 0; n < 2; ++n) \
            asm volatile("v_mfma_scale_f32_16x16x128_f8f6f4 %0, %1, %2, %0, %3, %3 op_sel_hi:[0,0,0]" : "+v"(acc[ai][bj][m][n]) : "v"(Bt8[n]), "v"(At8[m]), "v"(sc8_)); } \
        else { _Pragma("unroll") for (int m = 0; m < 4; ++m) _Pragma("unroll") for (int n = 0; n < 2; ++n) _Pragma("unroll") for (int k = 0; k < 2; ++k) \
            acc[ai][bj][m][n] = __builtin_amdgcn_mfma_f32_16x16x32_bf16(Bt[n][k], At[m][k], acc[ai][bj][m][n], 0, 0, 0); } \
        __builtin_amdgcn_s_setprio(0); } while (0)
#define PG8_WAIT_V(n) asm volatile("s_waitcnt vmcnt(" #n ")" ::: "memory")
#define PG8_WAIT_L(n) asm volatile("s_waitcnt lgkmcnt(" #n ")" ::: "memory")
#define PG8_BAR __builtin_amdgcn_s_barrier()
#define PG8_SCHED __builtin_amdgcn_sched_barrier(0)
#define PG8_SCHED8 do { if constexpr (F8) __builtin_amdgcn_sched_barrier(0); } while (0)
    Unit cur, nxt; int ui = 0;
    if (!S.next(0, cur)) return;
    constexpr float zero_ = 0.f;
    const int sc8_ = 0x7f7f7f7f;
    f32x4 acc[2][2][4][2];
#pragma unroll
    for (int a = 0; a < 2; ++a)
#pragma unroll
        for (int b = 0; b < 2; ++b)
#pragma unroll
            for (int m = 0; m < 4; ++m)
#pragma unroll
                for (int n = 0; n < 2; ++n) acc[a][b][m][n] = (f32x4){zero_, zero_, zero_, zero_};
    bf16x8 At[4][2], B0[2][2], B1[2][2];
    i32x8 At8[4], B08[2], B18[2];
    const char* cA = (const char*)g.A + cur.kofs + (size_t)cur.pm * tstep; const char* cB = (const char*)g.Bt + cur.bofs + cur.kofs + (size_t)cur.pn * tstep;
    S.a_ready(cur);
    if constexpr (SP2) {
        PG8_STAGE(PG8_SB(0, 0), cB, voffB); PG8_STAGE(PG8_SB(0, 1), cB + hstep, voffB); PG8_STAGE(PG8_SA(0, 0), cA, voffA); PG8_STAGE(PG8_SA(0, 1), cA + hstep, voffA);
        if (wr == 1) PG8_BAR;
        PG8_WAIT_V(2); PG8_BAR;
        PG8_STAGE(PG8_SB(1, 0), cB + kstep, voffB); PG8_STAGE(PG8_SA(1, 0), cA + kstep, voffA); PG8_STAGE(PG8_SB(1, 1), cB + hstep + kstep, voffB);
        PG8_WAIT_V(6); PG8_BAR;
    } else {
        PG8_STAGE(PG8_SB(0, 0), cB, voffB); PG8_STAGE(PG8_SA(0, 0), cA, voffA); PG8_STAGE(PG8_SB(0, 1), cB + hstep, voffB); PG8_STAGE(PG8_SA(0, 1), cA + hstep, voffA);
        if (wr == 1) PG8_BAR;
        PG8_WAIT_V(4); PG8_BAR;
        PG8_STAGE(PG8_SB(1, 0), cB + kstep, voffB); PG8_STAGE(PG8_SA(1, 0), cA + kstep, voffA); PG8_STAGE(PG8_SB(1, 1), cB + hstep + kstep, voffB);
        PG8_WAIT_V(6); PG8_BAR;
    }
    for (;;) {
        const bool has_next = S.next(ui + 1, nxt);
        const char* nA = has_next ? (const char*)g.A + nxt.kofs + (size_t)nxt.pm * tstep : cA; const char* nB = has_next ? (const char*)g.Bt + nxt.bofs + nxt.kofs + (size_t)nxt.pn * tstep : cB;
#pragma clang loop unroll(disable)
        for (int t = 0; t < nt; t += 2) {
            const bool last = (t == nt - 2);
            const char* a1 = cA + (size_t)(t + 1) * kstep;
            const char* a2 = last ? nA : cA + (size_t)(t + 2) * kstep; const char* b2 = last ? nB : cB + (size_t)(t + 2) * kstep;
            const char* a3 = a2 + kstep; const char* b3 = b2 + kstep;
            if (last && has_next) S.a_ready(nxt);
            if constexpr (SP2) {
            PG8_LDB(B0, B08, 0, 0); PG8_LDB(B1, B18, 0, 1); PG8_SCHED; PG8_LDA(At, At8, 0, 0); PG8_STAGE(PG8_SA(1, 1), a1 + hstep, voffA);
            PG8_WAIT_V(8); PG8_WAIT_L(0); PG8_BAR; PG8_SCHED8; PG8_MMA(0, 0, At, At8, B0, B08); PG8_MMA(0, 1, At, At8, B1, B18); PG8_SCHED8; PG8_BAR; PG8_SCHED;
            PG8_LDA(At, At8, 0, 1); PG8_STAGE(PG8_SB(0, 0), b2, voffB); PG8_STAGE(PG8_SB(0, 1), b2 + hstep, voffB); PG8_STAGE(PG8_SA(0, 0), a2, voffA);
            PG8_WAIT_V(8); PG8_WAIT_L(0); PG8_BAR; PG8_SCHED8; PG8_MMA(1, 0, At, At8, B0, B08); PG8_MMA(1, 1, At, At8, B1, B18); PG8_SCHED8; PG8_BAR; PG8_SCHED;
            PG8_LDB(B0, B08, 1, 0); PG8_LDB(B1, B18, 1, 1); PG8_SCHED; PG8_LDA(At, At8, 1, 0); PG8_STAGE(PG8_SA(0, 1), a2 + hstep, voffA);
            PG8_WAIT_V(8); PG8_WAIT_L(0); PG8_BAR; PG8_SCHED8; PG8_MMA(0, 0, At, At8, B0, B08); PG8_MMA(0, 1, At, At8, B1, B18); PG8_SCHED8; PG8_BAR; PG8_SCHED;
            PG8_LDA(At, At8, 1, 1); PG8_STAGE(PG8_SB(1, 0), b3, voffB); PG8_STAGE(PG8_SB(1, 1), b3 + hstep, voffB); PG8_STAGE(PG8_SA(1, 0), a3, voffA);
            PG8_WAIT_V(8); PG8_WAIT_L(0); PG8_BAR; PG8_SCHED8; PG8_MMA(1, 0, At, At8, B0, B08); PG8_MMA(1, 1, At, At8, B1, B18); PG8_SCHED8; PG8_BAR; PG8_SCHED;
            } else {
            PG8_LDB(B0, B08, 0, 0); PG8_SCHED; PG8_LDA(At, At8, 0, 0); PG8_STAGE(PG8_SA(1, 1), a1 + hstep, voffA);
            PG8_WAIT_L(8); PG8_BAR; PG8_WAIT_L(0); PG8_MMA(0, 0, At, At8, B0, B08); PG8_BAR; PG8_SCHED;
            PG8_LDB(B1, B18, 0, 1); PG8_STAGE(PG8_SB(0, 0), b2, voffB);
            PG8_BAR; PG8_WAIT_L(0); PG8_MMA(0, 1, At, At8, B1, B18); PG8_BAR;
            PG8_LDA(At, At8, 0, 1); PG8_STAGE(PG8_SA(0, 0), a2, voffA);
            PG8_BAR; PG8_WAIT_L(0); PG8_MMA(1, 0, At, At8, B0, B08); PG8_BAR; PG8_SCHED;
            PG8_STAGE(PG8_SB(0, 1), b2 + hstep, voffB);
            PG8_WAIT_V(6); PG8_BAR; PG8_MMA(1, 1, At, At8, B1, B18); PG8_BAR;
            PG8_LDB(B0, B08, 1, 0); PG8_SCHED; PG8_LDA(At, At8, 1, 0); PG8_STAGE(PG8_SA(0, 1), a2 + hstep, voffA);
            PG8_WAIT_L(8); PG8_BAR; PG8_WAIT_L(0); PG8_MMA(0, 0, At, At8, B0, B08); PG8_BAR; PG8_SCHED;
            PG8_LDB(B1, B18, 1, 1); PG8_STAGE(PG8_SB(1, 0), b3, voffB);
            PG8_BAR; PG8_WAIT_L(0); PG8_MMA(0, 1, At, At8, B1, B18); PG8_BAR;
            PG8_LDA(At, At8, 1, 1); PG8_STAGE(PG8_SA(1, 0), a3, voffA);
            PG8_BAR; PG8_WAIT_L(0); PG8_MMA(1, 0, At, At8, B0, B08); PG8_BAR; PG8_SCHED;
            PG8_STAGE(PG8_SB(1, 1), b3 + hstep, voffB);
            PG8_WAIT_V(6); PG8_BAR; PG8_MMA(1, 1, At, At8, B1, B18); PG8_BAR;
            }
        }
        if constexpr (ALIGN_EPI) { if (wr == 0) PG8_BAR; }
        if constexpr (F8) asm volatile("s_nop 15\n\ts_nop 15" ::: "memory");
        if constexpr (!Epi::AFTER_DRAIN) { E(acc, cur, wr, wc, fr, fq); S.done(cur); }
        if (!has_next) break;
#pragma unroll
        for (int a = 0; a < 2; ++a)
#pragma unroll
            for (int b = 0; b < 2; ++b)
#pragma unroll
                for (int m = 0; m < 4; ++m)
#pragma unroll
                    for (int n = 0; n < 2; ++n) acc[a][b][m][n] = (f32x4){zero_, zero_, zero_, zero_};
        cur = nxt; cA = nA; cB = nB; ++ui;
        if constexpr (ALIGN_EPI) { if (wr == 1) PG8_BAR; }
    }
    PG8_WAIT_V(0);
    if constexpr (!ALIGN_EPI) { if (wr == 0) PG8_BAR; }
    PG8_BAR;
    if constexpr (Epi::AFTER_DRAIN) { E.fused(acc, cur, wr, wc, fr, fq, lds, wid, lane); S.done(cur); }
#undef PG8_SA
#undef PG8_SB
#undef PG8_STAGE
#undef PG8_LDA
#undef PG8_LDB
#undef PG8_MMA
#undef PG8_LD8
#undef PG8_WAIT_V
#undef PG8_WAIT_L
#undef PG8_BAR
#undef PG8_SCHED
#undef PG8_SCHED8
}

}

#define GAS __attribute__((address_space(1)))
#define LAS __attribute__((address_space(3)))
typedef unsigned v4u __attribute__((ext_vector_type(4)));
typedef float f32x4 __attribute__((ext_vector_type(4)));
#define LDS_WAIT() asm volatile("s_waitcnt lgkmcnt(0)" ::: "memory")
#define VM_WAIT() asm volatile("s_waitcnt vmcnt(0)" ::: "memory")

#define XB_TMO      128
#define XB_XCNT(j)  (256  + 64 * (j))
#define XB_XSUB(j)  (1280 + 64 * (j))
#define XB_XGEN(j)  (2304 + 64 * (j))
#define XB_TOP      3328
#define XB_TOPGEN   3392
#define XCD_BAR_WORDS 3456
#define XB_SPIN_CAP (1u << 18)

__device__ __forceinline__ unsigned xb_ld(unsigned* p)              { return __hip_atomic_load(p, __ATOMIC_RELAXED, __HIP_MEMORY_SCOPE_AGENT); }
__device__ __forceinline__ unsigned xb_add(unsigned* p, unsigned v) { return __hip_atomic_fetch_add(p, v, __ATOMIC_RELAXED, __HIP_MEMORY_SCOPE_AGENT); }
__device__ __forceinline__ unsigned xb_xcc_id() { return (unsigned)__builtin_amdgcn_s_getreg((3 << 11) | 20) & 0xFu; }
#define XB_SPIN(cond, bar) do { unsigned _sp = 0; while (cond) { __builtin_amdgcn_s_sleep(1); \
    if ((++_sp & 255u) == 0u) { if (xb_ld(&(bar)[XB_TMO])) break; if (_sp > XB_SPIN_CAP) { atomicAdd(&(bar)[XB_TMO], 1u); break; } } } } while (0)

struct XcdBarrier {
    unsigned* bar; unsigned x;
    volatile LAS unsigned* st;
};

__device__ __forceinline__ XcdBarrier xcd_barrier_post(unsigned* bar, volatile LAS unsigned* st, bool t0) {
    XcdBarrier b; b.bar = bar; b.x = xb_xcc_id(); b.st = st;
    if (t0) (void)xb_add(&bar[XB_XCNT(b.x)], 1u);
    return b;
}
__device__ __forceinline__ void xcd_barrier_complete(unsigned* bar, unsigned x, unsigned& nloc, unsigned& nx) {
    const unsigned G = gridDim.x * gridDim.y * gridDim.z;
    unsigned sum, cnt, mine, sp = 0u;
    for (;;) {
        sum = 0u; cnt = 0u; mine = 0u;
#pragma unroll
        for (unsigned j = 0; j < 16; ++j) { const unsigned c = xb_ld(&bar[XB_XCNT(j)]); sum += c; cnt += (c > 0u) ? 1u : 0u; mine = (j == x) ? c : mine; }
        if (sum == G) break;
        __builtin_amdgcn_s_sleep(1);
        if ((++sp & 255u) == 0u) { if (xb_ld(&bar[XB_TMO])) break; if (sp > XB_SPIN_CAP) { atomicAdd(&bar[XB_TMO], 1u); break; } }
    }
    nloc = mine > 0u ? mine : 1u; nx = cnt > 0u ? cnt : 1u;
}

__device__ __forceinline__ void xcd_barrier(const XcdBarrier& b, bool t0) {
    asm volatile("s_waitcnt vmcnt(0)" ::: "memory");
    __syncthreads();
    if (t0) {
        unsigned* bar = b.bar;
        __builtin_amdgcn_s_waitcnt(0);
        unsigned nloc = b.st[0], nx = b.st[1];
        if (nloc == 0u) { xcd_barrier_complete(bar, b.x, nloc, nx); b.st[0] = nloc; b.st[1] = nx; }
        const unsigned old = xb_add(&bar[XB_XSUB(b.x)], 1u);
        const unsigned gen = old / nloc;
        if (old + 1u == (gen + 1u) * nloc) {
            __builtin_amdgcn_fence(__ATOMIC_RELEASE, "agent");
            asm volatile("s_waitcnt vmcnt(0)" ::: "memory");
            const unsigned og = xb_add(&bar[XB_TOP], 1u);
            const unsigned tg = og / nx;
            if (og + 1u == (tg + 1u) * nx) xb_add(&bar[XB_TOPGEN], 1u);
            else XB_SPIN(xb_ld(&bar[XB_TOPGEN]) == tg, bar);
            __builtin_amdgcn_fence(__ATOMIC_ACQUIRE, "agent");
            xb_add(&bar[XB_XGEN(b.x)], 1u);
            asm volatile("s_waitcnt vmcnt(0)" ::: "memory");
        } else {
            XB_SPIN(xb_ld(&bar[XB_XGEN(b.x)]) == gen, bar);
            __builtin_amdgcn_fence(__ATOMIC_ACQUIRE, "agent");
            asm volatile("s_waitcnt vmcnt(0)" ::: "memory");
        }
    }
    __syncthreads();
}

struct XcdToken { unsigned gen, tg; int role; };
__device__ __forceinline__ XcdToken xcd_barrier_arrive(const XcdBarrier& b, bool t0) {
    XcdToken k; k.gen = 0u; k.tg = 0u; k.role = 0;
    asm volatile("s_waitcnt vmcnt(0)" ::: "memory");
    __syncthreads();
    if (t0) {
        unsigned* bar = b.bar;
        __builtin_amdgcn_s_waitcnt(0);
        unsigned nloc = b.st[0], nx = b.st[1];
        if (nloc == 0u) { xcd_barrier_complete(bar, b.x, nloc, nx); b.st[0] = nloc; b.st[1] = nx; }
        const unsigned old = xb_add(&bar[XB_XSUB(b.x)], 1u);
        k.gen = old / nloc;
        if (old + 1u == (k.gen + 1u) * nloc) {
            __builtin_amdgcn_fence(__ATOMIC_RELEASE, "agent");
            asm volatile("s_waitcnt vmcnt(0)" ::: "memory");
            const unsigned og = xb_add(&bar[XB_TOP], 1u);
            k.tg = og / nx;
            if (og + 1u == (k.tg + 1u) * nx) { xb_add(&bar[XB_TOPGEN], 1u); k.role = 2; } else k.role = 1;
        }
    }
    return k;
}
__device__ __forceinline__ void xcd_barrier_wait(const XcdBarrier& b, const XcdToken& k, bool t0) {
    if (t0) {
        unsigned* bar = b.bar;
        if (k.role) {
            if (k.role == 1) XB_SPIN(xb_ld(&bar[XB_TOPGEN]) == k.tg, bar);
            __builtin_amdgcn_fence(__ATOMIC_ACQUIRE, "agent");
            xb_add(&bar[XB_XGEN(b.x)], 1u);
            asm volatile("s_waitcnt vmcnt(0)" ::: "memory");
        } else {
            XB_SPIN(xb_ld(&bar[XB_XGEN(b.x)]) == k.gen, bar);
            __builtin_amdgcn_fence(__ATOMIC_ACQUIRE, "agent");
            asm volatile("s_waitcnt vmcnt(0)" ::: "memory");
        }
    }
    __syncthreads();
}

constexpr int RING_OFF = 0, RING_BYTES = 131072;
constexpr int MISC_OFF = 143360;
constexpr int LDS_BYTES = 147456;
constexpr int NWAVES = 8;

struct Ctx { LAS unsigned char* lds; volatile LAS unsigned* MISC; unsigned* ctl; int wave, G, gw, NGW; };

__device__ __forceinline__ void cvt_item(const float* W, int K, int N, bf16_t* WT, int mode, LAS float* scr, int item, int lane) {
    const int kblk = K / 64, nb = item / kblk, kb = item % kblk, k0 = 64 * kb, n0 = 64 * nb;
    f32x4 ld[16];
#pragma unroll
    for (int i = 0; i < 16; ++i) { const int kk = 4 * i + (lane >> 4), c4 = 4 * (lane & 15); ld[i] = __builtin_nontemporal_load((const f32x4*)(W + (size_t)(k0 + kk) * N + n0 + c4));     }
#pragma unroll
    for (int i = 0; i < 16; ++i) { const int kk = 4 * i + (lane >> 4), c4 = 4 * (lane & 15);
        LAS float* s = scr + kk * 65 + c4; s[0] = ld[i][0]; s[1] = ld[i][1]; s[2] = ld[i][2]; s[3] = ld[i][3]; }
    LDS_WAIT(); asm volatile("" ::: "memory");
    const int c = lane >> 3;
#pragma unroll
    for (int j = 0; j < 8; ++j) { const int n = (lane & 7) + 8 * j; const LAS float* s = scr + (8 * c) * 65 + n;
        v4u o; o.x = pk2(s[0 * 65], s[1 * 65]); o.y = pk2(s[2 * 65], s[3 * 65]); o.z = pk2(s[4 * 65], s[5 * 65]); o.w = pk2(s[6 * 65], s[7 * 65]);
        const int nn = n0 + n; const int drow = mode == 0 ? nn : (nn / 128) * 256 + (mode - 1) * 128 + (nn % 128);
        *(v4u*)(WT + (size_t)drow * K + k0 + 8 * c) = o; }
    LDS_WAIT(); asm volatile("" ::: "memory");
}
__device__ __forceinline__ void cvt_item8(const float* W, int K, int N, unsigned char* WT, int mode, LAS float* scr, int item, int lane) {
    const int kblk = K / 64, nb = item / kblk, kb = item % kblk, k0 = 64 * kb, n0 = 64 * nb;
    f32x4 ld[16];
#pragma unroll
    for (int i = 0; i < 16; ++i) { const int kk = 4 * i + (lane >> 4), c4 = 4 * (lane & 15); ld[i] = __builtin_nontemporal_load((const f32x4*)(W + (size_t)(k0 + kk) * N + n0 + c4));     }
#pragma unroll
    for (int i = 0; i < 16; ++i) { const int kk = 4 * i + (lane >> 4), c4 = 4 * (lane & 15);
        LAS float* s = scr + kk * 65 + c4; s[0] = ld[i][0]; s[1] = ld[i][1]; s[2] = ld[i][2]; s[3] = ld[i][3]; }
    LDS_WAIT(); asm volatile("" ::: "memory");
    const int c = lane >> 3;
#pragma unroll
    for (int j = 0; j < 8; ++j) { const int n = (lane & 7) + 8 * j; const LAS float* s = scr + (8 * c) * 65 + n;
        v2u o; o.x = pk4_fp8(s[0 * 65] * W8_SCALE, s[1 * 65] * W8_SCALE, s[2 * 65] * W8_SCALE, s[3 * 65] * W8_SCALE); o.y = pk4_fp8(s[4 * 65] * W8_SCALE, s[5 * 65] * W8_SCALE, s[6 * 65] * W8_SCALE, s[7 * 65] * W8_SCALE);
        const int nn = n0 + n; const int drow = mode == 0 ? nn : (nn / 128) * 256 + (mode - 1) * 128 + (nn % 128);
        *(v2u*)(WT + (size_t)drow * K + k0 + 8 * c) = o; }
    LDS_WAIT(); asm volatile("" ::: "memory");
}
constexpr int MOE_S_F = 16 * 44, MOE_ITEMS = 24 * MOE_S_F;
__device__ __forceinline__ void moe_cvt_item(const Params& p, int r, LAS float* scr, int lane_) {
    constexpr int S_F = MOE_S_F;
    if (r < 8 * S_F) { const int e = r / S_F; cvt_item8(p.in[I_MWG] + (size_t)e * DM * DFF, DM, DFF, (unsigned char*)(p.ws + W_MGU) + (size_t)e * 2 * DFF * DM, 1, scr, r % S_F, lane_); return; } r -= 8 * S_F;
    if (r < 8 * S_F) { const int e = r / S_F; cvt_item8(p.in[I_MWU] + (size_t)e * DM * DFF, DM, DFF, (unsigned char*)(p.ws + W_MGU) + (size_t)e * 2 * DFF * DM, 2, scr, r % S_F, lane_); return; } r -= 8 * S_F;
    { const int e = r / S_F; cvt_item8(p.in[I_MWD] + (size_t)e * DFF * DM, DFF, DM, (unsigned char*)(p.ws + W_MD) + (size_t)e * DM * DFF, 0, scr, r % S_F, lane_); }
}
#if SEAM_CVT
constexpr int SEAM_CVT_SEAMS = 17;
__device__ __forceinline__ void seam_fill(const Params& p, Ctx& F, int s) {
    if (s >= SEAM_CVT_SEAMS || (F.wave & 1) != (s & 1)) return;
    const int it = s * (F.G * 4) + (int)blockIdx.x * 4 + (F.wave >> 1);
    if (it < MOE_ITEMS) moe_cvt_item(p, it, (LAS float*)(F.lds + RING_OFF) + F.wave * (64 * 65), lane_id());
}
__device__ __forceinline__ void moe_cvt_rest(const Params& p, Ctx& F) {
    for (int it = SEAM_CVT_SEAMS * (F.G * 4) + F.gw; it < MOE_ITEMS; it += F.NGW) moe_cvt_item(p, it, (LAS float*)(F.lds + RING_OFF) + F.wave * (64 * 65), lane_id());
}
#endif
__device__ __forceinline__ void p0_prologue(const Params& p, Ctx& F) {
    const int lane_ = lane_id(), tid_ = F.wave * 64 + lane_;
    LAS float* fl = (LAS float*)(F.lds + RING_OFF);
    for (int it = blockIdx.x; it < 192; it += F.G) {
        const int l = it / 96, n = (it % 96) * 64 + lane_;
        LAS float* sv = fl;
        LAS float* red = fl + 3 * 1024;
        for (int i = tid_; i < 3 * 1024; i += 512) { const int rt = i >> 10, k = i & 1023; const float v = rt < 2 ? p.in[I_C][rt * DM + k] : p.in[I_CCTX][k]; sv[i] = siluf(v); }
        __syncthreads();
        const float* W = p.in[I_ADAW] + (size_t)l * DM * 6144 + n;
        float a0 = 0.f, a1 = 0.f, a2 = 0.f;
        for (int kb = 0; kb < 128; kb += 32) {
            float wv[32];
#pragma unroll
            for (int j = 0; j < 32; ++j) wv[j] = W[(size_t)(F.wave * 128 + kb + j) * 6144];
#pragma unroll
            for (int j = 0; j < 32; ++j) { const int k = F.wave * 128 + kb + j; a0 += sv[k] * wv[j]; a1 += sv[1024 + k] * wv[j]; a2 += sv[2048 + k] * wv[j]; }
        }
        red[(F.wave * 3 + 0) * 64 + lane_] = a0; red[(F.wave * 3 + 1) * 64 + lane_] = a1; red[(F.wave * 3 + 2) * 64 + lane_] = a2;
        __syncthreads();
        if (tid_ < 192) { const int rt = tid_ >> 6, ln = tid_ & 63; float s = 0.f;
#pragma unroll
            for (int w = 0; w < 8; ++w) s += red[(w * 3 + rt) * 64 + ln];
            const int nn = (it % 96) * 64 + ln;
            ((float*)(p.ws + WS_MODV))[(size_t)(l * 3 + rt) * 6144 + nn] = s + p.in[I_ADAB][l * 6144 + nn]; }
        __syncthreads();
    }
    LAS float* scr = (LAS float*)(F.lds + RING_OFF) + F.wave * (64 * 65);
    constexpr int S_WIN = 16 * 56, S_WOUT = 16 * 16, S_F = 16 * 44;
    constexpr int NITEMS = 2 * S_WIN + 2 * S_WOUT + 3 * S_F + (SEAM_CVT ? 0 : 24 * S_F);
    static_assert(NITEMS + (SEAM_CVT ? 24 * S_F : 0) == 21312, "items");
    for (int it = F.gw; it < NITEMS; it += F.NGW) {
        int r = it;
        if (r < 2 * S_WIN) { const int l = r / S_WIN; cvt_item(p.in[I_WIN] + (size_t)l * DM * DP, DM, DP, (bf16_t*)(p.ws + W_WIN) + (size_t)l * DP * DM, 0, scr, r % S_WIN, lane_); continue; } r -= 2 * S_WIN;
        if (r < 2 * S_WOUT) { const int l = r / S_WOUT; cvt_item(p.in[I_WOUT] + (size_t)l * DM * DM, DM, DM, (bf16_t*)(p.ws + W_WOUT) + (size_t)l * DM * DM, 0, scr, r % S_WOUT, lane_); continue; } r -= 2 * S_WOUT;
        if (r < S_F) { cvt_item(p.in[I_FWG], DM, DFF, (bf16_t*)(p.ws + W_FGU), 1, scr, r, lane_); continue; } r -= S_F;
        if (r < S_F) { cvt_item(p.in[I_FWU], DM, DFF, (bf16_t*)(p.ws + W_FGU), 2, scr, r, lane_); continue; } r -= S_F;
        if (r < S_F) { cvt_item(p.in[I_FWD], DFF, DM, (bf16_t*)(p.ws + W_FD), 0, scr, r, lane_); continue; } r -= S_F;
        moe_cvt_item(p, r, scr, lane_);
    }
}

__device__ __forceinline__ void norm_phase(const Params& p, Ctx& F, int l, int which, int nrows) {
    const int lane_ = lane_id(), tid_ = F.wave * 64 + lane_;
    const float* g = p.in[which ? I_N2G : I_N1G] + l * DM;
    for (int m = F.gw; m < nrows; m += F.NGW) {
        const float* xrow;
        if (l == 0 && which == 0) xrow = m < NL ? p.in[I_X] + (size_t)m * DM : p.in[I_CTX] + (size_t)(m - NL) * DM;
        else xrow = xr_row(p, m);
        const int rt = rowtype(m);
        const float* sh = modv(p, l, rt, which ? 3 : 0); const float* sc = modv(p, l, rt, which ? 4 : 1);
        f32x4 v[4]; float ss = 0.f;
        if (m >= NL && !(l == 0 && which == 0)) {
            const int nsl = which ? DM / 256 : DFF / 256; const float* gate = modv(p, 0, 2, which ? 2 : 5);
            const float* base = (l == 0) ? p.in[I_CTX] + (size_t)(m - NL) * DM : xrow;
            const float* part = (const float*)(p.ws + WS_PART) + (size_t)(m - NL) * DM;
#pragma unroll
            for (int j = 0; j < 4; ++j) { const int col = 256 * j + 4 * lane_; f32x4 a = {0.f, 0.f, 0.f, 0.f};
                for (int sl = 0; sl < nsl; ++sl) a += *(const f32x4*)(part + (size_t)sl * NC * DM + col);
                v[j] = *(const f32x4*)(base + col) + *(const f32x4*)(gate + col) * a;
                *(f32x4*)((float*)(p.ws + WS_XRC) + (size_t)(m - NL) * DM + col) = v[j];
                ss += (v[j][0] * v[j][0] + v[j][1] * v[j][1]) + (v[j][2] * v[j][2] + v[j][3] * v[j][3]); }
        } else
#pragma unroll
        for (int j = 0; j < 4; ++j) { v[j] = *(const f32x4*)(xrow + 256 * j + 4 * lane_); ss += (v[j][0] * v[j][0] + v[j][1] * v[j][1]) + (v[j][2] * v[j][2] + v[j][3] * v[j][3]); }
        const float r = rsqrtf(wave_sum(ss) * (1.f / DM) + EPS);
        bf16_t* hb = (bf16_t*)(p.ws + WS_HBUF) + (size_t)m * DM;
#pragma unroll
        for (int j = 0; j < 4; ++j) { const int col = 256 * j + 4 * lane_;
            const f32x4 gg = *(const f32x4*)(g + col), s4 = *(const f32x4*)(sc + col), h4 = *(const f32x4*)(sh + col);
            const f32x4 y = v[j] * r * gg * (1.f + s4) + h4;
            v2u o; o.x = pk2(y[0], y[1]); o.y = pk2(y[2], y[3]); *(v2u*)(hb + col) = o; }
    }
}


__device__ __forceinline__ void router_phase(const Params& p, Ctx& F) {
    const int lane_ = lane_id(), tid_ = F.wave * 64 + lane_;
    LAS int* lcnt = (LAS int*)(F.lds + RING_OFF);
    LAS int* gbase = lcnt + 8;
    LAS int* ent_e = lcnt + 16;
    LAS int* ent_pos = lcnt + 16 + 128;
    const float* g = p.in[I_N2G] + DM; const float* rw = p.in[I_RW];
    int* tok_e = (int*)(p.ws + WS_ROUTE); float* tok_w = (float*)(p.ws + WS_ROUTE) + 2 * NL; int* tok_pos = (int*)(p.ws + WS_ROUTE) + 4 * NL;
    f32x4 rwa[4][4], rwb[4][4];
#pragma unroll
    for (int j = 0; j < 4; ++j)
#pragma unroll
        for (int q = 0; q < 4; ++q) { const int col = 256 * j + 4 * lane_ + q; rwa[j][q] = *(const f32x4*)(rw + (size_t)col * 8); rwb[j][q] = *(const f32x4*)(rw + (size_t)col * 8 + 4); }
    const int myexp = ((lane_ >> 5) & 1) * 4 + ((lane_ >> 4) & 1) * 2 + ((lane_ >> 3) & 1);
    for (int ch = blockIdx.x; ch < NL / 64; ch += F.G) {
        if (tid_ < 8) lcnt[tid_] = 0;
        __syncthreads();
        const int rt = (ch * 64) / T;
        const float* sh = modv(p, 1, rt, 3); const float* sc = modv(p, 1, rt, 4);
        f32x4 gs[4], hs[4]; float bsum;
        { float bb[8] = {0.f, 0.f, 0.f, 0.f, 0.f, 0.f, 0.f, 0.f};
#pragma unroll
          for (int j = 0; j < 4; ++j) { const int col = 256 * j + 4 * lane_; gs[j] = *(const f32x4*)(g + col) * (1.f + *(const f32x4*)(sc + col)); hs[j] = *(const f32x4*)(sh + col);
#pragma unroll
            for (int q = 0; q < 4; ++q) { bb[0] += hs[j][q] * rwa[j][q][0]; bb[1] += hs[j][q] * rwa[j][q][1]; bb[2] += hs[j][q] * rwa[j][q][2]; bb[3] += hs[j][q] * rwa[j][q][3];
                                          bb[4] += hs[j][q] * rwb[j][q][0]; bb[5] += hs[j][q] * rwb[j][q][1]; bb[6] += hs[j][q] * rwb[j][q][2]; bb[7] += hs[j][q] * rwb[j][q][3]; } }
          float c4[4];
#pragma unroll
          for (int k = 0; k < 4; ++k) { const float keep = (lane_ & 32) ? bb[k + 4] : bb[k], give = (lane_ & 32) ? bb[k] : bb[k + 4]; c4[k] = keep + __shfl_xor(give, 32); }
          float c2[2];
#pragma unroll
          for (int k = 0; k < 2; ++k) { const float keep = (lane_ & 16) ? c4[k + 2] : c4[k], give = (lane_ & 16) ? c4[k] : c4[k + 2]; c2[k] = keep + __shfl_xor(give, 16); }
          float c1 = ((lane_ & 8) ? c2[1] : c2[0]) + __shfl_xor((lane_ & 8) ? c2[0] : c2[1], 8);
          c1 += __shfl_xor(c1, 4); c1 += __shfl_xor(c1, 2); c1 += __shfl_xor(c1, 1);
          bsum = c1 + p.in[I_RB][myexp]; }
        for (int i = 0; i < 8; ++i) {
            const int ti = F.wave * 8 + i, m = ch * 64 + ti;
            const float* xrow = p.out + (size_t)m * DM;
            f32x4 v[4]; float ss = 0.f; float aa[8] = {0.f, 0.f, 0.f, 0.f, 0.f, 0.f, 0.f, 0.f};
#pragma unroll
            for (int j = 0; j < 4; ++j) { v[j] = *(const f32x4*)(xrow + 256 * j + 4 * lane_); ss += (v[j][0] * v[j][0] + v[j][1] * v[j][1]) + (v[j][2] * v[j][2] + v[j][3] * v[j][3]); }
#pragma unroll
            for (int j = 0; j < 4; ++j) { v[j] = v[j] * gs[j];
#pragma unroll
                for (int q = 0; q < 4; ++q) { aa[0] += v[j][q] * rwa[j][q][0]; aa[1] += v[j][q] * rwa[j][q][1]; aa[2] += v[j][q] * rwa[j][q][2]; aa[3] += v[j][q] * rwa[j][q][3];
                                              aa[4] += v[j][q] * rwb[j][q][0]; aa[5] += v[j][q] * rwb[j][q][1]; aa[6] += v[j][q] * rwb[j][q][2]; aa[7] += v[j][q] * rwb[j][q][3]; } }
            float c4[4];
#pragma unroll
            for (int k = 0; k < 4; ++k) { const float keep = (lane_ & 32) ? aa[k + 4] : aa[k], give = (lane_ & 32) ? aa[k] : aa[k + 4]; c4[k] = keep + __shfl_xor(give, 32); }
            float c2[2];
#pragma unroll
            for (int k = 0; k < 2; ++k) { const float keep = (lane_ & 16) ? c4[k + 2] : c4[k], give = (lane_ & 16) ? c4[k] : c4[k + 2]; c2[k] = keep + __shfl_xor(give, 16); }
            float c1 = ((lane_ & 8) ? c2[1] : c2[0]) + __shfl_xor((lane_ & 8) ? c2[0] : c2[1], 8);
            c1 += __shfl_xor(c1, 4); c1 += __shfl_xor(c1, 2); c1 += __shfl_xor(c1, 1);
            const float r = rsqrtf(wave_sum(ss) * (1.f / DM) + EPS);
            const float mylogit = r * c1 + bsum;
#define RLF(L) __uint_as_float((unsigned)__builtin_amdgcn_readlane((int)__float_as_uint(mylogit), L))
            const float lg0 = RLF(0), lg1 = RLF(8), lg2 = RLF(16), lg3 = RLF(24), lg4 = RLF(32), lg5 = RLF(40), lg6 = RLF(48), lg7 = RLF(56);
#undef RLF
            unsigned char* hb = (unsigned char*)(p.ws + WS_HBUF) + (size_t)m * DM;
#pragma unroll
            for (int j = 0; j < 4; ++j) { const f32x4 y = v[j] * r + hs[j]; *(unsigned*)(hb + 256 * j + 4 * lane_) = pk4_fp8(y[0], y[1], y[2], y[3]); }
            int i1 = 0; float v1 = lg0;
            if (lg1 > v1) { v1 = lg1; i1 = 1; } if (lg2 > v1) { v1 = lg2; i1 = 2; } if (lg3 > v1) { v1 = lg3; i1 = 3; }
            if (lg4 > v1) { v1 = lg4; i1 = 4; } if (lg5 > v1) { v1 = lg5; i1 = 5; } if (lg6 > v1) { v1 = lg6; i1 = 6; } if (lg7 > v1) { v1 = lg7; i1 = 7; }
            int i2 = -1; float v2 = -3.4e38f;
            if (i1 != 0 && lg0 > v2) { v2 = lg0; i2 = 0; } if (i1 != 1 && lg1 > v2) { v2 = lg1; i2 = 1; } if (i1 != 2 && lg2 > v2) { v2 = lg2; i2 = 2; } if (i1 != 3 && lg3 > v2) { v2 = lg3; i2 = 3; }
            if (i1 != 4 && lg4 > v2) { v2 = lg4; i2 = 4; } if (i1 != 5 && lg5 > v2) { v2 = lg5; i2 = 5; } if (i1 != 6 && lg6 > v2) { v2 = lg6; i2 = 6; } if (i1 != 7 && lg7 > v2) { v2 = lg7; i2 = 7; }
            const float w1 = 1.f / (1.f + __expf(v2 - v1));
            if (lane_ == 0) {
                const int p1 = __hip_atomic_fetch_add(lcnt + i1, 1, __ATOMIC_RELAXED, __HIP_MEMORY_SCOPE_WORKGROUP);
                const int p2 = __hip_atomic_fetch_add(lcnt + i2, 1, __ATOMIC_RELAXED, __HIP_MEMORY_SCOPE_WORKGROUP);
                ent_e[2 * ti] = i1; ent_e[2 * ti + 1] = i2; ent_pos[2 * ti] = p1; ent_pos[2 * ti + 1] = p2;
                tok_e[2 * m] = i1; tok_e[2 * m + 1] = i2; tok_w[2 * m] = w1; tok_w[2 * m + 1] = 1.f - w1; }
        }
        __syncthreads();
        if (tid_ < 8) gbase[tid_] = (int)__hip_atomic_fetch_add(F.ctl + CW_CNT + 64 * tid_, (unsigned)lcnt[tid_], __ATOMIC_RELAXED, __HIP_MEMORY_SCOPE_AGENT);
        __syncthreads();
        if (tid_ < 128) tok_pos[ch * 128 + tid_] = gbase[ent_e[tid_]] + ent_pos[tid_];
        __syncthreads();
    }
}
__device__ __forceinline__ void moe_table(Ctx& F) {
    const int lane_ = lane_id(), tid_ = F.wave * 64 + lane_;
    volatile LAS unsigned* tb = F.MISC + 32;
    if (tid_ == 0) { unsigned acc = 0;
        for (int e = 0; e < 8; ++e) { const unsigned c = __hip_atomic_load(F.ctl + CW_CNT + 64 * e, __ATOMIC_RELAXED, __HIP_MEMORY_SCOPE_AGENT); tb[e] = acc; tb[16 + e] = c; acc += (c + 255u) / 256u * 256u; }
        tb[8] = acc; }
    __syncthreads();
}
__device__ __forceinline__ void moe_order(Ctx& F, pg8::Order& S, int nN, long estride) {
    volatile LAS unsigned* tb = F.MISC + 32;
#define RFL(x) __builtin_amdgcn_readfirstlane((int)(x))
    S.init(RFL(tb[8] / 256u), nN, F.G, (int)blockIdx.x);
    S.e1 = RFL(tb[1] / 256u); S.e2 = RFL(tb[2] / 256u); S.e3 = RFL(tb[3] / 256u); S.e4 = RFL(tb[4] / 256u); S.e5 = RFL(tb[5] / 256u); S.e6 = RFL(tb[6] / 256u); S.e7 = RFL(tb[7] / 256u);
#undef RFL
    S.estride = estride;
}
__device__ __forceinline__ void gather_phase(const Params& p, Ctx& F) {
    const int lane_ = lane_id(), tid_ = F.wave * 64 + lane_;
    moe_table(F);
    volatile LAS unsigned* tb = F.MISC + 32;
    const int* tok_e = (const int*)(p.ws + WS_ROUTE); const float* tok_w = (const float*)(p.ws + WS_ROUTE) + 2 * NL; const int* tok_pos = (const int*)(p.ws + WS_ROUTE) + 4 * NL;
    int* row_tok = (int*)(p.ws + WS_ROUTE) + 6 * NL; float* row_gate = (float*)(p.ws + WS_ROUTE) + 6 * NL + MP_MAX;
    const unsigned char* hb = (const unsigned char*)(p.ws + WS_HBUF); unsigned char* h2s = (unsigned char*)(p.ws + WS_H2S);
    for (int it = F.gw; it < 2 * NL; it += F.NGW) {
        const int t = it >> 1, e = tok_e[it], r = (int)tb[e] + tok_pos[it];
        *((v4u*)(h2s + (size_t)r * DM) + lane_) = *((const v4u*)(hb + (size_t)t * DM) + lane_);
        if (lane_ == 0) { row_tok[r] = t; row_gate[r] = tok_w[it]; }
    }
    for (int i = F.gw; i < NE * 256; i += F.NGW) {
        const int e = i >> 8, j = i & 255, r = (int)tb[e] + (int)tb[16 + e] + j;
        if (r < (int)tb[e + 1]) { const v4u z = {0u, 0u, 0u, 0u}; *((v4u*)(h2s + (size_t)r * DM) + lane_) = z; if (lane_ == 0) { row_tok[r] = -1; row_gate[r] = 0.f; } }
    }
}
__device__ __forceinline__ void combine_phase(const Params& p, Ctx& F) {
    const int lane_ = lane_id(), tid_ = F.wave * 64 + lane_;
    moe_table(F);
    volatile LAS unsigned* tb = F.MISC + 32;
    const int* tok_e = (const int*)(p.ws + WS_ROUTE); const int* tok_pos = (const int*)(p.ws + WS_ROUTE) + 4 * NL;
    const bf16_t* yb = (const bf16_t*)(p.ws + WS_YBUF);
    for (int t = F.gw; t < NL; t += F.NGW) {
        const int r0 = (int)tb[tok_e[2 * t]] + tok_pos[2 * t], r1 = (int)tb[tok_e[2 * t + 1]] + tok_pos[2 * t + 1];
        const float* g5 = modv(p, 1, t / T, 5);
        float* orow = p.out + (size_t)t * DM;
#pragma unroll
        for (int j = 0; j < 4; ++j) { const int col = 256 * j + 4 * lane_;
            const v2u a = *(const v2u*)(yb + (size_t)r0 * DM + col), b = *(const v2u*)(yb + (size_t)r1 * DM + col);
            f32x4 y; y[0] = __uint_as_float(a.x << 16) + __uint_as_float(b.x << 16); y[1] = __uint_as_float(a.x & 0xffff0000u) + __uint_as_float(b.x & 0xffff0000u);
            y[2] = __uint_as_float(a.y << 16) + __uint_as_float(b.y << 16); y[3] = __uint_as_float(a.y & 0xffff0000u) + __uint_as_float(b.y & 0xffff0000u);
            const f32x4 x = *(const f32x4*)(orow + col), gg = *(const f32x4*)(g5 + col);
            *(f32x4*)(orow + col) = x + gg * y; }
    }
}

namespace att {
#ifndef EXP_TREE
#define EXP_TREE 1
#endif
constexpr float THR = 8.f;
constexpr int KVBLK = 64;
constexpr int SHM_V = KVBLK * 128 * 2, SHM_K = KVBLK * 128 * 2;
using bf16x8 = __attribute__((ext_vector_type(8))) short;
using s16x4  = __attribute__((ext_vector_type(4))) short;
using f32x16 = __attribute__((ext_vector_type(16))) float;
using f32x8  = __attribute__((ext_vector_type(8))) float;
using u32x4  = __attribute__((ext_vector_type(4))) unsigned;
using f32x4v = __attribute__((ext_vector_type(4))) float;
#define KSWZ(row, colB) ((row) * 256 + ((colB) ^ (((row) & 7) << 4)))
#define SBAR() __builtin_amdgcn_sched_barrier(0)
__device__ __forceinline__ int crow(int r, int hi) { return (r & 3) + 8 * (r >> 2) + 4 * hi; }
__device__ __forceinline__ unsigned cvtpk(float lo, float hi) {
  unsigned r; asm volatile("v_cvt_pk_bf16_f32 %0, %1, %2" : "=v"(r) : "v"(lo), "v"(hi)); return r;
}
__device__ __forceinline__ void partialSM(f32x16& p0, f32x16& p1, float& m_reg, float& mn, float& alpha) {
  constexpr float C = 1.4426950408889634f;
  float pmax = p0[0]; for (int r = 1; r < 16; ++r) pmax = fmaxf(pmax, p0[r]); for (int r = 0; r < 16; ++r) pmax = fmaxf(pmax, p1[r]);
  { auto rr = __builtin_amdgcn_permlane32_swap(__float_as_uint(pmax), __float_as_uint(pmax), false, false);
    pmax = fmaxf(__uint_as_float(rr[0]), __uint_as_float(rr[1])); }
  if (__builtin_expect(__all(pmax - m_reg <= THR), 1)) { mn = m_reg; alpha = 1.f; }
  else { mn = fmaxf(m_reg, pmax); alpha = __builtin_amdgcn_exp2f((m_reg - mn) * C); m_reg = mn; }
  float mnC = -mn * C;
  for (int r = 0; r < 16; ++r) p0[r] = fmaf(p0[r], C, mnC); for (int r = 0; r < 16; ++r) p1[r] = fmaf(p1[r], C, mnC);
  for (int r = 0; r < 16; ++r) p0[r] = __builtin_amdgcn_exp2f(p0[r]);
}
__device__ __forceinline__ void finishSM(f32x16& p0, f32x16& p1, float alpha, float& l_reg, bf16x8& pa0, bf16x8& pa1, bf16x8& pa2, bf16x8& pa3) {
  for (int r = 0; r < 16; ++r) p1[r] = __builtin_amdgcn_exp2f(p1[r]);
  float ps = 0; for (int r = 0; r < 16; ++r) ps += p0[r]; for (int r = 0; r < 16; ++r) ps += p1[r];
  { auto rr = __builtin_amdgcn_permlane32_swap(__float_as_uint(ps), __float_as_uint(ps), false, false);
    ps = __uint_as_float(rr[0]) + __uint_as_float(rr[1]); }
  l_reg = l_reg * alpha + ps;
#define PK4(P, BASE, OUT) do { unsigned a0 = cvtpk(P[BASE + 0], P[BASE + 1]), a1 = cvtpk(P[BASE + 2], P[BASE + 3]);   \
    unsigned b0 = cvtpk(P[BASE + 4], P[BASE + 5]), b1 = cvtpk(P[BASE + 6], P[BASE + 7]);                              \
    auto r0 = __builtin_amdgcn_permlane32_swap(a0, b0, false, false); auto r1 = __builtin_amdgcn_permlane32_swap(a1, b1, false, false); \
    u32x4 w = {r0[0], r1[0], r0[1], r1[1]}; OUT = *reinterpret_cast<bf16x8*>(&w); } while (0)
  PK4(p0, 0, pa0); PK4(p0, 8, pa1); PK4(p1, 0, pa2); PK4(p1, 8, pa3);
#undef PK4
}
template <int ND0>
__device__ __forceinline__ void qkt(f32x16& p0, f32x16& p1, const LAS char* Ks, const bf16x8* qr, int r32, int hi, int dbase) {
  p0 = f32x16{}; p1 = f32x16{};
#pragma unroll
  for (int d0 = 0; d0 < ND0; ++d0) { int cb = ((dbase + d0) * 16 + hi * 8) * 2;
    bf16x8 b0 = *reinterpret_cast<const LAS bf16x8*>(Ks + KSWZ(r32, cb));
    bf16x8 b1 = *reinterpret_cast<const LAS bf16x8*>(Ks + KSWZ(32 + r32, cb));
    p0 = __builtin_amdgcn_mfma_f32_32x32x16_bf16(b0, qr[d0], p0, 0, 0, 0);
    p1 = __builtin_amdgcn_mfma_f32_32x32x16_bf16(b1, qr[d0], p1, 0, 0, 0); }
}
__device__ __forceinline__ int v_st(int k, int c) { const int kk = (k & ~0xC) | ((k & 4) << 1) | ((k & 8) >> 1); return ((kk >> 3) * 4 + (c >> 5)) * 512 + ((kk & 7) * 32 + (c & 31)) * 2; }
__device__ __forceinline__ int v_st_lin(int k, int c) { return ((k >> 3) * 4 + (c >> 5)) * 512 + ((k & 7) * 32 + (c & 31)) * 2; }
__device__ __forceinline__ int vt_off(int dv, int key) {
  const int pos = (key & ~0xC) | ((key & 4) << 1) | ((key & 8) >> 1), ch = pos >> 3;
  return dv * 128 + (((ch & 4) | ((ch & 3) ^ ((dv >> 1) & 3))) << 4) + (pos & 7) * 2;
}
__device__ __forceinline__ int v_rd_base(int lane) { return ((lane & 3) << 3) | (((lane >> 2) & 3) << 6) | (((lane >> 4) & 1) << 5) | (((lane >> 5) & 1) << 8); }
constexpr int v_rd_off(int d0, int ks, int half) { return d0 * 512 + ks * 4096 + half * 2048; }
template <int OFF> __device__ __forceinline__ s16x4 tr_read(int vb) {
  s16x4 r; asm volatile("ds_read_b64_tr_b16 %0, %1 offset:%2" : "=&v"(r) : "v"(vb), "i"(OFF) : "memory"); return r;
}
template <int D0> __device__ __forceinline__ void pv_one(f32x16& od, int vb, bf16x8 pa0, bf16x8 pa1, bf16x8 pa2, bf16x8 pa3) {
  const s16x4 l0 = tr_read<v_rd_off(D0, 0, 0)>(vb), h0 = tr_read<v_rd_off(D0, 0, 1)>(vb), l1 = tr_read<v_rd_off(D0, 1, 0)>(vb), h1 = tr_read<v_rd_off(D0, 1, 1)>(vb);
  const s16x4 l2 = tr_read<v_rd_off(D0, 2, 0)>(vb), h2 = tr_read<v_rd_off(D0, 2, 1)>(vb), l3 = tr_read<v_rd_off(D0, 3, 0)>(vb), h3 = tr_read<v_rd_off(D0, 3, 1)>(vb);
#if defined(DUMMY_TR) && DUMMY_TR
  { s16x4 dd; for (int i = 0; i < DUMMY_TR; ++i) asm volatile("ds_read_b64_tr_b16 %0, %1 offset:%2" : "=&v"(dd) : "v"(vb), "i"(v_rd_off(D0, 0, 0)) : "memory"); }
#endif
#if defined(DUMMY_MFMA) && DUMMY_MFMA
  { f32x4v dm = {0.f, 0.f, 0.f, 0.f}; for (int i = 0; i < DUMMY_MFMA; ++i) asm volatile("v_mfma_f32_16x16x32_bf16 %0, %1, %2, %0" : "+v"(dm) : "v"(pa0), "v"(pa1)); }
#endif
  asm volatile("s_waitcnt lgkmcnt(0)" ::: "memory"); SBAR();
#define PK(L, H) (bf16x8){L[0], L[1], L[2], L[3], H[0], H[1], H[2], H[3]}
  od = __builtin_amdgcn_mfma_f32_32x32x16_bf16(pa0, PK(l0, h0), od, 0, 0, 0);
  od = __builtin_amdgcn_mfma_f32_32x32x16_bf16(pa1, PK(l1, h1), od, 0, 0, 0);
  od = __builtin_amdgcn_mfma_f32_32x32x16_bf16(pa2, PK(l2, h2), od, 0, 0, 0);
  od = __builtin_amdgcn_mfma_f32_32x32x16_bf16(pa3, PK(l3, h3), od, 0, 0, 0);
#undef PK
}
__device__ __forceinline__ void pv_d0(f32x16* o, int vb, bf16x8 pa0, bf16x8 pa1, bf16x8 pa2, bf16x8 pa3) {
  pv_one<0>(o[0], vb, pa0, pa1, pa2, pa3); pv_one<1>(o[1], vb, pa0, pa1, pa2, pa3); pv_one<2>(o[2], vb, pa0, pa1, pa2, pa3); pv_one<3>(o[3], vb, pa0, pa1, pa2, pa3);
}

#ifndef DUMMY_EXP
#define DUMMY_EXP 0
#endif
#ifndef DUMMY_TR
#define DUMMY_TR 0
#endif
#ifndef DUMMY_MFMA
#define DUMMY_MFMA 0
#endif
__device__ __forceinline__ void dummy_exp(float x) { float d; for (int i = 0; i < DUMMY_EXP; ++i) asm volatile("v_exp_f32 %0, %1" : "=v"(d) : "v"(x)); }
__device__ __forceinline__ void expA(f32x16& p0) {
#pragma unroll
  for (int r = 0; r < 16; ++r) { dummy_exp(p0[r]); p0[r] = __builtin_amdgcn_exp2f(p0[r]); }
}
__device__ __forceinline__ void expB_sum_pack(f32x16& p0, f32x16& p1, float& l_reg, bf16x8& pa0, bf16x8& pa1, bf16x8& pa2, bf16x8& pa3) {
#pragma unroll
  for (int r = 0; r < 16; ++r) { dummy_exp(p1[r]); p1[r] = __builtin_amdgcn_exp2f(p1[r]); }
  float ps = 0;
#pragma unroll
  for (int r = 0; r < 16; ++r) ps += p0[r];
#pragma unroll
  for (int r = 0; r < 16; ++r) ps += p1[r];
  { auto rr = __builtin_amdgcn_permlane32_swap(__float_as_uint(ps), __float_as_uint(ps), false, false);
    ps = __uint_as_float(rr[0]) + __uint_as_float(rr[1]); }
  l_reg += ps;
#define PK4(P, BASE, OUT) do { unsigned a0 = cvtpk(P[BASE + 0], P[BASE + 1]), a1 = cvtpk(P[BASE + 2], P[BASE + 3]);   \
    unsigned b0 = cvtpk(P[BASE + 4], P[BASE + 5]), b1 = cvtpk(P[BASE + 6], P[BASE + 7]);                              \
    auto r0 = __builtin_amdgcn_permlane32_swap(a0, b0, false, false); auto r1 = __builtin_amdgcn_permlane32_swap(a1, b1, false, false); \
    u32x4 w = {r0[0], r1[0], r0[1], r1[1]}; OUT = *reinterpret_cast<bf16x8*>(&w); } while (0)
  PK4(p0, 0, pa0); PK4(p0, 8, pa1); PK4(p1, 0, pa2); PK4(p1, 8, pa3);
#undef PK4
}
__device__ __forceinline__ bf16x8 ld8(const bf16_t* p) { return *reinterpret_cast<const bf16x8*>(p); }

constexpr int TP = 132;
__device__ __forceinline__ void tile_to_rows(const f32x16 (&o)[4], LAS float* scr, int r32, int hi, float (&v)[64]) {
#pragma unroll
  for (int d0 = 0; d0 < 4; ++d0)
#pragma unroll
    for (int r = 0; r < 16; ++r) scr[crow(r, hi) * TP + 32 * d0 + r32] = o[d0][r];
  asm volatile("s_waitcnt lgkmcnt(0)" ::: "memory");
#pragma unroll
  for (int i = 0; i < 16; ++i) { const f32x4v t = *(const LAS f32x4v*)(scr + r32 * TP + 64 * hi + 4 * i); v[4 * i] = t[0]; v[4 * i + 1] = t[1]; v[4 * i + 2] = t[2]; v[4 * i + 3] = t[3]; }
}
__device__ __forceinline__ float pair_sum(float x) {
  auto rr = __builtin_amdgcn_permlane32_swap(__float_as_uint(x), __float_as_uint(x), false, false); return __uint_as_float(rr[0]) + __uint_as_float(rr[1]);
}


#define PVX_RD2(L0, H0, D0, KS) do { L0 = tr_read<v_rd_off(D0, KS, 0)>(vb); H0 = tr_read<v_rd_off(D0, KS, 1)>(vb); } while (0)
#define PVX_PK(L, H) (bf16x8){L[0], L[1], L[2], L[3], H[0], H[1], H[2], H[3]}
#define PVX_E(i) do { if (DOEXP) { pn[i] = __builtin_amdgcn_exp2f(pn[i]); psn += pn[i]; } } while (0)
#define PVX_W(n) asm volatile("s_waitcnt lgkmcnt(" #n ")" ::: "memory")
#define PVX_BLOCK(D0, E0) do { \
    PVX_W(6); SBAR(); o[D0] = __builtin_amdgcn_mfma_f32_32x32x16_bf16(pa0, PVX_PK(fl0, fh0), o[D0], 0, 0, 0); PVX_E(E0 + 0); PVX_RD2(fl0, fh0, D0 + 1, 0); SBAR(); \
    PVX_W(6); SBAR(); o[D0] = __builtin_amdgcn_mfma_f32_32x32x16_bf16(pa1, PVX_PK(fl1, fh1), o[D0], 0, 0, 0); PVX_E(E0 + 1); PVX_RD2(fl1, fh1, D0 + 1, 1); SBAR(); \
    PVX_W(6); SBAR(); o[D0] = __builtin_amdgcn_mfma_f32_32x32x16_bf16(pa2, PVX_PK(fl2, fh2), o[D0], 0, 0, 0); PVX_E(E0 + 2); PVX_RD2(fl2, fh2, D0 + 1, 2); SBAR(); \
    PVX_W(6); SBAR(); o[D0] = __builtin_amdgcn_mfma_f32_32x32x16_bf16(pa3, PVX_PK(fl3, fh3), o[D0], 0, 0, 0); PVX_E(E0 + 3); PVX_RD2(fl3, fh3, D0 + 1, 3); SBAR(); } while (0)
template <bool DOEXP>
__device__ __forceinline__ void pv_exp(f32x16* o, int vb, bf16x8 pa0, bf16x8 pa1, bf16x8 pa2, bf16x8 pa3, f32x16& pn, float& psn) {
  s16x4 fl0, fh0, fl1, fh1, fl2, fh2, fl3, fh3;
  asm volatile("s_waitcnt lgkmcnt(0)" ::: "memory");
  PVX_RD2(fl0, fh0, 0, 0); PVX_RD2(fl1, fh1, 0, 1); PVX_RD2(fl2, fh2, 0, 2); PVX_RD2(fl3, fh3, 0, 3);
  PVX_BLOCK(0, 0); PVX_BLOCK(1, 4); PVX_BLOCK(2, 8);
  PVX_W(6); SBAR(); o[3] = __builtin_amdgcn_mfma_f32_32x32x16_bf16(pa0, PVX_PK(fl0, fh0), o[3], 0, 0, 0); PVX_E(12); SBAR();
  PVX_W(4); SBAR(); o[3] = __builtin_amdgcn_mfma_f32_32x32x16_bf16(pa1, PVX_PK(fl1, fh1), o[3], 0, 0, 0); PVX_E(13); SBAR();
  PVX_W(2); SBAR(); o[3] = __builtin_amdgcn_mfma_f32_32x32x16_bf16(pa2, PVX_PK(fl2, fh2), o[3], 0, 0, 0); PVX_E(14); SBAR();
  PVX_W(0); SBAR(); o[3] = __builtin_amdgcn_mfma_f32_32x32x16_bf16(pa3, PVX_PK(fl3, fh3), o[3], 0, 0, 0); PVX_E(15); SBAR();
}
__device__ __forceinline__ void expB_sum_pack2(f32x16& p0, f32x16& p1, float ps, float& l_reg, bf16x8& pa0, bf16x8& pa1, bf16x8& pa2, bf16x8& pa3) {
#pragma unroll
  for (int r = 0; r < 16; ++r) { p1[r] = __builtin_amdgcn_exp2f(p1[r]); ps += p1[r]; }
  { auto rr = __builtin_amdgcn_permlane32_swap(__float_as_uint(ps), __float_as_uint(ps), false, false);
    ps = __uint_as_float(rr[0]) + __uint_as_float(rr[1]); }
  l_reg += ps;
#define PK4(P, BASE, OUT) do { unsigned a0 = cvtpk(P[BASE + 0], P[BASE + 1]), a1 = cvtpk(P[BASE + 2], P[BASE + 3]);   \
    unsigned b0 = cvtpk(P[BASE + 4], P[BASE + 5]), b1 = cvtpk(P[BASE + 6], P[BASE + 7]);                              \
    auto r0 = __builtin_amdgcn_permlane32_swap(a0, b0, false, false); auto r1 = __builtin_amdgcn_permlane32_swap(a1, b1, false, false); \
    u32x4 w = {r0[0], r1[0], r0[1], r1[1]}; OUT = *reinterpret_cast<bf16x8*>(&w); } while (0)
  PK4(p0, 0, pa0); PK4(p0, 8, pa1); PK4(p1, 0, pa2); PK4(p1, 8, pa3);
#undef PK4
}
__device__ __forceinline__ float exp_sum16(f32x16& p0) { float ps = 0.f;
#pragma unroll
  for (int r = 0; r < 16; ++r) { p0[r] = __builtin_amdgcn_exp2f(p0[r]); ps += p0[r]; }
  return ps; }

__device__ __forceinline__ void attn_unit(const int wid, const bf16_t* __restrict__ proj, const char* __restrict__ Kt_bh, const char* __restrict__ Vt_bh, bf16_t* __restrict__ concat, int qrow0, int NT, int h,
                                          LAS char* lds, float lam, float omli, const float* __restrict__ subln) {
  const int lane = lane_id(), tid = wid * 64 + lane, r32 = lane & 31, hi = lane >> 5, rg = wid & 3, c = wid >> 2;
  LAS char* V_lds = lds; LAS char* K_lds = lds + 4 * SHM_V;
  LAS float* li_l = (LAS float*)(lds + 4 * SHM_V + 4 * SHM_K) + wid * 64;
  float l_reg = 0; f32x16 o[4] = {}; bf16x8 qr[4];
  const bf16_t* Qw = proj + (size_t)(qrow0 + rg * 32 + r32) * DP + C_DQ + h * 128 + c * 64 + hi * 8;
#pragma unroll
  for (int d0 = 0; d0 < 4; ++d0) qr[d0] = ld8(Qw + d0 * 16);
  const int vb0 = (int)(uintptr_t)V_lds + v_rd_base(lane);
  const char* kg0 = Kt_bh + wid * 2048 + lane * 16; const char* vg0 = Vt_bh + wid * 2048 + lane * 16;
#define DMA_TILE(tile, slot) do { const size_t to_ = (size_t)(tile) * 16384; \
    __builtin_amdgcn_global_load_lds((const unsigned*)(kg0 + to_), (LAS unsigned*)(K_lds + (slot) * SHM_K + wid * 2048), 16, 0, 0); \
    __builtin_amdgcn_global_load_lds((const unsigned*)(kg0 + to_ + 1024), (LAS unsigned*)(K_lds + (slot) * SHM_K + wid * 2048 + 1024), 16, 0, 0); \
    __builtin_amdgcn_global_load_lds((const unsigned*)(vg0 + to_), (LAS unsigned*)(V_lds + (slot) * SHM_V + wid * 2048), 16, 0, 0); \
    __builtin_amdgcn_global_load_lds((const unsigned*)(vg0 + to_ + 1024), (LAS unsigned*)(V_lds + (slot) * SHM_V + wid * 2048 + 1024), 16, 0, 0); } while (0)
#define BAR() do { asm volatile("s_waitcnt vmcnt(0) lgkmcnt(0)" ::: "memory"); __builtin_amdgcn_s_barrier(); asm volatile("" ::: "memory"); } while (0)
#define STAGE(b) do { if ((b) + 3 < NT) DMA_TILE((b) + 3, ((b) + 3) & 3); } while (0)
#define STAGES(b, slot) do { if ((b) + 3 < NT) DMA_TILE((b) + 3, slot); } while (0)
#define QKT(P0, P1, t) qkt<4>(P0, P1, K_lds + ((t) & 3) * SHM_K, qr, r32, hi, 4 * c)
#define QKTS(P0, P1, slot) qkt<4>(P0, P1, K_lds + (slot) * SHM_K, qr, r32, hi, 4 * c)
#define PV(t) pv_d0(o, vb0 + ((t) & 3) * SHM_V, pa0, pa1, pa2, pa3)
  f32x16 pA0, pA1, pB0, pB1; bf16x8 pa0, pa1, pa2, pa3; float psA = 0.f, psB = 0.f;
#define PVE(t, PN, PSN) do { PSN = 0.f; pv_exp<true>(o, vb0 + ((t) & 3) * SHM_V, pa0, pa1, pa2, pa3, PN, PSN); } while (0)
#define PVES(slot, PN, PSN) do { PSN = 0.f; pv_exp<true>(o, vb0 + (slot) * SHM_V, pa0, pa1, pa2, pa3, PN, PSN); } while (0)
#define PVL(t) do { float d_ = 0.f; pv_exp<false>(o, vb0 + ((t) & 3) * SHM_V, pa0, pa1, pa2, pa3, pA0, d_); } while (0)
  DMA_TILE(0, 0); DMA_TILE(1, 1); DMA_TILE(2, 2);
  BAR();
  QKT(pA0, pA1, 0); psA = exp_sum16(pA0);
  for (int t = 0; t < NT; t += 4) {
    if (c == 0) { BAR(); STAGES(t, 3); } SBAR();
    QKTS(pB0, pB1, 1); expB_sum_pack2(pA0, pA1, psA, l_reg, pa0, pa1, pa2, pa3); SBAR();
    if (c == 1) { BAR(); STAGES(t, 3); } SBAR();
    PVES(0, pB0, psB); SBAR();
    if (c == 0) { BAR(); STAGES(t + 1, 0); } SBAR();
    QKTS(pA0, pA1, 2); expB_sum_pack2(pB0, pB1, psB, l_reg, pa0, pa1, pa2, pa3); SBAR();
    if (c == 1) { BAR(); STAGES(t + 1, 0); } SBAR();
    PVES(1, pA0, psA); SBAR();
    if (c == 0) { BAR(); STAGES(t + 2, 1); } SBAR();
    QKTS(pB0, pB1, 3); expB_sum_pack2(pA0, pA1, psA, l_reg, pa0, pa1, pa2, pa3); SBAR();
    if (c == 1) { BAR(); STAGES(t + 2, 1); } SBAR();
    PVES(2, pB0, psB); SBAR();
    if (c == 0) { BAR(); STAGES(t + 3, 2); } SBAR();
    if (t + 4 < NT) QKTS(pA0, pA1, 0);
    expB_sum_pack2(pB0, pB1, psB, l_reg, pa0, pa1, pa2, pa3); SBAR();
    if (c == 1) { BAR(); STAGES(t + 3, 2); } SBAR();
    PVES(3, pA0, psA);
    SBAR();
  }
#undef PVE
#undef PVES
#undef QKTS
#undef STAGES
#undef PVL
  if (hi == 0) li_l[r32] = l_reg; asm volatile("s_waitcnt lgkmcnt(0)" ::: "memory");
#pragma unroll
  for (int r = 0; r < 16; ++r) { const float rl = __builtin_amdgcn_rcpf(li_l[crow(r, hi)]);
#pragma unroll
    for (int d0 = 0; d0 < 4; ++d0) o[d0][r] *= rl; }
  __syncthreads();
  LAS float* xch = (LAS float*)lds + rg * 4096;
  if (c == 1) {
#pragma unroll
    for (int d0 = 0; d0 < 4; ++d0)
#pragma unroll
      for (int r = 0; r < 16; ++r) xch[(d0 * 16 + r) * 64 + lane] = o[d0][r];
  }
  __syncthreads();
  if (c == 0) {
#pragma unroll
    for (int r = 0; r < 16; ++r) { float s = 0.f;
#pragma unroll
      for (int d0 = 0; d0 < 4; ++d0) { const float d = o[d0][r] - lam * xch[(d0 * 16 + r) * 64 + lane]; o[d0][r] = d; s += d * d; }
      s += __shfl_xor(s, 1); s += __shfl_xor(s, 2); s += __shfl_xor(s, 4); s += __shfl_xor(s, 8); s += __shfl_xor(s, 16);
      const float rr = rsqrtf(s * (1.f / 128.f) + EPS) * omli;
      bf16_t* orow = concat + (size_t)(qrow0 + rg * 32 + crow(r, hi)) * DM + 512 + h * 128 + r32;
#pragma unroll
      for (int d0 = 0; d0 < 4; ++d0) orow[d0 * 32] = f2bf(o[d0][r] * rr * subln[d0 * 32 + r32]); }
  }
  __syncthreads();
#undef DMA_TILE
#undef BAR
#undef STAGE
#undef QKT
#undef PV
}


typedef float f32x2 __attribute__((ext_vector_type(2)));
__device__ __forceinline__ void exp_half(f32x16& ph, f32x2& lacc) {
#if EXP_TREE
  f32x2 e[8];
#pragma unroll
  for (int r = 0; r < 16; r += 2) { ph[r] = __builtin_amdgcn_exp2f(ph[r]); ph[r + 1] = __builtin_amdgcn_exp2f(ph[r + 1]); e[r >> 1] = f32x2{ph[r], ph[r + 1]}; }
  lacc += ((e[0] + e[1]) + (e[2] + e[3])) + ((e[4] + e[5]) + (e[6] + e[7]));
#else
#pragma unroll
  for (int r = 0; r < 16; r += 2) { ph[r] = __builtin_amdgcn_exp2f(ph[r]); ph[r + 1] = __builtin_amdgcn_exp2f(ph[r + 1]); const f32x2 e = {ph[r], ph[r + 1]}; lacc += e; }
#endif
}
__device__ __forceinline__ void pack_half(const f32x16& ph, bf16x8& x0, bf16x8& x1) {
  { u32x4 w = {cvtpk(ph[0], ph[1]), cvtpk(ph[2], ph[3]), cvtpk(ph[4], ph[5]), cvtpk(ph[6], ph[7])}; x0 = *reinterpret_cast<bf16x8*>(&w); }
  { u32x4 w = {cvtpk(ph[8], ph[9]), cvtpk(ph[10], ph[11]), cvtpk(ph[12], ph[13]), cvtpk(ph[14], ph[15])}; x1 = *reinterpret_cast<bf16x8*>(&w); }
}

template <int D0> __device__ __forceinline__ void pv2_block(f32x16& oa, f32x16& ob, int vb, s16x4& fl0, s16x4& fh0, s16x4& fl1, s16x4& fh1, s16x4& fl2, s16x4& fh2, s16x4& fl3, s16x4& fh3,
                                                           bf16x8 a0, bf16x8 a1, bf16x8 a2, bf16x8 a3, bf16x8 b0, bf16x8 b1, bf16x8 b2, bf16x8 b3) {
#define PV2_STEP(A, B, FL, FH, KS, WN) do { asm volatile("s_waitcnt lgkmcnt(" #WN ")" ::: "memory"); SBAR(); \
    oa = __builtin_amdgcn_mfma_f32_32x32x16_bf16(A, PVX_PK(FL, FH), oa, 0, 0, 0); ob = __builtin_amdgcn_mfma_f32_32x32x16_bf16(B, PVX_PK(FL, FH), ob, 0, 0, 0); \
    if (D0 < 3) { FL = tr_read<v_rd_off((D0 + 1) & 3, KS, 0)>(vb); FH = tr_read<v_rd_off((D0 + 1) & 3, KS, 1)>(vb); } SBAR(); } while (0)
  if (D0 < 3) { PV2_STEP(a0, b0, fl0, fh0, 0, 6); PV2_STEP(a1, b1, fl1, fh1, 1, 6); PV2_STEP(a2, b2, fl2, fh2, 2, 6); PV2_STEP(a3, b3, fl3, fh3, 3, 6); }
  else        { PV2_STEP(a0, b0, fl0, fh0, 0, 6); PV2_STEP(a1, b1, fl1, fh1, 1, 4); PV2_STEP(a2, b2, fl2, fh2, 2, 2); PV2_STEP(a3, b3, fl3, fh3, 3, 0); }
#undef PV2_STEP
}
__device__ __forceinline__ void attn_unit3p(const int wid, const bf16_t* __restrict__ proj, const char* __restrict__ Kt_bh, const char* __restrict__ Vt_bh, bf16_t* __restrict__ concat, int qrow0, int NT, int h,
                                            LAS char* lds, float lam, float omli, const float* __restrict__ subln) {
  const int lane = lane_id(), r32 = lane & 31, hi = lane >> 5;
  LAS char* V_lds = lds; LAS char* K_lds = lds + 2 * SHM_V; LAS char* Qw = lds + 65536 + wid * 8192;
  LAS float* li_l = (LAS float*)(lds + 131072) + wid * 64;
  f32x2 l0v = {0.f, 0.f}, l1v = {0.f, 0.f}; f32x16 o0[4] = {}, o1[4] = {};
  const int vb0 = (int)(uintptr_t)V_lds + v_rd_base(lane);
  const char* kg0 = Kt_bh + wid * 2048 + lane * 16; const char* vg0 = Vt_bh + wid * 2048 + lane * 16;
#define DMA_TILE(tile, slot) do { const size_t to_ = (size_t)(tile) * 16384; \
    __builtin_amdgcn_global_load_lds((const unsigned*)(kg0 + to_), (LAS unsigned*)(K_lds + (slot) * SHM_K + wid * 2048), 16, 0, 0); \
    __builtin_amdgcn_global_load_lds((const unsigned*)(kg0 + to_ + 1024), (LAS unsigned*)(K_lds + (slot) * SHM_K + wid * 2048 + 1024), 16, 0, 0); \
    __builtin_amdgcn_global_load_lds((const unsigned*)(vg0 + to_), (LAS unsigned*)(V_lds + (slot) * SHM_V + wid * 2048), 16, 0, 0); \
    __builtin_amdgcn_global_load_lds((const unsigned*)(vg0 + to_ + 1024), (LAS unsigned*)(V_lds + (slot) * SHM_V + wid * 2048 + 1024), 16, 0, 0); } while (0)
#define BAR() do { asm volatile("s_waitcnt vmcnt(0) lgkmcnt(0)" ::: "memory"); __builtin_amdgcn_s_barrier(); asm volatile("" ::: "memory"); } while (0)
  bf16x8 qf00, qf01, qf02, qf03, qf10, qf11, qf12, qf13;
  { const bf16_t* qg = proj + (size_t)(qrow0 + wid * 32 + r32) * DP + C_DQ + h * 128 + hi * 8;
    qf00 = ld8(qg); qf01 = ld8(qg + 16); qf02 = ld8(qg + 32); qf03 = ld8(qg + 48); qf10 = ld8(qg + 64); qf11 = ld8(qg + 80); qf12 = ld8(qg + 96); qf13 = ld8(qg + 112); }
  DMA_TILE(0, 0);
  bf16x8 a0, a1, a2, a3, b0, b1, b2, b3;
  int sw0 = KSWZ(r32, (0 * 16 + hi * 8) * 2), sw1 = KSWZ(r32, (1 * 16 + hi * 8) * 2), sw2 = KSWZ(r32, (2 * 16 + hi * 8) * 2), sw3 = KSWZ(r32, (3 * 16 + hi * 8) * 2);
  int kad0_ = (int)(uintptr_t)K_lds + sw0, kad1_ = (int)(uintptr_t)K_lds + sw1, kad2_ = (int)(uintptr_t)K_lds + sw2, kad3_ = (int)(uintptr_t)K_lds + sw3;
  asm volatile("" : "+v"(kad0_), "+v"(kad1_), "+v"(kad2_), "+v"(kad3_));
  LAS char* const kad0 = (LAS char*)(uintptr_t)kad0_; LAS char* const kad1 = (LAS char*)(uintptr_t)kad1_; LAS char* const kad2 = (LAS char*)(uintptr_t)kad2_; LAS char* const kad3 = (LAS char*)(uintptr_t)kad3_;
#define QK2(P0, P1, so, cc) do { P0 = f32x16{}; P1 = f32x16{}; _Pragma("unroll") for (int d0 = 0; d0 < 4; ++d0) { const int cb = ((4 * (cc) + d0) * 16 + hi * 8) * 2; \
    const bf16x8 ka_ = *reinterpret_cast<const LAS bf16x8*>(K_lds + (so) * SHM_K + KSWZ(r32, cb)), kb_ = *reinterpret_cast<const LAS bf16x8*>(K_lds + (so) * SHM_K + KSWZ(32 + r32, cb)); \
    const bf16x8 q_ = *reinterpret_cast<const LAS bf16x8*>(Qw + KSWZ(r32, cb)); \
    P0 = __builtin_amdgcn_mfma_f32_32x32x16_bf16(ka_, q_, P0, 0, 0, 0); P1 = __builtin_amdgcn_mfma_f32_32x32x16_bf16(kb_, q_, P1, 0, 0, 0); } } while (0)
#define QKA(PH, so, cc, koff) do { PH = f32x16{}; \
    { const bf16x8 k_ = *reinterpret_cast<const LAS bf16x8*>(kad0 + ((so) * SHM_K + (koff) * 256 + 128 * (cc))); PH = __builtin_amdgcn_mfma_f32_32x32x16_bf16(k_, (cc) ? qf10 : qf00, PH, 0, 0, 0); } \
    { const bf16x8 k_ = *reinterpret_cast<const LAS bf16x8*>(kad1 + ((so) * SHM_K + (koff) * 256 + 128 * (cc))); PH = __builtin_amdgcn_mfma_f32_32x32x16_bf16(k_, (cc) ? qf11 : qf01, PH, 0, 0, 0); } } while (0)
#define QKB(PH, so, cc, koff) do { \
    { const bf16x8 k_ = *reinterpret_cast<const LAS bf16x8*>(kad2 + ((so) * SHM_K + (koff) * 256 + 128 * (cc))); PH = __builtin_amdgcn_mfma_f32_32x32x16_bf16(k_, (cc) ? qf12 : qf02, PH, 0, 0, 0); } \
    { const bf16x8 k_ = *reinterpret_cast<const LAS bf16x8*>(kad3 + ((so) * SHM_K + (koff) * 256 + 128 * (cc))); PH = __builtin_amdgcn_mfma_f32_32x32x16_bf16(k_, (cc) ? qf13 : qf03, PH, 0, 0, 0); } } while (0)
#define QKH(PH, so, cc, koff) do { QKA(PH, so, cc, koff); QKB(PH, so, cc, koff); } while (0)
#define SGB(m, n) __builtin_amdgcn_sched_group_barrier(m, n, 0)
#define STEP(PN, so, cc, koff, PO, LV, X0, X1) do { \
    QKA(PN, so, cc, koff); exp_half(PO, LV); SGB(0x100, 2); SGB(0x8, 1); SGB(0x2, 12); SGB(0x8, 1); SGB(0x2, 12); SBAR(); asm volatile("" : "+v"(LV)); SBAR(); \
    QKB(PN, so, cc, koff); pack_half(PO, X0, X1); SGB(0x100, 2); SGB(0x8, 1); SGB(0x2, 4); SGB(0x8, 1); SGB(0x2, 4); MBAR(PN); } while (0)
#define MBAR(X) do { SBAR(); asm volatile("" : "+v"(X) :: "memory"); SBAR(); } while (0)
#define TILE(t, so) do { BAR(); if ((t) + 1 < NT) DMA_TILE((t) + 1, 1 - (so)); SBAR(); \
    { f32x16 p0, p1; \
      QKH(p0, so, 0, 0); MBAR(p0); \
      STEP(p1, so, 0, 32, p0, l0v, a0, a1); \
      STEP(p0, so, 1, 0, p1, l0v, a2, a3); \
      STEP(p1, so, 1, 32, p0, l1v, b0, b1); \
      exp_half(p1, l1v); SBAR(); asm volatile("" : "+v"(l1v)); SBAR(); pack_half(p1, b2, b3); } SBAR(); \
    { const int vb = vb0 + (so) * SHM_V; s16x4 fl0, fh0, fl1, fh1, fl2, fh2, fl3, fh3; \
      asm volatile("s_waitcnt lgkmcnt(0)" ::: "memory"); \
      PVX_RD2(fl0, fh0, 0, 0); PVX_RD2(fl1, fh1, 0, 1); PVX_RD2(fl2, fh2, 0, 2); PVX_RD2(fl3, fh3, 0, 3); \
      pv2_block<0>(o0[0], o1[0], vb, fl0, fh0, fl1, fh1, fl2, fh2, fl3, fh3, a0, a1, a2, a3, b0, b1, b2, b3); \
      pv2_block<1>(o0[1], o1[1], vb, fl0, fh0, fl1, fh1, fl2, fh2, fl3, fh3, a0, a1, a2, a3, b0, b1, b2, b3); \
      pv2_block<2>(o0[2], o1[2], vb, fl0, fh0, fl1, fh1, fl2, fh2, fl3, fh3, a0, a1, a2, a3, b0, b1, b2, b3); \
      pv2_block<3>(o0[3], o1[3], vb, fl0, fh0, fl1, fh1, fl2, fh2, fl3, fh3, a0, a1, a2, a3, b0, b1, b2, b3); } SBAR(); } while (0)
  for (int t = 0; t < NT; t += 2) { TILE(t, 0); TILE(t + 1, 1); }
  const float l0 = pair_sum(l0v[0] + l0v[1]), l1 = pair_sum(l1v[0] + l1v[1]);
  if (hi == 0) { li_l[r32] = l0; li_l[32 + r32] = l1; } asm volatile("s_waitcnt lgkmcnt(0)" ::: "memory");
#pragma unroll
  for (int r = 0; r < 16; ++r) { const float ra = __builtin_amdgcn_rcpf(li_l[crow(r, hi)]), rb = lam * __builtin_amdgcn_rcpf(li_l[32 + crow(r, hi)]);
    float s = 0.f;
#pragma unroll
    for (int d0 = 0; d0 < 4; ++d0) { const float d = o0[d0][r] * ra - o1[d0][r] * rb; o0[d0][r] = d; s += d * d; }
    s += __shfl_xor(s, 1); s += __shfl_xor(s, 2); s += __shfl_xor(s, 4); s += __shfl_xor(s, 8); s += __shfl_xor(s, 16);
    const float rr = rsqrtf(s * (1.f / 128.f) + EPS) * omli;
    bf16_t* orow = concat + (size_t)(qrow0 + wid * 32 + crow(r, hi)) * DM + 512 + h * 128 + r32;
#pragma unroll
    for (int d0 = 0; d0 < 4; ++d0) orow[d0 * 32] = f2bf(o0[d0][r] * rr * subln[d0 * 32 + r32]); }
  asm volatile("s_waitcnt vmcnt(0) lgkmcnt(0)" ::: "memory"); __syncthreads();
#undef DMA_TILE
#undef BAR
#undef QK2
#undef QKH
#undef QKA
#undef QKB
#undef TILE
#undef STEP
#undef MBAR
#undef SGB
}

#ifndef EXP_TREE
#define EXP_TREE 1
#endif
#ifndef ATT_PRIO
#define ATT_PRIO 1
#endif
template <int OFF> __device__ __forceinline__ bf16x8 ldsb128(int addr) { bf16x8 r; asm volatile("ds_read_b128 %0, %1 offset:%2" : "=&v"(r) : "v"(addr), "i"(OFF) : "memory"); return r; }
constexpr int vt_rd_off(int so, int d0, int ks) { return so * 16384 + d0 * 4096 + (ks >> 1) * 64; }
template <int SO, int D0> __device__ __forceinline__ void pvt_block(f32x16& oa, f32x16& ob, int va0, int va1, bf16x8& f0, bf16x8& f1, bf16x8& f2, bf16x8& f3,
                                                                   bf16x8 a0, bf16x8 a1, bf16x8 a2, bf16x8 a3, bf16x8 b0, bf16x8 b1, bf16x8 b2, bf16x8 b3) {
#define PVT_STEP(A, B, F, KS, WN) do { asm volatile("s_waitcnt lgkmcnt(" #WN ")" ::: "memory"); SBAR(); \
    oa = __builtin_amdgcn_mfma_f32_32x32x16_bf16(A, F, oa, 0, 0, 0); ob = __builtin_amdgcn_mfma_f32_32x32x16_bf16(B, F, ob, 0, 0, 0); \
    if (D0 < 3) F = ldsb128<vt_rd_off(SO, (D0 + 1) & 3, KS)>((KS & 1) ? va1 : va0); SBAR(); } while (0)
  if (D0 < 3) { PVT_STEP(a0, b0, f0, 0, 3); PVT_STEP(a1, b1, f1, 1, 3); PVT_STEP(a2, b2, f2, 2, 3); PVT_STEP(a3, b3, f3, 3, 3); }
  else        { PVT_STEP(a0, b0, f0, 0, 3); PVT_STEP(a1, b1, f1, 1, 2); PVT_STEP(a2, b2, f2, 2, 1); PVT_STEP(a3, b3, f3, 3, 0); }
#undef PVT_STEP
}
__device__ __forceinline__ void exp_only(f32x16& ph) {
#pragma unroll
  for (int r = 0; r < 16; ++r) ph[r] = __builtin_amdgcn_exp2f(ph[r]);
}
__device__ __forceinline__ void dot_ones(float& la, float& lb, bf16x8 x) {
  const u32x4 w = *reinterpret_cast<const u32x4*>(&x); const unsigned ones = 0x3F803F80u;
  asm volatile("v_dot2_f32_bf16 %0, %1, %2, %0" : "+v"(la) : "v"(w[0]), "v"(ones));
  asm volatile("v_dot2_f32_bf16 %0, %1, %2, %0" : "+v"(lb) : "v"(w[1]), "v"(ones));
  asm volatile("v_dot2_f32_bf16 %0, %1, %2, %0" : "+v"(la) : "v"(w[2]), "v"(ones));
  asm volatile("v_dot2_f32_bf16 %0, %1, %2, %0" : "+v"(lb) : "v"(w[3]), "v"(ones));
}
__device__ __forceinline__ void attn_unit3q(const int wid, const bf16_t* __restrict__ proj, const char* __restrict__ Kt_bh, const char* __restrict__ Vt_bh, bf16_t* __restrict__ concat, int qrow0, int NT, int h,
                                            LAS char* lds, float lam, float omli, const float* __restrict__ subln) {
  const int lane = lane_id(), r32 = lane & 31, hi = lane >> 5, rg = wid & 3, c = wid >> 2;
  LAS char* V_lds = lds; LAS char* K_lds = lds + 2 * SHM_V;
  LAS float* li_l = (LAS float*)(lds + 131072) + wid * 64;
  float l0a = 0.f, l0b = 0.f, l1a = 0.f, l1b = 0.f; f32x16 o0[4] = {}, o1[4] = {};
  int va0 = (int)(uintptr_t)V_lds + r32 * 128 + ((hi ^ ((r32 >> 1) & 3)) << 4), va1 = (int)(uintptr_t)V_lds + r32 * 128 + (((2 + hi) ^ ((r32 >> 1) & 3)) << 4);
  asm volatile("" : "+v"(va0), "+v"(va1));
  const char* kg0 = Kt_bh + wid * 2048 + lane * 16; const char* vg0 = Vt_bh + wid * 2048 + lane * 16;
#define DMA_TILE(tile, slot) do { const size_t to_ = (size_t)(tile) * 16384; \
    __builtin_amdgcn_global_load_lds((const unsigned*)(kg0 + to_), (LAS unsigned*)(K_lds + (slot) * SHM_K + wid * 2048), 16, 0, 0); \
    __builtin_amdgcn_global_load_lds((const unsigned*)(kg0 + to_ + 1024), (LAS unsigned*)(K_lds + (slot) * SHM_K + wid * 2048 + 1024), 16, 0, 0); \
    __builtin_amdgcn_global_load_lds((const unsigned*)(vg0 + to_), (LAS unsigned*)(V_lds + (slot) * SHM_V + wid * 2048), 16, 0, 0); \
    __builtin_amdgcn_global_load_lds((const unsigned*)(vg0 + to_ + 1024), (LAS unsigned*)(V_lds + (slot) * SHM_V + wid * 2048 + 1024), 16, 0, 0); } while (0)
#define BAR() do { asm volatile("s_waitcnt vmcnt(0) lgkmcnt(0)" ::: "memory"); __builtin_amdgcn_s_barrier(); asm volatile("" ::: "memory"); } while (0)
  bf16x8 qf00, qf01, qf02, qf03, qf10, qf11, qf12, qf13;
  { const bf16_t* qg = proj + (size_t)(qrow0 + rg * 64 + r32) * DP + C_DQ + h * 128 + c * 64 + hi * 8;
    qf00 = ld8(qg); qf01 = ld8(qg + 16); qf02 = ld8(qg + 32); qf03 = ld8(qg + 48); qg += (size_t)32 * DP;
    qf10 = ld8(qg); qf11 = ld8(qg + 16); qf12 = ld8(qg + 32); qf13 = ld8(qg + 48); }
  DMA_TILE(0, 0);
  bf16x8 a0, a1, a2, a3, b0, b1, b2, b3;
  int kad0_ = (int)(uintptr_t)K_lds + KSWZ(r32, (0 * 16 + hi * 8) * 2) + 128 * c, kad1_ = (int)(uintptr_t)K_lds + KSWZ(r32, (1 * 16 + hi * 8) * 2) + 128 * c;
  int kad2_ = (int)(uintptr_t)K_lds + KSWZ(r32, (2 * 16 + hi * 8) * 2) + 128 * c, kad3_ = (int)(uintptr_t)K_lds + KSWZ(r32, (3 * 16 + hi * 8) * 2) + 128 * c;
  asm volatile("" : "+v"(kad0_), "+v"(kad1_), "+v"(kad2_), "+v"(kad3_));
  LAS char* const kad0 = (LAS char*)(uintptr_t)kad0_; LAS char* const kad1 = (LAS char*)(uintptr_t)kad1_; LAS char* const kad2 = (LAS char*)(uintptr_t)kad2_; LAS char* const kad3 = (LAS char*)(uintptr_t)kad3_;
#define QKA(PH, so, rb, koff, LK) do { PH = f32x16{}; \
    { if (LK) kf0 = *reinterpret_cast<const LAS bf16x8*>(kad0 + ((so) * SHM_K + (koff) * 256)); PH = __builtin_amdgcn_mfma_f32_32x32x16_bf16(kf0, (rb) ? qf10 : qf00, PH, 0, 0, 0); } \
    { if (LK) kf1 = *reinterpret_cast<const LAS bf16x8*>(kad1 + ((so) * SHM_K + (koff) * 256)); PH = __builtin_amdgcn_mfma_f32_32x32x16_bf16(kf1, (rb) ? qf11 : qf01, PH, 0, 0, 0); } } while (0)
#define QKB(PH, so, rb, koff, LK) do { \
    { if (LK) kf2 = *reinterpret_cast<const LAS bf16x8*>(kad2 + ((so) * SHM_K + (koff) * 256)); PH = __builtin_amdgcn_mfma_f32_32x32x16_bf16(kf2, (rb) ? qf12 : qf02, PH, 0, 0, 0); } \
    { if (LK) kf3 = *reinterpret_cast<const LAS bf16x8*>(kad3 + ((so) * SHM_K + (koff) * 256)); PH = __builtin_amdgcn_mfma_f32_32x32x16_bf16(kf3, (rb) ? qf13 : qf03, PH, 0, 0, 0); } } while (0)
#define SGB(m, n) __builtin_amdgcn_sched_group_barrier(m, n, 0)
#define MBAR(X) do { SBAR(); asm volatile("" : "+v"(X) :: "memory"); SBAR(); } while (0)
#define STEP(PN, so, rb, koff, LK, PO, X0, X1) do { \
    QKA(PN, so, rb, koff, LK); exp_only(PO); if (LK) SGB(0x100, 2); SGB(0x8, 1); SGB(0x2, 8); SGB(0x8, 1); SGB(0x2, 8); SBAR(); \
    QKB(PN, so, rb, koff, LK); pack_half(PO, X0, X1); if (LK) SGB(0x100, 2); SGB(0x8, 1); SGB(0x2, 4); SGB(0x8, 1); SGB(0x2, 4); MBAR(PN); } while (0)
#define PVS(OA, OB, A, B, F, WN, so, ND0, NKS) do { asm volatile("s_waitcnt lgkmcnt(" #WN ")" ::: "memory"); SBAR(); \
    OA = __builtin_amdgcn_mfma_f32_32x32x16_bf16(A, F, OA, 0, 0, 0); OB = __builtin_amdgcn_mfma_f32_32x32x16_bf16(B, F, OB, 0, 0, 0); \
    if ((ND0) >= 0) F = ldsb128<vt_rd_off(so, (ND0) < 0 ? 0 : (ND0), NKS)>(((NKS) & 1) ? va1 : va0); SBAR(); } while (0)
#define EXQ(PH, R0) do { PH[(R0)] = __builtin_amdgcn_exp2f(PH[(R0)]); PH[(R0) + 1] = __builtin_amdgcn_exp2f(PH[(R0) + 1]); PH[(R0) + 2] = __builtin_amdgcn_exp2f(PH[(R0) + 2]); PH[(R0) + 3] = __builtin_amdgcn_exp2f(PH[(R0) + 3]); SBAR(); } while (0)
#define DOT(LA, LB, X) do { dot_ones(LA, LB, X); SBAR(); } while (0)
#define PKQ(PH, R0, X) do { u32x4 w_ = {cvtpk(PH[(R0)], PH[(R0) + 1]), cvtpk(PH[(R0) + 2], PH[(R0) + 3]), cvtpk(PH[(R0) + 4], PH[(R0) + 5]), cvtpk(PH[(R0) + 6], PH[(R0) + 7])}; X = *reinterpret_cast<bf16x8*>(&w_); SBAR(); } while (0)
#define TILE(t, so) do { BAR(); if ((t) + 1 < NT) DMA_TILE((t) + 1, 1 - (so)); SBAR(); \
    bf16x8 vf0, vf1, vf2, vf3; \
    { f32x16 p0, p1; bf16x8 kf0, kf1, kf2, kf3; \
      QKA(p0, so, 0, 0, 1); QKB(p0, so, 0, 0, 1); MBAR(p0); \
      STEP(p1, so, 1, 0, 0, p0, a0, a1); \
      STEP(p0, so, 0, 32, 1, p1, b0, b1); \
      STEP(p1, so, 1, 32, 0, p0, a2, a3); \
      SBAR(); vf0 = ldsb128<vt_rd_off(so, 0, 0)>(va0); vf1 = ldsb128<vt_rd_off(so, 0, 1)>(va1); vf2 = ldsb128<vt_rd_off(so, 1, 0)>(va0); vf3 = ldsb128<vt_rd_off(so, 1, 1)>(va1); SBAR(); \
        \
        \
      PVS(o0[0], o1[0], a0, b0, vf0, 3, so, 2, 0); EXQ(p1, 0); \
      PVS(o0[0], o1[0], a1, b1, vf1, 3, so, 2, 1); EXQ(p1, 4); \
      PVS(o0[1], o1[1], a0, b0, vf2, 3, so, 3, 0); EXQ(p1, 8); \
      PVS(o0[1], o1[1], a1, b1, vf3, 3, so, 3, 1); EXQ(p1, 12); \
      PVS(o0[2], o1[2], a0, b0, vf0, 3, so, 0, 2); PKQ(p1, 0, b2); \
      PVS(o0[2], o1[2], a1, b1, vf1, 3, so, 0, 3); PKQ(p1, 8, b3); \
      PVS(o0[3], o1[3], a0, b0, vf2, 3, so, 1, 2); DOT(l0a, l0b, a0); DOT(l1a, l1b, b0); \
      PVS(o0[3], o1[3], a1, b1, vf3, 3, so, 1, 3); DOT(l0a, l0b, a1); DOT(l1a, l1b, b1); } SBAR(); \
    { \
      PVS(o0[0], o1[0], a2, b2, vf0, 3, so, 2, 2); DOT(l0a, l0b, a2); PVS(o0[0], o1[0], a3, b3, vf1, 3, so, 2, 3); DOT(l0a, l0b, a3); \
      PVS(o0[1], o1[1], a2, b2, vf2, 3, so, 3, 2); DOT(l1a, l1b, b2); PVS(o0[1], o1[1], a3, b3, vf3, 3, so, 3, 3); DOT(l1a, l1b, b3); \
      PVS(o0[2], o1[2], a2, b2, vf0, 3, so, -1, 0); PVS(o0[2], o1[2], a3, b3, vf1, 2, so, -1, 0); \
      PVS(o0[3], o1[3], a2, b2, vf2, 1, so, -1, 0); PVS(o0[3], o1[3], a3, b3, vf3, 0, so, -1, 0); } SBAR(); } while (0)
#if ATT_PRIO
  if (wid >= 4) __builtin_amdgcn_s_setprio(1);
#endif
  for (int t = 0; t < NT; t += 2) { TILE(t, 0); TILE(t + 1, 1); }
#if ATT_PRIO
  __builtin_amdgcn_s_setprio(0);
#endif
  const float l0 = pair_sum(l0a + l0b), l1 = pair_sum(l1a + l1b);
  if (hi == 0) { li_l[r32] = l0; li_l[32 + r32] = l1; }
  asm volatile("s_waitcnt vmcnt(0) lgkmcnt(0)" ::: "memory"); __syncthreads();
  LAS float* xw = (LAS float*)(lds + (rg * 2 + c) * 16384) + lane; const LAS float* xr = (const LAS float*)(lds + (rg * 2 + (1 - c)) * 16384) + lane;
  const float sgn = c ? lam : 1.f;
#define SEND(OX, LOFF) do { _Pragma("unroll") for (int r = 0; r < 16; ++r) { const float rl = sgn * __builtin_amdgcn_rcpf(li_l[(LOFF) + crow(r, hi)]); \
    _Pragma("unroll") for (int d0 = 0; d0 < 4; ++d0) xw[(d0 * 16 + r) * 64] = OX[d0][r] * rl; } } while (0)
  if (c == 0) SEND(o1, 32); else SEND(o0, 0);
  asm volatile("s_waitcnt lgkmcnt(0)" ::: "memory"); __syncthreads();
#define FINISH(OX, LOFF, RB) do { _Pragma("unroll") for (int r = 0; r < 16; ++r) { const float rl = sgn * __builtin_amdgcn_rcpf(li_l[(LOFF) + crow(r, hi)]); float s = 0.f; \
    _Pragma("unroll") for (int d0 = 0; d0 < 4; ++d0) { const float own = OX[d0][r] * rl, oth = xr[(d0 * 16 + r) * 64]; const float d = c ? oth - own : own - oth; OX[d0][r] = d; s += d * d; } \
    s += __shfl_xor(s, 1); s += __shfl_xor(s, 2); s += __shfl_xor(s, 4); s += __shfl_xor(s, 8); s += __shfl_xor(s, 16); \
    const float rr = rsqrtf(s * (1.f / 128.f) + EPS) * omli; \
    bf16_t* orow = concat + (size_t)(qrow0 + rg * 64 + (RB) * 32 + crow(r, hi)) * DM + 512 + h * 128 + r32; \
    _Pragma("unroll") for (int d0 = 0; d0 < 4; ++d0) orow[d0 * 32] = f2bf(OX[d0][r] * rr * subln[d0 * 32 + r32]); } } while (0)
  if (c == 0) FINISH(o0, 0, 0); else FINISH(o1, 32, 1);
  asm volatile("s_waitcnt vmcnt(0) lgkmcnt(0)" ::: "memory"); __syncthreads();
#undef SEND
#undef FINISH
#undef DMA_TILE
#undef BAR
#undef QKA
#undef QKB
#undef TILE
#undef PVS
#undef EXQ
#undef DOT
#undef PKQ
#undef STEP
#undef MBAR
#undef SGB
}

__device__ __forceinline__ bf16x8 scale8(bf16x8 v, float s) {
  u32x4 w;
#pragma unroll
  for (int i = 0; i < 4; ++i) { const float a = __uint_as_float(((unsigned)(unsigned short)v[2 * i]) << 16) * s, b = __uint_as_float(((unsigned)(unsigned short)v[2 * i + 1]) << 16) * s; w[i] = cvtpk(a, b); }
  return *reinterpret_cast<bf16x8*>(&w);
}
template <int KS> __device__ __forceinline__ void trfrag_issue(int vb, s16x4& l, s16x4& h) { l = tr_read<v_rd_off(0, KS, 0)>(vb); h = tr_read<v_rd_off(0, KS, 1)>(vb); }
#define PKF(L, H) (bf16x8){L[0], L[1], L[2], L[3], H[0], H[1], H[2], H[3]}
template <int KS> __device__ __forceinline__ void cs_step(f32x16* acc, int kb, int vv) {
  s16x4 al, ah, b0l, b0h, b1l, b1h, b2l, b2h, b3l, b3h;
  trfrag_issue<KS>(kb, al, ah); trfrag_issue<KS>(vv, b0l, b0h); trfrag_issue<KS>(vv + 512, b1l, b1h); trfrag_issue<KS>(vv + 1024, b2l, b2h); trfrag_issue<KS>(vv + 1536, b3l, b3h);
  asm volatile("s_waitcnt lgkmcnt(0)" ::: "memory"); SBAR();
  const bf16x8 a = PKF(al, ah);
  acc[0] = __builtin_amdgcn_mfma_f32_32x32x16_bf16(a, PKF(b0l, b0h), acc[0], 0, 0, 0);
  acc[1] = __builtin_amdgcn_mfma_f32_32x32x16_bf16(a, PKF(b1l, b1h), acc[1], 0, 0, 0);
  acc[2] = __builtin_amdgcn_mfma_f32_32x32x16_bf16(a, PKF(b2l, b2h), acc[2], 0, 0, 0);
  acc[3] = __builtin_amdgcn_mfma_f32_32x32x16_bf16(a, PKF(b3l, b3h), acc[3], 0, 0, 0);
}
__device__ __forceinline__ void chunk_state_unit(const int wid, const bf16_t* __restrict__ proj, bf16_t* __restrict__ csf, bf16_t* __restrict__ csb, int rowbase, int h, float lgf2, float lgb2, LAS char* lds) {
  const int lane = lane_id(), tid = wid * 64 + lane, r32 = lane & 31, hi = lane >> 5;
  const int sr = tid >> 4, sc = (tid & 15) * 8;
  { bf16x8 kv[4], vv[4];
#pragma unroll
    for (int g = 0; g < 4; ++g) { const bf16_t* rp = proj + (size_t)(rowbase + 32 * g + sr) * DP + h * 128 + sc; kv[g] = ld8(rp + C_RK); vv[g] = ld8(rp + C_RV); }
#pragma unroll
    for (int g = 0; g < 4; ++g) { const int row = 32 * g + sr;
      const float wf = __builtin_amdgcn_exp2f(lgf2 * (float)(127 - row)), wb = __builtin_amdgcn_exp2f(lgb2 * (float)row);
      const int off = (row >> 6) * 16384 + v_st(row & 63, sc);
      *(LAS bf16x8*)(lds + off) = vv[g]; *(LAS bf16x8*)(lds + 32768 + off) = scale8(kv[g], wf); *(LAS bf16x8*)(lds + 65536 + off) = scale8(kv[g], wb); } }
  __syncthreads();
  const int dir = wid >> 2, ib = wid & 3;
  const int vbK = (int)(uintptr_t)(lds + 32768 + dir * 32768) + v_rd_base(lane) + ib * 512, vbV = (int)(uintptr_t)lds + v_rd_base(lane);
  f32x16 acc[4] = {};
  cs_step<0>(acc, vbK, vbV); cs_step<1>(acc, vbK, vbV); cs_step<2>(acc, vbK, vbV); cs_step<3>(acc, vbK, vbV);
  cs_step<0>(acc, vbK + 16384, vbV + 16384); cs_step<1>(acc, vbK + 16384, vbV + 16384); cs_step<2>(acc, vbK + 16384, vbV + 16384); cs_step<3>(acc, vbK + 16384, vbV + 16384);
  bf16_t* outp = (dir ? csb : csf) + r32;
#pragma unroll
  for (int r = 0; r < 16; ++r) { bf16_t* orow = outp + (size_t)(32 * ib + crow(r, hi)) * 128;
#pragma unroll
    for (int jb = 0; jb < 4; ++jb) orow[32 * jb] = f2bf(acc[jb][r]); }
  __syncthreads();
}
__device__ __forceinline__ void pack_p(const f32x16& p0, const f32x16& p1, bf16x8& pa0, bf16x8& pa1, bf16x8& pa2, bf16x8& pa3) {
#define PK4(P, BASE, OUT) do { unsigned a0 = cvtpk(P[BASE + 0], P[BASE + 1]), a1 = cvtpk(P[BASE + 2], P[BASE + 3]);   \
    unsigned b0 = cvtpk(P[BASE + 4], P[BASE + 5]), b1 = cvtpk(P[BASE + 6], P[BASE + 7]);                              \
    auto r0 = __builtin_amdgcn_permlane32_swap(a0, b0, false, false); auto r1 = __builtin_amdgcn_permlane32_swap(a1, b1, false, false); \
    u32x4 w = {r0[0], r1[0], r0[1], r1[1]}; OUT = *reinterpret_cast<bf16x8*>(&w); } while (0)
  PK4(p0, 0, pa0); PK4(p0, 8, pa1); PK4(p1, 0, pa2); PK4(p1, 8, pa3);
#undef PK4
}
__device__ __forceinline__ float decay_w(int d, float lgf2, float lgb2) {
  const float e = __builtin_amdgcn_exp2f(d < 0 ? lgf2 * (float)(-d) : lgb2 * (float)d); return d == 0 ? 2.f : e;
}
__device__ __forceinline__ void ret_out_unit(const int wid, const bf16_t* __restrict__ proj, bf16_t* __restrict__ concat, const bf16_t* __restrict__ spA, const bf16_t* __restrict__ spB, size_t dstride,
                                             int rowA, int rowB, int h, float lgf2, float lgb2, const float* __restrict__ gn, LAS char* lds) {
  const int lane = lane_id(), tid = wid * 64 + lane, r32 = lane & 31, hi = lane >> 5, rg = wid & 3, ch = wid >> 2;
  const int sr = tid >> 4, sc = (tid & 15) * 8;
  const int rowbase = ch ? rowB : rowA;
  { bf16x8 kv[8], vv[8];
#pragma unroll
    for (int c2 = 0; c2 < 2; ++c2)
#pragma unroll
      for (int g = 0; g < 4; ++g) { const bf16_t* rp = proj + (size_t)((c2 ? rowB : rowA) + 32 * g + sr) * DP + h * 128 + sc; kv[c2 * 4 + g] = ld8(rp + C_RK); vv[c2 * 4 + g] = ld8(rp + C_RV); }
#pragma unroll
    for (int c2 = 0; c2 < 2; ++c2)
#pragma unroll
      for (int g = 0; g < 4; ++g) { const int row = 32 * g + sr;
        *(LAS bf16x8*)(lds + c2 * 65536 + (row >> 6) * 16384 + KSWZ(row & 63, sc * 2)) = kv[c2 * 4 + g];
        *(LAS bf16x8*)(lds + c2 * 65536 + 32768 + (row >> 6) * 16384 + v_st(row & 63, sc)) = vv[c2 * 4 + g]; } }
  bf16x8 qr[8];
  const bf16_t* Qw = proj + (size_t)(rowbase + rg * 32 + r32) * DP + C_RQ + h * 128 + hi * 8;
#pragma unroll
  for (int d0 = 0; d0 < 8; ++d0) qr[d0] = ld8(Qw + d0 * 16);
  __syncthreads();
  const int m = rg * 32 + r32;
  LAS char* myreg = lds + ch * 65536;
  const int vb = (int)(uintptr_t)myreg + v_rd_base(lane);
  f32x16 o[4] = {}; f32x16 p0, p1; bf16x8 pa0, pa1, pa2, pa3;
#pragma unroll
  for (int kt = 0; kt < 2; ++kt) {
    qkt<8>(p0, p1, myreg + kt * 16384, qr, r32, hi, 0);
    int mm = m - 4 * hi; asm volatile("" : "+v"(mm));
#pragma unroll
    for (int r = 0; r < 16; ++r) { const int s0 = 64 * kt + (r & 3) + 8 * (r >> 2); p0[r] *= decay_w(s0 - mm, lgf2, lgb2); p1[r] *= decay_w(s0 + 32 - mm, lgf2, lgb2); }
    pack_p(p0, p1, pa0, pa1, pa2, pa3);
    pv_d0(o, vb + 32768 + kt * 16384, pa0, pa1, pa2, pa3);
  }
  __syncthreads();
  { bf16x8 sv[16];
#pragma unroll
    for (int c2 = 0; c2 < 2; ++c2)
#pragma unroll
      for (int d = 0; d < 2; ++d)
#pragma unroll
        for (int g = 0; g < 4; ++g) sv[(c2 * 2 + d) * 4 + g] = ld8((c2 ? spB : spA) + (size_t)d * dstride + (size_t)(32 * g + sr) * 128 + sc);
#pragma unroll
    for (int c2 = 0; c2 < 2; ++c2)
#pragma unroll
      for (int d = 0; d < 2; ++d)
#pragma unroll
        for (int g = 0; g < 4; ++g) { const int row = 32 * g + sr;
          *(LAS bf16x8*)(lds + c2 * 65536 + d * 32768 + (row >> 6) * 16384 + v_st(row & 63, sc)) = sv[(c2 * 2 + d) * 4 + g]; } }
  const float xf = __builtin_amdgcn_exp2f(lgf2 * (float)(m + 1)), xb = __builtin_amdgcn_exp2f(lgb2 * (float)(128 - m));
  __syncthreads();
#pragma unroll
  for (int d = 0; d < 2; ++d) { const float xs = d ? xb : xf;
#pragma unroll
    for (int sub = 0; sub < 2; ++sub) {
      const bf16x8 a0 = scale8(qr[4 * sub + 0], xs), a1 = scale8(qr[4 * sub + 1], xs), a2 = scale8(qr[4 * sub + 2], xs), a3 = scale8(qr[4 * sub + 3], xs);
      pv_d0(o, vb + d * 32768 + sub * 16384, a0, a1, a2, a3); } }
#pragma unroll
  for (int r = 0; r < 16; ++r) {
    float s = (o[0][r] + o[1][r]) + (o[2][r] + o[3][r]);
    s += __shfl_xor(s, 1); s += __shfl_xor(s, 2); s += __shfl_xor(s, 4); s += __shfl_xor(s, 8); s += __shfl_xor(s, 16);
    const float mu = s * (1.f / 128.f);
    float q = 0.f;
#pragma unroll
    for (int d0 = 0; d0 < 4; ++d0) { const float dd = o[d0][r] - mu; o[d0][r] = dd; q += dd * dd; }
    q += __shfl_xor(q, 1); q += __shfl_xor(q, 2); q += __shfl_xor(q, 4); q += __shfl_xor(q, 8); q += __shfl_xor(q, 16);
    const float rr = rsqrtf(q * (1.f / 128.f) + EPS);
    const size_t grow = (size_t)(rowbase + rg * 32 + crow(r, hi));
    const bf16_t* gp = proj + grow * DP + C_RG + h * 128 + r32; bf16_t* op = concat + grow * DM + h * 128 + r32;
#pragma unroll
    for (int d0 = 0; d0 < 4; ++d0) { const float gv = bf2f(gp[32 * d0]); op[32 * d0] = f2bf(o[d0][r] * rr * gn[32 * d0 + r32] * (gv * __builtin_amdgcn_rcpf(1.f + __builtin_amdgcn_exp2f(-1.4426950408889634f * gv)))); }
  }
  __syncthreads();
}

}


__device__ __forceinline__ float log2_sigmoid(float x) { return -log1pf(__expf(-x)) * 1.4426950408889634f; }
__device__ __forceinline__ bf16_t* cs_ptr(const Params& p, int b, int h, int dir, int j) { return (bf16_t*)(p.ws + WS_CS) + ((size_t)((b * NH + h) * 2 + dir) * 66 + j) * 16384; }
__device__ __forceinline__ void qkrope_phase(const Params& p, Ctx& F, int l) {
    const int lane = lane_id();
    float gq[8], gk[8], fr[8];
#pragma unroll
    for (int i = 0; i < 8; ++i) { gq[i] = p.in[I_QNG][l * 64 + 8 * (lane & 7) + i] * 0.18033688011112042f;
        gk[i] = p.in[I_KNG][l * 64 + 8 * (lane & 7) + i];
        fr[i] = exp2f(-(float)(8 * (lane & 1) + i) * (13.287712379549449f / 16.f)) * 0.15915494309189535f; }
    const bool lowhalf = (lane & 4) == 0;
    for (int m = F.gw; m < NR; m += F.NGW) {
        bf16_t* row = (bf16_t*)(p.ws + WS_PROJ) + (size_t)m * DP;
        v4u* qp = (v4u*)(row + C_DQ) + lane; const v4u* kp = (const v4u*)(row + C_DK) + lane;
#if FAST_ATT
        const v4u qv = *qp, kv = *kp;
#else
        const v4u qv = *qp, kv = *kp, vv = *((const v4u*)(row + C_DV) + lane);
#endif
        float q[8], k[8];
#pragma unroll
        for (int i = 0; i < 4; ++i) { q[2 * i] = __uint_as_float(qv[i] << 16); q[2 * i + 1] = __uint_as_float(qv[i] & 0xffff0000u); k[2 * i] = __uint_as_float(kv[i] << 16); k[2 * i + 1] = __uint_as_float(kv[i] & 0xffff0000u); }
        float sq = 0.f, sk = 0.f;
#pragma unroll
        for (int i = 0; i < 8; ++i) { sq += q[i] * q[i]; sk += k[i] * k[i]; }
        sq += __shfl_xor(sq, 1); sq += __shfl_xor(sq, 2); sq += __shfl_xor(sq, 4);
        sk += __shfl_xor(sk, 1); sk += __shfl_xor(sk, 2); sk += __shfl_xor(sk, 4);
        const float rq = rsqrtf(sq * (1.f / 64.f) + EPS), rk = rsqrtf(sk * (1.f / 64.f) + EPS);
#pragma unroll
        for (int i = 0; i < 8; ++i) { q[i] *= rq * gq[i]; k[i] *= rk * gk[i]; }
        if (m < NL) {
            const int t = m % T; const float pos = (float)((lane & 2) ? (t % 64) : (t / 64));
#pragma unroll
            for (int i = 0; i < 8; ++i) {
                const float rev = pos * fr[i]; const float cs = __builtin_amdgcn_cosf(rev), sn = __builtin_amdgcn_sinf(rev);
                const float oq = __shfl_xor(q[i], 4), ok = __shfl_xor(k[i], 4);
                q[i] = lowhalf ? q[i] * cs - oq * sn : q[i] * cs + oq * sn;
                k[i] = lowhalf ? k[i] * cs - ok * sn : k[i] * cs + ok * sn;
            }
        }
        v4u qo, ko;
#pragma unroll
        for (int i = 0; i < 4; ++i) { qo[i] = pk2(q[2 * i], q[2 * i + 1]); ko[i] = pk2(k[2 * i], k[2 * i + 1]); }
        *qp = qo;
        { const int bb = m < NL ? m / T : (m - NL) / TC, kidx = m < NL ? TC + (m % T) : (m - NL) % TC, tile = kidx >> 6, r = kidx & 63, hh = lane >> 4, ci = lane & 15;
          const size_t blk = ((size_t)(bb * NH + hh) * 132 + tile) * 16384;
          *(v4u*)(p.ws + WS_KT + blk + KSWZ(r, 16 * ci)) = ko;
#if FAST_ATT
          }
#else
          *(v4u*)(p.ws + WS_VT + blk + att::v_st(r, 8 * ci)) = vv; }
#endif
    }
}
__device__ __forceinline__ void scan_phase(const Params& p, Ctx& F, int l) {
    const int lane_ = lane_id(), tid_ = F.wave * 64 + lane_;
    unsigned* cs = (unsigned*)(p.ws + WS_CS);
    for (int i = blockIdx.x * (NWAVES * 64) + tid_; i < 16 * 8192; i += F.G * NWAVES * 64) {
        const int combo = i >> 13, e2 = i & 8191, dir = combo & 1, h = (combo >> 1) & 3;
        const float lg2 = log2_sigmoid(dir ? p.in[I_DECB][l * NH + h] : p.in[I_DECF][l * NH + h]);
        const float decay = exp2f(lg2 * 128.f);
        unsigned* base = cs + (size_t)combo * 66 * 8192 + e2;
        float s0 = 0.f, s1 = 0.f;
#pragma unroll 1
        for (int jj = 0; jj < 66; jj += 22) {
            unsigned tv[22];
#pragma unroll
            for (int k = 0; k < 22; ++k) { const int q = jj + k, idx = dir ? (q < 2 ? 1 - q : 67 - q) : q; tv[k] = base[(size_t)idx * 8192]; }
#pragma unroll
            for (int k = 0; k < 22; ++k) { const int q = jj + k, idx = dir ? (q < 2 ? 1 - q : 67 - q) : q;
                base[(size_t)idx * 8192] = pk2(s0, s1);
                s0 = decay * s0 + __uint_as_float(tv[k] << 16); s1 = decay * s1 + __uint_as_float(tv[k] & 0xffff0000u); }
        }
    }
}

#define IN(k) (lo <= (k) && (k) < hi)
#if SEAM_CVT
#define SEAM(k) do { if (IN(k) && IN((k) + 1)) { const bool t0_ = F.wave == 0 && lane_id() == 0; const XcdToken tk_ = xcd_barrier_arrive(bar, t0_); seam_fill(p, F, (k)); xcd_barrier_wait(bar, tk_, t0_); } } while (0)
#else
#define SEAM(k) do { if (IN(k) && IN((k) + 1)) xcd_barrier(bar, F.wave == 0 && lane_id() == 0); } while (0)
#endif
#ifndef REP_ATT
#define REP_ATT 1
#endif
#ifndef REP_RET
#define REP_RET 1
#endif
#ifndef REP_B
#define REP_B 1
#endif
#ifndef REP_H0
#define REP_H0 1
#endif
#ifndef REP_H1
#define REP_H1 1
#endif
#ifndef REP_I1
#define REP_I1 1
#endif
#ifndef REP_P0
#define REP_P0 1
#endif
#ifndef REP_CS
#define REP_CS 1
#endif
#ifndef REP_A
#define REP_A 1
#endif
#ifndef REP_I0
#define REP_I0 1
#endif
#ifndef REP_F0
#define REP_F0 1
#endif
#ifndef REP_G2
#define REP_G2 1
#endif
#ifndef REP_BAR
#define REP_BAR 0
#endif
template <int l>
__device__ __forceinline__ void layer_phases(const Params& p, Ctx& F, const XcdBarrier& bar, const int lo, const int hi) {
    constexpr int base = 1 + 9 * l;

        if (IN(base + 0)) { for (int rep_ = 0; rep_ < REP_A; ++rep_) norm_phase(p, F, l, 0, NR); for (int rep_ = 0; rep_ < REP_BAR; ++rep_) xcd_barrier(bar, F.wave == 0 && lane_id() == 0); SEAM(base + 0); }
        if (IN(base + 1)) {
            pg8::Gemm g{(const bf16_t*)(p.ws + WS_HBUF), (const bf16_t*)(p.ws + W_WIN) + (size_t)l * DP * DM, NR, DP, DM, DM};
            pg8::Order S; S.init(NR / 256, DP / 256, F.G, (int)blockIdx.x);
            pg8::EpiProj E{(bf16_t*)(p.ws + WS_PROJ), (char*)(p.ws + WS_VT)};
            { pg8::gemm_phase<pg8::EpiProj, pg8::Order, true, true>(F.lds + RING_OFF, g, S, E, F.wave); if (REP_B > 1) { pg8::gemm_phase<pg8::EpiProj, pg8::Order, true, true>(F.lds + RING_OFF, g, S, E, F.wave); } }
            SEAM(base + 1);
        }
        if (IN(base + 2)) {
            qkrope_phase(p, F, l);
            for (int rep_ = 0; rep_ < REP_CS; ++rep_)
            for (int u = blockIdx.x; u < 8 * 66; u += F.G) {
                const int bh = u & 7, j = u >> 3, b = bh >> 2, h = bh & 3;
                const int rowbase = j < 2 ? NL + b * TC + 128 * j : b * T + 128 * (j - 2);
                att::chunk_state_unit(F.wave, (const bf16_t*)(p.ws + WS_PROJ), cs_ptr(p, b, h, 0, j), cs_ptr(p, b, h, 1, j), rowbase, h,
                                      log2_sigmoid(p.in[I_DECF][l * NH + h]), log2_sigmoid(p.in[I_DECB][l * NH + h]), (LAS char*)(F.lds + RING_OFF));
            }
            SEAM(base + 2);
        }
        if (IN(base + 3)) { scan_phase(p, F, l); SEAM(base + 3); }
        if (IN(base + 4)) {
#if FAST_RET
            for (int rep_ = 0; rep_ < REP_RET; ++rep_)
            for (int u = blockIdx.x; u < (l == 0 ? 8 * 33 : 8 * 32); u += F.G) {
                const int bh = u & 7, jp = (u >> 3) + (l == 0 ? 0 : 1), b = bh >> 2, h = bh & 3;
                const int rowA = jp == 0 ? NL + b * TC : b * T + 128 * (2 * jp - 2);
                att::ret_out_unit(F.wave, (const bf16_t*)(p.ws + WS_PROJ), (bf16_t*)(p.ws + WS_CONCAT), cs_ptr(p, b, h, 0, 2 * jp), cs_ptr(p, b, h, 0, 2 * jp + 1), (size_t)66 * 16384,
                                  rowA, rowA + 128, h, log2_sigmoid(p.in[I_DECF][l * NH + h]), log2_sigmoid(p.in[I_DECB][l * NH + h]), p.in[I_GNG] + l * 512 + h * 128, (LAS char*)(F.lds + RING_OFF));
            }
#endif
#if FAST_ATT
            { const int lane_ = lane_id();
              const float s1 = wave_sum(p.in[I_LQ1][l * 64 + lane_] * p.in[I_LK1][l * 64 + lane_]), s2 = wave_sum(p.in[I_LQ2][l * 64 + lane_] * p.in[I_LK2][l * 64 + lane_]);
              const float li = lam_init_of(l), lam = __expf(s1) - __expf(s2) + li;
#if ATT_V3
              constexpr int nunits = 256 + (l == 0 ? 8 : 0);
              for (int rep_ = 0; rep_ < REP_ATT; ++rep_)
              for (int w = ((int)blockIdx.x + F.G - (8 % F.G)) % F.G; w < nunits; w += F.G) {
                  const int u = w < 256 ? ((w + 8) & 255) : w;
                  int b, h, qrow0, NT;
                  if (u < 256) { const int bh = u & 7, qb = u >> 3; b = bh >> 2; h = bh & 3; qrow0 = b * T + qb * 256; NT = (TC + T) / 64; }
                  else { const int bh = u - 256; b = bh >> 2; h = bh & 3; qrow0 = NL + b * TC; NT = TC / 64; }
                  att::ATT_UNIT(F.wave, (const bf16_t*)(p.ws + WS_PROJ), (const char*)(p.ws + WS_KT) + (size_t)(b * NH + h) * 132 * 16384, (const char*)(p.ws + WS_VT) + (size_t)(b * NH + h) * 132 * 16384, (bf16_t*)(p.ws + WS_CONCAT), qrow0, NT, h, (LAS char*)(F.lds + RING_OFF), lam, 1.f - li, p.in[I_SUBLN] + l * 128);
              }
#else
              constexpr int nunits = 512 + (l == 0 ? 16 : 0);
              for (int rep_ = 0; rep_ < REP_ATT; ++rep_)
              for (int u = blockIdx.x; u < nunits; u += F.G) {
                  int b, h, qrow0, NT;
                  if (u < 512) { const int bh = u & 7, qb = u >> 3; b = bh >> 2; h = bh & 3; qrow0 = b * T + qb * 128; NT = (TC + T) / 64; }
                  else { const int v = u - 512, bh = v & 7, blk = v >> 3; b = bh >> 2; h = bh & 3; qrow0 = NL + b * TC + blk * 128; NT = TC / 64; }
                  att::attn_unit(F.wave, (const bf16_t*)(p.ws + WS_PROJ), (const char*)(p.ws + WS_KT) + (size_t)(b * NH + h) * 132 * 16384, (const char*)(p.ws + WS_VT) + (size_t)(b * NH + h) * 132 * 16384, (bf16_t*)(p.ws + WS_CONCAT), qrow0, NT, h, (LAS char*)(F.lds + RING_OFF), lam, 1.f - li, p.in[I_SUBLN] + l * 128);
              }
#endif
            }
#endif
            SEAM(base + 4);
        }
        if (IN(base + 5)) {
            pg8::Gemm g{(const bf16_t*)(p.ws + WS_CONCAT), (const bf16_t*)(p.ws + W_WOUT) + (size_t)l * DM * DM, NR, DM, DM, DM};
            pg8::Order S; S.init(NL / 256, DM / 256, F.G, (int)blockIdx.x);
            pg8::EpiResid E{l == 0 ? p.in[I_X] : p.out, l == 0 ? p.in[I_CTX] : (const float*)(p.ws + WS_XRC), p.out, (float*)(p.ws + WS_XRC), modv(p, l, 0, 2), modv(p, l, 2, 2)};
            if (REP_F0 > 1 && l == 0) { pg8::gemm_phase<pg8::EpiResid, pg8::Order, true, true>(F.lds + RING_OFF, g, S, E, F.wave); }
            pg8::gemm_phase<pg8::EpiResid, pg8::Order, true, true>(F.lds + RING_OFF, g, S, E, F.wave);
            if constexpr (l == 0) {
                pg8::Gemm g2{(const bf16_t*)(p.ws + WS_CONCAT), (const bf16_t*)(p.ws + W_WOUT), NR, DM, 256, DM};
                pg8::SplitOrder S2; S2.init(NL / 256, 2, DM / 256, DM / 256, F.G, (int)blockIdx.x);
                pg8::EpiPartial E2{(float*)(p.ws + WS_PART), NL / 256, NC};
                pg8::gemm_phase<pg8::EpiPartial, pg8::SplitOrder, true, true>(F.lds + RING_OFF, g2, S2, E2, F.wave);
            }
            SEAM(base + 5);
        }
        if (IN(base + 6)) { if constexpr (l == 0) norm_phase(p, F, 0, 1, NR); else router_phase(p, F); SEAM(base + 6); }
        if constexpr (l == 0) {
            if (IN(8)) {
                pg8::Gemm g{(const bf16_t*)(p.ws + WS_HBUF), (const bf16_t*)(p.ws + W_FGU), NR, 2 * DFF, DM, DM};
                pg8::Order S; S.init(NR / 256, 2 * DFF / 256, F.G, (int)blockIdx.x);
                pg8::EpiSwiglu E{(bf16_t*)(p.ws + WS_ACT)};
                { pg8::gemm_phase<pg8::EpiSwiglu, pg8::Order, true, true>(F.lds + RING_OFF, g, S, E, F.wave); if (REP_H0 > 1) { pg8::gemm_phase<pg8::EpiSwiglu, pg8::Order, true, true>(F.lds + RING_OFF, g, S, E, F.wave); } }
                SEAM(8);
            }
            if (IN(9)) {
                pg8::Gemm g{(const bf16_t*)(p.ws + WS_ACT), (const bf16_t*)(p.ws + W_FD), NR, DM, DFF, DFF};
                pg8::Order S; S.init(NL / 256, DM / 256, F.G, (int)blockIdx.x);
                pg8::EpiResid E{p.out, (const float*)(p.ws + WS_XRC), p.out, (float*)(p.ws + WS_XRC), modv(p, 0, 0, 5), modv(p, 0, 2, 5)};
                if (REP_I0 > 1) { pg8::EpiResid Ed{p.out, (const float*)(p.ws + WS_XRC), (float*)(p.ws + WS_H2S), (float*)(p.ws + WS_H2S) + (size_t)NL * DM, modv(p, 0, 0, 5), modv(p, 0, 2, 5)}; pg8::gemm_phase<pg8::EpiResid, pg8::Order, true, true>(F.lds + RING_OFF, g, S, Ed, F.wave); }
                pg8::gemm_phase<pg8::EpiResid, pg8::Order, true, true>(F.lds + RING_OFF, g, S, E, F.wave);
                {
                    pg8::Gemm g2{(const bf16_t*)(p.ws + WS_ACT), (const bf16_t*)(p.ws + W_FD), NR, DM, 256, DFF};
                    pg8::SplitOrder S2; S2.init(NL / 256, 2, DM / 256, DFF / 256, F.G, (int)blockIdx.x);
                    pg8::EpiPartial E2{(float*)(p.ws + WS_PART), NL / 256, NC};
                    pg8::gemm_phase<pg8::EpiPartial, pg8::SplitOrder, true, true>(F.lds + RING_OFF, g2, S2, E2, F.wave);
                }
                SEAM(9);
            }
        } else {
            if (IN(17)) {
#if SEAM_CVT
                moe_cvt_rest(p, F);
#endif
                for (int rep_ = 0; rep_ < REP_G2; ++rep_) gather_phase(p, F); SEAM(17); }
            if (IN(18)) {
                moe_table(F);
                pg8::Gemm g{(const bf16_t*)(p.ws + WS_H2S), (const bf16_t*)(p.ws + W_MGU), MP_MAX, 2 * DFF, DM / 2, DM / 2};
                pg8::Order S; moe_order(F, S, 2 * DFF / 256, (long)2 * DFF * DM);
                pg8::EpiSwiglu8 E{(unsigned char*)(p.ws + WS_ACTS)};
                { pg8::gemm_phase<pg8::EpiSwiglu8, pg8::Order, true, true, true>(F.lds + RING_OFF, g, S, E, F.wave); if (REP_H1 > 1) { pg8::gemm_phase<pg8::EpiSwiglu8, pg8::Order, true, true, true>(F.lds + RING_OFF, g, S, E, F.wave); } }
                SEAM(18);
            }
            if (IN(19)) {
                moe_table(F);
                pg8::Gemm g{(const bf16_t*)(p.ws + WS_ACTS), (const bf16_t*)(p.ws + W_MD), MP_MAX, DM, DFF / 2, DFF / 2};
                pg8::Order S; moe_order(F, S, DM / 256, (long)DM * DFF);
                pg8::EpiMoeDown E{(bf16_t*)(p.ws + WS_YBUF), (const float*)(p.ws + WS_ROUTE) + 6 * NL + MP_MAX, 1.f / (W8_SCALE * A8_SCALE)};
                { pg8::gemm_phase<pg8::EpiMoeDown, pg8::Order, true, true, true>(F.lds + RING_OFF, g, S, E, F.wave); if (REP_I1 > 1) { pg8::gemm_phase<pg8::EpiMoeDown, pg8::Order, true, true, true>(F.lds + RING_OFF, g, S, E, F.wave); } }
                SEAM(19);
            }
            if (IN(20)) { combine_phase(p, F); }
        }
}
struct MArgs { Params p; int ph_lo, ph_hi, li, pad; };
constexpr int N_PHASES = 21;
__global__ void __launch_bounds__(NWAVES * 64, 2) mega(MArgs args) {
    extern __shared__ __attribute__((aligned(16))) unsigned char lds_raw[];
    const Params& p = args.p;
    Ctx F;
    F.lds = (LAS unsigned char*)lds_raw; F.MISC = (volatile LAS unsigned*)(F.lds + MISC_OFF);
    F.wave = __builtin_amdgcn_readfirstlane((int)threadIdx.x >> 6);
    const int lane_ = lane_id(), tid_ = F.wave * 64 + lane_;
    F.G = gridDim.x; F.gw = blockIdx.x * NWAVES + F.wave; F.NGW = F.G * NWAVES;
    F.ctl = (unsigned*)(p.ws + WS_CTL);
    for (int u = tid_; u < (LDS_BYTES - MISC_OFF) / 4; u += NWAVES * 64) ((LAS unsigned*)(F.lds + MISC_OFF))[u] = 0u;
    __syncthreads();
    XcdBarrier bar = xcd_barrier_post(F.ctl + CW_BAR + args.li * XCD_BAR_WORDS, F.MISC + 8, tid_ == 0);
    const int lo = args.ph_lo, hi = args.ph_hi;

    if (IN(0)) { for (int rep_ = 0; rep_ < REP_P0; ++rep_) { if (rep_) __syncthreads(); p0_prologue(p, F); } SEAM(0); }
    layer_phases<0>(p, F, bar, lo, hi);
    layer_phases<1>(p, F, bar, lo, hi);
#undef IN
#undef SEAM
}

#ifndef FAST_MASK
#define FAST_MASK 0x1u
#endif
static void launch_naive_e(const Params& p, int l, bool ret, bool att, hipStream_t stream) {
    const int nrows_mix = l == 0 ? NR : NL;
    if (ret) k_ret_naive<<<nrows_mix * NH / 4, 256, 0, stream>>>(p, l, nrows_mix);
    if (att) k_attn_naive<<<nrows_mix * NH / 4, 256, 0, stream>>>(p, l, nrows_mix);
}
static void launch_naive(const Params& p, int ph, hipStream_t stream) {
    const int l = ph >= 10 ? 1 : 0, rel = ph == 0 ? -1 : (ph - 1 - 9 * l);
    const int nrows_mix = l == 0 ? NR : NL;
    if (ph == 0) { k_mod<<<(2 * 3 * 6144 + 255) / 256, 256, 0, stream>>>(p); return; }
    switch (rel) {
    case 0: k_norm<<<NR / 4, 256, 0, stream>>>(p, l, 0, NR); break;
    case 1: k_gemm_proj<<<dim3(DP / 64, NR / 4), dim3(64, 4), 0, stream>>>(p, l); break;
    case 2: k_qkrope<<<NR / 4, 256, 0, stream>>>(p, l); break;
    case 3: break;
    case 4: launch_naive_e(p, l, true, true, stream); break;
    case 5: k_gemm_out<<<dim3(DM / 64, nrows_mix / 4), dim3(64, 4), 0, stream>>>(p, l); break;
    case 6: k_norm<<<nrows_mix / 4, 256, 0, stream>>>(p, l, 1, nrows_mix); break;
    case 7: if (l == 0) k_ffn_gu<<<dim3(DFF / 64, NR / 4), dim3(64, 4), 0, stream>>>(p); break;
    case 8: if (l == 0) k_ffn_down<<<dim3(DM / 64, NR / 4), dim3(64, 4), 0, stream>>>(p); else k_moe_gu<<<dim3(DFF / 64, 2 * NL / 4), dim3(64, 4), 0, stream>>>(p); break;
    case 9: k_moe_down<<<dim3(DM / 64, NL / 4), dim3(64, 4), 0, stream>>>(p); break;
    default: break;
    }
}
extern "C" void kernel_launch(void* const* d_in, const int* in_sizes, int n_in, void* d_out, int out_size, void* d_ws, size_t ws_size, hipStream_t stream) {
    static int grid = 0;
    if (grid == 0) {
        if (n_in != 28 || out_size != NL * DM || ws_size < WS_END) { fprintf(stderr, "kernel_launch: unexpected shapes (n_in %d out %d ws %zu need %zu)\n", n_in, out_size, ws_size, (size_t)WS_END); grid = -1; return; }
        int dev = 0, cus = 0, per_cu = 0;
        if (hipGetDevice(&dev) != hipSuccess || hipDeviceGetAttribute(&cus, hipDeviceAttributeMultiprocessorCount, dev) != hipSuccess) { grid = -1; return; }
        if (hipFuncSetAttribute((const void*)mega, hipFuncAttributeMaxDynamicSharedMemorySize, LDS_BYTES) != hipSuccess) { fprintf(stderr, "kernel_launch: hipFuncSetAttribute failed\n"); grid = -1; return; }
        if (hipOccupancyMaxActiveBlocksPerMultiprocessor(&per_cu, (const void*)mega, NWAVES * 64, LDS_BYTES) != hipSuccess || per_cu < 1) { fprintf(stderr, "kernel_launch: occupancy query says %d\n", per_cu); (void)hipGetLastError(); grid = -1; return; }
        grid = cus;
    }
    if (grid < 0) return;
    (void)hipMemsetAsync((char*)d_ws + WS_CTL, 0, CTL_ZERO_BYTES, stream);
    MArgs a{};
    for (int i = 0; i < 28; ++i) a.p.in[i] = (const float*)d_in[i];
    a.p.out = (float*)d_out; a.p.ws = (unsigned char*)d_ws;
    const unsigned mask = FAST_MASK;
    int li = 0, ph = 0;
    while (ph < N_PHASES) {
        if ((mask >> ph) & 1u) { int e = ph; bool cutE = false;
            while (e < N_PHASES && ((mask >> e) & 1u)) { const bool isE = (e == 5 || e == 14); ++e; if (isE && !(FAST_ATT && FAST_RET)) { cutE = true; break; } }
            a.ph_lo = ph; a.ph_hi = e; a.li = li++;
            hipLaunchKernelGGL(mega, dim3(grid), dim3(NWAVES * 64), LDS_BYTES, stream, a);
            if (cutE) launch_naive_e(a.p, e - 1 == 5 ? 0 : 1, !FAST_RET, !FAST_ATT, stream);
            ph = e; }
        else { launch_naive(a.p, ph, stream); ++ph; }
    }
}
```
